# Optimizing an MI355X kernel written in HIP

```python
import jax
import jax.numpy as jnp
from jax import lax
import numpy as np

D_MODEL = 1024
BATCH = 8
SEQ = 4096
DEPTH = 1

N_MEM = 256
EPS = 1e-6
NEG_INF = -1e30
SEL_FORCE = 1e4

R_HEADS = 4
R_DK = 128
R_DV = 256
R_CHUNK = 128
ROPE_BASE = 10000.0

NSA_HEADS = 8
NSA_GROUPS = 2
NSA_HPG = NSA_HEADS // NSA_GROUPS
NSA_DH = 128
CMP_LEN = 32
CMP_STRIDE = 16
SEL_LEN = 64
SEL_TOPK = 16
SEL_QCHUNK = 32
WINDOW = 512
WIN_QBLOCK = 128

X_HEADS = 4
X_DH = D_MODEL // X_HEADS

N_EGROUPS = 4
EXP_PER_GROUP = 8
N_EXPERTS = N_EGROUPS * EXP_PER_GROUP
EXP_TOPK = 2
D_EXPERT = 512
MOE_BLOCK = 256

RET_QK = R_HEADS * R_DK
RET_V = R_HEADS * R_DV
NSA_Q = NSA_HEADS * NSA_DH
NSA_KV = NSA_GROUPS * NSA_DH
SPLITS = (RET_QK, RET_QK, RET_V, RET_V, NSA_Q, NSA_KV, NSA_KV, NSA_KV, NSA_KV, NSA_KV, NSA_KV,
          3 * NSA_HEADS, D_MODEL, D_MODEL)
D_IN = sum(SPLITS)

kernel_name = 'hybrid_retention_nsa_hmoe_block'


def rmsnorm(x, g):
    xf = x.astype(jnp.float32)
    y = xf * lax.rsqrt(jnp.mean(xf * xf, axis=-1, keepdims=True) + EPS)
    return (y * g.astype(jnp.float32)).astype(x.dtype)


def masked_softmax(s, mask):
    p = jax.nn.softmax(jnp.where(mask, s, NEG_INF), axis=-1)
    return jnp.where(jnp.any(mask, axis=-1, keepdims=True), p, 0.0)


def rotate_pairs(t, cos, sin):
    t1 = t[..., 0::2]
    t2 = t[..., 1::2]
    out = jnp.stack([t1 * cos - t2 * sin, t1 * sin + t2 * cos], axis=-1)
    return out.reshape(t.shape).astype(t.dtype)


def retention(q, k, v, g):
    bsz, seq = q.shape[0], q.shape[1]
    nc = seq // R_CHUNK
    pos = jnp.arange(seq, dtype=jnp.float32)
    inv_freq = ROPE_BASE ** (-jnp.arange(0, R_DK, 2, dtype=jnp.float32) / R_DK)
    ang = pos[:, None] * inv_freq[None, :]
    cos = jnp.cos(ang)[None, :, None, :]
    sin = jnp.sin(ang)[None, :, None, :]
    q = rotate_pairs(q, cos, sin)
    k = rotate_pairs(k, cos, sin) * (R_DK ** -0.5)
    log_g = jnp.log1p(-jnp.exp2(-5.0 - jnp.arange(R_HEADS, dtype=jnp.float32)))
    n = jnp.arange(R_CHUNK, dtype=jnp.float32)
    diff = n[:, None] - n[None, :]
    decay = jnp.where(diff >= 0, jnp.exp(log_g[:, None, None] * jnp.maximum(diff, 0.0)), 0.0)
    qc = q.reshape(bsz, nc, R_CHUNK, R_HEADS, R_DK)
    kc = k.reshape(bsz, nc, R_CHUNK, R_HEADS, R_DK)
    vc = v.reshape(bsz, nc, R_CHUNK, R_HEADS, R_DV)
    scores = jnp.einsum('bcnhd,bcmhd->bchnm', qc, kc) * decay[None, None]
    inner = jnp.einsum('bchnm,bcmhe->bcnhe', scores, vc)
    zeta = jnp.exp(log_g[:, None] * (R_CHUNK - 1.0 - n)[None, :])
    kv = jnp.einsum('bcmhd,hm,bcmhe->bchde', kc, zeta, vc)
    chunk_decay = jnp.exp(log_g * R_CHUNK).astype(kv.dtype)

    def step(state, kv_c):
        return state * chunk_decay[None, :, None, None] + kv_c, state

    _, prev = lax.scan(step, jnp.zeros((bsz, R_HEADS, R_DK, R_DV), kv.dtype), jnp.moveaxis(kv, 1, 0))
    prev = jnp.moveaxis(prev, 0, 1)
    xi = jnp.exp(log_g[:, None] * (n + 1.0)[None, :])
    cross = jnp.einsum('bcnhd,bchde->bcnhe', qc, prev) * xi.T[None, None, :, :, None]
    o = (inner + cross).reshape(bsz, seq, R_HEADS, R_DV).astype(jnp.float32)
    o = o * lax.rsqrt(jnp.mean(o * o, axis=-1, keepdims=True) + EPS)
    return jax.nn.silu(g) * o.reshape(bsz, seq, RET_V).astype(g.dtype)


def compress_blocks(kv, pe, w1, w2):
    seq = kv.shape[1]
    ncmp = (seq - CMP_LEN) // CMP_STRIDE + 1
    idx = jnp.arange(ncmp)[:, None] * CMP_STRIDE + jnp.arange(CMP_LEN)[None, :]
    blocks = kv[:, idx] + pe[None, None, :, None, :]
    hid = jax.nn.gelu(jnp.einsum('bnlgd,lde->bnge', blocks, w1))
    return jnp.einsum('bnge,ef->bngf', hid, w2)


def gather_blocks(blocks, idx):
    return jax.vmap(jax.vmap(lambda blk, ix: blk[ix]))(blocks, idx)


def nsa(q, k_c, v_c, k_s, v_s, k_w, v_w, gate_logits, pe_k, w1_k, w2_k, pe_v, w1_v, w2_v):
    bsz, seq = q.shape[0], q.shape[1]
    scale = NSA_DH ** -0.5
    qg = q.reshape(bsz, seq, NSA_GROUPS, NSA_HPG, NSA_DH)
    shp = (bsz, seq, NSA_GROUPS, NSA_DH)
    k_c, v_c, k_s, v_s, k_w, v_w = [a.reshape(shp) for a in (k_c, v_c, k_s, v_s, k_w, v_w)]
    t = jnp.arange(seq)

    kcmp = compress_blocks(k_c, pe_k, w1_k, w2_k)
    vcmp = compress_blocks(v_c, pe_v, w1_v, w2_v)
    ncmp = kcmp.shape[1]
    cstart = jnp.arange(ncmp) * CMP_STRIDE
    cmask = (cstart + CMP_LEN - 1)[None, :] <= t[:, None]
    s_c = jnp.einsum('bsghd,bngd->bghsn', qg, kcmp).astype(jnp.float32) * scale
    p_c = masked_softmax(s_c, cmask)
    o_cmp = jnp.einsum('bghsn,bngd->bsghd', p_c.astype(q.dtype), vcmp)

    nb = seq // SEL_LEN
    jstart = jnp.arange(nb) * SEL_LEN
    overlap = ((cstart[:, None] < jstart[None, :] + SEL_LEN) &
               (cstart[:, None] + CMP_LEN > jstart[None, :])).astype(jnp.float32)
    imp = jnp.einsum('bghsn,nj->bgsj', p_c, overlap)
    tb = t // SEL_LEN
    jj = jnp.arange(nb)
    forced = (jj[None, :] == 0) | (jj[None, :] == tb[:, None]) | (jj[None, :] == tb[:, None] - 1)
    future = jj[None, :] > tb[:, None]
    imp = jnp.where(future, -SEL_FORCE, jnp.where(forced, SEL_FORCE, imp))
    k_sel = min(SEL_TOPK, nb)
    _, sel_idx = lax.top_k(imp, k_sel)

    ksb = k_s.reshape(bsz, nb, SEL_LEN, NSA_GROUPS, NSA_DH).transpose(0, 3, 1, 2, 4)
    vsb = v_s.reshape(bsz, nb, SEL_LEN, NSA_GROUPS, NSA_DH).transpose(0, 3, 1, 2, 4)
    nqc = seq // SEL_QCHUNK
    q_chunks = jnp.moveaxis(qg.reshape(bsz, nqc, SEL_QCHUNK, NSA_GROUPS, NSA_HPG, NSA_DH), 1, 0)
    idx_chunks = jnp.moveaxis(sel_idx.reshape(bsz, NSA_GROUPS, nqc, SEL_QCHUNK, k_sel), 2, 0)
    q_starts = jnp.arange(nqc) * SEL_QCHUNK

    def sel_body(args):
        qc, ix, st = args
        kg = gather_blocks(ksb, ix)
        vg = gather_blocks(vsb, ix)
        s = jnp.einsum('bqghd,bgqnld->bghqnl', qc, kg).astype(jnp.float32) * scale
        kpos = ix[..., None] * SEL_LEN + jnp.arange(SEL_LEN)
        tq = st + jnp.arange(SEL_QCHUNK)
        m = (kpos <= tq[None, None, :, None, None])[:, :, None]
        s = jnp.where(m, s, NEG_INF).reshape(bsz, NSA_GROUPS, NSA_HPG, SEL_QCHUNK, k_sel * SEL_LEN)
        p = jax.nn.softmax(s, axis=-1).reshape(bsz, NSA_GROUPS, NSA_HPG, SEL_QCHUNK, k_sel, SEL_LEN)
        return jnp.einsum('bghqnl,bgqnld->bqghd', p.astype(qc.dtype), vg)

    o_sel = lax.map(sel_body, (q_chunks, idx_chunks, q_starts))
    o_sel = jnp.moveaxis(o_sel, 0, 1).reshape(bsz, seq, NSA_GROUPS, NSA_HPG, NSA_DH)

    kpad = jnp.pad(k_w, ((0, 0), (WINDOW, 0), (0, 0), (0, 0)))
    vpad = jnp.pad(v_w, ((0, 0), (WINDOW, 0), (0, 0), (0, 0)))
    nwb = seq // WIN_QBLOCK
    q_blocks = jnp.moveaxis(qg.reshape(bsz, nwb, WIN_QBLOCK, NSA_GROUPS, NSA_HPG, NSA_DH), 1, 0)

    def win_body(args):
        qb, i = args
        st = i * WIN_QBLOCK
        kb = lax.dynamic_slice_in_dim(kpad, st, WINDOW + WIN_QBLOCK, axis=1)
        vb = lax.dynamic_slice_in_dim(vpad, st, WINDOW + WIN_QBLOCK, axis=1)
        s = jnp.einsum('bqghd,bkgd->bghqk', qb, kb).astype(jnp.float32) * scale
        kp = st - WINDOW + jnp.arange(WINDOW + WIN_QBLOCK)
        tq = st + jnp.arange(WIN_QBLOCK)
        m = (kp[None, :] <= tq[:, None]) & (kp[None, :] > tq[:, None] - WINDOW) & (kp[None, :] >= 0)
        p = jax.nn.softmax(jnp.where(m, s, NEG_INF), axis=-1)
        return jnp.einsum('bghqk,bkgd->bqghd', p.astype(qb.dtype), vb)

    o_win = lax.map(win_body, (q_blocks, jnp.arange(nwb)))
    o_win = jnp.moveaxis(o_win, 0, 1).reshape(bsz, seq, NSA_GROUPS, NSA_HPG, NSA_DH)

    gates = jax.nn.sigmoid(gate_logits.astype(jnp.float32)).reshape(bsz, seq, NSA_GROUPS, NSA_HPG, 3)
    gates = gates.astype(q.dtype)
    o = gates[..., 0, None] * o_cmp + gates[..., 1, None] * o_sel + gates[..., 2, None] * o_win
    return o.reshape(bsz, seq, NSA_Q)


def cross_attention(h, m, w_q, w_kv, w_o):
    bsz, seq = h.shape[0], h.shape[1]
    nmem = m.shape[1]
    q = (h @ w_q).reshape(bsz, seq, X_HEADS, X_DH)
    k, v = jnp.split(m @ w_kv, 2, axis=-1)
    k = k.reshape(bsz, nmem, X_HEADS, X_DH)
    v = v.reshape(bsz, nmem, X_HEADS, X_DH)
    s = jnp.einsum('bshd,bmhd->bhsm', q, k).astype(jnp.float32) * (X_DH ** -0.5)
    p = jax.nn.softmax(s, axis=-1).astype(h.dtype)
    o = jnp.einsum('bhsm,bmhd->bshd', p, v).reshape(bsz, seq, D_MODEL)
    return o @ w_o


def hier_moe(h, w_grp, b_grp, w_rt, b_rt, w1, w3, w2):
    n_tok = h.shape[0]
    lg = (h @ w_grp + b_grp).astype(jnp.float32)
    pg = jax.nn.softmax(lg, axis=-1)
    grp = jnp.argmax(lg, axis=-1)
    g_gate = jnp.take_along_axis(pg, grp[:, None], axis=-1)[:, 0]
    le = (h @ w_rt + b_rt).astype(jnp.float32).reshape(n_tok, N_EGROUPS, EXP_PER_GROUP)
    le_g = jnp.take_along_axis(le, grp[:, None, None], axis=1)[:, 0]
    pe = jax.nn.softmax(le_g, axis=-1)
    top_p, top_i = lax.top_k(pe, EXP_TOPK)
    wts = g_gate[:, None] * top_p / jnp.sum(top_p, axis=-1, keepdims=True)
    eid = (grp[:, None] * EXP_PER_GROUP + top_i).reshape(-1).astype(jnp.int32)
    wflat = wts.reshape(-1)
    n_asg = n_tok * EXP_TOPK
    tok = (jnp.arange(n_asg) // EXP_TOPK).astype(jnp.int32)
    order = jnp.argsort(eid)
    se = eid[order]
    counts = jnp.bincount(eid, length=N_EXPERTS)
    padded = (counts + MOE_BLOCK - 1) // MOE_BLOCK * MOE_BLOCK
    starts = jnp.cumsum(counts) - counts
    pends = jnp.cumsum(padded)
    pstarts = pends - padded
    dest = pstarts[se] + (jnp.arange(n_asg) - starts[se])
    cap = ((n_asg + MOE_BLOCK - 1) // MOE_BLOCK + N_EXPERTS) * MOE_BLOCK
    nblk = cap // MOE_BLOCK
    buf_tok = jnp.full((cap,), n_tok, jnp.int32).at[dest].set(tok[order])
    buf_w = jnp.zeros((cap,), h.dtype).at[dest].set(wflat[order].astype(h.dtype))
    blk_e = jnp.minimum(jnp.searchsorted(pends, jnp.arange(nblk) * MOE_BLOCK, side='right'), N_EXPERTS - 1)
    hp = jnp.concatenate([h, jnp.zeros((1, h.shape[1]), h.dtype)], axis=0)

    def body(args):
        e, tk, wb = args
        xb = hp[tk]
        y = (jax.nn.silu(xb @ w1[e]) * (xb @ w3[e])) @ w2[e]
        return y * wb[:, None]

    ys = lax.map(body, (blk_e, buf_tok.reshape(nblk, MOE_BLOCK), buf_w.reshape(nblk, MOE_BLOCK)))
    out = jnp.zeros((n_tok + 1, h.shape[1]), h.dtype).at[buf_tok].add(ys.reshape(cap, h.shape[1]))
    return out[:n_tok]


def setup_inputs(seed: int = 0) -> dict:
    key = jax.random.key(seed)
    ks = jax.random.split(key, 32)
    f32 = jnp.float32

    def nrm(k, shape, fan_in):
        return jax.random.normal(k, shape, f32) * (fan_in ** -0.5)

    def gain(k, shape):
        return 1.0 + 0.02 * jax.random.normal(k, shape, f32)

    L = DEPTH
    return {
        'x': jax.random.normal(ks[0], (BATCH, SEQ, D_MODEL), f32),
        'mem': jax.random.normal(ks[1], (BATCH, N_MEM, D_MODEL), f32),
        'norm_mix_g': gain(ks[2], (L, D_MODEL)),
        'w_in': nrm(ks[3], (L, D_MODEL, D_IN), D_MODEL),
        'w_ret_o': nrm(ks[4], (L, RET_V, D_MODEL), RET_V),
        'w_nsa_o': nrm(ks[5], (L, NSA_Q, D_MODEL), NSA_Q),
        'w_out': nrm(ks[6], (L, D_MODEL, D_MODEL), D_MODEL),
        'cmp_pe_k': 0.1 * jax.random.normal(ks[7], (L, CMP_LEN, NSA_DH), f32),
        'cmp_w1_k': nrm(ks[8], (L, CMP_LEN, NSA_DH, NSA_DH), CMP_LEN * NSA_DH),
        'cmp_w2_k': nrm(ks[9], (L, NSA_DH, NSA_DH), NSA_DH),
        'cmp_pe_v': 0.1 * jax.random.normal(ks[10], (L, CMP_LEN, NSA_DH), f32),
        'cmp_w1_v': nrm(ks[11], (L, CMP_LEN, NSA_DH, NSA_DH), CMP_LEN * NSA_DH),
        'cmp_w2_v': nrm(ks[12], (L, NSA_DH, NSA_DH), NSA_DH),
        'norm_x_g': gain(ks[13], (L, D_MODEL)),
        'norm_mem_g': gain(ks[14], (L, D_MODEL)),
        'w_xq': nrm(ks[15], (L, D_MODEL, D_MODEL), D_MODEL),
        'w_xkv': nrm(ks[16], (L, D_MODEL, 2 * D_MODEL), D_MODEL),
        'w_xo': nrm(ks[17], (L, D_MODEL, D_MODEL), D_MODEL),
        'norm_ffn_g': gain(ks[18], (L, D_MODEL)),
        'w_grp': nrm(ks[19], (L, D_MODEL, N_EGROUPS), D_MODEL),
        'b_grp': 0.01 * jax.random.normal(ks[20], (L, N_EGROUPS), f32),
        'w_rt': nrm(ks[21], (L, D_MODEL, N_EXPERTS), D_MODEL),
        'b_rt': 0.01 * jax.random.normal(ks[22], (L, N_EXPERTS), f32),
        'w_e1': nrm(ks[23], (L, N_EXPERTS, D_MODEL, D_EXPERT), D_MODEL),
        'w_e3': nrm(ks[24], (L, N_EXPERTS, D_MODEL, D_EXPERT), D_MODEL),
        'w_e2': nrm(ks[25], (L, N_EXPERTS, D_EXPERT, D_MODEL), D_EXPERT),
        'norm_f_g': gain(ks[26], (D_MODEL,)),
    }


def reference(x, mem, norm_mix_g, w_in, w_ret_o, w_nsa_o, w_out, cmp_pe_k, cmp_w1_k, cmp_w2_k,
              cmp_pe_v, cmp_w1_v, cmp_w2_v, norm_x_g, norm_mem_g, w_xq, w_xkv, w_xo, norm_ffn_g,
              w_grp, b_grp, w_rt, b_rt, w_e1, w_e3, w_e2, norm_f_g):
    bsz, seq = x.shape[0], x.shape[1]
    split_points = np.cumsum(SPLITS)[:-1].tolist()
    for l in range(DEPTH):
        h = rmsnorm(x, norm_mix_g[l])
        proj = h @ w_in[l]
        (rq, rk, rv, rg, nq, ck, cv, sk, sv, wk, wv, ngl, ga, gb) = jnp.split(proj, split_points, axis=-1)
        y_ret = retention(rq.reshape(bsz, seq, R_HEADS, R_DK), rk.reshape(bsz, seq, R_HEADS, R_DK),
                          rv.reshape(bsz, seq, R_HEADS, R_DV), rg) @ w_ret_o[l]
        y_nsa = nsa(nq, ck, cv, sk, sv, wk, wv, ngl, cmp_pe_k[l], cmp_w1_k[l], cmp_w2_k[l],
                    cmp_pe_v[l], cmp_w1_v[l], cmp_w2_v[l]) @ w_nsa_o[l]
        y = jax.nn.sigmoid(ga) * y_ret + jax.nn.sigmoid(gb) * y_nsa
        x = x + y @ w_out[l]
        x = x + cross_attention(rmsnorm(x, norm_x_g[l]), rmsnorm(mem, norm_mem_g[l]),
                                w_xq[l], w_xkv[l], w_xo[l])
        hf = rmsnorm(x, norm_ffn_g[l]).reshape(bsz * seq, D_MODEL)
        x = x + hier_moe(hf, w_grp[l], b_grp[l], w_rt[l], b_rt[l], w_e1[l], w_e3[l], w_e2[l]).reshape(bsz, seq, D_MODEL)
    return rmsnorm(x, norm_f_g)
```

```cpp
#include <hip/hip_runtime.h>
#include <cstdio>
#include <cstdint>

#ifndef MK_N_LAUNCHES
#define MK_N_LAUNCHES 1
#endif

#define LAS __attribute__((address_space(3)))
#define GAS __attribute__((address_space(1)))
#define HD __host__ __device__
#define HDI __host__ __device__ __attribute__((always_inline)) inline
typedef unsigned short bf16;
typedef short bf16x8 __attribute__((ext_vector_type(8)));
typedef float f32x4 __attribute__((ext_vector_type(4)));
typedef float f32x2 __attribute__((ext_vector_type(2)));
typedef float f32x16 __attribute__((ext_vector_type(16)));
typedef unsigned u32x4 __attribute__((ext_vector_type(4)));
typedef unsigned u32x2 __attribute__((ext_vector_type(2)));

constexpr int D = 1024, BATCH = 8, SEQ = 4096, NTOK = BATCH * SEQ, NMEM = 256, NMEMTOK = BATCH * NMEM;
constexpr int DIN = 7704;
constexpr int C_RQ = 0, C_RK = 512, C_RV = 1024, C_RG = 2048, C_NQ = 3072, C_CK = 4096, C_NGL = 5632, C_GA = 5656, C_GB = 6680;
constexpr int NPROJ = 5632;
constexpr int NEXP = 32, DEXP = 512;
constexpr float EPS = 1e-6f;
constexpr int NWAVES = 8, NTHREADS = 512;

constexpr size_t MiB = 1u << 20;
constexpr size_t WS_CTL = 0, CTL_ZERO_BYTES = 1 * MiB;
constexpr size_t WS_ROPE_COS = 1 * MiB, WS_ROPE_SIN = 2 * MiB;
constexpr size_t WS_SMALLW = 3 * MiB;
constexpr size_t WS_MEMVT = 24 * MiB;
constexpr size_t WS_KCMP = 4 * MiB, WS_VCMP = 5 * MiB, WS_VCMPT = 35 * MiB;
constexpr size_t WS_GATES = 10 * MiB;
constexpr size_t WS_SSQ = 13 * MiB;
constexpr size_t WS_ROUTE = 15 * MiB;
constexpr size_t WS_LISTS = 16 * MiB;
constexpr size_t WS_W = 36 * MiB;
constexpr size_t W_IN = WS_W;
constexpr size_t W_GA = W_IN + 11 * MiB, W_GB = W_GA + 2 * MiB;
constexpr size_t W_RO = W_GB + 2 * MiB, W_NO = W_RO + 2 * MiB, W_OUT = W_NO + 2 * MiB, W_XQ = W_OUT + 2 * MiB, W_XO = W_XQ + 2 * MiB;
constexpr size_t W_XKV = W_XO + 2 * MiB;
constexpr size_t W_C1K = W_XKV + 4 * MiB, W_C1V = W_C1K + 2 * MiB;
constexpr size_t WS_MEMN = W_C1V + 2 * MiB;
constexpr size_t WS_MEMKV = WS_MEMN + 4 * MiB;
constexpr size_t WS_H = 84 * MiB;
constexpr size_t WS_NQ = WS_H + 64 * MiB;
constexpr size_t WS_RV = WS_NQ + 64 * MiB;
constexpr size_t WS_RQ = WS_RV + 64 * MiB;
constexpr size_t WS_RK = WS_RQ + 32 * MiB;
constexpr size_t WS_RG = WS_RK + 32 * MiB;
constexpr size_t WS_KV6 = WS_RG + 64 * MiB;
constexpr size_t KV_STRIDE = 16 * MiB;
constexpr size_t WS_END = WS_KV6 + 96 * MiB;
constexpr size_t WS_Y = WS_RQ, WS_P4SCR = WS_RG, WS_W13 = WS_RQ, WS_W2 = WS_RG, WS_H1 = WS_KV6, WS_X1B = WS_H, WS_X2B = WS_RV, WS_YS0 = WS_H, WS_YS1 = WS_NQ;
static_assert(WS_MEMKV + 8 * MiB <= WS_H && WS_VCMPT + 1 * MiB <= WS_W && WS_MEMVT + 4 * MiB <= WS_VCMPT, "ws map");
constexpr int CW_BAR = 4096;
constexpr int CW_ECNT = 16384;
constexpr int LDS_BYTES = 147456, RING_BYTES = 131072, MISC_OFF = RING_BYTES + 320;

HD inline float bf2f(bf16 b) { return __builtin_bit_cast(float, (unsigned)b << 16); }
HD inline unsigned f2bf(float f) { unsigned u = __builtin_bit_cast(unsigned, f); return (u + 0x7fffu + ((u >> 16) & 1u)) >> 16; }
HD inline unsigned pk2(float lo, float hi) { return f2bf(lo) | (f2bf(hi) << 16); }
HD inline float lo16(unsigned w) { return __builtin_bit_cast(float, w << 16); }
HD inline float hi16(unsigned w) { return __builtin_bit_cast(float, w & 0xffff0000u); }
__device__ __forceinline__ unsigned cvt_pk_bf16(float lo, float hi) { unsigned r; asm volatile("v_cvt_pk_bf16_f32 %0, %1, %2" : "=v"(r) : "v"(lo), "v"(hi)); return r; }
#define DPP_F(v, ctrl, rmask) __builtin_bit_cast(float, __builtin_amdgcn_update_dpp(0, __builtin_bit_cast(int, v), ctrl, rmask, 0xf, false))
__device__ __forceinline__ float wave_sum(float v) {
    v += DPP_F(v, 0xB1, 0xf);
    v += DPP_F(v, 0x4E, 0xf);
    v += DPP_F(v, 0x141, 0xf);
    v += DPP_F(v, 0x140, 0xf);
    v += DPP_F(v, 0x142, 0xa);
    v += DPP_F(v, 0x143, 0xc);
    return __builtin_bit_cast(float, __builtin_amdgcn_readlane(__builtin_bit_cast(int, v), 63));
}
__device__ __forceinline__ float wave_max(float v) {
#pragma unroll
    for (int o = 1; o < 64; o <<= 1) v = fmaxf(v, __shfl_xor(v, o));
    return v;
}
__device__ __forceinline__ float sigmoidf_(float x) { return __builtin_amdgcn_rcpf(1.0f + __builtin_amdgcn_exp2f(-1.4426950408889634f * x)); }
#define LAUNDER(p) asm volatile("" : "+v"(p))
#define LDS_WAIT() asm volatile("s_waitcnt lgkmcnt(0)" ::: "memory")
#define VM_WAIT() asm volatile("s_waitcnt vmcnt(0)" ::: "memory")

#define XB_TMO      128
#define XB_XCNT(j)  (256  + 64 * (j))
#define XB_XSUB(j)  (1280 + 64 * (j))
#define XB_XGEN(j)  (2304 + 64 * (j))
#define XB_TOP      3328
#define XB_TOPGEN   3392
#define XCD_BAR_WORDS 3456
#define XB_SPIN_CAP (1u << 24)
__device__ __forceinline__ unsigned xb_ld(unsigned* p)              { return __hip_atomic_load(p, __ATOMIC_RELAXED, __HIP_MEMORY_SCOPE_AGENT); }
__device__ __forceinline__ unsigned xb_add(unsigned* p, unsigned v) { return __hip_atomic_fetch_add(p, v, __ATOMIC_RELAXED, __HIP_MEMORY_SCOPE_AGENT); }
__device__ __forceinline__ unsigned xb_xcc_id() { return (unsigned)__builtin_amdgcn_s_getreg((3 << 11) | 20) & 0xFu; }
#define XB_SPIN(cond, bar) do { unsigned _sp = 0; while (cond) { __builtin_amdgcn_s_sleep(1); \
    if ((++_sp & 255u) == 0u) { if (xb_ld(&(bar)[XB_TMO])) break; if (_sp > XB_SPIN_CAP) { atomicAdd(&(bar)[XB_TMO], 1u); break; } } } } while (0)
struct XcdBarrier { unsigned* bar; unsigned x; volatile LAS unsigned* st; };
__device__ __forceinline__ XcdBarrier xcd_barrier_post(unsigned* bar, volatile LAS unsigned* st) {
    XcdBarrier b; b.bar = bar; b.x = xb_xcc_id(); b.st = st;
    if (threadIdx.x == 0) (void)xb_add(&bar[XB_XCNT(b.x)], 1u);
    return b;
}
__device__ __forceinline__ void xcd_barrier_complete(unsigned* bar, unsigned x, unsigned& nloc, unsigned& nx) {
    const unsigned G = gridDim.x * gridDim.y * gridDim.z;
    unsigned sum, cnt, mine, sp = 0u;
    for (;;) {
        sum = 0u; cnt = 0u; mine = 0u;
#pragma unroll
        for (unsigned j = 0; j < 16; ++j) { const unsigned c = xb_ld(&bar[XB_XCNT(j)]); sum += c; cnt += (c > 0u) ? 1u : 0u; mine = (j == x) ? c : mine; }
        if (sum == G) break;
        __builtin_amdgcn_s_sleep(1);
        if ((++sp & 255u) == 0u) { if (xb_ld(&bar[XB_TMO])) break; if (sp > XB_SPIN_CAP) { atomicAdd(&bar[XB_TMO], 1u); break; } }
    }
    nloc = mine > 0u ? mine : 1u; nx = cnt > 0u ? cnt : 1u;
}
__device__ __forceinline__ void xcd_barrier(const XcdBarrier& b) {
    asm volatile("s_waitcnt vmcnt(0)" ::: "memory");
    __syncthreads();
    if (threadIdx.x == 0) {
        unsigned* bar = b.bar;
        __builtin_amdgcn_s_waitcnt(0);
        unsigned nloc = b.st[0], nx = b.st[1];
        if (nloc == 0u) { xcd_barrier_complete(bar, b.x, nloc, nx); b.st[0] = nloc; b.st[1] = nx; }
        const unsigned old = xb_add(&bar[XB_XSUB(b.x)], 1u);
        const unsigned gen = old / nloc;
        if (old + 1u == (gen + 1u) * nloc) {
            __builtin_amdgcn_fence(__ATOMIC_RELEASE, "agent");
            asm volatile("s_waitcnt vmcnt(0)" ::: "memory");
            const unsigned og = xb_add(&bar[XB_TOP], 1u);
            const unsigned tg = og / nx;
            if (og + 1u == (tg + 1u) * nx) xb_add(&bar[XB_TOPGEN], 1u);
            else XB_SPIN(xb_ld(&bar[XB_TOPGEN]) == tg, bar);
            __builtin_amdgcn_fence(__ATOMIC_ACQUIRE, "agent");
            xb_add(&bar[XB_XGEN(b.x)], 1u);
            asm volatile("s_waitcnt vmcnt(0)" ::: "memory");
        } else {
            XB_SPIN(xb_ld(&bar[XB_XGEN(b.x)]) == gen, bar);
            __builtin_amdgcn_fence(__ATOMIC_ACQUIRE, "agent");
            asm volatile("s_waitcnt vmcnt(0)" ::: "memory");
        }
    }
    __syncthreads();
}

namespace pg8 {
constexpr int BM = 256, BK = 64, HALF = 128, HTB = HALF * BK * 2, NXCD = 8, WGM = 8;
HD __forceinline__ int lds_byte(int r, int c) { const int st = (r >> 4) * 2 + (c >> 5), rr = r & 15, cc = c & 31, ob = rr * 64 + cc * 2; return st * 1024 + (ob ^ (((ob >> 9) & 1) << 5)); }
HD __forceinline__ void stage_rc(int b, int& R, int& C) { const int st = b / 1024, sb = b % 1024, swz = sb ^ (((sb >> 9) & 1) << 5); R = (st >> 1) * 16 + swz / 64; C = (st & 1) * 32 + (swz % 64) / 2; }
HD __forceinline__ int perm32(int rho) { const int n = rho >> 4, i = rho & 15; return 8 * (i >> 2) + 4 * n + (i & 3); }
HD __forceinline__ void tile_map(int L, int nM, int nN, int& pm, int& pn) {
    const int nwg = nM * nN; int wgid = L; { const int q = nwg / NXCD, r = nwg % NXCD, xcd = wgid % NXCD, off = wgid / NXCD; wgid = (xcd < r ? xcd * (q + 1) : r * (q + 1) + (xcd - r) * q) + off; }
    const int nig = WGM * nN, gid = wgid / nig, fm = gid * WGM, gsz = (nM - fm) < WGM ? (nM - fm) : WGM;
    pm = fm + ((wgid % nig) % gsz); pn = (wgid % nig) / gsz;
}
struct GU { const char* A; const char* B; const int* rows; int nvalid; int kind, pm, pn, aux; };
template <class Epi, class Sched, bool GATHER>
__device__ __forceinline__ void gemm_phase(LAS unsigned char* lds, const int K, const int lda, const int ldb, const Sched& S, const Epi& E) {
    int tid_ = threadIdx.x; LAUNDER(tid_);
    const int tid = tid_, wid = __builtin_amdgcn_readfirstlane(tid >> 6), lane = tid & 63, wr = wid >> 2, wc = wid & 3, fr = lane & 15, fq = lane >> 4;
    const int nt = K / BK;
    unsigned voffB[2];
#pragma unroll
    for (int i = 0; i < 2; ++i) { int R, C; stage_rc(tid * 16 + i * 8192, R, C); const int Rb = Epi::PERM ? ((R & ~31) + perm32(R & 31)) : R; voffB[i] = (unsigned)(Rb * ldb + C) * 2u; }
    const size_t kstep = (size_t)(BK * 2);
    const size_t hstepB = (size_t)HALF * ldb * 2;
    const unsigned ldsw = (unsigned)wid * 1024u;
    const int aoff = lds_byte(wr * 64 + fr, fq * 8), boff = lds_byte(wc * 32 + fr, fq * 8);
#define PG8_SA(b, h) (((b) * 2 + (h)) * HTB)
#define PG8_SB(b, h) ((4 + (b) * 2 + (h)) * HTB)
#define PG8_STAGE2(bufoff, gbase, v0, v1) do { \
        __builtin_amdgcn_global_load_lds((const unsigned*)((const char*)(gbase) + (v0)), (LAS unsigned*)(lds + (bufoff) + ldsw), 16, 0, 0); \
        __builtin_amdgcn_global_load_lds((const unsigned*)((const char*)(gbase) + (v1)), (LAS unsigned*)(lds + (bufoff) + ldsw + 8192), 16, 0, 0); } while (0)
#define PG8_STAGEB(bufoff, gbase) PG8_STAGE2(bufoff, gbase, voffB[0], voffB[1])
#define PG8_LDA(dst, b, h) do { _Pragma("unroll") for (int m = 0; m < 4; ++m) _Pragma("unroll") for (int k = 0; k < 2; ++k) dst[m][k] = *(const LAS bf16x8*)(lds + PG8_SA(b, h) + aoff + m * 2048 + k * 1024); } while (0)
#define PG8_LDB(dst, b, h) do { _Pragma("unroll") for (int n = 0; n < 2; ++n) _Pragma("unroll") for (int k = 0; k < 2; ++k) dst[n][k] = *(const LAS bf16x8*)(lds + PG8_SB(b, h) + boff + n * 2048 + k * 1024); } while (0)
#define PG8_MMA(ai, bj, At, Bt) do { __builtin_amdgcn_s_setprio(1); _Pragma("unroll") for (int m = 0; m < 4; ++m) _Pragma("unroll") for (int n = 0; n < 2; ++n) _Pragma("unroll") for (int k = 0; k < 2; ++k) \
        acc[ai][bj][m][n] = __builtin_amdgcn_mfma_f32_16x16x32_bf16(Bt[n][k], At[m][k], acc[ai][bj][m][n], 0, 0, 0); __builtin_amdgcn_s_setprio(0); } while (0)
#define PG8_WAIT_V(n) asm volatile("s_waitcnt vmcnt(" #n ")" ::: "memory")
#define PG8_WAIT_L(n) asm volatile("s_waitcnt lgkmcnt(" #n ")" ::: "memory")
#define PG8_BAR __builtin_amdgcn_s_barrier()
#define PG8_SCHED __builtin_amdgcn_sched_barrier(0)
#define PG8_VOFFA(u, vo) do { _Pragma("unroll") for (int h = 0; h < 2; ++h) _Pragma("unroll") for (int i = 0; i < 2; ++i) { int R_, C_; stage_rc(tid * 16 + i * 8192, R_, C_); const int R = R_ + HALF * h; \
        int ridx = R; if (GATHER) { ridx = (R < (u).nvalid) ? ((u).rows[R] >> 1) : 0; } vo[h][i] = (unsigned)(ridx * lda + C_) * 2u; } if (GATHER) asm volatile("" :: "v"(vo[0][0]), "v"(vo[0][1]), "v"(vo[1][0]), "v"(vo[1][1])); } while (0)
    GU cur, nxt; int ui = 0;
    if (!S.next(0, cur)) return;
    f32x4 acc[2][2][4][2];
#pragma unroll
    for (int a = 0; a < 2; ++a)
#pragma unroll
        for (int b = 0; b < 2; ++b)
#pragma unroll
            for (int m = 0; m < 4; ++m)
#pragma unroll
                for (int n = 0; n < 2; ++n) acc[a][b][m][n] = (f32x4){0.f, 0.f, 0.f, 0.f};
    bf16x8 At[4][2], B0[2][2], B1[2][2];
    unsigned cv[2][2], nv[2][2];
    PG8_VOFFA(cur, cv);
    const char* cA = cur.A; const char* cB = cur.B;
    PG8_STAGEB(PG8_SB(0, 0), cB); PG8_STAGEB(PG8_SB(0, 1), cB + hstepB); PG8_STAGE2(PG8_SA(0, 0), cA, cv[0][0], cv[0][1]); PG8_STAGE2(PG8_SA(0, 1), cA, cv[1][0], cv[1][1]);
    if (wr == 1) PG8_BAR;
    PG8_WAIT_V(2); PG8_BAR;
    PG8_STAGEB(PG8_SB(1, 0), cB + kstep); PG8_STAGE2(PG8_SA(1, 0), cA + kstep, cv[0][0], cv[0][1]); PG8_STAGEB(PG8_SB(1, 1), cB + hstepB + kstep);
    PG8_WAIT_V(6); PG8_BAR;
    for (;;) {
        const bool has_next = S.next(ui + 1, nxt);
        const char* nA = has_next ? nxt.A : cA; const char* nB = has_next ? nxt.B : cB;
        if (has_next) { PG8_VOFFA(nxt, nv); } else {
#pragma unroll
            for (int h = 0; h < 2; ++h)
#pragma unroll
                for (int i = 0; i < 2; ++i) nv[h][i] = cv[h][i]; }
        for (int t = 0; t < nt; t += 2) {
            const bool last = (t == nt - 2);
            const char* a1 = cA + (size_t)(t + 1) * kstep;
            const char* a2 = last ? nA : cA + (size_t)(t + 2) * kstep; const char* b2 = last ? nB : cB + (size_t)(t + 2) * kstep;
            const char* a3 = a2 + kstep; const char* b3 = b2 + kstep;
            const unsigned w00 = last ? nv[0][0] : cv[0][0], w01 = last ? nv[0][1] : cv[0][1], w10 = last ? nv[1][0] : cv[1][0], w11 = last ? nv[1][1] : cv[1][1];
            PG8_LDB(B0, 0, 0); PG8_LDB(B1, 0, 1); PG8_SCHED; PG8_LDA(At, 0, 0); PG8_STAGE2(PG8_SA(1, 1), a1, cv[1][0], cv[1][1]);
            PG8_WAIT_V(8); PG8_WAIT_L(0); PG8_BAR; PG8_MMA(0, 0, At, B0); PG8_MMA(0, 1, At, B1); PG8_BAR; PG8_SCHED;
            PG8_LDA(At, 0, 1); PG8_STAGEB(PG8_SB(0, 0), b2); PG8_STAGEB(PG8_SB(0, 1), b2 + hstepB); PG8_STAGE2(PG8_SA(0, 0), a2, w00, w01);
            PG8_WAIT_V(8); PG8_WAIT_L(0); PG8_BAR; PG8_MMA(1, 0, At, B0); PG8_MMA(1, 1, At, B1); PG8_BAR; PG8_SCHED;
            PG8_LDB(B0, 1, 0); PG8_LDB(B1, 1, 1); PG8_SCHED; PG8_LDA(At, 1, 0); PG8_STAGE2(PG8_SA(0, 1), a2, w10, w11);
            PG8_WAIT_V(8); PG8_WAIT_L(0); PG8_BAR; PG8_MMA(0, 0, At, B0); PG8_MMA(0, 1, At, B1); PG8_BAR; PG8_SCHED;
            PG8_LDA(At, 1, 1); PG8_STAGEB(PG8_SB(1, 0), b3); PG8_STAGEB(PG8_SB(1, 1), b3 + hstepB); PG8_STAGE2(PG8_SA(1, 0), a3, w00, w01);
            PG8_WAIT_V(8); PG8_WAIT_L(0); PG8_BAR; PG8_MMA(1, 0, At, B0); PG8_MMA(1, 1, At, B1); PG8_BAR; PG8_SCHED;
        }
        if (wr == 0) PG8_BAR;
        E(acc, cur, wr, wc, fr, fq);
        if (!has_next) break;
#pragma unroll
        for (int a = 0; a < 2; ++a)
#pragma unroll
            for (int b = 0; b < 2; ++b)
#pragma unroll
                for (int m = 0; m < 4; ++m)
#pragma unroll
                    for (int n = 0; n < 2; ++n) acc[a][b][m][n] = (f32x4){0.f, 0.f, 0.f, 0.f};
        cur = nxt; cA = nA; cB = nB; ++ui;
#pragma unroll
        for (int h = 0; h < 2; ++h)
#pragma unroll
            for (int i = 0; i < 2; ++i) cv[h][i] = nv[h][i];
        if (wr == 1) PG8_BAR;
    }
    PG8_WAIT_V(0);
    PG8_BAR;
#undef PG8_SA
#undef PG8_SB
#undef PG8_STAGE2
#undef PG8_STAGEB
#undef PG8_LDA
#undef PG8_LDB
#undef PG8_MMA
#undef PG8_WAIT_V
#undef PG8_WAIT_L
#undef PG8_BAR
#undef PG8_SCHED
#undef PG8_VOFFA
}
}
using pg8::GU;

struct Args {
    const float* in[27]; float* out; unsigned char* ws; int ph_lo, ph_hi; int pad0, pad1;
};
enum { IN_X = 0, IN_MEM, IN_NORM_MIX_G, IN_W_IN, IN_W_RET_O, IN_W_NSA_O, IN_W_OUT, IN_CMP_PE_K, IN_CMP_W1_K, IN_CMP_W2_K, IN_CMP_PE_V, IN_CMP_W1_V, IN_CMP_W2_V,
       IN_NORM_X_G, IN_NORM_MEM_G, IN_W_XQ, IN_W_XKV, IN_W_XO, IN_NORM_FFN_G, IN_W_GRP, IN_B_GRP, IN_W_RT, IN_B_RT, IN_W_E1, IN_W_E3, IN_W_E2, IN_NORM_F_G };
struct Frame {
    LAS unsigned char* lds; volatile LAS unsigned* MISC; unsigned* ctl; unsigned char* ws;
    int tid, lane, wave, G, bx;
};

__device__ __forceinline__ bool phase_begin(Frame& F) { int t = threadIdx.x; LAUNDER(t); F.tid = t; F.lane = t & 63; return true; }
__device__ __forceinline__ void transpose_item(const float* W, int ldw, int c0, int k0, bf16* WT, int ldt, int mode, int row_off, int cbase, const float* kscale, float scale, LAS float* scr, int lane) {
    float vv[32];
#pragma unroll
    for (int i = 0; i < 32; ++i) { const int kk = 2 * i + (lane >> 5); vv[i] = W[(size_t)(k0 + kk) * ldw + c0 + (lane & 31)]; }
    if (kscale) {
#pragma unroll
        for (int i = 0; i < 32; ++i) { const int kk = 2 * i + (lane >> 5); vv[i] *= kscale[k0 + kk]; } }
#pragma unroll
    for (int i = 0; i < 32; ++i) { const int kk = 2 * i + (lane >> 5); scr[kk * 33 + (lane & 31)] = vv[i] * scale; }
    LDS_WAIT(); asm volatile("" ::: "memory");
    const int c = lane & 7;
#pragma unroll
    for (int j = 0; j < 4; ++j) { const int n = (lane >> 3) + 8 * j; const LAS float* s = scr + (8 * c) * 33 + n;
        u32x4 o; o.x = pk2(s[0 * 33], s[1 * 33]); o.y = pk2(s[2 * 33], s[3 * 33]); o.z = pk2(s[4 * 33], s[5 * 33]); o.w = pk2(s[6 * 33], s[7 * 33]);
        const int jc = c0 - cbase + n; const int drow = mode == 0 ? row_off + jc : (8 * (jc >> 2) + 4 * row_off + (jc & 3));
        *(u32x4*)(WT + (size_t)drow * ldt + k0 + 8 * c) = o; }
    LDS_WAIT(); asm volatile("" ::: "memory");
}
__device__ __forceinline__ void transpose_matrix(Frame& F, int& item_base, const float* W, int ldw, int K, int cbase, int ncols, bf16* WT, int ldt, int mode, int row_off, const float* kscale, float scale) {
    LAS float* scr = (LAS float*)(F.lds + F.wave * 16384);
    const int gw = F.bx * NWAVES + F.wave, NGW = F.G * NWAVES;
    const int nb = ncols / 32, nitems = (K / 64) * nb;
    int it = (gw - item_base % NGW + NGW) % NGW;
    for (; it < nitems; it += NGW) transpose_item(W, ldw, cbase + 32 * (it % nb), 64 * (it / nb), WT, ldt, mode, row_off, cbase, kscale, scale, scr, F.lane);
    item_base += nitems;
}
__device__ __forceinline__ void rms_row_to_bf16(int lane, const float* xrow, const float* g, bf16* orow) {
    const f32x4* xr = (const f32x4*)xrow + lane; const f32x4* gr = (const f32x4*)g + lane;
    f32x4 v[4]; float s = 0.f;
#pragma unroll
    for (int j = 0; j < 4; ++j) { v[j] = xr[64 * j]; s += (v[j].x * v[j].x + v[j].y * v[j].y) + (v[j].z * v[j].z + v[j].w * v[j].w); }
    const float rstd = 1.0f / sqrtf(wave_sum(s) * (1.f / D) + EPS);
    unsigned long long* o8 = (unsigned long long*)orow + lane;
#pragma unroll
    for (int j = 0; j < 4; ++j) { const f32x4 gg = gr[64 * j];
        o8[64 * j] = (unsigned long long)pk2(v[j].x * rstd * gg.x, v[j].y * rstd * gg.y) | ((unsigned long long)pk2(v[j].z * rstd * gg.z, v[j].w * rstd * gg.w) << 32); }
}

__device__ __forceinline__ void p0_prologue(Frame& F, const Args& a) {
    unsigned char* ws = F.ws;
    const float* w_in = a.in[IN_W_IN];
    int ib = 0;
    transpose_matrix(F, ib, w_in, DIN, D, 0, 512, (bf16*)(ws + W_IN), D, 0, 0, nullptr, 1.0f);
    transpose_matrix(F, ib, w_in, DIN, D, 512, 512, (bf16*)(ws + W_IN), D, 0, 512, nullptr, 0.08838834764831845f);
    transpose_matrix(F, ib, w_in, DIN, D, 1024, NPROJ - 1024, (bf16*)(ws + W_IN), D, 0, 1024, nullptr, 1.0f);
    transpose_matrix(F, ib, w_in, DIN, D, C_GA, 1024, (bf16*)(ws + W_GA), D, 0, 0, nullptr, 1.0f);
    transpose_matrix(F, ib, w_in, DIN, D, C_GB, 1024, (bf16*)(ws + W_GB), D, 0, 0, nullptr, 1.0f);
    transpose_matrix(F, ib, a.in[IN_W_RET_O], D, D, 0, D, (bf16*)(ws + W_RO), D, 0, 0, nullptr, 1.0f);
    transpose_matrix(F, ib, a.in[IN_W_NSA_O], D, D, 0, D, (bf16*)(ws + W_NO), D, 0, 0, nullptr, 1.0f);
    transpose_matrix(F, ib, a.in[IN_W_OUT], D, D, 0, D, (bf16*)(ws + W_OUT), D, 0, 0, nullptr, 1.0f);
    transpose_matrix(F, ib, a.in[IN_W_XQ], D, D, 0, D, (bf16*)(ws + W_XQ), D, 0, 0, a.in[IN_NORM_X_G], 1.0f);
    transpose_matrix(F, ib, a.in[IN_W_XO], D, D, 0, D, (bf16*)(ws + W_XO), D, 0, 0, nullptr, 1.0f);
    transpose_matrix(F, ib, a.in[IN_W_XKV], 2 * D, D, 0, 2 * D, (bf16*)(ws + W_XKV), D, 0, 0, nullptr, 1.0f);
    transpose_matrix(F, ib, a.in[IN_CMP_W1_K], 128, 4096, 0, 128, (bf16*)(ws + W_C1K), 4096, 0, 0, nullptr, 1.0f);
    transpose_matrix(F, ib, a.in[IN_CMP_W1_V], 128, 4096, 0, 128, (bf16*)(ws + W_C1V), 4096, 0, 0, nullptr, 1.0f);
    const int gt = F.bx * NTHREADS + F.tid, NGT = F.G * NTHREADS;
    for (int i = gt; i < 2 * 128 * 4096 / 8; i += NGT) { const int m = i / (128 * 4096 / 8), r = i % (128 * 4096 / 8);
        *(u32x4*)(ws + (m ? W_C1V : W_C1K) + (size_t)128 * 4096 * 2 + (size_t)r * 16) = (u32x4){0u, 0u, 0u, 0u}; }
    bf16* wngl = (bf16*)(ws + WS_SMALLW);
    for (int i = gt; i < 32 * 1024; i += NGT) { const int r = i >> 10, k = i & 1023; wngl[i] = r < 24 ? (bf16)f2bf(w_in[(size_t)k * DIN + C_NGL + r]) : (bf16)0; }
    bf16* w2k = (bf16*)(ws + WS_SMALLW + 65536); bf16* w2v = w2k + 128 * 128;
    for (int i = gt; i < 2 * 128 * 128; i += NGT) { const int m = i >> 14, r = i & 16383, f = r >> 7, e = r & 127; const float* src = a.in[m ? IN_CMP_W2_V : IN_CMP_W2_K];
        (m ? w2v : w2k)[f * 128 + e] = (bf16)f2bf(src[e * 128 + f]); }
    float* cbias = (float*)(ws + WS_SMALLW + 65536 + 2 * 128 * 128 * 2);
    const int gw = F.bx * NWAVES + F.wave, NGW = F.G * NWAVES;
    for (int o = gw; o < 256; o += NGW) { const int m = o >> 7, e = o & 127; const float* pe = a.in[m ? IN_CMP_PE_V : IN_CMP_PE_K]; const float* w1 = a.in[m ? IN_CMP_W1_V : IN_CMP_W1_K];
        float s = 0.f; for (int k = F.lane; k < 4096; k += 64) s += pe[k] * w1[(size_t)k * 128 + e];
        s = wave_sum(s); if (F.lane == 0) cbias[o] = s; }
    float* cosT = (float*)(ws + WS_ROPE_COS); float* sinT = (float*)(ws + WS_ROPE_SIN);
    for (int i = gt; i < SEQ * 64; i += NGT) { const int pos = i >> 6, j = i & 63; const float inv = powf(10000.0f, -(float)(2 * j) / 128.0f); const float ang = (float)pos * inv;
        cosT[i] = cosf(ang); sinT[i] = sinf(ang); }
    { f32x4 nx[4]; const float* X = a.in[IN_X]; const f32x4* gr = (const f32x4*)a.in[IN_NORM_MIX_G] + F.lane;
      if (gw < NTOK) {
#pragma unroll
          for (int j = 0; j < 4; ++j) nx[j] = ((const f32x4*)(X + (size_t)gw * D) + F.lane)[64 * j]; }
      for (int m = gw; m < NTOK; m += NGW) { f32x4 v[4]; float sq = 0.f;
#pragma unroll
          for (int j = 0; j < 4; ++j) { v[j] = nx[j]; sq += (v[j].x * v[j].x + v[j].y * v[j].y) + (v[j].z * v[j].z + v[j].w * v[j].w); }
          if (m + NGW < NTOK) {
#pragma unroll
              for (int j = 0; j < 4; ++j) nx[j] = ((const f32x4*)(X + (size_t)(m + NGW) * D) + F.lane)[64 * j]; }
          const float rstd = 1.0f / sqrtf(wave_sum(sq) * (1.f / D) + EPS); unsigned long long* o8 = (unsigned long long*)((bf16*)(ws + WS_H) + (size_t)m * D) + F.lane;
#pragma unroll
          for (int j = 0; j < 4; ++j) { const f32x4 gg = gr[64 * j]; o8[64 * j] = (unsigned long long)pk2(v[j].x * rstd * gg.x, v[j].y * rstd * gg.y) | ((unsigned long long)pk2(v[j].z * rstd * gg.z, v[j].w * rstd * gg.w) << 32); } } }
    for (int m = gw; m < NMEMTOK; m += NGW) rms_row_to_bf16(F.lane, a.in[IN_MEM] + (size_t)m * D, a.in[IN_NORM_MEM_G], (bf16*)(ws + WS_MEMN) + (size_t)m * D);
}

struct SchedP1 {
    unsigned char* ws; int G, c;
    __device__ __forceinline__ bool next(int i, GU& u) const {
        constexpr int NP = 128 * 22; const int L = i * G + c;
        u.rows = nullptr; u.nvalid = 0; u.aux = 0;
        if (L < NP) { int pm, pn; pg8::tile_map(L, 128, 22, pm, pn); u.A = (const char*)ws + WS_H + (size_t)pm * 256 * D * 2; u.B = (const char*)ws + W_IN + (size_t)pn * 256 * D * 2; u.pm = pm; u.pn = pn;
            u.kind = pn < 2 ? 0 : pn < 4 ? 1 : pn < 8 ? 2 : pn < 12 ? 3 : pn < 16 ? 4 : 5; return true; }
        const int L2 = L - NP; if (L2 >= 64) return false;
        const int pm = L2 & 7, pn = L2 >> 3; u.A = (const char*)ws + WS_MEMN + (size_t)pm * 256 * D * 2; u.B = (const char*)ws + W_XKV + (size_t)pn * 256 * D * 2; u.pm = pm; u.pn = pn; u.kind = 6; return true;
    }
};
struct EpiP1 {
    static constexpr bool PERM = true;
    unsigned char* ws;
    __device__ __forceinline__ void operator()(const f32x4 (&acc)[2][2][4][2], const GU& u, int wr, int wc, int fr, int fq) const {
        const int kind = u.kind;
        const float* cosT = (const float*)(ws + WS_ROPE_COS); const float* sinT = (const float*)(ws + WS_ROPE_SIN);
#pragma unroll
        for (int ai = 0; ai < 2; ++ai)
#pragma unroll
            for (int m = 0; m < 4; ++m) {
                const int r = 128 * ai + 64 * wr + 16 * m + fr; const int tok = u.pm * 256 + r;
#pragma unroll
                for (int bj = 0; bj < 2; ++bj) {
                    f32x4 v0 = acc[ai][bj][m][0], v1 = acc[ai][bj][m][1];
                    const int ct = 128 * bj + 32 * wc + 8 * fq;
                    bf16* dst;
                    if (kind <= 1) {
                        const int s = tok & (SEQ - 1), i0 = ((ct & 127) >> 1);
                        const f32x4 cs = *(const f32x4*)(cosT + s * 64 + i0), sn = *(const f32x4*)(sinT + s * 64 + i0);
                        const f32x4 a0 = v0, a1 = v1;
                        v0[0] = a0[0] * cs[0] - a0[1] * sn[0]; v0[1] = a0[0] * sn[0] + a0[1] * cs[0];
                        v0[2] = a0[2] * cs[1] - a0[3] * sn[1]; v0[3] = a0[2] * sn[1] + a0[3] * cs[1];
                        v1[0] = a1[0] * cs[2] - a1[1] * sn[2]; v1[1] = a1[0] * sn[2] + a1[1] * cs[2];
                        v1[2] = a1[2] * cs[3] - a1[3] * sn[3]; v1[3] = a1[2] * sn[3] + a1[3] * cs[3];
                        dst = (bf16*)(ws + (kind == 0 ? WS_RQ : WS_RK)) + (size_t)tok * 512 + (u.pn & 1) * 256 + ct;
                    } else if (kind == 2) { dst = (bf16*)(ws + WS_RV) + (size_t)tok * 1024 + (u.pn - 4) * 256 + ct;
                    } else if (kind == 3) {
#pragma unroll
                        for (int j = 0; j < 4; ++j) { v0[j] = v0[j] * sigmoidf_(v0[j]); v1[j] = v1[j] * sigmoidf_(v1[j]); }
                        dst = (bf16*)(ws + WS_RG) + (size_t)tok * 1024 + (u.pn - 8) * 256 + ct;
                    } else if (kind == 4) { dst = (bf16*)(ws + WS_NQ) + (size_t)tok * 1024 + (u.pn - 12) * 256 + ct;
                    } else if (kind == 5) {
                        const int b = tok >> 12, s = tok & (SEQ - 1);
                        unsigned char* kvb = ws + WS_KV6 + (size_t)(u.pn - 16) * KV_STRIDE;
                        dst = (bf16*)kvb + ((size_t)(b * 2 + bj) * SEQ + s) * 128 + (ct & 127);
                    } else { dst = (bf16*)(ws + WS_MEMKV) + (size_t)tok * 2048 + u.pn * 256 + ct; }
                    u32x4 w; w.x = cvt_pk_bf16(v0[0], v0[1]); w.y = cvt_pk_bf16(v0[2], v0[3]); w.z = cvt_pk_bf16(v1[0], v1[1]); w.w = cvt_pk_bf16(v1[2], v1[3]);
                    *(u32x4*)dst = w;
                }
            }
    }
};
__device__ __forceinline__ void p1_gate_logits(Frame& F) {
    const bf16* H = (const bf16*)(F.ws + WS_H); const bf16* W = (const bf16*)(F.ws + WS_SMALLW); float* gates = (float*)(F.ws + WS_GATES);
    const int gw = F.bx * NWAVES + F.wave, NGW = F.G * NWAVES; const int r = F.lane & 31, hh = F.lane >> 5;
    for (int rb = gw; rb < NTOK / 32; rb += NGW) {
        f32x16 acc; for (int j = 0; j < 16; ++j) acc[j] = 0.f;
        const bf16* ap = H + (size_t)(rb * 32 + r) * D + 8 * hh; const bf16* bp = W + (size_t)r * D + 8 * hh;
        for (int s8 = 0; s8 < 8; ++s8) { bf16x8 av[8], bv[8];
#pragma unroll
            for (int q = 0; q < 8; ++q) { av[q] = *(const bf16x8*)(ap + 16 * (8 * s8 + q)); bv[q] = *(const bf16x8*)(bp + 16 * (8 * s8 + q)); }
#pragma unroll
            for (int q = 0; q < 8; ++q) acc = __builtin_amdgcn_mfma_f32_32x32x16_bf16(av[q], bv[q], acc, 0, 0, 0); }
        if (r < 24) {
#pragma unroll
            for (int reg = 0; reg < 16; ++reg) { const int row = (reg & 3) + 8 * (reg >> 2) + 4 * hh; gates[(size_t)(rb * 32 + row) * 24 + r] = sigmoidf_(acc[reg]); }
        }
    }
}

namespace retf {
constexpr int ROWB = 272;
constexpr int OFF_K = 0, OFF_KT = 128 * ROWB, OFF_VT = 2 * 128 * ROWB, OFF_ZVT = OFF_VT + 32 * ROWB, OFF_ST = OFF_ZVT + 32 * ROWB, OFF_PART = OFF_ST + 32 * ROWB;
static_assert(OFF_PART + 4 * 4096 <= RING_BYTES, "retention LDS map");
}
__device__ __forceinline__ void p2_retention_fast(Frame& F, int unit, bf16* outbase) {
    using namespace retf;
    const int bh = unit >> 3, sl = unit & 7, b = bh >> 2, h = bh & 3;
    const bf16* rq = (const bf16*)(F.ws + WS_RQ); const bf16* rk = (const bf16*)(F.ws + WS_RK); const bf16* rv = (const bf16*)(F.ws + WS_RV);
    const int tid = F.tid, lane = F.lane, wave = F.wave, r = lane & 31, hi = lane >> 5; LAS unsigned char* lds = F.lds;
    const float lg = log2f(1.0f - exp2f(-5.0f - (float)h));
    const int nt = wave & 3, mh = wave >> 2;
    for (int i = tid; i < 32 * ROWB / 4; i += NTHREADS) ((LAS unsigned*)(lds + OFF_ST))[i] = 0u;
    f32x16 ST;
#pragma unroll
    for (int j = 0; j < 16; ++j) ST[j] = 0.f;
    const float gC = exp2f(128.0f * lg);
    u32x4 kreg[4], vreg; bf16x8 qn[8];
    {   const int tok0 = b * SEQ;
#pragma unroll
        for (int i = 0; i < 4; ++i) { const int p = tid + 512 * i, m = p >> 4, cc = p & 15; kreg[i] = *(const u32x4*)(rk + (size_t)(tok0 + m) * 512 + h * 128 + cc * 8); }
        { const int m = tid >> 2, cc = tid & 3; vreg = *(const u32x4*)(rv + (size_t)(tok0 + m) * 1024 + h * 256 + sl * 32 + cc * 8); }
        const bf16* qrow = rq + (size_t)(tok0 + 32 * nt + r) * 512 + h * 128;
#pragma unroll
        for (int s_ = 0; s_ < 8; ++s_) qn[s_] = *(const bf16x8*)(qrow + 16 * s_ + 8 * hi); }
    for (int c = 0; c < SEQ / 128; ++c) {
        const int tok0 = b * SEQ + c * 128;
        __syncthreads();
#pragma unroll
        for (int i = 0; i < 4; ++i) { const int p = tid + 512 * i, m = p >> 4, cc = p & 15; const u32x4 v = kreg[i];
            *(LAS u32x4*)(lds + OFF_K + m * ROWB + cc * 16) = v;
            LAS unsigned short* kt = (LAS unsigned short*)(lds + OFF_KT) + (cc * 8) * (ROWB / 2) + m;
            kt[0 * (ROWB / 2)] = (unsigned short)(v.x & 0xffffu); kt[1 * (ROWB / 2)] = (unsigned short)(v.x >> 16); kt[2 * (ROWB / 2)] = (unsigned short)(v.y & 0xffffu); kt[3 * (ROWB / 2)] = (unsigned short)(v.y >> 16);
            kt[4 * (ROWB / 2)] = (unsigned short)(v.z & 0xffffu); kt[5 * (ROWB / 2)] = (unsigned short)(v.z >> 16); kt[6 * (ROWB / 2)] = (unsigned short)(v.w & 0xffffu); kt[7 * (ROWB / 2)] = (unsigned short)(v.w >> 16); }
        { const int m = tid >> 2, cc = tid & 3; const u32x4 v = vreg;
            const float z = exp2f((float)(127 - m) * lg);
            LAS unsigned short* vt = (LAS unsigned short*)(lds + OFF_VT) + (cc * 8) * (ROWB / 2) + m; LAS unsigned short* zt = (LAS unsigned short*)(lds + OFF_ZVT) + (cc * 8) * (ROWB / 2) + m;
            const unsigned w4[4] = {v.x, v.y, v.z, v.w};
#pragma unroll
            for (int q = 0; q < 4; ++q) { vt[(2 * q) * (ROWB / 2)] = (unsigned short)(w4[q] & 0xffffu); vt[(2 * q + 1) * (ROWB / 2)] = (unsigned short)(w4[q] >> 16);
                zt[(2 * q) * (ROWB / 2)] = (unsigned short)f2bf(lo16(w4[q]) * z); zt[(2 * q + 1) * (ROWB / 2)] = (unsigned short)f2bf(hi16(w4[q]) * z); } }
        bf16x8 qf[8];
#pragma unroll
        for (int s_ = 0; s_ < 8; ++s_) qf[s_] = qn[s_];
        __syncthreads();
        if (c + 1 < SEQ / 128) { const int tok1 = tok0 + 128;
#pragma unroll
            for (int i = 0; i < 4; ++i) { const int p = tid + 512 * i, m = p >> 4, cc = p & 15; kreg[i] = *(const u32x4*)(rk + (size_t)(tok1 + m) * 512 + h * 128 + cc * 8); }
            { const int m = tid >> 2, cc = tid & 3; vreg = *(const u32x4*)(rv + (size_t)(tok1 + m) * 1024 + h * 256 + sl * 32 + cc * 8); }
            const bf16* qrow = rq + (size_t)(tok1 + 32 * nt + r) * 512 + h * 128;
#pragma unroll
            for (int s_ = 0; s_ < 8; ++s_) qn[s_] = *(const bf16x8*)(qrow + 16 * s_ + 8 * hi); }
        f32x16 CR;
#pragma unroll
        for (int j = 0; j < 16; ++j) CR[j] = 0.f;
        if (mh == 0) {
#pragma unroll
            for (int s_ = 0; s_ < 8; ++s_) { const bf16x8 a = *(const LAS bf16x8*)(lds + OFF_ST + r * ROWB + (16 * s_ + 8 * hi) * 2); CR = __builtin_amdgcn_mfma_f32_32x32x16_bf16(a, qf[s_], CR, 0, 0, 0); }
        }
        f32x16 IN_;
#pragma unroll
        for (int j = 0; j < 16; ++j) IN_[j] = 0.f;
#pragma unroll
        for (int mi = 0; mi < 2; ++mi) { const int mt = 2 * mh + mi;
            if (mt <= nt) {
                f32x16 A;
#pragma unroll
                for (int j = 0; j < 16; ++j) A[j] = 0.f;
#pragma unroll
                for (int s_ = 0; s_ < 8; ++s_) { const bf16x8 a = *(const LAS bf16x8*)(lds + OFF_K + (32 * mt + r) * ROWB + (16 * s_ + 8 * hi) * 2); A = __builtin_amdgcn_mfma_f32_32x32x16_bf16(a, qf[s_], A, 0, 0, 0); }
#pragma unroll
                for (int j = 0; j < 16; ++j) { const int dd = (32 * nt + r) - (32 * mt + (j & 3) + 8 * (j >> 2) + 4 * hi); A[j] = dd >= 0 ? A[j] * exp2f((float)dd * lg) : 0.f; }
#pragma unroll
                for (int s2 = 0; s2 < 2; ++s2) { u32x4 w; w.x = cvt_pk_bf16(A[8 * s2 + 0], A[8 * s2 + 1]); w.y = cvt_pk_bf16(A[8 * s2 + 2], A[8 * s2 + 3]); w.z = cvt_pk_bf16(A[8 * s2 + 4], A[8 * s2 + 5]); w.w = cvt_pk_bf16(A[8 * s2 + 6], A[8 * s2 + 7]);
                    const LAS unsigned char* vp = lds + OFF_VT + r * ROWB + (32 * mt + 16 * s2 + 4 * hi) * 2; const u32x2 lo = *(const LAS u32x2*)vp, hi2 = *(const LAS u32x2*)(vp + 16);
                    IN_ = __builtin_amdgcn_mfma_f32_32x32x16_bf16(__builtin_bit_cast(bf16x8, (u32x4){lo.x, lo.y, hi2.x, hi2.y}), __builtin_bit_cast(bf16x8, w), IN_, 0, 0, 0); }
            } }
        if (mh == 1) {
#pragma unroll
            for (int j = 0; j < 16; ++j) ((LAS float*)(lds + OFF_PART))[(nt * 16 + j) * 64 + lane] = IN_[j];
        }
        __syncthreads();
        if (mh == 0) {
            const float xi = exp2f((float)(32 * nt + r + 1) * lg);
            bf16* orow = outbase + (size_t)(tok0 + 32 * nt + r) * 1024 + h * 256 + sl * 32;
#pragma unroll
            for (int q4 = 0; q4 < 4; ++q4) { float o_[4];
#pragma unroll
                for (int e = 0; e < 4; ++e) { const int j = 4 * q4 + e; o_[e] = IN_[j] + ((const LAS float*)(lds + OFF_PART))[(nt * 16 + j) * 64 + lane] + xi * CR[j]; }
                *(u32x2*)(orow + 8 * q4 + 4 * hi) = (u32x2){cvt_pk_bf16(o_[0], o_[1]), cvt_pk_bf16(o_[2], o_[3])}; }
        } else {
#pragma unroll
            for (int j = 0; j < 16; ++j) ST[j] *= gC;
#pragma unroll
            for (int s_ = 0; s_ < 8; ++s_) { const bf16x8 a = *(const LAS bf16x8*)(lds + OFF_ZVT + r * ROWB + (16 * s_ + 8 * hi) * 2); const bf16x8 kb = *(const LAS bf16x8*)(lds + OFF_KT + (32 * nt + r) * ROWB + (16 * s_ + 8 * hi) * 2);
                ST = __builtin_amdgcn_mfma_f32_32x32x16_bf16(a, kb, ST, 0, 0, 0); }
#pragma unroll
            for (int j = 0; j < 16; ++j) { const int dv = (j & 3) + 8 * (j >> 2) + 4 * hi; ((LAS unsigned short*)(lds + OFF_ST))[dv * (ROWB / 2) + 32 * nt + r] = (unsigned short)f2bf(ST[j]); }
        }
    }
    __syncthreads();
}
__device__ __forceinline__ void transpose_kv_tiles(Frame& F, const bf16* src, bf16* dst, int w0, int nw) {
    LAS unsigned short* tl_ = (LAS unsigned short*)(F.lds + F.wave * 16384); const int lane = F.lane;
    for (int tile = w0; tile < 16 * 64 * 2; tile += nw) {
        const int dh = tile & 1, st = (tile >> 1) & 63, bg = tile >> 7;
        const bf16* sp = src + ((size_t)bg * SEQ + st * 64) * 128 + dh * 64; bf16* dp = dst + ((size_t)bg * 128 + dh * 64) * SEQ + st * 64;
#pragma unroll
        for (int i = 0; i < 8; ++i) { const int row = i * 8 + (lane >> 3), c = lane & 7; const u32x4 v = *(const u32x4*)(sp + (size_t)row * 128 + c * 8); LAS unsigned short* q = tl_ + row * 66 + c * 8;
            q[0] = (unsigned short)(v.x & 0xffffu); q[1] = (unsigned short)(v.x >> 16); q[2] = (unsigned short)(v.y & 0xffffu); q[3] = (unsigned short)(v.y >> 16);
            q[4] = (unsigned short)(v.z & 0xffffu); q[5] = (unsigned short)(v.z >> 16); q[6] = (unsigned short)(v.w & 0xffffu); q[7] = (unsigned short)(v.w >> 16); }
        LDS_WAIT(); asm volatile("" ::: "memory");
#pragma unroll
        for (int i = 0; i < 8; ++i) { const int d = i * 8 + (lane >> 3), c = lane & 7; const LAS unsigned short* q = tl_ + (c * 8) * 66 + d;
            u32x4 o; o.x = (unsigned)q[0] | ((unsigned)q[66] << 16); o.y = (unsigned)q[2 * 66] | ((unsigned)q[3 * 66] << 16); o.z = (unsigned)q[4 * 66] | ((unsigned)q[5 * 66] << 16); o.w = (unsigned)q[6 * 66] | ((unsigned)q[7 * 66] << 16);
            *(u32x4*)(dp + (size_t)d * SEQ + c * 8) = o; }
        LDS_WAIT(); asm volatile("" ::: "memory");
    }
}
struct SchedCmp {
    unsigned char* ws; int first, G, c;
    __device__ __forceinline__ bool next(int i, GU& u) const {
        const int L = i * G + c - first; if (L < 0 || L >= 256) return false;
        const int ks = L & 7, mb = L >> 3, m = mb >> 4, bg = mb & 15;
        u.A = (const char*)ws + WS_KV6 + (size_t)m * KV_STRIDE + (size_t)bg * SEQ * 128 * 2 + (size_t)ks * 512 * 2; u.B = (const char*)ws + (m ? W_C1V : W_C1K) + (size_t)ks * 512 * 2;
        u.pm = mb; u.pn = 0; u.kind = ks; u.rows = nullptr; u.nvalid = 0; u.aux = 0; return true;
    }
};
struct EpiCmp {
    static constexpr bool PERM = false;
    float* hid;
    __device__ __forceinline__ void operator()(const f32x4 (&acc)[2][2][4][2], const GU& u, int wr, int wc, int fr, int fq) const {
#pragma unroll
        for (int ai = 0; ai < 2; ++ai)
#pragma unroll
            for (int m = 0; m < 4; ++m) { const int r = 128 * ai + 64 * wr + 16 * m + fr; float* rowp = hid + (size_t)u.kind * (32 * 256 * 128) + ((size_t)u.pm * 256 + r) * 128 + 32 * wc + 4 * fq;
#pragma unroll
                for (int n = 0; n < 2; ++n) *(f32x4*)(rowp + 16 * n) = acc[ai][0][m][n]; }
    }
};
__device__ __forceinline__ float gelu_tanh(float x) { const float u = 0.7978845608028654f * (x + 0.044715f * x * x * x); return 0.5f * x * (1.0f + tanhf(u)); }
__device__ __forceinline__ void p2b_compress_out(Frame& F, const Args& a) {
    const float* hid = (const float*)a.out + (size_t)16 * MiB; const float* cbias = (const float*)(F.ws + WS_SMALLW + 65536 + 2 * 128 * 128 * 2);
    const int gw = F.bx * NWAVES + F.wave, NGW = F.G * NWAVES;
    for (int row = gw; row < 2 * 16 * 256; row += NGW) {
        const int m = row >> 12, n = row & 255; const float* w2 = a.in[m ? IN_CMP_W2_V : IN_CMP_W2_K];
        bf16* dst = (bf16*)(F.ws + (m ? WS_VCMP : WS_KCMP)) + (size_t)(row & 4095) * 128;
        float o0 = 0.f, o1 = 0.f;
        if (n < 255) { const float* hr = hid + (size_t)row * 128;
            for (int e = 0; e < 128; ++e) { float hsum = 0.f;
#pragma unroll
                for (int ks = 0; ks < 8; ++ks) hsum += hr[(size_t)ks * (32 * 256 * 128) + e];
                const float g = gelu_tanh(hsum + cbias[m * 128 + e]); o0 += g * w2[e * 128 + F.lane]; o1 += g * w2[e * 128 + 64 + F.lane]; } }
        dst[F.lane] = (bf16)f2bf(o0); dst[64 + F.lane] = (bf16)f2bf(o1);
        if (m == 1) { bf16* dt = (bf16*)(F.ws + WS_VCMPT) + (size_t)((row >> 8) & 15) * 128 * 256 + n; dt[(size_t)F.lane * 256] = (bf16)f2bf(o0); dt[(size_t)(64 + F.lane) * 256] = (bf16)f2bf(o1); }
    }
}

__device__ __forceinline__ void p3_ret_normalize(Frame& F) {
    bf16* rv = (bf16*)(F.ws + WS_RV); const bf16* rg = (const bf16*)(F.ws + WS_RG);
    const int gw = F.bx * NWAVES + F.wave, NGW = F.G * NWAVES;
    for (int it = gw; it < NTOK * 4; it += NGW) {
        u32x2* p = (u32x2*)(rv + (size_t)it * 256) + F.lane; const u32x2 w = *p; const u32x2 gq = *((const u32x2*)(rg + (size_t)it * 256) + F.lane);
        const float o0 = lo16(w.x), o1 = hi16(w.x), o2 = lo16(w.y), o3 = hi16(w.y);
        const float ss = wave_sum((o0 * o0 + o1 * o1) + (o2 * o2 + o3 * o3));
        const float r = 1.0f / sqrtf(ss * (1.0f / 256.0f) + EPS);
        u32x2 q; q.x = pk2(o0 * r * lo16(gq.x), o1 * r * hi16(gq.x)); q.y = pk2(o2 * r * lo16(gq.y), o3 * r * hi16(gq.y)); *p = q;
    }
}
namespace nsaf {
constexpr int KROW = 272, VROW = 136, KT_BYTES = 64 * KROW, VT_BYTES = 128 * VROW;
constexpr int OFF_K = 0, OFF_V = KT_BYTES, BUF_BYTES = KT_BYTES + VT_BYTES, OFF_IMP = 2 * BUF_BYTES, OFF_MASK = OFF_IMP + 64 * 64 * 4;
constexpr float NEG = -1.0e30f, MASKED = -3.0e38f, CS = 0.08838834764831845f * 1.4426950408889634f;
struct Stage { u32x4 k0, k1, v0, v1; };
__device__ __forceinline__ void stage_load(Stage& st, const bf16* K, const bf16* VT, size_t vpitch, int key0, int tid) {
    const int r0 = tid >> 4, c0 = tid & 15;
    st.k0 = *(const u32x4*)(K + (size_t)(key0 + r0) * 128 + c0 * 8); st.k1 = *(const u32x4*)(K + (size_t)(key0 + r0 + 32) * 128 + c0 * 8);
    const int d0 = tid >> 3, c1 = tid & 7;
    st.v0 = *(const u32x4*)(VT + (size_t)d0 * vpitch + key0 + c1 * 8); st.v1 = *(const u32x4*)(VT + (size_t)(d0 + 64) * vpitch + key0 + c1 * 8);
}
__device__ __forceinline__ void stage_write(const Stage& st, LAS unsigned char* lds, int tid) {
    const int r0 = tid >> 4, c0 = tid & 15;
    *(LAS u32x4*)(lds + OFF_K + r0 * KROW + c0 * 16) = st.k0; *(LAS u32x4*)(lds + OFF_K + (r0 + 32) * KROW + c0 * 16) = st.k1;
    const int d0 = tid >> 3, c1 = tid & 7;
    LAS unsigned char* p0 = lds + OFF_V + d0 * VROW + c1 * 16; LAS unsigned char* p1 = lds + OFF_V + (d0 + 64) * VROW + c1 * 16;
    *(LAS u32x2*)p0 = (u32x2){st.v0.x, st.v0.y}; *(LAS u32x2*)(p0 + 8) = (u32x2){st.v0.z, st.v0.w};
    *(LAS u32x2*)p1 = (u32x2){st.v1.x, st.v1.y}; *(LAS u32x2*)(p1 + 8) = (u32x2){st.v1.z, st.v1.w};
}
template <int MODE>
__device__ __forceinline__ void block_step(const LAS unsigned char* lds, LAS unsigned char* ldstab, const bf16x8 (&qf)[8], f32x16 (&O)[4], float& m, float& l, int blk, int tl_in, int itile, int nvr_in, bool rowsel, float inv_l, int lane_in) {
    int tl = tl_in, nvr = nvr_in, lane = lane_in; LAUNDER(tl); LAUNDER(nvr); LAUNDER(lane);
    const int r = lane & 31, hi = lane >> 5;
    f32x16 S[2];
#pragma unroll
    for (int kh = 0; kh < 2; ++kh) {
#pragma unroll
        for (int j = 0; j < 16; ++j) S[kh][j] = 0.f;
    }
    {
        const unsigned kaddr = (unsigned)(size_t)(lds + OFF_K + r * KROW + 16 * hi);
        u32x4 ka[4], kb[4];
#define NSAF_KRD(dst, t, s4) asm volatile("ds_read_b128 %0, %1 offset:%2" : "=v"(dst) : "v"(kaddr), "i"((t) * 32 * KROW + (s4) * 32))
#define NSAF_KRD4(set, t, s0) do { NSAF_KRD(set[0], t, (s0)); NSAF_KRD(set[1], t, (s0) + 1); NSAF_KRD(set[2], t, (s0) + 2); NSAF_KRD(set[3], t, (s0) + 3); } while (0)
#define NSAF_KWAIT(n, set) asm volatile("s_waitcnt lgkmcnt(" #n ")" : "+v"(set[0]), "+v"(set[1]), "+v"(set[2]), "+v"(set[3]))
#define NSAF_KMMA(set, t, s0) do { _Pragma("unroll") for (int q_ = 0; q_ < 4; ++q_) S[t] = __builtin_amdgcn_mfma_f32_32x32x16_bf16(__builtin_bit_cast(bf16x8, set[q_]), qf[(s0) + q_], S[t], 0, 0, 0); } while (0)
        NSAF_KRD4(ka, 0, 0); NSAF_KRD4(kb, 0, 4);
        NSAF_KWAIT(4, ka); NSAF_KMMA(ka, 0, 0); NSAF_KRD4(ka, 1, 0);
        NSAF_KWAIT(4, kb); NSAF_KMMA(kb, 0, 4); NSAF_KRD4(kb, 1, 4);
        NSAF_KWAIT(4, ka); NSAF_KMMA(ka, 1, 0);
        NSAF_KWAIT(0, kb); NSAF_KMMA(kb, 1, 4);
#undef NSAF_KRD
#undef NSAF_KRD4
#undef NSAF_KWAIT
#undef NSAF_KMMA
    }
    bool need_mask;
    if (MODE <= 1) need_mask = true; else if (MODE == 2) need_mask = (blk == itile); else need_mask = (blk == itile) || (blk == itile - 8);
    float mx = MASKED;
    if (need_mask) {
        int lo_ = -1, hi_ = 63;
        if (MODE <= 1) hi_ = nvr - 64 * blk - 1; else if (MODE == 2) hi_ = tl; else { hi_ = (blk == itile) ? tl : 63; lo_ = (blk == itile - 8) ? tl : -1; }
        lo_ -= 4 * hi; hi_ -= 4 * hi;
#pragma unroll
        for (int kh = 0; kh < 2; ++kh)
#pragma unroll
            for (int j = 0; j < 16; ++j) { const int kc_ = 32 * kh + (j & 3) + 8 * (j >> 2); const bool ok = (kc_ > lo_) & (kc_ <= hi_); const float v = ok ? S[kh][j] : MASKED; S[kh][j] = v; mx = fmaxf(mx, v); }
    } else {
#pragma unroll
        for (int kh = 0; kh < 2; ++kh)
#pragma unroll
            for (int j = 0; j < 16; ++j) mx = fmaxf(mx, S[kh][j]);
    }
    if (MODE == 2) mx = rowsel ? mx : MASKED;
    if (MODE == 1) {
        LAS float* imp = (LAS float*)(ldstab + OFF_IMP) + tl * 64;
#pragma unroll
        for (int kh = 0; kh < 2; ++kh)
#pragma unroll
            for (int j = 0; j < 16; ++j) { const int n = 64 * blk + 32 * kh + (j & 3) + 8 * (j >> 2) + 4 * hi; const float v = S[kh][j]; const float p = __builtin_amdgcn_exp2f(v - m) * inv_l; S[kh][j] = p;
                if (v > 0.5f * MASKED) { __hip_atomic_fetch_add(imp + (n >> 2), p, __ATOMIC_RELAXED, __HIP_MEMORY_SCOPE_WORKGROUP); if ((n & 3) == 3 && (n >> 2) + 1 < 64) __hip_atomic_fetch_add(imp + (n >> 2) + 1, p, __ATOMIC_RELAXED, __HIP_MEMORY_SCOPE_WORKGROUP); } }
    } else {
        mx = fmaxf(mx, __shfl_xor(mx, 32));
        if (__any(mx > m + 8.0f)) { const float mn = fmaxf(m, mx); const float alpha = __builtin_amdgcn_exp2f(m - mn); m = mn; l *= alpha;
            if (MODE != 0) {
#pragma unroll
                for (int dt = 0; dt < 4; ++dt)
#pragma unroll
                    for (int j = 0; j < 16; ++j) O[dt][j] *= alpha; } }
        float rs = 0.f;
        if (MODE == 2) {
#pragma unroll
            for (int kh = 0; kh < 2; ++kh)
#pragma unroll
                for (int j = 0; j < 16; ++j) { const float p = rowsel ? __builtin_amdgcn_exp2f(S[kh][j] - m) : 0.f; S[kh][j] = p; rs += p; }
        } else {
#pragma unroll
            for (int kh = 0; kh < 2; ++kh)
#pragma unroll
                for (int j = 0; j < 16; ++j) { const float p = __builtin_amdgcn_exp2f(S[kh][j] - m); S[kh][j] = p; rs += p; }
        }
        l += rs;
        if (MODE == 0) return;
    }
    bf16x8 pf[2][2];
#pragma unroll
    for (int kh = 0; kh < 2; ++kh)
#pragma unroll
        for (int s2 = 0; s2 < 2; ++s2) { u32x4 w; w.x = cvt_pk_bf16(S[kh][8 * s2 + 0], S[kh][8 * s2 + 1]); w.y = cvt_pk_bf16(S[kh][8 * s2 + 2], S[kh][8 * s2 + 3]); w.z = cvt_pk_bf16(S[kh][8 * s2 + 4], S[kh][8 * s2 + 5]); w.w = cvt_pk_bf16(S[kh][8 * s2 + 6], S[kh][8 * s2 + 7]);
            pf[kh][s2] = __builtin_bit_cast(bf16x8, w); }
    {
        const unsigned vaddr = (unsigned)(size_t)(lds + OFF_V + r * VROW + 8 * hi);
        u32x2 va[8], vb[8];
#define NSAF_VRD(dst, dt, i) asm volatile("ds_read_b64 %0, %1 offset:%2" : "=v"(dst) : "v"(vaddr), "i"((dt) * 32 * VROW + ((i) >> 1) * 32 + ((i) & 1) * 16))
#define NSAF_VRD8(set, dt) do { NSAF_VRD(set[0], dt, 0); NSAF_VRD(set[1], dt, 1); NSAF_VRD(set[2], dt, 2); NSAF_VRD(set[3], dt, 3); NSAF_VRD(set[4], dt, 4); NSAF_VRD(set[5], dt, 5); NSAF_VRD(set[6], dt, 6); NSAF_VRD(set[7], dt, 7); } while (0)
#define NSAF_VWAIT(n, set) asm volatile("s_waitcnt lgkmcnt(" #n ")" : "+v"(set[0]), "+v"(set[1]), "+v"(set[2]), "+v"(set[3]), "+v"(set[4]), "+v"(set[5]), "+v"(set[6]), "+v"(set[7]))
#define NSAF_VMMA(set, dt) do { _Pragma("unroll") for (int ks = 0; ks < 4; ++ks) { const u32x4 a_ = (u32x4){set[2 * ks].x, set[2 * ks].y, set[2 * ks + 1].x, set[2 * ks + 1].y}; \
            O[dt] = __builtin_amdgcn_mfma_f32_32x32x16_bf16(__builtin_bit_cast(bf16x8, a_), pf[ks >> 1][ks & 1], O[dt], 0, 0, 0); } } while (0)
        NSAF_VRD8(va, 0); NSAF_VRD8(vb, 1);
        NSAF_VWAIT(8, va); NSAF_VMMA(va, 0); NSAF_VRD8(va, 2);
        NSAF_VWAIT(8, vb); NSAF_VMMA(vb, 1); NSAF_VRD8(vb, 3);
        NSAF_VWAIT(8, va); NSAF_VMMA(va, 2);
        NSAF_VWAIT(0, vb); NSAF_VMMA(vb, 3);
#undef NSAF_VRD
#undef NSAF_VRD8
#undef NSAF_VWAIT
#undef NSAF_VMMA
    }
}
template <int MODE>
__device__ __forceinline__ void run_pass(LAS unsigned char* lds, const bf16* K, const bf16* VT, size_t vpitch, int jb, int je, const bf16x8 (&qf)[8], f32x16 (&O)[4], float& m, float& l, int tl, int itile, int nvr, unsigned long long selmask, float inv_l, int tid, int lane) {
    Stage st; stage_load(st, K, VT, vpitch, jb * 64, tid); stage_write(st, lds, tid);
    if (jb < je) stage_load(st, K, VT, vpitch, (jb + 1) * 64, tid);
    __syncthreads();
    for (int j = jb; j <= je; ++j) {
        const int cur = (j - jb) & 1;
        if (j < je) { stage_write(st, lds + (cur ^ 1) * BUF_BYTES, tid); if (j + 1 < je) stage_load(st, K, VT, vpitch, (j + 2) * 64, tid); }
        const bool rowsel = (MODE == 2) ? (((selmask >> j) & 1ull) != 0ull) : true;
        if (MODE != 2 || __ballot(rowsel) != 0ull) block_step<MODE>(lds + cur * BUF_BYTES, lds, qf, O, m, l, j, tl, itile, nvr, rowsel, inv_l, lane);
        __syncthreads();
    }
}
}
__device__ __forceinline__ void p3_nsa_fast(Frame& F, const bf16* svT, const bf16* wvT, bf16* outbase) {
    using namespace nsaf;
    unsigned char* ws = F.ws; const int tid = F.tid, lane = F.lane, wave = F.wave; LAS unsigned char* lds = F.lds;
    bf16* nq = (bf16*)(ws + WS_NQ); const float* gates = (const float*)(ws + WS_GATES);
    const int r = lane & 31, hi = lane >> 5, qrow = wave * 32 + r, tl = qrow >> 2, head = qrow & 3;
    for (int u4 = 0; u4 < 4; ++u4) {
        const int pr = F.bx + (u4 >> 1) * F.G; if (pr >= 512) break;
        const int bg = pr >> 5, ii = pr & 31, itile = (u4 & 1) ? (63 - ii) : ii, g = bg & 1, b = bg >> 1;
        const int tok = b * SEQ + itile * 64 + tl, t = itile * 64 + tl;
        const bf16* kc = (const bf16*)(ws + WS_KCMP) + (size_t)bg * 256 * 128; const bf16* vcT = (const bf16*)(ws + WS_VCMPT) + (size_t)bg * 128 * 256;
        const bf16* ks = (const bf16*)(ws + WS_KV6 + 2 * KV_STRIDE) + (size_t)bg * SEQ * 128; const bf16* kw = (const bf16*)(ws + WS_KV6 + 4 * KV_STRIDE) + (size_t)bg * SEQ * 128;
        const bf16* vsT = svT + (size_t)bg * 128 * SEQ; const bf16* vwT = wvT + (size_t)bg * 128 * SEQ;
        __syncthreads();
        for (int i = tid; i < 64 * 64; i += NTHREADS) ((LAS float*)(lds + OFF_IMP))[i] = 0.f;
        bf16x8 qf[8]; bf16* qrowp = nq + (size_t)tok * 1024 + g * 512 + head * 128; bf16* orowp = outbase + (size_t)tok * 1024 + g * 512 + head * 128;
#pragma unroll
        for (int s_ = 0; s_ < 8; ++s_) { const u32x4 w_ = *(const u32x4*)(qrowp + 16 * s_ + 8 * hi);
            u32x4 o_; o_.x = cvt_pk_bf16(lo16(w_.x) * CS, hi16(w_.x) * CS); o_.y = cvt_pk_bf16(lo16(w_.y) * CS, hi16(w_.y) * CS); o_.z = cvt_pk_bf16(lo16(w_.z) * CS, hi16(w_.z) * CS); o_.w = cvt_pk_bf16(lo16(w_.w) * CS, hi16(w_.w) * CS);
            qf[s_] = __builtin_bit_cast(bf16x8, o_); }
        const float g0 = gates[(size_t)tok * 24 + (g * 4 + head) * 3 + 0], g1 = gates[(size_t)tok * 24 + (g * 4 + head) * 3 + 1], g2 = gates[(size_t)tok * 24 + (g * 4 + head) * 3 + 2];
        const int nvr = (t >= 31) ? (((t - 31) >> 4) + 1 > 255 ? 255 : ((t - 31) >> 4) + 1) : 0;
        const int jec = ((4 * itile + 2) >> 6) > 3 ? 3 : ((4 * itile + 2) >> 6);
        f32x16 O[4];
#define NSAF_ZERO_O() do { _Pragma("unroll") for (int dt = 0; dt < 4; ++dt) _Pragma("unroll") for (int j = 0; j < 16; ++j) O[dt][j] = 0.f; } while (0)
#define NSAF_ACCUM(coef, FIRST) do { const float cf_ = (coef); _Pragma("unroll") for (int dt = 0; dt < 4; ++dt) { _Pragma("unroll") for (int q4 = 0; q4 < 4; ++q4) { u32x2* p_ = (u32x2*)(orowp + 32 * dt + 8 * q4 + 4 * hi); \
            float a0_ = cf_ * O[dt][4 * q4], a1_ = cf_ * O[dt][4 * q4 + 1], a2_ = cf_ * O[dt][4 * q4 + 2], a3_ = cf_ * O[dt][4 * q4 + 3]; \
            if (!(FIRST)) { const u32x2 o_ = *p_; a0_ += lo16(o_.x); a1_ += hi16(o_.x); a2_ += lo16(o_.y); a3_ += hi16(o_.y); } \
            *p_ = (u32x2){cvt_pk_bf16(a0_, a1_), cvt_pk_bf16(a2_, a3_)}; } asm volatile("" ::: "memory"); } } while (0)
        float m = NEG, l = 0.f; NSAF_ZERO_O();
        run_pass<0>(lds, kc, vcT, 256, 0, jec, qf, O, m, l, tl, itile, nvr, 0ull, 0.f, tid, lane);
        l += __shfl_xor(l, 32); const float invl = l > 0.f ? 1.0f / l : 0.f;
        run_pass<1>(lds, kc, vcT, 256, 0, jec, qf, O, m, l, tl, itile, nvr, 0ull, invl, tid, lane);
        NSAF_ACCUM(g0, true);
        __syncthreads();
        for (int tk = 0; tk < 8; ++tk) { const int tokl = wave * 8 + tk; float v = ((const LAS float*)(lds + OFF_IMP))[tokl * 64 + lane];
            const bool forced = (lane == 0) || (lane == itile) || (lane == itile - 1); v = (lane > itile) ? -1.0e4f : (forced ? 1.0e4f : v);
            int rank = 0;
#pragma unroll 16
            for (int i = 0; i < 64; ++i) { const float w = __builtin_bit_cast(float, __builtin_amdgcn_readlane(__builtin_bit_cast(int, v), i)); rank += (w > v || (w == v && i < lane)) ? 1 : 0; }
            const unsigned long long mk = __ballot(rank < 16);
            if (lane == 0) { ((LAS unsigned*)(lds + OFF_MASK))[tokl * 2] = (unsigned)mk; ((LAS unsigned*)(lds + OFF_MASK))[tokl * 2 + 1] = (unsigned)(mk >> 32); } }
        __syncthreads();
        const unsigned long long selmask = (unsigned long long)((const LAS unsigned*)(lds + OFF_MASK))[tl * 2] | ((unsigned long long)((const LAS unsigned*)(lds + OFF_MASK))[tl * 2 + 1] << 32);
        m = NEG; l = 0.f; NSAF_ZERO_O();
        run_pass<2>(lds, ks, vsT, SEQ, 0, itile, qf, O, m, l, tl, itile, 0, selmask, 0.f, tid, lane);
        l += __shfl_xor(l, 32); NSAF_ACCUM(l > 0.f ? g1 / l : 0.f, false);
        m = NEG; l = 0.f; NSAF_ZERO_O();
        run_pass<3>(lds, kw, vwT, SEQ, itile > 8 ? itile - 8 : 0, itile, qf, O, m, l, tl, itile, 0, 0ull, 0.f, tid, lane);
        l += __shfl_xor(l, 32); NSAF_ACCUM(l > 0.f ? g2 / l : 0.f, false);
#undef NSAF_ZERO_O
#undef NSAF_ACCUM
    }
    __syncthreads();
}
struct SchedP4 {
    unsigned char* ws; int G, c;
    __device__ __forceinline__ bool next(int i, GU& u) const {
        const int ti = i >> 2, sub = i & 3; const int L = ti * G + c; if (L >= 128 * 4) return false;
        int pm, pn; pg8::tile_map(L, 128, 4, pm, pn);
        const size_t ao = sub == 1 ? WS_RV : sub == 3 ? WS_NQ : WS_H; const size_t bo = sub == 0 ? W_GA : sub == 1 ? W_RO : sub == 2 ? W_GB : W_NO;
        u.A = (const char*)ws + ao + (size_t)pm * 256 * D * 2; u.B = (const char*)ws + bo + (size_t)pn * 256 * D * 2; u.pm = pm; u.pn = pn; u.kind = sub; u.rows = nullptr; u.nvalid = 0; u.aux = 0; return true;
    }
};
struct EpiP4 {
    static constexpr bool PERM = true;
    float* scr;
    bf16* Y;
    static __device__ __forceinline__ u32x2 pk4(const f32x4 v) { return (u32x2){cvt_pk_bf16(v[0], v[1]), cvt_pk_bf16(v[2], v[3])}; }
    static __device__ __forceinline__ f32x4 up4(const u32x2 w) { return (f32x4){lo16(w.x), hi16(w.x), lo16(w.y), hi16(w.y)}; }
    __device__ __forceinline__ void operator()(const f32x4 (&acc)[2][2][4][2], const GU& u, int wr, int wc, int fr, int fq) const {
        u32x2* p0 = (u32x2*)scr + threadIdx.x; u32x2* p1 = p0 + 32 * 512;
        if (u.kind == 0 || u.kind == 2) {
            u32x2* p = u.kind == 0 ? p0 : p1;
#pragma unroll
            for (int ai = 0; ai < 2; ++ai)
#pragma unroll
                for (int m = 0; m < 4; ++m) {
#pragma unroll
                    for (int bj = 0; bj < 2; ++bj) { f32x4 v0 = acc[ai][bj][m][0], v1 = acc[ai][bj][m][1];
#pragma unroll
                        for (int j = 0; j < 4; ++j) { v0[j] = sigmoidf_(v0[j]); v1[j] = sigmoidf_(v1[j]); }
                        p[(2 * bj) * 512] = pk4(v0); p[(2 * bj + 1) * 512] = pk4(v1); }
                    p += 4 * 512; LAUNDER(p); }
        } else if (u.kind == 1) {
#pragma unroll
            for (int ai = 0; ai < 2; ++ai)
#pragma unroll
                for (int m = 0; m < 4; ++m) {
#pragma unroll
                    for (int bj = 0; bj < 2; ++bj) { p0[(2 * bj) * 512] = pk4(up4(p0[(2 * bj) * 512]) * acc[ai][bj][m][0]); p0[(2 * bj + 1) * 512] = pk4(up4(p0[(2 * bj + 1) * 512]) * acc[ai][bj][m][1]); }
                    p0 += 4 * 512; LAUNDER(p0); }
        } else {
            bf16* yb = Y + (size_t)(u.pm * 256 + 64 * wr + fr) * D + u.pn * 256 + 32 * wc + 8 * fq;
#pragma unroll
            for (int ai = 0; ai < 2; ++ai)
#pragma unroll
                for (int m = 0; m < 4; ++m) {
#pragma unroll
                    for (int bj = 0; bj < 2; ++bj) {
                        const f32x4 v0 = up4(p0[(2 * bj) * 512]) + up4(p1[(2 * bj) * 512]) * acc[ai][bj][m][0], v1 = up4(p0[(2 * bj + 1) * 512]) + up4(p1[(2 * bj + 1) * 512]) * acc[ai][bj][m][1];
                        u32x4 w; w.x = cvt_pk_bf16(v0[0], v0[1]); w.y = cvt_pk_bf16(v0[2], v0[3]); w.z = cvt_pk_bf16(v1[0], v1[1]); w.w = cvt_pk_bf16(v1[2], v1[3]);
                        *(u32x4*)(yb + (size_t)(128 * ai + 16 * m) * D + 128 * bj) = w; }
                    p0 += 4 * 512; p1 += 4 * 512; LAUNDER(p0); LAUNDER(p1); }
        }
    }
};

struct SchedMN {
    unsigned char* ws; size_t ao, bo; int G, c;
    __device__ __forceinline__ bool next(int i, GU& u) const {
        const int L = i * G + c; if (L >= 128 * 4) return false; int pm, pn; pg8::tile_map(L, 128, 4, pm, pn);
        u.A = (const char*)ws + ao + (size_t)pm * 256 * D * 2; u.B = (const char*)ws + bo + (size_t)pn * 256 * D * 2; u.pm = pm; u.pn = pn; u.kind = 0; u.rows = nullptr; u.nvalid = 0; u.aux = 0; return true;
    }
};
template <bool SSQ> struct EpiRes {
    static constexpr bool PERM = false;
    const float* basef; const bf16* baseb; float* out; bf16* ob; float* ssq;
    __device__ __forceinline__ void operator()(const f32x4 (&acc)[2][2][4][2], const GU& u, int wr, int wc, int fr, int fq) const {
#pragma unroll
        for (int ai = 0; ai < 2; ++ai)
#pragma unroll
            for (int m = 0; m < 4; ++m) { const int r = u.pm * 256 + 128 * ai + 64 * wr + 16 * m + fr; const size_t off = (size_t)r * D + u.pn * 256 + 32 * wc + 4 * fq; float sq = 0.f;
#pragma unroll
                for (int bj = 0; bj < 2; ++bj)
#pragma unroll
                    for (int n = 0; n < 2; ++n) { const size_t o = off + 128 * bj + 16 * n; f32x4 bv;
                        if (SSQ) bv = *(const f32x4*)(basef + o); else { const u32x2 bw = *(const u32x2*)(baseb + o); bv = (f32x4){lo16(bw.x), hi16(bw.x), lo16(bw.y), hi16(bw.y)}; }
                        const f32x4 v = bv + acc[ai][bj][m][n];
                        if (!SSQ) *(f32x4*)(out + o) = v;
                        u32x2 w; w.x = cvt_pk_bf16(v[0], v[1]); w.y = cvt_pk_bf16(v[2], v[3]); *(u32x2*)(ob + o) = w; sq += (v[0] * v[0] + v[1] * v[1]) + (v[2] * v[2] + v[3] * v[3]); }
                if (SSQ) { sq += __shfl_xor(sq, 16); sq += __shfl_xor(sq, 32); if (fq == 0) ssq[(size_t)r * 16 + u.pn * 4 + wc] = sq; }
            }
    }
};
struct EpiQ {
    static constexpr bool PERM = true;
    const float* ssq; bf16* Q;
    __device__ __forceinline__ void operator()(const f32x4 (&acc)[2][2][4][2], const GU& u, int wr, int wc, int fr, int fq) const {
#pragma unroll
        for (int ai = 0; ai < 2; ++ai)
#pragma unroll
            for (int m = 0; m < 4; ++m) { const int r = u.pm * 256 + 128 * ai + 64 * wr + 16 * m + fr; const f32x4* sp = (const f32x4*)(ssq + (size_t)r * 16);
                const f32x4 a = sp[0], b = sp[1], c = sp[2], d = sp[3]; const float tot = ((a[0] + a[1]) + (a[2] + a[3])) + ((b[0] + b[1]) + (b[2] + b[3])) + ((c[0] + c[1]) + (c[2] + c[3])) + ((d[0] + d[1]) + (d[2] + d[3]));
                const float rstd = 1.0f / sqrtf(tot * (1.0f / D) + EPS);
#pragma unroll
                for (int bj = 0; bj < 2; ++bj) { const f32x4 v0 = acc[ai][bj][m][0] * rstd, v1 = acc[ai][bj][m][1] * rstd;
                    u32x4 w; w.x = cvt_pk_bf16(v0[0], v0[1]); w.y = cvt_pk_bf16(v0[2], v0[3]); w.z = cvt_pk_bf16(v1[0], v1[1]); w.w = cvt_pk_bf16(v1[2], v1[3]);
                    *(u32x4*)(Q + (size_t)r * D + u.pn * 256 + 128 * bj + 32 * wc + 8 * fq) = w; } }
    }
};

namespace xatf {
constexpr int KROW = 528, VROW = 136, KT_BYTES = 64 * KROW, OFF_K = 0, OFF_V = KT_BYTES;
constexpr float NEG = -1.0e30f, CS = 0.0625f * 1.4426950408889634f;
struct Stage { u32x4 k[4]; u32x4 v[2]; };
__device__ __forceinline__ void stage_load(Stage& st, const bf16* K, const bf16* VT, int key0, int tid) {
#pragma unroll
    for (int i = 0; i < 4; ++i) { const int p = tid + 512 * i, row = p >> 5, c = p & 31; st.k[i] = *(const u32x4*)(K + (size_t)(key0 + row) * 2048 + c * 8); }
#pragma unroll
    for (int i = 0; i < 2; ++i) { const int p = tid + 512 * i, d = p >> 3, c = p & 7; st.v[i] = *(const u32x4*)(VT + (size_t)d * 256 + key0 + c * 8); }
}
__device__ __forceinline__ void stage_write(const Stage& st, LAS unsigned char* lds, int tid) {
#pragma unroll
    for (int i = 0; i < 4; ++i) { const int p = tid + 512 * i, row = p >> 5, c = p & 31; *(LAS u32x4*)(lds + OFF_K + row * KROW + c * 16) = st.k[i]; }
#pragma unroll
    for (int i = 0; i < 2; ++i) { const int p = tid + 512 * i, d = p >> 3, c = p & 7; LAS unsigned char* q = lds + OFF_V + d * VROW + c * 16;
        *(LAS u32x2*)q = (u32x2){st.v[i].x, st.v[i].y}; *(LAS u32x2*)(q + 8) = (u32x2){st.v[i].z, st.v[i].w}; }
}
__device__ __forceinline__ void block_step(const LAS unsigned char* lds, const bf16x8 (&qf)[16], f32x16 (&O)[4], float& m, float& l, int lane) {
    const int r = lane & 31, hi = lane >> 5;
    f32x16 S[2];
#pragma unroll
    for (int kh = 0; kh < 2; ++kh) {
#pragma unroll
        for (int j = 0; j < 16; ++j) S[kh][j] = 0.f;
#pragma unroll
        for (int s_ = 0; s_ < 16; ++s_) { const bf16x8 a = *(const LAS bf16x8*)(lds + OFF_K + (kh * 32 + r) * KROW + (16 * s_ + 8 * hi) * 2); S[kh] = __builtin_amdgcn_mfma_f32_32x32x16_bf16(a, qf[s_], S[kh], 0, 0, 0); }
    }
    float mx = NEG;
#pragma unroll
    for (int kh = 0; kh < 2; ++kh)
#pragma unroll
        for (int j = 0; j < 16; ++j) { const float v = S[kh][j] * CS; S[kh][j] = v; mx = fmaxf(mx, v); }
    mx = fmaxf(mx, __shfl_xor(mx, 32));
    const float mn = fmaxf(m, mx); const float alpha = __builtin_amdgcn_exp2f(m - mn); m = mn; float rs = 0.f;
#pragma unroll
    for (int kh = 0; kh < 2; ++kh)
#pragma unroll
        for (int j = 0; j < 16; ++j) { const float p = __builtin_amdgcn_exp2f(S[kh][j] - mn); S[kh][j] = p; rs += p; }
    l = l * alpha + rs;
#pragma unroll
    for (int dt = 0; dt < 4; ++dt)
#pragma unroll
        for (int j = 0; j < 16; ++j) O[dt][j] *= alpha;
    bf16x8 pf[2][2];
#pragma unroll
    for (int kh = 0; kh < 2; ++kh)
#pragma unroll
        for (int s2 = 0; s2 < 2; ++s2) { u32x4 w; w.x = cvt_pk_bf16(S[kh][8 * s2 + 0], S[kh][8 * s2 + 1]); w.y = cvt_pk_bf16(S[kh][8 * s2 + 2], S[kh][8 * s2 + 3]); w.z = cvt_pk_bf16(S[kh][8 * s2 + 4], S[kh][8 * s2 + 5]); w.w = cvt_pk_bf16(S[kh][8 * s2 + 6], S[kh][8 * s2 + 7]);
            pf[kh][s2] = __builtin_bit_cast(bf16x8, w); }
#pragma unroll
    for (int dt = 0; dt < 4; ++dt)
#pragma unroll
        for (int kh = 0; kh < 2; ++kh)
#pragma unroll
            for (int s2 = 0; s2 < 2; ++s2) { const LAS unsigned char* vp = lds + OFF_V + (dt * 32 + r) * VROW + (32 * kh + 16 * s2 + 4 * hi) * 2;
                const u32x2 lo = *(const LAS u32x2*)vp, hi2 = *(const LAS u32x2*)(vp + 16); const u32x4 av = (u32x4){lo.x, lo.y, hi2.x, hi2.y};
                O[dt] = __builtin_amdgcn_mfma_f32_32x32x16_bf16(__builtin_bit_cast(bf16x8, av), pf[kh][s2], O[dt], 0, 0, 0); }
}
}
__device__ __forceinline__ void p7_xattn_fast(Frame& F, const bf16* vT, bf16* outbase) {
    using namespace xatf;
    bf16* Q = (bf16*)(F.ws + WS_NQ); const bf16* KV = (const bf16*)(F.ws + WS_MEMKV);
    const int tid = F.tid, lane = F.lane, wave = F.wave, r = lane & 31, hi = lane >> 5; LAS unsigned char* lds = F.lds;
    for (int u = F.bx; u < BATCH * 4 * 16; u += F.G) {
        const int tt = u & 15, bh = u >> 4, b = bh >> 2, h = bh & 3; const int tok = b * SEQ + tt * 256 + wave * 32 + r;
        bf16* qrow = Q + (size_t)tok * D + h * 256; bf16* orow = outbase + (size_t)tok * D + h * 256; const bf16* Kb = KV + (size_t)(b * NMEM) * 2048 + h * 256;
        bf16x8 qf[16];
#pragma unroll
        for (int s_ = 0; s_ < 16; ++s_) qf[s_] = *(const bf16x8*)(qrow + 16 * s_ + 8 * hi);
#pragma unroll
        for (int half = 0; half < 2; ++half) {
            const bf16* VTb = vT + ((size_t)bh * 256 + half * 128) * 256;
            f32x16 O[4]; float m = NEG, l = 0.f;
#pragma unroll
            for (int dt = 0; dt < 4; ++dt)
#pragma unroll
                for (int j = 0; j < 16; ++j) O[dt][j] = 0.f;
            for (int j = 0; j < 4; ++j) {
                __syncthreads(); { Stage st; stage_load(st, Kb, VTb, j * 64, tid); stage_write(st, lds, tid); } __syncthreads();
                block_step(lds, qf, O, m, l, lane);
            }
            l += __shfl_xor(l, 32); const float inv = 1.0f / l;
#pragma unroll
            for (int dt = 0; dt < 4; ++dt)
#pragma unroll
                for (int q4 = 0; q4 < 4; ++q4) *(u32x2*)(orow + half * 128 + 32 * dt + 8 * q4 + 4 * hi) = (u32x2){cvt_pk_bf16(O[dt][4 * q4] * inv, O[dt][4 * q4 + 1] * inv), cvt_pk_bf16(O[dt][4 * q4 + 2] * inv, O[dt][4 * q4 + 3] * inv)};
        }
    }
    __syncthreads();
}
__device__ __forceinline__ void transpose_memv_tiles(Frame& F, bf16* vT, int w0, int nw) {
    LAS unsigned short* tl_ = (LAS unsigned short*)(F.lds + F.wave * 16384); const int lane = F.lane; const bf16* KV = (const bf16*)(F.ws + WS_MEMKV);
    for (int tile = w0; tile < 32 * 16; tile += nw) {
        const int dq = tile & 3, kq = (tile >> 2) & 3, bh = tile >> 4, b = bh >> 2, h = bh & 3;
        const bf16* sp = KV + (size_t)(b * NMEM + kq * 64) * 2048 + 1024 + h * 256 + dq * 64; bf16* dp = vT + ((size_t)bh * 256 + dq * 64) * 256 + kq * 64;
#pragma unroll
        for (int i = 0; i < 8; ++i) { const int row = i * 8 + (lane >> 3), c = lane & 7; const u32x4 v = *(const u32x4*)(sp + (size_t)row * 2048 + c * 8); LAS unsigned short* q = tl_ + row * 66 + c * 8;
            q[0] = (unsigned short)(v.x & 0xffffu); q[1] = (unsigned short)(v.x >> 16); q[2] = (unsigned short)(v.y & 0xffffu); q[3] = (unsigned short)(v.y >> 16);
            q[4] = (unsigned short)(v.z & 0xffffu); q[5] = (unsigned short)(v.z >> 16); q[6] = (unsigned short)(v.w & 0xffffu); q[7] = (unsigned short)(v.w >> 16); }
        LDS_WAIT(); asm volatile("" ::: "memory");
#pragma unroll
        for (int i = 0; i < 8; ++i) { const int d = i * 8 + (lane >> 3), c = lane & 7; const LAS unsigned short* q = tl_ + (c * 8) * 66 + d;
            u32x4 o; o.x = (unsigned)q[0] | ((unsigned)q[66] << 16); o.y = (unsigned)q[2 * 66] | ((unsigned)q[3 * 66] << 16); o.z = (unsigned)q[4 * 66] | ((unsigned)q[5 * 66] << 16); o.w = (unsigned)q[6 * 66] | ((unsigned)q[7 * 66] << 16);
            *(u32x4*)(dp + (size_t)d * 256 + c * 8) = o; }
        LDS_WAIT(); asm volatile("" ::: "memory");
    }
}

__device__ __forceinline__ void p9_route(Frame& F, const Args& a) {
    unsigned char* ws = F.ws; const float* X2 = a.out;
    const float* gff = a.in[IN_NORM_FFN_G]; const float* wgrp = a.in[IN_W_GRP]; const float* bgrp = a.in[IN_B_GRP]; const float* wrt = a.in[IN_W_RT]; const float* brt = a.in[IN_B_RT];
    float* wts = (float*)(ws + WS_ROUTE); float* rstd2 = wts + 2 * NTOK; int* lists = (int*)(ws + WS_LISTS);
    const int gw = F.bx * NWAVES + F.wave, NGW = F.G * NWAVES, lane = F.lane;
    f32x4 vnext[4];
    if (gw < NTOK) {
#pragma unroll
        for (int j = 0; j < 4; ++j) vnext[j] = ((const f32x4*)(X2 + (size_t)gw * D) + lane)[64 * j]; }
    int my_ea = -1, my_eb = -1, my_tok = -1, it_ = 0; float my_w1 = 0.f, my_w2 = 0.f, my_rstd = 0.f;
    for (int tok = gw; tok < NTOK; tok += NGW, ++it_) {
        const f32x4* gr = (const f32x4*)gff + lane;
        f32x4 v[4]; float s = 0.f;
#pragma unroll
        for (int j = 0; j < 4; ++j) { v[j] = vnext[j]; s += (v[j].x * v[j].x + v[j].y * v[j].y) + (v[j].z * v[j].z + v[j].w * v[j].w); }
        if (tok + NGW < NTOK) {
#pragma unroll
            for (int j = 0; j < 4; ++j) vnext[j] = ((const f32x4*)(X2 + (size_t)(tok + NGW) * D) + lane)[64 * j]; }
        const float rstd = 1.0f / sqrtf(wave_sum(s) * (1.f / D) + EPS);
        float lg[4] = {0.f, 0.f, 0.f, 0.f};
        const float* pwg = wgrp + (size_t)(4 * lane) * 4;
#pragma unroll
        for (int j = 0; j < 4; ++j) { const f32x4 gg = gr[64 * j];
#pragma unroll
            for (int c = 0; c < 4; ++c) { const float hf = v[j][c] * rstd * gg[c]; v[j][c] = hf; const f32x4 wg = *(const f32x4*)(pwg + c * 4);
#pragma unroll
                for (int i = 0; i < 4; ++i) lg[i] += hf * wg[i]; }
            pwg += 256 * 4; LAUNDER(pwg); }
#pragma unroll
        for (int i = 0; i < 4; ++i) lg[i] = wave_sum(lg[i]) + bgrp[i];
        int grp = 0; float gm = lg[0];
#pragma unroll
        for (int i = 1; i < 4; ++i) if (lg[i] > gm) { gm = lg[i]; grp = i; }
        grp = __builtin_amdgcn_readfirstlane(grp);
        float gs = 0.f;
#pragma unroll
        for (int i = 0; i < 4; ++i) gs += expf(lg[i] - gm);
        const float g_gate = 1.0f / gs;
        float lq[8];
#pragma unroll
        for (int i = 0; i < 8; ++i) lq[i] = 0.f;
        const float* pwr = wrt + (size_t)(4 * lane) * 32 + grp * 8;
#pragma unroll
        for (int j = 0; j < 4; ++j) {
#pragma unroll
            for (int c = 0; c < 4; ++c) { const float hf = v[j][c]; const f32x4 wa = *(const f32x4*)(pwr + c * 32), wb = *(const f32x4*)(pwr + c * 32 + 4);
#pragma unroll
                for (int i = 0; i < 4; ++i) { lq[i] += hf * wa[i]; lq[4 + i] += hf * wb[i]; } }
            pwr += 256 * 32; LAUNDER(pwr); }
#pragma unroll
        for (int i = 0; i < 8; ++i) lq[i] = wave_sum(lq[i]) + brt[grp * 8 + i];
        int i1 = 0; float m1 = lq[0];
#pragma unroll
        for (int i = 1; i < 8; ++i) if (lq[i] > m1) { m1 = lq[i]; i1 = i; }
        int i2 = -1; float m2 = -3.0e38f;
#pragma unroll
        for (int i = 0; i < 8; ++i) if (i != i1 && lq[i] > m2) { m2 = lq[i]; i2 = i; }
        const float e2 = expf(m2 - m1), den = 1.0f + e2; const float w1 = g_gate / den, w2 = g_gate * e2 / den;
        if (lane == it_) { my_ea = grp * 8 + i1; my_eb = grp * 8 + i2; my_tok = tok; my_w1 = w1; my_w2 = w2; my_rstd = rstd; }
    }
    if (my_tok >= 0) {
        const unsigned sa = __hip_atomic_fetch_add(F.ctl + CW_ECNT + 64 * my_ea, 1u, __ATOMIC_RELAXED, __HIP_MEMORY_SCOPE_AGENT);
        const unsigned sb = __hip_atomic_fetch_add(F.ctl + CW_ECNT + 64 * my_eb, 1u, __ATOMIC_RELAXED, __HIP_MEMORY_SCOPE_AGENT);
        lists[(size_t)my_ea * NTOK + sa] = my_tok * 2; lists[(size_t)my_eb * NTOK + sb] = my_tok * 2 + 1;
        wts[my_tok * 2] = my_w1; wts[my_tok * 2 + 1] = my_w2; rstd2[my_tok] = my_rstd;
    }
    int ib = 0;
    for (int e_ = 0; e_ < NEXP; ++e_) {
        transpose_matrix(F, ib, a.in[IN_W_E1] + (size_t)e_ * D * DEXP, DEXP, D, 0, DEXP, (bf16*)(ws + WS_W13) + (size_t)e_ * D * D, D, 1, 0, gff, 1.0f);
        transpose_matrix(F, ib, a.in[IN_W_E3] + (size_t)e_ * D * DEXP, DEXP, D, 0, DEXP, (bf16*)(ws + WS_W13) + (size_t)e_ * D * D, D, 1, 1, gff, 1.0f);
        transpose_matrix(F, ib, a.in[IN_W_E2] + (size_t)e_ * DEXP * D, D, DEXP, 0, D, (bf16*)(ws + WS_W2) + (size_t)e_ * D * DEXP, DEXP, 0, 0, nullptr, 1.0f);
    }
}

__device__ __forceinline__ void moe_tiles(Frame& F) {
    __syncthreads();
    if (F.tid == 0) { unsigned accu = 0u; for (int e = 0; e < NEXP; ++e) { const unsigned c = __hip_atomic_load(F.ctl + CW_ECNT + 64 * e, __ATOMIC_RELAXED, __HIP_MEMORY_SCOPE_AGENT); F.MISC[16 + e] = accu; F.MISC[64 + e] = c; accu += (c + 255u) >> 8; } F.MISC[16 + NEXP] = accu; }
    __syncthreads();
}
template <int WHICH> struct SchedMoe {
    volatile LAS unsigned* MISC; unsigned char* ws; int G, c;
    __device__ __forceinline__ bool next(int i, GU& u) const {
        const int L = i * G + c; const int T = (int)MISC[16 + NEXP]; if (L >= 4 * T) return false;
        const int tau = L >> 2, pn = L & 3; int e = 0;
        for (int k = 1; k < NEXP; ++k) if ((int)MISC[16 + k] <= tau) e = k;
        const int lt = tau - (int)MISC[16 + e]; const int cnt = (int)MISC[64 + e]; int nv = cnt - lt * 256; nv = nv > 256 ? 256 : nv;
        u.rows = (const int*)(ws + WS_LISTS) + (size_t)e * NTOK + lt * 256; u.nvalid = nv; u.pm = tau; u.pn = pn; u.kind = 0; u.aux = e;
        if (WHICH == 0) { u.A = (const char*)ws + WS_X2B; u.B = (const char*)ws + WS_W13 + (size_t)e * D * D * 2 + (size_t)pn * 256 * D * 2; }
        else { u.A = (const char*)ws + WS_H1 + (size_t)tau * 256 * DEXP * 2; u.B = (const char*)ws + WS_W2 + (size_t)e * D * DEXP * 2 + (size_t)pn * 256 * DEXP * 2; }
        return true;
    }
};
struct EpiMoe1 {
    static constexpr bool PERM = true;
    const float* rstd2; bf16* H1;
    __device__ __forceinline__ void operator()(const f32x4 (&acc)[2][2][4][2], const GU& u, int wr, int wc, int fr, int fq) const {
        char* hb = (char*)H1 + (size_t)u.pm * 256 * DEXP * 2;
        const int j00 = (u.pn * 256 + 32 * wc + 8 * fq) >> 1;
#pragma unroll
        for (int ai = 0; ai < 2; ++ai) {
            int r = 128 * ai + 64 * wr + fr; LAUNDER(r);
#pragma unroll
            for (int m = 0; m < 4; ++m) { const bool ok = r < u.nvalid; const float rs = ok ? rstd2[u.rows[r] >> 1] : 0.f;
#pragma unroll
                for (int bj = 0; bj < 2; ++bj) { const f32x4 a1 = acc[ai][bj][m][0] * rs, a3 = acc[ai][bj][m][1] * rs; f32x4 hv;
#pragma unroll
                    for (int j = 0; j < 4; ++j) hv[j] = a1[j] * sigmoidf_(a1[j]) * a3[j];
                    u32x2 w; w.x = cvt_pk_bf16(hv[0], hv[1]); w.y = cvt_pk_bf16(hv[2], hv[3]); *(u32x2*)(hb + (unsigned)((r * DEXP + j00 + 64 * bj) * 2)) = w; }
                r += 16; LAUNDER(r); }
        }
    }
};
struct EpiMoe2 {
    static constexpr bool PERM = true;
    const float* wts; bf16* Y0; bf16* Y1;
    __device__ __forceinline__ void operator()(const f32x4 (&acc)[2][2][4][2], const GU& u, int wr, int wc, int fr, int fq) const {
#pragma unroll
        for (int ai = 0; ai < 2; ++ai)
#pragma unroll
            for (int m = 0; m < 4; ++m) { const int r = 128 * ai + 64 * wr + 16 * m + fr;
                if (r < u.nvalid) { const int ent = u.rows[r]; const float w8 = wts[ent]; bf16* dst = ((ent & 1) ? Y1 : Y0) + (size_t)(ent >> 1) * D + u.pn * 256 + 32 * wc + 8 * fq;
#pragma unroll
                    for (int bj = 0; bj < 2; ++bj) { const f32x4 v0 = acc[ai][bj][m][0] * w8, v1 = acc[ai][bj][m][1] * w8;
                        u32x4 w; w.x = cvt_pk_bf16(v0[0], v0[1]); w.y = cvt_pk_bf16(v0[2], v0[3]); w.z = cvt_pk_bf16(v1[0], v1[1]); w.w = cvt_pk_bf16(v1[2], v1[3]);
                        *(u32x4*)(dst + 128 * bj) = w; } } }
    }
};

__device__ __forceinline__ void p12_final(Frame& F, const Args& a) {
    const bf16* Y0 = (const bf16*)(F.ws + WS_YS0); const bf16* Y1 = (const bf16*)(F.ws + WS_YS1); const float* g = a.in[IN_NORM_F_G];
    const int gw = F.bx * NWAVES + F.wave, NGW = F.G * NWAVES, lane = F.lane;
    for (int tok = gw; tok < NTOK; tok += NGW) {
        f32x4* xr = (f32x4*)(a.out + (size_t)tok * D) + lane; const u32x2* y0 = (const u32x2*)(Y0 + (size_t)tok * D) + lane; const u32x2* y1 = (const u32x2*)(Y1 + (size_t)tok * D) + lane;
        f32x4 v[4]; float s = 0.f;
#pragma unroll
        for (int j = 0; j < 4; ++j) { v[j] = xr[64 * j]; const u32x2 p = y0[64 * j], q = y1[64 * j];
            v[j].x += lo16(p.x) + lo16(q.x); v[j].y += hi16(p.x) + hi16(q.x); v[j].z += lo16(p.y) + lo16(q.y); v[j].w += hi16(p.y) + hi16(q.y);
            s += (v[j].x * v[j].x + v[j].y * v[j].y) + (v[j].z * v[j].z + v[j].w * v[j].w); }
        const float rstd = 1.0f / sqrtf(wave_sum(s) * (1.f / D) + EPS);
#pragma unroll
        for (int j = 0; j < 4; ++j) { const f32x4 gg = ((const f32x4*)g + lane)[64 * j]; xr[64 * j] = v[j] * rstd * gg; }
    }
}

constexpr int N_PHASES = 14;
__global__ void __launch_bounds__(NTHREADS, 2) fwd(Args args) {
    extern __shared__ __attribute__((aligned(16))) unsigned char lds[];
    Frame F;
    F.lds = (LAS unsigned char*)lds; F.MISC = (volatile LAS unsigned*)(F.lds + MISC_OFF);
    F.tid = threadIdx.x; F.lane = F.tid & 63; F.wave = __builtin_amdgcn_readfirstlane(F.tid >> 6); F.G = gridDim.x; F.bx = blockIdx.x;
    F.ws = args.ws; F.ctl = (unsigned*)(args.ws + WS_CTL);
    unsigned char* ws = args.ws;
    for (int u = F.tid; u < (LDS_BYTES - RING_BYTES) / 4; u += NTHREADS) ((LAS unsigned*)(F.lds + RING_BYTES))[u] = 0u;
    __syncthreads();
    const int lo = args.ph_lo, hi = args.ph_hi;
    const bool one = (hi - lo) > 1;
    XcdBarrier bar; bar.bar = F.ctl + CW_BAR; bar.x = 0; bar.st = F.MISC + 8;
    if (one) bar = xcd_barrier_post(F.ctl + CW_BAR, F.MISC + 8);
#define IN(k) (lo <= (k) && (k) < hi && phase_begin(F))
#define SEAM(k) do { if (lo <= (k) && (k) + 1 < hi) xcd_barrier(bar); } while (0)

    if (IN(0)) { p0_prologue(F, args); } SEAM(0);
    if (IN(1)) {
        SchedP1 S{ws, F.G, F.bx};
        EpiP1 E{ws};
        pg8::gemm_phase<EpiP1, SchedP1, false>(F.lds, D, D, D, S, E);
        p1_gate_logits(F);
    } SEAM(1);
    if (IN(2)) {
        p2_retention_fast(F, F.bx, (bf16*)(ws + WS_RV));
        { const int w0 = F.bx * NWAVES + F.wave, nw = F.G * NWAVES;
            transpose_kv_tiles(F, (const bf16*)(ws + WS_KV6 + 3 * KV_STRIDE), (bf16*)args.out, w0, nw);
            transpose_kv_tiles(F, (const bf16*)(ws + WS_KV6 + 5 * KV_STRIDE), (bf16*)((unsigned char*)args.out + KV_STRIDE), w0, nw);
            transpose_memv_tiles(F, (bf16*)(ws + WS_MEMVT), w0, nw); }
        __syncthreads();
        { SchedCmp S{ws, 0, F.G, F.bx}; EpiCmp E{(float*)args.out + (size_t)16 * MiB};
            pg8::gemm_phase<EpiCmp, SchedCmp, false>(F.lds, 512, 2048, 4096, S, E); }
    } SEAM(2);
    if (IN(3)) { p2b_compress_out(F, args); } SEAM(3);
    if (IN(4)) { p3_ret_normalize(F); p3_nsa_fast(F, (const bf16*)args.out, (const bf16*)((const unsigned char*)args.out + KV_STRIDE), (bf16*)(ws + WS_NQ)); } SEAM(4);
    if (IN(5)) {
        SchedP4 S{ws, F.G, F.bx};
        EpiP4 E{(float*)(ws + WS_P4SCR) + (size_t)F.bx * (2 * 32 * 512 * 4), (bf16*)(ws + WS_Y)};
        pg8::gemm_phase<EpiP4, SchedP4, false>(F.lds, D, D, D, S, E);
    } SEAM(5);
    if (IN(6)) {
        SchedMN S{ws, WS_Y, W_OUT, F.G, F.bx}; EpiRes<true> E{args.in[IN_X], nullptr, nullptr, (bf16*)(ws + WS_X1B), (float*)(ws + WS_SSQ)};
        pg8::gemm_phase<EpiRes<true>, SchedMN, false>(F.lds, D, D, D, S, E);
    } SEAM(6);
    if (IN(7)) {
        SchedMN S{ws, WS_X1B, W_XQ, F.G, F.bx}; EpiQ E{(const float*)(ws + WS_SSQ), (bf16*)(ws + WS_NQ)};
        pg8::gemm_phase<EpiQ, SchedMN, false>(F.lds, D, D, D, S, E);
    } SEAM(7);
    if (IN(8)) { p7_xattn_fast(F, (const bf16*)(ws + WS_MEMVT), (bf16*)(ws + WS_NQ)); } SEAM(8);
    if (IN(9)) {
        SchedMN S{ws, WS_NQ, W_XO, F.G, F.bx}; EpiRes<false> E{nullptr, (const bf16*)(ws + WS_X1B), args.out, (bf16*)(ws + WS_X2B), nullptr};
        pg8::gemm_phase<EpiRes<false>, SchedMN, false>(F.lds, D, D, D, S, E);
    } SEAM(9);
    if (IN(10)) { p9_route(F, args); } SEAM(10);
    if (IN(11)) {
        moe_tiles(F);
        SchedMoe<0> S{F.MISC, ws, F.G, F.bx}; EpiMoe1 E{(const float*)(ws + WS_ROUTE) + 2 * NTOK, (bf16*)(ws + WS_H1)};
        pg8::gemm_phase<EpiMoe1, SchedMoe<0>, true>(F.lds, D, D, D, S, E);
    } SEAM(11);
    if (IN(12)) {
        moe_tiles(F);
        SchedMoe<1> S{F.MISC, ws, F.G, F.bx}; EpiMoe2 E{(const float*)(ws + WS_ROUTE), (bf16*)(ws + WS_YS0), (bf16*)(ws + WS_YS1)};
        pg8::gemm_phase<EpiMoe2, SchedMoe<1>, false>(F.lds, DEXP, DEXP, DEXP, S, E);
    } SEAM(12);
    if (IN(13)) { p12_final(F, args); }
#undef IN
#undef SEAM
}

extern "C" void kernel_launch(void* const* d_in, const int* in_sizes, int n_in, void* d_out, int out_size, void* d_ws, size_t ws_size, hipStream_t stream) {
    static int grid = 0;
    if (grid == 0) {
        if (n_in != 27 || in_sizes[0] != NTOK * D || out_size != NTOK * D || ws_size < WS_END) {
            fprintf(stderr, "kernel_launch: unexpected shapes: n_in %d in0 %d out %d ws %zu (need %zu)\n", n_in, n_in > 0 ? in_sizes[0] : -1, out_size, ws_size, (size_t)WS_END); grid = -1; return; }
        int dev = 0, cus = 0, per_cu = 0;
        if (hipGetDevice(&dev) != hipSuccess || hipDeviceGetAttribute(&cus, hipDeviceAttributeMultiprocessorCount, dev) != hipSuccess) { grid = -1; return; }
        if (hipFuncSetAttribute((const void*)fwd, hipFuncAttributeMaxDynamicSharedMemorySize, LDS_BYTES) != hipSuccess) { fprintf(stderr, "kernel_launch: hipFuncSetAttribute failed\n"); grid = -1; return; }
        if (hipOccupancyMaxActiveBlocksPerMultiprocessor(&per_cu, (const void*)fwd, NTHREADS, LDS_BYTES) != hipSuccess || per_cu < 1) fprintf(stderr, "kernel_launch: occupancy query reports %d\n", per_cu);
        (void)hipGetLastError();
        grid = cus < 256 ? cus : 256;
    }
    if (grid < 0) return;
    (void)hipMemsetAsync((char*)d_ws + WS_CTL, 0, CTL_ZERO_BYTES, stream);
    Args a{};
    for (int i = 0; i < 27; ++i) a.in[i] = (const float*)d_in[i];
    a.out = (float*)d_out; a.ws = (unsigned char*)d_ws;
#if MK_N_LAUNCHES == 1
    a.ph_lo = 0; a.ph_hi = N_PHASES;
    hipLaunchKernelGGL(fwd, dim3(grid), dim3(NTHREADS), LDS_BYTES, stream, a);
#else
    for (int p = 0; p < N_PHASES; ++p) { a.ph_lo = p; a.ph_hi = p + 1; hipLaunchKernelGGL(fwd, dim3(grid), dim3(NTHREADS), LDS_BYTES, stream, a); }
#endif
}
```

```cpp
#include <hip/hip_runtime.h>
#include <cstdio>
#include <cstdint>

#ifndef MK_N_LAUNCHES
#define MK_N_LAUNCHES 1
#endif

#define LAS __attribute__((address_space(3)))
#define GAS __attribute__((address_space(1)))
#define HD __host__ __device__
#define HDI __host__ __device__ __attribute__((always_inline)) inline
typedef unsigned short bf16;
typedef short bf16x8 __attribute__((ext_vector_type(8)));
typedef float f32x4 __attribute__((ext_vector_type(4)));
typedef float f32x2 __attribute__((ext_vector_type(2)));
typedef float f32x16 __attribute__((ext_vector_type(16)));
typedef unsigned u32x4 __attribute__((ext_vector_type(4)));
typedef unsigned u32x2 __attribute__((ext_vector_type(2)));

constexpr int D = 1024, BATCH = 8, SEQ = 4096, NTOK = BATCH * SEQ, NMEM = 256, NMEMTOK = BATCH * NMEM;
constexpr int DIN = 7704;
constexpr int C_RQ = 0, C_RK = 512, C_RV = 1024, C_RG = 2048, C_NQ = 3072, C_CK = 4096, C_NGL = 5632, C_GA = 5656, C_GB = 6680;
constexpr int NPROJ = 5632;
constexpr int NEXP = 32, DEXP = 512;
constexpr float EPS = 1e-6f;
constexpr int NWAVES = 8, NTHREADS = 512;

constexpr size_t MiB = 1u << 20;
constexpr size_t WS_CTL = 0, CTL_ZERO_BYTES = 1 * MiB;
constexpr size_t WS_ROPE_COS = 1 * MiB, WS_ROPE_SIN = 2 * MiB;
constexpr size_t WS_SMALLW = 3 * MiB;
constexpr size_t WS_MEMVT = 24 * MiB;
constexpr size_t WS_KCMP = 4 * MiB, WS_VCMP = 5 * MiB, WS_VCMPT = 35 * MiB;
constexpr size_t WS_GATES = 10 * MiB;
constexpr size_t WS_SSQ = 13 * MiB;
constexpr size_t WS_ROUTE = 15 * MiB;
constexpr size_t WS_LISTS = 16 * MiB;
constexpr size_t WS_W = 36 * MiB;
constexpr size_t W_IN = WS_W;
constexpr size_t W_GA = W_IN + 11 * MiB, W_GB = W_GA + 2 * MiB;
constexpr size_t W_RO = W_GB + 2 * MiB, W_NO = W_RO + 2 * MiB, W_OUT = W_NO + 2 * MiB, W_XQ = W_OUT + 2 * MiB, W_XO = W_XQ + 2 * MiB;
constexpr size_t W_XKV = W_XO + 2 * MiB;
constexpr size_t W_C1K = W_XKV + 4 * MiB, W_C1V = W_C1K + 2 * MiB;
constexpr size_t WS_MEMN = W_C1V + 2 * MiB;
constexpr size_t WS_MEMKV = WS_MEMN + 4 * MiB;
constexpr size_t WS_H = 84 * MiB;
constexpr size_t WS_NQ = WS_H + 64 * MiB;
constexpr size_t WS_RV = WS_NQ + 64 * MiB;
constexpr size_t WS_RQ = WS_RV + 64 * MiB;
constexpr size_t WS_RK = WS_RQ + 32 * MiB;
constexpr size_t WS_RG = WS_RK + 32 * MiB;
constexpr size_t WS_KV6 = WS_RG + 64 * MiB;
constexpr size_t KV_STRIDE = 16 * MiB;
constexpr size_t WS_END = WS_KV6 + 96 * MiB;
constexpr size_t WS_Y = WS_RQ, WS_P4SCR = WS_RG, WS_W13 = WS_RQ, WS_W2 = WS_RG, WS_H1 = WS_KV6, WS_X1B = WS_H, WS_X2B = WS_RV, WS_YS0 = WS_H, WS_YS1 = WS_NQ;
static_assert(WS_MEMKV + 8 * MiB <= WS_H && WS_VCMPT + 1 * MiB <= WS_W && WS_MEMVT + 4 * MiB <= WS_VCMPT, "ws map");
constexpr int CW_BAR = 4096;
constexpr int CW_ECNT = 16384;
constexpr int LDS_BYTES = 147456, RING_BYTES = 131072, MISC_OFF = RING_BYTES + 320;

HD inline float bf2f(bf16 b) { return __builtin_bit_cast(float, (unsigned)b << 16); }
HD inline unsigned f2bf(float f) { unsigned u = __builtin_bit_cast(unsigned, f); return (u + 0x7fffu + ((u >> 16) & 1u)) >> 16; }
HD inline unsigned pk2(float lo, float hi) { return f2bf(lo) | (f2bf(hi) << 16); }
HD inline float lo16(unsigned w) { return __builtin_bit_cast(float, w << 16); }
HD inline float hi16(unsigned w) { return __builtin_bit_cast(float, w & 0xffff0000u); }
__device__ __forceinline__ unsigned cvt_pk_bf16(float lo, float hi) { unsigned r; asm volatile("v_cvt_pk_bf16_f32 %0, %1, %2" : "=v"(r) : "v"(lo), "v"(hi)); return r; }
#define DPP_F(v, ctrl, rmask) __builtin_bit_cast(float, __builtin_amdgcn_update_dpp(0, __builtin_bit_cast(int, v), ctrl, rmask, 0xf, false))
__device__ __forceinline__ float wave_sum(float v) {
    v += DPP_F(v, 0xB1, 0xf);
    v += DPP_F(v, 0x4E, 0xf);
    v += DPP_F(v, 0x141, 0xf);
    v += DPP_F(v, 0x140, 0xf);
    v += DPP_F(v, 0x142, 0xa);
    v += DPP_F(v, 0x143, 0xc);
    return __builtin_bit_cast(float, __builtin_amdgcn_readlane(__builtin_bit_cast(int, v), 63));
}
__device__ __forceinline__ float wave_max(float v) {
#pragma unroll
    for (int o = 1; o < 64; o <<= 1) v = fmaxf(v, __shfl_xor(v, o));
    return v;
}
__device__ __forceinline__ float sigmoidf_(float x) { return __builtin_amdgcn_rcpf(1.0f + __builtin_amdgcn_exp2f(-1.4426950408889634f * x)); }
#define LAUNDER(p) asm volatile("" : "+v"(p))
#define LDS_WAIT() asm volatile("s_waitcnt lgkmcnt(0)" ::: "memory")
#define VM_WAIT() asm volatile("s_waitcnt vmcnt(0)" ::: "memory")

#define XB_TMO      128
#define XB_XCNT(j)  (256  + 64 * (j))
#define XB_XSUB(j)  (1280 + 64 * (j))
#define XB_XGEN(j)  (2304 + 64 * (j))
#define XB_TOP      3328
#define XB_TOPGEN   3392
#define XCD_BAR_WORDS 3456
#define XB_SPIN_CAP (1u << 24)
__device__ __forceinline__ unsigned xb_ld(unsigned* p)              { return __hip_atomic_load(p, __ATOMIC_RELAXED, __HIP_MEMORY_SCOPE_AGENT); }
__device__ __forceinline__ unsigned xb_add(unsigned* p, unsigned v) { return __hip_atomic_fetch_add(p, v, __ATOMIC_RELAXED, __HIP_MEMORY_SCOPE_AGENT); }
__device__ __forceinline__ unsigned xb_xcc_id() { return (unsigned)__builtin_amdgcn_s_getreg((3 << 11) | 20) & 0xFu; }
#define XB_SPIN(cond, bar) do { unsigned _sp = 0; while (cond) { __builtin_amdgcn_s_sleep(1); \
    if ((++_sp & 255u) == 0u) { if (xb_ld(&(bar)[XB_TMO])) break; if (_sp > XB_SPIN_CAP) { atomicAdd(&(bar)[XB_TMO], 1u); break; } } } } while (0)
struct XcdBarrier { unsigned* bar; unsigned x; volatile LAS unsigned* st; };
__device__ __forceinline__ XcdBarrier xcd_barrier_post(unsigned* bar, volatile LAS unsigned* st) {
    XcdBarrier b; b.bar = bar; b.x = xb_xcc_id(); b.st = st;
    if (threadIdx.x == 0) (void)xb_add(&bar[XB_XCNT(b.x)], 1u);
    return b;
}
__device__ __forceinline__ void xcd_barrier_complete(unsigned* bar, unsigned x, unsigned& nloc, unsigned& nx) {
    const unsigned G = gridDim.x * gridDim.y * gridDim.z;
    unsigned sum, cnt, mine, sp = 0u;
    for (;;) {
        sum = 0u; cnt = 0u; mine = 0u;
#pragma unroll
        for (unsigned j = 0; j < 16; ++j) { const unsigned c = xb_ld(&bar[XB_XCNT(j)]); sum += c; cnt += (c > 0u) ? 1u : 0u; mine = (j == x) ? c : mine; }
        if (sum == G) break;
        __builtin_amdgcn_s_sleep(1);
        if ((++sp & 255u) == 0u) { if (xb_ld(&bar[XB_TMO])) break; if (sp > XB_SPIN_CAP) { atomicAdd(&bar[XB_TMO], 1u); break; } }
    }
    nloc = mine > 0u ? mine : 1u; nx = cnt > 0u ? cnt : 1u;
}
__device__ __forceinline__ void xcd_barrier(const XcdBarrier& b) {
    asm volatile("s_waitcnt vmcnt(0)" ::: "memory");
    __syncthreads();
    if (threadIdx.x == 0) {
        unsigned* bar = b.bar;
        __builtin_amdgcn_s_waitcnt(0);
        unsigned nloc = b.st[0], nx = b.st[1];
        if (nloc == 0u) { xcd_barrier_complete(bar, b.x, nloc, nx); b.st[0] = nloc; b.st[1] = nx; }
        const unsigned old = xb_add(&bar[XB_XSUB(b.x)], 1u);
        const unsigned gen = old / nloc;
        if (old + 1u == (gen + 1u) * nloc) {
            __builtin_amdgcn_fence(__ATOMIC_RELEASE, "agent");
            asm volatile("s_waitcnt vmcnt(0)" ::: "memory");
            const unsigned og = xb_add(&bar[XB_TOP], 1u);
            const unsigned tg = og / nx;
            if (og + 1u == (tg + 1u) * nx) xb_add(&bar[XB_TOPGEN], 1u);
            else XB_SPIN(xb_ld(&bar[XB_TOPGEN]) == tg, bar);
            __builtin_amdgcn_fence(__ATOMIC_ACQUIRE, "agent");
            xb_add(&bar[XB_XGEN(b.x)], 1u);
            asm volatile("s_waitcnt vmcnt(0)" ::: "memory");
        } else {
            XB_SPIN(xb_ld(&bar[XB_XGEN(b.x)]) == gen, bar);
            __builtin_amdgcn_fence(__ATOMIC_ACQUIRE, "agent");
            asm volatile("s_waitcnt vmcnt(0)" ::: "memory");
        }
    }
    __syncthreads();
}

namespace pg8 {
constexpr int BM = 256, BK = 64, HALF = 128, HTB = HALF * BK * 2, NXCD = 8, WGM = 8;
HD __forceinline__ int lds_byte(int r, int c) { const int st = (r >> 4) * 2 + (c >> 5), rr = r & 15, cc = c & 31, ob = rr * 64 + cc * 2; return st * 1024 + (ob ^ (((ob >> 9) & 1) << 5)); }
HD __forceinline__ void stage_rc(int b, int& R, int& C) { const int st = b / 1024, sb = b % 1024, swz = sb ^ (((sb >> 9) & 1) << 5); R = (st >> 1) * 16 + swz / 64; C = (st & 1) * 32 + (swz % 64) / 2; }
HD __forceinline__ int perm32(int rho) { const int n = rho >> 4, i = rho & 15; return 8 * (i >> 2) + 4 * n + (i & 3); }
HD __forceinline__ void tile_map(int L, int nM, int nN, int& pm, int& pn) {
    const int nwg = nM * nN; int wgid = L; { const int q = nwg / NXCD, r = nwg % NXCD, xcd = wgid % NXCD, off = wgid / NXCD; wgid = (xcd < r ? xcd * (q + 1) : r * (q + 1) + (xcd - r) * q) + off; }
    const int nig = WGM * nN, gid = wgid / nig, fm = gid * WGM, gsz = (nM - fm) < WGM ? (nM - fm) : WGM;
    pm = fm + ((wgid % nig) % gsz); pn = (wgid % nig) / gsz;
}
struct GU { const char* A; const char* B; const int* rows; int nvalid; int kind, pm, pn, aux; };
template <class Epi, class Sched, bool GATHER>
__device__ __forceinline__ void gemm_phase(LAS unsigned char* lds, const int K, const int lda, const int ldb, const Sched& S, const Epi& E) {
    int tid_ = threadIdx.x; LAUNDER(tid_);
    const int tid = tid_, wid = __builtin_amdgcn_readfirstlane(tid >> 6), lane = tid & 63, wr = wid >> 2, wc = wid & 3, fr = lane & 15, fq = lane >> 4;
    const int nt = K / BK;
    unsigned voffB[2];
#pragma unroll
    for (int i = 0; i < 2; ++i) { int R, C; stage_rc(tid * 16 + i * 8192, R, C); const int Rb = Epi::PERM ? ((R & ~31) + perm32(R & 31)) : R; voffB[i] = (unsigned)(Rb * ldb + C) * 2u; }
    const size_t kstep = (size_t)(BK * 2);
    const size_t hstepB = (size_t)HALF * ldb * 2;
    const unsigned ldsw = (unsigned)wid * 1024u;
    const int aoff = lds_byte(wr * 64 + fr, fq * 8), boff = lds_byte(wc * 32 + fr, fq * 8);
#define PG8_SA(b, h) (((b) * 2 + (h)) * HTB)
#define PG8_SB(b, h) ((4 + (b) * 2 + (h)) * HTB)
#define PG8_STAGE2(bufoff, gbase, v0, v1) do { \
        __builtin_amdgcn_global_load_lds((const unsigned*)((const char*)(gbase) + (v0)), (LAS unsigned*)(lds + (bufoff) + ldsw), 16, 0, 0); \
        __builtin_amdgcn_global_load_lds((const unsigned*)((const char*)(gbase) + (v1)), (LAS unsigned*)(lds + (bufoff) + ldsw + 8192), 16, 0, 0); } while (0)
#define PG8_STAGEB(bufoff, gbase) PG8_STAGE2(bufoff, gbase, voffB[0], voffB[1])
#define PG8_LDA(dst, b, h) do { _Pragma("unroll") for (int m = 0; m < 4; ++m) _Pragma("unroll") for (int k = 0; k < 2; ++k) dst[m][k] = *(const LAS bf16x8*)(lds + PG8_SA(b, h) + aoff + m * 2048 + k * 1024); } while (0)
#define PG8_LDB(dst, b, h) do { _Pragma("unroll") for (int n = 0; n < 2; ++n) _Pragma("unroll") for (int k = 0; k < 2; ++k) dst[n][k] = *(const LAS bf16x8*)(lds + PG8_SB(b, h) + boff + n * 2048 + k * 1024); } while (0)
#define PG8_MMA(ai, bj, At, Bt) do { __builtin_amdgcn_s_setprio(1); _Pragma("unroll") for (int m = 0; m < 4; ++m) _Pragma("unroll") for (int n = 0; n < 2; ++n) _Pragma("unroll") for (int k = 0; k < 2; ++k) \
        acc[ai][bj][m][n] = __builtin_amdgcn_mfma_f32_16x16x32_bf16(Bt[n][k], At[m][k], acc[ai][bj][m][n], 0, 0, 0); __builtin_amdgcn_s_setprio(0); } while (0)
#define PG8_WAIT_V(n) asm volatile("s_waitcnt vmcnt(" #n ")" ::: "memory")
#define PG8_WAIT_L(n) asm volatile("s_waitcnt lgkmcnt(" #n ")" ::: "memory")
#define PG8_BAR __builtin_amdgcn_s_barrier()
#define PG8_SCHED __builtin_amdgcn_sched_barrier(0)
#define PG8_VOFFA(u, vo) do { _Pragma("unroll") for (int h = 0; h < 2; ++h) _Pragma("unroll") for (int i = 0; i < 2; ++i) { int R_, C_; stage_rc(tid * 16 + i * 8192, R_, C_); const int R = R_ + HALF * h; \
        int ridx = R; if (GATHER) { ridx = (R < (u).nvalid) ? ((u).rows[R] >> 1) : 0; } vo[h][i] = (unsigned)(ridx * lda + C_) * 2u; } if (GATHER) asm volatile("" :: "v"(vo[0][0]), "v"(vo[0][1]), "v"(vo[1][0]), "v"(vo[1][1])); } while (0)
    GU cur, nxt; int ui = 0;
    if (!S.next(0, cur)) return;
    f32x4 acc[2][2][4][2];
#pragma unroll
    for (int a = 0; a < 2; ++a)
#pragma unroll
        for (int b = 0; b < 2; ++b)
#pragma unroll
            for (int m = 0; m < 4; ++m)
#pragma unroll
                for (int n = 0; n < 2; ++n) acc[a][b][m][n] = (f32x4){0.f, 0.f, 0.f, 0.f};
    bf16x8 At[4][2], B0[2][2], B1[2][2];
    unsigned cv[2][2], nv[2][2];
    PG8_VOFFA(cur, cv);
    const char* cA = cur.A; const char* cB = cur.B;
    PG8_STAGEB(PG8_SB(0, 0), cB); PG8_STAGEB(PG8_SB(0, 1), cB + hstepB); PG8_STAGE2(PG8_SA(0, 0), cA, cv[0][0], cv[0][1]); PG8_STAGE2(PG8_SA(0, 1), cA, cv[1][0], cv[1][1]);
    if (wr == 1) PG8_BAR;
    PG8_WAIT_V(2); PG8_BAR;
    PG8_STAGEB(PG8_SB(1, 0), cB + kstep); PG8_STAGE2(PG8_SA(1, 0), cA + kstep, cv[0][0], cv[0][1]); PG8_STAGEB(PG8_SB(1, 1), cB + hstepB + kstep);
    PG8_WAIT_V(6); PG8_BAR;
    for (;;) {
        const bool has_next = S.next(ui + 1, nxt);
        const char* nA = has_next ? nxt.A : cA; const char* nB = has_next ? nxt.B : cB;
        if (has_next) { PG8_VOFFA(nxt, nv); } else {
#pragma unroll
            for (int h = 0; h < 2; ++h)
#pragma unroll
                for (int i = 0; i < 2; ++i) nv[h][i] = cv[h][i]; }
        for (int t = 0; t < nt; t += 2) {
            const bool last = (t == nt - 2);
            const char* a1 = cA + (size_t)(t + 1) * kstep;
            const char* a2 = last ? nA : cA + (size_t)(t + 2) * kstep; const char* b2 = last ? nB : cB + (size_t)(t + 2) * kstep;
            const char* a3 = a2 + kstep; const char* b3 = b2 + kstep;
            const unsigned w00 = last ? nv[0][0] : cv[0][0], w01 = last ? nv[0][1] : cv[0][1], w10 = last ? nv[1][0] : cv[1][0], w11 = last ? nv[1][1] : cv[1][1];
            PG8_LDB(B0, 0, 0); PG8_LDB(B1, 0, 1); PG8_SCHED; PG8_LDA(At, 0, 0); PG8_STAGE2(PG8_SA(1, 1), a1, cv[1][0], cv[1][1]);
            PG8_WAIT_V(8); PG8_WAIT_L(0); PG8_BAR; PG8_MMA(0, 0, At, B0); PG8_MMA(0, 1, At, B1); PG8_BAR; PG8_SCHED;
            PG8_LDA(At, 0, 1); PG8_STAGEB(PG8_SB(0, 0), b2); PG8_STAGEB(PG8_SB(0, 1), b2 + hstepB); PG8_STAGE2(PG8_SA(0, 0), a2, w00, w01);
            PG8_WAIT_V(8); PG8_WAIT_L(0); PG8_BAR; PG8_MMA(1, 0, At, B0); PG8_MMA(1, 1, At, B1); PG8_BAR; PG8_SCHED;
            PG8_LDB(B0, 1, 0); PG8_LDB(B1, 1, 1); PG8_SCHED; PG8_LDA(At, 1, 0); PG8_STAGE2(PG8_SA(0, 1), a2, w10, w11);
            PG8_WAIT_V(8); PG8_WAIT_L(0); PG8_BAR; PG8_MMA(0, 0, At, B0); PG8_MMA(0, 1, At, B1); PG8_BAR; PG8_SCHED;
            PG8_LDA(At, 1, 1); PG8_STAGEB(PG8_SB(1, 0), b3); PG8_STAGEB(PG8_SB(1, 1), b3 + hstepB); PG8_STAGE2(PG8_SA(1, 0), a3, w00, w01);
            PG8_WAIT_V(8); PG8_WAIT_L(0); PG8_BAR; PG8_MMA(1, 0, At, B0); PG8_MMA(1, 1, At, B1); PG8_BAR; PG8_SCHED;
        }
        if (wr == 0) PG8_BAR;
        E(acc, cur, wr, wc, fr, fq);
        if (!has_next) break;
#pragma unroll
        for (int a = 0; a < 2; ++a)
#pragma unroll
            for (int b = 0; b < 2; ++b)
#pragma unroll
                for (int m = 0; m < 4; ++m)
#pragma unroll
                    for (int n = 0; n < 2; ++n) acc[a][b][m][n] = (f32x4){0.f, 0.f, 0.f, 0.f};
        cur = nxt; cA = nA; cB = nB; ++ui;
#pragma unroll
        for (int h = 0; h < 2; ++h)
#pragma unroll
            for (int i = 0; i < 2; ++i) cv[h][i] = nv[h][i];
        if (wr == 1) PG8_BAR;
    }
    PG8_WAIT_V(0);
    PG8_BAR;
#undef PG8_SA
#undef PG8_SB
#undef PG8_STAGE2
#undef PG8_STAGEB
#undef PG8_LDA
#undef PG8_LDB
#undef PG8_MMA
#undef PG8_WAIT_V
#undef PG8_WAIT_L
#undef PG8_BAR
#undef PG8_SCHED
#undef PG8_VOFFA
}
}
using pg8::GU;

struct Args {
    const float* in[27]; float* out; unsigned char* ws; int ph_lo, ph_hi; int pad0, pad1;
};
enum { IN_X = 0, IN_MEM, IN_NORM_MIX_G, IN_W_IN, IN_W_RET_O, IN_W_NSA_O, IN_W_OUT, IN_CMP_PE_K, IN_CMP_W1_K, IN_CMP_W2_K, IN_CMP_PE_V, IN_CMP_W1_V, IN_CMP_W2_V,
       IN_NORM_X_G, IN_NORM_MEM_G, IN_W_XQ, IN_W_XKV, IN_W_XO, IN_NORM_FFN_G, IN_W_GRP, IN_B_GRP, IN_W_RT, IN_B_RT, IN_W_E1, IN_W_E3, IN_W_E2, IN_NORM_F_G };
struct Frame {
    LAS unsigned char* lds; volatile LAS unsigned* MISC; unsigned* ctl; unsigned char* ws;
    int tid, lane, wave, G, bx;
};

__device__ __forceinline__ bool phase_begin(Frame& F) { int t = threadIdx.x; LAUNDER(t); F.tid = t; F.lane = t & 63; return true; }
__device__ __forceinline__ void transpose_item(const float* W, int ldw, int c0, int k0, bf16* WT, int ldt, int mode, int row_off, int cbase, const float* kscale, float scale, LAS float* scr, int lane) {
    float vv[32];
#pragma unroll
    for (int i = 0; i < 32; ++i) { const int kk = 2 * i + (lane >> 5); vv[i] = W[(size_t)(k0 + kk) * ldw + c0 + (lane & 31)]; }
    if (kscale) {
#pragma unroll
        for (int i = 0; i < 32; ++i) { const int kk = 2 * i + (lane >> 5); vv[i] *= kscale[k0 + kk]; } }
#pragma unroll
    for (int i = 0; i < 32; ++i) { const int kk = 2 * i + (lane >> 5); scr[kk * 33 + (lane & 31)] = vv[i] * scale; }
    LDS_WAIT(); asm volatile("" ::: "memory");
    const int c = lane & 7;
#pragma unroll
    for (int j = 0; j < 4; ++j) { const int n = (lane >> 3) + 8 * j; const LAS float* s = scr + (8 * c) * 33 + n;
        u32x4 o; o.x = pk2(s[0 * 33], s[1 * 33]); o.y = pk2(s[2 * 33], s[3 * 33]); o.z = pk2(s[4 * 33], s[5 * 33]); o.w = pk2(s[6 * 33], s[7 * 33]);
        const int jc = c0 - cbase + n; const int drow = mode == 0 ? row_off + jc : (8 * (jc >> 2) + 4 * row_off + (jc & 3));
        *(u32x4*)(WT + (size_t)drow * ldt + k0 + 8 * c) = o; }
    LDS_WAIT(); asm volatile("" ::: "memory");
}
__device__ __forceinline__ void transpose_matrix(Frame& F, int& item_base, const float* W, int ldw, int K, int cbase, int ncols, bf16* WT, int ldt, int mode, int row_off, const float* kscale, float scale) {
    LAS float* scr = (LAS float*)(F.lds + F.wave * 16384);
    const int gw = F.bx * NWAVES + F.wave, NGW = F.G * NWAVES;
    const int nb = ncols / 32, nitems = (K / 64) * nb;
    int it = (gw - item_base % NGW + NGW) % NGW;
    for (; it < nitems; it += NGW) transpose_item(W, ldw, cbase + 32 * (it % nb), 64 * (it / nb), WT, ldt, mode, row_off, cbase, kscale, scale, scr, F.lane);
    item_base += nitems;
}
__device__ __forceinline__ void rms_row_to_bf16(int lane, const float* xrow, const float* g, bf16* orow) {
    const f32x4* xr = (const f32x4*)xrow + lane; const f32x4* gr = (const f32x4*)g + lane;
    f32x4 v[4]; float s = 0.f;
#pragma unroll
    for (int j = 0; j < 4; ++j) { v[j] = xr[64 * j]; s += (v[j].x * v[j].x + v[j].y * v[j].y) + (v[j].z * v[j].z + v[j].w * v[j].w); }
    const float rstd = 1.0f / sqrtf(wave_sum(s) * (1.f / D) + EPS);
    unsigned long long* o8 = (unsigned long long*)orow + lane;
#pragma unroll
    for (int j = 0; j < 4; ++j) { const f32x4 gg = gr[64 * j];
        o8[64 * j] = (unsigned long long)pk2(v[j].x * rstd * gg.x, v[j].y * rstd * gg.y) | ((unsigned long long)pk2(v[j].z * rstd * gg.z, v[j].w * rstd * gg.w) << 32); }
}

__device__ __forceinline__ void p0_prologue(Frame& F, const Args& a) {
    unsigned char* ws = F.ws;
    const float* w_in = a.in[IN_W_IN];
    int ib = 0;
    transpose_matrix(F, ib, w_in, DIN, D, 0, 512, (bf16*)(ws + W_IN), D, 0, 0, nullptr, 1.0f);
    transpose_matrix(F, ib, w_in, DIN, D, 512, 512, (bf16*)(ws + W_IN), D, 0, 512, nullptr, 0.08838834764831845f);
    transpose_matrix(F, ib, w_in, DIN, D, 1024, NPROJ - 1024, (bf16*)(ws + W_IN), D, 0, 1024, nullptr, 1.0f);
    transpose_matrix(F, ib, w_in, DIN, D, C_GA, 1024, (bf16*)(ws + W_GA), D, 0, 0, nullptr, 1.0f);
    transpose_matrix(F, ib, w_in, DIN, D, C_GB, 1024, (bf16*)(ws + W_GB), D, 0, 0, nullptr, 1.0f);
    transpose_matrix(F, ib, a.in[IN_W_RET_O], D, D, 0, D, (bf16*)(ws + W_RO), D, 0, 0, nullptr, 1.0f);
    transpose_matrix(F, ib, a.in[IN_W_NSA_O], D, D, 0, D, (bf16*)(ws + W_NO), D, 0, 0, nullptr, 1.0f);
    transpose_matrix(F, ib, a.in[IN_W_OUT], D, D, 0, D, (bf16*)(ws + W_OUT), D, 0, 0, nullptr, 1.0f);
    transpose_matrix(F, ib, a.in[IN_W_XQ], D, D, 0, D, (bf16*)(ws + W_XQ), D, 0, 0, a.in[IN_NORM_X_G], 1.0f);
    transpose_matrix(F, ib, a.in[IN_W_XO], D, D, 0, D, (bf16*)(ws + W_XO), D, 0, 0, nullptr, 1.0f);
    transpose_matrix(F, ib, a.in[IN_W_XKV], 2 * D, D, 0, 2 * D, (bf16*)(ws + W_XKV), D, 0, 0, nullptr, 1.0f);
    transpose_matrix(F, ib, a.in[IN_CMP_W1_K], 128, 4096, 0, 128, (bf16*)(ws + W_C1K), 4096, 0, 0, nullptr, 1.0f);
    transpose_matrix(F, ib, a.in[IN_CMP_W1_V], 128, 4096, 0, 128, (bf16*)(ws + W_C1V), 4096, 0, 0, nullptr, 1.0f);
    const int gt = F.bx * NTHREADS + F.tid, NGT = F.G * NTHREADS;
    for (int i = gt; i < 2 * 128 * 4096 / 8; i += NGT) { const int m = i / (128 * 4096 / 8), r = i % (128 * 4096 / 8);
        *(u32x4*)(ws + (m ? W_C1V : W_C1K) + (size_t)128 * 4096 * 2 + (size_t)r * 16) = (u32x4){0u, 0u, 0u, 0u}; }
    bf16* wngl = (bf16*)(ws + WS_SMALLW);
    for (int i = gt; i < 32 * 1024; i += NGT) { const int r = i >> 10, k = i & 1023; wngl[i] = r < 24 ? (bf16)f2bf(w_in[(size_t)k * DIN + C_NGL + r]) : (bf16)0; }
    bf16* w2k = (bf16*)(ws + WS_SMALLW + 65536); bf16* w2v = w2k + 128 * 128;
    for (int i = gt; i < 2 * 128 * 128; i += NGT) { const int m = i >> 14, r = i & 16383, f = r >> 7, e = r & 127; const float* src = a.in[m ? IN_CMP_W2_V : IN_CMP_W2_K];
        (m ? w2v : w2k)[f * 128 + e] = (bf16)f2bf(src[e * 128 + f]); }
    float* cbias = (float*)(ws + WS_SMALLW + 65536 + 2 * 128 * 128 * 2);
    const int gw = F.bx * NWAVES + F.wave, NGW = F.G * NWAVES;
    for (int o = gw; o < 256; o += NGW) { const int m = o >> 7, e = o & 127; const float* pe = a.in[m ? IN_CMP_PE_V : IN_CMP_PE_K]; const float* w1 = a.in[m ? IN_CMP_W1_V : IN_CMP_W1_K];
        float s = 0.f; for (int k = F.lane; k < 4096; k += 64) s += pe[k] * w1[(size_t)k * 128 + e];
        s = wave_sum(s); if (F.lane == 0) cbias[o] = s; }
    float* cosT = (float*)(ws + WS_ROPE_COS); float* sinT = (float*)(ws + WS_ROPE_SIN);
    for (int i = gt; i < SEQ * 64; i += NGT) { const int pos = i >> 6, j = i & 63; const float inv = powf(10000.0f, -(float)(2 * j) / 128.0f); const float ang = (float)pos * inv;
        cosT[i] = cosf(ang); sinT[i] = sinf(ang); }
    { f32x4 nx[4]; const float* X = a.in[IN_X]; const f32x4* gr = (const f32x4*)a.in[IN_NORM_MIX_G] + F.lane;
      if (gw < NTOK) {
#pragma unroll
          for (int j = 0; j < 4; ++j) nx[j] = ((const f32x4*)(X + (size_t)gw * D) + F.lane)[64 * j]; }
      for (int m = gw; m < NTOK; m += NGW) { f32x4 v[4]; float sq = 0.f;
#pragma unroll
          for (int j = 0; j < 4; ++j) { v[j] = nx[j]; sq += (v[j].x * v[j].x + v[j].y * v[j].y) + (v[j].z * v[j].z + v[j].w * v[j].w); }
          if (m + NGW < NTOK) {
#pragma unroll
              for (int j = 0; j < 4; ++j) nx[j] = ((const f32x4*)(X + (size_t)(m + NGW) * D) + F.lane)[64 * j]; }
          const float rstd = 1.0f / sqrtf(wave_sum(sq) * (1.f / D) + EPS); unsigned long long* o8 = (unsigned long long*)((bf16*)(ws + WS_H) + (size_t)m * D) + F.lane;
#pragma unroll
          for (int j = 0; j < 4; ++j) { const f32x4 gg = gr[64 * j]; o8[64 * j] = (unsigned long long)pk2(v[j].x * rstd * gg.x, v[j].y * rstd * gg.y) | ((unsigned long long)pk2(v[j].z * rstd * gg.z, v[j].w * rstd * gg.w) << 32); } } }
    for (int m = gw; m < NMEMTOK; m += NGW) rms_row_to_bf16(F.lane, a.in[IN_MEM] + (size_t)m * D, a.in[IN_NORM_MEM_G], (bf16*)(ws + WS_MEMN) + (size_t)m * D);
}

struct SchedP1 {
    unsigned char* ws; int G, c;
    __device__ __forceinline__ bool next(int i, GU& u) const {
        constexpr int NP = 128 * 22; const int L = i * G + c;
        u.rows = nullptr; u.nvalid = 0; u.aux = 0;
        if (L < NP) { int pm, pn; pg8::tile_map(L, 128, 22, pm, pn); u.A = (const char*)ws + WS_H + (size_t)pm * 256 * D * 2; u.B = (const char*)ws + W_IN + (size_t)pn * 256 * D * 2; u.pm = pm; u.pn = pn;
            u.kind = pn < 2 ? 0 : pn < 4 ? 1 : pn < 8 ? 2 : pn < 12 ? 3 : pn < 16 ? 4 : 5; return true; }
        const int L2 = L - NP; if (L2 >= 64) return false;
        const int pm = L2 & 7, pn = L2 >> 3; u.A = (const char*)ws + WS_MEMN + (size_t)pm * 256 * D * 2; u.B = (const char*)ws + W_XKV + (size_t)pn * 256 * D * 2; u.pm = pm; u.pn = pn; u.kind = 6; return true;
    }
};
struct EpiP1 {
    static constexpr bool PERM = true;
    unsigned char* ws;
    __device__ __forceinline__ void operator()(const f32x4 (&acc)[2][2][4][2], const GU& u, int wr, int wc, int fr, int fq) const {
        const int kind = u.kind;
        const float* cosT = (const float*)(ws + WS_ROPE_COS); const float* sinT = (const float*)(ws + WS_ROPE_SIN);
#pragma unroll
        for (int ai = 0; ai < 2; ++ai)
#pragma unroll
            for (int m = 0; m < 4; ++m) {
                const int r = 128 * ai + 64 * wr + 16 * m + fr; const int tok = u.pm * 256 + r;
#pragma unroll
                for (int bj = 0; bj < 2; ++bj) {
                    f32x4 v0 = acc[ai][bj][m][0], v1 = acc[ai][bj][m][1];
                    const int ct = 128 * bj + 32 * wc + 8 * fq;
                    bf16* dst;
                    if (kind <= 1) {
                        const int s = tok & (SEQ - 1), i0 = ((ct & 127) >> 1);
                        const f32x4 cs = *(const f32x4*)(cosT + s * 64 + i0), sn = *(const f32x4*)(sinT + s * 64 + i0);
                        const f32x4 a0 = v0, a1 = v1;
                        v0[0] = a0[0] * cs[0] - a0[1] * sn[0]; v0[1] = a0[0] * sn[0] + a0[1] * cs[0];
                        v0[2] = a0[2] * cs[1] - a0[3] * sn[1]; v0[3] = a0[2] * sn[1] + a0[3] * cs[1];
                        v1[0] = a1[0] * cs[2] - a1[1] * sn[2]; v1[1] = a1[0] * sn[2] + a1[1] * cs[2];
                        v1[2] = a1[2] * cs[3] - a1[3] * sn[3]; v1[3] = a1[2] * sn[3] + a1[3] * cs[3];
                        dst = (bf16*)(ws + (kind == 0 ? WS_RQ : WS_RK)) + (size_t)tok * 512 + (u.pn & 1) * 256 + ct;
                    } else if (kind == 2) { dst = (bf16*)(ws + WS_RV) + (size_t)tok * 1024 + (u.pn - 4) * 256 + ct;
                    } else if (kind == 3) {
#pragma unroll
                        for (int j = 0; j < 4; ++j) { v0[j] = v0[j] * sigmoidf_(v0[j]); v1[j] = v1[j] * sigmoidf_(v1[j]); }
                        dst = (bf16*)(ws + WS_RG) + (size_t)tok * 1024 + (u.pn - 8) * 256 + ct;
                    } else if (kind == 4) { dst = (bf16*)(ws + WS_NQ) + (size_t)tok * 1024 + (u.pn - 12) * 256 + ct;
                    } else if (kind == 5) {
                        const int b = tok >> 12, s = tok & (SEQ - 1);
                        unsigned char* kvb = ws + WS_KV6 + (size_t)(u.pn - 16) * KV_STRIDE;
                        dst = (bf16*)kvb + ((size_t)(b * 2 + bj) * SEQ + s) * 128 + (ct & 127);
                    } else { dst = (bf16*)(ws + WS_MEMKV) + (size_t)tok * 2048 + u.pn * 256 + ct; }
                    u32x4 w; w.x = cvt_pk_bf16(v0[0], v0[1]); w.y = cvt_pk_bf16(v0[2], v0[3]); w.z = cvt_pk_bf16(v1[0], v1[1]); w.w = cvt_pk_bf16(v1[2], v1[3]);
                    *(u32x4*)dst = w;
                }
            }
    }
};
__device__ __forceinline__ void p1_gate_logits(Frame& F) {
    const bf16* H = (const bf16*)(F.ws + WS_H); const bf16* W = (const bf16*)(F.ws + WS_SMALLW); float* gates = (float*)(F.ws + WS_GATES);
    const int gw = F.bx * NWAVES + F.wave, NGW = F.G * NWAVES; const int r = F.lane & 31, hh = F.lane >> 5;
    for (int rb = gw; rb < NTOK / 32; rb += NGW) {
        f32x16 acc; for (int j = 0; j < 16; ++j) acc[j] = 0.f;
        const bf16* ap = H + (size_t)(rb * 32 + r) * D + 8 * hh; const bf16* bp = W + (size_t)r * D + 8 * hh;
        for (int s8 = 0; s8 < 8; ++s8) { bf16x8 av[8], bv[8];
#pragma unroll
            for (int q = 0; q < 8; ++q) { av[q] = *(const bf16x8*)(ap + 16 * (8 * s8 + q)); bv[q] = *(const bf16x8*)(bp + 16 * (8 * s8 + q)); }
#pragma unroll
            for (int q = 0; q < 8; ++q) acc = __builtin_amdgcn_mfma_f32_32x32x16_bf16(av[q], bv[q], acc, 0, 0, 0); }
        if (r < 24) {
#pragma unroll
            for (int reg = 0; reg < 16; ++reg) { const int row = (reg & 3) + 8 * (reg >> 2) + 4 * hh; gates[(size_t)(rb * 32 + row) * 24 + r] = sigmoidf_(acc[reg]); }
        }
    }
}

namespace retf {
constexpr int ROWB = 272;
constexpr int OFF_K = 0, OFF_KT = 128 * ROWB, OFF_VT = 2 * 128 * ROWB, OFF_ZVT = OFF_VT + 32 * ROWB, OFF_ST = OFF_ZVT + 32 * ROWB, OFF_PART = OFF_ST + 32 * ROWB;
static_assert(OFF_PART + 4 * 4096 <= RING_BYTES, "retention LDS map");
}
__device__ __forceinline__ void p2_retention_fast(Frame& F, int unit, bf16* outbase) {
    using namespace retf;
    const int bh = unit >> 3, sl = unit & 7, b = bh >> 2, h = bh & 3;
    const bf16* rq = (const bf16*)(F.ws + WS_RQ); const bf16* rk = (const bf16*)(F.ws + WS_RK); const bf16* rv = (const bf16*)(F.ws + WS_RV);
    const int tid = F.tid, lane = F.lane, wave = F.wave, r = lane & 31, hi = lane >> 5; LAS unsigned char* lds = F.lds;
    const float lg = log2f(1.0f - exp2f(-5.0f - (float)h));
    const int nt = wave & 3, mh = wave >> 2;
    for (int i = tid; i < 32 * ROWB / 4; i += NTHREADS) ((LAS unsigned*)(lds + OFF_ST))[i] = 0u;
    f32x16 ST;
#pragma unroll
    for (int j = 0; j < 16; ++j) ST[j] = 0.f;
    const float gC = exp2f(128.0f * lg);
    u32x4 kreg[4], vreg; bf16x8 qn[8];
    {   const int tok0 = b * SEQ;
#pragma unroll
        for (int i = 0; i < 4; ++i) { const int p = tid + 512 * i, m = p >> 4, cc = p & 15; kreg[i] = *(const u32x4*)(rk + (size_t)(tok0 + m) * 512 + h * 128 + cc * 8); }
        { const int m = tid >> 2, cc = tid & 3; vreg = *(const u32x4*)(rv + (size_t)(tok0 + m) * 1024 + h * 256 + sl * 32 + cc * 8); }
        const bf16* qrow = rq + (size_t)(tok0 + 32 * nt + r) * 512 + h * 128;
#pragma unroll
        for (int s_ = 0; s_ < 8; ++s_) qn[s_] = *(const bf16x8*)(qrow + 16 * s_ + 8 * hi); }
    for (int c = 0; c < SEQ / 128; ++c) {
        const int tok0 = b * SEQ + c * 128;
        __syncthreads();
#pragma unroll
        for (int i = 0; i < 4; ++i) { const int p = tid + 512 * i, m = p >> 4, cc = p & 15; const u32x4 v = kreg[i];
            *(LAS u32x4*)(lds + OFF_K + m * ROWB + cc * 16) = v;
            LAS unsigned short* kt = (LAS unsigned short*)(lds + OFF_KT) + (cc * 8) * (ROWB / 2) + m;
            kt[0 * (ROWB / 2)] = (unsigned short)(v.x & 0xffffu); kt[1 * (ROWB / 2)] = (unsigned short)(v.x >> 16); kt[2 * (ROWB / 2)] = (unsigned short)(v.y & 0xffffu); kt[3 * (ROWB / 2)] = (unsigned short)(v.y >> 16);
            kt[4 * (ROWB / 2)] = (unsigned short)(v.z & 0xffffu); kt[5 * (ROWB / 2)] = (unsigned short)(v.z >> 16); kt[6 * (ROWB / 2)] = (unsigned short)(v.w & 0xffffu); kt[7 * (ROWB / 2)] = (unsigned short)(v.w >> 16); }
        { const int m = tid >> 2, cc = tid & 3; const u32x4 v = vreg;
            const float z = exp2f((float)(127 - m) * lg);
            LAS unsigned short* vt = (LAS unsigned short*)(lds + OFF_VT) + (cc * 8) * (ROWB / 2) + m; LAS unsigned short* zt = (LAS unsigned short*)(lds + OFF_ZVT) + (cc * 8) * (ROWB / 2) + m;
            const unsigned w4[4] = {v.x, v.y, v.z, v.w};
#pragma unroll
            for (int q = 0; q < 4; ++q) { vt[(2 * q) * (ROWB / 2)] = (unsigned short)(w4[q] & 0xffffu); vt[(2 * q + 1) * (ROWB / 2)] = (unsigned short)(w4[q] >> 16);
                zt[(2 * q) * (ROWB / 2)] = (unsigned short)f2bf(lo16(w4[q]) * z); zt[(2 * q + 1) * (ROWB / 2)] = (unsigned short)f2bf(hi16(w4[q]) * z); } }
        bf16x8 qf[8];
#pragma unroll
        for (int s_ = 0; s_ < 8; ++s_) qf[s_] = qn[s_];
        __syncthreads();
        if (c + 1 < SEQ / 128) { const int tok1 = tok0 + 128;
#pragma unroll
            for (int i = 0; i < 4; ++i) { const int p = tid + 512 * i, m = p >> 4, cc = p & 15; kreg[i] = *(const u32x4*)(rk + (size_t)(tok1 + m) * 512 + h * 128 + cc * 8); }
            { const int m = tid >> 2, cc = tid & 3; vreg = *(const u32x4*)(rv + (size_t)(tok1 + m) * 1024 + h * 256 + sl * 32 + cc * 8); }
            const bf16* qrow = rq + (size_t)(tok1 + 32 * nt + r) * 512 + h * 128;
#pragma unroll
            for (int s_ = 0; s_ < 8; ++s_) qn[s_] = *(const bf16x8*)(qrow + 16 * s_ + 8 * hi); }
        f32x16 CR;
#pragma unroll
        for (int j = 0; j < 16; ++j) CR[j] = 0.f;
        if (mh == 0) {
#pragma unroll
            for (int s_ = 0; s_ < 8; ++s_) { const bf16x8 a = *(const LAS bf16x8*)(lds + OFF_ST + r * ROWB + (16 * s_ + 8 * hi) * 2); CR = __builtin_amdgcn_mfma_f32_32x32x16_bf16(a, qf[s_], CR, 0, 0, 0); }
        }
        f32x16 IN_;
#pragma unroll
        for (int j = 0; j < 16; ++j) IN_[j] = 0.f;
#pragma unroll
        for (int mi = 0; mi < 2; ++mi) { const int mt = 2 * mh + mi;
            if (mt <= nt) {
                f32x16 A;
#pragma unroll
                for (int j = 0; j < 16; ++j) A[j] = 0.f;
#pragma unroll
                for (int s_ = 0; s_ < 8; ++s_) { const bf16x8 a = *(const LAS bf16x8*)(lds + OFF_K + (32 * mt + r) * ROWB + (16 * s_ + 8 * hi) * 2); A = __builtin_amdgcn_mfma_f32_32x32x16_bf16(a, qf[s_], A, 0, 0, 0); }
#pragma unroll
                for (int j = 0; j < 16; ++j) { const int dd = (32 * nt + r) - (32 * mt + (j & 3) + 8 * (j >> 2) + 4 * hi); A[j] = dd >= 0 ? A[j] * exp2f((float)dd * lg) : 0.f; }
#pragma unroll
                for (int s2 = 0; s2 < 2; ++s2) { u32x4 w; w.x = cvt_pk_bf16(A[8 * s2 + 0], A[8 * s2 + 1]); w.y = cvt_pk_bf16(A[8 * s2 + 2], A[8 * s2 + 3]); w.z = cvt_pk_bf16(A[8 * s2 + 4], A[8 * s2 + 5]); w.w = cvt_pk_bf16(A[8 * s2 + 6], A[8 * s2 + 7]);
                    const LAS unsigned char* vp = lds + OFF_VT + r * ROWB + (32 * mt + 16 * s2 + 4 * hi) * 2; const u32x2 lo = *(const LAS u32x2*)vp, hi2 = *(const LAS u32x2*)(vp + 16);
                    IN_ = __builtin_amdgcn_mfma_f32_32x32x16_bf16(__builtin_bit_cast(bf16x8, (u32x4){lo.x, lo.y, hi2.x, hi2.y}), __builtin_bit_cast(bf16x8, w), IN_, 0, 0, 0); }
            } }
        if (mh == 1) {
#pragma unroll
            for (int j = 0; j < 16; ++j) ((LAS float*)(lds + OFF_PART))[(nt * 16 + j) * 64 + lane] = IN_[j];
        }
        __syncthreads();
        if (mh == 0) {
            const float xi = exp2f((float)(32 * nt + r + 1) * lg);
            bf16* orow = outbase + (size_t)(tok0 + 32 * nt + r) * 1024 + h * 256 + sl * 32;
#pragma unroll
            for (int q4 = 0; q4 < 4; ++q4) { float o_[4];
#pragma unroll
                for (int e = 0; e < 4; ++e) { const int j = 4 * q4 + e; o_[e] = IN_[j] + ((const LAS float*)(lds + OFF_PART))[(nt * 16 + j) * 64 + lane] + xi * CR[j]; }
                *(u32x2*)(orow + 8 * q4 + 4 * hi) = (u32x2){cvt_pk_bf16(o_[0], o_[1]), cvt_pk_bf16(o_[2], o_[3])}; }
        } else {
#pragma unroll
            for (int j = 0; j < 16; ++j) ST[j] *= gC;
#pragma unroll
            for (int s_ = 0; s_ < 8; ++s_) { const bf16x8 a = *(const LAS bf16x8*)(lds + OFF_ZVT + r * ROWB + (16 * s_ + 8 * hi) * 2); const bf16x8 kb = *(const LAS bf16x8*)(lds + OFF_KT + (32 * nt + r) * ROWB + (16 * s_ + 8 * hi) * 2);
                ST = __builtin_amdgcn_mfma_f32_32x32x16_bf16(a, kb, ST, 0, 0, 0); }
#pragma unroll
            for (int j = 0; j < 16; ++j) { const int dv = (j & 3) + 8 * (j >> 2) + 4 * hi; ((LAS unsigned short*)(lds + OFF_ST))[dv * (ROWB / 2) + 32 * nt + r] = (unsigned short)f2bf(ST[j]); }
        }
    }
    __syncthreads();
}
__device__ __forceinline__ void transpose_kv_tiles(Frame& F, const bf16* src, bf16* dst, int w0, int nw) {
    LAS unsigned short* tl_ = (LAS unsigned short*)(F.lds + F.wave * 16384); const int lane = F.lane;
    for (int tile = w0; tile < 16 * 64 * 2; tile += nw) {
        const int dh = tile & 1, st = (tile >> 1) & 63, bg = tile >> 7;
        const bf16* sp = src + ((size_t)bg * SEQ + st * 64) * 128 + dh * 64; bf16* dp = dst + ((size_t)bg * 128 + dh * 64) * SEQ + st * 64;
#pragma unroll
        for (int i = 0; i < 8; ++i) { const int row = i * 8 + (lane >> 3), c = lane & 7; const u32x4 v = *(const u32x4*)(sp + (size_t)row * 128 + c * 8); LAS unsigned short* q = tl_ + row * 66 + c * 8;
            q[0] = (unsigned short)(v.x & 0xffffu); q[1] = (unsigned short)(v.x >> 16); q[2] = (unsigned short)(v.y & 0xffffu); q[3] = (unsigned short)(v.y >> 16);
            q[4] = (unsigned short)(v.z & 0xffffu); q[5] = (unsigned short)(v.z >> 16); q[6] = (unsigned short)(v.w & 0xffffu); q[7] = (unsigned short)(v.w >> 16); }
        LDS_WAIT(); asm volatile("" ::: "memory");
#pragma unroll
        for (int i = 0; i < 8; ++i) { const int d = i * 8 + (lane >> 3), c = lane & 7; const LAS unsigned short* q = tl_ + (c * 8) * 66 + d;
            u32x4 o; o.x = (unsigned)q[0] | ((unsigned)q[66] << 16); o.y = (unsigned)q[2 * 66] | ((unsigned)q[3 * 66] << 16); o.z = (unsigned)q[4 * 66] | ((unsigned)q[5 * 66] << 16); o.w = (unsigned)q[6 * 66] | ((unsigned)q[7 * 66] << 16);
            *(u32x4*)(dp + (size_t)d * SEQ + c * 8) = o; }
        LDS_WAIT(); asm volatile("" ::: "memory");
    }
}
struct SchedCmp {
    unsigned char* ws; int first, G, c;
    __device__ __forceinline__ bool next(int i, GU& u) const {
        const int L = i * G + c - first; if (L < 0 || L >= 256) return false;
        const int ks = L & 7, mb = L >> 3, m = mb >> 4, bg = mb & 15;
        u.A = (const char*)ws + WS_KV6 + (size_t)m * KV_STRIDE + (size_t)bg * SEQ * 128 * 2 + (size_t)ks * 512 * 2; u.B = (const char*)ws + (m ? W_C1V : W_C1K) + (size_t)ks * 512 * 2;
        u.pm = mb; u.pn = 0; u.kind = ks; u.rows = nullptr; u.nvalid = 0; u.aux = 0; return true;
    }
};
struct EpiCmp {
    static constexpr bool PERM = false;
    float* hid;
    __device__ __forceinline__ void operator()(const f32x4 (&acc)[2][2][4][2], const GU& u, int wr, int wc, int fr, int fq) const {
#pragma unroll
        for (int ai = 0; ai < 2; ++ai)
#pragma unroll
            for (int m = 0; m < 4; ++m) { const int r = 128 * ai + 64 * wr + 16 * m + fr; float* rowp = hid + (size_t)u.kind * (32 * 256 * 128) + ((size_t)u.pm * 256 + r) * 128 + 32 * wc + 4 * fq;
#pragma unroll
                for (int n = 0; n < 2; ++n) *(f32x4*)(rowp + 16 * n) = acc[ai][0][m][n]; }
    }
};
__device__ __forceinline__ float gelu_tanh(float x) { const float u = 0.7978845608028654f * (x + 0.044715f * x * x * x); return 0.5f * x * (1.0f + tanhf(u)); }
__device__ __forceinline__ void p2b_compress_out(Frame& F, const Args& a) {
    const float* hid = (const float*)a.out + (size_t)16 * MiB; const float* cbias = (const float*)(F.ws + WS_SMALLW + 65536 + 2 * 128 * 128 * 2);
    const int gw = F.bx * NWAVES + F.wave, NGW = F.G * NWAVES;
    for (int row = gw; row < 2 * 16 * 256; row += NGW) {
        const int m = row >> 12, n = row & 255; const float* w2 = a.in[m ? IN_CMP_W2_V : IN_CMP_W2_K];
        bf16* dst = (bf16*)(F.ws + (m ? WS_VCMP : WS_KCMP)) + (size_t)(row & 4095) * 128;
        float o0 = 0.f, o1 = 0.f;
        if (n < 255) { const float* hr = hid + (size_t)row * 128;
            for (int e = 0; e < 128; ++e) { float hsum = 0.f;
#pragma unroll
                for (int ks = 0; ks < 8; ++ks) hsum += hr[(size_t)ks * (32 * 256 * 128) + e];
                const float g = gelu_tanh(hsum + cbias[m * 128 + e]); o0 += g * w2[e * 128 + F.lane]; o1 += g * w2[e * 128 + 64 + F.lane]; } }
        dst[F.lane] = (bf16)f2bf(o0); dst[64 + F.lane] = (bf16)f2bf(o1);
        if (m == 1) { bf16* dt = (bf16*)(F.ws + WS_VCMPT) + (size_t)((row >> 8) & 15) * 128 * 256 + n; dt[(size_t)F.lane * 256] = (bf16)f2bf(o0); dt[(size_t)(64 + F.lane) * 256] = (bf16)f2bf(o1); }
    }
}

__device__ __forceinline__ void p3_ret_normalize(Frame& F) {
    bf16* rv = (bf16*)(F.ws + WS_RV); const bf16* rg = (const bf16*)(F.ws + WS_RG);
    const int gw = F.bx * NWAVES + F.wave, NGW = F.G * NWAVES;
    for (int it = gw; it < NTOK * 4; it += NGW) {
        u32x2* p = (u32x2*)(rv + (size_t)it * 256) + F.lane; const u32x2 w = *p; const u32x2 gq = *((const u32x2*)(rg + (size_t)it * 256) + F.lane);
        const float o0 = lo16(w.x), o1 = hi16(w.x), o2 = lo16(w.y), o3 = hi16(w.y);
        const float ss = wave_sum((o0 * o0 + o1 * o1) + (o2 * o2 + o3 * o3));
        const float r = 1.0f / sqrtf(ss * (1.0f / 256.0f) + EPS);
        u32x2 q; q.x = pk2(o0 * r * lo16(gq.x), o1 * r * hi16(gq.x)); q.y = pk2(o2 * r * lo16(gq.y), o3 * r * hi16(gq.y)); *p = q;
    }
}
namespace nsaf {
constexpr int KROW = 272, VROW = 136, KT_BYTES = 64 * KROW, VT_BYTES = 128 * VROW;
constexpr int OFF_K = 0, OFF_V = KT_BYTES, BUF_BYTES = KT_BYTES + VT_BYTES, OFF_IMP = 2 * BUF_BYTES, OFF_MASK = OFF_IMP + 64 * 64 * 4;
constexpr float NEG = -1.0e30f, MASKED = -3.0e38f, CS = 0.08838834764831845f * 1.4426950408889634f;
struct Stage { u32x4 k0, k1, v0, v1; };
__device__ __forceinline__ void stage_load(Stage& st, const bf16* K, const bf16* VT, size_t vpitch, int key0, int tid) {
    const int r0 = tid >> 4, c0 = tid & 15;
    st.k0 = *(const u32x4*)(K + (size_t)(key0 + r0) * 128 + c0 * 8); st.k1 = *(const u32x4*)(K + (size_t)(key0 + r0 + 32) * 128 + c0 * 8);
    const int d0 = tid >> 3, c1 = tid & 7;
    st.v0 = *(const u32x4*)(VT + (size_t)d0 * vpitch + key0 + c1 * 8); st.v1 = *(const u32x4*)(VT + (size_t)(d0 + 64) * vpitch + key0 + c1 * 8);
}
__device__ __forceinline__ void stage_write(const Stage& st, LAS unsigned char* lds, int tid) {
    const int r0 = tid >> 4, c0 = tid & 15;
    *(LAS u32x4*)(lds + OFF_K + r0 * KROW + c0 * 16) = st.k0; *(LAS u32x4*)(lds + OFF_K + (r0 + 32) * KROW + c0 * 16) = st.k1;
    const int d0 = tid >> 3, c1 = tid & 7;
    LAS unsigned char* p0 = lds + OFF_V + d0 * VROW + c1 * 16; LAS unsigned char* p1 = lds + OFF_V + (d0 + 64) * VROW + c1 * 16;
    *(LAS u32x2*)p0 = (u32x2){st.v0.x, st.v0.y}; *(LAS u32x2*)(p0 + 8) = (u32x2){st.v0.z, st.v0.w};
    *(LAS u32x2*)p1 = (u32x2){st.v1.x, st.v1.y}; *(LAS u32x2*)(p1 + 8) = (u32x2){st.v1.z, st.v1.w};
}
template <int MODE>
__device__ __forceinline__ void block_step(const LAS unsigned char* lds, LAS unsigned char* ldstab, const bf16x8 (&qf)[8], f32x16 (&O)[4], float& m, float& l, int blk, int tl_in, int itile, int nvr_in, bool rowsel, float inv_l, int lane_in) {
    int tl = tl_in, nvr = nvr_in, lane = lane_in; LAUNDER(tl); LAUNDER(nvr); LAUNDER(lane);
    const int r = lane & 31, hi = lane >> 5;
    f32x16 S[2];
#pragma unroll
    for (int kh = 0; kh < 2; ++kh) {
#pragma unroll
        for (int j = 0; j < 16; ++j) S[kh][j] = 0.f;
    }
    {
        const unsigned kaddr = (unsigned)(size_t)(lds + OFF_K + r * KROW + 16 * hi);
        u32x4 ka[4], kb[4];
#define NSAF_KRD(dst, t, s4) asm volatile("ds_read_b128 %0, %1 offset:%2" : "=v"(dst) : "v"(kaddr), "i"((t) * 32 * KROW + (s4) * 32))
#define NSAF_KRD4(set, t, s0) do { NSAF_KRD(set[0], t, (s0)); NSAF_KRD(set[1], t, (s0) + 1); NSAF_KRD(set[2], t, (s0) + 2); NSAF_KRD(set[3], t, (s0) + 3); } while (0)
#define NSAF_KWAIT(n, set) asm volatile("s_waitcnt lgkmcnt(" #n ")" : "+v"(set[0]), "+v"(set[1]), "+v"(set[2]), "+v"(set[3]))
#define NSAF_KMMA(set, t, s0) do { _Pragma("unroll") for (int q_ = 0; q_ < 4; ++q_) S[t] = __builtin_amdgcn_mfma_f32_32x32x16_bf16(__builtin_bit_cast(bf16x8, set[q_]), qf[(s0) + q_], S[t], 0, 0, 0); } while (0)
        NSAF_KRD4(ka, 0, 0); NSAF_KRD4(kb, 0, 4);
        NSAF_KWAIT(4, ka); NSAF_KMMA(ka, 0, 0); NSAF_KRD4(ka, 1, 0);
        NSAF_KWAIT(4, kb); NSAF_KMMA(kb, 0, 4); NSAF_KRD4(kb, 1, 4);
        NSAF_KWAIT(4, ka); NSAF_KMMA(ka, 1, 0);
        NSAF_KWAIT(0, kb); NSAF_KMMA(kb, 1, 4);
#undef NSAF_KRD
#undef NSAF_KRD4
#undef NSAF_KWAIT
#undef NSAF_KMMA
    }
    bool need_mask;
    if (MODE <= 1) need_mask = true; else if (MODE == 2) need_mask = (blk == itile); else need_mask = (blk == itile) || (blk == itile - 8);
    float mx = MASKED;
    if (need_mask) {
        int lo_ = -1, hi_ = 63;
        if (MODE <= 1) hi_ = nvr - 64 * blk - 1; else if (MODE == 2) hi_ = tl; else { hi_ = (blk == itile) ? tl : 63; lo_ = (blk == itile - 8) ? tl : -1; }
        lo_ -= 4 * hi; hi_ -= 4 * hi;
#pragma unroll
        for (int kh = 0; kh < 2; ++kh)
#pragma unroll
            for (int j = 0; j < 16; ++j) { const int kc_ = 32 * kh + (j & 3) + 8 * (j >> 2); const bool ok = (kc_ > lo_) & (kc_ <= hi_); const float v = ok ? S[kh][j] : MASKED; S[kh][j] = v; mx = fmaxf(mx, v); }
    } else {
#pragma unroll
        for (int kh = 0; kh < 2; ++kh)
#pragma unroll
            for (int j = 0; j < 16; ++j) mx = fmaxf(mx, S[kh][j]);
    }
    if (MODE == 2) mx = rowsel ? mx : MASKED;
    if (MODE == 1) {
        LAS float* imp = (LAS float*)(ldstab + OFF_IMP) + tl * 64;
#pragma unroll
        for (int kh = 0; kh < 2; ++kh)
#pragma unroll
            for (int j = 0; j < 16; ++j) { const int n = 64 * blk + 32 * kh + (j & 3) + 8 * (j >> 2) + 4 * hi; const float v = S[kh][j]; const float p = __builtin_amdgcn_exp2f(v - m) * inv_l; S[kh][j] = p;
                if (v > 0.5f * MASKED) { __hip_atomic_fetch_add(imp + (n >> 2), p, __ATOMIC_RELAXED, __HIP_MEMORY_SCOPE_WORKGROUP); if ((n & 3) == 3 && (n >> 2) + 1 < 64) __hip_atomic_fetch_add(imp + (n >> 2) + 1, p, __ATOMIC_RELAXED, __HIP_MEMORY_SCOPE_WORKGROUP); } }
    } else {
        mx = fmaxf(mx, __shfl_xor(mx, 32));
        if (__any(mx > m + 8.0f)) { const float mn = fmaxf(m, mx); const float alpha = __builtin_amdgcn_exp2f(m - mn); m = mn; l *= alpha;
            if (MODE != 0) {
#pragma unroll
                for (int dt = 0; dt < 4; ++dt)
#pragma unroll
                    for (int j = 0; j < 16; ++j) O[dt][j] *= alpha; } }
        float rs = 0.f;
        if (MODE == 2) {
#pragma unroll
            for (int kh = 0; kh < 2; ++kh)
#pragma unroll
                for (int j = 0; j < 16; ++j) { const float p = rowsel ? __builtin_amdgcn_exp2f(S[kh][j] - m) : 0.f; S[kh][j] = p; rs += p; }
        } else {
#pragma unroll
            for (int kh = 0; kh < 2; ++kh)
#pragma unroll
                for (int j = 0; j < 16; ++j) { const float p = __builtin_amdgcn_exp2f(S[kh][j] - m); S[kh][j] = p; rs += p; }
        }
        l += rs;
        if (MODE == 0) return;
    }
    bf16x8 pf[2][2];
#pragma unroll
    for (int kh = 0; kh < 2; ++kh)
#pragma unroll
        for (int s2 = 0; s2 < 2; ++s2) { u32x4 w; w.x = cvt_pk_bf16(S[kh][8 * s2 + 0], S[kh][8 * s2 + 1]); w.y = cvt_pk_bf16(S[kh][8 * s2 + 2], S[kh][8 * s2 + 3]); w.z = cvt_pk_bf16(S[kh][8 * s2 + 4], S[kh][8 * s2 + 5]); w.w = cvt_pk_bf16(S[kh][8 * s2 + 6], S[kh][8 * s2 + 7]);
            pf[kh][s2] = __builtin_bit_cast(bf16x8, w); }
    {
        const unsigned vaddr = (unsigned)(size_t)(lds + OFF_V + r * VROW + 8 * hi);
        u32x2 va[8], vb[8];
#define NSAF_VRD(dst, dt, i) asm volatile("ds_read_b64 %0, %1 offset:%2" : "=v"(dst) : "v"(vaddr), "i"((dt) * 32 * VROW + ((i) >> 1) * 32 + ((i) & 1) * 16))
#define NSAF_VRD8(set, dt) do { NSAF_VRD(set[0], dt, 0); NSAF_VRD(set[1], dt, 1); NSAF_VRD(set[2], dt, 2); NSAF_VRD(set[3], dt, 3); NSAF_VRD(set[4], dt, 4); NSAF_VRD(set[5], dt, 5); NSAF_VRD(set[6], dt, 6); NSAF_VRD(set[7], dt, 7); } while (0)
#define NSAF_VWAIT(n, set) asm volatile("s_waitcnt lgkmcnt(" #n ")" : "+v"(set[0]), "+v"(set[1]), "+v"(set[2]), "+v"(set[3]), "+v"(set[4]), "+v"(set[5]), "+v"(set[6]), "+v"(set[7]))
#define NSAF_VMMA(set, dt) do { _Pragma("unroll") for (int ks = 0; ks < 4; ++ks) { const u32x4 a_ = (u32x4){set[2 * ks].x, set[2 * ks].y, set[2 * ks + 1].x, set[2 * ks + 1].y}; \
            O[dt] = __builtin_amdgcn_mfma_f32_32x32x16_bf16(__builtin_bit_cast(bf16x8, a_), pf[ks >> 1][ks & 1], O[dt], 0, 0, 0); } } while (0)
        NSAF_VRD8(va, 0); NSAF_VRD8(vb, 1);
        NSAF_VWAIT(8, va); NSAF_VMMA(va, 0); NSAF_VRD8(va, 2);
        NSAF_VWAIT(8, vb); NSAF_VMMA(vb, 1); NSAF_VRD8(vb, 3);
        NSAF_VWAIT(8, va); NSAF_VMMA(va, 2);
        NSAF_VWAIT(0, vb); NSAF_VMMA(vb, 3);
#undef NSAF_VRD
#undef NSAF_VRD8
#undef NSAF_VWAIT
#undef NSAF_VMMA
    }
}
template <int MODE>
__device__ __forceinline__ void run_pass(LAS unsigned char* lds, const bf16* K, const bf16* VT, size_t vpitch, int jb, int je, const bf16x8 (&qf)[8], f32x16 (&O)[4], float& m, float& l, int tl, int itile, int nvr, unsigned long long selmask, float inv_l, int tid, int lane) {
    Stage st; stage_load(st, K, VT, vpitch, jb * 64, tid); stage_write(st, lds, tid);
    if (jb < je) stage_load(st, K, VT, vpitch, (jb + 1) * 64, tid);
    __syncthreads();
    for (int j = jb; j <= je; ++j) {
        const int cur = (j - jb) & 1;
        if (j < je) { stage_write(st, lds + (cur ^ 1) * BUF_BYTES, tid); if (j + 1 < je) stage_load(st, K, VT, vpitch, (j + 2) * 64, tid); }
        const bool rowsel = (MODE == 2) ? (((selmask >> j) & 1ull) != 0ull) : true;
        if (MODE != 2 || __ballot(rowsel) != 0ull) block_step<MODE>(lds + cur * BUF_BYTES, lds, qf, O, m, l, j, tl, itile, nvr, rowsel, inv_l, lane);
        __syncthreads();
    }
}
}
__device__ __forceinline__ void p3_nsa_fast(Frame& F, const bf16* svT, const bf16* wvT, bf16* outbase) {
    using namespace nsaf;
    unsigned char* ws = F.ws; const int tid = F.tid, lane = F.lane, wave = F.wave; LAS unsigned char* lds = F.lds;
    bf16* nq = (bf16*)(ws + WS_NQ); const float* gates = (const float*)(ws + WS_GATES);
    const int r = lane & 31, hi = lane >> 5, qrow = wave * 32 + r, tl = qrow >> 2, head = qrow & 3;
    for (int u4 = 0; u4 < 4; ++u4) {
        const int pr = F.bx + (u4 >> 1) * F.G; if (pr >= 512) break;
        const int bg = pr >> 5, ii = pr & 31, itile = (u4 & 1) ? (63 - ii) : ii, g = bg & 1, b = bg >> 1;
        const int tok = b * SEQ + itile * 64 + tl, t = itile * 64 + tl;
        const bf16* kc = (const bf16*)(ws + WS_KCMP) + (size_t)bg * 256 * 128; const bf16* vcT = (const bf16*)(ws + WS_VCMPT) + (size_t)bg * 128 * 256;
        const bf16* ks = (const bf16*)(ws + WS_KV6 + 2 * KV_STRIDE) + (size_t)bg * SEQ * 128; const bf16* kw = (const bf16*)(ws + WS_KV6 + 4 * KV_STRIDE) + (size_t)bg * SEQ * 128;
        const bf16* vsT = svT + (size_t)bg * 128 * SEQ; const bf16* vwT = wvT + (size_t)bg * 128 * SEQ;
        __syncthreads();
        for (int i = tid; i < 64 * 64; i += NTHREADS) ((LAS float*)(lds + OFF_IMP))[i] = 0.f;
        bf16x8 qf[8]; bf16* qrowp = nq + (size_t)tok * 1024 + g * 512 + head * 128; bf16* orowp = outbase + (size_t)tok * 1024 + g * 512 + head * 128;
#pragma unroll
        for (int s_ = 0; s_ < 8; ++s_) { const u32x4 w_ = *(const u32x4*)(qrowp + 16 * s_ + 8 * hi);
            u32x4 o_; o_.x = cvt_pk_bf16(lo16(w_.x) * CS, hi16(w_.x) * CS); o_.y = cvt_pk_bf16(lo16(w_.y) * CS, hi16(w_.y) * CS); o_.z = cvt_pk_bf16(lo16(w_.z) * CS, hi16(w_.z) * CS); o_.w = cvt_pk_bf16(lo16(w_.w) * CS, hi16(w_.w) * CS);
            qf[s_] = __builtin_bit_cast(bf16x8, o_); }
        const float g0 = gates[(size_t)tok * 24 + (g * 4 + head) * 3 + 0], g1 = gates[(size_t)tok * 24 + (g * 4 + head) * 3 + 1], g2 = gates[(size_t)tok * 24 + (g * 4 + head) * 3 + 2];
        const int nvr = (t >= 31) ? (((t - 31) >> 4) + 1 > 255 ? 255 : ((t - 31) >> 4) + 1) : 0;
        const int jec = ((4 * itile + 2) >> 6) > 3 ? 3 : ((4 * itile + 2) >> 6);
        f32x16 O[4];
#define NSAF_ZERO_O() do { _Pragma("unroll") for (int dt = 0; dt < 4; ++dt) _Pragma("unroll") for (int j = 0; j < 16; ++j) O[dt][j] = 0.f; } while (0)
#define NSAF_ACCUM(coef, FIRST) do { const float cf_ = (coef); _Pragma("unroll") for (int dt = 0; dt < 4; ++dt) { _Pragma("unroll") for (int q4 = 0; q4 < 4; ++q4) { u32x2* p_ = (u32x2*)(orowp + 32 * dt + 8 * q4 + 4 * hi); \
            float a0_ = cf_ * O[dt][4 * q4], a1_ = cf_ * O[dt][4 * q4 + 1], a2_ = cf_ * O[dt][4 * q4 + 2], a3_ = cf_ * O[dt][4 * q4 + 3]; \
            if (!(FIRST)) { const u32x2 o_ = *p_; a0_ += lo16(o_.x); a1_ += hi16(o_.x); a2_ += lo16(o_.y); a3_ += hi16(o_.y); } \
            *p_ = (u32x2){cvt_pk_bf16(a0_, a1_), cvt_pk_bf16(a2_, a3_)}; } asm volatile("" ::: "memory"); } } while (0)
        float m = NEG, l = 0.f; NSAF_ZERO_O();
        run_pass<0>(lds, kc, vcT, 256, 0, jec, qf, O, m, l, tl, itile, nvr, 0ull, 0.f, tid, lane);
        l += __shfl_xor(l, 32); const float invl = l > 0.f ? 1.0f / l : 0.f;
        run_pass<1>(lds, kc, vcT, 256, 0, jec, qf, O, m, l, tl, itile, nvr, 0ull, invl, tid, lane);
        NSAF_ACCUM(g0, true);
        __syncthreads();
        for (int tk = 0; tk < 8; ++tk) { const int tokl = wave * 8 + tk; float v = ((const LAS float*)(lds + OFF_IMP))[tokl * 64 + lane];
            const bool forced = (lane == 0) || (lane == itile) || (lane == itile - 1); v = (lane > itile) ? -1.0e4f : (forced ? 1.0e4f : v);
            int rank = 0;
#pragma unroll 16
            for (int i = 0; i < 64; ++i) { const float w = __builtin_bit_cast(float, __builtin_amdgcn_readlane(__builtin_bit_cast(int, v), i)); rank += (w > v || (w == v && i < lane)) ? 1 : 0; }
            const unsigned long long mk = __ballot(rank < 16);
            if (lane == 0) { ((LAS unsigned*)(lds + OFF_MASK))[tokl * 2] = (unsigned)mk; ((LAS unsigned*)(lds + OFF_MASK))[tokl * 2 + 1] = (unsigned)(mk >> 32); } }
        __syncthreads();
        const unsigned long long selmask = (unsigned long long)((const LAS unsigned*)(lds + OFF_MASK))[tl * 2] | ((unsigned long long)((const LAS unsigned*)(lds + OFF_MASK))[tl * 2 + 1] << 32);
        m = NEG; l = 0.f; NSAF_ZERO_O();
        run_pass<2>(lds, ks, vsT, SEQ, 0, itile, qf, O, m, l, tl, itile, 0, selmask, 0.f, tid, lane);
        l += __shfl_xor(l, 32); NSAF_ACCUM(l > 0.f ? g1 / l : 0.f, false);
        m = NEG; l = 0.f; NSAF_ZERO_O();
        run_pass<3>(lds, kw, vwT, SEQ, itile > 8 ? itile - 8 : 0, itile, qf, O, m, l, tl, itile, 0, 0ull, 0.f, tid, lane);
        l += __shfl_xor(l, 32); NSAF_ACCUM(l > 0.f ? g2 / l : 0.f, false);
#undef NSAF_ZERO_O
#undef NSAF_ACCUM
    }
    __syncthreads();
}
struct SchedP4 {
    unsigned char* ws; int G, c;
    __device__ __forceinline__ bool next(int i, GU& u) const {
        const int ti = i >> 2, sub = i & 3; const int L = ti * G + c; if (L >= 128 * 4) return false;
        int pm, pn; pg8::tile_map(L, 128, 4, pm, pn);
        const size_t ao = sub == 1 ? WS_RV : sub == 3 ? WS_NQ : WS_H; const size_t bo = sub == 0 ? W_GA : sub == 1 ? W_RO : sub == 2 ? W_GB : W_NO;
        u.A = (const char*)ws + ao + (size_t)pm * 256 * D * 2; u.B = (const char*)ws + bo + (size_t)pn * 256 * D * 2; u.pm = pm; u.pn = pn; u.kind = sub; u.rows = nullptr; u.nvalid = 0; u.aux = 0; return true;
    }
};
struct EpiP4 {
    static constexpr bool PERM = true;
    float* scr;
    bf16* Y;
    static __device__ __forceinline__ u32x2 pk4(const f32x4 v) { return (u32x2){cvt_pk_bf16(v[0], v[1]), cvt_pk_bf16(v[2], v[3])}; }
    static __device__ __forceinline__ f32x4 up4(const u32x2 w) { return (f32x4){lo16(w.x), hi16(w.x), lo16(w.y), hi16(w.y)}; }
    __device__ __forceinline__ void operator()(const f32x4 (&acc)[2][2][4][2], const GU& u, int wr, int wc, int fr, int fq) const {
        u32x2* p0 = (u32x2*)scr + threadIdx.x; u32x2* p1 = p0 + 32 * 512;
        if (u.kind == 0 || u.kind == 2) {
            u32x2* p = u.kind == 0 ? p0 : p1;
#pragma unroll
            for (int ai = 0; ai < 2; ++ai)
#pragma unroll
                for (int m = 0; m < 4; ++m) {
#pragma unroll
                    for (int bj = 0; bj < 2; ++bj) { f32x4 v0 = acc[ai][bj][m][0], v1 = acc[ai][bj][m][1];
#pragma unroll
                        for (int j = 0; j < 4; ++j) { v0[j] = sigmoidf_(v0[j]); v1[j] = sigmoidf_(v1[j]); }
                        p[(2 * bj) * 512] = pk4(v0); p[(2 * bj + 1) * 512] = pk4(v1); }
                    p += 4 * 512; LAUNDER(p); }
        } else if (u.kind == 1) {
#pragma unroll
            for (int ai = 0; ai < 2; ++ai)
#pragma unroll
                for (int m = 0; m < 4; ++m) {
#pragma unroll
                    for (int bj = 0; bj < 2; ++bj) { p0[(2 * bj) * 512] = pk4(up4(p0[(2 * bj) * 512]) * acc[ai][bj][m][0]); p0[(2 * bj + 1) * 512] = pk4(up4(p0[(2 * bj + 1) * 512]) * acc[ai][bj][m][1]); }
                    p0 += 4 * 512; LAUNDER(p0); }
        } else {
            bf16* yb = Y + (size_t)(u.pm * 256 + 64 * wr + fr) * D + u.pn * 256 + 32 * wc + 8 * fq;
#pragma unroll
            for (int ai = 0; ai < 2; ++ai)
#pragma unroll
                for (int m = 0; m < 4; ++m) {
#pragma unroll
                    for (int bj = 0; bj < 2; ++bj) {
                        const f32x4 v0 = up4(p0[(2 * bj) * 512]) + up4(p1[(2 * bj) * 512]) * acc[ai][bj][m][0], v1 = up4(p0[(2 * bj + 1) * 512]) + up4(p1[(2 * bj + 1) * 512]) * acc[ai][bj][m][1];
                        u32x4 w; w.x = cvt_pk_bf16(v0[0], v0[1]); w.y = cvt_pk_bf16(v0[2], v0[3]); w.z = cvt_pk_bf16(v1[0], v1[1]); w.w = cvt_pk_bf16(v1[2], v1[3]);
                        *(u32x4*)(yb + (size_t)(128 * ai + 16 * m) * D + 128 * bj) = w; }
                    p0 += 4 * 512; p1 += 4 * 512; LAUNDER(p0); LAUNDER(p1); }
        }
    }
};

struct SchedMN {
    unsigned char* ws; size_t ao, bo; int G, c;
    __device__ __forceinline__ bool next(int i, GU& u) const {
        const int L = i * G + c; if (L >= 128 * 4) return false; int pm, pn; pg8::tile_map(L, 128, 4, pm, pn);
        u.A = (const char*)ws + ao + (size_t)pm * 256 * D * 2; u.B = (const char*)ws + bo + (size_t)pn * 256 * D * 2; u.pm = pm; u.pn = pn; u.kind = 0; u.rows = nullptr; u.nvalid = 0; u.aux = 0; return true;
    }
};
template <bool SSQ> struct EpiRes {
    static constexpr bool PERM = false;
    const float* basef; const bf16* baseb; float* out; bf16* ob; float* ssq;
    __device__ __forceinline__ void operator()(const f32x4 (&acc)[2][2][4][2], const GU& u, int wr, int wc, int fr, int fq) const {
#pragma unroll
        for (int ai = 0; ai < 2; ++ai)
#pragma unroll
            for (int m = 0; m < 4; ++m) { const int r = u.pm * 256 + 128 * ai + 64 * wr + 16 * m + fr; const size_t off = (size_t)r * D + u.pn * 256 + 32 * wc + 4 * fq; float sq = 0.f;
#pragma unroll
                for (int bj = 0; bj < 2; ++bj)
#pragma unroll
                    for (int n = 0; n < 2; ++n) { const size_t o = off + 128 * bj + 16 * n; f32x4 bv;
                        if (SSQ) bv = *(const f32x4*)(basef + o); else { const u32x2 bw = *(const u32x2*)(baseb + o); bv = (f32x4){lo16(bw.x), hi16(bw.x), lo16(bw.y), hi16(bw.y)}; }
                        const f32x4 v = bv + acc[ai][bj][m][n];
                        if (!SSQ) *(f32x4*)(out + o) = v;
                        u32x2 w; w.x = cvt_pk_bf16(v[0], v[1]); w.y = cvt_pk_bf16(v[2], v[3]); *(u32x2*)(ob + o) = w; sq += (v[0] * v[0] + v[1] * v[1]) + (v[2] * v[2] + v[3] * v[3]); }
                if (SSQ) { sq += __shfl_xor(sq, 16); sq += __shfl_xor(sq, 32); if (fq == 0) ssq[(size_t)r * 16 + u.pn * 4 + wc] = sq; }
            }
    }
};
struct EpiQ {
    static constexpr bool PERM = true;
    const float* ssq; bf16* Q;
    __device__ __forceinline__ void operator()(const f32x4 (&acc)[2][2][4][2], const GU& u, int wr, int wc, int fr, int fq) const {
#pragma unroll
        for (int ai = 0; ai < 2; ++ai)
#pragma unroll
            for (int m = 0; m < 4; ++m) { const int r = u.pm * 256 + 128 * ai + 64 * wr + 16 * m + fr; const f32x4* sp = (const f32x4*)(ssq + (size_t)r * 16);
                const f32x4 a = sp[0], b = sp[1], c = sp[2], d = sp[3]; const float tot = ((a[0] + a[1]) + (a[2] + a[3])) + ((b[0] + b[1]) + (b[2] + b[3])) + ((c[0] + c[1]) + (c[2] + c[3])) + ((d[0] + d[1]) + (d[2] + d[3]));
                const float rstd = 1.0f / sqrtf(tot * (1.0f / D) + EPS);
#pragma unroll
                for (int bj = 0; bj < 2; ++bj) { const f32x4 v0 = acc[ai][bj][m][0] * rstd, v1 = acc[ai][bj][m][1] * rstd;
                    u32x4 w; w.x = cvt_pk_bf16(v0[0], v0[1]); w.y = cvt_pk_bf16(v0[2], v0[3]); w.z = cvt_pk_bf16(v1[0], v1[1]); w.w = cvt_pk_bf16(v1[2], v1[3]);
                    *(u32x4*)(Q + (size_t)r * D + u.pn * 256 + 128 * bj + 32 * wc + 8 * fq) = w; } }
    }
};

namespace xatf {
constexpr int KROW = 528, VROW = 136, KT_BYTES = 64 * KROW, OFF_K = 0, OFF_V = KT_BYTES;
constexpr float NEG = -1.0e30f, CS = 0.0625f * 1.4426950408889634f;
struct Stage { u32x4 k[4]; u32x4 v[2]; };
__device__ __forceinline__ void stage_load(Stage& st, const bf16* K, const bf16* VT, int key0, int tid) {
#pragma unroll
    for (int i = 0; i < 4; ++i) { const int p = tid + 512 * i, row = p >> 5, c = p & 31; st.k[i] = *(const u32x4*)(K + (size_t)(key0 + row) * 2048 + c * 8); }
#pragma unroll
    for (int i = 0; i < 2; ++i) { const int p = tid + 512 * i, d = p >> 3, c = p & 7; st.v[i] = *(const u32x4*)(VT + (size_t)d * 256 + key0 + c * 8); }
}
__device__ __forceinline__ void stage_write(const Stage& st, LAS unsigned char* lds, int tid) {
#pragma unroll
    for (int i = 0; i < 4; ++i) { const int p = tid + 512 * i, row = p >> 5, c = p & 31; *(LAS u32x4*)(lds + OFF_K + row * KROW + c * 16) = st.k[i]; }
#pragma unroll
    for (int i = 0; i < 2; ++i) { const int p = tid + 512 * i, d = p >> 3, c = p & 7; LAS unsigned char* q = lds + OFF_V + d * VROW + c * 16;
        *(LAS u32x2*)q = (u32x2){st.v[i].x, st.v[i].y}; *(LAS u32x2*)(q + 8) = (u32x2){st.v[i].z, st.v[i].w}; }
}
__device__ __forceinline__ void block_step(const LAS unsigned char* lds, const bf16x8 (&qf)[16], f32x16 (&O)[4], float& m, float& l, int lane) {
    const int r = lane & 31, hi = lane >> 5;
    f32x16 S[2];
#pragma unroll
    for (int kh = 0; kh < 2; ++kh) {
#pragma unroll
        for (int j = 0; j < 16; ++j) S[kh][j] = 0.f;
#pragma unroll
        for (int s_ = 0; s_ < 16; ++s_) { const bf16x8 a = *(const LAS bf16x8*)(lds + OFF_K + (kh * 32 + r) * KROW + (16 * s_ + 8 * hi) * 2); S[kh] = __builtin_amdgcn_mfma_f32_32x32x16_bf16(a, qf[s_], S[kh], 0, 0, 0); }
    }
    float mx = NEG;
#pragma unroll
    for (int kh = 0; kh < 2; ++kh)
#pragma unroll
        for (int j = 0; j < 16; ++j) { const float v = S[kh][j] * CS; S[kh][j] = v; mx = fmaxf(mx, v); }
    mx = fmaxf(mx, __shfl_xor(mx, 32));
    const float mn = fmaxf(m, mx); const float alpha = __builtin_amdgcn_exp2f(m - mn); m = mn; float rs = 0.f;
#pragma unroll
    for (int kh = 0; kh < 2; ++kh)
#pragma unroll
        for (int j = 0; j < 16; ++j) { const float p = __builtin_amdgcn_exp2f(S[kh][j] - mn); S[kh][j] = p; rs += p; }
    l = l * alpha + rs;
#pragma unroll
    for (int dt = 0; dt < 4; ++dt)
#pragma unroll
        for (int j = 0; j < 16; ++j) O[dt][j] *= alpha;
    bf16x8 pf[2][2];
#pragma unroll
    for (int kh = 0; kh < 2; ++kh)
#pragma unroll
        for (int s2 = 0; s2 < 2; ++s2) { u32x4 w; w.x = cvt_pk_bf16(S[kh][8 * s2 + 0], S[kh][8 * s2 + 1]); w.y = cvt_pk_bf16(S[kh][8 * s2 + 2], S[kh][8 * s2 + 3]); w.z = cvt_pk_bf16(S[kh][8 * s2 + 4], S[kh][8 * s2 + 5]); w.w = cvt_pk_bf16(S[kh][8 * s2 + 6], S[kh][8 * s2 + 7]);
            pf[kh][s2] = __builtin_bit_cast(bf16x8, w); }
#pragma unroll
    for (int dt = 0; dt < 4; ++dt)
#pragma unroll
        for (int kh = 0; kh < 2; ++kh)
#pragma unroll
            for (int s2 = 0; s2 < 2; ++s2) { const LAS unsigned char* vp = lds + OFF_V + (dt * 32 + r) * VROW + (32 * kh + 16 * s2 + 4 * hi) * 2;
                const u32x2 lo = *(const LAS u32x2*)vp, hi2 = *(const LAS u32x2*)(vp + 16); const u32x4 av = (u32x4){lo.x, lo.y, hi2.x, hi2.y};
                O[dt] = __builtin_amdgcn_mfma_f32_32x32x16_bf16(__builtin_bit_cast(bf16x8, av), pf[kh][s2], O[dt], 0, 0, 0); }
}
}
__device__ __forceinline__ void p7_xattn_fast(Frame& F, const bf16* vT, bf16* outbase) {
    using namespace xatf;
    bf16* Q = (bf16*)(F.ws + WS_NQ); const bf16* KV = (const bf16*)(F.ws + WS_MEMKV);
    const int tid = F.tid, lane = F.lane, wave = F.wave, r = lane & 31, hi = lane >> 5; LAS unsigned char* lds = F.lds;
    for (int u = F.bx; u < BATCH * 4 * 16; u += F.G) {
        const int tt = u & 15, bh = u >> 4, b = bh >> 2, h = bh & 3; const int tok = b * SEQ + tt * 256 + wave * 32 + r;
        bf16* qrow = Q + (size_t)tok * D + h * 256; bf16* orow = outbase + (size_t)tok * D + h * 256; const bf16* Kb = KV + (size_t)(b * NMEM) * 2048 + h * 256;
        bf16x8 qf[16];
#pragma unroll
        for (int s_ = 0; s_ < 16; ++s_) qf[s_] = *(const bf16x8*)(qrow + 16 * s_ + 8 * hi);
#pragma unroll
        for (int half = 0; half < 2; ++half) {
            const bf16* VTb = vT + ((size_t)bh * 256 + half * 128) * 256;
            f32x16 O[4]; float m = NEG, l = 0.f;
#pragma unroll
            for (int dt = 0; dt < 4; ++dt)
#pragma unroll
                for (int j = 0; j < 16; ++j) O[dt][j] = 0.f;
            for (int j = 0; j < 4; ++j) {
                __syncthreads(); { Stage st; stage_load(st, Kb, VTb, j * 64, tid); stage_write(st, lds, tid); } __syncthreads();
                block_step(lds, qf, O, m, l, lane);
            }
            l += __shfl_xor(l, 32); const float inv = 1.0f / l;
#pragma unroll
            for (int dt = 0; dt < 4; ++dt)
#pragma unroll
                for (int q4 = 0; q4 < 4; ++q4) *(u32x2*)(orow + half * 128 + 32 * dt + 8 * q4 + 4 * hi) = (u32x2){cvt_pk_bf16(O[dt][4 * q4] * inv, O[dt][4 * q4 + 1] * inv), cvt_pk_bf16(O[dt][4 * q4 + 2] * inv, O[dt][4 * q4 + 3] * inv)};
        }
    }
    __syncthreads();
}
__device__ __forceinline__ void transpose_memv_tiles(Frame& F, bf16* vT, int w0, int nw) {
    LAS unsigned short* tl_ = (LAS unsigned short*)(F.lds + F.wave * 16384); const int lane = F.lane; const bf16* KV = (const bf16*)(F.ws + WS_MEMKV);
    for (int tile = w0; tile < 32 * 16; tile += nw) {
        const int dq = tile & 3, kq = (tile >> 2) & 3, bh = tile >> 4, b = bh >> 2, h = bh & 3;
        const bf16* sp = KV + (size_t)(b * NMEM + kq * 64) * 2048 + 1024 + h * 256 + dq * 64; bf16* dp = vT + ((size_t)bh * 256 + dq * 64) * 256 + kq * 64;
#pragma unroll
        for (int i = 0; i < 8; ++i) { const int row = i * 8 + (lane >> 3), c = lane & 7; const u32x4 v = *(const u32x4*)(sp + (size_t)row * 2048 + c * 8); LAS unsigned short* q = tl_ + row * 66 + c * 8;
            q[0] = (unsigned short)(v.x & 0xffffu); q[1] = (unsigned short)(v.x >> 16); q[2] = (unsigned short)(v.y & 0xffffu); q[3] = (unsigned short)(v.y >> 16);
            q[4] = (unsigned short)(v.z & 0xffffu); q[5] = (unsigned short)(v.z >> 16); q[6] = (unsigned short)(v.w & 0xffffu); q[7] = (unsigned short)(v.w >> 16); }
        LDS_WAIT(); asm volatile("" ::: "memory");
#pragma unroll
        for (int i = 0; i < 8; ++i) { const int d = i * 8 + (lane >> 3), c = lane & 7; const LAS unsigned short* q = tl_ + (c * 8) * 66 + d;
            u32x4 o; o.x = (unsigned)q[0] | ((unsigned)q[66] << 16); o.y = (unsigned)q[2 * 66] | ((unsigned)q[3 * 66] << 16); o.z = (unsigned)q[4 * 66] | ((unsigned)q[5 * 66] << 16); o.w = (unsigned)q[6 * 66] | ((unsigned)q[7 * 66] << 16);
            *(u32x4*)(dp + (size_t)d * 256 + c * 8) = o; }
        LDS_WAIT(); asm volatile("" ::: "memory");
    }
}

__device__ __forceinline__ void p9_route(Frame& F, const Args& a) {
    unsigned char* ws = F.ws; const float* X2 = a.out;
    const float* gff = a.in[IN_NORM_FFN_G]; const float* wgrp = a.in[IN_W_GRP]; const float* bgrp = a.in[IN_B_GRP]; const float* wrt = a.in[IN_W_RT]; const float* brt = a.in[IN_B_RT];
    float* wts = (float*)(ws + WS_ROUTE); float* rstd2 = wts + 2 * NTOK; int* lists = (int*)(ws + WS_LISTS);
    const int gw = F.bx * NWAVES + F.wave, NGW = F.G * NWAVES, lane = F.lane;
    f32x4 vnext[4];
    if (gw < NTOK) {
#pragma unroll
        for (int j = 0; j < 4; ++j) vnext[j] = ((const f32x4*)(X2 + (size_t)gw * D) + lane)[64 * j]; }
    int my_ea = -1, my_eb = -1, my_tok = -1, it_ = 0; float my_w1 = 0.f, my_w2 = 0.f, my_rstd = 0.f;
    for (int tok = gw; tok < NTOK; tok += NGW, ++it_) {
        const f32x4* gr = (const f32x4*)gff + lane;
        f32x4 v[4]; float s = 0.f;
#pragma unroll
        for (int j = 0; j < 4; ++j) { v[j] = vnext[j]; s += (v[j].x * v[j].x + v[j].y * v[j].y) + (v[j].z * v[j].z + v[j].w * v[j].w); }
        if (tok + NGW < NTOK) {
#pragma unroll
            for (int j = 0; j < 4; ++j) vnext[j] = ((const f32x4*)(X2 + (size_t)(tok + NGW) * D) + lane)[64 * j]; }
        const float rstd = 1.0f / sqrtf(wave_sum(s) * (1.f / D) + EPS);
        float lg[4] = {0.f, 0.f, 0.f, 0.f};
        const float* pwg = wgrp + (size_t)(4 * lane) * 4;
#pragma unroll
        for (int j = 0; j < 4; ++j) { const f32x4 gg = gr[64 * j];
#pragma unroll
            for (int c = 0; c < 4; ++c) { const float hf = v[j][c] * rstd * gg[c]; v[j][c] = hf; const f32x4 wg = *(const f32x4*)(pwg + c * 4);
#pragma unroll
                for (int i = 0; i < 4; ++i) lg[i] += hf * wg[i]; }
            pwg += 256 * 4; LAUNDER(pwg); }
#pragma unroll
        for (int i = 0; i < 4; ++i) lg[i] = wave_sum(lg[i]) + bgrp[i];
        int grp = 0; float gm = lg[0];
#pragma unroll
        for (int i = 1; i < 4; ++i) if (lg[i] > gm) { gm = lg[i]; grp = i; }
        grp = __builtin_amdgcn_readfirstlane(grp);
        float gs = 0.f;
#pragma unroll
        for (int i = 0; i < 4; ++i) gs += expf(lg[i] - gm);
        const float g_gate = 1.0f / gs;
        float lq[8];
#pragma unroll
        for (int i = 0; i < 8; ++i) lq[i] = 0.f;
        const float* pwr = wrt + (size_t)(4 * lane) * 32 + grp * 8;
#pragma unroll
        for (int j = 0; j < 4; ++j) {
#pragma unroll
            for (int c = 0; c < 4; ++c) { const float hf = v[j][c]; const f32x4 wa = *(const f32x4*)(pwr + c * 32), wb = *(const f32x4*)(pwr + c * 32 + 4);
#pragma unroll
                for (int i = 0; i < 4; ++i) { lq[i] += hf * wa[i]; lq[4 + i] += hf * wb[i]; } }
            pwr += 256 * 32; LAUNDER(pwr); }
#pragma unroll
        for (int i = 0; i < 8; ++i) lq[i] = wave_sum(lq[i]) + brt[grp * 8 + i];
        int i1 = 0; float m1 = lq[0];
#pragma unroll
        for (int i = 1; i < 8; ++i) if (lq[i] > m1) { m1 = lq[i]; i1 = i; }
        int i2 = -1; float m2 = -3.0e38f;
#pragma unroll
        for (int i = 0; i < 8; ++i) if (i != i1 && lq[i] > m2) { m2 = lq[i]; i2 = i; }
        const float e2 = expf(m2 - m1), den = 1.0f + e2; const float w1 = g_gate / den, w2 = g_gate * e2 / den;
        if (lane == it_) { my_ea = grp * 8 + i1; my_eb = grp * 8 + i2; my_tok = tok; my_w1 = w1; my_w2 = w2; my_rstd = rstd; }
    }
    if (my_tok >= 0) {
        const unsigned sa = __hip_atomic_fetch_add(F.ctl + CW_ECNT + 64 * my_ea, 1u, __ATOMIC_RELAXED, __HIP_MEMORY_SCOPE_AGENT);
        const unsigned sb = __hip_atomic_fetch_add(F.ctl + CW_ECNT + 64 * my_eb, 1u, __ATOMIC_RELAXED, __HIP_MEMORY_SCOPE_AGENT);
        lists[(size_t)my_ea * NTOK + sa] = my_tok * 2; lists[(size_t)my_eb * NTOK + sb] = my_tok * 2 + 1;
        wts[my_tok * 2] = my_w1; wts[my_tok * 2 + 1] = my_w2; rstd2[my_tok] = my_rstd;
    }
}
struct XItem { const float* src; bf16* dst; const float* ks; int ldw, ldt, mode, row_off, c0, k0, has_ks; };
__device__ __forceinline__ void xitem_decode(const Args& a, unsigned char* ws, int it, XItem& x) {
    const int e = it / 768, r = it % 768, which = r >> 8, t = r & 255;
    x.ks = a.in[IN_NORM_FFN_G];
    if (which < 2) { x.src = a.in[which ? IN_W_E3 : IN_W_E1] + (size_t)e * D * DEXP; x.ldw = DEXP; x.dst = (bf16*)(ws + WS_W13) + (size_t)e * D * D; x.ldt = D; x.mode = 1; x.row_off = which; x.has_ks = 1; x.c0 = 32 * (t & 15); x.k0 = 64 * (t >> 4); }
    else { x.src = a.in[IN_W_E2] + (size_t)e * DEXP * D; x.ldw = D; x.dst = (bf16*)(ws + WS_W2) + (size_t)e * D * DEXP; x.ldt = DEXP; x.mode = 0; x.row_off = 0; x.has_ks = 0; x.c0 = 32 * (t & 31); x.k0 = 64 * (t >> 5); }
}
__device__ __forceinline__ void xitem_load(const XItem& x, int lane, float (&vv)[32], f32x4& k0v, f32x4& k1v) {
#pragma unroll
    for (int i = 0; i < 32; ++i) { const int kk = 2 * i + (lane >> 5); vv[i] = x.src[(size_t)(x.k0 + kk) * x.ldw + x.c0 + (lane & 31)]; }
    const f32x4* p = (const f32x4*)(x.ks + x.k0 + 8 * (lane & 7)); k0v = p[0]; k1v = p[1];
}
__device__ __forceinline__ void xitem_finish(const XItem& x, int lane, const float (&vv)[32], f32x4 k0v, f32x4 k1v, LAS float* scr) {
    if (!x.has_ks) { k0v = (f32x4){1.f, 1.f, 1.f, 1.f}; k1v = k0v; }
#pragma unroll
    for (int i = 0; i < 32; ++i) { const int kk = 2 * i + (lane >> 5); scr[kk * 33 + (lane & 31)] = vv[i]; }
    LDS_WAIT(); asm volatile("" ::: "memory");
    const int c = lane & 7;
#pragma unroll
    for (int j = 0; j < 4; ++j) { const int n = (lane >> 3) + 8 * j; const LAS float* s = scr + (8 * c) * 33 + n;
        u32x4 o; o.x = pk2(s[0 * 33] * k0v.x, s[1 * 33] * k0v.y); o.y = pk2(s[2 * 33] * k0v.z, s[3 * 33] * k0v.w); o.z = pk2(s[4 * 33] * k1v.x, s[5 * 33] * k1v.y); o.w = pk2(s[6 * 33] * k1v.z, s[7 * 33] * k1v.w);
        const int jc = x.c0 + n; const int drow = x.mode == 0 ? jc : (8 * (jc >> 2) + 4 * x.row_off + (jc & 3));
        *(u32x4*)(x.dst + (size_t)drow * x.ldt + x.k0 + 8 * c) = o; }
    LDS_WAIT(); asm volatile("" ::: "memory");
}
__device__ __forceinline__ void expert_copies(Frame& F, const Args& a, int e_lo, int e_hi) {
    LAS float* scr = (LAS float*)(F.lds + F.wave * 16384);
    const int gw = F.bx * NWAVES + F.wave, NGW = F.G * NWAVES, lane = F.lane;
    const int it_end = e_hi * 768;
    int it = e_lo * 768 + gw;
    if (it < it_end) {
        float va[32], vb[32]; f32x4 ka0, ka1, kb0, kb1; XItem xa, xb;
        xitem_decode(a, F.ws, it, xa); xitem_load(xa, lane, va, ka0, ka1);
        for (;;) {
            int itn = it + NGW; bool hn = itn < it_end;
            xitem_decode(a, F.ws, hn ? itn : it, xb); xitem_load(xb, lane, vb, kb0, kb1);
            xitem_finish(xa, lane, va, ka0, ka1, scr);
            if (!hn) break;
            it = itn; itn = it + NGW; hn = itn < it_end;
            xitem_decode(a, F.ws, hn ? itn : it, xa); xitem_load(xa, lane, va, ka0, ka1);
            xitem_finish(xb, lane, vb, kb0, kb1, scr);
            if (!hn) break;
            it = itn;
        }
    }
    __syncthreads();
}

__device__ __forceinline__ void moe_tiles(Frame& F) {
    __syncthreads();
    if (F.tid == 0) { unsigned accu = 0u; for (int e = 0; e < NEXP; ++e) { const unsigned c = __hip_atomic_load(F.ctl + CW_ECNT + 64 * e, __ATOMIC_RELAXED, __HIP_MEMORY_SCOPE_AGENT); F.MISC[16 + e] = accu; F.MISC[64 + e] = c; accu += (c + 255u) >> 8; } F.MISC[16 + NEXP] = accu; }
    __syncthreads();
}
template <int WHICH> struct SchedMoe {
    volatile LAS unsigned* MISC; unsigned char* ws; int G, c;
    __device__ __forceinline__ bool next(int i, GU& u) const {
        const int L = i * G + c; const int T = (int)MISC[16 + NEXP]; if (L >= 4 * T) return false;
        const int tau = L >> 2, pn = L & 3; int e = 0;
        for (int k = 1; k < NEXP; ++k) if ((int)MISC[16 + k] <= tau) e = k;
        const int lt = tau - (int)MISC[16 + e]; const int cnt = (int)MISC[64 + e]; int nv = cnt - lt * 256; nv = nv > 256 ? 256 : nv;
        u.rows = (const int*)(ws + WS_LISTS) + (size_t)e * NTOK + lt * 256; u.nvalid = nv; u.pm = tau; u.pn = pn; u.kind = 0; u.aux = e;
        if (WHICH == 0) { u.A = (const char*)ws + WS_X2B; u.B = (const char*)ws + WS_W13 + (size_t)e * D * D * 2 + (size_t)pn * 256 * D * 2; }
        else { u.A = (const char*)ws + WS_H1 + (size_t)tau * 256 * DEXP * 2; u.B = (const char*)ws + WS_W2 + (size_t)e * D * DEXP * 2 + (size_t)pn * 256 * DEXP * 2; }
        return true;
    }
};
struct EpiMoe1 {
    static constexpr bool PERM = true;
    const float* rstd2; bf16* H1;
    __device__ __forceinline__ void operator()(const f32x4 (&acc)[2][2][4][2], const GU& u, int wr, int wc, int fr, int fq) const {
        char* hb = (char*)H1 + (size_t)u.pm * 256 * DEXP * 2;
        const int j00 = (u.pn * 256 + 32 * wc + 8 * fq) >> 1;
#pragma unroll
        for (int ai = 0; ai < 2; ++ai) {
            int r = 128 * ai + 64 * wr + fr; LAUNDER(r);
#pragma unroll
            for (int m = 0; m < 4; ++m) { const bool ok = r < u.nvalid; const float rs = ok ? rstd2[u.rows[r] >> 1] : 0.f;
#pragma unroll
                for (int bj = 0; bj < 2; ++bj) { const f32x4 a1 = acc[ai][bj][m][0] * rs, a3 = acc[ai][bj][m][1] * rs; f32x4 hv;
#pragma unroll
                    for (int j = 0; j < 4; ++j) hv[j] = a1[j] * sigmoidf_(a1[j]) * a3[j];
                    u32x2 w; w.x = cvt_pk_bf16(hv[0], hv[1]); w.y = cvt_pk_bf16(hv[2], hv[3]); *(u32x2*)(hb + (unsigned)((r * DEXP + j00 + 64 * bj) * 2)) = w; }
                r += 16; LAUNDER(r); }
        }
    }
};
struct EpiMoe2 {
    static constexpr bool PERM = true;
    const float* wts; bf16* Y0; bf16* Y1;
    __device__ __forceinline__ void operator()(const f32x4 (&acc)[2][2][4][2], const GU& u, int wr, int wc, int fr, int fq) const {
#pragma unroll
        for (int ai = 0; ai < 2; ++ai)
#pragma unroll
            for (int m = 0; m < 4; ++m) { const int r = 128 * ai + 64 * wr + 16 * m + fr;
                if (r < u.nvalid) { const int ent = u.rows[r]; const float w8 = wts[ent]; bf16* dst = ((ent & 1) ? Y1 : Y0) + (size_t)(ent >> 1) * D + u.pn * 256 + 32 * wc + 8 * fq;
#pragma unroll
                    for (int bj = 0; bj < 2; ++bj) { const f32x4 v0 = acc[ai][bj][m][0] * w8, v1 = acc[ai][bj][m][1] * w8;
                        u32x4 w; w.x = cvt_pk_bf16(v0[0], v0[1]); w.y = cvt_pk_bf16(v0[2], v0[3]); w.z = cvt_pk_bf16(v1[0], v1[1]); w.w = cvt_pk_bf16(v1[2], v1[3]);
                        *(u32x4*)(dst + 128 * bj) = w; } } }
    }
};

__device__ __forceinline__ void p12_final(Frame& F, const Args& a) {
    const bf16* Y0 = (const bf16*)(F.ws + WS_YS0); const bf16* Y1 = (const bf16*)(F.ws + WS_YS1); const float* g = a.in[IN_NORM_F_G];
    const int gw = F.bx * NWAVES + F.wave, NGW = F.G * NWAVES, lane = F.lane;
    for (int tok = gw; tok < NTOK; tok += NGW) {
        f32x4* xr = (f32x4*)(a.out + (size_t)tok * D) + lane; const u32x2* y0 = (const u32x2*)(Y0 + (size_t)tok * D) + lane; const u32x2* y1 = (const u32x2*)(Y1 + (size_t)tok * D) + lane;
        f32x4 v[4]; float s = 0.f;
#pragma unroll
        for (int j = 0; j < 4; ++j) { v[j] = xr[64 * j]; const u32x2 p = y0[64 * j], q = y1[64 * j];
            v[j].x += lo16(p.x) + lo16(q.x); v[j].y += hi16(p.x) + hi16(q.x); v[j].z += lo16(p.y) + lo16(q.y); v[j].w += hi16(p.y) + hi16(q.y);
            s += (v[j].x * v[j].x + v[j].y * v[j].y) + (v[j].z * v[j].z + v[j].w * v[j].w); }
        const float rstd = 1.0f / sqrtf(wave_sum(s) * (1.f / D) + EPS);
#pragma unroll
        for (int j = 0; j < 4; ++j) { const f32x4 gg = ((const f32x4*)g + lane)[64 * j]; xr[64 * j] = v[j] * rstd * gg; }
    }
}

constexpr int N_PHASES = 14;
__global__ void __launch_bounds__(NTHREADS, 2) fwd(Args args) {
    extern __shared__ __attribute__((aligned(16))) unsigned char lds[];
    Frame F;
    F.lds = (LAS unsigned char*)lds; F.MISC = (volatile LAS unsigned*)(F.lds + MISC_OFF);
    F.tid = threadIdx.x; F.lane = F.tid & 63; F.wave = __builtin_amdgcn_readfirstlane(F.tid >> 6); F.G = gridDim.x; F.bx = blockIdx.x;
    F.ws = args.ws; F.ctl = (unsigned*)(args.ws + WS_CTL);
    unsigned char* ws = args.ws;
    for (int u = F.tid; u < (LDS_BYTES - RING_BYTES) / 4; u += NTHREADS) ((LAS unsigned*)(F.lds + RING_BYTES))[u] = 0u;
    __syncthreads();
    const int lo = args.ph_lo, hi = args.ph_hi;
    const bool one = (hi - lo) > 1;
    XcdBarrier bar; bar.bar = F.ctl + CW_BAR; bar.x = 0; bar.st = F.MISC + 8;
    if (one) bar = xcd_barrier_post(F.ctl + CW_BAR, F.MISC + 8);
#define IN(k) (lo <= (k) && (k) < hi && phase_begin(F))
#define SEAM(k) do { if (lo <= (k) && (k) + 1 < hi) xcd_barrier(bar); } while (0)

    if (IN(0)) { p0_prologue(F, args); } SEAM(0);
    if (IN(1)) {
        SchedP1 S{ws, F.G, F.bx};
        EpiP1 E{ws};
        pg8::gemm_phase<EpiP1, SchedP1, false>(F.lds, D, D, D, S, E);
        p1_gate_logits(F);
    } SEAM(1);
    if (IN(2)) {
        p2_retention_fast(F, F.bx, (bf16*)(ws + WS_RV));
        { const int w0 = F.bx * NWAVES + F.wave, nw = F.G * NWAVES;
            transpose_kv_tiles(F, (const bf16*)(ws + WS_KV6 + 3 * KV_STRIDE), (bf16*)args.out, w0, nw);
            transpose_kv_tiles(F, (const bf16*)(ws + WS_KV6 + 5 * KV_STRIDE), (bf16*)((unsigned char*)args.out + KV_STRIDE), w0, nw);
            transpose_memv_tiles(F, (bf16*)(ws + WS_MEMVT), w0, nw); }
        __syncthreads();
        { SchedCmp S{ws, 0, F.G, F.bx}; EpiCmp E{(float*)args.out + (size_t)16 * MiB};
            pg8::gemm_phase<EpiCmp, SchedCmp, false>(F.lds, 512, 2048, 4096, S, E); }
    } SEAM(2);
    if (IN(3)) { p2b_compress_out(F, args); } SEAM(3);
    if (IN(4)) { p3_ret_normalize(F); p3_nsa_fast(F, (const bf16*)args.out, (const bf16*)((const unsigned char*)args.out + KV_STRIDE), (bf16*)(ws + WS_NQ)); } SEAM(4);
    if (IN(5)) {
        SchedP4 S{ws, F.G, F.bx};
        EpiP4 E{(float*)(ws + WS_P4SCR) + (size_t)F.bx * (2 * 32 * 512 * 4), (bf16*)(ws + WS_Y)};
        pg8::gemm_phase<EpiP4, SchedP4, false>(F.lds, D, D, D, S, E);
    } SEAM(5);
    if (IN(6)) {
        SchedMN S{ws, WS_Y, W_OUT, F.G, F.bx}; EpiRes<true> E{args.in[IN_X], nullptr, nullptr, (bf16*)(ws + WS_X1B), (float*)(ws + WS_SSQ)};
        pg8::gemm_phase<EpiRes<true>, SchedMN, false>(F.lds, D, D, D, S, E);
    } SEAM(6);
    if (IN(7)) {
        const bool early = ((F.bx >> 3) & 1) == 0;
        if (early) expert_copies(F, args, 0, NEXP / 2);
        SchedMN S{ws, WS_X1B, W_XQ, F.G, F.bx}; EpiQ E{(const float*)(ws + WS_SSQ), (bf16*)(ws + WS_NQ)};
        pg8::gemm_phase<EpiQ, SchedMN, false>(F.lds, D, D, D, S, E);
        if (!early) { __syncthreads(); expert_copies(F, args, 0, NEXP / 2); }
    } SEAM(7);
    if (IN(8)) { p7_xattn_fast(F, (const bf16*)(ws + WS_MEMVT), (bf16*)(ws + WS_NQ)); } SEAM(8);
    if (IN(9)) {
        const bool early = ((F.bx >> 3) & 1) == 0;
        if (early) expert_copies(F, args, NEXP / 2, NEXP);
        SchedMN S{ws, WS_NQ, W_XO, F.G, F.bx}; EpiRes<false> E{nullptr, (const bf16*)(ws + WS_X1B), args.out, (bf16*)(ws + WS_X2B), nullptr};
        pg8::gemm_phase<EpiRes<false>, SchedMN, false>(F.lds, D, D, D, S, E);
        if (!early) { __syncthreads(); expert_copies(F, args, NEXP / 2, NEXP); }
    } SEAM(9);
    if (IN(10)) { p9_route(F, args); } SEAM(10);
    if (IN(11)) {
        moe_tiles(F);
        SchedMoe<0> S{F.MISC, ws, F.G, F.bx}; EpiMoe1 E{(const float*)(ws + WS_ROUTE) + 2 * NTOK, (bf16*)(ws + WS_H1)};
        pg8::gemm_phase<EpiMoe1, SchedMoe<0>, true>(F.lds, D, D, D, S, E);
    } SEAM(11);
    if (IN(12)) {
        moe_tiles(F);
        SchedMoe<1> S{F.MISC, ws, F.G, F.bx}; EpiMoe2 E{(const float*)(ws + WS_ROUTE), (bf16*)(ws + WS_YS0), (bf16*)(ws + WS_YS1)};
        pg8::gemm_phase<EpiMoe2, SchedMoe<1>, false>(F.lds, DEXP, DEXP, DEXP, S, E);
    } SEAM(12);
    if (IN(13)) { p12_final(F, args); }
#undef IN
#undef SEAM
}

extern "C" void kernel_launch(void* const* d_in, const int* in_sizes, int n_in, void* d_out, int out_size, void* d_ws, size_t ws_size, hipStream_t stream) {
    static int grid = 0;
    if (grid == 0) {
        if (n_in != 27 || in_sizes[0] != NTOK * D || out_size != NTOK * D || ws_size < WS_END) {
            fprintf(stderr, "kernel_launch: unexpected shapes: n_in %d in0 %d out %d ws %zu (need %zu)\n", n_in, n_in > 0 ? in_sizes[0] : -1, out_size, ws_size, (size_t)WS_END); grid = -1; return; }
        int dev = 0, cus = 0, per_cu = 0;
        if (hipGetDevice(&dev) != hipSuccess || hipDeviceGetAttribute(&cus, hipDeviceAttributeMultiprocessorCount, dev) != hipSuccess) { grid = -1; return; }
        if (hipFuncSetAttribute((const void*)fwd, hipFuncAttributeMaxDynamicSharedMemorySize, LDS_BYTES) != hipSuccess) { fprintf(stderr, "kernel_launch: hipFuncSetAttribute failed\n"); grid = -1; return; }
        if (hipOccupancyMaxActiveBlocksPerMultiprocessor(&per_cu, (const void*)fwd, NTHREADS, LDS_BYTES) != hipSuccess || per_cu < 1) fprintf(stderr, "kernel_launch: occupancy query reports %d\n", per_cu);
        (void)hipGetLastError();
        grid = cus < 256 ? cus : 256;
    }
    if (grid < 0) return;
    (void)hipMemsetAsync((char*)d_ws + WS_CTL, 0, CTL_ZERO_BYTES, stream);
    Args a{};
    for (int i = 0; i < 27; ++i) a.in[i] = (const float*)d_in[i];
    a.out = (float*)d_out; a.ws = (unsigned char*)d_ws;
#if MK_N_LAUNCHES == 1
    a.ph_lo = 0; a.ph_hi = N_PHASES;
    hipLaunchKernelGGL(fwd, dim3(grid), dim3(NTHREADS), LDS_BYTES, stream, a);
#else
    for (int p = 0; p < N_PHASES; ++p) { a.ph_lo = p; a.ph_hi = p + 1; hipLaunchKernelGGL(fwd, dim3(grid), dim3(NTHREADS), LDS_BYTES, stream, a); }
#endif
}
```

```cpp
#include <hip/hip_runtime.h>
#include <cstdio>
#include <cstdint>

#ifndef MK_N_LAUNCHES
#define MK_N_LAUNCHES 1
#endif

#define LAS __attribute__((address_space(3)))
#define GAS __attribute__((address_space(1)))
#define HD __host__ __device__
#define HDI __host__ __device__ __attribute__((always_inline)) inline
typedef unsigned short bf16;
typedef short bf16x8 __attribute__((ext_vector_type(8)));
typedef float f32x4 __attribute__((ext_vector_type(4)));
typedef float f32x2 __attribute__((ext_vector_type(2)));
typedef float f32x16 __attribute__((ext_vector_type(16)));
typedef unsigned u32x4 __attribute__((ext_vector_type(4)));
typedef unsigned u32x2 __attribute__((ext_vector_type(2)));

constexpr int D = 1024, BATCH = 8, SEQ = 4096, NTOK = BATCH * SEQ, NMEM = 256, NMEMTOK = BATCH * NMEM;
constexpr int DIN = 7704;
constexpr int C_RQ = 0, C_RK = 512, C_RV = 1024, C_RG = 2048, C_NQ = 3072, C_CK = 4096, C_NGL = 5632, C_GA = 5656, C_GB = 6680;
constexpr int NPROJ = 5632;
constexpr int NEXP = 32, DEXP = 512;
constexpr float EPS = 1e-6f;
constexpr int NWAVES = 8, NTHREADS = 512;

constexpr size_t MiB = 1u << 20;
constexpr size_t WS_CTL = 0, CTL_ZERO_BYTES = 1 * MiB;
constexpr size_t WS_ROPE_COS = 1 * MiB, WS_ROPE_SIN = 2 * MiB;
constexpr size_t WS_SMALLW = 3 * MiB;
constexpr size_t WS_MEMVT = 24 * MiB;
constexpr size_t WS_KCMP = 4 * MiB, WS_VCMP = 5 * MiB, WS_VCMPT = 35 * MiB;
constexpr size_t WS_GATES = 10 * MiB;
constexpr size_t WS_SSQ = 13 * MiB;
constexpr size_t WS_ROUTE = 15 * MiB;
constexpr size_t WS_LISTS = 16 * MiB;
constexpr size_t WS_W = 36 * MiB;
constexpr size_t W_IN = WS_W;
constexpr size_t W_GA = W_IN + 11 * MiB, W_GB = W_GA + 2 * MiB;
constexpr size_t W_RO = W_GB + 2 * MiB, W_NO = W_RO + 2 * MiB, W_OUT = W_NO + 2 * MiB, W_XQ = W_OUT + 2 * MiB, W_XO = W_XQ + 2 * MiB;
constexpr size_t W_XKV = W_XO + 2 * MiB;
constexpr size_t W_C1K = W_XKV + 4 * MiB, W_C1V = W_C1K + 2 * MiB;
constexpr size_t WS_MEMN = W_C1V + 2 * MiB;
constexpr size_t WS_MEMKV = WS_MEMN + 4 * MiB;
constexpr size_t WS_H = 84 * MiB;
constexpr size_t WS_NQ = WS_H + 64 * MiB;
constexpr size_t WS_RV = WS_NQ + 64 * MiB;
constexpr size_t WS_RQ = WS_RV + 64 * MiB;
constexpr size_t WS_RK = WS_RQ + 32 * MiB;
constexpr size_t WS_RG = WS_RK + 32 * MiB;
constexpr size_t WS_KV6 = WS_RG + 64 * MiB;
constexpr size_t KV_STRIDE = 16 * MiB;
constexpr size_t WS_END = WS_KV6 + 96 * MiB;
constexpr size_t WS_Y = WS_RQ, WS_P4SCR = WS_RG, WS_W13 = WS_RQ, WS_W2 = WS_RG, WS_H1 = WS_KV6, WS_X1B = WS_H, WS_X2B = WS_RV, WS_YS0 = WS_H, WS_YS1 = WS_NQ;
static_assert(WS_MEMKV + 8 * MiB <= WS_H && WS_VCMPT + 1 * MiB <= WS_W && WS_MEMVT + 4 * MiB <= WS_VCMPT, "ws map");
constexpr int CW_BAR = 4096;
constexpr int CW_ECNT = 16384;
constexpr int LDS_BYTES = 147456, RING_BYTES = 131072, MISC_OFF = RING_BYTES + 320;

HD inline float bf2f(bf16 b) { return __builtin_bit_cast(float, (unsigned)b << 16); }
HD inline unsigned f2bf(float f) { unsigned u = __builtin_bit_cast(unsigned, f); return (u + 0x7fffu + ((u >> 16) & 1u)) >> 16; }
HD inline unsigned pk2(float lo, float hi) { return f2bf(lo) | (f2bf(hi) << 16); }
HD inline float lo16(unsigned w) { return __builtin_bit_cast(float, w << 16); }
HD inline float hi16(unsigned w) { return __builtin_bit_cast(float, w & 0xffff0000u); }
__device__ __forceinline__ unsigned cvt_pk_bf16(float lo, float hi) { unsigned r; asm volatile("v_cvt_pk_bf16_f32 %0, %1, %2" : "=v"(r) : "v"(lo), "v"(hi)); return r; }
#define DPP_F(v, ctrl, rmask) __builtin_bit_cast(float, __builtin_amdgcn_update_dpp(0, __builtin_bit_cast(int, v), ctrl, rmask, 0xf, false))
__device__ __forceinline__ float wave_sum(float v) {
    v += DPP_F(v, 0xB1, 0xf);
    v += DPP_F(v, 0x4E, 0xf);
    v += DPP_F(v, 0x141, 0xf);
    v += DPP_F(v, 0x140, 0xf);
    v += DPP_F(v, 0x142, 0xa);
    v += DPP_F(v, 0x143, 0xc);
    return __builtin_bit_cast(float, __builtin_amdgcn_readlane(__builtin_bit_cast(int, v), 63));
}
__device__ __forceinline__ float wave_max(float v) {
#pragma unroll
    for (int o = 1; o < 64; o <<= 1) v = fmaxf(v, __shfl_xor(v, o));
    return v;
}
__device__ __forceinline__ float sigmoidf_(float x) { return __builtin_amdgcn_rcpf(1.0f + __builtin_amdgcn_exp2f(-1.4426950408889634f * x)); }
#define LAUNDER(p) asm volatile("" : "+v"(p))
#define LDS_WAIT() asm volatile("s_waitcnt lgkmcnt(0)" ::: "memory")
#define VM_WAIT() asm volatile("s_waitcnt vmcnt(0)" ::: "memory")

#define XB_TMO      128
#define XB_XCNT(j)  (256  + 64 * (j))
#define XB_XSUB(j)  (1280 + 64 * (j))
#define XB_XGEN(j)  (2304 + 64 * (j))
#define XB_TOP      3328
#define XB_TOPGEN   3392
#define XCD_BAR_WORDS 3456
#define XB_SPIN_CAP (1u << 24)
__device__ __forceinline__ unsigned xb_ld(unsigned* p)              { return __hip_atomic_load(p, __ATOMIC_RELAXED, __HIP_MEMORY_SCOPE_AGENT); }
__device__ __forceinline__ unsigned xb_add(unsigned* p, unsigned v) { return __hip_atomic_fetch_add(p, v, __ATOMIC_RELAXED, __HIP_MEMORY_SCOPE_AGENT); }
__device__ __forceinline__ unsigned xb_xcc_id() { return (unsigned)__builtin_amdgcn_s_getreg((3 << 11) | 20) & 0xFu; }
#define XB_SPIN(cond, bar) do { unsigned _sp = 0; while (cond) { __builtin_amdgcn_s_sleep(1); \
    if ((++_sp & 255u) == 0u) { if (xb_ld(&(bar)[XB_TMO])) break; if (_sp > XB_SPIN_CAP) { atomicAdd(&(bar)[XB_TMO], 1u); break; } } } } while (0)
struct XcdBarrier { unsigned* bar; unsigned x; volatile LAS unsigned* st; };
__device__ __forceinline__ XcdBarrier xcd_barrier_post(unsigned* bar, volatile LAS unsigned* st) {
    XcdBarrier b; b.bar = bar; b.x = xb_xcc_id(); b.st = st;
    if (threadIdx.x == 0) (void)xb_add(&bar[XB_XCNT(b.x)], 1u);
    return b;
}
__device__ __forceinline__ void xcd_barrier_complete(unsigned* bar, unsigned x, unsigned& nloc, unsigned& nx) {
    const unsigned G = gridDim.x * gridDim.y * gridDim.z;
    unsigned sum, cnt, mine, sp = 0u;
    for (;;) {
        sum = 0u; cnt = 0u; mine = 0u;
#pragma unroll
        for (unsigned j = 0; j < 16; ++j) { const unsigned c = xb_ld(&bar[XB_XCNT(j)]); sum += c; cnt += (c > 0u) ? 1u : 0u; mine = (j == x) ? c : mine; }
        if (sum == G) break;
        __builtin_amdgcn_s_sleep(1);
        if ((++sp & 255u) == 0u) { if (xb_ld(&bar[XB_TMO])) break; if (sp > XB_SPIN_CAP) { atomicAdd(&bar[XB_TMO], 1u); break; } }
    }
    nloc = mine > 0u ? mine : 1u; nx = cnt > 0u ? cnt : 1u;
}
__device__ __forceinline__ void xcd_barrier(const XcdBarrier& b) {
    asm volatile("s_waitcnt vmcnt(0)" ::: "memory");
    __syncthreads();
    if (threadIdx.x == 0) {
        unsigned* bar = b.bar;
        __builtin_amdgcn_s_waitcnt(0);
        unsigned nloc = b.st[0], nx = b.st[1];
        if (nloc == 0u) { xcd_barrier_complete(bar, b.x, nloc, nx); b.st[0] = nloc; b.st[1] = nx; }
        const unsigned old = xb_add(&bar[XB_XSUB(b.x)], 1u);
        const unsigned gen = old / nloc;
        if (old + 1u == (gen + 1u) * nloc) {
            __builtin_amdgcn_fence(__ATOMIC_RELEASE, "agent");
            asm volatile("s_waitcnt vmcnt(0)" ::: "memory");
            const unsigned og = xb_add(&bar[XB_TOP], 1u);
            const unsigned tg = og / nx;
            if (og + 1u == (tg + 1u) * nx) xb_add(&bar[XB_TOPGEN], 1u);
            else XB_SPIN(xb_ld(&bar[XB_TOPGEN]) == tg, bar);
            __builtin_amdgcn_fence(__ATOMIC_ACQUIRE, "agent");
            xb_add(&bar[XB_XGEN(b.x)], 1u);
            asm volatile("s_waitcnt vmcnt(0)" ::: "memory");
        } else {
            XB_SPIN(xb_ld(&bar[XB_XGEN(b.x)]) == gen, bar);
            __builtin_amdgcn_fence(__ATOMIC_ACQUIRE, "agent");
            asm volatile("s_waitcnt vmcnt(0)" ::: "memory");
        }
    }
    __syncthreads();
}

namespace pg8 {
constexpr int BM = 256, BK = 64, HALF = 128, HTB = HALF * BK * 2, NXCD = 8, WGM = 8;
HD __forceinline__ int lds_byte(int r, int c) { const int st = (r >> 4) * 2 + (c >> 5), rr = r & 15, cc = c & 31, ob = rr * 64 + cc * 2; return st * 1024 + (ob ^ (((ob >> 9) & 1) << 5)); }
HD __forceinline__ void stage_rc(int b, int& R, int& C) { const int st = b / 1024, sb = b % 1024, swz = sb ^ (((sb >> 9) & 1) << 5); R = (st >> 1) * 16 + swz / 64; C = (st & 1) * 32 + (swz % 64) / 2; }
HD __forceinline__ int perm32(int rho) { const int n = rho >> 4, i = rho & 15; return 8 * (i >> 2) + 4 * n + (i & 3); }
HD __forceinline__ void tile_map(int L, int nM, int nN, int& pm, int& pn) {
    const int nwg = nM * nN; int wgid = L; { const int q = nwg / NXCD, r = nwg % NXCD, xcd = wgid % NXCD, off = wgid / NXCD; wgid = (xcd < r ? xcd * (q + 1) : r * (q + 1) + (xcd - r) * q) + off; }
    const int nig = WGM * nN, gid = wgid / nig, fm = gid * WGM, gsz = (nM - fm) < WGM ? (nM - fm) : WGM;
    pm = fm + ((wgid % nig) % gsz); pn = (wgid % nig) / gsz;
}
struct GU { const char* A; const char* B; const int* rows; int nvalid; int kind, pm, pn, aux; };
template <class Epi, class Sched, bool GATHER>
__device__ __forceinline__ void gemm_phase(LAS unsigned char* lds, const int K, const int lda, const int ldb, const Sched& S, const Epi& E) {
    int tid_ = threadIdx.x; LAUNDER(tid_);
    const int tid = tid_, wid = __builtin_amdgcn_readfirstlane(tid >> 6), lane = tid & 63, wr = wid >> 2, wc = wid & 3, fr = lane & 15, fq = lane >> 4;
    const int nt = K / BK;
    unsigned voffB[2];
#pragma unroll
    for (int i = 0; i < 2; ++i) { int R, C; stage_rc(tid * 16 + i * 8192, R, C); const int Rb = Epi::PERM ? ((R & ~31) + perm32(R & 31)) : R; voffB[i] = (unsigned)(Rb * ldb + C) * 2u; }
    const size_t kstep = (size_t)(BK * 2);
    const size_t hstepB = (size_t)HALF * ldb * 2;
    const unsigned ldsw = (unsigned)wid * 1024u;
    const int aoff = lds_byte(wr * 64 + fr, fq * 8), boff = lds_byte(wc * 32 + fr, fq * 8);
#define PG8_SA(b, h) (((b) * 2 + (h)) * HTB)
#define PG8_SB(b, h) ((4 + (b) * 2 + (h)) * HTB)
#define PG8_STAGE2(bufoff, gbase, v0, v1) do { \
        __builtin_amdgcn_global_load_lds((const unsigned*)((const char*)(gbase) + (v0)), (LAS unsigned*)(lds + (bufoff) + ldsw), 16, 0, 0); \
        __builtin_amdgcn_global_load_lds((const unsigned*)((const char*)(gbase) + (v1)), (LAS unsigned*)(lds + (bufoff) + ldsw + 8192), 16, 0, 0); } while (0)
#define PG8_STAGEB(bufoff, gbase) PG8_STAGE2(bufoff, gbase, voffB[0], voffB[1])
#define PG8_LDA(dst, b, h) do { _Pragma("unroll") for (int m = 0; m < 4; ++m) _Pragma("unroll") for (int k = 0; k < 2; ++k) dst[m][k] = *(const LAS bf16x8*)(lds + PG8_SA(b, h) + aoff + m * 2048 + k * 1024); } while (0)
#define PG8_LDB(dst, b, h) do { _Pragma("unroll") for (int n = 0; n < 2; ++n) _Pragma("unroll") for (int k = 0; k < 2; ++k) dst[n][k] = *(const LAS bf16x8*)(lds + PG8_SB(b, h) + boff + n * 2048 + k * 1024); } while (0)
#define PG8_MMA(ai, bj, At, Bt) do { __builtin_amdgcn_s_setprio(1); _Pragma("unroll") for (int m = 0; m < 4; ++m) _Pragma("unroll") for (int n = 0; n < 2; ++n) _Pragma("unroll") for (int k = 0; k < 2; ++k) \
        acc[ai][bj][m][n] = __builtin_amdgcn_mfma_f32_16x16x32_bf16(Bt[n][k], At[m][k], acc[ai][bj][m][n], 0, 0, 0); __builtin_amdgcn_s_setprio(0); } while (0)
#define PG8_WAIT_V(n) asm volatile("s_waitcnt vmcnt(" #n ")" ::: "memory")
#define PG8_WAIT_L(n) asm volatile("s_waitcnt lgkmcnt(" #n ")" ::: "memory")
#define PG8_BAR __builtin_amdgcn_s_barrier()
#define PG8_SCHED __builtin_amdgcn_sched_barrier(0)
#define PG8_VOFFA(u, vo) do { _Pragma("unroll") for (int h = 0; h < 2; ++h) _Pragma("unroll") for (int i = 0; i < 2; ++i) { int R_, C_; stage_rc(tid * 16 + i * 8192, R_, C_); const int R = R_ + HALF * h; \
        int ridx = R; if (GATHER) { ridx = (R < (u).nvalid) ? ((u).rows[R] >> 1) : 0; } vo[h][i] = (unsigned)(ridx * lda + C_) * 2u; } if (GATHER) asm volatile("" :: "v"(vo[0][0]), "v"(vo[0][1]), "v"(vo[1][0]), "v"(vo[1][1])); } while (0)
    GU cur, nxt; int ui = 0;
    if (!S.next(0, cur)) return;
    f32x4 acc[2][2][4][2];
#pragma unroll
    for (int a = 0; a < 2; ++a)
#pragma unroll
        for (int b = 0; b < 2; ++b)
#pragma unroll
            for (int m = 0; m < 4; ++m)
#pragma unroll
                for (int n = 0; n < 2; ++n) acc[a][b][m][n] = (f32x4){0.f, 0.f, 0.f, 0.f};
    bf16x8 At[4][2], B0[2][2], B1[2][2];
    unsigned cv[2][2], nv[2][2];
    PG8_VOFFA(cur, cv);
    const char* cA = cur.A; const char* cB = cur.B;
    PG8_STAGEB(PG8_SB(0, 0), cB); PG8_STAGEB(PG8_SB(0, 1), cB + hstepB); PG8_STAGE2(PG8_SA(0, 0), cA, cv[0][0], cv[0][1]); PG8_STAGE2(PG8_SA(0, 1), cA, cv[1][0], cv[1][1]);
    if (wr == 1) PG8_BAR;
    PG8_WAIT_V(2); PG8_BAR;
    PG8_STAGEB(PG8_SB(1, 0), cB + kstep); PG8_STAGE2(PG8_SA(1, 0), cA + kstep, cv[0][0], cv[0][1]); PG8_STAGEB(PG8_SB(1, 1), cB + hstepB + kstep);
    PG8_WAIT_V(6); PG8_BAR;
    for (;;) {
        const bool has_next = S.next(ui + 1, nxt);
        const char* nA = has_next ? nxt.A : cA; const char* nB = has_next ? nxt.B : cB;
        if (has_next) { PG8_VOFFA(nxt, nv); } else {
#pragma unroll
            for (int h = 0; h < 2; ++h)
#pragma unroll
                for (int i = 0; i < 2; ++i) nv[h][i] = cv[h][i]; }
        for (int t = 0; t < nt; t += 2) {
            const bool last = (t == nt - 2);
            const char* a1 = cA + (size_t)(t + 1) * kstep;
            const char* a2 = last ? nA : cA + (size_t)(t + 2) * kstep; const char* b2 = last ? nB : cB + (size_t)(t + 2) * kstep;
            const char* a3 = a2 + kstep; const char* b3 = b2 + kstep;
            const unsigned w00 = last ? nv[0][0] : cv[0][0], w01 = last ? nv[0][1] : cv[0][1], w10 = last ? nv[1][0] : cv[1][0], w11 = last ? nv[1][1] : cv[1][1];
            PG8_LDB(B0, 0, 0); PG8_LDB(B1, 0, 1); PG8_SCHED; PG8_LDA(At, 0, 0); PG8_STAGE2(PG8_SA(1, 1), a1, cv[1][0], cv[1][1]);
            PG8_WAIT_V(8); PG8_WAIT_L(0); PG8_BAR; PG8_MMA(0, 0, At, B0); PG8_MMA(0, 1, At, B1); PG8_BAR; PG8_SCHED;
            PG8_LDA(At, 0, 1); PG8_STAGEB(PG8_SB(0, 0), b2); PG8_STAGEB(PG8_SB(0, 1), b2 + hstepB); PG8_STAGE2(PG8_SA(0, 0), a2, w00, w01);
            PG8_WAIT_V(8); PG8_WAIT_L(0); PG8_BAR; PG8_MMA(1, 0, At, B0); PG8_MMA(1, 1, At, B1); PG8_BAR; PG8_SCHED;
            PG8_LDB(B0, 1, 0); PG8_LDB(B1, 1, 1); PG8_SCHED; PG8_LDA(At, 1, 0); PG8_STAGE2(PG8_SA(0, 1), a2, w10, w11);
            PG8_WAIT_V(8); PG8_WAIT_L(0); PG8_BAR; PG8_MMA(0, 0, At, B0); PG8_MMA(0, 1, At, B1); PG8_BAR; PG8_SCHED;
            PG8_LDA(At, 1, 1); PG8_STAGEB(PG8_SB(1, 0), b3); PG8_STAGEB(PG8_SB(1, 1), b3 + hstepB); PG8_STAGE2(PG8_SA(1, 0), a3, w00, w01);
            PG8_WAIT_V(8); PG8_WAIT_L(0); PG8_BAR; PG8_MMA(1, 0, At, B0); PG8_MMA(1, 1, At, B1); PG8_BAR; PG8_SCHED;
        }
        if (wr == 0) PG8_BAR;
        E(acc, cur, wr, wc, fr, fq);
        if (!has_next) break;
#pragma unroll
        for (int a = 0; a < 2; ++a)
#pragma unroll
            for (int b = 0; b < 2; ++b)
#pragma unroll
                for (int m = 0; m < 4; ++m)
#pragma unroll
                    for (int n = 0; n < 2; ++n) acc[a][b][m][n] = (f32x4){0.f, 0.f, 0.f, 0.f};
        cur = nxt; cA = nA; cB = nB; ++ui;
#pragma unroll
        for (int h = 0; h < 2; ++h)
#pragma unroll
            for (int i = 0; i < 2; ++i) cv[h][i] = nv[h][i];
        if (wr == 1) PG8_BAR;
    }
    PG8_WAIT_V(0);
    PG8_BAR;
#undef PG8_SA
#undef PG8_SB
#undef PG8_STAGE2
#undef PG8_STAGEB
#undef PG8_LDA
#undef PG8_LDB
#undef PG8_MMA
#undef PG8_WAIT_V
#undef PG8_WAIT_L
#undef PG8_BAR
#undef PG8_SCHED
#undef PG8_VOFFA
}
}
using pg8::GU;

struct Args {
    const float* in[27]; float* out; unsigned char* ws; int ph_lo, ph_hi; int pad0, pad1;
};
enum { IN_X = 0, IN_MEM, IN_NORM_MIX_G, IN_W_IN, IN_W_RET_O, IN_W_NSA_O, IN_W_OUT, IN_CMP_PE_K, IN_CMP_W1_K, IN_CMP_W2_K, IN_CMP_PE_V, IN_CMP_W1_V, IN_CMP_W2_V,
       IN_NORM_X_G, IN_NORM_MEM_G, IN_W_XQ, IN_W_XKV, IN_W_XO, IN_NORM_FFN_G, IN_W_GRP, IN_B_GRP, IN_W_RT, IN_B_RT, IN_W_E1, IN_W_E3, IN_W_E2, IN_NORM_F_G };
struct Frame {
    LAS unsigned char* lds; volatile LAS unsigned* MISC; unsigned* ctl; unsigned char* ws;
    int tid, lane, wave, G, bx;
};

__device__ __forceinline__ bool phase_begin(Frame& F) { int t = threadIdx.x; LAUNDER(t); F.tid = t; F.lane = t & 63; return true; }
__device__ __forceinline__ void transpose_item(const float* W, int ldw, int c0, int k0, bf16* WT, int ldt, int mode, int row_off, int cbase, const float* kscale, float scale, LAS float* scr, int lane) {
    float vv[32];
#pragma unroll
    for (int i = 0; i < 32; ++i) { const int kk = 2 * i + (lane >> 5); vv[i] = W[(size_t)(k0 + kk) * ldw + c0 + (lane & 31)]; }
    if (kscale) {
#pragma unroll
        for (int i = 0; i < 32; ++i) { const int kk = 2 * i + (lane >> 5); vv[i] *= kscale[k0 + kk]; } }
#pragma unroll
    for (int i = 0; i < 32; ++i) { const int kk = 2 * i + (lane >> 5); scr[kk * 33 + (lane & 31)] = vv[i] * scale; }
    LDS_WAIT(); asm volatile("" ::: "memory");
    const int c = lane & 7;
#pragma unroll
    for (int j = 0; j < 4; ++j) { const int n = (lane >> 3) + 8 * j; const LAS float* s = scr + (8 * c) * 33 + n;
        u32x4 o; o.x = pk2(s[0 * 33], s[1 * 33]); o.y = pk2(s[2 * 33], s[3 * 33]); o.z = pk2(s[4 * 33], s[5 * 33]); o.w = pk2(s[6 * 33], s[7 * 33]);
        const int jc = c0 - cbase + n; const int drow = mode == 0 ? row_off + jc : (8 * (jc >> 2) + 4 * row_off + (jc & 3));
        *(u32x4*)(WT + (size_t)drow * ldt + k0 + 8 * c) = o; }
    LDS_WAIT(); asm volatile("" ::: "memory");
}
__device__ __forceinline__ void transpose_matrix(Frame& F, int& item_base, const float* W, int ldw, int K, int cbase, int ncols, bf16* WT, int ldt, int mode, int row_off, const float* kscale, float scale) {
    LAS float* scr = (LAS float*)(F.lds + F.wave * 16384);
    const int gw = F.bx * NWAVES + F.wave, NGW = F.G * NWAVES;
    const int nb = ncols / 32, nitems = (K / 64) * nb;
    int it = (gw - item_base % NGW + NGW) % NGW;
    for (; it < nitems; it += NGW) transpose_item(W, ldw, cbase + 32 * (it % nb), 64 * (it / nb), WT, ldt, mode, row_off, cbase, kscale, scale, scr, F.lane);
    item_base += nitems;
}
__device__ __forceinline__ void rms_row_to_bf16(int lane, const float* xrow, const float* g, bf16* orow) {
    const f32x4* xr = (const f32x4*)xrow + lane; const f32x4* gr = (const f32x4*)g + lane;
    f32x4 v[4]; float s = 0.f;
#pragma unroll
    for (int j = 0; j < 4; ++j) { v[j] = xr[64 * j]; s += (v[j].x * v[j].x + v[j].y * v[j].y) + (v[j].z * v[j].z + v[j].w * v[j].w); }
    const float rstd = 1.0f / sqrtf(wave_sum(s) * (1.f / D) + EPS);
    unsigned long long* o8 = (unsigned long long*)orow + lane;
#pragma unroll
    for (int j = 0; j < 4; ++j) { const f32x4 gg = gr[64 * j];
        o8[64 * j] = (unsigned long long)pk2(v[j].x * rstd * gg.x, v[j].y * rstd * gg.y) | ((unsigned long long)pk2(v[j].z * rstd * gg.z, v[j].w * rstd * gg.w) << 32); }
}

__device__ __forceinline__ void p0_prologue(Frame& F, const Args& a) {
    unsigned char* ws = F.ws;
    const float* w_in = a.in[IN_W_IN];
    int ib = 0;
    transpose_matrix(F, ib, w_in, DIN, D, 0, 512, (bf16*)(ws + W_IN), D, 0, 0, nullptr, 1.0f);
    transpose_matrix(F, ib, w_in, DIN, D, 512, 512, (bf16*)(ws + W_IN), D, 0, 512, nullptr, 0.08838834764831845f);
    transpose_matrix(F, ib, w_in, DIN, D, 1024, NPROJ - 1024, (bf16*)(ws + W_IN), D, 0, 1024, nullptr, 1.0f);
    transpose_matrix(F, ib, w_in, DIN, D, C_GA, 1024, (bf16*)(ws + W_GA), D, 0, 0, nullptr, 1.0f);
    transpose_matrix(F, ib, w_in, DIN, D, C_GB, 1024, (bf16*)(ws + W_GB), D, 0, 0, nullptr, 1.0f);
    transpose_matrix(F, ib, a.in[IN_W_RET_O], D, D, 0, D, (bf16*)(ws + W_RO), D, 0, 0, nullptr, 1.0f);
    transpose_matrix(F, ib, a.in[IN_W_NSA_O], D, D, 0, D, (bf16*)(ws + W_NO), D, 0, 0, nullptr, 1.0f);
    transpose_matrix(F, ib, a.in[IN_W_OUT], D, D, 0, D, (bf16*)(ws + W_OUT), D, 0, 0, nullptr, 1.0f);
    transpose_matrix(F, ib, a.in[IN_W_XQ], D, D, 0, D, (bf16*)(ws + W_XQ), D, 0, 0, a.in[IN_NORM_X_G], 1.0f);
    transpose_matrix(F, ib, a.in[IN_W_XO], D, D, 0, D, (bf16*)(ws + W_XO), D, 0, 0, nullptr, 1.0f);
    transpose_matrix(F, ib, a.in[IN_W_XKV], 2 * D, D, 0, 2 * D, (bf16*)(ws + W_XKV), D, 0, 0, nullptr, 1.0f);
    transpose_matrix(F, ib, a.in[IN_CMP_W1_K], 128, 4096, 0, 128, (bf16*)(ws + W_C1K), 4096, 0, 0, nullptr, 1.0f);
    transpose_matrix(F, ib, a.in[IN_CMP_W1_V], 128, 4096, 0, 128, (bf16*)(ws + W_C1V), 4096, 0, 0, nullptr, 1.0f);
    const int gt = F.bx * NTHREADS + F.tid, NGT = F.G * NTHREADS;
    for (int i = gt; i < 2 * 128 * 4096 / 8; i += NGT) { const int m = i / (128 * 4096 / 8), r = i % (128 * 4096 / 8);
        *(u32x4*)(ws + (m ? W_C1V : W_C1K) + (size_t)128 * 4096 * 2 + (size_t)r * 16) = (u32x4){0u, 0u, 0u, 0u}; }
    bf16* wngl = (bf16*)(ws + WS_SMALLW);
    for (int i = gt; i < 32 * 1024; i += NGT) { const int r = i >> 10, k = i & 1023; wngl[i] = r < 24 ? (bf16)f2bf(w_in[(size_t)k * DIN + C_NGL + r]) : (bf16)0; }
    bf16* w2k = (bf16*)(ws + WS_SMALLW + 65536); bf16* w2v = w2k + 128 * 128;
    for (int i = gt; i < 2 * 128 * 128; i += NGT) { const int m = i >> 14, r = i & 16383, f = r >> 7, e = r & 127; const float* src = a.in[m ? IN_CMP_W2_V : IN_CMP_W2_K];
        (m ? w2v : w2k)[f * 128 + e] = (bf16)f2bf(src[e * 128 + f]); }
    float* cbias = (float*)(ws + WS_SMALLW + 65536 + 2 * 128 * 128 * 2);
    const int gw = F.bx * NWAVES + F.wave, NGW = F.G * NWAVES;
    for (int o = gw; o < 256; o += NGW) { const int m = o >> 7, e = o & 127; const float* pe = a.in[m ? IN_CMP_PE_V : IN_CMP_PE_K]; const float* w1 = a.in[m ? IN_CMP_W1_V : IN_CMP_W1_K];
        float s = 0.f; for (int k = F.lane; k < 4096; k += 64) s += pe[k] * w1[(size_t)k * 128 + e];
        s = wave_sum(s); if (F.lane == 0) cbias[o] = s; }
    float* cosT = (float*)(ws + WS_ROPE_COS); float* sinT = (float*)(ws + WS_ROPE_SIN);
    for (int i = gt; i < SEQ * 64; i += NGT) { const int pos = i >> 6, j = i & 63; const float inv = powf(10000.0f, -(float)(2 * j) / 128.0f); const float ang = (float)pos * inv;
        cosT[i] = cosf(ang); sinT[i] = sinf(ang); }
    { f32x4 nx[4]; const float* X = a.in[IN_X]; const f32x4* gr = (const f32x4*)a.in[IN_NORM_MIX_G] + F.lane;
      if (gw < NTOK) {
#pragma unroll
          for (int j = 0; j < 4; ++j) nx[j] = ((const f32x4*)(X + (size_t)gw * D) + F.lane)[64 * j]; }
      for (int m = gw; m < NTOK; m += NGW) { f32x4 v[4]; float sq = 0.f;
#pragma unroll
          for (int j = 0; j < 4; ++j) { v[j] = nx[j]; sq += (v[j].x * v[j].x + v[j].y * v[j].y) + (v[j].z * v[j].z + v[j].w * v[j].w); }
          if (m + NGW < NTOK) {
#pragma unroll
              for (int j = 0; j < 4; ++j) nx[j] = ((const f32x4*)(X + (size_t)(m + NGW) * D) + F.lane)[64 * j]; }
          const float rstd = 1.0f / sqrtf(wave_sum(sq) * (1.f / D) + EPS); unsigned long long* o8 = (unsigned long long*)((bf16*)(ws + WS_H) + (size_t)m * D) + F.lane;
#pragma unroll
          for (int j = 0; j < 4; ++j) { const f32x4 gg = gr[64 * j]; o8[64 * j] = (unsigned long long)pk2(v[j].x * rstd * gg.x, v[j].y * rstd * gg.y) | ((unsigned long long)pk2(v[j].z * rstd * gg.z, v[j].w * rstd * gg.w) << 32); } } }
    for (int m = gw; m < NMEMTOK; m += NGW) rms_row_to_bf16(F.lane, a.in[IN_MEM] + (size_t)m * D, a.in[IN_NORM_MEM_G], (bf16*)(ws + WS_MEMN) + (size_t)m * D);
}

struct SchedP1 {
    unsigned char* ws; int G, c;
    __device__ __forceinline__ bool next(int i, GU& u) const {
        constexpr int NP = 128 * 22; const int L = i * G + c;
        u.rows = nullptr; u.nvalid = 0; u.aux = 0;
        if (L < NP) { int pm, pn; pg8::tile_map(L, 128, 22, pm, pn); u.A = (const char*)ws + WS_H + (size_t)pm * 256 * D * 2; u.B = (const char*)ws + W_IN + (size_t)pn * 256 * D * 2; u.pm = pm; u.pn = pn;
            u.kind = pn < 2 ? 0 : pn < 4 ? 1 : pn < 8 ? 2 : pn < 12 ? 3 : pn < 16 ? 4 : 5; return true; }
        const int L2 = L - NP; if (L2 >= 64) return false;
        const int pm = L2 & 7, pn = L2 >> 3; u.A = (const char*)ws + WS_MEMN + (size_t)pm * 256 * D * 2; u.B = (const char*)ws + W_XKV + (size_t)pn * 256 * D * 2; u.pm = pm; u.pn = pn; u.kind = 6; return true;
    }
};
struct EpiP1 {
    static constexpr bool PERM = true;
    unsigned char* ws;
    __device__ __forceinline__ void operator()(const f32x4 (&acc)[2][2][4][2], const GU& u, int wr, int wc, int fr, int fq) const {
        const int kind = u.kind;
        const float* cosT = (const float*)(ws + WS_ROPE_COS); const float* sinT = (const float*)(ws + WS_ROPE_SIN);
#pragma unroll
        for (int ai = 0; ai < 2; ++ai)
#pragma unroll
            for (int m = 0; m < 4; ++m) {
                const int r = 128 * ai + 64 * wr + 16 * m + fr; const int tok = u.pm * 256 + r;
#pragma unroll
                for (int bj = 0; bj < 2; ++bj) {
                    f32x4 v0 = acc[ai][bj][m][0], v1 = acc[ai][bj][m][1];
                    const int ct = 128 * bj + 32 * wc + 8 * fq;
                    bf16* dst;
                    if (kind <= 1) {
                        const int s = tok & (SEQ - 1), i0 = ((ct & 127) >> 1);
                        const f32x4 cs = *(const f32x4*)(cosT + s * 64 + i0), sn = *(const f32x4*)(sinT + s * 64 + i0);
                        const f32x4 a0 = v0, a1 = v1;
                        v0[0] = a0[0] * cs[0] - a0[1] * sn[0]; v0[1] = a0[0] * sn[0] + a0[1] * cs[0];
                        v0[2] = a0[2] * cs[1] - a0[3] * sn[1]; v0[3] = a0[2] * sn[1] + a0[3] * cs[1];
                        v1[0] = a1[0] * cs[2] - a1[1] * sn[2]; v1[1] = a1[0] * sn[2] + a1[1] * cs[2];
                        v1[2] = a1[2] * cs[3] - a1[3] * sn[3]; v1[3] = a1[2] * sn[3] + a1[3] * cs[3];
                        dst = (bf16*)(ws + (kind == 0 ? WS_RQ : WS_RK)) + (size_t)tok * 512 + (u.pn & 1) * 256 + ct;
                    } else if (kind == 2) { dst = (bf16*)(ws + WS_RV) + (size_t)tok * 1024 + (u.pn - 4) * 256 + ct;
                    } else if (kind == 3) {
#pragma unroll
                        for (int j = 0; j < 4; ++j) { v0[j] = v0[j] * sigmoidf_(v0[j]); v1[j] = v1[j] * sigmoidf_(v1[j]); }
                        dst = (bf16*)(ws + WS_RG) + (size_t)tok * 1024 + (u.pn - 8) * 256 + ct;
                    } else if (kind == 4) { dst = (bf16*)(ws + WS_NQ) + (size_t)tok * 1024 + (u.pn - 12) * 256 + ct;
                    } else if (kind == 5) {
                        const int b = tok >> 12, s = tok & (SEQ - 1);
                        unsigned char* kvb = ws + WS_KV6 + (size_t)(u.pn - 16) * KV_STRIDE;
                        dst = (bf16*)kvb + ((size_t)(b * 2 + bj) * SEQ + s) * 128 + (ct & 127);
                    } else { dst = (bf16*)(ws + WS_MEMKV) + (size_t)tok * 2048 + u.pn * 256 + ct; }
                    u32x4 w; w.x = cvt_pk_bf16(v0[0], v0[1]); w.y = cvt_pk_bf16(v0[2], v0[3]); w.z = cvt_pk_bf16(v1[0], v1[1]); w.w = cvt_pk_bf16(v1[2], v1[3]);
                    *(u32x4*)dst = w;
                }
            }
    }
};
__device__ __forceinline__ void p1_gate_logits(Frame& F) {
    const bf16* H = (const bf16*)(F.ws + WS_H); const bf16* W = (const bf16*)(F.ws + WS_SMALLW); float* gates = (float*)(F.ws + WS_GATES);
    const int gw = F.bx * NWAVES + F.wave, NGW = F.G * NWAVES; const int r = F.lane & 31, hh = F.lane >> 5;
    for (int rb = gw; rb < NTOK / 32; rb += NGW) {
        f32x16 acc; for (int j = 0; j < 16; ++j) acc[j] = 0.f;
        const bf16* ap = H + (size_t)(rb * 32 + r) * D + 8 * hh; const bf16* bp = W + (size_t)r * D + 8 * hh;
        for (int s8 = 0; s8 < 8; ++s8) { bf16x8 av[8], bv[8];
#pragma unroll
            for (int q = 0; q < 8; ++q) { av[q] = *(const bf16x8*)(ap + 16 * (8 * s8 + q)); bv[q] = *(const bf16x8*)(bp + 16 * (8 * s8 + q)); }
#pragma unroll
            for (int q = 0; q < 8; ++q) acc = __builtin_amdgcn_mfma_f32_32x32x16_bf16(av[q], bv[q], acc, 0, 0, 0); }
        if (r < 24) {
#pragma unroll
            for (int reg = 0; reg < 16; ++reg) { const int row = (reg & 3) + 8 * (reg >> 2) + 4 * hh; gates[(size_t)(rb * 32 + row) * 24 + r] = sigmoidf_(acc[reg]); }
        }
    }
}

namespace retf {
constexpr int ROWB = 272;
constexpr int OFF_K = 0, OFF_V = 128 * 256, OFF_ZV = OFF_V + 128 * 64, OFF_ST = OFF_ZV + 128 * 64, OFF_PART = OFF_ST + 32 * ROWB;
static_assert(OFF_PART + 4 * 4096 <= RING_BYTES, "retention LDS map");
typedef short s16x4 __attribute__((ext_vector_type(4)));
__device__ __forceinline__ u32x2 lds_tr(const LAS unsigned char* p) { return __builtin_bit_cast(u32x2, __builtin_amdgcn_ds_read_tr16_b64_v4i16((LAS s16x4*)p)); }
}
__device__ __forceinline__ void p2_retention_fast(Frame& F, int unit, bf16* outbase) {
    using namespace retf;
    const int bh = unit >> 3, sl = unit & 7, b = bh >> 2, h = bh & 3;
    const bf16* rq = (const bf16*)(F.ws + WS_RQ); const bf16* rk = (const bf16*)(F.ws + WS_RK); const bf16* rv = (const bf16*)(F.ws + WS_RV);
    const int tid = F.tid, lane = F.lane, wave = F.wave, r = lane & 31, hi = lane >> 5; LAS unsigned char* lds = F.lds;
    const float lg = log2f(1.0f - exp2f(-5.0f - (float)h));
    const int nt = wave & 3, mh = wave >> 2;
    for (int i = tid; i < 32 * ROWB / 4; i += NTHREADS) ((LAS unsigned*)(lds + OFF_ST))[i] = 0u;
    f32x16 ST;
#pragma unroll
    for (int j = 0; j < 16; ++j) ST[j] = 0.f;
    const float gC = exp2f(128.0f * lg);
    const float zeta = exp2f((float)(127 - (tid >> 2)) * lg);
    const int blk = (lane >> 4) & 1, q4 = (lane & 15) >> 2, p4 = lane & 3;
    const int vtr = (4 * hi + q4) * 64 + 32 * blk + 8 * p4;
    const int ztr = (8 * hi + q4) * 64 + 32 * blk + 8 * p4;
    int ktr[2];
#pragma unroll
    for (int t = 0; t < 2; ++t) ktr[t] = 256 * (8 * hi + 4 * t + q4) + 16 * ((4 * nt + 2 * blk + (p4 >> 1)) ^ ((q4 << 2) | ((2 * hi + t) & 3))) + 8 * (p4 & 1);
    const int krow = 256 * r + 16 * (hi ^ (((r & 3) << 2) | ((r >> 2) & 3)));
    u32x4 kreg[4], vreg; bf16x8 qn[8];
    {   const int tok0 = b * SEQ;
#pragma unroll
        for (int i = 0; i < 4; ++i) { const int p = tid + 512 * i, m = p >> 4, cc = p & 15; kreg[i] = *(const u32x4*)(rk + (size_t)(tok0 + m) * 512 + h * 128 + cc * 8); }
        { const int m = tid >> 2, cc = tid & 3; vreg = *(const u32x4*)(rv + (size_t)(tok0 + m) * 1024 + h * 256 + sl * 32 + cc * 8); }
        const bf16* qrow = rq + (size_t)(tok0 + 32 * nt + r) * 512 + h * 128;
#pragma unroll
        for (int s_ = 0; s_ < 8; ++s_) qn[s_] = *(const bf16x8*)(qrow + 16 * s_ + 8 * hi); }
    for (int c = 0; c < SEQ / 128; ++c) {
        const int tok0 = b * SEQ + c * 128;
        __syncthreads();
#pragma unroll
        for (int i = 0; i < 4; ++i) { const int p = tid + 512 * i, m = p >> 4, cc = p & 15;
            *(LAS u32x4*)(lds + OFF_K + 256 * m + 16 * (cc ^ (((m & 3) << 2) | ((m >> 2) & 3)))) = kreg[i]; }
        { const u32x4 v = vreg; u32x4 zv;
            zv.x = cvt_pk_bf16(lo16(v.x) * zeta, hi16(v.x) * zeta); zv.y = cvt_pk_bf16(lo16(v.y) * zeta, hi16(v.y) * zeta); zv.z = cvt_pk_bf16(lo16(v.z) * zeta, hi16(v.z) * zeta); zv.w = cvt_pk_bf16(lo16(v.w) * zeta, hi16(v.w) * zeta);
            *(LAS u32x4*)(lds + OFF_V + tid * 16) = v; *(LAS u32x4*)(lds + OFF_ZV + tid * 16) = zv; }
        bf16x8 qf[8];
#pragma unroll
        for (int s_ = 0; s_ < 8; ++s_) qf[s_] = qn[s_];
        __syncthreads();
        if (c + 1 < SEQ / 128) { const int tok1 = tok0 + 128;
#pragma unroll
            for (int i = 0; i < 4; ++i) { const int p = tid + 512 * i, m = p >> 4, cc = p & 15; kreg[i] = *(const u32x4*)(rk + (size_t)(tok1 + m) * 512 + h * 128 + cc * 8); }
            { const int m = tid >> 2, cc = tid & 3; vreg = *(const u32x4*)(rv + (size_t)(tok1 + m) * 1024 + h * 256 + sl * 32 + cc * 8); }
            const bf16* qrow = rq + (size_t)(tok1 + 32 * nt + r) * 512 + h * 128;
#pragma unroll
            for (int s_ = 0; s_ < 8; ++s_) qn[s_] = *(const bf16x8*)(qrow + 16 * s_ + 8 * hi); }
        f32x16 CR;
#pragma unroll
        for (int j = 0; j < 16; ++j) CR[j] = 0.f;
        if (mh == 0) {
#pragma unroll
            for (int s_ = 0; s_ < 8; ++s_) { const bf16x8 a = *(const LAS bf16x8*)(lds + OFF_ST + r * ROWB + (16 * s_ + 8 * hi) * 2); CR = __builtin_amdgcn_mfma_f32_32x32x16_bf16(a, qf[s_], CR, 0, 0, 0); }
        }
        f32x16 IN_;
#pragma unroll
        for (int j = 0; j < 16; ++j) IN_[j] = 0.f;
#pragma unroll
        for (int mi = 0; mi < 2; ++mi) { const int mt = 2 * mh + mi;
            if (mt <= nt) {
                f32x16 A;
#pragma unroll
                for (int j = 0; j < 16; ++j) A[j] = 0.f;
#pragma unroll
                for (int s_ = 0; s_ < 8; ++s_) { const bf16x8 a = *(const LAS bf16x8*)(lds + OFF_K + 8192 * mt + (krow ^ (32 * s_))); A = __builtin_amdgcn_mfma_f32_32x32x16_bf16(a, qf[s_], A, 0, 0, 0); }
#pragma unroll
                for (int j = 0; j < 16; ++j) { const int dd = (32 * nt + r) - (32 * mt + (j & 3) + 8 * (j >> 2) + 4 * hi); A[j] = dd >= 0 ? A[j] * __builtin_amdgcn_exp2f((float)dd * lg) : 0.f; }
#pragma unroll
                for (int s2 = 0; s2 < 2; ++s2) { u32x4 w; w.x = cvt_pk_bf16(A[8 * s2 + 0], A[8 * s2 + 1]); w.y = cvt_pk_bf16(A[8 * s2 + 2], A[8 * s2 + 3]); w.z = cvt_pk_bf16(A[8 * s2 + 4], A[8 * s2 + 5]); w.w = cvt_pk_bf16(A[8 * s2 + 6], A[8 * s2 + 7]);
                    const LAS unsigned char* vp = lds + OFF_V + vtr + (32 * mt + 16 * s2) * 64; const u32x2 lo = lds_tr(vp), hi2 = lds_tr(vp + 8 * 64);
                    IN_ = __builtin_amdgcn_mfma_f32_32x32x16_bf16(__builtin_bit_cast(bf16x8, (u32x4){lo.x, lo.y, hi2.x, hi2.y}), __builtin_bit_cast(bf16x8, w), IN_, 0, 0, 0); }
            } }
        if (mh == 1) {
#pragma unroll
            for (int j = 0; j < 16; ++j) ((LAS float*)(lds + OFF_PART))[(nt * 16 + j) * 64 + lane] = IN_[j];
        }
        __syncthreads();
        if (mh == 0) {
            const float xi = __builtin_amdgcn_exp2f((float)(32 * nt + r + 1) * lg);
            bf16* orow = outbase + (size_t)(tok0 + 32 * nt + r) * 1024 + h * 256 + sl * 32;
#pragma unroll
            for (int q4_ = 0; q4_ < 4; ++q4_) { float o_[4];
#pragma unroll
                for (int e = 0; e < 4; ++e) { const int j = 4 * q4_ + e; o_[e] = IN_[j] + ((const LAS float*)(lds + OFF_PART))[(nt * 16 + j) * 64 + lane] + xi * CR[j]; }
                *(u32x2*)(orow + 8 * q4_ + 4 * hi) = (u32x2){cvt_pk_bf16(o_[0], o_[1]), cvt_pk_bf16(o_[2], o_[3])}; }
        } else {
#pragma unroll
            for (int j = 0; j < 16; ++j) ST[j] *= gC;
#pragma unroll
            for (int s_ = 0; s_ < 8; ++s_) {
                const LAS unsigned char* zp = lds + OFF_ZV + ztr + (16 * s_) * 64; const u32x2 z0 = lds_tr(zp), z1 = lds_tr(zp + 4 * 64);
                const u32x2 k0 = lds_tr(lds + OFF_K + ktr[0] + 4096 * s_), k1 = lds_tr(lds + OFF_K + ktr[1] + 4096 * s_);
                ST = __builtin_amdgcn_mfma_f32_32x32x16_bf16(__builtin_bit_cast(bf16x8, (u32x4){z0.x, z0.y, z1.x, z1.y}), __builtin_bit_cast(bf16x8, (u32x4){k0.x, k0.y, k1.x, k1.y}), ST, 0, 0, 0); }
#pragma unroll
            for (int j = 0; j < 16; ++j) { const int dv = (j & 3) + 8 * (j >> 2) + 4 * hi; ((LAS unsigned short*)(lds + OFF_ST))[dv * (ROWB / 2) + 32 * nt + r] = (unsigned short)f2bf(ST[j]); }
        }
    }
    __syncthreads();
}
__device__ __forceinline__ void transpose_kv_tiles(Frame& F, const bf16* src, bf16* dst, int w0, int nw) {
    LAS unsigned short* tl_ = (LAS unsigned short*)(F.lds + F.wave * 16384); const int lane = F.lane;
    for (int tile = w0; tile < 16 * 64 * 2; tile += nw) {
        const int dh = tile & 1, st = (tile >> 1) & 63, bg = tile >> 7;
        const bf16* sp = src + ((size_t)bg * SEQ + st * 64) * 128 + dh * 64; bf16* dp = dst + ((size_t)bg * 128 + dh * 64) * SEQ + st * 64;
#pragma unroll
        for (int i = 0; i < 8; ++i) { const int row = i * 8 + (lane >> 3), c = lane & 7; const u32x4 v = *(const u32x4*)(sp + (size_t)row * 128 + c * 8); LAS unsigned short* q = tl_ + row * 66 + c * 8;
            q[0] = (unsigned short)(v.x & 0xffffu); q[1] = (unsigned short)(v.x >> 16); q[2] = (unsigned short)(v.y & 0xffffu); q[3] = (unsigned short)(v.y >> 16);
            q[4] = (unsigned short)(v.z & 0xffffu); q[5] = (unsigned short)(v.z >> 16); q[6] = (unsigned short)(v.w & 0xffffu); q[7] = (unsigned short)(v.w >> 16); }
        LDS_WAIT(); asm volatile("" ::: "memory");
#pragma unroll
        for (int i = 0; i < 8; ++i) { const int d = i * 8 + (lane >> 3), c = lane & 7; const LAS unsigned short* q = tl_ + (c * 8) * 66 + d;
            u32x4 o; o.x = (unsigned)q[0] | ((unsigned)q[66] << 16); o.y = (unsigned)q[2 * 66] | ((unsigned)q[3 * 66] << 16); o.z = (unsigned)q[4 * 66] | ((unsigned)q[5 * 66] << 16); o.w = (unsigned)q[6 * 66] | ((unsigned)q[7 * 66] << 16);
            *(u32x4*)(dp + (size_t)d * SEQ + c * 8) = o; }
        LDS_WAIT(); asm volatile("" ::: "memory");
    }
}
struct SchedCmp {
    unsigned char* ws; int first, G, c;
    __device__ __forceinline__ bool next(int i, GU& u) const {
        const int L = i * G + c - first; if (L < 0 || L >= 256) return false;
        const int ks = L & 7, mb = L >> 3, m = mb >> 4, bg = mb & 15;
        u.A = (const char*)ws + WS_KV6 + (size_t)m * KV_STRIDE + (size_t)bg * SEQ * 128 * 2 + (size_t)ks * 512 * 2; u.B = (const char*)ws + (m ? W_C1V : W_C1K) + (size_t)ks * 512 * 2;
        u.pm = mb; u.pn = 0; u.kind = ks; u.rows = nullptr; u.nvalid = 0; u.aux = 0; return true;
    }
};
struct EpiCmp {
    static constexpr bool PERM = false;
    float* hid;
    __device__ __forceinline__ void operator()(const f32x4 (&acc)[2][2][4][2], const GU& u, int wr, int wc, int fr, int fq) const {
#pragma unroll
        for (int ai = 0; ai < 2; ++ai)
#pragma unroll
            for (int m = 0; m < 4; ++m) { const int r = 128 * ai + 64 * wr + 16 * m + fr; float* rowp = hid + (size_t)u.kind * (32 * 256 * 128) + ((size_t)u.pm * 256 + r) * 128 + 32 * wc + 4 * fq;
#pragma unroll
                for (int n = 0; n < 2; ++n) *(f32x4*)(rowp + 16 * n) = acc[ai][0][m][n]; }
    }
};
__device__ __forceinline__ float gelu_tanh(float x) { const float u = 0.7978845608028654f * (x + 0.044715f * x * x * x); return 0.5f * x * (1.0f + tanhf(u)); }
__device__ __forceinline__ void p2b_compress_out(Frame& F, const Args& a) {
    const float* hid = (const float*)a.out + (size_t)16 * MiB; const float* cbias = (const float*)(F.ws + WS_SMALLW + 65536 + 2 * 128 * 128 * 2);
    const int gw = F.bx * NWAVES + F.wave, NGW = F.G * NWAVES;
    for (int row = gw; row < 2 * 16 * 256; row += NGW) {
        const int m = row >> 12, n = row & 255; const float* w2 = a.in[m ? IN_CMP_W2_V : IN_CMP_W2_K];
        bf16* dst = (bf16*)(F.ws + (m ? WS_VCMP : WS_KCMP)) + (size_t)(row & 4095) * 128;
        float o0 = 0.f, o1 = 0.f;
        if (n < 255) { const float* hr = hid + (size_t)row * 128;
            for (int e = 0; e < 128; ++e) { float hsum = 0.f;
#pragma unroll
                for (int ks = 0; ks < 8; ++ks) hsum += hr[(size_t)ks * (32 * 256 * 128) + e];
                const float g = gelu_tanh(hsum + cbias[m * 128 + e]); o0 += g * w2[e * 128 + F.lane]; o1 += g * w2[e * 128 + 64 + F.lane]; } }
        dst[F.lane] = (bf16)f2bf(o0); dst[64 + F.lane] = (bf16)f2bf(o1);
        if (m == 1) { bf16* dt = (bf16*)(F.ws + WS_VCMPT) + (size_t)((row >> 8) & 15) * 128 * 256 + n; dt[(size_t)F.lane * 256] = (bf16)f2bf(o0); dt[(size_t)(64 + F.lane) * 256] = (bf16)f2bf(o1); }
    }
}

__device__ __forceinline__ void p3_ret_normalize(Frame& F) {
    bf16* rv = (bf16*)(F.ws + WS_RV); const bf16* rg = (const bf16*)(F.ws + WS_RG);
    const int gw = F.bx * NWAVES + F.wave, NGW = F.G * NWAVES;
    for (int it = gw; it < NTOK * 4; it += NGW) {
        u32x2* p = (u32x2*)(rv + (size_t)it * 256) + F.lane; const u32x2 w = *p; const u32x2 gq = *((const u32x2*)(rg + (size_t)it * 256) + F.lane);
        const float o0 = lo16(w.x), o1 = hi16(w.x), o2 = lo16(w.y), o3 = hi16(w.y);
        const float ss = wave_sum((o0 * o0 + o1 * o1) + (o2 * o2 + o3 * o3));
        const float r = 1.0f / sqrtf(ss * (1.0f / 256.0f) + EPS);
        u32x2 q; q.x = pk2(o0 * r * lo16(gq.x), o1 * r * hi16(gq.x)); q.y = pk2(o2 * r * lo16(gq.y), o3 * r * hi16(gq.y)); *p = q;
    }
}
namespace nsaf {
constexpr int KROW = 272, VROW = 136, KT_BYTES = 64 * KROW, VT_BYTES = 128 * VROW;
constexpr int OFF_K = 0, OFF_V = KT_BYTES, BUF_BYTES = KT_BYTES + VT_BYTES, OFF_IMP = 2 * BUF_BYTES, OFF_MASK = OFF_IMP + 64 * 64 * 4;
constexpr float NEG = -1.0e30f, MASKED = -3.0e38f, CS = 0.08838834764831845f * 1.4426950408889634f;
struct Stage { u32x4 k0, k1, v0, v1; };
__device__ __forceinline__ void stage_load(Stage& st, const bf16* K, const bf16* VT, size_t vpitch, int key0, int tid) {
    const int r0 = tid >> 4, c0 = tid & 15;
    st.k0 = *(const u32x4*)(K + (size_t)(key0 + r0) * 128 + c0 * 8); st.k1 = *(const u32x4*)(K + (size_t)(key0 + r0 + 32) * 128 + c0 * 8);
    const int d0 = tid >> 3, c1 = tid & 7;
    st.v0 = *(const u32x4*)(VT + (size_t)d0 * vpitch + key0 + c1 * 8); st.v1 = *(const u32x4*)(VT + (size_t)(d0 + 64) * vpitch + key0 + c1 * 8);
}
__device__ __forceinline__ void stage_write(const Stage& st, LAS unsigned char* lds, int tid) {
    const int r0 = tid >> 4, c0 = tid & 15;
    *(LAS u32x4*)(lds + OFF_K + r0 * KROW + c0 * 16) = st.k0; *(LAS u32x4*)(lds + OFF_K + (r0 + 32) * KROW + c0 * 16) = st.k1;
    const int d0 = tid >> 3, c1 = tid & 7;
    LAS unsigned char* p0 = lds + OFF_V + d0 * VROW + c1 * 16; LAS unsigned char* p1 = lds + OFF_V + (d0 + 64) * VROW + c1 * 16;
    *(LAS u32x2*)p0 = (u32x2){st.v0.x, st.v0.y}; *(LAS u32x2*)(p0 + 8) = (u32x2){st.v0.z, st.v0.w};
    *(LAS u32x2*)p1 = (u32x2){st.v1.x, st.v1.y}; *(LAS u32x2*)(p1 + 8) = (u32x2){st.v1.z, st.v1.w};
}
template <int MODE>
__device__ __forceinline__ void block_step(const LAS unsigned char* lds, LAS unsigned char* ldstab, const bf16x8 (&qf)[8], f32x16 (&O)[4], float& m, float& l, int blk, int tl_in, int itile, int nvr_in, bool rowsel, float inv_l, int lane_in) {
    int tl = tl_in, nvr = nvr_in, lane = lane_in; LAUNDER(tl); LAUNDER(nvr); LAUNDER(lane);
    const int r = lane & 31, hi = lane >> 5;
    f32x16 S[2];
#pragma unroll
    for (int kh = 0; kh < 2; ++kh) {
#pragma unroll
        for (int j = 0; j < 16; ++j) S[kh][j] = 0.f;
    }
    {
        const unsigned kaddr = (unsigned)(size_t)(lds + OFF_K + r * KROW + 16 * hi);
        u32x4 ka[4], kb[4];
#define NSAF_KRD(dst, t, s4) asm volatile("ds_read_b128 %0, %1 offset:%2" : "=v"(dst) : "v"(kaddr), "i"((t) * 32 * KROW + (s4) * 32))
#define NSAF_KRD4(set, t, s0) do { NSAF_KRD(set[0], t, (s0)); NSAF_KRD(set[1], t, (s0) + 1); NSAF_KRD(set[2], t, (s0) + 2); NSAF_KRD(set[3], t, (s0) + 3); } while (0)
#define NSAF_KWAIT(n, set) asm volatile("s_waitcnt lgkmcnt(" #n ")" : "+v"(set[0]), "+v"(set[1]), "+v"(set[2]), "+v"(set[3]))
#define NSAF_KMMA(set, t, s0) do { _Pragma("unroll") for (int q_ = 0; q_ < 4; ++q_) S[t] = __builtin_amdgcn_mfma_f32_32x32x16_bf16(__builtin_bit_cast(bf16x8, set[q_]), qf[(s0) + q_], S[t], 0, 0, 0); } while (0)
        NSAF_KRD4(ka, 0, 0); NSAF_KRD4(kb, 0, 4);
        NSAF_KWAIT(4, ka); NSAF_KMMA(ka, 0, 0); NSAF_KRD4(ka, 1, 0);
        NSAF_KWAIT(4, kb); NSAF_KMMA(kb, 0, 4); NSAF_KRD4(kb, 1, 4);
        NSAF_KWAIT(4, ka); NSAF_KMMA(ka, 1, 0);
        NSAF_KWAIT(0, kb); NSAF_KMMA(kb, 1, 4);
#undef NSAF_KRD
#undef NSAF_KRD4
#undef NSAF_KWAIT
#undef NSAF_KMMA
    }
    bool need_mask;
    if (MODE <= 1) need_mask = true; else if (MODE == 2) need_mask = (blk == itile); else need_mask = (blk == itile) || (blk == itile - 8);
    float mx = MASKED;
    if (need_mask) {
        int lo_ = -1, hi_ = 63;
        if (MODE <= 1) hi_ = nvr - 64 * blk - 1; else if (MODE == 2) hi_ = tl; else { hi_ = (blk == itile) ? tl : 63; lo_ = (blk == itile - 8) ? tl : -1; }
        lo_ -= 4 * hi; hi_ -= 4 * hi;
#pragma unroll
        for (int kh = 0; kh < 2; ++kh)
#pragma unroll
            for (int j = 0; j < 16; ++j) { const int kc_ = 32 * kh + (j & 3) + 8 * (j >> 2); const bool ok = (kc_ > lo_) & (kc_ <= hi_); const float v = ok ? S[kh][j] : MASKED; S[kh][j] = v; mx = fmaxf(mx, v); }
    } else {
#pragma unroll
        for (int kh = 0; kh < 2; ++kh)
#pragma unroll
            for (int j = 0; j < 16; ++j) mx = fmaxf(mx, S[kh][j]);
    }
    if (MODE == 2) mx = rowsel ? mx : MASKED;
    if (MODE == 1) {
        LAS float* imp = (LAS float*)(ldstab + OFF_IMP) + tl * 64;
#pragma unroll
        for (int kh = 0; kh < 2; ++kh)
#pragma unroll
            for (int j = 0; j < 16; ++j) { const int n = 64 * blk + 32 * kh + (j & 3) + 8 * (j >> 2) + 4 * hi; const float v = S[kh][j]; const float p = __builtin_amdgcn_exp2f(v - m) * inv_l; S[kh][j] = p;
                if (v > 0.5f * MASKED) { __hip_atomic_fetch_add(imp + (n >> 2), p, __ATOMIC_RELAXED, __HIP_MEMORY_SCOPE_WORKGROUP); if ((n & 3) == 3 && (n >> 2) + 1 < 64) __hip_atomic_fetch_add(imp + (n >> 2) + 1, p, __ATOMIC_RELAXED, __HIP_MEMORY_SCOPE_WORKGROUP); } }
    } else {
        mx = fmaxf(mx, __shfl_xor(mx, 32));
        if (__any(mx > m + 8.0f)) { const float mn = fmaxf(m, mx); const float alpha = __builtin_amdgcn_exp2f(m - mn); m = mn; l *= alpha;
            if (MODE != 0) {
#pragma unroll
                for (int dt = 0; dt < 4; ++dt)
#pragma unroll
                    for (int j = 0; j < 16; ++j) O[dt][j] *= alpha; } }
        float rs = 0.f;
        if (MODE == 2) {
#pragma unroll
            for (int kh = 0; kh < 2; ++kh)
#pragma unroll
                for (int j = 0; j < 16; ++j) { const float p = rowsel ? __builtin_amdgcn_exp2f(S[kh][j] - m) : 0.f; S[kh][j] = p; rs += p; }
        } else {
#pragma unroll
            for (int kh = 0; kh < 2; ++kh)
#pragma unroll
                for (int j = 0; j < 16; ++j) { const float p = __builtin_amdgcn_exp2f(S[kh][j] - m); S[kh][j] = p; rs += p; }
        }
        l += rs;
        if (MODE == 0) return;
    }
    bf16x8 pf[2][2];
#pragma unroll
    for (int kh = 0; kh < 2; ++kh)
#pragma unroll
        for (int s2 = 0; s2 < 2; ++s2) { u32x4 w; w.x = cvt_pk_bf16(S[kh][8 * s2 + 0], S[kh][8 * s2 + 1]); w.y = cvt_pk_bf16(S[kh][8 * s2 + 2], S[kh][8 * s2 + 3]); w.z = cvt_pk_bf16(S[kh][8 * s2 + 4], S[kh][8 * s2 + 5]); w.w = cvt_pk_bf16(S[kh][8 * s2 + 6], S[kh][8 * s2 + 7]);
            pf[kh][s2] = __builtin_bit_cast(bf16x8, w); }
    {
        const unsigned vaddr = (unsigned)(size_t)(lds + OFF_V + r * VROW + 8 * hi);
        u32x2 va[8], vb[8];
#define NSAF_VRD(dst, dt, i) asm volatile("ds_read_b64 %0, %1 offset:%2" : "=v"(dst) : "v"(vaddr), "i"((dt) * 32 * VROW + ((i) >> 1) * 32 + ((i) & 1) * 16))
#define NSAF_VRD8(set, dt) do { NSAF_VRD(set[0], dt, 0); NSAF_VRD(set[1], dt, 1); NSAF_VRD(set[2], dt, 2); NSAF_VRD(set[3], dt, 3); NSAF_VRD(set[4], dt, 4); NSAF_VRD(set[5], dt, 5); NSAF_VRD(set[6], dt, 6); NSAF_VRD(set[7], dt, 7); } while (0)
#define NSAF_VWAIT(n, set) asm volatile("s_waitcnt lgkmcnt(" #n ")" : "+v"(set[0]), "+v"(set[1]), "+v"(set[2]), "+v"(set[3]), "+v"(set[4]), "+v"(set[5]), "+v"(set[6]), "+v"(set[7]))
#define NSAF_VMMA(set, dt) do { _Pragma("unroll") for (int ks = 0; ks < 4; ++ks) { const u32x4 a_ = (u32x4){set[2 * ks].x, set[2 * ks].y, set[2 * ks + 1].x, set[2 * ks + 1].y}; \
            O[dt] = __builtin_amdgcn_mfma_f32_32x32x16_bf16(__builtin_bit_cast(bf16x8, a_), pf[ks >> 1][ks & 1], O[dt], 0, 0, 0); } } while (0)
        NSAF_VRD8(va, 0); NSAF_VRD8(vb, 1);
        NSAF_VWAIT(8, va); NSAF_VMMA(va, 0); NSAF_VRD8(va, 2);
        NSAF_VWAIT(8, vb); NSAF_VMMA(vb, 1); NSAF_VRD8(vb, 3);
        NSAF_VWAIT(8, va); NSAF_VMMA(va, 2);
        NSAF_VWAIT(0, vb); NSAF_VMMA(vb, 3);
#undef NSAF_VRD
#undef NSAF_VRD8
#undef NSAF_VWAIT
#undef NSAF_VMMA
    }
}
template <int MODE>
__device__ __forceinline__ void run_pass(LAS unsigned char* lds, const bf16* K, const bf16* VT, size_t vpitch, int jb, int je, const bf16x8 (&qf)[8], f32x16 (&O)[4], float& m, float& l, int tl, int itile, int nvr, unsigned long long selmask, float inv_l, int tid, int lane) {
    Stage st; stage_load(st, K, VT, vpitch, jb * 64, tid); stage_write(st, lds, tid);
    if (jb < je) stage_load(st, K, VT, vpitch, (jb + 1) * 64, tid);
    __syncthreads();
    for (int j = jb; j <= je; ++j) {
        const int cur = (j - jb) & 1;
        if (j < je) { stage_write(st, lds + (cur ^ 1) * BUF_BYTES, tid); if (j + 1 < je) stage_load(st, K, VT, vpitch, (j + 2) * 64, tid); }
        const bool rowsel = (MODE == 2) ? (((selmask >> j) & 1ull) != 0ull) : true;
        if (MODE != 2 || __ballot(rowsel) != 0ull) block_step<MODE>(lds + cur * BUF_BYTES, lds, qf, O, m, l, j, tl, itile, nvr, rowsel, inv_l, lane);
        __syncthreads();
    }
}
}
__device__ __forceinline__ void p3_nsa_fast(Frame& F, const bf16* svT, const bf16* wvT, bf16* outbase) {
    using namespace nsaf;
    unsigned char* ws = F.ws; const int tid = F.tid, lane = F.lane, wave = F.wave; LAS unsigned char* lds = F.lds;
    bf16* nq = (bf16*)(ws + WS_NQ); const float* gates = (const float*)(ws + WS_GATES);
    const int r = lane & 31, hi = lane >> 5, qrow = wave * 32 + r, tl = qrow >> 2, head = qrow & 3;
    for (int u4 = 0; u4 < 4; ++u4) {
        const int pr = F.bx + (u4 >> 1) * F.G; if (pr >= 512) break;
        const int bg = pr >> 5, ii = pr & 31, itile = (u4 & 1) ? (63 - ii) : ii, g = bg & 1, b = bg >> 1;
        const int tok = b * SEQ + itile * 64 + tl, t = itile * 64 + tl;
        const bf16* kc = (const bf16*)(ws + WS_KCMP) + (size_t)bg * 256 * 128; const bf16* vcT = (const bf16*)(ws + WS_VCMPT) + (size_t)bg * 128 * 256;
        const bf16* ks = (const bf16*)(ws + WS_KV6 + 2 * KV_STRIDE) + (size_t)bg * SEQ * 128; const bf16* kw = (const bf16*)(ws + WS_KV6 + 4 * KV_STRIDE) + (size_t)bg * SEQ * 128;
        const bf16* vsT = svT + (size_t)bg * 128 * SEQ; const bf16* vwT = wvT + (size_t)bg * 128 * SEQ;
        __syncthreads();
        for (int i = tid; i < 64 * 64; i += NTHREADS) ((LAS float*)(lds + OFF_IMP))[i] = 0.f;
        bf16x8 qf[8]; bf16* qrowp = nq + (size_t)tok * 1024 + g * 512 + head * 128; bf16* orowp = outbase + (size_t)tok * 1024 + g * 512 + head * 128;
#pragma unroll
        for (int s_ = 0; s_ < 8; ++s_) { const u32x4 w_ = *(const u32x4*)(qrowp + 16 * s_ + 8 * hi);
            u32x4 o_; o_.x = cvt_pk_bf16(lo16(w_.x) * CS, hi16(w_.x) * CS); o_.y = cvt_pk_bf16(lo16(w_.y) * CS, hi16(w_.y) * CS); o_.z = cvt_pk_bf16(lo16(w_.z) * CS, hi16(w_.z) * CS); o_.w = cvt_pk_bf16(lo16(w_.w) * CS, hi16(w_.w) * CS);
            qf[s_] = __builtin_bit_cast(bf16x8, o_); }
        const float g0 = gates[(size_t)tok * 24 + (g * 4 + head) * 3 + 0], g1 = gates[(size_t)tok * 24 + (g * 4 + head) * 3 + 1], g2 = gates[(size_t)tok * 24 + (g * 4 + head) * 3 + 2];
        const int nvr = (t >= 31) ? (((t - 31) >> 4) + 1 > 255 ? 255 : ((t - 31) >> 4) + 1) : 0;
        const int jec = ((4 * itile + 2) >> 6) > 3 ? 3 : ((4 * itile + 2) >> 6);
        f32x16 O[4];
#define NSAF_ZERO_O() do { _Pragma("unroll") for (int dt = 0; dt < 4; ++dt) _Pragma("unroll") for (int j = 0; j < 16; ++j) O[dt][j] = 0.f; } while (0)
#define NSAF_ACCUM(coef, FIRST) do { const float cf_ = (coef); _Pragma("unroll") for (int dt = 0; dt < 4; ++dt) { _Pragma("unroll") for (int q4 = 0; q4 < 4; ++q4) { u32x2* p_ = (u32x2*)(orowp + 32 * dt + 8 * q4 + 4 * hi); \
            float a0_ = cf_ * O[dt][4 * q4], a1_ = cf_ * O[dt][4 * q4 + 1], a2_ = cf_ * O[dt][4 * q4 + 2], a3_ = cf_ * O[dt][4 * q4 + 3]; \
            if (!(FIRST)) { const u32x2 o_ = *p_; a0_ += lo16(o_.x); a1_ += hi16(o_.x); a2_ += lo16(o_.y); a3_ += hi16(o_.y); } \
            *p_ = (u32x2){cvt_pk_bf16(a0_, a1_), cvt_pk_bf16(a2_, a3_)}; } asm volatile("" ::: "memory"); } } while (0)
        float m = NEG, l = 0.f; NSAF_ZERO_O();
        run_pass<0>(lds, kc, vcT, 256, 0, jec, qf, O, m, l, tl, itile, nvr, 0ull, 0.f, tid, lane);
        l += __shfl_xor(l, 32); const float invl = l > 0.f ? 1.0f / l : 0.f;
        run_pass<1>(lds, kc, vcT, 256, 0, jec, qf, O, m, l, tl, itile, nvr, 0ull, invl, tid, lane);
        NSAF_ACCUM(g0, true);
        __syncthreads();
        for (int tk = 0; tk < 8; ++tk) { const int tokl = wave * 8 + tk; float v = ((const LAS float*)(lds + OFF_IMP))[tokl * 64 + lane];
            const bool forced = (lane == 0) || (lane == itile) || (lane == itile - 1); v = (lane > itile) ? -1.0e4f : (forced ? 1.0e4f : v);
            int rank = 0;
#pragma unroll 16
            for (int i = 0; i < 64; ++i) { const float w = __builtin_bit_cast(float, __builtin_amdgcn_readlane(__builtin_bit_cast(int, v), i)); rank += (w > v || (w == v && i < lane)) ? 1 : 0; }
            const unsigned long long mk = __ballot(rank < 16);
            if (lane == 0) { ((LAS unsigned*)(lds + OFF_MASK))[tokl * 2] = (unsigned)mk; ((LAS unsigned*)(lds + OFF_MASK))[tokl * 2 + 1] = (unsigned)(mk >> 32); } }
        __syncthreads();
        const unsigned long long selmask = (unsigned long long)((const LAS unsigned*)(lds + OFF_MASK))[tl * 2] | ((unsigned long long)((const LAS unsigned*)(lds + OFF_MASK))[tl * 2 + 1] << 32);
        m = NEG; l = 0.f; NSAF_ZERO_O();
        run_pass<2>(lds, ks, vsT, SEQ, 0, itile, qf, O, m, l, tl, itile, 0, selmask, 0.f, tid, lane);
        l += __shfl_xor(l, 32); NSAF_ACCUM(l > 0.f ? g1 / l : 0.f, false);
        m = NEG; l = 0.f; NSAF_ZERO_O();
        run_pass<3>(lds, kw, vwT, SEQ, itile > 8 ? itile - 8 : 0, itile, qf, O, m, l, tl, itile, 0, 0ull, 0.f, tid, lane);
        l += __shfl_xor(l, 32); NSAF_ACCUM(l > 0.f ? g2 / l : 0.f, false);
#undef NSAF_ZERO_O
#undef NSAF_ACCUM
    }
    __syncthreads();
}
struct SchedP4 {
    unsigned char* ws; int G, c;
    __device__ __forceinline__ bool next(int i, GU& u) const {
        const int ti = i >> 2, sub = i & 3; const int L = ti * G + c; if (L >= 128 * 4) return false;
        int pm, pn; pg8::tile_map(L, 128, 4, pm, pn);
        const size_t ao = sub == 1 ? WS_RV : sub == 3 ? WS_NQ : WS_H; const size_t bo = sub == 0 ? W_GA : sub == 1 ? W_RO : sub == 2 ? W_GB : W_NO;
        u.A = (const char*)ws + ao + (size_t)pm * 256 * D * 2; u.B = (const char*)ws + bo + (size_t)pn * 256 * D * 2; u.pm = pm; u.pn = pn; u.kind = sub; u.rows = nullptr; u.nvalid = 0; u.aux = 0; return true;
    }
};
struct EpiP4 {
    static constexpr bool PERM = true;
    float* scr;
    bf16* Y;
    static __device__ __forceinline__ u32x2 pk4(const f32x4 v) { return (u32x2){cvt_pk_bf16(v[0], v[1]), cvt_pk_bf16(v[2], v[3])}; }
    static __device__ __forceinline__ f32x4 up4(const u32x2 w) { return (f32x4){lo16(w.x), hi16(w.x), lo16(w.y), hi16(w.y)}; }
    __device__ __forceinline__ void operator()(const f32x4 (&acc)[2][2][4][2], const GU& u, int wr, int wc, int fr, int fq) const {
        u32x2* p0 = (u32x2*)scr + threadIdx.x; u32x2* p1 = p0 + 32 * 512;
        if (u.kind == 0 || u.kind == 2) {
            u32x2* p = u.kind == 0 ? p0 : p1;
#pragma unroll
            for (int ai = 0; ai < 2; ++ai)
#pragma unroll
                for (int m = 0; m < 4; ++m) {
#pragma unroll
                    for (int bj = 0; bj < 2; ++bj) { f32x4 v0 = acc[ai][bj][m][0], v1 = acc[ai][bj][m][1];
#pragma unroll
                        for (int j = 0; j < 4; ++j) { v0[j] = sigmoidf_(v0[j]); v1[j] = sigmoidf_(v1[j]); }
                        p[(2 * bj) * 512] = pk4(v0); p[(2 * bj + 1) * 512] = pk4(v1); }
                    p += 4 * 512; LAUNDER(p); }
        } else if (u.kind == 1) {
#pragma unroll
            for (int ai = 0; ai < 2; ++ai)
#pragma unroll
                for (int m = 0; m < 4; ++m) {
#pragma unroll
                    for (int bj = 0; bj < 2; ++bj) { p0[(2 * bj) * 512] = pk4(up4(p0[(2 * bj) * 512]) * acc[ai][bj][m][0]); p0[(2 * bj + 1) * 512] = pk4(up4(p0[(2 * bj + 1) * 512]) * acc[ai][bj][m][1]); }
                    p0 += 4 * 512; LAUNDER(p0); }
        } else {
            bf16* yb = Y + (size_t)(u.pm * 256 + 64 * wr + fr) * D + u.pn * 256 + 32 * wc + 8 * fq;
#pragma unroll
            for (int ai = 0; ai < 2; ++ai)
#pragma unroll
                for (int m = 0; m < 4; ++m) {
#pragma unroll
                    for (int bj = 0; bj < 2; ++bj) {
                        const f32x4 v0 = up4(p0[(2 * bj) * 512]) + up4(p1[(2 * bj) * 512]) * acc[ai][bj][m][0], v1 = up4(p0[(2 * bj + 1) * 512]) + up4(p1[(2 * bj + 1) * 512]) * acc[ai][bj][m][1];
                        u32x4 w; w.x = cvt_pk_bf16(v0[0], v0[1]); w.y = cvt_pk_bf16(v0[2], v0[3]); w.z = cvt_pk_bf16(v1[0], v1[1]); w.w = cvt_pk_bf16(v1[2], v1[3]);
                        *(u32x4*)(yb + (size_t)(128 * ai + 16 * m) * D + 128 * bj) = w; }
                    p0 += 4 * 512; p1 += 4 * 512; LAUNDER(p0); LAUNDER(p1); }
        }
    }
};

struct SchedMN {
    unsigned char* ws; size_t ao, bo; int G, c;
    __device__ __forceinline__ bool next(int i, GU& u) const {
        const int L = i * G + c; if (L >= 128 * 4) return false; int pm, pn; pg8::tile_map(L, 128, 4, pm, pn);
        u.A = (const char*)ws + ao + (size_t)pm * 256 * D * 2; u.B = (const char*)ws + bo + (size_t)pn * 256 * D * 2; u.pm = pm; u.pn = pn; u.kind = 0; u.rows = nullptr; u.nvalid = 0; u.aux = 0; return true;
    }
};
template <bool SSQ> struct EpiRes {
    static constexpr bool PERM = false;
    const float* basef; const bf16* baseb; float* out; bf16* ob; float* ssq;
    __device__ __forceinline__ void operator()(const f32x4 (&acc)[2][2][4][2], const GU& u, int wr, int wc, int fr, int fq) const {
#pragma unroll
        for (int ai = 0; ai < 2; ++ai)
#pragma unroll
            for (int m = 0; m < 4; ++m) { const int r = u.pm * 256 + 128 * ai + 64 * wr + 16 * m + fr; const size_t off = (size_t)r * D + u.pn * 256 + 32 * wc + 4 * fq; float sq = 0.f;
#pragma unroll
                for (int bj = 0; bj < 2; ++bj)
#pragma unroll
                    for (int n = 0; n < 2; ++n) { const size_t o = off + 128 * bj + 16 * n; f32x4 bv;
                        if (SSQ) bv = *(const f32x4*)(basef + o); else { const u32x2 bw = *(const u32x2*)(baseb + o); bv = (f32x4){lo16(bw.x), hi16(bw.x), lo16(bw.y), hi16(bw.y)}; }
                        const f32x4 v = bv + acc[ai][bj][m][n];
                        if (!SSQ) *(f32x4*)(out + o) = v;
                        u32x2 w; w.x = cvt_pk_bf16(v[0], v[1]); w.y = cvt_pk_bf16(v[2], v[3]); *(u32x2*)(ob + o) = w; sq += (v[0] * v[0] + v[1] * v[1]) + (v[2] * v[2] + v[3] * v[3]); }
                if (SSQ) { sq += __shfl_xor(sq, 16); sq += __shfl_xor(sq, 32); if (fq == 0) ssq[(size_t)r * 16 + u.pn * 4 + wc] = sq; }
            }
    }
};
struct EpiQ {
    static constexpr bool PERM = true;
    const float* ssq; bf16* Q;
    __device__ __forceinline__ void operator()(const f32x4 (&acc)[2][2][4][2], const GU& u, int wr, int wc, int fr, int fq) const {
#pragma unroll
        for (int ai = 0; ai < 2; ++ai)
#pragma unroll
            for (int m = 0; m < 4; ++m) { const int r = u.pm * 256 + 128 * ai + 64 * wr + 16 * m + fr; const f32x4* sp = (const f32x4*)(ssq + (size_t)r * 16);
                const f32x4 a = sp[0], b = sp[1], c = sp[2], d = sp[3]; const float tot = ((a[0] + a[1]) + (a[2] + a[3])) + ((b[0] + b[1]) + (b[2] + b[3])) + ((c[0] + c[1]) + (c[2] + c[3])) + ((d[0] + d[1]) + (d[2] + d[3]));
                const float rstd = 1.0f / sqrtf(tot * (1.0f / D) + EPS);
#pragma unroll
                for (int bj = 0; bj < 2; ++bj) { const f32x4 v0 = acc[ai][bj][m][0] * rstd, v1 = acc[ai][bj][m][1] * rstd;
                    u32x4 w; w.x = cvt_pk_bf16(v0[0], v0[1]); w.y = cvt_pk_bf16(v0[2], v0[3]); w.z = cvt_pk_bf16(v1[0], v1[1]); w.w = cvt_pk_bf16(v1[2], v1[3]);
                    *(u32x4*)(Q + (size_t)r * D + u.pn * 256 + 128 * bj + 32 * wc + 8 * fq) = w; } }
    }
};

namespace xatf {
constexpr int KROW = 528, VROW = 136, KT_BYTES = 64 * KROW, OFF_K = 0, OFF_V = KT_BYTES;
constexpr float NEG = -1.0e30f, CS = 0.0625f * 1.4426950408889634f;
struct Stage { u32x4 k[4]; u32x4 v[2]; };
__device__ __forceinline__ void stage_load(Stage& st, const bf16* K, const bf16* VT, int key0, int tid) {
#pragma unroll
    for (int i = 0; i < 4; ++i) { const int p = tid + 512 * i, row = p >> 5, c = p & 31; st.k[i] = *(const u32x4*)(K + (size_t)(key0 + row) * 2048 + c * 8); }
#pragma unroll
    for (int i = 0; i < 2; ++i) { const int p = tid + 512 * i, d = p >> 3, c = p & 7; st.v[i] = *(const u32x4*)(VT + (size_t)d * 256 + key0 + c * 8); }
}
__device__ __forceinline__ void stage_write(const Stage& st, LAS unsigned char* lds, int tid) {
#pragma unroll
    for (int i = 0; i < 4; ++i) { const int p = tid + 512 * i, row = p >> 5, c = p & 31; *(LAS u32x4*)(lds + OFF_K + row * KROW + c * 16) = st.k[i]; }
#pragma unroll
    for (int i = 0; i < 2; ++i) { const int p = tid + 512 * i, d = p >> 3, c = p & 7; LAS unsigned char* q = lds + OFF_V + d * VROW + c * 16;
        *(LAS u32x2*)q = (u32x2){st.v[i].x, st.v[i].y}; *(LAS u32x2*)(q + 8) = (u32x2){st.v[i].z, st.v[i].w}; }
}
__device__ __forceinline__ void block_step(const LAS unsigned char* lds, const bf16x8 (&qf)[16], f32x16 (&O)[4], float& m, float& l, int lane) {
    const int r = lane & 31, hi = lane >> 5;
    f32x16 S[2];
#pragma unroll
    for (int kh = 0; kh < 2; ++kh) {
#pragma unroll
        for (int j = 0; j < 16; ++j) S[kh][j] = 0.f;
#pragma unroll
        for (int s_ = 0; s_ < 16; ++s_) { const bf16x8 a = *(const LAS bf16x8*)(lds + OFF_K + (kh * 32 + r) * KROW + (16 * s_ + 8 * hi) * 2); S[kh] = __builtin_amdgcn_mfma_f32_32x32x16_bf16(a, qf[s_], S[kh], 0, 0, 0); }
    }
    float mx = NEG;
#pragma unroll
    for (int kh = 0; kh < 2; ++kh)
#pragma unroll
        for (int j = 0; j < 16; ++j) { const float v = S[kh][j] * CS; S[kh][j] = v; mx = fmaxf(mx, v); }
    mx = fmaxf(mx, __shfl_xor(mx, 32));
    const float mn = fmaxf(m, mx); const float alpha = __builtin_amdgcn_exp2f(m - mn); m = mn; float rs = 0.f;
#pragma unroll
    for (int kh = 0; kh < 2; ++kh)
#pragma unroll
        for (int j = 0; j < 16; ++j) { const float p = __builtin_amdgcn_exp2f(S[kh][j] - mn); S[kh][j] = p; rs += p; }
    l = l * alpha + rs;
#pragma unroll
    for (int dt = 0; dt < 4; ++dt)
#pragma unroll
        for (int j = 0; j < 16; ++j) O[dt][j] *= alpha;
    bf16x8 pf[2][2];
#pragma unroll
    for (int kh = 0; kh < 2; ++kh)
#pragma unroll
        for (int s2 = 0; s2 < 2; ++s2) { u32x4 w; w.x = cvt_pk_bf16(S[kh][8 * s2 + 0], S[kh][8 * s2 + 1]); w.y = cvt_pk_bf16(S[kh][8 * s2 + 2], S[kh][8 * s2 + 3]); w.z = cvt_pk_bf16(S[kh][8 * s2 + 4], S[kh][8 * s2 + 5]); w.w = cvt_pk_bf16(S[kh][8 * s2 + 6], S[kh][8 * s2 + 7]);
            pf[kh][s2] = __builtin_bit_cast(bf16x8, w); }
#pragma unroll
    for (int dt = 0; dt < 4; ++dt)
#pragma unroll
        for (int kh = 0; kh < 2; ++kh)
#pragma unroll
            for (int s2 = 0; s2 < 2; ++s2) { const LAS unsigned char* vp = lds + OFF_V + (dt * 32 + r) * VROW + (32 * kh + 16 * s2 + 4 * hi) * 2;
                const u32x2 lo = *(const LAS u32x2*)vp, hi2 = *(const LAS u32x2*)(vp + 16); const u32x4 av = (u32x4){lo.x, lo.y, hi2.x, hi2.y};
                O[dt] = __builtin_amdgcn_mfma_f32_32x32x16_bf16(__builtin_bit_cast(bf16x8, av), pf[kh][s2], O[dt], 0, 0, 0); }
}
}
__device__ __forceinline__ void p7_xattn_fast(Frame& F, const bf16* vT, bf16* outbase) {
    using namespace xatf;
    bf16* Q = (bf16*)(F.ws + WS_NQ); const bf16* KV = (const bf16*)(F.ws + WS_MEMKV);
    const int tid = F.tid, lane = F.lane, wave = F.wave, r = lane & 31, hi = lane >> 5; LAS unsigned char* lds = F.lds;
    for (int u = F.bx; u < BATCH * 4 * 16; u += F.G) {
        const int tt = u & 15, bh = u >> 4, b = bh >> 2, h = bh & 3; const int tok = b * SEQ + tt * 256 + wave * 32 + r;
        bf16* qrow = Q + (size_t)tok * D + h * 256; bf16* orow = outbase + (size_t)tok * D + h * 256; const bf16* Kb = KV + (size_t)(b * NMEM) * 2048 + h * 256;
        bf16x8 qf[16];
#pragma unroll
        for (int s_ = 0; s_ < 16; ++s_) qf[s_] = *(const bf16x8*)(qrow + 16 * s_ + 8 * hi);
#pragma unroll
        for (int half = 0; half < 2; ++half) {
            const bf16* VTb = vT + ((size_t)bh * 256 + half * 128) * 256;
            f32x16 O[4]; float m = NEG, l = 0.f;
#pragma unroll
            for (int dt = 0; dt < 4; ++dt)
#pragma unroll
                for (int j = 0; j < 16; ++j) O[dt][j] = 0.f;
            for (int j = 0; j < 4; ++j) {
                __syncthreads(); { Stage st; stage_load(st, Kb, VTb, j * 64, tid); stage_write(st, lds, tid); } __syncthreads();
                block_step(lds, qf, O, m, l, lane);
            }
            l += __shfl_xor(l, 32); const float inv = 1.0f / l;
#pragma unroll
            for (int dt = 0; dt < 4; ++dt)
#pragma unroll
                for (int q4 = 0; q4 < 4; ++q4) *(u32x2*)(orow + half * 128 + 32 * dt + 8 * q4 + 4 * hi) = (u32x2){cvt_pk_bf16(O[dt][4 * q4] * inv, O[dt][4 * q4 + 1] * inv), cvt_pk_bf16(O[dt][4 * q4 + 2] * inv, O[dt][4 * q4 + 3] * inv)};
        }
    }
    __syncthreads();
}
__device__ __forceinline__ void transpose_memv_tiles(Frame& F, bf16* vT, int w0, int nw) {
    LAS unsigned short* tl_ = (LAS unsigned short*)(F.lds + F.wave * 16384); const int lane = F.lane; const bf16* KV = (const bf16*)(F.ws + WS_MEMKV);
    for (int tile = w0; tile < 32 * 16; tile += nw) {
        const int dq = tile & 3, kq = (tile >> 2) & 3, bh = tile >> 4, b = bh >> 2, h = bh & 3;
        const bf16* sp = KV + (size_t)(b * NMEM + kq * 64) * 2048 + 1024 + h * 256 + dq * 64; bf16* dp = vT + ((size_t)bh * 256 + dq * 64) * 256 + kq * 64;
#pragma unroll
        for (int i = 0; i < 8; ++i) { const int row = i * 8 + (lane >> 3), c = lane & 7; const u32x4 v = *(const u32x4*)(sp + (size_t)row * 2048 + c * 8); LAS unsigned short* q = tl_ + row * 66 + c * 8;
            q[0] = (unsigned short)(v.x & 0xffffu); q[1] = (unsigned short)(v.x >> 16); q[2] = (unsigned short)(v.y & 0xffffu); q[3] = (unsigned short)(v.y >> 16);
            q[4] = (unsigned short)(v.z & 0xffffu); q[5] = (unsigned short)(v.z >> 16); q[6] = (unsigned short)(v.w & 0xffffu); q[7] = (unsigned short)(v.w >> 16); }
        LDS_WAIT(); asm volatile("" ::: "memory");
#pragma unroll
        for (int i = 0; i < 8; ++i) { const int d = i * 8 + (lane >> 3), c = lane & 7; const LAS unsigned short* q = tl_ + (c * 8) * 66 + d;
            u32x4 o; o.x = (unsigned)q[0] | ((unsigned)q[66] << 16); o.y = (unsigned)q[2 * 66] | ((unsigned)q[3 * 66] << 16); o.z = (unsigned)q[4 * 66] | ((unsigned)q[5 * 66] << 16); o.w = (unsigned)q[6 * 66] | ((unsigned)q[7 * 66] << 16);
            *(u32x4*)(dp + (size_t)d * 256 + c * 8) = o; }
        LDS_WAIT(); asm volatile("" ::: "memory");
    }
}

__device__ __forceinline__ void p9_route(Frame& F, const Args& a) {
    unsigned char* ws = F.ws; const float* X2 = a.out;
    const float* gff = a.in[IN_NORM_FFN_G]; const float* wgrp = a.in[IN_W_GRP]; const float* bgrp = a.in[IN_B_GRP]; const float* wrt = a.in[IN_W_RT]; const float* brt = a.in[IN_B_RT];
    float* wts = (float*)(ws + WS_ROUTE); float* rstd2 = wts + 2 * NTOK; int* lists = (int*)(ws + WS_LISTS);
    const int gw = F.bx * NWAVES + F.wave, NGW = F.G * NWAVES, lane = F.lane;
    f32x4 vnext[4];
    if (gw < NTOK) {
#pragma unroll
        for (int j = 0; j < 4; ++j) vnext[j] = ((const f32x4*)(X2 + (size_t)gw * D) + lane)[64 * j]; }
    int my_ea = -1, my_eb = -1, my_tok = -1, it_ = 0; float my_w1 = 0.f, my_w2 = 0.f, my_rstd = 0.f;
    for (int tok = gw; tok < NTOK; tok += NGW, ++it_) {
        const f32x4* gr = (const f32x4*)gff + lane;
        f32x4 v[4]; float s = 0.f;
#pragma unroll
        for (int j = 0; j < 4; ++j) { v[j] = vnext[j]; s += (v[j].x * v[j].x + v[j].y * v[j].y) + (v[j].z * v[j].z + v[j].w * v[j].w); }
        if (tok + NGW < NTOK) {
#pragma unroll
            for (int j = 0; j < 4; ++j) vnext[j] = ((const f32x4*)(X2 + (size_t)(tok + NGW) * D) + lane)[64 * j]; }
        const float rstd = 1.0f / sqrtf(wave_sum(s) * (1.f / D) + EPS);
        float lg[4] = {0.f, 0.f, 0.f, 0.f};
        const float* pwg = wgrp + (size_t)(4 * lane) * 4;
#pragma unroll
        for (int j = 0; j < 4; ++j) { const f32x4 gg = gr[64 * j];
#pragma unroll
            for (int c = 0; c < 4; ++c) { const float hf = v[j][c] * rstd * gg[c]; v[j][c] = hf; const f32x4 wg = *(const f32x4*)(pwg + c * 4);
#pragma unroll
                for (int i = 0; i < 4; ++i) lg[i] += hf * wg[i]; }
            pwg += 256 * 4; LAUNDER(pwg); }
#pragma unroll
        for (int i = 0; i < 4; ++i) lg[i] = wave_sum(lg[i]) + bgrp[i];
        int grp = 0; float gm = lg[0];
#pragma unroll
        for (int i = 1; i < 4; ++i) if (lg[i] > gm) { gm = lg[i]; grp = i; }
        grp = __builtin_amdgcn_readfirstlane(grp);
        float gs = 0.f;
#pragma unroll
        for (int i = 0; i < 4; ++i) gs += expf(lg[i] - gm);
        const float g_gate = 1.0f / gs;
        float lq[8];
#pragma unroll
        for (int i = 0; i < 8; ++i) lq[i] = 0.f;
        const float* pwr = wrt + (size_t)(4 * lane) * 32 + grp * 8;
#pragma unroll
        for (int j = 0; j < 4; ++j) {
#pragma unroll
            for (int c = 0; c < 4; ++c) { const float hf = v[j][c]; const f32x4 wa = *(const f32x4*)(pwr + c * 32), wb = *(const f32x4*)(pwr + c * 32 + 4);
#pragma unroll
                for (int i = 0; i < 4; ++i) { lq[i] += hf * wa[i]; lq[4 + i] += hf * wb[i]; } }
            pwr += 256 * 32; LAUNDER(pwr); }
#pragma unroll
        for (int i = 0; i < 8; ++i) lq[i] = wave_sum(lq[i]) + brt[grp * 8 + i];
        int i1 = 0; float m1 = lq[0];
#pragma unroll
        for (int i = 1; i < 8; ++i) if (lq[i] > m1) { m1 = lq[i]; i1 = i; }
        int i2 = -1; float m2 = -3.0e38f;
#pragma unroll
        for (int i = 0; i < 8; ++i) if (i != i1 && lq[i] > m2) { m2 = lq[i]; i2 = i; }
        const float e2 = expf(m2 - m1), den = 1.0f + e2; const float w1 = g_gate / den, w2 = g_gate * e2 / den;
        if (lane == it_) { my_ea = grp * 8 + i1; my_eb = grp * 8 + i2; my_tok = tok; my_w1 = w1; my_w2 = w2; my_rstd = rstd; }
    }
    if (my_tok >= 0) {
        const unsigned sa = __hip_atomic_fetch_add(F.ctl + CW_ECNT + 64 * my_ea, 1u, __ATOMIC_RELAXED, __HIP_MEMORY_SCOPE_AGENT);
        const unsigned sb = __hip_atomic_fetch_add(F.ctl + CW_ECNT + 64 * my_eb, 1u, __ATOMIC_RELAXED, __HIP_MEMORY_SCOPE_AGENT);
        lists[(size_t)my_ea * NTOK + sa] = my_tok * 2; lists[(size_t)my_eb * NTOK + sb] = my_tok * 2 + 1;
        wts[my_tok * 2] = my_w1; wts[my_tok * 2 + 1] = my_w2; rstd2[my_tok] = my_rstd;
    }
}
struct XItem { const float* src; bf16* dst; const float* ks; int ldw, ldt, mode, row_off, c0, k0, has_ks; };
__device__ __forceinline__ void xitem_decode(const Args& a, unsigned char* ws, int it, XItem& x) {
    const int e = it / 768, r = it % 768, which = r >> 8, t = r & 255;
    x.ks = a.in[IN_NORM_FFN_G];
    if (which < 2) { x.src = a.in[which ? IN_W_E3 : IN_W_E1] + (size_t)e * D * DEXP; x.ldw = DEXP; x.dst = (bf16*)(ws + WS_W13) + (size_t)e * D * D; x.ldt = D; x.mode = 1; x.row_off = which; x.has_ks = 1; x.c0 = 32 * (t & 15); x.k0 = 64 * (t >> 4); }
    else { x.src = a.in[IN_W_E2] + (size_t)e * DEXP * D; x.ldw = D; x.dst = (bf16*)(ws + WS_W2) + (size_t)e * D * DEXP; x.ldt = DEXP; x.mode = 0; x.row_off = 0; x.has_ks = 0; x.c0 = 32 * (t & 31); x.k0 = 64 * (t >> 5); }
}
__device__ __forceinline__ void xitem_load(const XItem& x, int lane, float (&vv)[32], f32x4& k0v, f32x4& k1v) {
#pragma unroll
    for (int i = 0; i < 32; ++i) { const int kk = 2 * i + (lane >> 5); vv[i] = x.src[(size_t)(x.k0 + kk) * x.ldw + x.c0 + (lane & 31)]; }
    const f32x4* p = (const f32x4*)(x.ks + x.k0 + 8 * (lane & 7)); k0v = p[0]; k1v = p[1];
}
__device__ __forceinline__ void xitem_finish(const XItem& x, int lane, const float (&vv)[32], f32x4 k0v, f32x4 k1v, LAS float* scr) {
    if (!x.has_ks) { k0v = (f32x4){1.f, 1.f, 1.f, 1.f}; k1v = k0v; }
#pragma unroll
    for (int i = 0; i < 32; ++i) { const int kk = 2 * i + (lane >> 5); scr[kk * 33 + (lane & 31)] = vv[i]; }
    LDS_WAIT(); asm volatile("" ::: "memory");
    const int c = lane & 7;
#pragma unroll
    for (int j = 0; j < 4; ++j) { const int n = (lane >> 3) + 8 * j; const LAS float* s = scr + (8 * c) * 33 + n;
        u32x4 o; o.x = pk2(s[0 * 33] * k0v.x, s[1 * 33] * k0v.y); o.y = pk2(s[2 * 33] * k0v.z, s[3 * 33] * k0v.w); o.z = pk2(s[4 * 33] * k1v.x, s[5 * 33] * k1v.y); o.w = pk2(s[6 * 33] * k1v.z, s[7 * 33] * k1v.w);
        const int jc = x.c0 + n; const int drow = x.mode == 0 ? jc : (8 * (jc >> 2) + 4 * x.row_off + (jc & 3));
        *(u32x4*)(x.dst + (size_t)drow * x.ldt + x.k0 + 8 * c) = o; }
    LDS_WAIT(); asm volatile("" ::: "memory");
}
__device__ __forceinline__ void expert_copies(Frame& F, const Args& a, int e_lo, int e_hi) {
    LAS float* scr = (LAS float*)(F.lds + F.wave * 16384);
    const int gw = F.bx * NWAVES + F.wave, NGW = F.G * NWAVES, lane = F.lane;
    const int it_end = e_hi * 768;
    int it = e_lo * 768 + gw;
    if (it < it_end) {
        float va[32], vb[32]; f32x4 ka0, ka1, kb0, kb1; XItem xa, xb;
        xitem_decode(a, F.ws, it, xa); xitem_load(xa, lane, va, ka0, ka1);
        for (;;) {
            int itn = it + NGW; bool hn = itn < it_end;
            xitem_decode(a, F.ws, hn ? itn : it, xb); xitem_load(xb, lane, vb, kb0, kb1);
            xitem_finish(xa, lane, va, ka0, ka1, scr);
            if (!hn) break;
            it = itn; itn = it + NGW; hn = itn < it_end;
            xitem_decode(a, F.ws, hn ? itn : it, xa); xitem_load(xa, lane, va, ka0, ka1);
            xitem_finish(xb, lane, vb, kb0, kb1, scr);
            if (!hn) break;
            it = itn;
        }
    }
    __syncthreads();
}

__device__ __forceinline__ void moe_tiles(Frame& F) {
    __syncthreads();
    if (F.tid == 0) { unsigned accu = 0u; for (int e = 0; e < NEXP; ++e) { const unsigned c = __hip_atomic_load(F.ctl + CW_ECNT + 64 * e, __ATOMIC_RELAXED, __HIP_MEMORY_SCOPE_AGENT); F.MISC[16 + e] = accu; F.MISC[64 + e] = c; accu += (c + 255u) >> 8; } F.MISC[16 + NEXP] = accu; }
    __syncthreads();
}
template <int WHICH> struct SchedMoe {
    volatile LAS unsigned* MISC; unsigned char* ws; int G, c;
    __device__ __forceinline__ bool next(int i, GU& u) const {
        const int L = i * G + c; const int T = (int)MISC[16 + NEXP]; if (L >= 4 * T) return false;
        const int tau = L >> 2, pn = L & 3; int e = 0;
        for (int k = 1; k < NEXP; ++k) if ((int)MISC[16 + k] <= tau) e = k;
        const int lt = tau - (int)MISC[16 + e]; const int cnt = (int)MISC[64 + e]; int nv = cnt - lt * 256; nv = nv > 256 ? 256 : nv;
        u.rows = (const int*)(ws + WS_LISTS) + (size_t)e * NTOK + lt * 256; u.nvalid = nv; u.pm = tau; u.pn = pn; u.kind = 0; u.aux = e;
        if (WHICH == 0) { u.A = (const char*)ws + WS_X2B; u.B = (const char*)ws + WS_W13 + (size_t)e * D * D * 2 + (size_t)pn * 256 * D * 2; }
        else { u.A = (const char*)ws + WS_H1 + (size_t)tau * 256 * DEXP * 2; u.B = (const char*)ws + WS_W2 + (size_t)e * D * DEXP * 2 + (size_t)pn * 256 * DEXP * 2; }
        return true;
    }
};
struct EpiMoe1 {
    static constexpr bool PERM = true;
    const float* rstd2; bf16* H1;
    __device__ __forceinline__ void operator()(const f32x4 (&acc)[2][2][4][2], const GU& u, int wr, int wc, int fr, int fq) const {
        char* hb = (char*)H1 + (size_t)u.pm * 256 * DEXP * 2;
        const int j00 = (u.pn * 256 + 32 * wc + 8 * fq) >> 1;
#pragma unroll
        for (int ai = 0; ai < 2; ++ai) {
            int r = 128 * ai + 64 * wr + fr; LAUNDER(r);
#pragma unroll
            for (int m = 0; m < 4; ++m) { const bool ok = r < u.nvalid; const float rs = ok ? rstd2[u.rows[r] >> 1] : 0.f;
#pragma unroll
                for (int bj = 0; bj < 2; ++bj) { const f32x4 a1 = acc[ai][bj][m][0] * rs, a3 = acc[ai][bj][m][1] * rs; f32x4 hv;
#pragma unroll
                    for (int j = 0; j < 4; ++j) hv[j] = a1[j] * sigmoidf_(a1[j]) * a3[j];
                    u32x2 w; w.x = cvt_pk_bf16(hv[0], hv[1]); w.y = cvt_pk_bf16(hv[2], hv[3]); *(u32x2*)(hb + (unsigned)((r * DEXP + j00 + 64 * bj) * 2)) = w; }
                r += 16; LAUNDER(r); }
        }
    }
};
struct EpiMoe2 {
    static constexpr bool PERM = true;
    const float* wts; bf16* Y0; bf16* Y1;
    __device__ __forceinline__ void operator()(const f32x4 (&acc)[2][2][4][2], const GU& u, int wr, int wc, int fr, int fq) const {
#pragma unroll
        for (int ai = 0; ai < 2; ++ai)
#pragma unroll
            for (int m = 0; m < 4; ++m) { const int r = 128 * ai + 64 * wr + 16 * m + fr;
                if (r < u.nvalid) { const int ent = u.rows[r]; const float w8 = wts[ent]; bf16* dst = ((ent & 1) ? Y1 : Y0) + (size_t)(ent >> 1) * D + u.pn * 256 + 32 * wc + 8 * fq;
#pragma unroll
                    for (int bj = 0; bj < 2; ++bj) { const f32x4 v0 = acc[ai][bj][m][0] * w8, v1 = acc[ai][bj][m][1] * w8;
                        u32x4 w; w.x = cvt_pk_bf16(v0[0], v0[1]); w.y = cvt_pk_bf16(v0[2], v0[3]); w.z = cvt_pk_bf16(v1[0], v1[1]); w.w = cvt_pk_bf16(v1[2], v1[3]);
                        *(u32x4*)(dst + 128 * bj) = w; } } }
    }
};

__device__ __forceinline__ void p12_final(Frame& F, const Args& a) {
    const bf16* Y0 = (const bf16*)(F.ws + WS_YS0); const bf16* Y1 = (const bf16*)(F.ws + WS_YS1); const float* g = a.in[IN_NORM_F_G];
    const int gw = F.bx * NWAVES + F.wave, NGW = F.G * NWAVES, lane = F.lane;
    for (int tok = gw; tok < NTOK; tok += NGW) {
        f32x4* xr = (f32x4*)(a.out + (size_t)tok * D) + lane; const u32x2* y0 = (const u32x2*)(Y0 + (size_t)tok * D) + lane; const u32x2* y1 = (const u32x2*)(Y1 + (size_t)tok * D) + lane;
        f32x4 v[4]; float s = 0.f;
#pragma unroll
        for (int j = 0; j < 4; ++j) { v[j] = xr[64 * j]; const u32x2 p = y0[64 * j], q = y1[64 * j];
            v[j].x += lo16(p.x) + lo16(q.x); v[j].y += hi16(p.x) + hi16(q.x); v[j].z += lo16(p.y) + lo16(q.y); v[j].w += hi16(p.y) + hi16(q.y);
            s += (v[j].x * v[j].x + v[j].y * v[j].y) + (v[j].z * v[j].z + v[j].w * v[j].w); }
        const float rstd = 1.0f / sqrtf(wave_sum(s) * (1.f / D) + EPS);
#pragma unroll
        for (int j = 0; j < 4; ++j) { const f32x4 gg = ((const f32x4*)g + lane)[64 * j]; xr[64 * j] = v[j] * rstd * gg; }
    }
}

constexpr int N_PHASES = 14;
__global__ void __launch_bounds__(NTHREADS, 2) fwd(Args args) {
    extern __shared__ __attribute__((aligned(16))) unsigned char lds[];
    Frame F;
    F.lds = (LAS unsigned char*)lds; F.MISC = (volatile LAS unsigned*)(F.lds + MISC_OFF);
    F.tid = threadIdx.x; F.lane = F.tid & 63; F.wave = __builtin_amdgcn_readfirstlane(F.tid >> 6); F.G = gridDim.x; F.bx = blockIdx.x;
    F.ws = args.ws; F.ctl = (unsigned*)(args.ws + WS_CTL);
    unsigned char* ws = args.ws;
    for (int u = F.tid; u < (LDS_BYTES - RING_BYTES) / 4; u += NTHREADS) ((LAS unsigned*)(F.lds + RING_BYTES))[u] = 0u;
    __syncthreads();
    const int lo = args.ph_lo, hi = args.ph_hi;
    const bool one = (hi - lo) > 1;
    XcdBarrier bar; bar.bar = F.ctl + CW_BAR; bar.x = 0; bar.st = F.MISC + 8;
    if (one) bar = xcd_barrier_post(F.ctl + CW_BAR, F.MISC + 8);
#define IN(k) (lo <= (k) && (k) < hi && phase_begin(F))
#define SEAM(k) do { if (lo <= (k) && (k) + 1 < hi) xcd_barrier(bar); } while (0)

    if (IN(0)) { p0_prologue(F, args); } SEAM(0);
    if (IN(1)) {
        SchedP1 S{ws, F.G, F.bx};
        EpiP1 E{ws};
        pg8::gemm_phase<EpiP1, SchedP1, false>(F.lds, D, D, D, S, E);
        p1_gate_logits(F);
    } SEAM(1);
    if (IN(2)) {
        p2_retention_fast(F, F.bx, (bf16*)(ws + WS_RV));
        { const int w0 = F.bx * NWAVES + F.wave, nw = F.G * NWAVES;
            transpose_kv_tiles(F, (const bf16*)(ws + WS_KV6 + 3 * KV_STRIDE), (bf16*)args.out, w0, nw);
            transpose_kv_tiles(F, (const bf16*)(ws + WS_KV6 + 5 * KV_STRIDE), (bf16*)((unsigned char*)args.out + KV_STRIDE), w0, nw);
            transpose_memv_tiles(F, (bf16*)(ws + WS_MEMVT), w0, nw); }
        __syncthreads();
        { SchedCmp S{ws, 0, F.G, F.bx}; EpiCmp E{(float*)args.out + (size_t)16 * MiB};
            pg8::gemm_phase<EpiCmp, SchedCmp, false>(F.lds, 512, 2048, 4096, S, E); }
    } SEAM(2);
    if (IN(3)) { p2b_compress_out(F, args); } SEAM(3);
    if (IN(4)) { p3_ret_normalize(F); p3_nsa_fast(F, (const bf16*)args.out, (const bf16*)((const unsigned char*)args.out + KV_STRIDE), (bf16*)(ws + WS_NQ)); } SEAM(4);
    if (IN(5)) {
        SchedP4 S{ws, F.G, F.bx};
        EpiP4 E{(float*)(ws + WS_P4SCR) + (size_t)F.bx * (2 * 32 * 512 * 4), (bf16*)(ws + WS_Y)};
        pg8::gemm_phase<EpiP4, SchedP4, false>(F.lds, D, D, D, S, E);
    } SEAM(5);
    if (IN(6)) {
        SchedMN S{ws, WS_Y, W_OUT, F.G, F.bx}; EpiRes<true> E{args.in[IN_X], nullptr, nullptr, (bf16*)(ws + WS_X1B), (float*)(ws + WS_SSQ)};
        pg8::gemm_phase<EpiRes<true>, SchedMN, false>(F.lds, D, D, D, S, E);
    } SEAM(6);
    if (IN(7)) {
        const bool early = ((F.bx >> 3) & 1) == 0;
        if (early) expert_copies(F, args, 0, NEXP / 2);
        SchedMN S{ws, WS_X1B, W_XQ, F.G, F.bx}; EpiQ E{(const float*)(ws + WS_SSQ), (bf16*)(ws + WS_NQ)};
        pg8::gemm_phase<EpiQ, SchedMN, false>(F.lds, D, D, D, S, E);
        if (!early) { __syncthreads(); expert_copies(F, args, 0, NEXP / 2); }
    } SEAM(7);
    if (IN(8)) { p7_xattn_fast(F, (const bf16*)(ws + WS_MEMVT), (bf16*)(ws + WS_NQ)); } SEAM(8);
    if (IN(9)) {
        const bool early = ((F.bx >> 3) & 1) == 0;
        if (early) expert_copies(F, args, NEXP / 2, NEXP);
        SchedMN S{ws, WS_NQ, W_XO, F.G, F.bx}; EpiRes<false> E{nullptr, (const bf16*)(ws + WS_X1B), args.out, (bf16*)(ws + WS_X2B), nullptr};
        pg8::gemm_phase<EpiRes<false>, SchedMN, false>(F.lds, D, D, D, S, E);
        if (!early) { __syncthreads(); expert_copies(F, args, NEXP / 2, NEXP); }
    } SEAM(9);
    if (IN(10)) { p9_route(F, args); } SEAM(10);
    if (IN(11)) {
        moe_tiles(F);
        SchedMoe<0> S{F.MISC, ws, F.G, F.bx}; EpiMoe1 E{(const float*)(ws + WS_ROUTE) + 2 * NTOK, (bf16*)(ws + WS_H1)};
        pg8::gemm_phase<EpiMoe1, SchedMoe<0>, true>(F.lds, D, D, D, S, E);
    } SEAM(11);
    if (IN(12)) {
        moe_tiles(F);
        SchedMoe<1> S{F.MISC, ws, F.G, F.bx}; EpiMoe2 E{(const float*)(ws + WS_ROUTE), (bf16*)(ws + WS_YS0), (bf16*)(ws + WS_YS1)};
        pg8::gemm_phase<EpiMoe2, SchedMoe<1>, false>(F.lds, DEXP, DEXP, DEXP, S, E);
    } SEAM(12);
    if (IN(13)) { p12_final(F, args); }
#undef IN
#undef SEAM
}

extern "C" void kernel_launch(void* const* d_in, const int* in_sizes, int n_in, void* d_out, int out_size, void* d_ws, size_t ws_size, hipStream_t stream) {
    static int grid = 0;
    if (grid == 0) {
        if (n_in != 27 || in_sizes[0] != NTOK * D || out_size != NTOK * D || ws_size < WS_END) {
            fprintf(stderr, "kernel_launch: unexpected shapes: n_in %d in0 %d out %d ws %zu (need %zu)\n", n_in, n_in > 0 ? in_sizes[0] : -1, out_size, ws_size, (size_t)WS_END); grid = -1; return; }
        int dev = 0, cus = 0, per_cu = 0;
        if (hipGetDevice(&dev) != hipSuccess || hipDeviceGetAttribute(&cus, hipDeviceAttributeMultiprocessorCount, dev) != hipSuccess) { grid = -1; return; }
        if (hipFuncSetAttribute((const void*)fwd, hipFuncAttributeMaxDynamicSharedMemorySize, LDS_BYTES) != hipSuccess) { fprintf(stderr, "kernel_launch: hipFuncSetAttribute failed\n"); grid = -1; return; }
        if (hipOccupancyMaxActiveBlocksPerMultiprocessor(&per_cu, (const void*)fwd, NTHREADS, LDS_BYTES) != hipSuccess || per_cu < 1) fprintf(stderr, "kernel_launch: occupancy query reports %d\n", per_cu);
        (void)hipGetLastError();
        grid = cus < 256 ? cus : 256;
    }
    if (grid < 0) return;
    (void)hipMemsetAsync((char*)d_ws + WS_CTL, 0, CTL_ZERO_BYTES, stream);
    Args a{};
    for (int i = 0; i < 27; ++i) a.in[i] = (const float*)d_in[i];
    a.out = (float*)d_out; a.ws = (unsigned char*)d_ws;
#if MK_N_LAUNCHES == 1
    a.ph_lo = 0; a.ph_hi = N_PHASES;
    hipLaunchKernelGGL(fwd, dim3(grid), dim3(NTHREADS), LDS_BYTES, stream, a);
#else
    for (int p = 0; p < N_PHASES; ++p) { a.ph_lo = p; a.ph_hi = p + 1; hipLaunchKernelGGL(fwd, dim3(grid), dim3(NTHREADS), LDS_BYTES, stream, a); }
#endif
}
```

```cpp
#include <hip/hip_runtime.h>
#include <cstdio>
#include <cstdint>

#ifndef MK_N_LAUNCHES
#define MK_N_LAUNCHES 1
#endif

#define LAS __attribute__((address_space(3)))
#define GAS __attribute__((address_space(1)))
#define HD __host__ __device__
#define HDI __host__ __device__ __attribute__((always_inline)) inline
typedef unsigned short bf16;
typedef short bf16x8 __attribute__((ext_vector_type(8)));
typedef float f32x4 __attribute__((ext_vector_type(4)));
typedef float f32x2 __attribute__((ext_vector_type(2)));
typedef float f32x16 __attribute__((ext_vector_type(16)));
typedef unsigned u32x4 __attribute__((ext_vector_type(4)));
typedef unsigned u32x2 __attribute__((ext_vector_type(2)));

constexpr int D = 1024, BATCH = 8, SEQ = 4096, NTOK = BATCH * SEQ, NMEM = 256, NMEMTOK = BATCH * NMEM;
constexpr int DIN = 7704;
constexpr int C_RQ = 0, C_RK = 512, C_RV = 1024, C_RG = 2048, C_NQ = 3072, C_CK = 4096, C_NGL = 5632, C_GA = 5656, C_GB = 6680;
constexpr int NPROJ = 5632;
constexpr int NEXP = 32, DEXP = 512;
constexpr float EPS = 1e-6f;
constexpr int NWAVES = 8, NTHREADS = 512;

constexpr size_t MiB = 1u << 20;
constexpr size_t WS_CTL = 0, CTL_ZERO_BYTES = 1 * MiB;
constexpr size_t WS_ROPE_COS = 1 * MiB, WS_ROPE_SIN = 2 * MiB;
constexpr size_t WS_SMALLW = 3 * MiB;
constexpr size_t WS_MEMVT = 24 * MiB;
constexpr size_t WS_KCMP = 4 * MiB, WS_VCMP = 5 * MiB, WS_VCMPT = 35 * MiB;
constexpr size_t WS_GATES = 10 * MiB;
constexpr size_t WS_SSQ = 13 * MiB;
constexpr size_t WS_ROUTE = 15 * MiB;
constexpr size_t WS_LISTS = 16 * MiB;
constexpr size_t WS_W = 36 * MiB;
constexpr size_t W_IN = WS_W;
constexpr size_t W_GA = W_IN + 11 * MiB, W_GB = W_GA + 2 * MiB;
constexpr size_t W_RO = W_GB + 2 * MiB, W_NO = W_RO + 2 * MiB, W_OUT = W_NO + 2 * MiB, W_XQ = W_OUT + 2 * MiB, W_XO = W_XQ + 2 * MiB;
constexpr size_t W_XKV = W_XO + 2 * MiB;
constexpr size_t W_C1K = W_XKV + 4 * MiB, W_C1V = W_C1K + 2 * MiB;
constexpr size_t WS_MEMN = W_C1V + 2 * MiB;
constexpr size_t WS_MEMKV = WS_MEMN + 4 * MiB;
constexpr size_t WS_H = 84 * MiB;
constexpr size_t WS_NQ = WS_H + 64 * MiB;
constexpr size_t WS_RV = WS_NQ + 64 * MiB;
constexpr size_t WS_RQ = WS_RV + 64 * MiB;
constexpr size_t WS_RK = WS_RQ + 32 * MiB;
constexpr size_t WS_RG = WS_RK + 32 * MiB;
constexpr size_t WS_KV6 = WS_RG + 64 * MiB;
constexpr size_t KV_STRIDE = 16 * MiB;
constexpr size_t WS_END = WS_KV6 + 96 * MiB;
constexpr size_t WS_Y = WS_RQ, WS_P4SCR = WS_RG, WS_W13 = WS_RQ, WS_W2 = WS_RG, WS_H1 = WS_KV6, WS_X1B = WS_H, WS_X2B = WS_RV, WS_YS0 = WS_H, WS_YS1 = WS_NQ;
static_assert(WS_MEMKV + 8 * MiB <= WS_H && WS_VCMPT + 1 * MiB <= WS_W && WS_MEMVT + 4 * MiB <= WS_VCMPT, "ws map");
constexpr int CW_BAR = 4096;
constexpr int CW_ECNT = 16384;
constexpr int LDS_BYTES = 147456, RING_BYTES = 131072, MISC_OFF = RING_BYTES + 320;

HD inline float bf2f(bf16 b) { return __builtin_bit_cast(float, (unsigned)b << 16); }
HD inline unsigned f2bf(float f) { unsigned u = __builtin_bit_cast(unsigned, f); return (u + 0x7fffu + ((u >> 16) & 1u)) >> 16; }
HD inline unsigned pk2(float lo, float hi) { return f2bf(lo) | (f2bf(hi) << 16); }
HD inline float lo16(unsigned w) { return __builtin_bit_cast(float, w << 16); }
HD inline float hi16(unsigned w) { return __builtin_bit_cast(float, w & 0xffff0000u); }
__device__ __forceinline__ unsigned cvt_pk_bf16(float lo, float hi) { unsigned r; asm volatile("v_cvt_pk_bf16_f32 %0, %1, %2" : "=v"(r) : "v"(lo), "v"(hi)); return r; }
#define DPP_F(v, ctrl, rmask) __builtin_bit_cast(float, __builtin_amdgcn_update_dpp(0, __builtin_bit_cast(int, v), ctrl, rmask, 0xf, false))
__device__ __forceinline__ float wave_sum(float v) {
    v += DPP_F(v, 0xB1, 0xf);
    v += DPP_F(v, 0x4E, 0xf);
    v += DPP_F(v, 0x141, 0xf);
    v += DPP_F(v, 0x140, 0xf);
    v += DPP_F(v, 0x142, 0xa);
    v += DPP_F(v, 0x143, 0xc);
    return __builtin_bit_cast(float, __builtin_amdgcn_readlane(__builtin_bit_cast(int, v), 63));
}
__device__ __forceinline__ float wave_max(float v) {
#pragma unroll
    for (int o = 1; o < 64; o <<= 1) v = fmaxf(v, __shfl_xor(v, o));
    return v;
}
__device__ __forceinline__ float sigmoidf_(float x) { return __builtin_amdgcn_rcpf(1.0f + __builtin_amdgcn_exp2f(-1.4426950408889634f * x)); }
#define LAUNDER(p) asm volatile("" : "+v"(p))
#define LDS_WAIT() asm volatile("s_waitcnt lgkmcnt(0)" ::: "memory")
#define VM_WAIT() asm volatile("s_waitcnt vmcnt(0)" ::: "memory")

#define XB_TMO      128
#define XB_XCNT(j)  (256  + 64 * (j))
#define XB_XSUB(j)  (1280 + 64 * (j))
#define XB_XGEN(j)  (2304 + 64 * (j))
#define XB_TOP      3328
#define XB_TOPGEN   3392
#define XCD_BAR_WORDS 3456
#define XB_SPIN_CAP (1u << 24)
__device__ __forceinline__ unsigned xb_ld(unsigned* p)              { return __hip_atomic_load(p, __ATOMIC_RELAXED, __HIP_MEMORY_SCOPE_AGENT); }
__device__ __forceinline__ unsigned xb_add(unsigned* p, unsigned v) { return __hip_atomic_fetch_add(p, v, __ATOMIC_RELAXED, __HIP_MEMORY_SCOPE_AGENT); }
__device__ __forceinline__ unsigned xb_xcc_id() { return (unsigned)__builtin_amdgcn_s_getreg((3 << 11) | 20) & 0xFu; }
#define XB_SPIN(cond, bar) do { unsigned _sp = 0; while (cond) { __builtin_amdgcn_s_sleep(1); \
    if ((++_sp & 255u) == 0u) { if (xb_ld(&(bar)[XB_TMO])) break; if (_sp > XB_SPIN_CAP) { atomicAdd(&(bar)[XB_TMO], 1u); break; } } } } while (0)
struct XcdBarrier { unsigned* bar; unsigned x; volatile LAS unsigned* st; };
__device__ __forceinline__ XcdBarrier xcd_barrier_post(unsigned* bar, volatile LAS unsigned* st) {
    XcdBarrier b; b.bar = bar; b.x = xb_xcc_id(); b.st = st;
    if (threadIdx.x == 0) (void)xb_add(&bar[XB_XCNT(b.x)], 1u);
    return b;
}
__device__ __forceinline__ void xcd_barrier_complete(unsigned* bar, unsigned x, unsigned& nloc, unsigned& nx) {
    const unsigned G = gridDim.x * gridDim.y * gridDim.z;
    unsigned sum, cnt, mine, sp = 0u;
    for (;;) {
        sum = 0u; cnt = 0u; mine = 0u;
#pragma unroll
        for (unsigned j = 0; j < 16; ++j) { const unsigned c = xb_ld(&bar[XB_XCNT(j)]); sum += c; cnt += (c > 0u) ? 1u : 0u; mine = (j == x) ? c : mine; }
        if (sum == G) break;
        __builtin_amdgcn_s_sleep(1);
        if ((++sp & 255u) == 0u) { if (xb_ld(&bar[XB_TMO])) break; if (sp > XB_SPIN_CAP) { atomicAdd(&bar[XB_TMO], 1u); break; } }
    }
    nloc = mine > 0u ? mine : 1u; nx = cnt > 0u ? cnt : 1u;
}
__device__ __forceinline__ void xcd_barrier(const XcdBarrier& b) {
    asm volatile("s_waitcnt vmcnt(0)" ::: "memory");
    __syncthreads();
    if (threadIdx.x == 0) {
        unsigned* bar = b.bar;
        __builtin_amdgcn_s_waitcnt(0);
        unsigned nloc = b.st[0], nx = b.st[1];
        if (nloc == 0u) { xcd_barrier_complete(bar, b.x, nloc, nx); b.st[0] = nloc; b.st[1] = nx; }
        const unsigned old = xb_add(&bar[XB_XSUB(b.x)], 1u);
        const unsigned gen = old / nloc;
        if (old + 1u == (gen + 1u) * nloc) {
            __builtin_amdgcn_fence(__ATOMIC_RELEASE, "agent");
            asm volatile("s_waitcnt vmcnt(0)" ::: "memory");
            const unsigned og = xb_add(&bar[XB_TOP], 1u);
            const unsigned tg = og / nx;
            if (og + 1u == (tg + 1u) * nx) xb_add(&bar[XB_TOPGEN], 1u);
            else XB_SPIN(xb_ld(&bar[XB_TOPGEN]) == tg, bar);
            __builtin_amdgcn_fence(__ATOMIC_ACQUIRE, "agent");
            xb_add(&bar[XB_XGEN(b.x)], 1u);
            asm volatile("s_waitcnt vmcnt(0)" ::: "memory");
        } else {
            XB_SPIN(xb_ld(&bar[XB_XGEN(b.x)]) == gen, bar);
            __builtin_amdgcn_fence(__ATOMIC_ACQUIRE, "agent");
            asm volatile("s_waitcnt vmcnt(0)" ::: "memory");
        }
    }
    __syncthreads();
}

namespace pg8 {
constexpr int BM = 256, BK = 64, HALF = 128, HTB = HALF * BK * 2, NXCD = 8, WGM = 8;
HD __forceinline__ int lds_byte(int r, int c) { const int st = (r >> 4) * 2 + (c >> 5), rr = r & 15, cc = c & 31, ob = rr * 64 + cc * 2; return st * 1024 + (ob ^ (((ob >> 9) & 1) << 5)); }
HD __forceinline__ void stage_rc(int b, int& R, int& C) { const int st = b / 1024, sb = b % 1024, swz = sb ^ (((sb >> 9) & 1) << 5); R = (st >> 1) * 16 + swz / 64; C = (st & 1) * 32 + (swz % 64) / 2; }
HD __forceinline__ int perm32(int rho) { const int n = rho >> 4, i = rho & 15; return 8 * (i >> 2) + 4 * n + (i & 3); }
HD __forceinline__ void tile_map(int L, int nM, int nN, int& pm, int& pn) {
    const int nwg = nM * nN; int wgid = L; { const int q = nwg / NXCD, r = nwg % NXCD, xcd = wgid % NXCD, off = wgid / NXCD; wgid = (xcd < r ? xcd * (q + 1) : r * (q + 1) + (xcd - r) * q) + off; }
    const int nig = WGM * nN, gid = wgid / nig, fm = gid * WGM, gsz = (nM - fm) < WGM ? (nM - fm) : WGM;
    pm = fm + ((wgid % nig) % gsz); pn = (wgid % nig) / gsz;
}
struct GU { const char* A; const char* B; const int* rows; int nvalid; int kind, pm, pn, aux; };
template <class Epi, class Sched, bool GATHER>
__device__ __forceinline__ void gemm_phase(LAS unsigned char* lds, const int K, const int lda, const int ldb, const Sched& S, const Epi& E) {
    int tid_ = threadIdx.x; LAUNDER(tid_);
    const int tid = tid_, wid = __builtin_amdgcn_readfirstlane(tid >> 6), lane = tid & 63, wr = wid >> 2, wc = wid & 3, fr = lane & 15, fq = lane >> 4;
    const int nt = K / BK;
    unsigned voffB[2];
#pragma unroll
    for (int i = 0; i < 2; ++i) { int R, C; stage_rc(tid * 16 + i * 8192, R, C); const int Rb = Epi::PERM ? ((R & ~31) + perm32(R & 31)) : R; voffB[i] = (unsigned)(Rb * ldb + C) * 2u; }
    const size_t kstep = (size_t)(BK * 2);
    const size_t hstepB = (size_t)HALF * ldb * 2;
    const unsigned ldsw = (unsigned)wid * 1024u;
    const int aoff = lds_byte(wr * 64 + fr, fq * 8), boff = lds_byte(wc * 32 + fr, fq * 8);
#define PG8_SA(b, h) (((b) * 2 + (h)) * HTB)
#define PG8_SB(b, h) ((4 + (b) * 2 + (h)) * HTB)
#define PG8_STAGE2(bufoff, gbase, v0, v1) do { \
        __builtin_amdgcn_global_load_lds((const unsigned*)((const char*)(gbase) + (v0)), (LAS unsigned*)(lds + (bufoff) + ldsw), 16, 0, 0); \
        __builtin_amdgcn_global_load_lds((const unsigned*)((const char*)(gbase) + (v1)), (LAS unsigned*)(lds + (bufoff) + ldsw + 8192), 16, 0, 0); } while (0)
#define PG8_STAGEB(bufoff, gbase) PG8_STAGE2(bufoff, gbase, voffB[0], voffB[1])
#define PG8_LDA(dst, b, h) do { _Pragma("unroll") for (int m = 0; m < 4; ++m) _Pragma("unroll") for (int k = 0; k < 2; ++k) dst[m][k] = *(const LAS bf16x8*)(lds + PG8_SA(b, h) + aoff + m * 2048 + k * 1024); } while (0)
#define PG8_LDB(dst, b, h) do { _Pragma("unroll") for (int n = 0; n < 2; ++n) _Pragma("unroll") for (int k = 0; k < 2; ++k) dst[n][k] = *(const LAS bf16x8*)(lds + PG8_SB(b, h) + boff + n * 2048 + k * 1024); } while (0)
#define PG8_MMA(ai, bj, At, Bt) do { __builtin_amdgcn_s_setprio(1); _Pragma("unroll") for (int m = 0; m < 4; ++m) _Pragma("unroll") for (int n = 0; n < 2; ++n) _Pragma("unroll") for (int k = 0; k < 2; ++k) \
        acc[ai][bj][m][n] = __builtin_amdgcn_mfma_f32_16x16x32_bf16(Bt[n][k], At[m][k], acc[ai][bj][m][n], 0, 0, 0); __builtin_amdgcn_s_setprio(0); } while (0)
#define PG8_WAIT_V(n) asm volatile("s_waitcnt vmcnt(" #n ")" ::: "memory")
#define PG8_WAIT_L(n) asm volatile("s_waitcnt lgkmcnt(" #n ")" ::: "memory")
#define PG8_BAR __builtin_amdgcn_s_barrier()
#define PG8_SCHED __builtin_amdgcn_sched_barrier(0)
#define PG8_VOFFA(u, vo) do { _Pragma("unroll") for (int h = 0; h < 2; ++h) _Pragma("unroll") for (int i = 0; i < 2; ++i) { int R_, C_; stage_rc(tid * 16 + i * 8192, R_, C_); const int R = R_ + HALF * h; \
        int ridx = R; if (GATHER) { ridx = (R < (u).nvalid) ? ((u).rows[R] >> 1) : 0; } vo[h][i] = (unsigned)(ridx * lda + C_) * 2u; } if (GATHER) asm volatile("" :: "v"(vo[0][0]), "v"(vo[0][1]), "v"(vo[1][0]), "v"(vo[1][1])); } while (0)
    GU cur, nxt; int ui = 0;
    if (!S.next(0, cur)) return;
    f32x4 acc[2][2][4][2];
#pragma unroll
    for (int a = 0; a < 2; ++a)
#pragma unroll
        for (int b = 0; b < 2; ++b)
#pragma unroll
            for (int m = 0; m < 4; ++m)
#pragma unroll
                for (int n = 0; n < 2; ++n) acc[a][b][m][n] = (f32x4){0.f, 0.f, 0.f, 0.f};
    bf16x8 At[4][2], B0[2][2], B1[2][2];
    unsigned cv[2][2], nv[2][2];
    PG8_VOFFA(cur, cv);
    const char* cA = cur.A; const char* cB = cur.B;
    PG8_STAGEB(PG8_SB(0, 0), cB); PG8_STAGEB(PG8_SB(0, 1), cB + hstepB); PG8_STAGE2(PG8_SA(0, 0), cA, cv[0][0], cv[0][1]); PG8_STAGE2(PG8_SA(0, 1), cA, cv[1][0], cv[1][1]);
    if (wr == 1) PG8_BAR;
    PG8_WAIT_V(2); PG8_BAR;
    PG8_STAGEB(PG8_SB(1, 0), cB + kstep); PG8_STAGE2(PG8_SA(1, 0), cA + kstep, cv[0][0], cv[0][1]); PG8_STAGEB(PG8_SB(1, 1), cB + hstepB + kstep);
    PG8_WAIT_V(6); PG8_BAR;
    for (;;) {
        const bool has_next = S.next(ui + 1, nxt);
        const char* nA = has_next ? nxt.A : cA; const char* nB = has_next ? nxt.B : cB;
        if (has_next) { PG8_VOFFA(nxt, nv); } else {
#pragma unroll
            for (int h = 0; h < 2; ++h)
#pragma unroll
                for (int i = 0; i < 2; ++i) nv[h][i] = cv[h][i]; }
        for (int t = 0; t < nt; t += 2) {
            const bool last = (t == nt - 2);
            const char* a1 = cA + (size_t)(t + 1) * kstep;
            const char* a2 = last ? nA : cA + (size_t)(t + 2) * kstep; const char* b2 = last ? nB : cB + (size_t)(t + 2) * kstep;
            const char* a3 = a2 + kstep; const char* b3 = b2 + kstep;
            const unsigned w00 = last ? nv[0][0] : cv[0][0], w01 = last ? nv[0][1] : cv[0][1], w10 = last ? nv[1][0] : cv[1][0], w11 = last ? nv[1][1] : cv[1][1];
            PG8_LDB(B0, 0, 0); PG8_LDB(B1, 0, 1); PG8_SCHED; PG8_LDA(At, 0, 0); PG8_STAGE2(PG8_SA(1, 1), a1, cv[1][0], cv[1][1]);
            PG8_WAIT_V(8); PG8_WAIT_L(0); PG8_BAR; PG8_MMA(0, 0, At, B0); PG8_MMA(0, 1, At, B1); PG8_BAR; PG8_SCHED;
            PG8_LDA(At, 0, 1); PG8_STAGEB(PG8_SB(0, 0), b2); PG8_STAGEB(PG8_SB(0, 1), b2 + hstepB); PG8_STAGE2(PG8_SA(0, 0), a2, w00, w01);
            PG8_WAIT_V(8); PG8_WAIT_L(0); PG8_BAR; PG8_MMA(1, 0, At, B0); PG8_MMA(1, 1, At, B1); PG8_BAR; PG8_SCHED;
            PG8_LDB(B0, 1, 0); PG8_LDB(B1, 1, 1); PG8_SCHED; PG8_LDA(At, 1, 0); PG8_STAGE2(PG8_SA(0, 1), a2, w10, w11);
            PG8_WAIT_V(8); PG8_WAIT_L(0); PG8_BAR; PG8_MMA(0, 0, At, B0); PG8_MMA(0, 1, At, B1); PG8_BAR; PG8_SCHED;
            PG8_LDA(At, 1, 1); PG8_STAGEB(PG8_SB(1, 0), b3); PG8_STAGEB(PG8_SB(1, 1), b3 + hstepB); PG8_STAGE2(PG8_SA(1, 0), a3, w00, w01);
            PG8_WAIT_V(8); PG8_WAIT_L(0); PG8_BAR; PG8_MMA(1, 0, At, B0); PG8_MMA(1, 1, At, B1); PG8_BAR; PG8_SCHED;
        }
        if (wr == 0) PG8_BAR;
        E(acc, cur, wr, wc, fr, fq);
        if (!has_next) break;
#pragma unroll
        for (int a = 0; a < 2; ++a)
#pragma unroll
            for (int b = 0; b < 2; ++b)
#pragma unroll
                for (int m = 0; m < 4; ++m)
#pragma unroll
                    for (int n = 0; n < 2; ++n) acc[a][b][m][n] = (f32x4){0.f, 0.f, 0.f, 0.f};
        cur = nxt; cA = nA; cB = nB; ++ui;
#pragma unroll
        for (int h = 0; h < 2; ++h)
#pragma unroll
            for (int i = 0; i < 2; ++i) cv[h][i] = nv[h][i];
        if (wr == 1) PG8_BAR;
    }
    PG8_WAIT_V(0);
    PG8_BAR;
#undef PG8_SA
#undef PG8_SB
#undef PG8_STAGE2
#undef PG8_STAGEB
#undef PG8_LDA
#undef PG8_LDB
#undef PG8_MMA
#undef PG8_WAIT_V
#undef PG8_WAIT_L
#undef PG8_BAR
#undef PG8_SCHED
#undef PG8_VOFFA
}
}
using pg8::GU;

struct Args {
    const float* in[27]; float* out; unsigned char* ws; int ph_lo, ph_hi; int pad0, pad1;
};
enum { IN_X = 0, IN_MEM, IN_NORM_MIX_G, IN_W_IN, IN_W_RET_O, IN_W_NSA_O, IN_W_OUT, IN_CMP_PE_K, IN_CMP_W1_K, IN_CMP_W2_K, IN_CMP_PE_V, IN_CMP_W1_V, IN_CMP_W2_V,
       IN_NORM_X_G, IN_NORM_MEM_G, IN_W_XQ, IN_W_XKV, IN_W_XO, IN_NORM_FFN_G, IN_W_GRP, IN_B_GRP, IN_W_RT, IN_B_RT, IN_W_E1, IN_W_E3, IN_W_E2, IN_NORM_F_G };
struct Frame {
    LAS unsigned char* lds; volatile LAS unsigned* MISC; unsigned* ctl; unsigned char* ws;
    int tid, lane, wave, G, bx;
};

__device__ __forceinline__ bool phase_begin(Frame& F) { int t = threadIdx.x; LAUNDER(t); F.tid = t; F.lane = t & 63; return true; }
__device__ __forceinline__ void transpose_item(const float* W, int ldw, int c0, int k0, bf16* WT, int ldt, int mode, int row_off, int cbase, const float* kscale, float scale, LAS float* scr, int lane) {
    float vv[32];
#pragma unroll
    for (int i = 0; i < 32; ++i) { const int kk = 2 * i + (lane >> 5); vv[i] = W[(size_t)(k0 + kk) * ldw + c0 + (lane & 31)]; }
    if (kscale) {
#pragma unroll
        for (int i = 0; i < 32; ++i) { const int kk = 2 * i + (lane >> 5); vv[i] *= kscale[k0 + kk]; } }
#pragma unroll
    for (int i = 0; i < 32; ++i) { const int kk = 2 * i + (lane >> 5); scr[kk * 33 + (lane & 31)] = vv[i] * scale; }
    LDS_WAIT(); asm volatile("" ::: "memory");
    const int c = lane & 7;
#pragma unroll
    for (int j = 0; j < 4; ++j) { const int n = (lane >> 3) + 8 * j; const LAS float* s = scr + (8 * c) * 33 + n;
        u32x4 o; o.x = pk2(s[0 * 33], s[1 * 33]); o.y = pk2(s[2 * 33], s[3 * 33]); o.z = pk2(s[4 * 33], s[5 * 33]); o.w = pk2(s[6 * 33], s[7 * 33]);
        const int jc = c0 - cbase + n; const int drow = mode == 0 ? row_off + jc : (8 * (jc >> 2) + 4 * row_off + (jc & 3));
        *(u32x4*)(WT + (size_t)drow * ldt + k0 + 8 * c) = o; }
    LDS_WAIT(); asm volatile("" ::: "memory");
}
__device__ __forceinline__ void transpose_matrix(Frame& F, int& item_base, const float* W, int ldw, int K, int cbase, int ncols, bf16* WT, int ldt, int mode, int row_off, const float* kscale, float scale) {
    LAS float* scr = (LAS float*)(F.lds + F.wave * 16384);
    const int gw = F.bx * NWAVES + F.wave, NGW = F.G * NWAVES;
    const int nb = ncols / 32, nitems = (K / 64) * nb;
    int it = (gw - item_base % NGW + NGW) % NGW;
    for (; it < nitems; it += NGW) transpose_item(W, ldw, cbase + 32 * (it % nb), 64 * (it / nb), WT, ldt, mode, row_off, cbase, kscale, scale, scr, F.lane);
    item_base += nitems;
}
__device__ __forceinline__ void rms_row_to_bf16(int lane, const float* xrow, const float* g, bf16* orow) {
    const f32x4* xr = (const f32x4*)xrow + lane; const f32x4* gr = (const f32x4*)g + lane;
    f32x4 v[4]; float s = 0.f;
#pragma unroll
    for (int j = 0; j < 4; ++j) { v[j] = xr[64 * j]; s += (v[j].x * v[j].x + v[j].y * v[j].y) + (v[j].z * v[j].z + v[j].w * v[j].w); }
    const float rstd = 1.0f / sqrtf(wave_sum(s) * (1.f / D) + EPS);
    unsigned long long* o8 = (unsigned long long*)orow + lane;
#pragma unroll
    for (int j = 0; j < 4; ++j) { const f32x4 gg = gr[64 * j];
        o8[64 * j] = (unsigned long long)pk2(v[j].x * rstd * gg.x, v[j].y * rstd * gg.y) | ((unsigned long long)pk2(v[j].z * rstd * gg.z, v[j].w * rstd * gg.w) << 32); }
}

__device__ __forceinline__ void p0_prologue(Frame& F, const Args& a) {
    unsigned char* ws = F.ws;
    const float* w_in = a.in[IN_W_IN];
    int ib = 0;
    transpose_matrix(F, ib, w_in, DIN, D, 0, 512, (bf16*)(ws + W_IN), D, 0, 0, nullptr, 1.0f);
    transpose_matrix(F, ib, w_in, DIN, D, 512, 512, (bf16*)(ws + W_IN), D, 0, 512, nullptr, 0.08838834764831845f);
    transpose_matrix(F, ib, w_in, DIN, D, 1024, NPROJ - 1024, (bf16*)(ws + W_IN), D, 0, 1024, nullptr, 1.0f);
    transpose_matrix(F, ib, w_in, DIN, D, C_GA, 1024, (bf16*)(ws + W_GA), D, 0, 0, nullptr, 1.0f);
    transpose_matrix(F, ib, w_in, DIN, D, C_GB, 1024, (bf16*)(ws + W_GB), D, 0, 0, nullptr, 1.0f);
    transpose_matrix(F, ib, a.in[IN_W_RET_O], D, D, 0, D, (bf16*)(ws + W_RO), D, 0, 0, nullptr, 1.0f);
    transpose_matrix(F, ib, a.in[IN_W_NSA_O], D, D, 0, D, (bf16*)(ws + W_NO), D, 0, 0, nullptr, 1.0f);
    transpose_matrix(F, ib, a.in[IN_W_OUT], D, D, 0, D, (bf16*)(ws + W_OUT), D, 0, 0, nullptr, 1.0f);
    transpose_matrix(F, ib, a.in[IN_W_XQ], D, D, 0, D, (bf16*)(ws + W_XQ), D, 0, 0, a.in[IN_NORM_X_G], 1.0f);
    transpose_matrix(F, ib, a.in[IN_W_XO], D, D, 0, D, (bf16*)(ws + W_XO), D, 0, 0, nullptr, 1.0f);
    transpose_matrix(F, ib, a.in[IN_W_XKV], 2 * D, D, 0, 2 * D, (bf16*)(ws + W_XKV), D, 0, 0, nullptr, 1.0f);
    transpose_matrix(F, ib, a.in[IN_CMP_W1_K], 128, 4096, 0, 128, (bf16*)(ws + W_C1K), 4096, 0, 0, nullptr, 1.0f);
    transpose_matrix(F, ib, a.in[IN_CMP_W1_V], 128, 4096, 0, 128, (bf16*)(ws + W_C1V), 4096, 0, 0, nullptr, 1.0f);
    const int gt = F.bx * NTHREADS + F.tid, NGT = F.G * NTHREADS;
    for (int i = gt; i < 2 * 128 * 4096 / 8; i += NGT) { const int m = i / (128 * 4096 / 8), r = i % (128 * 4096 / 8);
        *(u32x4*)(ws + (m ? W_C1V : W_C1K) + (size_t)128 * 4096 * 2 + (size_t)r * 16) = (u32x4){0u, 0u, 0u, 0u}; }
    bf16* wngl = (bf16*)(ws + WS_SMALLW);
    for (int i = gt; i < 32 * 1024; i += NGT) { const int r = i >> 10, k = i & 1023; wngl[i] = r < 24 ? (bf16)f2bf(w_in[(size_t)k * DIN + C_NGL + r]) : (bf16)0; }
    bf16* w2k = (bf16*)(ws + WS_SMALLW + 65536); bf16* w2v = w2k + 128 * 128;
    for (int i = gt; i < 2 * 128 * 128; i += NGT) { const int m = i >> 14, r = i & 16383, f = r >> 7, e = r & 127; const float* src = a.in[m ? IN_CMP_W2_V : IN_CMP_W2_K];
        (m ? w2v : w2k)[f * 128 + e] = (bf16)f2bf(src[e * 128 + f]); }
    float* cbias = (float*)(ws + WS_SMALLW + 65536 + 2 * 128 * 128 * 2);
    const int gw = F.bx * NWAVES + F.wave, NGW = F.G * NWAVES;
    for (int o = gw; o < 256; o += NGW) { const int m = o >> 7, e = o & 127; const float* pe = a.in[m ? IN_CMP_PE_V : IN_CMP_PE_K]; const float* w1 = a.in[m ? IN_CMP_W1_V : IN_CMP_W1_K];
        float s = 0.f; for (int k = F.lane; k < 4096; k += 64) s += pe[k] * w1[(size_t)k * 128 + e];
        s = wave_sum(s); if (F.lane == 0) cbias[o] = s; }
    float* cosT = (float*)(ws + WS_ROPE_COS); float* sinT = (float*)(ws + WS_ROPE_SIN);
    for (int i = gt; i < SEQ * 64; i += NGT) { const int pos = i >> 6, j = i & 63; const float inv = powf(10000.0f, -(float)(2 * j) / 128.0f); const float ang = (float)pos * inv;
        cosT[i] = cosf(ang); sinT[i] = sinf(ang); }
    { f32x4 nx[4]; const float* X = a.in[IN_X]; const f32x4* gr = (const f32x4*)a.in[IN_NORM_MIX_G] + F.lane;
      if (gw < NTOK) {
#pragma unroll
          for (int j = 0; j < 4; ++j) nx[j] = ((const f32x4*)(X + (size_t)gw * D) + F.lane)[64 * j]; }
      for (int m = gw; m < NTOK; m += NGW) { f32x4 v[4]; float sq = 0.f;
#pragma unroll
          for (int j = 0; j < 4; ++j) { v[j] = nx[j]; sq += (v[j].x * v[j].x + v[j].y * v[j].y) + (v[j].z * v[j].z + v[j].w * v[j].w); }
          if (m + NGW < NTOK) {
#pragma unroll
              for (int j = 0; j < 4; ++j) nx[j] = ((const f32x4*)(X + (size_t)(m + NGW) * D) + F.lane)[64 * j]; }
          const float rstd = 1.0f / sqrtf(wave_sum(sq) * (1.f / D) + EPS); unsigned long long* o8 = (unsigned long long*)((bf16*)(ws + WS_H) + (size_t)m * D) + F.lane;
#pragma unroll
          for (int j = 0; j < 4; ++j) { const f32x4 gg = gr[64 * j]; o8[64 * j] = (unsigned long long)pk2(v[j].x * rstd * gg.x, v[j].y * rstd * gg.y) | ((unsigned long long)pk2(v[j].z * rstd * gg.z, v[j].w * rstd * gg.w) << 32); } } }
    for (int m = gw; m < NMEMTOK; m += NGW) rms_row_to_bf16(F.lane, a.in[IN_MEM] + (size_t)m * D, a.in[IN_NORM_MEM_G], (bf16*)(ws + WS_MEMN) + (size_t)m * D);
}

struct SchedP1 {
    unsigned char* ws; int G, c;
    __device__ __forceinline__ bool next(int i, GU& u) const {
        constexpr int NP = 128 * 22; const int L = i * G + c;
        u.rows = nullptr; u.nvalid = 0; u.aux = 0;
        if (L < NP) { int pm, pn; pg8::tile_map(L, 128, 22, pm, pn); u.A = (const char*)ws + WS_H + (size_t)pm * 256 * D * 2; u.B = (const char*)ws + W_IN + (size_t)pn * 256 * D * 2; u.pm = pm; u.pn = pn;
            u.kind = pn < 2 ? 0 : pn < 4 ? 1 : pn < 8 ? 2 : pn < 12 ? 3 : pn < 16 ? 4 : 5; return true; }
        const int L2 = L - NP; if (L2 >= 64) return false;
        const int pm = L2 & 7, pn = L2 >> 3; u.A = (const char*)ws + WS_MEMN + (size_t)pm * 256 * D * 2; u.B = (const char*)ws + W_XKV + (size_t)pn * 256 * D * 2; u.pm = pm; u.pn = pn; u.kind = 6; return true;
    }
};
struct EpiP1 {
    static constexpr bool PERM = true;
    unsigned char* ws;
    __device__ __forceinline__ void operator()(const f32x4 (&acc)[2][2][4][2], const GU& u, int wr, int wc, int fr, int fq) const {
        const int kind = u.kind;
        const float* cosT = (const float*)(ws + WS_ROPE_COS); const float* sinT = (const float*)(ws + WS_ROPE_SIN);
#pragma unroll
        for (int ai = 0; ai < 2; ++ai)
#pragma unroll
            for (int m = 0; m < 4; ++m) {
                const int r = 128 * ai + 64 * wr + 16 * m + fr; const int tok = u.pm * 256 + r;
#pragma unroll
                for (int bj = 0; bj < 2; ++bj) {
                    f32x4 v0 = acc[ai][bj][m][0], v1 = acc[ai][bj][m][1];
                    const int ct = 128 * bj + 32 * wc + 8 * fq;
                    bf16* dst;
                    if (kind <= 1) {
                        const int s = tok & (SEQ - 1), i0 = ((ct & 127) >> 1);
                        const f32x4 cs = *(const f32x4*)(cosT + s * 64 + i0), sn = *(const f32x4*)(sinT + s * 64 + i0);
                        const f32x4 a0 = v0, a1 = v1;
                        v0[0] = a0[0] * cs[0] - a0[1] * sn[0]; v0[1] = a0[0] * sn[0] + a0[1] * cs[0];
                        v0[2] = a0[2] * cs[1] - a0[3] * sn[1]; v0[3] = a0[2] * sn[1] + a0[3] * cs[1];
                        v1[0] = a1[0] * cs[2] - a1[1] * sn[2]; v1[1] = a1[0] * sn[2] + a1[1] * cs[2];
                        v1[2] = a1[2] * cs[3] - a1[3] * sn[3]; v1[3] = a1[2] * sn[3] + a1[3] * cs[3];
                        dst = (bf16*)(ws + (kind == 0 ? WS_RQ : WS_RK)) + (size_t)tok * 512 + (u.pn & 1) * 256 + ct;
                    } else if (kind == 2) { dst = (bf16*)(ws + WS_RV) + (size_t)tok * 1024 + (u.pn - 4) * 256 + ct;
                    } else if (kind == 3) {
#pragma unroll
                        for (int j = 0; j < 4; ++j) { v0[j] = v0[j] * sigmoidf_(v0[j]); v1[j] = v1[j] * sigmoidf_(v1[j]); }
                        dst = (bf16*)(ws + WS_RG) + (size_t)tok * 1024 + (u.pn - 8) * 256 + ct;
                    } else if (kind == 4) { dst = (bf16*)(ws + WS_NQ) + (size_t)tok * 1024 + (u.pn - 12) * 256 + ct;
                    } else if (kind == 5) {
                        const int b = tok >> 12, s = tok & (SEQ - 1);
                        unsigned char* kvb = ws + WS_KV6 + (size_t)(u.pn - 16) * KV_STRIDE;
                        dst = (bf16*)kvb + ((size_t)(b * 2 + bj) * SEQ + s) * 128 + (ct & 127);
                    } else { dst = (bf16*)(ws + WS_MEMKV) + (size_t)tok * 2048 + u.pn * 256 + ct; }
                    u32x4 w; w.x = cvt_pk_bf16(v0[0], v0[1]); w.y = cvt_pk_bf16(v0[2], v0[3]); w.z = cvt_pk_bf16(v1[0], v1[1]); w.w = cvt_pk_bf16(v1[2], v1[3]);
                    *(u32x4*)dst = w;
                }
            }
    }
};
__device__ __forceinline__ void p1_gate_logits(Frame& F) {
    const bf16* H = (const bf16*)(F.ws + WS_H); const bf16* W = (const bf16*)(F.ws + WS_SMALLW); float* gates = (float*)(F.ws + WS_GATES);
    const int gw = F.bx * NWAVES + F.wave, NGW = F.G * NWAVES; const int r = F.lane & 31, hh = F.lane >> 5;
    for (int rb = gw; rb < NTOK / 32; rb += NGW) {
        f32x16 acc; for (int j = 0; j < 16; ++j) acc[j] = 0.f;
        const bf16* ap = H + (size_t)(rb * 32 + r) * D + 8 * hh; const bf16* bp = W + (size_t)r * D + 8 * hh;
        for (int s8 = 0; s8 < 8; ++s8) { bf16x8 av[8], bv[8];
#pragma unroll
            for (int q = 0; q < 8; ++q) { av[q] = *(const bf16x8*)(ap + 16 * (8 * s8 + q)); bv[q] = *(const bf16x8*)(bp + 16 * (8 * s8 + q)); }
#pragma unroll
            for (int q = 0; q < 8; ++q) acc = __builtin_amdgcn_mfma_f32_32x32x16_bf16(av[q], bv[q], acc, 0, 0, 0); }
        if (r < 24) {
#pragma unroll
            for (int reg = 0; reg < 16; ++reg) { const int row = (reg & 3) + 8 * (reg >> 2) + 4 * hh; gates[(size_t)(rb * 32 + row) * 24 + r] = sigmoidf_(acc[reg]); }
        }
    }
}

namespace retf {
constexpr int ROWB = 272;
constexpr int OFF_K = 0, OFF_V = 128 * 256, OFF_ZV = OFF_V + 128 * 64, OFF_ST = OFF_ZV + 128 * 64, OFF_PART = OFF_ST + 32 * ROWB, OFF_Q = OFF_PART + 4 * 4096;
static_assert(OFF_Q + 128 * 256 <= RING_BYTES, "retention LDS map");
typedef short s16x4 __attribute__((ext_vector_type(4)));
__device__ __forceinline__ u32x2 lds_tr(const LAS unsigned char* p) { return __builtin_bit_cast(u32x2, __builtin_amdgcn_ds_read_tr16_b64_v4i16((LAS s16x4*)p)); }
}
__device__ __forceinline__ void p2_retention_fast(Frame& F, int unit, bf16* outbase) {
    using namespace retf;
    const int bh = (unit & 7) * 4 + (unit >> 6), sl = (unit >> 3) & 7, b = bh >> 2, h = bh & 3;
    const bf16* rq = (const bf16*)(F.ws + WS_RQ); const bf16* rk = (const bf16*)(F.ws + WS_RK); const bf16* rv = (const bf16*)(F.ws + WS_RV);
    const int tid = F.tid, lane = F.lane, wave = F.wave, r = lane & 31, hi = lane >> 5; LAS unsigned char* lds = F.lds;
    const float lg = log2f(1.0f - exp2f(-5.0f - (float)h));
    const int nt = wave & 3, mh = wave >> 2;
    for (int i = tid; i < 32 * ROWB / 4; i += NTHREADS) ((LAS unsigned*)(lds + OFF_ST))[i] = 0u;
    f32x16 ST;
#pragma unroll
    for (int j = 0; j < 16; ++j) ST[j] = 0.f;
    const float gC = exp2f(128.0f * lg);
    const float zeta = exp2f((float)(127 - (tid >> 2)) * lg);
    const int blk = (lane >> 4) & 1, q4 = (lane & 15) >> 2, p4 = lane & 3;
    const int vtr = (4 * hi + q4) * 64 + 32 * blk + 8 * p4;
    const int ztr = (8 * hi + q4) * 64 + 32 * blk + 8 * p4;
    int ktr[2];
#pragma unroll
    for (int t = 0; t < 2; ++t) ktr[t] = 256 * (8 * hi + 4 * t + q4) + 16 * ((4 * nt + 2 * blk + (p4 >> 1)) ^ ((q4 << 2) | ((2 * hi + t) & 3))) + 8 * (p4 & 1);
    const int krow = 256 * r + 16 * (hi ^ (((r & 3) << 2) | ((r >> 2) & 3)));
    u32x4 kreg[4], qreg[4], vreg;
    {   const int tok0 = b * SEQ;
#pragma unroll
        for (int i = 0; i < 4; ++i) { const int p = tid + 512 * i, m = p >> 4, cc = p & 15; kreg[i] = *(const u32x4*)(rk + (size_t)(tok0 + m) * 512 + h * 128 + cc * 8); qreg[i] = *(const u32x4*)(rq + (size_t)(tok0 + m) * 512 + h * 128 + cc * 8); }
        { const int m = tid >> 2, cc = tid & 3; vreg = *(const u32x4*)(rv + (size_t)(tok0 + m) * 1024 + h * 256 + sl * 32 + cc * 8); } }
    for (int c = 0; c < SEQ / 128; ++c) {
        const int tok0 = b * SEQ + c * 128;
        __syncthreads();
#pragma unroll
        for (int i = 0; i < 4; ++i) { const int p = tid + 512 * i, m = p >> 4, cc = p & 15; const int o_ = 256 * m + 16 * (cc ^ (((m & 3) << 2) | ((m >> 2) & 3)));
            *(LAS u32x4*)(lds + OFF_K + o_) = kreg[i]; *(LAS u32x4*)(lds + OFF_Q + o_) = qreg[i]; }
        { const u32x4 v = vreg; u32x4 zv;
            zv.x = cvt_pk_bf16(lo16(v.x) * zeta, hi16(v.x) * zeta); zv.y = cvt_pk_bf16(lo16(v.y) * zeta, hi16(v.y) * zeta); zv.z = cvt_pk_bf16(lo16(v.z) * zeta, hi16(v.z) * zeta); zv.w = cvt_pk_bf16(lo16(v.w) * zeta, hi16(v.w) * zeta);
            *(LAS u32x4*)(lds + OFF_V + tid * 16) = v; *(LAS u32x4*)(lds + OFF_ZV + tid * 16) = zv; }
        __syncthreads();
        if (c + 1 < SEQ / 128) { const int tok1 = tok0 + 128;
#pragma unroll
            for (int i = 0; i < 4; ++i) { const int p = tid + 512 * i, m = p >> 4, cc = p & 15; kreg[i] = *(const u32x4*)(rk + (size_t)(tok1 + m) * 512 + h * 128 + cc * 8); qreg[i] = *(const u32x4*)(rq + (size_t)(tok1 + m) * 512 + h * 128 + cc * 8); }
            { const int m = tid >> 2, cc = tid & 3; vreg = *(const u32x4*)(rv + (size_t)(tok1 + m) * 1024 + h * 256 + sl * 32 + cc * 8); } }
        bf16x8 qf[8];
#pragma unroll
        for (int s_ = 0; s_ < 8; ++s_) qf[s_] = *(const LAS bf16x8*)(lds + OFF_Q + 8192 * nt + (krow ^ (32 * s_)));
        f32x16 CR;
#pragma unroll
        for (int j = 0; j < 16; ++j) CR[j] = 0.f;
        if (mh == 0) {
#pragma unroll
            for (int s_ = 0; s_ < 8; ++s_) { const bf16x8 a = *(const LAS bf16x8*)(lds + OFF_ST + r * ROWB + (16 * s_ + 8 * hi) * 2); CR = __builtin_amdgcn_mfma_f32_32x32x16_bf16(a, qf[s_], CR, 0, 0, 0); }
        }
        f32x16 IN_;
#pragma unroll
        for (int j = 0; j < 16; ++j) IN_[j] = 0.f;
#pragma unroll
        for (int mi = 0; mi < 2; ++mi) { const int mt = 2 * mh + mi;
            if (mt <= nt) {
                f32x16 A;
#pragma unroll
                for (int j = 0; j < 16; ++j) A[j] = 0.f;
#pragma unroll
                for (int s_ = 0; s_ < 8; ++s_) { const bf16x8 a = *(const LAS bf16x8*)(lds + OFF_K + 8192 * mt + (krow ^ (32 * s_))); A = __builtin_amdgcn_mfma_f32_32x32x16_bf16(a, qf[s_], A, 0, 0, 0); }
#pragma unroll
                for (int j = 0; j < 16; ++j) { const int dd = (32 * nt + r) - (32 * mt + (j & 3) + 8 * (j >> 2) + 4 * hi); A[j] = dd >= 0 ? A[j] * __builtin_amdgcn_exp2f((float)dd * lg) : 0.f; }
#pragma unroll
                for (int s2 = 0; s2 < 2; ++s2) { u32x4 w; w.x = cvt_pk_bf16(A[8 * s2 + 0], A[8 * s2 + 1]); w.y = cvt_pk_bf16(A[8 * s2 + 2], A[8 * s2 + 3]); w.z = cvt_pk_bf16(A[8 * s2 + 4], A[8 * s2 + 5]); w.w = cvt_pk_bf16(A[8 * s2 + 6], A[8 * s2 + 7]);
                    const LAS unsigned char* vp = lds + OFF_V + vtr + (32 * mt + 16 * s2) * 64; const u32x2 lo = lds_tr(vp), hi2 = lds_tr(vp + 8 * 64);
                    IN_ = __builtin_amdgcn_mfma_f32_32x32x16_bf16(__builtin_bit_cast(bf16x8, (u32x4){lo.x, lo.y, hi2.x, hi2.y}), __builtin_bit_cast(bf16x8, w), IN_, 0, 0, 0); }
            } }
        if (mh == 1) {
#pragma unroll
            for (int j = 0; j < 16; ++j) ((LAS float*)(lds + OFF_PART))[(nt * 16 + j) * 64 + lane] = IN_[j];
        }
        __syncthreads();
        if (mh == 0) {
            const float xi = __builtin_amdgcn_exp2f((float)(32 * nt + r + 1) * lg);
            bf16* orow = outbase + (size_t)(tok0 + 32 * nt + r) * 1024 + h * 256 + sl * 32;
#pragma unroll
            for (int q4_ = 0; q4_ < 4; ++q4_) { float o_[4];
#pragma unroll
                for (int e = 0; e < 4; ++e) { const int j = 4 * q4_ + e; o_[e] = IN_[j] + ((const LAS float*)(lds + OFF_PART))[(nt * 16 + j) * 64 + lane] + xi * CR[j]; }
                *(u32x2*)(orow + 8 * q4_ + 4 * hi) = (u32x2){cvt_pk_bf16(o_[0], o_[1]), cvt_pk_bf16(o_[2], o_[3])}; }
        } else {
#pragma unroll
            for (int j = 0; j < 16; ++j) ST[j] *= gC;
#pragma unroll
            for (int s_ = 0; s_ < 8; ++s_) {
                const LAS unsigned char* zp = lds + OFF_ZV + ztr + (16 * s_) * 64; const u32x2 z0 = lds_tr(zp), z1 = lds_tr(zp + 4 * 64);
                const u32x2 k0 = lds_tr(lds + OFF_K + ktr[0] + 4096 * s_), k1 = lds_tr(lds + OFF_K + ktr[1] + 4096 * s_);
                ST = __builtin_amdgcn_mfma_f32_32x32x16_bf16(__builtin_bit_cast(bf16x8, (u32x4){z0.x, z0.y, z1.x, z1.y}), __builtin_bit_cast(bf16x8, (u32x4){k0.x, k0.y, k1.x, k1.y}), ST, 0, 0, 0); }
#pragma unroll
            for (int j = 0; j < 16; ++j) { const int dv = (j & 3) + 8 * (j >> 2) + 4 * hi; ((LAS unsigned short*)(lds + OFF_ST))[dv * (ROWB / 2) + 32 * nt + r] = (unsigned short)f2bf(ST[j]); }
        }
    }
    __syncthreads();
}
__device__ __forceinline__ void transpose_kv_tiles(Frame& F, const bf16* src, bf16* dst, int w0, int nw) {
    LAS unsigned short* tl_ = (LAS unsigned short*)(F.lds + F.wave * 16384); const int lane = F.lane;
    for (int tile = w0; tile < 16 * 64 * 2; tile += nw) {
        const int dh = tile & 1, st = (tile >> 1) & 63, bg = tile >> 7;
        const bf16* sp = src + ((size_t)bg * SEQ + st * 64) * 128 + dh * 64; bf16* dp = dst + ((size_t)bg * 128 + dh * 64) * SEQ + st * 64;
#pragma unroll
        for (int i = 0; i < 8; ++i) { const int row = i * 8 + (lane >> 3), c = lane & 7; const u32x4 v = *(const u32x4*)(sp + (size_t)row * 128 + c * 8); LAS unsigned short* q = tl_ + row * 66 + c * 8;
            q[0] = (unsigned short)(v.x & 0xffffu); q[1] = (unsigned short)(v.x >> 16); q[2] = (unsigned short)(v.y & 0xffffu); q[3] = (unsigned short)(v.y >> 16);
            q[4] = (unsigned short)(v.z & 0xffffu); q[5] = (unsigned short)(v.z >> 16); q[6] = (unsigned short)(v.w & 0xffffu); q[7] = (unsigned short)(v.w >> 16); }
        LDS_WAIT(); asm volatile("" ::: "memory");
#pragma unroll
        for (int i = 0; i < 8; ++i) { const int d = i * 8 + (lane >> 3), c = lane & 7; const LAS unsigned short* q = tl_ + (c * 8) * 66 + d;
            u32x4 o; o.x = (unsigned)q[0] | ((unsigned)q[66] << 16); o.y = (unsigned)q[2 * 66] | ((unsigned)q[3 * 66] << 16); o.z = (unsigned)q[4 * 66] | ((unsigned)q[5 * 66] << 16); o.w = (unsigned)q[6 * 66] | ((unsigned)q[7 * 66] << 16);
            *(u32x4*)(dp + (size_t)d * SEQ + c * 8) = o; }
        LDS_WAIT(); asm volatile("" ::: "memory");
    }
}
struct SchedCmp {
    unsigned char* ws; int first, G, c;
    __device__ __forceinline__ bool next(int i, GU& u) const {
        const int L = i * G + c - first; if (L < 0 || L >= 256) return false;
        const int ks = L & 7, mb = L >> 3, m = mb >> 4, bg = mb & 15;
        u.A = (const char*)ws + WS_KV6 + (size_t)m * KV_STRIDE + (size_t)bg * SEQ * 128 * 2 + (size_t)ks * 512 * 2; u.B = (const char*)ws + (m ? W_C1V : W_C1K) + (size_t)ks * 512 * 2;
        u.pm = mb; u.pn = 0; u.kind = ks; u.rows = nullptr; u.nvalid = 0; u.aux = 0; return true;
    }
};
struct EpiCmp {
    static constexpr bool PERM = false;
    float* hid;
    __device__ __forceinline__ void operator()(const f32x4 (&acc)[2][2][4][2], const GU& u, int wr, int wc, int fr, int fq) const {
#pragma unroll
        for (int ai = 0; ai < 2; ++ai)
#pragma unroll
            for (int m = 0; m < 4; ++m) { const int r = 128 * ai + 64 * wr + 16 * m + fr; float* rowp = hid + (size_t)u.kind * (32 * 256 * 128) + ((size_t)u.pm * 256 + r) * 128 + 32 * wc + 4 * fq;
#pragma unroll
                for (int n = 0; n < 2; ++n) *(f32x4*)(rowp + 16 * n) = acc[ai][0][m][n]; }
    }
};
__device__ __forceinline__ float gelu_tanh(float x) { const float u = 0.7978845608028654f * (x + 0.044715f * x * x * x); return 0.5f * x * (1.0f + tanhf(u)); }
__device__ __forceinline__ void p2b_compress_out(Frame& F, const Args& a) {
    const float* hid = (const float*)a.out + (size_t)16 * MiB; const float* cbias = (const float*)(F.ws + WS_SMALLW + 65536 + 2 * 128 * 128 * 2);
    const int gw = F.bx * NWAVES + F.wave, NGW = F.G * NWAVES;
    for (int row = gw; row < 2 * 16 * 256; row += NGW) {
        const int m = row >> 12, n = row & 255; const float* w2 = a.in[m ? IN_CMP_W2_V : IN_CMP_W2_K];
        bf16* dst = (bf16*)(F.ws + (m ? WS_VCMP : WS_KCMP)) + (size_t)(row & 4095) * 128;
        float o0 = 0.f, o1 = 0.f;
        if (n < 255) { const float* hr = hid + (size_t)row * 128;
            for (int e = 0; e < 128; ++e) { float hsum = 0.f;
#pragma unroll
                for (int ks = 0; ks < 8; ++ks) hsum += hr[(size_t)ks * (32 * 256 * 128) + e];
                const float g = gelu_tanh(hsum + cbias[m * 128 + e]); o0 += g * w2[e * 128 + F.lane]; o1 += g * w2[e * 128 + 64 + F.lane]; } }
        dst[F.lane] = (bf16)f2bf(o0); dst[64 + F.lane] = (bf16)f2bf(o1);
        if (m == 1) { bf16* dt = (bf16*)(F.ws + WS_VCMPT) + (size_t)((row >> 8) & 15) * 128 * 256 + n; dt[(size_t)F.lane * 256] = (bf16)f2bf(o0); dt[(size_t)(64 + F.lane) * 256] = (bf16)f2bf(o1); }
    }
}

__device__ __forceinline__ void p3_ret_normalize(Frame& F) {
    bf16* rv = (bf16*)(F.ws + WS_RV); const bf16* rg = (const bf16*)(F.ws + WS_RG);
    const int gw = F.bx * NWAVES + F.wave, NGW = F.G * NWAVES;
    for (int it = gw; it < NTOK * 4; it += NGW) {
        u32x2* p = (u32x2*)(rv + (size_t)it * 256) + F.lane; const u32x2 w = *p; const u32x2 gq = *((const u32x2*)(rg + (size_t)it * 256) + F.lane);
        const float o0 = lo16(w.x), o1 = hi16(w.x), o2 = lo16(w.y), o3 = hi16(w.y);
        const float ss = wave_sum((o0 * o0 + o1 * o1) + (o2 * o2 + o3 * o3));
        const float r = 1.0f / sqrtf(ss * (1.0f / 256.0f) + EPS);
        u32x2 q; q.x = pk2(o0 * r * lo16(gq.x), o1 * r * hi16(gq.x)); q.y = pk2(o2 * r * lo16(gq.y), o3 * r * hi16(gq.y)); *p = q;
    }
}
namespace nsaf {
constexpr int KROW = 272, VROW = 136, KT_BYTES = 64 * KROW, VT_BYTES = 128 * VROW;
constexpr int OFF_K = 0, OFF_V = KT_BYTES, BUF_BYTES = KT_BYTES + VT_BYTES, OFF_IMP = 2 * BUF_BYTES, OFF_MASK = OFF_IMP + 64 * 64 * 4;
constexpr float NEG = -1.0e30f, MASKED = -3.0e38f, CS = 0.08838834764831845f * 1.4426950408889634f;
struct Stage { u32x4 k0, k1, v0, v1; };
__device__ __forceinline__ void stage_load(Stage& st, const bf16* K, const bf16* VT, size_t vpitch, int key0, int tid) {
    const int r0 = tid >> 4, c0 = tid & 15;
    st.k0 = *(const u32x4*)(K + (size_t)(key0 + r0) * 128 + c0 * 8); st.k1 = *(const u32x4*)(K + (size_t)(key0 + r0 + 32) * 128 + c0 * 8);
    const int d0 = tid >> 3, c1 = tid & 7;
    st.v0 = *(const u32x4*)(VT + (size_t)d0 * vpitch + key0 + c1 * 8); st.v1 = *(const u32x4*)(VT + (size_t)(d0 + 64) * vpitch + key0 + c1 * 8);
}
__device__ __forceinline__ void stage_write(const Stage& st, LAS unsigned char* lds, int tid) {
    const int r0 = tid >> 4, c0 = tid & 15;
    *(LAS u32x4*)(lds + OFF_K + r0 * KROW + c0 * 16) = st.k0; *(LAS u32x4*)(lds + OFF_K + (r0 + 32) * KROW + c0 * 16) = st.k1;
    const int d0 = tid >> 3, c1 = tid & 7;
    LAS unsigned char* p0 = lds + OFF_V + d0 * VROW + c1 * 16; LAS unsigned char* p1 = lds + OFF_V + (d0 + 64) * VROW + c1 * 16;
    *(LAS u32x2*)p0 = (u32x2){st.v0.x, st.v0.y}; *(LAS u32x2*)(p0 + 8) = (u32x2){st.v0.z, st.v0.w};
    *(LAS u32x2*)p1 = (u32x2){st.v1.x, st.v1.y}; *(LAS u32x2*)(p1 + 8) = (u32x2){st.v1.z, st.v1.w};
}
template <int MODE>
__device__ __forceinline__ void block_step(const LAS unsigned char* lds, LAS unsigned char* ldstab, const bf16x8 (&qf)[8], f32x16 (&O)[4], float& m, float& l, int blk, int tl_in, int itile, int nvr_in, bool rowsel, float inv_l, int lane_in) {
    int tl = tl_in, nvr = nvr_in, lane = lane_in; LAUNDER(tl); LAUNDER(nvr); LAUNDER(lane);
    const int r = lane & 31, hi = lane >> 5;
    f32x16 S[2];
#pragma unroll
    for (int kh = 0; kh < 2; ++kh) {
#pragma unroll
        for (int j = 0; j < 16; ++j) S[kh][j] = 0.f;
    }
    {
        const unsigned kaddr = (unsigned)(size_t)(lds + OFF_K + r * KROW + 16 * hi);
        u32x4 ka[4], kb[4];
#define NSAF_KRD(dst, t, s4) asm volatile("ds_read_b128 %0, %1 offset:%2" : "=v"(dst) : "v"(kaddr), "i"((t) * 32 * KROW + (s4) * 32))
#define NSAF_KRD4(set, t, s0) do { NSAF_KRD(set[0], t, (s0)); NSAF_KRD(set[1], t, (s0) + 1); NSAF_KRD(set[2], t, (s0) + 2); NSAF_KRD(set[3], t, (s0) + 3); } while (0)
#define NSAF_KWAIT(n, set) asm volatile("s_waitcnt lgkmcnt(" #n ")" : "+v"(set[0]), "+v"(set[1]), "+v"(set[2]), "+v"(set[3]))
#define NSAF_KMMA(set, t, s0) do { _Pragma("unroll") for (int q_ = 0; q_ < 4; ++q_) S[t] = __builtin_amdgcn_mfma_f32_32x32x16_bf16(__builtin_bit_cast(bf16x8, set[q_]), qf[(s0) + q_], S[t], 0, 0, 0); } while (0)
        NSAF_KRD4(ka, 0, 0); NSAF_KRD4(kb, 0, 4);
        NSAF_KWAIT(4, ka); NSAF_KMMA(ka, 0, 0); NSAF_KRD4(ka, 1, 0);
        NSAF_KWAIT(4, kb); NSAF_KMMA(kb, 0, 4); NSAF_KRD4(kb, 1, 4);
        NSAF_KWAIT(4, ka); NSAF_KMMA(ka, 1, 0);
        NSAF_KWAIT(0, kb); NSAF_KMMA(kb, 1, 4);
#undef NSAF_KRD
#undef NSAF_KRD4
#undef NSAF_KWAIT
#undef NSAF_KMMA
    }
    bool need_mask;
    if (MODE <= 1) need_mask = true; else if (MODE == 2) need_mask = (blk == itile); else need_mask = (blk == itile) || (blk == itile - 8);
    float mx = MASKED;
    if (need_mask) {
        int lo_ = -1, hi_ = 63;
        if (MODE <= 1) hi_ = nvr - 64 * blk - 1; else if (MODE == 2) hi_ = tl; else { hi_ = (blk == itile) ? tl : 63; lo_ = (blk == itile - 8) ? tl : -1; }
        lo_ -= 4 * hi; hi_ -= 4 * hi;
#pragma unroll
        for (int kh = 0; kh < 2; ++kh)
#pragma unroll
            for (int j = 0; j < 16; ++j) { const int kc_ = 32 * kh + (j & 3) + 8 * (j >> 2); const bool ok = (kc_ > lo_) & (kc_ <= hi_); const float v = ok ? S[kh][j] : MASKED; S[kh][j] = v; mx = fmaxf(mx, v); }
    } else {
#pragma unroll
        for (int kh = 0; kh < 2; ++kh)
#pragma unroll
            for (int j = 0; j < 16; ++j) mx = fmaxf(mx, S[kh][j]);
    }
    if (MODE == 2) mx = rowsel ? mx : MASKED;
    if (MODE == 1) {
        LAS float* imp = (LAS float*)(ldstab + OFF_IMP) + tl * 64;
#pragma unroll
        for (int kh = 0; kh < 2; ++kh)
#pragma unroll
            for (int j = 0; j < 16; ++j) { const int n = 64 * blk + 32 * kh + (j & 3) + 8 * (j >> 2) + 4 * hi; const float v = S[kh][j]; const float p = __builtin_amdgcn_exp2f(v - m) * inv_l; S[kh][j] = p;
                if (v > 0.5f * MASKED) { __hip_atomic_fetch_add(imp + (n >> 2), p, __ATOMIC_RELAXED, __HIP_MEMORY_SCOPE_WORKGROUP); if ((n & 3) == 3 && (n >> 2) + 1 < 64) __hip_atomic_fetch_add(imp + (n >> 2) + 1, p, __ATOMIC_RELAXED, __HIP_MEMORY_SCOPE_WORKGROUP); } }
    } else {
        mx = fmaxf(mx, __shfl_xor(mx, 32));
        if (__any(mx > m + 8.0f)) { const float mn = fmaxf(m, mx); const float alpha = __builtin_amdgcn_exp2f(m - mn); m = mn; l *= alpha;
            if (MODE != 0) {
#pragma unroll
                for (int dt = 0; dt < 4; ++dt)
#pragma unroll
                    for (int j = 0; j < 16; ++j) O[dt][j] *= alpha; } }
        float rs = 0.f;
        if (MODE == 2) {
#pragma unroll
            for (int kh = 0; kh < 2; ++kh)
#pragma unroll
                for (int j = 0; j < 16; ++j) { const float p = rowsel ? __builtin_amdgcn_exp2f(S[kh][j] - m) : 0.f; S[kh][j] = p; rs += p; }
        } else {
#pragma unroll
            for (int kh = 0; kh < 2; ++kh)
#pragma unroll
                for (int j = 0; j < 16; ++j) { const float p = __builtin_amdgcn_exp2f(S[kh][j] - m); S[kh][j] = p; rs += p; }
        }
        l += rs;
        if (MODE == 0) return;
    }
    bf16x8 pf[2][2];
#pragma unroll
    for (int kh = 0; kh < 2; ++kh)
#pragma unroll
        for (int s2 = 0; s2 < 2; ++s2) { u32x4 w; w.x = cvt_pk_bf16(S[kh][8 * s2 + 0], S[kh][8 * s2 + 1]); w.y = cvt_pk_bf16(S[kh][8 * s2 + 2], S[kh][8 * s2 + 3]); w.z = cvt_pk_bf16(S[kh][8 * s2 + 4], S[kh][8 * s2 + 5]); w.w = cvt_pk_bf16(S[kh][8 * s2 + 6], S[kh][8 * s2 + 7]);
            pf[kh][s2] = __builtin_bit_cast(bf16x8, w); }
    {
        const unsigned vaddr = (unsigned)(size_t)(lds + OFF_V + r * VROW + 8 * hi);
        u32x2 va[8], vb[8];
#define NSAF_VRD(dst, dt, i) asm volatile("ds_read_b64 %0, %1 offset:%2" : "=v"(dst) : "v"(vaddr), "i"((dt) * 32 * VROW + ((i) >> 1) * 32 + ((i) & 1) * 16))
#define NSAF_VRD8(set, dt) do { NSAF_VRD(set[0], dt, 0); NSAF_VRD(set[1], dt, 1); NSAF_VRD(set[2], dt, 2); NSAF_VRD(set[3], dt, 3); NSAF_VRD(set[4], dt, 4); NSAF_VRD(set[5], dt, 5); NSAF_VRD(set[6], dt, 6); NSAF_VRD(set[7], dt, 7); } while (0)
#define NSAF_VWAIT(n, set) asm volatile("s_waitcnt lgkmcnt(" #n ")" : "+v"(set[0]), "+v"(set[1]), "+v"(set[2]), "+v"(set[3]), "+v"(set[4]), "+v"(set[5]), "+v"(set[6]), "+v"(set[7]))
#define NSAF_VMMA(set, dt) do { _Pragma("unroll") for (int ks = 0; ks < 4; ++ks) { const u32x4 a_ = (u32x4){set[2 * ks].x, set[2 * ks].y, set[2 * ks + 1].x, set[2 * ks + 1].y}; \
            O[dt] = __builtin_amdgcn_mfma_f32_32x32x16_bf16(__builtin_bit_cast(bf16x8, a_), pf[ks >> 1][ks & 1], O[dt], 0, 0, 0); } } while (0)
        NSAF_VRD8(va, 0); NSAF_VRD8(vb, 1);
        NSAF_VWAIT(8, va); NSAF_VMMA(va, 0); NSAF_VRD8(va, 2);
        NSAF_VWAIT(8, vb); NSAF_VMMA(vb, 1); NSAF_VRD8(vb, 3);
        NSAF_VWAIT(8, va); NSAF_VMMA(va, 2);
        NSAF_VWAIT(0, vb); NSAF_VMMA(vb, 3);
#undef NSAF_VRD
#undef NSAF_VRD8
#undef NSAF_VWAIT
#undef NSAF_VMMA
    }
}
template <int MODE>
__device__ __forceinline__ void run_pass(LAS unsigned char* lds, const bf16* K, const bf16* VT, size_t vpitch, int jb, int je, const bf16x8 (&qf)[8], f32x16 (&O)[4], float& m, float& l, int tl, int itile, int nvr, unsigned long long selmask, float inv_l, int tid, int lane) {
    Stage st; stage_load(st, K, VT, vpitch, jb * 64, tid); stage_write(st, lds, tid);
    if (jb < je) stage_load(st, K, VT, vpitch, (jb + 1) * 64, tid);
    __syncthreads();
    for (int j = jb; j <= je; ++j) {
        const int cur = (j - jb) & 1;
        if (j < je) { stage_write(st, lds + (cur ^ 1) * BUF_BYTES, tid); if (j + 1 < je) stage_load(st, K, VT, vpitch, (j + 2) * 64, tid); }
        const bool rowsel = (MODE == 2) ? (((selmask >> j) & 1ull) != 0ull) : true;
        if (MODE != 2 || __ballot(rowsel) != 0ull) block_step<MODE>(lds + cur * BUF_BYTES, lds, qf, O, m, l, j, tl, itile, nvr, rowsel, inv_l, lane);
        __syncthreads();
    }
}
}
__device__ __forceinline__ void p3_nsa_fast(Frame& F, const bf16* svT, const bf16* wvT, bf16* outbase) {
    using namespace nsaf;
    unsigned char* ws = F.ws; const int tid = F.tid, lane = F.lane, wave = F.wave; LAS unsigned char* lds = F.lds;
    bf16* nq = (bf16*)(ws + WS_NQ); const float* gates = (const float*)(ws + WS_GATES);
    const int r = lane & 31, hi = lane >> 5, qrow = wave * 32 + r, tl = qrow >> 2, head = qrow & 3;
    for (int u4 = 0; u4 < 4; ++u4) {
        const int pr = (F.bx & 7) * 32 + (F.bx >> 3) + (u4 >> 1) * 256; if (F.bx >= 256) break;
        const int bg = pr >> 5, ii = pr & 31, itile = (u4 & 1) ? (63 - ii) : ii, g = bg & 1, b = bg >> 1;
        const int tok = b * SEQ + itile * 64 + tl, t = itile * 64 + tl;
        const bf16* kc = (const bf16*)(ws + WS_KCMP) + (size_t)bg * 256 * 128; const bf16* vcT = (const bf16*)(ws + WS_VCMPT) + (size_t)bg * 128 * 256;
        const bf16* ks = (const bf16*)(ws + WS_KV6 + 2 * KV_STRIDE) + (size_t)bg * SEQ * 128; const bf16* kw = (const bf16*)(ws + WS_KV6 + 4 * KV_STRIDE) + (size_t)bg * SEQ * 128;
        const bf16* vsT = svT + (size_t)bg * 128 * SEQ; const bf16* vwT = wvT + (size_t)bg * 128 * SEQ;
        __syncthreads();
        for (int i = tid; i < 64 * 64; i += NTHREADS) ((LAS float*)(lds + OFF_IMP))[i] = 0.f;
        bf16x8 qf[8]; bf16* qrowp = nq + (size_t)tok * 1024 + g * 512 + head * 128; bf16* orowp = outbase + (size_t)tok * 1024 + g * 512 + head * 128;
#pragma unroll
        for (int s_ = 0; s_ < 8; ++s_) { const u32x4 w_ = *(const u32x4*)(qrowp + 16 * s_ + 8 * hi);
            u32x4 o_; o_.x = cvt_pk_bf16(lo16(w_.x) * CS, hi16(w_.x) * CS); o_.y = cvt_pk_bf16(lo16(w_.y) * CS, hi16(w_.y) * CS); o_.z = cvt_pk_bf16(lo16(w_.z) * CS, hi16(w_.z) * CS); o_.w = cvt_pk_bf16(lo16(w_.w) * CS, hi16(w_.w) * CS);
            qf[s_] = __builtin_bit_cast(bf16x8, o_); }
        const float g0 = gates[(size_t)tok * 24 + (g * 4 + head) * 3 + 0], g1 = gates[(size_t)tok * 24 + (g * 4 + head) * 3 + 1], g2 = gates[(size_t)tok * 24 + (g * 4 + head) * 3 + 2];
        const int nvr = (t >= 31) ? (((t - 31) >> 4) + 1 > 255 ? 255 : ((t - 31) >> 4) + 1) : 0;
        const int jec = ((4 * itile + 2) >> 6) > 3 ? 3 : ((4 * itile + 2) >> 6);
        f32x16 O[4];
#define NSAF_ZERO_O() do { _Pragma("unroll") for (int dt = 0; dt < 4; ++dt) _Pragma("unroll") for (int j = 0; j < 16; ++j) O[dt][j] = 0.f; } while (0)
#define NSAF_ACCUM(coef, FIRST) do { const float cf_ = (coef); _Pragma("unroll") for (int dt = 0; dt < 4; ++dt) { _Pragma("unroll") for (int q4 = 0; q4 < 4; ++q4) { u32x2* p_ = (u32x2*)(orowp + 32 * dt + 8 * q4 + 4 * hi); \
            float a0_ = cf_ * O[dt][4 * q4], a1_ = cf_ * O[dt][4 * q4 + 1], a2_ = cf_ * O[dt][4 * q4 + 2], a3_ = cf_ * O[dt][4 * q4 + 3]; \
            if (!(FIRST)) { const u32x2 o_ = *p_; a0_ += lo16(o_.x); a1_ += hi16(o_.x); a2_ += lo16(o_.y); a3_ += hi16(o_.y); } \
            *p_ = (u32x2){cvt_pk_bf16(a0_, a1_), cvt_pk_bf16(a2_, a3_)}; } asm volatile("" ::: "memory"); } } while (0)
        float m = NEG, l = 0.f; NSAF_ZERO_O();
        run_pass<0>(lds, kc, vcT, 256, 0, jec, qf, O, m, l, tl, itile, nvr, 0ull, 0.f, tid, lane);
        l += __shfl_xor(l, 32); const float invl = l > 0.f ? 1.0f / l : 0.f;
        run_pass<1>(lds, kc, vcT, 256, 0, jec, qf, O, m, l, tl, itile, nvr, 0ull, invl, tid, lane);
        NSAF_ACCUM(g0, true);
        __syncthreads();
        for (int tk = 0; tk < 8; ++tk) { const int tokl = wave * 8 + tk; float v = ((const LAS float*)(lds + OFF_IMP))[tokl * 64 + lane];
            const bool forced = (lane == 0) || (lane == itile) || (lane == itile - 1); v = (lane > itile) ? -1.0e4f : (forced ? 1.0e4f : v);
            int rank = 0;
#pragma unroll 16
            for (int i = 0; i < 64; ++i) { const float w = __builtin_bit_cast(float, __builtin_amdgcn_readlane(__builtin_bit_cast(int, v), i)); rank += (w > v || (w == v && i < lane)) ? 1 : 0; }
            const unsigned long long mk = __ballot(rank < 16);
            if (lane == 0) { ((LAS unsigned*)(lds + OFF_MASK))[tokl * 2] = (unsigned)mk; ((LAS unsigned*)(lds + OFF_MASK))[tokl * 2 + 1] = (unsigned)(mk >> 32); } }
        __syncthreads();
        const unsigned long long selmask = (unsigned long long)((const LAS unsigned*)(lds + OFF_MASK))[tl * 2] | ((unsigned long long)((const LAS unsigned*)(lds + OFF_MASK))[tl * 2 + 1] << 32);
        m = NEG; l = 0.f; NSAF_ZERO_O();
        run_pass<2>(lds, ks, vsT, SEQ, 0, itile, qf, O, m, l, tl, itile, 0, selmask, 0.f, tid, lane);
        l += __shfl_xor(l, 32); NSAF_ACCUM(l > 0.f ? g1 / l : 0.f, false);
        m = NEG; l = 0.f; NSAF_ZERO_O();
        run_pass<3>(lds, kw, vwT, SEQ, itile > 8 ? itile - 8 : 0, itile, qf, O, m, l, tl, itile, 0, 0ull, 0.f, tid, lane);
        l += __shfl_xor(l, 32); NSAF_ACCUM(l > 0.f ? g2 / l : 0.f, false);
#undef NSAF_ZERO_O
#undef NSAF_ACCUM
    }
    __syncthreads();
}
struct SchedP4 {
    unsigned char* ws; int G, c;
    __device__ __forceinline__ bool next(int i, GU& u) const {
        const int ti = i >> 2, sub = i & 3; const int L = ti * G + c; if (L >= 128 * 4) return false;
        int pm, pn; pg8::tile_map(L, 128, 4, pm, pn);
        const size_t ao = sub == 1 ? WS_RV : sub == 3 ? WS_NQ : WS_H; const size_t bo = sub == 0 ? W_GA : sub == 1 ? W_RO : sub == 2 ? W_GB : W_NO;
        u.A = (const char*)ws + ao + (size_t)pm * 256 * D * 2; u.B = (const char*)ws + bo + (size_t)pn * 256 * D * 2; u.pm = pm; u.pn = pn; u.kind = sub; u.rows = nullptr; u.nvalid = 0; u.aux = 0; return true;
    }
};
struct EpiP4 {
    static constexpr bool PERM = true;
    float* scr;
    bf16* Y;
    static __device__ __forceinline__ u32x2 pk4(const f32x4 v) { return (u32x2){cvt_pk_bf16(v[0], v[1]), cvt_pk_bf16(v[2], v[3])}; }
    static __device__ __forceinline__ f32x4 up4(const u32x2 w) { return (f32x4){lo16(w.x), hi16(w.x), lo16(w.y), hi16(w.y)}; }
    __device__ __forceinline__ void operator()(const f32x4 (&acc)[2][2][4][2], const GU& u, int wr, int wc, int fr, int fq) const {
        u32x2* p0 = (u32x2*)scr + threadIdx.x; u32x2* p1 = p0 + 32 * 512;
        if (u.kind == 0 || u.kind == 2) {
            u32x2* p = u.kind == 0 ? p0 : p1;
#pragma unroll
            for (int ai = 0; ai < 2; ++ai)
#pragma unroll
                for (int m = 0; m < 4; ++m) {
#pragma unroll
                    for (int bj = 0; bj < 2; ++bj) { f32x4 v0 = acc[ai][bj][m][0], v1 = acc[ai][bj][m][1];
#pragma unroll
                        for (int j = 0; j < 4; ++j) { v0[j] = sigmoidf_(v0[j]); v1[j] = sigmoidf_(v1[j]); }
                        p[(2 * bj) * 512] = pk4(v0); p[(2 * bj + 1) * 512] = pk4(v1); }
                    p += 4 * 512; LAUNDER(p); }
        } else if (u.kind == 1) {
#pragma unroll
            for (int ai = 0; ai < 2; ++ai)
#pragma unroll
                for (int m = 0; m < 4; ++m) {
#pragma unroll
                    for (int bj = 0; bj < 2; ++bj) { p0[(2 * bj) * 512] = pk4(up4(p0[(2 * bj) * 512]) * acc[ai][bj][m][0]); p0[(2 * bj + 1) * 512] = pk4(up4(p0[(2 * bj + 1) * 512]) * acc[ai][bj][m][1]); }
                    p0 += 4 * 512; LAUNDER(p0); }
        } else {
            bf16* yb = Y + (size_t)(u.pm * 256 + 64 * wr + fr) * D + u.pn * 256 + 32 * wc + 8 * fq;
#pragma unroll
            for (int ai = 0; ai < 2; ++ai)
#pragma unroll
                for (int m = 0; m < 4; ++m) {
#pragma unroll
                    for (int bj = 0; bj < 2; ++bj) {
                        const f32x4 v0 = up4(p0[(2 * bj) * 512]) + up4(p1[(2 * bj) * 512]) * acc[ai][bj][m][0], v1 = up4(p0[(2 * bj + 1) * 512]) + up4(p1[(2 * bj + 1) * 512]) * acc[ai][bj][m][1];
                        u32x4 w; w.x = cvt_pk_bf16(v0[0], v0[1]); w.y = cvt_pk_bf16(v0[2], v0[3]); w.z = cvt_pk_bf16(v1[0], v1[1]); w.w = cvt_pk_bf16(v1[2], v1[3]);
                        *(u32x4*)(yb + (size_t)(128 * ai + 16 * m) * D + 128 * bj) = w; }
                    p0 += 4 * 512; p1 += 4 * 512; LAUNDER(p0); LAUNDER(p1); }
        }
    }
};

struct SchedMN {
    unsigned char* ws; size_t ao, bo; int G, c;
    __device__ __forceinline__ bool next(int i, GU& u) const {
        const int L = i * G + c; if (L >= 128 * 4) return false; int pm, pn; pg8::tile_map(L, 128, 4, pm, pn);
        u.A = (const char*)ws + ao + (size_t)pm * 256 * D * 2; u.B = (const char*)ws + bo + (size_t)pn * 256 * D * 2; u.pm = pm; u.pn = pn; u.kind = 0; u.rows = nullptr; u.nvalid = 0; u.aux = 0; return true;
    }
};
template <bool SSQ> struct EpiRes {
    static constexpr bool PERM = false;
    const float* basef; const bf16* baseb; float* out; bf16* ob; float* ssq;
    __device__ __forceinline__ void operator()(const f32x4 (&acc)[2][2][4][2], const GU& u, int wr, int wc, int fr, int fq) const {
#pragma unroll
        for (int ai = 0; ai < 2; ++ai)
#pragma unroll
            for (int m = 0; m < 4; ++m) { const int r = u.pm * 256 + 128 * ai + 64 * wr + 16 * m + fr; const size_t off = (size_t)r * D + u.pn * 256 + 32 * wc + 4 * fq; float sq = 0.f;
#pragma unroll
                for (int bj = 0; bj < 2; ++bj)
#pragma unroll
                    for (int n = 0; n < 2; ++n) { const size_t o = off + 128 * bj + 16 * n; f32x4 bv;
                        if (SSQ) bv = *(const f32x4*)(basef + o); else { const u32x2 bw = *(const u32x2*)(baseb + o); bv = (f32x4){lo16(bw.x), hi16(bw.x), lo16(bw.y), hi16(bw.y)}; }
                        const f32x4 v = bv + acc[ai][bj][m][n];
                        if (!SSQ) *(f32x4*)(out + o) = v;
                        u32x2 w; w.x = cvt_pk_bf16(v[0], v[1]); w.y = cvt_pk_bf16(v[2], v[3]); *(u32x2*)(ob + o) = w; sq += (v[0] * v[0] + v[1] * v[1]) + (v[2] * v[2] + v[3] * v[3]); }
                if (SSQ) { sq += __shfl_xor(sq, 16); sq += __shfl_xor(sq, 32); if (fq == 0) ssq[(size_t)r * 16 + u.pn * 4 + wc] = sq; }
            }
    }
};
struct EpiQ {
    static constexpr bool PERM = true;
    const float* ssq; bf16* Q;
    __device__ __forceinline__ void operator()(const f32x4 (&acc)[2][2][4][2], const GU& u, int wr, int wc, int fr, int fq) const {
#pragma unroll
        for (int ai = 0; ai < 2; ++ai)
#pragma unroll
            for (int m = 0; m < 4; ++m) { const int r = u.pm * 256 + 128 * ai + 64 * wr + 16 * m + fr; const f32x4* sp = (const f32x4*)(ssq + (size_t)r * 16);
                const f32x4 a = sp[0], b = sp[1], c = sp[2], d = sp[3]; const float tot = ((a[0] + a[1]) + (a[2] + a[3])) + ((b[0] + b[1]) + (b[2] + b[3])) + ((c[0] + c[1]) + (c[2] + c[3])) + ((d[0] + d[1]) + (d[2] + d[3]));
                const float rstd = 1.0f / sqrtf(tot * (1.0f / D) + EPS);
#pragma unroll
                for (int bj = 0; bj < 2; ++bj) { const f32x4 v0 = acc[ai][bj][m][0] * rstd, v1 = acc[ai][bj][m][1] * rstd;
                    u32x4 w; w.x = cvt_pk_bf16(v0[0], v0[1]); w.y = cvt_pk_bf16(v0[2], v0[3]); w.z = cvt_pk_bf16(v1[0], v1[1]); w.w = cvt_pk_bf16(v1[2], v1[3]);
                    *(u32x4*)(Q + (size_t)r * D + u.pn * 256 + 128 * bj + 32 * wc + 8 * fq) = w; } }
    }
};

namespace xatf {
constexpr int KROW = 528, VROW = 136, KT_BYTES = 64 * KROW, OFF_K = 0, OFF_V = KT_BYTES;
constexpr float NEG = -1.0e30f, CS = 0.0625f * 1.4426950408889634f;
struct Stage { u32x4 k[4]; u32x4 v[2]; };
__device__ __forceinline__ void stage_load(Stage& st, const bf16* K, const bf16* VT, int key0, int tid) {
#pragma unroll
    for (int i = 0; i < 4; ++i) { const int p = tid + 512 * i, row = p >> 5, c = p & 31; st.k[i] = *(const u32x4*)(K + (size_t)(key0 + row) * 2048 + c * 8); }
#pragma unroll
    for (int i = 0; i < 2; ++i) { const int p = tid + 512 * i, d = p >> 3, c = p & 7; st.v[i] = *(const u32x4*)(VT + (size_t)d * 256 + key0 + c * 8); }
}
__device__ __forceinline__ void stage_write(const Stage& st, LAS unsigned char* lds, int tid) {
#pragma unroll
    for (int i = 0; i < 4; ++i) { const int p = tid + 512 * i, row = p >> 5, c = p & 31; *(LAS u32x4*)(lds + OFF_K + row * KROW + c * 16) = st.k[i]; }
#pragma unroll
    for (int i = 0; i < 2; ++i) { const int p = tid + 512 * i, d = p >> 3, c = p & 7; LAS unsigned char* q = lds + OFF_V + d * VROW + c * 16;
        *(LAS u32x2*)q = (u32x2){st.v[i].x, st.v[i].y}; *(LAS u32x2*)(q + 8) = (u32x2){st.v[i].z, st.v[i].w}; }
}
__device__ __forceinline__ void block_step(const LAS unsigned char* lds, const bf16x8 (&qf)[16], f32x16 (&O)[4], float& m, float& l, int lane) {
    const int r = lane & 31, hi = lane >> 5;
    f32x16 S[2];
#pragma unroll
    for (int kh = 0; kh < 2; ++kh) {
#pragma unroll
        for (int j = 0; j < 16; ++j) S[kh][j] = 0.f;
#pragma unroll
        for (int s_ = 0; s_ < 16; ++s_) { const bf16x8 a = *(const LAS bf16x8*)(lds + OFF_K + (kh * 32 + r) * KROW + (16 * s_ + 8 * hi) * 2); S[kh] = __builtin_amdgcn_mfma_f32_32x32x16_bf16(a, qf[s_], S[kh], 0, 0, 0); }
    }
    float mx = NEG;
#pragma unroll
    for (int kh = 0; kh < 2; ++kh)
#pragma unroll
        for (int j = 0; j < 16; ++j) { const float v = S[kh][j] * CS; S[kh][j] = v; mx = fmaxf(mx, v); }
    mx = fmaxf(mx, __shfl_xor(mx, 32));
    const float mn = fmaxf(m, mx); const float alpha = __builtin_amdgcn_exp2f(m - mn); m = mn; float rs = 0.f;
#pragma unroll
    for (int kh = 0; kh < 2; ++kh)
#pragma unroll
        for (int j = 0; j < 16; ++j) { const float p = __builtin_amdgcn_exp2f(S[kh][j] - mn); S[kh][j] = p; rs += p; }
    l = l * alpha + rs;
#pragma unroll
    for (int dt = 0; dt < 4; ++dt)
#pragma unroll
        for (int j = 0; j < 16; ++j) O[dt][j] *= alpha;
    bf16x8 pf[2][2];
#pragma unroll
    for (int kh = 0; kh < 2; ++kh)
#pragma unroll
        for (int s2 = 0; s2 < 2; ++s2) { u32x4 w; w.x = cvt_pk_bf16(S[kh][8 * s2 + 0], S[kh][8 * s2 + 1]); w.y = cvt_pk_bf16(S[kh][8 * s2 + 2], S[kh][8 * s2 + 3]); w.z = cvt_pk_bf16(S[kh][8 * s2 + 4], S[kh][8 * s2 + 5]); w.w = cvt_pk_bf16(S[kh][8 * s2 + 6], S[kh][8 * s2 + 7]);
            pf[kh][s2] = __builtin_bit_cast(bf16x8, w); }
#pragma unroll
    for (int dt = 0; dt < 4; ++dt)
#pragma unroll
        for (int kh = 0; kh < 2; ++kh)
#pragma unroll
            for (int s2 = 0; s2 < 2; ++s2) { const LAS unsigned char* vp = lds + OFF_V + (dt * 32 + r) * VROW + (32 * kh + 16 * s2 + 4 * hi) * 2;
                const u32x2 lo = *(const LAS u32x2*)vp, hi2 = *(const LAS u32x2*)(vp + 16); const u32x4 av = (u32x4){lo.x, lo.y, hi2.x, hi2.y};
                O[dt] = __builtin_amdgcn_mfma_f32_32x32x16_bf16(__builtin_bit_cast(bf16x8, av), pf[kh][s2], O[dt], 0, 0, 0); }
}
}
__device__ __forceinline__ void p7_xattn_fast(Frame& F, const bf16* vT, bf16* outbase) {
    using namespace xatf;
    bf16* Q = (bf16*)(F.ws + WS_NQ); const bf16* KV = (const bf16*)(F.ws + WS_MEMKV);
    const int tid = F.tid, lane = F.lane, wave = F.wave, r = lane & 31, hi = lane >> 5; LAS unsigned char* lds = F.lds;
    for (int u = F.bx; u < BATCH * 4 * 16; u += F.G) {
        const int tt = u & 15, bh = u >> 4, b = bh >> 2, h = bh & 3; const int tok = b * SEQ + tt * 256 + wave * 32 + r;
        bf16* qrow = Q + (size_t)tok * D + h * 256; bf16* orow = outbase + (size_t)tok * D + h * 256; const bf16* Kb = KV + (size_t)(b * NMEM) * 2048 + h * 256;
        bf16x8 qf[16];
#pragma unroll
        for (int s_ = 0; s_ < 16; ++s_) qf[s_] = *(const bf16x8*)(qrow + 16 * s_ + 8 * hi);
#pragma unroll
        for (int half = 0; half < 2; ++half) {
            const bf16* VTb = vT + ((size_t)bh * 256 + half * 128) * 256;
            f32x16 O[4]; float m = NEG, l = 0.f;
#pragma unroll
            for (int dt = 0; dt < 4; ++dt)
#pragma unroll
                for (int j = 0; j < 16; ++j) O[dt][j] = 0.f;
            for (int j = 0; j < 4; ++j) {
                __syncthreads(); { Stage st; stage_load(st, Kb, VTb, j * 64, tid); stage_write(st, lds, tid); } __syncthreads();
                block_step(lds, qf, O, m, l, lane);
            }
            l += __shfl_xor(l, 32); const float inv = 1.0f / l;
#pragma unroll
            for (int dt = 0; dt < 4; ++dt)
#pragma unroll
                for (int q4 = 0; q4 < 4; ++q4) *(u32x2*)(orow + half * 128 + 32 * dt + 8 * q4 + 4 * hi) = (u32x2){cvt_pk_bf16(O[dt][4 * q4] * inv, O[dt][4 * q4 + 1] * inv), cvt_pk_bf16(O[dt][4 * q4 + 2] * inv, O[dt][4 * q4 + 3] * inv)};
        }
    }
    __syncthreads();
}
__device__ __forceinline__ void transpose_memv_tiles(Frame& F, bf16* vT, int w0, int nw) {
    LAS unsigned short* tl_ = (LAS unsigned short*)(F.lds + F.wave * 16384); const int lane = F.lane; const bf16* KV = (const bf16*)(F.ws + WS_MEMKV);
    for (int tile = w0; tile < 32 * 16; tile += nw) {
        const int dq = tile & 3, kq = (tile >> 2) & 3, bh = tile >> 4, b = bh >> 2, h = bh & 3;
        const bf16* sp = KV + (size_t)(b * NMEM + kq * 64) * 2048 + 1024 + h * 256 + dq * 64; bf16* dp = vT + ((size_t)bh * 256 + dq * 64) * 256 + kq * 64;
#pragma unroll
        for (int i = 0; i < 8; ++i) { const int row = i * 8 + (lane >> 3), c = lane & 7; const u32x4 v = *(const u32x4*)(sp + (size_t)row * 2048 + c * 8); LAS unsigned short* q = tl_ + row * 66 + c * 8;
            q[0] = (unsigned short)(v.x & 0xffffu); q[1] = (unsigned short)(v.x >> 16); q[2] = (unsigned short)(v.y & 0xffffu); q[3] = (unsigned short)(v.y >> 16);
            q[4] = (unsigned short)(v.z & 0xffffu); q[5] = (unsigned short)(v.z >> 16); q[6] = (unsigned short)(v.w & 0xffffu); q[7] = (unsigned short)(v.w >> 16); }
        LDS_WAIT(); asm volatile("" ::: "memory");
#pragma unroll
        for (int i = 0; i < 8; ++i) { const int d = i * 8 + (lane >> 3), c = lane & 7; const LAS unsigned short* q = tl_ + (c * 8) * 66 + d;
            u32x4 o; o.x = (unsigned)q[0] | ((unsigned)q[66] << 16); o.y = (unsigned)q[2 * 66] | ((unsigned)q[3 * 66] << 16); o.z = (unsigned)q[4 * 66] | ((unsigned)q[5 * 66] << 16); o.w = (unsigned)q[6 * 66] | ((unsigned)q[7 * 66] << 16);
            *(u32x4*)(dp + (size_t)d * 256 + c * 8) = o; }
        LDS_WAIT(); asm volatile("" ::: "memory");
    }
}

__device__ __forceinline__ void p9_route(Frame& F, const Args& a) {
    unsigned char* ws = F.ws; const float* X2 = a.out;
    const float* gff = a.in[IN_NORM_FFN_G]; const float* wgrp = a.in[IN_W_GRP]; const float* bgrp = a.in[IN_B_GRP]; const float* wrt = a.in[IN_W_RT]; const float* brt = a.in[IN_B_RT];
    float* wts = (float*)(ws + WS_ROUTE); float* rstd2 = wts + 2 * NTOK; int* lists = (int*)(ws + WS_LISTS);
    const int gw = F.bx * NWAVES + F.wave, NGW = F.G * NWAVES, lane = F.lane;
    f32x4 vnext[4];
    if (gw < NTOK) {
#pragma unroll
        for (int j = 0; j < 4; ++j) vnext[j] = ((const f32x4*)(X2 + (size_t)gw * D) + lane)[64 * j]; }
    int my_ea = -1, my_eb = -1, my_tok = -1, it_ = 0; float my_w1 = 0.f, my_w2 = 0.f, my_rstd = 0.f;
    for (int tok = gw; tok < NTOK; tok += NGW, ++it_) {
        const f32x4* gr = (const f32x4*)gff + lane;
        f32x4 v[4]; float s = 0.f;
#pragma unroll
        for (int j = 0; j < 4; ++j) { v[j] = vnext[j]; s += (v[j].x * v[j].x + v[j].y * v[j].y) + (v[j].z * v[j].z + v[j].w * v[j].w); }
        if (tok + NGW < NTOK) {
#pragma unroll
            for (int j = 0; j < 4; ++j) vnext[j] = ((const f32x4*)(X2 + (size_t)(tok + NGW) * D) + lane)[64 * j]; }
        const float rstd = 1.0f / sqrtf(wave_sum(s) * (1.f / D) + EPS);
        float lg[4] = {0.f, 0.f, 0.f, 0.f};
        const float* pwg = wgrp + (size_t)(4 * lane) * 4;
#pragma unroll
        for (int j = 0; j < 4; ++j) { const f32x4 gg = gr[64 * j];
#pragma unroll
            for (int c = 0; c < 4; ++c) { const float hf = v[j][c] * rstd * gg[c]; v[j][c] = hf; const f32x4 wg = *(const f32x4*)(pwg + c * 4);
#pragma unroll
                for (int i = 0; i < 4; ++i) lg[i] += hf * wg[i]; }
            pwg += 256 * 4; LAUNDER(pwg); }
#pragma unroll
        for (int i = 0; i < 4; ++i) lg[i] = wave_sum(lg[i]) + bgrp[i];
        int grp = 0; float gm = lg[0];
#pragma unroll
        for (int i = 1; i < 4; ++i) if (lg[i] > gm) { gm = lg[i]; grp = i; }
        grp = __builtin_amdgcn_readfirstlane(grp);
        float gs = 0.f;
#pragma unroll
        for (int i = 0; i < 4; ++i) gs += expf(lg[i] - gm);
        const float g_gate = 1.0f / gs;
        float lq[8];
#pragma unroll
        for (int i = 0; i < 8; ++i) lq[i] = 0.f;
        const float* pwr = wrt + (size_t)(4 * lane) * 32 + grp * 8;
#pragma unroll
        for (int j = 0; j < 4; ++j) {
#pragma unroll
            for (int c = 0; c < 4; ++c) { const float hf = v[j][c]; const f32x4 wa = *(const f32x4*)(pwr + c * 32), wb = *(const f32x4*)(pwr + c * 32 + 4);
#pragma unroll
                for (int i = 0; i < 4; ++i) { lq[i] += hf * wa[i]; lq[4 + i] += hf * wb[i]; } }
            pwr += 256 * 32; LAUNDER(pwr); }
#pragma unroll
        for (int i = 0; i < 8; ++i) lq[i] = wave_sum(lq[i]) + brt[grp * 8 + i];
        int i1 = 0; float m1 = lq[0];
#pragma unroll
        for (int i = 1; i < 8; ++i) if (lq[i] > m1) { m1 = lq[i]; i1 = i; }
        int i2 = -1; float m2 = -3.0e38f;
#pragma unroll
        for (int i = 0; i < 8; ++i) if (i != i1 && lq[i] > m2) { m2 = lq[i]; i2 = i; }
        const float e2 = expf(m2 - m1), den = 1.0f + e2; const float w1 = g_gate / den, w2 = g_gate * e2 / den;
        if (lane == it_) { my_ea = grp * 8 + i1; my_eb = grp * 8 + i2; my_tok = tok; my_w1 = w1; my_w2 = w2; my_rstd = rstd; }
    }
    if (my_tok >= 0) {
        const unsigned sa = __hip_atomic_fetch_add(F.ctl + CW_ECNT + 64 * my_ea, 1u, __ATOMIC_RELAXED, __HIP_MEMORY_SCOPE_AGENT);
        const unsigned sb = __hip_atomic_fetch_add(F.ctl + CW_ECNT + 64 * my_eb, 1u, __ATOMIC_RELAXED, __HIP_MEMORY_SCOPE_AGENT);
        lists[(size_t)my_ea * NTOK + sa] = my_tok * 2; lists[(size_t)my_eb * NTOK + sb] = my_tok * 2 + 1;
        wts[my_tok * 2] = my_w1; wts[my_tok * 2 + 1] = my_w2; rstd2[my_tok] = my_rstd;
    }
}
struct XItem { const float* src; bf16* dst; const float* ks; int ldw, ldt, mode, row_off, c0, k0, has_ks; };
__device__ __forceinline__ void xitem_decode(const Args& a, unsigned char* ws, int it, XItem& x) {
    const int e = it / 768, r = it % 768, which = r >> 8, t = r & 255;
    x.ks = a.in[IN_NORM_FFN_G];
    if (which < 2) { x.src = a.in[which ? IN_W_E3 : IN_W_E1] + (size_t)e * D * DEXP; x.ldw = DEXP; x.dst = (bf16*)(ws + WS_W13) + (size_t)e * D * D; x.ldt = D; x.mode = 1; x.row_off = which; x.has_ks = 1; x.c0 = 32 * (t & 15); x.k0 = 64 * (t >> 4); }
    else { x.src = a.in[IN_W_E2] + (size_t)e * DEXP * D; x.ldw = D; x.dst = (bf16*)(ws + WS_W2) + (size_t)e * D * DEXP; x.ldt = DEXP; x.mode = 0; x.row_off = 0; x.has_ks = 0; x.c0 = 32 * (t & 31); x.k0 = 64 * (t >> 5); }
}
__device__ __forceinline__ void xitem_load(const XItem& x, int lane, float (&vv)[32], f32x4& k0v, f32x4& k1v) {
#pragma unroll
    for (int i = 0; i < 32; ++i) { const int kk = 2 * i + (lane >> 5); vv[i] = x.src[(size_t)(x.k0 + kk) * x.ldw + x.c0 + (lane & 31)]; }
    const f32x4* p = (const f32x4*)(x.ks + x.k0 + 8 * (lane & 7)); k0v = p[0]; k1v = p[1];
}
__device__ __forceinline__ void xitem_finish(const XItem& x, int lane, const float (&vv)[32], f32x4 k0v, f32x4 k1v, LAS float* scr) {
    if (!x.has_ks) { k0v = (f32x4){1.f, 1.f, 1.f, 1.f}; k1v = k0v; }
#pragma unroll
    for (int i = 0; i < 32; ++i) { const int kk = 2 * i + (lane >> 5); scr[kk * 33 + (lane & 31)] = vv[i]; }
    LDS_WAIT(); asm volatile("" ::: "memory");
    const int c = lane & 7;
#pragma unroll
    for (int j = 0; j < 4; ++j) { const int n = (lane >> 3) + 8 * j; const LAS float* s = scr + (8 * c) * 33 + n;
        u32x4 o; o.x = pk2(s[0 * 33] * k0v.x, s[1 * 33] * k0v.y); o.y = pk2(s[2 * 33] * k0v.z, s[3 * 33] * k0v.w); o.z = pk2(s[4 * 33] * k1v.x, s[5 * 33] * k1v.y); o.w = pk2(s[6 * 33] * k1v.z, s[7 * 33] * k1v.w);
        const int jc = x.c0 + n; const int drow = x.mode == 0 ? jc : (8 * (jc >> 2) + 4 * x.row_off + (jc & 3));
        *(u32x4*)(x.dst + (size_t)drow * x.ldt + x.k0 + 8 * c) = o; }
    LDS_WAIT(); asm volatile("" ::: "memory");
}
__device__ __forceinline__ void expert_copies(Frame& F, const Args& a, int e_lo, int e_hi) {
    LAS float* scr = (LAS float*)(F.lds + F.wave * 16384);
    const int gw = F.bx * NWAVES + F.wave, NGW = F.G * NWAVES, lane = F.lane;
    const int it_end = e_hi * 768;
    int it = e_lo * 768 + gw;
    if (it < it_end) {
        float va[32], vb[32]; f32x4 ka0, ka1, kb0, kb1; XItem xa, xb;
        xitem_decode(a, F.ws, it, xa); xitem_load(xa, lane, va, ka0, ka1);
        for (;;) {
            int itn = it + NGW; bool hn = itn < it_end;
            xitem_decode(a, F.ws, hn ? itn : it, xb); xitem_load(xb, lane, vb, kb0, kb1);
            xitem_finish(xa, lane, va, ka0, ka1, scr);
            if (!hn) break;
            it = itn; itn = it + NGW; hn = itn < it_end;
            xitem_decode(a, F.ws, hn ? itn : it, xa); xitem_load(xa, lane, va, ka0, ka1);
            xitem_finish(xb, lane, vb, kb0, kb1, scr);
            if (!hn) break;
            it = itn;
        }
    }
    __syncthreads();
}

__device__ __forceinline__ void moe_tiles(Frame& F) {
    __syncthreads();
    if (F.tid == 0) { unsigned accu = 0u; for (int e = 0; e < NEXP; ++e) { const unsigned c = __hip_atomic_load(F.ctl + CW_ECNT + 64 * e, __ATOMIC_RELAXED, __HIP_MEMORY_SCOPE_AGENT); F.MISC[16 + e] = accu; F.MISC[64 + e] = c; accu += (c + 255u) >> 8; } F.MISC[16 + NEXP] = accu; }
    __syncthreads();
}
template <int WHICH> struct SchedMoe {
    volatile LAS unsigned* MISC; unsigned char* ws; int G, c;
    __device__ __forceinline__ bool next(int i, GU& u) const {
        const int L = i * G + c; const int T = (int)MISC[16 + NEXP]; if (L >= 4 * T) return false;
        const int tau = L >> 2, pn = L & 3; int e = 0;
        for (int k = 1; k < NEXP; ++k) if ((int)MISC[16 + k] <= tau) e = k;
        const int lt = tau - (int)MISC[16 + e]; const int cnt = (int)MISC[64 + e]; int nv = cnt - lt * 256; nv = nv > 256 ? 256 : nv;
        u.rows = (const int*)(ws + WS_LISTS) + (size_t)e * NTOK + lt * 256; u.nvalid = nv; u.pm = tau; u.pn = pn; u.kind = 0; u.aux = e;
        if (WHICH == 0) { u.A = (const char*)ws + WS_X2B; u.B = (const char*)ws + WS_W13 + (size_t)e * D * D * 2 + (size_t)pn * 256 * D * 2; }
        else { u.A = (const char*)ws + WS_H1 + (size_t)tau * 256 * DEXP * 2; u.B = (const char*)ws + WS_W2 + (size_t)e * D * DEXP * 2 + (size_t)pn * 256 * DEXP * 2; }
        return true;
    }
};
struct EpiMoe1 {
    static constexpr bool PERM = true;
    const float* rstd2; bf16* H1;
    __device__ __forceinline__ void operator()(const f32x4 (&acc)[2][2][4][2], const GU& u, int wr, int wc, int fr, int fq) const {
        char* hb = (char*)H1 + (size_t)u.pm * 256 * DEXP * 2;
        const int j00 = (u.pn * 256 + 32 * wc + 8 * fq) >> 1;
#pragma unroll
        for (int ai = 0; ai < 2; ++ai) {
            int r = 128 * ai + 64 * wr + fr; LAUNDER(r);
#pragma unroll
            for (int m = 0; m < 4; ++m) { const bool ok = r < u.nvalid; const float rs = ok ? rstd2[u.rows[r] >> 1] : 0.f;
#pragma unroll
                for (int bj = 0; bj < 2; ++bj) { const f32x4 a1 = acc[ai][bj][m][0] * rs, a3 = acc[ai][bj][m][1] * rs; f32x4 hv;
#pragma unroll
                    for (int j = 0; j < 4; ++j) hv[j] = a1[j] * sigmoidf_(a1[j]) * a3[j];
                    u32x2 w; w.x = cvt_pk_bf16(hv[0], hv[1]); w.y = cvt_pk_bf16(hv[2], hv[3]); *(u32x2*)(hb + (unsigned)((r * DEXP + j00 + 64 * bj) * 2)) = w; }
                r += 16; LAUNDER(r); }
        }
    }
};
struct EpiMoe2 {
    static constexpr bool PERM = true;
    const float* wts; bf16* Y0; bf16* Y1;
    __device__ __forceinline__ void operator()(const f32x4 (&acc)[2][2][4][2], const GU& u, int wr, int wc, int fr, int fq) const {
#pragma unroll
        for (int ai = 0; ai < 2; ++ai)
#pragma unroll
            for (int m = 0; m < 4; ++m) { const int r = 128 * ai + 64 * wr + 16 * m + fr;
                if (r < u.nvalid) { const int ent = u.rows[r]; const float w8 = wts[ent]; bf16* dst = ((ent & 1) ? Y1 : Y0) + (size_t)(ent >> 1) * D + u.pn * 256 + 32 * wc + 8 * fq;
#pragma unroll
                    for (int bj = 0; bj < 2; ++bj) { const f32x4 v0 = acc[ai][bj][m][0] * w8, v1 = acc[ai][bj][m][1] * w8;
                        u32x4 w; w.x = cvt_pk_bf16(v0[0], v0[1]); w.y = cvt_pk_bf16(v0[2], v0[3]); w.z = cvt_pk_bf16(v1[0], v1[1]); w.w = cvt_pk_bf16(v1[2], v1[3]);
                        *(u32x4*)(dst + 128 * bj) = w; } } }
    }
};

__device__ __forceinline__ void p12_final(Frame& F, const Args& a) {
    const bf16* Y0 = (const bf16*)(F.ws + WS_YS0); const bf16* Y1 = (const bf16*)(F.ws + WS_YS1); const float* g = a.in[IN_NORM_F_G];
    const int gw = F.bx * NWAVES + F.wave, NGW = F.G * NWAVES, lane = F.lane;
    for (int tok = gw; tok < NTOK; tok += NGW) {
        f32x4* xr = (f32x4*)(a.out + (size_t)tok * D) + lane; const u32x2* y0 = (const u32x2*)(Y0 + (size_t)tok * D) + lane; const u32x2* y1 = (const u32x2*)(Y1 + (size_t)tok * D) + lane;
        f32x4 v[4]; float s = 0.f;
#pragma unroll
        for (int j = 0; j < 4; ++j) { v[j] = xr[64 * j]; const u32x2 p = y0[64 * j], q = y1[64 * j];
            v[j].x += lo16(p.x) + lo16(q.x); v[j].y += hi16(p.x) + hi16(q.x); v[j].z += lo16(p.y) + lo16(q.y); v[j].w += hi16(p.y) + hi16(q.y);
            s += (v[j].x * v[j].x + v[j].y * v[j].y) + (v[j].z * v[j].z + v[j].w * v[j].w); }
        const float rstd = 1.0f / sqrtf(wave_sum(s) * (1.f / D) + EPS);
#pragma unroll
        for (int j = 0; j < 4; ++j) { const f32x4 gg = ((const f32x4*)g + lane)[64 * j]; xr[64 * j] = v[j] * rstd * gg; }
    }
}

constexpr int N_PHASES = 14;
__global__ void __launch_bounds__(NTHREADS, 2) fwd(Args args) {
    extern __shared__ __attribute__((aligned(16))) unsigned char lds[];
    Frame F;
    F.lds = (LAS unsigned char*)lds; F.MISC = (volatile LAS unsigned*)(F.lds + MISC_OFF);
    F.tid = threadIdx.x; F.lane = F.tid & 63; F.wave = __builtin_amdgcn_readfirstlane(F.tid >> 6); F.G = gridDim.x; F.bx = blockIdx.x;
    F.ws = args.ws; F.ctl = (unsigned*)(args.ws + WS_CTL);
    unsigned char* ws = args.ws;
    for (int u = F.tid; u < (LDS_BYTES - RING_BYTES) / 4; u += NTHREADS) ((LAS unsigned*)(F.lds + RING_BYTES))[u] = 0u;
    __syncthreads();
    const int lo = args.ph_lo, hi = args.ph_hi;
    const bool one = (hi - lo) > 1;
    XcdBarrier bar; bar.bar = F.ctl + CW_BAR; bar.x = 0; bar.st = F.MISC + 8;
    if (one) bar = xcd_barrier_post(F.ctl + CW_BAR, F.MISC + 8);
#define IN(k) (lo <= (k) && (k) < hi && phase_begin(F))
#define SEAM(k) do { if (lo <= (k) && (k) + 1 < hi) xcd_barrier(bar); } while (0)

    if (IN(0)) { p0_prologue(F, args); } SEAM(0);
    if (IN(1)) {
        SchedP1 S{ws, F.G, F.bx};
        EpiP1 E{ws};
        pg8::gemm_phase<EpiP1, SchedP1, false>(F.lds, D, D, D, S, E);
        p1_gate_logits(F);
    } SEAM(1);
    if (IN(2)) {
        p2_retention_fast(F, F.bx, (bf16*)(ws + WS_RV));
        { const int w0 = F.bx * NWAVES + F.wave, nw = F.G * NWAVES;
            transpose_kv_tiles(F, (const bf16*)(ws + WS_KV6 + 3 * KV_STRIDE), (bf16*)args.out, w0, nw);
            transpose_kv_tiles(F, (const bf16*)(ws + WS_KV6 + 5 * KV_STRIDE), (bf16*)((unsigned char*)args.out + KV_STRIDE), w0, nw);
            transpose_memv_tiles(F, (bf16*)(ws + WS_MEMVT), w0, nw); }
        __syncthreads();
        { SchedCmp S{ws, 0, F.G, F.bx}; EpiCmp E{(float*)args.out + (size_t)16 * MiB};
            pg8::gemm_phase<EpiCmp, SchedCmp, false>(F.lds, 512, 2048, 4096, S, E); }
    } SEAM(2);
    if (IN(3)) { p2b_compress_out(F, args); } SEAM(3);
    if (IN(4)) { p3_ret_normalize(F); p3_nsa_fast(F, (const bf16*)args.out, (const bf16*)((const unsigned char*)args.out + KV_STRIDE), (bf16*)(ws + WS_NQ)); } SEAM(4);
    if (IN(5)) {
        SchedP4 S{ws, F.G, F.bx};
        EpiP4 E{(float*)(ws + WS_P4SCR) + (size_t)F.bx * (2 * 32 * 512 * 4), (bf16*)(ws + WS_Y)};
        pg8::gemm_phase<EpiP4, SchedP4, false>(F.lds, D, D, D, S, E);
    } SEAM(5);
    if (IN(6)) {
        SchedMN S{ws, WS_Y, W_OUT, F.G, F.bx}; EpiRes<true> E{args.in[IN_X], nullptr, nullptr, (bf16*)(ws + WS_X1B), (float*)(ws + WS_SSQ)};
        pg8::gemm_phase<EpiRes<true>, SchedMN, false>(F.lds, D, D, D, S, E);
    } SEAM(6);
    if (IN(7)) {
        const bool early = ((F.bx >> 3) & 1) == 0;
        if (early) expert_copies(F, args, 0, NEXP / 2);
        SchedMN S{ws, WS_X1B, W_XQ, F.G, F.bx}; EpiQ E{(const float*)(ws + WS_SSQ), (bf16*)(ws + WS_NQ)};
        pg8::gemm_phase<EpiQ, SchedMN, false>(F.lds, D, D, D, S, E);
        if (!early) { __syncthreads(); expert_copies(F, args, 0, NEXP / 2); }
    } SEAM(7);
    if (IN(8)) { p7_xattn_fast(F, (const bf16*)(ws + WS_MEMVT), (bf16*)(ws + WS_NQ)); } SEAM(8);
    if (IN(9)) {
        const bool early = ((F.bx >> 3) & 1) == 0;
        if (early) expert_copies(F, args, NEXP / 2, NEXP);
        SchedMN S{ws, WS_NQ, W_XO, F.G, F.bx}; EpiRes<false> E{nullptr, (const bf16*)(ws + WS_X1B), args.out, (bf16*)(ws + WS_X2B), nullptr};
        pg8::gemm_phase<EpiRes<false>, SchedMN, false>(F.lds, D, D, D, S, E);
        if (!early) { __syncthreads(); expert_copies(F, args, NEXP / 2, NEXP); }
    } SEAM(9);
    if (IN(10)) { p9_route(F, args); } SEAM(10);
    if (IN(11)) {
        moe_tiles(F);
        SchedMoe<0> S{F.MISC, ws, F.G, F.bx}; EpiMoe1 E{(const float*)(ws + WS_ROUTE) + 2 * NTOK, (bf16*)(ws + WS_H1)};
        pg8::gemm_phase<EpiMoe1, SchedMoe<0>, true>(F.lds, D, D, D, S, E);
    } SEAM(11);
    if (IN(12)) {
        moe_tiles(F);
        SchedMoe<1> S{F.MISC, ws, F.G, F.bx}; EpiMoe2 E{(const float*)(ws + WS_ROUTE), (bf16*)(ws + WS_YS0), (bf16*)(ws + WS_YS1)};
        pg8::gemm_phase<EpiMoe2, SchedMoe<1>, false>(F.lds, DEXP, DEXP, DEXP, S, E);
    } SEAM(12);
    if (IN(13)) { p12_final(F, args); }
#undef IN
#undef SEAM
}

extern "C" void kernel_launch(void* const* d_in, const int* in_sizes, int n_in, void* d_out, int out_size, void* d_ws, size_t ws_size, hipStream_t stream) {
    static int grid = 0;
    if (grid == 0) {
        if (n_in != 27 || in_sizes[0] != NTOK * D || out_size != NTOK * D || ws_size < WS_END) {
            fprintf(stderr, "kernel_launch: unexpected shapes: n_in %d in0 %d out %d ws %zu (need %zu)\n", n_in, n_in > 0 ? in_sizes[0] : -1, out_size, ws_size, (size_t)WS_END); grid = -1; return; }
        int dev = 0, cus = 0, per_cu = 0;
        if (hipGetDevice(&dev) != hipSuccess || hipDeviceGetAttribute(&cus, hipDeviceAttributeMultiprocessorCount, dev) != hipSuccess) { grid = -1; return; }
        if (hipFuncSetAttribute((const void*)fwd, hipFuncAttributeMaxDynamicSharedMemorySize, LDS_BYTES) != hipSuccess) { fprintf(stderr, "kernel_launch: hipFuncSetAttribute failed\n"); grid = -1; return; }
        if (hipOccupancyMaxActiveBlocksPerMultiprocessor(&per_cu, (const void*)fwd, NTHREADS, LDS_BYTES) != hipSuccess || per_cu < 1) fprintf(stderr, "kernel_launch: occupancy query reports %d\n", per_cu);
        (void)hipGetLastError();
        grid = cus < 256 ? cus : 256;
    }
    if (grid < 0) return;
    (void)hipMemsetAsync((char*)d_ws + WS_CTL, 0, CTL_ZERO_BYTES, stream);
    Args a{};
    for (int i = 0; i < 27; ++i) a.in[i] = (const float*)d_in[i];
    a.out = (float*)d_out; a.ws = (unsigned char*)d_ws;
#if MK_N_LAUNCHES == 1
    a.ph_lo = 0; a.ph_hi = N_PHASES;
    hipLaunchKernelGGL(fwd, dim3(grid), dim3(NTHREADS), LDS_BYTES, stream, a);
#else
    for (int p = 0; p < N_PHASES; ++p) { a.ph_lo = p; a.ph_hi = p + 1; hipLaunchKernelGGL(fwd, dim3(grid), dim3(NTHREADS), LDS_BYTES, stream, a); }
#endif
}
```

```cpp
#include <hip/hip_runtime.h>
#include <cstdio>
#include <cstdint>

#ifndef MK_N_LAUNCHES
#define MK_N_LAUNCHES 1
#endif

#define LAS __attribute__((address_space(3)))
#define GAS __attribute__((address_space(1)))
#define HD __host__ __device__
#define HDI __host__ __device__ __attribute__((always_inline)) inline
typedef unsigned short bf16;
typedef short bf16x8 __attribute__((ext_vector_type(8)));
typedef float f32x4 __attribute__((ext_vector_type(4)));
typedef float f32x2 __attribute__((ext_vector_type(2)));
typedef float f32x16 __attribute__((ext_vector_type(16)));
typedef unsigned u32x4 __attribute__((ext_vector_type(4)));
typedef unsigned u32x2 __attribute__((ext_vector_type(2)));

constexpr int D = 1024, BATCH = 8, SEQ = 4096, NTOK = BATCH * SEQ, NMEM = 256, NMEMTOK = BATCH * NMEM;
constexpr int DIN = 7704;
constexpr int C_RQ = 0, C_RK = 512, C_RV = 1024, C_RG = 2048, C_NQ = 3072, C_CK = 4096, C_NGL = 5632, C_GA = 5656, C_GB = 6680;
constexpr int NPROJ = 5632;
constexpr int NEXP = 32, DEXP = 512;
constexpr float EPS = 1e-6f;
constexpr int NWAVES = 8, NTHREADS = 512;

constexpr size_t MiB = 1u << 20;
constexpr size_t WS_CTL = 0, CTL_ZERO_BYTES = 1 * MiB;
constexpr size_t WS_ROPE_COS = 1 * MiB, WS_ROPE_SIN = 2 * MiB;
constexpr size_t WS_SMALLW = 3 * MiB;
constexpr size_t WS_MEMVT = 24 * MiB;
constexpr size_t WS_KCMP = 4 * MiB, WS_VCMP = 5 * MiB, WS_VCMPT = 35 * MiB;
constexpr size_t WS_GATES = 10 * MiB;
constexpr size_t WS_SSQ = 13 * MiB;
constexpr size_t WS_ROUTE = 15 * MiB;
constexpr size_t WS_LISTS = 16 * MiB;
constexpr size_t WS_W = 36 * MiB;
constexpr size_t W_IN = WS_W;
constexpr size_t W_GA = W_IN + 11 * MiB, W_GB = W_GA + 2 * MiB;
constexpr size_t W_RO = W_GB + 2 * MiB, W_NO = W_RO + 2 * MiB, W_OUT = W_NO + 2 * MiB, W_XQ = W_OUT + 2 * MiB, W_XO = W_XQ + 2 * MiB;
constexpr size_t W_XKV = W_XO + 2 * MiB;
constexpr size_t W_C1K = W_XKV + 4 * MiB, W_C1V = W_C1K + 2 * MiB;
constexpr size_t WS_MEMN = W_C1V + 2 * MiB;
constexpr size_t WS_MEMKV = WS_MEMN + 4 * MiB;
constexpr size_t WS_H = 84 * MiB;
constexpr size_t WS_NQ = WS_H + 64 * MiB;
constexpr size_t WS_RV = WS_NQ + 64 * MiB;
constexpr size_t WS_RQ = WS_RV + 64 * MiB;
constexpr size_t WS_RK = WS_RQ + 32 * MiB;
constexpr size_t WS_RG = WS_RK + 32 * MiB;
constexpr size_t WS_KV6 = WS_RG + 64 * MiB;
constexpr size_t KV_STRIDE = 16 * MiB;
constexpr size_t WS_END = WS_KV6 + 96 * MiB;
constexpr size_t WS_Y = WS_RQ, WS_P4SCR = WS_RG, WS_W13 = WS_RQ, WS_W2 = WS_RG, WS_H1 = WS_KV6, WS_X1B = WS_H, WS_X2B = WS_RV, WS_YS0 = WS_H, WS_YS1 = WS_NQ;
static_assert(WS_MEMKV + 8 * MiB <= WS_H && WS_VCMPT + 1 * MiB <= WS_W && WS_MEMVT + 4 * MiB <= WS_VCMPT, "ws map");
constexpr int CW_BAR = 4096;
constexpr int CW_ECNT = 16384;
constexpr int LDS_BYTES = 147456, RING_BYTES = 131072, MISC_OFF = RING_BYTES + 320;

HD inline float bf2f(bf16 b) { return __builtin_bit_cast(float, (unsigned)b << 16); }
HD inline unsigned f2bf(float f) { unsigned u = __builtin_bit_cast(unsigned, f); return (u + 0x7fffu + ((u >> 16) & 1u)) >> 16; }
HD inline unsigned pk2(float lo, float hi) { return f2bf(lo) | (f2bf(hi) << 16); }
HD inline float lo16(unsigned w) { return __builtin_bit_cast(float, w << 16); }
HD inline float hi16(unsigned w) { return __builtin_bit_cast(float, w & 0xffff0000u); }
__device__ __forceinline__ unsigned cvt_pk_bf16(float lo, float hi) { unsigned r; asm volatile("v_cvt_pk_bf16_f32 %0, %1, %2" : "=v"(r) : "v"(lo), "v"(hi)); return r; }
#define DPP_F(v, ctrl, rmask) __builtin_bit_cast(float, __builtin_amdgcn_update_dpp(0, __builtin_bit_cast(int, v), ctrl, rmask, 0xf, false))
__device__ __forceinline__ float wave_sum(float v) {
    v += DPP_F(v, 0xB1, 0xf);
    v += DPP_F(v, 0x4E, 0xf);
    v += DPP_F(v, 0x141, 0xf);
    v += DPP_F(v, 0x140, 0xf);
    v += DPP_F(v, 0x142, 0xa);
    v += DPP_F(v, 0x143, 0xc);
    return __builtin_bit_cast(float, __builtin_amdgcn_readlane(__builtin_bit_cast(int, v), 63));
}
__device__ __forceinline__ float wave_max(float v) {
#pragma unroll
    for (int o = 1; o < 64; o <<= 1) v = fmaxf(v, __shfl_xor(v, o));
    return v;
}
__device__ __forceinline__ float sigmoidf_(float x) { return __builtin_amdgcn_rcpf(1.0f + __builtin_amdgcn_exp2f(-1.4426950408889634f * x)); }
#define LAUNDER(p) asm volatile("" : "+v"(p))
#define LDS_WAIT() asm volatile("s_waitcnt lgkmcnt(0)" ::: "memory")
#define VM_WAIT() asm volatile("s_waitcnt vmcnt(0)" ::: "memory")

#define XB_TMO      128
#define XB_XCNT(j)  (256  + 64 * (j))
#define XB_XSUB(j)  (1280 + 64 * (j))
#define XB_XGEN(j)  (2304 + 64 * (j))
#define XB_TOP      3328
#define XB_TOPGEN   3392
#define XCD_BAR_WORDS 3456
#define XB_SPIN_CAP (1u << 24)
__device__ __forceinline__ unsigned xb_ld(unsigned* p)              { return __hip_atomic_load(p, __ATOMIC_RELAXED, __HIP_MEMORY_SCOPE_AGENT); }
__device__ __forceinline__ unsigned xb_add(unsigned* p, unsigned v) { return __hip_atomic_fetch_add(p, v, __ATOMIC_RELAXED, __HIP_MEMORY_SCOPE_AGENT); }
__device__ __forceinline__ unsigned xb_xcc_id() { return (unsigned)__builtin_amdgcn_s_getreg((3 << 11) | 20) & 0xFu; }
#define XB_SPIN(cond, bar) do { unsigned _sp = 0; while (cond) { __builtin_amdgcn_s_sleep(1); \
    if ((++_sp & 255u) == 0u) { if (xb_ld(&(bar)[XB_TMO])) break; if (_sp > XB_SPIN_CAP) { atomicAdd(&(bar)[XB_TMO], 1u); break; } } } } while (0)
struct XcdBarrier { unsigned* bar; unsigned x; volatile LAS unsigned* st; };
__device__ __forceinline__ XcdBarrier xcd_barrier_post(unsigned* bar, volatile LAS unsigned* st) {
    XcdBarrier b; b.bar = bar; b.x = xb_xcc_id(); b.st = st;
    if (threadIdx.x == 0) (void)xb_add(&bar[XB_XCNT(b.x)], 1u);
    return b;
}
__device__ __forceinline__ void xcd_barrier_complete(unsigned* bar, unsigned x, unsigned& nloc, unsigned& nx) {
    const unsigned G = gridDim.x * gridDim.y * gridDim.z;
    unsigned sum, cnt, mine, sp = 0u;
    for (;;) {
        sum = 0u; cnt = 0u; mine = 0u;
#pragma unroll
        for (unsigned j = 0; j < 16; ++j) { const unsigned c = xb_ld(&bar[XB_XCNT(j)]); sum += c; cnt += (c > 0u) ? 1u : 0u; mine = (j == x) ? c : mine; }
        if (sum == G) break;
        __builtin_amdgcn_s_sleep(1);
        if ((++sp & 255u) == 0u) { if (xb_ld(&bar[XB_TMO])) break; if (sp > XB_SPIN_CAP) { atomicAdd(&bar[XB_TMO], 1u); break; } }
    }
    nloc = mine > 0u ? mine : 1u; nx = cnt > 0u ? cnt : 1u;
}
__device__ __forceinline__ void xcd_barrier(const XcdBarrier& b) {
    asm volatile("s_waitcnt vmcnt(0)" ::: "memory");
    __syncthreads();
    if (threadIdx.x == 0) {
        unsigned* bar = b.bar;
        __builtin_amdgcn_s_waitcnt(0);
        unsigned nloc = b.st[0], nx = b.st[1];
        if (nloc == 0u) { xcd_barrier_complete(bar, b.x, nloc, nx); b.st[0] = nloc; b.st[1] = nx; }
        const unsigned old = xb_add(&bar[XB_XSUB(b.x)], 1u);
        const unsigned gen = old / nloc;
        if (old + 1u == (gen + 1u) * nloc) {
            __builtin_amdgcn_fence(__ATOMIC_RELEASE, "agent");
            asm volatile("s_waitcnt vmcnt(0)" ::: "memory");
            const unsigned og = xb_add(&bar[XB_TOP], 1u);
            const unsigned tg = og / nx;
            if (og + 1u == (tg + 1u) * nx) xb_add(&bar[XB_TOPGEN], 1u);
            else XB_SPIN(xb_ld(&bar[XB_TOPGEN]) == tg, bar);
            __builtin_amdgcn_fence(__ATOMIC_ACQUIRE, "agent");
            xb_add(&bar[XB_XGEN(b.x)], 1u);
            asm volatile("s_waitcnt vmcnt(0)" ::: "memory");
        } else {
            XB_SPIN(xb_ld(&bar[XB_XGEN(b.x)]) == gen, bar);
            __builtin_amdgcn_fence(__ATOMIC_ACQUIRE, "agent");
            asm volatile("s_waitcnt vmcnt(0)" ::: "memory");
        }
    }
    __syncthreads();
}

namespace pg8 {
constexpr int BM = 256, BK = 64, HALF = 128, HTB = HALF * BK * 2, NXCD = 8, WGM = 8;
HD __forceinline__ int lds_byte(int r, int c) { const int st = (r >> 4) * 2 + (c >> 5), rr = r & 15, cc = c & 31, ob = rr * 64 + cc * 2; return st * 1024 + (ob ^ (((ob >> 9) & 1) << 5)); }
HD __forceinline__ void stage_rc(int b, int& R, int& C) { const int st = b / 1024, sb = b % 1024, swz = sb ^ (((sb >> 9) & 1) << 5); R = (st >> 1) * 16 + swz / 64; C = (st & 1) * 32 + (swz % 64) / 2; }
HD __forceinline__ int perm32(int rho) { const int n = rho >> 4, i = rho & 15; return 8 * (i >> 2) + 4 * n + (i & 3); }
HD __forceinline__ void tile_map(int L, int nM, int nN, int& pm, int& pn) {
    const int nwg = nM * nN; int wgid = L; { const int q = nwg / NXCD, r = nwg % NXCD, xcd = wgid % NXCD, off = wgid / NXCD; wgid = (xcd < r ? xcd * (q + 1) : r * (q + 1) + (xcd - r) * q) + off; }
    const int nig = WGM * nN, gid = wgid / nig, fm = gid * WGM, gsz = (nM - fm) < WGM ? (nM - fm) : WGM;
    pm = fm + ((wgid % nig) % gsz); pn = (wgid % nig) / gsz;
}
struct GU { const char* A; const char* B; const int* rows; int nvalid; int kind, pm, pn, aux; };
template <class Epi, class Sched, bool GATHER>
__device__ __forceinline__ void gemm_phase(LAS unsigned char* lds, const int K, const int lda, const int ldb, const Sched& S, const Epi& E) {
    int tid_ = threadIdx.x; LAUNDER(tid_);
    const int tid = tid_, wid = __builtin_amdgcn_readfirstlane(tid >> 6), lane = tid & 63, wr = wid >> 2, wc = wid & 3, fr = lane & 15, fq = lane >> 4;
    const int nt = K / BK;
    unsigned voffB[2];
#pragma unroll
    for (int i = 0; i < 2; ++i) { int R, C; stage_rc(tid * 16 + i * 8192, R, C); const int Rb = Epi::PERM ? ((R & ~31) + perm32(R & 31)) : R; voffB[i] = (unsigned)(Rb * ldb + C) * 2u; }
    const size_t kstep = (size_t)(BK * 2);
    const size_t hstepB = (size_t)HALF * ldb * 2;
    const unsigned ldsw = (unsigned)wid * 1024u;
    const int aoff = lds_byte(wr * 64 + fr, fq * 8), boff = lds_byte(wc * 32 + fr, fq * 8);
#define PG8_SA(b, h) (((b) * 2 + (h)) * HTB)
#define PG8_SB(b, h) ((4 + (b) * 2 + (h)) * HTB)
#define PG8_STAGE2(bufoff, gbase, v0, v1) do { \
        __builtin_amdgcn_global_load_lds((const unsigned*)((const char*)(gbase) + (v0)), (LAS unsigned*)(lds + (bufoff) + ldsw), 16, 0, 0); \
        __builtin_amdgcn_global_load_lds((const unsigned*)((const char*)(gbase) + (v1)), (LAS unsigned*)(lds + (bufoff) + ldsw + 8192), 16, 0, 0); } while (0)
#define PG8_STAGEB(bufoff, gbase) PG8_STAGE2(bufoff, gbase, voffB[0], voffB[1])
#define PG8_LDA(dst, b, h) do { _Pragma("unroll") for (int m = 0; m < 4; ++m) _Pragma("unroll") for (int k = 0; k < 2; ++k) dst[m][k] = *(const LAS bf16x8*)(lds + PG8_SA(b, h) + aoff + m * 2048 + k * 1024); } while (0)
#define PG8_LDB(dst, b, h) do { _Pragma("unroll") for (int n = 0; n < 2; ++n) _Pragma("unroll") for (int k = 0; k < 2; ++k) dst[n][k] = *(const LAS bf16x8*)(lds + PG8_SB(b, h) + boff + n * 2048 + k * 1024); } while (0)
#define PG8_MMA(ai, bj, At, Bt) do { __builtin_amdgcn_s_setprio(1); _Pragma("unroll") for (int m = 0; m < 4; ++m) _Pragma("unroll") for (int n = 0; n < 2; ++n) _Pragma("unroll") for (int k = 0; k < 2; ++k) \
        acc[ai][bj][m][n] = __builtin_amdgcn_mfma_f32_16x16x32_bf16(Bt[n][k], At[m][k], acc[ai][bj][m][n], 0, 0, 0); __builtin_amdgcn_s_setprio(0); } while (0)
#define PG8_WAIT_V(n) asm volatile("s_waitcnt vmcnt(" #n ")" ::: "memory")
#define PG8_WAIT_L(n) asm volatile("s_waitcnt lgkmcnt(" #n ")" ::: "memory")
#define PG8_BAR __builtin_amdgcn_s_barrier()
#define PG8_SCHED __builtin_amdgcn_sched_barrier(0)
#define PG8_VOFFA(u, vo) do { _Pragma("unroll") for (int h = 0; h < 2; ++h) _Pragma("unroll") for (int i = 0; i < 2; ++i) { int R_, C_; stage_rc(tid * 16 + i * 8192, R_, C_); const int R = R_ + HALF * h; \
        int ridx = R; if (GATHER) { ridx = (R < (u).nvalid) ? ((u).rows[R] >> 1) : 0; } vo[h][i] = (unsigned)(ridx * lda + C_) * 2u; } if (GATHER) asm volatile("" :: "v"(vo[0][0]), "v"(vo[0][1]), "v"(vo[1][0]), "v"(vo[1][1])); } while (0)
    GU cur, nxt; int ui = 0;
    if (!S.next(0, cur)) return;
    f32x4 acc[2][2][4][2];
#pragma unroll
    for (int a = 0; a < 2; ++a)
#pragma unroll
        for (int b = 0; b < 2; ++b)
#pragma unroll
            for (int m = 0; m < 4; ++m)
#pragma unroll
                for (int n = 0; n < 2; ++n) acc[a][b][m][n] = (f32x4){0.f, 0.f, 0.f, 0.f};
    bf16x8 At[4][2], B0[2][2], B1[2][2];
    unsigned cv[2][2], nv[2][2];
    PG8_VOFFA(cur, cv);
    const char* cA = cur.A; const char* cB = cur.B;
    PG8_STAGEB(PG8_SB(0, 0), cB); PG8_STAGEB(PG8_SB(0, 1), cB + hstepB); PG8_STAGE2(PG8_SA(0, 0), cA, cv[0][0], cv[0][1]); PG8_STAGE2(PG8_SA(0, 1), cA, cv[1][0], cv[1][1]);
    if (wr == 1) PG8_BAR;
    PG8_WAIT_V(2); PG8_BAR;
    PG8_STAGEB(PG8_SB(1, 0), cB + kstep); PG8_STAGE2(PG8_SA(1, 0), cA + kstep, cv[0][0], cv[0][1]); PG8_STAGEB(PG8_SB(1, 1), cB + hstepB + kstep);
    PG8_WAIT_V(6); PG8_BAR;
    for (;;) {
        const bool has_next = S.next(ui + 1, nxt);
        const char* nA = has_next ? nxt.A : cA; const char* nB = has_next ? nxt.B : cB;
        if (has_next) { PG8_VOFFA(nxt, nv); } else {
#pragma unroll
            for (int h = 0; h < 2; ++h)
#pragma unroll
                for (int i = 0; i < 2; ++i) nv[h][i] = cv[h][i]; }
        for (int t = 0; t < nt; t += 2) {
            const bool last = (t == nt - 2);
            const char* a1 = cA + (size_t)(t + 1) * kstep;
            const char* a2 = last ? nA : cA + (size_t)(t + 2) * kstep; const char* b2 = last ? nB : cB + (size_t)(t + 2) * kstep;
            const char* a3 = a2 + kstep; const char* b3 = b2 + kstep;
            const unsigned w00 = last ? nv[0][0] : cv[0][0], w01 = last ? nv[0][1] : cv[0][1], w10 = last ? nv[1][0] : cv[1][0], w11 = last ? nv[1][1] : cv[1][1];
            PG8_LDB(B0, 0, 0); PG8_LDB(B1, 0, 1); PG8_SCHED; PG8_LDA(At, 0, 0); PG8_STAGE2(PG8_SA(1, 1), a1, cv[1][0], cv[1][1]);
            PG8_WAIT_V(8); PG8_WAIT_L(0); PG8_BAR; PG8_MMA(0, 0, At, B0); PG8_MMA(0, 1, At, B1); PG8_BAR; PG8_SCHED;
            PG8_LDA(At, 0, 1); PG8_STAGEB(PG8_SB(0, 0), b2); PG8_STAGEB(PG8_SB(0, 1), b2 + hstepB); PG8_STAGE2(PG8_SA(0, 0), a2, w00, w01);
            PG8_WAIT_V(8); PG8_WAIT_L(0); PG8_BAR; PG8_MMA(1, 0, At, B0); PG8_MMA(1, 1, At, B1); PG8_BAR; PG8_SCHED;
            PG8_LDB(B0, 1, 0); PG8_LDB(B1, 1, 1); PG8_SCHED; PG8_LDA(At, 1, 0); PG8_STAGE2(PG8_SA(0, 1), a2, w10, w11);
            PG8_WAIT_V(8); PG8_WAIT_L(0); PG8_BAR; PG8_MMA(0, 0, At, B0); PG8_MMA(0, 1, At, B1); PG8_BAR; PG8_SCHED;
            PG8_LDA(At, 1, 1); PG8_STAGEB(PG8_SB(1, 0), b3); PG8_STAGEB(PG8_SB(1, 1), b3 + hstepB); PG8_STAGE2(PG8_SA(1, 0), a3, w00, w01);
            PG8_WAIT_V(8); PG8_WAIT_L(0); PG8_BAR; PG8_MMA(1, 0, At, B0); PG8_MMA(1, 1, At, B1); PG8_BAR; PG8_SCHED;
        }
        if (wr == 0) PG8_BAR;
        E(acc, cur, wr, wc, fr, fq);
        if (!has_next) break;
#pragma unroll
        for (int a = 0; a < 2; ++a)
#pragma unroll
            for (int b = 0; b < 2; ++b)
#pragma unroll
                for (int m = 0; m < 4; ++m)
#pragma unroll
                    for (int n = 0; n < 2; ++n) acc[a][b][m][n] = (f32x4){0.f, 0.f, 0.f, 0.f};
        cur = nxt; cA = nA; cB = nB; ++ui;
#pragma unroll
        for (int h = 0; h < 2; ++h)
#pragma unroll
            for (int i = 0; i < 2; ++i) cv[h][i] = nv[h][i];
        if (wr == 1) PG8_BAR;
    }
    PG8_WAIT_V(0);
    PG8_BAR;
#undef PG8_SA
#undef PG8_SB
#undef PG8_STAGE2
#undef PG8_STAGEB
#undef PG8_LDA
#undef PG8_LDB
#undef PG8_MMA
#undef PG8_WAIT_V
#undef PG8_WAIT_L
#undef PG8_BAR
#undef PG8_SCHED
#undef PG8_VOFFA
}
}
using pg8::GU;

struct Args {
    const float* in[27]; float* out; unsigned char* ws; int ph_lo, ph_hi; int pad0, pad1;
};
enum { IN_X = 0, IN_MEM, IN_NORM_MIX_G, IN_W_IN, IN_W_RET_O, IN_W_NSA_O, IN_W_OUT, IN_CMP_PE_K, IN_CMP_W1_K, IN_CMP_W2_K, IN_CMP_PE_V, IN_CMP_W1_V, IN_CMP_W2_V,
       IN_NORM_X_G, IN_NORM_MEM_G, IN_W_XQ, IN_W_XKV, IN_W_XO, IN_NORM_FFN_G, IN_W_GRP, IN_B_GRP, IN_W_RT, IN_B_RT, IN_W_E1, IN_W_E3, IN_W_E2, IN_NORM_F_G };
struct Frame {
    LAS unsigned char* lds; volatile LAS unsigned* MISC; unsigned* ctl; unsigned char* ws;
    int tid, lane, wave, G, bx;
};

__device__ __forceinline__ bool phase_begin(Frame& F) { int t = threadIdx.x; LAUNDER(t); F.tid = t; F.lane = t & 63; return true; }
__device__ __forceinline__ void transpose_item(const float* W, int ldw, int c0, int k0, bf16* WT, int ldt, int mode, int row_off, int cbase, const float* kscale, float scale, LAS float* scr, int lane) {
    float vv[32];
#pragma unroll
    for (int i = 0; i < 32; ++i) { const int kk = 2 * i + (lane >> 5); vv[i] = W[(size_t)(k0 + kk) * ldw + c0 + (lane & 31)]; }
    if (kscale) {
#pragma unroll
        for (int i = 0; i < 32; ++i) { const int kk = 2 * i + (lane >> 5); vv[i] *= kscale[k0 + kk]; } }
#pragma unroll
    for (int i = 0; i < 32; ++i) { const int kk = 2 * i + (lane >> 5); scr[kk * 33 + (lane & 31)] = vv[i] * scale; }
    LDS_WAIT(); asm volatile("" ::: "memory");
    const int c = lane & 7;
#pragma unroll
    for (int j = 0; j < 4; ++j) { const int n = (lane >> 3) + 8 * j; const LAS float* s = scr + (8 * c) * 33 + n;
        u32x4 o; o.x = pk2(s[0 * 33], s[1 * 33]); o.y = pk2(s[2 * 33], s[3 * 33]); o.z = pk2(s[4 * 33], s[5 * 33]); o.w = pk2(s[6 * 33], s[7 * 33]);
        const int jc = c0 - cbase + n; const int drow = mode == 0 ? row_off + jc : (8 * (jc >> 2) + 4 * row_off + (jc & 3));
        *(u32x4*)(WT + (size_t)drow * ldt + k0 + 8 * c) = o; }
    LDS_WAIT(); asm volatile("" ::: "memory");
}
__device__ __forceinline__ void transpose_matrix(Frame& F, int& item_base, const float* W, int ldw, int K, int cbase, int ncols, bf16* WT, int ldt, int mode, int row_off, const float* kscale, float scale) {
    LAS float* scr = (LAS float*)(F.lds + F.wave * 16384);
    const int gw = F.bx * NWAVES + F.wave, NGW = F.G * NWAVES;
    const int nb = ncols / 32, nitems = (K / 64) * nb;
    int it = (gw - item_base % NGW + NGW) % NGW;
    for (; it < nitems; it += NGW) transpose_item(W, ldw, cbase + 32 * (it % nb), 64 * (it / nb), WT, ldt, mode, row_off, cbase, kscale, scale, scr, F.lane);
    item_base += nitems;
}
__device__ __forceinline__ void rms_row_to_bf16(int lane, const float* xrow, const float* g, bf16* orow) {
    const f32x4* xr = (const f32x4*)xrow + lane; const f32x4* gr = (const f32x4*)g + lane;
    f32x4 v[4]; float s = 0.f;
#pragma unroll
    for (int j = 0; j < 4; ++j) { v[j] = xr[64 * j]; s += (v[j].x * v[j].x + v[j].y * v[j].y) + (v[j].z * v[j].z + v[j].w * v[j].w); }
    const float rstd = 1.0f / sqrtf(wave_sum(s) * (1.f / D) + EPS);
    unsigned long long* o8 = (unsigned long long*)orow + lane;
#pragma unroll
    for (int j = 0; j < 4; ++j) { const f32x4 gg = gr[64 * j];
        o8[64 * j] = (unsigned long long)pk2(v[j].x * rstd * gg.x, v[j].y * rstd * gg.y) | ((unsigned long long)pk2(v[j].z * rstd * gg.z, v[j].w * rstd * gg.w) << 32); }
}

__device__ __forceinline__ void p0_prologue(Frame& F, const Args& a) {
    unsigned char* ws = F.ws;
    const float* w_in = a.in[IN_W_IN];
    int ib = 0;
    transpose_matrix(F, ib, w_in, DIN, D, 0, 512, (bf16*)(ws + W_IN), D, 0, 0, nullptr, 1.0f);
    transpose_matrix(F, ib, w_in, DIN, D, 512, 512, (bf16*)(ws + W_IN), D, 0, 512, nullptr, 0.08838834764831845f);
    transpose_matrix(F, ib, w_in, DIN, D, 1024, NPROJ - 1024, (bf16*)(ws + W_IN), D, 0, 1024, nullptr, 1.0f);
    transpose_matrix(F, ib, w_in, DIN, D, C_GA, 1024, (bf16*)(ws + W_GA), D, 0, 0, nullptr, 1.0f);
    transpose_matrix(F, ib, w_in, DIN, D, C_GB, 1024, (bf16*)(ws + W_GB), D, 0, 0, nullptr, 1.0f);
    transpose_matrix(F, ib, a.in[IN_W_RET_O], D, D, 0, D, (bf16*)(ws + W_RO), D, 0, 0, nullptr, 1.0f);
    transpose_matrix(F, ib, a.in[IN_W_NSA_O], D, D, 0, D, (bf16*)(ws + W_NO), D, 0, 0, nullptr, 1.0f);
    transpose_matrix(F, ib, a.in[IN_W_OUT], D, D, 0, D, (bf16*)(ws + W_OUT), D, 0, 0, nullptr, 1.0f);
    transpose_matrix(F, ib, a.in[IN_W_XQ], D, D, 0, D, (bf16*)(ws + W_XQ), D, 0, 0, a.in[IN_NORM_X_G], 1.0f);
    transpose_matrix(F, ib, a.in[IN_W_XO], D, D, 0, D, (bf16*)(ws + W_XO), D, 0, 0, nullptr, 1.0f);
    transpose_matrix(F, ib, a.in[IN_W_XKV], 2 * D, D, 0, 2 * D, (bf16*)(ws + W_XKV), D, 0, 0, nullptr, 1.0f);
    transpose_matrix(F, ib, a.in[IN_CMP_W1_K], 128, 4096, 0, 128, (bf16*)(ws + W_C1K), 4096, 0, 0, nullptr, 1.0f);
    transpose_matrix(F, ib, a.in[IN_CMP_W1_V], 128, 4096, 0, 128, (bf16*)(ws + W_C1V), 4096, 0, 0, nullptr, 1.0f);
    const int gt = F.bx * NTHREADS + F.tid, NGT = F.G * NTHREADS;
    for (int i = gt; i < 2 * 128 * 4096 / 8; i += NGT) { const int m = i / (128 * 4096 / 8), r = i % (128 * 4096 / 8);
        *(u32x4*)(ws + (m ? W_C1V : W_C1K) + (size_t)128 * 4096 * 2 + (size_t)r * 16) = (u32x4){0u, 0u, 0u, 0u}; }
    bf16* wngl = (bf16*)(ws + WS_SMALLW);
    for (int i = gt; i < 32 * 1024; i += NGT) { const int r = i >> 10, k = i & 1023; wngl[i] = r < 24 ? (bf16)f2bf(w_in[(size_t)k * DIN + C_NGL + r]) : (bf16)0; }
    bf16* w2k = (bf16*)(ws + WS_SMALLW + 65536); bf16* w2v = w2k + 128 * 128;
    for (int i = gt; i < 2 * 128 * 128; i += NGT) { const int m = i >> 14, r = i & 16383, f = r >> 7, e = r & 127; const float* src = a.in[m ? IN_CMP_W2_V : IN_CMP_W2_K];
        (m ? w2v : w2k)[f * 128 + e] = (bf16)f2bf(src[e * 128 + f]); }
    float* cbias = (float*)(ws + WS_SMALLW + 65536 + 2 * 128 * 128 * 2);
    const int gw = F.bx * NWAVES + F.wave, NGW = F.G * NWAVES;
    for (int o = gw; o < 256; o += NGW) { const int m = o >> 7, e = o & 127; const float* pe = a.in[m ? IN_CMP_PE_V : IN_CMP_PE_K]; const float* w1 = a.in[m ? IN_CMP_W1_V : IN_CMP_W1_K];
        float s = 0.f; for (int k = F.lane; k < 4096; k += 64) s += pe[k] * w1[(size_t)k * 128 + e];
        s = wave_sum(s); if (F.lane == 0) cbias[o] = s; }
    float* cosT = (float*)(ws + WS_ROPE_COS); float* sinT = (float*)(ws + WS_ROPE_SIN);
    for (int i = gt; i < SEQ * 64; i += NGT) { const int pos = i >> 6, j = i & 63; const float inv = powf(10000.0f, -(float)(2 * j) / 128.0f); const float ang = (float)pos * inv;
        cosT[i] = cosf(ang); sinT[i] = sinf(ang); }
    { f32x4 nx[4]; const float* X = a.in[IN_X]; const f32x4* gr = (const f32x4*)a.in[IN_NORM_MIX_G] + F.lane;
      if (gw < NTOK) {
#pragma unroll
          for (int j = 0; j < 4; ++j) nx[j] = ((const f32x4*)(X + (size_t)gw * D) + F.lane)[64 * j]; }
      for (int m = gw; m < NTOK; m += NGW) { f32x4 v[4]; float sq = 0.f;
#pragma unroll
          for (int j = 0; j < 4; ++j) { v[j] = nx[j]; sq += (v[j].x * v[j].x + v[j].y * v[j].y) + (v[j].z * v[j].z + v[j].w * v[j].w); }
          if (m + NGW < NTOK) {
#pragma unroll
              for (int j = 0; j < 4; ++j) nx[j] = ((const f32x4*)(X + (size_t)(m + NGW) * D) + F.lane)[64 * j]; }
          const float rstd = 1.0f / sqrtf(wave_sum(sq) * (1.f / D) + EPS); unsigned long long* o8 = (unsigned long long*)((bf16*)(ws + WS_H) + (size_t)m * D) + F.lane;
#pragma unroll
          for (int j = 0; j < 4; ++j) { const f32x4 gg = gr[64 * j]; o8[64 * j] = (unsigned long long)pk2(v[j].x * rstd * gg.x, v[j].y * rstd * gg.y) | ((unsigned long long)pk2(v[j].z * rstd * gg.z, v[j].w * rstd * gg.w) << 32); } } }
    for (int m = gw; m < NMEMTOK; m += NGW) rms_row_to_bf16(F.lane, a.in[IN_MEM] + (size_t)m * D, a.in[IN_NORM_MEM_G], (bf16*)(ws + WS_MEMN) + (size_t)m * D);
}

struct SchedP1 {
    unsigned char* ws; int G, c;
    __device__ __forceinline__ bool next(int i, GU& u) const {
        constexpr int NP = 128 * 22; const int L = i * G + c;
        u.rows = nullptr; u.nvalid = 0; u.aux = 0;
        if (L < NP) { int pm, pn; pg8::tile_map(L, 128, 22, pm, pn); u.A = (const char*)ws + WS_H + (size_t)pm * 256 * D * 2; u.B = (const char*)ws + W_IN + (size_t)pn * 256 * D * 2; u.pm = pm; u.pn = pn;
            u.kind = pn < 2 ? 0 : pn < 4 ? 1 : pn < 8 ? 2 : pn < 12 ? 3 : pn < 16 ? 4 : 5; return true; }
        const int L2 = L - NP; if (L2 >= 64) return false;
        const int pm = L2 & 7, pn = L2 >> 3; u.A = (const char*)ws + WS_MEMN + (size_t)pm * 256 * D * 2; u.B = (const char*)ws + W_XKV + (size_t)pn * 256 * D * 2; u.pm = pm; u.pn = pn; u.kind = 6; return true;
    }
};
struct EpiP1 {
    static constexpr bool PERM = true;
    unsigned char* ws;
    __device__ __forceinline__ void operator()(const f32x4 (&acc)[2][2][4][2], const GU& u, int wr, int wc, int fr, int fq) const {
        const int kind = u.kind;
        const float* cosT = (const float*)(ws + WS_ROPE_COS); const float* sinT = (const float*)(ws + WS_ROPE_SIN);
#pragma unroll
        for (int ai = 0; ai < 2; ++ai)
#pragma unroll
            for (int m = 0; m < 4; ++m) {
                const int r = 128 * ai + 64 * wr + 16 * m + fr; const int tok = u.pm * 256 + r;
#pragma unroll
                for (int bj = 0; bj < 2; ++bj) {
                    f32x4 v0 = acc[ai][bj][m][0], v1 = acc[ai][bj][m][1];
                    const int ct = 128 * bj + 32 * wc + 8 * fq;
                    bf16* dst;
                    if (kind <= 1) {
                        const int s = tok & (SEQ - 1), i0 = ((ct & 127) >> 1);
                        const f32x4 cs = *(const f32x4*)(cosT + s * 64 + i0), sn = *(const f32x4*)(sinT + s * 64 + i0);
                        const f32x4 a0 = v0, a1 = v1;
                        v0[0] = a0[0] * cs[0] - a0[1] * sn[0]; v0[1] = a0[0] * sn[0] + a0[1] * cs[0];
                        v0[2] = a0[2] * cs[1] - a0[3] * sn[1]; v0[3] = a0[2] * sn[1] + a0[3] * cs[1];
                        v1[0] = a1[0] * cs[2] - a1[1] * sn[2]; v1[1] = a1[0] * sn[2] + a1[1] * cs[2];
                        v1[2] = a1[2] * cs[3] - a1[3] * sn[3]; v1[3] = a1[2] * sn[3] + a1[3] * cs[3];
                        dst = (bf16*)(ws + (kind == 0 ? WS_RQ : WS_RK)) + (size_t)tok * 512 + (u.pn & 1) * 256 + ct;
                    } else if (kind == 2) { dst = (bf16*)(ws + WS_RV) + (size_t)tok * 1024 + (u.pn - 4) * 256 + ct;
                    } else if (kind == 3) {
#pragma unroll
                        for (int j = 0; j < 4; ++j) { v0[j] = v0[j] * sigmoidf_(v0[j]); v1[j] = v1[j] * sigmoidf_(v1[j]); }
                        dst = (bf16*)(ws + WS_RG) + (size_t)tok * 1024 + (u.pn - 8) * 256 + ct;
                    } else if (kind == 4) { dst = (bf16*)(ws + WS_NQ) + (size_t)tok * 1024 + (u.pn - 12) * 256 + ct;
                    } else if (kind == 5) {
                        const int b = tok >> 12, s = tok & (SEQ - 1);
                        unsigned char* kvb = ws + WS_KV6 + (size_t)(u.pn - 16) * KV_STRIDE;
                        dst = (bf16*)kvb + ((size_t)(b * 2 + bj) * SEQ + s) * 128 + (ct & 127);
                    } else { dst = (bf16*)(ws + WS_MEMKV) + (size_t)tok * 2048 + u.pn * 256 + ct; }
                    u32x4 w; w.x = cvt_pk_bf16(v0[0], v0[1]); w.y = cvt_pk_bf16(v0[2], v0[3]); w.z = cvt_pk_bf16(v1[0], v1[1]); w.w = cvt_pk_bf16(v1[2], v1[3]);
                    *(u32x4*)dst = w;
                }
            }
    }
};
__device__ __forceinline__ void p1_gate_logits(Frame& F) {
    const bf16* H = (const bf16*)(F.ws + WS_H); const bf16* W = (const bf16*)(F.ws + WS_SMALLW); float* gates = (float*)(F.ws + WS_GATES);
    const int gw = F.bx * NWAVES + F.wave, NGW = F.G * NWAVES; const int r = F.lane & 31, hh = F.lane >> 5;
    for (int rb = gw; rb < NTOK / 32; rb += NGW) {
        f32x16 acc; for (int j = 0; j < 16; ++j) acc[j] = 0.f;
        const bf16* ap = H + (size_t)(rb * 32 + r) * D + 8 * hh; const bf16* bp = W + (size_t)r * D + 8 * hh;
        for (int s8 = 0; s8 < 8; ++s8) { bf16x8 av[8], bv[8];
#pragma unroll
            for (int q = 0; q < 8; ++q) { av[q] = *(const bf16x8*)(ap + 16 * (8 * s8 + q)); bv[q] = *(const bf16x8*)(bp + 16 * (8 * s8 + q)); }
#pragma unroll
            for (int q = 0; q < 8; ++q) acc = __builtin_amdgcn_mfma_f32_32x32x16_bf16(av[q], bv[q], acc, 0, 0, 0); }
        if (r < 24) {
#pragma unroll
            for (int reg = 0; reg < 16; ++reg) { const int row = (reg & 3) + 8 * (reg >> 2) + 4 * hh; gates[(size_t)(rb * 32 + row) * 24 + r] = sigmoidf_(acc[reg]); }
        }
    }
}

namespace retf {
constexpr int ROWB = 272;
constexpr int OFF_K = 0, OFF_V = 128 * 256, OFF_ZV = OFF_V + 128 * 64, OFF_ST = OFF_ZV + 128 * 64, OFF_PART = OFF_ST + 32 * ROWB, OFF_Q = OFF_PART + 4 * 4096;
static_assert(OFF_Q + 128 * 256 <= RING_BYTES, "retention LDS map");
typedef short s16x4 __attribute__((ext_vector_type(4)));
__device__ __forceinline__ u32x2 lds_tr(const LAS unsigned char* p) { return __builtin_bit_cast(u32x2, __builtin_amdgcn_ds_read_tr16_b64_v4i16((LAS s16x4*)p)); }
}
__device__ __forceinline__ void p2_retention_fast(Frame& F, int unit, bf16* outbase) {
    using namespace retf;
    const int bh = (unit & 7) * 4 + (unit >> 6), sl = (unit >> 3) & 7, b = bh >> 2, h = bh & 3;
    const bf16* rq = (const bf16*)(F.ws + WS_RQ); const bf16* rk = (const bf16*)(F.ws + WS_RK); const bf16* rv = (const bf16*)(F.ws + WS_RV);
    const int tid = F.tid, lane = F.lane, wave = F.wave, r = lane & 31, hi = lane >> 5; LAS unsigned char* lds = F.lds;
    const float lg = log2f(1.0f - exp2f(-5.0f - (float)h));
    const int nt = wave & 3, mh = wave >> 2;
    for (int i = tid; i < 32 * ROWB / 4; i += NTHREADS) ((LAS unsigned*)(lds + OFF_ST))[i] = 0u;
    f32x16 ST;
#pragma unroll
    for (int j = 0; j < 16; ++j) ST[j] = 0.f;
    const float gC = exp2f(128.0f * lg);
    const float zeta = exp2f((float)(127 - (tid >> 2)) * lg);
    const int blk = (lane >> 4) & 1, q4 = (lane & 15) >> 2, p4 = lane & 3;
    const int vtr = (4 * hi + q4) * 64 + 32 * blk + 8 * p4;
    const int ztr = (8 * hi + q4) * 64 + 32 * blk + 8 * p4;
    int ktr[2];
#pragma unroll
    for (int t = 0; t < 2; ++t) ktr[t] = 256 * (8 * hi + 4 * t + q4) + 16 * ((4 * nt + 2 * blk + (p4 >> 1)) ^ ((q4 << 2) | ((2 * hi + t) & 3))) + 8 * (p4 & 1);
    const int krow = 256 * r + 16 * (hi ^ (((r & 3) << 2) | ((r >> 2) & 3)));
    u32x4 kreg[4], qreg[4], vreg;
    {   const int tok0 = b * SEQ;
#pragma unroll
        for (int i = 0; i < 4; ++i) { const int p = tid + 512 * i, m = p >> 4, cc = p & 15; kreg[i] = *(const u32x4*)(rk + (size_t)(tok0 + m) * 512 + h * 128 + cc * 8); qreg[i] = *(const u32x4*)(rq + (size_t)(tok0 + m) * 512 + h * 128 + cc * 8); }
        { const int m = tid >> 2, cc = tid & 3; vreg = *(const u32x4*)(rv + (size_t)(tok0 + m) * 1024 + h * 256 + sl * 32 + cc * 8); } }
    u32x2 opk[4]; bf16* oprev = outbase;
#pragma unroll
    for (int i = 0; i < 4; ++i) opk[i] = (u32x2){0u, 0u};
    for (int c = 0; c < SEQ / 128; ++c) {
        const int tok0 = b * SEQ + c * 128;
        __syncthreads();
#pragma unroll
        for (int i = 0; i < 4; ++i) { const int p = tid + 512 * i, m = p >> 4, cc = p & 15; const int o_ = 256 * m + 16 * (cc ^ (((m & 3) << 2) | ((m >> 2) & 3)));
            *(LAS u32x4*)(lds + OFF_K + o_) = kreg[i]; *(LAS u32x4*)(lds + OFF_Q + o_) = qreg[i]; }
        { const u32x4 v = vreg; u32x4 zv;
            zv.x = cvt_pk_bf16(lo16(v.x) * zeta, hi16(v.x) * zeta); zv.y = cvt_pk_bf16(lo16(v.y) * zeta, hi16(v.y) * zeta); zv.z = cvt_pk_bf16(lo16(v.z) * zeta, hi16(v.z) * zeta); zv.w = cvt_pk_bf16(lo16(v.w) * zeta, hi16(v.w) * zeta);
            *(LAS u32x4*)(lds + OFF_V + tid * 16) = v; *(LAS u32x4*)(lds + OFF_ZV + tid * 16) = zv; }
        __syncthreads();
        if (mh == 0 && c > 0) {
#pragma unroll
            for (int i = 0; i < 4; ++i) *(u32x2*)(oprev + 8 * i + 4 * hi) = opk[i]; }
        if (c + 1 < SEQ / 128) { const int tok1 = tok0 + 128;
#pragma unroll
            for (int i = 0; i < 4; ++i) { const int p = tid + 512 * i, m = p >> 4, cc = p & 15; kreg[i] = *(const u32x4*)(rk + (size_t)(tok1 + m) * 512 + h * 128 + cc * 8); qreg[i] = *(const u32x4*)(rq + (size_t)(tok1 + m) * 512 + h * 128 + cc * 8); }
            { const int m = tid >> 2, cc = tid & 3; vreg = *(const u32x4*)(rv + (size_t)(tok1 + m) * 1024 + h * 256 + sl * 32 + cc * 8); } }
        bf16x8 qf[8];
#pragma unroll
        for (int s_ = 0; s_ < 8; ++s_) qf[s_] = *(const LAS bf16x8*)(lds + OFF_Q + 8192 * nt + (krow ^ (32 * s_)));
        f32x16 CR;
#pragma unroll
        for (int j = 0; j < 16; ++j) CR[j] = 0.f;
        if (mh == 0) {
#pragma unroll
            for (int s_ = 0; s_ < 8; ++s_) { const bf16x8 a = *(const LAS bf16x8*)(lds + OFF_ST + r * ROWB + (16 * s_ + 8 * hi) * 2); CR = __builtin_amdgcn_mfma_f32_32x32x16_bf16(a, qf[s_], CR, 0, 0, 0); }
        }
        f32x16 IN_;
#pragma unroll
        for (int j = 0; j < 16; ++j) IN_[j] = 0.f;
#pragma unroll
        for (int mi = 0; mi < 2; ++mi) { const int mt = 2 * mh + mi;
            if (mt <= nt) {
                f32x16 A;
#pragma unroll
                for (int j = 0; j < 16; ++j) A[j] = 0.f;
#pragma unroll
                for (int s_ = 0; s_ < 8; ++s_) { const bf16x8 a = *(const LAS bf16x8*)(lds + OFF_K + 8192 * mt + (krow ^ (32 * s_))); A = __builtin_amdgcn_mfma_f32_32x32x16_bf16(a, qf[s_], A, 0, 0, 0); }
#pragma unroll
                for (int j = 0; j < 16; ++j) { const int dd = (32 * nt + r) - (32 * mt + (j & 3) + 8 * (j >> 2) + 4 * hi); A[j] = dd >= 0 ? A[j] * __builtin_amdgcn_exp2f((float)dd * lg) : 0.f; }
#pragma unroll
                for (int s2 = 0; s2 < 2; ++s2) { u32x4 w; w.x = cvt_pk_bf16(A[8 * s2 + 0], A[8 * s2 + 1]); w.y = cvt_pk_bf16(A[8 * s2 + 2], A[8 * s2 + 3]); w.z = cvt_pk_bf16(A[8 * s2 + 4], A[8 * s2 + 5]); w.w = cvt_pk_bf16(A[8 * s2 + 6], A[8 * s2 + 7]);
                    const LAS unsigned char* vp = lds + OFF_V + vtr + (32 * mt + 16 * s2) * 64; const u32x2 lo = lds_tr(vp), hi2 = lds_tr(vp + 8 * 64);
                    IN_ = __builtin_amdgcn_mfma_f32_32x32x16_bf16(__builtin_bit_cast(bf16x8, (u32x4){lo.x, lo.y, hi2.x, hi2.y}), __builtin_bit_cast(bf16x8, w), IN_, 0, 0, 0); }
            } }
        if (mh == 1) {
#pragma unroll
            for (int j = 0; j < 16; ++j) ((LAS float*)(lds + OFF_PART))[(nt * 16 + j) * 64 + lane] = IN_[j];
        }
        __syncthreads();
        if (mh == 0) {
            const float xi = __builtin_amdgcn_exp2f((float)(32 * nt + r + 1) * lg);
            bf16* orow = outbase + (size_t)(tok0 + 32 * nt + r) * 1024 + h * 256 + sl * 32;
#pragma unroll
            for (int q4_ = 0; q4_ < 4; ++q4_) { float o_[4];
#pragma unroll
                for (int e = 0; e < 4; ++e) { const int j = 4 * q4_ + e; o_[e] = IN_[j] + ((const LAS float*)(lds + OFF_PART))[(nt * 16 + j) * 64 + lane] + xi * CR[j]; }
                opk[q4_] = (u32x2){cvt_pk_bf16(o_[0], o_[1]), cvt_pk_bf16(o_[2], o_[3])}; }
            oprev = orow;
        } else {
#pragma unroll
            for (int j = 0; j < 16; ++j) ST[j] *= gC;
#pragma unroll
            for (int s_ = 0; s_ < 8; ++s_) {
                const LAS unsigned char* zp = lds + OFF_ZV + ztr + (16 * s_) * 64; const u32x2 z0 = lds_tr(zp), z1 = lds_tr(zp + 4 * 64);
                const u32x2 k0 = lds_tr(lds + OFF_K + ktr[0] + 4096 * s_), k1 = lds_tr(lds + OFF_K + ktr[1] + 4096 * s_);
                ST = __builtin_amdgcn_mfma_f32_32x32x16_bf16(__builtin_bit_cast(bf16x8, (u32x4){z0.x, z0.y, z1.x, z1.y}), __builtin_bit_cast(bf16x8, (u32x4){k0.x, k0.y, k1.x, k1.y}), ST, 0, 0, 0); }
#pragma unroll
            for (int j = 0; j < 16; ++j) { const int dv = (j & 3) + 8 * (j >> 2) + 4 * hi; ((LAS unsigned short*)(lds + OFF_ST))[dv * (ROWB / 2) + 32 * nt + r] = (unsigned short)f2bf(ST[j]); }
        }
    }
    if (mh == 0) {
#pragma unroll
        for (int i = 0; i < 4; ++i) *(u32x2*)(oprev + 8 * i + 4 * hi) = opk[i]; }
    __syncthreads();
}
__device__ __forceinline__ void transpose_kv_tiles(Frame& F, const bf16* src, bf16* dst, int w0, int nw) {
    LAS unsigned short* tl_ = (LAS unsigned short*)(F.lds + F.wave * 16384); const int lane = F.lane;
    for (int tile = w0; tile < 16 * 64 * 2; tile += nw) {
        const int dh = tile & 1, st = (tile >> 1) & 63, bg = tile >> 7;
        const bf16* sp = src + ((size_t)bg * SEQ + st * 64) * 128 + dh * 64; bf16* dp = dst + ((size_t)bg * 128 + dh * 64) * SEQ + st * 64;
#pragma unroll
        for (int i = 0; i < 8; ++i) { const int row = i * 8 + (lane >> 3), c = lane & 7; const u32x4 v = *(const u32x4*)(sp + (size_t)row * 128 + c * 8); LAS unsigned short* q = tl_ + row * 66 + c * 8;
            q[0] = (unsigned short)(v.x & 0xffffu); q[1] = (unsigned short)(v.x >> 16); q[2] = (unsigned short)(v.y & 0xffffu); q[3] = (unsigned short)(v.y >> 16);
            q[4] = (unsigned short)(v.z & 0xffffu); q[5] = (unsigned short)(v.z >> 16); q[6] = (unsigned short)(v.w & 0xffffu); q[7] = (unsigned short)(v.w >> 16); }
        LDS_WAIT(); asm volatile("" ::: "memory");
#pragma unroll
        for (int i = 0; i < 8; ++i) { const int d = i * 8 + (lane >> 3), c = lane & 7; const LAS unsigned short* q = tl_ + (c * 8) * 66 + d;
            u32x4 o; o.x = (unsigned)q[0] | ((unsigned)q[66] << 16); o.y = (unsigned)q[2 * 66] | ((unsigned)q[3 * 66] << 16); o.z = (unsigned)q[4 * 66] | ((unsigned)q[5 * 66] << 16); o.w = (unsigned)q[6 * 66] | ((unsigned)q[7 * 66] << 16);
            *(u32x4*)(dp + (size_t)d * SEQ + c * 8) = o; }
        LDS_WAIT(); asm volatile("" ::: "memory");
    }
}
struct SchedCmp {
    unsigned char* ws; int first, G, c;
    __device__ __forceinline__ bool next(int i, GU& u) const {
        const int L = i * G + c - first; if (L < 0 || L >= 256) return false;
        const int ks = L & 7, mb = L >> 3, m = mb >> 4, bg = mb & 15;
        u.A = (const char*)ws + WS_KV6 + (size_t)m * KV_STRIDE + (size_t)bg * SEQ * 128 * 2 + (size_t)ks * 512 * 2; u.B = (const char*)ws + (m ? W_C1V : W_C1K) + (size_t)ks * 512 * 2;
        u.pm = mb; u.pn = 0; u.kind = ks; u.rows = nullptr; u.nvalid = 0; u.aux = 0; return true;
    }
};
struct EpiCmp {
    static constexpr bool PERM = false;
    float* hid;
    __device__ __forceinline__ void operator()(const f32x4 (&acc)[2][2][4][2], const GU& u, int wr, int wc, int fr, int fq) const {
#pragma unroll
        for (int ai = 0; ai < 2; ++ai)
#pragma unroll
            for (int m = 0; m < 4; ++m) { const int r = 128 * ai + 64 * wr + 16 * m + fr; float* rowp = hid + (size_t)u.kind * (32 * 256 * 128) + ((size_t)u.pm * 256 + r) * 128 + 32 * wc + 4 * fq;
#pragma unroll
                for (int n = 0; n < 2; ++n) *(f32x4*)(rowp + 16 * n) = acc[ai][0][m][n]; }
    }
};
__device__ __forceinline__ float gelu_tanh(float x) { const float u = 0.7978845608028654f * (x + 0.044715f * x * x * x); return 0.5f * x * (1.0f + tanhf(u)); }
__device__ __forceinline__ void p2b_compress_out(Frame& F, const Args& a) {
    const float* hid = (const float*)a.out + (size_t)16 * MiB; const float* cbias = (const float*)(F.ws + WS_SMALLW + 65536 + 2 * 128 * 128 * 2);
    const int gw = F.bx * NWAVES + F.wave, NGW = F.G * NWAVES;
    for (int row = gw; row < 2 * 16 * 256; row += NGW) {
        const int m = row >> 12, n = row & 255; const float* w2 = a.in[m ? IN_CMP_W2_V : IN_CMP_W2_K];
        bf16* dst = (bf16*)(F.ws + (m ? WS_VCMP : WS_KCMP)) + (size_t)(row & 4095) * 128;
        float o0 = 0.f, o1 = 0.f;
        if (n < 255) { const float* hr = hid + (size_t)row * 128;
            for (int e = 0; e < 128; ++e) { float hsum = 0.f;
#pragma unroll
                for (int ks = 0; ks < 8; ++ks) hsum += hr[(size_t)ks * (32 * 256 * 128) + e];
                const float g = gelu_tanh(hsum + cbias[m * 128 + e]); o0 += g * w2[e * 128 + F.lane]; o1 += g * w2[e * 128 + 64 + F.lane]; } }
        dst[F.lane] = (bf16)f2bf(o0); dst[64 + F.lane] = (bf16)f2bf(o1);
        if (m == 1) { bf16* dt = (bf16*)(F.ws + WS_VCMPT) + (size_t)((row >> 8) & 15) * 128 * 256 + n; dt[(size_t)F.lane * 256] = (bf16)f2bf(o0); dt[(size_t)(64 + F.lane) * 256] = (bf16)f2bf(o1); }
    }
}

__device__ __forceinline__ void p3_ret_normalize(Frame& F) {
    bf16* rv = (bf16*)(F.ws + WS_RV); const bf16* rg = (const bf16*)(F.ws + WS_RG);
    const int gw = F.bx * NWAVES + F.wave, NGW = F.G * NWAVES;
    for (int it = gw; it < NTOK * 4; it += NGW) {
        u32x2* p = (u32x2*)(rv + (size_t)it * 256) + F.lane; const u32x2 w = *p; const u32x2 gq = *((const u32x2*)(rg + (size_t)it * 256) + F.lane);
        const float o0 = lo16(w.x), o1 = hi16(w.x), o2 = lo16(w.y), o3 = hi16(w.y);
        const float ss = wave_sum((o0 * o0 + o1 * o1) + (o2 * o2 + o3 * o3));
        const float r = 1.0f / sqrtf(ss * (1.0f / 256.0f) + EPS);
        u32x2 q; q.x = pk2(o0 * r * lo16(gq.x), o1 * r * hi16(gq.x)); q.y = pk2(o2 * r * lo16(gq.y), o3 * r * hi16(gq.y)); *p = q;
    }
}
namespace nsaf {
constexpr int KROW = 272, VROW = 136, KT_BYTES = 64 * KROW, VT_BYTES = 128 * VROW;
constexpr int OFF_K = 0, OFF_V = KT_BYTES, BUF_BYTES = KT_BYTES + VT_BYTES, OFF_IMP = 2 * BUF_BYTES, OFF_MASK = OFF_IMP + 64 * 64 * 4;
constexpr float NEG = -1.0e30f, MASKED = -3.0e38f, CS = 0.08838834764831845f * 1.4426950408889634f;
struct Stage { u32x4 k0, k1, v0, v1; };
__device__ __forceinline__ void stage_load(Stage& st, const bf16* K, const bf16* VT, size_t vpitch, int key0, int tid) {
    const int r0 = tid >> 4, c0 = tid & 15;
    st.k0 = *(const u32x4*)(K + (size_t)(key0 + r0) * 128 + c0 * 8); st.k1 = *(const u32x4*)(K + (size_t)(key0 + r0 + 32) * 128 + c0 * 8);
    const int d0 = tid >> 3, c1 = tid & 7;
    st.v0 = *(const u32x4*)(VT + (size_t)d0 * vpitch + key0 + c1 * 8); st.v1 = *(const u32x4*)(VT + (size_t)(d0 + 64) * vpitch + key0 + c1 * 8);
}
__device__ __forceinline__ void stage_write(const Stage& st, LAS unsigned char* lds, int tid) {
    const int r0 = tid >> 4, c0 = tid & 15;
    *(LAS u32x4*)(lds + OFF_K + r0 * KROW + c0 * 16) = st.k0; *(LAS u32x4*)(lds + OFF_K + (r0 + 32) * KROW + c0 * 16) = st.k1;
    const int d0 = tid >> 3, c1 = tid & 7;
    LAS unsigned char* p0 = lds + OFF_V + d0 * VROW + c1 * 16; LAS unsigned char* p1 = lds + OFF_V + (d0 + 64) * VROW + c1 * 16;
    *(LAS u32x2*)p0 = (u32x2){st.v0.x, st.v0.y}; *(LAS u32x2*)(p0 + 8) = (u32x2){st.v0.z, st.v0.w};
    *(LAS u32x2*)p1 = (u32x2){st.v1.x, st.v1.y}; *(LAS u32x2*)(p1 + 8) = (u32x2){st.v1.z, st.v1.w};
}
template <int MODE>
__device__ __forceinline__ void block_step(const LAS unsigned char* lds, LAS unsigned char* ldstab, const bf16x8 (&qf)[8], f32x16 (&O)[4], float& m, float& l, int blk, int jfast, int tl_in, int itile, int nvr_in, bool rowsel, float inv_l, int lane_in) {
    int tl = tl_in, nvr = nvr_in, lane = lane_in; LAUNDER(tl); LAUNDER(nvr); LAUNDER(lane);
    const int r = lane & 31, hi = lane >> 5;
    f32x16 S[2];
#pragma unroll
    for (int kh = 0; kh < 2; ++kh) {
#pragma unroll
        for (int j = 0; j < 16; ++j) S[kh][j] = 0.f;
    }
    {
        const unsigned kaddr = (unsigned)(size_t)(lds + OFF_K + r * KROW + 16 * hi);
        u32x4 ka[4], kb[4];
#define NSAF_KRD(dst, t, s4) asm volatile("ds_read_b128 %0, %1 offset:%2" : "=v"(dst) : "v"(kaddr), "i"((t) * 32 * KROW + (s4) * 32))
#define NSAF_KRD4(set, t, s0) do { NSAF_KRD(set[0], t, (s0)); NSAF_KRD(set[1], t, (s0) + 1); NSAF_KRD(set[2], t, (s0) + 2); NSAF_KRD(set[3], t, (s0) + 3); } while (0)
#define NSAF_KWAIT(n, set) asm volatile("s_waitcnt lgkmcnt(" #n ")" : "+v"(set[0]), "+v"(set[1]), "+v"(set[2]), "+v"(set[3]))
#define NSAF_KMMA(set, t, s0) do { _Pragma("unroll") for (int q_ = 0; q_ < 4; ++q_) S[t] = __builtin_amdgcn_mfma_f32_32x32x16_bf16(__builtin_bit_cast(bf16x8, set[q_]), qf[(s0) + q_], S[t], 0, 0, 0); } while (0)
        NSAF_KRD4(ka, 0, 0); NSAF_KRD4(kb, 0, 4);
        NSAF_KWAIT(4, ka); NSAF_KMMA(ka, 0, 0); NSAF_KRD4(ka, 1, 0);
        NSAF_KWAIT(4, kb); NSAF_KMMA(kb, 0, 4); NSAF_KRD4(kb, 1, 4);
        NSAF_KWAIT(4, ka); NSAF_KMMA(ka, 1, 0);
        NSAF_KWAIT(0, kb); NSAF_KMMA(kb, 1, 4);
#undef NSAF_KRD
#undef NSAF_KRD4
#undef NSAF_KWAIT
#undef NSAF_KMMA
    }
    bool need_mask;
    if (MODE <= 1) need_mask = true; else if (MODE == 2) need_mask = (blk == itile); else need_mask = (blk == itile) || (blk == itile - 8);
    if (MODE >= 2 && !need_mask && blk >= jfast) {
        const float msub = (MODE == 2 && !rowsel) ? 3.0e38f : m;
        float rs = 0.f;
#pragma unroll
        for (int kh = 0; kh < 2; ++kh)
#pragma unroll
            for (int j = 0; j < 16; ++j) { const float p = __builtin_amdgcn_exp2f(S[kh][j] - msub); S[kh][j] = p; rs += p; }
        l += rs;
    } else {
    float mx = MASKED;
    if (need_mask) {
        int lo_ = -1, hi_ = 63;
        if (MODE <= 1) hi_ = nvr - 64 * blk - 1; else if (MODE == 2) hi_ = tl; else { hi_ = (blk == itile) ? tl : 63; lo_ = (blk == itile - 8) ? tl : -1; }
        lo_ -= 4 * hi; hi_ -= 4 * hi;
#pragma unroll
        for (int kh = 0; kh < 2; ++kh)
#pragma unroll
            for (int j = 0; j < 16; ++j) { const int kc_ = 32 * kh + (j & 3) + 8 * (j >> 2); const bool ok = (kc_ > lo_) & (kc_ <= hi_); const float v = ok ? S[kh][j] : MASKED; S[kh][j] = v; mx = fmaxf(mx, v); }
    } else {
#pragma unroll
        for (int kh = 0; kh < 2; ++kh)
#pragma unroll
            for (int j = 0; j < 16; ++j) mx = fmaxf(mx, S[kh][j]);
    }
    if (MODE == 2) mx = rowsel ? mx : MASKED;
    if (MODE == 1) {
        LAS float* imp = (LAS float*)(ldstab + OFF_IMP) + tl * 64;
#pragma unroll
        for (int kh = 0; kh < 2; ++kh)
#pragma unroll
            for (int j = 0; j < 16; ++j) { const int n = 64 * blk + 32 * kh + (j & 3) + 8 * (j >> 2) + 4 * hi; const float v = S[kh][j]; const float p = __builtin_amdgcn_exp2f(v - m) * inv_l; S[kh][j] = p;
                if (v > 0.5f * MASKED) { __hip_atomic_fetch_add(imp + (n >> 2), p, __ATOMIC_RELAXED, __HIP_MEMORY_SCOPE_WORKGROUP); if ((n & 3) == 3 && (n >> 2) + 1 < 64) __hip_atomic_fetch_add(imp + (n >> 2) + 1, p, __ATOMIC_RELAXED, __HIP_MEMORY_SCOPE_WORKGROUP); } }
    } else {
        mx = fmaxf(mx, __shfl_xor(mx, 32));
        if (__any(mx > m + 8.0f)) { const float mn = fmaxf(m, mx); const float alpha = __builtin_amdgcn_exp2f(m - mn); m = mn; l *= alpha;
            if (MODE != 0) {
#pragma unroll
                for (int dt = 0; dt < 4; ++dt)
#pragma unroll
                    for (int j = 0; j < 16; ++j) O[dt][j] *= alpha; } }
        float rs = 0.f;
        if (MODE == 2) {
#pragma unroll
            for (int kh = 0; kh < 2; ++kh)
#pragma unroll
                for (int j = 0; j < 16; ++j) { const float p = rowsel ? __builtin_amdgcn_exp2f(S[kh][j] - m) : 0.f; S[kh][j] = p; rs += p; }
        } else {
#pragma unroll
            for (int kh = 0; kh < 2; ++kh)
#pragma unroll
                for (int j = 0; j < 16; ++j) { const float p = __builtin_amdgcn_exp2f(S[kh][j] - m); S[kh][j] = p; rs += p; }
        }
        l += rs;
        if (MODE == 0) return;
    }
    }
    bf16x8 pf[2][2];
#pragma unroll
    for (int kh = 0; kh < 2; ++kh)
#pragma unroll
        for (int s2 = 0; s2 < 2; ++s2) { u32x4 w; w.x = cvt_pk_bf16(S[kh][8 * s2 + 0], S[kh][8 * s2 + 1]); w.y = cvt_pk_bf16(S[kh][8 * s2 + 2], S[kh][8 * s2 + 3]); w.z = cvt_pk_bf16(S[kh][8 * s2 + 4], S[kh][8 * s2 + 5]); w.w = cvt_pk_bf16(S[kh][8 * s2 + 6], S[kh][8 * s2 + 7]);
            pf[kh][s2] = __builtin_bit_cast(bf16x8, w); }
    {
        const unsigned vaddr = (unsigned)(size_t)(lds + OFF_V + r * VROW + 8 * hi);
        u32x2 va[8], vb[8];
#define NSAF_VRD(dst, dt, i) asm volatile("ds_read_b64 %0, %1 offset:%2" : "=v"(dst) : "v"(vaddr), "i"((dt) * 32 * VROW + ((i) >> 1) * 32 + ((i) & 1) * 16))
#define NSAF_VRD8(set, dt) do { NSAF_VRD(set[0], dt, 0); NSAF_VRD(set[1], dt, 1); NSAF_VRD(set[2], dt, 2); NSAF_VRD(set[3], dt, 3); NSAF_VRD(set[4], dt, 4); NSAF_VRD(set[5], dt, 5); NSAF_VRD(set[6], dt, 6); NSAF_VRD(set[7], dt, 7); } while (0)
#define NSAF_VWAIT(n, set) asm volatile("s_waitcnt lgkmcnt(" #n ")" : "+v"(set[0]), "+v"(set[1]), "+v"(set[2]), "+v"(set[3]), "+v"(set[4]), "+v"(set[5]), "+v"(set[6]), "+v"(set[7]))
#define NSAF_VMMA(set, dt) do { _Pragma("unroll") for (int ks = 0; ks < 4; ++ks) { const u32x4 a_ = (u32x4){set[2 * ks].x, set[2 * ks].y, set[2 * ks + 1].x, set[2 * ks + 1].y}; \
            O[dt] = __builtin_amdgcn_mfma_f32_32x32x16_bf16(__builtin_bit_cast(bf16x8, a_), pf[ks >> 1][ks & 1], O[dt], 0, 0, 0); } } while (0)
        NSAF_VRD8(va, 0); NSAF_VRD8(vb, 1);
        NSAF_VWAIT(8, va); NSAF_VMMA(va, 0); NSAF_VRD8(va, 2);
        NSAF_VWAIT(8, vb); NSAF_VMMA(vb, 1); NSAF_VRD8(vb, 3);
        NSAF_VWAIT(8, va); NSAF_VMMA(va, 2);
        NSAF_VWAIT(0, vb); NSAF_VMMA(vb, 3);
#undef NSAF_VRD
#undef NSAF_VRD8
#undef NSAF_VWAIT
#undef NSAF_VMMA
    }
}
template <int MODE>
__device__ __forceinline__ void run_pass(LAS unsigned char* lds, const bf16* K, const bf16* VT, size_t vpitch, int jb, int je, const bf16x8 (&qf)[8], f32x16 (&O)[4], float& m, float& l, bool allowfast, int tl, int itile, int nvr, unsigned long long selmask, float inv_l, int tid, int lane) {
    Stage st; stage_load(st, K, VT, vpitch, jb * 64, tid); stage_write(st, lds, tid);
    if (jb < je) stage_load(st, K, VT, vpitch, (jb + 1) * 64, tid);
    __syncthreads();
    for (int j = jb; j <= je; ++j) {
        const int cur = (j - jb) & 1;
        if (j < je) { stage_write(st, lds + (cur ^ 1) * BUF_BYTES, tid); if (j + 1 < je) stage_load(st, K, VT, vpitch, (j + 2) * 64, tid); }
        const bool rowsel = (MODE == 2) ? (((selmask >> j) & 1ull) != 0ull) : true;
        if (MODE != 2 || __ballot(rowsel) != 0ull) block_step<MODE>(lds + cur * BUF_BYTES, lds, qf, O, m, l, j, allowfast ? jb + (MODE == 2 ? 1 : 2) : 0x7fffffff, tl, itile, nvr, rowsel, inv_l, lane);
        __syncthreads();
    }
}
}
__device__ __forceinline__ void p3_nsa_fast(Frame& F, const bf16* svT, const bf16* wvT, bf16* outbase) {
    using namespace nsaf;
    unsigned char* ws = F.ws; const int tid = F.tid, lane = F.lane, wave = F.wave; LAS unsigned char* lds = F.lds;
    bf16* nq = (bf16*)(ws + WS_NQ); const float* gates = (const float*)(ws + WS_GATES);
    const int r = lane & 31, hi = lane >> 5, qrow = wave * 32 + r, tl = qrow >> 2, head = qrow & 3;
    unsigned failmask = 0u;
    for (int trip = 0; trip < 2; ++trip) {
    for (int u4 = 0; u4 < 4; ++u4) {
        if (trip == 1 && ((failmask >> u4) & 1u) == 0u) continue;
        const bool allowfast = trip == 0;
        const int pr = (F.bx & 7) * 32 + (F.bx >> 3) + (u4 >> 1) * 256; if (F.bx >= 256) break;
        const int bg = pr >> 5, ii = pr & 31, itile = (u4 & 1) ? (63 - ii) : ii, g = bg & 1, b = bg >> 1;
        const int tok = b * SEQ + itile * 64 + tl, t = itile * 64 + tl;
        const bf16* kc = (const bf16*)(ws + WS_KCMP) + (size_t)bg * 256 * 128; const bf16* vcT = (const bf16*)(ws + WS_VCMPT) + (size_t)bg * 128 * 256;
        const bf16* ks = (const bf16*)(ws + WS_KV6 + 2 * KV_STRIDE) + (size_t)bg * SEQ * 128; const bf16* kw = (const bf16*)(ws + WS_KV6 + 4 * KV_STRIDE) + (size_t)bg * SEQ * 128;
        const bf16* vsT = svT + (size_t)bg * 128 * SEQ; const bf16* vwT = wvT + (size_t)bg * 128 * SEQ;
        __syncthreads();
        for (int i = tid; i < 64 * 64; i += NTHREADS) ((LAS float*)(lds + OFF_IMP))[i] = 0.f;
        bf16x8 qf[8]; bf16* qrowp = nq + (size_t)tok * 1024 + g * 512 + head * 128; bf16* orowp = outbase + (size_t)tok * 1024 + g * 512 + head * 128;
#pragma unroll
        for (int s_ = 0; s_ < 8; ++s_) { const u32x4 w_ = *(const u32x4*)(qrowp + 16 * s_ + 8 * hi);
            u32x4 o_; o_.x = cvt_pk_bf16(lo16(w_.x) * CS, hi16(w_.x) * CS); o_.y = cvt_pk_bf16(lo16(w_.y) * CS, hi16(w_.y) * CS); o_.z = cvt_pk_bf16(lo16(w_.z) * CS, hi16(w_.z) * CS); o_.w = cvt_pk_bf16(lo16(w_.w) * CS, hi16(w_.w) * CS);
            qf[s_] = __builtin_bit_cast(bf16x8, o_); }
        const float* gatep = gates + (size_t)tok * 24 + (g * 4 + head) * 3;
        const int nvr = (t >= 31) ? (((t - 31) >> 4) + 1 > 255 ? 255 : ((t - 31) >> 4) + 1) : 0;
        const int jec = ((4 * itile + 2) >> 6) > 3 ? 3 : ((4 * itile + 2) >> 6);
        f32x16 O[4];
#define NSAF_ZERO_O() do { _Pragma("unroll") for (int dt = 0; dt < 4; ++dt) _Pragma("unroll") for (int j = 0; j < 16; ++j) O[dt][j] = 0.f; } while (0)
#define NSAF_ACCUM(coef, FIRST) do { const float cf_ = (coef); _Pragma("unroll") for (int dt = 0; dt < 4; ++dt) { _Pragma("unroll") for (int q4 = 0; q4 < 4; ++q4) { u32x2* p_ = (u32x2*)(orowp + 32 * dt + 8 * q4 + 4 * hi); \
            float a0_ = cf_ * O[dt][4 * q4], a1_ = cf_ * O[dt][4 * q4 + 1], a2_ = cf_ * O[dt][4 * q4 + 2], a3_ = cf_ * O[dt][4 * q4 + 3]; \
            if (!(FIRST)) { const u32x2 o_ = *p_; a0_ += lo16(o_.x); a1_ += hi16(o_.x); a2_ += lo16(o_.y); a3_ += hi16(o_.y); } \
            *p_ = (u32x2){cvt_pk_bf16(a0_, a1_), cvt_pk_bf16(a2_, a3_)}; } asm volatile("" ::: "memory"); } } while (0)
        float m = NEG, l = 0.f; NSAF_ZERO_O();
        run_pass<0>(lds, kc, vcT, 256, 0, jec, qf, O, m, l, false, tl, itile, nvr, 0ull, 0.f, tid, lane);
        l += __shfl_xor(l, 32); const float invl = l > 0.f ? 1.0f / l : 0.f;
        run_pass<1>(lds, kc, vcT, 256, 0, jec, qf, O, m, l, false, tl, itile, nvr, 0ull, invl, tid, lane);
        NSAF_ACCUM(gatep[0], true);
        __syncthreads();
        for (int tk = 0; tk < 8; ++tk) { const int tokl = wave * 8 + tk; float v = ((const LAS float*)(lds + OFF_IMP))[tokl * 64 + lane];
            const bool forced = (lane == 0) || (lane == itile) || (lane == itile - 1); v = (lane > itile) ? -1.0e4f : (forced ? 1.0e4f : v);
            int rank = 0;
#pragma unroll 16
            for (int i = 0; i < 64; ++i) { const float w = __builtin_bit_cast(float, __builtin_amdgcn_readlane(__builtin_bit_cast(int, v), i)); rank += (w > v || (w == v && i < lane)) ? 1 : 0; }
            const unsigned long long mk = __ballot(rank < 16);
            if (lane == 0) { ((LAS unsigned*)(lds + OFF_MASK))[tokl * 2] = (unsigned)mk; ((LAS unsigned*)(lds + OFF_MASK))[tokl * 2 + 1] = (unsigned)(mk >> 32); } }
        __syncthreads();
        const unsigned long long selmask = (unsigned long long)((const LAS unsigned*)(lds + OFF_MASK))[tl * 2] | ((unsigned long long)((const LAS unsigned*)(lds + OFF_MASK))[tl * 2 + 1] << 32);
        m = NEG; l = 0.f; NSAF_ZERO_O();
        run_pass<2>(lds, ks, vsT, SEQ, 0, itile, qf, O, m, l, allowfast, tl, itile, 0, selmask, 0.f, tid, lane);
        l += __shfl_xor(l, 32); bool bad = !(l < 1.0e12f);
        NSAF_ACCUM(l > 0.f ? gatep[1] / l : 0.f, false);
        m = NEG; l = 0.f; NSAF_ZERO_O();
        run_pass<3>(lds, kw, vwT, SEQ, itile > 8 ? itile - 8 : 0, itile, qf, O, m, l, allowfast, tl, itile, 0, 0ull, 0.f, tid, lane);
        l += __shfl_xor(l, 32); bad = bad | !(l < 1.0e12f);
        NSAF_ACCUM(l > 0.f ? gatep[2] / l : 0.f, false);
        if (allowfast && __syncthreads_or(bad ? 1 : 0)) failmask |= 1u << u4;
#undef NSAF_ZERO_O
#undef NSAF_ACCUM
    }
    if (failmask == 0u) break;
    }
    __syncthreads();
}
struct SchedP4 {
    unsigned char* ws; int G, c;
    __device__ __forceinline__ bool next(int i, GU& u) const {
        const int ti = i >> 2, sub = i & 3; const int L = ti * G + c; if (L >= 128 * 4) return false;
        int pm, pn; pg8::tile_map(L, 128, 4, pm, pn);
        const size_t ao = sub == 1 ? WS_RV : sub == 3 ? WS_NQ : WS_H; const size_t bo = sub == 0 ? W_GA : sub == 1 ? W_RO : sub == 2 ? W_GB : W_NO;
        u.A = (const char*)ws + ao + (size_t)pm * 256 * D * 2; u.B = (const char*)ws + bo + (size_t)pn * 256 * D * 2; u.pm = pm; u.pn = pn; u.kind = sub; u.rows = nullptr; u.nvalid = 0; u.aux = 0; return true;
    }
};
struct EpiP4 {
    static constexpr bool PERM = true;
    float* scr;
    bf16* Y;
    static __device__ __forceinline__ u32x2 pk4(const f32x4 v) { return (u32x2){cvt_pk_bf16(v[0], v[1]), cvt_pk_bf16(v[2], v[3])}; }
    static __device__ __forceinline__ f32x4 up4(const u32x2 w) { return (f32x4){lo16(w.x), hi16(w.x), lo16(w.y), hi16(w.y)}; }
    __device__ __forceinline__ void operator()(const f32x4 (&acc)[2][2][4][2], const GU& u, int wr, int wc, int fr, int fq) const {
        u32x2* p0 = (u32x2*)scr + threadIdx.x; u32x2* p1 = p0 + 32 * 512;
        if (u.kind == 0 || u.kind == 2) {
            u32x2* p = u.kind == 0 ? p0 : p1;
#pragma unroll
            for (int ai = 0; ai < 2; ++ai)
#pragma unroll
                for (int m = 0; m < 4; ++m) {
#pragma unroll
                    for (int bj = 0; bj < 2; ++bj) { f32x4 v0 = acc[ai][bj][m][0], v1 = acc[ai][bj][m][1];
#pragma unroll
                        for (int j = 0; j < 4; ++j) { v0[j] = sigmoidf_(v0[j]); v1[j] = sigmoidf_(v1[j]); }
                        p[(2 * bj) * 512] = pk4(v0); p[(2 * bj + 1) * 512] = pk4(v1); }
                    p += 4 * 512; LAUNDER(p); }
        } else if (u.kind == 1) {
#pragma unroll
            for (int ai = 0; ai < 2; ++ai)
#pragma unroll
                for (int m = 0; m < 4; ++m) {
#pragma unroll
                    for (int bj = 0; bj < 2; ++bj) { p0[(2 * bj) * 512] = pk4(up4(p0[(2 * bj) * 512]) * acc[ai][bj][m][0]); p0[(2 * bj + 1) * 512] = pk4(up4(p0[(2 * bj + 1) * 512]) * acc[ai][bj][m][1]); }
                    p0 += 4 * 512; LAUNDER(p0); }
        } else {
            bf16* yb = Y + (size_t)(u.pm * 256 + 64 * wr + fr) * D + u.pn * 256 + 32 * wc + 8 * fq;
#pragma unroll
            for (int ai = 0; ai < 2; ++ai)
#pragma unroll
                for (int m = 0; m < 4; ++m) {
#pragma unroll
                    for (int bj = 0; bj < 2; ++bj) {
                        const f32x4 v0 = up4(p0[(2 * bj) * 512]) + up4(p1[(2 * bj) * 512]) * acc[ai][bj][m][0], v1 = up4(p0[(2 * bj + 1) * 512]) + up4(p1[(2 * bj + 1) * 512]) * acc[ai][bj][m][1];
                        u32x4 w; w.x = cvt_pk_bf16(v0[0], v0[1]); w.y = cvt_pk_bf16(v0[2], v0[3]); w.z = cvt_pk_bf16(v1[0], v1[1]); w.w = cvt_pk_bf16(v1[2], v1[3]);
                        *(u32x4*)(yb + (size_t)(128 * ai + 16 * m) * D + 128 * bj) = w; }
                    p0 += 4 * 512; p1 += 4 * 512; LAUNDER(p0); LAUNDER(p1); }
        }
    }
};

struct SchedMN {
    unsigned char* ws; size_t ao, bo; int G, c;
    __device__ __forceinline__ bool next(int i, GU& u) const {
        const int L = i * G + c; if (L >= 128 * 4) return false; int pm, pn; pg8::tile_map(L, 128, 4, pm, pn);
        u.A = (const char*)ws + ao + (size_t)pm * 256 * D * 2; u.B = (const char*)ws + bo + (size_t)pn * 256 * D * 2; u.pm = pm; u.pn = pn; u.kind = 0; u.rows = nullptr; u.nvalid = 0; u.aux = 0; return true;
    }
};
template <bool SSQ> struct EpiRes {
    static constexpr bool PERM = false;
    const float* basef; const bf16* baseb; float* out; bf16* ob; float* ssq;
    __device__ __forceinline__ void operator()(const f32x4 (&acc)[2][2][4][2], const GU& u, int wr, int wc, int fr, int fq) const {
#pragma unroll
        for (int ai = 0; ai < 2; ++ai)
#pragma unroll
            for (int m = 0; m < 4; ++m) { const int r = u.pm * 256 + 128 * ai + 64 * wr + 16 * m + fr; const size_t off = (size_t)r * D + u.pn * 256 + 32 * wc + 4 * fq; float sq = 0.f;
#pragma unroll
                for (int bj = 0; bj < 2; ++bj)
#pragma unroll
                    for (int n = 0; n < 2; ++n) { const size_t o = off + 128 * bj + 16 * n; f32x4 bv;
                        if (SSQ) bv = *(const f32x4*)(basef + o); else { const u32x2 bw = *(const u32x2*)(baseb + o); bv = (f32x4){lo16(bw.x), hi16(bw.x), lo16(bw.y), hi16(bw.y)}; }
                        const f32x4 v = bv + acc[ai][bj][m][n];
                        if (!SSQ) *(f32x4*)(out + o) = v;
                        u32x2 w; w.x = cvt_pk_bf16(v[0], v[1]); w.y = cvt_pk_bf16(v[2], v[3]); *(u32x2*)(ob + o) = w; sq += (v[0] * v[0] + v[1] * v[1]) + (v[2] * v[2] + v[3] * v[3]); }
                if (SSQ) { sq += __shfl_xor(sq, 16); sq += __shfl_xor(sq, 32); if (fq == 0) ssq[(size_t)r * 16 + u.pn * 4 + wc] = sq; }
            }
    }
};
struct EpiQ {
    static constexpr bool PERM = true;
    const float* ssq; bf16* Q;
    __device__ __forceinline__ void operator()(const f32x4 (&acc)[2][2][4][2], const GU& u, int wr, int wc, int fr, int fq) const {
#pragma unroll
        for (int ai = 0; ai < 2; ++ai)
#pragma unroll
            for (int m = 0; m < 4; ++m) { const int r = u.pm * 256 + 128 * ai + 64 * wr + 16 * m + fr; const f32x4* sp = (const f32x4*)(ssq + (size_t)r * 16);
                const f32x4 a = sp[0], b = sp[1], c = sp[2], d = sp[3]; const float tot = ((a[0] + a[1]) + (a[2] + a[3])) + ((b[0] + b[1]) + (b[2] + b[3])) + ((c[0] + c[1]) + (c[2] + c[3])) + ((d[0] + d[1]) + (d[2] + d[3]));
                const float rstd = 1.0f / sqrtf(tot * (1.0f / D) + EPS);
#pragma unroll
                for (int bj = 0; bj < 2; ++bj) { const f32x4 v0 = acc[ai][bj][m][0] * rstd, v1 = acc[ai][bj][m][1] * rstd;
                    u32x4 w; w.x = cvt_pk_bf16(v0[0], v0[1]); w.y = cvt_pk_bf16(v0[2], v0[3]); w.z = cvt_pk_bf16(v1[0], v1[1]); w.w = cvt_pk_bf16(v1[2], v1[3]);
                    *(u32x4*)(Q + (size_t)r * D + u.pn * 256 + 128 * bj + 32 * wc + 8 * fq) = w; } }
    }
};

namespace xatf {
constexpr int KROW = 528, VROW = 136, KT_BYTES = 64 * KROW, OFF_K = 0, OFF_V = KT_BYTES;
constexpr float NEG = -1.0e30f, CS = 0.0625f * 1.4426950408889634f;
struct Stage { u32x4 k[4]; u32x4 v[2]; };
__device__ __forceinline__ void stage_load(Stage& st, const bf16* K, const bf16* VT, int key0, int tid) {
#pragma unroll
    for (int i = 0; i < 4; ++i) { const int p = tid + 512 * i, row = p >> 5, c = p & 31; st.k[i] = *(const u32x4*)(K + (size_t)(key0 + row) * 2048 + c * 8); }
#pragma unroll
    for (int i = 0; i < 2; ++i) { const int p = tid + 512 * i, d = p >> 3, c = p & 7; st.v[i] = *(const u32x4*)(VT + (size_t)d * 256 + key0 + c * 8); }
}
__device__ __forceinline__ void stage_write(const Stage& st, LAS unsigned char* lds, int tid) {
#pragma unroll
    for (int i = 0; i < 4; ++i) { const int p = tid + 512 * i, row = p >> 5, c = p & 31; *(LAS u32x4*)(lds + OFF_K + row * KROW + c * 16) = st.k[i]; }
#pragma unroll
    for (int i = 0; i < 2; ++i) { const int p = tid + 512 * i, d = p >> 3, c = p & 7; LAS unsigned char* q = lds + OFF_V + d * VROW + c * 16;
        *(LAS u32x2*)q = (u32x2){st.v[i].x, st.v[i].y}; *(LAS u32x2*)(q + 8) = (u32x2){st.v[i].z, st.v[i].w}; }
}
__device__ __forceinline__ void block_step(const LAS unsigned char* lds, const bf16x8 (&qf)[16], f32x16 (&O)[4], float& m, float& l, int lane) {
    const int r = lane & 31, hi = lane >> 5;
    f32x16 S[2];
#pragma unroll
    for (int kh = 0; kh < 2; ++kh) {
#pragma unroll
        for (int j = 0; j < 16; ++j) S[kh][j] = 0.f;
#pragma unroll
        for (int s_ = 0; s_ < 16; ++s_) { const bf16x8 a = *(const LAS bf16x8*)(lds + OFF_K + (kh * 32 + r) * KROW + (16 * s_ + 8 * hi) * 2); S[kh] = __builtin_amdgcn_mfma_f32_32x32x16_bf16(a, qf[s_], S[kh], 0, 0, 0); }
    }
    float mx = NEG;
#pragma unroll
    for (int kh = 0; kh < 2; ++kh)
#pragma unroll
        for (int j = 0; j < 16; ++j) { const float v = S[kh][j] * CS; S[kh][j] = v; mx = fmaxf(mx, v); }
    mx = fmaxf(mx, __shfl_xor(mx, 32));
    const float mn = fmaxf(m, mx); const float alpha = __builtin_amdgcn_exp2f(m - mn); m = mn; float rs = 0.f;
#pragma unroll
    for (int kh = 0; kh < 2; ++kh)
#pragma unroll
        for (int j = 0; j < 16; ++j) { const float p = __builtin_amdgcn_exp2f(S[kh][j] - mn); S[kh][j] = p; rs += p; }
    l = l * alpha + rs;
#pragma unroll
    for (int dt = 0; dt < 4; ++dt)
#pragma unroll
        for (int j = 0; j < 16; ++j) O[dt][j] *= alpha;
    bf16x8 pf[2][2];
#pragma unroll
    for (int kh = 0; kh < 2; ++kh)
#pragma unroll
        for (int s2 = 0; s2 < 2; ++s2) { u32x4 w; w.x = cvt_pk_bf16(S[kh][8 * s2 + 0], S[kh][8 * s2 + 1]); w.y = cvt_pk_bf16(S[kh][8 * s2 + 2], S[kh][8 * s2 + 3]); w.z = cvt_pk_bf16(S[kh][8 * s2 + 4], S[kh][8 * s2 + 5]); w.w = cvt_pk_bf16(S[kh][8 * s2 + 6], S[kh][8 * s2 + 7]);
            pf[kh][s2] = __builtin_bit_cast(bf16x8, w); }
#pragma unroll
    for (int dt = 0; dt < 4; ++dt)
#pragma unroll
        for (int kh = 0; kh < 2; ++kh)
#pragma unroll
            for (int s2 = 0; s2 < 2; ++s2) { const LAS unsigned char* vp = lds + OFF_V + (dt * 32 + r) * VROW + (32 * kh + 16 * s2 + 4 * hi) * 2;
                const u32x2 lo = *(const LAS u32x2*)vp, hi2 = *(const LAS u32x2*)(vp + 16); const u32x4 av = (u32x4){lo.x, lo.y, hi2.x, hi2.y};
                O[dt] = __builtin_amdgcn_mfma_f32_32x32x16_bf16(__builtin_bit_cast(bf16x8, av), pf[kh][s2], O[dt], 0, 0, 0); }
}
}
__device__ __forceinline__ void p7_xattn_fast(Frame& F, const bf16* vT, bf16* outbase) {
    using namespace xatf;
    bf16* Q = (bf16*)(F.ws + WS_NQ); const bf16* KV = (const bf16*)(F.ws + WS_MEMKV);
    const int tid = F.tid, lane = F.lane, wave = F.wave, r = lane & 31, hi = lane >> 5; LAS unsigned char* lds = F.lds;
    for (int u = F.bx; u < BATCH * 4 * 16; u += F.G) {
        const int tt = u & 15, bh = u >> 4, b = bh >> 2, h = bh & 3; const int tok = b * SEQ + tt * 256 + wave * 32 + r;
        bf16* qrow = Q + (size_t)tok * D + h * 256; bf16* orow = outbase + (size_t)tok * D + h * 256; const bf16* Kb = KV + (size_t)(b * NMEM) * 2048 + h * 256;
        bf16x8 qf[16];
#pragma unroll
        for (int s_ = 0; s_ < 16; ++s_) qf[s_] = *(const bf16x8*)(qrow + 16 * s_ + 8 * hi);
#pragma unroll
        for (int half = 0; half < 2; ++half) {
            const bf16* VTb = vT + ((size_t)bh * 256 + half * 128) * 256;
            f32x16 O[4]; float m = NEG, l = 0.f;
#pragma unroll
            for (int dt = 0; dt < 4; ++dt)
#pragma unroll
                for (int j = 0; j < 16; ++j) O[dt][j] = 0.f;
            for (int j = 0; j < 4; ++j) {
                __syncthreads(); { Stage st; stage_load(st, Kb, VTb, j * 64, tid); stage_write(st, lds, tid); } __syncthreads();
                block_step(lds, qf, O, m, l, lane);
            }
            l += __shfl_xor(l, 32); const float inv = 1.0f / l;
#pragma unroll
            for (int dt = 0; dt < 4; ++dt)
#pragma unroll
                for (int q4 = 0; q4 < 4; ++q4) *(u32x2*)(orow + half * 128 + 32 * dt + 8 * q4 + 4 * hi) = (u32x2){cvt_pk_bf16(O[dt][4 * q4] * inv, O[dt][4 * q4 + 1] * inv), cvt_pk_bf16(O[dt][4 * q4 + 2] * inv, O[dt][4 * q4 + 3] * inv)};
        }
    }
    __syncthreads();
}
__device__ __forceinline__ void transpose_memv_tiles(Frame& F, bf16* vT, int w0, int nw) {
    LAS unsigned short* tl_ = (LAS unsigned short*)(F.lds + F.wave * 16384); const int lane = F.lane; const bf16* KV = (const bf16*)(F.ws + WS_MEMKV);
    for (int tile = w0; tile < 32 * 16; tile += nw) {
        const int dq = tile & 3, kq = (tile >> 2) & 3, bh = tile >> 4, b = bh >> 2, h = bh & 3;
        const bf16* sp = KV + (size_t)(b * NMEM + kq * 64) * 2048 + 1024 + h * 256 + dq * 64; bf16* dp = vT + ((size_t)bh * 256 + dq * 64) * 256 + kq * 64;
#pragma unroll
        for (int i = 0; i < 8; ++i) { const int row = i * 8 + (lane >> 3), c = lane & 7; const u32x4 v = *(const u32x4*)(sp + (size_t)row * 2048 + c * 8); LAS unsigned short* q = tl_ + row * 66 + c * 8;
            q[0] = (unsigned short)(v.x & 0xffffu); q[1] = (unsigned short)(v.x >> 16); q[2] = (unsigned short)(v.y & 0xffffu); q[3] = (unsigned short)(v.y >> 16);
            q[4] = (unsigned short)(v.z & 0xffffu); q[5] = (unsigned short)(v.z >> 16); q[6] = (unsigned short)(v.w & 0xffffu); q[7] = (unsigned short)(v.w >> 16); }
        LDS_WAIT(); asm volatile("" ::: "memory");
#pragma unroll
        for (int i = 0; i < 8; ++i) { const int d = i * 8 + (lane >> 3), c = lane & 7; const LAS unsigned short* q = tl_ + (c * 8) * 66 + d;
            u32x4 o; o.x = (unsigned)q[0] | ((unsigned)q[66] << 16); o.y = (unsigned)q[2 * 66] | ((unsigned)q[3 * 66] << 16); o.z = (unsigned)q[4 * 66] | ((unsigned)q[5 * 66] << 16); o.w = (unsigned)q[6 * 66] | ((unsigned)q[7 * 66] << 16);
            *(u32x4*)(dp + (size_t)d * 256 + c * 8) = o; }
        LDS_WAIT(); asm volatile("" ::: "memory");
    }
}

__device__ __forceinline__ void p9_route(Frame& F, const Args& a) {
    unsigned char* ws = F.ws; const float* X2 = a.out;
    const float* gff = a.in[IN_NORM_FFN_G]; const float* wgrp = a.in[IN_W_GRP]; const float* bgrp = a.in[IN_B_GRP]; const float* wrt = a.in[IN_W_RT]; const float* brt = a.in[IN_B_RT];
    float* wts = (float*)(ws + WS_ROUTE); float* rstd2 = wts + 2 * NTOK; int* lists = (int*)(ws + WS_LISTS);
    const int gw = F.bx * NWAVES + F.wave, NGW = F.G * NWAVES, lane = F.lane;
    f32x4 vnext[4];
    if (gw < NTOK) {
#pragma unroll
        for (int j = 0; j < 4; ++j) vnext[j] = ((const f32x4*)(X2 + (size_t)gw * D) + lane)[64 * j]; }
    int my_ea = -1, my_eb = -1, my_tok = -1, it_ = 0; float my_w1 = 0.f, my_w2 = 0.f, my_rstd = 0.f;
    for (int tok = gw; tok < NTOK; tok += NGW, ++it_) {
        const f32x4* gr = (const f32x4*)gff + lane;
        f32x4 v[4]; float s = 0.f;
#pragma unroll
        for (int j = 0; j < 4; ++j) { v[j] = vnext[j]; s += (v[j].x * v[j].x + v[j].y * v[j].y) + (v[j].z * v[j].z + v[j].w * v[j].w); }
        if (tok + NGW < NTOK) {
#pragma unroll
            for (int j = 0; j < 4; ++j) vnext[j] = ((const f32x4*)(X2 + (size_t)(tok + NGW) * D) + lane)[64 * j]; }
        const float rstd = 1.0f / sqrtf(wave_sum(s) * (1.f / D) + EPS);
        float lg[4] = {0.f, 0.f, 0.f, 0.f};
        const float* pwg = wgrp + (size_t)(4 * lane) * 4;
#pragma unroll
        for (int j = 0; j < 4; ++j) { const f32x4 gg = gr[64 * j];
#pragma unroll
            for (int c = 0; c < 4; ++c) { const float hf = v[j][c] * rstd * gg[c]; v[j][c] = hf; const f32x4 wg = *(const f32x4*)(pwg + c * 4);
#pragma unroll
                for (int i = 0; i < 4; ++i) lg[i] += hf * wg[i]; }
            pwg += 256 * 4; LAUNDER(pwg); }
#pragma unroll
        for (int i = 0; i < 4; ++i) lg[i] = wave_sum(lg[i]) + bgrp[i];
        int grp = 0; float gm = lg[0];
#pragma unroll
        for (int i = 1; i < 4; ++i) if (lg[i] > gm) { gm = lg[i]; grp = i; }
        grp = __builtin_amdgcn_readfirstlane(grp);
        float gs = 0.f;
#pragma unroll
        for (int i = 0; i < 4; ++i) gs += expf(lg[i] - gm);
        const float g_gate = 1.0f / gs;
        float lq[8];
#pragma unroll
        for (int i = 0; i < 8; ++i) lq[i] = 0.f;
        const float* pwr = wrt + (size_t)(4 * lane) * 32 + grp * 8;
#pragma unroll
        for (int j = 0; j < 4; ++j) {
#pragma unroll
            for (int c = 0; c < 4; ++c) { const float hf = v[j][c]; const f32x4 wa = *(const f32x4*)(pwr + c * 32), wb = *(const f32x4*)(pwr + c * 32 + 4);
#pragma unroll
                for (int i = 0; i < 4; ++i) { lq[i] += hf * wa[i]; lq[4 + i] += hf * wb[i]; } }
            pwr += 256 * 32; LAUNDER(pwr); }
#pragma unroll
        for (int i = 0; i < 8; ++i) lq[i] = wave_sum(lq[i]) + brt[grp * 8 + i];
        int i1 = 0; float m1 = lq[0];
#pragma unroll
        for (int i = 1; i < 8; ++i) if (lq[i] > m1) { m1 = lq[i]; i1 = i; }
        int i2 = -1; float m2 = -3.0e38f;
#pragma unroll
        for (int i = 0; i < 8; ++i) if (i != i1 && lq[i] > m2) { m2 = lq[i]; i2 = i; }
        const float e2 = expf(m2 - m1), den = 1.0f + e2; const float w1 = g_gate / den, w2 = g_gate * e2 / den;
        if (lane == it_) { my_ea = grp * 8 + i1; my_eb = grp * 8 + i2; my_tok = tok; my_w1 = w1; my_w2 = w2; my_rstd = rstd; }
    }
    if (my_tok >= 0) {
        const unsigned sa = __hip_atomic_fetch_add(F.ctl + CW_ECNT + 64 * my_ea, 1u, __ATOMIC_RELAXED, __HIP_MEMORY_SCOPE_AGENT);
        const unsigned sb = __hip_atomic_fetch_add(F.ctl + CW_ECNT + 64 * my_eb, 1u, __ATOMIC_RELAXED, __HIP_MEMORY_SCOPE_AGENT);
        lists[(size_t)my_ea * NTOK + sa] = my_tok * 2; lists[(size_t)my_eb * NTOK + sb] = my_tok * 2 + 1;
        wts[my_tok * 2] = my_w1; wts[my_tok * 2 + 1] = my_w2; rstd2[my_tok] = my_rstd;
    }
}
struct XItem { const float* src; bf16* dst; const float* ks; int ldw, ldt, mode, row_off, c0, k0, has_ks; };
__device__ __forceinline__ void xitem_decode(const Args& a, unsigned char* ws, int it, XItem& x) {
    const int e = it / 768, r = it % 768, which = r >> 8, t = r & 255;
    x.ks = a.in[IN_NORM_FFN_G];
    if (which < 2) { x.src = a.in[which ? IN_W_E3 : IN_W_E1] + (size_t)e * D * DEXP; x.ldw = DEXP; x.dst = (bf16*)(ws + WS_W13) + (size_t)e * D * D; x.ldt = D; x.mode = 1; x.row_off = which; x.has_ks = 1; x.c0 = 32 * (t & 15); x.k0 = 64 * (t >> 4); }
    else { x.src = a.in[IN_W_E2] + (size_t)e * DEXP * D; x.ldw = D; x.dst = (bf16*)(ws + WS_W2) + (size_t)e * D * DEXP; x.ldt = DEXP; x.mode = 0; x.row_off = 0; x.has_ks = 0; x.c0 = 32 * (t & 31); x.k0 = 64 * (t >> 5); }
}
__device__ __forceinline__ void xitem_load(const XItem& x, int lane, float (&vv)[32], f32x4& k0v, f32x4& k1v) {
#pragma unroll
    for (int i = 0; i < 32; ++i) { const int kk = 2 * i + (lane >> 5); vv[i] = x.src[(size_t)(x.k0 + kk) * x.ldw + x.c0 + (lane & 31)]; }
    const f32x4* p = (const f32x4*)(x.ks + x.k0 + 8 * (lane & 7)); k0v = p[0]; k1v = p[1];
}
__device__ __forceinline__ void xitem_finish(const XItem& x, int lane, const float (&vv)[32], f32x4 k0v, f32x4 k1v, LAS float* scr) {
    if (!x.has_ks) { k0v = (f32x4){1.f, 1.f, 1.f, 1.f}; k1v = k0v; }
#pragma unroll
    for (int i = 0; i < 32; ++i) { const int kk = 2 * i + (lane >> 5); scr[kk * 33 + (lane & 31)] = vv[i]; }
    LDS_WAIT(); asm volatile("" ::: "memory");
    const int c = lane & 7;
#pragma unroll
    for (int j = 0; j < 4; ++j) { const int n = (lane >> 3) + 8 * j; const LAS float* s = scr + (8 * c) * 33 + n;
        u32x4 o; o.x = pk2(s[0 * 33] * k0v.x, s[1 * 33] * k0v.y); o.y = pk2(s[2 * 33] * k0v.z, s[3 * 33] * k0v.w); o.z = pk2(s[4 * 33] * k1v.x, s[5 * 33] * k1v.y); o.w = pk2(s[6 * 33] * k1v.z, s[7 * 33] * k1v.w);
        const int jc = x.c0 + n; const int drow = x.mode == 0 ? jc : (8 * (jc >> 2) + 4 * x.row_off + (jc & 3));
        *(u32x4*)(x.dst + (size_t)drow * x.ldt + x.k0 + 8 * c) = o; }
    LDS_WAIT(); asm volatile("" ::: "memory");
}
__device__ __forceinline__ void expert_copies(Frame& F, const Args& a, int e_lo, int e_hi) {
    LAS float* scr = (LAS float*)(F.lds + F.wave * 16384);
    const int gw = F.bx * NWAVES + F.wave, NGW = F.G * NWAVES, lane = F.lane;
    const int it_end = e_hi * 768;
    int it = e_lo * 768 + gw;
    if (it < it_end) {
        float va[32], vb[32]; f32x4 ka0, ka1, kb0, kb1; XItem xa, xb;
        xitem_decode(a, F.ws, it, xa); xitem_load(xa, lane, va, ka0, ka1);
        for (;;) {
            int itn = it + NGW; bool hn = itn < it_end;
            xitem_decode(a, F.ws, hn ? itn : it, xb); xitem_load(xb, lane, vb, kb0, kb1);
            xitem_finish(xa, lane, va, ka0, ka1, scr);
            if (!hn) break;
            it = itn; itn = it + NGW; hn = itn < it_end;
            xitem_decode(a, F.ws, hn ? itn : it, xa); xitem_load(xa, lane, va, ka0, ka1);
            xitem_finish(xb, lane, vb, kb0, kb1, scr);
            if (!hn) break;
            it = itn;
        }
    }
    __syncthreads();
}

__device__ __forceinline__ void moe_tiles(Frame& F) {
    __syncthreads();
    if (F.tid == 0) { unsigned accu = 0u; for (int e = 0; e < NEXP; ++e) { const unsigned c = __hip_atomic_load(F.ctl + CW_ECNT + 64 * e, __ATOMIC_RELAXED, __HIP_MEMORY_SCOPE_AGENT); F.MISC[16 + e] = accu; F.MISC[64 + e] = c; accu += (c + 255u) >> 8; } F.MISC[16 + NEXP] = accu; }
    __syncthreads();
}
template <int WHICH> struct SchedMoe {
    volatile LAS unsigned* MISC; unsigned char* ws; int G, c;
    __device__ __forceinline__ bool next(int i, GU& u) const {
        const int L = i * G + c; const int T = (int)MISC[16 + NEXP]; if (L >= 4 * T) return false;
        const int tau = L >> 2, pn = L & 3; int e = 0;
        for (int k = 1; k < NEXP; ++k) if ((int)MISC[16 + k] <= tau) e = k;
        const int lt = tau - (int)MISC[16 + e]; const int cnt = (int)MISC[64 + e]; int nv = cnt - lt * 256; nv = nv > 256 ? 256 : nv;
        u.rows = (const int*)(ws + WS_LISTS) + (size_t)e * NTOK + lt * 256; u.nvalid = nv; u.pm = tau; u.pn = pn; u.kind = 0; u.aux = e;
        if (WHICH == 0) { u.A = (const char*)ws + WS_X2B; u.B = (const char*)ws + WS_W13 + (size_t)e * D * D * 2 + (size_t)pn * 256 * D * 2; }
        else { u.A = (const char*)ws + WS_H1 + (size_t)tau * 256 * DEXP * 2; u.B = (const char*)ws + WS_W2 + (size_t)e * D * DEXP * 2 + (size_t)pn * 256 * DEXP * 2; }
        return true;
    }
};
struct EpiMoe1 {
    static constexpr bool PERM = true;
    const float* rstd2; bf16* H1;
    __device__ __forceinline__ void operator()(const f32x4 (&acc)[2][2][4][2], const GU& u, int wr, int wc, int fr, int fq) const {
        char* hb = (char*)H1 + (size_t)u.pm * 256 * DEXP * 2;
        const int j00 = (u.pn * 256 + 32 * wc + 8 * fq) >> 1;
#pragma unroll
        for (int ai = 0; ai < 2; ++ai) {
            int r = 128 * ai + 64 * wr + fr; LAUNDER(r);
#pragma unroll
            for (int m = 0; m < 4; ++m) { const bool ok = r < u.nvalid; const float rs = ok ? rstd2[u.rows[r] >> 1] : 0.f;
#pragma unroll
                for (int bj = 0; bj < 2; ++bj) { const f32x4 a1 = acc[ai][bj][m][0] * rs, a3 = acc[ai][bj][m][1] * rs; f32x4 hv;
#pragma unroll
                    for (int j = 0; j < 4; ++j) hv[j] = a1[j] * sigmoidf_(a1[j]) * a3[j];
                    u32x2 w; w.x = cvt_pk_bf16(hv[0], hv[1]); w.y = cvt_pk_bf16(hv[2], hv[3]); *(u32x2*)(hb + (unsigned)((r * DEXP + j00 + 64 * bj) * 2)) = w; }
                r += 16; LAUNDER(r); }
        }
    }
};
struct EpiMoe2 {
    static constexpr bool PERM = true;
    const float* wts; bf16* Y0; bf16* Y1;
    __device__ __forceinline__ void operator()(const f32x4 (&acc)[2][2][4][2], const GU& u, int wr, int wc, int fr, int fq) const {
#pragma unroll
        for (int ai = 0; ai < 2; ++ai)
#pragma unroll
            for (int m = 0; m < 4; ++m) { const int r = 128 * ai + 64 * wr + 16 * m + fr;
                if (r < u.nvalid) { const int ent = u.rows[r]; const float w8 = wts[ent]; bf16* dst = ((ent & 1) ? Y1 : Y0) + (size_t)(ent >> 1) * D + u.pn * 256 + 32 * wc + 8 * fq;
#pragma unroll
                    for (int bj = 0; bj < 2; ++bj) { const f32x4 v0 = acc[ai][bj][m][0] * w8, v1 = acc[ai][bj][m][1] * w8;
                        u32x4 w; w.x = cvt_pk_bf16(v0[0], v0[1]); w.y = cvt_pk_bf16(v0[2], v0[3]); w.z = cvt_pk_bf16(v1[0], v1[1]); w.w = cvt_pk_bf16(v1[2], v1[3]);
                        *(u32x4*)(dst + 128 * bj) = w; } } }
    }
};

__device__ __forceinline__ void p12_final(Frame& F, const Args& a) {
    const bf16* Y0 = (const bf16*)(F.ws + WS_YS0); const bf16* Y1 = (const bf16*)(F.ws + WS_YS1); const float* g = a.in[IN_NORM_F_G];
    const int gw = F.bx * NWAVES + F.wave, NGW = F.G * NWAVES, lane = F.lane;
    for (int tok = gw; tok < NTOK; tok += NGW) {
        f32x4* xr = (f32x4*)(a.out + (size_t)tok * D) + lane; const u32x2* y0 = (const u32x2*)(Y0 + (size_t)tok * D) + lane; const u32x2* y1 = (const u32x2*)(Y1 + (size_t)tok * D) + lane;
        f32x4 v[4]; float s = 0.f;
#pragma unroll
        for (int j = 0; j < 4; ++j) { v[j] = xr[64 * j]; const u32x2 p = y0[64 * j], q = y1[64 * j];
            v[j].x += lo16(p.x) + lo16(q.x); v[j].y += hi16(p.x) + hi16(q.x); v[j].z += lo16(p.y) + lo16(q.y); v[j].w += hi16(p.y) + hi16(q.y);
            s += (v[j].x * v[j].x + v[j].y * v[j].y) + (v[j].z * v[j].z + v[j].w * v[j].w); }
        const float rstd = 1.0f / sqrtf(wave_sum(s) * (1.f / D) + EPS);
#pragma unroll
        for (int j = 0; j < 4; ++j) { const f32x4 gg = ((const f32x4*)g + lane)[64 * j]; xr[64 * j] = v[j] * rstd * gg; }
    }
}

constexpr int N_PHASES = 14;
__global__ void __launch_bounds__(NTHREADS, 2) fwd(Args args) {
    extern __shared__ __attribute__((aligned(16))) unsigned char lds[];
    Frame F;
    F.lds = (LAS unsigned char*)lds; F.MISC = (volatile LAS unsigned*)(F.lds + MISC_OFF);
    F.tid = threadIdx.x; F.lane = F.tid & 63; F.wave = __builtin_amdgcn_readfirstlane(F.tid >> 6); F.G = gridDim.x; F.bx = blockIdx.x;
    F.ws = args.ws; F.ctl = (unsigned*)(args.ws + WS_CTL);
    unsigned char* ws = args.ws;
    for (int u = F.tid; u < (LDS_BYTES - RING_BYTES) / 4; u += NTHREADS) ((LAS unsigned*)(F.lds + RING_BYTES))[u] = 0u;
    __syncthreads();
    const int lo = args.ph_lo, hi = args.ph_hi;
    const bool one = (hi - lo) > 1;
    XcdBarrier bar; bar.bar = F.ctl + CW_BAR; bar.x = 0; bar.st = F.MISC + 8;
    if (one) bar = xcd_barrier_post(F.ctl + CW_BAR, F.MISC + 8);
#define IN(k) (lo <= (k) && (k) < hi && phase_begin(F))
#define SEAM(k) do { if (lo <= (k) && (k) + 1 < hi) xcd_barrier(bar); } while (0)

    if (IN(0)) { p0_prologue(F, args); } SEAM(0);
    if (IN(1)) {
        SchedP1 S{ws, F.G, F.bx};
        EpiP1 E{ws};
        pg8::gemm_phase<EpiP1, SchedP1, false>(F.lds, D, D, D, S, E);
        p1_gate_logits(F);
    } SEAM(1);
    if (IN(2)) {
        p2_retention_fast(F, F.bx, (bf16*)(ws + WS_RV));
        { const int w0 = F.bx * NWAVES + F.wave, nw = F.G * NWAVES;
            transpose_kv_tiles(F, (const bf16*)(ws + WS_KV6 + 3 * KV_STRIDE), (bf16*)args.out, w0, nw);
            transpose_kv_tiles(F, (const bf16*)(ws + WS_KV6 + 5 * KV_STRIDE), (bf16*)((unsigned char*)args.out + KV_STRIDE), w0, nw);
            transpose_memv_tiles(F, (bf16*)(ws + WS_MEMVT), w0, nw); }
        __syncthreads();
        { SchedCmp S{ws, 0, F.G, F.bx}; EpiCmp E{(float*)args.out + (size_t)16 * MiB};
            pg8::gemm_phase<EpiCmp, SchedCmp, false>(F.lds, 512, 2048, 4096, S, E); }
    } SEAM(2);
    if (IN(3)) { p2b_compress_out(F, args); } SEAM(3);
    if (IN(4)) { p3_ret_normalize(F); p3_nsa_fast(F, (const bf16*)args.out, (const bf16*)((const unsigned char*)args.out + KV_STRIDE), (bf16*)(ws + WS_NQ)); } SEAM(4);
    if (IN(5)) {
        SchedP4 S{ws, F.G, F.bx};
        EpiP4 E{(float*)(ws + WS_P4SCR) + (size_t)F.bx * (2 * 32 * 512 * 4), (bf16*)(ws + WS_Y)};
        pg8::gemm_phase<EpiP4, SchedP4, false>(F.lds, D, D, D, S, E);
    } SEAM(5);
    if (IN(6)) {
        SchedMN S{ws, WS_Y, W_OUT, F.G, F.bx}; EpiRes<true> E{args.in[IN_X], nullptr, nullptr, (bf16*)(ws + WS_X1B), (float*)(ws + WS_SSQ)};
        pg8::gemm_phase<EpiRes<true>, SchedMN, false>(F.lds, D, D, D, S, E);
    } SEAM(6);
    if (IN(7)) {
        const bool early = ((F.bx >> 3) & 1) == 0;
        if (early) expert_copies(F, args, 0, NEXP / 2);
        SchedMN S{ws, WS_X1B, W_XQ, F.G, F.bx}; EpiQ E{(const float*)(ws + WS_SSQ), (bf16*)(ws + WS_NQ)};
        pg8::gemm_phase<EpiQ, SchedMN, false>(F.lds, D, D, D, S, E);
        if (!early) { __syncthreads(); expert_copies(F, args, 0, NEXP / 2); }
    } SEAM(7);
    if (IN(8)) { p7_xattn_fast(F, (const bf16*)(ws + WS_MEMVT), (bf16*)(ws + WS_NQ)); } SEAM(8);
    if (IN(9)) {
        const bool early = ((F.bx >> 3) & 1) == 0;
        if (early) expert_copies(F, args, NEXP / 2, NEXP);
        SchedMN S{ws, WS_NQ, W_XO, F.G, F.bx}; EpiRes<false> E{nullptr, (const bf16*)(ws + WS_X1B), args.out, (bf16*)(ws + WS_X2B), nullptr};
        pg8::gemm_phase<EpiRes<false>, SchedMN, false>(F.lds, D, D, D, S, E);
        if (!early) { __syncthreads(); expert_copies(F, args, NEXP / 2, NEXP); }
    } SEAM(9);
    if (IN(10)) { p9_route(F, args); } SEAM(10);
    if (IN(11)) {
        moe_tiles(F);
        SchedMoe<0> S{F.MISC, ws, F.G, F.bx}; EpiMoe1 E{(const float*)(ws + WS_ROUTE) + 2 * NTOK, (bf16*)(ws + WS_H1)};
        pg8::gemm_phase<EpiMoe1, SchedMoe<0>, true>(F.lds, D, D, D, S, E);
    } SEAM(11);
    if (IN(12)) {
        moe_tiles(F);
        SchedMoe<1> S{F.MISC, ws, F.G, F.bx}; EpiMoe2 E{(const float*)(ws + WS_ROUTE), (bf16*)(ws + WS_YS0), (bf16*)(ws + WS_YS1)};
        pg8::gemm_phase<EpiMoe2, SchedMoe<1>, false>(F.lds, DEXP, DEXP, DEXP, S, E);
    } SEAM(12);
    if (IN(13)) { p12_final(F, args); }
#undef IN
#undef SEAM
}

extern "C" void kernel_launch(void* const* d_in, const int* in_sizes, int n_in, void* d_out, int out_size, void* d_ws, size_t ws_size, hipStream_t stream) {
    static int grid = 0;
    if (grid == 0) {
        if (n_in != 27 || in_sizes[0] != NTOK * D || out_size != NTOK * D || ws_size < WS_END) {
            fprintf(stderr, "kernel_launch: unexpected shapes: n_in %d in0 %d out %d ws %zu (need %zu)\n", n_in, n_in > 0 ? in_sizes[0] : -1, out_size, ws_size, (size_t)WS_END); grid = -1; return; }
        int dev = 0, cus = 0, per_cu = 0;
        if (hipGetDevice(&dev) != hipSuccess || hipDeviceGetAttribute(&cus, hipDeviceAttributeMultiprocessorCount, dev) != hipSuccess) { grid = -1; return; }
        if (hipFuncSetAttribute((const void*)fwd, hipFuncAttributeMaxDynamicSharedMemorySize, LDS_BYTES) != hipSuccess) { fprintf(stderr, "kernel_launch: hipFuncSetAttribute failed\n"); grid = -1; return; }
        if (hipOccupancyMaxActiveBlocksPerMultiprocessor(&per_cu, (const void*)fwd, NTHREADS, LDS_BYTES) != hipSuccess || per_cu < 1) fprintf(stderr, "kernel_launch: occupancy query reports %d\n", per_cu);
        (void)hipGetLastError();
        grid = cus < 256 ? cus : 256;
    }
    if (grid < 0) return;
    (void)hipMemsetAsync((char*)d_ws + WS_CTL, 0, CTL_ZERO_BYTES, stream);
    Args a{};
    for (int i = 0; i < 27; ++i) a.in[i] = (const float*)d_in[i];
    a.out = (float*)d_out; a.ws = (unsigned char*)d_ws;
#if MK_N_LAUNCHES == 1
    a.ph_lo = 0; a.ph_hi = N_PHASES;
    hipLaunchKernelGGL(fwd, dim3(grid), dim3(NTHREADS), LDS_BYTES, stream, a);
#else
    for (int p = 0; p < N_PHASES; ++p) { a.ph_lo = p; a.ph_hi = p + 1; hipLaunchKernelGGL(fwd, dim3(grid), dim3(NTHREADS), LDS_BYTES, stream, a); }
#endif
}
```

```cpp
#include <hip/hip_runtime.h>
#include <cstdio>
#include <cstdint>

#ifndef MK_N_LAUNCHES
#define MK_N_LAUNCHES 1
#endif

#define LAS __attribute__((address_space(3)))
#define GAS __attribute__((address_space(1)))
#define HD __host__ __device__
#define HDI __host__ __device__ __attribute__((always_inline)) inline
typedef unsigned short bf16;
typedef short bf16x8 __attribute__((ext_vector_type(8)));
typedef float f32x4 __attribute__((ext_vector_type(4)));
typedef float f32x2 __attribute__((ext_vector_type(2)));
typedef float f32x16 __attribute__((ext_vector_type(16)));
typedef unsigned u32x4 __attribute__((ext_vector_type(4)));
typedef unsigned u32x2 __attribute__((ext_vector_type(2)));

constexpr int D = 1024, BATCH = 8, SEQ = 4096, NTOK = BATCH * SEQ, NMEM = 256, NMEMTOK = BATCH * NMEM;
constexpr int DIN = 7704;
constexpr int C_RQ = 0, C_RK = 512, C_RV = 1024, C_RG = 2048, C_NQ = 3072, C_CK = 4096, C_NGL = 5632, C_GA = 5656, C_GB = 6680;
constexpr int NPROJ = 5632;
constexpr int NEXP = 32, DEXP = 512;
constexpr float EPS = 1e-6f;
constexpr int NWAVES = 8, NTHREADS = 512;

constexpr size_t MiB = 1u << 20;
constexpr size_t WS_CTL = 0, CTL_ZERO_BYTES = 1 * MiB;
constexpr size_t WS_ROPE_COS = 1 * MiB, WS_ROPE_SIN = 2 * MiB;
constexpr size_t WS_SMALLW = 3 * MiB;
constexpr size_t WS_MEMVT = 24 * MiB;
constexpr size_t WS_KCMP = 4 * MiB, WS_VCMP = 5 * MiB, WS_VCMPT = 35 * MiB;
constexpr size_t WS_GATES = 10 * MiB;
constexpr size_t WS_SSQ = 13 * MiB;
constexpr size_t WS_ROUTE = 15 * MiB;
constexpr size_t WS_LISTS = 16 * MiB;
constexpr size_t WS_W = 36 * MiB;
constexpr size_t W_IN = WS_W;
constexpr size_t W_GA = W_IN + 11 * MiB, W_GB = W_GA + 2 * MiB;
constexpr size_t W_RO = W_GB + 2 * MiB, W_NO = W_RO + 2 * MiB, W_OUT = W_NO + 2 * MiB, W_XQ = W_OUT + 2 * MiB, W_XO = W_XQ + 2 * MiB;
constexpr size_t W_XKV = W_XO + 2 * MiB;
constexpr size_t W_C1K = W_XKV + 4 * MiB, W_C1V = W_C1K + 2 * MiB;
constexpr size_t WS_MEMN = W_C1V + 2 * MiB;
constexpr size_t WS_MEMKV = WS_MEMN + 4 * MiB;
constexpr size_t WS_H = 84 * MiB;
constexpr size_t WS_NQ = WS_H + 64 * MiB;
constexpr size_t WS_RV = WS_NQ + 64 * MiB;
constexpr size_t WS_RQ = WS_RV + 64 * MiB;
constexpr size_t WS_RK = WS_RQ + 32 * MiB;
constexpr size_t WS_RG = WS_RK + 32 * MiB;
constexpr size_t WS_KV6 = WS_RG + 64 * MiB;
constexpr size_t KV_STRIDE = 16 * MiB;
constexpr size_t WS_END = WS_KV6 + 96 * MiB;
constexpr size_t WS_Y = WS_RQ, WS_P4SCR = WS_RG, WS_W13 = WS_RQ, WS_W2 = WS_RG, WS_H1 = WS_KV6, WS_X1B = WS_H, WS_X2B = WS_RV, WS_YS0 = WS_H, WS_YS1 = WS_NQ;
static_assert(WS_MEMKV + 8 * MiB <= WS_H && WS_VCMPT + 1 * MiB <= WS_W && WS_MEMVT + 4 * MiB <= WS_VCMPT, "ws map");
constexpr int CW_BAR = 4096;
constexpr int CW_ECNT = 16384;
constexpr int LDS_BYTES = 147456, RING_BYTES = 131072, MISC_OFF = RING_BYTES + 320;

HD inline float bf2f(bf16 b) { return __builtin_bit_cast(float, (unsigned)b << 16); }
HD inline unsigned f2bf(float f) { unsigned u = __builtin_bit_cast(unsigned, f); return (u + 0x7fffu + ((u >> 16) & 1u)) >> 16; }
HD inline unsigned pk2(float lo, float hi) { return f2bf(lo) | (f2bf(hi) << 16); }
HD inline float lo16(unsigned w) { return __builtin_bit_cast(float, w << 16); }
HD inline float hi16(unsigned w) { return __builtin_bit_cast(float, w & 0xffff0000u); }
__device__ __forceinline__ unsigned cvt_pk_bf16(float lo, float hi) { unsigned r; asm volatile("v_cvt_pk_bf16_f32 %0, %1, %2" : "=v"(r) : "v"(lo), "v"(hi)); return r; }
#define DPP_F(v, ctrl, rmask) __builtin_bit_cast(float, __builtin_amdgcn_update_dpp(0, __builtin_bit_cast(int, v), ctrl, rmask, 0xf, false))
__device__ __forceinline__ float wave_sum(float v) {
    v += DPP_F(v, 0xB1, 0xf);
    v += DPP_F(v, 0x4E, 0xf);
    v += DPP_F(v, 0x141, 0xf);
    v += DPP_F(v, 0x140, 0xf);
    v += DPP_F(v, 0x142, 0xa);
    v += DPP_F(v, 0x143, 0xc);
    return __builtin_bit_cast(float, __builtin_amdgcn_readlane(__builtin_bit_cast(int, v), 63));
}
__device__ __forceinline__ float wave_max(float v) {
#pragma unroll
    for (int o = 1; o < 64; o <<= 1) v = fmaxf(v, __shfl_xor(v, o));
    return v;
}
__device__ __forceinline__ float sigmoidf_(float x) { return __builtin_amdgcn_rcpf(1.0f + __builtin_amdgcn_exp2f(-1.4426950408889634f * x)); }
#define LAUNDER(p) asm volatile("" : "+v"(p))
#define LDS_WAIT() asm volatile("s_waitcnt lgkmcnt(0)" ::: "memory")
#define VM_WAIT() asm volatile("s_waitcnt vmcnt(0)" ::: "memory")

#define XB_TMO      128
#define XB_XCNT(j)  (256  + 64 * (j))
#define XB_XSUB(j)  (1280 + 64 * (j))
#define XB_XGEN(j)  (2304 + 64 * (j))
#define XB_TOP      3328
#define XB_TOPGEN   3392
#define XCD_BAR_WORDS 3456
#define XB_SPIN_CAP (1u << 24)
__device__ __forceinline__ unsigned xb_ld(unsigned* p)              { return __hip_atomic_load(p, __ATOMIC_RELAXED, __HIP_MEMORY_SCOPE_AGENT); }
__device__ __forceinline__ unsigned xb_add(unsigned* p, unsigned v) { return __hip_atomic_fetch_add(p, v, __ATOMIC_RELAXED, __HIP_MEMORY_SCOPE_AGENT); }
__device__ __forceinline__ unsigned xb_xcc_id() { return (unsigned)__builtin_amdgcn_s_getreg((3 << 11) | 20) & 0xFu; }
#define XB_SPIN(cond, bar) do { unsigned _sp = 0; while (cond) { __builtin_amdgcn_s_sleep(1); \
    if ((++_sp & 255u) == 0u) { if (xb_ld(&(bar)[XB_TMO])) break; if (_sp > XB_SPIN_CAP) { atomicAdd(&(bar)[XB_TMO], 1u); break; } } } } while (0)
struct XcdBarrier { unsigned* bar; unsigned x; volatile LAS unsigned* st; };
__device__ __forceinline__ XcdBarrier xcd_barrier_post(unsigned* bar, volatile LAS unsigned* st) {
    XcdBarrier b; b.bar = bar; b.x = xb_xcc_id(); b.st = st;
    if (threadIdx.x == 0) (void)xb_add(&bar[XB_XCNT(b.x)], 1u);
    return b;
}
__device__ __forceinline__ void xcd_barrier_complete(unsigned* bar, unsigned x, unsigned& nloc, unsigned& nx) {
    const unsigned G = gridDim.x * gridDim.y * gridDim.z;
    unsigned sum, cnt, mine, sp = 0u;
    for (;;) {
        sum = 0u; cnt = 0u; mine = 0u;
#pragma unroll
        for (unsigned j = 0; j < 16; ++j) { const unsigned c = xb_ld(&bar[XB_XCNT(j)]); sum += c; cnt += (c > 0u) ? 1u : 0u; mine = (j == x) ? c : mine; }
        if (sum == G) break;
        __builtin_amdgcn_s_sleep(1);
        if ((++sp & 255u) == 0u) { if (xb_ld(&bar[XB_TMO])) break; if (sp > XB_SPIN_CAP) { atomicAdd(&bar[XB_TMO], 1u); break; } }
    }
    nloc = mine > 0u ? mine : 1u; nx = cnt > 0u ? cnt : 1u;
}
__device__ __forceinline__ void xcd_barrier(const XcdBarrier& b) {
    asm volatile("s_waitcnt vmcnt(0)" ::: "memory");
    __syncthreads();
    if (threadIdx.x == 0) {
        unsigned* bar = b.bar;
        __builtin_amdgcn_s_waitcnt(0);
        unsigned nloc = b.st[0], nx = b.st[1];
        if (nloc == 0u) { xcd_barrier_complete(bar, b.x, nloc, nx); b.st[0] = nloc; b.st[1] = nx; }
        const unsigned old = xb_add(&bar[XB_XSUB(b.x)], 1u);
        const unsigned gen = old / nloc;
        if (old + 1u == (gen + 1u) * nloc) {
            __builtin_amdgcn_fence(__ATOMIC_RELEASE, "agent");
            asm volatile("s_waitcnt vmcnt(0)" ::: "memory");
            const unsigned og = xb_add(&bar[XB_TOP], 1u);
            const unsigned tg = og / nx;
            if (og + 1u == (tg + 1u) * nx) xb_add(&bar[XB_TOPGEN], 1u);
            else XB_SPIN(xb_ld(&bar[XB_TOPGEN]) == tg, bar);
            __builtin_amdgcn_fence(__ATOMIC_ACQUIRE, "agent");
            xb_add(&bar[XB_XGEN(b.x)], 1u);
            asm volatile("s_waitcnt vmcnt(0)" ::: "memory");
        } else {
            XB_SPIN(xb_ld(&bar[XB_XGEN(b.x)]) == gen, bar);
            __builtin_amdgcn_fence(__ATOMIC_ACQUIRE, "agent");
            asm volatile("s_waitcnt vmcnt(0)" ::: "memory");
        }
    }
    __syncthreads();
}

namespace pg8 {
constexpr int BM = 256, BK = 64, HALF = 128, HTB = HALF * BK * 2, NXCD = 8, WGM = 8;
HD __forceinline__ int lds_byte(int r, int c) { const int st = (r >> 4) * 2 + (c >> 5), rr = r & 15, cc = c & 31, ob = rr * 64 + cc * 2; return st * 1024 + (ob ^ (((ob >> 9) & 1) << 5)); }
HD __forceinline__ void stage_rc(int b, int& R, int& C) { const int st = b / 1024, sb = b % 1024, swz = sb ^ (((sb >> 9) & 1) << 5); R = (st >> 1) * 16 + swz / 64; C = (st & 1) * 32 + (swz % 64) / 2; }
HD __forceinline__ int perm32(int rho) { const int n = rho >> 4, i = rho & 15; return 8 * (i >> 2) + 4 * n + (i & 3); }
HD __forceinline__ void tile_map(int L, int nM, int nN, int& pm, int& pn) {
    const int nwg = nM * nN; int wgid = L; { const int q = nwg / NXCD, r = nwg % NXCD, xcd = wgid % NXCD, off = wgid / NXCD; wgid = (xcd < r ? xcd * (q + 1) : r * (q + 1) + (xcd - r) * q) + off; }
    const int nig = WGM * nN, gid = wgid / nig, fm = gid * WGM, gsz = (nM - fm) < WGM ? (nM - fm) : WGM;
    pm = fm + ((wgid % nig) % gsz); pn = (wgid % nig) / gsz;
}
struct GU { const char* A; const char* B; const int* rows; int nvalid; int kind, pm, pn, aux; };
template <class Epi, class Sched, bool GATHER>
__device__ __forceinline__ void gemm_phase(LAS unsigned char* lds, const int K, const int lda, const int ldb, const Sched& S, const Epi& E) {
    int tid_ = threadIdx.x; LAUNDER(tid_);
    const int tid = tid_, wid = __builtin_amdgcn_readfirstlane(tid >> 6), lane = tid & 63, wr = wid >> 2, wc = wid & 3, fr = lane & 15, fq = lane >> 4;
    const int nt = K / BK;
    unsigned voffB[2];
#pragma unroll
    for (int i = 0; i < 2; ++i) { int R, C; stage_rc(tid * 16 + i * 8192, R, C); const int Rb = Epi::PERM ? ((R & ~31) + perm32(R & 31)) : R; voffB[i] = (unsigned)(Rb * ldb + C) * 2u; }
    const size_t kstep = (size_t)(BK * 2);
    const size_t hstepB = (size_t)HALF * ldb * 2;
    const unsigned ldsw = (unsigned)wid * 1024u;
    const int aoff = lds_byte(wr * 64 + fr, fq * 8), boff = lds_byte(wc * 32 + fr, fq * 8);
#define PG8_SA(b, h) (((b) * 2 + (h)) * HTB)
#define PG8_SB(b, h) ((4 + (b) * 2 + (h)) * HTB)
#define PG8_STAGE2(bufoff, gbase, v0, v1) do { \
        __builtin_amdgcn_global_load_lds((const unsigned*)((const char*)(gbase) + (v0)), (LAS unsigned*)(lds + (bufoff) + ldsw), 16, 0, 0); \
        __builtin_amdgcn_global_load_lds((const unsigned*)((const char*)(gbase) + (v1)), (LAS unsigned*)(lds + (bufoff) + ldsw + 8192), 16, 0, 0); } while (0)
#define PG8_STAGEB(bufoff, gbase) PG8_STAGE2(bufoff, gbase, voffB[0], voffB[1])
#define PG8_LDA(dst, b, h) do { _Pragma("unroll") for (int m = 0; m < 4; ++m) _Pragma("unroll") for (int k = 0; k < 2; ++k) dst[m][k] = *(const LAS bf16x8*)(lds + PG8_SA(b, h) + aoff + m * 2048 + k * 1024); } while (0)
#define PG8_LDB(dst, b, h) do { _Pragma("unroll") for (int n = 0; n < 2; ++n) _Pragma("unroll") for (int k = 0; k < 2; ++k) dst[n][k] = *(const LAS bf16x8*)(lds + PG8_SB(b, h) + boff + n * 2048 + k * 1024); } while (0)
#define PG8_MMA(ai, bj, At, Bt) do { __builtin_amdgcn_s_setprio(1); _Pragma("unroll") for (int m = 0; m < 4; ++m) _Pragma("unroll") for (int n = 0; n < 2; ++n) _Pragma("unroll") for (int k = 0; k < 2; ++k) \
        acc[ai][bj][m][n] = __builtin_amdgcn_mfma_f32_16x16x32_bf16(Bt[n][k], At[m][k], acc[ai][bj][m][n], 0, 0, 0); __builtin_amdgcn_s_setprio(0); } while (0)
#define PG8_WAIT_V(n) asm volatile("s_waitcnt vmcnt(" #n ")" ::: "memory")
#define PG8_WAIT_L(n) asm volatile("s_waitcnt lgkmcnt(" #n ")" ::: "memory")
#define PG8_BAR __builtin_amdgcn_s_barrier()
#define PG8_SCHED __builtin_amdgcn_sched_barrier(0)
#define PG8_VOFFA(u, vo) do { _Pragma("unroll") for (int h = 0; h < 2; ++h) _Pragma("unroll") for (int i = 0; i < 2; ++i) { int R_, C_; stage_rc(tid * 16 + i * 8192, R_, C_); const int R = R_ + HALF * h; \
        int ridx = R; if (GATHER) { ridx = (R < (u).nvalid) ? ((u).rows[R] >> 1) : 0; } vo[h][i] = (unsigned)(ridx * lda + C_) * 2u; } if (GATHER) asm volatile("" :: "v"(vo[0][0]), "v"(vo[0][1]), "v"(vo[1][0]), "v"(vo[1][1])); } while (0)
    GU cur, nxt; int ui = 0;
    if (!S.next(0, cur)) return;
    f32x4 acc[2][2][4][2];
#pragma unroll
    for (int a = 0; a < 2; ++a)
#pragma unroll
        for (int b = 0; b < 2; ++b)
#pragma unroll
            for (int m = 0; m < 4; ++m)
#pragma unroll
                for (int n = 0; n < 2; ++n) acc[a][b][m][n] = (f32x4){0.f, 0.f, 0.f, 0.f};
    bf16x8 At[4][2], B0[2][2], B1[2][2];
    unsigned cv[2][2], nv[2][2];
    PG8_VOFFA(cur, cv);
    const char* cA = cur.A; const char* cB = cur.B;
    PG8_STAGEB(PG8_SB(0, 0), cB); PG8_STAGEB(PG8_SB(0, 1), cB + hstepB); PG8_STAGE2(PG8_SA(0, 0), cA, cv[0][0], cv[0][1]); PG8_STAGE2(PG8_SA(0, 1), cA, cv[1][0], cv[1][1]);
    if (wr == 1) PG8_BAR;
    PG8_WAIT_V(2); PG8_BAR;
    PG8_STAGEB(PG8_SB(1, 0), cB + kstep); PG8_STAGE2(PG8_SA(1, 0), cA + kstep, cv[0][0], cv[0][1]); PG8_STAGEB(PG8_SB(1, 1), cB + hstepB + kstep);
    PG8_WAIT_V(6); PG8_BAR;
    for (;;) {
        const bool has_next = S.next(ui + 1, nxt);
        const char* nA = has_next ? nxt.A : cA; const char* nB = has_next ? nxt.B : cB;
        if (has_next) { PG8_VOFFA(nxt, nv); } else {
#pragma unroll
            for (int h = 0; h < 2; ++h)
#pragma unroll
                for (int i = 0; i < 2; ++i) nv[h][i] = cv[h][i]; }
        for (int t = 0; t < nt; t += 2) {
            const bool last = (t == nt - 2);
            const char* a1 = cA + (size_t)(t + 1) * kstep;
            const char* a2 = last ? nA : cA + (size_t)(t + 2) * kstep; const char* b2 = last ? nB : cB + (size_t)(t + 2) * kstep;
            const char* a3 = a2 + kstep; const char* b3 = b2 + kstep;
            const unsigned w00 = last ? nv[0][0] : cv[0][0], w01 = last ? nv[0][1] : cv[0][1], w10 = last ? nv[1][0] : cv[1][0], w11 = last ? nv[1][1] : cv[1][1];
            PG8_LDB(B0, 0, 0); PG8_LDB(B1, 0, 1); PG8_SCHED; PG8_LDA(At, 0, 0); PG8_STAGE2(PG8_SA(1, 1), a1, cv[1][0], cv[1][1]);
            PG8_WAIT_V(8); PG8_WAIT_L(0); PG8_BAR; PG8_MMA(0, 0, At, B0); PG8_MMA(0, 1, At, B1); PG8_BAR; PG8_SCHED;
            PG8_LDA(At, 0, 1); PG8_STAGEB(PG8_SB(0, 0), b2); PG8_STAGEB(PG8_SB(0, 1), b2 + hstepB); PG8_STAGE2(PG8_SA(0, 0), a2, w00, w01);
            PG8_WAIT_V(8); PG8_WAIT_L(0); PG8_BAR; PG8_MMA(1, 0, At, B0); PG8_MMA(1, 1, At, B1); PG8_BAR; PG8_SCHED;
            PG8_LDB(B0, 1, 0); PG8_LDB(B1, 1, 1); PG8_SCHED; PG8_LDA(At, 1, 0); PG8_STAGE2(PG8_SA(0, 1), a2, w10, w11);
            PG8_WAIT_V(8); PG8_WAIT_L(0); PG8_BAR; PG8_MMA(0, 0, At, B0); PG8_MMA(0, 1, At, B1); PG8_BAR; PG8_SCHED;
            PG8_LDA(At, 1, 1); PG8_STAGEB(PG8_SB(1, 0), b3); PG8_STAGEB(PG8_SB(1, 1), b3 + hstepB); PG8_STAGE2(PG8_SA(1, 0), a3, w00, w01);
            PG8_WAIT_V(8); PG8_WAIT_L(0); PG8_BAR; PG8_MMA(1, 0, At, B0); PG8_MMA(1, 1, At, B1); PG8_BAR; PG8_SCHED;
        }
        if (wr == 0) PG8_BAR;
        E(acc, cur, wr, wc, fr, fq);
        if (!has_next) break;
#pragma unroll
        for (int a = 0; a < 2; ++a)
#pragma unroll
            for (int b = 0; b < 2; ++b)
#pragma unroll
                for (int m = 0; m < 4; ++m)
#pragma unroll
                    for (int n = 0; n < 2; ++n) acc[a][b][m][n] = (f32x4){0.f, 0.f, 0.f, 0.f};
        cur = nxt; cA = nA; cB = nB; ++ui;
#pragma unroll
        for (int h = 0; h < 2; ++h)
#pragma unroll
            for (int i = 0; i < 2; ++i) cv[h][i] = nv[h][i];
        if (wr == 1) PG8_BAR;
    }
    PG8_WAIT_V(0);
    PG8_BAR;
#undef PG8_SA
#undef PG8_SB
#undef PG8_STAGE2
#undef PG8_STAGEB
#undef PG8_LDA
#undef PG8_LDB
#undef PG8_MMA
#undef PG8_WAIT_V
#undef PG8_WAIT_L
#undef PG8_BAR
#undef PG8_SCHED
#undef PG8_VOFFA
}
}
using pg8::GU;

struct Args {
    const float* in[27]; float* out; unsigned char* ws; int ph_lo, ph_hi; int pad0, pad1;
};
enum { IN_X = 0, IN_MEM, IN_NORM_MIX_G, IN_W_IN, IN_W_RET_O, IN_W_NSA_O, IN_W_OUT, IN_CMP_PE_K, IN_CMP_W1_K, IN_CMP_W2_K, IN_CMP_PE_V, IN_CMP_W1_V, IN_CMP_W2_V,
       IN_NORM_X_G, IN_NORM_MEM_G, IN_W_XQ, IN_W_XKV, IN_W_XO, IN_NORM_FFN_G, IN_W_GRP, IN_B_GRP, IN_W_RT, IN_B_RT, IN_W_E1, IN_W_E3, IN_W_E2, IN_NORM_F_G };
struct Frame {
    LAS unsigned char* lds; volatile LAS unsigned* MISC; unsigned* ctl; unsigned char* ws;
    int tid, lane, wave, G, bx;
};

__device__ __forceinline__ bool phase_begin(Frame& F) { int t = threadIdx.x; LAUNDER(t); F.tid = t; F.lane = t & 63; return true; }
__device__ __forceinline__ void transpose_item(const float* W, int ldw, int c0, int k0, bf16* WT, int ldt, int mode, int row_off, int cbase, const float* kscale, float scale, LAS float* scr, int lane) {
    float vv[32];
#pragma unroll
    for (int i = 0; i < 32; ++i) { const int kk = 2 * i + (lane >> 5); vv[i] = W[(size_t)(k0 + kk) * ldw + c0 + (lane & 31)]; }
    if (kscale) {
#pragma unroll
        for (int i = 0; i < 32; ++i) { const int kk = 2 * i + (lane >> 5); vv[i] *= kscale[k0 + kk]; } }
#pragma unroll
    for (int i = 0; i < 32; ++i) { const int kk = 2 * i + (lane >> 5); scr[kk * 33 + (lane & 31)] = vv[i] * scale; }
    LDS_WAIT(); asm volatile("" ::: "memory");
    const int c = lane & 7;
#pragma unroll
    for (int j = 0; j < 4; ++j) { const int n = (lane >> 3) + 8 * j; const LAS float* s = scr + (8 * c) * 33 + n;
        u32x4 o; o.x = pk2(s[0 * 33], s[1 * 33]); o.y = pk2(s[2 * 33], s[3 * 33]); o.z = pk2(s[4 * 33], s[5 * 33]); o.w = pk2(s[6 * 33], s[7 * 33]);
        const int jc = c0 - cbase + n; const int drow = mode == 0 ? row_off + jc : (8 * (jc >> 2) + 4 * row_off + (jc & 3));
        *(u32x4*)(WT + (size_t)drow * ldt + k0 + 8 * c) = o; }
    LDS_WAIT(); asm volatile("" ::: "memory");
}
__device__ __forceinline__ void transpose_matrix(Frame& F, int& item_base, const float* W, int ldw, int K, int cbase, int ncols, bf16* WT, int ldt, int mode, int row_off, const float* kscale, float scale) {
    LAS float* scr = (LAS float*)(F.lds + F.wave * 16384);
    const int gw = F.bx * NWAVES + F.wave, NGW = F.G * NWAVES;
    const int nb = ncols / 32, nitems = (K / 64) * nb;
    int it = (gw - item_base % NGW + NGW) % NGW;
    for (; it < nitems; it += NGW) transpose_item(W, ldw, cbase + 32 * (it % nb), 64 * (it / nb), WT, ldt, mode, row_off, cbase, kscale, scale, scr, F.lane);
    item_base += nitems;
}
__device__ __forceinline__ void rms_row_to_bf16(int lane, const float* xrow, const float* g, bf16* orow) {
    const f32x4* xr = (const f32x4*)xrow + lane; const f32x4* gr = (const f32x4*)g + lane;
    f32x4 v[4]; float s = 0.f;
#pragma unroll
    for (int j = 0; j < 4; ++j) { v[j] = xr[64 * j]; s += (v[j].x * v[j].x + v[j].y * v[j].y) + (v[j].z * v[j].z + v[j].w * v[j].w); }
    const float rstd = 1.0f / sqrtf(wave_sum(s) * (1.f / D) + EPS);
    unsigned long long* o8 = (unsigned long long*)orow + lane;
#pragma unroll
    for (int j = 0; j < 4; ++j) { const f32x4 gg = gr[64 * j];
        o8[64 * j] = (unsigned long long)pk2(v[j].x * rstd * gg.x, v[j].y * rstd * gg.y) | ((unsigned long long)pk2(v[j].z * rstd * gg.z, v[j].w * rstd * gg.w) << 32); }
}

struct XItem { const float* src; bf16* dst; const float* ks; float scale; int ldw, ldt, mode, row_off, csrc, c0, k0, has_ks; };
__device__ __forceinline__ void xitem_decode_expert(const Args& a, unsigned char* ws, int it, XItem& x) {
    const int e = it / 768, r = it % 768, which = r >> 8, t = r & 255;
    x.ks = a.in[IN_NORM_FFN_G]; x.scale = 1.0f;
    if (which < 2) { x.src = a.in[which ? IN_W_E3 : IN_W_E1] + (size_t)e * D * DEXP; x.ldw = DEXP; x.dst = (bf16*)(ws + WS_W13) + (size_t)e * D * D; x.ldt = D; x.mode = 1; x.row_off = which; x.has_ks = 1; x.c0 = 32 * (t & 15); x.k0 = 64 * (t >> 4); }
    else { x.src = a.in[IN_W_E2] + (size_t)e * DEXP * D; x.ldw = D; x.dst = (bf16*)(ws + WS_W2) + (size_t)e * D * DEXP; x.ldt = DEXP; x.mode = 0; x.row_off = 0; x.has_ks = 0; x.c0 = 32 * (t & 31); x.k0 = 64 * (t >> 5); }
    x.csrc = x.c0;
}
constexpr int P0_NITEMS = 7936;
__device__ __forceinline__ void xitem_decode_p0(const Args& a, unsigned char* ws, int it, XItem& x) {
    int in_ = IN_W_IN, ldw = DIN, cb = 0, nc = 512, ldt = D, ro = 0, first = 0; size_t dst = W_IN; float sc = 1.0f; int hk = 0;
#define P0E(FIRST, IN__, LDW, CB, NC, DST, LDT, RO, SC, HK) if (it >= (FIRST)) { in_ = (IN__); ldw = (LDW); cb = (CB); nc = (NC); dst = (DST); ldt = (LDT); ro = (RO); sc = (SC); hk = (HK); first = (FIRST); }
    P0E(256, IN_W_IN, DIN, 512, 512, W_IN, D, 512, 0.08838834764831845f, 0)
    P0E(512, IN_W_IN, DIN, 1024, NPROJ - 1024, W_IN, D, 1024, 1.0f, 0)
    P0E(2816, IN_W_IN, DIN, C_GA, 1024, W_GA, D, 0, 1.0f, 0)
    P0E(3328, IN_W_IN, DIN, C_GB, 1024, W_GB, D, 0, 1.0f, 0)
    P0E(3840, IN_W_RET_O, D, 0, D, W_RO, D, 0, 1.0f, 0)
    P0E(4352, IN_W_NSA_O, D, 0, D, W_NO, D, 0, 1.0f, 0)
    P0E(4864, IN_W_OUT, D, 0, D, W_OUT, D, 0, 1.0f, 0)
    P0E(5376, IN_W_XQ, D, 0, D, W_XQ, D, 0, 1.0f, 1)
    P0E(5888, IN_W_XO, D, 0, D, W_XO, D, 0, 1.0f, 0)
    P0E(6400, IN_W_XKV, 2 * D, 0, 2 * D, W_XKV, D, 0, 1.0f, 0)
    P0E(7424, IN_CMP_W1_K, 128, 0, 128, W_C1K, 4096, 0, 1.0f, 0)
    P0E(7680, IN_CMP_W1_V, 128, 0, 128, W_C1V, 4096, 0, 1.0f, 0)
#undef P0E
    const int t = it - first, nb = nc >> 5;
    x.src = a.in[in_]; x.dst = (bf16*)(ws + dst); x.ks = a.in[IN_NORM_X_G]; x.scale = sc; x.ldw = ldw; x.ldt = ldt; x.mode = 0; x.row_off = ro; x.has_ks = hk;
    x.c0 = 32 * (t % nb); x.csrc = cb + x.c0; x.k0 = 64 * (t / nb);
}
__device__ __forceinline__ void xitem_load(const XItem& x, int lane, float (&vv)[32], f32x4& k0v, f32x4& k1v) {
#pragma unroll
    for (int i = 0; i < 32; ++i) { const int kk = 2 * i + (lane >> 5); vv[i] = x.src[(size_t)(x.k0 + kk) * x.ldw + x.csrc + (lane & 31)]; }
    const f32x4* p = (const f32x4*)(x.ks + ((x.k0 + 8 * (lane & 7)) & 1023)); k0v = p[0]; k1v = p[1];
}
__device__ __forceinline__ void xitem_finish(const XItem& x, int lane, const float (&vv)[32], f32x4 k0v, f32x4 k1v, LAS float* scr) {
    if (!x.has_ks) { k0v = (f32x4){1.f, 1.f, 1.f, 1.f}; k1v = k0v; }
    k0v *= x.scale; k1v *= x.scale;
#pragma unroll
    for (int i = 0; i < 32; ++i) { const int kk = 2 * i + (lane >> 5); scr[kk * 33 + (lane & 31)] = vv[i]; }
    LDS_WAIT(); asm volatile("" ::: "memory");
    const int c = lane & 7;
#pragma unroll
    for (int j = 0; j < 4; ++j) { const int n = (lane >> 3) + 8 * j; const LAS float* s = scr + (8 * c) * 33 + n;
        u32x4 o; o.x = pk2(s[0 * 33] * k0v.x, s[1 * 33] * k0v.y); o.y = pk2(s[2 * 33] * k0v.z, s[3 * 33] * k0v.w); o.z = pk2(s[4 * 33] * k1v.x, s[5 * 33] * k1v.y); o.w = pk2(s[6 * 33] * k1v.z, s[7 * 33] * k1v.w);
        const int jc = x.c0 + n; const int drow = x.mode == 0 ? x.row_off + jc : (8 * (jc >> 2) + 4 * x.row_off + (jc & 3));
        *(u32x4*)(x.dst + (size_t)drow * x.ldt + x.k0 + 8 * c) = o; }
    LDS_WAIT(); asm volatile("" ::: "memory");
}
template <bool EXPERT>
__device__ __forceinline__ void run_items(Frame& F, const Args& a, int it_begin, int it_end) {
    LAS float* scr = (LAS float*)(F.lds + F.wave * 16384);
    const int gw = F.bx * NWAVES + F.wave, NGW = F.G * NWAVES, lane = F.lane;
    int it = it_begin + gw;
#define XDEC(i_, x_) do { if (EXPERT) xitem_decode_expert(a, F.ws, (i_), x_); else xitem_decode_p0(a, F.ws, (i_), x_); } while (0)
    if (it < it_end) {
        float va[32], vb[32]; f32x4 ka0, ka1, kb0, kb1; XItem xa, xb;
        XDEC(it, xa); xitem_load(xa, lane, va, ka0, ka1);
        for (;;) {
            int itn = it + NGW; bool hn = itn < it_end;
            XDEC(hn ? itn : it, xb); xitem_load(xb, lane, vb, kb0, kb1);
            xitem_finish(xa, lane, va, ka0, ka1, scr);
            if (!hn) break;
            it = itn; itn = it + NGW; hn = itn < it_end;
            XDEC(hn ? itn : it, xa); xitem_load(xa, lane, va, ka0, ka1);
            xitem_finish(xb, lane, vb, kb0, kb1, scr);
            if (!hn) break;
            it = itn;
        }
    }
#undef XDEC
    __syncthreads();
}
__device__ __forceinline__ void expert_copies(Frame& F, const Args& a, int e_lo, int e_hi) { run_items<true>(F, a, e_lo * 768, e_hi * 768); }

__device__ __forceinline__ void p0_prologue(Frame& F, const Args& a) {
    unsigned char* ws = F.ws;
    const float* w_in = a.in[IN_W_IN];
    run_items<false>(F, a, 0, P0_NITEMS);
    const int gt = F.bx * NTHREADS + F.tid, NGT = F.G * NTHREADS;
    for (int i = gt; i < 2 * 128 * 4096 / 8; i += NGT) { const int m = i / (128 * 4096 / 8), r = i % (128 * 4096 / 8);
        *(u32x4*)(ws + (m ? W_C1V : W_C1K) + (size_t)128 * 4096 * 2 + (size_t)r * 16) = (u32x4){0u, 0u, 0u, 0u}; }
    bf16* wngl = (bf16*)(ws + WS_SMALLW);
    for (int i = gt; i < 32 * 1024; i += NGT) { const int r = i >> 10, k = i & 1023; wngl[i] = r < 24 ? (bf16)f2bf(w_in[(size_t)k * DIN + C_NGL + r]) : (bf16)0; }
    bf16* w2k = (bf16*)(ws + WS_SMALLW + 65536); bf16* w2v = w2k + 128 * 128;
    for (int i = gt; i < 2 * 128 * 128; i += NGT) { const int m = i >> 14, r = i & 16383, f = r >> 7, e = r & 127; const float* src = a.in[m ? IN_CMP_W2_V : IN_CMP_W2_K];
        (m ? w2v : w2k)[f * 128 + e] = (bf16)f2bf(src[e * 128 + f]); }
    float* cbias = (float*)(ws + WS_SMALLW + 65536 + 2 * 128 * 128 * 2);
    const int gw = F.bx * NWAVES + F.wave, NGW = F.G * NWAVES;
    for (int o = gw; o < 256; o += NGW) { const int m = o >> 7, e = o & 127; const float* pe = a.in[m ? IN_CMP_PE_V : IN_CMP_PE_K]; const float* w1 = a.in[m ? IN_CMP_W1_V : IN_CMP_W1_K];
        float s = 0.f; for (int k = F.lane; k < 4096; k += 64) s += pe[k] * w1[(size_t)k * 128 + e];
        s = wave_sum(s); if (F.lane == 0) cbias[o] = s; }
    float* cosT = (float*)(ws + WS_ROPE_COS); float* sinT = (float*)(ws + WS_ROPE_SIN);
    for (int i = gt; i < SEQ * 64; i += NGT) { const int pos = i >> 6, j = i & 63; const float inv = powf(10000.0f, -(float)(2 * j) / 128.0f); const float ang = (float)pos * inv;
        cosT[i] = cosf(ang); sinT[i] = sinf(ang); }
    { f32x4 nx[4]; const float* X = a.in[IN_X]; const f32x4* gr = (const f32x4*)a.in[IN_NORM_MIX_G] + F.lane;
      if (gw < NTOK) {
#pragma unroll
          for (int j = 0; j < 4; ++j) nx[j] = ((const f32x4*)(X + (size_t)gw * D) + F.lane)[64 * j]; }
      for (int m = gw; m < NTOK; m += NGW) { f32x4 v[4]; float sq = 0.f;
#pragma unroll
          for (int j = 0; j < 4; ++j) { v[j] = nx[j]; sq += (v[j].x * v[j].x + v[j].y * v[j].y) + (v[j].z * v[j].z + v[j].w * v[j].w); }
          if (m + NGW < NTOK) {
#pragma unroll
              for (int j = 0; j < 4; ++j) nx[j] = ((const f32x4*)(X + (size_t)(m + NGW) * D) + F.lane)[64 * j]; }
          const float rstd = 1.0f / sqrtf(wave_sum(sq) * (1.f / D) + EPS); unsigned long long* o8 = (unsigned long long*)((bf16*)(ws + WS_H) + (size_t)m * D) + F.lane;
#pragma unroll
          for (int j = 0; j < 4; ++j) { const f32x4 gg = gr[64 * j]; o8[64 * j] = (unsigned long long)pk2(v[j].x * rstd * gg.x, v[j].y * rstd * gg.y) | ((unsigned long long)pk2(v[j].z * rstd * gg.z, v[j].w * rstd * gg.w) << 32); } } }
    for (int m = gw; m < NMEMTOK; m += NGW) rms_row_to_bf16(F.lane, a.in[IN_MEM] + (size_t)m * D, a.in[IN_NORM_MEM_G], (bf16*)(ws + WS_MEMN) + (size_t)m * D);
}

struct SchedP1 {
    unsigned char* ws; int G, c;
    __device__ __forceinline__ bool next(int i, GU& u) const {
        constexpr int NP = 128 * 22; const int L = i * G + c;
        u.rows = nullptr; u.nvalid = 0; u.aux = 0;
        if (L < NP) { int pm, pn; pg8::tile_map(L, 128, 22, pm, pn); u.A = (const char*)ws + WS_H + (size_t)pm * 256 * D * 2; u.B = (const char*)ws + W_IN + (size_t)pn * 256 * D * 2; u.pm = pm; u.pn = pn;
            u.kind = pn < 2 ? 0 : pn < 4 ? 1 : pn < 8 ? 2 : pn < 12 ? 3 : pn < 16 ? 4 : 5; return true; }
        const int L2 = L - NP; if (L2 >= 64) return false;
        const int pm = L2 & 7, pn = L2 >> 3; u.A = (const char*)ws + WS_MEMN + (size_t)pm * 256 * D * 2; u.B = (const char*)ws + W_XKV + (size_t)pn * 256 * D * 2; u.pm = pm; u.pn = pn; u.kind = 6; return true;
    }
};
struct EpiP1 {
    static constexpr bool PERM = true;
    unsigned char* ws;
    __device__ __forceinline__ void operator()(const f32x4 (&acc)[2][2][4][2], const GU& u, int wr, int wc, int fr, int fq) const {
        const int kind = u.kind;
        const float* cosT = (const float*)(ws + WS_ROPE_COS); const float* sinT = (const float*)(ws + WS_ROPE_SIN);
#pragma unroll
        for (int ai = 0; ai < 2; ++ai)
#pragma unroll
            for (int m = 0; m < 4; ++m) {
                const int r = 128 * ai + 64 * wr + 16 * m + fr; const int tok = u.pm * 256 + r;
#pragma unroll
                for (int bj = 0; bj < 2; ++bj) {
                    f32x4 v0 = acc[ai][bj][m][0], v1 = acc[ai][bj][m][1];
                    const int ct = 128 * bj + 32 * wc + 8 * fq;
                    bf16* dst;
                    if (kind <= 1) {
                        const int s = tok & (SEQ - 1), i0 = ((ct & 127) >> 1);
                        const f32x4 cs = *(const f32x4*)(cosT + s * 64 + i0), sn = *(const f32x4*)(sinT + s * 64 + i0);
                        const f32x4 a0 = v0, a1 = v1;
                        v0[0] = a0[0] * cs[0] - a0[1] * sn[0]; v0[1] = a0[0] * sn[0] + a0[1] * cs[0];
                        v0[2] = a0[2] * cs[1] - a0[3] * sn[1]; v0[3] = a0[2] * sn[1] + a0[3] * cs[1];
                        v1[0] = a1[0] * cs[2] - a1[1] * sn[2]; v1[1] = a1[0] * sn[2] + a1[1] * cs[2];
                        v1[2] = a1[2] * cs[3] - a1[3] * sn[3]; v1[3] = a1[2] * sn[3] + a1[3] * cs[3];
                        dst = (bf16*)(ws + (kind == 0 ? WS_RQ : WS_RK)) + (size_t)tok * 512 + (u.pn & 1) * 256 + ct;
                    } else if (kind == 2) { dst = (bf16*)(ws + WS_RV) + (size_t)tok * 1024 + (u.pn - 4) * 256 + ct;
                    } else if (kind == 3) {
#pragma unroll
                        for (int j = 0; j < 4; ++j) { v0[j] = v0[j] * sigmoidf_(v0[j]); v1[j] = v1[j] * sigmoidf_(v1[j]); }
                        dst = (bf16*)(ws + WS_RG) + (size_t)tok * 1024 + (u.pn - 8) * 256 + ct;
                    } else if (kind == 4) { dst = (bf16*)(ws + WS_NQ) + (size_t)tok * 1024 + (u.pn - 12) * 256 + ct;
                    } else if (kind == 5) {
                        const int b = tok >> 12, s = tok & (SEQ - 1);
                        unsigned char* kvb = ws + WS_KV6 + (size_t)(u.pn - 16) * KV_STRIDE;
                        dst = (bf16*)kvb + ((size_t)(b * 2 + bj) * SEQ + s) * 128 + (ct & 127);
                    } else { dst = (bf16*)(ws + WS_MEMKV) + (size_t)tok * 2048 + u.pn * 256 + ct; }
                    u32x4 w; w.x = cvt_pk_bf16(v0[0], v0[1]); w.y = cvt_pk_bf16(v0[2], v0[3]); w.z = cvt_pk_bf16(v1[0], v1[1]); w.w = cvt_pk_bf16(v1[2], v1[3]);
                    *(u32x4*)dst = w;
                }
            }
    }
};
__device__ __forceinline__ void p1_gate_logits(Frame& F) {
    const bf16* H = (const bf16*)(F.ws + WS_H); const bf16* W = (const bf16*)(F.ws + WS_SMALLW); float* gates = (float*)(F.ws + WS_GATES);
    const int r = F.lane & 31, hh = F.lane >> 5;
    const int nb_ = F.G > 64 ? F.G - 64 : F.G, b0_ = F.G > 64 ? F.bx - 64 : F.bx;
    if (b0_ < 0) return;
    for (int rb = b0_ + nb_ * F.wave; rb < NTOK / 32; rb += nb_ * NWAVES) {
        f32x16 acc; for (int j = 0; j < 16; ++j) acc[j] = 0.f;
        const bf16* ap = H + (size_t)(rb * 32 + r) * D + 8 * hh; const bf16* bp = W + (size_t)r * D + 8 * hh;
        for (int s8 = 0; s8 < 8; ++s8) { bf16x8 av[8], bv[8];
#pragma unroll
            for (int q = 0; q < 8; ++q) { av[q] = *(const bf16x8*)(ap + 16 * (8 * s8 + q)); bv[q] = *(const bf16x8*)(bp + 16 * (8 * s8 + q)); }
#pragma unroll
            for (int q = 0; q < 8; ++q) acc = __builtin_amdgcn_mfma_f32_32x32x16_bf16(av[q], bv[q], acc, 0, 0, 0); }
        if (r < 24) {
#pragma unroll
            for (int reg = 0; reg < 16; ++reg) { const int row = (reg & 3) + 8 * (reg >> 2) + 4 * hh; gates[(size_t)(rb * 32 + row) * 24 + r] = sigmoidf_(acc[reg]); }
        }
    }
}

namespace retf {
constexpr int ROWB = 272;
constexpr int OFF_K = 0, OFF_V = 128 * 256, OFF_ZV = OFF_V + 128 * 64, OFF_ST = OFF_ZV + 128 * 64, OFF_PART = OFF_ST + 32 * ROWB, OFF_Q = OFF_PART + 4 * 4096;
static_assert(OFF_Q + 128 * 256 <= RING_BYTES, "retention LDS map");
typedef short s16x4 __attribute__((ext_vector_type(4)));
__device__ __forceinline__ u32x2 lds_tr(const LAS unsigned char* p) { return __builtin_bit_cast(u32x2, __builtin_amdgcn_ds_read_tr16_b64_v4i16((LAS s16x4*)p)); }
}
__device__ __forceinline__ void p2_retention_fast(Frame& F, int unit, bf16* outbase) {
    using namespace retf;
    const int bh = (unit & 7) * 4 + (unit >> 6), sl = (unit >> 3) & 7, b = bh >> 2, h = bh & 3;
    const bf16* rq = (const bf16*)(F.ws + WS_RQ); const bf16* rk = (const bf16*)(F.ws + WS_RK); const bf16* rv = (const bf16*)(F.ws + WS_RV);
    const int tid = F.tid, lane = F.lane, wave = F.wave, r = lane & 31, hi = lane >> 5; LAS unsigned char* lds = F.lds;
    const float lg = log2f(1.0f - exp2f(-5.0f - (float)h));
    const int nt = wave & 3, mh = wave >> 2;
    for (int i = tid; i < 32 * ROWB / 4; i += NTHREADS) ((LAS unsigned*)(lds + OFF_ST))[i] = 0u;
    f32x16 ST;
#pragma unroll
    for (int j = 0; j < 16; ++j) ST[j] = 0.f;
    const float gC = exp2f(128.0f * lg);
    const float zeta = exp2f((float)(127 - (tid >> 2)) * lg);
    const int blk = (lane >> 4) & 1, q4 = (lane & 15) >> 2, p4 = lane & 3;
    const int vtr = (4 * hi + q4) * 64 + 32 * blk + 8 * p4;
    const int ztr = (8 * hi + q4) * 64 + 32 * blk + 8 * p4;
    int ktr[2];
#pragma unroll
    for (int t = 0; t < 2; ++t) ktr[t] = 256 * (8 * hi + 4 * t + q4) + 16 * ((4 * nt + 2 * blk + (p4 >> 1)) ^ ((q4 << 2) | ((2 * hi + t) & 3))) + 8 * (p4 & 1);
    const int krow = 256 * r + 16 * (hi ^ (((r & 3) << 2) | ((r >> 2) & 3)));
    u32x4 kreg[4], qreg[4], vreg;
    {   const int tok0 = b * SEQ;
#pragma unroll
        for (int i = 0; i < 4; ++i) { const int p = tid + 512 * i, m = p >> 4, cc = p & 15; kreg[i] = *(const u32x4*)(rk + (size_t)(tok0 + m) * 512 + h * 128 + cc * 8); qreg[i] = *(const u32x4*)(rq + (size_t)(tok0 + m) * 512 + h * 128 + cc * 8); }
        { const int m = tid >> 2, cc = tid & 3; vreg = *(const u32x4*)(rv + (size_t)(tok0 + m) * 1024 + h * 256 + sl * 32 + cc * 8); } }
    u32x2 opk[4]; bf16* oprev = outbase;
#pragma unroll
    for (int i = 0; i < 4; ++i) opk[i] = (u32x2){0u, 0u};
    for (int c = 0; c < SEQ / 128; ++c) {
        const int tok0 = b * SEQ + c * 128;
        __syncthreads();
#pragma unroll
        for (int i = 0; i < 4; ++i) { const int p = tid + 512 * i, m = p >> 4, cc = p & 15; const int o_ = 256 * m + 16 * (cc ^ (((m & 3) << 2) | ((m >> 2) & 3)));
            *(LAS u32x4*)(lds + OFF_K + o_) = kreg[i]; *(LAS u32x4*)(lds + OFF_Q + o_) = qreg[i]; }
        { const u32x4 v = vreg; u32x4 zv;
            zv.x = cvt_pk_bf16(lo16(v.x) * zeta, hi16(v.x) * zeta); zv.y = cvt_pk_bf16(lo16(v.y) * zeta, hi16(v.y) * zeta); zv.z = cvt_pk_bf16(lo16(v.z) * zeta, hi16(v.z) * zeta); zv.w = cvt_pk_bf16(lo16(v.w) * zeta, hi16(v.w) * zeta);
            *(LAS u32x4*)(lds + OFF_V + tid * 16) = v; *(LAS u32x4*)(lds + OFF_ZV + tid * 16) = zv; }
        __syncthreads();
        if (mh == 0 && c > 0) {
#pragma unroll
            for (int i = 0; i < 4; ++i) *(u32x2*)(oprev + 8 * i + 4 * hi) = opk[i]; }
        if (c + 1 < SEQ / 128) { const int tok1 = tok0 + 128;
#pragma unroll
            for (int i = 0; i < 4; ++i) { const int p = tid + 512 * i, m = p >> 4, cc = p & 15; kreg[i] = *(const u32x4*)(rk + (size_t)(tok1 + m) * 512 + h * 128 + cc * 8); qreg[i] = *(const u32x4*)(rq + (size_t)(tok1 + m) * 512 + h * 128 + cc * 8); }
            { const int m = tid >> 2, cc = tid & 3; vreg = *(const u32x4*)(rv + (size_t)(tok1 + m) * 1024 + h * 256 + sl * 32 + cc * 8); } }
        bf16x8 qf[8];
#pragma unroll
        for (int s_ = 0; s_ < 8; ++s_) qf[s_] = *(const LAS bf16x8*)(lds + OFF_Q + 8192 * nt + (krow ^ (32 * s_)));
        f32x16 CR;
#pragma unroll
        for (int j = 0; j < 16; ++j) CR[j] = 0.f;
        if (mh == 0) {
#pragma unroll
            for (int s_ = 0; s_ < 8; ++s_) { const bf16x8 a = *(const LAS bf16x8*)(lds + OFF_ST + r * ROWB + (16 * s_ + 8 * hi) * 2); CR = __builtin_amdgcn_mfma_f32_32x32x16_bf16(a, qf[s_], CR, 0, 0, 0); }
        }
        f32x16 IN_;
#pragma unroll
        for (int j = 0; j < 16; ++j) IN_[j] = 0.f;
#pragma unroll
        for (int mi = 0; mi < 2; ++mi) { const int mt = 2 * mh + mi;
            if (mt <= nt) {
                f32x16 A;
#pragma unroll
                for (int j = 0; j < 16; ++j) A[j] = 0.f;
#pragma unroll
                for (int s_ = 0; s_ < 8; ++s_) { const bf16x8 a = *(const LAS bf16x8*)(lds + OFF_K + 8192 * mt + (krow ^ (32 * s_))); A = __builtin_amdgcn_mfma_f32_32x32x16_bf16(a, qf[s_], A, 0, 0, 0); }
#pragma unroll
                for (int j = 0; j < 16; ++j) { const int dd = (32 * nt + r) - (32 * mt + (j & 3) + 8 * (j >> 2) + 4 * hi); A[j] = dd >= 0 ? A[j] * __builtin_amdgcn_exp2f((float)dd * lg) : 0.f; }
#pragma unroll
                for (int s2 = 0; s2 < 2; ++s2) { u32x4 w; w.x = cvt_pk_bf16(A[8 * s2 + 0], A[8 * s2 + 1]); w.y = cvt_pk_bf16(A[8 * s2 + 2], A[8 * s2 + 3]); w.z = cvt_pk_bf16(A[8 * s2 + 4], A[8 * s2 + 5]); w.w = cvt_pk_bf16(A[8 * s2 + 6], A[8 * s2 + 7]);
                    const LAS unsigned char* vp = lds + OFF_V + vtr + (32 * mt + 16 * s2) * 64; const u32x2 lo = lds_tr(vp), hi2 = lds_tr(vp + 8 * 64);
                    IN_ = __builtin_amdgcn_mfma_f32_32x32x16_bf16(__builtin_bit_cast(bf16x8, (u32x4){lo.x, lo.y, hi2.x, hi2.y}), __builtin_bit_cast(bf16x8, w), IN_, 0, 0, 0); }
            } }
        if (mh == 1) {
#pragma unroll
            for (int j = 0; j < 16; ++j) ((LAS float*)(lds + OFF_PART))[(nt * 16 + j) * 64 + lane] = IN_[j];
        }
        __syncthreads();
        if (mh == 0) {
            const float xi = __builtin_amdgcn_exp2f((float)(32 * nt + r + 1) * lg);
            bf16* orow = outbase + (size_t)(tok0 + 32 * nt + r) * 1024 + h * 256 + sl * 32;
#pragma unroll
            for (int q4_ = 0; q4_ < 4; ++q4_) { float o_[4];
#pragma unroll
                for (int e = 0; e < 4; ++e) { const int j = 4 * q4_ + e; o_[e] = IN_[j] + ((const LAS float*)(lds + OFF_PART))[(nt * 16 + j) * 64 + lane] + xi * CR[j]; }
                opk[q4_] = (u32x2){cvt_pk_bf16(o_[0], o_[1]), cvt_pk_bf16(o_[2], o_[3])}; }
            oprev = orow;
        } else {
#pragma unroll
            for (int j = 0; j < 16; ++j) ST[j] *= gC;
#pragma unroll
            for (int s_ = 0; s_ < 8; ++s_) {
                const LAS unsigned char* zp = lds + OFF_ZV + ztr + (16 * s_) * 64; const u32x2 z0 = lds_tr(zp), z1 = lds_tr(zp + 4 * 64);
                const u32x2 k0 = lds_tr(lds + OFF_K + ktr[0] + 4096 * s_), k1 = lds_tr(lds + OFF_K + ktr[1] + 4096 * s_);
                ST = __builtin_amdgcn_mfma_f32_32x32x16_bf16(__builtin_bit_cast(bf16x8, (u32x4){z0.x, z0.y, z1.x, z1.y}), __builtin_bit_cast(bf16x8, (u32x4){k0.x, k0.y, k1.x, k1.y}), ST, 0, 0, 0); }
#pragma unroll
            for (int j = 0; j < 16; ++j) { const int dv = (j & 3) + 8 * (j >> 2) + 4 * hi; ((LAS unsigned short*)(lds + OFF_ST))[dv * (ROWB / 2) + 32 * nt + r] = (unsigned short)f2bf(ST[j]); }
        }
    }
    if (mh == 0) {
#pragma unroll
        for (int i = 0; i < 4; ++i) *(u32x2*)(oprev + 8 * i + 4 * hi) = opk[i]; }
    __syncthreads();
}
__device__ __forceinline__ void transpose_kv_tiles(Frame& F, const bf16* src, bf16* dst, int w0, int nw) {
    LAS unsigned short* tl_ = (LAS unsigned short*)(F.lds + F.wave * 16384); const int lane = F.lane;
    for (int tile = w0; tile < 16 * 64 * 2; tile += nw) {
        const int dh = tile & 1, st = (tile >> 1) & 63, bg = tile >> 7;
        const bf16* sp = src + ((size_t)bg * SEQ + st * 64) * 128 + dh * 64; bf16* dp = dst + ((size_t)bg * 128 + dh * 64) * SEQ + st * 64;
#pragma unroll
        for (int i = 0; i < 8; ++i) { const int row = i * 8 + (lane >> 3), c = lane & 7; const u32x4 v = *(const u32x4*)(sp + (size_t)row * 128 + c * 8); LAS unsigned short* q = tl_ + row * 66 + c * 8;
            q[0] = (unsigned short)(v.x & 0xffffu); q[1] = (unsigned short)(v.x >> 16); q[2] = (unsigned short)(v.y & 0xffffu); q[3] = (unsigned short)(v.y >> 16);
            q[4] = (unsigned short)(v.z & 0xffffu); q[5] = (unsigned short)(v.z >> 16); q[6] = (unsigned short)(v.w & 0xffffu); q[7] = (unsigned short)(v.w >> 16); }
        LDS_WAIT(); asm volatile("" ::: "memory");
#pragma unroll
        for (int i = 0; i < 8; ++i) { const int d = i * 8 + (lane >> 3), c = lane & 7; const LAS unsigned short* q = tl_ + (c * 8) * 66 + d;
            u32x4 o; o.x = (unsigned)q[0] | ((unsigned)q[66] << 16); o.y = (unsigned)q[2 * 66] | ((unsigned)q[3 * 66] << 16); o.z = (unsigned)q[4 * 66] | ((unsigned)q[5 * 66] << 16); o.w = (unsigned)q[6 * 66] | ((unsigned)q[7 * 66] << 16);
            *(u32x4*)(dp + (size_t)d * SEQ + c * 8) = o; }
        LDS_WAIT(); asm volatile("" ::: "memory");
    }
}
struct SchedCmp {
    unsigned char* ws; int first, G, c;
    __device__ __forceinline__ bool next(int i, GU& u) const {
        const int L = i * G + c - first; if (L < 0 || L >= 256) return false;
        const int ks = L & 7, mb = L >> 3, m = mb >> 4, bg = mb & 15;
        u.A = (const char*)ws + WS_KV6 + (size_t)m * KV_STRIDE + (size_t)bg * SEQ * 128 * 2 + (size_t)ks * 512 * 2; u.B = (const char*)ws + (m ? W_C1V : W_C1K) + (size_t)ks * 512 * 2;
        u.pm = mb; u.pn = 0; u.kind = ks; u.rows = nullptr; u.nvalid = 0; u.aux = 0; return true;
    }
};
struct EpiCmp {
    static constexpr bool PERM = false;
    float* hid;
    __device__ __forceinline__ void operator()(const f32x4 (&acc)[2][2][4][2], const GU& u, int wr, int wc, int fr, int fq) const {
#pragma unroll
        for (int ai = 0; ai < 2; ++ai)
#pragma unroll
            for (int m = 0; m < 4; ++m) { const int r = 128 * ai + 64 * wr + 16 * m + fr; float* rowp = hid + (size_t)u.kind * (32 * 256 * 128) + ((size_t)u.pm * 256 + r) * 128 + 32 * wc + 4 * fq;
#pragma unroll
                for (int n = 0; n < 2; ++n) *(f32x4*)(rowp + 16 * n) = acc[ai][0][m][n]; }
    }
};
__device__ __forceinline__ float gelu_tanh(float x) { const float u = 0.7978845608028654f * (x + 0.044715f * x * x * x); return 0.5f * x * (1.0f + tanhf(u)); }
__device__ __forceinline__ void p2b_compress_out(Frame& F, const Args& a) {
    const float* hid = (const float*)a.out + (size_t)16 * MiB; const float* cbias = (const float*)(F.ws + WS_SMALLW + 65536 + 2 * 128 * 128 * 2);
    const int gw = F.bx * NWAVES + F.wave, NGW = F.G * NWAVES;
    for (int row = gw; row < 2 * 16 * 256; row += NGW) {
        const int m = row >> 12, n = row & 255; const float* w2 = a.in[m ? IN_CMP_W2_V : IN_CMP_W2_K];
        bf16* dst = (bf16*)(F.ws + (m ? WS_VCMP : WS_KCMP)) + (size_t)(row & 4095) * 128;
        float o0 = 0.f, o1 = 0.f;
        if (n < 255) { const float* hr = hid + (size_t)row * 128;
            for (int e = 0; e < 128; ++e) { float hsum = 0.f;
#pragma unroll
                for (int ks = 0; ks < 8; ++ks) hsum += hr[(size_t)ks * (32 * 256 * 128) + e];
                const float g = gelu_tanh(hsum + cbias[m * 128 + e]); o0 += g * w2[e * 128 + F.lane]; o1 += g * w2[e * 128 + 64 + F.lane]; } }
        dst[F.lane] = (bf16)f2bf(o0); dst[64 + F.lane] = (bf16)f2bf(o1);
        if (m == 1) { bf16* dt = (bf16*)(F.ws + WS_VCMPT) + (size_t)((row >> 8) & 15) * 128 * 256 + n; dt[(size_t)F.lane * 256] = (bf16)f2bf(o0); dt[(size_t)(64 + F.lane) * 256] = (bf16)f2bf(o1); }
    }
}

__device__ __forceinline__ void p3_ret_normalize(Frame& F) {
    bf16* rv = (bf16*)(F.ws + WS_RV); const bf16* rg = (const bf16*)(F.ws + WS_RG);
    const int gw = F.bx * NWAVES + F.wave, NGW = F.G * NWAVES;
    for (int it = gw; it < NTOK * 4; it += NGW) {
        u32x2* p = (u32x2*)(rv + (size_t)it * 256) + F.lane; const u32x2 w = *p; const u32x2 gq = *((const u32x2*)(rg + (size_t)it * 256) + F.lane);
        const float o0 = lo16(w.x), o1 = hi16(w.x), o2 = lo16(w.y), o3 = hi16(w.y);
        const float ss = wave_sum((o0 * o0 + o1 * o1) + (o2 * o2 + o3 * o3));
        const float r = 1.0f / sqrtf(ss * (1.0f / 256.0f) + EPS);
        u32x2 q; q.x = pk2(o0 * r * lo16(gq.x), o1 * r * hi16(gq.x)); q.y = pk2(o2 * r * lo16(gq.y), o3 * r * hi16(gq.y)); *p = q;
    }
}
namespace nsaf {
constexpr int KROW = 272, VROW = 136, KT_BYTES = 64 * KROW, VT_BYTES = 128 * VROW;
constexpr int OFF_K = 0, OFF_V = KT_BYTES, BUF_BYTES = KT_BYTES + VT_BYTES, OFF_IMP = 2 * BUF_BYTES, OFF_MASK = OFF_IMP + 64 * 64 * 4;
constexpr float NEG = -1.0e30f, MASKED = -3.0e38f, CS = 0.08838834764831845f * 1.4426950408889634f;
struct Stage { u32x4 k0, k1, v0, v1; };
__device__ __forceinline__ void stage_load(Stage& st, const bf16* K, const bf16* VT, size_t vpitch, int key0, int tid) {
    const int r0 = tid >> 4, c0 = tid & 15;
    st.k0 = *(const u32x4*)(K + (size_t)(key0 + r0) * 128 + c0 * 8); st.k1 = *(const u32x4*)(K + (size_t)(key0 + r0 + 32) * 128 + c0 * 8);
    const int d0 = tid >> 3, c1 = tid & 7;
    st.v0 = *(const u32x4*)(VT + (size_t)d0 * vpitch + key0 + c1 * 8); st.v1 = *(const u32x4*)(VT + (size_t)(d0 + 64) * vpitch + key0 + c1 * 8);
}
__device__ __forceinline__ void stage_write(const Stage& st, LAS unsigned char* lds, int tid) {
    const int r0 = tid >> 4, c0 = tid & 15;
    *(LAS u32x4*)(lds + OFF_K + r0 * KROW + c0 * 16) = st.k0; *(LAS u32x4*)(lds + OFF_K + (r0 + 32) * KROW + c0 * 16) = st.k1;
    const int d0 = tid >> 3, c1 = tid & 7;
    LAS unsigned char* p0 = lds + OFF_V + d0 * VROW + c1 * 16; LAS unsigned char* p1 = lds + OFF_V + (d0 + 64) * VROW + c1 * 16;
    *(LAS u32x2*)p0 = (u32x2){st.v0.x, st.v0.y}; *(LAS u32x2*)(p0 + 8) = (u32x2){st.v0.z, st.v0.w};
    *(LAS u32x2*)p1 = (u32x2){st.v1.x, st.v1.y}; *(LAS u32x2*)(p1 + 8) = (u32x2){st.v1.z, st.v1.w};
}
template <int MODE>
__device__ __forceinline__ void block_step(const LAS unsigned char* lds, LAS unsigned char* ldstab, const bf16x8 (&qf)[8], f32x16 (&O)[4], float& m, float& l, int blk, int jfast, int tl_in, int itile, int nvr_in, bool rowsel, float inv_l, int lane_in) {
    int tl = tl_in, nvr = nvr_in, lane = lane_in; LAUNDER(tl); LAUNDER(nvr); LAUNDER(lane);
    const int r = lane & 31, hi = lane >> 5;
    f32x16 S[2];
#pragma unroll
    for (int kh = 0; kh < 2; ++kh) {
#pragma unroll
        for (int j = 0; j < 16; ++j) S[kh][j] = 0.f;
    }
    {
        const unsigned kaddr = (unsigned)(size_t)(lds + OFF_K + r * KROW + 16 * hi);
        u32x4 ka[4], kb[4];
#define NSAF_KRD(dst, t, s4) asm volatile("ds_read_b128 %0, %1 offset:%2" : "=v"(dst) : "v"(kaddr), "i"((t) * 32 * KROW + (s4) * 32))
#define NSAF_KRD4(set, t, s0) do { NSAF_KRD(set[0], t, (s0)); NSAF_KRD(set[1], t, (s0) + 1); NSAF_KRD(set[2], t, (s0) + 2); NSAF_KRD(set[3], t, (s0) + 3); } while (0)
#define NSAF_KWAIT(n, set) asm volatile("s_waitcnt lgkmcnt(" #n ")" : "+v"(set[0]), "+v"(set[1]), "+v"(set[2]), "+v"(set[3]))
#define NSAF_KMMA(set, t, s0) do { _Pragma("unroll") for (int q_ = 0; q_ < 4; ++q_) S[t] = __builtin_amdgcn_mfma_f32_32x32x16_bf16(__builtin_bit_cast(bf16x8, set[q_]), qf[(s0) + q_], S[t], 0, 0, 0); } while (0)
        NSAF_KRD4(ka, 0, 0); NSAF_KRD4(kb, 0, 4);
        NSAF_KWAIT(4, ka); NSAF_KMMA(ka, 0, 0); NSAF_KRD4(ka, 1, 0);
        NSAF_KWAIT(4, kb); NSAF_KMMA(kb, 0, 4); NSAF_KRD4(kb, 1, 4);
        NSAF_KWAIT(4, ka); NSAF_KMMA(ka, 1, 0);
        NSAF_KWAIT(0, kb); NSAF_KMMA(kb, 1, 4);
#undef NSAF_KRD
#undef NSAF_KRD4
#undef NSAF_KWAIT
#undef NSAF_KMMA
    }
    bool need_mask;
    if (MODE <= 1) need_mask = true; else if (MODE == 2) need_mask = (blk == itile); else need_mask = (blk == itile) || (blk == itile - 8);
    if (MODE >= 2 && !need_mask && blk >= jfast) {
        const float msub = (MODE == 2 && !rowsel) ? 3.0e38f : m;
        float rs = 0.f;
#pragma unroll
        for (int kh = 0; kh < 2; ++kh)
#pragma unroll
            for (int j = 0; j < 16; ++j) { const float p = __builtin_amdgcn_exp2f(S[kh][j] - msub); S[kh][j] = p; rs += p; }
        l += rs;
    } else {
    float mx = MASKED;
    if (need_mask) {
        int lo_ = -1, hi_ = 63;
        if (MODE <= 1) hi_ = nvr - 64 * blk - 1; else if (MODE == 2) hi_ = tl; else { hi_ = (blk == itile) ? tl : 63; lo_ = (blk == itile - 8) ? tl : -1; }
        lo_ -= 4 * hi; hi_ -= 4 * hi;
#pragma unroll
        for (int kh = 0; kh < 2; ++kh)
#pragma unroll
            for (int j = 0; j < 16; ++j) { const int kc_ = 32 * kh + (j & 3) + 8 * (j >> 2); const bool ok = (kc_ > lo_) & (kc_ <= hi_); const float v = ok ? S[kh][j] : MASKED; S[kh][j] = v; mx = fmaxf(mx, v); }
    } else {
#pragma unroll
        for (int kh = 0; kh < 2; ++kh)
#pragma unroll
            for (int j = 0; j < 16; ++j) mx = fmaxf(mx, S[kh][j]);
    }
    if (MODE == 2) mx = rowsel ? mx : MASKED;
    if (MODE == 1) {
        LAS float* imp = (LAS float*)(ldstab + OFF_IMP) + tl * 64;
#pragma unroll
        for (int kh = 0; kh < 2; ++kh)
#pragma unroll
            for (int j = 0; j < 16; ++j) { const int n = 64 * blk + 32 * kh + (j & 3) + 8 * (j >> 2) + 4 * hi; const float v = S[kh][j]; const float p = __builtin_amdgcn_exp2f(v - m) * inv_l; S[kh][j] = p;
                if (v > 0.5f * MASKED) { __hip_atomic_fetch_add(imp + (n >> 2), p, __ATOMIC_RELAXED, __HIP_MEMORY_SCOPE_WORKGROUP); if ((n & 3) == 3 && (n >> 2) + 1 < 64) __hip_atomic_fetch_add(imp + (n >> 2) + 1, p, __ATOMIC_RELAXED, __HIP_MEMORY_SCOPE_WORKGROUP); } }
    } else {
        mx = fmaxf(mx, __shfl_xor(mx, 32));
        if (__any(mx > m + 8.0f)) { const float mn = fmaxf(m, mx); const float alpha = __builtin_amdgcn_exp2f(m - mn); m = mn; l *= alpha;
            if (MODE != 0) {
#pragma unroll
                for (int dt = 0; dt < 4; ++dt)
#pragma unroll
                    for (int j = 0; j < 16; ++j) O[dt][j] *= alpha; } }
        float rs = 0.f;
        if (MODE == 2) {
#pragma unroll
            for (int kh = 0; kh < 2; ++kh)
#pragma unroll
                for (int j = 0; j < 16; ++j) { const float p = rowsel ? __builtin_amdgcn_exp2f(S[kh][j] - m) : 0.f; S[kh][j] = p; rs += p; }
        } else {
#pragma unroll
            for (int kh = 0; kh < 2; ++kh)
#pragma unroll
                for (int j = 0; j < 16; ++j) { const float p = __builtin_amdgcn_exp2f(S[kh][j] - m); S[kh][j] = p; rs += p; }
        }
        l += rs;
        if (MODE == 0) return;
    }
    }
    bf16x8 pf[2][2];
#pragma unroll
    for (int kh = 0; kh < 2; ++kh)
#pragma unroll
        for (int s2 = 0; s2 < 2; ++s2) { u32x4 w; w.x = cvt_pk_bf16(S[kh][8 * s2 + 0], S[kh][8 * s2 + 1]); w.y = cvt_pk_bf16(S[kh][8 * s2 + 2], S[kh][8 * s2 + 3]); w.z = cvt_pk_bf16(S[kh][8 * s2 + 4], S[kh][8 * s2 + 5]); w.w = cvt_pk_bf16(S[kh][8 * s2 + 6], S[kh][8 * s2 + 7]);
            pf[kh][s2] = __builtin_bit_cast(bf16x8, w); }
    {
        const unsigned vaddr = (unsigned)(size_t)(lds + OFF_V + r * VROW + 8 * hi);
        u32x2 va[8], vb[8];
#define NSAF_VRD(dst, dt, i) asm volatile("ds_read_b64 %0, %1 offset:%2" : "=v"(dst) : "v"(vaddr), "i"((dt) * 32 * VROW + ((i) >> 1) * 32 + ((i) & 1) * 16))
#define NSAF_VRD8(set, dt) do { NSAF_VRD(set[0], dt, 0); NSAF_VRD(set[1], dt, 1); NSAF_VRD(set[2], dt, 2); NSAF_VRD(set[3], dt, 3); NSAF_VRD(set[4], dt, 4); NSAF_VRD(set[5], dt, 5); NSAF_VRD(set[6], dt, 6); NSAF_VRD(set[7], dt, 7); } while (0)
#define NSAF_VWAIT(n, set) asm volatile("s_waitcnt lgkmcnt(" #n ")" : "+v"(set[0]), "+v"(set[1]), "+v"(set[2]), "+v"(set[3]), "+v"(set[4]), "+v"(set[5]), "+v"(set[6]), "+v"(set[7]))
#define NSAF_VMMA(set, dt) do { _Pragma("unroll") for (int ks = 0; ks < 4; ++ks) { const u32x4 a_ = (u32x4){set[2 * ks].x, set[2 * ks].y, set[2 * ks + 1].x, set[2 * ks + 1].y}; \
            O[dt] = __builtin_amdgcn_mfma_f32_32x32x16_bf16(__builtin_bit_cast(bf16x8, a_), pf[ks >> 1][ks & 1], O[dt], 0, 0, 0); } } while (0)
        NSAF_VRD8(va, 0); NSAF_VRD8(vb, 1);
        NSAF_VWAIT(8, va); NSAF_VMMA(va, 0); NSAF_VRD8(va, 2);
        NSAF_VWAIT(8, vb); NSAF_VMMA(vb, 1); NSAF_VRD8(vb, 3);
        NSAF_VWAIT(8, va); NSAF_VMMA(va, 2);
        NSAF_VWAIT(0, vb); NSAF_VMMA(vb, 3);
#undef NSAF_VRD
#undef NSAF_VRD8
#undef NSAF_VWAIT
#undef NSAF_VMMA
    }
}
template <int MODE>
__device__ __forceinline__ void run_pass(LAS unsigned char* lds, const bf16* K, const bf16* VT, size_t vpitch, int jb, int je, const bf16x8 (&qf)[8], f32x16 (&O)[4], float& m, float& l, bool allowfast, int tl, int itile, int nvr, unsigned long long selmask, float inv_l, int tid, int lane) {
    Stage st; stage_load(st, K, VT, vpitch, jb * 64, tid); stage_write(st, lds, tid);
    if (jb < je) stage_load(st, K, VT, vpitch, (jb + 1) * 64, tid);
    __syncthreads();
    for (int j = jb; j <= je; ++j) {
        const int cur = (j - jb) & 1;
        if (j < je) { stage_write(st, lds + (cur ^ 1) * BUF_BYTES, tid); if (j + 1 < je) stage_load(st, K, VT, vpitch, (j + 2) * 64, tid); }
        const bool rowsel = (MODE == 2) ? (((selmask >> j) & 1ull) != 0ull) : true;
        if (MODE != 2 || __ballot(rowsel) != 0ull) block_step<MODE>(lds + cur * BUF_BYTES, lds, qf, O, m, l, j, allowfast ? jb + (MODE == 2 ? 1 : 2) : 0x7fffffff, tl, itile, nvr, rowsel, inv_l, lane);
        __syncthreads();
    }
}
}
__device__ __forceinline__ void p3_nsa_fast(Frame& F, const bf16* svT, const bf16* wvT, bf16* outbase) {
    using namespace nsaf;
    unsigned char* ws = F.ws; const int tid = F.tid, lane = F.lane, wave = F.wave; LAS unsigned char* lds = F.lds;
    bf16* nq = (bf16*)(ws + WS_NQ); const float* gates = (const float*)(ws + WS_GATES);
    const int r = lane & 31, hi = lane >> 5, qrow = wave * 32 + r, tl = qrow >> 2, head = qrow & 3;
    unsigned failmask = 0u;
    for (int trip = 0; trip < 2; ++trip) {
    for (int u4 = 0; u4 < 4; ++u4) {
        if (trip == 1 && ((failmask >> u4) & 1u) == 0u) continue;
        const bool allowfast = trip == 0;
        const int pr = (F.bx & 7) * 32 + (F.bx >> 3) + (u4 >> 1) * 256; if (F.bx >= 256) break;
        const int bg = pr >> 5, ii = pr & 31, itile = (u4 & 1) ? (63 - ii) : ii, g = bg & 1, b = bg >> 1;
        const int tok = b * SEQ + itile * 64 + tl, t = itile * 64 + tl;
        const bf16* kc = (const bf16*)(ws + WS_KCMP) + (size_t)bg * 256 * 128; const bf16* vcT = (const bf16*)(ws + WS_VCMPT) + (size_t)bg * 128 * 256;
        const bf16* ks = (const bf16*)(ws + WS_KV6 + 2 * KV_STRIDE) + (size_t)bg * SEQ * 128; const bf16* kw = (const bf16*)(ws + WS_KV6 + 4 * KV_STRIDE) + (size_t)bg * SEQ * 128;
        const bf16* vsT = svT + (size_t)bg * 128 * SEQ; const bf16* vwT = wvT + (size_t)bg * 128 * SEQ;
        __syncthreads();
        for (int i = tid; i < 64 * 64; i += NTHREADS) ((LAS float*)(lds + OFF_IMP))[i] = 0.f;
        bf16x8 qf[8]; bf16* qrowp = nq + (size_t)tok * 1024 + g * 512 + head * 128; bf16* orowp = outbase + (size_t)tok * 1024 + g * 512 + head * 128;
#pragma unroll
        for (int s_ = 0; s_ < 8; ++s_) { const u32x4 w_ = *(const u32x4*)(qrowp + 16 * s_ + 8 * hi);
            u32x4 o_; o_.x = cvt_pk_bf16(lo16(w_.x) * CS, hi16(w_.x) * CS); o_.y = cvt_pk_bf16(lo16(w_.y) * CS, hi16(w_.y) * CS); o_.z = cvt_pk_bf16(lo16(w_.z) * CS, hi16(w_.z) * CS); o_.w = cvt_pk_bf16(lo16(w_.w) * CS, hi16(w_.w) * CS);
            qf[s_] = __builtin_bit_cast(bf16x8, o_); }
        const float* gatep = gates + (size_t)tok * 24 + (g * 4 + head) * 3;
        const int nvr = (t >= 31) ? (((t - 31) >> 4) + 1 > 255 ? 255 : ((t - 31) >> 4) + 1) : 0;
        const int jec = ((4 * itile + 2) >> 6) > 3 ? 3 : ((4 * itile + 2) >> 6);
        f32x16 O[4];
#define NSAF_ZERO_O() do { _Pragma("unroll") for (int dt = 0; dt < 4; ++dt) _Pragma("unroll") for (int j = 0; j < 16; ++j) O[dt][j] = 0.f; } while (0)
#define NSAF_ACCUM(coef, FIRST) do { const float cf_ = (coef); _Pragma("unroll") for (int dt = 0; dt < 4; ++dt) { _Pragma("unroll") for (int q4 = 0; q4 < 4; ++q4) { u32x2* p_ = (u32x2*)(orowp + 32 * dt + 8 * q4 + 4 * hi); \
            float a0_ = cf_ * O[dt][4 * q4], a1_ = cf_ * O[dt][4 * q4 + 1], a2_ = cf_ * O[dt][4 * q4 + 2], a3_ = cf_ * O[dt][4 * q4 + 3]; \
            if (!(FIRST)) { const u32x2 o_ = *p_; a0_ += lo16(o_.x); a1_ += hi16(o_.x); a2_ += lo16(o_.y); a3_ += hi16(o_.y); } \
            *p_ = (u32x2){cvt_pk_bf16(a0_, a1_), cvt_pk_bf16(a2_, a3_)}; } asm volatile("" ::: "memory"); } } while (0)
        float m = NEG, l = 0.f; NSAF_ZERO_O();
        run_pass<0>(lds, kc, vcT, 256, 0, jec, qf, O, m, l, false, tl, itile, nvr, 0ull, 0.f, tid, lane);
        l += __shfl_xor(l, 32); const float invl = l > 0.f ? 1.0f / l : 0.f;
        run_pass<1>(lds, kc, vcT, 256, 0, jec, qf, O, m, l, false, tl, itile, nvr, 0ull, invl, tid, lane);
        NSAF_ACCUM(gatep[0], true);
        __syncthreads();
        for (int tk = 0; tk < 8; ++tk) { const int tokl = wave * 8 + tk; float v = ((const LAS float*)(lds + OFF_IMP))[tokl * 64 + lane];
            const bool forced = (lane == 0) || (lane == itile) || (lane == itile - 1); v = (lane > itile) ? -1.0e4f : (forced ? 1.0e4f : v);
            int rank = 0;
#pragma unroll 16
            for (int i = 0; i < 64; ++i) { const float w = __builtin_bit_cast(float, __builtin_amdgcn_readlane(__builtin_bit_cast(int, v), i)); rank += (w > v || (w == v && i < lane)) ? 1 : 0; }
            const unsigned long long mk = __ballot(rank < 16);
            if (lane == 0) { ((LAS unsigned*)(lds + OFF_MASK))[tokl * 2] = (unsigned)mk; ((LAS unsigned*)(lds + OFF_MASK))[tokl * 2 + 1] = (unsigned)(mk >> 32); } }
        __syncthreads();
        const unsigned long long selmask = (unsigned long long)((const LAS unsigned*)(lds + OFF_MASK))[tl * 2] | ((unsigned long long)((const LAS unsigned*)(lds + OFF_MASK))[tl * 2 + 1] << 32);
        m = NEG; l = 0.f; NSAF_ZERO_O();
        run_pass<2>(lds, ks, vsT, SEQ, 0, itile, qf, O, m, l, allowfast, tl, itile, 0, selmask, 0.f, tid, lane);
        l += __shfl_xor(l, 32); bool bad = !(l < 1.0e12f);
        NSAF_ACCUM(l > 0.f ? gatep[1] / l : 0.f, false);
        m = NEG; l = 0.f; NSAF_ZERO_O();
        run_pass<3>(lds, kw, vwT, SEQ, itile > 8 ? itile - 8 : 0, itile, qf, O, m, l, allowfast, tl, itile, 0, 0ull, 0.f, tid, lane);
        l += __shfl_xor(l, 32); bad = bad | !(l < 1.0e12f);
        NSAF_ACCUM(l > 0.f ? gatep[2] / l : 0.f, false);
        if (allowfast && __syncthreads_or(bad ? 1 : 0)) failmask |= 1u << u4;
#undef NSAF_ZERO_O
#undef NSAF_ACCUM
    }
    if (failmask == 0u) break;
    }
    __syncthreads();
}
struct SchedP4 {
    unsigned char* ws; int G, c;
    __device__ __forceinline__ bool next(int i, GU& u) const {
        const int ti = i >> 2, sub = i & 3; const int L = ti * G + c; if (L >= 128 * 4) return false;
        int pm, pn; pg8::tile_map(L, 128, 4, pm, pn);
        const size_t ao = sub == 1 ? WS_RV : sub == 3 ? WS_NQ : WS_H; const size_t bo = sub == 0 ? W_GA : sub == 1 ? W_RO : sub == 2 ? W_GB : W_NO;
        u.A = (const char*)ws + ao + (size_t)pm * 256 * D * 2; u.B = (const char*)ws + bo + (size_t)pn * 256 * D * 2; u.pm = pm; u.pn = pn; u.kind = sub; u.rows = nullptr; u.nvalid = 0; u.aux = 0; return true;
    }
};
struct EpiP4 {
    static constexpr bool PERM = true;
    float* scr;
    bf16* Y;
    static __device__ __forceinline__ u32x2 pk4(const f32x4 v) { return (u32x2){cvt_pk_bf16(v[0], v[1]), cvt_pk_bf16(v[2], v[3])}; }
    static __device__ __forceinline__ f32x4 up4(const u32x2 w) { return (f32x4){lo16(w.x), hi16(w.x), lo16(w.y), hi16(w.y)}; }
    __device__ __forceinline__ void operator()(const f32x4 (&acc)[2][2][4][2], const GU& u, int wr, int wc, int fr, int fq) const {
        u32x2* p0 = (u32x2*)scr + threadIdx.x; u32x2* p1 = p0 + 32 * 512;
        if (u.kind == 0 || u.kind == 2) {
            u32x2* p = u.kind == 0 ? p0 : p1;
#pragma unroll
            for (int ai = 0; ai < 2; ++ai)
#pragma unroll
                for (int m = 0; m < 4; ++m) {
#pragma unroll
                    for (int bj = 0; bj < 2; ++bj) { f32x4 v0 = acc[ai][bj][m][0], v1 = acc[ai][bj][m][1];
#pragma unroll
                        for (int j = 0; j < 4; ++j) { v0[j] = sigmoidf_(v0[j]); v1[j] = sigmoidf_(v1[j]); }
                        p[(2 * bj) * 512] = pk4(v0); p[(2 * bj + 1) * 512] = pk4(v1); }
                    p += 4 * 512; LAUNDER(p); }
        } else if (u.kind == 1) {
#pragma unroll
            for (int ai = 0; ai < 2; ++ai)
#pragma unroll
                for (int m = 0; m < 4; ++m) {
#pragma unroll
                    for (int bj = 0; bj < 2; ++bj) { p0[(2 * bj) * 512] = pk4(up4(p0[(2 * bj) * 512]) * acc[ai][bj][m][0]); p0[(2 * bj + 1) * 512] = pk4(up4(p0[(2 * bj + 1) * 512]) * acc[ai][bj][m][1]); }
                    p0 += 4 * 512; LAUNDER(p0); }
        } else {
            bf16* yb = Y + (size_t)(u.pm * 256 + 64 * wr + fr) * D + u.pn * 256 + 32 * wc + 8 * fq;
#pragma unroll
            for (int ai = 0; ai < 2; ++ai)
#pragma unroll
                for (int m = 0; m < 4; ++m) {
#pragma unroll
                    for (int bj = 0; bj < 2; ++bj) {
                        const f32x4 v0 = up4(p0[(2 * bj) * 512]) + up4(p1[(2 * bj) * 512]) * acc[ai][bj][m][0], v1 = up4(p0[(2 * bj + 1) * 512]) + up4(p1[(2 * bj + 1) * 512]) * acc[ai][bj][m][1];
                        u32x4 w; w.x = cvt_pk_bf16(v0[0], v0[1]); w.y = cvt_pk_bf16(v0[2], v0[3]); w.z = cvt_pk_bf16(v1[0], v1[1]); w.w = cvt_pk_bf16(v1[2], v1[3]);
                        *(u32x4*)(yb + (size_t)(128 * ai + 16 * m) * D + 128 * bj) = w; }
                    p0 += 4 * 512; p1 += 4 * 512; LAUNDER(p0); LAUNDER(p1); }
        }
    }
};

struct SchedMN {
    unsigned char* ws; size_t ao, bo; int G, c;
    __device__ __forceinline__ bool next(int i, GU& u) const {
        const int L = i * G + c; if (L >= 128 * 4) return false; int pm, pn; pg8::tile_map(L, 128, 4, pm, pn);
        u.A = (const char*)ws + ao + (size_t)pm * 256 * D * 2; u.B = (const char*)ws + bo + (size_t)pn * 256 * D * 2; u.pm = pm; u.pn = pn; u.kind = 0; u.rows = nullptr; u.nvalid = 0; u.aux = 0; return true;
    }
};
template <bool SSQ> struct EpiRes {
    static constexpr bool PERM = false;
    const float* basef; const bf16* baseb; float* out; bf16* ob; float* ssq;
    __device__ __forceinline__ void operator()(const f32x4 (&acc)[2][2][4][2], const GU& u, int wr, int wc, int fr, int fq) const {
#pragma unroll
        for (int ai = 0; ai < 2; ++ai)
#pragma unroll
            for (int m = 0; m < 4; ++m) { const int r = u.pm * 256 + 128 * ai + 64 * wr + 16 * m + fr; const size_t off = (size_t)r * D + u.pn * 256 + 32 * wc + 4 * fq; float sq = 0.f;
#pragma unroll
                for (int bj = 0; bj < 2; ++bj)
#pragma unroll
                    for (int n = 0; n < 2; ++n) { const size_t o = off + 128 * bj + 16 * n; f32x4 bv;
                        if (SSQ) bv = *(const f32x4*)(basef + o); else { const u32x2 bw = *(const u32x2*)(baseb + o); bv = (f32x4){lo16(bw.x), hi16(bw.x), lo16(bw.y), hi16(bw.y)}; }
                        const f32x4 v = bv + acc[ai][bj][m][n];
                        if (!SSQ) *(f32x4*)(out + o) = v;
                        u32x2 w; w.x = cvt_pk_bf16(v[0], v[1]); w.y = cvt_pk_bf16(v[2], v[3]); *(u32x2*)(ob + o) = w; sq += (v[0] * v[0] + v[1] * v[1]) + (v[2] * v[2] + v[3] * v[3]); }
                if (SSQ) { sq += __shfl_xor(sq, 16); sq += __shfl_xor(sq, 32); if (fq == 0) ssq[(size_t)r * 16 + u.pn * 4 + wc] = sq; }
            }
    }
};
struct EpiQ {
    static constexpr bool PERM = true;
    const float* ssq; bf16* Q;
    __device__ __forceinline__ void operator()(const f32x4 (&acc)[2][2][4][2], const GU& u, int wr, int wc, int fr, int fq) const {
#pragma unroll
        for (int ai = 0; ai < 2; ++ai)
#pragma unroll
            for (int m = 0; m < 4; ++m) { const int r = u.pm * 256 + 128 * ai + 64 * wr + 16 * m + fr; const f32x4* sp = (const f32x4*)(ssq + (size_t)r * 16);
                const f32x4 a = sp[0], b = sp[1], c = sp[2], d = sp[3]; const float tot = ((a[0] + a[1]) + (a[2] + a[3])) + ((b[0] + b[1]) + (b[2] + b[3])) + ((c[0] + c[1]) + (c[2] + c[3])) + ((d[0] + d[1]) + (d[2] + d[3]));
                const float rstd = 1.0f / sqrtf(tot * (1.0f / D) + EPS);
#pragma unroll
                for (int bj = 0; bj < 2; ++bj) { const f32x4 v0 = acc[ai][bj][m][0] * rstd, v1 = acc[ai][bj][m][1] * rstd;
                    u32x4 w; w.x = cvt_pk_bf16(v0[0], v0[1]); w.y = cvt_pk_bf16(v0[2], v0[3]); w.z = cvt_pk_bf16(v1[0], v1[1]); w.w = cvt_pk_bf16(v1[2], v1[3]);
                    *(u32x4*)(Q + (size_t)r * D + u.pn * 256 + 128 * bj + 32 * wc + 8 * fq) = w; } }
    }
};

namespace xatf {
constexpr int KROW = 528, VROW = 136, KT_BYTES = 64 * KROW, OFF_K = 0, OFF_V = KT_BYTES;
constexpr float NEG = -1.0e30f, CS = 0.0625f * 1.4426950408889634f;
struct Stage { u32x4 k[4]; u32x4 v[2]; };
__device__ __forceinline__ void stage_load(Stage& st, const bf16* K, const bf16* VT, int key0, int tid) {
#pragma unroll
    for (int i = 0; i < 4; ++i) { const int p = tid + 512 * i, row = p >> 5, c = p & 31; st.k[i] = *(const u32x4*)(K + (size_t)(key0 + row) * 2048 + c * 8); }
#pragma unroll
    for (int i = 0; i < 2; ++i) { const int p = tid + 512 * i, d = p >> 3, c = p & 7; st.v[i] = *(const u32x4*)(VT + (size_t)d * 256 + key0 + c * 8); }
}
__device__ __forceinline__ void stage_write(const Stage& st, LAS unsigned char* lds, int tid) {
#pragma unroll
    for (int i = 0; i < 4; ++i) { const int p = tid + 512 * i, row = p >> 5, c = p & 31; *(LAS u32x4*)(lds + OFF_K + row * KROW + c * 16) = st.k[i]; }
#pragma unroll
    for (int i = 0; i < 2; ++i) { const int p = tid + 512 * i, d = p >> 3, c = p & 7; LAS unsigned char* q = lds + OFF_V + d * VROW + c * 16;
        *(LAS u32x2*)q = (u32x2){st.v[i].x, st.v[i].y}; *(LAS u32x2*)(q + 8) = (u32x2){st.v[i].z, st.v[i].w}; }
}
__device__ __forceinline__ void block_step(const LAS unsigned char* lds, const bf16x8 (&qf)[16], f32x16 (&O)[4], float& m, float& l, int lane) {
    const int r = lane & 31, hi = lane >> 5;
    f32x16 S[2];
#pragma unroll
    for (int kh = 0; kh < 2; ++kh) {
#pragma unroll
        for (int j = 0; j < 16; ++j) S[kh][j] = 0.f;
#pragma unroll
        for (int s_ = 0; s_ < 16; ++s_) { const bf16x8 a = *(const LAS bf16x8*)(lds + OFF_K + (kh * 32 + r) * KROW + (16 * s_ + 8 * hi) * 2); S[kh] = __builtin_amdgcn_mfma_f32_32x32x16_bf16(a, qf[s_], S[kh], 0, 0, 0); }
    }
    float mx = NEG;
#pragma unroll
    for (int kh = 0; kh < 2; ++kh)
#pragma unroll
        for (int j = 0; j < 16; ++j) { const float v = S[kh][j] * CS; S[kh][j] = v; mx = fmaxf(mx, v); }
    mx = fmaxf(mx, __shfl_xor(mx, 32));
    const float mn = fmaxf(m, mx); const float alpha = __builtin_amdgcn_exp2f(m - mn); m = mn; float rs = 0.f;
#pragma unroll
    for (int kh = 0; kh < 2; ++kh)
#pragma unroll
        for (int j = 0; j < 16; ++j) { const float p = __builtin_amdgcn_exp2f(S[kh][j] - mn); S[kh][j] = p; rs += p; }
    l = l * alpha + rs;
#pragma unroll
    for (int dt = 0; dt < 4; ++dt)
#pragma unroll
        for (int j = 0; j < 16; ++j) O[dt][j] *= alpha;
    bf16x8 pf[2][2];
#pragma unroll
    for (int kh = 0; kh < 2; ++kh)
#pragma unroll
        for (int s2 = 0; s2 < 2; ++s2) { u32x4 w; w.x = cvt_pk_bf16(S[kh][8 * s2 + 0], S[kh][8 * s2 + 1]); w.y = cvt_pk_bf16(S[kh][8 * s2 + 2], S[kh][8 * s2 + 3]); w.z = cvt_pk_bf16(S[kh][8 * s2 + 4], S[kh][8 * s2 + 5]); w.w = cvt_pk_bf16(S[kh][8 * s2 + 6], S[kh][8 * s2 + 7]);
            pf[kh][s2] = __builtin_bit_cast(bf16x8, w); }
#pragma unroll
    for (int dt = 0; dt < 4; ++dt)
#pragma unroll
        for (int kh = 0; kh < 2; ++kh)
#pragma unroll
            for (int s2 = 0; s2 < 2; ++s2) { const LAS unsigned char* vp = lds + OFF_V + (dt * 32 + r) * VROW + (32 * kh + 16 * s2 + 4 * hi) * 2;
                const u32x2 lo = *(const LAS u32x2*)vp, hi2 = *(const LAS u32x2*)(vp + 16); const u32x4 av = (u32x4){lo.x, lo.y, hi2.x, hi2.y};
                O[dt] = __builtin_amdgcn_mfma_f32_32x32x16_bf16(__builtin_bit_cast(bf16x8, av), pf[kh][s2], O[dt], 0, 0, 0); }
}
}
__device__ __forceinline__ void p7_xattn_fast(Frame& F, const bf16* vT, bf16* outbase) {
    using namespace xatf;
    bf16* Q = (bf16*)(F.ws + WS_NQ); const bf16* KV = (const bf16*)(F.ws + WS_MEMKV);
    const int tid = F.tid, lane = F.lane, wave = F.wave, r = lane & 31, hi = lane >> 5; LAS unsigned char* lds = F.lds;
    for (int u = F.bx; u < BATCH * 4 * 16; u += F.G) {
        const int tt = u & 15, bh = u >> 4, b = bh >> 2, h = bh & 3; const int tok = b * SEQ + tt * 256 + wave * 32 + r;
        bf16* qrow = Q + (size_t)tok * D + h * 256; bf16* orow = outbase + (size_t)tok * D + h * 256; const bf16* Kb = KV + (size_t)(b * NMEM) * 2048 + h * 256;
        bf16x8 qf[16];
#pragma unroll
        for (int s_ = 0; s_ < 16; ++s_) qf[s_] = *(const bf16x8*)(qrow + 16 * s_ + 8 * hi);
#pragma unroll
        for (int half = 0; half < 2; ++half) {
            const bf16* VTb = vT + ((size_t)bh * 256 + half * 128) * 256;
            f32x16 O[4]; float m = NEG, l = 0.f;
#pragma unroll
            for (int dt = 0; dt < 4; ++dt)
#pragma unroll
                for (int j = 0; j < 16; ++j) O[dt][j] = 0.f;
            for (int j = 0; j < 4; ++j) {
                __syncthreads(); { Stage st; stage_load(st, Kb, VTb, j * 64, tid); stage_write(st, lds, tid); } __syncthreads();
                block_step(lds, qf, O, m, l, lane);
            }
            l += __shfl_xor(l, 32); const float inv = 1.0f / l;
#pragma unroll
            for (int dt = 0; dt < 4; ++dt)
#pragma unroll
                for (int q4 = 0; q4 < 4; ++q4) *(u32x2*)(orow + half * 128 + 32 * dt + 8 * q4 + 4 * hi) = (u32x2){cvt_pk_bf16(O[dt][4 * q4] * inv, O[dt][4 * q4 + 1] * inv), cvt_pk_bf16(O[dt][4 * q4 + 2] * inv, O[dt][4 * q4 + 3] * inv)};
        }
    }
    __syncthreads();
}
__device__ __forceinline__ void transpose_memv_tiles(Frame& F, bf16* vT, int w0, int nw) {
    LAS unsigned short* tl_ = (LAS unsigned short*)(F.lds + F.wave * 16384); const int lane = F.lane; const bf16* KV = (const bf16*)(F.ws + WS_MEMKV);
    for (int tile = w0; tile < 32 * 16; tile += nw) {
        const int dq = tile & 3, kq = (tile >> 2) & 3, bh = tile >> 4, b = bh >> 2, h = bh & 3;
        const bf16* sp = KV + (size_t)(b * NMEM + kq * 64) * 2048 + 1024 + h * 256 + dq * 64; bf16* dp = vT + ((size_t)bh * 256 + dq * 64) * 256 + kq * 64;
#pragma unroll
        for (int i = 0; i < 8; ++i) { const int row = i * 8 + (lane >> 3), c = lane & 7; const u32x4 v = *(const u32x4*)(sp + (size_t)row * 2048 + c * 8); LAS unsigned short* q = tl_ + row * 66 + c * 8;
            q[0] = (unsigned short)(v.x & 0xffffu); q[1] = (unsigned short)(v.x >> 16); q[2] = (unsigned short)(v.y & 0xffffu); q[3] = (unsigned short)(v.y >> 16);
            q[4] = (unsigned short)(v.z & 0xffffu); q[5] = (unsigned short)(v.z >> 16); q[6] = (unsigned short)(v.w & 0xffffu); q[7] = (unsigned short)(v.w >> 16); }
        LDS_WAIT(); asm volatile("" ::: "memory");
#pragma unroll
        for (int i = 0; i < 8; ++i) { const int d = i * 8 + (lane >> 3), c = lane & 7; const LAS unsigned short* q = tl_ + (c * 8) * 66 + d;
            u32x4 o; o.x = (unsigned)q[0] | ((unsigned)q[66] << 16); o.y = (unsigned)q[2 * 66] | ((unsigned)q[3 * 66] << 16); o.z = (unsigned)q[4 * 66] | ((unsigned)q[5 * 66] << 16); o.w = (unsigned)q[6 * 66] | ((unsigned)q[7 * 66] << 16);
            *(u32x4*)(dp + (size_t)d * 256 + c * 8) = o; }
        LDS_WAIT(); asm volatile("" ::: "memory");
    }
}

__device__ __forceinline__ void p9_route(Frame& F, const Args& a) {
    unsigned char* ws = F.ws; const float* X2 = a.out;
    const float* gff = a.in[IN_NORM_FFN_G]; const float* wgrp = a.in[IN_W_GRP]; const float* bgrp = a.in[IN_B_GRP]; const float* wrt = a.in[IN_W_RT]; const float* brt = a.in[IN_B_RT];
    float* wts = (float*)(ws + WS_ROUTE); float* rstd2 = wts + 2 * NTOK; int* lists = (int*)(ws + WS_LISTS);
    const int gw = F.bx * NWAVES + F.wave, NGW = F.G * NWAVES, lane = F.lane;
    f32x4 vnext[4];
    if (gw < NTOK) {
#pragma unroll
        for (int j = 0; j < 4; ++j) vnext[j] = ((const f32x4*)(X2 + (size_t)gw * D) + lane)[64 * j]; }
    int my_ea = -1, my_eb = -1, my_tok = -1, it_ = 0; float my_w1 = 0.f, my_w2 = 0.f, my_rstd = 0.f;
    for (int tok = gw; tok < NTOK; tok += NGW, ++it_) {
        const f32x4* gr = (const f32x4*)gff + lane;
        f32x4 v[4]; float s = 0.f;
#pragma unroll
        for (int j = 0; j < 4; ++j) { v[j] = vnext[j]; s += (v[j].x * v[j].x + v[j].y * v[j].y) + (v[j].z * v[j].z + v[j].w * v[j].w); }
        if (tok + NGW < NTOK) {
#pragma unroll
            for (int j = 0; j < 4; ++j) vnext[j] = ((const f32x4*)(X2 + (size_t)(tok + NGW) * D) + lane)[64 * j]; }
        const float rstd = 1.0f / sqrtf(wave_sum(s) * (1.f / D) + EPS);
        float lg[4] = {0.f, 0.f, 0.f, 0.f};
        const float* pwg = wgrp + (size_t)(4 * lane) * 4;
#pragma unroll
        for (int j = 0; j < 4; ++j) { const f32x4 gg = gr[64 * j];
#pragma unroll
            for (int c = 0; c < 4; ++c) { const float hf = v[j][c] * rstd * gg[c]; v[j][c] = hf; const f32x4 wg = *(const f32x4*)(pwg + c * 4);
#pragma unroll
                for (int i = 0; i < 4; ++i) lg[i] += hf * wg[i]; }
            pwg += 256 * 4; LAUNDER(pwg); }
#pragma unroll
        for (int i = 0; i < 4; ++i) lg[i] = wave_sum(lg[i]) + bgrp[i];
        int grp = 0; float gm = lg[0];
#pragma unroll
        for (int i = 1; i < 4; ++i) if (lg[i] > gm) { gm = lg[i]; grp = i; }
        grp = __builtin_amdgcn_readfirstlane(grp);
        float gs = 0.f;
#pragma unroll
        for (int i = 0; i < 4; ++i) gs += expf(lg[i] - gm);
        const float g_gate = 1.0f / gs;
        float lq[8];
#pragma unroll
        for (int i = 0; i < 8; ++i) lq[i] = 0.f;
        const float* pwr = wrt + (size_t)(4 * lane) * 32 + grp * 8;
#pragma unroll
        for (int j = 0; j < 4; ++j) {
#pragma unroll
            for (int c = 0; c < 4; ++c) { const float hf = v[j][c]; const f32x4 wa = *(const f32x4*)(pwr + c * 32), wb = *(const f32x4*)(pwr + c * 32 + 4);
#pragma unroll
                for (int i = 0; i < 4; ++i) { lq[i] += hf * wa[i]; lq[4 + i] += hf * wb[i]; } }
            pwr += 256 * 32; LAUNDER(pwr); }
#pragma unroll
        for (int i = 0; i < 8; ++i) lq[i] = wave_sum(lq[i]) + brt[grp * 8 + i];
        int i1 = 0; float m1 = lq[0];
#pragma unroll
        for (int i = 1; i < 8; ++i) if (lq[i] > m1) { m1 = lq[i]; i1 = i; }
        int i2 = -1; float m2 = -3.0e38f;
#pragma unroll
        for (int i = 0; i < 8; ++i) if (i != i1 && lq[i] > m2) { m2 = lq[i]; i2 = i; }
        const float e2 = expf(m2 - m1), den = 1.0f + e2; const float w1 = g_gate / den, w2 = g_gate * e2 / den;
        if (lane == it_) { my_ea = grp * 8 + i1; my_eb = grp * 8 + i2; my_tok = tok; my_w1 = w1; my_w2 = w2; my_rstd = rstd; }
    }
    if (my_tok >= 0) {
        const unsigned sa = __hip_atomic_fetch_add(F.ctl + CW_ECNT + 64 * my_ea, 1u, __ATOMIC_RELAXED, __HIP_MEMORY_SCOPE_AGENT);
        const unsigned sb = __hip_atomic_fetch_add(F.ctl + CW_ECNT + 64 * my_eb, 1u, __ATOMIC_RELAXED, __HIP_MEMORY_SCOPE_AGENT);
        lists[(size_t)my_ea * NTOK + sa] = my_tok * 2; lists[(size_t)my_eb * NTOK + sb] = my_tok * 2 + 1;
        wts[my_tok * 2] = my_w1; wts[my_tok * 2 + 1] = my_w2; rstd2[my_tok] = my_rstd;
    }
}
__device__ __forceinline__ void moe_tiles(Frame& F) {
    __syncthreads();
    if (F.tid == 0) { unsigned accu = 0u; for (int e = 0; e < NEXP; ++e) { const unsigned c = __hip_atomic_load(F.ctl + CW_ECNT + 64 * e, __ATOMIC_RELAXED, __HIP_MEMORY_SCOPE_AGENT); F.MISC[16 + e] = accu; F.MISC[64 + e] = c; accu += (c + 255u) >> 8; } F.MISC[16 + NEXP] = accu; }
    __syncthreads();
}
template <int WHICH> struct SchedMoe {
    volatile LAS unsigned* MISC; unsigned char* ws; int G, c;
    __device__ __forceinline__ bool next(int i, GU& u) const {
        const int L = i * G + c; const int T = (int)MISC[16 + NEXP]; if (L >= 4 * T) return false;
        const int tau = L >> 2, pn = L & 3; int e = 0;
        for (int k = 1; k < NEXP; ++k) if ((int)MISC[16 + k] <= tau) e = k;
        const int lt = tau - (int)MISC[16 + e]; const int cnt = (int)MISC[64 + e]; int nv = cnt - lt * 256; nv = nv > 256 ? 256 : nv;
        u.rows = (const int*)(ws + WS_LISTS) + (size_t)e * NTOK + lt * 256; u.nvalid = nv; u.pm = tau; u.pn = pn; u.kind = 0; u.aux = e;
        if (WHICH == 0) { u.A = (const char*)ws + WS_X2B; u.B = (const char*)ws + WS_W13 + (size_t)e * D * D * 2 + (size_t)pn * 256 * D * 2; }
        else { u.A = (const char*)ws + WS_H1 + (size_t)tau * 256 * DEXP * 2; u.B = (const char*)ws + WS_W2 + (size_t)e * D * DEXP * 2 + (size_t)pn * 256 * DEXP * 2; }
        return true;
    }
};
struct EpiMoe1 {
    static constexpr bool PERM = true;
    const float* rstd2; bf16* H1;
    __device__ __forceinline__ void operator()(const f32x4 (&acc)[2][2][4][2], const GU& u, int wr, int wc, int fr, int fq) const {
        char* hb = (char*)H1 + (size_t)u.pm * 256 * DEXP * 2;
        const int j00 = (u.pn * 256 + 32 * wc + 8 * fq) >> 1;
#pragma unroll
        for (int ai = 0; ai < 2; ++ai) {
            int r = 128 * ai + 64 * wr + fr; LAUNDER(r);
#pragma unroll
            for (int m = 0; m < 4; ++m) { const bool ok = r < u.nvalid; const float rs = ok ? rstd2[u.rows[r] >> 1] : 0.f;
#pragma unroll
                for (int bj = 0; bj < 2; ++bj) { const f32x4 a1 = acc[ai][bj][m][0] * rs, a3 = acc[ai][bj][m][1] * rs; f32x4 hv;
#pragma unroll
                    for (int j = 0; j < 4; ++j) hv[j] = a1[j] * sigmoidf_(a1[j]) * a3[j];
                    u32x2 w; w.x = cvt_pk_bf16(hv[0], hv[1]); w.y = cvt_pk_bf16(hv[2], hv[3]); *(u32x2*)(hb + (unsigned)((r * DEXP + j00 + 64 * bj) * 2)) = w; }
                r += 16; LAUNDER(r); }
        }
    }
};
struct EpiMoe2 {
    static constexpr bool PERM = true;
    const float* wts; bf16* Y0; bf16* Y1;
    __device__ __forceinline__ void operator()(const f32x4 (&acc)[2][2][4][2], const GU& u, int wr, int wc, int fr, int fq) const {
#pragma unroll
        for (int ai = 0; ai < 2; ++ai)
#pragma unroll
            for (int m = 0; m < 4; ++m) { const int r = 128 * ai + 64 * wr + 16 * m + fr;
                if (r < u.nvalid) { const int ent = u.rows[r]; const float w8 = wts[ent]; bf16* dst = ((ent & 1) ? Y1 : Y0) + (size_t)(ent >> 1) * D + u.pn * 256 + 32 * wc + 8 * fq;
#pragma unroll
                    for (int bj = 0; bj < 2; ++bj) { const f32x4 v0 = acc[ai][bj][m][0] * w8, v1 = acc[ai][bj][m][1] * w8;
                        u32x4 w; w.x = cvt_pk_bf16(v0[0], v0[1]); w.y = cvt_pk_bf16(v0[2], v0[3]); w.z = cvt_pk_bf16(v1[0], v1[1]); w.w = cvt_pk_bf16(v1[2], v1[3]);
                        *(u32x4*)(dst + 128 * bj) = w; } } }
    }
};

__device__ __forceinline__ void p12_final(Frame& F, const Args& a) {
    const bf16* Y0 = (const bf16*)(F.ws + WS_YS0); const bf16* Y1 = (const bf16*)(F.ws + WS_YS1); const bf16* X2 = (const bf16*)(F.ws + WS_X2B); const float* g = a.in[IN_NORM_F_G];
    const int gw = F.bx * NWAVES + F.wave, NGW = F.G * NWAVES, lane = F.lane;
    for (int tok = gw; tok < NTOK; tok += NGW) {
        f32x4* xr = (f32x4*)(a.out + (size_t)tok * D) + lane; const u32x2* x2 = (const u32x2*)(X2 + (size_t)tok * D) + lane; const u32x2* y0 = (const u32x2*)(Y0 + (size_t)tok * D) + lane; const u32x2* y1 = (const u32x2*)(Y1 + (size_t)tok * D) + lane;
        f32x4 v[4]; float s = 0.f;
#pragma unroll
        for (int j = 0; j < 4; ++j) { const u32x2 xx = x2[64 * j], p = y0[64 * j], q = y1[64 * j];
            v[j].x = lo16(xx.x) + (lo16(p.x) + lo16(q.x)); v[j].y = hi16(xx.x) + (hi16(p.x) + hi16(q.x)); v[j].z = lo16(xx.y) + (lo16(p.y) + lo16(q.y)); v[j].w = hi16(xx.y) + (hi16(p.y) + hi16(q.y));
            s += (v[j].x * v[j].x + v[j].y * v[j].y) + (v[j].z * v[j].z + v[j].w * v[j].w); }
        const float rstd = 1.0f / sqrtf(wave_sum(s) * (1.f / D) + EPS);
#pragma unroll
        for (int j = 0; j < 4; ++j) { const f32x4 gg = ((const f32x4*)g + lane)[64 * j]; xr[64 * j] = v[j] * rstd * gg; }
    }
}

constexpr int N_PHASES = 14;
__global__ void __launch_bounds__(NTHREADS, 2) fwd(Args args) {
    extern __shared__ __attribute__((aligned(16))) unsigned char lds[];
    Frame F;
    F.lds = (LAS unsigned char*)lds; F.MISC = (volatile LAS unsigned*)(F.lds + MISC_OFF);
    F.tid = threadIdx.x; F.lane = F.tid & 63; F.wave = __builtin_amdgcn_readfirstlane(F.tid >> 6); F.G = gridDim.x; F.bx = blockIdx.x;
    F.ws = args.ws; F.ctl = (unsigned*)(args.ws + WS_CTL);
    unsigned char* ws = args.ws;
    for (int u = F.tid; u < (LDS_BYTES - RING_BYTES) / 4; u += NTHREADS) ((LAS unsigned*)(F.lds + RING_BYTES))[u] = 0u;
    __syncthreads();
    const int lo = args.ph_lo, hi = args.ph_hi;
    const bool one = (hi - lo) > 1;
    XcdBarrier bar; bar.bar = F.ctl + CW_BAR; bar.x = 0; bar.st = F.MISC + 8;
    if (one) bar = xcd_barrier_post(F.ctl + CW_BAR, F.MISC + 8);
#define IN(k) (lo <= (k) && (k) < hi && phase_begin(F))
#define SEAM(k) do { if (lo <= (k) && (k) + 1 < hi) xcd_barrier(bar); } while (0)

    if (IN(0)) { p0_prologue(F, args); } SEAM(0);
    if (IN(1)) {
        SchedP1 S{ws, F.G, F.bx};
        EpiP1 E{ws};
        pg8::gemm_phase<EpiP1, SchedP1, false>(F.lds, D, D, D, S, E);
        p1_gate_logits(F);
    } SEAM(1);
    if (IN(2)) {
        p2_retention_fast(F, F.bx, (bf16*)(ws + WS_RV));
        { const int w0 = F.bx * NWAVES + F.wave, nw = F.G * NWAVES;
            transpose_kv_tiles(F, (const bf16*)(ws + WS_KV6 + 3 * KV_STRIDE), (bf16*)args.out, w0, nw);
            transpose_kv_tiles(F, (const bf16*)(ws + WS_KV6 + 5 * KV_STRIDE), (bf16*)((unsigned char*)args.out + KV_STRIDE), w0, nw);
            transpose_memv_tiles(F, (bf16*)(ws + WS_MEMVT), w0, nw); }
        __syncthreads();
        { SchedCmp S{ws, 0, F.G, F.bx}; EpiCmp E{(float*)args.out + (size_t)16 * MiB};
            pg8::gemm_phase<EpiCmp, SchedCmp, false>(F.lds, 512, 2048, 4096, S, E); }
    } SEAM(2);
    if (IN(3)) { p2b_compress_out(F, args); } SEAM(3);
    if (IN(4)) { p3_ret_normalize(F); p3_nsa_fast(F, (const bf16*)args.out, (const bf16*)((const unsigned char*)args.out + KV_STRIDE), (bf16*)(ws + WS_NQ)); } SEAM(4);
    if (IN(5)) {
        SchedP4 S{ws, F.G, F.bx};
        EpiP4 E{(float*)(ws + WS_P4SCR) + (size_t)F.bx * (2 * 32 * 512 * 4), (bf16*)(ws + WS_Y)};
        pg8::gemm_phase<EpiP4, SchedP4, false>(F.lds, D, D, D, S, E);
    } SEAM(5);
    if (IN(6)) {
        SchedMN S{ws, WS_Y, W_OUT, F.G, F.bx}; EpiRes<true> E{args.in[IN_X], nullptr, nullptr, (bf16*)(ws + WS_X1B), (float*)(ws + WS_SSQ)};
        pg8::gemm_phase<EpiRes<true>, SchedMN, false>(F.lds, D, D, D, S, E);
    } SEAM(6);
    if (IN(7)) {
        const bool early = ((F.bx >> 3) & 1) == 0;
        if (early) expert_copies(F, args, 0, NEXP / 2);
        SchedMN S{ws, WS_X1B, W_XQ, F.G, F.bx}; EpiQ E{(const float*)(ws + WS_SSQ), (bf16*)(ws + WS_NQ)};
        pg8::gemm_phase<EpiQ, SchedMN, false>(F.lds, D, D, D, S, E);
        if (!early) { __syncthreads(); expert_copies(F, args, 0, NEXP / 2); }
    } SEAM(7);
    if (IN(8)) { p7_xattn_fast(F, (const bf16*)(ws + WS_MEMVT), (bf16*)(ws + WS_NQ)); } SEAM(8);
    if (IN(9)) {
        const bool early = ((F.bx >> 3) & 1) == 0;
        if (early) expert_copies(F, args, NEXP / 2, NEXP);
        SchedMN S{ws, WS_NQ, W_XO, F.G, F.bx}; EpiRes<false> E{nullptr, (const bf16*)(ws + WS_X1B), args.out, (bf16*)(ws + WS_X2B), nullptr};
        pg8::gemm_phase<EpiRes<false>, SchedMN, false>(F.lds, D, D, D, S, E);
        if (!early) { __syncthreads(); expert_copies(F, args, NEXP / 2, NEXP); }
    } SEAM(9);
    if (IN(10)) { p9_route(F, args); } SEAM(10);
    if (IN(11)) {
        moe_tiles(F);
        SchedMoe<0> S{F.MISC, ws, F.G, F.bx}; EpiMoe1 E{(const float*)(ws + WS_ROUTE) + 2 * NTOK, (bf16*)(ws + WS_H1)};
        pg8::gemm_phase<EpiMoe1, SchedMoe<0>, true>(F.lds, D, D, D, S, E);
    } SEAM(11);
    if (IN(12)) {
        moe_tiles(F);
        SchedMoe<1> S{F.MISC, ws, F.G, F.bx}; EpiMoe2 E{(const float*)(ws + WS_ROUTE), (bf16*)(ws + WS_YS0), (bf16*)(ws + WS_YS1)};
        pg8::gemm_phase<EpiMoe2, SchedMoe<1>, false>(F.lds, DEXP, DEXP, DEXP, S, E);
    } SEAM(12);
    if (IN(13)) { p12_final(F, args); }
#undef IN
#undef SEAM
}

extern "C" void kernel_launch(void* const* d_in, const int* in_sizes, int n_in, void* d_out, int out_size, void* d_ws, size_t ws_size, hipStream_t stream) {
    static int grid = 0;
    if (grid == 0) {
        if (n_in != 27 || in_sizes[0] != NTOK * D || out_size != NTOK * D || ws_size < WS_END) {
            fprintf(stderr, "kernel_launch: unexpected shapes: n_in %d in0 %d out %d ws %zu (need %zu)\n", n_in, n_in > 0 ? in_sizes[0] : -1, out_size, ws_size, (size_t)WS_END); grid = -1; return; }
        int dev = 0, cus = 0, per_cu = 0;
        if (hipGetDevice(&dev) != hipSuccess || hipDeviceGetAttribute(&cus, hipDeviceAttributeMultiprocessorCount, dev) != hipSuccess) { grid = -1; return; }
        if (hipFuncSetAttribute((const void*)fwd, hipFuncAttributeMaxDynamicSharedMemorySize, LDS_BYTES) != hipSuccess) { fprintf(stderr, "kernel_launch: hipFuncSetAttribute failed\n"); grid = -1; return; }
        if (hipOccupancyMaxActiveBlocksPerMultiprocessor(&per_cu, (const void*)fwd, NTHREADS, LDS_BYTES) != hipSuccess || per_cu < 1) fprintf(stderr, "kernel_launch: occupancy query reports %d\n", per_cu);
        (void)hipGetLastError();
        grid = cus < 256 ? cus : 256;
    }
    if (grid < 0) return;
    (void)hipMemsetAsync((char*)d_ws + WS_CTL, 0, CTL_ZERO_BYTES, stream);
    Args a{};
    for (int i = 0; i < 27; ++i) a.in[i] = (const float*)d_in[i];
    a.out = (float*)d_out; a.ws = (unsigned char*)d_ws;
#if MK_N_LAUNCHES == 1
    a.ph_lo = 0; a.ph_hi = N_PHASES;
    hipLaunchKernelGGL(fwd, dim3(grid), dim3(NTHREADS), LDS_BYTES, stream, a);
#else
    for (int p = 0; p < N_PHASES; ++p) { a.ph_lo = p; a.ph_hi = p + 1; hipLaunchKernelGGL(fwd, dim3(grid), dim3(NTHREADS), LDS_BYTES, stream, a); }
#endif
}
```

```cpp
#include <hip/hip_runtime.h>
#include <cstdio>
#include <cstdint>

#ifndef MK_N_LAUNCHES
#define MK_N_LAUNCHES 1
#endif

#define LAS __attribute__((address_space(3)))
#define GAS __attribute__((address_space(1)))
#define HD __host__ __device__
#define HDI __host__ __device__ __attribute__((always_inline)) inline
typedef unsigned short bf16;
typedef short bf16x8 __attribute__((ext_vector_type(8)));
typedef float f32x4 __attribute__((ext_vector_type(4)));
typedef float f32x2 __attribute__((ext_vector_type(2)));
typedef float f32x16 __attribute__((ext_vector_type(16)));
typedef unsigned u32x4 __attribute__((ext_vector_type(4)));
typedef unsigned u32x2 __attribute__((ext_vector_type(2)));

constexpr int D = 1024, BATCH = 8, SEQ = 4096, NTOK = BATCH * SEQ, NMEM = 256, NMEMTOK = BATCH * NMEM;
constexpr int DIN = 7704;
constexpr int C_RQ = 0, C_RK = 512, C_RV = 1024, C_RG = 2048, C_NQ = 3072, C_CK = 4096, C_NGL = 5632, C_GA = 5656, C_GB = 6680;
constexpr int NPROJ = 5632;
constexpr int NEXP = 32, DEXP = 512;
constexpr float EPS = 1e-6f;
constexpr int NWAVES = 8, NTHREADS = 512;

constexpr size_t MiB = 1u << 20;
constexpr size_t WS_CTL = 0, CTL_ZERO_BYTES = 1 * MiB;
constexpr size_t WS_ROPE_COS = 1 * MiB, WS_ROPE_SIN = 2 * MiB;
constexpr size_t WS_RTW = 3 * MiB + 512 * 1024;
constexpr size_t WS_SMALLW = 3 * MiB;
constexpr size_t WS_MEMVT = 24 * MiB;
constexpr size_t WS_KCMP = 4 * MiB, WS_VCMP = 5 * MiB, WS_VCMPT = 35 * MiB;
constexpr size_t WS_GATES = 10 * MiB;
constexpr size_t WS_SSQ = 13 * MiB;
constexpr size_t WS_ROUTE = 15 * MiB;
constexpr size_t WS_LISTS = 16 * MiB;
constexpr size_t WS_W = 36 * MiB;
constexpr size_t W_IN = WS_W;
constexpr size_t W_GA = W_IN + 11 * MiB, W_GB = W_GA + 2 * MiB;
constexpr size_t W_RO = W_GB + 2 * MiB, W_NO = W_RO + 2 * MiB, W_OUT = W_NO + 2 * MiB, W_XQ = W_OUT + 2 * MiB, W_XO = W_XQ + 2 * MiB;
constexpr size_t W_XKV = W_XO + 2 * MiB;
constexpr size_t W_C1K = W_XKV + 4 * MiB, W_C1V = W_C1K + 2 * MiB;
constexpr size_t WS_MEMN = W_C1V + 2 * MiB;
constexpr size_t WS_MEMKV = WS_MEMN + 4 * MiB;
constexpr size_t WS_H = 84 * MiB;
constexpr size_t WS_NQ = WS_H + 64 * MiB;
constexpr size_t WS_RV = WS_NQ + 64 * MiB;
constexpr size_t WS_RQ = WS_RV + 64 * MiB;
constexpr size_t WS_RK = WS_RQ + 32 * MiB;
constexpr size_t WS_RG = WS_RK + 32 * MiB;
constexpr size_t WS_KV6 = WS_RG + 64 * MiB;
constexpr size_t KV_STRIDE = 16 * MiB;
constexpr size_t WS_END = WS_KV6 + 96 * MiB;
constexpr size_t WS_Y = WS_RQ, WS_P4SCR = WS_RG, WS_W13 = WS_RQ, WS_W2 = WS_RG, WS_H1 = WS_KV6, WS_X1B = WS_H, WS_X2B = WS_RV, WS_YS0 = WS_H, WS_YS1 = WS_NQ;
static_assert(WS_MEMKV + 8 * MiB <= WS_H && WS_VCMPT + 1 * MiB <= WS_W && WS_MEMVT + 4 * MiB <= WS_VCMPT, "ws map");
constexpr int CW_BAR = 4096;
constexpr int CW_ECNT = 16384;
constexpr int LDS_BYTES = 147456, RING_BYTES = 131072, MISC_OFF = RING_BYTES + 320;

HD inline float bf2f(bf16 b) { return __builtin_bit_cast(float, (unsigned)b << 16); }
HD inline unsigned f2bf(float f) { unsigned u = __builtin_bit_cast(unsigned, f); return (u + 0x7fffu + ((u >> 16) & 1u)) >> 16; }
HD inline unsigned pk2(float lo, float hi) { return f2bf(lo) | (f2bf(hi) << 16); }
HD inline float lo16(unsigned w) { return __builtin_bit_cast(float, w << 16); }
HD inline float hi16(unsigned w) { return __builtin_bit_cast(float, w & 0xffff0000u); }
__device__ __forceinline__ unsigned cvt_pk_bf16(float lo, float hi) { unsigned r; asm volatile("v_cvt_pk_bf16_f32 %0, %1, %2" : "=v"(r) : "v"(lo), "v"(hi)); return r; }
#define DPP_F(v, ctrl, rmask) __builtin_bit_cast(float, __builtin_amdgcn_update_dpp(0, __builtin_bit_cast(int, v), ctrl, rmask, 0xf, false))
__device__ __forceinline__ float wave_sum(float v) {
    v += DPP_F(v, 0xB1, 0xf);
    v += DPP_F(v, 0x4E, 0xf);
    v += DPP_F(v, 0x141, 0xf);
    v += DPP_F(v, 0x140, 0xf);
    v += DPP_F(v, 0x142, 0xa);
    v += DPP_F(v, 0x143, 0xc);
    return __builtin_bit_cast(float, __builtin_amdgcn_readlane(__builtin_bit_cast(int, v), 63));
}
__device__ __forceinline__ float wave_max(float v) {
#pragma unroll
    for (int o = 1; o < 64; o <<= 1) v = fmaxf(v, __shfl_xor(v, o));
    return v;
}
__device__ __forceinline__ float sigmoidf_(float x) { return __builtin_amdgcn_rcpf(1.0f + __builtin_amdgcn_exp2f(-1.4426950408889634f * x)); }
#define LAUNDER(p) asm volatile("" : "+v"(p))
#define LDS_WAIT() asm volatile("s_waitcnt lgkmcnt(0)" ::: "memory")
#define VM_WAIT() asm volatile("s_waitcnt vmcnt(0)" ::: "memory")

#define XB_TMO      128
#define XB_XCNT(j)  (256  + 64 * (j))
#define XB_XSUB(j)  (1280 + 64 * (j))
#define XB_XGEN(j)  (2304 + 64 * (j))
#define XB_TOP      3328
#define XB_TOPGEN   3392
#define XCD_BAR_WORDS 3456
#define XB_SPIN_CAP (1u << 24)
__device__ __forceinline__ unsigned xb_ld(unsigned* p)              { return __hip_atomic_load(p, __ATOMIC_RELAXED, __HIP_MEMORY_SCOPE_AGENT); }
__device__ __forceinline__ unsigned xb_add(unsigned* p, unsigned v) { return __hip_atomic_fetch_add(p, v, __ATOMIC_RELAXED, __HIP_MEMORY_SCOPE_AGENT); }
__device__ __forceinline__ unsigned xb_xcc_id() { return (unsigned)__builtin_amdgcn_s_getreg((3 << 11) | 20) & 0xFu; }
#define XB_SPIN(cond, bar) do { unsigned _sp = 0; while (cond) { __builtin_amdgcn_s_sleep(1); \
    if ((++_sp & 255u) == 0u) { if (xb_ld(&(bar)[XB_TMO])) break; if (_sp > XB_SPIN_CAP) { atomicAdd(&(bar)[XB_TMO], 1u); break; } } } } while (0)
struct XcdBarrier { unsigned* bar; unsigned x; volatile LAS unsigned* st; };
__device__ __forceinline__ XcdBarrier xcd_barrier_post(unsigned* bar, volatile LAS unsigned* st) {
    XcdBarrier b; b.bar = bar; b.x = xb_xcc_id(); b.st = st;
    if (threadIdx.x == 0) (void)xb_add(&bar[XB_XCNT(b.x)], 1u);
    return b;
}
__device__ __forceinline__ void xcd_barrier_complete(unsigned* bar, unsigned x, unsigned& nloc, unsigned& nx) {
    const unsigned G = gridDim.x * gridDim.y * gridDim.z;
    unsigned sum, cnt, mine, sp = 0u;
    for (;;) {
        sum = 0u; cnt = 0u; mine = 0u;
#pragma unroll
        for (unsigned j = 0; j < 16; ++j) { const unsigned c = xb_ld(&bar[XB_XCNT(j)]); sum += c; cnt += (c > 0u) ? 1u : 0u; mine = (j == x) ? c : mine; }
        if (sum == G) break;
        __builtin_amdgcn_s_sleep(1);
        if ((++sp & 255u) == 0u) { if (xb_ld(&bar[XB_TMO])) break; if (sp > XB_SPIN_CAP) { atomicAdd(&bar[XB_TMO], 1u); break; } }
    }
    nloc = mine > 0u ? mine : 1u; nx = cnt > 0u ? cnt : 1u;
}
__device__ __forceinline__ void xcd_barrier(const XcdBarrier& b) {
    asm volatile("s_waitcnt vmcnt(0)" ::: "memory");
    __syncthreads();
    if (threadIdx.x == 0) {
        unsigned* bar = b.bar;
        __builtin_amdgcn_s_waitcnt(0);
        unsigned nloc = b.st[0], nx = b.st[1];
        if (nloc == 0u) { xcd_barrier_complete(bar, b.x, nloc, nx); b.st[0] = nloc; b.st[1] = nx; }
        const unsigned old = xb_add(&bar[XB_XSUB(b.x)], 1u);
        const unsigned gen = old / nloc;
        if (old + 1u == (gen + 1u) * nloc) {
            __builtin_amdgcn_fence(__ATOMIC_RELEASE, "agent");
            asm volatile("s_waitcnt vmcnt(0)" ::: "memory");
            const unsigned og = xb_add(&bar[XB_TOP], 1u);
            const unsigned tg = og / nx;
            if (og + 1u == (tg + 1u) * nx) xb_add(&bar[XB_TOPGEN], 1u);
            else XB_SPIN(xb_ld(&bar[XB_TOPGEN]) == tg, bar);
            __builtin_amdgcn_fence(__ATOMIC_ACQUIRE, "agent");
            xb_add(&bar[XB_XGEN(b.x)], 1u);
            asm volatile("s_waitcnt vmcnt(0)" ::: "memory");
        } else {
            XB_SPIN(xb_ld(&bar[XB_XGEN(b.x)]) == gen, bar);
            __builtin_amdgcn_fence(__ATOMIC_ACQUIRE, "agent");
            asm volatile("s_waitcnt vmcnt(0)" ::: "memory");
        }
    }
    __syncthreads();
}

namespace pg8 {
constexpr int BM = 256, BK = 64, HALF = 128, HTB = HALF * BK * 2, NXCD = 8, WGM = 8;
HD __forceinline__ int lds_byte(int r, int c) { const int st = (r >> 4) * 2 + (c >> 5), rr = r & 15, cc = c & 31, ob = rr * 64 + cc * 2; return st * 1024 + (ob ^ (((ob >> 9) & 1) << 5)); }
HD __forceinline__ void stage_rc(int b, int& R, int& C) { const int st = b / 1024, sb = b % 1024, swz = sb ^ (((sb >> 9) & 1) << 5); R = (st >> 1) * 16 + swz / 64; C = (st & 1) * 32 + (swz % 64) / 2; }
HD __forceinline__ int perm32(int rho) { const int n = rho >> 4, i = rho & 15; return 8 * (i >> 2) + 4 * n + (i & 3); }
HD __forceinline__ void tile_map(int L, int nM, int nN, int& pm, int& pn) {
    const int nwg = nM * nN; int wgid = L; { const int q = nwg / NXCD, r = nwg % NXCD, xcd = wgid % NXCD, off = wgid / NXCD; wgid = (xcd < r ? xcd * (q + 1) : r * (q + 1) + (xcd - r) * q) + off; }
    const int nig = WGM * nN, gid = wgid / nig, fm = gid * WGM, gsz = (nM - fm) < WGM ? (nM - fm) : WGM;
    pm = fm + ((wgid % nig) % gsz); pn = (wgid % nig) / gsz;
}
struct GU { const char* A; const char* B; const int* rows; int nvalid; int kind, pm, pn, aux; };
template <class Epi, class Sched, bool GATHER>
__device__ __forceinline__ void gemm_phase(LAS unsigned char* lds, const int K, const int lda, const int ldb, const Sched& S, const Epi& E) {
    int tid_ = threadIdx.x; LAUNDER(tid_);
    const int tid = tid_, wid = __builtin_amdgcn_readfirstlane(tid >> 6), lane = tid & 63, wr = wid >> 2, wc = wid & 3, fr = lane & 15, fq = lane >> 4;
    const int nt = K / BK;
    unsigned voffB[2];
#pragma unroll
    for (int i = 0; i < 2; ++i) { int R, C; stage_rc(tid * 16 + i * 8192, R, C); const int Rb = Epi::PERM ? ((R & ~31) + perm32(R & 31)) : R; voffB[i] = (unsigned)(Rb * ldb + C) * 2u; }
    const size_t kstep = (size_t)(BK * 2);
    const size_t hstepB = (size_t)HALF * ldb * 2;
    const unsigned ldsw = (unsigned)wid * 1024u;
    const int aoff = lds_byte(wr * 64 + fr, fq * 8), boff = lds_byte(wc * 32 + fr, fq * 8);
#define PG8_SA(b, h) (((b) * 2 + (h)) * HTB)
#define PG8_SB(b, h) ((4 + (b) * 2 + (h)) * HTB)
#define PG8_STAGE2(bufoff, gbase, v0, v1) do { \
        __builtin_amdgcn_global_load_lds((const unsigned*)((const char*)(gbase) + (v0)), (LAS unsigned*)(lds + (bufoff) + ldsw), 16, 0, 0); \
        __builtin_amdgcn_global_load_lds((const unsigned*)((const char*)(gbase) + (v1)), (LAS unsigned*)(lds + (bufoff) + ldsw + 8192), 16, 0, 0); } while (0)
#define PG8_STAGEB(bufoff, gbase) PG8_STAGE2(bufoff, gbase, voffB[0], voffB[1])
#define PG8_LDA(dst, b, h) do { _Pragma("unroll") for (int m = 0; m < 4; ++m) _Pragma("unroll") for (int k = 0; k < 2; ++k) dst[m][k] = *(const LAS bf16x8*)(lds + PG8_SA(b, h) + aoff + m * 2048 + k * 1024); } while (0)
#define PG8_LDB(dst, b, h) do { _Pragma("unroll") for (int n = 0; n < 2; ++n) _Pragma("unroll") for (int k = 0; k < 2; ++k) dst[n][k] = *(const LAS bf16x8*)(lds + PG8_SB(b, h) + boff + n * 2048 + k * 1024); } while (0)
#define PG8_MMA(ai, bj, At, Bt) do { __builtin_amdgcn_s_setprio(1); _Pragma("unroll") for (int m = 0; m < 4; ++m) _Pragma("unroll") for (int n = 0; n < 2; ++n) _Pragma("unroll") for (int k = 0; k < 2; ++k) \
        acc[ai][bj][m][n] = __builtin_amdgcn_mfma_f32_16x16x32_bf16(Bt[n][k], At[m][k], acc[ai][bj][m][n], 0, 0, 0); __builtin_amdgcn_s_setprio(0); } while (0)
#define PG8_WAIT_V(n) asm volatile("s_waitcnt vmcnt(" #n ")" ::: "memory")
#define PG8_WAIT_L(n) asm volatile("s_waitcnt lgkmcnt(" #n ")" ::: "memory")
#define PG8_BAR __builtin_amdgcn_s_barrier()
#define PG8_SCHED __builtin_amdgcn_sched_barrier(0)
#define PG8_VOFFA(u, vo) do { _Pragma("unroll") for (int h = 0; h < 2; ++h) _Pragma("unroll") for (int i = 0; i < 2; ++i) { int R_, C_; stage_rc(tid * 16 + i * 8192, R_, C_); const int R = R_ + HALF * h; \
        int ridx = R; if (GATHER) { ridx = (R < (u).nvalid) ? ((u).rows[R] >> 1) : 0; } vo[h][i] = (unsigned)(ridx * lda + C_) * 2u; } if (GATHER) asm volatile("" :: "v"(vo[0][0]), "v"(vo[0][1]), "v"(vo[1][0]), "v"(vo[1][1])); } while (0)
    GU cur, nxt; int ui = 0;
    if (!S.next(0, cur)) return;
    f32x4 acc[2][2][4][2];
#pragma unroll
    for (int a = 0; a < 2; ++a)
#pragma unroll
        for (int b = 0; b < 2; ++b)
#pragma unroll
            for (int m = 0; m < 4; ++m)
#pragma unroll
                for (int n = 0; n < 2; ++n) acc[a][b][m][n] = (f32x4){0.f, 0.f, 0.f, 0.f};
    bf16x8 At[4][2], B0[2][2], B1[2][2];
    unsigned cv[2][2], nv[2][2];
    PG8_VOFFA(cur, cv);
    const char* cA = cur.A; const char* cB = cur.B;
    PG8_STAGEB(PG8_SB(0, 0), cB); PG8_STAGEB(PG8_SB(0, 1), cB + hstepB); PG8_STAGE2(PG8_SA(0, 0), cA, cv[0][0], cv[0][1]); PG8_STAGE2(PG8_SA(0, 1), cA, cv[1][0], cv[1][1]);
    if (wr == 1) PG8_BAR;
    PG8_WAIT_V(2); PG8_BAR;
    PG8_STAGEB(PG8_SB(1, 0), cB + kstep); PG8_STAGE2(PG8_SA(1, 0), cA + kstep, cv[0][0], cv[0][1]); PG8_STAGEB(PG8_SB(1, 1), cB + hstepB + kstep);
    PG8_WAIT_V(6); PG8_BAR;
    for (;;) {
        const bool has_next = S.next(ui + 1, nxt);
        const char* nA = has_next ? nxt.A : cA; const char* nB = has_next ? nxt.B : cB;
        if (has_next) { PG8_VOFFA(nxt, nv); } else {
#pragma unroll
            for (int h = 0; h < 2; ++h)
#pragma unroll
                for (int i = 0; i < 2; ++i) nv[h][i] = cv[h][i]; }
        for (int t = 0; t < nt; t += 2) {
            const bool last = (t == nt - 2);
            const char* a1 = cA + (size_t)(t + 1) * kstep;
            const char* a2 = last ? nA : cA + (size_t)(t + 2) * kstep; const char* b2 = last ? nB : cB + (size_t)(t + 2) * kstep;
            const char* a3 = a2 + kstep; const char* b3 = b2 + kstep;
            const unsigned w00 = last ? nv[0][0] : cv[0][0], w01 = last ? nv[0][1] : cv[0][1], w10 = last ? nv[1][0] : cv[1][0], w11 = last ? nv[1][1] : cv[1][1];
            PG8_LDB(B0, 0, 0); PG8_LDB(B1, 0, 1); PG8_SCHED; PG8_LDA(At, 0, 0); PG8_STAGE2(PG8_SA(1, 1), a1, cv[1][0], cv[1][1]);
            PG8_WAIT_V(8); PG8_WAIT_L(0); PG8_BAR; PG8_MMA(0, 0, At, B0); PG8_MMA(0, 1, At, B1); PG8_BAR; PG8_SCHED;
            PG8_LDA(At, 0, 1); PG8_STAGEB(PG8_SB(0, 0), b2); PG8_STAGEB(PG8_SB(0, 1), b2 + hstepB); PG8_STAGE2(PG8_SA(0, 0), a2, w00, w01);
            PG8_WAIT_V(8); PG8_WAIT_L(0); PG8_BAR; PG8_MMA(1, 0, At, B0); PG8_MMA(1, 1, At, B1); PG8_BAR; PG8_SCHED;
            PG8_LDB(B0, 1, 0); PG8_LDB(B1, 1, 1); PG8_SCHED; PG8_LDA(At, 1, 0); PG8_STAGE2(PG8_SA(0, 1), a2, w10, w11);
            PG8_WAIT_V(8); PG8_WAIT_L(0); PG8_BAR; PG8_MMA(0, 0, At, B0); PG8_MMA(0, 1, At, B1); PG8_BAR; PG8_SCHED;
            PG8_LDA(At, 1, 1); PG8_STAGEB(PG8_SB(1, 0), b3); PG8_STAGEB(PG8_SB(1, 1), b3 + hstepB); PG8_STAGE2(PG8_SA(1, 0), a3, w00, w01);
            PG8_WAIT_V(8); PG8_WAIT_L(0); PG8_BAR; PG8_MMA(1, 0, At, B0); PG8_MMA(1, 1, At, B1); PG8_BAR; PG8_SCHED;
        }
        if (wr == 0) PG8_BAR;
        E(acc, cur, wr, wc, fr, fq);
        if (!has_next) break;
#pragma unroll
        for (int a = 0; a < 2; ++a)
#pragma unroll
            for (int b = 0; b < 2; ++b)
#pragma unroll
                for (int m = 0; m < 4; ++m)
#pragma unroll
                    for (int n = 0; n < 2; ++n) acc[a][b][m][n] = (f32x4){0.f, 0.f, 0.f, 0.f};
        cur = nxt; cA = nA; cB = nB; ++ui;
#pragma unroll
        for (int h = 0; h < 2; ++h)
#pragma unroll
            for (int i = 0; i < 2; ++i) cv[h][i] = nv[h][i];
        if (wr == 1) PG8_BAR;
    }
    PG8_WAIT_V(0);
    PG8_BAR;
#undef PG8_SA
#undef PG8_SB
#undef PG8_STAGE2
#undef PG8_STAGEB
#undef PG8_LDA
#undef PG8_LDB
#undef PG8_MMA
#undef PG8_WAIT_V
#undef PG8_WAIT_L
#undef PG8_BAR
#undef PG8_SCHED
#undef PG8_VOFFA
}
}
using pg8::GU;

struct Args {
    const float* in[27]; float* out; unsigned char* ws; int ph_lo, ph_hi; int pad0, pad1;
};
enum { IN_X = 0, IN_MEM, IN_NORM_MIX_G, IN_W_IN, IN_W_RET_O, IN_W_NSA_O, IN_W_OUT, IN_CMP_PE_K, IN_CMP_W1_K, IN_CMP_W2_K, IN_CMP_PE_V, IN_CMP_W1_V, IN_CMP_W2_V,
       IN_NORM_X_G, IN_NORM_MEM_G, IN_W_XQ, IN_W_XKV, IN_W_XO, IN_NORM_FFN_G, IN_W_GRP, IN_B_GRP, IN_W_RT, IN_B_RT, IN_W_E1, IN_W_E3, IN_W_E2, IN_NORM_F_G };
struct Frame {
    LAS unsigned char* lds; volatile LAS unsigned* MISC; unsigned* ctl; unsigned char* ws;
    int tid, lane, wave, G, bx;
};

__device__ __forceinline__ bool phase_begin(Frame& F) { int t = threadIdx.x; LAUNDER(t); F.tid = t; F.lane = t & 63; return true; }
__device__ __forceinline__ void transpose_item(const float* W, int ldw, int c0, int k0, bf16* WT, int ldt, int mode, int row_off, int cbase, const float* kscale, float scale, LAS float* scr, int lane) {
    float vv[32];
#pragma unroll
    for (int i = 0; i < 32; ++i) { const int kk = 2 * i + (lane >> 5); vv[i] = W[(size_t)(k0 + kk) * ldw + c0 + (lane & 31)]; }
    if (kscale) {
#pragma unroll
        for (int i = 0; i < 32; ++i) { const int kk = 2 * i + (lane >> 5); vv[i] *= kscale[k0 + kk]; } }
#pragma unroll
    for (int i = 0; i < 32; ++i) { const int kk = 2 * i + (lane >> 5); scr[kk * 33 + (lane & 31)] = vv[i] * scale; }
    LDS_WAIT(); asm volatile("" ::: "memory");
    const int c = lane & 7;
#pragma unroll
    for (int j = 0; j < 4; ++j) { const int n = (lane >> 3) + 8 * j; const LAS float* s = scr + (8 * c) * 33 + n;
        u32x4 o; o.x = pk2(s[0 * 33], s[1 * 33]); o.y = pk2(s[2 * 33], s[3 * 33]); o.z = pk2(s[4 * 33], s[5 * 33]); o.w = pk2(s[6 * 33], s[7 * 33]);
        const int jc = c0 - cbase + n; const int drow = mode == 0 ? row_off + jc : (8 * (jc >> 2) + 4 * row_off + (jc & 3));
        *(u32x4*)(WT + (size_t)drow * ldt + k0 + 8 * c) = o; }
    LDS_WAIT(); asm volatile("" ::: "memory");
}
__device__ __forceinline__ void transpose_matrix(Frame& F, int& item_base, const float* W, int ldw, int K, int cbase, int ncols, bf16* WT, int ldt, int mode, int row_off, const float* kscale, float scale) {
    LAS float* scr = (LAS float*)(F.lds + F.wave * 16384);
    const int gw = F.bx * NWAVES + F.wave, NGW = F.G * NWAVES;
    const int nb = ncols / 32, nitems = (K / 64) * nb;
    int it = (gw - item_base % NGW + NGW) % NGW;
    for (; it < nitems; it += NGW) transpose_item(W, ldw, cbase + 32 * (it % nb), 64 * (it / nb), WT, ldt, mode, row_off, cbase, kscale, scale, scr, F.lane);
    item_base += nitems;
}
__device__ __forceinline__ void rms_row_to_bf16(int lane, const float* xrow, const float* g, bf16* orow) {
    const f32x4* xr = (const f32x4*)xrow + lane; const f32x4* gr = (const f32x4*)g + lane;
    f32x4 v[4]; float s = 0.f;
#pragma unroll
    for (int j = 0; j < 4; ++j) { v[j] = xr[64 * j]; s += (v[j].x * v[j].x + v[j].y * v[j].y) + (v[j].z * v[j].z + v[j].w * v[j].w); }
    const float rstd = 1.0f / sqrtf(wave_sum(s) * (1.f / D) + EPS);
    unsigned long long* o8 = (unsigned long long*)orow + lane;
#pragma unroll
    for (int j = 0; j < 4; ++j) { const f32x4 gg = gr[64 * j];
        o8[64 * j] = (unsigned long long)pk2(v[j].x * rstd * gg.x, v[j].y * rstd * gg.y) | ((unsigned long long)pk2(v[j].z * rstd * gg.z, v[j].w * rstd * gg.w) << 32); }
}

struct XItem { const float* src; bf16* dst; const float* ks; float scale; int ldw, ldt, mode, row_off, csrc, c0, k0, has_ks; };
__device__ __forceinline__ void xitem_decode_expert(const Args& a, unsigned char* ws, int it, XItem& x) {
    const int e = it / 768, r = it % 768, which = r >> 8, t = r & 255;
    x.ks = a.in[IN_NORM_FFN_G]; x.scale = 1.0f;
    if (which < 2) { x.src = a.in[which ? IN_W_E3 : IN_W_E1] + (size_t)e * D * DEXP; x.ldw = DEXP; x.dst = (bf16*)(ws + WS_W13) + (size_t)e * D * D; x.ldt = D; x.mode = 1; x.row_off = which; x.has_ks = 1; x.c0 = 32 * (t & 15); x.k0 = 64 * (t >> 4); }
    else { x.src = a.in[IN_W_E2] + (size_t)e * DEXP * D; x.ldw = D; x.dst = (bf16*)(ws + WS_W2) + (size_t)e * D * DEXP; x.ldt = DEXP; x.mode = 0; x.row_off = 0; x.has_ks = 0; x.c0 = 32 * (t & 31); x.k0 = 64 * (t >> 5); }
    x.csrc = x.c0;
}
constexpr int P0_NITEMS = 7936;
__device__ __forceinline__ void xitem_decode_p0(const Args& a, unsigned char* ws, int it, XItem& x) {
    int in_ = IN_W_IN, ldw = DIN, cb = 0, nc = 512, ldt = D, ro = 0, first = 0; size_t dst = W_IN; float sc = 1.0f; int hk = 0;
#define P0E(FIRST, IN__, LDW, CB, NC, DST, LDT, RO, SC, HK) if (it >= (FIRST)) { in_ = (IN__); ldw = (LDW); cb = (CB); nc = (NC); dst = (DST); ldt = (LDT); ro = (RO); sc = (SC); hk = (HK); first = (FIRST); }
    P0E(256, IN_W_IN, DIN, 512, 512, W_IN, D, 512, 0.08838834764831845f, 0)
    P0E(512, IN_W_IN, DIN, 1024, NPROJ - 1024, W_IN, D, 1024, 1.0f, 0)
    P0E(2816, IN_W_IN, DIN, C_GA, 1024, W_GA, D, 0, 1.0f, 0)
    P0E(3328, IN_W_IN, DIN, C_GB, 1024, W_GB, D, 0, 1.0f, 0)
    P0E(3840, IN_W_RET_O, D, 0, D, W_RO, D, 0, 1.0f, 0)
    P0E(4352, IN_W_NSA_O, D, 0, D, W_NO, D, 0, 1.0f, 0)
    P0E(4864, IN_W_OUT, D, 0, D, W_OUT, D, 0, 1.0f, 0)
    P0E(5376, IN_W_XQ, D, 0, D, W_XQ, D, 0, 1.0f, 1)
    P0E(5888, IN_W_XO, D, 0, D, W_XO, D, 0, 1.0f, 0)
    P0E(6400, IN_W_XKV, 2 * D, 0, 2 * D, W_XKV, D, 0, 1.0f, 0)
    P0E(7424, IN_CMP_W1_K, 128, 0, 128, W_C1K, 4096, 0, 1.0f, 0)
    P0E(7680, IN_CMP_W1_V, 128, 0, 128, W_C1V, 4096, 0, 1.0f, 0)
#undef P0E
    const int t = it - first, nb = nc >> 5;
    x.src = a.in[in_]; x.dst = (bf16*)(ws + dst); x.ks = a.in[IN_NORM_X_G]; x.scale = sc; x.ldw = ldw; x.ldt = ldt; x.mode = 0; x.row_off = ro; x.has_ks = hk;
    x.c0 = 32 * (t % nb); x.csrc = cb + x.c0; x.k0 = 64 * (t / nb);
}
__device__ __forceinline__ void xitem_load(const XItem& x, int lane, float (&vv)[32], f32x4& k0v, f32x4& k1v) {
#pragma unroll
    for (int i = 0; i < 32; ++i) { const int kk = 2 * i + (lane >> 5); vv[i] = x.src[(size_t)(x.k0 + kk) * x.ldw + x.csrc + (lane & 31)]; }
    const f32x4* p = (const f32x4*)(x.ks + ((x.k0 + 8 * (lane & 7)) & 1023)); k0v = p[0]; k1v = p[1];
}
__device__ __forceinline__ void xitem_finish(const XItem& x, int lane, const float (&vv)[32], f32x4 k0v, f32x4 k1v, LAS float* scr) {
    if (!x.has_ks) { k0v = (f32x4){1.f, 1.f, 1.f, 1.f}; k1v = k0v; }
    k0v *= x.scale; k1v *= x.scale;
#pragma unroll
    for (int i = 0; i < 32; ++i) { const int kk = 2 * i + (lane >> 5); scr[kk * 33 + (lane & 31)] = vv[i]; }
    LDS_WAIT(); asm volatile("" ::: "memory");
    const int c = lane & 7;
#pragma unroll
    for (int j = 0; j < 4; ++j) { const int n = (lane >> 3) + 8 * j; const LAS float* s = scr + (8 * c) * 33 + n;
        u32x4 o; o.x = pk2(s[0 * 33] * k0v.x, s[1 * 33] * k0v.y); o.y = pk2(s[2 * 33] * k0v.z, s[3 * 33] * k0v.w); o.z = pk2(s[4 * 33] * k1v.x, s[5 * 33] * k1v.y); o.w = pk2(s[6 * 33] * k1v.z, s[7 * 33] * k1v.w);
        const int jc = x.c0 + n; const int drow = x.mode == 0 ? x.row_off + jc : (8 * (jc >> 2) + 4 * x.row_off + (jc & 3));
        *(u32x4*)(x.dst + (size_t)drow * x.ldt + x.k0 + 8 * c) = o; }
    LDS_WAIT(); asm volatile("" ::: "memory");
}
template <bool EXPERT>
__device__ __forceinline__ void run_items(Frame& F, const Args& a, int it_begin, int it_end) {
    LAS float* scr = (LAS float*)(F.lds + F.wave * 16384);
    const int gw = F.bx * NWAVES + F.wave, NGW = F.G * NWAVES, lane = F.lane;
    int it = it_begin + gw;
#define XDEC(i_, x_) do { if (EXPERT) xitem_decode_expert(a, F.ws, (i_), x_); else xitem_decode_p0(a, F.ws, (i_), x_); } while (0)
    if (it < it_end) {
        float va[32], vb[32]; f32x4 ka0, ka1, kb0, kb1; XItem xa, xb;
        XDEC(it, xa); xitem_load(xa, lane, va, ka0, ka1);
        for (;;) {
            int itn = it + NGW; bool hn = itn < it_end;
            XDEC(hn ? itn : it, xb); xitem_load(xb, lane, vb, kb0, kb1);
            xitem_finish(xa, lane, va, ka0, ka1, scr);
            if (!hn) break;
            it = itn; itn = it + NGW; hn = itn < it_end;
            XDEC(hn ? itn : it, xa); xitem_load(xa, lane, va, ka0, ka1);
            xitem_finish(xb, lane, vb, kb0, kb1, scr);
            if (!hn) break;
            it = itn;
        }
    }
#undef XDEC
    __syncthreads();
}
__device__ __forceinline__ void expert_copies(Frame& F, const Args& a, int e_lo, int e_hi) { run_items<true>(F, a, e_lo * 768, e_hi * 768); }

__device__ __forceinline__ void p0_prologue(Frame& F, const Args& a) {
    unsigned char* ws = F.ws;
    const float* w_in = a.in[IN_W_IN];
    run_items<false>(F, a, 0, P0_NITEMS);
    const int gt = F.bx * NTHREADS + F.tid, NGT = F.G * NTHREADS;
    for (int i = gt; i < 2 * 128 * 4096 / 8; i += NGT) { const int m = i / (128 * 4096 / 8), r = i % (128 * 4096 / 8);
        *(u32x4*)(ws + (m ? W_C1V : W_C1K) + (size_t)128 * 4096 * 2 + (size_t)r * 16) = (u32x4){0u, 0u, 0u, 0u}; }
    bf16* wngl = (bf16*)(ws + WS_SMALLW);
    for (int i = gt; i < 32 * 1024; i += NGT) { const int r = i >> 10, k = i & 1023; wngl[i] = r < 24 ? (bf16)f2bf(w_in[(size_t)k * DIN + C_NGL + r]) : (bf16)0; }
    bf16* w2k = (bf16*)(ws + WS_SMALLW + 65536); bf16* w2v = w2k + 128 * 128;
    for (int i = gt; i < 2 * 128 * 128; i += NGT) { const int m = i >> 14, r = i & 16383, f = r >> 7, e = r & 127; const float* src = a.in[m ? IN_CMP_W2_V : IN_CMP_W2_K];
        (m ? w2v : w2k)[f * 128 + e] = (bf16)f2bf(src[e * 128 + f]); }
    { const float* gff = a.in[IN_NORM_FFN_G]; const float* wgrp = a.in[IN_W_GRP]; const float* wrt = a.in[IN_W_RT]; float* wgp = (float*)(ws + WS_RTW); float* wep = wgp + 4096;
      for (int i = gt; i < 4096; i += NGT) wgp[i] = gff[i >> 2] * wgrp[i];
      for (int i = gt; i < 32768; i += NGT) { const int j = i & 3, l = (i >> 2) & 63, half = (i >> 8) & 1, ii = (i >> 9) & 15, grp = i >> 13, k = 64 * ii + l; wep[i] = gff[k] * wrt[k * 32 + grp * 8 + half * 4 + j]; } }
    float* cbias = (float*)(ws + WS_SMALLW + 65536 + 2 * 128 * 128 * 2);
    const int gw = F.bx * NWAVES + F.wave, NGW = F.G * NWAVES;
    for (int o = gw; o < 256; o += NGW) { const int m = o >> 7, e = o & 127; const float* pe = a.in[m ? IN_CMP_PE_V : IN_CMP_PE_K]; const float* w1 = a.in[m ? IN_CMP_W1_V : IN_CMP_W1_K];
        float s = 0.f; for (int k = F.lane; k < 4096; k += 64) s += pe[k] * w1[(size_t)k * 128 + e];
        s = wave_sum(s); if (F.lane == 0) cbias[o] = s; }
    float* cosT = (float*)(ws + WS_ROPE_COS); float* sinT = (float*)(ws + WS_ROPE_SIN);
    for (int i = gt; i < SEQ * 64; i += NGT) { const int pos = i >> 6, j = i & 63; const float inv = powf(10000.0f, -(float)(2 * j) / 128.0f); const float ang = (float)pos * inv;
        cosT[i] = cosf(ang); sinT[i] = sinf(ang); }
    { f32x4 nx[4]; const float* X = a.in[IN_X]; const f32x4* gr = (const f32x4*)a.in[IN_NORM_MIX_G] + F.lane;
      if (gw < NTOK) {
#pragma unroll
          for (int j = 0; j < 4; ++j) nx[j] = ((const f32x4*)(X + (size_t)gw * D) + F.lane)[64 * j]; }
      for (int m = gw; m < NTOK; m += NGW) { f32x4 v[4]; float sq = 0.f;
#pragma unroll
          for (int j = 0; j < 4; ++j) { v[j] = nx[j]; sq += (v[j].x * v[j].x + v[j].y * v[j].y) + (v[j].z * v[j].z + v[j].w * v[j].w); }
          if (m + NGW < NTOK) {
#pragma unroll
              for (int j = 0; j < 4; ++j) nx[j] = ((const f32x4*)(X + (size_t)(m + NGW) * D) + F.lane)[64 * j]; }
          const float rstd = 1.0f / sqrtf(wave_sum(sq) * (1.f / D) + EPS); unsigned long long* o8 = (unsigned long long*)((bf16*)(ws + WS_H) + (size_t)m * D) + F.lane;
#pragma unroll
          for (int j = 0; j < 4; ++j) { const f32x4 gg = gr[64 * j]; o8[64 * j] = (unsigned long long)pk2(v[j].x * rstd * gg.x, v[j].y * rstd * gg.y) | ((unsigned long long)pk2(v[j].z * rstd * gg.z, v[j].w * rstd * gg.w) << 32); } } }
    for (int m = gw; m < NMEMTOK; m += NGW) rms_row_to_bf16(F.lane, a.in[IN_MEM] + (size_t)m * D, a.in[IN_NORM_MEM_G], (bf16*)(ws + WS_MEMN) + (size_t)m * D);
}

struct SchedP1 {
    unsigned char* ws; int G, c;
    __device__ __forceinline__ bool next(int i, GU& u) const {
        constexpr int NP = 128 * 22; const int L = i * G + c;
        u.rows = nullptr; u.nvalid = 0; u.aux = 0;
        if (L < NP) { int pm, pn; pg8::tile_map(L, 128, 22, pm, pn); u.A = (const char*)ws + WS_H + (size_t)pm * 256 * D * 2; u.B = (const char*)ws + W_IN + (size_t)pn * 256 * D * 2; u.pm = pm; u.pn = pn;
            u.kind = pn < 2 ? 0 : pn < 4 ? 1 : pn < 8 ? 2 : pn < 12 ? 3 : pn < 16 ? 4 : 5; return true; }
        const int L2 = L - NP; if (L2 >= 64) return false;
        const int pm = L2 & 7, pn = L2 >> 3; u.A = (const char*)ws + WS_MEMN + (size_t)pm * 256 * D * 2; u.B = (const char*)ws + W_XKV + (size_t)pn * 256 * D * 2; u.pm = pm; u.pn = pn; u.kind = 6; return true;
    }
};
struct EpiP1 {
    static constexpr bool PERM = true;
    unsigned char* ws;
    __device__ __forceinline__ void operator()(const f32x4 (&acc)[2][2][4][2], const GU& u, int wr, int wc, int fr, int fq) const {
        const int kind = u.kind;
        const float* cosT = (const float*)(ws + WS_ROPE_COS); const float* sinT = (const float*)(ws + WS_ROPE_SIN);
#pragma unroll
        for (int ai = 0; ai < 2; ++ai)
#pragma unroll
            for (int m = 0; m < 4; ++m) {
                const int r = 128 * ai + 64 * wr + 16 * m + fr; const int tok = u.pm * 256 + r;
#pragma unroll
                for (int bj = 0; bj < 2; ++bj) {
                    f32x4 v0 = acc[ai][bj][m][0], v1 = acc[ai][bj][m][1];
                    const int ct = 128 * bj + 32 * wc + 8 * fq;
                    bf16* dst;
                    if (kind <= 1) {
                        const int s = tok & (SEQ - 1), i0 = ((ct & 127) >> 1);
                        const f32x4 cs = *(const f32x4*)(cosT + s * 64 + i0), sn = *(const f32x4*)(sinT + s * 64 + i0);
                        const f32x4 a0 = v0, a1 = v1;
                        v0[0] = a0[0] * cs[0] - a0[1] * sn[0]; v0[1] = a0[0] * sn[0] + a0[1] * cs[0];
                        v0[2] = a0[2] * cs[1] - a0[3] * sn[1]; v0[3] = a0[2] * sn[1] + a0[3] * cs[1];
                        v1[0] = a1[0] * cs[2] - a1[1] * sn[2]; v1[1] = a1[0] * sn[2] + a1[1] * cs[2];
                        v1[2] = a1[2] * cs[3] - a1[3] * sn[3]; v1[3] = a1[2] * sn[3] + a1[3] * cs[3];
                        dst = (bf16*)(ws + (kind == 0 ? WS_RQ : WS_RK)) + (size_t)tok * 512 + (u.pn & 1) * 256 + ct;
                    } else if (kind == 2) { dst = (bf16*)(ws + WS_RV) + (size_t)tok * 1024 + (u.pn - 4) * 256 + ct;
                    } else if (kind == 3) {
#pragma unroll
                        for (int j = 0; j < 4; ++j) { v0[j] = v0[j] * sigmoidf_(v0[j]); v1[j] = v1[j] * sigmoidf_(v1[j]); }
                        dst = (bf16*)(ws + WS_RG) + (size_t)tok * 1024 + (u.pn - 8) * 256 + ct;
                    } else if (kind == 4) { dst = (bf16*)(ws + WS_NQ) + (size_t)tok * 1024 + (u.pn - 12) * 256 + ct;
                    } else if (kind == 5) {
                        const int b = tok >> 12, s = tok & (SEQ - 1);
                        unsigned char* kvb = ws + WS_KV6 + (size_t)(u.pn - 16) * KV_STRIDE;
                        dst = (bf16*)kvb + ((size_t)(b * 2 + bj) * SEQ + s) * 128 + (ct & 127);
                    } else { dst = (bf16*)(ws + WS_MEMKV) + (size_t)tok * 2048 + u.pn * 256 + ct; }
                    u32x4 w; w.x = cvt_pk_bf16(v0[0], v0[1]); w.y = cvt_pk_bf16(v0[2], v0[3]); w.z = cvt_pk_bf16(v1[0], v1[1]); w.w = cvt_pk_bf16(v1[2], v1[3]);
                    *(u32x4*)dst = w;
                }
            }
    }
};
__device__ __forceinline__ void p1_gate_logits(Frame& F) {
    const bf16* H = (const bf16*)(F.ws + WS_H); const bf16* W = (const bf16*)(F.ws + WS_SMALLW); float* gates = (float*)(F.ws + WS_GATES);
    const int r = F.lane & 31, hh = F.lane >> 5;
    const int nb_ = F.G > 64 ? F.G - 64 : F.G, b0_ = F.G > 64 ? F.bx - 64 : F.bx;
    if (b0_ < 0) return;
    for (int rb = b0_ + nb_ * F.wave; rb < NTOK / 32; rb += nb_ * NWAVES) {
        f32x16 acc; for (int j = 0; j < 16; ++j) acc[j] = 0.f;
        const bf16* ap = H + (size_t)(rb * 32 + r) * D + 8 * hh; const bf16* bp = W + (size_t)r * D + 8 * hh;
        for (int s8 = 0; s8 < 8; ++s8) { bf16x8 av[8], bv[8];
#pragma unroll
            for (int q = 0; q < 8; ++q) { av[q] = *(const bf16x8*)(ap + 16 * (8 * s8 + q)); bv[q] = *(const bf16x8*)(bp + 16 * (8 * s8 + q)); }
#pragma unroll
            for (int q = 0; q < 8; ++q) acc = __builtin_amdgcn_mfma_f32_32x32x16_bf16(av[q], bv[q], acc, 0, 0, 0); }
        if (r < 24) {
#pragma unroll
            for (int reg = 0; reg < 16; ++reg) { const int row = (reg & 3) + 8 * (reg >> 2) + 4 * hh; gates[(size_t)(rb * 32 + row) * 24 + r] = sigmoidf_(acc[reg]); }
        }
    }
}

namespace retf {
constexpr int ROWB = 272;
constexpr int OFF_K = 0, OFF_V = 128 * 256, OFF_ZV = OFF_V + 128 * 64, OFF_ST = OFF_ZV + 128 * 64, OFF_PART = OFF_ST + 32 * ROWB, OFF_Q = OFF_PART + 4 * 4096;
static_assert(OFF_Q + 128 * 256 <= RING_BYTES, "retention LDS map");
typedef short s16x4 __attribute__((ext_vector_type(4)));
__device__ __forceinline__ u32x2 lds_tr(const LAS unsigned char* p) { return __builtin_bit_cast(u32x2, __builtin_amdgcn_ds_read_tr16_b64_v4i16((LAS s16x4*)p)); }
}
__device__ __forceinline__ void p2_retention_fast(Frame& F, int unit, bf16* outbase) {
    using namespace retf;
    const int bh = (unit & 7) * 4 + (unit >> 6), sl = (unit >> 3) & 7, b = bh >> 2, h = bh & 3;
    const bf16* rq = (const bf16*)(F.ws + WS_RQ); const bf16* rk = (const bf16*)(F.ws + WS_RK); const bf16* rv = (const bf16*)(F.ws + WS_RV);
    const int tid = F.tid, lane = F.lane, wave = F.wave, r = lane & 31, hi = lane >> 5; LAS unsigned char* lds = F.lds;
    const float lg = log2f(1.0f - exp2f(-5.0f - (float)h));
    const int nt = wave & 3, mh = wave >> 2;
    for (int i = tid; i < 32 * ROWB / 4; i += NTHREADS) ((LAS unsigned*)(lds + OFF_ST))[i] = 0u;
    f32x16 ST;
#pragma unroll
    for (int j = 0; j < 16; ++j) ST[j] = 0.f;
    const float gC = exp2f(128.0f * lg);
    const float zeta = exp2f((float)(127 - (tid >> 2)) * lg);
    const int blk = (lane >> 4) & 1, q4 = (lane & 15) >> 2, p4 = lane & 3;
    const int vtr = (4 * hi + q4) * 64 + 32 * blk + 8 * p4;
    const int ztr = (8 * hi + q4) * 64 + 32 * blk + 8 * p4;
    int ktr[2];
#pragma unroll
    for (int t = 0; t < 2; ++t) ktr[t] = 256 * (8 * hi + 4 * t + q4) + 16 * ((4 * nt + 2 * blk + (p4 >> 1)) ^ ((q4 << 2) | ((2 * hi + t) & 3))) + 8 * (p4 & 1);
    const int krow = 256 * r + 16 * (hi ^ (((r & 3) << 2) | ((r >> 2) & 3)));
    u32x4 kreg[4], qreg[4], vreg;
    {   const int tok0 = b * SEQ;
#pragma unroll
        for (int i = 0; i < 4; ++i) { const int p = tid + 512 * i, m = p >> 4, cc = p & 15; kreg[i] = *(const u32x4*)(rk + (size_t)(tok0 + m) * 512 + h * 128 + cc * 8); qreg[i] = *(const u32x4*)(rq + (size_t)(tok0 + m) * 512 + h * 128 + cc * 8); }
        { const int m = tid >> 2, cc = tid & 3; vreg = *(const u32x4*)(rv + (size_t)(tok0 + m) * 1024 + h * 256 + sl * 32 + cc * 8); } }
    u32x2 opk[4]; bf16* oprev = outbase;
#pragma unroll
    for (int i = 0; i < 4; ++i) opk[i] = (u32x2){0u, 0u};
    for (int c = 0; c < SEQ / 128; ++c) {
        const int tok0 = b * SEQ + c * 128;
        __syncthreads();
#pragma unroll
        for (int i = 0; i < 4; ++i) { const int p = tid + 512 * i, m = p >> 4, cc = p & 15; const int o_ = 256 * m + 16 * (cc ^ (((m & 3) << 2) | ((m >> 2) & 3)));
            *(LAS u32x4*)(lds + OFF_K + o_) = kreg[i]; *(LAS u32x4*)(lds + OFF_Q + o_) = qreg[i]; }
        { const u32x4 v = vreg; u32x4 zv;
            zv.x = cvt_pk_bf16(lo16(v.x) * zeta, hi16(v.x) * zeta); zv.y = cvt_pk_bf16(lo16(v.y) * zeta, hi16(v.y) * zeta); zv.z = cvt_pk_bf16(lo16(v.z) * zeta, hi16(v.z) * zeta); zv.w = cvt_pk_bf16(lo16(v.w) * zeta, hi16(v.w) * zeta);
            *(LAS u32x4*)(lds + OFF_V + tid * 16) = v; *(LAS u32x4*)(lds + OFF_ZV + tid * 16) = zv; }
        __syncthreads();
        if (mh == 0 && c > 0) {
#pragma unroll
            for (int i = 0; i < 4; ++i) *(u32x2*)(oprev + 8 * i + 4 * hi) = opk[i]; }
        if (c + 1 < SEQ / 128) { const int tok1 = tok0 + 128;
#pragma unroll
            for (int i = 0; i < 4; ++i) { const int p = tid + 512 * i, m = p >> 4, cc = p & 15; kreg[i] = *(const u32x4*)(rk + (size_t)(tok1 + m) * 512 + h * 128 + cc * 8); qreg[i] = *(const u32x4*)(rq + (size_t)(tok1 + m) * 512 + h * 128 + cc * 8); }
            { const int m = tid >> 2, cc = tid & 3; vreg = *(const u32x4*)(rv + (size_t)(tok1 + m) * 1024 + h * 256 + sl * 32 + cc * 8); } }
        bf16x8 qf[8];
#pragma unroll
        for (int s_ = 0; s_ < 8; ++s_) qf[s_] = *(const LAS bf16x8*)(lds + OFF_Q + 8192 * nt + (krow ^ (32 * s_)));
        f32x16 CR;
#pragma unroll
        for (int j = 0; j < 16; ++j) CR[j] = 0.f;
        if (mh == 0) {
#pragma unroll
            for (int s_ = 0; s_ < 8; ++s_) { const bf16x8 a = *(const LAS bf16x8*)(lds + OFF_ST + r * ROWB + (16 * s_ + 8 * hi) * 2); CR = __builtin_amdgcn_mfma_f32_32x32x16_bf16(a, qf[s_], CR, 0, 0, 0); }
        }
        f32x16 IN_;
#pragma unroll
        for (int j = 0; j < 16; ++j) IN_[j] = 0.f;
#pragma unroll
        for (int mi = 0; mi < 2; ++mi) { const int mt = 2 * mh + mi;
            if (mt <= nt) {
                f32x16 A;
#pragma unroll
                for (int j = 0; j < 16; ++j) A[j] = 0.f;
#pragma unroll
                for (int s_ = 0; s_ < 8; ++s_) { const bf16x8 a = *(const LAS bf16x8*)(lds + OFF_K + 8192 * mt + (krow ^ (32 * s_))); A = __builtin_amdgcn_mfma_f32_32x32x16_bf16(a, qf[s_], A, 0, 0, 0); }
#pragma unroll
                for (int j = 0; j < 16; ++j) { const int dd = (32 * nt + r) - (32 * mt + (j & 3) + 8 * (j >> 2) + 4 * hi); A[j] = dd >= 0 ? A[j] * __builtin_amdgcn_exp2f((float)dd * lg) : 0.f; }
#pragma unroll
                for (int s2 = 0; s2 < 2; ++s2) { u32x4 w; w.x = cvt_pk_bf16(A[8 * s2 + 0], A[8 * s2 + 1]); w.y = cvt_pk_bf16(A[8 * s2 + 2], A[8 * s2 + 3]); w.z = cvt_pk_bf16(A[8 * s2 + 4], A[8 * s2 + 5]); w.w = cvt_pk_bf16(A[8 * s2 + 6], A[8 * s2 + 7]);
                    const LAS unsigned char* vp = lds + OFF_V + vtr + (32 * mt + 16 * s2) * 64; const u32x2 lo = lds_tr(vp), hi2 = lds_tr(vp + 8 * 64);
                    IN_ = __builtin_amdgcn_mfma_f32_32x32x16_bf16(__builtin_bit_cast(bf16x8, (u32x4){lo.x, lo.y, hi2.x, hi2.y}), __builtin_bit_cast(bf16x8, w), IN_, 0, 0, 0); }
            } }
        if (mh == 1) {
#pragma unroll
            for (int j = 0; j < 16; ++j) ((LAS float*)(lds + OFF_PART))[(nt * 16 + j) * 64 + lane] = IN_[j];
        }
        __syncthreads();
        if (mh == 0) {
            const float xi = __builtin_amdgcn_exp2f((float)(32 * nt + r + 1) * lg);
            bf16* orow = outbase + (size_t)(tok0 + 32 * nt + r) * 1024 + h * 256 + sl * 32;
#pragma unroll
            for (int q4_ = 0; q4_ < 4; ++q4_) { float o_[4];
#pragma unroll
                for (int e = 0; e < 4; ++e) { const int j = 4 * q4_ + e; o_[e] = IN_[j] + ((const LAS float*)(lds + OFF_PART))[(nt * 16 + j) * 64 + lane] + xi * CR[j]; }
                opk[q4_] = (u32x2){cvt_pk_bf16(o_[0], o_[1]), cvt_pk_bf16(o_[2], o_[3])}; }
            oprev = orow;
        } else {
#pragma unroll
            for (int j = 0; j < 16; ++j) ST[j] *= gC;
#pragma unroll
            for (int s_ = 0; s_ < 8; ++s_) {
                const LAS unsigned char* zp = lds + OFF_ZV + ztr + (16 * s_) * 64; const u32x2 z0 = lds_tr(zp), z1 = lds_tr(zp + 4 * 64);
                const u32x2 k0 = lds_tr(lds + OFF_K + ktr[0] + 4096 * s_), k1 = lds_tr(lds + OFF_K + ktr[1] + 4096 * s_);
                ST = __builtin_amdgcn_mfma_f32_32x32x16_bf16(__builtin_bit_cast(bf16x8, (u32x4){z0.x, z0.y, z1.x, z1.y}), __builtin_bit_cast(bf16x8, (u32x4){k0.x, k0.y, k1.x, k1.y}), ST, 0, 0, 0); }
#pragma unroll
            for (int j = 0; j < 16; ++j) { const int dv = (j & 3) + 8 * (j >> 2) + 4 * hi; ((LAS unsigned short*)(lds + OFF_ST))[dv * (ROWB / 2) + 32 * nt + r] = (unsigned short)f2bf(ST[j]); }
        }
    }
    if (mh == 0) {
#pragma unroll
        for (int i = 0; i < 4; ++i) *(u32x2*)(oprev + 8 * i + 4 * hi) = opk[i]; }
    __syncthreads();
}
__device__ __forceinline__ void transpose_kv_tiles(Frame& F, const bf16* src, bf16* dst, int w0, int nw) {
    LAS unsigned short* tl_ = (LAS unsigned short*)(F.lds + F.wave * 16384); const int lane = F.lane;
    for (int tile = w0; tile < 16 * 64 * 2; tile += nw) {
        const int dh = tile & 1, st = (tile >> 1) & 63, bg = tile >> 7;
        const bf16* sp = src + ((size_t)bg * SEQ + st * 64) * 128 + dh * 64; bf16* dp = dst + ((size_t)bg * 128 + dh * 64) * SEQ + st * 64;
#pragma unroll
        for (int i = 0; i < 8; ++i) { const int row = i * 8 + (lane >> 3), c = lane & 7; const u32x4 v = *(const u32x4*)(sp + (size_t)row * 128 + c * 8); LAS unsigned short* q = tl_ + row * 66 + c * 8;
            q[0] = (unsigned short)(v.x & 0xffffu); q[1] = (unsigned short)(v.x >> 16); q[2] = (unsigned short)(v.y & 0xffffu); q[3] = (unsigned short)(v.y >> 16);
            q[4] = (unsigned short)(v.z & 0xffffu); q[5] = (unsigned short)(v.z >> 16); q[6] = (unsigned short)(v.w & 0xffffu); q[7] = (unsigned short)(v.w >> 16); }
        LDS_WAIT(); asm volatile("" ::: "memory");
#pragma unroll
        for (int i = 0; i < 8; ++i) { const int d = i * 8 + (lane >> 3), c = lane & 7; const LAS unsigned short* q = tl_ + (c * 8) * 66 + d;
            u32x4 o; o.x = (unsigned)q[0] | ((unsigned)q[66] << 16); o.y = (unsigned)q[2 * 66] | ((unsigned)q[3 * 66] << 16); o.z = (unsigned)q[4 * 66] | ((unsigned)q[5 * 66] << 16); o.w = (unsigned)q[6 * 66] | ((unsigned)q[7 * 66] << 16);
            *(u32x4*)(dp + (size_t)d * SEQ + c * 8) = o; }
        LDS_WAIT(); asm volatile("" ::: "memory");
    }
}
struct SchedCmp {
    unsigned char* ws; int first, G, c;
    __device__ __forceinline__ bool next(int i, GU& u) const {
        const int L = i * G + c - first; if (L < 0 || L >= 256) return false;
        const int ks = L & 7, mb = L >> 3, m = mb >> 4, bg = mb & 15;
        u.A = (const char*)ws + WS_KV6 + (size_t)m * KV_STRIDE + (size_t)bg * SEQ * 128 * 2 + (size_t)ks * 512 * 2; u.B = (const char*)ws + (m ? W_C1V : W_C1K) + (size_t)ks * 512 * 2;
        u.pm = mb; u.pn = 0; u.kind = ks; u.rows = nullptr; u.nvalid = 0; u.aux = 0; return true;
    }
};
struct EpiCmp {
    static constexpr bool PERM = false;
    float* hid;
    __device__ __forceinline__ void operator()(const f32x4 (&acc)[2][2][4][2], const GU& u, int wr, int wc, int fr, int fq) const {
#pragma unroll
        for (int ai = 0; ai < 2; ++ai)
#pragma unroll
            for (int m = 0; m < 4; ++m) { const int r = 128 * ai + 64 * wr + 16 * m + fr; float* rowp = hid + (size_t)u.kind * (32 * 256 * 128) + ((size_t)u.pm * 256 + r) * 128 + 32 * wc + 4 * fq;
#pragma unroll
                for (int n = 0; n < 2; ++n) *(f32x4*)(rowp + 16 * n) = acc[ai][0][m][n]; }
    }
};
__device__ __forceinline__ float gelu_tanh(float x) { const float u = 0.7978845608028654f * (x + 0.044715f * x * x * x); return 0.5f * x * (1.0f + tanhf(u)); }
__device__ __forceinline__ void p2b_compress_out(Frame& F, const Args& a) {
    const float* hid = (const float*)a.out + (size_t)16 * MiB; const float* cbias = (const float*)(F.ws + WS_SMALLW + 65536 + 2 * 128 * 128 * 2);
    const int gw = F.bx * NWAVES + F.wave, NGW = F.G * NWAVES;
    for (int row = gw; row < 2 * 16 * 256; row += NGW) {
        const int m = row >> 12, n = row & 255; const float* w2 = a.in[m ? IN_CMP_W2_V : IN_CMP_W2_K];
        bf16* dst = (bf16*)(F.ws + (m ? WS_VCMP : WS_KCMP)) + (size_t)(row & 4095) * 128;
        float o0 = 0.f, o1 = 0.f;
        if (n < 255) { const float* hr = hid + (size_t)row * 128;
            for (int e = 0; e < 128; ++e) { float hsum = 0.f;
#pragma unroll
                for (int ks = 0; ks < 8; ++ks) hsum += hr[(size_t)ks * (32 * 256 * 128) + e];
                const float g = gelu_tanh(hsum + cbias[m * 128 + e]); o0 += g * w2[e * 128 + F.lane]; o1 += g * w2[e * 128 + 64 + F.lane]; } }
        dst[F.lane] = (bf16)f2bf(o0); dst[64 + F.lane] = (bf16)f2bf(o1);
        if (m == 1) { bf16* dt = (bf16*)(F.ws + WS_VCMPT) + (size_t)((row >> 8) & 15) * 128 * 256 + n; dt[(size_t)F.lane * 256] = (bf16)f2bf(o0); dt[(size_t)(64 + F.lane) * 256] = (bf16)f2bf(o1); }
    }
}

__device__ __forceinline__ void p3_ret_normalize(Frame& F) {
    bf16* rv = (bf16*)(F.ws + WS_RV); const bf16* rg = (const bf16*)(F.ws + WS_RG);
    const int gw = F.bx * NWAVES + F.wave, NGW = F.G * NWAVES;
    for (int it = gw; it < NTOK * 4; it += NGW) {
        u32x2* p = (u32x2*)(rv + (size_t)it * 256) + F.lane; const u32x2 w = *p; const u32x2 gq = *((const u32x2*)(rg + (size_t)it * 256) + F.lane);
        const float o0 = lo16(w.x), o1 = hi16(w.x), o2 = lo16(w.y), o3 = hi16(w.y);
        const float ss = wave_sum((o0 * o0 + o1 * o1) + (o2 * o2 + o3 * o3));
        const float r = 1.0f / sqrtf(ss * (1.0f / 256.0f) + EPS);
        u32x2 q; q.x = pk2(o0 * r * lo16(gq.x), o1 * r * hi16(gq.x)); q.y = pk2(o2 * r * lo16(gq.y), o3 * r * hi16(gq.y)); *p = q;
    }
}
namespace nsaf {
constexpr int KROW = 272, VROW = 136, KT_BYTES = 64 * KROW, VT_BYTES = 128 * VROW;
constexpr int OFF_K = 0, OFF_V = KT_BYTES, BUF_BYTES = KT_BYTES + VT_BYTES, OFF_IMP = 2 * BUF_BYTES, OFF_MASK = OFF_IMP + 64 * 64 * 4;
constexpr float NEG = -1.0e30f, MASKED = -3.0e38f, CS = 0.08838834764831845f * 1.4426950408889634f;
struct Stage { u32x4 k0, k1, v0, v1; };
__device__ __forceinline__ void stage_load(Stage& st, const bf16* K, const bf16* VT, size_t vpitch, int key0, int tid) {
    const int r0 = tid >> 4, c0 = tid & 15;
    st.k0 = *(const u32x4*)(K + (size_t)(key0 + r0) * 128 + c0 * 8); st.k1 = *(const u32x4*)(K + (size_t)(key0 + r0 + 32) * 128 + c0 * 8);
    const int d0 = tid >> 3, c1 = tid & 7;
    st.v0 = *(const u32x4*)(VT + (size_t)d0 * vpitch + key0 + c1 * 8); st.v1 = *(const u32x4*)(VT + (size_t)(d0 + 64) * vpitch + key0 + c1 * 8);
}
__device__ __forceinline__ void stage_write(const Stage& st, LAS unsigned char* lds, int tid) {
    const int r0 = tid >> 4, c0 = tid & 15;
    *(LAS u32x4*)(lds + OFF_K + r0 * KROW + c0 * 16) = st.k0; *(LAS u32x4*)(lds + OFF_K + (r0 + 32) * KROW + c0 * 16) = st.k1;
    const int d0 = tid >> 3, c1 = tid & 7;
    LAS unsigned char* p0 = lds + OFF_V + d0 * VROW + c1 * 16; LAS unsigned char* p1 = lds + OFF_V + (d0 + 64) * VROW + c1 * 16;
    *(LAS u32x2*)p0 = (u32x2){st.v0.x, st.v0.y}; *(LAS u32x2*)(p0 + 8) = (u32x2){st.v0.z, st.v0.w};
    *(LAS u32x2*)p1 = (u32x2){st.v1.x, st.v1.y}; *(LAS u32x2*)(p1 + 8) = (u32x2){st.v1.z, st.v1.w};
}
template <int MODE>
__device__ __forceinline__ void block_step(const LAS unsigned char* lds, LAS unsigned char* ldstab, const bf16x8 (&qf)[8], f32x16 (&O)[4], float& m, float& l, int blk, int jfast, int tl_in, int itile, int nvr_in, bool rowsel, float inv_l, int lane_in) {
    int tl = tl_in, nvr = nvr_in, lane = lane_in; LAUNDER(tl); LAUNDER(nvr); LAUNDER(lane);
    const int r = lane & 31, hi = lane >> 5;
    f32x16 S[2];
#pragma unroll
    for (int kh = 0; kh < 2; ++kh) {
#pragma unroll
        for (int j = 0; j < 16; ++j) S[kh][j] = 0.f;
    }
    {
        const unsigned kaddr = (unsigned)(size_t)(lds + OFF_K + r * KROW + 16 * hi);
        u32x4 ka[4], kb[4];
#define NSAF_KRD(dst, t, s4) asm volatile("ds_read_b128 %0, %1 offset:%2" : "=v"(dst) : "v"(kaddr), "i"((t) * 32 * KROW + (s4) * 32))
#define NSAF_KRD4(set, t, s0) do { NSAF_KRD(set[0], t, (s0)); NSAF_KRD(set[1], t, (s0) + 1); NSAF_KRD(set[2], t, (s0) + 2); NSAF_KRD(set[3], t, (s0) + 3); } while (0)
#define NSAF_KWAIT(n, set) asm volatile("s_waitcnt lgkmcnt(" #n ")" : "+v"(set[0]), "+v"(set[1]), "+v"(set[2]), "+v"(set[3]))
#define NSAF_KMMA(set, t, s0) do { _Pragma("unroll") for (int q_ = 0; q_ < 4; ++q_) S[t] = __builtin_amdgcn_mfma_f32_32x32x16_bf16(__builtin_bit_cast(bf16x8, set[q_]), qf[(s0) + q_], S[t], 0, 0, 0); } while (0)
        NSAF_KRD4(ka, 0, 0); NSAF_KRD4(kb, 0, 4);
        NSAF_KWAIT(4, ka); NSAF_KMMA(ka, 0, 0); NSAF_KRD4(ka, 1, 0);
        NSAF_KWAIT(4, kb); NSAF_KMMA(kb, 0, 4); NSAF_KRD4(kb, 1, 4);
        NSAF_KWAIT(4, ka); NSAF_KMMA(ka, 1, 0);
        NSAF_KWAIT(0, kb); NSAF_KMMA(kb, 1, 4);
#undef NSAF_KRD
#undef NSAF_KRD4
#undef NSAF_KWAIT
#undef NSAF_KMMA
    }
    bool need_mask;
    if (MODE <= 1) need_mask = true; else if (MODE == 2) need_mask = (blk == itile); else need_mask = (blk == itile) || (blk == itile - 8);
    if (MODE >= 2 && !need_mask && blk >= jfast) {
        const float msub = (MODE == 2 && !rowsel) ? 3.0e38f : m;
        float rs = 0.f;
#pragma unroll
        for (int kh = 0; kh < 2; ++kh)
#pragma unroll
            for (int j = 0; j < 16; ++j) { const float p = __builtin_amdgcn_exp2f(S[kh][j] - msub); S[kh][j] = p; rs += p; }
        l += rs;
    } else {
    float mx = MASKED;
    if (need_mask) {
        int lo_ = -1, hi_ = 63;
        if (MODE <= 1) hi_ = nvr - 64 * blk - 1; else if (MODE == 2) hi_ = tl; else { hi_ = (blk == itile) ? tl : 63; lo_ = (blk == itile - 8) ? tl : -1; }
        lo_ -= 4 * hi; hi_ -= 4 * hi;
#pragma unroll
        for (int kh = 0; kh < 2; ++kh)
#pragma unroll
            for (int j = 0; j < 16; ++j) { const int kc_ = 32 * kh + (j & 3) + 8 * (j >> 2); const bool ok = (kc_ > lo_) & (kc_ <= hi_); const float v = ok ? S[kh][j] : MASKED; S[kh][j] = v; mx = fmaxf(mx, v); }
    } else {
#pragma unroll
        for (int kh = 0; kh < 2; ++kh)
#pragma unroll
            for (int j = 0; j < 16; ++j) mx = fmaxf(mx, S[kh][j]);
    }
    if (MODE == 2) mx = rowsel ? mx : MASKED;
    if (MODE == 1) {
        LAS float* imp = (LAS float*)(ldstab + OFF_IMP) + tl * 64;
#pragma unroll
        for (int kh = 0; kh < 2; ++kh)
#pragma unroll
            for (int j = 0; j < 16; ++j) { const int n = 64 * blk + 32 * kh + (j & 3) + 8 * (j >> 2) + 4 * hi; const float v = S[kh][j]; const float p = __builtin_amdgcn_exp2f(v - m) * inv_l; S[kh][j] = p;
                if (v > 0.5f * MASKED) { __hip_atomic_fetch_add(imp + (n >> 2), p, __ATOMIC_RELAXED, __HIP_MEMORY_SCOPE_WORKGROUP); if ((n & 3) == 3 && (n >> 2) + 1 < 64) __hip_atomic_fetch_add(imp + (n >> 2) + 1, p, __ATOMIC_RELAXED, __HIP_MEMORY_SCOPE_WORKGROUP); } }
    } else {
        mx = fmaxf(mx, __shfl_xor(mx, 32));
        if (__any(mx > m + 8.0f)) { const float mn = fmaxf(m, mx); const float alpha = __builtin_amdgcn_exp2f(m - mn); m = mn; l *= alpha;
            if (MODE != 0) {
#pragma unroll
                for (int dt = 0; dt < 4; ++dt)
#pragma unroll
                    for (int j = 0; j < 16; ++j) O[dt][j] *= alpha; } }
        float rs = 0.f;
        if (MODE == 2) {
#pragma unroll
            for (int kh = 0; kh < 2; ++kh)
#pragma unroll
                for (int j = 0; j < 16; ++j) { const float p = rowsel ? __builtin_amdgcn_exp2f(S[kh][j] - m) : 0.f; S[kh][j] = p; rs += p; }
        } else {
#pragma unroll
            for (int kh = 0; kh < 2; ++kh)
#pragma unroll
                for (int j = 0; j < 16; ++j) { const float p = __builtin_amdgcn_exp2f(S[kh][j] - m); S[kh][j] = p; rs += p; }
        }
        l += rs;
        if (MODE == 0) return;
    }
    }
    bf16x8 pf[2][2];
#pragma unroll
    for (int kh = 0; kh < 2; ++kh)
#pragma unroll
        for (int s2 = 0; s2 < 2; ++s2) { u32x4 w; w.x = cvt_pk_bf16(S[kh][8 * s2 + 0], S[kh][8 * s2 + 1]); w.y = cvt_pk_bf16(S[kh][8 * s2 + 2], S[kh][8 * s2 + 3]); w.z = cvt_pk_bf16(S[kh][8 * s2 + 4], S[kh][8 * s2 + 5]); w.w = cvt_pk_bf16(S[kh][8 * s2 + 6], S[kh][8 * s2 + 7]);
            pf[kh][s2] = __builtin_bit_cast(bf16x8, w); }
    {
        const unsigned vaddr = (unsigned)(size_t)(lds + OFF_V + r * VROW + 8 * hi);
        u32x2 va[8], vb[8];
#define NSAF_VRD(dst, dt, i) asm volatile("ds_read_b64 %0, %1 offset:%2" : "=v"(dst) : "v"(vaddr), "i"((dt) * 32 * VROW + ((i) >> 1) * 32 + ((i) & 1) * 16))
#define NSAF_VRD8(set, dt) do { NSAF_VRD(set[0], dt, 0); NSAF_VRD(set[1], dt, 1); NSAF_VRD(set[2], dt, 2); NSAF_VRD(set[3], dt, 3); NSAF_VRD(set[4], dt, 4); NSAF_VRD(set[5], dt, 5); NSAF_VRD(set[6], dt, 6); NSAF_VRD(set[7], dt, 7); } while (0)
#define NSAF_VWAIT(n, set) asm volatile("s_waitcnt lgkmcnt(" #n ")" : "+v"(set[0]), "+v"(set[1]), "+v"(set[2]), "+v"(set[3]), "+v"(set[4]), "+v"(set[5]), "+v"(set[6]), "+v"(set[7]))
#define NSAF_VMMA(set, dt) do { _Pragma("unroll") for (int ks = 0; ks < 4; ++ks) { const u32x4 a_ = (u32x4){set[2 * ks].x, set[2 * ks].y, set[2 * ks + 1].x, set[2 * ks + 1].y}; \
            O[dt] = __builtin_amdgcn_mfma_f32_32x32x16_bf16(__builtin_bit_cast(bf16x8, a_), pf[ks >> 1][ks & 1], O[dt], 0, 0, 0); } } while (0)
        NSAF_VRD8(va, 0); NSAF_VRD8(vb, 1);
        NSAF_VWAIT(8, va); NSAF_VMMA(va, 0); NSAF_VRD8(va, 2);
        NSAF_VWAIT(8, vb); NSAF_VMMA(vb, 1); NSAF_VRD8(vb, 3);
        NSAF_VWAIT(8, va); NSAF_VMMA(va, 2);
        NSAF_VWAIT(0, vb); NSAF_VMMA(vb, 3);
#undef NSAF_VRD
#undef NSAF_VRD8
#undef NSAF_VWAIT
#undef NSAF_VMMA
    }
}
template <int MODE>
__device__ __forceinline__ void run_pass(LAS unsigned char* lds, const bf16* K, const bf16* VT, size_t vpitch, int jb, int je, const bf16x8 (&qf)[8], f32x16 (&O)[4], float& m, float& l, bool allowfast, int tl, int itile, int nvr, unsigned long long selmask, float inv_l, int tid, int lane) {
    Stage st; stage_load(st, K, VT, vpitch, jb * 64, tid); stage_write(st, lds, tid);
    if (jb < je) stage_load(st, K, VT, vpitch, (jb + 1) * 64, tid);
    __syncthreads();
    for (int j = jb; j <= je; ++j) {
        const int cur = (j - jb) & 1;
        if (j < je) { stage_write(st, lds + (cur ^ 1) * BUF_BYTES, tid); if (j + 1 < je) stage_load(st, K, VT, vpitch, (j + 2) * 64, tid); }
        const bool rowsel = (MODE == 2) ? (((selmask >> j) & 1ull) != 0ull) : true;
        if (MODE != 2 || __ballot(rowsel) != 0ull) block_step<MODE>(lds + cur * BUF_BYTES, lds, qf, O, m, l, j, allowfast ? jb + (MODE == 2 ? 1 : 2) : 0x7fffffff, tl, itile, nvr, rowsel, inv_l, lane);
        __syncthreads();
    }
}
}
__device__ __forceinline__ void p3_nsa_fast(Frame& F, const bf16* svT, const bf16* wvT, bf16* outbase) {
    using namespace nsaf;
    unsigned char* ws = F.ws; const int tid = F.tid, lane = F.lane, wave = F.wave; LAS unsigned char* lds = F.lds;
    bf16* nq = (bf16*)(ws + WS_NQ); const float* gates = (const float*)(ws + WS_GATES);
    const int r = lane & 31, hi = lane >> 5, qrow = wave * 32 + r, tl = qrow >> 2, head = qrow & 3;
    unsigned failmask = 0u;
    for (int trip = 0; trip < 2; ++trip) {
    for (int u4 = 0; u4 < 4; ++u4) {
        if (trip == 1 && ((failmask >> u4) & 1u) == 0u) continue;
        const bool allowfast = trip == 0;
        const int pr = (F.bx & 7) * 32 + (F.bx >> 3) + (u4 >> 1) * 256; if (F.bx >= 256) break;
        const int bg = pr >> 5, ii = pr & 31, itile = (u4 & 1) ? (63 - ii) : ii, g = bg & 1, b = bg >> 1;
        const int tok = b * SEQ + itile * 64 + tl, t = itile * 64 + tl;
        const bf16* kc = (const bf16*)(ws + WS_KCMP) + (size_t)bg * 256 * 128; const bf16* vcT = (const bf16*)(ws + WS_VCMPT) + (size_t)bg * 128 * 256;
        const bf16* ks = (const bf16*)(ws + WS_KV6 + 2 * KV_STRIDE) + (size_t)bg * SEQ * 128; const bf16* kw = (const bf16*)(ws + WS_KV6 + 4 * KV_STRIDE) + (size_t)bg * SEQ * 128;
        const bf16* vsT = svT + (size_t)bg * 128 * SEQ; const bf16* vwT = wvT + (size_t)bg * 128 * SEQ;
        __syncthreads();
        for (int i = tid; i < 64 * 64; i += NTHREADS) ((LAS float*)(lds + OFF_IMP))[i] = 0.f;
        bf16x8 qf[8]; bf16* qrowp = nq + (size_t)tok * 1024 + g * 512 + head * 128; bf16* orowp = outbase + (size_t)tok * 1024 + g * 512 + head * 128;
#pragma unroll
        for (int s_ = 0; s_ < 8; ++s_) { const u32x4 w_ = *(const u32x4*)(qrowp + 16 * s_ + 8 * hi);
            u32x4 o_; o_.x = cvt_pk_bf16(lo16(w_.x) * CS, hi16(w_.x) * CS); o_.y = cvt_pk_bf16(lo16(w_.y) * CS, hi16(w_.y) * CS); o_.z = cvt_pk_bf16(lo16(w_.z) * CS, hi16(w_.z) * CS); o_.w = cvt_pk_bf16(lo16(w_.w) * CS, hi16(w_.w) * CS);
            qf[s_] = __builtin_bit_cast(bf16x8, o_); }
        const float* gatep = gates + (size_t)tok * 24 + (g * 4 + head) * 3;
        const int nvr = (t >= 31) ? (((t - 31) >> 4) + 1 > 255 ? 255 : ((t - 31) >> 4) + 1) : 0;
        const int jec = ((4 * itile + 2) >> 6) > 3 ? 3 : ((4 * itile + 2) >> 6);
        f32x16 O[4];
#define NSAF_ZERO_O() do { _Pragma("unroll") for (int dt = 0; dt < 4; ++dt) _Pragma("unroll") for (int j = 0; j < 16; ++j) O[dt][j] = 0.f; } while (0)
#define NSAF_ACCUM(coef, FIRST) do { const float cf_ = (coef); _Pragma("unroll") for (int dt = 0; dt < 4; ++dt) { _Pragma("unroll") for (int q4 = 0; q4 < 4; ++q4) { u32x2* p_ = (u32x2*)(orowp + 32 * dt + 8 * q4 + 4 * hi); \
            float a0_ = cf_ * O[dt][4 * q4], a1_ = cf_ * O[dt][4 * q4 + 1], a2_ = cf_ * O[dt][4 * q4 + 2], a3_ = cf_ * O[dt][4 * q4 + 3]; \
            if (!(FIRST)) { const u32x2 o_ = *p_; a0_ += lo16(o_.x); a1_ += hi16(o_.x); a2_ += lo16(o_.y); a3_ += hi16(o_.y); } \
            *p_ = (u32x2){cvt_pk_bf16(a0_, a1_), cvt_pk_bf16(a2_, a3_)}; } asm volatile("" ::: "memory"); } } while (0)
        float m = NEG, l = 0.f; NSAF_ZERO_O();
        run_pass<0>(lds, kc, vcT, 256, 0, jec, qf, O, m, l, false, tl, itile, nvr, 0ull, 0.f, tid, lane);
        l += __shfl_xor(l, 32); const float invl = l > 0.f ? 1.0f / l : 0.f;
        run_pass<1>(lds, kc, vcT, 256, 0, jec, qf, O, m, l, false, tl, itile, nvr, 0ull, invl, tid, lane);
        NSAF_ACCUM(gatep[0], true);
        __syncthreads();
        for (int tk = 0; tk < 8; ++tk) { const int tokl = wave * 8 + tk; float v = ((const LAS float*)(lds + OFF_IMP))[tokl * 64 + lane];
            const bool forced = (lane == 0) || (lane == itile) || (lane == itile - 1); v = (lane > itile) ? -1.0e4f : (forced ? 1.0e4f : v);
            int rank = 0;
#pragma unroll 16
            for (int i = 0; i < 64; ++i) { const float w = __builtin_bit_cast(float, __builtin_amdgcn_readlane(__builtin_bit_cast(int, v), i)); rank += (w > v || (w == v && i < lane)) ? 1 : 0; }
            const unsigned long long mk = __ballot(rank < 16);
            if (lane == 0) { ((LAS unsigned*)(lds + OFF_MASK))[tokl * 2] = (unsigned)mk; ((LAS unsigned*)(lds + OFF_MASK))[tokl * 2 + 1] = (unsigned)(mk >> 32); } }
        __syncthreads();
        const unsigned long long selmask = (unsigned long long)((const LAS unsigned*)(lds + OFF_MASK))[tl * 2] | ((unsigned long long)((const LAS unsigned*)(lds + OFF_MASK))[tl * 2 + 1] << 32);
        m = NEG; l = 0.f; NSAF_ZERO_O();
        run_pass<2>(lds, ks, vsT, SEQ, 0, itile, qf, O, m, l, allowfast, tl, itile, 0, selmask, 0.f, tid, lane);
        l += __shfl_xor(l, 32); bool bad = !(l < 1.0e12f);
        NSAF_ACCUM(l > 0.f ? gatep[1] / l : 0.f, false);
        m = NEG; l = 0.f; NSAF_ZERO_O();
        run_pass<3>(lds, kw, vwT, SEQ, itile > 8 ? itile - 8 : 0, itile, qf, O, m, l, allowfast, tl, itile, 0, 0ull, 0.f, tid, lane);
        l += __shfl_xor(l, 32); bad = bad | !(l < 1.0e12f);
        NSAF_ACCUM(l > 0.f ? gatep[2] / l : 0.f, false);
        if (allowfast && __syncthreads_or(bad ? 1 : 0)) failmask |= 1u << u4;
#undef NSAF_ZERO_O
#undef NSAF_ACCUM
    }
    if (failmask == 0u) break;
    }
    __syncthreads();
}
struct SchedP4 {
    unsigned char* ws; int G, c;
    __device__ __forceinline__ bool next(int i, GU& u) const {
        const int ti = i >> 2, sub = i & 3; const int L = ti * G + c; if (L >= 128 * 4) return false;
        int pm, pn; pg8::tile_map(L, 128, 4, pm, pn);
        const size_t ao = sub == 1 ? WS_RV : sub == 3 ? WS_NQ : WS_H; const size_t bo = sub == 0 ? W_GA : sub == 1 ? W_RO : sub == 2 ? W_GB : W_NO;
        u.A = (const char*)ws + ao + (size_t)pm * 256 * D * 2; u.B = (const char*)ws + bo + (size_t)pn * 256 * D * 2; u.pm = pm; u.pn = pn; u.kind = sub; u.rows = nullptr; u.nvalid = 0; u.aux = 0; return true;
    }
};
struct EpiP4 {
    static constexpr bool PERM = true;
    float* scr;
    bf16* Y;
    static __device__ __forceinline__ u32x2 pk4(const f32x4 v) { return (u32x2){cvt_pk_bf16(v[0], v[1]), cvt_pk_bf16(v[2], v[3])}; }
    static __device__ __forceinline__ f32x4 up4(const u32x2 w) { return (f32x4){lo16(w.x), hi16(w.x), lo16(w.y), hi16(w.y)}; }
    __device__ __forceinline__ void operator()(const f32x4 (&acc)[2][2][4][2], const GU& u, int wr, int wc, int fr, int fq) const {
        u32x2* p0 = (u32x2*)scr + threadIdx.x; u32x2* p1 = p0 + 32 * 512;
        if (u.kind == 0 || u.kind == 2) {
            u32x2* p = u.kind == 0 ? p0 : p1;
#pragma unroll
            for (int ai = 0; ai < 2; ++ai)
#pragma unroll
                for (int m = 0; m < 4; ++m) {
#pragma unroll
                    for (int bj = 0; bj < 2; ++bj) { f32x4 v0 = acc[ai][bj][m][0], v1 = acc[ai][bj][m][1];
#pragma unroll
                        for (int j = 0; j < 4; ++j) { v0[j] = sigmoidf_(v0[j]); v1[j] = sigmoidf_(v1[j]); }
                        p[(2 * bj) * 512] = pk4(v0); p[(2 * bj + 1) * 512] = pk4(v1); }
                    p += 4 * 512; LAUNDER(p); }
        } else if (u.kind == 1) {
#pragma unroll
            for (int ai = 0; ai < 2; ++ai)
#pragma unroll
                for (int m = 0; m < 4; ++m) {
#pragma unroll
                    for (int bj = 0; bj < 2; ++bj) { p0[(2 * bj) * 512] = pk4(up4(p0[(2 * bj) * 512]) * acc[ai][bj][m][0]); p0[(2 * bj + 1) * 512] = pk4(up4(p0[(2 * bj + 1) * 512]) * acc[ai][bj][m][1]); }
                    p0 += 4 * 512; LAUNDER(p0); }
        } else {
            bf16* yb = Y + (size_t)(u.pm * 256 + 64 * wr + fr) * D + u.pn * 256 + 32 * wc + 8 * fq;
#pragma unroll
            for (int ai = 0; ai < 2; ++ai)
#pragma unroll
                for (int m = 0; m < 4; ++m) {
#pragma unroll
                    for (int bj = 0; bj < 2; ++bj) {
                        const f32x4 v0 = up4(p0[(2 * bj) * 512]) + up4(p1[(2 * bj) * 512]) * acc[ai][bj][m][0], v1 = up4(p0[(2 * bj + 1) * 512]) + up4(p1[(2 * bj + 1) * 512]) * acc[ai][bj][m][1];
                        u32x4 w; w.x = cvt_pk_bf16(v0[0], v0[1]); w.y = cvt_pk_bf16(v0[2], v0[3]); w.z = cvt_pk_bf16(v1[0], v1[1]); w.w = cvt_pk_bf16(v1[2], v1[3]);
                        *(u32x4*)(yb + (size_t)(128 * ai + 16 * m) * D + 128 * bj) = w; }
                    p0 += 4 * 512; p1 += 4 * 512; LAUNDER(p0); LAUNDER(p1); }
        }
    }
};

struct SchedMN {
    unsigned char* ws; size_t ao, bo; int G, c;
    __device__ __forceinline__ bool next(int i, GU& u) const {
        const int L = i * G + c; if (L >= 128 * 4) return false; int pm, pn; pg8::tile_map(L, 128, 4, pm, pn);
        u.A = (const char*)ws + ao + (size_t)pm * 256 * D * 2; u.B = (const char*)ws + bo + (size_t)pn * 256 * D * 2; u.pm = pm; u.pn = pn; u.kind = 0; u.rows = nullptr; u.nvalid = 0; u.aux = 0; return true;
    }
};
template <bool SSQ> struct EpiRes {
    static constexpr bool PERM = false;
    const float* basef; const bf16* baseb; float* out; bf16* ob; float* ssq;
    __device__ __forceinline__ void operator()(const f32x4 (&acc)[2][2][4][2], const GU& u, int wr, int wc, int fr, int fq) const {
#pragma unroll
        for (int ai = 0; ai < 2; ++ai)
#pragma unroll
            for (int m = 0; m < 4; ++m) { const int r = u.pm * 256 + 128 * ai + 64 * wr + 16 * m + fr; const size_t off = (size_t)r * D + u.pn * 256 + 32 * wc + 4 * fq; float sq = 0.f;
#pragma unroll
                for (int bj = 0; bj < 2; ++bj)
#pragma unroll
                    for (int n = 0; n < 2; ++n) { const size_t o = off + 128 * bj + 16 * n; f32x4 bv;
                        if (SSQ) bv = *(const f32x4*)(basef + o); else { const u32x2 bw = *(const u32x2*)(baseb + o); bv = (f32x4){lo16(bw.x), hi16(bw.x), lo16(bw.y), hi16(bw.y)}; }
                        const f32x4 v = bv + acc[ai][bj][m][n];
                        if (!SSQ) *(f32x4*)(out + o) = v;
                        u32x2 w; w.x = cvt_pk_bf16(v[0], v[1]); w.y = cvt_pk_bf16(v[2], v[3]); *(u32x2*)(ob + o) = w; sq += (v[0] * v[0] + v[1] * v[1]) + (v[2] * v[2] + v[3] * v[3]); }
                if (SSQ) { sq += __shfl_xor(sq, 16); sq += __shfl_xor(sq, 32); if (fq == 0) ssq[(size_t)r * 16 + u.pn * 4 + wc] = sq; }
            }
    }
};
struct EpiQ {
    static constexpr bool PERM = true;
    const float* ssq; bf16* Q;
    __device__ __forceinline__ void operator()(const f32x4 (&acc)[2][2][4][2], const GU& u, int wr, int wc, int fr, int fq) const {
#pragma unroll
        for (int ai = 0; ai < 2; ++ai)
#pragma unroll
            for (int m = 0; m < 4; ++m) { const int r = u.pm * 256 + 128 * ai + 64 * wr + 16 * m + fr; const f32x4* sp = (const f32x4*)(ssq + (size_t)r * 16);
                const f32x4 a = sp[0], b = sp[1], c = sp[2], d = sp[3]; const float tot = ((a[0] + a[1]) + (a[2] + a[3])) + ((b[0] + b[1]) + (b[2] + b[3])) + ((c[0] + c[1]) + (c[2] + c[3])) + ((d[0] + d[1]) + (d[2] + d[3]));
                const float rstd = 1.0f / sqrtf(tot * (1.0f / D) + EPS);
#pragma unroll
                for (int bj = 0; bj < 2; ++bj) { const f32x4 v0 = acc[ai][bj][m][0] * rstd, v1 = acc[ai][bj][m][1] * rstd;
                    u32x4 w; w.x = cvt_pk_bf16(v0[0], v0[1]); w.y = cvt_pk_bf16(v0[2], v0[3]); w.z = cvt_pk_bf16(v1[0], v1[1]); w.w = cvt_pk_bf16(v1[2], v1[3]);
                    *(u32x4*)(Q + (size_t)r * D + u.pn * 256 + 128 * bj + 32 * wc + 8 * fq) = w; } }
    }
};

namespace xatf {
constexpr int KROW = 528, VROW = 136, KT_BYTES = 64 * KROW, OFF_K = 0, OFF_V = KT_BYTES;
constexpr float NEG = -1.0e30f, CS = 0.0625f * 1.4426950408889634f;
struct Stage { u32x4 k[4]; u32x4 v[2]; };
__device__ __forceinline__ void stage_load(Stage& st, const bf16* K, const bf16* VT, int key0, int tid) {
#pragma unroll
    for (int i = 0; i < 4; ++i) { const int p = tid + 512 * i, row = p >> 5, c = p & 31; st.k[i] = *(const u32x4*)(K + (size_t)(key0 + row) * 2048 + c * 8); }
#pragma unroll
    for (int i = 0; i < 2; ++i) { const int p = tid + 512 * i, d = p >> 3, c = p & 7; st.v[i] = *(const u32x4*)(VT + (size_t)d * 256 + key0 + c * 8); }
}
__device__ __forceinline__ void stage_write(const Stage& st, LAS unsigned char* lds, int tid) {
#pragma unroll
    for (int i = 0; i < 4; ++i) { const int p = tid + 512 * i, row = p >> 5, c = p & 31; *(LAS u32x4*)(lds + OFF_K + row * KROW + c * 16) = st.k[i]; }
#pragma unroll
    for (int i = 0; i < 2; ++i) { const int p = tid + 512 * i, d = p >> 3, c = p & 7; LAS unsigned char* q = lds + OFF_V + d * VROW + c * 16;
        *(LAS u32x2*)q = (u32x2){st.v[i].x, st.v[i].y}; *(LAS u32x2*)(q + 8) = (u32x2){st.v[i].z, st.v[i].w}; }
}
__device__ __forceinline__ void block_step(const LAS unsigned char* lds, const bf16x8 (&qf)[16], f32x16 (&O)[4], float& m, float& l, int lane) {
    const int r = lane & 31, hi = lane >> 5;
    f32x16 S[2];
#pragma unroll
    for (int kh = 0; kh < 2; ++kh) {
#pragma unroll
        for (int j = 0; j < 16; ++j) S[kh][j] = 0.f;
#pragma unroll
        for (int s_ = 0; s_ < 16; ++s_) { const bf16x8 a = *(const LAS bf16x8*)(lds + OFF_K + (kh * 32 + r) * KROW + (16 * s_ + 8 * hi) * 2); S[kh] = __builtin_amdgcn_mfma_f32_32x32x16_bf16(a, qf[s_], S[kh], 0, 0, 0); }
    }
    float mx = NEG;
#pragma unroll
    for (int kh = 0; kh < 2; ++kh)
#pragma unroll
        for (int j = 0; j < 16; ++j) { const float v = S[kh][j] * CS; S[kh][j] = v; mx = fmaxf(mx, v); }
    mx = fmaxf(mx, __shfl_xor(mx, 32));
    const float mn = fmaxf(m, mx); const float alpha = __builtin_amdgcn_exp2f(m - mn); m = mn; float rs = 0.f;
#pragma unroll
    for (int kh = 0; kh < 2; ++kh)
#pragma unroll
        for (int j = 0; j < 16; ++j) { const float p = __builtin_amdgcn_exp2f(S[kh][j] - mn); S[kh][j] = p; rs += p; }
    l = l * alpha + rs;
#pragma unroll
    for (int dt = 0; dt < 4; ++dt)
#pragma unroll
        for (int j = 0; j < 16; ++j) O[dt][j] *= alpha;
    bf16x8 pf[2][2];
#pragma unroll
    for (int kh = 0; kh < 2; ++kh)
#pragma unroll
        for (int s2 = 0; s2 < 2; ++s2) { u32x4 w; w.x = cvt_pk_bf16(S[kh][8 * s2 + 0], S[kh][8 * s2 + 1]); w.y = cvt_pk_bf16(S[kh][8 * s2 + 2], S[kh][8 * s2 + 3]); w.z = cvt_pk_bf16(S[kh][8 * s2 + 4], S[kh][8 * s2 + 5]); w.w = cvt_pk_bf16(S[kh][8 * s2 + 6], S[kh][8 * s2 + 7]);
            pf[kh][s2] = __builtin_bit_cast(bf16x8, w); }
#pragma unroll
    for (int dt = 0; dt < 4; ++dt)
#pragma unroll
        for (int kh = 0; kh < 2; ++kh)
#pragma unroll
            for (int s2 = 0; s2 < 2; ++s2) { const LAS unsigned char* vp = lds + OFF_V + (dt * 32 + r) * VROW + (32 * kh + 16 * s2 + 4 * hi) * 2;
                const u32x2 lo = *(const LAS u32x2*)vp, hi2 = *(const LAS u32x2*)(vp + 16); const u32x4 av = (u32x4){lo.x, lo.y, hi2.x, hi2.y};
                O[dt] = __builtin_amdgcn_mfma_f32_32x32x16_bf16(__builtin_bit_cast(bf16x8, av), pf[kh][s2], O[dt], 0, 0, 0); }
}
}
__device__ __forceinline__ void p7_xattn_fast(Frame& F, const bf16* vT, bf16* outbase) {
    using namespace xatf;
    bf16* Q = (bf16*)(F.ws + WS_NQ); const bf16* KV = (const bf16*)(F.ws + WS_MEMKV);
    const int tid = F.tid, lane = F.lane, wave = F.wave, r = lane & 31, hi = lane >> 5; LAS unsigned char* lds = F.lds;
    for (int u = F.bx; u < BATCH * 4 * 16; u += F.G) {
        const int tt = u & 15, bh = u >> 4, b = bh >> 2, h = bh & 3; const int tok = b * SEQ + tt * 256 + wave * 32 + r;
        bf16* qrow = Q + (size_t)tok * D + h * 256; bf16* orow = outbase + (size_t)tok * D + h * 256; const bf16* Kb = KV + (size_t)(b * NMEM) * 2048 + h * 256;
        bf16x8 qf[16];
#pragma unroll
        for (int s_ = 0; s_ < 16; ++s_) qf[s_] = *(const bf16x8*)(qrow + 16 * s_ + 8 * hi);
#pragma unroll
        for (int half = 0; half < 2; ++half) {
            const bf16* VTb = vT + ((size_t)bh * 256 + half * 128) * 256;
            f32x16 O[4]; float m = NEG, l = 0.f;
#pragma unroll
            for (int dt = 0; dt < 4; ++dt)
#pragma unroll
                for (int j = 0; j < 16; ++j) O[dt][j] = 0.f;
            for (int j = 0; j < 4; ++j) {
                __syncthreads(); { Stage st; stage_load(st, Kb, VTb, j * 64, tid); stage_write(st, lds, tid); } __syncthreads();
                block_step(lds, qf, O, m, l, lane);
            }
            l += __shfl_xor(l, 32); const float inv = 1.0f / l;
#pragma unroll
            for (int dt = 0; dt < 4; ++dt)
#pragma unroll
                for (int q4 = 0; q4 < 4; ++q4) *(u32x2*)(orow + half * 128 + 32 * dt + 8 * q4 + 4 * hi) = (u32x2){cvt_pk_bf16(O[dt][4 * q4] * inv, O[dt][4 * q4 + 1] * inv), cvt_pk_bf16(O[dt][4 * q4 + 2] * inv, O[dt][4 * q4 + 3] * inv)};
        }
    }
    __syncthreads();
}
__device__ __forceinline__ void transpose_memv_tiles(Frame& F, bf16* vT, int w0, int nw) {
    LAS unsigned short* tl_ = (LAS unsigned short*)(F.lds + F.wave * 16384); const int lane = F.lane; const bf16* KV = (const bf16*)(F.ws + WS_MEMKV);
    for (int tile = w0; tile < 32 * 16; tile += nw) {
        const int dq = tile & 3, kq = (tile >> 2) & 3, bh = tile >> 4, b = bh >> 2, h = bh & 3;
        const bf16* sp = KV + (size_t)(b * NMEM + kq * 64) * 2048 + 1024 + h * 256 + dq * 64; bf16* dp = vT + ((size_t)bh * 256 + dq * 64) * 256 + kq * 64;
#pragma unroll
        for (int i = 0; i < 8; ++i) { const int row = i * 8 + (lane >> 3), c = lane & 7; const u32x4 v = *(const u32x4*)(sp + (size_t)row * 2048 + c * 8); LAS unsigned short* q = tl_ + row * 66 + c * 8;
            q[0] = (unsigned short)(v.x & 0xffffu); q[1] = (unsigned short)(v.x >> 16); q[2] = (unsigned short)(v.y & 0xffffu); q[3] = (unsigned short)(v.y >> 16);
            q[4] = (unsigned short)(v.z & 0xffffu); q[5] = (unsigned short)(v.z >> 16); q[6] = (unsigned short)(v.w & 0xffffu); q[7] = (unsigned short)(v.w >> 16); }
        LDS_WAIT(); asm volatile("" ::: "memory");
#pragma unroll
        for (int i = 0; i < 8; ++i) { const int d = i * 8 + (lane >> 3), c = lane & 7; const LAS unsigned short* q = tl_ + (c * 8) * 66 + d;
            u32x4 o; o.x = (unsigned)q[0] | ((unsigned)q[66] << 16); o.y = (unsigned)q[2 * 66] | ((unsigned)q[3 * 66] << 16); o.z = (unsigned)q[4 * 66] | ((unsigned)q[5 * 66] << 16); o.w = (unsigned)q[6 * 66] | ((unsigned)q[7 * 66] << 16);
            *(u32x4*)(dp + (size_t)d * 256 + c * 8) = o; }
        LDS_WAIT(); asm volatile("" ::: "memory");
    }
}

__device__ __forceinline__ void p9_route(Frame& F, const Args& a) {
    unsigned char* ws = F.ws; const float* X2 = a.out;
    const float* gff = a.in[IN_NORM_FFN_G]; const float* wgrp = a.in[IN_W_GRP]; const float* bgrp = a.in[IN_B_GRP]; const float* wrt = a.in[IN_W_RT]; const float* brt = a.in[IN_B_RT];
    float* wts = (float*)(ws + WS_ROUTE); float* rstd2 = wts + 2 * NTOK; int* lists = (int*)(ws + WS_LISTS);
    const int gw = F.bx * NWAVES + F.wave, NGW = F.G * NWAVES, lane = F.lane;
    const f32x4* wgp = (const f32x4*)(ws + WS_RTW); const f32x4* wep = wgp + 1024;
    float xn[16];
    if (gw < NTOK) {
#pragma unroll
        for (int i = 0; i < 16; ++i) xn[i] = X2[(size_t)gw * D + 64 * i + lane]; }
    int my_ea = -1, my_eb = -1, my_tok = -1, it_ = 0; float my_w1 = 0.f, my_w2 = 0.f, my_rstd = 0.f;
    for (int tok = gw; tok < NTOK; tok += NGW, ++it_) {
        float xa[16]; float s = 0.f;
#pragma unroll
        for (int i = 0; i < 16; ++i) { xa[i] = xn[i]; s += xa[i] * xa[i]; }
        if (tok + NGW < NTOK) {
#pragma unroll
            for (int i = 0; i < 16; ++i) xn[i] = X2[(size_t)(tok + NGW) * D + 64 * i + lane]; }
        const float rstd = 1.0f / sqrtf(wave_sum(s) * (1.f / D) + EPS);
        float lg[4] = {0.f, 0.f, 0.f, 0.f};
#pragma unroll
        for (int i = 0; i < 16; ++i) { const f32x4 wg = wgp[64 * i + lane];
#pragma unroll
            for (int c = 0; c < 4; ++c) lg[c] += xa[i] * wg[c]; }
#pragma unroll
        for (int i = 0; i < 4; ++i) lg[i] = rstd * wave_sum(lg[i]) + bgrp[i];
        int grp = 0; float gm = lg[0];
#pragma unroll
        for (int i = 1; i < 4; ++i) if (lg[i] > gm) { gm = lg[i]; grp = i; }
        grp = __builtin_amdgcn_readfirstlane(grp);
        float gs = 0.f;
#pragma unroll
        for (int i = 0; i < 4; ++i) gs += expf(lg[i] - gm);
        const float g_gate = 1.0f / gs;
        float lq[8];
#pragma unroll
        for (int i = 0; i < 8; ++i) lq[i] = 0.f;
        const f32x4* pwe = wep + (size_t)grp * (16 * 2 * 64) + lane;
#pragma unroll
        for (int i = 0; i < 16; ++i) { const f32x4 wa = pwe[(2 * i) * 64], wb = pwe[(2 * i + 1) * 64];
#pragma unroll
            for (int c = 0; c < 4; ++c) { lq[c] += xa[i] * wa[c]; lq[4 + c] += xa[i] * wb[c]; } }
#pragma unroll
        for (int i = 0; i < 8; ++i) lq[i] = rstd * wave_sum(lq[i]) + brt[grp * 8 + i];
        int i1 = 0; float m1 = lq[0];
#pragma unroll
        for (int i = 1; i < 8; ++i) if (lq[i] > m1) { m1 = lq[i]; i1 = i; }
        int i2 = -1; float m2 = -3.0e38f;
#pragma unroll
        for (int i = 0; i < 8; ++i) if (i != i1 && lq[i] > m2) { m2 = lq[i]; i2 = i; }
        const float e2 = expf(m2 - m1), den = 1.0f + e2; const float w1 = g_gate / den, w2 = g_gate * e2 / den;
        if (lane == it_) { my_ea = grp * 8 + i1; my_eb = grp * 8 + i2; my_tok = tok; my_w1 = w1; my_w2 = w2; my_rstd = rstd; }
    }
    if (my_tok >= 0) {
        const unsigned sa = __hip_atomic_fetch_add(F.ctl + CW_ECNT + 64 * my_ea, 1u, __ATOMIC_RELAXED, __HIP_MEMORY_SCOPE_AGENT);
        const unsigned sb = __hip_atomic_fetch_add(F.ctl + CW_ECNT + 64 * my_eb, 1u, __ATOMIC_RELAXED, __HIP_MEMORY_SCOPE_AGENT);
        lists[(size_t)my_ea * NTOK + sa] = my_tok * 2; lists[(size_t)my_eb * NTOK + sb] = my_tok * 2 + 1;
        wts[my_tok * 2] = my_w1; wts[my_tok * 2 + 1] = my_w2; rstd2[my_tok] = my_rstd;
    }
}
__device__ __forceinline__ void moe_tiles(Frame& F) {
    __syncthreads();
    if (F.tid == 0) { unsigned accu = 0u; for (int e = 0; e < NEXP; ++e) { const unsigned c = __hip_atomic_load(F.ctl + CW_ECNT + 64 * e, __ATOMIC_RELAXED, __HIP_MEMORY_SCOPE_AGENT); F.MISC[16 + e] = accu; F.MISC[64 + e] = c; accu += (c + 255u) >> 8; } F.MISC[16 + NEXP] = accu; }
    __syncthreads();
}
template <int WHICH> struct SchedMoe {
    volatile LAS unsigned* MISC; unsigned char* ws; int G, c;
    __device__ __forceinline__ bool next(int i, GU& u) const {
        const int L = i * G + c; const int T = (int)MISC[16 + NEXP]; if (L >= 4 * T) return false;
        const int tau = L >> 2, pn = L & 3; int e = 0;
        for (int k = 1; k < NEXP; ++k) if ((int)MISC[16 + k] <= tau) e = k;
        const int lt = tau - (int)MISC[16 + e]; const int cnt = (int)MISC[64 + e]; int nv = cnt - lt * 256; nv = nv > 256 ? 256 : nv;
        u.rows = (const int*)(ws + WS_LISTS) + (size_t)e * NTOK + lt * 256; u.nvalid = nv; u.pm = tau; u.pn = pn; u.kind = 0; u.aux = e;
        if (WHICH == 0) { u.A = (const char*)ws + WS_X2B; u.B = (const char*)ws + WS_W13 + (size_t)e * D * D * 2 + (size_t)pn * 256 * D * 2; }
        else { u.A = (const char*)ws + WS_H1 + (size_t)tau * 256 * DEXP * 2; u.B = (const char*)ws + WS_W2 + (size_t)e * D * DEXP * 2 + (size_t)pn * 256 * DEXP * 2; }
        return true;
    }
};
struct EpiMoe1 {
    static constexpr bool PERM = true;
    const float* rstd2; bf16* H1;
    __device__ __forceinline__ void operator()(const f32x4 (&acc)[2][2][4][2], const GU& u, int wr, int wc, int fr, int fq) const {
        char* hb = (char*)H1 + (size_t)u.pm * 256 * DEXP * 2;
        const int j00 = (u.pn * 256 + 32 * wc + 8 * fq) >> 1;
#pragma unroll
        for (int ai = 0; ai < 2; ++ai) {
            int r = 128 * ai + 64 * wr + fr; LAUNDER(r);
#pragma unroll
            for (int m = 0; m < 4; ++m) { const bool ok = r < u.nvalid; const float rs = ok ? rstd2[u.rows[r] >> 1] : 0.f;
#pragma unroll
                for (int bj = 0; bj < 2; ++bj) { const f32x4 a1 = acc[ai][bj][m][0] * rs, a3 = acc[ai][bj][m][1] * rs; f32x4 hv;
#pragma unroll
                    for (int j = 0; j < 4; ++j) hv[j] = a1[j] * sigmoidf_(a1[j]) * a3[j];
                    u32x2 w; w.x = cvt_pk_bf16(hv[0], hv[1]); w.y = cvt_pk_bf16(hv[2], hv[3]); *(u32x2*)(hb + (unsigned)((r * DEXP + j00 + 64 * bj) * 2)) = w; }
                r += 16; LAUNDER(r); }
        }
    }
};
struct EpiMoe2 {
    static constexpr bool PERM = true;
    const float* wts; bf16* Y0; bf16* Y1;
    __device__ __forceinline__ void operator()(const f32x4 (&acc)[2][2][4][2], const GU& u, int wr, int wc, int fr, int fq) const {
#pragma unroll
        for (int ai = 0; ai < 2; ++ai)
#pragma unroll
            for (int m = 0; m < 4; ++m) { const int r = 128 * ai + 64 * wr + 16 * m + fr;
                if (r < u.nvalid) { const int ent = u.rows[r]; const float w8 = wts[ent]; bf16* dst = ((ent & 1) ? Y1 : Y0) + (size_t)(ent >> 1) * D + u.pn * 256 + 32 * wc + 8 * fq;
#pragma unroll
                    for (int bj = 0; bj < 2; ++bj) { const f32x4 v0 = acc[ai][bj][m][0] * w8, v1 = acc[ai][bj][m][1] * w8;
                        u32x4 w; w.x = cvt_pk_bf16(v0[0], v0[1]); w.y = cvt_pk_bf16(v0[2], v0[3]); w.z = cvt_pk_bf16(v1[0], v1[1]); w.w = cvt_pk_bf16(v1[2], v1[3]);
                        *(u32x4*)(dst + 128 * bj) = w; } } }
    }
};

__device__ __forceinline__ void p12_final(Frame& F, const Args& a) {
    const bf16* Y0 = (const bf16*)(F.ws + WS_YS0); const bf16* Y1 = (const bf16*)(F.ws + WS_YS1); const bf16* X2 = (const bf16*)(F.ws + WS_X2B); const float* g = a.in[IN_NORM_F_G];
    const int gw = F.bx * NWAVES + F.wave, NGW = F.G * NWAVES, lane = F.lane;
    for (int tok = gw; tok < NTOK; tok += NGW) {
        f32x4* xr = (f32x4*)(a.out + (size_t)tok * D) + lane; const u32x2* x2 = (const u32x2*)(X2 + (size_t)tok * D) + lane; const u32x2* y0 = (const u32x2*)(Y0 + (size_t)tok * D) + lane; const u32x2* y1 = (const u32x2*)(Y1 + (size_t)tok * D) + lane;
        f32x4 v[4]; float s = 0.f;
#pragma unroll
        for (int j = 0; j < 4; ++j) { const u32x2 xx = x2[64 * j], p = y0[64 * j], q = y1[64 * j];
            v[j].x = lo16(xx.x) + (lo16(p.x) + lo16(q.x)); v[j].y = hi16(xx.x) + (hi16(p.x) + hi16(q.x)); v[j].z = lo16(xx.y) + (lo16(p.y) + lo16(q.y)); v[j].w = hi16(xx.y) + (hi16(p.y) + hi16(q.y));
            s += (v[j].x * v[j].x + v[j].y * v[j].y) + (v[j].z * v[j].z + v[j].w * v[j].w); }
        const float rstd = 1.0f / sqrtf(wave_sum(s) * (1.f / D) + EPS);
#pragma unroll
        for (int j = 0; j < 4; ++j) { const f32x4 gg = ((const f32x4*)g + lane)[64 * j]; xr[64 * j] = v[j] * rstd * gg; }
    }
}

constexpr int N_PHASES = 14;
__global__ void __launch_bounds__(NTHREADS, 2) fwd(Args args) {
    extern __shared__ __attribute__((aligned(16))) unsigned char lds[];
    Frame F;
    F.lds = (LAS unsigned char*)lds; F.MISC = (volatile LAS unsigned*)(F.lds + MISC_OFF);
    F.tid = threadIdx.x; F.lane = F.tid & 63; F.wave = __builtin_amdgcn_readfirstlane(F.tid >> 6); F.G = gridDim.x; F.bx = blockIdx.x;
    F.ws = args.ws; F.ctl = (unsigned*)(args.ws + WS_CTL);
    unsigned char* ws = args.ws;
    for (int u = F.tid; u < (LDS_BYTES - RING_BYTES) / 4; u += NTHREADS) ((LAS unsigned*)(F.lds + RING_BYTES))[u] = 0u;
    __syncthreads();
    const int lo = args.ph_lo, hi = args.ph_hi;
    const bool one = (hi - lo) > 1;
    XcdBarrier bar; bar.bar = F.ctl + CW_BAR; bar.x = 0; bar.st = F.MISC + 8;
    if (one) bar = xcd_barrier_post(F.ctl + CW_BAR, F.MISC + 8);
#define IN(k) (lo <= (k) && (k) < hi && phase_begin(F))
#define SEAM(k) do { if (lo <= (k) && (k) + 1 < hi) xcd_barrier(bar); } while (0)

    if (IN(0)) { p0_prologue(F, args); } SEAM(0);
    if (IN(1)) {
        SchedP1 S{ws, F.G, F.bx};
        EpiP1 E{ws};
        pg8::gemm_phase<EpiP1, SchedP1, false>(F.lds, D, D, D, S, E);
        p1_gate_logits(F);
    } SEAM(1);
    if (IN(2)) {
        p2_retention_fast(F, F.bx, (bf16*)(ws + WS_RV));
        { const int w0 = F.bx * NWAVES + F.wave, nw = F.G * NWAVES;
            transpose_kv_tiles(F, (const bf16*)(ws + WS_KV6 + 3 * KV_STRIDE), (bf16*)args.out, w0, nw);
            transpose_kv_tiles(F, (const bf16*)(ws + WS_KV6 + 5 * KV_STRIDE), (bf16*)((unsigned char*)args.out + KV_STRIDE), w0, nw);
            transpose_memv_tiles(F, (bf16*)(ws + WS_MEMVT), w0, nw); }
        __syncthreads();
        { SchedCmp S{ws, 0, F.G, F.bx}; EpiCmp E{(float*)args.out + (size_t)16 * MiB};
            pg8::gemm_phase<EpiCmp, SchedCmp, false>(F.lds, 512, 2048, 4096, S, E); }
    } SEAM(2);
    if (IN(3)) { p2b_compress_out(F, args); } SEAM(3);
    if (IN(4)) { p3_ret_normalize(F); p3_nsa_fast(F, (const bf16*)args.out, (const bf16*)((const unsigned char*)args.out + KV_STRIDE), (bf16*)(ws + WS_NQ)); } SEAM(4);
    if (IN(5)) {
        SchedP4 S{ws, F.G, F.bx};
        EpiP4 E{(float*)(ws + WS_P4SCR) + (size_t)F.bx * (2 * 32 * 512 * 4), (bf16*)(ws + WS_Y)};
        pg8::gemm_phase<EpiP4, SchedP4, false>(F.lds, D, D, D, S, E);
    } SEAM(5);
    if (IN(6)) {
        SchedMN S{ws, WS_Y, W_OUT, F.G, F.bx}; EpiRes<true> E{args.in[IN_X], nullptr, nullptr, (bf16*)(ws + WS_X1B), (float*)(ws + WS_SSQ)};
        pg8::gemm_phase<EpiRes<true>, SchedMN, false>(F.lds, D, D, D, S, E);
    } SEAM(6);
    if (IN(7)) {
        const bool early = ((F.bx >> 3) & 1) == 0;
        if (early) expert_copies(F, args, 0, NEXP / 2);
        SchedMN S{ws, WS_X1B, W_XQ, F.G, F.bx}; EpiQ E{(const float*)(ws + WS_SSQ), (bf16*)(ws + WS_NQ)};
        pg8::gemm_phase<EpiQ, SchedMN, false>(F.lds, D, D, D, S, E);
        if (!early) { __syncthreads(); expert_copies(F, args, 0, NEXP / 2); }
    } SEAM(7);
    if (IN(8)) { p7_xattn_fast(F, (const bf16*)(ws + WS_MEMVT), (bf16*)(ws + WS_NQ)); } SEAM(8);
    if (IN(9)) {
        const bool early = ((F.bx >> 3) & 1) == 0;
        if (early) expert_copies(F, args, NEXP / 2, NEXP);
        SchedMN S{ws, WS_NQ, W_XO, F.G, F.bx}; EpiRes<false> E{nullptr, (const bf16*)(ws + WS_X1B), args.out, (bf16*)(ws + WS_X2B), nullptr};
        pg8::gemm_phase<EpiRes<false>, SchedMN, false>(F.lds, D, D, D, S, E);
        if (!early) { __syncthreads(); expert_copies(F, args, NEXP / 2, NEXP); }
    } SEAM(9);
    if (IN(10)) { p9_route(F, args); } SEAM(10);
    if (IN(11)) {
        moe_tiles(F);
        SchedMoe<0> S{F.MISC, ws, F.G, F.bx}; EpiMoe1 E{(const float*)(ws + WS_ROUTE) + 2 * NTOK, (bf16*)(ws + WS_H1)};
        pg8::gemm_phase<EpiMoe1, SchedMoe<0>, true>(F.lds, D, D, D, S, E);
    } SEAM(11);
    if (IN(12)) {
        moe_tiles(F);
        SchedMoe<1> S{F.MISC, ws, F.G, F.bx}; EpiMoe2 E{(const float*)(ws + WS_ROUTE), (bf16*)(ws + WS_YS0), (bf16*)(ws + WS_YS1)};
        pg8::gemm_phase<EpiMoe2, SchedMoe<1>, false>(F.lds, DEXP, DEXP, DEXP, S, E);
    } SEAM(12);
    if (IN(13)) { p12_final(F, args); }
#undef IN
#undef SEAM
}

extern "C" void kernel_launch(void* const* d_in, const int* in_sizes, int n_in, void* d_out, int out_size, void* d_ws, size_t ws_size, hipStream_t stream) {
    static int grid = 0;
    if (grid == 0) {
        if (n_in != 27 || in_sizes[0] != NTOK * D || out_size != NTOK * D || ws_size < WS_END) {
            fprintf(stderr, "kernel_launch: unexpected shapes: n_in %d in0 %d out %d ws %zu (need %zu)\n", n_in, n_in > 0 ? in_sizes[0] : -1, out_size, ws_size, (size_t)WS_END); grid = -1; return; }
        int dev = 0, cus = 0, per_cu = 0;
        if (hipGetDevice(&dev) != hipSuccess || hipDeviceGetAttribute(&cus, hipDeviceAttributeMultiprocessorCount, dev) != hipSuccess) { grid = -1; return; }
        if (hipFuncSetAttribute((const void*)fwd, hipFuncAttributeMaxDynamicSharedMemorySize, LDS_BYTES) != hipSuccess) { fprintf(stderr, "kernel_launch: hipFuncSetAttribute failed\n"); grid = -1; return; }
        if (hipOccupancyMaxActiveBlocksPerMultiprocessor(&per_cu, (const void*)fwd, NTHREADS, LDS_BYTES) != hipSuccess || per_cu < 1) fprintf(stderr, "kernel_launch: occupancy query reports %d\n", per_cu);
        (void)hipGetLastError();
        grid = cus < 256 ? cus : 256;
    }
    if (grid < 0) return;
    (void)hipMemsetAsync((char*)d_ws + WS_CTL, 0, CTL_ZERO_BYTES, stream);
    Args a{};
    for (int i = 0; i < 27; ++i) a.in[i] = (const float*)d_in[i];
    a.out = (float*)d_out; a.ws = (unsigned char*)d_ws;
#if MK_N_LAUNCHES == 1
    a.ph_lo = 0; a.ph_hi = N_PHASES;
    hipLaunchKernelGGL(fwd, dim3(grid), dim3(NTHREADS), LDS_BYTES, stream, a);
#else
    for (int p = 0; p < N_PHASES; ++p) { a.ph_lo = p; a.ph_hi = p + 1; hipLaunchKernelGGL(fwd, dim3(grid), dim3(NTHREADS), LDS_BYTES, stream, a); }
#endif
}
```

```cpp
#include <hip/hip_runtime.h>
#include <cstdio>
#include <cstdint>

#ifndef MK_N_LAUNCHES
#define MK_N_LAUNCHES 1
#endif

#define LAS __attribute__((address_space(3)))
#define GAS __attribute__((address_space(1)))
#define HD __host__ __device__
#define HDI __host__ __device__ __attribute__((always_inline)) inline
typedef unsigned short bf16;
typedef short bf16x8 __attribute__((ext_vector_type(8)));
typedef float f32x4 __attribute__((ext_vector_type(4)));
typedef float f32x2 __attribute__((ext_vector_type(2)));
typedef float f32x16 __attribute__((ext_vector_type(16)));
typedef unsigned u32x4 __attribute__((ext_vector_type(4)));
typedef unsigned u32x2 __attribute__((ext_vector_type(2)));

constexpr int D = 1024, BATCH = 8, SEQ = 4096, NTOK = BATCH * SEQ, NMEM = 256, NMEMTOK = BATCH * NMEM;
constexpr int DIN = 7704;
constexpr int C_RQ = 0, C_RK = 512, C_RV = 1024, C_RG = 2048, C_NQ = 3072, C_CK = 4096, C_NGL = 5632, C_GA = 5656, C_GB = 6680;
constexpr int NPROJ = 5632;
constexpr int NEXP = 32, DEXP = 512;
constexpr float EPS = 1e-6f;
constexpr int NWAVES = 8, NTHREADS = 512;

constexpr size_t MiB = 1u << 20;
constexpr size_t WS_CTL = 0, CTL_ZERO_BYTES = 1 * MiB;
constexpr size_t WS_ROPE_COS = 1 * MiB, WS_ROPE_SIN = 2 * MiB;
constexpr size_t WS_RTW = 3 * MiB + 512 * 1024;
constexpr size_t WS_SMALLW = 3 * MiB;
constexpr size_t WS_MEMVT = 24 * MiB;
constexpr size_t WS_KCMP = 4 * MiB, WS_VCMP = 5 * MiB, WS_VCMPT = 35 * MiB;
constexpr size_t WS_GATES = 10 * MiB;
constexpr size_t WS_SSQ = 13 * MiB;
constexpr size_t WS_ROUTE = 15 * MiB;
constexpr size_t WS_LISTS = 16 * MiB;
constexpr size_t WS_W = 36 * MiB;
constexpr size_t W_IN = WS_W;
constexpr size_t W_GA = W_IN + 11 * MiB, W_GB = W_GA + 2 * MiB;
constexpr size_t W_RO = W_GB + 2 * MiB, W_NO = W_RO + 2 * MiB, W_OUT = W_NO + 2 * MiB, W_XQ = W_OUT + 2 * MiB, W_XO = W_XQ + 2 * MiB;
constexpr size_t W_XKV = W_XO + 2 * MiB;
constexpr size_t W_C1K = W_XKV + 4 * MiB, W_C1V = W_C1K + 2 * MiB;
constexpr size_t WS_MEMN = W_C1V + 2 * MiB;
constexpr size_t WS_MEMKV = WS_MEMN + 4 * MiB;
constexpr size_t WS_H = 84 * MiB;
constexpr size_t WS_NQ = WS_H + 64 * MiB;
constexpr size_t WS_RV = WS_NQ + 64 * MiB;
constexpr size_t WS_RQ = WS_RV + 64 * MiB;
constexpr size_t WS_RK = WS_RQ + 32 * MiB;
constexpr size_t WS_RG = WS_RK + 32 * MiB;
constexpr size_t WS_KV6 = WS_RG + 64 * MiB;
constexpr size_t KV_STRIDE = 16 * MiB;
constexpr size_t WS_END = WS_KV6 + 96 * MiB;
constexpr size_t WS_Y = WS_RQ, WS_P4SCR = WS_RG, WS_W13 = WS_RQ, WS_W2 = WS_RG, WS_H1 = WS_KV6, WS_X1B = WS_H, WS_X2B = WS_RV, WS_YS0 = WS_H, WS_YS1 = WS_NQ;
static_assert(WS_MEMKV + 8 * MiB <= WS_H && WS_VCMPT + 1 * MiB <= WS_W && WS_MEMVT + 4 * MiB <= WS_VCMPT, "ws map");
constexpr int CW_BAR = 4096;
constexpr int CW_ECNT = 16384;
constexpr int LDS_BYTES = 147456, RING_BYTES = 131072, MISC_OFF = RING_BYTES + 320;

HD inline float bf2f(bf16 b) { return __builtin_bit_cast(float, (unsigned)b << 16); }
HD inline unsigned f2bf(float f) { unsigned u = __builtin_bit_cast(unsigned, f); return (u + 0x7fffu + ((u >> 16) & 1u)) >> 16; }
HD inline unsigned pk2(float lo, float hi) { return f2bf(lo) | (f2bf(hi) << 16); }
HD inline float lo16(unsigned w) { return __builtin_bit_cast(float, w << 16); }
HD inline float hi16(unsigned w) { return __builtin_bit_cast(float, w & 0xffff0000u); }
__device__ __forceinline__ unsigned cvt_pk_bf16(float lo, float hi) { unsigned r; asm volatile("v_cvt_pk_bf16_f32 %0, %1, %2" : "=v"(r) : "v"(lo), "v"(hi)); return r; }
#define DPP_F(v, ctrl, rmask) __builtin_bit_cast(float, __builtin_amdgcn_update_dpp(0, __builtin_bit_cast(int, v), ctrl, rmask, 0xf, false))
__device__ __forceinline__ float wave_sum(float v) {
    v += DPP_F(v, 0xB1, 0xf);
    v += DPP_F(v, 0x4E, 0xf);
    v += DPP_F(v, 0x141, 0xf);
    v += DPP_F(v, 0x140, 0xf);
    v += DPP_F(v, 0x142, 0xa);
    v += DPP_F(v, 0x143, 0xc);
    return __builtin_bit_cast(float, __builtin_amdgcn_readlane(__builtin_bit_cast(int, v), 63));
}
__device__ __forceinline__ float wave_max(float v) {
#pragma unroll
    for (int o = 1; o < 64; o <<= 1) v = fmaxf(v, __shfl_xor(v, o));
    return v;
}
__device__ __forceinline__ float sigmoidf_(float x) { return __builtin_amdgcn_rcpf(1.0f + __builtin_amdgcn_exp2f(-1.4426950408889634f * x)); }
#define LAUNDER(p) asm volatile("" : "+v"(p))
#define LDS_WAIT() asm volatile("s_waitcnt lgkmcnt(0)" ::: "memory")
#define VM_WAIT() asm volatile("s_waitcnt vmcnt(0)" ::: "memory")

#define XB_TMO      128
#define XB_XCNT(j)  (256  + 64 * (j))
#define XB_XSUB(j)  (1280 + 64 * (j))
#define XB_XGEN(j)  (2304 + 64 * (j))
#define XB_TOP      3328
#define XB_TOPGEN   3392
#define XCD_BAR_WORDS 3456
#define XB_SPIN_CAP (1u << 24)
__device__ __forceinline__ unsigned xb_ld(unsigned* p)              { return __hip_atomic_load(p, __ATOMIC_RELAXED, __HIP_MEMORY_SCOPE_AGENT); }
__device__ __forceinline__ unsigned xb_add(unsigned* p, unsigned v) { return __hip_atomic_fetch_add(p, v, __ATOMIC_RELAXED, __HIP_MEMORY_SCOPE_AGENT); }
__device__ __forceinline__ unsigned xb_xcc_id() { return (unsigned)__builtin_amdgcn_s_getreg((3 << 11) | 20) & 0xFu; }
#define XB_SPIN(cond, bar) do { unsigned _sp = 0; while (cond) { __builtin_amdgcn_s_sleep(1); \
    if ((++_sp & 255u) == 0u) { if (xb_ld(&(bar)[XB_TMO])) break; if (_sp > XB_SPIN_CAP) { atomicAdd(&(bar)[XB_TMO], 1u); break; } } } } while (0)
struct XcdBarrier { unsigned* bar; unsigned x; volatile LAS unsigned* st; };
__device__ __forceinline__ XcdBarrier xcd_barrier_post(unsigned* bar, volatile LAS unsigned* st) {
    XcdBarrier b; b.bar = bar; b.x = xb_xcc_id(); b.st = st;
    if (threadIdx.x == 0) (void)xb_add(&bar[XB_XCNT(b.x)], 1u);
    return b;
}
__device__ __forceinline__ void xcd_barrier_complete(unsigned* bar, unsigned x, unsigned& nloc, unsigned& nx) {
    const unsigned G = gridDim.x * gridDim.y * gridDim.z;
    unsigned sum, cnt, mine, sp = 0u;
    for (;;) {
        sum = 0u; cnt = 0u; mine = 0u;
#pragma unroll
        for (unsigned j = 0; j < 16; ++j) { const unsigned c = xb_ld(&bar[XB_XCNT(j)]); sum += c; cnt += (c > 0u) ? 1u : 0u; mine = (j == x) ? c : mine; }
        if (sum == G) break;
        __builtin_amdgcn_s_sleep(1);
        if ((++sp & 255u) == 0u) { if (xb_ld(&bar[XB_TMO])) break; if (sp > XB_SPIN_CAP) { atomicAdd(&bar[XB_TMO], 1u); break; } }
    }
    nloc = mine > 0u ? mine : 1u; nx = cnt > 0u ? cnt : 1u;
}
__device__ __forceinline__ void xcd_barrier(const XcdBarrier& b) {
    asm volatile("s_waitcnt vmcnt(0)" ::: "memory");
    __syncthreads();
    if (threadIdx.x == 0) {
        unsigned* bar = b.bar;
        __builtin_amdgcn_s_waitcnt(0);
        unsigned nloc = b.st[0], nx = b.st[1];
        if (nloc == 0u) { xcd_barrier_complete(bar, b.x, nloc, nx); b.st[0] = nloc; b.st[1] = nx; }
        const unsigned old = xb_add(&bar[XB_XSUB(b.x)], 1u);
        const unsigned gen = old / nloc;
        if (old + 1u == (gen + 1u) * nloc) {
            __builtin_amdgcn_fence(__ATOMIC_RELEASE, "agent");
            asm volatile("s_waitcnt vmcnt(0)" ::: "memory");
            const unsigned og = xb_add(&bar[XB_TOP], 1u);
            const unsigned tg = og / nx;
            if (og + 1u == (tg + 1u) * nx) xb_add(&bar[XB_TOPGEN], 1u);
            else XB_SPIN(xb_ld(&bar[XB_TOPGEN]) == tg, bar);
            __builtin_amdgcn_fence(__ATOMIC_ACQUIRE, "agent");
            xb_add(&bar[XB_XGEN(b.x)], 1u);
            asm volatile("s_waitcnt vmcnt(0)" ::: "memory");
        } else {
            XB_SPIN(xb_ld(&bar[XB_XGEN(b.x)]) == gen, bar);
            __builtin_amdgcn_fence(__ATOMIC_ACQUIRE, "agent");
            asm volatile("s_waitcnt vmcnt(0)" ::: "memory");
        }
    }
    __syncthreads();
}

namespace pg8 {
constexpr int BM = 256, BK = 64, HALF = 128, HTB = HALF * BK * 2, NXCD = 8, WGM = 8;
HD __forceinline__ int lds_byte(int r, int c) { const int st = (r >> 4) * 2 + (c >> 5), rr = r & 15, cc = c & 31, ob = rr * 64 + cc * 2; return st * 1024 + (ob ^ (((ob >> 9) & 1) << 5)); }
HD __forceinline__ void stage_rc(int b, int& R, int& C) { const int st = b / 1024, sb = b % 1024, swz = sb ^ (((sb >> 9) & 1) << 5); R = (st >> 1) * 16 + swz / 64; C = (st & 1) * 32 + (swz % 64) / 2; }
HD __forceinline__ int perm32(int rho) { const int n = rho >> 4, i = rho & 15; return 8 * (i >> 2) + 4 * n + (i & 3); }
HD __forceinline__ void tile_map(int L, int nM, int nN, int& pm, int& pn) {
    const int nwg = nM * nN; int wgid = L; { const int q = nwg / NXCD, r = nwg % NXCD, xcd = wgid % NXCD, off = wgid / NXCD; wgid = (xcd < r ? xcd * (q + 1) : r * (q + 1) + (xcd - r) * q) + off; }
    const int nig = WGM * nN, gid = wgid / nig, fm = gid * WGM, gsz = (nM - fm) < WGM ? (nM - fm) : WGM;
    pm = fm + ((wgid % nig) % gsz); pn = (wgid % nig) / gsz;
}
struct GU { const char* A; const char* B; const int* rows; int nvalid; int kind, pm, pn, aux; };
template <class Epi, class Sched, bool GATHER>
__device__ __forceinline__ void gemm_phase(LAS unsigned char* lds, const int K, const int lda, const int ldb, const Sched& S, const Epi& E) {
    int tid_ = threadIdx.x; LAUNDER(tid_);
    const int tid = tid_, wid = __builtin_amdgcn_readfirstlane(tid >> 6), lane = tid & 63, wr = wid >> 2, wc = wid & 3, fr = lane & 15, fq = lane >> 4;
    const int nt = K / BK;
    unsigned voffB[2];
#pragma unroll
    for (int i = 0; i < 2; ++i) { int R, C; stage_rc(tid * 16 + i * 8192, R, C); const int Rb = Epi::PERM ? ((R & ~31) + perm32(R & 31)) : R; voffB[i] = (unsigned)(Rb * ldb + C) * 2u; }
    const size_t kstep = (size_t)(BK * 2);
    const size_t hstepB = (size_t)HALF * ldb * 2;
    const unsigned ldsw = (unsigned)wid * 1024u;
    const int aoff = lds_byte(wr * 64 + fr, fq * 8), boff = lds_byte(wc * 32 + fr, fq * 8);
#define PG8_SA(b, h) (((b) * 2 + (h)) * HTB)
#define PG8_SB(b, h) ((4 + (b) * 2 + (h)) * HTB)
#define PG8_STAGE2(bufoff, gbase, v0, v1) do { \
        __builtin_amdgcn_global_load_lds((const unsigned*)((const char*)(gbase) + (v0)), (LAS unsigned*)(lds + (bufoff) + ldsw), 16, 0, 0); \
        __builtin_amdgcn_global_load_lds((const unsigned*)((const char*)(gbase) + (v1)), (LAS unsigned*)(lds + (bufoff) + ldsw + 8192), 16, 0, 0); } while (0)
#define PG8_STAGEB(bufoff, gbase) PG8_STAGE2(bufoff, gbase, voffB[0], voffB[1])
#define PG8_LDA(dst, b, h) do { _Pragma("unroll") for (int m = 0; m < 4; ++m) _Pragma("unroll") for (int k = 0; k < 2; ++k) dst[m][k] = *(const LAS bf16x8*)(lds + PG8_SA(b, h) + aoff + m * 2048 + k * 1024); } while (0)
#define PG8_LDB(dst, b, h) do { _Pragma("unroll") for (int n = 0; n < 2; ++n) _Pragma("unroll") for (int k = 0; k < 2; ++k) dst[n][k] = *(const LAS bf16x8*)(lds + PG8_SB(b, h) + boff + n * 2048 + k * 1024); } while (0)
#define PG8_MMA(ai, bj, At, Bt) do { __builtin_amdgcn_s_setprio(1); _Pragma("unroll") for (int m = 0; m < 4; ++m) _Pragma("unroll") for (int n = 0; n < 2; ++n) _Pragma("unroll") for (int k = 0; k < 2; ++k) \
        acc[ai][bj][m][n] = __builtin_amdgcn_mfma_f32_16x16x32_bf16(Bt[n][k], At[m][k], acc[ai][bj][m][n], 0, 0, 0); __builtin_amdgcn_s_setprio(0); } while (0)
#define PG8_WAIT_V(n) asm volatile("s_waitcnt vmcnt(" #n ")" ::: "memory")
#define PG8_WAIT_L(n) asm volatile("s_waitcnt lgkmcnt(" #n ")" ::: "memory")
#define PG8_BAR __builtin_amdgcn_s_barrier()
#define PG8_SCHED __builtin_amdgcn_sched_barrier(0)
#define PG8_VOFFA(u, vo) do { _Pragma("unroll") for (int h = 0; h < 2; ++h) _Pragma("unroll") for (int i = 0; i < 2; ++i) { int R_, C_; stage_rc(tid * 16 + i * 8192, R_, C_); const int R = R_ + HALF * h; \
        int ridx = R; if (GATHER) { ridx = (R < (u).nvalid) ? ((u).rows[R] >> 1) : 0; } vo[h][i] = (unsigned)(ridx * lda + C_) * 2u; } if (GATHER) asm volatile("" :: "v"(vo[0][0]), "v"(vo[0][1]), "v"(vo[1][0]), "v"(vo[1][1])); } while (0)
    GU cur, nxt; int ui = 0;
    if (!S.next(0, cur)) return;
    f32x4 acc[2][2][4][2];
#pragma unroll
    for (int a = 0; a < 2; ++a)
#pragma unroll
        for (int b = 0; b < 2; ++b)
#pragma unroll
            for (int m = 0; m < 4; ++m)
#pragma unroll
                for (int n = 0; n < 2; ++n) acc[a][b][m][n] = (f32x4){0.f, 0.f, 0.f, 0.f};
    bf16x8 At[4][2], B0[2][2], B1[2][2];
    unsigned cv[2][2], nv[2][2];
    PG8_VOFFA(cur, cv);
    const char* cA = cur.A; const char* cB = cur.B;
    PG8_STAGEB(PG8_SB(0, 0), cB); PG8_STAGEB(PG8_SB(0, 1), cB + hstepB); PG8_STAGE2(PG8_SA(0, 0), cA, cv[0][0], cv[0][1]); PG8_STAGE2(PG8_SA(0, 1), cA, cv[1][0], cv[1][1]);
    if (wr == 1) PG8_BAR;
    PG8_WAIT_V(2); PG8_BAR;
    PG8_STAGEB(PG8_SB(1, 0), cB + kstep); PG8_STAGE2(PG8_SA(1, 0), cA + kstep, cv[0][0], cv[0][1]); PG8_STAGEB(PG8_SB(1, 1), cB + hstepB + kstep);
    PG8_WAIT_V(6); PG8_BAR;
    for (;;) {
        const bool has_next = S.next(ui + 1, nxt);
        const char* nA = has_next ? nxt.A : cA; const char* nB = has_next ? nxt.B : cB;
        if (has_next) { PG8_VOFFA(nxt, nv); } else {
#pragma unroll
            for (int h = 0; h < 2; ++h)
#pragma unroll
                for (int i = 0; i < 2; ++i) nv[h][i] = cv[h][i]; }
        for (int t = 0; t < nt; t += 2) {
            const bool last = (t == nt - 2);
            const char* a1 = cA + (size_t)(t + 1) * kstep;
            const char* a2 = last ? nA : cA + (size_t)(t + 2) * kstep; const char* b2 = last ? nB : cB + (size_t)(t + 2) * kstep;
            const char* a3 = a2 + kstep; const char* b3 = b2 + kstep;
            const unsigned w00 = last ? nv[0][0] : cv[0][0], w01 = last ? nv[0][1] : cv[0][1], w10 = last ? nv[1][0] : cv[1][0], w11 = last ? nv[1][1] : cv[1][1];
            PG8_LDB(B0, 0, 0); PG8_LDB(B1, 0, 1); PG8_SCHED; PG8_LDA(At, 0, 0); PG8_STAGE2(PG8_SA(1, 1), a1, cv[1][0], cv[1][1]);
            PG8_WAIT_V(8); PG8_WAIT_L(0); PG8_BAR; PG8_MMA(0, 0, At, B0); PG8_MMA(0, 1, At, B1); PG8_BAR; PG8_SCHED;
            PG8_LDA(At, 0, 1); PG8_STAGEB(PG8_SB(0, 0), b2); PG8_STAGEB(PG8_SB(0, 1), b2 + hstepB); PG8_STAGE2(PG8_SA(0, 0), a2, w00, w01);
            PG8_WAIT_V(8); PG8_WAIT_L(0); PG8_BAR; PG8_MMA(1, 0, At, B0); PG8_MMA(1, 1, At, B1); PG8_BAR; PG8_SCHED;
            PG8_LDB(B0, 1, 0); PG8_LDB(B1, 1, 1); PG8_SCHED; PG8_LDA(At, 1, 0); PG8_STAGE2(PG8_SA(0, 1), a2, w10, w11);
            PG8_WAIT_V(8); PG8_WAIT_L(0); PG8_BAR; PG8_MMA(0, 0, At, B0); PG8_MMA(0, 1, At, B1); PG8_BAR; PG8_SCHED;
            PG8_LDA(At, 1, 1); PG8_STAGEB(PG8_SB(1, 0), b3); PG8_STAGEB(PG8_SB(1, 1), b3 + hstepB); PG8_STAGE2(PG8_SA(1, 0), a3, w00, w01);
            PG8_WAIT_V(8); PG8_WAIT_L(0); PG8_BAR; PG8_MMA(1, 0, At, B0); PG8_MMA(1, 1, At, B1); PG8_BAR; PG8_SCHED;
        }
        if (wr == 0) PG8_BAR;
        E(acc, cur, wr, wc, fr, fq);
        if (!has_next) break;
#pragma unroll
        for (int a = 0; a < 2; ++a)
#pragma unroll
            for (int b = 0; b < 2; ++b)
#pragma unroll
                for (int m = 0; m < 4; ++m)
#pragma unroll
                    for (int n = 0; n < 2; ++n) acc[a][b][m][n] = (f32x4){0.f, 0.f, 0.f, 0.f};
        cur = nxt; cA = nA; cB = nB; ++ui;
#pragma unroll
        for (int h = 0; h < 2; ++h)
#pragma unroll
            for (int i = 0; i < 2; ++i) cv[h][i] = nv[h][i];
        if (wr == 1) PG8_BAR;
    }
    PG8_WAIT_V(0);
    PG8_BAR;
#undef PG8_SA
#undef PG8_SB
#undef PG8_STAGE2
#undef PG8_STAGEB
#undef PG8_LDA
#undef PG8_LDB
#undef PG8_MMA
#undef PG8_WAIT_V
#undef PG8_WAIT_L
#undef PG8_BAR
#undef PG8_SCHED
#undef PG8_VOFFA
}
}
using pg8::GU;

struct Args {
    const float* in[27]; float* out; unsigned char* ws; int ph_lo, ph_hi; int pad0, pad1;
};
enum { IN_X = 0, IN_MEM, IN_NORM_MIX_G, IN_W_IN, IN_W_RET_O, IN_W_NSA_O, IN_W_OUT, IN_CMP_PE_K, IN_CMP_W1_K, IN_CMP_W2_K, IN_CMP_PE_V, IN_CMP_W1_V, IN_CMP_W2_V,
       IN_NORM_X_G, IN_NORM_MEM_G, IN_W_XQ, IN_W_XKV, IN_W_XO, IN_NORM_FFN_G, IN_W_GRP, IN_B_GRP, IN_W_RT, IN_B_RT, IN_W_E1, IN_W_E3, IN_W_E2, IN_NORM_F_G };
struct Frame {
    LAS unsigned char* lds; volatile LAS unsigned* MISC; unsigned* ctl; unsigned char* ws;
    int tid, lane, wave, G, bx;
};

__device__ __forceinline__ bool phase_begin(Frame& F) { int t = threadIdx.x; LAUNDER(t); F.tid = t; F.lane = t & 63; return true; }
__device__ __forceinline__ void transpose_item(const float* W, int ldw, int c0, int k0, bf16* WT, int ldt, int mode, int row_off, int cbase, const float* kscale, float scale, LAS float* scr, int lane) {
    float vv[32];
#pragma unroll
    for (int i = 0; i < 32; ++i) { const int kk = 2 * i + (lane >> 5); vv[i] = W[(size_t)(k0 + kk) * ldw + c0 + (lane & 31)]; }
    if (kscale) {
#pragma unroll
        for (int i = 0; i < 32; ++i) { const int kk = 2 * i + (lane >> 5); vv[i] *= kscale[k0 + kk]; } }
#pragma unroll
    for (int i = 0; i < 32; ++i) { const int kk = 2 * i + (lane >> 5); scr[kk * 33 + (lane & 31)] = vv[i] * scale; }
    LDS_WAIT(); asm volatile("" ::: "memory");
    const int c = lane & 7;
#pragma unroll
    for (int j = 0; j < 4; ++j) { const int n = (lane >> 3) + 8 * j; const LAS float* s = scr + (8 * c) * 33 + n;
        u32x4 o; o.x = pk2(s[0 * 33], s[1 * 33]); o.y = pk2(s[2 * 33], s[3 * 33]); o.z = pk2(s[4 * 33], s[5 * 33]); o.w = pk2(s[6 * 33], s[7 * 33]);
        const int jc = c0 - cbase + n; const int drow = mode == 0 ? row_off + jc : (8 * (jc >> 2) + 4 * row_off + (jc & 3));
        *(u32x4*)(WT + (size_t)drow * ldt + k0 + 8 * c) = o; }
    LDS_WAIT(); asm volatile("" ::: "memory");
}
__device__ __forceinline__ void transpose_matrix(Frame& F, int& item_base, const float* W, int ldw, int K, int cbase, int ncols, bf16* WT, int ldt, int mode, int row_off, const float* kscale, float scale) {
    LAS float* scr = (LAS float*)(F.lds + F.wave * 16384);
    const int gw = F.bx * NWAVES + F.wave, NGW = F.G * NWAVES;
    const int nb = ncols / 32, nitems = (K / 64) * nb;
    int it = (gw - item_base % NGW + NGW) % NGW;
    for (; it < nitems; it += NGW) transpose_item(W, ldw, cbase + 32 * (it % nb), 64 * (it / nb), WT, ldt, mode, row_off, cbase, kscale, scale, scr, F.lane);
    item_base += nitems;
}
__device__ __forceinline__ void rms_row_to_bf16(int lane, const float* xrow, const float* g, bf16* orow) {
    const f32x4* xr = (const f32x4*)xrow + lane; const f32x4* gr = (const f32x4*)g + lane;
    f32x4 v[4]; float s = 0.f;
#pragma unroll
    for (int j = 0; j < 4; ++j) { v[j] = xr[64 * j]; s += (v[j].x * v[j].x + v[j].y * v[j].y) + (v[j].z * v[j].z + v[j].w * v[j].w); }
    const float rstd = 1.0f / sqrtf(wave_sum(s) * (1.f / D) + EPS);
    unsigned long long* o8 = (unsigned long long*)orow + lane;
#pragma unroll
    for (int j = 0; j < 4; ++j) { const f32x4 gg = gr[64 * j];
        o8[64 * j] = (unsigned long long)pk2(v[j].x * rstd * gg.x, v[j].y * rstd * gg.y) | ((unsigned long long)pk2(v[j].z * rstd * gg.z, v[j].w * rstd * gg.w) << 32); }
}

struct XItem { const float* src; bf16* dst; const float* ks; float scale; int ldw, ldt, mode, row_off, csrc, c0, k0, has_ks; };
__device__ __forceinline__ void xitem_decode_expert(const Args& a, unsigned char* ws, int it, XItem& x) {
    const int e = it / 768, r = it % 768, which = r >> 8, t = r & 255;
    x.ks = a.in[IN_NORM_FFN_G]; x.scale = 1.0f;
    if (which < 2) { x.src = a.in[which ? IN_W_E3 : IN_W_E1] + (size_t)e * D * DEXP; x.ldw = DEXP; x.dst = (bf16*)(ws + WS_W13) + (size_t)e * D * D; x.ldt = D; x.mode = 1; x.row_off = which; x.has_ks = 1; x.c0 = 32 * (t & 15); x.k0 = 64 * (t >> 4); }
    else { x.src = a.in[IN_W_E2] + (size_t)e * DEXP * D; x.ldw = D; x.dst = (bf16*)(ws + WS_W2) + (size_t)e * D * DEXP; x.ldt = DEXP; x.mode = 0; x.row_off = 0; x.has_ks = 0; x.c0 = 32 * (t & 31); x.k0 = 64 * (t >> 5); }
    x.csrc = x.c0;
}
constexpr int P0_NITEMS = 7936;
__device__ __forceinline__ void xitem_decode_p0(const Args& a, unsigned char* ws, int it, XItem& x) {
    int in_ = IN_W_IN, ldw = DIN, cb = 0, nc = 512, ldt = D, ro = 0, first = 0; size_t dst = W_IN; float sc = 1.0f; int hk = 0;
#define P0E(FIRST, IN__, LDW, CB, NC, DST, LDT, RO, SC, HK) if (it >= (FIRST)) { in_ = (IN__); ldw = (LDW); cb = (CB); nc = (NC); dst = (DST); ldt = (LDT); ro = (RO); sc = (SC); hk = (HK); first = (FIRST); }
    P0E(256, IN_W_IN, DIN, 512, 512, W_IN, D, 512, 0.08838834764831845f, 0)
    P0E(512, IN_W_IN, DIN, 1024, NPROJ - 1024, W_IN, D, 1024, 1.0f, 0)
    P0E(2816, IN_W_IN, DIN, C_GA, 1024, W_GA, D, 0, 1.0f, 0)
    P0E(3328, IN_W_IN, DIN, C_GB, 1024, W_GB, D, 0, 1.0f, 0)
    P0E(3840, IN_W_RET_O, D, 0, D, W_RO, D, 0, 1.0f, 0)
    P0E(4352, IN_W_NSA_O, D, 0, D, W_NO, D, 0, 1.0f, 0)
    P0E(4864, IN_W_OUT, D, 0, D, W_OUT, D, 0, 1.0f, 0)
    P0E(5376, IN_W_XQ, D, 0, D, W_XQ, D, 0, 1.0f, 1)
    P0E(5888, IN_W_XO, D, 0, D, W_XO, D, 0, 1.0f, 0)
    P0E(6400, IN_W_XKV, 2 * D, 0, 2 * D, W_XKV, D, 0, 1.0f, 0)
    P0E(7424, IN_CMP_W1_K, 128, 0, 128, W_C1K, 4096, 0, 1.0f, 0)
    P0E(7680, IN_CMP_W1_V, 128, 0, 128, W_C1V, 4096, 0, 1.0f, 0)
#undef P0E
    const int t = it - first, nb = nc >> 5;
    x.src = a.in[in_]; x.dst = (bf16*)(ws + dst); x.ks = a.in[IN_NORM_X_G]; x.scale = sc; x.ldw = ldw; x.ldt = ldt; x.mode = 0; x.row_off = ro; x.has_ks = hk;
    x.c0 = 32 * (t % nb); x.csrc = cb + x.c0; x.k0 = 64 * (t / nb);
}
__device__ __forceinline__ void xitem_load(const XItem& x, int lane, float (&vv)[32], f32x4& k0v, f32x4& k1v) {
#pragma unroll
    for (int i = 0; i < 32; ++i) { const int kk = 2 * i + (lane >> 5); vv[i] = x.src[(size_t)(x.k0 + kk) * x.ldw + x.csrc + (lane & 31)]; }
    const f32x4* p = (const f32x4*)(x.ks + ((x.k0 + 8 * (lane & 7)) & 1023)); k0v = p[0]; k1v = p[1];
}
__device__ __forceinline__ void xitem_finish(const XItem& x, int lane, const float (&vv)[32], f32x4 k0v, f32x4 k1v, LAS float* scr) {
    if (!x.has_ks) { k0v = (f32x4){1.f, 1.f, 1.f, 1.f}; k1v = k0v; }
    k0v *= x.scale; k1v *= x.scale;
#pragma unroll
    for (int i = 0; i < 32; ++i) { const int kk = 2 * i + (lane >> 5); scr[kk * 33 + (lane & 31)] = vv[i]; }
    LDS_WAIT(); asm volatile("" ::: "memory");
    const int c = lane & 7;
#pragma unroll
    for (int j = 0; j < 4; ++j) { const int n = (lane >> 3) + 8 * j; const LAS float* s = scr + (8 * c) * 33 + n;
        u32x4 o; o.x = pk2(s[0 * 33] * k0v.x, s[1 * 33] * k0v.y); o.y = pk2(s[2 * 33] * k0v.z, s[3 * 33] * k0v.w); o.z = pk2(s[4 * 33] * k1v.x, s[5 * 33] * k1v.y); o.w = pk2(s[6 * 33] * k1v.z, s[7 * 33] * k1v.w);
        const int jc = x.c0 + n; const int drow = x.mode == 0 ? x.row_off + jc : (8 * (jc >> 2) + 4 * x.row_off + (jc & 3));
        *(u32x4*)(x.dst + (size_t)drow * x.ldt + x.k0 + 8 * c) = o; }
    LDS_WAIT(); asm volatile("" ::: "memory");
}
template <bool EXPERT>
__device__ __forceinline__ void run_items(Frame& F, const Args& a, int it_begin, int it_end) {
    LAS float* scr = (LAS float*)(F.lds + F.wave * 16384);
    const int gw = F.bx * NWAVES + F.wave, NGW = F.G * NWAVES, lane = F.lane;
    int it = it_begin + gw;
#define XDEC(i_, x_) do { if (EXPERT) xitem_decode_expert(a, F.ws, (i_), x_); else xitem_decode_p0(a, F.ws, (i_), x_); } while (0)
    if (it < it_end) {
        float va[32], vb[32]; f32x4 ka0, ka1, kb0, kb1; XItem xa, xb;
        XDEC(it, xa); xitem_load(xa, lane, va, ka0, ka1);
        for (;;) {
            int itn = it + NGW; bool hn = itn < it_end;
            XDEC(hn ? itn : it, xb); xitem_load(xb, lane, vb, kb0, kb1);
            xitem_finish(xa, lane, va, ka0, ka1, scr);
            if (!hn) break;
            it = itn; itn = it + NGW; hn = itn < it_end;
            XDEC(hn ? itn : it, xa); xitem_load(xa, lane, va, ka0, ka1);
            xitem_finish(xb, lane, vb, kb0, kb1, scr);
            if (!hn) break;
            it = itn;
        }
    }
#undef XDEC
    __syncthreads();
}
__device__ __forceinline__ void expert_copies(Frame& F, const Args& a, int e_lo, int e_hi) { run_items<true>(F, a, e_lo * 768, e_hi * 768); }

__device__ __forceinline__ void p0_prologue(Frame& F, const Args& a) {
    unsigned char* ws = F.ws;
    const float* w_in = a.in[IN_W_IN];
    run_items<false>(F, a, 0, P0_NITEMS);
    const int gt = F.bx * NTHREADS + F.tid, NGT = F.G * NTHREADS;
    for (int i = gt; i < 2 * 128 * 4096 / 8; i += NGT) { const int m = i / (128 * 4096 / 8), r = i % (128 * 4096 / 8);
        *(u32x4*)(ws + (m ? W_C1V : W_C1K) + (size_t)128 * 4096 * 2 + (size_t)r * 16) = (u32x4){0u, 0u, 0u, 0u}; }
    bf16* wngl = (bf16*)(ws + WS_SMALLW);
    for (int i = gt; i < 32 * 1024; i += NGT) { const int r = i >> 10, k = i & 1023; wngl[i] = r < 24 ? (bf16)f2bf(w_in[(size_t)k * DIN + C_NGL + r]) : (bf16)0; }
    bf16* w2k = (bf16*)(ws + WS_SMALLW + 65536); bf16* w2v = w2k + 128 * 128;
    for (int i = gt; i < 2 * 128 * 128; i += NGT) { const int m = i >> 14, r = i & 16383, f = r >> 7, e = r & 127; const float* src = a.in[m ? IN_CMP_W2_V : IN_CMP_W2_K];
        (m ? w2v : w2k)[f * 128 + e] = (bf16)f2bf(src[e * 128 + f]); }
    { const float* gff = a.in[IN_NORM_FFN_G]; const float* wgrp = a.in[IN_W_GRP]; const float* wrt = a.in[IN_W_RT]; float* wgp = (float*)(ws + WS_RTW); float* wep = wgp + 4096;
      for (int i = gt; i < 4096; i += NGT) wgp[i] = gff[i >> 2] * wgrp[i];
      for (int i = gt; i < 32768; i += NGT) { const int j = i & 3, l = (i >> 2) & 63, half = (i >> 8) & 1, ii = (i >> 9) & 15, grp = i >> 13, k = 64 * ii + l; wep[i] = gff[k] * wrt[k * 32 + grp * 8 + half * 4 + j]; } }
    float* cbias = (float*)(ws + WS_SMALLW + 65536 + 2 * 128 * 128 * 2);
    const int gw = F.bx * NWAVES + F.wave, NGW = F.G * NWAVES;
    for (int o = gw; o < 256; o += NGW) { const int m = o >> 7, e = o & 127; const float* pe = a.in[m ? IN_CMP_PE_V : IN_CMP_PE_K]; const float* w1 = a.in[m ? IN_CMP_W1_V : IN_CMP_W1_K];
        float s = 0.f; for (int k = F.lane; k < 4096; k += 64) s += pe[k] * w1[(size_t)k * 128 + e];
        s = wave_sum(s); if (F.lane == 0) cbias[o] = s; }
    float* cosT = (float*)(ws + WS_ROPE_COS); float* sinT = (float*)(ws + WS_ROPE_SIN);
    for (int i = gt; i < SEQ * 64; i += NGT) { const int pos = i >> 6, j = i & 63; const float inv = powf(10000.0f, -(float)(2 * j) / 128.0f); const float ang = (float)pos * inv;
        cosT[i] = cosf(ang); sinT[i] = sinf(ang); }
    { f32x4 nx[4]; const float* X = a.in[IN_X]; const f32x4* gr = (const f32x4*)a.in[IN_NORM_MIX_G] + F.lane;
      if (gw < NTOK) {
#pragma unroll
          for (int j = 0; j < 4; ++j) nx[j] = ((const f32x4*)(X + (size_t)gw * D) + F.lane)[64 * j]; }
      for (int m = gw; m < NTOK; m += NGW) { f32x4 v[4]; float sq = 0.f;
#pragma unroll
          for (int j = 0; j < 4; ++j) { v[j] = nx[j]; sq += (v[j].x * v[j].x + v[j].y * v[j].y) + (v[j].z * v[j].z + v[j].w * v[j].w); }
          if (m + NGW < NTOK) {
#pragma unroll
              for (int j = 0; j < 4; ++j) nx[j] = ((const f32x4*)(X + (size_t)(m + NGW) * D) + F.lane)[64 * j]; }
          const float rstd = 1.0f / sqrtf(wave_sum(sq) * (1.f / D) + EPS); unsigned long long* o8 = (unsigned long long*)((bf16*)(ws + WS_H) + (size_t)m * D) + F.lane;
#pragma unroll
          for (int j = 0; j < 4; ++j) { const f32x4 gg = gr[64 * j]; o8[64 * j] = (unsigned long long)pk2(v[j].x * rstd * gg.x, v[j].y * rstd * gg.y) | ((unsigned long long)pk2(v[j].z * rstd * gg.z, v[j].w * rstd * gg.w) << 32); } } }
    for (int m = gw; m < NMEMTOK; m += NGW) rms_row_to_bf16(F.lane, a.in[IN_MEM] + (size_t)m * D, a.in[IN_NORM_MEM_G], (bf16*)(ws + WS_MEMN) + (size_t)m * D);
}

struct SchedP1 {
    unsigned char* ws; int G, c;
    __device__ __forceinline__ bool next(int i, GU& u) const {
        constexpr int NP = 128 * 22; const int L = i * G + c;
        u.rows = nullptr; u.nvalid = 0; u.aux = 0;
        if (L < NP) { int pm, pn; pg8::tile_map(L, 128, 22, pm, pn); u.A = (const char*)ws + WS_H + (size_t)pm * 256 * D * 2; u.B = (const char*)ws + W_IN + (size_t)pn * 256 * D * 2; u.pm = pm; u.pn = pn;
            u.kind = pn < 2 ? 0 : pn < 4 ? 1 : pn < 8 ? 2 : pn < 12 ? 3 : pn < 16 ? 4 : 5; return true; }
        const int L2 = L - NP; if (L2 >= 64) return false;
        const int pm = L2 & 7, pn = L2 >> 3; u.A = (const char*)ws + WS_MEMN + (size_t)pm * 256 * D * 2; u.B = (const char*)ws + W_XKV + (size_t)pn * 256 * D * 2; u.pm = pm; u.pn = pn; u.kind = 6; return true;
    }
};
struct EpiP1 {
    static constexpr bool PERM = true;
    unsigned char* ws;
    __device__ __forceinline__ void operator()(const f32x4 (&acc)[2][2][4][2], const GU& u, int wr, int wc, int fr, int fq) const {
        const int kind = u.kind;
        const float* cosT = (const float*)(ws + WS_ROPE_COS); const float* sinT = (const float*)(ws + WS_ROPE_SIN);
#pragma unroll
        for (int ai = 0; ai < 2; ++ai)
#pragma unroll
            for (int m = 0; m < 4; ++m) {
                const int r = 128 * ai + 64 * wr + 16 * m + fr; const int tok = u.pm * 256 + r;
#pragma unroll
                for (int bj = 0; bj < 2; ++bj) {
                    f32x4 v0 = acc[ai][bj][m][0], v1 = acc[ai][bj][m][1];
                    const int ct = 128 * bj + 32 * wc + 8 * fq;
                    bf16* dst;
                    if (kind <= 1) {
                        const int s = tok & (SEQ - 1), i0 = ((ct & 127) >> 1);
                        const f32x4 cs = *(const f32x4*)(cosT + s * 64 + i0), sn = *(const f32x4*)(sinT + s * 64 + i0);
                        const f32x4 a0 = v0, a1 = v1;
                        v0[0] = a0[0] * cs[0] - a0[1] * sn[0]; v0[1] = a0[0] * sn[0] + a0[1] * cs[0];
                        v0[2] = a0[2] * cs[1] - a0[3] * sn[1]; v0[3] = a0[2] * sn[1] + a0[3] * cs[1];
                        v1[0] = a1[0] * cs[2] - a1[1] * sn[2]; v1[1] = a1[0] * sn[2] + a1[1] * cs[2];
                        v1[2] = a1[2] * cs[3] - a1[3] * sn[3]; v1[3] = a1[2] * sn[3] + a1[3] * cs[3];
                        dst = (bf16*)(ws + (kind == 0 ? WS_RQ : WS_RK)) + (size_t)tok * 512 + (u.pn & 1) * 256 + ct;
                    } else if (kind == 2) { dst = (bf16*)(ws + WS_RV) + (size_t)tok * 1024 + (u.pn - 4) * 256 + ct;
                    } else if (kind == 3) {
#pragma unroll
                        for (int j = 0; j < 4; ++j) { v0[j] = v0[j] * sigmoidf_(v0[j]); v1[j] = v1[j] * sigmoidf_(v1[j]); }
                        dst = (bf16*)(ws + WS_RG) + (size_t)tok * 1024 + (u.pn - 8) * 256 + ct;
                    } else if (kind == 4) { dst = (bf16*)(ws + WS_NQ) + (size_t)tok * 1024 + (u.pn - 12) * 256 + ct;
                    } else if (kind == 5) {
                        const int b = tok >> 12, s = tok & (SEQ - 1);
                        unsigned char* kvb = ws + WS_KV6 + (size_t)(u.pn - 16) * KV_STRIDE;
                        dst = (bf16*)kvb + ((size_t)(b * 2 + bj) * SEQ + s) * 128 + (ct & 127);
                    } else { dst = (bf16*)(ws + WS_MEMKV) + (size_t)tok * 2048 + u.pn * 256 + ct; }
                    u32x4 w; w.x = cvt_pk_bf16(v0[0], v0[1]); w.y = cvt_pk_bf16(v0[2], v0[3]); w.z = cvt_pk_bf16(v1[0], v1[1]); w.w = cvt_pk_bf16(v1[2], v1[3]);
                    *(u32x4*)dst = w;
                }
            }
    }
};
__device__ __forceinline__ void p1_gate_logits(Frame& F) {
    const bf16* H = (const bf16*)(F.ws + WS_H); const bf16* W = (const bf16*)(F.ws + WS_SMALLW); float* gates = (float*)(F.ws + WS_GATES);
    const int r = F.lane & 31, hh = F.lane >> 5;
    const int nb_ = F.G > 64 ? F.G - 64 : F.G, b0_ = F.G > 64 ? F.bx - 64 : F.bx;
    if (b0_ < 0) return;
    for (int rb = b0_ + nb_ * F.wave; rb < NTOK / 32; rb += nb_ * NWAVES) {
        f32x16 acc; for (int j = 0; j < 16; ++j) acc[j] = 0.f;
        const bf16* ap = H + (size_t)(rb * 32 + r) * D + 8 * hh; const bf16* bp = W + (size_t)r * D + 8 * hh;
        for (int s8 = 0; s8 < 8; ++s8) { bf16x8 av[8], bv[8];
#pragma unroll
            for (int q = 0; q < 8; ++q) { av[q] = *(const bf16x8*)(ap + 16 * (8 * s8 + q)); bv[q] = *(const bf16x8*)(bp + 16 * (8 * s8 + q)); }
#pragma unroll
            for (int q = 0; q < 8; ++q) acc = __builtin_amdgcn_mfma_f32_32x32x16_bf16(av[q], bv[q], acc, 0, 0, 0); }
        if (r < 24) {
#pragma unroll
            for (int reg = 0; reg < 16; ++reg) { const int row = (reg & 3) + 8 * (reg >> 2) + 4 * hh; gates[(size_t)(rb * 32 + row) * 24 + r] = sigmoidf_(acc[reg]); }
        }
    }
}

namespace retf {
constexpr int ROWB = 272;
constexpr int OFF_K = 0, OFF_V = 128 * 256, OFF_ZV = OFF_V + 128 * 64, OFF_ST = OFF_ZV + 128 * 64, OFF_PART = OFF_ST + 32 * ROWB, OFF_Q = OFF_PART + 4 * 4096;
static_assert(OFF_Q + 128 * 256 <= RING_BYTES, "retention LDS map");
typedef short s16x4 __attribute__((ext_vector_type(4)));
__device__ __forceinline__ u32x2 lds_tr(const LAS unsigned char* p) { return __builtin_bit_cast(u32x2, __builtin_amdgcn_ds_read_tr16_b64_v4i16((LAS s16x4*)p)); }
}
__device__ __forceinline__ void p2_retention_fast(Frame& F, int unit, bf16* outbase) {
    using namespace retf;
    const int bh = (unit & 7) * 4 + (unit >> 6), sl = (unit >> 3) & 7, b = bh >> 2, h = bh & 3;
    const bf16* rq = (const bf16*)(F.ws + WS_RQ); const bf16* rk = (const bf16*)(F.ws + WS_RK); const bf16* rv = (const bf16*)(F.ws + WS_RV);
    const int tid = F.tid, lane = F.lane, wave = F.wave, r = lane & 31, hi = lane >> 5; LAS unsigned char* lds = F.lds;
    const float lg = log2f(1.0f - exp2f(-5.0f - (float)h));
    const int nt = wave & 3, mh = wave >> 2;
    for (int i = tid; i < 32 * ROWB / 4; i += NTHREADS) ((LAS unsigned*)(lds + OFF_ST))[i] = 0u;
    f32x16 ST;
#pragma unroll
    for (int j = 0; j < 16; ++j) ST[j] = 0.f;
    const float gC = exp2f(128.0f * lg);
    const float zeta = exp2f((float)(127 - (tid >> 2)) * lg);
    const int blk = (lane >> 4) & 1, q4 = (lane & 15) >> 2, p4 = lane & 3;
    const int vtr = (4 * hi + q4) * 64 + 32 * blk + 8 * p4;
    const int ztr = (8 * hi + q4) * 64 + 32 * blk + 8 * p4;
    int ktr[2];
#pragma unroll
    for (int t = 0; t < 2; ++t) ktr[t] = 256 * (8 * hi + 4 * t + q4) + 16 * ((4 * nt + 2 * blk + (p4 >> 1)) ^ ((q4 << 2) | ((2 * hi + t) & 3))) + 8 * (p4 & 1);
    const int krow = 256 * r + 16 * (hi ^ (((r & 3) << 2) | ((r >> 2) & 3)));
    u32x4 kreg[4], qreg[4], vreg;
    {   const int tok0 = b * SEQ;
#pragma unroll
        for (int i = 0; i < 4; ++i) { const int p = tid + 512 * i, m = p >> 4, cc = p & 15; kreg[i] = *(const u32x4*)(rk + (size_t)(tok0 + m) * 512 + h * 128 + cc * 8); qreg[i] = *(const u32x4*)(rq + (size_t)(tok0 + m) * 512 + h * 128 + cc * 8); }
        { const int m = tid >> 2, cc = tid & 3; vreg = *(const u32x4*)(rv + (size_t)(tok0 + m) * 1024 + h * 256 + sl * 32 + cc * 8); } }
    u32x2 opk[4]; bf16* oprev = outbase;
#pragma unroll
    for (int i = 0; i < 4; ++i) opk[i] = (u32x2){0u, 0u};
    for (int c = 0; c < SEQ / 128; ++c) {
        const int tok0 = b * SEQ + c * 128;
        __syncthreads();
#pragma unroll
        for (int i = 0; i < 4; ++i) { const int p = tid + 512 * i, m = p >> 4, cc = p & 15; const int o_ = 256 * m + 16 * (cc ^ (((m & 3) << 2) | ((m >> 2) & 3)));
            *(LAS u32x4*)(lds + OFF_K + o_) = kreg[i]; *(LAS u32x4*)(lds + OFF_Q + o_) = qreg[i]; }
        { const u32x4 v = vreg; u32x4 zv;
            zv.x = cvt_pk_bf16(lo16(v.x) * zeta, hi16(v.x) * zeta); zv.y = cvt_pk_bf16(lo16(v.y) * zeta, hi16(v.y) * zeta); zv.z = cvt_pk_bf16(lo16(v.z) * zeta, hi16(v.z) * zeta); zv.w = cvt_pk_bf16(lo16(v.w) * zeta, hi16(v.w) * zeta);
            *(LAS u32x4*)(lds + OFF_V + tid * 16) = v; *(LAS u32x4*)(lds + OFF_ZV + tid * 16) = zv; }
        __syncthreads();
        if (mh == 0 && c > 0) {
#pragma unroll
            for (int i = 0; i < 4; ++i) *(u32x2*)(oprev + 8 * i + 4 * hi) = opk[i]; }
        if (c + 1 < SEQ / 128) { const int tok1 = tok0 + 128;
#pragma unroll
            for (int i = 0; i < 4; ++i) { const int p = tid + 512 * i, m = p >> 4, cc = p & 15; kreg[i] = *(const u32x4*)(rk + (size_t)(tok1 + m) * 512 + h * 128 + cc * 8); qreg[i] = *(const u32x4*)(rq + (size_t)(tok1 + m) * 512 + h * 128 + cc * 8); }
            { const int m = tid >> 2, cc = tid & 3; vreg = *(const u32x4*)(rv + (size_t)(tok1 + m) * 1024 + h * 256 + sl * 32 + cc * 8); } }
        bf16x8 qf[8];
#pragma unroll
        for (int s_ = 0; s_ < 8; ++s_) qf[s_] = *(const LAS bf16x8*)(lds + OFF_Q + 8192 * nt + (krow ^ (32 * s_)));
        f32x16 CR;
#pragma unroll
        for (int j = 0; j < 16; ++j) CR[j] = 0.f;
        if (mh == 0) {
#pragma unroll
            for (int s_ = 0; s_ < 8; ++s_) { const bf16x8 a = *(const LAS bf16x8*)(lds + OFF_ST + r * ROWB + (16 * s_ + 8 * hi) * 2); CR = __builtin_amdgcn_mfma_f32_32x32x16_bf16(a, qf[s_], CR, 0, 0, 0); }
        }
        f32x16 IN_;
#pragma unroll
        for (int j = 0; j < 16; ++j) IN_[j] = 0.f;
#pragma unroll
        for (int mi = 0; mi < 2; ++mi) { const int mt = 2 * mh + mi;
            if (mt <= nt) {
                f32x16 A;
#pragma unroll
                for (int j = 0; j < 16; ++j) A[j] = 0.f;
#pragma unroll
                for (int s_ = 0; s_ < 8; ++s_) { const bf16x8 a = *(const LAS bf16x8*)(lds + OFF_K + 8192 * mt + (krow ^ (32 * s_))); A = __builtin_amdgcn_mfma_f32_32x32x16_bf16(a, qf[s_], A, 0, 0, 0); }
#pragma unroll
                for (int j = 0; j < 16; ++j) { const int dd = (32 * nt + r) - (32 * mt + (j & 3) + 8 * (j >> 2) + 4 * hi); A[j] = dd >= 0 ? A[j] * __builtin_amdgcn_exp2f((float)dd * lg) : 0.f; }
#pragma unroll
                for (int s2 = 0; s2 < 2; ++s2) { u32x4 w; w.x = cvt_pk_bf16(A[8 * s2 + 0], A[8 * s2 + 1]); w.y = cvt_pk_bf16(A[8 * s2 + 2], A[8 * s2 + 3]); w.z = cvt_pk_bf16(A[8 * s2 + 4], A[8 * s2 + 5]); w.w = cvt_pk_bf16(A[8 * s2 + 6], A[8 * s2 + 7]);
                    const LAS unsigned char* vp = lds + OFF_V + vtr + (32 * mt + 16 * s2) * 64; const u32x2 lo = lds_tr(vp), hi2 = lds_tr(vp + 8 * 64);
                    IN_ = __builtin_amdgcn_mfma_f32_32x32x16_bf16(__builtin_bit_cast(bf16x8, (u32x4){lo.x, lo.y, hi2.x, hi2.y}), __builtin_bit_cast(bf16x8, w), IN_, 0, 0, 0); }
            } }
        if (mh == 1) {
#pragma unroll
            for (int j = 0; j < 16; ++j) ((LAS float*)(lds + OFF_PART))[(nt * 16 + j) * 64 + lane] = IN_[j];
        }
        __syncthreads();
        if (mh == 0) {
            const float xi = __builtin_amdgcn_exp2f((float)(32 * nt + r + 1) * lg);
            bf16* orow = outbase + (size_t)(tok0 + 32 * nt + r) * 1024 + h * 256 + sl * 32;
#pragma unroll
            for (int q4_ = 0; q4_ < 4; ++q4_) { float o_[4];
#pragma unroll
                for (int e = 0; e < 4; ++e) { const int j = 4 * q4_ + e; o_[e] = IN_[j] + ((const LAS float*)(lds + OFF_PART))[(nt * 16 + j) * 64 + lane] + xi * CR[j]; }
                opk[q4_] = (u32x2){cvt_pk_bf16(o_[0], o_[1]), cvt_pk_bf16(o_[2], o_[3])}; }
            oprev = orow;
        } else {
#pragma unroll
            for (int j = 0; j < 16; ++j) ST[j] *= gC;
#pragma unroll
            for (int s_ = 0; s_ < 8; ++s_) {
                const LAS unsigned char* zp = lds + OFF_ZV + ztr + (16 * s_) * 64; const u32x2 z0 = lds_tr(zp), z1 = lds_tr(zp + 4 * 64);
                const u32x2 k0 = lds_tr(lds + OFF_K + ktr[0] + 4096 * s_), k1 = lds_tr(lds + OFF_K + ktr[1] + 4096 * s_);
                ST = __builtin_amdgcn_mfma_f32_32x32x16_bf16(__builtin_bit_cast(bf16x8, (u32x4){z0.x, z0.y, z1.x, z1.y}), __builtin_bit_cast(bf16x8, (u32x4){k0.x, k0.y, k1.x, k1.y}), ST, 0, 0, 0); }
#pragma unroll
            for (int j = 0; j < 16; ++j) { const int dv = (j & 3) + 8 * (j >> 2) + 4 * hi; ((LAS unsigned short*)(lds + OFF_ST))[dv * (ROWB / 2) + 32 * nt + r] = (unsigned short)f2bf(ST[j]); }
        }
    }
    if (mh == 0) {
#pragma unroll
        for (int i = 0; i < 4; ++i) *(u32x2*)(oprev + 8 * i + 4 * hi) = opk[i]; }
    __syncthreads();
}
__device__ __forceinline__ void transpose_kv_tiles(Frame& F, const bf16* src, bf16* dst, int w0, int nw) {
    LAS unsigned short* tl_ = (LAS unsigned short*)(F.lds + F.wave * 16384); const int lane = F.lane;
    for (int tile = w0; tile < 16 * 64 * 2; tile += nw) {
        const int dh = tile & 1, st = (tile >> 1) & 63, bg = tile >> 7;
        const bf16* sp = src + ((size_t)bg * SEQ + st * 64) * 128 + dh * 64; bf16* dp = dst + ((size_t)bg * 128 + dh * 64) * SEQ + st * 64;
#pragma unroll
        for (int i = 0; i < 8; ++i) { const int row = i * 8 + (lane >> 3), c = lane & 7; const u32x4 v = *(const u32x4*)(sp + (size_t)row * 128 + c * 8); LAS unsigned short* q = tl_ + row * 66 + c * 8;
            q[0] = (unsigned short)(v.x & 0xffffu); q[1] = (unsigned short)(v.x >> 16); q[2] = (unsigned short)(v.y & 0xffffu); q[3] = (unsigned short)(v.y >> 16);
            q[4] = (unsigned short)(v.z & 0xffffu); q[5] = (unsigned short)(v.z >> 16); q[6] = (unsigned short)(v.w & 0xffffu); q[7] = (unsigned short)(v.w >> 16); }
        LDS_WAIT(); asm volatile("" ::: "memory");
#pragma unroll
        for (int i = 0; i < 8; ++i) { const int d = i * 8 + (lane >> 3), c = lane & 7; const LAS unsigned short* q = tl_ + (c * 8) * 66 + d;
            u32x4 o; o.x = (unsigned)q[0] | ((unsigned)q[66] << 16); o.y = (unsigned)q[2 * 66] | ((unsigned)q[3 * 66] << 16); o.z = (unsigned)q[4 * 66] | ((unsigned)q[5 * 66] << 16); o.w = (unsigned)q[6 * 66] | ((unsigned)q[7 * 66] << 16);
            *(u32x4*)(dp + (size_t)d * SEQ + c * 8) = o; }
        LDS_WAIT(); asm volatile("" ::: "memory");
    }
}
struct SchedCmp {
    unsigned char* ws; int first, G, c;
    __device__ __forceinline__ bool next(int i, GU& u) const {
        const int L = i * G + c - first; if (L < 0 || L >= 256) return false;
        const int ks = L & 7, mb = L >> 3, m = mb >> 4, bg = mb & 15;
        u.A = (const char*)ws + WS_KV6 + (size_t)m * KV_STRIDE + (size_t)bg * SEQ * 128 * 2 + (size_t)ks * 512 * 2; u.B = (const char*)ws + (m ? W_C1V : W_C1K) + (size_t)ks * 512 * 2;
        u.pm = mb; u.pn = 0; u.kind = ks; u.rows = nullptr; u.nvalid = 0; u.aux = 0; return true;
    }
};
struct EpiCmp {
    static constexpr bool PERM = false;
    float* hid;
    __device__ __forceinline__ void operator()(const f32x4 (&acc)[2][2][4][2], const GU& u, int wr, int wc, int fr, int fq) const {
#pragma unroll
        for (int ai = 0; ai < 2; ++ai)
#pragma unroll
            for (int m = 0; m < 4; ++m) { const int r = 128 * ai + 64 * wr + 16 * m + fr; float* rowp = hid + (size_t)u.kind * (32 * 256 * 128) + ((size_t)u.pm * 256 + r) * 128 + 32 * wc + 4 * fq;
#pragma unroll
                for (int n = 0; n < 2; ++n) *(f32x4*)(rowp + 16 * n) = acc[ai][0][m][n]; }
    }
};
__device__ __forceinline__ float gelu_tanh(float x) { const float u = 0.7978845608028654f * (x + 0.044715f * x * x * x); return 0.5f * x * (1.0f + tanhf(u)); }
__device__ __forceinline__ void p2b_compress_out(Frame& F, const Args& a) {
    const float* hid = (const float*)a.out + (size_t)16 * MiB; const float* cbias = (const float*)(F.ws + WS_SMALLW + 65536 + 2 * 128 * 128 * 2);
    const int gw = F.bx * NWAVES + F.wave, NGW = F.G * NWAVES;
    for (int row = gw; row < 2 * 16 * 256; row += NGW) {
        const int m = row >> 12, n = row & 255; const float* w2 = a.in[m ? IN_CMP_W2_V : IN_CMP_W2_K];
        bf16* dst = (bf16*)(F.ws + (m ? WS_VCMP : WS_KCMP)) + (size_t)(row & 4095) * 128;
        float o0 = 0.f, o1 = 0.f;
        if (n < 255) { const float* hr = hid + (size_t)row * 128;
            for (int e = 0; e < 128; ++e) { float hsum = 0.f;
#pragma unroll
                for (int ks = 0; ks < 8; ++ks) hsum += hr[(size_t)ks * (32 * 256 * 128) + e];
                const float g = gelu_tanh(hsum + cbias[m * 128 + e]); o0 += g * w2[e * 128 + F.lane]; o1 += g * w2[e * 128 + 64 + F.lane]; } }
        dst[F.lane] = (bf16)f2bf(o0); dst[64 + F.lane] = (bf16)f2bf(o1);
        if (m == 1) { bf16* dt = (bf16*)(F.ws + WS_VCMPT) + (size_t)((row >> 8) & 15) * 128 * 256 + n; dt[(size_t)F.lane * 256] = (bf16)f2bf(o0); dt[(size_t)(64 + F.lane) * 256] = (bf16)f2bf(o1); }
    }
}

__device__ __forceinline__ void p3_ret_normalize(Frame& F) {
    bf16* rv = (bf16*)(F.ws + WS_RV); const bf16* rg = (const bf16*)(F.ws + WS_RG);
    const int gw = F.bx * NWAVES + F.wave, NGW = F.G * NWAVES;
    for (int it = gw; it < NTOK * 4; it += NGW) {
        u32x2* p = (u32x2*)(rv + (size_t)it * 256) + F.lane; const u32x2 w = *p; const u32x2 gq = *((const u32x2*)(rg + (size_t)it * 256) + F.lane);
        const float o0 = lo16(w.x), o1 = hi16(w.x), o2 = lo16(w.y), o3 = hi16(w.y);
        const float ss = wave_sum((o0 * o0 + o1 * o1) + (o2 * o2 + o3 * o3));
        const float r = 1.0f / sqrtf(ss * (1.0f / 256.0f) + EPS);
        u32x2 q; q.x = pk2(o0 * r * lo16(gq.x), o1 * r * hi16(gq.x)); q.y = pk2(o2 * r * lo16(gq.y), o3 * r * hi16(gq.y)); *p = q;
    }
}
namespace nsaf {
constexpr int KROW = 272, VROW = 136, KT_BYTES = 64 * KROW, VT_BYTES = 128 * VROW;
constexpr int OFF_K = 0, OFF_V = KT_BYTES, BUF_BYTES = KT_BYTES + VT_BYTES, OFF_IMP = 2 * BUF_BYTES, OFF_MASK = OFF_IMP + 64 * 64 * 4;
constexpr float NEG = -1.0e30f, MASKED = -3.0e38f, CS = 0.08838834764831845f * 1.4426950408889634f;
struct Stage { u32x4 k0, k1, v0, v1; };
__device__ __forceinline__ void stage_load(Stage& st, const bf16* K, const bf16* VT, size_t vpitch, int key0, int tid) {
    const int r0 = tid >> 4, c0 = tid & 15;
    st.k0 = *(const u32x4*)(K + (size_t)(key0 + r0) * 128 + c0 * 8); st.k1 = *(const u32x4*)(K + (size_t)(key0 + r0 + 32) * 128 + c0 * 8);
    const int d0 = tid >> 3, c1 = tid & 7;
    st.v0 = *(const u32x4*)(VT + (size_t)d0 * vpitch + key0 + c1 * 8); st.v1 = *(const u32x4*)(VT + (size_t)(d0 + 64) * vpitch + key0 + c1 * 8);
}
__device__ __forceinline__ void stage_write(const Stage& st, LAS unsigned char* lds, int tid) {
    const int r0 = tid >> 4, c0 = tid & 15;
    *(LAS u32x4*)(lds + OFF_K + r0 * KROW + c0 * 16) = st.k0; *(LAS u32x4*)(lds + OFF_K + (r0 + 32) * KROW + c0 * 16) = st.k1;
    const int d0 = tid >> 3, c1 = tid & 7;
    LAS unsigned char* p0 = lds + OFF_V + d0 * VROW + c1 * 16; LAS unsigned char* p1 = lds + OFF_V + (d0 + 64) * VROW + c1 * 16;
    *(LAS u32x2*)p0 = (u32x2){st.v0.x, st.v0.y}; *(LAS u32x2*)(p0 + 8) = (u32x2){st.v0.z, st.v0.w};
    *(LAS u32x2*)p1 = (u32x2){st.v1.x, st.v1.y}; *(LAS u32x2*)(p1 + 8) = (u32x2){st.v1.z, st.v1.w};
}
template <int MODE>
__device__ __forceinline__ void block_step(const LAS unsigned char* lds, LAS unsigned char* ldstab, const bf16x8 (&qf)[8], f32x16 (&O)[4], float& m, float& l, int blk, int jfast, int tl_in, int itile, int nvr_in, bool rowsel, float inv_l, int lane_in) {
    int tl = tl_in, nvr = nvr_in, lane = lane_in; LAUNDER(tl); LAUNDER(nvr); LAUNDER(lane);
    const int r = lane & 31, hi = lane >> 5;
    f32x16 S[2];
#pragma unroll
    for (int kh = 0; kh < 2; ++kh) {
#pragma unroll
        for (int j = 0; j < 16; ++j) S[kh][j] = 0.f;
    }
    {
        const unsigned kaddr = (unsigned)(size_t)(lds + OFF_K + r * KROW + 16 * hi);
        u32x4 ka[4], kb[4];
#define NSAF_KRD(dst, t, s4) asm volatile("ds_read_b128 %0, %1 offset:%2" : "=v"(dst) : "v"(kaddr), "i"((t) * 32 * KROW + (s4) * 32))
#define NSAF_KRD4(set, t, s0) do { NSAF_KRD(set[0], t, (s0)); NSAF_KRD(set[1], t, (s0) + 1); NSAF_KRD(set[2], t, (s0) + 2); NSAF_KRD(set[3], t, (s0) + 3); } while (0)
#define NSAF_KWAIT(n, set) asm volatile("s_waitcnt lgkmcnt(" #n ")" : "+v"(set[0]), "+v"(set[1]), "+v"(set[2]), "+v"(set[3]))
#define NSAF_KMMA(set, t, s0) do { _Pragma("unroll") for (int q_ = 0; q_ < 4; ++q_) S[t] = __builtin_amdgcn_mfma_f32_32x32x16_bf16(__builtin_bit_cast(bf16x8, set[q_]), qf[(s0) + q_], S[t], 0, 0, 0); } while (0)
        NSAF_KRD4(ka, 0, 0); NSAF_KRD4(kb, 0, 4);
        NSAF_KWAIT(4, ka); NSAF_KMMA(ka, 0, 0); NSAF_KRD4(ka, 1, 0);
        NSAF_KWAIT(4, kb); NSAF_KMMA(kb, 0, 4); NSAF_KRD4(kb, 1, 4);
        NSAF_KWAIT(4, ka); NSAF_KMMA(ka, 1, 0);
        NSAF_KWAIT(0, kb); NSAF_KMMA(kb, 1, 4);
#undef NSAF_KRD
#undef NSAF_KRD4
#undef NSAF_KWAIT
#undef NSAF_KMMA
    }
    bool need_mask;
    if (MODE <= 1) need_mask = true; else if (MODE == 2) need_mask = (blk == itile); else need_mask = (blk == itile) || (blk == itile - 8);
    if (MODE >= 2 && !need_mask && blk >= jfast) {
        const float msub = (MODE == 2 && !rowsel) ? 3.0e38f : m;
        float rs = 0.f;
#pragma unroll
        for (int kh = 0; kh < 2; ++kh)
#pragma unroll
            for (int j = 0; j < 16; ++j) { const float p = __builtin_amdgcn_exp2f(S[kh][j] - msub); S[kh][j] = p; rs += p; }
        l += rs;
    } else {
    float mx = MASKED;
    if (need_mask) {
        int lo_ = -1, hi_ = 63;
        if (MODE <= 1) hi_ = nvr - 64 * blk - 1; else if (MODE == 2) hi_ = tl; else { hi_ = (blk == itile) ? tl : 63; lo_ = (blk == itile - 8) ? tl : -1; }
        lo_ -= 4 * hi; hi_ -= 4 * hi;
#pragma unroll
        for (int kh = 0; kh < 2; ++kh)
#pragma unroll
            for (int j = 0; j < 16; ++j) { const int kc_ = 32 * kh + (j & 3) + 8 * (j >> 2); const bool ok = (kc_ > lo_) & (kc_ <= hi_); const float v = ok ? S[kh][j] : MASKED; S[kh][j] = v; mx = fmaxf(mx, v); }
    } else {
#pragma unroll
        for (int kh = 0; kh < 2; ++kh)
#pragma unroll
            for (int j = 0; j < 16; ++j) mx = fmaxf(mx, S[kh][j]);
    }
    if (MODE == 2) mx = rowsel ? mx : MASKED;
    if (MODE == 1) {
        LAS float* imp = (LAS float*)(ldstab + OFF_IMP) + tl * 64;
#pragma unroll
        for (int kh = 0; kh < 2; ++kh)
#pragma unroll
            for (int j = 0; j < 16; ++j) { const int n = 64 * blk + 32 * kh + (j & 3) + 8 * (j >> 2) + 4 * hi; const float v = S[kh][j]; const float p = __builtin_amdgcn_exp2f(v - m) * inv_l; S[kh][j] = p;
                if (v > 0.5f * MASKED) { __hip_atomic_fetch_add(imp + (n >> 2), p, __ATOMIC_RELAXED, __HIP_MEMORY_SCOPE_WORKGROUP); if ((n & 3) == 3 && (n >> 2) + 1 < 64) __hip_atomic_fetch_add(imp + (n >> 2) + 1, p, __ATOMIC_RELAXED, __HIP_MEMORY_SCOPE_WORKGROUP); } }
    } else {
        mx = fmaxf(mx, __shfl_xor(mx, 32));
        if (__any(mx > m + 8.0f)) { const float mn = fmaxf(m, mx); const float alpha = __builtin_amdgcn_exp2f(m - mn); m = mn; l *= alpha;
            if (MODE != 0) {
#pragma unroll
                for (int dt = 0; dt < 4; ++dt)
#pragma unroll
                    for (int j = 0; j < 16; ++j) O[dt][j] *= alpha; } }
        float rs = 0.f;
        if (MODE == 2) {
#pragma unroll
            for (int kh = 0; kh < 2; ++kh)
#pragma unroll
                for (int j = 0; j < 16; ++j) { const float p = rowsel ? __builtin_amdgcn_exp2f(S[kh][j] - m) : 0.f; S[kh][j] = p; rs += p; }
        } else {
#pragma unroll
            for (int kh = 0; kh < 2; ++kh)
#pragma unroll
                for (int j = 0; j < 16; ++j) { const float p = __builtin_amdgcn_exp2f(S[kh][j] - m); S[kh][j] = p; rs += p; }
        }
        l += rs;
        if (MODE == 0) return;
    }
    }
    bf16x8 pf[2][2];
#pragma unroll
    for (int kh = 0; kh < 2; ++kh)
#pragma unroll
        for (int s2 = 0; s2 < 2; ++s2) { u32x4 w; w.x = cvt_pk_bf16(S[kh][8 * s2 + 0], S[kh][8 * s2 + 1]); w.y = cvt_pk_bf16(S[kh][8 * s2 + 2], S[kh][8 * s2 + 3]); w.z = cvt_pk_bf16(S[kh][8 * s2 + 4], S[kh][8 * s2 + 5]); w.w = cvt_pk_bf16(S[kh][8 * s2 + 6], S[kh][8 * s2 + 7]);
            pf[kh][s2] = __builtin_bit_cast(bf16x8, w); }
    {
        const unsigned vaddr = (unsigned)(size_t)(lds + OFF_V + r * VROW + 8 * hi);
        u32x2 va[8], vb[8];
#define NSAF_VRD(dst, dt, i) asm volatile("ds_read_b64 %0, %1 offset:%2" : "=v"(dst) : "v"(vaddr), "i"((dt) * 32 * VROW + ((i) >> 1) * 32 + ((i) & 1) * 16))
#define NSAF_VRD8(set, dt) do { NSAF_VRD(set[0], dt, 0); NSAF_VRD(set[1], dt, 1); NSAF_VRD(set[2], dt, 2); NSAF_VRD(set[3], dt, 3); NSAF_VRD(set[4], dt, 4); NSAF_VRD(set[5], dt, 5); NSAF_VRD(set[6], dt, 6); NSAF_VRD(set[7], dt, 7); } while (0)
#define NSAF_VWAIT(n, set) asm volatile("s_waitcnt lgkmcnt(" #n ")" : "+v"(set[0]), "+v"(set[1]), "+v"(set[2]), "+v"(set[3]), "+v"(set[4]), "+v"(set[5]), "+v"(set[6]), "+v"(set[7]))
#define NSAF_VMMA(set, dt) do { _Pragma("unroll") for (int ks = 0; ks < 4; ++ks) { const u32x4 a_ = (u32x4){set[2 * ks].x, set[2 * ks].y, set[2 * ks + 1].x, set[2 * ks + 1].y}; \
            O[dt] = __builtin_amdgcn_mfma_f32_32x32x16_bf16(__builtin_bit_cast(bf16x8, a_), pf[ks >> 1][ks & 1], O[dt], 0, 0, 0); } } while (0)
        NSAF_VRD8(va, 0); NSAF_VRD8(vb, 1);
        NSAF_VWAIT(8, va); NSAF_VMMA(va, 0); NSAF_VRD8(va, 2);
        NSAF_VWAIT(8, vb); NSAF_VMMA(vb, 1); NSAF_VRD8(vb, 3);
        NSAF_VWAIT(8, va); NSAF_VMMA(va, 2);
        NSAF_VWAIT(0, vb); NSAF_VMMA(vb, 3);
#undef NSAF_VRD
#undef NSAF_VRD8
#undef NSAF_VWAIT
#undef NSAF_VMMA
    }
}
template <int MODE>
__device__ __forceinline__ void run_pass(LAS unsigned char* lds, const bf16* K, const bf16* VT, size_t vpitch, int jb, int je, const bf16x8 (&qf)[8], f32x16 (&O)[4], float& m, float& l, bool allowfast, int tl, int itile, int nvr, unsigned long long selmask, float inv_l, int tid, int lane) {
    Stage st; stage_load(st, K, VT, vpitch, jb * 64, tid); stage_write(st, lds, tid);
    if (jb < je) stage_load(st, K, VT, vpitch, (jb + 1) * 64, tid);
    __syncthreads();
    for (int j = jb; j <= je; ++j) {
        const int cur = (j - jb) & 1;
        if (j < je) { stage_write(st, lds + (cur ^ 1) * BUF_BYTES, tid); if (j + 1 < je) stage_load(st, K, VT, vpitch, (j + 2) * 64, tid); }
        const bool rowsel = (MODE == 2) ? (((selmask >> j) & 1ull) != 0ull) : true;
        if (MODE != 2 || __ballot(rowsel) != 0ull) block_step<MODE>(lds + cur * BUF_BYTES, lds, qf, O, m, l, j, allowfast ? jb + (MODE == 2 ? 1 : 2) : 0x7fffffff, tl, itile, nvr, rowsel, inv_l, lane);
        __syncthreads();
    }
}
}
__device__ __forceinline__ void p3_nsa_fast(Frame& F, const bf16* svT, const bf16* wvT, bf16* outbase) {
    using namespace nsaf;
    unsigned char* ws = F.ws; const int tid = F.tid, lane = F.lane, wave = F.wave; LAS unsigned char* lds = F.lds;
    bf16* nq = (bf16*)(ws + WS_NQ); const float* gates = (const float*)(ws + WS_GATES);
    const int r = lane & 31, hi = lane >> 5, qrow = wave * 32 + r, tl = qrow >> 2, head = qrow & 3;
    unsigned failmask = 0u;
    for (int trip = 0; trip < 2; ++trip) {
    for (int u4 = 0; u4 < 4; ++u4) {
        if (trip == 1 && ((failmask >> u4) & 1u) == 0u) continue;
        const bool allowfast = trip == 0;
        const int pr = (F.bx & 7) * 32 + (F.bx >> 3) + (u4 >> 1) * 256; if (F.bx >= 256) break;
        const int bg = pr >> 5, ii = pr & 31, itile = (u4 & 1) ? (63 - ii) : ii, g = bg & 1, b = bg >> 1;
        const int tok = b * SEQ + itile * 64 + tl, t = itile * 64 + tl;
        const bf16* kc = (const bf16*)(ws + WS_KCMP) + (size_t)bg * 256 * 128; const bf16* vcT = (const bf16*)(ws + WS_VCMPT) + (size_t)bg * 128 * 256;
        const bf16* ks = (const bf16*)(ws + WS_KV6 + 2 * KV_STRIDE) + (size_t)bg * SEQ * 128; const bf16* kw = (const bf16*)(ws + WS_KV6 + 4 * KV_STRIDE) + (size_t)bg * SEQ * 128;
        const bf16* vsT = svT + (size_t)bg * 128 * SEQ; const bf16* vwT = wvT + (size_t)bg * 128 * SEQ;
        __syncthreads();
        for (int i = tid; i < 64 * 64; i += NTHREADS) ((LAS float*)(lds + OFF_IMP))[i] = 0.f;
        bf16x8 qf[8];
        {
            LAS unsigned char* tb_ = lds + wave * 8704;
#pragma unroll
            for (int k_ = 0; k_ < 8; ++k_) { const int rr_ = 4 * k_ + (lane >> 4), ch_ = lane & 15, qr_ = wave * 32 + rr_;
                *(LAS u32x4*)(tb_ + rr_ * 272 + ch_ * 16) = *(const u32x4*)(nq + (size_t)(b * SEQ + itile * 64 + (qr_ >> 2)) * 1024 + g * 512 + (qr_ & 3) * 128 + ch_ * 8); }
            LDS_WAIT(); asm volatile("" ::: "memory");
#pragma unroll
            for (int s_ = 0; s_ < 8; ++s_) { const u32x4 w_ = *(const LAS u32x4*)(tb_ + r * 272 + (16 * s_ + 8 * hi) * 2);
                u32x4 o_; o_.x = cvt_pk_bf16(lo16(w_.x) * CS, hi16(w_.x) * CS); o_.y = cvt_pk_bf16(lo16(w_.y) * CS, hi16(w_.y) * CS); o_.z = cvt_pk_bf16(lo16(w_.z) * CS, hi16(w_.z) * CS); o_.w = cvt_pk_bf16(lo16(w_.w) * CS, hi16(w_.w) * CS);
                qf[s_] = __builtin_bit_cast(bf16x8, o_); }
            __syncthreads();
        }
        const float* gatep = gates + (size_t)tok * 24 + (g * 4 + head) * 3;
        const int nvr = (t >= 31) ? (((t - 31) >> 4) + 1 > 255 ? 255 : ((t - 31) >> 4) + 1) : 0;
        const int jec = ((4 * itile + 2) >> 6) > 3 ? 3 : ((4 * itile + 2) >> 6);
        f32x16 O[4];
#define NSAF_ZERO_O() do { _Pragma("unroll") for (int dt = 0; dt < 4; ++dt) _Pragma("unroll") for (int j = 0; j < 16; ++j) O[dt][j] = 0.f; } while (0)
#define NSAF_ADD2(a_, b_) cvt_pk_bf16(lo16(a_) + lo16(b_), hi16(a_) + hi16(b_))
#define NSAF_ACCUM(coef, FIRST) do { const float cf_ = (coef); LAS unsigned char* tb_ = lds + wave * 8704; \
        _Pragma("unroll") for (int dt = 0; dt < 4; ++dt) { _Pragma("unroll") for (int q4 = 0; q4 < 4; ++q4) \
            *(LAS u32x2*)(tb_ + r * 272 + (32 * dt + 8 * q4 + 4 * hi) * 2) = (u32x2){cvt_pk_bf16(cf_ * O[dt][4 * q4], cf_ * O[dt][4 * q4 + 1]), cvt_pk_bf16(cf_ * O[dt][4 * q4 + 2], cf_ * O[dt][4 * q4 + 3])}; } \
        LDS_WAIT(); asm volatile("" ::: "memory"); \
        _Pragma("unroll 2") for (int k_ = 0; k_ < 8; ++k_) { const int rr_ = 4 * k_ + (lane >> 4), ch_ = lane & 15, qr_ = wave * 32 + rr_; \
            const u32x4 nv_ = *(const LAS u32x4*)(tb_ + rr_ * 272 + ch_ * 16); \
            u32x4* gp_ = (u32x4*)(outbase + (size_t)(b * SEQ + itile * 64 + (qr_ >> 2)) * 1024 + g * 512 + (qr_ & 3) * 128 + ch_ * 8); \
            u32x4 w_ = nv_; if (!(FIRST)) { const u32x4 ov_ = *gp_; w_.x = NSAF_ADD2(nv_.x, ov_.x); w_.y = NSAF_ADD2(nv_.y, ov_.y); w_.z = NSAF_ADD2(nv_.z, ov_.z); w_.w = NSAF_ADD2(nv_.w, ov_.w); } \
            *gp_ = w_; } \
        asm volatile("" ::: "memory"); } while (0)
        float m = NEG, l = 0.f; NSAF_ZERO_O();
        run_pass<0>(lds, kc, vcT, 256, 0, jec, qf, O, m, l, false, tl, itile, nvr, 0ull, 0.f, tid, lane);
        l += __shfl_xor(l, 32); const float invl = l > 0.f ? 1.0f / l : 0.f;
        run_pass<1>(lds, kc, vcT, 256, 0, jec, qf, O, m, l, false, tl, itile, nvr, 0ull, invl, tid, lane);
        NSAF_ACCUM(gatep[0], true);
        __syncthreads();
        for (int tk = 0; tk < 8; ++tk) { const int tokl = wave * 8 + tk; float v = ((const LAS float*)(lds + OFF_IMP))[tokl * 64 + lane];
            const bool forced = (lane == 0) || (lane == itile) || (lane == itile - 1); v = (lane > itile) ? -1.0e4f : (forced ? 1.0e4f : v);
            int rank = 0;
#pragma unroll 16
            for (int i = 0; i < 64; ++i) { const float w = __builtin_bit_cast(float, __builtin_amdgcn_readlane(__builtin_bit_cast(int, v), i)); rank += (w > v || (w == v && i < lane)) ? 1 : 0; }
            const unsigned long long mk = __ballot(rank < 16);
            if (lane == 0) { ((LAS unsigned*)(lds + OFF_MASK))[tokl * 2] = (unsigned)mk; ((LAS unsigned*)(lds + OFF_MASK))[tokl * 2 + 1] = (unsigned)(mk >> 32); } }
        __syncthreads();
        const unsigned long long selmask = (unsigned long long)((const LAS unsigned*)(lds + OFF_MASK))[tl * 2] | ((unsigned long long)((const LAS unsigned*)(lds + OFF_MASK))[tl * 2 + 1] << 32);
        m = NEG; l = 0.f; NSAF_ZERO_O();
        run_pass<2>(lds, ks, vsT, SEQ, 0, itile, qf, O, m, l, allowfast, tl, itile, 0, selmask, 0.f, tid, lane);
        l += __shfl_xor(l, 32); bool bad = !(l < 1.0e12f);
        NSAF_ACCUM(l > 0.f ? gatep[1] / l : 0.f, false);
        __syncthreads();
        m = NEG; l = 0.f; NSAF_ZERO_O();
        run_pass<3>(lds, kw, vwT, SEQ, itile > 8 ? itile - 8 : 0, itile, qf, O, m, l, allowfast, tl, itile, 0, 0ull, 0.f, tid, lane);
        l += __shfl_xor(l, 32); bad = bad | !(l < 1.0e12f);
        NSAF_ACCUM(l > 0.f ? gatep[2] / l : 0.f, false);
        if (allowfast && __syncthreads_or(bad ? 1 : 0)) failmask |= 1u << u4;
#undef NSAF_ZERO_O
#undef NSAF_ACCUM
#undef NSAF_ADD2
    }
    if (failmask == 0u) break;
    }
    __syncthreads();
}
struct SchedP4 {
    unsigned char* ws; int G, c; const char* nsa;
    __device__ __forceinline__ bool next(int i, GU& u) const {
        const int ti = i >> 2, sub = i & 3; const int L = ti * G + c; if (L >= 128 * 4) return false;
        int pm, pn; pg8::tile_map(L, 128, 4, pm, pn);
        const size_t ao = sub == 1 ? WS_RV : sub == 3 ? WS_NQ : WS_H; const size_t bo = sub == 0 ? W_GA : sub == 1 ? W_RO : sub == 2 ? W_GB : W_NO;
        u.A = (sub == 3 ? nsa : (const char*)ws + ao) + (size_t)pm * 256 * D * 2; u.B = (const char*)ws + bo + (size_t)pn * 256 * D * 2; u.pm = pm; u.pn = pn; u.kind = sub; u.rows = nullptr; u.nvalid = 0; u.aux = 0; return true;
    }
};
struct EpiP4 {
    static constexpr bool PERM = true;
    float* scr;
    bf16* Y;
    static __device__ __forceinline__ u32x2 pk4(const f32x4 v) { return (u32x2){cvt_pk_bf16(v[0], v[1]), cvt_pk_bf16(v[2], v[3])}; }
    static __device__ __forceinline__ f32x4 up4(const u32x2 w) { return (f32x4){lo16(w.x), hi16(w.x), lo16(w.y), hi16(w.y)}; }
    __device__ __forceinline__ void operator()(const f32x4 (&acc)[2][2][4][2], const GU& u, int wr, int wc, int fr, int fq) const {
        u32x2* p0 = (u32x2*)scr + threadIdx.x; u32x2* p1 = p0 + 32 * 512;
        if (u.kind == 0 || u.kind == 2) {
            u32x2* p = u.kind == 0 ? p0 : p1;
#pragma unroll
            for (int ai = 0; ai < 2; ++ai)
#pragma unroll
                for (int m = 0; m < 4; ++m) {
#pragma unroll
                    for (int bj = 0; bj < 2; ++bj) { f32x4 v0 = acc[ai][bj][m][0], v1 = acc[ai][bj][m][1];
#pragma unroll
                        for (int j = 0; j < 4; ++j) { v0[j] = sigmoidf_(v0[j]); v1[j] = sigmoidf_(v1[j]); }
                        p[(2 * bj) * 512] = pk4(v0); p[(2 * bj + 1) * 512] = pk4(v1); }
                    p += 4 * 512; LAUNDER(p); }
        } else if (u.kind == 1) {
#pragma unroll
            for (int ai = 0; ai < 2; ++ai)
#pragma unroll
                for (int m = 0; m < 4; ++m) {
#pragma unroll
                    for (int bj = 0; bj < 2; ++bj) { p0[(2 * bj) * 512] = pk4(up4(p0[(2 * bj) * 512]) * acc[ai][bj][m][0]); p0[(2 * bj + 1) * 512] = pk4(up4(p0[(2 * bj + 1) * 512]) * acc[ai][bj][m][1]); }
                    p0 += 4 * 512; LAUNDER(p0); }
        } else {
            bf16* yb = Y + (size_t)(u.pm * 256 + 64 * wr + fr) * D + u.pn * 256 + 32 * wc + 8 * fq;
#pragma unroll
            for (int ai = 0; ai < 2; ++ai)
#pragma unroll
                for (int m = 0; m < 4; ++m) {
#pragma unroll
                    for (int bj = 0; bj < 2; ++bj) {
                        const f32x4 v0 = up4(p0[(2 * bj) * 512]) + up4(p1[(2 * bj) * 512]) * acc[ai][bj][m][0], v1 = up4(p0[(2 * bj + 1) * 512]) + up4(p1[(2 * bj + 1) * 512]) * acc[ai][bj][m][1];
                        u32x4 w; w.x = cvt_pk_bf16(v0[0], v0[1]); w.y = cvt_pk_bf16(v0[2], v0[3]); w.z = cvt_pk_bf16(v1[0], v1[1]); w.w = cvt_pk_bf16(v1[2], v1[3]);
                        *(u32x4*)(yb + (size_t)(128 * ai + 16 * m) * D + 128 * bj) = w; }
                    p0 += 4 * 512; p1 += 4 * 512; LAUNDER(p0); LAUNDER(p1); }
        }
    }
};

struct SchedMN {
    unsigned char* ws; size_t ao, bo; int G, c;
    __device__ __forceinline__ bool next(int i, GU& u) const {
        const int L = i * G + c; if (L >= 128 * 4) return false; int pm, pn; pg8::tile_map(L, 128, 4, pm, pn);
        u.A = (const char*)ws + ao + (size_t)pm * 256 * D * 2; u.B = (const char*)ws + bo + (size_t)pn * 256 * D * 2; u.pm = pm; u.pn = pn; u.kind = 0; u.rows = nullptr; u.nvalid = 0; u.aux = 0; return true;
    }
};
template <bool SSQ> struct EpiRes {
    static constexpr bool PERM = false;
    const float* basef; const bf16* baseb; float* out; bf16* ob; float* ssq;
    __device__ __forceinline__ void operator()(const f32x4 (&acc)[2][2][4][2], const GU& u, int wr, int wc, int fr, int fq) const {
#pragma unroll
        for (int ai = 0; ai < 2; ++ai)
#pragma unroll
            for (int m = 0; m < 4; ++m) { const int r = u.pm * 256 + 128 * ai + 64 * wr + 16 * m + fr; const size_t off = (size_t)r * D + u.pn * 256 + 32 * wc + 4 * fq; float sq = 0.f;
#pragma unroll
                for (int bj = 0; bj < 2; ++bj)
#pragma unroll
                    for (int n = 0; n < 2; ++n) { const size_t o = off + 128 * bj + 16 * n; f32x4 bv;
                        if (SSQ) bv = *(const f32x4*)(basef + o); else { const u32x2 bw = *(const u32x2*)(baseb + o); bv = (f32x4){lo16(bw.x), hi16(bw.x), lo16(bw.y), hi16(bw.y)}; }
                        const f32x4 v = bv + acc[ai][bj][m][n];
                        if (!SSQ) *(f32x4*)(out + o) = v;
                        u32x2 w; w.x = cvt_pk_bf16(v[0], v[1]); w.y = cvt_pk_bf16(v[2], v[3]); *(u32x2*)(ob + o) = w; sq += (v[0] * v[0] + v[1] * v[1]) + (v[2] * v[2] + v[3] * v[3]); }
                if (SSQ) { sq += __shfl_xor(sq, 16); sq += __shfl_xor(sq, 32); if (fq == 0) ssq[(size_t)r * 16 + u.pn * 4 + wc] = sq; }
            }
    }
};
struct EpiQ {
    static constexpr bool PERM = true;
    const float* ssq; bf16* Q;
    __device__ __forceinline__ void operator()(const f32x4 (&acc)[2][2][4][2], const GU& u, int wr, int wc, int fr, int fq) const {
#pragma unroll
        for (int ai = 0; ai < 2; ++ai)
#pragma unroll
            for (int m = 0; m < 4; ++m) { const int r = u.pm * 256 + 128 * ai + 64 * wr + 16 * m + fr; const f32x4* sp = (const f32x4*)(ssq + (size_t)r * 16);
                const f32x4 a = sp[0], b = sp[1], c = sp[2], d = sp[3]; const float tot = ((a[0] + a[1]) + (a[2] + a[3])) + ((b[0] + b[1]) + (b[2] + b[3])) + ((c[0] + c[1]) + (c[2] + c[3])) + ((d[0] + d[1]) + (d[2] + d[3]));
                const float rstd = 1.0f / sqrtf(tot * (1.0f / D) + EPS);
#pragma unroll
                for (int bj = 0; bj < 2; ++bj) { const f32x4 v0 = acc[ai][bj][m][0] * rstd, v1 = acc[ai][bj][m][1] * rstd;
                    u32x4 w; w.x = cvt_pk_bf16(v0[0], v0[1]); w.y = cvt_pk_bf16(v0[2], v0[3]); w.z = cvt_pk_bf16(v1[0], v1[1]); w.w = cvt_pk_bf16(v1[2], v1[3]);
                    *(u32x4*)(Q + (size_t)r * D + u.pn * 256 + 128 * bj + 32 * wc + 8 * fq) = w; } }
    }
};

namespace xatf {
constexpr int KROW = 528, VROW = 136, KT_BYTES = 64 * KROW, OFF_K = 0, OFF_V = KT_BYTES;
constexpr float NEG = -1.0e30f, CS = 0.0625f * 1.4426950408889634f;
struct Stage { u32x4 k[4]; u32x4 v[2]; };
__device__ __forceinline__ void stage_load(Stage& st, const bf16* K, const bf16* VT, int key0, int tid) {
#pragma unroll
    for (int i = 0; i < 4; ++i) { const int p = tid + 512 * i, row = p >> 5, c = p & 31; st.k[i] = *(const u32x4*)(K + (size_t)(key0 + row) * 2048 + c * 8); }
#pragma unroll
    for (int i = 0; i < 2; ++i) { const int p = tid + 512 * i, d = p >> 3, c = p & 7; st.v[i] = *(const u32x4*)(VT + (size_t)d * 256 + key0 + c * 8); }
}
__device__ __forceinline__ void stage_write(const Stage& st, LAS unsigned char* lds, int tid) {
#pragma unroll
    for (int i = 0; i < 4; ++i) { const int p = tid + 512 * i, row = p >> 5, c = p & 31; *(LAS u32x4*)(lds + OFF_K + row * KROW + c * 16) = st.k[i]; }
#pragma unroll
    for (int i = 0; i < 2; ++i) { const int p = tid + 512 * i, d = p >> 3, c = p & 7; LAS unsigned char* q = lds + OFF_V + d * VROW + c * 16;
        *(LAS u32x2*)q = (u32x2){st.v[i].x, st.v[i].y}; *(LAS u32x2*)(q + 8) = (u32x2){st.v[i].z, st.v[i].w}; }
}
__device__ __forceinline__ void block_step(const LAS unsigned char* lds, const bf16x8 (&qf)[16], f32x16 (&O)[4], float& m, float& l, int lane) {
    const int r = lane & 31, hi = lane >> 5;
    f32x16 S[2];
#pragma unroll
    for (int kh = 0; kh < 2; ++kh) {
#pragma unroll
        for (int j = 0; j < 16; ++j) S[kh][j] = 0.f;
#pragma unroll
        for (int s_ = 0; s_ < 16; ++s_) { const bf16x8 a = *(const LAS bf16x8*)(lds + OFF_K + (kh * 32 + r) * KROW + (16 * s_ + 8 * hi) * 2); S[kh] = __builtin_amdgcn_mfma_f32_32x32x16_bf16(a, qf[s_], S[kh], 0, 0, 0); }
    }
    float mx = NEG;
#pragma unroll
    for (int kh = 0; kh < 2; ++kh)
#pragma unroll
        for (int j = 0; j < 16; ++j) { const float v = S[kh][j] * CS; S[kh][j] = v; mx = fmaxf(mx, v); }
    mx = fmaxf(mx, __shfl_xor(mx, 32));
    const float mn = fmaxf(m, mx); const float alpha = __builtin_amdgcn_exp2f(m - mn); m = mn; float rs = 0.f;
#pragma unroll
    for (int kh = 0; kh < 2; ++kh)
#pragma unroll
        for (int j = 0; j < 16; ++j) { const float p = __builtin_amdgcn_exp2f(S[kh][j] - mn); S[kh][j] = p; rs += p; }
    l = l * alpha + rs;
#pragma unroll
    for (int dt = 0; dt < 4; ++dt)
#pragma unroll
        for (int j = 0; j < 16; ++j) O[dt][j] *= alpha;
    bf16x8 pf[2][2];
#pragma unroll
    for (int kh = 0; kh < 2; ++kh)
#pragma unroll
        for (int s2 = 0; s2 < 2; ++s2) { u32x4 w; w.x = cvt_pk_bf16(S[kh][8 * s2 + 0], S[kh][8 * s2 + 1]); w.y = cvt_pk_bf16(S[kh][8 * s2 + 2], S[kh][8 * s2 + 3]); w.z = cvt_pk_bf16(S[kh][8 * s2 + 4], S[kh][8 * s2 + 5]); w.w = cvt_pk_bf16(S[kh][8 * s2 + 6], S[kh][8 * s2 + 7]);
            pf[kh][s2] = __builtin_bit_cast(bf16x8, w); }
#pragma unroll
    for (int dt = 0; dt < 4; ++dt)
#pragma unroll
        for (int kh = 0; kh < 2; ++kh)
#pragma unroll
            for (int s2 = 0; s2 < 2; ++s2) { const LAS unsigned char* vp = lds + OFF_V + (dt * 32 + r) * VROW + (32 * kh + 16 * s2 + 4 * hi) * 2;
                const u32x2 lo = *(const LAS u32x2*)vp, hi2 = *(const LAS u32x2*)(vp + 16); const u32x4 av = (u32x4){lo.x, lo.y, hi2.x, hi2.y};
                O[dt] = __builtin_amdgcn_mfma_f32_32x32x16_bf16(__builtin_bit_cast(bf16x8, av), pf[kh][s2], O[dt], 0, 0, 0); }
}
}
__device__ __forceinline__ void p7_xattn_fast(Frame& F, const bf16* vT, bf16* outbase) {
    using namespace xatf;
    bf16* Q = (bf16*)(F.ws + WS_NQ); const bf16* KV = (const bf16*)(F.ws + WS_MEMKV);
    const int tid = F.tid, lane = F.lane, wave = F.wave, r = lane & 31, hi = lane >> 5; LAS unsigned char* lds = F.lds;
    for (int u = F.bx; u < BATCH * 4 * 16; u += F.G) {
        const int tt = u & 15, bh = u >> 4, b = bh >> 2, h = bh & 3; const int tok = b * SEQ + tt * 256 + wave * 32 + r;
        bf16* qrow = Q + (size_t)tok * D + h * 256; bf16* orow = outbase + (size_t)tok * D + h * 256; const bf16* Kb = KV + (size_t)(b * NMEM) * 2048 + h * 256;
        bf16x8 qf[16];
#pragma unroll
        for (int s_ = 0; s_ < 16; ++s_) qf[s_] = *(const bf16x8*)(qrow + 16 * s_ + 8 * hi);
        const bf16* VT0 = vT + (size_t)bh * 256 * 256;
        Stage st; stage_load(st, Kb, VT0, 0, tid);
        f32x16 O[4]; float m = NEG, l = 0.f;
        for (int idx = 0; idx < 8; ++idx) {
            const int half = idx >> 2, j = idx & 3;
            if (j == 0) { m = NEG; l = 0.f;
#pragma unroll
                for (int dt = 0; dt < 4; ++dt)
#pragma unroll
                    for (int jj = 0; jj < 16; ++jj) O[dt][jj] = 0.f; }
            __syncthreads(); stage_write(st, lds, tid);
            { const int i2 = idx < 7 ? idx + 1 : idx; stage_load(st, Kb, VT0 + (size_t)((i2 >> 2) * 128) * 256, (i2 & 3) * 64, tid); }
            __syncthreads();
            block_step(lds, qf, O, m, l, lane);
            if (j == 3) {
                l += __shfl_xor(l, 32); const float inv = 1.0f / l;
#pragma unroll
                for (int dt = 0; dt < 4; ++dt)
#pragma unroll
                    for (int q4 = 0; q4 < 4; ++q4) *(u32x2*)(orow + half * 128 + 32 * dt + 8 * q4 + 4 * hi) = (u32x2){cvt_pk_bf16(O[dt][4 * q4] * inv, O[dt][4 * q4 + 1] * inv), cvt_pk_bf16(O[dt][4 * q4 + 2] * inv, O[dt][4 * q4 + 3] * inv)};
            }
        }
    }
    __syncthreads();
}
__device__ __forceinline__ void transpose_memv_tiles(Frame& F, bf16* vT, int w0, int nw) {
    LAS unsigned short* tl_ = (LAS unsigned short*)(F.lds + F.wave * 16384); const int lane = F.lane; const bf16* KV = (const bf16*)(F.ws + WS_MEMKV);
    for (int tile = w0; tile < 32 * 16; tile += nw) {
        const int dq = tile & 3, kq = (tile >> 2) & 3, bh = tile >> 4, b = bh >> 2, h = bh & 3;
        const bf16* sp = KV + (size_t)(b * NMEM + kq * 64) * 2048 + 1024 + h * 256 + dq * 64; bf16* dp = vT + ((size_t)bh * 256 + dq * 64) * 256 + kq * 64;
#pragma unroll
        for (int i = 0; i < 8; ++i) { const int row = i * 8 + (lane >> 3), c = lane & 7; const u32x4 v = *(const u32x4*)(sp + (size_t)row * 2048 + c * 8); LAS unsigned short* q = tl_ + row * 66 + c * 8;
            q[0] = (unsigned short)(v.x & 0xffffu); q[1] = (unsigned short)(v.x >> 16); q[2] = (unsigned short)(v.y & 0xffffu); q[3] = (unsigned short)(v.y >> 16);
            q[4] = (unsigned short)(v.z & 0xffffu); q[5] = (unsigned short)(v.z >> 16); q[6] = (unsigned short)(v.w & 0xffffu); q[7] = (unsigned short)(v.w >> 16); }
        LDS_WAIT(); asm volatile("" ::: "memory");
#pragma unroll
        for (int i = 0; i < 8; ++i) { const int d = i * 8 + (lane >> 3), c = lane & 7; const LAS unsigned short* q = tl_ + (c * 8) * 66 + d;
            u32x4 o; o.x = (unsigned)q[0] | ((unsigned)q[66] << 16); o.y = (unsigned)q[2 * 66] | ((unsigned)q[3 * 66] << 16); o.z = (unsigned)q[4 * 66] | ((unsigned)q[5 * 66] << 16); o.w = (unsigned)q[6 * 66] | ((unsigned)q[7 * 66] << 16);
            *(u32x4*)(dp + (size_t)d * 256 + c * 8) = o; }
        LDS_WAIT(); asm volatile("" ::: "memory");
    }
}

__device__ __forceinline__ void p9_route(Frame& F, const Args& a) {
    unsigned char* ws = F.ws; const float* X2 = a.out;
    const float* gff = a.in[IN_NORM_FFN_G]; const float* wgrp = a.in[IN_W_GRP]; const float* bgrp = a.in[IN_B_GRP]; const float* wrt = a.in[IN_W_RT]; const float* brt = a.in[IN_B_RT];
    float* wts = (float*)(ws + WS_ROUTE); float* rstd2 = wts + 2 * NTOK; int* lists = (int*)(ws + WS_LISTS);
    const int gw = F.bx * NWAVES + F.wave, NGW = F.G * NWAVES, lane = F.lane;
    const f32x4* wgp = (const f32x4*)(ws + WS_RTW); const f32x4* wep = wgp + 1024;
    float xn[16];
    if (gw < NTOK) {
#pragma unroll
        for (int i = 0; i < 16; ++i) xn[i] = X2[(size_t)gw * D + 64 * i + lane]; }
    int my_ea = -1, my_eb = -1, my_tok = -1, it_ = 0; float my_w1 = 0.f, my_w2 = 0.f, my_rstd = 0.f;
    for (int tok = gw; tok < NTOK; tok += NGW, ++it_) {
        float xa[16]; float s = 0.f;
#pragma unroll
        for (int i = 0; i < 16; ++i) { xa[i] = xn[i]; s += xa[i] * xa[i]; }
        if (tok + NGW < NTOK) {
#pragma unroll
            for (int i = 0; i < 16; ++i) xn[i] = X2[(size_t)(tok + NGW) * D + 64 * i + lane]; }
        const float rstd = 1.0f / sqrtf(wave_sum(s) * (1.f / D) + EPS);
        float lg[4] = {0.f, 0.f, 0.f, 0.f};
#pragma unroll
        for (int i = 0; i < 16; ++i) { const f32x4 wg = wgp[64 * i + lane];
#pragma unroll
            for (int c = 0; c < 4; ++c) lg[c] += xa[i] * wg[c]; }
#pragma unroll
        for (int i = 0; i < 4; ++i) lg[i] = rstd * wave_sum(lg[i]) + bgrp[i];
        int grp = 0; float gm = lg[0];
#pragma unroll
        for (int i = 1; i < 4; ++i) if (lg[i] > gm) { gm = lg[i]; grp = i; }
        grp = __builtin_amdgcn_readfirstlane(grp);
        float gs = 0.f;
#pragma unroll
        for (int i = 0; i < 4; ++i) gs += expf(lg[i] - gm);
        const float g_gate = 1.0f / gs;
        float lq[8];
#pragma unroll
        for (int i = 0; i < 8; ++i) lq[i] = 0.f;
        const f32x4* pwe = wep + (size_t)grp * (16 * 2 * 64) + lane;
#pragma unroll
        for (int i = 0; i < 16; ++i) { const f32x4 wa = pwe[(2 * i) * 64], wb = pwe[(2 * i + 1) * 64];
#pragma unroll
            for (int c = 0; c < 4; ++c) { lq[c] += xa[i] * wa[c]; lq[4 + c] += xa[i] * wb[c]; } }
#pragma unroll
        for (int i = 0; i < 8; ++i) lq[i] = rstd * wave_sum(lq[i]) + brt[grp * 8 + i];
        int i1 = 0; float m1 = lq[0];
#pragma unroll
        for (int i = 1; i < 8; ++i) if (lq[i] > m1) { m1 = lq[i]; i1 = i; }
        int i2 = -1; float m2 = -3.0e38f;
#pragma unroll
        for (int i = 0; i < 8; ++i) if (i != i1 && lq[i] > m2) { m2 = lq[i]; i2 = i; }
        const float e2 = expf(m2 - m1), den = 1.0f + e2; const float w1 = g_gate / den, w2 = g_gate * e2 / den;
        if (lane == it_) { my_ea = grp * 8 + i1; my_eb = grp * 8 + i2; my_tok = tok; my_w1 = w1; my_w2 = w2; my_rstd = rstd; }
    }
    if (my_tok >= 0) {
        const unsigned sa = __hip_atomic_fetch_add(F.ctl + CW_ECNT + 64 * my_ea, 1u, __ATOMIC_RELAXED, __HIP_MEMORY_SCOPE_AGENT);
        const unsigned sb = __hip_atomic_fetch_add(F.ctl + CW_ECNT + 64 * my_eb, 1u, __ATOMIC_RELAXED, __HIP_MEMORY_SCOPE_AGENT);
        lists[(size_t)my_ea * NTOK + sa] = my_tok * 2; lists[(size_t)my_eb * NTOK + sb] = my_tok * 2 + 1;
        wts[my_tok * 2] = my_w1; wts[my_tok * 2 + 1] = my_w2; rstd2[my_tok] = my_rstd;
    }
}
__device__ __forceinline__ void moe_tiles(Frame& F) {
    __syncthreads();
    if (F.tid == 0) { unsigned accu = 0u; for (int e = 0; e < NEXP; ++e) { const unsigned c = __hip_atomic_load(F.ctl + CW_ECNT + 64 * e, __ATOMIC_RELAXED, __HIP_MEMORY_SCOPE_AGENT); F.MISC[16 + e] = accu; F.MISC[64 + e] = c; accu += (c + 255u) >> 8; } F.MISC[16 + NEXP] = accu; }
    __syncthreads();
}
template <int WHICH> struct SchedMoe {
    volatile LAS unsigned* MISC; unsigned char* ws; int G, c;
    __device__ __forceinline__ bool next(int i, GU& u) const {
        const int L = i * G + c; const int T = (int)MISC[16 + NEXP]; if (L >= 4 * T) return false;
        const int tau = L >> 2, pn = L & 3; int e = 0;
        for (int k = 1; k < NEXP; ++k) if ((int)MISC[16 + k] <= tau) e = k;
        const int lt = tau - (int)MISC[16 + e]; const int cnt = (int)MISC[64 + e]; int nv = cnt - lt * 256; nv = nv > 256 ? 256 : nv;
        u.rows = (const int*)(ws + WS_LISTS) + (size_t)e * NTOK + lt * 256; u.nvalid = nv; u.pm = tau; u.pn = pn; u.kind = 0; u.aux = e;
        if (WHICH == 0) { u.A = (const char*)ws + WS_X2B; u.B = (const char*)ws + WS_W13 + (size_t)e * D * D * 2 + (size_t)pn * 256 * D * 2; }
        else { u.A = (const char*)ws + WS_H1 + (size_t)tau * 256 * DEXP * 2; u.B = (const char*)ws + WS_W2 + (size_t)e * D * DEXP * 2 + (size_t)pn * 256 * DEXP * 2; }
        return true;
    }
};
struct EpiMoe1 {
    static constexpr bool PERM = true;
    const float* rstd2; bf16* H1;
    __device__ __forceinline__ void operator()(const f32x4 (&acc)[2][2][4][2], const GU& u, int wr, int wc, int fr, int fq) const {
        char* hb = (char*)H1 + (size_t)u.pm * 256 * DEXP * 2;
        const int j00 = (u.pn * 256 + 32 * wc + 8 * fq) >> 1;
#pragma unroll
        for (int ai = 0; ai < 2; ++ai) {
            int r = 128 * ai + 64 * wr + fr; LAUNDER(r);
#pragma unroll
            for (int m = 0; m < 4; ++m) { const bool ok = r < u.nvalid; const float rs = ok ? rstd2[u.rows[r] >> 1] : 0.f;
#pragma unroll
                for (int bj = 0; bj < 2; ++bj) { const f32x4 a1 = acc[ai][bj][m][0] * rs, a3 = acc[ai][bj][m][1] * rs; f32x4 hv;
#pragma unroll
                    for (int j = 0; j < 4; ++j) hv[j] = a1[j] * sigmoidf_(a1[j]) * a3[j];
                    u32x2 w; w.x = cvt_pk_bf16(hv[0], hv[1]); w.y = cvt_pk_bf16(hv[2], hv[3]); *(u32x2*)(hb + (unsigned)((r * DEXP + j00 + 64 * bj) * 2)) = w; }
                r += 16; LAUNDER(r); }
        }
    }
};
struct EpiMoe2 {
    static constexpr bool PERM = true;
    const float* wts; bf16* Y0; bf16* Y1;
    __device__ __forceinline__ void operator()(const f32x4 (&acc)[2][2][4][2], const GU& u, int wr, int wc, int fr, int fq) const {
#pragma unroll
        for (int ai = 0; ai < 2; ++ai)
#pragma unroll
            for (int m = 0; m < 4; ++m) { const int r = 128 * ai + 64 * wr + 16 * m + fr;
                if (r < u.nvalid) { const int ent = u.rows[r]; const float w8 = wts[ent]; bf16* dst = ((ent & 1) ? Y1 : Y0) + (size_t)(ent >> 1) * D + u.pn * 256 + 32 * wc + 8 * fq;
#pragma unroll
                    for (int bj = 0; bj < 2; ++bj) { const f32x4 v0 = acc[ai][bj][m][0] * w8, v1 = acc[ai][bj][m][1] * w8;
                        u32x4 w; w.x = cvt_pk_bf16(v0[0], v0[1]); w.y = cvt_pk_bf16(v0[2], v0[3]); w.z = cvt_pk_bf16(v1[0], v1[1]); w.w = cvt_pk_bf16(v1[2], v1[3]);
                        *(u32x4*)(dst + 128 * bj) = w; } } }
    }
};

__device__ __forceinline__ void p12_final(Frame& F, const Args& a) {
    const bf16* Y0 = (const bf16*)(F.ws + WS_YS0); const bf16* Y1 = (const bf16*)(F.ws + WS_YS1); const bf16* X2 = (const bf16*)(F.ws + WS_X2B); const float* g = a.in[IN_NORM_F_G];
    const int gw = F.bx * NWAVES + F.wave, NGW = F.G * NWAVES, lane = F.lane;
    for (int tok = gw; tok < NTOK; tok += NGW) {
        f32x4* xr = (f32x4*)(a.out + (size_t)tok * D) + lane; const u32x2* x2 = (const u32x2*)(X2 + (size_t)tok * D) + lane; const u32x2* y0 = (const u32x2*)(Y0 + (size_t)tok * D) + lane; const u32x2* y1 = (const u32x2*)(Y1 + (size_t)tok * D) + lane;
        f32x4 v[4]; float s = 0.f;
#pragma unroll
        for (int j = 0; j < 4; ++j) { const u32x2 xx = x2[64 * j], p = y0[64 * j], q = y1[64 * j];
            v[j].x = lo16(xx.x) + (lo16(p.x) + lo16(q.x)); v[j].y = hi16(xx.x) + (hi16(p.x) + hi16(q.x)); v[j].z = lo16(xx.y) + (lo16(p.y) + lo16(q.y)); v[j].w = hi16(xx.y) + (hi16(p.y) + hi16(q.y));
            s += (v[j].x * v[j].x + v[j].y * v[j].y) + (v[j].z * v[j].z + v[j].w * v[j].w); }
        const float rstd = 1.0f / sqrtf(wave_sum(s) * (1.f / D) + EPS);
#pragma unroll
        for (int j = 0; j < 4; ++j) { const f32x4 gg = ((const f32x4*)g + lane)[64 * j]; xr[64 * j] = v[j] * rstd * gg; }
    }
}

constexpr int N_PHASES = 14;
__global__ void __launch_bounds__(NTHREADS, 2) fwd(Args args) {
    extern __shared__ __attribute__((aligned(16))) unsigned char lds[];
    Frame F;
    F.lds = (LAS unsigned char*)lds; F.MISC = (volatile LAS unsigned*)(F.lds + MISC_OFF);
    F.tid = threadIdx.x; F.lane = F.tid & 63; F.wave = __builtin_amdgcn_readfirstlane(F.tid >> 6); F.G = gridDim.x; F.bx = blockIdx.x;
    F.ws = args.ws; F.ctl = (unsigned*)(args.ws + WS_CTL);
    unsigned char* ws = args.ws;
    for (int u = F.tid; u < (LDS_BYTES - RING_BYTES) / 4; u += NTHREADS) ((LAS unsigned*)(F.lds + RING_BYTES))[u] = 0u;
    __syncthreads();
    const int lo = args.ph_lo, hi = args.ph_hi;
    const bool one = (hi - lo) > 1;
    XcdBarrier bar; bar.bar = F.ctl + CW_BAR; bar.x = 0; bar.st = F.MISC + 8;
    if (one) bar = xcd_barrier_post(F.ctl + CW_BAR, F.MISC + 8);
#define IN(k) (lo <= (k) && (k) < hi && phase_begin(F))
#define SEAM(k) do { if (lo <= (k) && (k) + 1 < hi) xcd_barrier(bar); } while (0)

    if (IN(0)) { p0_prologue(F, args); } SEAM(0);
    if (IN(1)) {
        SchedP1 S{ws, F.G, F.bx};
        EpiP1 E{ws};
        pg8::gemm_phase<EpiP1, SchedP1, false>(F.lds, D, D, D, S, E);
        p1_gate_logits(F);
    } SEAM(1);
    if (IN(2)) {
        p2_retention_fast(F, F.bx, (bf16*)(ws + WS_RV));
        { const int w0 = F.bx * NWAVES + F.wave, nw = F.G * NWAVES;
            transpose_kv_tiles(F, (const bf16*)(ws + WS_KV6 + 3 * KV_STRIDE), (bf16*)args.out, w0, nw);
            transpose_kv_tiles(F, (const bf16*)(ws + WS_KV6 + 5 * KV_STRIDE), (bf16*)((unsigned char*)args.out + KV_STRIDE), w0, nw);
            transpose_memv_tiles(F, (bf16*)(ws + WS_MEMVT), w0, nw); }
        __syncthreads();
        { SchedCmp S{ws, 0, F.G, F.bx}; EpiCmp E{(float*)args.out + (size_t)16 * MiB};
            pg8::gemm_phase<EpiCmp, SchedCmp, false>(F.lds, 512, 2048, 4096, S, E); }
    } SEAM(2);
    if (IN(3)) { p2b_compress_out(F, args); } SEAM(3);
    if (IN(4)) { p3_ret_normalize(F); p3_nsa_fast(F, (const bf16*)args.out, (const bf16*)((const unsigned char*)args.out + KV_STRIDE), (bf16*)((unsigned char*)args.out + 64 * MiB)); } SEAM(4);
    if (IN(5)) {
        SchedP4 S{ws, F.G, F.bx, (const char*)args.out + 64 * MiB};
        EpiP4 E{(float*)(ws + WS_P4SCR) + (size_t)F.bx * (2 * 32 * 512 * 4), (bf16*)(ws + WS_Y)};
        pg8::gemm_phase<EpiP4, SchedP4, false>(F.lds, D, D, D, S, E);
    } SEAM(5);
    if (IN(6)) {
        SchedMN S{ws, WS_Y, W_OUT, F.G, F.bx}; EpiRes<true> E{args.in[IN_X], nullptr, nullptr, (bf16*)(ws + WS_X1B), (float*)(ws + WS_SSQ)};
        pg8::gemm_phase<EpiRes<true>, SchedMN, false>(F.lds, D, D, D, S, E);
    } SEAM(6);
    if (IN(7)) {
        const bool early = ((F.bx >> 3) & 1) == 0;
        if (early) expert_copies(F, args, 0, NEXP / 2);
        SchedMN S{ws, WS_X1B, W_XQ, F.G, F.bx}; EpiQ E{(const float*)(ws + WS_SSQ), (bf16*)(ws + WS_NQ)};
        pg8::gemm_phase<EpiQ, SchedMN, false>(F.lds, D, D, D, S, E);
        if (!early) { __syncthreads(); expert_copies(F, args, 0, NEXP / 2); }
    } SEAM(7);
    if (IN(8)) { p7_xattn_fast(F, (const bf16*)(ws + WS_MEMVT), (bf16*)(ws + WS_NQ)); } SEAM(8);
    if (IN(9)) {
        const bool early = ((F.bx >> 3) & 1) == 0;
        if (early) expert_copies(F, args, NEXP / 2, NEXP);
        SchedMN S{ws, WS_NQ, W_XO, F.G, F.bx}; EpiRes<false> E{nullptr, (const bf16*)(ws + WS_X1B), args.out, (bf16*)(ws + WS_X2B), nullptr};
        pg8::gemm_phase<EpiRes<false>, SchedMN, false>(F.lds, D, D, D, S, E);
        if (!early) { __syncthreads(); expert_copies(F, args, NEXP / 2, NEXP); }
    } SEAM(9);
    if (IN(10)) { p9_route(F, args); } SEAM(10);
    if (IN(11)) {
        moe_tiles(F);
        SchedMoe<0> S{F.MISC, ws, F.G, F.bx}; EpiMoe1 E{(const float*)(ws + WS_ROUTE) + 2 * NTOK, (bf16*)(ws + WS_H1)};
        pg8::gemm_phase<EpiMoe1, SchedMoe<0>, true>(F.lds, D, D, D, S, E);
    } SEAM(11);
    if (IN(12)) {
        moe_tiles(F);
        SchedMoe<1> S{F.MISC, ws, F.G, F.bx}; EpiMoe2 E{(const float*)(ws + WS_ROUTE), (bf16*)(ws + WS_YS0), (bf16*)(ws + WS_YS1)};
        pg8::gemm_phase<EpiMoe2, SchedMoe<1>, false>(F.lds, DEXP, DEXP, DEXP, S, E);
    } SEAM(12);
    if (IN(13)) { p12_final(F, args); }
#undef IN
#undef SEAM
}

extern "C" void kernel_launch(void* const* d_in, const int* in_sizes, int n_in, void* d_out, int out_size, void* d_ws, size_t ws_size, hipStream_t stream) {
    static int grid = 0;
    if (grid == 0) {
        if (n_in != 27 || in_sizes[0] != NTOK * D || out_size != NTOK * D || ws_size < WS_END) {
            fprintf(stderr, "kernel_launch: unexpected shapes: n_in %d in0 %d out %d ws %zu (need %zu)\n", n_in, n_in > 0 ? in_sizes[0] : -1, out_size, ws_size, (size_t)WS_END); grid = -1; return; }
        int dev = 0, cus = 0, per_cu = 0;
        if (hipGetDevice(&dev) != hipSuccess || hipDeviceGetAttribute(&cus, hipDeviceAttributeMultiprocessorCount, dev) != hipSuccess) { grid = -1; return; }
        if (hipFuncSetAttribute((const void*)fwd, hipFuncAttributeMaxDynamicSharedMemorySize, LDS_BYTES) != hipSuccess) { fprintf(stderr, "kernel_launch: hipFuncSetAttribute failed\n"); grid = -1; return; }
        if (hipOccupancyMaxActiveBlocksPerMultiprocessor(&per_cu, (const void*)fwd, NTHREADS, LDS_BYTES) != hipSuccess || per_cu < 1) fprintf(stderr, "kernel_launch: occupancy query reports %d\n", per_cu);
        (void)hipGetLastError();
        grid = cus < 256 ? cus : 256;
    }
    if (grid < 0) return;
    (void)hipMemsetAsync((char*)d_ws + WS_CTL, 0, CTL_ZERO_BYTES, stream);
    Args a{};
    for (int i = 0; i < 27; ++i) a.in[i] = (const float*)d_in[i];
    a.out = (float*)d_out; a.ws = (unsigned char*)d_ws;
#if MK_N_LAUNCHES == 1
    a.ph_lo = 0; a.ph_hi = N_PHASES;
    hipLaunchKernelGGL(fwd, dim3(grid), dim3(NTHREADS), LDS_BYTES, stream, a);
#else
    for (int p = 0; p < N_PHASES; ++p) { a.ph_lo = p; a.ph_hi = p + 1; hipLaunchKernelGGL(fwd, dim3(grid), dim3(NTHREADS), LDS_BYTES, stream, a); }
#endif
}
```

```cpp
#include <hip/hip_runtime.h>
#include <cstdio>
#include <cstdint>

#ifndef MK_N_LAUNCHES
#define MK_N_LAUNCHES 1
#endif

#define LAS __attribute__((address_space(3)))
#define GAS __attribute__((address_space(1)))
#define HD __host__ __device__
#define HDI __host__ __device__ __attribute__((always_inline)) inline
typedef unsigned short bf16;
typedef short bf16x8 __attribute__((ext_vector_type(8)));
typedef float f32x4 __attribute__((ext_vector_type(4)));
typedef float f32x2 __attribute__((ext_vector_type(2)));
typedef float f32x16 __attribute__((ext_vector_type(16)));
typedef unsigned u32x4 __attribute__((ext_vector_type(4)));
typedef unsigned u32x2 __attribute__((ext_vector_type(2)));

constexpr int D = 1024, BATCH = 8, SEQ = 4096, NTOK = BATCH * SEQ, NMEM = 256, NMEMTOK = BATCH * NMEM;
constexpr int DIN = 7704;
constexpr int C_RQ = 0, C_RK = 512, C_RV = 1024, C_RG = 2048, C_NQ = 3072, C_CK = 4096, C_NGL = 5632, C_GA = 5656, C_GB = 6680;
constexpr int NPROJ = 5632;
constexpr int NEXP = 32, DEXP = 512;
constexpr float EPS = 1e-6f;
constexpr int NWAVES = 8, NTHREADS = 512;

constexpr size_t MiB = 1u << 20;
constexpr size_t WS_CTL = 0, CTL_ZERO_BYTES = 1 * MiB;
constexpr size_t WS_ROPE_COS = 1 * MiB, WS_ROPE_SIN = 2 * MiB;
constexpr size_t WS_RTW = 3 * MiB + 512 * 1024;
constexpr size_t WS_SMALLW = 3 * MiB;
constexpr size_t WS_MEMVT = 24 * MiB;
constexpr size_t WS_KCMP = 4 * MiB, WS_VCMP = 5 * MiB, WS_VCMPT = 35 * MiB;
constexpr size_t WS_GATES = 10 * MiB;
constexpr size_t WS_SSQ = 13 * MiB;
constexpr size_t WS_ROUTE = 15 * MiB;
constexpr size_t WS_LISTS = 16 * MiB;
constexpr size_t WS_W = 36 * MiB;
constexpr size_t W_IN = WS_W;
constexpr size_t W_GA = W_IN + 11 * MiB, W_GB = W_GA + 2 * MiB;
constexpr size_t W_RO = W_GB + 2 * MiB, W_NO = W_RO + 2 * MiB, W_OUT = W_NO + 2 * MiB, W_XQ = W_OUT + 2 * MiB, W_XO = W_XQ + 2 * MiB;
constexpr size_t W_XKV = W_XO + 2 * MiB;
constexpr size_t W_C1K = W_XKV + 4 * MiB, W_C1V = W_C1K + 2 * MiB;
constexpr size_t WS_MEMN = W_C1V + 2 * MiB;
constexpr size_t WS_MEMKV = WS_MEMN + 4 * MiB;
constexpr size_t WS_H = 84 * MiB;
constexpr size_t WS_NQ = WS_H + 64 * MiB;
constexpr size_t WS_RV = WS_NQ + 64 * MiB;
constexpr size_t WS_RQ = WS_RV + 64 * MiB;
constexpr size_t WS_RK = WS_RQ + 32 * MiB;
constexpr size_t WS_RG = WS_RK + 32 * MiB;
constexpr size_t WS_KV6 = WS_RG + 64 * MiB;
constexpr size_t KV_STRIDE = 16 * MiB;
constexpr size_t WS_END = WS_KV6 + 96 * MiB;
constexpr size_t WS_Y = WS_RQ, WS_P4SCR = WS_RG, WS_W13 = WS_RQ, WS_W2 = WS_RG, WS_H1 = WS_KV6, WS_X1B = WS_H, WS_X2B = WS_RV, WS_YS0 = WS_H, WS_YS1 = WS_NQ;
static_assert(WS_MEMKV + 8 * MiB <= WS_H && WS_VCMPT + 1 * MiB <= WS_W && WS_MEMVT + 4 * MiB <= WS_VCMPT, "ws map");
constexpr int CW_BAR = 4096;
constexpr int CW_ECNT = 16384;
constexpr int LDS_BYTES = 147456, RING_BYTES = 131072, MISC_OFF = RING_BYTES + 320;

HD inline float bf2f(bf16 b) { return __builtin_bit_cast(float, (unsigned)b << 16); }
HD inline unsigned f2bf(float f) { unsigned u = __builtin_bit_cast(unsigned, f); return (u + 0x7fffu + ((u >> 16) & 1u)) >> 16; }
HD inline unsigned pk2(float lo, float hi) { return f2bf(lo) | (f2bf(hi) << 16); }
HD inline float lo16(unsigned w) { return __builtin_bit_cast(float, w << 16); }
HD inline float hi16(unsigned w) { return __builtin_bit_cast(float, w & 0xffff0000u); }
__device__ __forceinline__ unsigned cvt_pk_bf16(float lo, float hi) { unsigned r; asm volatile("v_cvt_pk_bf16_f32 %0, %1, %2" : "=v"(r) : "v"(lo), "v"(hi)); return r; }
#define DPP_F(v, ctrl, rmask) __builtin_bit_cast(float, __builtin_amdgcn_update_dpp(0, __builtin_bit_cast(int, v), ctrl, rmask, 0xf, false))
__device__ __forceinline__ float wave_sum(float v) {
    v += DPP_F(v, 0xB1, 0xf);
    v += DPP_F(v, 0x4E, 0xf);
    v += DPP_F(v, 0x141, 0xf);
    v += DPP_F(v, 0x140, 0xf);
    v += DPP_F(v, 0x142, 0xa);
    v += DPP_F(v, 0x143, 0xc);
    return __builtin_bit_cast(float, __builtin_amdgcn_readlane(__builtin_bit_cast(int, v), 63));
}
__device__ __forceinline__ float wave_max(float v) {
#pragma unroll
    for (int o = 1; o < 64; o <<= 1) v = fmaxf(v, __shfl_xor(v, o));
    return v;
}
__device__ __forceinline__ float sigmoidf_(float x) { return __builtin_amdgcn_rcpf(1.0f + __builtin_amdgcn_exp2f(-1.4426950408889634f * x)); }
#define LAUNDER(p) asm volatile("" : "+v"(p))
#define LDS_WAIT() asm volatile("s_waitcnt lgkmcnt(0)" ::: "memory")
#define VM_WAIT() asm volatile("s_waitcnt vmcnt(0)" ::: "memory")

#define XB_TMO      128
#define XB_XCNT(j)  (256  + 64 * (j))
#define XB_XSUB(j)  (1280 + 64 * (j))
#define XB_XGEN(j)  (2304 + 64 * (j))
#define XB_TOP      3328
#define XB_TOPGEN   3392
#define XCD_BAR_WORDS 3456
#define XB_SPIN_CAP (1u << 24)
__device__ __forceinline__ unsigned xb_ld(unsigned* p)              { return __hip_atomic_load(p, __ATOMIC_RELAXED, __HIP_MEMORY_SCOPE_AGENT); }
__device__ __forceinline__ unsigned xb_add(unsigned* p, unsigned v) { return __hip_atomic_fetch_add(p, v, __ATOMIC_RELAXED, __HIP_MEMORY_SCOPE_AGENT); }
__device__ __forceinline__ unsigned xb_xcc_id() { return (unsigned)__builtin_amdgcn_s_getreg((3 << 11) | 20) & 0xFu; }
#define XB_SPIN(cond, bar) do { unsigned _sp = 0; while (cond) { __builtin_amdgcn_s_sleep(1); \
    if ((++_sp & 255u) == 0u) { if (xb_ld(&(bar)[XB_TMO])) break; if (_sp > XB_SPIN_CAP) { atomicAdd(&(bar)[XB_TMO], 1u); break; } } } } while (0)
struct XcdBarrier { unsigned* bar; unsigned x; volatile LAS unsigned* st; };
__device__ __forceinline__ XcdBarrier xcd_barrier_post(unsigned* bar, volatile LAS unsigned* st) {
    XcdBarrier b; b.bar = bar; b.x = xb_xcc_id(); b.st = st;
    if (threadIdx.x == 0) (void)xb_add(&bar[XB_XCNT(b.x)], 1u);
    return b;
}
__device__ __forceinline__ void xcd_barrier_complete(unsigned* bar, unsigned x, unsigned& nloc, unsigned& nx) {
    const unsigned G = gridDim.x * gridDim.y * gridDim.z;
    unsigned sum, cnt, mine, sp = 0u;
    for (;;) {
        sum = 0u; cnt = 0u; mine = 0u;
#pragma unroll
        for (unsigned j = 0; j < 16; ++j) { const unsigned c = xb_ld(&bar[XB_XCNT(j)]); sum += c; cnt += (c > 0u) ? 1u : 0u; mine = (j == x) ? c : mine; }
        if (sum == G) break;
        __builtin_amdgcn_s_sleep(1);
        if ((++sp & 255u) == 0u) { if (xb_ld(&bar[XB_TMO])) break; if (sp > XB_SPIN_CAP) { atomicAdd(&bar[XB_TMO], 1u); break; } }
    }
    nloc = mine > 0u ? mine : 1u; nx = cnt > 0u ? cnt : 1u;
}
__device__ __forceinline__ void xcd_barrier(const XcdBarrier& b) {
    asm volatile("s_waitcnt vmcnt(0)" ::: "memory");
    __syncthreads();
    if (threadIdx.x == 0) {
        unsigned* bar = b.bar;
        __builtin_amdgcn_s_waitcnt(0);
        unsigned nloc = b.st[0], nx = b.st[1];
        if (nloc == 0u) { xcd_barrier_complete(bar, b.x, nloc, nx); b.st[0] = nloc; b.st[1] = nx; }
        const unsigned old = xb_add(&bar[XB_XSUB(b.x)], 1u);
        const unsigned gen = old / nloc;
        if (old + 1u == (gen + 1u) * nloc) {
            __builtin_amdgcn_fence(__ATOMIC_RELEASE, "agent");
            asm volatile("s_waitcnt vmcnt(0)" ::: "memory");
            const unsigned og = xb_add(&bar[XB_TOP], 1u);
            const unsigned tg = og / nx;
            if (og + 1u == (tg + 1u) * nx) xb_add(&bar[XB_TOPGEN], 1u);
            else XB_SPIN(xb_ld(&bar[XB_TOPGEN]) == tg, bar);
            __builtin_amdgcn_fence(__ATOMIC_ACQUIRE, "agent");
            xb_add(&bar[XB_XGEN(b.x)], 1u);
            asm volatile("s_waitcnt vmcnt(0)" ::: "memory");
        } else {
            XB_SPIN(xb_ld(&bar[XB_XGEN(b.x)]) == gen, bar);
            __builtin_amdgcn_fence(__ATOMIC_ACQUIRE, "agent");
            asm volatile("s_waitcnt vmcnt(0)" ::: "memory");
        }
    }
    __syncthreads();
}

namespace pg8 {
constexpr int BM = 256, BK = 64, HALF = 128, HTB = HALF * BK * 2, NXCD = 8, WGM = 8;
HD __forceinline__ int lds_byte(int r, int c) { const int st = (r >> 4) * 2 + (c >> 5), rr = r & 15, cc = c & 31, ob = rr * 64 + cc * 2; return st * 1024 + (ob ^ (((ob >> 9) & 1) << 5)); }
HD __forceinline__ void stage_rc(int b, int& R, int& C) { const int st = b / 1024, sb = b % 1024, swz = sb ^ (((sb >> 9) & 1) << 5); R = (st >> 1) * 16 + swz / 64; C = (st & 1) * 32 + (swz % 64) / 2; }
HD __forceinline__ int perm32(int rho) { const int n = rho >> 4, i = rho & 15; return 8 * (i >> 2) + 4 * n + (i & 3); }
HD __forceinline__ void tile_map(int L, int nM, int nN, int& pm, int& pn) {
    const int nwg = nM * nN; int wgid = L; { const int q = nwg / NXCD, r = nwg % NXCD, xcd = wgid % NXCD, off = wgid / NXCD; wgid = (xcd < r ? xcd * (q + 1) : r * (q + 1) + (xcd - r) * q) + off; }
    const int nig = WGM * nN, gid = wgid / nig, fm = gid * WGM, gsz = (nM - fm) < WGM ? (nM - fm) : WGM;
    pm = fm + ((wgid % nig) % gsz); pn = (wgid % nig) / gsz;
}
struct GU { const char* A; const char* B; const int* rows; int nvalid; int kind, pm, pn, aux; };
template <class Epi, class Sched, bool GATHER>
__device__ __forceinline__ void gemm_phase(LAS unsigned char* lds, const int K, const int lda, const int ldb, const Sched& S, const Epi& E) {
    int tid_ = threadIdx.x; LAUNDER(tid_);
    const int tid = tid_, wid = __builtin_amdgcn_readfirstlane(tid >> 6), lane = tid & 63, wr = wid >> 2, wc = wid & 3, fr = lane & 15, fq = lane >> 4;
    const int nt = K / BK;
    unsigned voffB[2];
#pragma unroll
    for (int i = 0; i < 2; ++i) { int R, C; stage_rc(tid * 16 + i * 8192, R, C); const int Rb = Epi::PERM ? ((R & ~31) + perm32(R & 31)) : R; voffB[i] = (unsigned)(Rb * ldb + C) * 2u; }
    const size_t kstep = (size_t)(BK * 2);
    const size_t hstepB = (size_t)HALF * ldb * 2;
    const unsigned ldsw = (unsigned)wid * 1024u;
    const int aoff = lds_byte(wr * 64 + fr, fq * 8), boff = lds_byte(wc * 32 + fr, fq * 8);
#define PG8_SA(b, h) (((b) * 2 + (h)) * HTB)
#define PG8_SB(b, h) ((4 + (b) * 2 + (h)) * HTB)
#define PG8_STAGE2(bufoff, gbase, v0, v1) do { \
        __builtin_amdgcn_global_load_lds((const unsigned*)((const char*)(gbase) + (v0)), (LAS unsigned*)(lds + (bufoff) + ldsw), 16, 0, 0); \
        __builtin_amdgcn_global_load_lds((const unsigned*)((const char*)(gbase) + (v1)), (LAS unsigned*)(lds + (bufoff) + ldsw + 8192), 16, 0, 0); } while (0)
#define PG8_STAGEB(bufoff, gbase) PG8_STAGE2(bufoff, gbase, voffB[0], voffB[1])
#define PG8_LDA(dst, b, h) do { _Pragma("unroll") for (int m = 0; m < 4; ++m) _Pragma("unroll") for (int k = 0; k < 2; ++k) dst[m][k] = *(const LAS bf16x8*)(lds + PG8_SA(b, h) + aoff + m * 2048 + k * 1024); } while (0)
#define PG8_LDB(dst, b, h) do { _Pragma("unroll") for (int n = 0; n < 2; ++n) _Pragma("unroll") for (int k = 0; k < 2; ++k) dst[n][k] = *(const LAS bf16x8*)(lds + PG8_SB(b, h) + boff + n * 2048 + k * 1024); } while (0)
#define PG8_MMA(ai, bj, At, Bt) do { __builtin_amdgcn_s_setprio(1); _Pragma("unroll") for (int m = 0; m < 4; ++m) _Pragma("unroll") for (int n = 0; n < 2; ++n) _Pragma("unroll") for (int k = 0; k < 2; ++k) \
        acc[ai][bj][m][n] = __builtin_amdgcn_mfma_f32_16x16x32_bf16(Bt[n][k], At[m][k], acc[ai][bj][m][n], 0, 0, 0); __builtin_amdgcn_s_setprio(0); } while (0)
#define PG8_WAIT_V(n) asm volatile("s_waitcnt vmcnt(" #n ")" ::: "memory")
#define PG8_WAIT_L(n) asm volatile("s_waitcnt lgkmcnt(" #n ")" ::: "memory")
#define PG8_BAR __builtin_amdgcn_s_barrier()
#define PG8_SCHED __builtin_amdgcn_sched_barrier(0)
#define PG8_VOFFA(u, vo) do { _Pragma("unroll") for (int h = 0; h < 2; ++h) _Pragma("unroll") for (int i = 0; i < 2; ++i) { int R_, C_; stage_rc(tid * 16 + i * 8192, R_, C_); const int R = R_ + HALF * h; \
        int ridx = R; if (GATHER) { ridx = (R < (u).nvalid) ? ((u).rows[R] >> 1) : 0; } vo[h][i] = (unsigned)(ridx * lda + C_) * 2u; } if (GATHER) asm volatile("" :: "v"(vo[0][0]), "v"(vo[0][1]), "v"(vo[1][0]), "v"(vo[1][1])); } while (0)
    GU cur, nxt; int ui = 0;
    if (!S.next(0, cur)) return;
    f32x4 acc[2][2][4][2];
#pragma unroll
    for (int a = 0; a < 2; ++a)
#pragma unroll
        for (int b = 0; b < 2; ++b)
#pragma unroll
            for (int m = 0; m < 4; ++m)
#pragma unroll
                for (int n = 0; n < 2; ++n) acc[a][b][m][n] = (f32x4){0.f, 0.f, 0.f, 0.f};
    bf16x8 At[4][2], B0[2][2], B1[2][2];
    unsigned cv[2][2], nv[2][2];
    PG8_VOFFA(cur, cv);
    const char* cA = cur.A; const char* cB = cur.B;
    PG8_STAGEB(PG8_SB(0, 0), cB); PG8_STAGEB(PG8_SB(0, 1), cB + hstepB); PG8_STAGE2(PG8_SA(0, 0), cA, cv[0][0], cv[0][1]); PG8_STAGE2(PG8_SA(0, 1), cA, cv[1][0], cv[1][1]);
    if (wr == 1) PG8_BAR;
    PG8_WAIT_V(2); PG8_BAR;
    PG8_STAGEB(PG8_SB(1, 0), cB + kstep); PG8_STAGE2(PG8_SA(1, 0), cA + kstep, cv[0][0], cv[0][1]); PG8_STAGEB(PG8_SB(1, 1), cB + hstepB + kstep);
    PG8_WAIT_V(6); PG8_BAR;
    for (;;) {
        const bool has_next = S.next(ui + 1, nxt);
        const char* nA = has_next ? nxt.A : cA; const char* nB = has_next ? nxt.B : cB;
        if (has_next) { PG8_VOFFA(nxt, nv); } else {
#pragma unroll
            for (int h = 0; h < 2; ++h)
#pragma unroll
                for (int i = 0; i < 2; ++i) nv[h][i] = cv[h][i]; }
        for (int t = 0; t < nt; t += 2) {
            const bool last = (t == nt - 2);
            const char* a1 = cA + (size_t)(t + 1) * kstep;
            const char* a2 = last ? nA : cA + (size_t)(t + 2) * kstep; const char* b2 = last ? nB : cB + (size_t)(t + 2) * kstep;
            const char* a3 = a2 + kstep; const char* b3 = b2 + kstep;
            const unsigned w00 = last ? nv[0][0] : cv[0][0], w01 = last ? nv[0][1] : cv[0][1], w10 = last ? nv[1][0] : cv[1][0], w11 = last ? nv[1][1] : cv[1][1];
            PG8_LDB(B0, 0, 0); PG8_LDB(B1, 0, 1); PG8_SCHED; PG8_LDA(At, 0, 0); PG8_STAGE2(PG8_SA(1, 1), a1, cv[1][0], cv[1][1]);
            PG8_WAIT_V(8); PG8_WAIT_L(0); PG8_BAR; PG8_MMA(0, 0, At, B0); PG8_MMA(0, 1, At, B1); PG8_BAR; PG8_SCHED;
            PG8_LDA(At, 0, 1); PG8_STAGEB(PG8_SB(0, 0), b2); PG8_STAGEB(PG8_SB(0, 1), b2 + hstepB); PG8_STAGE2(PG8_SA(0, 0), a2, w00, w01);
            PG8_WAIT_V(8); PG8_WAIT_L(0); PG8_BAR; PG8_MMA(1, 0, At, B0); PG8_MMA(1, 1, At, B1); PG8_BAR; PG8_SCHED;
            PG8_LDB(B0, 1, 0); PG8_LDB(B1, 1, 1); PG8_SCHED; PG8_LDA(At, 1, 0); PG8_STAGE2(PG8_SA(0, 1), a2, w10, w11);
            PG8_WAIT_V(8); PG8_WAIT_L(0); PG8_BAR; PG8_MMA(0, 0, At, B0); PG8_MMA(0, 1, At, B1); PG8_BAR; PG8_SCHED;
            PG8_LDA(At, 1, 1); PG8_STAGEB(PG8_SB(1, 0), b3); PG8_STAGEB(PG8_SB(1, 1), b3 + hstepB); PG8_STAGE2(PG8_SA(1, 0), a3, w00, w01);
            PG8_WAIT_V(8); PG8_WAIT_L(0); PG8_BAR; PG8_MMA(1, 0, At, B0); PG8_MMA(1, 1, At, B1); PG8_BAR; PG8_SCHED;
        }
        if (wr == 0) PG8_BAR;
        E(acc, cur, wr, wc, fr, fq);
        if (!has_next) break;
#pragma unroll
        for (int a = 0; a < 2; ++a)
#pragma unroll
            for (int b = 0; b < 2; ++b)
#pragma unroll
                for (int m = 0; m < 4; ++m)
#pragma unroll
                    for (int n = 0; n < 2; ++n) acc[a][b][m][n] = (f32x4){0.f, 0.f, 0.f, 0.f};
        cur = nxt; cA = nA; cB = nB; ++ui;
#pragma unroll
        for (int h = 0; h < 2; ++h)
#pragma unroll
            for (int i = 0; i < 2; ++i) cv[h][i] = nv[h][i];
        if (wr == 1) PG8_BAR;
    }
    PG8_WAIT_V(0);
    PG8_BAR;
#undef PG8_SA
#undef PG8_SB
#undef PG8_STAGE2
#undef PG8_STAGEB
#undef PG8_LDA
#undef PG8_LDB
#undef PG8_MMA
#undef PG8_WAIT_V
#undef PG8_WAIT_L
#undef PG8_BAR
#undef PG8_SCHED
#undef PG8_VOFFA
}
}
using pg8::GU;

struct Args {
    const float* in[27]; float* out; unsigned char* ws; int ph_lo, ph_hi; int pad0, pad1;
};
enum { IN_X = 0, IN_MEM, IN_NORM_MIX_G, IN_W_IN, IN_W_RET_O, IN_W_NSA_O, IN_W_OUT, IN_CMP_PE_K, IN_CMP_W1_K, IN_CMP_W2_K, IN_CMP_PE_V, IN_CMP_W1_V, IN_CMP_W2_V,
       IN_NORM_X_G, IN_NORM_MEM_G, IN_W_XQ, IN_W_XKV, IN_W_XO, IN_NORM_FFN_G, IN_W_GRP, IN_B_GRP, IN_W_RT, IN_B_RT, IN_W_E1, IN_W_E3, IN_W_E2, IN_NORM_F_G };
struct Frame {
    LAS unsigned char* lds; volatile LAS unsigned* MISC; unsigned* ctl; unsigned char* ws;
    int tid, lane, wave, G, bx;
};

__device__ __forceinline__ bool phase_begin(Frame& F) { int t = threadIdx.x; LAUNDER(t); F.tid = t; F.lane = t & 63; return true; }
__device__ __forceinline__ void transpose_item(const float* W, int ldw, int c0, int k0, bf16* WT, int ldt, int mode, int row_off, int cbase, const float* kscale, float scale, LAS float* scr, int lane) {
    float vv[32];
#pragma unroll
    for (int i = 0; i < 32; ++i) { const int kk = 2 * i + (lane >> 5); vv[i] = W[(size_t)(k0 + kk) * ldw + c0 + (lane & 31)]; }
    if (kscale) {
#pragma unroll
        for (int i = 0; i < 32; ++i) { const int kk = 2 * i + (lane >> 5); vv[i] *= kscale[k0 + kk]; } }
#pragma unroll
    for (int i = 0; i < 32; ++i) { const int kk = 2 * i + (lane >> 5); scr[kk * 33 + (lane & 31)] = vv[i] * scale; }
    LDS_WAIT(); asm volatile("" ::: "memory");
    const int c = lane & 7;
#pragma unroll
    for (int j = 0; j < 4; ++j) { const int n = (lane >> 3) + 8 * j; const LAS float* s = scr + (8 * c) * 33 + n;
        u32x4 o; o.x = pk2(s[0 * 33], s[1 * 33]); o.y = pk2(s[2 * 33], s[3 * 33]); o.z = pk2(s[4 * 33], s[5 * 33]); o.w = pk2(s[6 * 33], s[7 * 33]);
        const int jc = c0 - cbase + n; const int drow = mode == 0 ? row_off + jc : (8 * (jc >> 2) + 4 * row_off + (jc & 3));
        *(u32x4*)(WT + (size_t)drow * ldt + k0 + 8 * c) = o; }
    LDS_WAIT(); asm volatile("" ::: "memory");
}
__device__ __forceinline__ void transpose_matrix(Frame& F, int& item_base, const float* W, int ldw, int K, int cbase, int ncols, bf16* WT, int ldt, int mode, int row_off, const float* kscale, float scale) {
    LAS float* scr = (LAS float*)(F.lds + F.wave * 16384);
    const int gw = F.bx * NWAVES + F.wave, NGW = F.G * NWAVES;
    const int nb = ncols / 32, nitems = (K / 64) * nb;
    int it = (gw - item_base % NGW + NGW) % NGW;
    for (; it < nitems; it += NGW) transpose_item(W, ldw, cbase + 32 * (it % nb), 64 * (it / nb), WT, ldt, mode, row_off, cbase, kscale, scale, scr, F.lane);
    item_base += nitems;
}
__device__ __forceinline__ void rms_row_to_bf16(int lane, const float* xrow, const float* g, bf16* orow) {
    const f32x4* xr = (const f32x4*)xrow + lane; const f32x4* gr = (const f32x4*)g + lane;
    f32x4 v[4]; float s = 0.f;
#pragma unroll
    for (int j = 0; j < 4; ++j) { v[j] = xr[64 * j]; s += (v[j].x * v[j].x + v[j].y * v[j].y) + (v[j].z * v[j].z + v[j].w * v[j].w); }
    const float rstd = 1.0f / sqrtf(wave_sum(s) * (1.f / D) + EPS);
    unsigned long long* o8 = (unsigned long long*)orow + lane;
#pragma unroll
    for (int j = 0; j < 4; ++j) { const f32x4 gg = gr[64 * j];
        o8[64 * j] = (unsigned long long)pk2(v[j].x * rstd * gg.x, v[j].y * rstd * gg.y) | ((unsigned long long)pk2(v[j].z * rstd * gg.z, v[j].w * rstd * gg.w) << 32); }
}

struct XItem { const float* src; bf16* dst; const float* ks; float scale; int ldw, ldt, mode, row_off, csrc, c0, k0, has_ks; };
__device__ __forceinline__ void xitem_decode_expert(const Args& a, unsigned char* ws, int it, XItem& x) {
    const int e = it / 768, r = it % 768, which = r >> 8, t = r & 255;
    x.ks = a.in[IN_NORM_FFN_G]; x.scale = 1.0f;
    if (which < 2) { x.src = a.in[which ? IN_W_E3 : IN_W_E1] + (size_t)e * D * DEXP; x.ldw = DEXP; x.dst = (bf16*)(ws + WS_W13) + (size_t)e * D * D; x.ldt = D; x.mode = 1; x.row_off = which; x.has_ks = 1; x.c0 = 32 * (t & 15); x.k0 = 64 * (t >> 4); }
    else { x.src = a.in[IN_W_E2] + (size_t)e * DEXP * D; x.ldw = D; x.dst = (bf16*)(ws + WS_W2) + (size_t)e * D * DEXP; x.ldt = DEXP; x.mode = 0; x.row_off = 0; x.has_ks = 0; x.c0 = 32 * (t & 31); x.k0 = 64 * (t >> 5); }
    x.csrc = x.c0;
}
constexpr int P0_NITEMS = 7936;
__device__ __forceinline__ void xitem_decode_p0(const Args& a, unsigned char* ws, int it, XItem& x) {
    int in_ = IN_W_IN, ldw = DIN, cb = 0, nc = 512, ldt = D, ro = 0, first = 0; size_t dst = W_IN; float sc = 1.0f; int hk = 0;
#define P0E(FIRST, IN__, LDW, CB, NC, DST, LDT, RO, SC, HK) if (it >= (FIRST)) { in_ = (IN__); ldw = (LDW); cb = (CB); nc = (NC); dst = (DST); ldt = (LDT); ro = (RO); sc = (SC); hk = (HK); first = (FIRST); }
    P0E(256, IN_W_IN, DIN, 512, 512, W_IN, D, 512, 0.08838834764831845f, 0)
    P0E(512, IN_W_IN, DIN, 1024, NPROJ - 1024, W_IN, D, 1024, 1.0f, 0)
    P0E(2816, IN_W_IN, DIN, C_GA, 1024, W_GA, D, 0, 1.0f, 0)
    P0E(3328, IN_W_IN, DIN, C_GB, 1024, W_GB, D, 0, 1.0f, 0)
    P0E(3840, IN_W_RET_O, D, 0, D, W_RO, D, 0, 1.0f, 0)
    P0E(4352, IN_W_NSA_O, D, 0, D, W_NO, D, 0, 1.0f, 0)
    P0E(4864, IN_W_OUT, D, 0, D, W_OUT, D, 0, 1.0f, 0)
    P0E(5376, IN_W_XQ, D, 0, D, W_XQ, D, 0, 1.0f, 1)
    P0E(5888, IN_W_XO, D, 0, D, W_XO, D, 0, 1.0f, 0)
    P0E(6400, IN_W_XKV, 2 * D, 0, 2 * D, W_XKV, D, 0, 1.0f, 0)
    P0E(7424, IN_CMP_W1_K, 128, 0, 128, W_C1K, 4096, 0, 1.0f, 0)
    P0E(7680, IN_CMP_W1_V, 128, 0, 128, W_C1V, 4096, 0, 1.0f, 0)
#undef P0E
    const int t = it - first, nb = nc >> 5;
    x.src = a.in[in_]; x.dst = (bf16*)(ws + dst); x.ks = a.in[IN_NORM_X_G]; x.scale = sc; x.ldw = ldw; x.ldt = ldt; x.mode = 0; x.row_off = ro; x.has_ks = hk;
    x.c0 = 32 * (t % nb); x.csrc = cb + x.c0; x.k0 = 64 * (t / nb);
}
__device__ __forceinline__ void xitem_load(const XItem& x, int lane, float (&vv)[32], f32x4& k0v, f32x4& k1v) {
#pragma unroll
    for (int i = 0; i < 32; ++i) { const int kk = 2 * i + (lane >> 5); vv[i] = x.src[(size_t)(x.k0 + kk) * x.ldw + x.csrc + (lane & 31)]; }
    const f32x4* p = (const f32x4*)(x.ks + ((x.k0 + 8 * (lane & 7)) & 1023)); k0v = p[0]; k1v = p[1];
}
__device__ __forceinline__ void xitem_finish(const XItem& x, int lane, const float (&vv)[32], f32x4 k0v, f32x4 k1v, LAS float* scr) {
    if (!x.has_ks) { k0v = (f32x4){1.f, 1.f, 1.f, 1.f}; k1v = k0v; }
    k0v *= x.scale; k1v *= x.scale;
#pragma unroll
    for (int i = 0; i < 32; ++i) { const int kk = 2 * i + (lane >> 5); scr[kk * 33 + (lane & 31)] = vv[i]; }
    LDS_WAIT(); asm volatile("" ::: "memory");
    const int c = lane & 7;
#pragma unroll
    for (int j = 0; j < 4; ++j) { const int n = (lane >> 3) + 8 * j; const LAS float* s = scr + (8 * c) * 33 + n;
        u32x4 o; o.x = pk2(s[0 * 33] * k0v.x, s[1 * 33] * k0v.y); o.y = pk2(s[2 * 33] * k0v.z, s[3 * 33] * k0v.w); o.z = pk2(s[4 * 33] * k1v.x, s[5 * 33] * k1v.y); o.w = pk2(s[6 * 33] * k1v.z, s[7 * 33] * k1v.w);
        const int jc = x.c0 + n; const int drow = x.mode == 0 ? x.row_off + jc : (8 * (jc >> 2) + 4 * x.row_off + (jc & 3));
        *(u32x4*)(x.dst + (size_t)drow * x.ldt + x.k0 + 8 * c) = o; }
    LDS_WAIT(); asm volatile("" ::: "memory");
}
template <bool EXPERT>
__device__ __forceinline__ void run_items(Frame& F, const Args& a, int it_begin, int it_end) {
    LAS float* scr = (LAS float*)(F.lds + F.wave * 16384);
    const int gw = F.bx * NWAVES + F.wave, NGW = F.G * NWAVES, lane = F.lane;
    int it = it_begin + gw;
#define XDEC(i_, x_) do { if (EXPERT) xitem_decode_expert(a, F.ws, (i_), x_); else xitem_decode_p0(a, F.ws, (i_), x_); } while (0)
    if (it < it_end) {
        float va[32], vb[32]; f32x4 ka0, ka1, kb0, kb1; XItem xa, xb;
        XDEC(it, xa); xitem_load(xa, lane, va, ka0, ka1);
        for (;;) {
            int itn = it + NGW; bool hn = itn < it_end;
            XDEC(hn ? itn : it, xb); xitem_load(xb, lane, vb, kb0, kb1);
            xitem_finish(xa, lane, va, ka0, ka1, scr);
            if (!hn) break;
            it = itn; itn = it + NGW; hn = itn < it_end;
            XDEC(hn ? itn : it, xa); xitem_load(xa, lane, va, ka0, ka1);
            xitem_finish(xb, lane, vb, kb0, kb1, scr);
            if (!hn) break;
            it = itn;
        }
    }
#undef XDEC
    __syncthreads();
}
__device__ __forceinline__ void expert_copies(Frame& F, const Args& a, int e_lo, int e_hi) { run_items<true>(F, a, e_lo * 768, e_hi * 768); }

__device__ __forceinline__ void p0_prologue(Frame& F, const Args& a) {
    unsigned char* ws = F.ws;
    const float* w_in = a.in[IN_W_IN];
    run_items<false>(F, a, 0, P0_NITEMS);
    const int gt = F.bx * NTHREADS + F.tid, NGT = F.G * NTHREADS;
    for (int i = gt; i < 2 * 128 * 4096 / 8; i += NGT) { const int m = i / (128 * 4096 / 8), r = i % (128 * 4096 / 8);
        *(u32x4*)(ws + (m ? W_C1V : W_C1K) + (size_t)128 * 4096 * 2 + (size_t)r * 16) = (u32x4){0u, 0u, 0u, 0u}; }
    bf16* wngl = (bf16*)(ws + WS_SMALLW);
    for (int i = gt; i < 32 * 1024; i += NGT) { const int r = i >> 10, k = i & 1023; wngl[i] = r < 24 ? (bf16)f2bf(w_in[(size_t)k * DIN + C_NGL + r]) : (bf16)0; }
    bf16* w2k = (bf16*)(ws + WS_SMALLW + 65536); bf16* w2v = w2k + 128 * 128;
    for (int i = gt; i < 2 * 128 * 128; i += NGT) { const int m = i >> 14, r = i & 16383, f = r >> 7, e = r & 127; const float* src = a.in[m ? IN_CMP_W2_V : IN_CMP_W2_K];
        (m ? w2v : w2k)[f * 128 + e] = (bf16)f2bf(src[e * 128 + f]); }
    { const float* gff = a.in[IN_NORM_FFN_G]; const float* wgrp = a.in[IN_W_GRP]; const float* wrt = a.in[IN_W_RT]; float* wgp = (float*)(ws + WS_RTW); float* wep = wgp + 4096;
      for (int i = gt; i < 4096; i += NGT) wgp[i] = gff[i >> 2] * wgrp[i];
      for (int i = gt; i < 32768; i += NGT) { const int j = i & 3, l = (i >> 2) & 63, half = (i >> 8) & 1, ii = (i >> 9) & 15, grp = i >> 13, k = 64 * ii + l; wep[i] = gff[k] * wrt[k * 32 + grp * 8 + half * 4 + j]; } }
    float* cbias = (float*)(ws + WS_SMALLW + 65536 + 2 * 128 * 128 * 2);
    const int gw = F.bx * NWAVES + F.wave, NGW = F.G * NWAVES;
    for (int o = gw; o < 256; o += NGW) { const int m = o >> 7, e = o & 127; const float* pe = a.in[m ? IN_CMP_PE_V : IN_CMP_PE_K]; const float* w1 = a.in[m ? IN_CMP_W1_V : IN_CMP_W1_K];
        float s = 0.f; for (int k = F.lane; k < 4096; k += 64) s += pe[k] * w1[(size_t)k * 128 + e];
        s = wave_sum(s); if (F.lane == 0) cbias[o] = s; }
    float* cosT = (float*)(ws + WS_ROPE_COS); float* sinT = (float*)(ws + WS_ROPE_SIN);
    for (int i = gt; i < SEQ * 64; i += NGT) { const int pos = i >> 6, j = i & 63; const float inv = powf(10000.0f, -(float)(2 * j) / 128.0f); const float ang = (float)pos * inv;
        cosT[i] = cosf(ang); sinT[i] = sinf(ang); }
    { f32x4 nx[4]; const float* X = a.in[IN_X]; const f32x4* gr = (const f32x4*)a.in[IN_NORM_MIX_G] + F.lane;
      if (gw < NTOK) {
#pragma unroll
          for (int j = 0; j < 4; ++j) nx[j] = ((const f32x4*)(X + (size_t)gw * D) + F.lane)[64 * j]; }
      for (int m = gw; m < NTOK; m += NGW) { f32x4 v[4]; float sq = 0.f;
#pragma unroll
          for (int j = 0; j < 4; ++j) { v[j] = nx[j]; sq += (v[j].x * v[j].x + v[j].y * v[j].y) + (v[j].z * v[j].z + v[j].w * v[j].w); }
          if (m + NGW < NTOK) {
#pragma unroll
              for (int j = 0; j < 4; ++j) nx[j] = ((const f32x4*)(X + (size_t)(m + NGW) * D) + F.lane)[64 * j]; }
          const float rstd = 1.0f / sqrtf(wave_sum(sq) * (1.f / D) + EPS); unsigned long long* o8 = (unsigned long long*)((bf16*)(ws + WS_H) + (size_t)m * D) + F.lane;
#pragma unroll
          for (int j = 0; j < 4; ++j) { const f32x4 gg = gr[64 * j]; o8[64 * j] = (unsigned long long)pk2(v[j].x * rstd * gg.x, v[j].y * rstd * gg.y) | ((unsigned long long)pk2(v[j].z * rstd * gg.z, v[j].w * rstd * gg.w) << 32); } } }
    for (int m = gw; m < NMEMTOK; m += NGW) rms_row_to_bf16(F.lane, a.in[IN_MEM] + (size_t)m * D, a.in[IN_NORM_MEM_G], (bf16*)(ws + WS_MEMN) + (size_t)m * D);
}

struct SchedP1 {
    unsigned char* ws; int G, c;
    __device__ __forceinline__ bool next(int i, GU& u) const {
        constexpr int NP = 128 * 22; const int L = i * G + c;
        u.rows = nullptr; u.nvalid = 0; u.aux = 0;
        if (L < NP) { int pm, pn; pg8::tile_map(L, 128, 22, pm, pn); u.A = (const char*)ws + WS_H + (size_t)pm * 256 * D * 2; u.B = (const char*)ws + W_IN + (size_t)pn * 256 * D * 2; u.pm = pm; u.pn = pn;
            u.kind = pn < 2 ? 0 : pn < 4 ? 1 : pn < 8 ? 2 : pn < 12 ? 3 : pn < 16 ? 4 : 5; return true; }
        const int L2 = L - NP; if (L2 >= 64) return false;
        const int pm = L2 & 7, pn = L2 >> 3; u.A = (const char*)ws + WS_MEMN + (size_t)pm * 256 * D * 2; u.B = (const char*)ws + W_XKV + (size_t)pn * 256 * D * 2; u.pm = pm; u.pn = pn; u.kind = 6; return true;
    }
};
struct EpiP1 {
    static constexpr bool PERM = true;
    unsigned char* ws;
    __device__ __forceinline__ void operator()(const f32x4 (&acc)[2][2][4][2], const GU& u, int wr, int wc, int fr, int fq) const {
        const int kind = u.kind;
        const float* cosT = (const float*)(ws + WS_ROPE_COS); const float* sinT = (const float*)(ws + WS_ROPE_SIN);
#pragma unroll
        for (int ai = 0; ai < 2; ++ai)
#pragma unroll
            for (int m = 0; m < 4; ++m) {
                const int r = 128 * ai + 64 * wr + 16 * m + fr; const int tok = u.pm * 256 + r;
#pragma unroll
                for (int bj = 0; bj < 2; ++bj) {
                    f32x4 v0 = acc[ai][bj][m][0], v1 = acc[ai][bj][m][1];
                    const int ct = 128 * bj + 32 * wc + 8 * fq;
                    bf16* dst;
                    if (kind <= 1) {
                        const int s = tok & (SEQ - 1), i0 = ((ct & 127) >> 1);
                        const f32x4 cs = *(const f32x4*)(cosT + s * 64 + i0), sn = *(const f32x4*)(sinT + s * 64 + i0);
                        const f32x4 a0 = v0, a1 = v1;
                        v0[0] = a0[0] * cs[0] - a0[1] * sn[0]; v0[1] = a0[0] * sn[0] + a0[1] * cs[0];
                        v0[2] = a0[2] * cs[1] - a0[3] * sn[1]; v0[3] = a0[2] * sn[1] + a0[3] * cs[1];
                        v1[0] = a1[0] * cs[2] - a1[1] * sn[2]; v1[1] = a1[0] * sn[2] + a1[1] * cs[2];
                        v1[2] = a1[2] * cs[3] - a1[3] * sn[3]; v1[3] = a1[2] * sn[3] + a1[3] * cs[3];
                        dst = (bf16*)(ws + (kind == 0 ? WS_RQ : WS_RK)) + (size_t)tok * 512 + (u.pn & 1) * 256 + ct;
                    } else if (kind == 2) { dst = (bf16*)(ws + WS_RV) + (size_t)tok * 1024 + (u.pn - 4) * 256 + ct;
                    } else if (kind == 3) {
#pragma unroll
                        for (int j = 0; j < 4; ++j) { v0[j] = v0[j] * sigmoidf_(v0[j]); v1[j] = v1[j] * sigmoidf_(v1[j]); }
                        dst = (bf16*)(ws + WS_RG) + (size_t)tok * 1024 + (u.pn - 8) * 256 + ct;
                    } else if (kind == 4) { dst = (bf16*)(ws + WS_NQ) + (size_t)tok * 1024 + (u.pn - 12) * 256 + ct;
                    } else if (kind == 5) {
                        const int b = tok >> 12, s = tok & (SEQ - 1);
                        unsigned char* kvb = ws + WS_KV6 + (size_t)(u.pn - 16) * KV_STRIDE;
                        dst = (bf16*)kvb + ((size_t)(b * 2 + bj) * SEQ + s) * 128 + (ct & 127);
                    } else { dst = (bf16*)(ws + WS_MEMKV) + (size_t)tok * 2048 + u.pn * 256 + ct; }
                    u32x4 w; w.x = cvt_pk_bf16(v0[0], v0[1]); w.y = cvt_pk_bf16(v0[2], v0[3]); w.z = cvt_pk_bf16(v1[0], v1[1]); w.w = cvt_pk_bf16(v1[2], v1[3]);
                    *(u32x4*)dst = w;
                }
            }
    }
};
__device__ __forceinline__ void p1_gate_logits(Frame& F) {
    const bf16* H = (const bf16*)(F.ws + WS_H); const bf16* W = (const bf16*)(F.ws + WS_SMALLW); float* gates = (float*)(F.ws + WS_GATES);
    const int r = F.lane & 31, hh = F.lane >> 5;
    const int nb_ = F.G > 64 ? F.G - 64 : F.G, b0_ = F.G > 64 ? F.bx - 64 : F.bx;
    if (b0_ < 0) return;
    for (int rb = b0_ + nb_ * F.wave; rb < NTOK / 32; rb += nb_ * NWAVES) {
        f32x16 acc; for (int j = 0; j < 16; ++j) acc[j] = 0.f;
        const bf16* ap = H + (size_t)(rb * 32 + r) * D + 8 * hh; const bf16* bp = W + (size_t)r * D + 8 * hh;
        for (int s8 = 0; s8 < 8; ++s8) { bf16x8 av[8], bv[8];
#pragma unroll
            for (int q = 0; q < 8; ++q) { av[q] = *(const bf16x8*)(ap + 16 * (8 * s8 + q)); bv[q] = *(const bf16x8*)(bp + 16 * (8 * s8 + q)); }
#pragma unroll
            for (int q = 0; q < 8; ++q) acc = __builtin_amdgcn_mfma_f32_32x32x16_bf16(av[q], bv[q], acc, 0, 0, 0); }
        if (r < 24) {
#pragma unroll
            for (int reg = 0; reg < 16; ++reg) { const int row = (reg & 3) + 8 * (reg >> 2) + 4 * hh; gates[(size_t)(rb * 32 + row) * 24 + r] = sigmoidf_(acc[reg]); }
        }
    }
}

namespace retf {
constexpr int ROWB = 272;
constexpr int OFF_K = 0, OFF_V = 128 * 256, OFF_ZV = OFF_V + 128 * 64, OFF_ST = OFF_ZV + 128 * 64, OFF_PART = OFF_ST + 32 * ROWB, OFF_Q = OFF_PART + 4 * 4096;
static_assert(OFF_Q + 128 * 256 <= RING_BYTES, "retention LDS map");
typedef short s16x4 __attribute__((ext_vector_type(4)));
__device__ __forceinline__ u32x2 lds_tr(const LAS unsigned char* p) { return __builtin_bit_cast(u32x2, __builtin_amdgcn_ds_read_tr16_b64_v4i16((LAS s16x4*)p)); }
}
__device__ __forceinline__ void p2_retention_fast(Frame& F, int unit, bf16* outbase) {
    using namespace retf;
    const int bh = (unit & 7) * 4 + (unit >> 6), sl = (unit >> 3) & 7, b = bh >> 2, h = bh & 3;
    const bf16* rq = (const bf16*)(F.ws + WS_RQ); const bf16* rk = (const bf16*)(F.ws + WS_RK); const bf16* rv = (const bf16*)(F.ws + WS_RV);
    const int tid = F.tid, lane = F.lane, wave = F.wave, r = lane & 31, hi = lane >> 5; LAS unsigned char* lds = F.lds;
    const float lg = log2f(1.0f - exp2f(-5.0f - (float)h));
    const int nt = wave & 3, mh = wave >> 2;
    for (int i = tid; i < 32 * ROWB / 4; i += NTHREADS) ((LAS unsigned*)(lds + OFF_ST))[i] = 0u;
    f32x16 ST;
#pragma unroll
    for (int j = 0; j < 16; ++j) ST[j] = 0.f;
    const float gC = exp2f(128.0f * lg);
    const float zeta = exp2f((float)(127 - (tid >> 2)) * lg);
    const int blk = (lane >> 4) & 1, q4 = (lane & 15) >> 2, p4 = lane & 3;
    const int vtr = (4 * hi + q4) * 64 + 32 * blk + 8 * p4;
    const int ztr = (8 * hi + q4) * 64 + 32 * blk + 8 * p4;
    int ktr[2];
#pragma unroll
    for (int t = 0; t < 2; ++t) ktr[t] = 256 * (8 * hi + 4 * t + q4) + 16 * ((4 * nt + 2 * blk + (p4 >> 1)) ^ ((q4 << 2) | ((2 * hi + t) & 3))) + 8 * (p4 & 1);
    const int krow = 256 * r + 16 * (hi ^ (((r & 3) << 2) | ((r >> 2) & 3)));
    u32x4 kreg[4], qreg[4], vreg;
    {   const int tok0 = b * SEQ;
#pragma unroll
        for (int i = 0; i < 4; ++i) { const int p = tid + 512 * i, m = p >> 4, cc = p & 15; kreg[i] = *(const u32x4*)(rk + (size_t)(tok0 + m) * 512 + h * 128 + cc * 8); qreg[i] = *(const u32x4*)(rq + (size_t)(tok0 + m) * 512 + h * 128 + cc * 8); }
        { const int m = tid >> 2, cc = tid & 3; vreg = *(const u32x4*)(rv + (size_t)(tok0 + m) * 1024 + h * 256 + sl * 32 + cc * 8); } }
    u32x2 opk[4]; bf16* oprev = outbase;
#pragma unroll
    for (int i = 0; i < 4; ++i) opk[i] = (u32x2){0u, 0u};
    for (int c = 0; c < SEQ / 128; ++c) {
        const int tok0 = b * SEQ + c * 128;
        __syncthreads();
#pragma unroll
        for (int i = 0; i < 4; ++i) { const int p = tid + 512 * i, m = p >> 4, cc = p & 15; const int o_ = 256 * m + 16 * (cc ^ (((m & 3) << 2) | ((m >> 2) & 3)));
            *(LAS u32x4*)(lds + OFF_K + o_) = kreg[i]; *(LAS u32x4*)(lds + OFF_Q + o_) = qreg[i]; }
        { const u32x4 v = vreg; u32x4 zv;
            zv.x = cvt_pk_bf16(lo16(v.x) * zeta, hi16(v.x) * zeta); zv.y = cvt_pk_bf16(lo16(v.y) * zeta, hi16(v.y) * zeta); zv.z = cvt_pk_bf16(lo16(v.z) * zeta, hi16(v.z) * zeta); zv.w = cvt_pk_bf16(lo16(v.w) * zeta, hi16(v.w) * zeta);
            *(LAS u32x4*)(lds + OFF_V + tid * 16) = v; *(LAS u32x4*)(lds + OFF_ZV + tid * 16) = zv; }
        __syncthreads();
        if (mh == 0 && c > 0) {
#pragma unroll
            for (int i = 0; i < 4; ++i) *(u32x2*)(oprev + 8 * i + 4 * hi) = opk[i]; }
        if (c + 1 < SEQ / 128) { const int tok1 = tok0 + 128;
#pragma unroll
            for (int i = 0; i < 4; ++i) { const int p = tid + 512 * i, m = p >> 4, cc = p & 15; kreg[i] = *(const u32x4*)(rk + (size_t)(tok1 + m) * 512 + h * 128 + cc * 8); qreg[i] = *(const u32x4*)(rq + (size_t)(tok1 + m) * 512 + h * 128 + cc * 8); }
            { const int m = tid >> 2, cc = tid & 3; vreg = *(const u32x4*)(rv + (size_t)(tok1 + m) * 1024 + h * 256 + sl * 32 + cc * 8); } }
        bf16x8 qf[8];
#pragma unroll
        for (int s_ = 0; s_ < 8; ++s_) qf[s_] = *(const LAS bf16x8*)(lds + OFF_Q + 8192 * nt + (krow ^ (32 * s_)));
        f32x16 CR;
#pragma unroll
        for (int j = 0; j < 16; ++j) CR[j] = 0.f;
        if (mh == 0) {
#pragma unroll
            for (int s_ = 0; s_ < 8; ++s_) { const bf16x8 a = *(const LAS bf16x8*)(lds + OFF_ST + r * ROWB + (16 * s_ + 8 * hi) * 2); CR = __builtin_amdgcn_mfma_f32_32x32x16_bf16(a, qf[s_], CR, 0, 0, 0); }
        }
        f32x16 IN_;
#pragma unroll
        for (int j = 0; j < 16; ++j) IN_[j] = 0.f;
#pragma unroll
        for (int mi = 0; mi < 2; ++mi) { const int mt = 2 * mh + mi;
            if (mt <= nt) {
                f32x16 A;
#pragma unroll
                for (int j = 0; j < 16; ++j) A[j] = 0.f;
#pragma unroll
                for (int s_ = 0; s_ < 8; ++s_) { const bf16x8 a = *(const LAS bf16x8*)(lds + OFF_K + 8192 * mt + (krow ^ (32 * s_))); A = __builtin_amdgcn_mfma_f32_32x32x16_bf16(a, qf[s_], A, 0, 0, 0); }
#pragma unroll
                for (int j = 0; j < 16; ++j) { const int dd = (32 * nt + r) - (32 * mt + (j & 3) + 8 * (j >> 2) + 4 * hi); A[j] = dd >= 0 ? A[j] * __builtin_amdgcn_exp2f((float)dd * lg) : 0.f; }
#pragma unroll
                for (int s2 = 0; s2 < 2; ++s2) { u32x4 w; w.x = cvt_pk_bf16(A[8 * s2 + 0], A[8 * s2 + 1]); w.y = cvt_pk_bf16(A[8 * s2 + 2], A[8 * s2 + 3]); w.z = cvt_pk_bf16(A[8 * s2 + 4], A[8 * s2 + 5]); w.w = cvt_pk_bf16(A[8 * s2 + 6], A[8 * s2 + 7]);
                    const LAS unsigned char* vp = lds + OFF_V + vtr + (32 * mt + 16 * s2) * 64; const u32x2 lo = lds_tr(vp), hi2 = lds_tr(vp + 8 * 64);
                    IN_ = __builtin_amdgcn_mfma_f32_32x32x16_bf16(__builtin_bit_cast(bf16x8, (u32x4){lo.x, lo.y, hi2.x, hi2.y}), __builtin_bit_cast(bf16x8, w), IN_, 0, 0, 0); }
            } }
        if (mh == 1) {
#pragma unroll
            for (int j = 0; j < 16; ++j) ((LAS float*)(lds + OFF_PART))[(nt * 16 + j) * 64 + lane] = IN_[j];
        }
        __syncthreads();
        if (mh == 0) {
            const float xi = __builtin_amdgcn_exp2f((float)(32 * nt + r + 1) * lg);
            bf16* orow = outbase + (size_t)(tok0 + 32 * nt + r) * 1024 + h * 256 + sl * 32;
#pragma unroll
            for (int q4_ = 0; q4_ < 4; ++q4_) { float o_[4];
#pragma unroll
                for (int e = 0; e < 4; ++e) { const int j = 4 * q4_ + e; o_[e] = IN_[j] + ((const LAS float*)(lds + OFF_PART))[(nt * 16 + j) * 64 + lane] + xi * CR[j]; }
                opk[q4_] = (u32x2){cvt_pk_bf16(o_[0], o_[1]), cvt_pk_bf16(o_[2], o_[3])}; }
            oprev = orow;
        } else {
#pragma unroll
            for (int j = 0; j < 16; ++j) ST[j] *= gC;
#pragma unroll
            for (int s_ = 0; s_ < 8; ++s_) {
                const LAS unsigned char* zp = lds + OFF_ZV + ztr + (16 * s_) * 64; const u32x2 z0 = lds_tr(zp), z1 = lds_tr(zp + 4 * 64);
                const u32x2 k0 = lds_tr(lds + OFF_K + ktr[0] + 4096 * s_), k1 = lds_tr(lds + OFF_K + ktr[1] + 4096 * s_);
                ST = __builtin_amdgcn_mfma_f32_32x32x16_bf16(__builtin_bit_cast(bf16x8, (u32x4){z0.x, z0.y, z1.x, z1.y}), __builtin_bit_cast(bf16x8, (u32x4){k0.x, k0.y, k1.x, k1.y}), ST, 0, 0, 0); }
#pragma unroll
            for (int j = 0; j < 16; ++j) { const int dv = (j & 3) + 8 * (j >> 2) + 4 * hi; ((LAS unsigned short*)(lds + OFF_ST))[dv * (ROWB / 2) + 32 * nt + r] = (unsigned short)f2bf(ST[j]); }
        }
    }
    if (mh == 0) {
#pragma unroll
        for (int i = 0; i < 4; ++i) *(u32x2*)(oprev + 8 * i + 4 * hi) = opk[i]; }
    __syncthreads();
}
__device__ __forceinline__ void transpose_kv_tiles(Frame& F, const bf16* src, bf16* dst, int w0, int nw) {
    LAS unsigned short* tl_ = (LAS unsigned short*)(F.lds + F.wave * 16384); const int lane = F.lane;
    for (int tile = w0; tile < 16 * 64 * 2; tile += nw) {
        const int dh = tile & 1, st = (tile >> 1) & 63, bg = tile >> 7;
        const bf16* sp = src + ((size_t)bg * SEQ + st * 64) * 128 + dh * 64; bf16* dp = dst + ((size_t)bg * 128 + dh * 64) * SEQ + st * 64;
#pragma unroll
        for (int i = 0; i < 8; ++i) { const int row = i * 8 + (lane >> 3), c = lane & 7; const u32x4 v = *(const u32x4*)(sp + (size_t)row * 128 + c * 8); LAS unsigned short* q = tl_ + row * 66 + c * 8;
            q[0] = (unsigned short)(v.x & 0xffffu); q[1] = (unsigned short)(v.x >> 16); q[2] = (unsigned short)(v.y & 0xffffu); q[3] = (unsigned short)(v.y >> 16);
            q[4] = (unsigned short)(v.z & 0xffffu); q[5] = (unsigned short)(v.z >> 16); q[6] = (unsigned short)(v.w & 0xffffu); q[7] = (unsigned short)(v.w >> 16); }
        LDS_WAIT(); asm volatile("" ::: "memory");
#pragma unroll
        for (int i = 0; i < 8; ++i) { const int d = i * 8 + (lane >> 3), c = lane & 7; const LAS unsigned short* q = tl_ + (c * 8) * 66 + d;
            u32x4 o; o.x = (unsigned)q[0] | ((unsigned)q[66] << 16); o.y = (unsigned)q[2 * 66] | ((unsigned)q[3 * 66] << 16); o.z = (unsigned)q[4 * 66] | ((unsigned)q[5 * 66] << 16); o.w = (unsigned)q[6 * 66] | ((unsigned)q[7 * 66] << 16);
            *(u32x4*)(dp + (size_t)d * SEQ + c * 8) = o; }
        LDS_WAIT(); asm volatile("" ::: "memory");
    }
}
struct SchedCmp {
    unsigned char* ws; int first, G, c;
    __device__ __forceinline__ bool next(int i, GU& u) const {
        const int L = i * G + c - first; if (L < 0 || L >= 256) return false;
        const int ks = L & 7, mb = L >> 3, m = mb >> 4, bg = mb & 15;
        u.A = (const char*)ws + WS_KV6 + (size_t)m * KV_STRIDE + (size_t)bg * SEQ * 128 * 2 + (size_t)ks * 512 * 2; u.B = (const char*)ws + (m ? W_C1V : W_C1K) + (size_t)ks * 512 * 2;
        u.pm = mb; u.pn = 0; u.kind = ks; u.rows = nullptr; u.nvalid = 0; u.aux = 0; return true;
    }
};
struct EpiCmp {
    static constexpr bool PERM = false;
    float* hid;
    __device__ __forceinline__ void operator()(const f32x4 (&acc)[2][2][4][2], const GU& u, int wr, int wc, int fr, int fq) const {
#pragma unroll
        for (int ai = 0; ai < 2; ++ai)
#pragma unroll
            for (int m = 0; m < 4; ++m) { const int r = 128 * ai + 64 * wr + 16 * m + fr; float* rowp = hid + (size_t)u.kind * (32 * 256 * 128) + ((size_t)u.pm * 256 + r) * 128 + 32 * wc + 4 * fq;
#pragma unroll
                for (int n = 0; n < 2; ++n) *(f32x4*)(rowp + 16 * n) = acc[ai][0][m][n]; }
    }
};
__device__ __forceinline__ float gelu_tanh(float x) { const float u = 0.7978845608028654f * (x + 0.044715f * x * x * x); return 0.5f * x * (1.0f + tanhf(u)); }
__device__ __forceinline__ void p2b_compress_out(Frame& F, const Args& a) {
    const float* hid = (const float*)a.out + (size_t)16 * MiB; const float* cbias = (const float*)(F.ws + WS_SMALLW + 65536 + 2 * 128 * 128 * 2);
    const int gw = F.bx * NWAVES + F.wave, NGW = F.G * NWAVES;
    for (int row = gw; row < 2 * 16 * 256; row += NGW) {
        const int m = row >> 12, n = row & 255; const float* w2 = a.in[m ? IN_CMP_W2_V : IN_CMP_W2_K];
        bf16* dst = (bf16*)(F.ws + (m ? WS_VCMP : WS_KCMP)) + (size_t)(row & 4095) * 128;
        float o0 = 0.f, o1 = 0.f;
        if (n < 255) { const float* hr = hid + (size_t)row * 128;
            for (int e = 0; e < 128; ++e) { float hsum = 0.f;
#pragma unroll
                for (int ks = 0; ks < 8; ++ks) hsum += hr[(size_t)ks * (32 * 256 * 128) + e];
                const float g = gelu_tanh(hsum + cbias[m * 128 + e]); o0 += g * w2[e * 128 + F.lane]; o1 += g * w2[e * 128 + 64 + F.lane]; } }
        dst[F.lane] = (bf16)f2bf(o0); dst[64 + F.lane] = (bf16)f2bf(o1);
        if (m == 1) { bf16* dt = (bf16*)(F.ws + WS_VCMPT) + (size_t)((row >> 8) & 15) * 128 * 256 + n; dt[(size_t)F.lane * 256] = (bf16)f2bf(o0); dt[(size_t)(64 + F.lane) * 256] = (bf16)f2bf(o1); }
    }
}

__device__ __forceinline__ void p3_ret_normalize(Frame& F) {
    bf16* rv = (bf16*)(F.ws + WS_RV); const bf16* rg = (const bf16*)(F.ws + WS_RG);
    const int gw = F.bx * NWAVES + F.wave, NGW = F.G * NWAVES;
    for (int it = gw; it < NTOK * 4; it += NGW) {
        u32x2* p = (u32x2*)(rv + (size_t)it * 256) + F.lane; const u32x2 w = *p; const u32x2 gq = *((const u32x2*)(rg + (size_t)it * 256) + F.lane);
        const float o0 = lo16(w.x), o1 = hi16(w.x), o2 = lo16(w.y), o3 = hi16(w.y);
        const float ss = wave_sum((o0 * o0 + o1 * o1) + (o2 * o2 + o3 * o3));
        const float r = 1.0f / sqrtf(ss * (1.0f / 256.0f) + EPS);
        u32x2 q; q.x = pk2(o0 * r * lo16(gq.x), o1 * r * hi16(gq.x)); q.y = pk2(o2 * r * lo16(gq.y), o3 * r * hi16(gq.y)); *p = q;
    }
}
namespace nsaf {
constexpr int KROW = 272, VROW = 136, KT_BYTES = 64 * KROW, VT_BYTES = 128 * VROW;
constexpr int OFF_K = 0, OFF_V = KT_BYTES, BUF_BYTES = KT_BYTES + VT_BYTES, OFF_IMP = 2 * BUF_BYTES, OFF_MASK = OFF_IMP + 64 * 64 * 4;
constexpr float NEG = -1.0e30f, MASKED = -3.0e38f, CS = 0.08838834764831845f * 1.4426950408889634f;
struct Stage { u32x4 k0, k1, v0, v1; };
__device__ __forceinline__ void stage_load(Stage& st, const bf16* K, const bf16* VT, size_t vpitch, int key0, int tid) {
    const int r0 = tid >> 4, c0 = tid & 15;
    st.k0 = *(const u32x4*)(K + (size_t)(key0 + r0) * 128 + c0 * 8); st.k1 = *(const u32x4*)(K + (size_t)(key0 + r0 + 32) * 128 + c0 * 8);
    const int d0 = tid >> 3, c1 = tid & 7;
    st.v0 = *(const u32x4*)(VT + (size_t)d0 * vpitch + key0 + c1 * 8); st.v1 = *(const u32x4*)(VT + (size_t)(d0 + 64) * vpitch + key0 + c1 * 8);
}
__device__ __forceinline__ void stage_write(const Stage& st, LAS unsigned char* lds, int tid) {
    const int r0 = tid >> 4, c0 = tid & 15;
    *(LAS u32x4*)(lds + OFF_K + r0 * KROW + c0 * 16) = st.k0; *(LAS u32x4*)(lds + OFF_K + (r0 + 32) * KROW + c0 * 16) = st.k1;
    const int d0 = tid >> 3, c1 = tid & 7;
    LAS unsigned char* p0 = lds + OFF_V + d0 * VROW + c1 * 16; LAS unsigned char* p1 = lds + OFF_V + (d0 + 64) * VROW + c1 * 16;
    *(LAS u32x2*)p0 = (u32x2){st.v0.x, st.v0.y}; *(LAS u32x2*)(p0 + 8) = (u32x2){st.v0.z, st.v0.w};
    *(LAS u32x2*)p1 = (u32x2){st.v1.x, st.v1.y}; *(LAS u32x2*)(p1 + 8) = (u32x2){st.v1.z, st.v1.w};
}
template <int MODE>
__device__ __forceinline__ void block_step(const LAS unsigned char* lds, LAS unsigned char* ldstab, const bf16x8 (&qf)[8], f32x16 (&O)[4], float& m, float& l, int blk, int jfast, int tl_in, int itile, int nvr_in, bool rowsel, float inv_l, int lane_in) {
    int tl = tl_in, nvr = nvr_in, lane = lane_in; LAUNDER(tl); LAUNDER(nvr); LAUNDER(lane);
    const int r = lane & 31, hi = lane >> 5;
    f32x16 S[2];
#pragma unroll
    for (int kh = 0; kh < 2; ++kh) {
#pragma unroll
        for (int j = 0; j < 16; ++j) S[kh][j] = 0.f;
    }
    {
        const unsigned kaddr = (unsigned)(size_t)(lds + OFF_K + r * KROW + 16 * hi);
        u32x4 ka[4], kb[4];
#define NSAF_KRD(dst, t, s4) asm volatile("ds_read_b128 %0, %1 offset:%2" : "=v"(dst) : "v"(kaddr), "i"((t) * 32 * KROW + (s4) * 32))
#define NSAF_KRD4(set, t, s0) do { NSAF_KRD(set[0], t, (s0)); NSAF_KRD(set[1], t, (s0) + 1); NSAF_KRD(set[2], t, (s0) + 2); NSAF_KRD(set[3], t, (s0) + 3); } while (0)
#define NSAF_KWAIT(n, set) asm volatile("s_waitcnt lgkmcnt(" #n ")" : "+v"(set[0]), "+v"(set[1]), "+v"(set[2]), "+v"(set[3]))
#define NSAF_KMMA(set, t, s0) do { _Pragma("unroll") for (int q_ = 0; q_ < 4; ++q_) S[t] = __builtin_amdgcn_mfma_f32_32x32x16_bf16(__builtin_bit_cast(bf16x8, set[q_]), qf[(s0) + q_], S[t], 0, 0, 0); } while (0)
        NSAF_KRD4(ka, 0, 0); NSAF_KRD4(kb, 0, 4);
        NSAF_KWAIT(4, ka); NSAF_KMMA(ka, 0, 0); NSAF_KRD4(ka, 1, 0);
        NSAF_KWAIT(4, kb); NSAF_KMMA(kb, 0, 4); NSAF_KRD4(kb, 1, 4);
        NSAF_KWAIT(4, ka); NSAF_KMMA(ka, 1, 0);
        NSAF_KWAIT(0, kb); NSAF_KMMA(kb, 1, 4);
#undef NSAF_KRD
#undef NSAF_KRD4
#undef NSAF_KWAIT
#undef NSAF_KMMA
    }
    bool need_mask;
    if (MODE <= 1) need_mask = true; else if (MODE == 2) need_mask = (blk == itile); else need_mask = (blk == itile) || (blk == itile - 8);
    if (MODE >= 2 && !need_mask && blk >= jfast) {
        const float msub = (MODE == 2 && !rowsel) ? 3.0e38f : m;
        float rs = 0.f;
#pragma unroll
        for (int kh = 0; kh < 2; ++kh)
#pragma unroll
            for (int j = 0; j < 16; ++j) { const float p = __builtin_amdgcn_exp2f(S[kh][j] - msub); S[kh][j] = p; rs += p; }
        l += rs;
    } else {
    float mx = MASKED;
    if (need_mask) {
        int lo_ = -1, hi_ = 63;
        if (MODE <= 1) hi_ = nvr - 64 * blk - 1; else if (MODE == 2) hi_ = tl; else { hi_ = (blk == itile) ? tl : 63; lo_ = (blk == itile - 8) ? tl : -1; }
        lo_ -= 4 * hi; hi_ -= 4 * hi;
#pragma unroll
        for (int kh = 0; kh < 2; ++kh)
#pragma unroll
            for (int j = 0; j < 16; ++j) { const int kc_ = 32 * kh + (j & 3) + 8 * (j >> 2); const bool ok = (kc_ > lo_) & (kc_ <= hi_); const float v = ok ? S[kh][j] : MASKED; S[kh][j] = v; mx = fmaxf(mx, v); }
    } else {
#pragma unroll
        for (int kh = 0; kh < 2; ++kh)
#pragma unroll
            for (int j = 0; j < 16; ++j) mx = fmaxf(mx, S[kh][j]);
    }
    if (MODE == 2) mx = rowsel ? mx : MASKED;
    if (MODE == 1) {
        LAS float* imp = (LAS float*)(ldstab + OFF_IMP) + tl * 64;
#pragma unroll
        for (int kh = 0; kh < 2; ++kh)
#pragma unroll
            for (int j = 0; j < 16; ++j) { const int n = 64 * blk + 32 * kh + (j & 3) + 8 * (j >> 2) + 4 * hi; const float v = S[kh][j]; const float p = __builtin_amdgcn_exp2f(v - m) * inv_l; S[kh][j] = p;
                if (v > 0.5f * MASKED) { __hip_atomic_fetch_add(imp + (n >> 2), p, __ATOMIC_RELAXED, __HIP_MEMORY_SCOPE_WORKGROUP); if ((n & 3) == 3 && (n >> 2) + 1 < 64) __hip_atomic_fetch_add(imp + (n >> 2) + 1, p, __ATOMIC_RELAXED, __HIP_MEMORY_SCOPE_WORKGROUP); } }
    } else {
        mx = fmaxf(mx, __shfl_xor(mx, 32));
        if (__any(mx > m + 8.0f)) { const float mn = fmaxf(m, mx); const float alpha = __builtin_amdgcn_exp2f(m - mn); m = mn; l *= alpha;
            if (MODE != 0) {
#pragma unroll
                for (int dt = 0; dt < 4; ++dt)
#pragma unroll
                    for (int j = 0; j < 16; ++j) O[dt][j] *= alpha; } }
        float rs = 0.f;
        if (MODE == 2) {
#pragma unroll
            for (int kh = 0; kh < 2; ++kh)
#pragma unroll
                for (int j = 0; j < 16; ++j) { const float p = rowsel ? __builtin_amdgcn_exp2f(S[kh][j] - m) : 0.f; S[kh][j] = p; rs += p; }
        } else {
#pragma unroll
            for (int kh = 0; kh < 2; ++kh)
#pragma unroll
                for (int j = 0; j < 16; ++j) { const float p = __builtin_amdgcn_exp2f(S[kh][j] - m); S[kh][j] = p; rs += p; }
        }
        l += rs;
        if (MODE == 0) return;
    }
    }
    bf16x8 pf[2][2];
#pragma unroll
    for (int kh = 0; kh < 2; ++kh)
#pragma unroll
        for (int s2 = 0; s2 < 2; ++s2) { u32x4 w; w.x = cvt_pk_bf16(S[kh][8 * s2 + 0], S[kh][8 * s2 + 1]); w.y = cvt_pk_bf16(S[kh][8 * s2 + 2], S[kh][8 * s2 + 3]); w.z = cvt_pk_bf16(S[kh][8 * s2 + 4], S[kh][8 * s2 + 5]); w.w = cvt_pk_bf16(S[kh][8 * s2 + 6], S[kh][8 * s2 + 7]);
            pf[kh][s2] = __builtin_bit_cast(bf16x8, w); }
    {
        const unsigned vaddr = (unsigned)(size_t)(lds + OFF_V + r * VROW + 8 * hi);
        u32x2 va[8], vb[8];
#define NSAF_VRD(dst, dt, i) asm volatile("ds_read_b64 %0, %1 offset:%2" : "=v"(dst) : "v"(vaddr), "i"((dt) * 32 * VROW + ((i) >> 1) * 32 + ((i) & 1) * 16))
#define NSAF_VRD8(set, dt) do { NSAF_VRD(set[0], dt, 0); NSAF_VRD(set[1], dt, 1); NSAF_VRD(set[2], dt, 2); NSAF_VRD(set[3], dt, 3); NSAF_VRD(set[4], dt, 4); NSAF_VRD(set[5], dt, 5); NSAF_VRD(set[6], dt, 6); NSAF_VRD(set[7], dt, 7); } while (0)
#define NSAF_VWAIT(n, set) asm volatile("s_waitcnt lgkmcnt(" #n ")" : "+v"(set[0]), "+v"(set[1]), "+v"(set[2]), "+v"(set[3]), "+v"(set[4]), "+v"(set[5]), "+v"(set[6]), "+v"(set[7]))
#define NSAF_VMMA(set, dt) do { _Pragma("unroll") for (int ks = 0; ks < 4; ++ks) { const u32x4 a_ = (u32x4){set[2 * ks].x, set[2 * ks].y, set[2 * ks + 1].x, set[2 * ks + 1].y}; \
            O[dt] = __builtin_amdgcn_mfma_f32_32x32x16_bf16(__builtin_bit_cast(bf16x8, a_), pf[ks >> 1][ks & 1], O[dt], 0, 0, 0); } } while (0)
        NSAF_VRD8(va, 0); NSAF_VRD8(vb, 1);
        NSAF_VWAIT(8, va); NSAF_VMMA(va, 0); NSAF_VRD8(va, 2);
        NSAF_VWAIT(8, vb); NSAF_VMMA(vb, 1); NSAF_VRD8(vb, 3);
        NSAF_VWAIT(8, va); NSAF_VMMA(va, 2);
        NSAF_VWAIT(0, vb); NSAF_VMMA(vb, 3);
#undef NSAF_VRD
#undef NSAF_VRD8
#undef NSAF_VWAIT
#undef NSAF_VMMA
    }
}
template <int MODE>
__device__ __forceinline__ void run_pass(LAS unsigned char* lds, const bf16* K, const bf16* VT, size_t vpitch, int jb, int je, const bf16x8 (&qf)[8], f32x16 (&O)[4], float& m, float& l, bool allowfast, int tl, int itile, int nvr, unsigned long long selmask, float inv_l, int tid, int lane) {
    Stage st; stage_load(st, K, VT, vpitch, jb * 64, tid); stage_write(st, lds, tid);
    if (jb < je) stage_load(st, K, VT, vpitch, (jb + 1) * 64, tid);
    __syncthreads();
    for (int j = jb; j <= je; ++j) {
        const int cur = (j - jb) & 1;
        if (j < je) { stage_write(st, lds + (cur ^ 1) * BUF_BYTES, tid); if (j + 1 < je) stage_load(st, K, VT, vpitch, (j + 2) * 64, tid); }
        const bool rowsel = (MODE == 2) ? (((selmask >> j) & 1ull) != 0ull) : true;
        if (MODE != 2 || __ballot(rowsel) != 0ull) block_step<MODE>(lds + cur * BUF_BYTES, lds, qf, O, m, l, j, allowfast ? jb + (MODE == 2 ? 1 : 2) : 0x7fffffff, tl, itile, nvr, rowsel, inv_l, lane);
        __syncthreads();
    }
}
}
__device__ __forceinline__ void p3_nsa_fast(Frame& F, const bf16* svT, const bf16* wvT, bf16* outbase) {
    using namespace nsaf;
    unsigned char* ws = F.ws; const int tid = F.tid, lane = F.lane, wave = F.wave; LAS unsigned char* lds = F.lds;
    bf16* nq = (bf16*)(ws + WS_NQ); const float* gates = (const float*)(ws + WS_GATES);
    const int r = lane & 31, hi = lane >> 5, qrow = wave * 32 + r, tl = qrow >> 2, head = qrow & 3;
    unsigned failmask = 0u;
    for (int trip = 0; trip < 2; ++trip) {
    for (int u4 = 0; u4 < 4; ++u4) {
        if (trip == 1 && ((failmask >> u4) & 1u) == 0u) continue;
        const bool allowfast = trip == 0;
        const int pr = (F.bx & 7) * 32 + (F.bx >> 3) + (u4 >> 1) * 256; if (F.bx >= 256) break;
        const int bg = pr >> 5, ii = pr & 31, itile = (u4 & 1) ? (63 - ii) : ii, g = bg & 1, b = bg >> 1;
        const int tok = b * SEQ + itile * 64 + tl, t = itile * 64 + tl;
        const bf16* kc = (const bf16*)(ws + WS_KCMP) + (size_t)bg * 256 * 128; const bf16* vcT = (const bf16*)(ws + WS_VCMPT) + (size_t)bg * 128 * 256;
        const bf16* ks = (const bf16*)(ws + WS_KV6 + 2 * KV_STRIDE) + (size_t)bg * SEQ * 128; const bf16* kw = (const bf16*)(ws + WS_KV6 + 4 * KV_STRIDE) + (size_t)bg * SEQ * 128;
        const bf16* vsT = svT + (size_t)bg * 128 * SEQ; const bf16* vwT = wvT + (size_t)bg * 128 * SEQ;
        __syncthreads();
        for (int i = tid; i < 64 * 64; i += NTHREADS) ((LAS float*)(lds + OFF_IMP))[i] = 0.f;
        bf16x8 qf[8];
        {
            LAS unsigned char* tb_ = lds + wave * 8704;
#pragma unroll
            for (int k_ = 0; k_ < 8; ++k_) { const int rr_ = 4 * k_ + (lane >> 4), ch_ = lane & 15, qr_ = wave * 32 + rr_;
                *(LAS u32x4*)(tb_ + rr_ * 272 + ch_ * 16) = *(const u32x4*)(nq + (size_t)(b * SEQ + itile * 64 + (qr_ >> 2)) * 1024 + g * 512 + (qr_ & 3) * 128 + ch_ * 8); }
            LDS_WAIT(); asm volatile("" ::: "memory");
#pragma unroll
            for (int s_ = 0; s_ < 8; ++s_) { const u32x4 w_ = *(const LAS u32x4*)(tb_ + r * 272 + (16 * s_ + 8 * hi) * 2);
                u32x4 o_; o_.x = cvt_pk_bf16(lo16(w_.x) * CS, hi16(w_.x) * CS); o_.y = cvt_pk_bf16(lo16(w_.y) * CS, hi16(w_.y) * CS); o_.z = cvt_pk_bf16(lo16(w_.z) * CS, hi16(w_.z) * CS); o_.w = cvt_pk_bf16(lo16(w_.w) * CS, hi16(w_.w) * CS);
                qf[s_] = __builtin_bit_cast(bf16x8, o_); }
            __syncthreads();
        }
        const float* gatep = gates + (size_t)tok * 24 + (g * 4 + head) * 3;
        const int nvr = (t >= 31) ? (((t - 31) >> 4) + 1 > 255 ? 255 : ((t - 31) >> 4) + 1) : 0;
        const int jec = ((4 * itile + 2) >> 6) > 3 ? 3 : ((4 * itile + 2) >> 6);
        f32x16 O[4];
#define NSAF_ZERO_O() do { _Pragma("unroll") for (int dt = 0; dt < 4; ++dt) _Pragma("unroll") for (int j = 0; j < 16; ++j) O[dt][j] = 0.f; } while (0)
#define NSAF_ADD2(a_, b_) cvt_pk_bf16(lo16(a_) + lo16(b_), hi16(a_) + hi16(b_))
#define NSAF_ACCUM(coef, FIRST) do { const float cf_ = (coef); LAS unsigned char* tb_ = lds + wave * 8704; \
        _Pragma("unroll") for (int dt = 0; dt < 4; ++dt) { _Pragma("unroll") for (int q4 = 0; q4 < 4; ++q4) \
            *(LAS u32x2*)(tb_ + r * 272 + (32 * dt + 8 * q4 + 4 * hi) * 2) = (u32x2){cvt_pk_bf16(cf_ * O[dt][4 * q4], cf_ * O[dt][4 * q4 + 1]), cvt_pk_bf16(cf_ * O[dt][4 * q4 + 2], cf_ * O[dt][4 * q4 + 3])}; } \
        LDS_WAIT(); asm volatile("" ::: "memory"); \
        _Pragma("unroll 2") for (int k_ = 0; k_ < 8; ++k_) { const int rr_ = 4 * k_ + (lane >> 4), ch_ = lane & 15, qr_ = wave * 32 + rr_; \
            const u32x4 nv_ = *(const LAS u32x4*)(tb_ + rr_ * 272 + ch_ * 16); \
            u32x4* gp_ = (u32x4*)(outbase + (size_t)(b * SEQ + itile * 64 + (qr_ >> 2)) * 1024 + g * 512 + (qr_ & 3) * 128 + ch_ * 8); \
            u32x4 w_ = nv_; if (!(FIRST)) { const u32x4 ov_ = *gp_; w_.x = NSAF_ADD2(nv_.x, ov_.x); w_.y = NSAF_ADD2(nv_.y, ov_.y); w_.z = NSAF_ADD2(nv_.z, ov_.z); w_.w = NSAF_ADD2(nv_.w, ov_.w); } \
            *gp_ = w_; } \
        asm volatile("" ::: "memory"); } while (0)
        float m = NEG, l = 0.f; NSAF_ZERO_O();
        run_pass<0>(lds, kc, vcT, 256, 0, jec, qf, O, m, l, false, tl, itile, nvr, 0ull, 0.f, tid, lane);
        l += __shfl_xor(l, 32); const float invl = l > 0.f ? 1.0f / l : 0.f;
        run_pass<1>(lds, kc, vcT, 256, 0, jec, qf, O, m, l, false, tl, itile, nvr, 0ull, invl, tid, lane);
        NSAF_ACCUM(gatep[0], true);
        __syncthreads();
        for (int tk = 0; tk < 8; ++tk) { const int tokl = wave * 8 + tk; float v = ((const LAS float*)(lds + OFF_IMP))[tokl * 64 + lane];
            const bool forced = (lane == 0) || (lane == itile) || (lane == itile - 1); v = (lane > itile) ? -1.0e4f : (forced ? 1.0e4f : v);
            int rank = 0;
#pragma unroll 16
            for (int i = 0; i < 64; ++i) { const float w = __builtin_bit_cast(float, __builtin_amdgcn_readlane(__builtin_bit_cast(int, v), i)); rank += (w > v || (w == v && i < lane)) ? 1 : 0; }
            const unsigned long long mk = __ballot(rank < 16);
            if (lane == 0) { ((LAS unsigned*)(lds + OFF_MASK))[tokl * 2] = (unsigned)mk; ((LAS unsigned*)(lds + OFF_MASK))[tokl * 2 + 1] = (unsigned)(mk >> 32); } }
        __syncthreads();
        const unsigned long long selmask = (unsigned long long)((const LAS unsigned*)(lds + OFF_MASK))[tl * 2] | ((unsigned long long)((const LAS unsigned*)(lds + OFF_MASK))[tl * 2 + 1] << 32);
        m = NEG; l = 0.f; NSAF_ZERO_O();
        run_pass<2>(lds, ks, vsT, SEQ, 0, itile, qf, O, m, l, allowfast, tl, itile, 0, selmask, 0.f, tid, lane);
        l += __shfl_xor(l, 32); bool bad = !(l < 1.0e12f);
        NSAF_ACCUM(l > 0.f ? gatep[1] / l : 0.f, false);
        __syncthreads();
        m = NEG; l = 0.f; NSAF_ZERO_O();
        run_pass<3>(lds, kw, vwT, SEQ, itile > 8 ? itile - 8 : 0, itile, qf, O, m, l, allowfast, tl, itile, 0, 0ull, 0.f, tid, lane);
        l += __shfl_xor(l, 32); bad = bad | !(l < 1.0e12f);
        NSAF_ACCUM(l > 0.f ? gatep[2] / l : 0.f, false);
        if (allowfast && __syncthreads_or(bad ? 1 : 0)) failmask |= 1u << u4;
#undef NSAF_ZERO_O
#undef NSAF_ACCUM
#undef NSAF_ADD2
    }
    if (failmask == 0u) break;
    }
    __syncthreads();
}
struct SchedP4 {
    unsigned char* ws; int G, c; const char* nsa;
    __device__ __forceinline__ bool next(int i, GU& u) const {
        const int ti = i >> 2, sub = i & 3; const int L = ti * G + c; if (L >= 128 * 4) return false;
        int pm, pn; pg8::tile_map(L, 128, 4, pm, pn);
        const size_t ao = sub == 1 ? WS_RV : sub == 3 ? WS_NQ : WS_H; const size_t bo = sub == 0 ? W_GA : sub == 1 ? W_RO : sub == 2 ? W_GB : W_NO;
        u.A = (sub == 3 ? nsa : (const char*)ws + ao) + (size_t)pm * 256 * D * 2; u.B = (const char*)ws + bo + (size_t)pn * 256 * D * 2; u.pm = pm; u.pn = pn; u.kind = sub; u.rows = nullptr; u.nvalid = 0; u.aux = 0; return true;
    }
};
struct EpiP4 {
    static constexpr bool PERM = true;
    float* scr;
    bf16* Y;
    static __device__ __forceinline__ u32x2 pk4(const f32x4 v) { return (u32x2){cvt_pk_bf16(v[0], v[1]), cvt_pk_bf16(v[2], v[3])}; }
    static __device__ __forceinline__ f32x4 up4(const u32x2 w) { return (f32x4){lo16(w.x), hi16(w.x), lo16(w.y), hi16(w.y)}; }
    __device__ __forceinline__ void operator()(const f32x4 (&acc)[2][2][4][2], const GU& u, int wr, int wc, int fr, int fq) const {
        u32x2* p0 = (u32x2*)scr + threadIdx.x; u32x2* p1 = p0 + 32 * 512;
        if (u.kind == 0 || u.kind == 2) {
            u32x2* p = u.kind == 0 ? p0 : p1;
#pragma unroll
            for (int ai = 0; ai < 2; ++ai)
#pragma unroll
                for (int m = 0; m < 4; ++m) {
#pragma unroll
                    for (int bj = 0; bj < 2; ++bj) { f32x4 v0 = acc[ai][bj][m][0], v1 = acc[ai][bj][m][1];
#pragma unroll
                        for (int j = 0; j < 4; ++j) { v0[j] = sigmoidf_(v0[j]); v1[j] = sigmoidf_(v1[j]); }
                        p[(2 * bj) * 512] = pk4(v0); p[(2 * bj + 1) * 512] = pk4(v1); }
                    p += 4 * 512; LAUNDER(p); }
        } else if (u.kind == 1) {
#pragma unroll
            for (int ai = 0; ai < 2; ++ai)
#pragma unroll
                for (int m = 0; m < 4; ++m) {
#pragma unroll
                    for (int bj = 0; bj < 2; ++bj) { p0[(2 * bj) * 512] = pk4(up4(p0[(2 * bj) * 512]) * acc[ai][bj][m][0]); p0[(2 * bj + 1) * 512] = pk4(up4(p0[(2 * bj + 1) * 512]) * acc[ai][bj][m][1]); }
                    p0 += 4 * 512; LAUNDER(p0); }
        } else {
            bf16* yb = Y + (size_t)(u.pm * 256 + 64 * wr + fr) * D + u.pn * 256 + 32 * wc + 8 * fq;
#pragma unroll
            for (int ai = 0; ai < 2; ++ai)
#pragma unroll
                for (int m = 0; m < 4; ++m) {
#pragma unroll
                    for (int bj = 0; bj < 2; ++bj) {
                        const f32x4 v0 = up4(p0[(2 * bj) * 512]) + up4(p1[(2 * bj) * 512]) * acc[ai][bj][m][0], v1 = up4(p0[(2 * bj + 1) * 512]) + up4(p1[(2 * bj + 1) * 512]) * acc[ai][bj][m][1];
                        u32x4 w; w.x = cvt_pk_bf16(v0[0], v0[1]); w.y = cvt_pk_bf16(v0[2], v0[3]); w.z = cvt_pk_bf16(v1[0], v1[1]); w.w = cvt_pk_bf16(v1[2], v1[3]);
                        *(u32x4*)(yb + (size_t)(128 * ai + 16 * m) * D + 128 * bj) = w; }
                    p0 += 4 * 512; p1 += 4 * 512; LAUNDER(p0); LAUNDER(p1); }
        }
    }
};

struct SchedMN {
    unsigned char* ws; size_t ao, bo; int G, c;
    __device__ __forceinline__ bool next(int i, GU& u) const {
        const int L = i * G + c; if (L >= 128 * 4) return false; int pm, pn; pg8::tile_map(L, 128, 4, pm, pn);
        u.A = (const char*)ws + ao + (size_t)pm * 256 * D * 2; u.B = (const char*)ws + bo + (size_t)pn * 256 * D * 2; u.pm = pm; u.pn = pn; u.kind = 0; u.rows = nullptr; u.nvalid = 0; u.aux = 0; return true;
    }
};
template <bool SSQ> struct EpiRes {
    static constexpr bool PERM = false;
    const float* basef; const bf16* baseb; float* out; bf16* ob; float* ssq;
    __device__ __forceinline__ void operator()(const f32x4 (&acc)[2][2][4][2], const GU& u, int wr, int wc, int fr, int fq) const {
#pragma unroll
        for (int ai = 0; ai < 2; ++ai)
#pragma unroll
            for (int m = 0; m < 4; ++m) { const int r = u.pm * 256 + 128 * ai + 64 * wr + 16 * m + fr; const size_t off = (size_t)r * D + u.pn * 256 + 32 * wc + 4 * fq; float sq = 0.f;
#pragma unroll
                for (int bj = 0; bj < 2; ++bj)
#pragma unroll
                    for (int n = 0; n < 2; ++n) { const size_t o = off + 128 * bj + 16 * n; f32x4 bv;
                        if (SSQ) bv = *(const f32x4*)(basef + o); else { const u32x2 bw = *(const u32x2*)(baseb + o); bv = (f32x4){lo16(bw.x), hi16(bw.x), lo16(bw.y), hi16(bw.y)}; }
                        const f32x4 v = bv + acc[ai][bj][m][n];
                        if (!SSQ) *(f32x4*)(out + o) = v;
                        u32x2 w; w.x = cvt_pk_bf16(v[0], v[1]); w.y = cvt_pk_bf16(v[2], v[3]); *(u32x2*)(ob + o) = w; sq += (v[0] * v[0] + v[1] * v[1]) + (v[2] * v[2] + v[3] * v[3]); }
                if (SSQ) { sq += __shfl_xor(sq, 16); sq += __shfl_xor(sq, 32); if (fq == 0) ssq[(size_t)r * 16 + u.pn * 4 + wc] = sq; }
            }
    }
};
struct EpiQ {
    static constexpr bool PERM = true;
    const float* ssq; bf16* Q;
    __device__ __forceinline__ void operator()(const f32x4 (&acc)[2][2][4][2], const GU& u, int wr, int wc, int fr, int fq) const {
#pragma unroll
        for (int ai = 0; ai < 2; ++ai)
#pragma unroll
            for (int m = 0; m < 4; ++m) { const int r = u.pm * 256 + 128 * ai + 64 * wr + 16 * m + fr; const f32x4* sp = (const f32x4*)(ssq + (size_t)r * 16);
                const f32x4 a = sp[0], b = sp[1], c = sp[2], d = sp[3]; const float tot = ((a[0] + a[1]) + (a[2] + a[3])) + ((b[0] + b[1]) + (b[2] + b[3])) + ((c[0] + c[1]) + (c[2] + c[3])) + ((d[0] + d[1]) + (d[2] + d[3]));
                const float rstd = 1.0f / sqrtf(tot * (1.0f / D) + EPS);
#pragma unroll
                for (int bj = 0; bj < 2; ++bj) { const f32x4 v0 = acc[ai][bj][m][0] * rstd, v1 = acc[ai][bj][m][1] * rstd;
                    u32x4 w; w.x = cvt_pk_bf16(v0[0], v0[1]); w.y = cvt_pk_bf16(v0[2], v0[3]); w.z = cvt_pk_bf16(v1[0], v1[1]); w.w = cvt_pk_bf16(v1[2], v1[3]);
                    *(u32x4*)(Q + (size_t)r * D + u.pn * 256 + 128 * bj + 32 * wc + 8 * fq) = w; } }
    }
};

namespace xatf {
constexpr int KROW = 528, VROW = 136, KT_BYTES = 64 * KROW, OFF_K = 0, OFF_V = KT_BYTES;
constexpr float NEG = -1.0e30f, CS = 0.0625f * 1.4426950408889634f;
struct Stage { u32x4 k[4]; u32x4 v[2]; };
__device__ __forceinline__ void stage_load(Stage& st, const bf16* K, const bf16* VT, int key0, int tid) {
#pragma unroll
    for (int i = 0; i < 4; ++i) { const int p = tid + 512 * i, row = p >> 5, c = p & 31; st.k[i] = *(const u32x4*)(K + (size_t)(key0 + row) * 2048 + c * 8); }
#pragma unroll
    for (int i = 0; i < 2; ++i) { const int p = tid + 512 * i, d = p >> 3, c = p & 7; st.v[i] = *(const u32x4*)(VT + (size_t)d * 256 + key0 + c * 8); }
}
__device__ __forceinline__ void stage_write(const Stage& st, LAS unsigned char* lds, int tid) {
#pragma unroll
    for (int i = 0; i < 4; ++i) { const int p = tid + 512 * i, row = p >> 5, c = p & 31; *(LAS u32x4*)(lds + OFF_K + row * KROW + c * 16) = st.k[i]; }
#pragma unroll
    for (int i = 0; i < 2; ++i) { const int p = tid + 512 * i, d = p >> 3, c = p & 7; LAS unsigned char* q = lds + OFF_V + d * VROW + c * 16;
        *(LAS u32x2*)q = (u32x2){st.v[i].x, st.v[i].y}; *(LAS u32x2*)(q + 8) = (u32x2){st.v[i].z, st.v[i].w}; }
}
__device__ __forceinline__ void block_step(const LAS unsigned char* lds, const bf16x8 (&qf)[16], f32x16 (&O)[4], float& m, float& l, int lane) {
    const int r = lane & 31, hi = lane >> 5;
    f32x16 S[2];
#pragma unroll
    for (int kh = 0; kh < 2; ++kh) {
#pragma unroll
        for (int j = 0; j < 16; ++j) S[kh][j] = 0.f;
#pragma unroll
        for (int s_ = 0; s_ < 16; ++s_) { const bf16x8 a = *(const LAS bf16x8*)(lds + OFF_K + (kh * 32 + r) * KROW + (16 * s_ + 8 * hi) * 2); S[kh] = __builtin_amdgcn_mfma_f32_32x32x16_bf16(a, qf[s_], S[kh], 0, 0, 0); }
    }
    float mx = NEG;
#pragma unroll
    for (int kh = 0; kh < 2; ++kh)
#pragma unroll
        for (int j = 0; j < 16; ++j) { const float v = S[kh][j] * CS; S[kh][j] = v; mx = fmaxf(mx, v); }
    mx = fmaxf(mx, __shfl_xor(mx, 32));
    const float mn = fmaxf(m, mx); const float alpha = __builtin_amdgcn_exp2f(m - mn); m = mn; float rs = 0.f;
#pragma unroll
    for (int kh = 0; kh < 2; ++kh)
#pragma unroll
        for (int j = 0; j < 16; ++j) { const float p = __builtin_amdgcn_exp2f(S[kh][j] - mn); S[kh][j] = p; rs += p; }
    l = l * alpha + rs;
#pragma unroll
    for (int dt = 0; dt < 4; ++dt)
#pragma unroll
        for (int j = 0; j < 16; ++j) O[dt][j] *= alpha;
    bf16x8 pf[2][2];
#pragma unroll
    for (int kh = 0; kh < 2; ++kh)
#pragma unroll
        for (int s2 = 0; s2 < 2; ++s2) { u32x4 w; w.x = cvt_pk_bf16(S[kh][8 * s2 + 0], S[kh][8 * s2 + 1]); w.y = cvt_pk_bf16(S[kh][8 * s2 + 2], S[kh][8 * s2 + 3]); w.z = cvt_pk_bf16(S[kh][8 * s2 + 4], S[kh][8 * s2 + 5]); w.w = cvt_pk_bf16(S[kh][8 * s2 + 6], S[kh][8 * s2 + 7]);
            pf[kh][s2] = __builtin_bit_cast(bf16x8, w); }
#pragma unroll
    for (int dt = 0; dt < 4; ++dt)
#pragma unroll
        for (int kh = 0; kh < 2; ++kh)
#pragma unroll
            for (int s2 = 0; s2 < 2; ++s2) { const LAS unsigned char* vp = lds + OFF_V + (dt * 32 + r) * VROW + (32 * kh + 16 * s2 + 4 * hi) * 2;
                const u32x2 lo = *(const LAS u32x2*)vp, hi2 = *(const LAS u32x2*)(vp + 16); const u32x4 av = (u32x4){lo.x, lo.y, hi2.x, hi2.y};
                O[dt] = __builtin_amdgcn_mfma_f32_32x32x16_bf16(__builtin_bit_cast(bf16x8, av), pf[kh][s2], O[dt], 0, 0, 0); }
}
}
__device__ __forceinline__ void p7_xattn_fast(Frame& F, const bf16* vT, bf16* outbase) {
    using namespace xatf;
    bf16* Q = (bf16*)(F.ws + WS_NQ); const bf16* KV = (const bf16*)(F.ws + WS_MEMKV);
    const int tid = F.tid, lane = F.lane, wave = F.wave, r = lane & 31, hi = lane >> 5; LAS unsigned char* lds = F.lds;
    for (int u = F.bx; u < BATCH * 4 * 16; u += F.G) {
        const int tt = u & 15, bh = u >> 4, b = bh >> 2, h = bh & 3; const int tok = b * SEQ + tt * 256 + wave * 32 + r;
        bf16* qrow = Q + (size_t)tok * D + h * 256; bf16* orow = outbase + (size_t)tok * D + h * 256; const bf16* Kb = KV + (size_t)(b * NMEM) * 2048 + h * 256;
        bf16x8 qf[16];
        LAS unsigned char* tb_ = lds + 61440 + wave * 8704;
        bf16* rows0 = Q + (size_t)(b * SEQ + tt * 256 + wave * 32) * D + h * 256;
#pragma unroll
        for (int hq = 0; hq < 2; ++hq) {
#pragma unroll 4
            for (int k_ = 0; k_ < 8; ++k_) { const int rr_ = 4 * k_ + (lane >> 4), ch_ = lane & 15; *(LAS u32x4*)(tb_ + rr_ * 272 + ch_ * 16) = *(const u32x4*)(rows0 + (size_t)rr_ * D + hq * 128 + ch_ * 8); }
            LDS_WAIT(); asm volatile("" ::: "memory");
#pragma unroll
            for (int s_ = 0; s_ < 8; ++s_) qf[8 * hq + s_] = *(const LAS bf16x8*)(tb_ + r * 272 + (16 * s_ + 8 * hi) * 2);
            LDS_WAIT(); asm volatile("" ::: "memory");
        }
        const bf16* VT0 = vT + (size_t)bh * 256 * 256;
        Stage st; stage_load(st, Kb, VT0, 0, tid);
        f32x16 O[4]; float m = NEG, l = 0.f;
        for (int idx = 0; idx < 8; ++idx) {
            const int half = idx >> 2, j = idx & 3;
            if (j == 0) { m = NEG; l = 0.f;
#pragma unroll
                for (int dt = 0; dt < 4; ++dt)
#pragma unroll
                    for (int jj = 0; jj < 16; ++jj) O[dt][jj] = 0.f; }
            __syncthreads(); stage_write(st, lds, tid);
            { const int i2 = idx < 7 ? idx + 1 : idx; stage_load(st, Kb, VT0 + (size_t)((i2 >> 2) * 128) * 256, (i2 & 3) * 64, tid); }
            __syncthreads();
            block_step(lds, qf, O, m, l, lane);
            if (j == 3) {
                l += __shfl_xor(l, 32); const float inv = 1.0f / l;
#pragma unroll
                for (int dt = 0; dt < 4; ++dt)
#pragma unroll
                    for (int q4 = 0; q4 < 4; ++q4) *(LAS u32x2*)(tb_ + r * 272 + (32 * dt + 8 * q4 + 4 * hi) * 2) = (u32x2){cvt_pk_bf16(O[dt][4 * q4] * inv, O[dt][4 * q4 + 1] * inv), cvt_pk_bf16(O[dt][4 * q4 + 2] * inv, O[dt][4 * q4 + 3] * inv)};
                LDS_WAIT(); asm volatile("" ::: "memory");
#pragma unroll 2
                for (int k_ = 0; k_ < 8; ++k_) { const int rr_ = 4 * k_ + (lane >> 4), ch_ = lane & 15; *(u32x4*)(rows0 + (size_t)rr_ * D + half * 128 + ch_ * 8) = *(const LAS u32x4*)(tb_ + rr_ * 272 + ch_ * 16); }
                LDS_WAIT(); asm volatile("" ::: "memory");
            }
        }
    }
    __syncthreads();
}
__device__ __forceinline__ void transpose_memv_tiles(Frame& F, bf16* vT, int w0, int nw) {
    LAS unsigned short* tl_ = (LAS unsigned short*)(F.lds + F.wave * 16384); const int lane = F.lane; const bf16* KV = (const bf16*)(F.ws + WS_MEMKV);
    for (int tile = w0; tile < 32 * 16; tile += nw) {
        const int dq = tile & 3, kq = (tile >> 2) & 3, bh = tile >> 4, b = bh >> 2, h = bh & 3;
        const bf16* sp = KV + (size_t)(b * NMEM + kq * 64) * 2048 + 1024 + h * 256 + dq * 64; bf16* dp = vT + ((size_t)bh * 256 + dq * 64) * 256 + kq * 64;
#pragma unroll
        for (int i = 0; i < 8; ++i) { const int row = i * 8 + (lane >> 3), c = lane & 7; const u32x4 v = *(const u32x4*)(sp + (size_t)row * 2048 + c * 8); LAS unsigned short* q = tl_ + row * 66 + c * 8;
            q[0] = (unsigned short)(v.x & 0xffffu); q[1] = (unsigned short)(v.x >> 16); q[2] = (unsigned short)(v.y & 0xffffu); q[3] = (unsigned short)(v.y >> 16);
            q[4] = (unsigned short)(v.z & 0xffffu); q[5] = (unsigned short)(v.z >> 16); q[6] = (unsigned short)(v.w & 0xffffu); q[7] = (unsigned short)(v.w >> 16); }
        LDS_WAIT(); asm volatile("" ::: "memory");
#pragma unroll
        for (int i = 0; i < 8; ++i) { const int d = i * 8 + (lane >> 3), c = lane & 7; const LAS unsigned short* q = tl_ + (c * 8) * 66 + d;
            u32x4 o; o.x = (unsigned)q[0] | ((unsigned)q[66] << 16); o.y = (unsigned)q[2 * 66] | ((unsigned)q[3 * 66] << 16); o.z = (unsigned)q[4 * 66] | ((unsigned)q[5 * 66] << 16); o.w = (unsigned)q[6 * 66] | ((unsigned)q[7 * 66] << 16);
            *(u32x4*)(dp + (size_t)d * 256 + c * 8) = o; }
        LDS_WAIT(); asm volatile("" ::: "memory");
    }
}

__device__ __forceinline__ void p9_route(Frame& F, const Args& a) {
    unsigned char* ws = F.ws; const float* X2 = a.out;
    const float* gff = a.in[IN_NORM_FFN_G]; const float* wgrp = a.in[IN_W_GRP]; const float* bgrp = a.in[IN_B_GRP]; const float* wrt = a.in[IN_W_RT]; const float* brt = a.in[IN_B_RT];
    float* wts = (float*)(ws + WS_ROUTE); float* rstd2 = wts + 2 * NTOK; int* lists = (int*)(ws + WS_LISTS);
    const int gw = F.bx * NWAVES + F.wave, NGW = F.G * NWAVES, lane = F.lane;
    const f32x4* wgp = (const f32x4*)(ws + WS_RTW); const f32x4* wep = wgp + 1024;
    float xn[16];
    if (gw < NTOK) {
#pragma unroll
        for (int i = 0; i < 16; ++i) xn[i] = X2[(size_t)gw * D + 64 * i + lane]; }
    int my_ea = -1, my_eb = -1, my_tok = -1, it_ = 0; float my_w1 = 0.f, my_w2 = 0.f, my_rstd = 0.f;
    for (int tok = gw; tok < NTOK; tok += NGW, ++it_) {
        float xa[16]; float s = 0.f;
#pragma unroll
        for (int i = 0; i < 16; ++i) { xa[i] = xn[i]; s += xa[i] * xa[i]; }
        if (tok + NGW < NTOK) {
#pragma unroll
            for (int i = 0; i < 16; ++i) xn[i] = X2[(size_t)(tok + NGW) * D + 64 * i + lane]; }
        const float rstd = 1.0f / sqrtf(wave_sum(s) * (1.f / D) + EPS);
        float lg[4] = {0.f, 0.f, 0.f, 0.f};
#pragma unroll
        for (int i = 0; i < 16; ++i) { const f32x4 wg = wgp[64 * i + lane];
#pragma unroll
            for (int c = 0; c < 4; ++c) lg[c] += xa[i] * wg[c]; }
#pragma unroll
        for (int i = 0; i < 4; ++i) lg[i] = rstd * wave_sum(lg[i]) + bgrp[i];
        int grp = 0; float gm = lg[0];
#pragma unroll
        for (int i = 1; i < 4; ++i) if (lg[i] > gm) { gm = lg[i]; grp = i; }
        grp = __builtin_amdgcn_readfirstlane(grp);
        float gs = 0.f;
#pragma unroll
        for (int i = 0; i < 4; ++i) gs += expf(lg[i] - gm);
        const float g_gate = 1.0f / gs;
        float lq[8];
#pragma unroll
        for (int i = 0; i < 8; ++i) lq[i] = 0.f;
        const f32x4* pwe = wep + (size_t)grp * (16 * 2 * 64) + lane;
#pragma unroll
        for (int i = 0; i < 16; ++i) { const f32x4 wa = pwe[(2 * i) * 64], wb = pwe[(2 * i + 1) * 64];
#pragma unroll
            for (int c = 0; c < 4; ++c) { lq[c] += xa[i] * wa[c]; lq[4 + c] += xa[i] * wb[c]; } }
#pragma unroll
        for (int i = 0; i < 8; ++i) lq[i] = rstd * wave_sum(lq[i]) + brt[grp * 8 + i];
        int i1 = 0; float m1 = lq[0];
#pragma unroll
        for (int i = 1; i < 8; ++i) if (lq[i] > m1) { m1 = lq[i]; i1 = i; }
        int i2 = -1; float m2 = -3.0e38f;
#pragma unroll
        for (int i = 0; i < 8; ++i) if (i != i1 && lq[i] > m2) { m2 = lq[i]; i2 = i; }
        const float e2 = expf(m2 - m1), den = 1.0f + e2; const float w1 = g_gate / den, w2 = g_gate * e2 / den;
        if (lane == it_) { my_ea = grp * 8 + i1; my_eb = grp * 8 + i2; my_tok = tok; my_w1 = w1; my_w2 = w2; my_rstd = rstd; }
    }
    if (my_tok >= 0) {
        const unsigned sa = __hip_atomic_fetch_add(F.ctl + CW_ECNT + 64 * my_ea, 1u, __ATOMIC_RELAXED, __HIP_MEMORY_SCOPE_AGENT);
        const unsigned sb = __hip_atomic_fetch_add(F.ctl + CW_ECNT + 64 * my_eb, 1u, __ATOMIC_RELAXED, __HIP_MEMORY_SCOPE_AGENT);
        lists[(size_t)my_ea * NTOK + sa] = my_tok * 2; lists[(size_t)my_eb * NTOK + sb] = my_tok * 2 + 1;
        wts[my_tok * 2] = my_w1; wts[my_tok * 2 + 1] = my_w2; rstd2[my_tok] = my_rstd;
    }
}
__device__ __forceinline__ void moe_tiles(Frame& F) {
    __syncthreads();
    if (F.tid == 0) { unsigned accu = 0u; for (int e = 0; e < NEXP; ++e) { const unsigned c = __hip_atomic_load(F.ctl + CW_ECNT + 64 * e, __ATOMIC_RELAXED, __HIP_MEMORY_SCOPE_AGENT); F.MISC[16 + e] = accu; F.MISC[64 + e] = c; accu += (c + 255u) >> 8; } F.MISC[16 + NEXP] = accu; }
    __syncthreads();
}
template <int WHICH> struct SchedMoe {
    volatile LAS unsigned* MISC; unsigned char* ws; int G, c;
    __device__ __forceinline__ bool next(int i, GU& u) const {
        const int L = i * G + c; const int T = (int)MISC[16 + NEXP]; if (L >= 4 * T) return false;
        const int tau = L >> 2, pn = L & 3; int e = 0;
        for (int k = 1; k < NEXP; ++k) if ((int)MISC[16 + k] <= tau) e = k;
        const int lt = tau - (int)MISC[16 + e]; const int cnt = (int)MISC[64 + e]; int nv = cnt - lt * 256; nv = nv > 256 ? 256 : nv;
        u.rows = (const int*)(ws + WS_LISTS) + (size_t)e * NTOK + lt * 256; u.nvalid = nv; u.pm = tau; u.pn = pn; u.kind = 0; u.aux = e;
        if (WHICH == 0) { u.A = (const char*)ws + WS_X2B; u.B = (const char*)ws + WS_W13 + (size_t)e * D * D * 2 + (size_t)pn * 256 * D * 2; }
        else { u.A = (const char*)ws + WS_H1 + (size_t)tau * 256 * DEXP * 2; u.B = (const char*)ws + WS_W2 + (size_t)e * D * DEXP * 2 + (size_t)pn * 256 * DEXP * 2; }
        return true;
    }
};
struct EpiMoe1 {
    static constexpr bool PERM = true;
    const float* rstd2; bf16* H1;
    __device__ __forceinline__ void operator()(const f32x4 (&acc)[2][2][4][2], const GU& u, int wr, int wc, int fr, int fq) const {
        char* hb = (char*)H1 + (size_t)u.pm * 256 * DEXP * 2;
        const int j00 = (u.pn * 256 + 32 * wc + 8 * fq) >> 1;
#pragma unroll
        for (int ai = 0; ai < 2; ++ai) {
            int r = 128 * ai + 64 * wr + fr; LAUNDER(r);
#pragma unroll
            for (int m = 0; m < 4; ++m) { const bool ok = r < u.nvalid; const float rs = ok ? rstd2[u.rows[r] >> 1] : 0.f;
#pragma unroll
                for (int bj = 0; bj < 2; ++bj) { const f32x4 a1 = acc[ai][bj][m][0] * rs, a3 = acc[ai][bj][m][1] * rs; f32x4 hv;
#pragma unroll
                    for (int j = 0; j < 4; ++j) hv[j] = a1[j] * sigmoidf_(a1[j]) * a3[j];
                    u32x2 w; w.x = cvt_pk_bf16(hv[0], hv[1]); w.y = cvt_pk_bf16(hv[2], hv[3]); *(u32x2*)(hb + (unsigned)((r * DEXP + j00 + 64 * bj) * 2)) = w; }
                r += 16; LAUNDER(r); }
        }
    }
};
struct EpiMoe2 {
    static constexpr bool PERM = true;
    const float* wts; bf16* Y0; bf16* Y1;
    __device__ __forceinline__ void operator()(const f32x4 (&acc)[2][2][4][2], const GU& u, int wr, int wc, int fr, int fq) const {
#pragma unroll
        for (int ai = 0; ai < 2; ++ai)
#pragma unroll
            for (int m = 0; m < 4; ++m) { const int r = 128 * ai + 64 * wr + 16 * m + fr;
                if (r < u.nvalid) { const int ent = u.rows[r]; const float w8 = wts[ent]; bf16* dst = ((ent & 1) ? Y1 : Y0) + (size_t)(ent >> 1) * D + u.pn * 256 + 32 * wc + 8 * fq;
#pragma unroll
                    for (int bj = 0; bj < 2; ++bj) { const f32x4 v0 = acc[ai][bj][m][0] * w8, v1 = acc[ai][bj][m][1] * w8;
                        u32x4 w; w.x = cvt_pk_bf16(v0[0], v0[1]); w.y = cvt_pk_bf16(v0[2], v0[3]); w.z = cvt_pk_bf16(v1[0], v1[1]); w.w = cvt_pk_bf16(v1[2], v1[3]);
                        *(u32x4*)(dst + 128 * bj) = w; } } }
    }
};

__device__ __forceinline__ void p12_final(Frame& F, const Args& a) {
    const bf16* Y0 = (const bf16*)(F.ws + WS_YS0); const bf16* Y1 = (const bf16*)(F.ws + WS_YS1); const bf16* X2 = (const bf16*)(F.ws + WS_X2B); const float* g = a.in[IN_NORM_F_G];
    const int gw = F.bx * NWAVES + F.wave, NGW = F.G * NWAVES, lane = F.lane;
    for (int tok = gw; tok < NTOK; tok += NGW) {
        f32x4* xr = (f32x4*)(a.out + (size_t)tok * D) + lane; const u32x2* x2 = (const u32x2*)(X2 + (size_t)tok * D) + lane; const u32x2* y0 = (const u32x2*)(Y0 + (size_t)tok * D) + lane; const u32x2* y1 = (const u32x2*)(Y1 + (size_t)tok * D) + lane;
        f32x4 v[4]; float s = 0.f;
#pragma unroll
        for (int j = 0; j < 4; ++j) { const u32x2 xx = x2[64 * j], p = y0[64 * j], q = y1[64 * j];
            v[j].x = lo16(xx.x) + (lo16(p.x) + lo16(q.x)); v[j].y = hi16(xx.x) + (hi16(p.x) + hi16(q.x)); v[j].z = lo16(xx.y) + (lo16(p.y) + lo16(q.y)); v[j].w = hi16(xx.y) + (hi16(p.y) + hi16(q.y));
            s += (v[j].x * v[j].x + v[j].y * v[j].y) + (v[j].z * v[j].z + v[j].w * v[j].w); }
        const float rstd = 1.0f / sqrtf(wave_sum(s) * (1.f / D) + EPS);
#pragma unroll
        for (int j = 0; j < 4; ++j) { const f32x4 gg = ((const f32x4*)g + lane)[64 * j]; xr[64 * j] = v[j] * rstd * gg; }
    }
}

constexpr int N_PHASES = 14;
__global__ void __launch_bounds__(NTHREADS, 2) fwd(Args args) {
    extern __shared__ __attribute__((aligned(16))) unsigned char lds[];
    Frame F;
    F.lds = (LAS unsigned char*)lds; F.MISC = (volatile LAS unsigned*)(F.lds + MISC_OFF);
    F.tid = threadIdx.x; F.lane = F.tid & 63; F.wave = __builtin_amdgcn_readfirstlane(F.tid >> 6); F.G = gridDim.x; F.bx = blockIdx.x;
    F.ws = args.ws; F.ctl = (unsigned*)(args.ws + WS_CTL);
    unsigned char* ws = args.ws;
    for (int u = F.tid; u < (LDS_BYTES - RING_BYTES) / 4; u += NTHREADS) ((LAS unsigned*)(F.lds + RING_BYTES))[u] = 0u;
    __syncthreads();
    const int lo = args.ph_lo, hi = args.ph_hi;
    const bool one = (hi - lo) > 1;
    XcdBarrier bar; bar.bar = F.ctl + CW_BAR; bar.x = 0; bar.st = F.MISC + 8;
    if (one) bar = xcd_barrier_post(F.ctl + CW_BAR, F.MISC + 8);
#define IN(k) (lo <= (k) && (k) < hi && phase_begin(F))
#define SEAM(k) do { if (lo <= (k) && (k) + 1 < hi) xcd_barrier(bar); } while (0)

    if (IN(0)) { p0_prologue(F, args); } SEAM(0);
    if (IN(1)) {
        SchedP1 S{ws, F.G, F.bx};
        EpiP1 E{ws};
        pg8::gemm_phase<EpiP1, SchedP1, false>(F.lds, D, D, D, S, E);
        p1_gate_logits(F);
    } SEAM(1);
    if (IN(2)) {
        p2_retention_fast(F, F.bx, (bf16*)(ws + WS_RV));
        { const int w0 = F.bx * NWAVES + F.wave, nw = F.G * NWAVES;
            transpose_kv_tiles(F, (const bf16*)(ws + WS_KV6 + 3 * KV_STRIDE), (bf16*)args.out, w0, nw);
            transpose_kv_tiles(F, (const bf16*)(ws + WS_KV6 + 5 * KV_STRIDE), (bf16*)((unsigned char*)args.out + KV_STRIDE), w0, nw);
            transpose_memv_tiles(F, (bf16*)(ws + WS_MEMVT), w0, nw); }
        __syncthreads();
        { SchedCmp S{ws, 0, F.G, F.bx}; EpiCmp E{(float*)args.out + (size_t)16 * MiB};
            pg8::gemm_phase<EpiCmp, SchedCmp, false>(F.lds, 512, 2048, 4096, S, E); }
    } SEAM(2);
    if (IN(3)) { p2b_compress_out(F, args); } SEAM(3);
    if (IN(4)) { p3_ret_normalize(F); p3_nsa_fast(F, (const bf16*)args.out, (const bf16*)((const unsigned char*)args.out + KV_STRIDE), (bf16*)((unsigned char*)args.out + 64 * MiB)); } SEAM(4);
    if (IN(5)) {
        SchedP4 S{ws, F.G, F.bx, (const char*)args.out + 64 * MiB};
        EpiP4 E{(float*)(ws + WS_P4SCR) + (size_t)F.bx * (2 * 32 * 512 * 4), (bf16*)(ws + WS_Y)};
        pg8::gemm_phase<EpiP4, SchedP4, false>(F.lds, D, D, D, S, E);
    } SEAM(5);
    if (IN(6)) {
        SchedMN S{ws, WS_Y, W_OUT, F.G, F.bx}; EpiRes<true> E{args.in[IN_X], nullptr, nullptr, (bf16*)(ws + WS_X1B), (float*)(ws + WS_SSQ)};
        pg8::gemm_phase<EpiRes<true>, SchedMN, false>(F.lds, D, D, D, S, E);
    } SEAM(6);
    if (IN(7)) {
        const bool early = ((F.bx >> 3) & 1) == 0;
        if (early) expert_copies(F, args, 0, NEXP / 2);
        SchedMN S{ws, WS_X1B, W_XQ, F.G, F.bx}; EpiQ E{(const float*)(ws + WS_SSQ), (bf16*)(ws + WS_NQ)};
        pg8::gemm_phase<EpiQ, SchedMN, false>(F.lds, D, D, D, S, E);
        if (!early) { __syncthreads(); expert_copies(F, args, 0, NEXP / 2); }
    } SEAM(7);
    if (IN(8)) { p7_xattn_fast(F, (const bf16*)(ws + WS_MEMVT), (bf16*)(ws + WS_NQ)); } SEAM(8);
    if (IN(9)) {
        const bool early = ((F.bx >> 3) & 1) == 0;
        if (early) expert_copies(F, args, NEXP / 2, NEXP);
        SchedMN S{ws, WS_NQ, W_XO, F.G, F.bx}; EpiRes<false> E{nullptr, (const bf16*)(ws + WS_X1B), args.out, (bf16*)(ws + WS_X2B), nullptr};
        pg8::gemm_phase<EpiRes<false>, SchedMN, false>(F.lds, D, D, D, S, E);
        if (!early) { __syncthreads(); expert_copies(F, args, NEXP / 2, NEXP); }
    } SEAM(9);
    if (IN(10)) { p9_route(F, args); } SEAM(10);
    if (IN(11)) {
        moe_tiles(F);
        SchedMoe<0> S{F.MISC, ws, F.G, F.bx}; EpiMoe1 E{(const float*)(ws + WS_ROUTE) + 2 * NTOK, (bf16*)(ws + WS_H1)};
        pg8::gemm_phase<EpiMoe1, SchedMoe<0>, true>(F.lds, D, D, D, S, E);
    } SEAM(11);
    if (IN(12)) {
        moe_tiles(F);
        SchedMoe<1> S{F.MISC, ws, F.G, F.bx}; EpiMoe2 E{(const float*)(ws + WS_ROUTE), (bf16*)(ws + WS_YS0), (bf16*)(ws + WS_YS1)};
        pg8::gemm_phase<EpiMoe2, SchedMoe<1>, false>(F.lds, DEXP, DEXP, DEXP, S, E);
    } SEAM(12);
    if (IN(13)) { p12_final(F, args); }
#undef IN
#undef SEAM
}

extern "C" void kernel_launch(void* const* d_in, const int* in_sizes, int n_in, void* d_out, int out_size, void* d_ws, size_t ws_size, hipStream_t stream) {
    static int grid = 0;
    if (grid == 0) {
        if (n_in != 27 || in_sizes[0] != NTOK * D || out_size != NTOK * D || ws_size < WS_END) {
            fprintf(stderr, "kernel_launch: unexpected shapes: n_in %d in0 %d out %d ws %zu (need %zu)\n", n_in, n_in > 0 ? in_sizes[0] : -1, out_size, ws_size, (size_t)WS_END); grid = -1; return; }
        int dev = 0, cus = 0, per_cu = 0;
        if (hipGetDevice(&dev) != hipSuccess || hipDeviceGetAttribute(&cus, hipDeviceAttributeMultiprocessorCount, dev) != hipSuccess) { grid = -1; return; }
        if (hipFuncSetAttribute((const void*)fwd, hipFuncAttributeMaxDynamicSharedMemorySize, LDS_BYTES) != hipSuccess) { fprintf(stderr, "kernel_launch: hipFuncSetAttribute failed\n"); grid = -1; return; }
        if (hipOccupancyMaxActiveBlocksPerMultiprocessor(&per_cu, (const void*)fwd, NTHREADS, LDS_BYTES) != hipSuccess || per_cu < 1) fprintf(stderr, "kernel_launch: occupancy query reports %d\n", per_cu);
        (void)hipGetLastError();
        grid = cus < 256 ? cus : 256;
    }
    if (grid < 0) return;
    (void)hipMemsetAsync((char*)d_ws + WS_CTL, 0, CTL_ZERO_BYTES, stream);
    Args a{};
    for (int i = 0; i < 27; ++i) a.in[i] = (const float*)d_in[i];
    a.out = (float*)d_out; a.ws = (unsigned char*)d_ws;
#if MK_N_LAUNCHES == 1
    a.ph_lo = 0; a.ph_hi = N_PHASES;
    hipLaunchKernelGGL(fwd, dim3(grid), dim3(NTHREADS), LDS_BYTES, stream, a);
#else
    for (int p = 0; p < N_PHASES; ++p) { a.ph_lo = p; a.ph_hi = p + 1; hipLaunchKernelGGL(fwd, dim3(grid), dim3(NTHREADS), LDS_BYTES, stream, a); }
#endif
}
```

```cpp
#include <hip/hip_runtime.h>
#include <cstdio>
#include <cstdint>

#ifndef MK_N_LAUNCHES
#define MK_N_LAUNCHES 1
#endif

#define LAS __attribute__((address_space(3)))
#define GAS __attribute__((address_space(1)))
#define HD __host__ __device__
#define HDI __host__ __device__ __attribute__((always_inline)) inline
typedef unsigned short bf16;
typedef short bf16x8 __attribute__((ext_vector_type(8)));
typedef float f32x4 __attribute__((ext_vector_type(4)));
typedef float f32x2 __attribute__((ext_vector_type(2)));
typedef float f32x16 __attribute__((ext_vector_type(16)));
typedef unsigned u32x4 __attribute__((ext_vector_type(4)));
typedef unsigned u32x2 __attribute__((ext_vector_type(2)));

constexpr int D = 1024, BATCH = 8, SEQ = 4096, NTOK = BATCH * SEQ, NMEM = 256, NMEMTOK = BATCH * NMEM;
constexpr int DIN = 7704;
constexpr int C_RQ = 0, C_RK = 512, C_RV = 1024, C_RG = 2048, C_NQ = 3072, C_CK = 4096, C_NGL = 5632, C_GA = 5656, C_GB = 6680;
constexpr int NPROJ = 5632;
constexpr int NEXP = 32, DEXP = 512;
constexpr float EPS = 1e-6f;
constexpr int NWAVES = 8, NTHREADS = 512;

constexpr size_t MiB = 1u << 20;
constexpr size_t WS_CTL = 0, CTL_ZERO_BYTES = 1 * MiB;
constexpr size_t WS_ROPE_COS = 1 * MiB, WS_ROPE_SIN = 2 * MiB;
constexpr size_t WS_RTW = 3 * MiB + 512 * 1024;
constexpr size_t WS_SMALLW = 3 * MiB;
constexpr size_t WS_MEMVT = 24 * MiB;
constexpr size_t WS_KCMP = 4 * MiB, WS_VCMP = 5 * MiB, WS_VCMPT = 35 * MiB;
constexpr size_t WS_GATES = 10 * MiB;
constexpr size_t WS_SSQ = 13 * MiB;
constexpr size_t WS_ROUTE = 15 * MiB;
constexpr size_t WS_LISTS = 16 * MiB;
constexpr size_t WS_W = 36 * MiB;
constexpr size_t W_IN = WS_W;
constexpr size_t W_GA = W_IN + 11 * MiB, W_GB = W_GA + 2 * MiB;
constexpr size_t W_RO = W_GB + 2 * MiB, W_NO = W_RO + 2 * MiB, W_OUT = W_NO + 2 * MiB, W_XQ = W_OUT + 2 * MiB, W_XO = W_XQ + 2 * MiB;
constexpr size_t W_XKV = W_XO + 2 * MiB;
constexpr size_t W_C1K = W_XKV + 4 * MiB, W_C1V = W_C1K + 2 * MiB;
constexpr size_t WS_MEMN = W_C1V + 2 * MiB;
constexpr size_t WS_MEMKV = WS_MEMN + 4 * MiB;
constexpr size_t WS_H = 84 * MiB;
constexpr size_t WS_NQ = WS_H + 64 * MiB;
constexpr size_t WS_RV = WS_NQ + 64 * MiB;
constexpr size_t WS_RQ = WS_RV + 64 * MiB;
constexpr size_t WS_RK = WS_RQ + 32 * MiB;
constexpr size_t WS_RG = WS_RK + 32 * MiB;
constexpr size_t WS_KV6 = WS_RG + 64 * MiB;
constexpr size_t KV_STRIDE = 16 * MiB;
constexpr size_t WS_END = WS_KV6 + 96 * MiB;
constexpr size_t WS_Y = WS_RQ, WS_P4SCR = WS_RG, WS_W13 = WS_RQ, WS_W2 = WS_RG, WS_H1 = WS_KV6, WS_X1B = WS_H, WS_X2B = WS_RV, WS_YS0 = WS_H, WS_YS1 = WS_NQ;
static_assert(WS_MEMKV + 8 * MiB <= WS_H && WS_VCMPT + 1 * MiB <= WS_W && WS_MEMVT + 4 * MiB <= WS_VCMPT, "ws map");
constexpr int CW_BAR = 4096;
constexpr int CW_ECNT = 16384;
constexpr int LDS_BYTES = 147456, RING_BYTES = 131072, MISC_OFF = RING_BYTES + 320;

HD inline float bf2f(bf16 b) { return __builtin_bit_cast(float, (unsigned)b << 16); }
HD inline unsigned f2bf(float f) { unsigned u = __builtin_bit_cast(unsigned, f); return (u + 0x7fffu + ((u >> 16) & 1u)) >> 16; }
HD inline unsigned pk2(float lo, float hi) { return f2bf(lo) | (f2bf(hi) << 16); }
HD inline float lo16(unsigned w) { return __builtin_bit_cast(float, w << 16); }
HD inline float hi16(unsigned w) { return __builtin_bit_cast(float, w & 0xffff0000u); }
__device__ __forceinline__ unsigned cvt_pk_bf16(float lo, float hi) { unsigned r; asm volatile("v_cvt_pk_bf16_f32 %0, %1, %2" : "=v"(r) : "v"(lo), "v"(hi)); return r; }
#define DPP_F(v, ctrl, rmask) __builtin_bit_cast(float, __builtin_amdgcn_update_dpp(0, __builtin_bit_cast(int, v), ctrl, rmask, 0xf, false))
__device__ __forceinline__ float wave_sum(float v) {
    v += DPP_F(v, 0xB1, 0xf);
    v += DPP_F(v, 0x4E, 0xf);
    v += DPP_F(v, 0x141, 0xf);
    v += DPP_F(v, 0x140, 0xf);
    v += DPP_F(v, 0x142, 0xa);
    v += DPP_F(v, 0x143, 0xc);
    return __builtin_bit_cast(float, __builtin_amdgcn_readlane(__builtin_bit_cast(int, v), 63));
}
__device__ __forceinline__ float wave_max(float v) {
#pragma unroll
    for (int o = 1; o < 64; o <<= 1) v = fmaxf(v, __shfl_xor(v, o));
    return v;
}
__device__ __forceinline__ float sigmoidf_(float x) { return __builtin_amdgcn_rcpf(1.0f + __builtin_amdgcn_exp2f(-1.4426950408889634f * x)); }
#define LAUNDER(p) asm volatile("" : "+v"(p))
#define LDS_WAIT() asm volatile("s_waitcnt lgkmcnt(0)" ::: "memory")
#define VM_WAIT() asm volatile("s_waitcnt vmcnt(0)" ::: "memory")

#define XB_TMO      128
#define XB_XCNT(j)  (256  + 64 * (j))
#define XB_XSUB(j)  (1280 + 64 * (j))
#define XB_XGEN(j)  (2304 + 64 * (j))
#define XB_TOP      3328
#define XB_TOPGEN   3392
#define XCD_BAR_WORDS 3456
#define XB_SPIN_CAP (1u << 24)
__device__ __forceinline__ unsigned xb_ld(unsigned* p)              { return __hip_atomic_load(p, __ATOMIC_RELAXED, __HIP_MEMORY_SCOPE_AGENT); }
__device__ __forceinline__ unsigned xb_add(unsigned* p, unsigned v) { return __hip_atomic_fetch_add(p, v, __ATOMIC_RELAXED, __HIP_MEMORY_SCOPE_AGENT); }
__device__ __forceinline__ unsigned xb_xcc_id() { return (unsigned)__builtin_amdgcn_s_getreg((3 << 11) | 20) & 0xFu; }
#define XB_SPIN(cond, bar) do { unsigned _sp = 0; while (cond) { __builtin_amdgcn_s_sleep(1); \
    if ((++_sp & 255u) == 0u) { if (xb_ld(&(bar)[XB_TMO])) break; if (_sp > XB_SPIN_CAP) { atomicAdd(&(bar)[XB_TMO], 1u); break; } } } } while (0)
struct XcdBarrier { unsigned* bar; unsigned x; volatile LAS unsigned* st; };
__device__ __forceinline__ XcdBarrier xcd_barrier_post(unsigned* bar, volatile LAS unsigned* st) {
    XcdBarrier b; b.bar = bar; b.x = xb_xcc_id(); b.st = st;
    if (threadIdx.x == 0) (void)xb_add(&bar[XB_XCNT(b.x)], 1u);
    return b;
}
__device__ __forceinline__ void xcd_barrier_complete(unsigned* bar, unsigned x, unsigned& nloc, unsigned& nx) {
    const unsigned G = gridDim.x * gridDim.y * gridDim.z;
    unsigned sum, cnt, mine, sp = 0u;
    for (;;) {
        sum = 0u; cnt = 0u; mine = 0u;
#pragma unroll
        for (unsigned j = 0; j < 16; ++j) { const unsigned c = xb_ld(&bar[XB_XCNT(j)]); sum += c; cnt += (c > 0u) ? 1u : 0u; mine = (j == x) ? c : mine; }
        if (sum == G) break;
        __builtin_amdgcn_s_sleep(1);
        if ((++sp & 255u) == 0u) { if (xb_ld(&bar[XB_TMO])) break; if (sp > XB_SPIN_CAP) { atomicAdd(&bar[XB_TMO], 1u); break; } }
    }
    nloc = mine > 0u ? mine : 1u; nx = cnt > 0u ? cnt : 1u;
}
__device__ __forceinline__ void xcd_barrier(const XcdBarrier& b) {
    asm volatile("s_waitcnt vmcnt(0)" ::: "memory");
    __syncthreads();
    if (threadIdx.x == 0) {
        unsigned* bar = b.bar;
        __builtin_amdgcn_s_waitcnt(0);
        unsigned nloc = b.st[0], nx = b.st[1];
        if (nloc == 0u) { xcd_barrier_complete(bar, b.x, nloc, nx); b.st[0] = nloc; b.st[1] = nx; }
        const unsigned old = xb_add(&bar[XB_XSUB(b.x)], 1u);
        const unsigned gen = old / nloc;
        if (old + 1u == (gen + 1u) * nloc) {
            __builtin_amdgcn_fence(__ATOMIC_RELEASE, "agent");
            asm volatile("s_waitcnt vmcnt(0)" ::: "memory");
            const unsigned og = xb_add(&bar[XB_TOP], 1u);
            const unsigned tg = og / nx;
            if (og + 1u == (tg + 1u) * nx) xb_add(&bar[XB_TOPGEN], 1u);
            else XB_SPIN(xb_ld(&bar[XB_TOPGEN]) == tg, bar);
            __builtin_amdgcn_fence(__ATOMIC_ACQUIRE, "agent");
            xb_add(&bar[XB_XGEN(b.x)], 1u);
            asm volatile("s_waitcnt vmcnt(0)" ::: "memory");
        } else {
            XB_SPIN(xb_ld(&bar[XB_XGEN(b.x)]) == gen, bar);
            __builtin_amdgcn_fence(__ATOMIC_ACQUIRE, "agent");
            asm volatile("s_waitcnt vmcnt(0)" ::: "memory");
        }
    }
    __syncthreads();
}

namespace pg8 {
constexpr int BM = 256, BK = 64, HALF = 128, HTB = HALF * BK * 2, NXCD = 8, WGM = 8;
HD __forceinline__ int lds_byte(int r, int c) { const int st = (r >> 4) * 2 + (c >> 5), rr = r & 15, cc = c & 31, ob = rr * 64 + cc * 2; return st * 1024 + (ob ^ (((ob >> 9) & 1) << 5)); }
HD __forceinline__ void stage_rc(int b, int& R, int& C) { const int st = b / 1024, sb = b % 1024, swz = sb ^ (((sb >> 9) & 1) << 5); R = (st >> 1) * 16 + swz / 64; C = (st & 1) * 32 + (swz % 64) / 2; }
HD __forceinline__ int perm32(int rho) { const int n = rho >> 4, i = rho & 15; return 8 * (i >> 2) + 4 * n + (i & 3); }
HD __forceinline__ void tile_map(int L, int nM, int nN, int& pm, int& pn) {
    const int nwg = nM * nN; int wgid = L; { const int q = nwg / NXCD, r = nwg % NXCD, xcd = wgid % NXCD, off = wgid / NXCD; wgid = (xcd < r ? xcd * (q + 1) : r * (q + 1) + (xcd - r) * q) + off; }
    const int nig = WGM * nN, gid = wgid / nig, fm = gid * WGM, gsz = (nM - fm) < WGM ? (nM - fm) : WGM;
    pm = fm + ((wgid % nig) % gsz); pn = (wgid % nig) / gsz;
}
struct GU { const char* A; const char* B; const int* rows; int nvalid; int kind, pm, pn, aux; };
template <class Epi, class Sched, bool GATHER>
__device__ __forceinline__ void gemm_phase(LAS unsigned char* lds, const int K, const int lda, const int ldb, const Sched& S, const Epi& E) {
    int tid_ = threadIdx.x; LAUNDER(tid_);
    const int tid = tid_, wid = __builtin_amdgcn_readfirstlane(tid >> 6), lane = tid & 63, wr = wid >> 2, wc = wid & 3, fr = lane & 15, fq = lane >> 4;
    const int nt = K / BK;
    unsigned voffB[2];
#pragma unroll
    for (int i = 0; i < 2; ++i) { int R, C; stage_rc(tid * 16 + i * 8192, R, C); const int Rb = Epi::PERM ? ((R & ~31) + perm32(R & 31)) : R; voffB[i] = (unsigned)(Rb * ldb + C) * 2u; }
    const size_t kstep = (size_t)(BK * 2);
    const size_t hstepB = (size_t)HALF * ldb * 2;
    const unsigned ldsw = (unsigned)wid * 1024u;
    const int aoff = lds_byte(wr * 64 + fr, fq * 8), boff = lds_byte(wc * 32 + fr, fq * 8);
#define PG8_SA(b, h) (((b) * 2 + (h)) * HTB)
#define PG8_SB(b, h) ((4 + (b) * 2 + (h)) * HTB)
#define PG8_STAGE2(bufoff, gbase, v0, v1) do { \
        __builtin_amdgcn_global_load_lds((const unsigned*)((const char*)(gbase) + (v0)), (LAS unsigned*)(lds + (bufoff) + ldsw), 16, 0, 0); \
        __builtin_amdgcn_global_load_lds((const unsigned*)((const char*)(gbase) + (v1)), (LAS unsigned*)(lds + (bufoff) + ldsw + 8192), 16, 0, 0); } while (0)
#define PG8_STAGEB(bufoff, gbase) PG8_STAGE2(bufoff, gbase, voffB[0], voffB[1])
#define PG8_LDA(dst, b, h) do { _Pragma("unroll") for (int m = 0; m < 4; ++m) _Pragma("unroll") for (int k = 0; k < 2; ++k) dst[m][k] = *(const LAS bf16x8*)(lds + PG8_SA(b, h) + aoff + m * 2048 + k * 1024); } while (0)
#define PG8_LDB(dst, b, h) do { _Pragma("unroll") for (int n = 0; n < 2; ++n) _Pragma("unroll") for (int k = 0; k < 2; ++k) dst[n][k] = *(const LAS bf16x8*)(lds + PG8_SB(b, h) + boff + n * 2048 + k * 1024); } while (0)
#define PG8_MMA(ai, bj, At, Bt) do { __builtin_amdgcn_s_setprio(1); _Pragma("unroll") for (int m = 0; m < 4; ++m) _Pragma("unroll") for (int n = 0; n < 2; ++n) _Pragma("unroll") for (int k = 0; k < 2; ++k) \
        acc[ai][bj][m][n] = __builtin_amdgcn_mfma_f32_16x16x32_bf16(Bt[n][k], At[m][k], acc[ai][bj][m][n], 0, 0, 0); __builtin_amdgcn_s_setprio(0); } while (0)
#define PG8_WAIT_V(n) asm volatile("s_waitcnt vmcnt(" #n ")" ::: "memory")
#define PG8_WAIT_L(n) asm volatile("s_waitcnt lgkmcnt(" #n ")" ::: "memory")
#define PG8_BAR __builtin_amdgcn_s_barrier()
#define PG8_SCHED __builtin_amdgcn_sched_barrier(0)
#define PG8_VOFFA(u, vo) do { _Pragma("unroll") for (int h = 0; h < 2; ++h) _Pragma("unroll") for (int i = 0; i < 2; ++i) { int R_, C_; stage_rc(tid * 16 + i * 8192, R_, C_); const int R = R_ + HALF * h; \
        int ridx = R; if (GATHER) { ridx = (R < (u).nvalid) ? ((u).rows[R] >> 1) : 0; } vo[h][i] = (unsigned)(ridx * lda + C_) * 2u; } if (GATHER) asm volatile("" :: "v"(vo[0][0]), "v"(vo[0][1]), "v"(vo[1][0]), "v"(vo[1][1])); } while (0)
    GU cur, nxt; int ui = 0;
    if (!S.next(0, cur)) return;
    f32x4 acc[2][2][4][2];
#pragma unroll
    for (int a = 0; a < 2; ++a)
#pragma unroll
        for (int b = 0; b < 2; ++b)
#pragma unroll
            for (int m = 0; m < 4; ++m)
#pragma unroll
                for (int n = 0; n < 2; ++n) acc[a][b][m][n] = (f32x4){0.f, 0.f, 0.f, 0.f};
    bf16x8 At[4][2], B0[2][2], B1[2][2];
    unsigned cv[2][2], nv[2][2];
    PG8_VOFFA(cur, cv);
    const char* cA = cur.A; const char* cB = cur.B;
    PG8_STAGEB(PG8_SB(0, 0), cB); PG8_STAGEB(PG8_SB(0, 1), cB + hstepB); PG8_STAGE2(PG8_SA(0, 0), cA, cv[0][0], cv[0][1]); PG8_STAGE2(PG8_SA(0, 1), cA, cv[1][0], cv[1][1]);
    if (wr == 1) PG8_BAR;
    PG8_WAIT_V(2); PG8_BAR;
    PG8_STAGEB(PG8_SB(1, 0), cB + kstep); PG8_STAGE2(PG8_SA(1, 0), cA + kstep, cv[0][0], cv[0][1]); PG8_STAGEB(PG8_SB(1, 1), cB + hstepB + kstep);
    PG8_WAIT_V(6); PG8_BAR;
    for (;;) {
        const bool has_next = S.next(ui + 1, nxt);
        const char* nA = has_next ? nxt.A : cA; const char* nB = has_next ? nxt.B : cB;
        if (has_next) { PG8_VOFFA(nxt, nv); } else {
#pragma unroll
            for (int h = 0; h < 2; ++h)
#pragma unroll
                for (int i = 0; i < 2; ++i) nv[h][i] = cv[h][i]; }
        for (int t = 0; t < nt; t += 2) {
            const bool last = (t == nt - 2);
            const char* a1 = cA + (size_t)(t + 1) * kstep;
            const char* a2 = last ? nA : cA + (size_t)(t + 2) * kstep; const char* b2 = last ? nB : cB + (size_t)(t + 2) * kstep;
            const char* a3 = a2 + kstep; const char* b3 = b2 + kstep;
            const unsigned w00 = last ? nv[0][0] : cv[0][0], w01 = last ? nv[0][1] : cv[0][1], w10 = last ? nv[1][0] : cv[1][0], w11 = last ? nv[1][1] : cv[1][1];
            PG8_LDB(B0, 0, 0); PG8_LDB(B1, 0, 1); PG8_SCHED; PG8_LDA(At, 0, 0); PG8_STAGE2(PG8_SA(1, 1), a1, cv[1][0], cv[1][1]);
            PG8_WAIT_V(8); PG8_WAIT_L(0); PG8_BAR; PG8_MMA(0, 0, At, B0); PG8_MMA(0, 1, At, B1); PG8_BAR; PG8_SCHED;
            PG8_LDA(At, 0, 1); PG8_STAGEB(PG8_SB(0, 0), b2); PG8_STAGEB(PG8_SB(0, 1), b2 + hstepB); PG8_STAGE2(PG8_SA(0, 0), a2, w00, w01);
            PG8_WAIT_V(8); PG8_WAIT_L(0); PG8_BAR; PG8_MMA(1, 0, At, B0); PG8_MMA(1, 1, At, B1); PG8_BAR; PG8_SCHED;
            PG8_LDB(B0, 1, 0); PG8_LDB(B1, 1, 1); PG8_SCHED; PG8_LDA(At, 1, 0); PG8_STAGE2(PG8_SA(0, 1), a2, w10, w11);
            PG8_WAIT_V(8); PG8_WAIT_L(0); PG8_BAR; PG8_MMA(0, 0, At, B0); PG8_MMA(0, 1, At, B1); PG8_BAR; PG8_SCHED;
            PG8_LDA(At, 1, 1); PG8_STAGEB(PG8_SB(1, 0), b3); PG8_STAGEB(PG8_SB(1, 1), b3 + hstepB); PG8_STAGE2(PG8_SA(1, 0), a3, w00, w01);
            PG8_WAIT_V(8); PG8_WAIT_L(0); PG8_BAR; PG8_MMA(1, 0, At, B0); PG8_MMA(1, 1, At, B1); PG8_BAR; PG8_SCHED;
        }
        if (wr == 0) PG8_BAR;
        E(acc, cur, wr, wc, fr, fq);
        if (!has_next) break;
#pragma unroll
        for (int a = 0; a < 2; ++a)
#pragma unroll
            for (int b = 0; b < 2; ++b)
#pragma unroll
                for (int m = 0; m < 4; ++m)
#pragma unroll
                    for (int n = 0; n < 2; ++n) acc[a][b][m][n] = (f32x4){0.f, 0.f, 0.f, 0.f};
        cur = nxt; cA = nA; cB = nB; ++ui;
#pragma unroll
        for (int h = 0; h < 2; ++h)
#pragma unroll
            for (int i = 0; i < 2; ++i) cv[h][i] = nv[h][i];
        if (wr == 1) PG8_BAR;
    }
    PG8_WAIT_V(0);
    PG8_BAR;
#undef PG8_SA
#undef PG8_SB
#undef PG8_STAGE2
#undef PG8_STAGEB
#undef PG8_LDA
#undef PG8_LDB
#undef PG8_MMA
#undef PG8_WAIT_V
#undef PG8_WAIT_L
#undef PG8_BAR
#undef PG8_SCHED
#undef PG8_VOFFA
}
}
using pg8::GU;

struct Args {
    const float* in[27]; float* out; unsigned char* ws; int ph_lo, ph_hi; int pad0, pad1;
};
enum { IN_X = 0, IN_MEM, IN_NORM_MIX_G, IN_W_IN, IN_W_RET_O, IN_W_NSA_O, IN_W_OUT, IN_CMP_PE_K, IN_CMP_W1_K, IN_CMP_W2_K, IN_CMP_PE_V, IN_CMP_W1_V, IN_CMP_W2_V,
       IN_NORM_X_G, IN_NORM_MEM_G, IN_W_XQ, IN_W_XKV, IN_W_XO, IN_NORM_FFN_G, IN_W_GRP, IN_B_GRP, IN_W_RT, IN_B_RT, IN_W_E1, IN_W_E3, IN_W_E2, IN_NORM_F_G };
struct Frame {
    LAS unsigned char* lds; volatile LAS unsigned* MISC; unsigned* ctl; unsigned char* ws;
    int tid, lane, wave, G, bx;
};

__device__ __forceinline__ bool phase_begin(Frame& F) { int t = threadIdx.x; LAUNDER(t); F.tid = t; F.lane = t & 63; return true; }
__device__ __forceinline__ void transpose_item(const float* W, int ldw, int c0, int k0, bf16* WT, int ldt, int mode, int row_off, int cbase, const float* kscale, float scale, LAS float* scr, int lane) {
    float vv[32];
#pragma unroll
    for (int i = 0; i < 32; ++i) { const int kk = 2 * i + (lane >> 5); vv[i] = W[(size_t)(k0 + kk) * ldw + c0 + (lane & 31)]; }
    if (kscale) {
#pragma unroll
        for (int i = 0; i < 32; ++i) { const int kk = 2 * i + (lane >> 5); vv[i] *= kscale[k0 + kk]; } }
#pragma unroll
    for (int i = 0; i < 32; ++i) { const int kk = 2 * i + (lane >> 5); scr[kk * 33 + (lane & 31)] = vv[i] * scale; }
    LDS_WAIT(); asm volatile("" ::: "memory");
    const int c = lane & 7;
#pragma unroll
    for (int j = 0; j < 4; ++j) { const int n = (lane >> 3) + 8 * j; const LAS float* s = scr + (8 * c) * 33 + n;
        u32x4 o; o.x = pk2(s[0 * 33], s[1 * 33]); o.y = pk2(s[2 * 33], s[3 * 33]); o.z = pk2(s[4 * 33], s[5 * 33]); o.w = pk2(s[6 * 33], s[7 * 33]);
        const int jc = c0 - cbase + n; const int drow = mode == 0 ? row_off + jc : (8 * (jc >> 2) + 4 * row_off + (jc & 3));
        *(u32x4*)(WT + (size_t)drow * ldt + k0 + 8 * c) = o; }
    LDS_WAIT(); asm volatile("" ::: "memory");
}
__device__ __forceinline__ void transpose_matrix(Frame& F, int& item_base, const float* W, int ldw, int K, int cbase, int ncols, bf16* WT, int ldt, int mode, int row_off, const float* kscale, float scale) {
    LAS float* scr = (LAS float*)(F.lds + F.wave * 16384);
    const int gw = F.bx * NWAVES + F.wave, NGW = F.G * NWAVES;
    const int nb = ncols / 32, nitems = (K / 64) * nb;
    int it = (gw - item_base % NGW + NGW) % NGW;
    for (; it < nitems; it += NGW) transpose_item(W, ldw, cbase + 32 * (it % nb), 64 * (it / nb), WT, ldt, mode, row_off, cbase, kscale, scale, scr, F.lane);
    item_base += nitems;
}
__device__ __forceinline__ void rms_row_to_bf16(int lane, const float* xrow, const float* g, bf16* orow) {
    const f32x4* xr = (const f32x4*)xrow + lane; const f32x4* gr = (const f32x4*)g + lane;
    f32x4 v[4]; float s = 0.f;
#pragma unroll
    for (int j = 0; j < 4; ++j) { v[j] = xr[64 * j]; s += (v[j].x * v[j].x + v[j].y * v[j].y) + (v[j].z * v[j].z + v[j].w * v[j].w); }
    const float rstd = 1.0f / sqrtf(wave_sum(s) * (1.f / D) + EPS);
    unsigned long long* o8 = (unsigned long long*)orow + lane;
#pragma unroll
    for (int j = 0; j < 4; ++j) { const f32x4 gg = gr[64 * j];
        o8[64 * j] = (unsigned long long)pk2(v[j].x * rstd * gg.x, v[j].y * rstd * gg.y) | ((unsigned long long)pk2(v[j].z * rstd * gg.z, v[j].w * rstd * gg.w) << 32); }
}

struct XItem { const float* src; bf16* dst; const float* ks; float scale; int ldw, ldt, mode, row_off, csrc, c0, k0, has_ks; };
__device__ __forceinline__ void xitem_decode_expert(const Args& a, unsigned char* ws, int it, XItem& x) {
    const int e = it / 768, r = it % 768, which = r >> 8, t = r & 255;
    x.ks = a.in[IN_NORM_FFN_G]; x.scale = 1.0f;
    if (which < 2) { x.src = a.in[which ? IN_W_E3 : IN_W_E1] + (size_t)e * D * DEXP; x.ldw = DEXP; x.dst = (bf16*)(ws + WS_W13) + (size_t)e * D * D; x.ldt = D; x.mode = 1; x.row_off = which; x.has_ks = 1; x.c0 = 32 * (t & 15); x.k0 = 64 * (t >> 4); }
    else { x.src = a.in[IN_W_E2] + (size_t)e * DEXP * D; x.ldw = D; x.dst = (bf16*)(ws + WS_W2) + (size_t)e * D * DEXP; x.ldt = DEXP; x.mode = 0; x.row_off = 0; x.has_ks = 0; x.c0 = 32 * (t & 31); x.k0 = 64 * (t >> 5); }
    x.csrc = x.c0;
}
constexpr int P0_NITEMS = 7936;
__device__ __forceinline__ void xitem_decode_p0(const Args& a, unsigned char* ws, int it, XItem& x) {
    int in_ = IN_W_IN, ldw = DIN, cb = 0, nc = 512, ldt = D, ro = 0, first = 0; size_t dst = W_IN; float sc = 1.0f; int hk = 0;
#define P0E(FIRST, IN__, LDW, CB, NC, DST, LDT, RO, SC, HK) if (it >= (FIRST)) { in_ = (IN__); ldw = (LDW); cb = (CB); nc = (NC); dst = (DST); ldt = (LDT); ro = (RO); sc = (SC); hk = (HK); first = (FIRST); }
    P0E(256, IN_W_IN, DIN, 512, 512, W_IN, D, 512, 0.08838834764831845f, 0)
    P0E(512, IN_W_IN, DIN, 1024, NPROJ - 1024, W_IN, D, 1024, 1.0f, 0)
    P0E(2816, IN_W_IN, DIN, C_GA, 1024, W_GA, D, 0, 1.0f, 0)
    P0E(3328, IN_W_IN, DIN, C_GB, 1024, W_GB, D, 0, 1.0f, 0)
    P0E(3840, IN_W_RET_O, D, 0, D, W_RO, D, 0, 1.0f, 0)
    P0E(4352, IN_W_NSA_O, D, 0, D, W_NO, D, 0, 1.0f, 0)
    P0E(4864, IN_W_OUT, D, 0, D, W_OUT, D, 0, 1.0f, 0)
    P0E(5376, IN_W_XQ, D, 0, D, W_XQ, D, 0, 1.0f, 1)
    P0E(5888, IN_W_XO, D, 0, D, W_XO, D, 0, 1.0f, 0)
    P0E(6400, IN_W_XKV, 2 * D, 0, 2 * D, W_XKV, D, 0, 1.0f, 0)
    P0E(7424, IN_CMP_W1_K, 128, 0, 128, W_C1K, 4096, 0, 1.0f, 0)
    P0E(7680, IN_CMP_W1_V, 128, 0, 128, W_C1V, 4096, 0, 1.0f, 0)
#undef P0E
    const int t = it - first, nb = nc >> 5;
    x.src = a.in[in_]; x.dst = (bf16*)(ws + dst); x.ks = a.in[IN_NORM_X_G]; x.scale = sc; x.ldw = ldw; x.ldt = ldt; x.mode = 0; x.row_off = ro; x.has_ks = hk;
    x.c0 = 32 * (t % nb); x.csrc = cb + x.c0; x.k0 = 64 * (t / nb);
}
__device__ __forceinline__ void xitem_load(const XItem& x, int lane, float (&vv)[32], f32x4& k0v, f32x4& k1v) {
#pragma unroll
    for (int i = 0; i < 32; ++i) { const int kk = 2 * i + (lane >> 5); vv[i] = x.src[(size_t)(x.k0 + kk) * x.ldw + x.csrc + (lane & 31)]; }
    const f32x4* p = (const f32x4*)(x.ks + ((x.k0 + 8 * (lane & 7)) & 1023)); k0v = p[0]; k1v = p[1];
}
__device__ __forceinline__ void xitem_finish(const XItem& x, int lane, const float (&vv)[32], f32x4 k0v, f32x4 k1v, LAS float* scr) {
    if (!x.has_ks) { k0v = (f32x4){1.f, 1.f, 1.f, 1.f}; k1v = k0v; }
    k0v *= x.scale; k1v *= x.scale;
#pragma unroll
    for (int i = 0; i < 32; ++i) { const int kk = 2 * i + (lane >> 5); scr[kk * 33 + (lane & 31)] = vv[i]; }
    LDS_WAIT(); asm volatile("" ::: "memory");
    const int c = lane & 7;
#pragma unroll
    for (int j = 0; j < 4; ++j) { const int n = (lane >> 3) + 8 * j; const LAS float* s = scr + (8 * c) * 33 + n;
        u32x4 o; o.x = pk2(s[0 * 33] * k0v.x, s[1 * 33] * k0v.y); o.y = pk2(s[2 * 33] * k0v.z, s[3 * 33] * k0v.w); o.z = pk2(s[4 * 33] * k1v.x, s[5 * 33] * k1v.y); o.w = pk2(s[6 * 33] * k1v.z, s[7 * 33] * k1v.w);
        const int jc = x.c0 + n; const int drow = x.mode == 0 ? x.row_off + jc : (8 * (jc >> 2) + 4 * x.row_off + (jc & 3));
        *(u32x4*)(x.dst + (size_t)drow * x.ldt + x.k0 + 8 * c) = o; }
    LDS_WAIT(); asm volatile("" ::: "memory");
}
template <bool EXPERT>
__device__ __forceinline__ void run_items(Frame& F, const Args& a, int it_begin, int it_end) {
    LAS float* scr = (LAS float*)(F.lds + F.wave * 16384);
    const int gw = F.bx * NWAVES + F.wave, NGW = F.G * NWAVES, lane = F.lane;
    int it = it_begin + gw;
#define XDEC(i_, x_) do { if (EXPERT) xitem_decode_expert(a, F.ws, (i_), x_); else xitem_decode_p0(a, F.ws, (i_), x_); } while (0)
    if (it < it_end) {
        float va[32], vb[32]; f32x4 ka0, ka1, kb0, kb1; XItem xa, xb;
        XDEC(it, xa); xitem_load(xa, lane, va, ka0, ka1);
        for (;;) {
            int itn = it + NGW; bool hn = itn < it_end;
            XDEC(hn ? itn : it, xb); xitem_load(xb, lane, vb, kb0, kb1);
            xitem_finish(xa, lane, va, ka0, ka1, scr);
            if (!hn) break;
            it = itn; itn = it + NGW; hn = itn < it_end;
            XDEC(hn ? itn : it, xa); xitem_load(xa, lane, va, ka0, ka1);
            xitem_finish(xb, lane, vb, kb0, kb1, scr);
            if (!hn) break;
            it = itn;
        }
    }
#undef XDEC
    __syncthreads();
}
__device__ __forceinline__ void expert_copies(Frame& F, const Args& a, int e_lo, int e_hi) { run_items<true>(F, a, e_lo * 768, e_hi * 768); }

__device__ __forceinline__ void p0_prologue(Frame& F, const Args& a) {
    unsigned char* ws = F.ws;
    const float* w_in = a.in[IN_W_IN];
    run_items<false>(F, a, 0, P0_NITEMS);
    const int gt = F.bx * NTHREADS + F.tid, NGT = F.G * NTHREADS;
    for (int i = gt; i < 2 * 128 * 4096 / 8; i += NGT) { const int m = i / (128 * 4096 / 8), r = i % (128 * 4096 / 8);
        *(u32x4*)(ws + (m ? W_C1V : W_C1K) + (size_t)128 * 4096 * 2 + (size_t)r * 16) = (u32x4){0u, 0u, 0u, 0u}; }
    bf16* wngl = (bf16*)(ws + WS_SMALLW);
    for (int i = gt; i < 32 * 1024; i += NGT) { const int r = i >> 10, k = i & 1023; wngl[i] = r < 24 ? (bf16)f2bf(w_in[(size_t)k * DIN + C_NGL + r]) : (bf16)0; }
    bf16* w2k = (bf16*)(ws + WS_SMALLW + 65536); bf16* w2v = w2k + 128 * 128;
    for (int i = gt; i < 2 * 128 * 128; i += NGT) { const int m = i >> 14, r = i & 16383, f = r >> 7, e = r & 127; const float* src = a.in[m ? IN_CMP_W2_V : IN_CMP_W2_K];
        (m ? w2v : w2k)[f * 128 + e] = (bf16)f2bf(src[e * 128 + f]); }
    { const float* gff = a.in[IN_NORM_FFN_G]; const float* wgrp = a.in[IN_W_GRP]; const float* wrt = a.in[IN_W_RT]; float* wgp = (float*)(ws + WS_RTW); float* wep = wgp + 4096;
      for (int i = gt; i < 4096; i += NGT) wgp[i] = gff[i >> 2] * wgrp[i];
      for (int i = gt; i < 32768; i += NGT) { const int j = i & 3, l = (i >> 2) & 63, half = (i >> 8) & 1, ii = (i >> 9) & 15, grp = i >> 13, k = 64 * ii + l; wep[i] = gff[k] * wrt[k * 32 + grp * 8 + half * 4 + j]; } }
    float* cbias = (float*)(ws + WS_SMALLW + 65536 + 2 * 128 * 128 * 2);
    const int gw = F.bx * NWAVES + F.wave, NGW = F.G * NWAVES;
    for (int o = gw; o < 256; o += NGW) { const int m = o >> 7, e = o & 127; const float* pe = a.in[m ? IN_CMP_PE_V : IN_CMP_PE_K]; const float* w1 = a.in[m ? IN_CMP_W1_V : IN_CMP_W1_K];
        float s = 0.f; for (int k = F.lane; k < 4096; k += 64) s += pe[k] * w1[(size_t)k * 128 + e];
        s = wave_sum(s); if (F.lane == 0) cbias[o] = s; }
    float* cosT = (float*)(ws + WS_ROPE_COS); float* sinT = (float*)(ws + WS_ROPE_SIN);
    for (int i = gt; i < SEQ * 64; i += NGT) { const int pos = i >> 6, j = i & 63; const float inv = powf(10000.0f, -(float)(2 * j) / 128.0f); const float ang = (float)pos * inv;
        cosT[i] = cosf(ang); sinT[i] = sinf(ang); }
    { f32x4 nx[4]; const float* X = a.in[IN_X]; const f32x4* gr = (const f32x4*)a.in[IN_NORM_MIX_G] + F.lane;
      if (gw < NTOK) {
#pragma unroll
          for (int j = 0; j < 4; ++j) nx[j] = ((const f32x4*)(X + (size_t)gw * D) + F.lane)[64 * j]; }
      for (int m = gw; m < NTOK; m += NGW) { f32x4 v[4]; float sq = 0.f;
#pragma unroll
          for (int j = 0; j < 4; ++j) { v[j] = nx[j]; sq += (v[j].x * v[j].x + v[j].y * v[j].y) + (v[j].z * v[j].z + v[j].w * v[j].w); }
          if (m + NGW < NTOK) {
#pragma unroll
              for (int j = 0; j < 4; ++j) nx[j] = ((const f32x4*)(X + (size_t)(m + NGW) * D) + F.lane)[64 * j]; }
          const float rstd = 1.0f / sqrtf(wave_sum(sq) * (1.f / D) + EPS); unsigned long long* o8 = (unsigned long long*)((bf16*)(ws + WS_H) + (size_t)m * D) + F.lane;
#pragma unroll
          for (int j = 0; j < 4; ++j) { const f32x4 gg = gr[64 * j]; o8[64 * j] = (unsigned long long)pk2(v[j].x * rstd * gg.x, v[j].y * rstd * gg.y) | ((unsigned long long)pk2(v[j].z * rstd * gg.z, v[j].w * rstd * gg.w) << 32); } } }
    for (int m = gw; m < NMEMTOK; m += NGW) rms_row_to_bf16(F.lane, a.in[IN_MEM] + (size_t)m * D, a.in[IN_NORM_MEM_G], (bf16*)(ws + WS_MEMN) + (size_t)m * D);
}

struct SchedP1 {
    unsigned char* ws; int G, c;
    __device__ __forceinline__ bool next(int i, GU& u) const {
        constexpr int NP = 128 * 22; const int L = i * G + c;
        u.rows = nullptr; u.nvalid = 0; u.aux = 0;
        if (L < NP) { int pm, pn; pg8::tile_map(L, 128, 22, pm, pn); u.A = (const char*)ws + WS_H + (size_t)pm * 256 * D * 2; u.B = (const char*)ws + W_IN + (size_t)pn * 256 * D * 2; u.pm = pm; u.pn = pn;
            u.kind = pn < 2 ? 0 : pn < 4 ? 1 : pn < 8 ? 2 : pn < 12 ? 3 : pn < 16 ? 4 : 5; return true; }
        const int L2 = L - NP; if (L2 >= 64) return false;
        const int pm = L2 & 7, pn = L2 >> 3; u.A = (const char*)ws + WS_MEMN + (size_t)pm * 256 * D * 2; u.B = (const char*)ws + W_XKV + (size_t)pn * 256 * D * 2; u.pm = pm; u.pn = pn; u.kind = 6; return true;
    }
};
struct EpiP1 {
    static constexpr bool PERM = true;
    unsigned char* ws;
    __device__ __forceinline__ void operator()(const f32x4 (&acc)[2][2][4][2], const GU& u, int wr, int wc, int fr, int fq) const {
        const int kind = u.kind;
        const float* cosT = (const float*)(ws + WS_ROPE_COS); const float* sinT = (const float*)(ws + WS_ROPE_SIN);
#pragma unroll
        for (int ai = 0; ai < 2; ++ai)
#pragma unroll
            for (int m = 0; m < 4; ++m) {
                const int r = 128 * ai + 64 * wr + 16 * m + fr; const int tok = u.pm * 256 + r;
#pragma unroll
                for (int bj = 0; bj < 2; ++bj) {
                    f32x4 v0 = acc[ai][bj][m][0], v1 = acc[ai][bj][m][1];
                    const int ct = 128 * bj + 32 * wc + 8 * fq;
                    bf16* dst;
                    if (kind <= 1) {
                        const int s = tok & (SEQ - 1), i0 = ((ct & 127) >> 1);
                        const f32x4 cs = *(const f32x4*)(cosT + s * 64 + i0), sn = *(const f32x4*)(sinT + s * 64 + i0);
                        const f32x4 a0 = v0, a1 = v1;
                        v0[0] = a0[0] * cs[0] - a0[1] * sn[0]; v0[1] = a0[0] * sn[0] + a0[1] * cs[0];
                        v0[2] = a0[2] * cs[1] - a0[3] * sn[1]; v0[3] = a0[2] * sn[1] + a0[3] * cs[1];
                        v1[0] = a1[0] * cs[2] - a1[1] * sn[2]; v1[1] = a1[0] * sn[2] + a1[1] * cs[2];
                        v1[2] = a1[2] * cs[3] - a1[3] * sn[3]; v1[3] = a1[2] * sn[3] + a1[3] * cs[3];
                        dst = (bf16*)(ws + (kind == 0 ? WS_RQ : WS_RK)) + (size_t)tok * 512 + (u.pn & 1) * 256 + ct;
                    } else if (kind == 2) { dst = (bf16*)(ws + WS_RV) + (size_t)tok * 1024 + (u.pn - 4) * 256 + ct;
                    } else if (kind == 3) {
#pragma unroll
                        for (int j = 0; j < 4; ++j) { v0[j] = v0[j] * sigmoidf_(v0[j]); v1[j] = v1[j] * sigmoidf_(v1[j]); }
                        dst = (bf16*)(ws + WS_RG) + (size_t)tok * 1024 + (u.pn - 8) * 256 + ct;
                    } else if (kind == 4) { dst = (bf16*)(ws + WS_NQ) + (size_t)tok * 1024 + (u.pn - 12) * 256 + ct;
                    } else if (kind == 5) {
                        const int b = tok >> 12, s = tok & (SEQ - 1);
                        unsigned char* kvb = ws + WS_KV6 + (size_t)(u.pn - 16) * KV_STRIDE;
                        dst = (bf16*)kvb + ((size_t)(b * 2 + bj) * SEQ + s) * 128 + (ct & 127);
                    } else { dst = (bf16*)(ws + WS_MEMKV) + (size_t)tok * 2048 + u.pn * 256 + ct; }
                    u32x4 w; w.x = cvt_pk_bf16(v0[0], v0[1]); w.y = cvt_pk_bf16(v0[2], v0[3]); w.z = cvt_pk_bf16(v1[0], v1[1]); w.w = cvt_pk_bf16(v1[2], v1[3]);
                    *(u32x4*)dst = w;
                }
            }
    }
};
__device__ __forceinline__ void p1_gate_logits(Frame& F) {
    const bf16* H = (const bf16*)(F.ws + WS_H); const bf16* W = (const bf16*)(F.ws + WS_SMALLW); float* gates = (float*)(F.ws + WS_GATES);
    const int r = F.lane & 31, hh = F.lane >> 5;
    const int nb_ = F.G > 64 ? F.G - 64 : F.G, b0_ = F.G > 64 ? F.bx - 64 : F.bx;
    if (b0_ < 0) return;
    for (int rb = b0_ + nb_ * F.wave; rb < NTOK / 32; rb += nb_ * NWAVES) {
        f32x16 acc; for (int j = 0; j < 16; ++j) acc[j] = 0.f;
        const bf16* ap = H + (size_t)(rb * 32 + r) * D + 8 * hh; const bf16* bp = W + (size_t)r * D + 8 * hh;
        for (int s8 = 0; s8 < 8; ++s8) { bf16x8 av[8], bv[8];
#pragma unroll
            for (int q = 0; q < 8; ++q) { av[q] = *(const bf16x8*)(ap + 16 * (8 * s8 + q)); bv[q] = *(const bf16x8*)(bp + 16 * (8 * s8 + q)); }
#pragma unroll
            for (int q = 0; q < 8; ++q) acc = __builtin_amdgcn_mfma_f32_32x32x16_bf16(av[q], bv[q], acc, 0, 0, 0); }
        if (r < 24) {
#pragma unroll
            for (int reg = 0; reg < 16; ++reg) { const int row = (reg & 3) + 8 * (reg >> 2) + 4 * hh; gates[(size_t)(rb * 32 + row) * 24 + r] = sigmoidf_(acc[reg]); }
        }
    }
}

namespace retf {
constexpr int ROWB = 272;
constexpr int OFF_K = 0, OFF_V = 128 * 256, OFF_ZV = OFF_V + 128 * 64, OFF_ST = OFF_ZV + 128 * 64, OFF_PART = OFF_ST + 32 * ROWB, OFF_Q = OFF_PART + 4 * 4096;
static_assert(OFF_Q + 128 * 256 <= RING_BYTES, "retention LDS map");
typedef short s16x4 __attribute__((ext_vector_type(4)));
__device__ __forceinline__ u32x2 lds_tr(const LAS unsigned char* p) { return __builtin_bit_cast(u32x2, __builtin_amdgcn_ds_read_tr16_b64_v4i16((LAS s16x4*)p)); }
}
__device__ __forceinline__ void p2_retention_fast(Frame& F, int unit, bf16* outbase) {
    using namespace retf;
    const int bh = (unit & 7) * 4 + (unit >> 6), sl = (unit >> 3) & 7, b = bh >> 2, h = bh & 3;
    const bf16* rq = (const bf16*)(F.ws + WS_RQ); const bf16* rk = (const bf16*)(F.ws + WS_RK); const bf16* rv = (const bf16*)(F.ws + WS_RV);
    const int tid = F.tid, lane = F.lane, wave = F.wave, r = lane & 31, hi = lane >> 5; LAS unsigned char* lds = F.lds;
    const float lg = log2f(1.0f - exp2f(-5.0f - (float)h));
    const int nt = wave & 3, mh = wave >> 2;
    for (int i = tid; i < 32 * ROWB / 4; i += NTHREADS) ((LAS unsigned*)(lds + OFF_ST))[i] = 0u;
    f32x16 ST;
#pragma unroll
    for (int j = 0; j < 16; ++j) ST[j] = 0.f;
    const float gC = exp2f(128.0f * lg);
    const float zeta = exp2f((float)(127 - (tid >> 2)) * lg);
    const int blk = (lane >> 4) & 1, q4 = (lane & 15) >> 2, p4 = lane & 3;
    const int vtr = (4 * hi + q4) * 64 + 32 * blk + 8 * p4;
    const int ztr = (8 * hi + q4) * 64 + 32 * blk + 8 * p4;
    int ktr[2];
#pragma unroll
    for (int t = 0; t < 2; ++t) ktr[t] = 256 * (8 * hi + 4 * t + q4) + 16 * ((4 * nt + 2 * blk + (p4 >> 1)) ^ ((q4 << 2) | ((2 * hi + t) & 3))) + 8 * (p4 & 1);
    const int krow = 256 * r + 16 * (hi ^ (((r & 3) << 2) | ((r >> 2) & 3)));
    u32x4 kreg[4], qreg[4], vreg;
    {   const int tok0 = b * SEQ;
#pragma unroll
        for (int i = 0; i < 4; ++i) { const int p = tid + 512 * i, m = p >> 4, cc = p & 15; kreg[i] = *(const u32x4*)(rk + (size_t)(tok0 + m) * 512 + h * 128 + cc * 8); qreg[i] = *(const u32x4*)(rq + (size_t)(tok0 + m) * 512 + h * 128 + cc * 8); }
        { const int m = tid >> 2, cc = tid & 3; vreg = *(const u32x4*)(rv + (size_t)(tok0 + m) * 1024 + h * 256 + sl * 32 + cc * 8); } }
    u32x2 opk[4]; bf16* oprev = outbase;
#pragma unroll
    for (int i = 0; i < 4; ++i) opk[i] = (u32x2){0u, 0u};
    for (int c = 0; c < SEQ / 128; ++c) {
        const int tok0 = b * SEQ + c * 128;
        __syncthreads();
#pragma unroll
        for (int i = 0; i < 4; ++i) { const int p = tid + 512 * i, m = p >> 4, cc = p & 15; const int o_ = 256 * m + 16 * (cc ^ (((m & 3) << 2) | ((m >> 2) & 3)));
            *(LAS u32x4*)(lds + OFF_K + o_) = kreg[i]; *(LAS u32x4*)(lds + OFF_Q + o_) = qreg[i]; }
        { const u32x4 v = vreg; u32x4 zv;
            zv.x = cvt_pk_bf16(lo16(v.x) * zeta, hi16(v.x) * zeta); zv.y = cvt_pk_bf16(lo16(v.y) * zeta, hi16(v.y) * zeta); zv.z = cvt_pk_bf16(lo16(v.z) * zeta, hi16(v.z) * zeta); zv.w = cvt_pk_bf16(lo16(v.w) * zeta, hi16(v.w) * zeta);
            *(LAS u32x4*)(lds + OFF_V + tid * 16) = v; *(LAS u32x4*)(lds + OFF_ZV + tid * 16) = zv; }
        __syncthreads();
        if (mh == 0 && c > 0) {
#pragma unroll
            for (int i = 0; i < 4; ++i) *(u32x2*)(oprev + 8 * i + 4 * hi) = opk[i]; }
        if (c + 1 < SEQ / 128) { const int tok1 = tok0 + 128;
#pragma unroll
            for (int i = 0; i < 4; ++i) { const int p = tid + 512 * i, m = p >> 4, cc = p & 15; kreg[i] = *(const u32x4*)(rk + (size_t)(tok1 + m) * 512 + h * 128 + cc * 8); qreg[i] = *(const u32x4*)(rq + (size_t)(tok1 + m) * 512 + h * 128 + cc * 8); }
            { const int m = tid >> 2, cc = tid & 3; vreg = *(const u32x4*)(rv + (size_t)(tok1 + m) * 1024 + h * 256 + sl * 32 + cc * 8); } }
        bf16x8 qf[8];
#pragma unroll
        for (int s_ = 0; s_ < 8; ++s_) qf[s_] = *(const LAS bf16x8*)(lds + OFF_Q + 8192 * nt + (krow ^ (32 * s_)));
        f32x16 CR;
#pragma unroll
        for (int j = 0; j < 16; ++j) CR[j] = 0.f;
        if (mh == 0) {
#pragma unroll
            for (int s_ = 0; s_ < 8; ++s_) { const bf16x8 a = *(const LAS bf16x8*)(lds + OFF_ST + r * ROWB + (16 * s_ + 8 * hi) * 2); CR = __builtin_amdgcn_mfma_f32_32x32x16_bf16(a, qf[s_], CR, 0, 0, 0); }
        }
        f32x16 IN_;
#pragma unroll
        for (int j = 0; j < 16; ++j) IN_[j] = 0.f;
#pragma unroll
        for (int mi = 0; mi < 2; ++mi) { const int mt = 2 * mh + mi;
            if (mt <= nt) {
                f32x16 A;
#pragma unroll
                for (int j = 0; j < 16; ++j) A[j] = 0.f;
#pragma unroll
                for (int s_ = 0; s_ < 8; ++s_) { const bf16x8 a = *(const LAS bf16x8*)(lds + OFF_K + 8192 * mt + (krow ^ (32 * s_))); A = __builtin_amdgcn_mfma_f32_32x32x16_bf16(a, qf[s_], A, 0, 0, 0); }
#pragma unroll
                for (int j = 0; j < 16; ++j) { const int dd = (32 * nt + r) - (32 * mt + (j & 3) + 8 * (j >> 2) + 4 * hi); A[j] = dd >= 0 ? A[j] * __builtin_amdgcn_exp2f((float)dd * lg) : 0.f; }
#pragma unroll
                for (int s2 = 0; s2 < 2; ++s2) { u32x4 w; w.x = cvt_pk_bf16(A[8 * s2 + 0], A[8 * s2 + 1]); w.y = cvt_pk_bf16(A[8 * s2 + 2], A[8 * s2 + 3]); w.z = cvt_pk_bf16(A[8 * s2 + 4], A[8 * s2 + 5]); w.w = cvt_pk_bf16(A[8 * s2 + 6], A[8 * s2 + 7]);
                    const LAS unsigned char* vp = lds + OFF_V + vtr + (32 * mt + 16 * s2) * 64; const u32x2 lo = lds_tr(vp), hi2 = lds_tr(vp + 8 * 64);
                    IN_ = __builtin_amdgcn_mfma_f32_32x32x16_bf16(__builtin_bit_cast(bf16x8, (u32x4){lo.x, lo.y, hi2.x, hi2.y}), __builtin_bit_cast(bf16x8, w), IN_, 0, 0, 0); }
            } }
        if (mh == 1) {
#pragma unroll
            for (int j = 0; j < 16; ++j) ((LAS float*)(lds + OFF_PART))[(nt * 16 + j) * 64 + lane] = IN_[j];
        }
        __syncthreads();
        if (mh == 0) {
            const float xi = __builtin_amdgcn_exp2f((float)(32 * nt + r + 1) * lg);
            bf16* orow = outbase + (size_t)(tok0 + 32 * nt + r) * 1024 + h * 256 + sl * 32;
#pragma unroll
            for (int q4_ = 0; q4_ < 4; ++q4_) { float o_[4];
#pragma unroll
                for (int e = 0; e < 4; ++e) { const int j = 4 * q4_ + e; o_[e] = IN_[j] + ((const LAS float*)(lds + OFF_PART))[(nt * 16 + j) * 64 + lane] + xi * CR[j]; }
                opk[q4_] = (u32x2){cvt_pk_bf16(o_[0], o_[1]), cvt_pk_bf16(o_[2], o_[3])}; }
            oprev = orow;
        } else {
#pragma unroll
            for (int j = 0; j < 16; ++j) ST[j] *= gC;
#pragma unroll
            for (int s_ = 0; s_ < 8; ++s_) {
                const LAS unsigned char* zp = lds + OFF_ZV + ztr + (16 * s_) * 64; const u32x2 z0 = lds_tr(zp), z1 = lds_tr(zp + 4 * 64);
                const u32x2 k0 = lds_tr(lds + OFF_K + ktr[0] + 4096 * s_), k1 = lds_tr(lds + OFF_K + ktr[1] + 4096 * s_);
                ST = __builtin_amdgcn_mfma_f32_32x32x16_bf16(__builtin_bit_cast(bf16x8, (u32x4){z0.x, z0.y, z1.x, z1.y}), __builtin_bit_cast(bf16x8, (u32x4){k0.x, k0.y, k1.x, k1.y}), ST, 0, 0, 0); }
#pragma unroll
            for (int j = 0; j < 16; ++j) { const int dv = (j & 3) + 8 * (j >> 2) + 4 * hi; ((LAS unsigned short*)(lds + OFF_ST))[dv * (ROWB / 2) + 32 * nt + r] = (unsigned short)f2bf(ST[j]); }
        }
    }
    if (mh == 0) {
#pragma unroll
        for (int i = 0; i < 4; ++i) *(u32x2*)(oprev + 8 * i + 4 * hi) = opk[i]; }
    __syncthreads();
}
__device__ __forceinline__ void transpose_kv_tiles(Frame& F, const bf16* src, bf16* dst, int w0, int nw) {
    LAS unsigned short* tl_ = (LAS unsigned short*)(F.lds + F.wave * 16384); const int lane = F.lane;
    for (int tile = w0; tile < 16 * 64 * 2; tile += nw) {
        const int dh = tile & 1, st = (tile >> 1) & 63, bg = tile >> 7;
        const bf16* sp = src + ((size_t)bg * SEQ + st * 64) * 128 + dh * 64; bf16* dp = dst + ((size_t)bg * 128 + dh * 64) * SEQ + st * 64;
#pragma unroll
        for (int i = 0; i < 8; ++i) { const int row = i * 8 + (lane >> 3), c = lane & 7; const u32x4 v = *(const u32x4*)(sp + (size_t)row * 128 + c * 8); LAS unsigned short* q = tl_ + row * 66 + c * 8;
            q[0] = (unsigned short)(v.x & 0xffffu); q[1] = (unsigned short)(v.x >> 16); q[2] = (unsigned short)(v.y & 0xffffu); q[3] = (unsigned short)(v.y >> 16);
            q[4] = (unsigned short)(v.z & 0xffffu); q[5] = (unsigned short)(v.z >> 16); q[6] = (unsigned short)(v.w & 0xffffu); q[7] = (unsigned short)(v.w >> 16); }
        LDS_WAIT(); asm volatile("" ::: "memory");
#pragma unroll
        for (int i = 0; i < 8; ++i) { const int d = i * 8 + (lane >> 3), c = lane & 7; const LAS unsigned short* q = tl_ + (c * 8) * 66 + d;
            u32x4 o; o.x = (unsigned)q[0] | ((unsigned)q[66] << 16); o.y = (unsigned)q[2 * 66] | ((unsigned)q[3 * 66] << 16); o.z = (unsigned)q[4 * 66] | ((unsigned)q[5 * 66] << 16); o.w = (unsigned)q[6 * 66] | ((unsigned)q[7 * 66] << 16);
            *(u32x4*)(dp + (size_t)d * SEQ + c * 8) = o; }
        LDS_WAIT(); asm volatile("" ::: "memory");
    }
}
struct SchedCmp {
    unsigned char* ws; int first, G, c;
    __device__ __forceinline__ bool next(int i, GU& u) const {
        const int L = i * G + c - first; if (L < 0 || L >= 256) return false;
        const int ks = L & 7, mb = L >> 3, m = mb >> 4, bg = mb & 15;
        u.A = (const char*)ws + WS_KV6 + (size_t)m * KV_STRIDE + (size_t)bg * SEQ * 128 * 2 + (size_t)ks * 512 * 2; u.B = (const char*)ws + (m ? W_C1V : W_C1K) + (size_t)ks * 512 * 2;
        u.pm = mb; u.pn = 0; u.kind = ks; u.rows = nullptr; u.nvalid = 0; u.aux = 0; return true;
    }
};
struct EpiCmp {
    static constexpr bool PERM = false;
    float* hid;
    __device__ __forceinline__ void operator()(const f32x4 (&acc)[2][2][4][2], const GU& u, int wr, int wc, int fr, int fq) const {
#pragma unroll
        for (int ai = 0; ai < 2; ++ai)
#pragma unroll
            for (int m = 0; m < 4; ++m) { const int r = 128 * ai + 64 * wr + 16 * m + fr; float* rowp = hid + (size_t)u.kind * (32 * 256 * 128) + ((size_t)u.pm * 256 + r) * 128 + 32 * wc + 4 * fq;
#pragma unroll
                for (int n = 0; n < 2; ++n) *(f32x4*)(rowp + 16 * n) = acc[ai][0][m][n]; }
    }
};
__device__ __forceinline__ float gelu_tanh(float x) { const float u = 0.7978845608028654f * (x + 0.044715f * x * x * x); return 0.5f * x * (1.0f + tanhf(u)); }
__device__ __forceinline__ void p2b_compress_out(Frame& F, const Args& a) {
    const float* hid = (const float*)a.out + (size_t)16 * MiB; const float* cbias = (const float*)(F.ws + WS_SMALLW + 65536 + 2 * 128 * 128 * 2);
    const int gw = F.bx * NWAVES + F.wave, NGW = F.G * NWAVES;
    for (int row = gw; row < 2 * 16 * 256; row += NGW) {
        const int m = row >> 12, n = row & 255; const float* w2 = a.in[m ? IN_CMP_W2_V : IN_CMP_W2_K];
        bf16* dst = (bf16*)(F.ws + (m ? WS_VCMP : WS_KCMP)) + (size_t)(row & 4095) * 128;
        float o0 = 0.f, o1 = 0.f;
        if (n < 255) { const float* hr = hid + (size_t)row * 128;
            for (int e = 0; e < 128; ++e) { float hsum = 0.f;
#pragma unroll
                for (int ks = 0; ks < 8; ++ks) hsum += hr[(size_t)ks * (32 * 256 * 128) + e];
                const float g = gelu_tanh(hsum + cbias[m * 128 + e]); o0 += g * w2[e * 128 + F.lane]; o1 += g * w2[e * 128 + 64 + F.lane]; } }
        dst[F.lane] = (bf16)f2bf(o0); dst[64 + F.lane] = (bf16)f2bf(o1);
        if (m == 1) { bf16* dt = (bf16*)(F.ws + WS_VCMPT) + (size_t)((row >> 8) & 15) * 128 * 256 + n; dt[(size_t)F.lane * 256] = (bf16)f2bf(o0); dt[(size_t)(64 + F.lane) * 256] = (bf16)f2bf(o1); }
    }
}

__device__ __forceinline__ void p3_ret_normalize(Frame& F) {
    bf16* rv = (bf16*)(F.ws + WS_RV); const bf16* rg = (const bf16*)(F.ws + WS_RG);
    const int gw = F.bx * NWAVES + F.wave, NGW = F.G * NWAVES;
    for (int it = gw; it < NTOK * 4; it += NGW) {
        u32x2* p = (u32x2*)(rv + (size_t)it * 256) + F.lane; const u32x2 w = *p; const u32x2 gq = *((const u32x2*)(rg + (size_t)it * 256) + F.lane);
        const float o0 = lo16(w.x), o1 = hi16(w.x), o2 = lo16(w.y), o3 = hi16(w.y);
        const float ss = wave_sum((o0 * o0 + o1 * o1) + (o2 * o2 + o3 * o3));
        const float r = 1.0f / sqrtf(ss * (1.0f / 256.0f) + EPS);
        u32x2 q; q.x = pk2(o0 * r * lo16(gq.x), o1 * r * hi16(gq.x)); q.y = pk2(o2 * r * lo16(gq.y), o3 * r * hi16(gq.y)); *p = q;
    }
}
namespace nsaf {
constexpr int KROW = 272, VROW = 136, KT_BYTES = 64 * KROW, VT_BYTES = 128 * VROW;
constexpr int OFF_K = 0, OFF_V = KT_BYTES, BUF_BYTES = KT_BYTES + VT_BYTES, OFF_IMP = 2 * BUF_BYTES, OFF_MASK = OFF_IMP + 64 * 64 * 4;
constexpr float NEG = -1.0e30f, MASKED = -3.0e38f, CS = 0.08838834764831845f * 1.4426950408889634f;
struct Stage { u32x4 k0, k1, v0, v1; };
__device__ __forceinline__ void stage_load(Stage& st, const bf16* K, const bf16* VT, size_t vpitch, int key0, int tid) {
    const int r0 = tid >> 4, c0 = tid & 15;
    st.k0 = *(const u32x4*)(K + (size_t)(key0 + r0) * 128 + c0 * 8); st.k1 = *(const u32x4*)(K + (size_t)(key0 + r0 + 32) * 128 + c0 * 8);
    const int d0 = tid >> 3, c1 = tid & 7;
    st.v0 = *(const u32x4*)(VT + (size_t)d0 * vpitch + key0 + c1 * 8); st.v1 = *(const u32x4*)(VT + (size_t)(d0 + 64) * vpitch + key0 + c1 * 8);
}
__device__ __forceinline__ void stage_write(const Stage& st, LAS unsigned char* lds, int tid) {
    const int r0 = tid >> 4, c0 = tid & 15;
    *(LAS u32x4*)(lds + OFF_K + r0 * KROW + c0 * 16) = st.k0; *(LAS u32x4*)(lds + OFF_K + (r0 + 32) * KROW + c0 * 16) = st.k1;
    const int d0 = tid >> 3, c1 = tid & 7;
    LAS unsigned char* p0 = lds + OFF_V + d0 * VROW + c1 * 16; LAS unsigned char* p1 = lds + OFF_V + (d0 + 64) * VROW + c1 * 16;
    *(LAS u32x2*)p0 = (u32x2){st.v0.x, st.v0.y}; *(LAS u32x2*)(p0 + 8) = (u32x2){st.v0.z, st.v0.w};
    *(LAS u32x2*)p1 = (u32x2){st.v1.x, st.v1.y}; *(LAS u32x2*)(p1 + 8) = (u32x2){st.v1.z, st.v1.w};
}
template <int MODE>
__device__ __forceinline__ void block_step(const LAS unsigned char* lds, LAS unsigned char* ldstab, const bf16x8 (&qf)[8], f32x16 (&O)[4], float& m, float& l, int blk, int jfast, int tl_in, int itile, int nvr_in, bool rowsel, float inv_l, int lane_in) {
    int tl = tl_in, nvr = nvr_in, lane = lane_in; LAUNDER(tl); LAUNDER(nvr); LAUNDER(lane);
    const int r = lane & 31, hi = lane >> 5;
    f32x16 S[2];
#pragma unroll
    for (int kh = 0; kh < 2; ++kh) {
#pragma unroll
        for (int j = 0; j < 16; ++j) S[kh][j] = 0.f;
    }
    {
        const unsigned kaddr = (unsigned)(size_t)(lds + OFF_K + r * KROW + 16 * hi);
        u32x4 ka[4], kb[4];
#define NSAF_KRD(dst, t, s4) asm volatile("ds_read_b128 %0, %1 offset:%2" : "=v"(dst) : "v"(kaddr), "i"((t) * 32 * KROW + (s4) * 32))
#define NSAF_KRD4(set, t, s0) do { NSAF_KRD(set[0], t, (s0)); NSAF_KRD(set[1], t, (s0) + 1); NSAF_KRD(set[2], t, (s0) + 2); NSAF_KRD(set[3], t, (s0) + 3); } while (0)
#define NSAF_KWAIT(n, set) asm volatile("s_waitcnt lgkmcnt(" #n ")" : "+v"(set[0]), "+v"(set[1]), "+v"(set[2]), "+v"(set[3]))
#define NSAF_KMMA(set, t, s0) do { _Pragma("unroll") for (int q_ = 0; q_ < 4; ++q_) S[t] = __builtin_amdgcn_mfma_f32_32x32x16_bf16(__builtin_bit_cast(bf16x8, set[q_]), qf[(s0) + q_], S[t], 0, 0, 0); } while (0)
        NSAF_KRD4(ka, 0, 0); NSAF_KRD4(kb, 0, 4);
        NSAF_KWAIT(4, ka); NSAF_KMMA(ka, 0, 0); NSAF_KRD4(ka, 1, 0);
        NSAF_KWAIT(4, kb); NSAF_KMMA(kb, 0, 4); NSAF_KRD4(kb, 1, 4);
        NSAF_KWAIT(4, ka); NSAF_KMMA(ka, 1, 0);
        NSAF_KWAIT(0, kb); NSAF_KMMA(kb, 1, 4);
#undef NSAF_KRD
#undef NSAF_KRD4
#undef NSAF_KWAIT
#undef NSAF_KMMA
    }
    bool need_mask;
    if (MODE <= 1) need_mask = true; else if (MODE == 2) need_mask = (blk == itile); else need_mask = (blk == itile) || (blk == itile - 8);
    if (MODE >= 2 && !need_mask && blk >= jfast) {
        const float msub = (MODE == 2 && !rowsel) ? 3.0e38f : m;
        float rs = 0.f;
#pragma unroll
        for (int kh = 0; kh < 2; ++kh)
#pragma unroll
            for (int j = 0; j < 16; ++j) { const float p = __builtin_amdgcn_exp2f(S[kh][j] - msub); S[kh][j] = p; rs += p; }
        l += rs;
    } else {
    float mx = MASKED;
    if (need_mask) {
        int lo_ = -1, hi_ = 63;
        if (MODE <= 1) hi_ = nvr - 64 * blk - 1; else if (MODE == 2) hi_ = tl; else { hi_ = (blk == itile) ? tl : 63; lo_ = (blk == itile - 8) ? tl : -1; }
        lo_ -= 4 * hi; hi_ -= 4 * hi;
#pragma unroll
        for (int kh = 0; kh < 2; ++kh)
#pragma unroll
            for (int j = 0; j < 16; ++j) { const int kc_ = 32 * kh + (j & 3) + 8 * (j >> 2); const bool ok = (kc_ > lo_) & (kc_ <= hi_); const float v = ok ? S[kh][j] : MASKED; S[kh][j] = v; mx = fmaxf(mx, v); }
    } else {
#pragma unroll
        for (int kh = 0; kh < 2; ++kh)
#pragma unroll
            for (int j = 0; j < 16; ++j) mx = fmaxf(mx, S[kh][j]);
    }
    if (MODE == 2) mx = rowsel ? mx : MASKED;
    if (MODE == 1) {
        LAS float* imp = (LAS float*)(ldstab + OFF_IMP) + tl * 64;
        const bool adder = (lane & 3) == 0;
#pragma unroll
        for (int kh = 0; kh < 2; ++kh)
#pragma unroll
            for (int q = 0; q < 4; ++q) {
                float p4[4];
#pragma unroll
                for (int e = 0; e < 4; ++e) { const float p = __builtin_amdgcn_exp2f(S[kh][4 * q + e] - m) * inv_l; S[kh][4 * q + e] = p; p4[e] = p; }
                float sb = (p4[0] + p4[1]) + (p4[2] + p4[3]), sn = p4[3];
                sb += DPP_F(sb, 0xB1, 0xf); sn += DPP_F(sn, 0xB1, 0xf);
                sb += DPP_F(sb, 0x4E, 0xf); sn += DPP_F(sn, 0x4E, 0xf);
                const int bin = 16 * blk + 8 * kh + 2 * q + hi;
                if (adder) { __hip_atomic_fetch_add(imp + bin, sb, __ATOMIC_RELAXED, __HIP_MEMORY_SCOPE_WORKGROUP); if (bin + 1 < 64) __hip_atomic_fetch_add(imp + bin + 1, sn, __ATOMIC_RELAXED, __HIP_MEMORY_SCOPE_WORKGROUP); }
            }
    } else {
        mx = fmaxf(mx, __shfl_xor(mx, 32));
        if (__any(mx > m + 8.0f)) { const float mn = fmaxf(m, mx); const float alpha = __builtin_amdgcn_exp2f(m - mn); m = mn; l *= alpha;
            if (MODE != 0) {
#pragma unroll
                for (int dt = 0; dt < 4; ++dt)
#pragma unroll
                    for (int j = 0; j < 16; ++j) O[dt][j] *= alpha; } }
        float rs = 0.f;
        if (MODE == 2) {
#pragma unroll
            for (int kh = 0; kh < 2; ++kh)
#pragma unroll
                for (int j = 0; j < 16; ++j) { const float p = rowsel ? __builtin_amdgcn_exp2f(S[kh][j] - m) : 0.f; S[kh][j] = p; rs += p; }
        } else {
#pragma unroll
            for (int kh = 0; kh < 2; ++kh)
#pragma unroll
                for (int j = 0; j < 16; ++j) { const float p = __builtin_amdgcn_exp2f(S[kh][j] - m); S[kh][j] = p; rs += p; }
        }
        l += rs;
        if (MODE == 0) return;
    }
    }
    bf16x8 pf[2][2];
#pragma unroll
    for (int kh = 0; kh < 2; ++kh)
#pragma unroll
        for (int s2 = 0; s2 < 2; ++s2) { u32x4 w; w.x = cvt_pk_bf16(S[kh][8 * s2 + 0], S[kh][8 * s2 + 1]); w.y = cvt_pk_bf16(S[kh][8 * s2 + 2], S[kh][8 * s2 + 3]); w.z = cvt_pk_bf16(S[kh][8 * s2 + 4], S[kh][8 * s2 + 5]); w.w = cvt_pk_bf16(S[kh][8 * s2 + 6], S[kh][8 * s2 + 7]);
            pf[kh][s2] = __builtin_bit_cast(bf16x8, w); }
    {
        const unsigned vaddr = (unsigned)(size_t)(lds + OFF_V + r * VROW + 8 * hi);
        u32x2 va[8], vb[8];
#define NSAF_VRD(dst, dt, i) asm volatile("ds_read_b64 %0, %1 offset:%2" : "=v"(dst) : "v"(vaddr), "i"((dt) * 32 * VROW + ((i) >> 1) * 32 + ((i) & 1) * 16))
#define NSAF_VRD8(set, dt) do { NSAF_VRD(set[0], dt, 0); NSAF_VRD(set[1], dt, 1); NSAF_VRD(set[2], dt, 2); NSAF_VRD(set[3], dt, 3); NSAF_VRD(set[4], dt, 4); NSAF_VRD(set[5], dt, 5); NSAF_VRD(set[6], dt, 6); NSAF_VRD(set[7], dt, 7); } while (0)
#define NSAF_VWAIT(n, set) asm volatile("s_waitcnt lgkmcnt(" #n ")" : "+v"(set[0]), "+v"(set[1]), "+v"(set[2]), "+v"(set[3]), "+v"(set[4]), "+v"(set[5]), "+v"(set[6]), "+v"(set[7]))
#define NSAF_VMMA(set, dt) do { _Pragma("unroll") for (int ks = 0; ks < 4; ++ks) { const u32x4 a_ = (u32x4){set[2 * ks].x, set[2 * ks].y, set[2 * ks + 1].x, set[2 * ks + 1].y}; \
            O[dt] = __builtin_amdgcn_mfma_f32_32x32x16_bf16(__builtin_bit_cast(bf16x8, a_), pf[ks >> 1][ks & 1], O[dt], 0, 0, 0); } } while (0)
        NSAF_VRD8(va, 0); NSAF_VRD8(vb, 1);
        NSAF_VWAIT(8, va); NSAF_VMMA(va, 0); NSAF_VRD8(va, 2);
        NSAF_VWAIT(8, vb); NSAF_VMMA(vb, 1); NSAF_VRD8(vb, 3);
        NSAF_VWAIT(8, va); NSAF_VMMA(va, 2);
        NSAF_VWAIT(0, vb); NSAF_VMMA(vb, 3);
#undef NSAF_VRD
#undef NSAF_VRD8
#undef NSAF_VWAIT
#undef NSAF_VMMA
    }
}
template <int MODE>
__device__ __forceinline__ void run_pass(LAS unsigned char* lds, const bf16* K, const bf16* VT, size_t vpitch, int jb, int je, const bf16x8 (&qf)[8], f32x16 (&O)[4], float& m, float& l, bool allowfast, int tl, int itile, int nvr, unsigned long long selmask, float inv_l, int tid, int lane) {
    Stage st; stage_load(st, K, VT, vpitch, jb * 64, tid); stage_write(st, lds, tid);
    if (jb < je) stage_load(st, K, VT, vpitch, (jb + 1) * 64, tid);
    __syncthreads();
    for (int j = jb; j <= je; ++j) {
        const int cur = (j - jb) & 1;
        if (j < je) { stage_write(st, lds + (cur ^ 1) * BUF_BYTES, tid); if (j + 1 < je) stage_load(st, K, VT, vpitch, (j + 2) * 64, tid); }
        const bool rowsel = (MODE == 2) ? (((selmask >> j) & 1ull) != 0ull) : true;
        if (MODE != 2 || __ballot(rowsel) != 0ull) block_step<MODE>(lds + cur * BUF_BYTES, lds, qf, O, m, l, j, allowfast ? jb + (MODE == 2 ? 1 : 2) : 0x7fffffff, tl, itile, nvr, rowsel, inv_l, lane);
        __syncthreads();
    }
}
}
__device__ __forceinline__ void p3_nsa_fast(Frame& F, const bf16* svT, const bf16* wvT, bf16* outbase) {
    using namespace nsaf;
    unsigned char* ws = F.ws; const int tid = F.tid, lane = F.lane, wave = F.wave; LAS unsigned char* lds = F.lds;
    bf16* nq = (bf16*)(ws + WS_NQ); const float* gates = (const float*)(ws + WS_GATES);
    const int r = lane & 31, hi = lane >> 5, qrow = wave * 32 + r, tl = qrow >> 2, head = qrow & 3;
    unsigned failmask = 0u;
    for (int trip = 0; trip < 2; ++trip) {
    for (int u4 = 0; u4 < 4; ++u4) {
        if (trip == 1 && ((failmask >> u4) & 1u) == 0u) continue;
        const bool allowfast = trip == 0;
        const int pr = (F.bx & 7) * 32 + (F.bx >> 3) + (u4 >> 1) * 256; if (F.bx >= 256) break;
        const int bg = pr >> 5, ii = pr & 31, itile = (u4 & 1) ? (63 - ii) : ii, g = bg & 1, b = bg >> 1;
        const int tok = b * SEQ + itile * 64 + tl, t = itile * 64 + tl;
        const bf16* kc = (const bf16*)(ws + WS_KCMP) + (size_t)bg * 256 * 128; const bf16* vcT = (const bf16*)(ws + WS_VCMPT) + (size_t)bg * 128 * 256;
        const bf16* ks = (const bf16*)(ws + WS_KV6 + 2 * KV_STRIDE) + (size_t)bg * SEQ * 128; const bf16* kw = (const bf16*)(ws + WS_KV6 + 4 * KV_STRIDE) + (size_t)bg * SEQ * 128;
        const bf16* vsT = svT + (size_t)bg * 128 * SEQ; const bf16* vwT = wvT + (size_t)bg * 128 * SEQ;
        __syncthreads();
        for (int i = tid; i < 64 * 64; i += NTHREADS) ((LAS float*)(lds + OFF_IMP))[i] = 0.f;
        bf16x8 qf[8];
        {
            LAS unsigned char* tb_ = lds + wave * 8704;
#pragma unroll
            for (int k_ = 0; k_ < 8; ++k_) { const int rr_ = 4 * k_ + (lane >> 4), ch_ = lane & 15, qr_ = wave * 32 + rr_;
                *(LAS u32x4*)(tb_ + rr_ * 272 + ch_ * 16) = *(const u32x4*)(nq + (size_t)(b * SEQ + itile * 64 + (qr_ >> 2)) * 1024 + g * 512 + (qr_ & 3) * 128 + ch_ * 8); }
            LDS_WAIT(); asm volatile("" ::: "memory");
#pragma unroll
            for (int s_ = 0; s_ < 8; ++s_) { const u32x4 w_ = *(const LAS u32x4*)(tb_ + r * 272 + (16 * s_ + 8 * hi) * 2);
                u32x4 o_; o_.x = cvt_pk_bf16(lo16(w_.x) * CS, hi16(w_.x) * CS); o_.y = cvt_pk_bf16(lo16(w_.y) * CS, hi16(w_.y) * CS); o_.z = cvt_pk_bf16(lo16(w_.z) * CS, hi16(w_.z) * CS); o_.w = cvt_pk_bf16(lo16(w_.w) * CS, hi16(w_.w) * CS);
                qf[s_] = __builtin_bit_cast(bf16x8, o_); }
            __syncthreads();
        }
        const float* gatep = gates + (size_t)tok * 24 + (g * 4 + head) * 3;
        const int nvr = (t >= 31) ? (((t - 31) >> 4) + 1 > 255 ? 255 : ((t - 31) >> 4) + 1) : 0;
        const int jec = ((4 * itile + 2) >> 6) > 3 ? 3 : ((4 * itile + 2) >> 6);
        f32x16 O[4];
#define NSAF_ZERO_O() do { _Pragma("unroll") for (int dt = 0; dt < 4; ++dt) _Pragma("unroll") for (int j = 0; j < 16; ++j) O[dt][j] = 0.f; } while (0)
#define NSAF_ADD2(a_, b_) cvt_pk_bf16(lo16(a_) + lo16(b_), hi16(a_) + hi16(b_))
#define NSAF_ACCUM(coef, FIRST) do { const float cf_ = (coef); LAS unsigned char* tb_ = lds + wave * 8704; \
        _Pragma("unroll") for (int dt = 0; dt < 4; ++dt) { _Pragma("unroll") for (int q4 = 0; q4 < 4; ++q4) \
            *(LAS u32x2*)(tb_ + r * 272 + (32 * dt + 8 * q4 + 4 * hi) * 2) = (u32x2){cvt_pk_bf16(cf_ * O[dt][4 * q4], cf_ * O[dt][4 * q4 + 1]), cvt_pk_bf16(cf_ * O[dt][4 * q4 + 2], cf_ * O[dt][4 * q4 + 3])}; } \
        LDS_WAIT(); asm volatile("" ::: "memory"); \
        _Pragma("unroll 2") for (int k_ = 0; k_ < 8; ++k_) { const int rr_ = 4 * k_ + (lane >> 4), ch_ = lane & 15, qr_ = wave * 32 + rr_; \
            const u32x4 nv_ = *(const LAS u32x4*)(tb_ + rr_ * 272 + ch_ * 16); \
            u32x4* gp_ = (u32x4*)(outbase + (size_t)(b * SEQ + itile * 64 + (qr_ >> 2)) * 1024 + g * 512 + (qr_ & 3) * 128 + ch_ * 8); \
            u32x4 w_ = nv_; if (!(FIRST)) { const u32x4 ov_ = *gp_; w_.x = NSAF_ADD2(nv_.x, ov_.x); w_.y = NSAF_ADD2(nv_.y, ov_.y); w_.z = NSAF_ADD2(nv_.z, ov_.z); w_.w = NSAF_ADD2(nv_.w, ov_.w); } \
            *gp_ = w_; } \
        asm volatile("" ::: "memory"); } while (0)
        float m = NEG, l = 0.f; NSAF_ZERO_O();
        run_pass<0>(lds, kc, vcT, 256, 0, jec, qf, O, m, l, false, tl, itile, nvr, 0ull, 0.f, tid, lane);
        l += __shfl_xor(l, 32); const float invl = l > 0.f ? 1.0f / l : 0.f;
        run_pass<1>(lds, kc, vcT, 256, 0, jec, qf, O, m, l, false, tl, itile, nvr, 0ull, invl, tid, lane);
        NSAF_ACCUM(gatep[0], true);
        __syncthreads();
        for (int tk = 0; tk < 8; ++tk) { const int tokl = wave * 8 + tk; float v = ((const LAS float*)(lds + OFF_IMP))[tokl * 64 + lane];
            const bool forced = (lane == 0) || (lane == itile) || (lane == itile - 1); v = (lane > itile) ? -1.0e4f : (forced ? 1.0e4f : v);
            int rank = 0;
#pragma unroll 16
            for (int i = 0; i < 64; ++i) { const float w = __builtin_bit_cast(float, __builtin_amdgcn_readlane(__builtin_bit_cast(int, v), i)); rank += (w > v || (w == v && i < lane)) ? 1 : 0; }
            const unsigned long long mk = __ballot(rank < 16);
            if (lane == 0) { ((LAS unsigned*)(lds + OFF_MASK))[tokl * 2] = (unsigned)mk; ((LAS unsigned*)(lds + OFF_MASK))[tokl * 2 + 1] = (unsigned)(mk >> 32); } }
        __syncthreads();
        const unsigned long long selmask = (unsigned long long)((const LAS unsigned*)(lds + OFF_MASK))[tl * 2] | ((unsigned long long)((const LAS unsigned*)(lds + OFF_MASK))[tl * 2 + 1] << 32);
        m = NEG; l = 0.f; NSAF_ZERO_O();
        run_pass<2>(lds, ks, vsT, SEQ, 0, itile, qf, O, m, l, allowfast, tl, itile, 0, selmask, 0.f, tid, lane);
        l += __shfl_xor(l, 32); bool bad = !(l < 1.0e12f);
        NSAF_ACCUM(l > 0.f ? gatep[1] / l : 0.f, false);
        __syncthreads();
        m = NEG; l = 0.f; NSAF_ZERO_O();
        run_pass<3>(lds, kw, vwT, SEQ, itile > 8 ? itile - 8 : 0, itile, qf, O, m, l, allowfast, tl, itile, 0, 0ull, 0.f, tid, lane);
        l += __shfl_xor(l, 32); bad = bad | !(l < 1.0e12f);
        NSAF_ACCUM(l > 0.f ? gatep[2] / l : 0.f, false);
        if (allowfast && __syncthreads_or(bad ? 1 : 0)) failmask |= 1u << u4;
#undef NSAF_ZERO_O
#undef NSAF_ACCUM
#undef NSAF_ADD2
    }
    if (failmask == 0u) break;
    }
    __syncthreads();
}
struct SchedP4 {
    unsigned char* ws; int G, c; const char* nsa;
    __device__ __forceinline__ bool next(int i, GU& u) const {
        const int ti = i >> 2, sub = i & 3; const int L = ti * G + c; if (L >= 128 * 4) return false;
        int pm, pn; pg8::tile_map(L, 128, 4, pm, pn);
        const size_t ao = sub == 1 ? WS_RV : sub == 3 ? WS_NQ : WS_H; const size_t bo = sub == 0 ? W_GA : sub == 1 ? W_RO : sub == 2 ? W_GB : W_NO;
        u.A = (sub == 3 ? nsa : (const char*)ws + ao) + (size_t)pm * 256 * D * 2; u.B = (const char*)ws + bo + (size_t)pn * 256 * D * 2; u.pm = pm; u.pn = pn; u.kind = sub; u.rows = nullptr; u.nvalid = 0; u.aux = 0; return true;
    }
};
struct EpiP4 {
    static constexpr bool PERM = true;
    float* scr;
    bf16* Y;
    static __device__ __forceinline__ u32x2 pk4(const f32x4 v) { return (u32x2){cvt_pk_bf16(v[0], v[1]), cvt_pk_bf16(v[2], v[3])}; }
    static __device__ __forceinline__ f32x4 up4(const u32x2 w) { return (f32x4){lo16(w.x), hi16(w.x), lo16(w.y), hi16(w.y)}; }
    __device__ __forceinline__ void operator()(const f32x4 (&acc)[2][2][4][2], const GU& u, int wr, int wc, int fr, int fq) const {
        u32x2* p0 = (u32x2*)scr + threadIdx.x; u32x2* p1 = p0 + 32 * 512;
        if (u.kind == 0 || u.kind == 2) {
            u32x2* p = u.kind == 0 ? p0 : p1;
#pragma unroll
            for (int ai = 0; ai < 2; ++ai)
#pragma unroll
                for (int m = 0; m < 4; ++m) {
#pragma unroll
                    for (int bj = 0; bj < 2; ++bj) { f32x4 v0 = acc[ai][bj][m][0], v1 = acc[ai][bj][m][1];
#pragma unroll
                        for (int j = 0; j < 4; ++j) { v0[j] = sigmoidf_(v0[j]); v1[j] = sigmoidf_(v1[j]); }
                        p[(2 * bj) * 512] = pk4(v0); p[(2 * bj + 1) * 512] = pk4(v1); }
                    p += 4 * 512; LAUNDER(p); }
        } else if (u.kind == 1) {
#pragma unroll
            for (int ai = 0; ai < 2; ++ai)
#pragma unroll
                for (int m = 0; m < 4; ++m) {
#pragma unroll
                    for (int bj = 0; bj < 2; ++bj) { p0[(2 * bj) * 512] = pk4(up4(p0[(2 * bj) * 512]) * acc[ai][bj][m][0]); p0[(2 * bj + 1) * 512] = pk4(up4(p0[(2 * bj + 1) * 512]) * acc[ai][bj][m][1]); }
                    p0 += 4 * 512; LAUNDER(p0); }
        } else {
            bf16* yb = Y + (size_t)(u.pm * 256 + 64 * wr + fr) * D + u.pn * 256 + 32 * wc + 8 * fq;
#pragma unroll
            for (int ai = 0; ai < 2; ++ai)
#pragma unroll
                for (int m = 0; m < 4; ++m) {
#pragma unroll
                    for (int bj = 0; bj < 2; ++bj) {
                        const f32x4 v0 = up4(p0[(2 * bj) * 512]) + up4(p1[(2 * bj) * 512]) * acc[ai][bj][m][0], v1 = up4(p0[(2 * bj + 1) * 512]) + up4(p1[(2 * bj + 1) * 512]) * acc[ai][bj][m][1];
                        u32x4 w; w.x = cvt_pk_bf16(v0[0], v0[1]); w.y = cvt_pk_bf16(v0[2], v0[3]); w.z = cvt_pk_bf16(v1[0], v1[1]); w.w = cvt_pk_bf16(v1[2], v1[3]);
                        *(u32x4*)(yb + (size_t)(128 * ai + 16 * m) * D + 128 * bj) = w; }
                    p0 += 4 * 512; p1 += 4 * 512; LAUNDER(p0); LAUNDER(p1); }
        }
    }
};

struct SchedMN {
    unsigned char* ws; size_t ao, bo; int G, c;
    __device__ __forceinline__ bool next(int i, GU& u) const {
        const int L = i * G + c; if (L >= 128 * 4) return false; int pm, pn; pg8::tile_map(L, 128, 4, pm, pn);
        u.A = (const char*)ws + ao + (size_t)pm * 256 * D * 2; u.B = (const char*)ws + bo + (size_t)pn * 256 * D * 2; u.pm = pm; u.pn = pn; u.kind = 0; u.rows = nullptr; u.nvalid = 0; u.aux = 0; return true;
    }
};
template <bool SSQ> struct EpiRes {
    static constexpr bool PERM = false;
    const float* basef; const bf16* baseb; float* out; bf16* ob; float* ssq;
    __device__ __forceinline__ void operator()(const f32x4 (&acc)[2][2][4][2], const GU& u, int wr, int wc, int fr, int fq) const {
#pragma unroll
        for (int ai = 0; ai < 2; ++ai)
#pragma unroll
            for (int m = 0; m < 4; ++m) { const int r = u.pm * 256 + 128 * ai + 64 * wr + 16 * m + fr; const size_t off = (size_t)r * D + u.pn * 256 + 32 * wc + 4 * fq; float sq = 0.f;
#pragma unroll
                for (int bj = 0; bj < 2; ++bj)
#pragma unroll
                    for (int n = 0; n < 2; ++n) { const size_t o = off + 128 * bj + 16 * n; f32x4 bv;
                        if (SSQ) bv = *(const f32x4*)(basef + o); else { const u32x2 bw = *(const u32x2*)(baseb + o); bv = (f32x4){lo16(bw.x), hi16(bw.x), lo16(bw.y), hi16(bw.y)}; }
                        const f32x4 v = bv + acc[ai][bj][m][n];
                        if (!SSQ) *(f32x4*)(out + o) = v;
                        u32x2 w; w.x = cvt_pk_bf16(v[0], v[1]); w.y = cvt_pk_bf16(v[2], v[3]); *(u32x2*)(ob + o) = w; sq += (v[0] * v[0] + v[1] * v[1]) + (v[2] * v[2] + v[3] * v[3]); }
                if (SSQ) { sq += __shfl_xor(sq, 16); sq += __shfl_xor(sq, 32); if (fq == 0) ssq[(size_t)r * 16 + u.pn * 4 + wc] = sq; }
            }
    }
};
struct EpiQ {
    static constexpr bool PERM = true;
    const float* ssq; bf16* Q;
    __device__ __forceinline__ void operator()(const f32x4 (&acc)[2][2][4][2], const GU& u, int wr, int wc, int fr, int fq) const {
#pragma unroll
        for (int ai = 0; ai < 2; ++ai)
#pragma unroll
            for (int m = 0; m < 4; ++m) { const int r = u.pm * 256 + 128 * ai + 64 * wr + 16 * m + fr; const f32x4* sp = (const f32x4*)(ssq + (size_t)r * 16);
                const f32x4 a = sp[0], b = sp[1], c = sp[2], d = sp[3]; const float tot = ((a[0] + a[1]) + (a[2] + a[3])) + ((b[0] + b[1]) + (b[2] + b[3])) + ((c[0] + c[1]) + (c[2] + c[3])) + ((d[0] + d[1]) + (d[2] + d[3]));
                const float rstd = 1.0f / sqrtf(tot * (1.0f / D) + EPS);
#pragma unroll
                for (int bj = 0; bj < 2; ++bj) { const f32x4 v0 = acc[ai][bj][m][0] * rstd, v1 = acc[ai][bj][m][1] * rstd;
                    u32x4 w; w.x = cvt_pk_bf16(v0[0], v0[1]); w.y = cvt_pk_bf16(v0[2], v0[3]); w.z = cvt_pk_bf16(v1[0], v1[1]); w.w = cvt_pk_bf16(v1[2], v1[3]);
                    *(u32x4*)(Q + (size_t)r * D + u.pn * 256 + 128 * bj + 32 * wc + 8 * fq) = w; } }
    }
};

namespace xatf {
constexpr int KROW = 528, VROW = 136, KT_BYTES = 64 * KROW, OFF_K = 0, OFF_V = KT_BYTES;
constexpr float NEG = -1.0e30f, CS = 0.0625f * 1.4426950408889634f;
struct Stage { u32x4 k[4]; u32x4 v[2]; };
__device__ __forceinline__ void stage_load(Stage& st, const bf16* K, const bf16* VT, int key0, int tid) {
#pragma unroll
    for (int i = 0; i < 4; ++i) { const int p = tid + 512 * i, row = p >> 5, c = p & 31; st.k[i] = *(const u32x4*)(K + (size_t)(key0 + row) * 2048 + c * 8); }
#pragma unroll
    for (int i = 0; i < 2; ++i) { const int p = tid + 512 * i, d = p >> 3, c = p & 7; st.v[i] = *(const u32x4*)(VT + (size_t)d * 256 + key0 + c * 8); }
}
__device__ __forceinline__ void stage_write(const Stage& st, LAS unsigned char* lds, int tid) {
#pragma unroll
    for (int i = 0; i < 4; ++i) { const int p = tid + 512 * i, row = p >> 5, c = p & 31; *(LAS u32x4*)(lds + OFF_K + row * KROW + c * 16) = st.k[i]; }
#pragma unroll
    for (int i = 0; i < 2; ++i) { const int p = tid + 512 * i, d = p >> 3, c = p & 7; LAS unsigned char* q = lds + OFF_V + d * VROW + c * 16;
        *(LAS u32x2*)q = (u32x2){st.v[i].x, st.v[i].y}; *(LAS u32x2*)(q + 8) = (u32x2){st.v[i].z, st.v[i].w}; }
}
__device__ __forceinline__ void block_step(const LAS unsigned char* lds, const bf16x8 (&qf)[16], f32x16 (&O)[4], float& m, float& l, int lane) {
    const int r = lane & 31, hi = lane >> 5;
    f32x16 S[2];
#pragma unroll
    for (int kh = 0; kh < 2; ++kh) {
#pragma unroll
        for (int j = 0; j < 16; ++j) S[kh][j] = 0.f;
#pragma unroll
        for (int s_ = 0; s_ < 16; ++s_) { const bf16x8 a = *(const LAS bf16x8*)(lds + OFF_K + (kh * 32 + r) * KROW + (16 * s_ + 8 * hi) * 2); S[kh] = __builtin_amdgcn_mfma_f32_32x32x16_bf16(a, qf[s_], S[kh], 0, 0, 0); }
    }
    float mx = NEG;
#pragma unroll
    for (int kh = 0; kh < 2; ++kh)
#pragma unroll
        for (int j = 0; j < 16; ++j) { const float v = S[kh][j] * CS; S[kh][j] = v; mx = fmaxf(mx, v); }
    mx = fmaxf(mx, __shfl_xor(mx, 32));
    const float mn = fmaxf(m, mx); const float alpha = __builtin_amdgcn_exp2f(m - mn); m = mn; float rs = 0.f;
#pragma unroll
    for (int kh = 0; kh < 2; ++kh)
#pragma unroll
        for (int j = 0; j < 16; ++j) { const float p = __builtin_amdgcn_exp2f(S[kh][j] - mn); S[kh][j] = p; rs += p; }
    l = l * alpha + rs;
#pragma unroll
    for (int dt = 0; dt < 4; ++dt)
#pragma unroll
        for (int j = 0; j < 16; ++j) O[dt][j] *= alpha;
    bf16x8 pf[2][2];
#pragma unroll
    for (int kh = 0; kh < 2; ++kh)
#pragma unroll
        for (int s2 = 0; s2 < 2; ++s2) { u32x4 w; w.x = cvt_pk_bf16(S[kh][8 * s2 + 0], S[kh][8 * s2 + 1]); w.y = cvt_pk_bf16(S[kh][8 * s2 + 2], S[kh][8 * s2 + 3]); w.z = cvt_pk_bf16(S[kh][8 * s2 + 4], S[kh][8 * s2 + 5]); w.w = cvt_pk_bf16(S[kh][8 * s2 + 6], S[kh][8 * s2 + 7]);
            pf[kh][s2] = __builtin_bit_cast(bf16x8, w); }
#pragma unroll
    for (int dt = 0; dt < 4; ++dt)
#pragma unroll
        for (int kh = 0; kh < 2; ++kh)
#pragma unroll
            for (int s2 = 0; s2 < 2; ++s2) { const LAS unsigned char* vp = lds + OFF_V + (dt * 32 + r) * VROW + (32 * kh + 16 * s2 + 4 * hi) * 2;
                const u32x2 lo = *(const LAS u32x2*)vp, hi2 = *(const LAS u32x2*)(vp + 16); const u32x4 av = (u32x4){lo.x, lo.y, hi2.x, hi2.y};
                O[dt] = __builtin_amdgcn_mfma_f32_32x32x16_bf16(__builtin_bit_cast(bf16x8, av), pf[kh][s2], O[dt], 0, 0, 0); }
}
}
__device__ __forceinline__ void p7_xattn_fast(Frame& F, const bf16* vT, bf16* outbase) {
    using namespace xatf;
    bf16* Q = (bf16*)(F.ws + WS_NQ); const bf16* KV = (const bf16*)(F.ws + WS_MEMKV);
    const int tid = F.tid, lane = F.lane, wave = F.wave, r = lane & 31, hi = lane >> 5; LAS unsigned char* lds = F.lds;
    for (int u = F.bx; u < BATCH * 4 * 16; u += F.G) {
        const int tt = u & 15, bh = u >> 4, b = bh >> 2, h = bh & 3; const int tok = b * SEQ + tt * 256 + wave * 32 + r;
        bf16* qrow = Q + (size_t)tok * D + h * 256; bf16* orow = outbase + (size_t)tok * D + h * 256; const bf16* Kb = KV + (size_t)(b * NMEM) * 2048 + h * 256;
        bf16x8 qf[16];
        LAS unsigned char* tb_ = lds + 61440 + wave * 8704;
        bf16* rows0 = Q + (size_t)(b * SEQ + tt * 256 + wave * 32) * D + h * 256;
#pragma unroll
        for (int hq = 0; hq < 2; ++hq) {
#pragma unroll 4
            for (int k_ = 0; k_ < 8; ++k_) { const int rr_ = 4 * k_ + (lane >> 4), ch_ = lane & 15; *(LAS u32x4*)(tb_ + rr_ * 272 + ch_ * 16) = *(const u32x4*)(rows0 + (size_t)rr_ * D + hq * 128 + ch_ * 8); }
            LDS_WAIT(); asm volatile("" ::: "memory");
#pragma unroll
            for (int s_ = 0; s_ < 8; ++s_) qf[8 * hq + s_] = *(const LAS bf16x8*)(tb_ + r * 272 + (16 * s_ + 8 * hi) * 2);
            LDS_WAIT(); asm volatile("" ::: "memory");
        }
        const bf16* VT0 = vT + (size_t)bh * 256 * 256;
        Stage st; stage_load(st, Kb, VT0, 0, tid);
        f32x16 O[4]; float m = NEG, l = 0.f;
        for (int idx = 0; idx < 8; ++idx) {
            const int half = idx >> 2, j = idx & 3;
            if (j == 0) { m = NEG; l = 0.f;
#pragma unroll
                for (int dt = 0; dt < 4; ++dt)
#pragma unroll
                    for (int jj = 0; jj < 16; ++jj) O[dt][jj] = 0.f; }
            __syncthreads(); stage_write(st, lds, tid);
            { const int i2 = idx < 7 ? idx + 1 : idx; stage_load(st, Kb, VT0 + (size_t)((i2 >> 2) * 128) * 256, (i2 & 3) * 64, tid); }
            __syncthreads();
            block_step(lds, qf, O, m, l, lane);
            if (j == 3) {
                l += __shfl_xor(l, 32); const float inv = 1.0f / l;
#pragma unroll
                for (int dt = 0; dt < 4; ++dt)
#pragma unroll
                    for (int q4 = 0; q4 < 4; ++q4) *(LAS u32x2*)(tb_ + r * 272 + (32 * dt + 8 * q4 + 4 * hi) * 2) = (u32x2){cvt_pk_bf16(O[dt][4 * q4] * inv, O[dt][4 * q4 + 1] * inv), cvt_pk_bf16(O[dt][4 * q4 + 2] * inv, O[dt][4 * q4 + 3] * inv)};
                LDS_WAIT(); asm volatile("" ::: "memory");
#pragma unroll 2
                for (int k_ = 0; k_ < 8; ++k_) { const int rr_ = 4 * k_ + (lane >> 4), ch_ = lane & 15; *(u32x4*)(rows0 + (size_t)rr_ * D + half * 128 + ch_ * 8) = *(const LAS u32x4*)(tb_ + rr_ * 272 + ch_ * 16); }
                LDS_WAIT(); asm volatile("" ::: "memory");
            }
        }
    }
    __syncthreads();
}
__device__ __forceinline__ void transpose_memv_tiles(Frame& F, bf16* vT, int w0, int nw) {
    LAS unsigned short* tl_ = (LAS unsigned short*)(F.lds + F.wave * 16384); const int lane = F.lane; const bf16* KV = (const bf16*)(F.ws + WS_MEMKV);
    for (int tile = w0; tile < 32 * 16; tile += nw) {
        const int dq = tile & 3, kq = (tile >> 2) & 3, bh = tile >> 4, b = bh >> 2, h = bh & 3;
        const bf16* sp = KV + (size_t)(b * NMEM + kq * 64) * 2048 + 1024 + h * 256 + dq * 64; bf16* dp = vT + ((size_t)bh * 256 + dq * 64) * 256 + kq * 64;
#pragma unroll
        for (int i = 0; i < 8; ++i) { const int row = i * 8 + (lane >> 3), c = lane & 7; const u32x4 v = *(const u32x4*)(sp + (size_t)row * 2048 + c * 8); LAS unsigned short* q = tl_ + row * 66 + c * 8;
            q[0] = (unsigned short)(v.x & 0xffffu); q[1] = (unsigned short)(v.x >> 16); q[2] = (unsigned short)(v.y & 0xffffu); q[3] = (unsigned short)(v.y >> 16);
            q[4] = (unsigned short)(v.z & 0xffffu); q[5] = (unsigned short)(v.z >> 16); q[6] = (unsigned short)(v.w & 0xffffu); q[7] = (unsigned short)(v.w >> 16); }
        LDS_WAIT(); asm volatile("" ::: "memory");
#pragma unroll
        for (int i = 0; i < 8; ++i) { const int d = i * 8 + (lane >> 3), c = lane & 7; const LAS unsigned short* q = tl_ + (c * 8) * 66 + d;
            u32x4 o; o.x = (unsigned)q[0] | ((unsigned)q[66] << 16); o.y = (unsigned)q[2 * 66] | ((unsigned)q[3 * 66] << 16); o.z = (unsigned)q[4 * 66] | ((unsigned)q[5 * 66] << 16); o.w = (unsigned)q[6 * 66] | ((unsigned)q[7 * 66] << 16);
            *(u32x4*)(dp + (size_t)d * 256 + c * 8) = o; }
        LDS_WAIT(); asm volatile("" ::: "memory");
    }
}

__device__ __forceinline__ void p9_route(Frame& F, const Args& a) {
    unsigned char* ws = F.ws; const float* X2 = a.out;
    const float* gff = a.in[IN_NORM_FFN_G]; const float* wgrp = a.in[IN_W_GRP]; const float* bgrp = a.in[IN_B_GRP]; const float* wrt = a.in[IN_W_RT]; const float* brt = a.in[IN_B_RT];
    float* wts = (float*)(ws + WS_ROUTE); float* rstd2 = wts + 2 * NTOK; int* lists = (int*)(ws + WS_LISTS);
    const int gw = F.bx * NWAVES + F.wave, NGW = F.G * NWAVES, lane = F.lane;
    const f32x4* wgp = (const f32x4*)(ws + WS_RTW); const f32x4* wep = wgp + 1024;
    float xn[16];
    if (gw < NTOK) {
#pragma unroll
        for (int i = 0; i < 16; ++i) xn[i] = X2[(size_t)gw * D + 64 * i + lane]; }
    int my_ea = -1, my_eb = -1, my_tok = -1, it_ = 0; float my_w1 = 0.f, my_w2 = 0.f, my_rstd = 0.f;
    for (int tok = gw; tok < NTOK; tok += NGW, ++it_) {
        float xa[16]; float s = 0.f;
#pragma unroll
        for (int i = 0; i < 16; ++i) { xa[i] = xn[i]; s += xa[i] * xa[i]; }
        if (tok + NGW < NTOK) {
#pragma unroll
            for (int i = 0; i < 16; ++i) xn[i] = X2[(size_t)(tok + NGW) * D + 64 * i + lane]; }
        const float rstd = 1.0f / sqrtf(wave_sum(s) * (1.f / D) + EPS);
        float lg[4] = {0.f, 0.f, 0.f, 0.f};
#pragma unroll
        for (int i = 0; i < 16; ++i) { const f32x4 wg = wgp[64 * i + lane];
#pragma unroll
            for (int c = 0; c < 4; ++c) lg[c] += xa[i] * wg[c]; }
#pragma unroll
        for (int i = 0; i < 4; ++i) lg[i] = rstd * wave_sum(lg[i]) + bgrp[i];
        int grp = 0; float gm = lg[0];
#pragma unroll
        for (int i = 1; i < 4; ++i) if (lg[i] > gm) { gm = lg[i]; grp = i; }
        grp = __builtin_amdgcn_readfirstlane(grp);
        float gs = 0.f;
#pragma unroll
        for (int i = 0; i < 4; ++i) gs += expf(lg[i] - gm);
        const float g_gate = 1.0f / gs;
        float lq[8];
#pragma unroll
        for (int i = 0; i < 8; ++i) lq[i] = 0.f;
        const f32x4* pwe = wep + (size_t)grp * (16 * 2 * 64) + lane;
#pragma unroll
        for (int i = 0; i < 16; ++i) { const f32x4 wa = pwe[(2 * i) * 64], wb = pwe[(2 * i + 1) * 64];
#pragma unroll
            for (int c = 0; c < 4; ++c) { lq[c] += xa[i] * wa[c]; lq[4 + c] += xa[i] * wb[c]; } }
#pragma unroll
        for (int i = 0; i < 8; ++i) lq[i] = rstd * wave_sum(lq[i]) + brt[grp * 8 + i];
        int i1 = 0; float m1 = lq[0];
#pragma unroll
        for (int i = 1; i < 8; ++i) if (lq[i] > m1) { m1 = lq[i]; i1 = i; }
        int i2 = -1; float m2 = -3.0e38f;
#pragma unroll
        for (int i = 0; i < 8; ++i) if (i != i1 && lq[i] > m2) { m2 = lq[i]; i2 = i; }
        const float e2 = expf(m2 - m1), den = 1.0f + e2; const float w1 = g_gate / den, w2 = g_gate * e2 / den;
        if (lane == it_) { my_ea = grp * 8 + i1; my_eb = grp * 8 + i2; my_tok = tok; my_w1 = w1; my_w2 = w2; my_rstd = rstd; }
    }
    if (my_tok >= 0) {
        const unsigned sa = __hip_atomic_fetch_add(F.ctl + CW_ECNT + 64 * my_ea, 1u, __ATOMIC_RELAXED, __HIP_MEMORY_SCOPE_AGENT);
        const unsigned sb = __hip_atomic_fetch_add(F.ctl + CW_ECNT + 64 * my_eb, 1u, __ATOMIC_RELAXED, __HIP_MEMORY_SCOPE_AGENT);
        lists[(size_t)my_ea * NTOK + sa] = my_tok * 2; lists[(size_t)my_eb * NTOK + sb] = my_tok * 2 + 1;
        wts[my_tok * 2] = my_w1; wts[my_tok * 2 + 1] = my_w2; rstd2[my_tok] = my_rstd;
    }
}
__device__ __forceinline__ void moe_tiles(Frame& F) {
    __syncthreads();
    if (F.tid == 0) { unsigned accu = 0u; for (int e = 0; e < NEXP; ++e) { const unsigned c = __hip_atomic_load(F.ctl + CW_ECNT + 64 * e, __ATOMIC_RELAXED, __HIP_MEMORY_SCOPE_AGENT); F.MISC[16 + e] = accu; F.MISC[64 + e] = c; accu += (c + 255u) >> 8; } F.MISC[16 + NEXP] = accu; }
    __syncthreads();
}
template <int WHICH> struct SchedMoe {
    volatile LAS unsigned* MISC; unsigned char* ws; int G, c;
    __device__ __forceinline__ bool next(int i, GU& u) const {
        const int L = i * G + c; const int T = (int)MISC[16 + NEXP]; if (L >= 4 * T) return false;
        const int tau = L >> 2, pn = L & 3; int e = 0;
        for (int k = 1; k < NEXP; ++k) if ((int)MISC[16 + k] <= tau) e = k;
        const int lt = tau - (int)MISC[16 + e]; const int cnt = (int)MISC[64 + e]; int nv = cnt - lt * 256; nv = nv > 256 ? 256 : nv;
        u.rows = (const int*)(ws + WS_LISTS) + (size_t)e * NTOK + lt * 256; u.nvalid = nv; u.pm = tau; u.pn = pn; u.kind = 0; u.aux = e;
        if (WHICH == 0) { u.A = (const char*)ws + WS_X2B; u.B = (const char*)ws + WS_W13 + (size_t)e * D * D * 2 + (size_t)pn * 256 * D * 2; }
        else { u.A = (const char*)ws + WS_H1 + (size_t)tau * 256 * DEXP * 2; u.B = (const char*)ws + WS_W2 + (size_t)e * D * DEXP * 2 + (size_t)pn * 256 * DEXP * 2; }
        return true;
    }
};
struct EpiMoe1 {
    static constexpr bool PERM = true;
    const float* rstd2; bf16* H1;
    __device__ __forceinline__ void operator()(const f32x4 (&acc)[2][2][4][2], const GU& u, int wr, int wc, int fr, int fq) const {
        char* hb = (char*)H1 + (size_t)u.pm * 256 * DEXP * 2;
        const int j00 = (u.pn * 256 + 32 * wc + 8 * fq) >> 1;
#pragma unroll
        for (int ai = 0; ai < 2; ++ai) {
            int r = 128 * ai + 64 * wr + fr; LAUNDER(r);
#pragma unroll
            for (int m = 0; m < 4; ++m) { const bool ok = r < u.nvalid; const float rs = ok ? rstd2[u.rows[r] >> 1] : 0.f;
#pragma unroll
                for (int bj = 0; bj < 2; ++bj) { const f32x4 a1 = acc[ai][bj][m][0] * rs, a3 = acc[ai][bj][m][1] * rs; f32x4 hv;
#pragma unroll
                    for (int j = 0; j < 4; ++j) hv[j] = a1[j] * sigmoidf_(a1[j]) * a3[j];
                    u32x2 w; w.x = cvt_pk_bf16(hv[0], hv[1]); w.y = cvt_pk_bf16(hv[2], hv[3]); *(u32x2*)(hb + (unsigned)((r * DEXP + j00 + 64 * bj) * 2)) = w; }
                r += 16; LAUNDER(r); }
        }
    }
};
struct EpiMoe2 {
    static constexpr bool PERM = true;
    const float* wts; bf16* Y0; bf16* Y1;
    __device__ __forceinline__ void operator()(const f32x4 (&acc)[2][2][4][2], const GU& u, int wr, int wc, int fr, int fq) const {
#pragma unroll
        for (int ai = 0; ai < 2; ++ai)
#pragma unroll
            for (int m = 0; m < 4; ++m) { const int r = 128 * ai + 64 * wr + 16 * m + fr;
                if (r < u.nvalid) { const int ent = u.rows[r]; const float w8 = wts[ent]; bf16* dst = ((ent & 1) ? Y1 : Y0) + (size_t)(ent >> 1) * D + u.pn * 256 + 32 * wc + 8 * fq;
#pragma unroll
                    for (int bj = 0; bj < 2; ++bj) { const f32x4 v0 = acc[ai][bj][m][0] * w8, v1 = acc[ai][bj][m][1] * w8;
                        u32x4 w; w.x = cvt_pk_bf16(v0[0], v0[1]); w.y = cvt_pk_bf16(v0[2], v0[3]); w.z = cvt_pk_bf16(v1[0], v1[1]); w.w = cvt_pk_bf16(v1[2], v1[3]);
                        *(u32x4*)(dst + 128 * bj) = w; } } }
    }
};

__device__ __forceinline__ void p12_final(Frame& F, const Args& a) {
    const bf16* Y0 = (const bf16*)(F.ws + WS_YS0); const bf16* Y1 = (const bf16*)(F.ws + WS_YS1); const bf16* X2 = (const bf16*)(F.ws + WS_X2B); const float* g = a.in[IN_NORM_F_G];
    const int gw = F.bx * NWAVES + F.wave, NGW = F.G * NWAVES, lane = F.lane;
    for (int tok = gw; tok < NTOK; tok += NGW) {
        f32x4* xr = (f32x4*)(a.out + (size_t)tok * D) + lane; const u32x2* x2 = (const u32x2*)(X2 + (size_t)tok * D) + lane; const u32x2* y0 = (const u32x2*)(Y0 + (size_t)tok * D) + lane; const u32x2* y1 = (const u32x2*)(Y1 + (size_t)tok * D) + lane;
        f32x4 v[4]; float s = 0.f;
#pragma unroll
        for (int j = 0; j < 4; ++j) { const u32x2 xx = x2[64 * j], p = y0[64 * j], q = y1[64 * j];
            v[j].x = lo16(xx.x) + (lo16(p.x) + lo16(q.x)); v[j].y = hi16(xx.x) + (hi16(p.x) + hi16(q.x)); v[j].z = lo16(xx.y) + (lo16(p.y) + lo16(q.y)); v[j].w = hi16(xx.y) + (hi16(p.y) + hi16(q.y));
            s += (v[j].x * v[j].x + v[j].y * v[j].y) + (v[j].z * v[j].z + v[j].w * v[j].w); }
        const float rstd = 1.0f / sqrtf(wave_sum(s) * (1.f / D) + EPS);
#pragma unroll
        for (int j = 0; j < 4; ++j) { const f32x4 gg = ((const f32x4*)g + lane)[64 * j]; xr[64 * j] = v[j] * rstd * gg; }
    }
}

constexpr int N_PHASES = 14;
__global__ void __launch_bounds__(NTHREADS, 2) fwd(Args args) {
    extern __shared__ __attribute__((aligned(16))) unsigned char lds[];
    Frame F;
    F.lds = (LAS unsigned char*)lds; F.MISC = (volatile LAS unsigned*)(F.lds + MISC_OFF);
    F.tid = threadIdx.x; F.lane = F.tid & 63; F.wave = __builtin_amdgcn_readfirstlane(F.tid >> 6); F.G = gridDim.x; F.bx = blockIdx.x;
    F.ws = args.ws; F.ctl = (unsigned*)(args.ws + WS_CTL);
    unsigned char* ws = args.ws;
    for (int u = F.tid; u < (LDS_BYTES - RING_BYTES) / 4; u += NTHREADS) ((LAS unsigned*)(F.lds + RING_BYTES))[u] = 0u;
    __syncthreads();
    const int lo = args.ph_lo, hi = args.ph_hi;
    const bool one = (hi - lo) > 1;
    XcdBarrier bar; bar.bar = F.ctl + CW_BAR; bar.x = 0; bar.st = F.MISC + 8;
    if (one) bar = xcd_barrier_post(F.ctl + CW_BAR, F.MISC + 8);
#define IN(k) (lo <= (k) && (k) < hi && phase_begin(F))
#define SEAM(k) do { if (lo <= (k) && (k) + 1 < hi) xcd_barrier(bar); } while (0)

    if (IN(0)) { p0_prologue(F, args); } SEAM(0);
    if (IN(1)) {
        SchedP1 S{ws, F.G, F.bx};
        EpiP1 E{ws};
        pg8::gemm_phase<EpiP1, SchedP1, false>(F.lds, D, D, D, S, E);
        p1_gate_logits(F);
    } SEAM(1);
    if (IN(2)) {
        p2_retention_fast(F, F.bx, (bf16*)(ws + WS_RV));
        { const int w0 = F.bx * NWAVES + F.wave, nw = F.G * NWAVES;
            transpose_kv_tiles(F, (const bf16*)(ws + WS_KV6 + 3 * KV_STRIDE), (bf16*)args.out, w0, nw);
            transpose_kv_tiles(F, (const bf16*)(ws + WS_KV6 + 5 * KV_STRIDE), (bf16*)((unsigned char*)args.out + KV_STRIDE), w0, nw);
            transpose_memv_tiles(F, (bf16*)(ws + WS_MEMVT), w0, nw); }
        __syncthreads();
        { SchedCmp S{ws, 0, F.G, F.bx}; EpiCmp E{(float*)args.out + (size_t)16 * MiB};
            pg8::gemm_phase<EpiCmp, SchedCmp, false>(F.lds, 512, 2048, 4096, S, E); }
    } SEAM(2);
    if (IN(3)) { p2b_compress_out(F, args); } SEAM(3);
    if (IN(4)) { p3_ret_normalize(F); p3_nsa_fast(F, (const bf16*)args.out, (const bf16*)((const unsigned char*)args.out + KV_STRIDE), (bf16*)((unsigned char*)args.out + 64 * MiB)); } SEAM(4);
    if (IN(5)) {
        SchedP4 S{ws, F.G, F.bx, (const char*)args.out + 64 * MiB};
        EpiP4 E{(float*)(ws + WS_P4SCR) + (size_t)F.bx * (2 * 32 * 512 * 4), (bf16*)(ws + WS_Y)};
        pg8::gemm_phase<EpiP4, SchedP4, false>(F.lds, D, D, D, S, E);
    } SEAM(5);
    if (IN(6)) {
        SchedMN S{ws, WS_Y, W_OUT, F.G, F.bx}; EpiRes<true> E{args.in[IN_X], nullptr, nullptr, (bf16*)(ws + WS_X1B), (float*)(ws + WS_SSQ)};
        pg8::gemm_phase<EpiRes<true>, SchedMN, false>(F.lds, D, D, D, S, E);
    } SEAM(6);
    if (IN(7)) {
        const bool early = ((F.bx >> 3) & 1) == 0;
        if (early) expert_copies(F, args, 0, NEXP / 2);
        SchedMN S{ws, WS_X1B, W_XQ, F.G, F.bx}; EpiQ E{(const float*)(ws + WS_SSQ), (bf16*)(ws + WS_NQ)};
        pg8::gemm_phase<EpiQ, SchedMN, false>(F.lds, D, D, D, S, E);
        if (!early) { __syncthreads(); expert_copies(F, args, 0, NEXP / 2); }
    } SEAM(7);
    if (IN(8)) { p7_xattn_fast(F, (const bf16*)(ws + WS_MEMVT), (bf16*)(ws + WS_NQ)); } SEAM(8);
    if (IN(9)) {
        const bool early = ((F.bx >> 3) & 1) == 0;
        if (early) expert_copies(F, args, NEXP / 2, NEXP);
        SchedMN S{ws, WS_NQ, W_XO, F.G, F.bx}; EpiRes<false> E{nullptr, (const bf16*)(ws + WS_X1B), args.out, (bf16*)(ws + WS_X2B), nullptr};
        pg8::gemm_phase<EpiRes<false>, SchedMN, false>(F.lds, D, D, D, S, E);
        if (!early) { __syncthreads(); expert_copies(F, args, NEXP / 2, NEXP); }
    } SEAM(9);
    if (IN(10)) { p9_route(F, args); } SEAM(10);
    if (IN(11)) {
        moe_tiles(F);
        SchedMoe<0> S{F.MISC, ws, F.G, F.bx}; EpiMoe1 E{(const float*)(ws + WS_ROUTE) + 2 * NTOK, (bf16*)(ws + WS_H1)};
        pg8::gemm_phase<EpiMoe1, SchedMoe<0>, true>(F.lds, D, D, D, S, E);
    } SEAM(11);
    if (IN(12)) {
        moe_tiles(F);
        SchedMoe<1> S{F.MISC, ws, F.G, F.bx}; EpiMoe2 E{(const float*)(ws + WS_ROUTE), (bf16*)(ws + WS_YS0), (bf16*)(ws + WS_YS1)};
        pg8::gemm_phase<EpiMoe2, SchedMoe<1>, false>(F.lds, DEXP, DEXP, DEXP, S, E);
    } SEAM(12);
    if (IN(13)) { p12_final(F, args); }
#undef IN
#undef SEAM
}

extern "C" void kernel_launch(void* const* d_in, const int* in_sizes, int n_in, void* d_out, int out_size, void* d_ws, size_t ws_size, hipStream_t stream) {
    static int grid = 0;
    if (grid == 0) {
        if (n_in != 27 || in_sizes[0] != NTOK * D || out_size != NTOK * D || ws_size < WS_END) {
            fprintf(stderr, "kernel_launch: unexpected shapes: n_in %d in0 %d out %d ws %zu (need %zu)\n", n_in, n_in > 0 ? in_sizes[0] : -1, out_size, ws_size, (size_t)WS_END); grid = -1; return; }
        int dev = 0, cus = 0, per_cu = 0;
        if (hipGetDevice(&dev) != hipSuccess || hipDeviceGetAttribute(&cus, hipDeviceAttributeMultiprocessorCount, dev) != hipSuccess) { grid = -1; return; }
        if (hipFuncSetAttribute((const void*)fwd, hipFuncAttributeMaxDynamicSharedMemorySize, LDS_BYTES) != hipSuccess) { fprintf(stderr, "kernel_launch: hipFuncSetAttribute failed\n"); grid = -1; return; }
        if (hipOccupancyMaxActiveBlocksPerMultiprocessor(&per_cu, (const void*)fwd, NTHREADS, LDS_BYTES) != hipSuccess || per_cu < 1) fprintf(stderr, "kernel_launch: occupancy query reports %d\n", per_cu);
        (void)hipGetLastError();
        grid = cus < 256 ? cus : 256;
    }
    if (grid < 0) return;
    (void)hipMemsetAsync((char*)d_ws + WS_CTL, 0, CTL_ZERO_BYTES, stream);
    Args a{};
    for (int i = 0; i < 27; ++i) a.in[i] = (const float*)d_in[i];
    a.out = (float*)d_out; a.ws = (unsigned char*)d_ws;
#if MK_N_LAUNCHES == 1
    a.ph_lo = 0; a.ph_hi = N_PHASES;
    hipLaunchKernelGGL(fwd, dim3(grid), dim3(NTHREADS), LDS_BYTES, stream, a);
#else
    for (int p = 0; p < N_PHASES; ++p) { a.ph_lo = p; a.ph_hi = p + 1; hipLaunchKernelGGL(fwd, dim3(grid), dim3(NTHREADS), LDS_BYTES, stream, a); }
#endif
}
```

```cpp
#include <hip/hip_runtime.h>
#include <cstdio>
#include <cstdint>

#ifndef MK_N_LAUNCHES
#define MK_N_LAUNCHES 1
#endif

#define LAS __attribute__((address_space(3)))
#define GAS __attribute__((address_space(1)))
#define HD __host__ __device__
#define HDI __host__ __device__ __attribute__((always_inline)) inline
typedef unsigned short bf16;
typedef short bf16x8 __attribute__((ext_vector_type(8)));
typedef float f32x4 __attribute__((ext_vector_type(4)));
typedef float f32x2 __attribute__((ext_vector_type(2)));
typedef float f32x16 __attribute__((ext_vector_type(16)));
typedef unsigned u32x4 __attribute__((ext_vector_type(4)));
typedef unsigned u32x2 __attribute__((ext_vector_type(2)));

constexpr int D = 1024, BATCH = 8, SEQ = 4096, NTOK = BATCH * SEQ, NMEM = 256, NMEMTOK = BATCH * NMEM;
constexpr int DIN = 7704;
constexpr int C_RQ = 0, C_RK = 512, C_RV = 1024, C_RG = 2048, C_NQ = 3072, C_CK = 4096, C_NGL = 5632, C_GA = 5656, C_GB = 6680;
constexpr int NPROJ = 5632;
constexpr int NEXP = 32, DEXP = 512;
constexpr float EPS = 1e-6f;
constexpr int NWAVES = 8, NTHREADS = 512;

constexpr size_t MiB = 1u << 20;
constexpr size_t WS_CTL = 0, CTL_ZERO_BYTES = 1 * MiB;
constexpr size_t WS_ROPE_COS = 1 * MiB, WS_ROPE_SIN = 2 * MiB;
constexpr size_t WS_RTW = 3 * MiB + 512 * 1024;
constexpr size_t WS_SMALLW = 3 * MiB;
constexpr size_t WS_MEMVT = 24 * MiB;
constexpr size_t WS_KCMP = 4 * MiB, WS_VCMP = 5 * MiB, WS_VCMPT = 35 * MiB;
constexpr size_t WS_GATES = 10 * MiB;
constexpr size_t WS_SSQ = 13 * MiB;
constexpr size_t WS_ROUTE = 15 * MiB;
constexpr size_t WS_LISTS = 16 * MiB;
constexpr size_t WS_W = 36 * MiB;
constexpr size_t W_IN = WS_W;
constexpr size_t W_GA = W_IN + 11 * MiB, W_GB = W_GA + 2 * MiB;
constexpr size_t W_RO = W_GB + 2 * MiB, W_NO = W_RO + 2 * MiB, W_OUT = W_NO + 2 * MiB, W_XQ = W_OUT + 2 * MiB, W_XO = W_XQ + 2 * MiB;
constexpr size_t W_XKV = W_XO + 2 * MiB;
constexpr size_t W_C1K = W_XKV + 4 * MiB, W_C1V = W_C1K + 2 * MiB;
constexpr size_t WS_MEMN = W_C1V + 2 * MiB;
constexpr size_t WS_MEMKV = WS_MEMN + 4 * MiB;
constexpr size_t WS_H = 84 * MiB;
constexpr size_t WS_NQ = WS_H + 64 * MiB;
constexpr size_t WS_RV = WS_NQ + 64 * MiB;
constexpr size_t WS_RQ = WS_RV + 64 * MiB;
constexpr size_t WS_RK = WS_RQ + 32 * MiB;
constexpr size_t WS_RG = WS_RK + 32 * MiB;
constexpr size_t WS_KV6 = WS_RG + 64 * MiB;
constexpr size_t KV_STRIDE = 16 * MiB;
constexpr size_t WS_END = WS_KV6 + 96 * MiB;
constexpr size_t WS_Y = WS_RQ, WS_P4SCR = WS_RG, WS_W13 = WS_RQ, WS_W2 = WS_RG, WS_H1 = WS_KV6, WS_X1B = WS_H, WS_X2B = WS_RV, WS_YS0 = WS_H, WS_YS1 = WS_NQ;
static_assert(WS_MEMKV + 8 * MiB <= WS_H && WS_VCMPT + 1 * MiB <= WS_W && WS_MEMVT + 4 * MiB <= WS_VCMPT, "ws map");
constexpr int CW_BAR = 4096;
constexpr int CW_ECNT = 16384;
constexpr int LDS_BYTES = 147456, RING_BYTES = 131072, MISC_OFF = RING_BYTES + 320;

HD inline float bf2f(bf16 b) { return __builtin_bit_cast(float, (unsigned)b << 16); }
HD inline unsigned f2bf(float f) { unsigned u = __builtin_bit_cast(unsigned, f); return (u + 0x7fffu + ((u >> 16) & 1u)) >> 16; }
HD inline unsigned pk2(float lo, float hi) { return f2bf(lo) | (f2bf(hi) << 16); }
HD inline float lo16(unsigned w) { return __builtin_bit_cast(float, w << 16); }
HD inline float hi16(unsigned w) { return __builtin_bit_cast(float, w & 0xffff0000u); }
__device__ __forceinline__ unsigned cvt_pk_bf16(float lo, float hi) { unsigned r; asm volatile("v_cvt_pk_bf16_f32 %0, %1, %2" : "=v"(r) : "v"(lo), "v"(hi)); return r; }
#define DPP_F(v, ctrl, rmask) __builtin_bit_cast(float, __builtin_amdgcn_update_dpp(0, __builtin_bit_cast(int, v), ctrl, rmask, 0xf, false))
__device__ __forceinline__ float wave_sum(float v) {
    v += DPP_F(v, 0xB1, 0xf);
    v += DPP_F(v, 0x4E, 0xf);
    v += DPP_F(v, 0x141, 0xf);
    v += DPP_F(v, 0x140, 0xf);
    v += DPP_F(v, 0x142, 0xa);
    v += DPP_F(v, 0x143, 0xc);
    return __builtin_bit_cast(float, __builtin_amdgcn_readlane(__builtin_bit_cast(int, v), 63));
}
__device__ __forceinline__ float wave_max(float v) {
#pragma unroll
    for (int o = 1; o < 64; o <<= 1) v = fmaxf(v, __shfl_xor(v, o));
    return v;
}
__device__ __forceinline__ float sigmoidf_(float x) { return __builtin_amdgcn_rcpf(1.0f + __builtin_amdgcn_exp2f(-1.4426950408889634f * x)); }
#define LAUNDER(p) asm volatile("" : "+v"(p))
#define LDS_WAIT() asm volatile("s_waitcnt lgkmcnt(0)" ::: "memory")
#define VM_WAIT() asm volatile("s_waitcnt vmcnt(0)" ::: "memory")

#define XB_TMO      128
#define XB_XCNT(j)  (256  + 64 * (j))
#define XB_XSUB(j)  (1280 + 64 * (j))
#define XB_XGEN(j)  (2304 + 64 * (j))
#define XB_TOP      3328
#define XB_TOPGEN   3392
#define XCD_BAR_WORDS 3456
#define XB_SPIN_CAP (1u << 24)
__device__ __forceinline__ unsigned xb_ld(unsigned* p)              { return __hip_atomic_load(p, __ATOMIC_RELAXED, __HIP_MEMORY_SCOPE_AGENT); }
__device__ __forceinline__ unsigned xb_add(unsigned* p, unsigned v) { return __hip_atomic_fetch_add(p, v, __ATOMIC_RELAXED, __HIP_MEMORY_SCOPE_AGENT); }
__device__ __forceinline__ unsigned xb_xcc_id() { return (unsigned)__builtin_amdgcn_s_getreg((3 << 11) | 20) & 0xFu; }
#define XB_SPIN(cond, bar) do { unsigned _sp = 0; while (cond) { __builtin_amdgcn_s_sleep(1); \
    if ((++_sp & 255u) == 0u) { if (xb_ld(&(bar)[XB_TMO])) break; if (_sp > XB_SPIN_CAP) { atomicAdd(&(bar)[XB_TMO], 1u); break; } } } } while (0)
struct XcdBarrier { unsigned* bar; unsigned x; volatile LAS unsigned* st; };
__device__ __forceinline__ XcdBarrier xcd_barrier_post(unsigned* bar, volatile LAS unsigned* st) {
    XcdBarrier b; b.bar = bar; b.x = xb_xcc_id(); b.st = st;
    if (threadIdx.x == 0) (void)xb_add(&bar[XB_XCNT(b.x)], 1u);
    return b;
}
__device__ __forceinline__ void xcd_barrier_complete(unsigned* bar, unsigned x, unsigned& nloc, unsigned& nx) {
    const unsigned G = gridDim.x * gridDim.y * gridDim.z;
    unsigned sum, cnt, mine, sp = 0u;
    for (;;) {
        sum = 0u; cnt = 0u; mine = 0u;
#pragma unroll
        for (unsigned j = 0; j < 16; ++j) { const unsigned c = xb_ld(&bar[XB_XCNT(j)]); sum += c; cnt += (c > 0u) ? 1u : 0u; mine = (j == x) ? c : mine; }
        if (sum == G) break;
        __builtin_amdgcn_s_sleep(1);
        if ((++sp & 255u) == 0u) { if (xb_ld(&bar[XB_TMO])) break; if (sp > XB_SPIN_CAP) { atomicAdd(&bar[XB_TMO], 1u); break; } }
    }
    nloc = mine > 0u ? mine : 1u; nx = cnt > 0u ? cnt : 1u;
}
__device__ __forceinline__ void xcd_barrier(const XcdBarrier& b) {
    asm volatile("s_waitcnt vmcnt(0)" ::: "memory");
    __syncthreads();
    if (threadIdx.x == 0) {
        unsigned* bar = b.bar;
        __builtin_amdgcn_s_waitcnt(0);
        unsigned nloc = b.st[0], nx = b.st[1];
        if (nloc == 0u) { xcd_barrier_complete(bar, b.x, nloc, nx); b.st[0] = nloc; b.st[1] = nx; }
        const unsigned old = xb_add(&bar[XB_XSUB(b.x)], 1u);
        const unsigned gen = old / nloc;
        if (old + 1u == (gen + 1u) * nloc) {
            __builtin_amdgcn_fence(__ATOMIC_RELEASE, "agent");
            asm volatile("s_waitcnt vmcnt(0)" ::: "memory");
            const unsigned og = xb_add(&bar[XB_TOP], 1u);
            const unsigned tg = og / nx;
            if (og + 1u == (tg + 1u) * nx) xb_add(&bar[XB_TOPGEN], 1u);
            else XB_SPIN(xb_ld(&bar[XB_TOPGEN]) == tg, bar);
            __builtin_amdgcn_fence(__ATOMIC_ACQUIRE, "agent");
            xb_add(&bar[XB_XGEN(b.x)], 1u);
            asm volatile("s_waitcnt vmcnt(0)" ::: "memory");
        } else {
            XB_SPIN(xb_ld(&bar[XB_XGEN(b.x)]) == gen, bar);
            __builtin_amdgcn_fence(__ATOMIC_ACQUIRE, "agent");
            asm volatile("s_waitcnt vmcnt(0)" ::: "memory");
        }
    }
    __syncthreads();
}

namespace pg8 {
constexpr int BM = 256, BK = 64, HALF = 128, HTB = HALF * BK * 2, NXCD = 8, WGM = 8;
HD __forceinline__ int lds_byte(int r, int c) { const int st = (r >> 4) * 2 + (c >> 5), rr = r & 15, cc = c & 31, ob = rr * 64 + cc * 2; return st * 1024 + (ob ^ (((ob >> 9) & 1) << 5)); }
HD __forceinline__ void stage_rc(int b, int& R, int& C) { const int st = b / 1024, sb = b % 1024, swz = sb ^ (((sb >> 9) & 1) << 5); R = (st >> 1) * 16 + swz / 64; C = (st & 1) * 32 + (swz % 64) / 2; }
HD __forceinline__ int perm32(int rho) { const int n = rho >> 4, i = rho & 15; return 8 * (i >> 2) + 4 * n + (i & 3); }
HD __forceinline__ void tile_map(int L, int nM, int nN, int& pm, int& pn) {
    const int nwg = nM * nN; int wgid = L; { const int q = nwg / NXCD, r = nwg % NXCD, xcd = wgid % NXCD, off = wgid / NXCD; wgid = (xcd < r ? xcd * (q + 1) : r * (q + 1) + (xcd - r) * q) + off; }
    const int nig = WGM * nN, gid = wgid / nig, fm = gid * WGM, gsz = (nM - fm) < WGM ? (nM - fm) : WGM;
    pm = fm + ((wgid % nig) % gsz); pn = (wgid % nig) / gsz;
}
struct GU { const char* A; const char* B; const int* rows; int nvalid; int kind, pm, pn, aux; };
template <class Epi, class Sched, bool GATHER>
__device__ __forceinline__ void gemm_phase(LAS unsigned char* lds, const int K, const int lda, const int ldb, const Sched& S, const Epi& E) {
    int tid_ = threadIdx.x; LAUNDER(tid_);
    const int tid = tid_, wid = __builtin_amdgcn_readfirstlane(tid >> 6), lane = tid & 63, wr = wid >> 2, wc = wid & 3, fr = lane & 15, fq = lane >> 4;
    const int nt = K / BK;
    unsigned voffB[2];
#pragma unroll
    for (int i = 0; i < 2; ++i) { int R, C; stage_rc(tid * 16 + i * 8192, R, C); const int Rb = Epi::PERM ? ((R & ~31) + perm32(R & 31)) : R; voffB[i] = (unsigned)(Rb * ldb + C) * 2u; }
    const size_t kstep = (size_t)(BK * 2);
    const size_t hstepB = (size_t)HALF * ldb * 2;
    const unsigned ldsw = (unsigned)wid * 1024u;
    const int aoff = lds_byte(wr * 64 + fr, fq * 8), boff = lds_byte(wc * 32 + fr, fq * 8);
#define PG8_SA(b, h) (((b) * 2 + (h)) * HTB)
#define PG8_SB(b, h) ((4 + (b) * 2 + (h)) * HTB)
#define PG8_STAGE2(bufoff, gbase, v0, v1) do { \
        __builtin_amdgcn_global_load_lds((const unsigned*)((const char*)(gbase) + (v0)), (LAS unsigned*)(lds + (bufoff) + ldsw), 16, 0, 0); \
        __builtin_amdgcn_global_load_lds((const unsigned*)((const char*)(gbase) + (v1)), (LAS unsigned*)(lds + (bufoff) + ldsw + 8192), 16, 0, 0); } while (0)
#define PG8_STAGEB(bufoff, gbase) PG8_STAGE2(bufoff, gbase, voffB[0], voffB[1])
#define PG8_LDA(dst, b, h) do { _Pragma("unroll") for (int m = 0; m < 4; ++m) _Pragma("unroll") for (int k = 0; k < 2; ++k) dst[m][k] = *(const LAS bf16x8*)(lds + PG8_SA(b, h) + aoff + m * 2048 + k * 1024); } while (0)
#define PG8_LDB(dst, b, h) do { _Pragma("unroll") for (int n = 0; n < 2; ++n) _Pragma("unroll") for (int k = 0; k < 2; ++k) dst[n][k] = *(const LAS bf16x8*)(lds + PG8_SB(b, h) + boff + n * 2048 + k * 1024); } while (0)
#define PG8_MMA(ai, bj, At, Bt) do { __builtin_amdgcn_s_setprio(1); _Pragma("unroll") for (int m = 0; m < 4; ++m) _Pragma("unroll") for (int n = 0; n < 2; ++n) _Pragma("unroll") for (int k = 0; k < 2; ++k) \
        acc[ai][bj][m][n] = __builtin_amdgcn_mfma_f32_16x16x32_bf16(Bt[n][k], At[m][k], acc[ai][bj][m][n], 0, 0, 0); __builtin_amdgcn_s_setprio(0); } while (0)
#define PG8_WAIT_V(n) asm volatile("s_waitcnt vmcnt(" #n ")" ::: "memory")
#define PG8_WAIT_L(n) asm volatile("s_waitcnt lgkmcnt(" #n ")" ::: "memory")
#define PG8_BAR __builtin_amdgcn_s_barrier()
#define PG8_SCHED __builtin_amdgcn_sched_barrier(0)
#define PG8_VOFFA(u, vo) do { _Pragma("unroll") for (int h = 0; h < 2; ++h) _Pragma("unroll") for (int i = 0; i < 2; ++i) { int R_, C_; stage_rc(tid * 16 + i * 8192, R_, C_); const int R = R_ + HALF * h; \
        int ridx = R; if (GATHER) { ridx = (R < (u).nvalid) ? ((u).rows[R] >> 1) : 0; } vo[h][i] = (unsigned)(ridx * lda + C_) * 2u; } if (GATHER) asm volatile("" :: "v"(vo[0][0]), "v"(vo[0][1]), "v"(vo[1][0]), "v"(vo[1][1])); } while (0)
    GU cur, nxt; int ui = 0;
    if (!S.next(0, cur)) return;
    f32x4 acc[2][2][4][2];
#pragma unroll
    for (int a = 0; a < 2; ++a)
#pragma unroll
        for (int b = 0; b < 2; ++b)
#pragma unroll
            for (int m = 0; m < 4; ++m)
#pragma unroll
                for (int n = 0; n < 2; ++n) acc[a][b][m][n] = (f32x4){0.f, 0.f, 0.f, 0.f};
    bf16x8 At[4][2], B0[2][2], B1[2][2];
    unsigned cv[2][2], nv[2][2];
    PG8_VOFFA(cur, cv);
    const char* cA = cur.A; const char* cB = cur.B;
    PG8_STAGEB(PG8_SB(0, 0), cB); PG8_STAGEB(PG8_SB(0, 1), cB + hstepB); PG8_STAGE2(PG8_SA(0, 0), cA, cv[0][0], cv[0][1]); PG8_STAGE2(PG8_SA(0, 1), cA, cv[1][0], cv[1][1]);
    if (wr == 1) PG8_BAR;
    PG8_WAIT_V(2); PG8_BAR;
    PG8_STAGEB(PG8_SB(1, 0), cB + kstep); PG8_STAGE2(PG8_SA(1, 0), cA + kstep, cv[0][0], cv[0][1]); PG8_STAGEB(PG8_SB(1, 1), cB + hstepB + kstep);
    PG8_WAIT_V(6); PG8_BAR;
    for (;;) {
        const bool has_next = S.next(ui + 1, nxt);
        const char* nA = has_next ? nxt.A : cA; const char* nB = has_next ? nxt.B : cB;
        if (has_next) { PG8_VOFFA(nxt, nv); } else {
#pragma unroll
            for (int h = 0; h < 2; ++h)
#pragma unroll
                for (int i = 0; i < 2; ++i) nv[h][i] = cv[h][i]; }
        for (int t = 0; t < nt; t += 2) {
            const bool last = (t == nt - 2);
            const char* a1 = cA + (size_t)(t + 1) * kstep;
            const char* a2 = last ? nA : cA + (size_t)(t + 2) * kstep; const char* b2 = last ? nB : cB + (size_t)(t + 2) * kstep;
            const char* a3 = a2 + kstep; const char* b3 = b2 + kstep;
            const unsigned w00 = last ? nv[0][0] : cv[0][0], w01 = last ? nv[0][1] : cv[0][1], w10 = last ? nv[1][0] : cv[1][0], w11 = last ? nv[1][1] : cv[1][1];
            PG8_LDB(B0, 0, 0); PG8_LDB(B1, 0, 1); PG8_SCHED; PG8_LDA(At, 0, 0); PG8_STAGE2(PG8_SA(1, 1), a1, cv[1][0], cv[1][1]);
            PG8_WAIT_V(8); PG8_WAIT_L(0); PG8_BAR; PG8_MMA(0, 0, At, B0); PG8_MMA(0, 1, At, B1); PG8_BAR; PG8_SCHED;
            PG8_LDA(At, 0, 1); PG8_STAGEB(PG8_SB(0, 0), b2); PG8_STAGEB(PG8_SB(0, 1), b2 + hstepB); PG8_STAGE2(PG8_SA(0, 0), a2, w00, w01);
            PG8_WAIT_V(8); PG8_WAIT_L(0); PG8_BAR; PG8_MMA(1, 0, At, B0); PG8_MMA(1, 1, At, B1); PG8_BAR; PG8_SCHED;
            PG8_LDB(B0, 1, 0); PG8_LDB(B1, 1, 1); PG8_SCHED; PG8_LDA(At, 1, 0); PG8_STAGE2(PG8_SA(0, 1), a2, w10, w11);
            PG8_WAIT_V(8); PG8_WAIT_L(0); PG8_BAR; PG8_MMA(0, 0, At, B0); PG8_MMA(0, 1, At, B1); PG8_BAR; PG8_SCHED;
            PG8_LDA(At, 1, 1); PG8_STAGEB(PG8_SB(1, 0), b3); PG8_STAGEB(PG8_SB(1, 1), b3 + hstepB); PG8_STAGE2(PG8_SA(1, 0), a3, w00, w01);
            PG8_WAIT_V(8); PG8_WAIT_L(0); PG8_BAR; PG8_MMA(1, 0, At, B0); PG8_MMA(1, 1, At, B1); PG8_BAR; PG8_SCHED;
        }
        if (wr == 0) PG8_BAR;
        E(acc, cur, wr, wc, fr, fq);
        if (!has_next) break;
#pragma unroll
        for (int a = 0; a < 2; ++a)
#pragma unroll
            for (int b = 0; b < 2; ++b)
#pragma unroll
                for (int m = 0; m < 4; ++m)
#pragma unroll
                    for (int n = 0; n < 2; ++n) acc[a][b][m][n] = (f32x4){0.f, 0.f, 0.f, 0.f};
        cur = nxt; cA = nA; cB = nB; ++ui;
#pragma unroll
        for (int h = 0; h < 2; ++h)
#pragma unroll
            for (int i = 0; i < 2; ++i) cv[h][i] = nv[h][i];
        if (wr == 1) PG8_BAR;
    }
    PG8_WAIT_V(0);
    PG8_BAR;
#undef PG8_SA
#undef PG8_SB
#undef PG8_STAGE2
#undef PG8_STAGEB
#undef PG8_LDA
#undef PG8_LDB
#undef PG8_MMA
#undef PG8_WAIT_V
#undef PG8_WAIT_L
#undef PG8_BAR
#undef PG8_SCHED
#undef PG8_VOFFA
}
}
using pg8::GU;

struct Args {
    const float* in[27]; float* out; unsigned char* ws; int ph_lo, ph_hi; int pad0, pad1;
};
enum { IN_X = 0, IN_MEM, IN_NORM_MIX_G, IN_W_IN, IN_W_RET_O, IN_W_NSA_O, IN_W_OUT, IN_CMP_PE_K, IN_CMP_W1_K, IN_CMP_W2_K, IN_CMP_PE_V, IN_CMP_W1_V, IN_CMP_W2_V,
       IN_NORM_X_G, IN_NORM_MEM_G, IN_W_XQ, IN_W_XKV, IN_W_XO, IN_NORM_FFN_G, IN_W_GRP, IN_B_GRP, IN_W_RT, IN_B_RT, IN_W_E1, IN_W_E3, IN_W_E2, IN_NORM_F_G };
struct Frame {
    LAS unsigned char* lds; volatile LAS unsigned* MISC; unsigned* ctl; unsigned char* ws;
    int tid, lane, wave, G, bx;
};

__device__ __forceinline__ bool phase_begin(Frame& F) { int t = threadIdx.x; LAUNDER(t); F.tid = t; F.lane = t & 63; return true; }
__device__ __forceinline__ void transpose_item(const float* W, int ldw, int c0, int k0, bf16* WT, int ldt, int mode, int row_off, int cbase, const float* kscale, float scale, LAS float* scr, int lane) {
    float vv[32];
#pragma unroll
    for (int i = 0; i < 32; ++i) { const int kk = 2 * i + (lane >> 5); vv[i] = W[(size_t)(k0 + kk) * ldw + c0 + (lane & 31)]; }
    if (kscale) {
#pragma unroll
        for (int i = 0; i < 32; ++i) { const int kk = 2 * i + (lane >> 5); vv[i] *= kscale[k0 + kk]; } }
#pragma unroll
    for (int i = 0; i < 32; ++i) { const int kk = 2 * i + (lane >> 5); scr[kk * 33 + (lane & 31)] = vv[i] * scale; }
    LDS_WAIT(); asm volatile("" ::: "memory");
    const int c = lane & 7;
#pragma unroll
    for (int j = 0; j < 4; ++j) { const int n = (lane >> 3) + 8 * j; const LAS float* s = scr + (8 * c) * 33 + n;
        u32x4 o; o.x = pk2(s[0 * 33], s[1 * 33]); o.y = pk2(s[2 * 33], s[3 * 33]); o.z = pk2(s[4 * 33], s[5 * 33]); o.w = pk2(s[6 * 33], s[7 * 33]);
        const int jc = c0 - cbase + n; const int drow = mode == 0 ? row_off + jc : (8 * (jc >> 2) + 4 * row_off + (jc & 3));
        *(u32x4*)(WT + (size_t)drow * ldt + k0 + 8 * c) = o; }
    LDS_WAIT(); asm volatile("" ::: "memory");
}
__device__ __forceinline__ void transpose_matrix(Frame& F, int& item_base, const float* W, int ldw, int K, int cbase, int ncols, bf16* WT, int ldt, int mode, int row_off, const float* kscale, float scale) {
    LAS float* scr = (LAS float*)(F.lds + F.wave * 16384);
    const int gw = F.bx * NWAVES + F.wave, NGW = F.G * NWAVES;
    const int nb = ncols / 32, nitems = (K / 64) * nb;
    int it = (gw - item_base % NGW + NGW) % NGW;
    for (; it < nitems; it += NGW) transpose_item(W, ldw, cbase + 32 * (it % nb), 64 * (it / nb), WT, ldt, mode, row_off, cbase, kscale, scale, scr, F.lane);
    item_base += nitems;
}
__device__ __forceinline__ void rms_row_to_bf16(int lane, const float* xrow, const float* g, bf16* orow) {
    const f32x4* xr = (const f32x4*)xrow + lane; const f32x4* gr = (const f32x4*)g + lane;
    f32x4 v[4]; float s = 0.f;
#pragma unroll
    for (int j = 0; j < 4; ++j) { v[j] = xr[64 * j]; s += (v[j].x * v[j].x + v[j].y * v[j].y) + (v[j].z * v[j].z + v[j].w * v[j].w); }
    const float rstd = 1.0f / sqrtf(wave_sum(s) * (1.f / D) + EPS);
    unsigned long long* o8 = (unsigned long long*)orow + lane;
#pragma unroll
    for (int j = 0; j < 4; ++j) { const f32x4 gg = gr[64 * j];
        o8[64 * j] = (unsigned long long)pk2(v[j].x * rstd * gg.x, v[j].y * rstd * gg.y) | ((unsigned long long)pk2(v[j].z * rstd * gg.z, v[j].w * rstd * gg.w) << 32); }
}

struct XItem { const float* src; bf16* dst; const float* ks; float scale; int ldw, ldt, mode, row_off, csrc, c0, k0, has_ks; };
__device__ __forceinline__ void xitem_decode_expert(const Args& a, unsigned char* ws, int it, XItem& x) {
    const int e = it / 768, r = it % 768, which = r >> 8, t = r & 255;
    x.ks = a.in[IN_NORM_FFN_G]; x.scale = 1.0f;
    if (which < 2) { x.src = a.in[which ? IN_W_E3 : IN_W_E1] + (size_t)e * D * DEXP; x.ldw = DEXP; x.dst = (bf16*)(ws + WS_W13) + (size_t)e * D * D; x.ldt = D; x.mode = 1; x.row_off = which; x.has_ks = 1; x.c0 = 32 * (t & 15); x.k0 = 64 * (t >> 4); }
    else { x.src = a.in[IN_W_E2] + (size_t)e * DEXP * D; x.ldw = D; x.dst = (bf16*)(ws + WS_W2) + (size_t)e * D * DEXP; x.ldt = DEXP; x.mode = 0; x.row_off = 0; x.has_ks = 0; x.c0 = 32 * (t & 31); x.k0 = 64 * (t >> 5); }
    x.csrc = x.c0;
}
constexpr int P0_NITEMS = 7936;
__device__ __forceinline__ void xitem_decode_p0(const Args& a, unsigned char* ws, int it, XItem& x) {
    int in_ = IN_W_IN, ldw = DIN, cb = 0, nc = 512, ldt = D, ro = 0, first = 0; size_t dst = W_IN; float sc = 1.0f; int hk = 0;
#define P0E(FIRST, IN__, LDW, CB, NC, DST, LDT, RO, SC, HK) if (it >= (FIRST)) { in_ = (IN__); ldw = (LDW); cb = (CB); nc = (NC); dst = (DST); ldt = (LDT); ro = (RO); sc = (SC); hk = (HK); first = (FIRST); }
    P0E(256, IN_W_IN, DIN, 512, 512, W_IN, D, 512, 0.08838834764831845f, 0)
    P0E(512, IN_W_IN, DIN, 1024, NPROJ - 1024, W_IN, D, 1024, 1.0f, 0)
    P0E(2816, IN_W_IN, DIN, C_GA, 1024, W_GA, D, 0, 1.0f, 0)
    P0E(3328, IN_W_IN, DIN, C_GB, 1024, W_GB, D, 0, 1.0f, 0)
    P0E(3840, IN_W_RET_O, D, 0, D, W_RO, D, 0, 1.0f, 0)
    P0E(4352, IN_W_NSA_O, D, 0, D, W_NO, D, 0, 1.0f, 0)
    P0E(4864, IN_W_OUT, D, 0, D, W_OUT, D, 0, 1.0f, 0)
    P0E(5376, IN_W_XQ, D, 0, D, W_XQ, D, 0, 1.0f, 1)
    P0E(5888, IN_W_XO, D, 0, D, W_XO, D, 0, 1.0f, 0)
    P0E(6400, IN_W_XKV, 2 * D, 0, 2 * D, W_XKV, D, 0, 1.0f, 0)
    P0E(7424, IN_CMP_W1_K, 128, 0, 128, W_C1K, 4096, 0, 1.0f, 0)
    P0E(7680, IN_CMP_W1_V, 128, 0, 128, W_C1V, 4096, 0, 1.0f, 0)
#undef P0E
    const int t = it - first, nb = nc >> 5;
    x.src = a.in[in_]; x.dst = (bf16*)(ws + dst); x.ks = a.in[IN_NORM_X_G]; x.scale = sc; x.ldw = ldw; x.ldt = ldt; x.mode = 0; x.row_off = ro; x.has_ks = hk;
    x.c0 = 32 * (t % nb); x.csrc = cb + x.c0; x.k0 = 64 * (t / nb);
}
__device__ __forceinline__ void xitem_load(const XItem& x, int lane, float (&vv)[32], f32x4& k0v, f32x4& k1v) {
#pragma unroll
    for (int i = 0; i < 32; ++i) { const int kk = 2 * i + (lane >> 5); vv[i] = x.src[(size_t)(x.k0 + kk) * x.ldw + x.csrc + (lane & 31)]; }
    const f32x4* p = (const f32x4*)(x.ks + ((x.k0 + 8 * (lane & 7)) & 1023)); k0v = p[0]; k1v = p[1];
}
__device__ __forceinline__ void xitem_finish(const XItem& x, int lane, const float (&vv)[32], f32x4 k0v, f32x4 k1v, LAS float* scr) {
    if (!x.has_ks) { k0v = (f32x4){1.f, 1.f, 1.f, 1.f}; k1v = k0v; }
    k0v *= x.scale; k1v *= x.scale;
#pragma unroll
    for (int i = 0; i < 32; ++i) { const int kk = 2 * i + (lane >> 5); scr[kk * 33 + (lane & 31)] = vv[i]; }
    LDS_WAIT(); asm volatile("" ::: "memory");
    const int c = lane & 7;
#pragma unroll
    for (int j = 0; j < 4; ++j) { const int n = (lane >> 3) + 8 * j; const LAS float* s = scr + (8 * c) * 33 + n;
        u32x4 o; o.x = pk2(s[0 * 33] * k0v.x, s[1 * 33] * k0v.y); o.y = pk2(s[2 * 33] * k0v.z, s[3 * 33] * k0v.w); o.z = pk2(s[4 * 33] * k1v.x, s[5 * 33] * k1v.y); o.w = pk2(s[6 * 33] * k1v.z, s[7 * 33] * k1v.w);
        const int jc = x.c0 + n; const int drow = x.mode == 0 ? x.row_off + jc : (8 * (jc >> 2) + 4 * x.row_off + (jc & 3));
        *(u32x4*)(x.dst + (size_t)drow * x.ldt + x.k0 + 8 * c) = o; }
    LDS_WAIT(); asm volatile("" ::: "memory");
}
template <bool EXPERT>
__device__ __forceinline__ void run_items(Frame& F, const Args& a, int it_begin, int it_end) {
    LAS float* scr = (LAS float*)(F.lds + F.wave * 16384);
    const int gw = F.bx * NWAVES + F.wave, NGW = F.G * NWAVES, lane = F.lane;
    int it = it_begin + gw;
#define XDEC(i_, x_) do { if (EXPERT) xitem_decode_expert(a, F.ws, (i_), x_); else xitem_decode_p0(a, F.ws, (i_), x_); } while (0)
    if (it < it_end) {
        float va[32], vb[32]; f32x4 ka0, ka1, kb0, kb1; XItem xa, xb;
        XDEC(it, xa); xitem_load(xa, lane, va, ka0, ka1);
        for (;;) {
            int itn = it + NGW; bool hn = itn < it_end;
            XDEC(hn ? itn : it, xb); xitem_load(xb, lane, vb, kb0, kb1);
            xitem_finish(xa, lane, va, ka0, ka1, scr);
            if (!hn) break;
            it = itn; itn = it + NGW; hn = itn < it_end;
            XDEC(hn ? itn : it, xa); xitem_load(xa, lane, va, ka0, ka1);
            xitem_finish(xb, lane, vb, kb0, kb1, scr);
            if (!hn) break;
            it = itn;
        }
    }
#undef XDEC
    __syncthreads();
}
__device__ __forceinline__ void expert_copies(Frame& F, const Args& a, int e_lo, int e_hi) { run_items<true>(F, a, e_lo * 768, e_hi * 768); }

__device__ __forceinline__ void p0_prologue(Frame& F, const Args& a) {
    unsigned char* ws = F.ws;
    const float* w_in = a.in[IN_W_IN];
    run_items<false>(F, a, 0, P0_NITEMS);
    const int gt = F.bx * NTHREADS + F.tid, NGT = F.G * NTHREADS;
    for (int i = gt; i < 2 * 128 * 4096 / 8; i += NGT) { const int m = i / (128 * 4096 / 8), r = i % (128 * 4096 / 8);
        *(u32x4*)(ws + (m ? W_C1V : W_C1K) + (size_t)128 * 4096 * 2 + (size_t)r * 16) = (u32x4){0u, 0u, 0u, 0u}; }
    bf16* wngl = (bf16*)(ws + WS_SMALLW);
    for (int i = gt; i < 32 * 1024; i += NGT) { const int r = i >> 10, k = i & 1023; wngl[i] = r < 24 ? (bf16)f2bf(w_in[(size_t)k * DIN + C_NGL + r]) : (bf16)0; }
    bf16* w2k = (bf16*)(ws + WS_SMALLW + 65536); bf16* w2v = w2k + 128 * 128;
    for (int i = gt; i < 2 * 128 * 128; i += NGT) { const int m = i >> 14, r = i & 16383, f = r >> 7, e = r & 127; const float* src = a.in[m ? IN_CMP_W2_V : IN_CMP_W2_K];
        (m ? w2v : w2k)[f * 128 + e] = (bf16)f2bf(src[e * 128 + f]); }
    { const float* gff = a.in[IN_NORM_FFN_G]; const float* wgrp = a.in[IN_W_GRP]; const float* wrt = a.in[IN_W_RT]; float* wgp = (float*)(ws + WS_RTW); float* wep = wgp + 4096;
      for (int i = gt; i < 4096; i += NGT) wgp[i] = gff[i >> 2] * wgrp[i];
      for (int i = gt; i < 32768; i += NGT) { const int j = i & 3, l = (i >> 2) & 63, half = (i >> 8) & 1, ii = (i >> 9) & 15, grp = i >> 13, k = 64 * ii + l; wep[i] = gff[k] * wrt[k * 32 + grp * 8 + half * 4 + j]; } }
    float* cbias = (float*)(ws + WS_SMALLW + 65536 + 2 * 128 * 128 * 2);
    const int gw = F.bx * NWAVES + F.wave, NGW = F.G * NWAVES;
    for (int o = gw; o < 256; o += NGW) { const int m = o >> 7, e = o & 127; const float* pe = a.in[m ? IN_CMP_PE_V : IN_CMP_PE_K]; const float* w1 = a.in[m ? IN_CMP_W1_V : IN_CMP_W1_K];
        float s = 0.f; for (int k = F.lane; k < 4096; k += 64) s += pe[k] * w1[(size_t)k * 128 + e];
        s = wave_sum(s); if (F.lane == 0) cbias[o] = s; }
    float* cosT = (float*)(ws + WS_ROPE_COS); float* sinT = (float*)(ws + WS_ROPE_SIN);
    for (int i = gt; i < SEQ * 64; i += NGT) { const int pos = i >> 6, j = i & 63; const float inv = powf(10000.0f, -(float)(2 * j) / 128.0f); const float ang = (float)pos * inv;
        cosT[i] = cosf(ang); sinT[i] = sinf(ang); }
    { f32x4 nx[4]; const float* X = a.in[IN_X]; const f32x4* gr = (const f32x4*)a.in[IN_NORM_MIX_G] + F.lane;
      if (gw < NTOK) {
#pragma unroll
          for (int j = 0; j < 4; ++j) nx[j] = ((const f32x4*)(X + (size_t)gw * D) + F.lane)[64 * j]; }
      for (int m = gw; m < NTOK; m += NGW) { f32x4 v[4]; float sq = 0.f;
#pragma unroll
          for (int j = 0; j < 4; ++j) { v[j] = nx[j]; sq += (v[j].x * v[j].x + v[j].y * v[j].y) + (v[j].z * v[j].z + v[j].w * v[j].w); }
          if (m + NGW < NTOK) {
#pragma unroll
              for (int j = 0; j < 4; ++j) nx[j] = ((const f32x4*)(X + (size_t)(m + NGW) * D) + F.lane)[64 * j]; }
          const float rstd = 1.0f / sqrtf(wave_sum(sq) * (1.f / D) + EPS); unsigned long long* o8 = (unsigned long long*)((bf16*)(ws + WS_H) + (size_t)m * D) + F.lane;
#pragma unroll
          for (int j = 0; j < 4; ++j) { const f32x4 gg = gr[64 * j]; o8[64 * j] = (unsigned long long)pk2(v[j].x * rstd * gg.x, v[j].y * rstd * gg.y) | ((unsigned long long)pk2(v[j].z * rstd * gg.z, v[j].w * rstd * gg.w) << 32); } } }
    for (int m = gw; m < NMEMTOK; m += NGW) rms_row_to_bf16(F.lane, a.in[IN_MEM] + (size_t)m * D, a.in[IN_NORM_MEM_G], (bf16*)(ws + WS_MEMN) + (size_t)m * D);
}

struct SchedP1 {
    unsigned char* ws; int G, c;
    __device__ __forceinline__ bool next(int i, GU& u) const {
        constexpr int NP = 128 * 22; const int L = i * G + c;
        u.rows = nullptr; u.nvalid = 0; u.aux = 0;
        if (L < NP) { int pm, pn; pg8::tile_map(L, 128, 22, pm, pn); u.A = (const char*)ws + WS_H + (size_t)pm * 256 * D * 2; u.B = (const char*)ws + W_IN + (size_t)pn * 256 * D * 2; u.pm = pm; u.pn = pn;
            u.kind = pn < 2 ? 0 : pn < 4 ? 1 : pn < 8 ? 2 : pn < 12 ? 3 : pn < 16 ? 4 : 5; return true; }
        const int L2 = L - NP; if (L2 >= 64) return false;
        const int pm = L2 & 7, pn = L2 >> 3; u.A = (const char*)ws + WS_MEMN + (size_t)pm * 256 * D * 2; u.B = (const char*)ws + W_XKV + (size_t)pn * 256 * D * 2; u.pm = pm; u.pn = pn; u.kind = 6; return true;
    }
};
struct EpiP1 {
    static constexpr bool PERM = true;
    unsigned char* ws;
    __device__ __forceinline__ void operator()(const f32x4 (&acc)[2][2][4][2], const GU& u, int wr, int wc, int fr, int fq) const {
        const int kind = u.kind;
        const float* cosT = (const float*)(ws + WS_ROPE_COS); const float* sinT = (const float*)(ws + WS_ROPE_SIN);
#pragma unroll
        for (int ai = 0; ai < 2; ++ai)
#pragma unroll
            for (int m = 0; m < 4; ++m) {
                const int r = 128 * ai + 64 * wr + 16 * m + fr; const int tok = u.pm * 256 + r;
#pragma unroll
                for (int bj = 0; bj < 2; ++bj) {
                    f32x4 v0 = acc[ai][bj][m][0], v1 = acc[ai][bj][m][1];
                    const int ct = 128 * bj + 32 * wc + 8 * fq;
                    bf16* dst;
                    if (kind <= 1) {
                        const int s = tok & (SEQ - 1), i0 = ((ct & 127) >> 1);
                        const f32x4 cs = *(const f32x4*)(cosT + s * 64 + i0), sn = *(const f32x4*)(sinT + s * 64 + i0);
                        const f32x4 a0 = v0, a1 = v1;
                        v0[0] = a0[0] * cs[0] - a0[1] * sn[0]; v0[1] = a0[0] * sn[0] + a0[1] * cs[0];
                        v0[2] = a0[2] * cs[1] - a0[3] * sn[1]; v0[3] = a0[2] * sn[1] + a0[3] * cs[1];
                        v1[0] = a1[0] * cs[2] - a1[1] * sn[2]; v1[1] = a1[0] * sn[2] + a1[1] * cs[2];
                        v1[2] = a1[2] * cs[3] - a1[3] * sn[3]; v1[3] = a1[2] * sn[3] + a1[3] * cs[3];
                        dst = (bf16*)(ws + (kind == 0 ? WS_RQ : WS_RK)) + (size_t)tok * 512 + (u.pn & 1) * 256 + ct;
                    } else if (kind == 2) { dst = (bf16*)(ws + WS_RV) + (size_t)tok * 1024 + (u.pn - 4) * 256 + ct;
                    } else if (kind == 3) {
#pragma unroll
                        for (int j = 0; j < 4; ++j) { v0[j] = v0[j] * sigmoidf_(v0[j]); v1[j] = v1[j] * sigmoidf_(v1[j]); }
                        dst = (bf16*)(ws + WS_RG) + (size_t)tok * 1024 + (u.pn - 8) * 256 + ct;
                    } else if (kind == 4) { dst = (bf16*)(ws + WS_NQ) + (size_t)tok * 1024 + (u.pn - 12) * 256 + ct;
                    } else if (kind == 5) {
                        const int b = tok >> 12, s = tok & (SEQ - 1);
                        unsigned char* kvb = ws + WS_KV6 + (size_t)(u.pn - 16) * KV_STRIDE;
                        dst = (bf16*)kvb + ((size_t)(b * 2 + bj) * SEQ + s) * 128 + (ct & 127);
                    } else { dst = (bf16*)(ws + WS_MEMKV) + (size_t)tok * 2048 + u.pn * 256 + ct; }
                    u32x4 w; w.x = cvt_pk_bf16(v0[0], v0[1]); w.y = cvt_pk_bf16(v0[2], v0[3]); w.z = cvt_pk_bf16(v1[0], v1[1]); w.w = cvt_pk_bf16(v1[2], v1[3]);
                    *(u32x4*)dst = w;
                }
            }
    }
};
__device__ __forceinline__ void p1_gate_logits(Frame& F) {
    const bf16* H = (const bf16*)(F.ws + WS_H); const bf16* W = (const bf16*)(F.ws + WS_SMALLW); float* gates = (float*)(F.ws + WS_GATES);
    const int r = F.lane & 31, hh = F.lane >> 5;
    const int nb_ = F.G > 64 ? F.G - 64 : F.G, b0_ = F.G > 64 ? F.bx - 64 : F.bx;
    if (b0_ < 0) return;
    for (int rb = b0_ + nb_ * F.wave; rb < NTOK / 32; rb += nb_ * NWAVES) {
        f32x16 acc; for (int j = 0; j < 16; ++j) acc[j] = 0.f;
        const bf16* ap = H + (size_t)(rb * 32 + r) * D + 8 * hh; const bf16* bp = W + (size_t)r * D + 8 * hh;
        for (int s8 = 0; s8 < 8; ++s8) { bf16x8 av[8], bv[8];
#pragma unroll
            for (int q = 0; q < 8; ++q) { av[q] = *(const bf16x8*)(ap + 16 * (8 * s8 + q)); bv[q] = *(const bf16x8*)(bp + 16 * (8 * s8 + q)); }
#pragma unroll
            for (int q = 0; q < 8; ++q) acc = __builtin_amdgcn_mfma_f32_32x32x16_bf16(av[q], bv[q], acc, 0, 0, 0); }
        if (r < 24) {
#pragma unroll
            for (int reg = 0; reg < 16; ++reg) { const int row = (reg & 3) + 8 * (reg >> 2) + 4 * hh; gates[(size_t)(rb * 32 + row) * 24 + r] = sigmoidf_(acc[reg]); }
        }
    }
}

namespace retf {
constexpr int ROWB = 272;
constexpr int OFF_K = 0, OFF_V = 128 * 256, OFF_ZV = OFF_V + 128 * 64, OFF_ST = OFF_ZV + 128 * 64, OFF_PART = OFF_ST + 32 * ROWB, OFF_Q = OFF_PART + 4 * 4096;
static_assert(OFF_Q + 128 * 256 <= RING_BYTES, "retention LDS map");
typedef short s16x4 __attribute__((ext_vector_type(4)));
__device__ __forceinline__ u32x2 lds_tr(const LAS unsigned char* p) { return __builtin_bit_cast(u32x2, __builtin_amdgcn_ds_read_tr16_b64_v4i16((LAS s16x4*)p)); }
}
__device__ __forceinline__ void p2_retention_fast(Frame& F, int unit, bf16* outbase) {
    using namespace retf;
    const int bh = (unit & 7) * 4 + (unit >> 6), sl = (unit >> 3) & 7, b = bh >> 2, h = bh & 3;
    const bf16* rq = (const bf16*)(F.ws + WS_RQ); const bf16* rk = (const bf16*)(F.ws + WS_RK); const bf16* rv = (const bf16*)(F.ws + WS_RV);
    const int tid = F.tid, lane = F.lane, wave = F.wave, r = lane & 31, hi = lane >> 5; LAS unsigned char* lds = F.lds;
    const float lg = log2f(1.0f - exp2f(-5.0f - (float)h));
    const int nt = wave & 3, mh = wave >> 2;
    for (int i = tid; i < 32 * ROWB / 4; i += NTHREADS) ((LAS unsigned*)(lds + OFF_ST))[i] = 0u;
    f32x16 ST;
#pragma unroll
    for (int j = 0; j < 16; ++j) ST[j] = 0.f;
    const float gC = exp2f(128.0f * lg);
    const float zeta = exp2f((float)(127 - (tid >> 2)) * lg);
    const int blk = (lane >> 4) & 1, q4 = (lane & 15) >> 2, p4 = lane & 3;
    const int vtr = (4 * hi + q4) * 64 + 32 * blk + 8 * p4;
    const int ztr = (8 * hi + q4) * 64 + 32 * blk + 8 * p4;
    int ktr[2];
#pragma unroll
    for (int t = 0; t < 2; ++t) ktr[t] = 256 * (8 * hi + 4 * t + q4) + 16 * ((4 * nt + 2 * blk + (p4 >> 1)) ^ ((q4 << 2) | ((2 * hi + t) & 3))) + 8 * (p4 & 1);
    const int krow = 256 * r + 16 * (hi ^ (((r & 3) << 2) | ((r >> 2) & 3)));
    u32x4 kreg[4], qreg[4], vreg;
    {   const int tok0 = b * SEQ;
#pragma unroll
        for (int i = 0; i < 4; ++i) { const int p = tid + 512 * i, m = p >> 4, cc = p & 15; kreg[i] = *(const u32x4*)(rk + (size_t)(tok0 + m) * 512 + h * 128 + cc * 8); qreg[i] = *(const u32x4*)(rq + (size_t)(tok0 + m) * 512 + h * 128 + cc * 8); }
        { const int m = tid >> 2, cc = tid & 3; vreg = *(const u32x4*)(rv + (size_t)(tok0 + m) * 1024 + h * 256 + sl * 32 + cc * 8); } }
    u32x2 opk[4]; bf16* oprev = outbase;
#pragma unroll
    for (int i = 0; i < 4; ++i) opk[i] = (u32x2){0u, 0u};
    for (int c = 0; c < SEQ / 128; ++c) {
        const int tok0 = b * SEQ + c * 128;
        __syncthreads();
#pragma unroll
        for (int i = 0; i < 4; ++i) { const int p = tid + 512 * i, m = p >> 4, cc = p & 15; const int o_ = 256 * m + 16 * (cc ^ (((m & 3) << 2) | ((m >> 2) & 3)));
            *(LAS u32x4*)(lds + OFF_K + o_) = kreg[i]; *(LAS u32x4*)(lds + OFF_Q + o_) = qreg[i]; }
        { const u32x4 v = vreg; u32x4 zv;
            zv.x = cvt_pk_bf16(lo16(v.x) * zeta, hi16(v.x) * zeta); zv.y = cvt_pk_bf16(lo16(v.y) * zeta, hi16(v.y) * zeta); zv.z = cvt_pk_bf16(lo16(v.z) * zeta, hi16(v.z) * zeta); zv.w = cvt_pk_bf16(lo16(v.w) * zeta, hi16(v.w) * zeta);
            *(LAS u32x4*)(lds + OFF_V + tid * 16) = v; *(LAS u32x4*)(lds + OFF_ZV + tid * 16) = zv; }
        __syncthreads();
        if (mh == 0 && c > 0) {
#pragma unroll
            for (int i = 0; i < 4; ++i) *(u32x2*)(oprev + 8 * i + 4 * hi) = opk[i]; }
        if (c + 1 < SEQ / 128) { const int tok1 = tok0 + 128;
#pragma unroll
            for (int i = 0; i < 4; ++i) { const int p = tid + 512 * i, m = p >> 4, cc = p & 15; kreg[i] = *(const u32x4*)(rk + (size_t)(tok1 + m) * 512 + h * 128 + cc * 8); qreg[i] = *(const u32x4*)(rq + (size_t)(tok1 + m) * 512 + h * 128 + cc * 8); }
            { const int m = tid >> 2, cc = tid & 3; vreg = *(const u32x4*)(rv + (size_t)(tok1 + m) * 1024 + h * 256 + sl * 32 + cc * 8); } }
        bf16x8 qf[8];
#pragma unroll
        for (int s_ = 0; s_ < 8; ++s_) qf[s_] = *(const LAS bf16x8*)(lds + OFF_Q + 8192 * nt + (krow ^ (32 * s_)));
        f32x16 CR;
#pragma unroll
        for (int j = 0; j < 16; ++j) CR[j] = 0.f;
        if (mh == 0) {
#pragma unroll
            for (int s_ = 0; s_ < 8; ++s_) { const bf16x8 a = *(const LAS bf16x8*)(lds + OFF_ST + r * ROWB + (16 * s_ + 8 * hi) * 2); CR = __builtin_amdgcn_mfma_f32_32x32x16_bf16(a, qf[s_], CR, 0, 0, 0); }
        }
        f32x16 IN_;
#pragma unroll
        for (int j = 0; j < 16; ++j) IN_[j] = 0.f;
#pragma unroll
        for (int mi = 0; mi < 2; ++mi) { const int mt = 2 * mh + mi;
            if (mt <= nt) {
                f32x16 A;
#pragma unroll
                for (int j = 0; j < 16; ++j) A[j] = 0.f;
#pragma unroll
                for (int s_ = 0; s_ < 8; ++s_) { const bf16x8 a = *(const LAS bf16x8*)(lds + OFF_K + 8192 * mt + (krow ^ (32 * s_))); A = __builtin_amdgcn_mfma_f32_32x32x16_bf16(a, qf[s_], A, 0, 0, 0); }
#pragma unroll
                for (int j = 0; j < 16; ++j) { const int dd = (32 * nt + r) - (32 * mt + (j & 3) + 8 * (j >> 2) + 4 * hi); A[j] = dd >= 0 ? A[j] * __builtin_amdgcn_exp2f((float)dd * lg) : 0.f; }
#pragma unroll
                for (int s2 = 0; s2 < 2; ++s2) { u32x4 w; w.x = cvt_pk_bf16(A[8 * s2 + 0], A[8 * s2 + 1]); w.y = cvt_pk_bf16(A[8 * s2 + 2], A[8 * s2 + 3]); w.z = cvt_pk_bf16(A[8 * s2 + 4], A[8 * s2 + 5]); w.w = cvt_pk_bf16(A[8 * s2 + 6], A[8 * s2 + 7]);
                    const LAS unsigned char* vp = lds + OFF_V + vtr + (32 * mt + 16 * s2) * 64; const u32x2 lo = lds_tr(vp), hi2 = lds_tr(vp + 8 * 64);
                    IN_ = __builtin_amdgcn_mfma_f32_32x32x16_bf16(__builtin_bit_cast(bf16x8, (u32x4){lo.x, lo.y, hi2.x, hi2.y}), __builtin_bit_cast(bf16x8, w), IN_, 0, 0, 0); }
            } }
        if (mh == 1) {
#pragma unroll
            for (int j = 0; j < 16; ++j) ((LAS float*)(lds + OFF_PART))[(nt * 16 + j) * 64 + lane] = IN_[j];
        }
        __syncthreads();
        if (mh == 0) {
            const float xi = __builtin_amdgcn_exp2f((float)(32 * nt + r + 1) * lg);
            bf16* orow = outbase + (size_t)(tok0 + 32 * nt + r) * 1024 + h * 256 + sl * 32;
#pragma unroll
            for (int q4_ = 0; q4_ < 4; ++q4_) { float o_[4];
#pragma unroll
                for (int e = 0; e < 4; ++e) { const int j = 4 * q4_ + e; o_[e] = IN_[j] + ((const LAS float*)(lds + OFF_PART))[(nt * 16 + j) * 64 + lane] + xi * CR[j]; }
                opk[q4_] = (u32x2){cvt_pk_bf16(o_[0], o_[1]), cvt_pk_bf16(o_[2], o_[3])}; }
            oprev = orow;
        } else {
#pragma unroll
            for (int j = 0; j < 16; ++j) ST[j] *= gC;
#pragma unroll
            for (int s_ = 0; s_ < 8; ++s_) {
                const LAS unsigned char* zp = lds + OFF_ZV + ztr + (16 * s_) * 64; const u32x2 z0 = lds_tr(zp), z1 = lds_tr(zp + 4 * 64);
                const u32x2 k0 = lds_tr(lds + OFF_K + ktr[0] + 4096 * s_), k1 = lds_tr(lds + OFF_K + ktr[1] + 4096 * s_);
                ST = __builtin_amdgcn_mfma_f32_32x32x16_bf16(__builtin_bit_cast(bf16x8, (u32x4){z0.x, z0.y, z1.x, z1.y}), __builtin_bit_cast(bf16x8, (u32x4){k0.x, k0.y, k1.x, k1.y}), ST, 0, 0, 0); }
#pragma unroll
            for (int j = 0; j < 16; ++j) { const int dv = (j & 3) + 8 * (j >> 2) + 4 * hi; ((LAS unsigned short*)(lds + OFF_ST))[dv * (ROWB / 2) + 32 * nt + r] = (unsigned short)f2bf(ST[j]); }
        }
    }
    if (mh == 0) {
#pragma unroll
        for (int i = 0; i < 4; ++i) *(u32x2*)(oprev + 8 * i + 4 * hi) = opk[i]; }
    __syncthreads();
}
__device__ __forceinline__ void transpose_kv_tiles(Frame& F, const bf16* src, bf16* dst, int w0, int nw) {
    LAS unsigned short* tl_ = (LAS unsigned short*)(F.lds + F.wave * 16384); const int lane = F.lane;
    for (int tile = w0; tile < 16 * 64 * 2; tile += nw) {
        const int dh = tile & 1, st = (tile >> 1) & 63, bg = tile >> 7;
        const bf16* sp = src + ((size_t)bg * SEQ + st * 64) * 128 + dh * 64; bf16* dp = dst + ((size_t)bg * 128 + dh * 64) * SEQ + st * 64;
#pragma unroll
        for (int i = 0; i < 8; ++i) { const int row = i * 8 + (lane >> 3), c = lane & 7; const u32x4 v = *(const u32x4*)(sp + (size_t)row * 128 + c * 8); LAS unsigned short* q = tl_ + row * 66 + c * 8;
            q[0] = (unsigned short)(v.x & 0xffffu); q[1] = (unsigned short)(v.x >> 16); q[2] = (unsigned short)(v.y & 0xffffu); q[3] = (unsigned short)(v.y >> 16);
            q[4] = (unsigned short)(v.z & 0xffffu); q[5] = (unsigned short)(v.z >> 16); q[6] = (unsigned short)(v.w & 0xffffu); q[7] = (unsigned short)(v.w >> 16); }
        LDS_WAIT(); asm volatile("" ::: "memory");
#pragma unroll
        for (int i = 0; i < 8; ++i) { const int d = i * 8 + (lane >> 3), c = lane & 7; const LAS unsigned short* q = tl_ + (c * 8) * 66 + d;
            u32x4 o; o.x = (unsigned)q[0] | ((unsigned)q[66] << 16); o.y = (unsigned)q[2 * 66] | ((unsigned)q[3 * 66] << 16); o.z = (unsigned)q[4 * 66] | ((unsigned)q[5 * 66] << 16); o.w = (unsigned)q[6 * 66] | ((unsigned)q[7 * 66] << 16);
            *(u32x4*)(dp + (size_t)d * SEQ + c * 8) = o; }
        LDS_WAIT(); asm volatile("" ::: "memory");
    }
}
struct SchedCmp {
    unsigned char* ws; int first, G, c;
    __device__ __forceinline__ bool next(int i, GU& u) const {
        const int L = i * G + c - first; if (L < 0 || L >= 256) return false;
        const int ks = L & 7, mb = L >> 3, m = mb >> 4, bg = mb & 15;
        u.A = (const char*)ws + WS_KV6 + (size_t)m * KV_STRIDE + (size_t)bg * SEQ * 128 * 2 + (size_t)ks * 512 * 2; u.B = (const char*)ws + (m ? W_C1V : W_C1K) + (size_t)ks * 512 * 2;
        u.pm = mb; u.pn = 0; u.kind = ks; u.rows = nullptr; u.nvalid = 0; u.aux = 0; return true;
    }
};
struct EpiCmp {
    static constexpr bool PERM = false;
    float* hid;
    __device__ __forceinline__ void operator()(const f32x4 (&acc)[2][2][4][2], const GU& u, int wr, int wc, int fr, int fq) const {
#pragma unroll
        for (int ai = 0; ai < 2; ++ai)
#pragma unroll
            for (int m = 0; m < 4; ++m) { const int r = 128 * ai + 64 * wr + 16 * m + fr; float* rowp = hid + (size_t)u.kind * (32 * 256 * 128) + ((size_t)u.pm * 256 + r) * 128 + 32 * wc + 4 * fq;
#pragma unroll
                for (int n = 0; n < 2; ++n) *(f32x4*)(rowp + 16 * n) = acc[ai][0][m][n]; }
    }
};
__device__ __forceinline__ float gelu_tanh(float x) { const float u = 0.7978845608028654f * (x + 0.044715f * x * x * x); return 0.5f * x * (1.0f + tanhf(u)); }
__device__ __forceinline__ void p2b_compress_out(Frame& F, const Args& a) {
    const float* hid = (const float*)a.out + (size_t)16 * MiB; const float* cbias = (const float*)(F.ws + WS_SMALLW + 65536 + 2 * 128 * 128 * 2);
    const int gw = F.bx * NWAVES + F.wave, NGW = F.G * NWAVES;
    for (int row = gw; row < 2 * 16 * 256; row += NGW) {
        const int m = row >> 12, n = row & 255; const float* w2 = a.in[m ? IN_CMP_W2_V : IN_CMP_W2_K];
        bf16* dst = (bf16*)(F.ws + (m ? WS_VCMP : WS_KCMP)) + (size_t)(row & 4095) * 128;
        float o0 = 0.f, o1 = 0.f;
        if (n < 255) { const float* hr = hid + (size_t)row * 128;
            for (int e = 0; e < 128; ++e) { float hsum = 0.f;
#pragma unroll
                for (int ks = 0; ks < 8; ++ks) hsum += hr[(size_t)ks * (32 * 256 * 128) + e];
                const float g = gelu_tanh(hsum + cbias[m * 128 + e]); o0 += g * w2[e * 128 + F.lane]; o1 += g * w2[e * 128 + 64 + F.lane]; } }
        dst[F.lane] = (bf16)f2bf(o0); dst[64 + F.lane] = (bf16)f2bf(o1);
        if (m == 1) { bf16* dt = (bf16*)(F.ws + WS_VCMPT) + (size_t)((row >> 8) & 15) * 128 * 256 + n; dt[(size_t)F.lane * 256] = (bf16)f2bf(o0); dt[(size_t)(64 + F.lane) * 256] = (bf16)f2bf(o1); }
    }
}

__device__ __forceinline__ void p3_ret_normalize(Frame& F) {
    bf16* rv = (bf16*)(F.ws + WS_RV); const bf16* rg = (const bf16*)(F.ws + WS_RG);
    const int gw = F.bx * NWAVES + F.wave, NGW = F.G * NWAVES;
    for (int it = gw; it < NTOK * 4; it += NGW) {
        u32x2* p = (u32x2*)(rv + (size_t)it * 256) + F.lane; const u32x2 w = *p; const u32x2 gq = *((const u32x2*)(rg + (size_t)it * 256) + F.lane);
        const float o0 = lo16(w.x), o1 = hi16(w.x), o2 = lo16(w.y), o3 = hi16(w.y);
        const float ss = wave_sum((o0 * o0 + o1 * o1) + (o2 * o2 + o3 * o3));
        const float r = 1.0f / sqrtf(ss * (1.0f / 256.0f) + EPS);
        u32x2 q; q.x = pk2(o0 * r * lo16(gq.x), o1 * r * hi16(gq.x)); q.y = pk2(o2 * r * lo16(gq.y), o3 * r * hi16(gq.y)); *p = q;
    }
}
namespace nsaf {
constexpr int KROW = 272, VROW = 136, KT_BYTES = 64 * KROW, VT_BYTES = 128 * VROW;
constexpr int OFF_K = 0, OFF_V = KT_BYTES, BUF_BYTES = KT_BYTES + VT_BYTES, OFF_IMP = 2 * BUF_BYTES, OFF_MASK = OFF_IMP + 64 * 64 * 4;
constexpr float NEG = -1.0e30f, MASKED = -3.0e38f, CS = 0.08838834764831845f * 1.4426950408889634f;
struct Stage { u32x4 k0, k1, v0, v1; };
__device__ __forceinline__ void stage_load(Stage& st, const bf16* K, const bf16* VT, size_t vpitch, int key0, int tid) {
    const int r0 = tid >> 4, c0 = tid & 15;
    st.k0 = *(const u32x4*)(K + (size_t)(key0 + r0) * 128 + c0 * 8); st.k1 = *(const u32x4*)(K + (size_t)(key0 + r0 + 32) * 128 + c0 * 8);
    const int d0 = tid >> 3, c1 = tid & 7;
    st.v0 = *(const u32x4*)(VT + (size_t)d0 * vpitch + key0 + c1 * 8); st.v1 = *(const u32x4*)(VT + (size_t)(d0 + 64) * vpitch + key0 + c1 * 8);
}
__device__ __forceinline__ void stage_write(const Stage& st, LAS unsigned char* lds, int tid) {
    const int r0 = tid >> 4, c0 = tid & 15;
    *(LAS u32x4*)(lds + OFF_K + r0 * KROW + c0 * 16) = st.k0; *(LAS u32x4*)(lds + OFF_K + (r0 + 32) * KROW + c0 * 16) = st.k1;
    const int d0 = tid >> 3, c1 = tid & 7;
    LAS unsigned char* p0 = lds + OFF_V + d0 * VROW + c1 * 16; LAS unsigned char* p1 = lds + OFF_V + (d0 + 64) * VROW + c1 * 16;
    *(LAS u32x2*)p0 = (u32x2){st.v0.x, st.v0.y}; *(LAS u32x2*)(p0 + 8) = (u32x2){st.v0.z, st.v0.w};
    *(LAS u32x2*)p1 = (u32x2){st.v1.x, st.v1.y}; *(LAS u32x2*)(p1 + 8) = (u32x2){st.v1.z, st.v1.w};
}
template <int MODE>
__device__ __forceinline__ void block_step(const LAS unsigned char* lds, LAS unsigned char* ldstab, const bf16x8 (&qf)[8], f32x16 (&O)[4], float& m, float& l, int blk, int jfast, int tl_in, int itile, int nvr_in, bool rowsel, float inv_l, int lane_in) {
    int tl = tl_in, nvr = nvr_in, lane = lane_in; LAUNDER(tl); LAUNDER(nvr); LAUNDER(lane);
    const int r = lane & 31, hi = lane >> 5;
    f32x16 S[2];
#pragma unroll
    for (int kh = 0; kh < 2; ++kh) {
#pragma unroll
        for (int j = 0; j < 16; ++j) S[kh][j] = 0.f;
    }
    {
        const unsigned kaddr = (unsigned)(size_t)(lds + OFF_K + r * KROW + 16 * hi);
        u32x4 ka[4], kb[4];
#define NSAF_KRD(dst, t, s4) asm volatile("ds_read_b128 %0, %1 offset:%2" : "=v"(dst) : "v"(kaddr), "i"((t) * 32 * KROW + (s4) * 32))
#define NSAF_KRD4(set, t, s0) do { NSAF_KRD(set[0], t, (s0)); NSAF_KRD(set[1], t, (s0) + 1); NSAF_KRD(set[2], t, (s0) + 2); NSAF_KRD(set[3], t, (s0) + 3); } while (0)
#define NSAF_KWAIT(n, set) asm volatile("s_waitcnt lgkmcnt(" #n ")" : "+v"(set[0]), "+v"(set[1]), "+v"(set[2]), "+v"(set[3]))
#define NSAF_KMMA(set, t, s0) do { _Pragma("unroll") for (int q_ = 0; q_ < 4; ++q_) S[t] = __builtin_amdgcn_mfma_f32_32x32x16_bf16(__builtin_bit_cast(bf16x8, set[q_]), qf[(s0) + q_], S[t], 0, 0, 0); } while (0)
        NSAF_KRD4(ka, 0, 0); NSAF_KRD4(kb, 0, 4);
        NSAF_KWAIT(4, ka); NSAF_KMMA(ka, 0, 0); NSAF_KRD4(ka, 1, 0);
        NSAF_KWAIT(4, kb); NSAF_KMMA(kb, 0, 4); NSAF_KRD4(kb, 1, 4);
        NSAF_KWAIT(4, ka); NSAF_KMMA(ka, 1, 0);
        NSAF_KWAIT(0, kb); NSAF_KMMA(kb, 1, 4);
#undef NSAF_KRD
#undef NSAF_KRD4
#undef NSAF_KWAIT
#undef NSAF_KMMA
    }
    bool need_mask;
    if (MODE <= 1) need_mask = true; else if (MODE == 2) need_mask = (blk == itile); else need_mask = (blk == itile) || (blk == itile - 8);
    if (MODE >= 2 && !need_mask && blk >= jfast) {
        const float msub = (MODE == 2 && !rowsel) ? 3.0e38f : m;
        float rs = 0.f;
#pragma unroll
        for (int kh = 0; kh < 2; ++kh)
#pragma unroll
            for (int j = 0; j < 16; ++j) { const float p = __builtin_amdgcn_exp2f(S[kh][j] - msub); S[kh][j] = p; rs += p; }
        l += rs;
    } else {
    float mx = MASKED;
    if (need_mask) {
        int lo_ = -1, hi_ = 63;
        if (MODE <= 1) hi_ = nvr - 64 * blk - 1; else if (MODE == 2) hi_ = tl; else { hi_ = (blk == itile) ? tl : 63; lo_ = (blk == itile - 8) ? tl : -1; }
        lo_ -= 4 * hi; hi_ -= 4 * hi;
#pragma unroll
        for (int kh = 0; kh < 2; ++kh)
#pragma unroll
            for (int j = 0; j < 16; ++j) { const int kc_ = 32 * kh + (j & 3) + 8 * (j >> 2); const bool ok = (kc_ > lo_) & (kc_ <= hi_); const float v = ok ? S[kh][j] : MASKED; S[kh][j] = v; mx = fmaxf(mx, v); }
    } else {
#pragma unroll
        for (int kh = 0; kh < 2; ++kh)
#pragma unroll
            for (int j = 0; j < 16; ++j) mx = fmaxf(mx, S[kh][j]);
    }
    if (MODE == 2) mx = rowsel ? mx : MASKED;
    if (MODE == 1) {
        LAS float* imp = (LAS float*)(ldstab + OFF_IMP) + tl * 64;
        const bool adder = (lane & 3) == 0;
#pragma unroll
        for (int kh = 0; kh < 2; ++kh)
#pragma unroll
            for (int q = 0; q < 4; ++q) {
                float p4[4];
#pragma unroll
                for (int e = 0; e < 4; ++e) { const float p = __builtin_amdgcn_exp2f(S[kh][4 * q + e] - m) * inv_l; S[kh][4 * q + e] = p; p4[e] = p; }
                float sb = (p4[0] + p4[1]) + (p4[2] + p4[3]), sn = p4[3];
                sb += DPP_F(sb, 0xB1, 0xf); sn += DPP_F(sn, 0xB1, 0xf);
                sb += DPP_F(sb, 0x4E, 0xf); sn += DPP_F(sn, 0x4E, 0xf);
                const int bin = 16 * blk + 8 * kh + 2 * q + hi;
                if (adder) { __hip_atomic_fetch_add(imp + bin, sb, __ATOMIC_RELAXED, __HIP_MEMORY_SCOPE_WORKGROUP); if (bin + 1 < 64) __hip_atomic_fetch_add(imp + bin + 1, sn, __ATOMIC_RELAXED, __HIP_MEMORY_SCOPE_WORKGROUP); }
            }
    } else {
        mx = fmaxf(mx, __shfl_xor(mx, 32));
        if (__any(mx > m + 8.0f)) { const float mn = fmaxf(m, mx); const float alpha = __builtin_amdgcn_exp2f(m - mn); m = mn; l *= alpha;
            if (MODE != 0) {
#pragma unroll
                for (int dt = 0; dt < 4; ++dt)
#pragma unroll
                    for (int j = 0; j < 16; ++j) O[dt][j] *= alpha; } }
        float rs = 0.f;
        if (MODE == 2) {
#pragma unroll
            for (int kh = 0; kh < 2; ++kh)
#pragma unroll
                for (int j = 0; j < 16; ++j) { const float p = rowsel ? __builtin_amdgcn_exp2f(S[kh][j] - m) : 0.f; S[kh][j] = p; rs += p; }
        } else {
#pragma unroll
            for (int kh = 0; kh < 2; ++kh)
#pragma unroll
                for (int j = 0; j < 16; ++j) { const float p = __builtin_amdgcn_exp2f(S[kh][j] - m); S[kh][j] = p; rs += p; }
        }
        l += rs;
        if (MODE == 0) return;
    }
    }
    bf16x8 pf[2][2];
#pragma unroll
    for (int kh = 0; kh < 2; ++kh)
#pragma unroll
        for (int s2 = 0; s2 < 2; ++s2) { u32x4 w; w.x = cvt_pk_bf16(S[kh][8 * s2 + 0], S[kh][8 * s2 + 1]); w.y = cvt_pk_bf16(S[kh][8 * s2 + 2], S[kh][8 * s2 + 3]); w.z = cvt_pk_bf16(S[kh][8 * s2 + 4], S[kh][8 * s2 + 5]); w.w = cvt_pk_bf16(S[kh][8 * s2 + 6], S[kh][8 * s2 + 7]);
            pf[kh][s2] = __builtin_bit_cast(bf16x8, w); }
    {
        const unsigned vaddr = (unsigned)(size_t)(lds + OFF_V + r * VROW + 8 * hi);
        u32x2 va[8], vb[8];
#define NSAF_VRD(dst, dt, i) asm volatile("ds_read_b64 %0, %1 offset:%2" : "=v"(dst) : "v"(vaddr), "i"((dt) * 32 * VROW + ((i) >> 1) * 32 + ((i) & 1) * 16))
#define NSAF_VRD8(set, dt) do { NSAF_VRD(set[0], dt, 0); NSAF_VRD(set[1], dt, 1); NSAF_VRD(set[2], dt, 2); NSAF_VRD(set[3], dt, 3); NSAF_VRD(set[4], dt, 4); NSAF_VRD(set[5], dt, 5); NSAF_VRD(set[6], dt, 6); NSAF_VRD(set[7], dt, 7); } while (0)
#define NSAF_VWAIT(n, set) asm volatile("s_waitcnt lgkmcnt(" #n ")" : "+v"(set[0]), "+v"(set[1]), "+v"(set[2]), "+v"(set[3]), "+v"(set[4]), "+v"(set[5]), "+v"(set[6]), "+v"(set[7]))
#define NSAF_VMMA(set, dt) do { _Pragma("unroll") for (int ks = 0; ks < 4; ++ks) { const u32x4 a_ = (u32x4){set[2 * ks].x, set[2 * ks].y, set[2 * ks + 1].x, set[2 * ks + 1].y}; \
            O[dt] = __builtin_amdgcn_mfma_f32_32x32x16_bf16(__builtin_bit_cast(bf16x8, a_), pf[ks >> 1][ks & 1], O[dt], 0, 0, 0); } } while (0)
        NSAF_VRD8(va, 0); NSAF_VRD8(vb, 1);
        NSAF_VWAIT(8, va); NSAF_VMMA(va, 0); NSAF_VRD8(va, 2);
        NSAF_VWAIT(8, vb); NSAF_VMMA(vb, 1); NSAF_VRD8(vb, 3);
        NSAF_VWAIT(8, va); NSAF_VMMA(va, 2);
        NSAF_VWAIT(0, vb); NSAF_VMMA(vb, 3);
#undef NSAF_VRD
#undef NSAF_VRD8
#undef NSAF_VWAIT
#undef NSAF_VMMA
    }
}
template <int MODE>
__device__ __forceinline__ void run_pass(LAS unsigned char* lds, const bf16* K, const bf16* VT, size_t vpitch, int jb, int je, const bf16x8 (&qf)[8], f32x16 (&O)[4], float& m, float& l, bool allowfast, int tl, int itile, int nvr, unsigned long long selmask, float inv_l, int tid, int lane) {
    Stage st; stage_load(st, K, VT, vpitch, jb * 64, tid); stage_write(st, lds, tid);
    if (jb < je) stage_load(st, K, VT, vpitch, (jb + 1) * 64, tid);
    __syncthreads();
    for (int j = jb; j <= je; ++j) {
        const int cur = (j - jb) & 1;
        if (j < je) { stage_write(st, lds + (cur ^ 1) * BUF_BYTES, tid); if (j + 1 < je) stage_load(st, K, VT, vpitch, (j + 2) * 64, tid); }
        const bool rowsel = (MODE == 2) ? (((selmask >> j) & 1ull) != 0ull) : true;
        if (MODE != 2 || __ballot(rowsel) != 0ull) block_step<MODE>(lds + cur * BUF_BYTES, lds, qf, O, m, l, j, allowfast ? jb + (MODE == 2 ? 1 : 2) : 0x7fffffff, tl, itile, nvr, rowsel, inv_l, lane);
        __syncthreads();
    }
}
}
__device__ __forceinline__ void p3_nsa_fast(Frame& F, const bf16* svT, const bf16* wvT, bf16* outbase) {
    using namespace nsaf;
    unsigned char* ws = F.ws; const int tid = F.tid, lane = F.lane, wave = F.wave; LAS unsigned char* lds = F.lds;
    bf16* nq = (bf16*)(ws + WS_NQ); const float* gates = (const float*)(ws + WS_GATES);
    const int r = lane & 31, hi = lane >> 5, qrow = wave * 32 + r, tl = qrow >> 2, head = qrow & 3;
    unsigned failmask = 0u;
    for (int trip = 0; trip < 2; ++trip) {
    for (int u4 = 0; u4 < 4; ++u4) {
        if (trip == 1 && ((failmask >> u4) & 1u) == 0u) continue;
        const bool allowfast = trip == 0;
        const int pr = (F.bx & 7) * 32 + (F.bx >> 3) + (u4 >> 1) * 256; if (F.bx >= 256) break;
        const int bg = pr >> 5, ii = pr & 31, itile = (u4 & 1) ? (63 - ii) : ii, g = bg & 1, b = bg >> 1;
        const int tok = b * SEQ + itile * 64 + tl, t = itile * 64 + tl;
        const bf16* kc = (const bf16*)(ws + WS_KCMP) + (size_t)bg * 256 * 128; const bf16* vcT = (const bf16*)(ws + WS_VCMPT) + (size_t)bg * 128 * 256;
        const bf16* ks = (const bf16*)(ws + WS_KV6 + 2 * KV_STRIDE) + (size_t)bg * SEQ * 128; const bf16* kw = (const bf16*)(ws + WS_KV6 + 4 * KV_STRIDE) + (size_t)bg * SEQ * 128;
        const bf16* vsT = svT + (size_t)bg * 128 * SEQ; const bf16* vwT = wvT + (size_t)bg * 128 * SEQ;
        __syncthreads();
        for (int i = tid; i < 64 * 64; i += NTHREADS) ((LAS float*)(lds + OFF_IMP))[i] = 0.f;
        bf16x8 qf[8];
        {
            LAS unsigned char* tb_ = lds + wave * 8704;
#pragma unroll
            for (int k_ = 0; k_ < 8; ++k_) { const int rr_ = 4 * k_ + (lane >> 4), ch_ = lane & 15, qr_ = wave * 32 + rr_;
                *(LAS u32x4*)(tb_ + rr_ * 272 + ch_ * 16) = *(const u32x4*)(nq + (size_t)(b * SEQ + itile * 64 + (qr_ >> 2)) * 1024 + g * 512 + (qr_ & 3) * 128 + ch_ * 8); }
            LDS_WAIT(); asm volatile("" ::: "memory");
#pragma unroll
            for (int s_ = 0; s_ < 8; ++s_) { const u32x4 w_ = *(const LAS u32x4*)(tb_ + r * 272 + (16 * s_ + 8 * hi) * 2);
                u32x4 o_; o_.x = cvt_pk_bf16(lo16(w_.x) * CS, hi16(w_.x) * CS); o_.y = cvt_pk_bf16(lo16(w_.y) * CS, hi16(w_.y) * CS); o_.z = cvt_pk_bf16(lo16(w_.z) * CS, hi16(w_.z) * CS); o_.w = cvt_pk_bf16(lo16(w_.w) * CS, hi16(w_.w) * CS);
                qf[s_] = __builtin_bit_cast(bf16x8, o_); }
            __syncthreads();
        }
        const float* gatep = gates + (size_t)tok * 24 + (g * 4 + head) * 3;
        const int nvr = (t >= 31) ? (((t - 31) >> 4) + 1 > 255 ? 255 : ((t - 31) >> 4) + 1) : 0;
        const int jec = ((4 * itile + 2) >> 6) > 3 ? 3 : ((4 * itile + 2) >> 6);
        f32x16 O[4];
#define NSAF_ZERO_O() do { _Pragma("unroll") for (int dt = 0; dt < 4; ++dt) _Pragma("unroll") for (int j = 0; j < 16; ++j) O[dt][j] = 0.f; } while (0)
#define NSAF_ADD2(a_, b_) cvt_pk_bf16(lo16(a_) + lo16(b_), hi16(a_) + hi16(b_))
#define NSAF_ACCUM(coef, FIRST) do { const float cf_ = (coef); LAS unsigned char* tb_ = lds + wave * 8704; \
        _Pragma("unroll") for (int dt = 0; dt < 4; ++dt) { _Pragma("unroll") for (int q4 = 0; q4 < 4; ++q4) \
            *(LAS u32x2*)(tb_ + r * 272 + (32 * dt + 8 * q4 + 4 * hi) * 2) = (u32x2){cvt_pk_bf16(cf_ * O[dt][4 * q4], cf_ * O[dt][4 * q4 + 1]), cvt_pk_bf16(cf_ * O[dt][4 * q4 + 2], cf_ * O[dt][4 * q4 + 3])}; } \
        LDS_WAIT(); asm volatile("" ::: "memory"); \
        _Pragma("unroll 2") for (int k_ = 0; k_ < 8; ++k_) { const int rr_ = 4 * k_ + (lane >> 4), ch_ = lane & 15, qr_ = wave * 32 + rr_; \
            const u32x4 nv_ = *(const LAS u32x4*)(tb_ + rr_ * 272 + ch_ * 16); \
            u32x4* gp_ = (u32x4*)(outbase + (size_t)(b * SEQ + itile * 64 + (qr_ >> 2)) * 1024 + g * 512 + (qr_ & 3) * 128 + ch_ * 8); \
            u32x4 w_ = nv_; if (!(FIRST)) { const u32x4 ov_ = *gp_; w_.x = NSAF_ADD2(nv_.x, ov_.x); w_.y = NSAF_ADD2(nv_.y, ov_.y); w_.z = NSAF_ADD2(nv_.z, ov_.z); w_.w = NSAF_ADD2(nv_.w, ov_.w); } \
            *gp_ = w_; } \
        asm volatile("" ::: "memory"); } while (0)
        float m = NEG, l = 0.f; NSAF_ZERO_O();
        run_pass<0>(lds, kc, vcT, 256, 0, jec, qf, O, m, l, false, tl, itile, nvr, 0ull, 0.f, tid, lane);
        l += __shfl_xor(l, 32); const float invl = l > 0.f ? 1.0f / l : 0.f;
        run_pass<1>(lds, kc, vcT, 256, 0, jec, qf, O, m, l, false, tl, itile, nvr, 0ull, invl, tid, lane);
        NSAF_ACCUM(gatep[0], true);
        __syncthreads();
        for (int tk = 0; tk < 8; ++tk) { const int tokl = wave * 8 + tk; float v = ((const LAS float*)(lds + OFF_IMP))[tokl * 64 + lane];
            const bool forced = (lane == 0) || (lane == itile) || (lane == itile - 1); v = (lane > itile) ? -1.0e4f : (forced ? 1.0e4f : v);
            int rank = 0;
#pragma unroll 16
            for (int i = 0; i < 64; ++i) { const float w = __builtin_bit_cast(float, __builtin_amdgcn_readlane(__builtin_bit_cast(int, v), i)); rank += (w > v || (w == v && i < lane)) ? 1 : 0; }
            const unsigned long long mk = __ballot(rank < 16);
            if (lane == 0) { ((LAS unsigned*)(lds + OFF_MASK))[tokl * 2] = (unsigned)mk; ((LAS unsigned*)(lds + OFF_MASK))[tokl * 2 + 1] = (unsigned)(mk >> 32); } }
        __syncthreads();
        const unsigned long long selmask = (unsigned long long)((const LAS unsigned*)(lds + OFF_MASK))[tl * 2] | ((unsigned long long)((const LAS unsigned*)(lds + OFF_MASK))[tl * 2 + 1] << 32);
        m = NEG; l = 0.f; NSAF_ZERO_O();
        run_pass<2>(lds, ks, vsT, SEQ, 0, itile, qf, O, m, l, allowfast, tl, itile, 0, selmask, 0.f, tid, lane);
        l += __shfl_xor(l, 32); bool bad = !(l < 1.0e12f);
        NSAF_ACCUM(l > 0.f ? gatep[1] / l : 0.f, false);
        __syncthreads();
        m = NEG; l = 0.f; NSAF_ZERO_O();
        run_pass<3>(lds, kw, vwT, SEQ, itile > 8 ? itile - 8 : 0, itile, qf, O, m, l, allowfast, tl, itile, 0, 0ull, 0.f, tid, lane);
        l += __shfl_xor(l, 32); bad = bad | !(l < 1.0e12f);
        NSAF_ACCUM(l > 0.f ? gatep[2] / l : 0.f, false);
        if (allowfast && __syncthreads_or(bad ? 1 : 0)) failmask |= 1u << u4;
#undef NSAF_ZERO_O
#undef NSAF_ACCUM
#undef NSAF_ADD2
    }
    if (failmask == 0u) break;
    }
    __syncthreads();
}
struct SchedP4 {
    unsigned char* ws; int G, c; const char* nsa;
    __device__ __forceinline__ bool next(int i, GU& u) const {
        const int ti = i >> 2, sub = i & 3; const int L = ti * G + c; if (L >= 128 * 4) return false;
        int pm, pn; pg8::tile_map(L, 128, 4, pm, pn);
        const size_t ao = sub == 1 ? WS_RV : sub == 3 ? WS_NQ : WS_H; const size_t bo = sub == 0 ? W_GA : sub == 1 ? W_RO : sub == 2 ? W_GB : W_NO;
        u.A = (sub == 3 ? nsa : (const char*)ws + ao) + (size_t)pm * 256 * D * 2; u.B = (const char*)ws + bo + (size_t)pn * 256 * D * 2; u.pm = pm; u.pn = pn; u.kind = sub; u.rows = nullptr; u.nvalid = 0; u.aux = 0; return true;
    }
};
struct EpiP4 {
    static constexpr bool PERM = true;
    float* scr;
    bf16* Y;
    static __device__ __forceinline__ u32x2 pk4(const f32x4 v) { return (u32x2){cvt_pk_bf16(v[0], v[1]), cvt_pk_bf16(v[2], v[3])}; }
    static __device__ __forceinline__ f32x4 up4(const u32x2 w) { return (f32x4){lo16(w.x), hi16(w.x), lo16(w.y), hi16(w.y)}; }
    __device__ __forceinline__ void operator()(const f32x4 (&acc)[2][2][4][2], const GU& u, int wr, int wc, int fr, int fq) const {
        u32x2* p0 = (u32x2*)scr + threadIdx.x; u32x2* p1 = p0 + 32 * 512;
        if (u.kind == 0 || u.kind == 2) {
            u32x2* p = u.kind == 0 ? p0 : p1;
#pragma unroll
            for (int ai = 0; ai < 2; ++ai)
#pragma unroll
                for (int m = 0; m < 4; ++m) {
#pragma unroll
                    for (int bj = 0; bj < 2; ++bj) { f32x4 v0 = acc[ai][bj][m][0], v1 = acc[ai][bj][m][1];
#pragma unroll
                        for (int j = 0; j < 4; ++j) { v0[j] = sigmoidf_(v0[j]); v1[j] = sigmoidf_(v1[j]); }
                        p[(2 * bj) * 512] = pk4(v0); p[(2 * bj + 1) * 512] = pk4(v1); }
                    p += 4 * 512; LAUNDER(p); }
        } else if (u.kind == 1) {
#pragma unroll
            for (int ai = 0; ai < 2; ++ai)
#pragma unroll
                for (int m = 0; m < 4; ++m) {
#pragma unroll
                    for (int bj = 0; bj < 2; ++bj) { p0[(2 * bj) * 512] = pk4(up4(p0[(2 * bj) * 512]) * acc[ai][bj][m][0]); p0[(2 * bj + 1) * 512] = pk4(up4(p0[(2 * bj + 1) * 512]) * acc[ai][bj][m][1]); }
                    p0 += 4 * 512; LAUNDER(p0); }
        } else {
            bf16* yb = Y + (size_t)(u.pm * 256 + 64 * wr + fr) * D + u.pn * 256 + 32 * wc + 8 * fq;
#pragma unroll
            for (int ai = 0; ai < 2; ++ai)
#pragma unroll
                for (int m = 0; m < 4; ++m) {
#pragma unroll
                    for (int bj = 0; bj < 2; ++bj) {
                        const f32x4 v0 = up4(p0[(2 * bj) * 512]) + up4(p1[(2 * bj) * 512]) * acc[ai][bj][m][0], v1 = up4(p0[(2 * bj + 1) * 512]) + up4(p1[(2 * bj + 1) * 512]) * acc[ai][bj][m][1];
                        u32x4 w; w.x = cvt_pk_bf16(v0[0], v0[1]); w.y = cvt_pk_bf16(v0[2], v0[3]); w.z = cvt_pk_bf16(v1[0], v1[1]); w.w = cvt_pk_bf16(v1[2], v1[3]);
                        *(u32x4*)(yb + (size_t)(128 * ai + 16 * m) * D + 128 * bj) = w; }
                    p0 += 4 * 512; p1 += 4 * 512; LAUNDER(p0); LAUNDER(p1); }
        }
    }
};

struct SchedMN {
    unsigned char* ws; size_t ao, bo; int G, c;
    __device__ __forceinline__ bool next(int i, GU& u) const {
        const int L = i * G + c; if (L >= 128 * 4) return false; int pm, pn; pg8::tile_map(L, 128, 4, pm, pn);
        u.A = (const char*)ws + ao + (size_t)pm * 256 * D * 2; u.B = (const char*)ws + bo + (size_t)pn * 256 * D * 2; u.pm = pm; u.pn = pn; u.kind = 0; u.rows = nullptr; u.nvalid = 0; u.aux = 0; return true;
    }
};
template <bool SSQ> struct EpiRes {
    static constexpr bool PERM = false;
    const float* basef; const bf16* baseb; float* out; bf16* ob; float* ssq;
    __device__ __forceinline__ void operator()(const f32x4 (&acc)[2][2][4][2], const GU& u, int wr, int wc, int fr, int fq) const {
#pragma unroll
        for (int ai = 0; ai < 2; ++ai)
#pragma unroll
            for (int m = 0; m < 4; ++m) { const int r = u.pm * 256 + 128 * ai + 64 * wr + 16 * m + fr; const size_t off = (size_t)r * D + u.pn * 256 + 32 * wc + 4 * fq; float sq = 0.f;
#pragma unroll
                for (int bj = 0; bj < 2; ++bj)
#pragma unroll
                    for (int n = 0; n < 2; ++n) { const size_t o = off + 128 * bj + 16 * n; f32x4 bv;
                        if (SSQ) bv = *(const f32x4*)(basef + o); else { const u32x2 bw = *(const u32x2*)(baseb + o); bv = (f32x4){lo16(bw.x), hi16(bw.x), lo16(bw.y), hi16(bw.y)}; }
                        const f32x4 v = bv + acc[ai][bj][m][n];
                        if (!SSQ) *(f32x4*)(out + o) = v;
                        u32x2 w; w.x = cvt_pk_bf16(v[0], v[1]); w.y = cvt_pk_bf16(v[2], v[3]); *(u32x2*)(ob + o) = w; sq += (v[0] * v[0] + v[1] * v[1]) + (v[2] * v[2] + v[3] * v[3]); }
                if (SSQ) { sq += __shfl_xor(sq, 16); sq += __shfl_xor(sq, 32); if (fq == 0) ssq[(size_t)r * 16 + u.pn * 4 + wc] = sq; }
            }
    }
};
struct EpiQ {
    static constexpr bool PERM = true;
    const float* ssq; bf16* Q;
    __device__ __forceinline__ void operator()(const f32x4 (&acc)[2][2][4][2], const GU& u, int wr, int wc, int fr, int fq) const {
#pragma unroll
        for (int ai = 0; ai < 2; ++ai)
#pragma unroll
            for (int m = 0; m < 4; ++m) { const int r = u.pm * 256 + 128 * ai + 64 * wr + 16 * m + fr; const f32x4* sp = (const f32x4*)(ssq + (size_t)r * 16);
                const f32x4 a = sp[0], b = sp[1], c = sp[2], d = sp[3]; const float tot = ((a[0] + a[1]) + (a[2] + a[3])) + ((b[0] + b[1]) + (b[2] + b[3])) + ((c[0] + c[1]) + (c[2] + c[3])) + ((d[0] + d[1]) + (d[2] + d[3]));
                const float rstd = 1.0f / sqrtf(tot * (1.0f / D) + EPS);
#pragma unroll
                for (int bj = 0; bj < 2; ++bj) { const f32x4 v0 = acc[ai][bj][m][0] * rstd, v1 = acc[ai][bj][m][1] * rstd;
                    u32x4 w; w.x = cvt_pk_bf16(v0[0], v0[1]); w.y = cvt_pk_bf16(v0[2], v0[3]); w.z = cvt_pk_bf16(v1[0], v1[1]); w.w = cvt_pk_bf16(v1[2], v1[3]);
                    *(u32x4*)(Q + (size_t)r * D + u.pn * 256 + 128 * bj + 32 * wc + 8 * fq) = w; } }
    }
};

namespace xatf {
constexpr int KROW = 528, VROW = 136, KT_BYTES = 64 * KROW, OFF_K = 0, OFF_V = KT_BYTES;
constexpr float NEG = -1.0e30f, CS = 0.0625f * 1.4426950408889634f;
struct Stage { u32x4 k[4]; u32x4 v[2]; };
__device__ __forceinline__ void stage_load(Stage& st, const bf16* K, const bf16* VT, int key0, int tid) {
#pragma unroll
    for (int i = 0; i < 4; ++i) { const int p = tid + 512 * i, row = p >> 5, c = p & 31; st.k[i] = *(const u32x4*)(K + (size_t)(key0 + row) * 2048 + c * 8); }
#pragma unroll
    for (int i = 0; i < 2; ++i) { const int p = tid + 512 * i, d = p >> 3, c = p & 7; st.v[i] = *(const u32x4*)(VT + (size_t)d * 256 + key0 + c * 8); }
}
__device__ __forceinline__ void stage_write(const Stage& st, LAS unsigned char* lds, int tid) {
#pragma unroll
    for (int i = 0; i < 4; ++i) { const int p = tid + 512 * i, row = p >> 5, c = p & 31; *(LAS u32x4*)(lds + OFF_K + row * KROW + c * 16) = st.k[i]; }
#pragma unroll
    for (int i = 0; i < 2; ++i) { const int p = tid + 512 * i, d = p >> 3, c = p & 7; LAS unsigned char* q = lds + OFF_V + d * VROW + c * 16;
        *(LAS u32x2*)q = (u32x2){st.v[i].x, st.v[i].y}; *(LAS u32x2*)(q + 8) = (u32x2){st.v[i].z, st.v[i].w}; }
}
__device__ __forceinline__ void block_step(const LAS unsigned char* lds, const bf16x8 (&qf)[16], f32x16 (&O)[4], float& m, float& l, int lane) {
    const int r = lane & 31, hi = lane >> 5;
    f32x16 S[2];
#pragma unroll
    for (int kh = 0; kh < 2; ++kh) {
#pragma unroll
        for (int j = 0; j < 16; ++j) S[kh][j] = 0.f;
#pragma unroll
        for (int s_ = 0; s_ < 16; ++s_) { const bf16x8 a = *(const LAS bf16x8*)(lds + OFF_K + (kh * 32 + r) * KROW + (16 * s_ + 8 * hi) * 2); S[kh] = __builtin_amdgcn_mfma_f32_32x32x16_bf16(a, qf[s_], S[kh], 0, 0, 0); }
    }
    float mx = NEG;
#pragma unroll
    for (int kh = 0; kh < 2; ++kh)
#pragma unroll
        for (int j = 0; j < 16; ++j) { const float v = S[kh][j] * CS; S[kh][j] = v; mx = fmaxf(mx, v); }
    mx = fmaxf(mx, __shfl_xor(mx, 32));
    const float mn = fmaxf(m, mx); const float alpha = __builtin_amdgcn_exp2f(m - mn); m = mn; float rs = 0.f;
#pragma unroll
    for (int kh = 0; kh < 2; ++kh)
#pragma unroll
        for (int j = 0; j < 16; ++j) { const float p = __builtin_amdgcn_exp2f(S[kh][j] - mn); S[kh][j] = p; rs += p; }
    l = l * alpha + rs;
#pragma unroll
    for (int dt = 0; dt < 4; ++dt)
#pragma unroll
        for (int j = 0; j < 16; ++j) O[dt][j] *= alpha;
    bf16x8 pf[2][2];
#pragma unroll
    for (int kh = 0; kh < 2; ++kh)
#pragma unroll
        for (int s2 = 0; s2 < 2; ++s2) { u32x4 w; w.x = cvt_pk_bf16(S[kh][8 * s2 + 0], S[kh][8 * s2 + 1]); w.y = cvt_pk_bf16(S[kh][8 * s2 + 2], S[kh][8 * s2 + 3]); w.z = cvt_pk_bf16(S[kh][8 * s2 + 4], S[kh][8 * s2 + 5]); w.w = cvt_pk_bf16(S[kh][8 * s2 + 6], S[kh][8 * s2 + 7]);
            pf[kh][s2] = __builtin_bit_cast(bf16x8, w); }
#pragma unroll
    for (int dt = 0; dt < 4; ++dt)
#pragma unroll
        for (int kh = 0; kh < 2; ++kh)
#pragma unroll
            for (int s2 = 0; s2 < 2; ++s2) { const LAS unsigned char* vp = lds + OFF_V + (dt * 32 + r) * VROW + (32 * kh + 16 * s2 + 4 * hi) * 2;
                const u32x2 lo = *(const LAS u32x2*)vp, hi2 = *(const LAS u32x2*)(vp + 16); const u32x4 av = (u32x4){lo.x, lo.y, hi2.x, hi2.y};
                O[dt] = __builtin_amdgcn_mfma_f32_32x32x16_bf16(__builtin_bit_cast(bf16x8, av), pf[kh][s2], O[dt], 0, 0, 0); }
}
}
__device__ __forceinline__ void p7_xattn_fast(Frame& F, const bf16* vT, bf16* outbase) {
    using namespace xatf;
    bf16* Q = (bf16*)(F.ws + WS_NQ); const bf16* KV = (const bf16*)(F.ws + WS_MEMKV);
    const int tid = F.tid, lane = F.lane, wave = F.wave, r = lane & 31, hi = lane >> 5; LAS unsigned char* lds = F.lds;
    for (int u = F.bx; u < BATCH * 4 * 16; u += F.G) {
        const int tt = u & 15, bh = u >> 4, b = bh >> 2, h = bh & 3; const int tok = b * SEQ + tt * 256 + wave * 32 + r;
        bf16* qrow = Q + (size_t)tok * D + h * 256; bf16* orow = outbase + (size_t)tok * D + h * 256; const bf16* Kb = KV + (size_t)(b * NMEM) * 2048 + h * 256;
        bf16x8 qf[16];
        LAS unsigned char* tb_ = lds + 61440 + wave * 8704;
        bf16* rows0 = Q + (size_t)(b * SEQ + tt * 256 + wave * 32) * D + h * 256;
#pragma unroll
        for (int hq = 0; hq < 2; ++hq) {
#pragma unroll 4
            for (int k_ = 0; k_ < 8; ++k_) { const int rr_ = 4 * k_ + (lane >> 4), ch_ = lane & 15; *(LAS u32x4*)(tb_ + rr_ * 272 + ch_ * 16) = *(const u32x4*)(rows0 + (size_t)rr_ * D + hq * 128 + ch_ * 8); }
            LDS_WAIT(); asm volatile("" ::: "memory");
#pragma unroll
            for (int s_ = 0; s_ < 8; ++s_) qf[8 * hq + s_] = *(const LAS bf16x8*)(tb_ + r * 272 + (16 * s_ + 8 * hi) * 2);
            LDS_WAIT(); asm volatile("" ::: "memory");
        }
        const bf16* VT0 = vT + (size_t)bh * 256 * 256;
        Stage st; stage_load(st, Kb, VT0, 0, tid);
        f32x16 O[4]; float m = NEG, l = 0.f;
        for (int idx = 0; idx < 8; ++idx) {
            const int half = idx >> 2, j = idx & 3;
            if (j == 0) { m = NEG; l = 0.f;
#pragma unroll
                for (int dt = 0; dt < 4; ++dt)
#pragma unroll
                    for (int jj = 0; jj < 16; ++jj) O[dt][jj] = 0.f; }
            __syncthreads(); stage_write(st, lds, tid);
            { const int i2 = idx < 7 ? idx + 1 : idx; stage_load(st, Kb, VT0 + (size_t)((i2 >> 2) * 128) * 256, (i2 & 3) * 64, tid); }
            __syncthreads();
            block_step(lds, qf, O, m, l, lane);
            if (j == 3) {
                l += __shfl_xor(l, 32); const float inv = 1.0f / l;
#pragma unroll
                for (int dt = 0; dt < 4; ++dt)
#pragma unroll
                    for (int q4 = 0; q4 < 4; ++q4) *(LAS u32x2*)(tb_ + r * 272 + (32 * dt + 8 * q4 + 4 * hi) * 2) = (u32x2){cvt_pk_bf16(O[dt][4 * q4] * inv, O[dt][4 * q4 + 1] * inv), cvt_pk_bf16(O[dt][4 * q4 + 2] * inv, O[dt][4 * q4 + 3] * inv)};
                LDS_WAIT(); asm volatile("" ::: "memory");
#pragma unroll 2
                for (int k_ = 0; k_ < 8; ++k_) { const int rr_ = 4 * k_ + (lane >> 4), ch_ = lane & 15; *(u32x4*)(rows0 + (size_t)rr_ * D + half * 128 + ch_ * 8) = *(const LAS u32x4*)(tb_ + rr_ * 272 + ch_ * 16); }
                LDS_WAIT(); asm volatile("" ::: "memory");
            }
        }
    }
    __syncthreads();
}
__device__ __forceinline__ void transpose_memv_tiles(Frame& F, bf16* vT, int w0, int nw) {
    LAS unsigned short* tl_ = (LAS unsigned short*)(F.lds + F.wave * 16384); const int lane = F.lane; const bf16* KV = (const bf16*)(F.ws + WS_MEMKV);
    for (int tile = w0; tile < 32 * 16; tile += nw) {
        const int dq = tile & 3, kq = (tile >> 2) & 3, bh = tile >> 4, b = bh >> 2, h = bh & 3;
        const bf16* sp = KV + (size_t)(b * NMEM + kq * 64) * 2048 + 1024 + h * 256 + dq * 64; bf16* dp = vT + ((size_t)bh * 256 + dq * 64) * 256 + kq * 64;
#pragma unroll
        for (int i = 0; i < 8; ++i) { const int row = i * 8 + (lane >> 3), c = lane & 7; const u32x4 v = *(const u32x4*)(sp + (size_t)row * 2048 + c * 8); LAS unsigned short* q = tl_ + row * 66 + c * 8;
            q[0] = (unsigned short)(v.x & 0xffffu); q[1] = (unsigned short)(v.x >> 16); q[2] = (unsigned short)(v.y & 0xffffu); q[3] = (unsigned short)(v.y >> 16);
            q[4] = (unsigned short)(v.z & 0xffffu); q[5] = (unsigned short)(v.z >> 16); q[6] = (unsigned short)(v.w & 0xffffu); q[7] = (unsigned short)(v.w >> 16); }
        LDS_WAIT(); asm volatile("" ::: "memory");
#pragma unroll
        for (int i = 0; i < 8; ++i) { const int d = i * 8 + (lane >> 3), c = lane & 7; const LAS unsigned short* q = tl_ + (c * 8) * 66 + d;
            u32x4 o; o.x = (unsigned)q[0] | ((unsigned)q[66] << 16); o.y = (unsigned)q[2 * 66] | ((unsigned)q[3 * 66] << 16); o.z = (unsigned)q[4 * 66] | ((unsigned)q[5 * 66] << 16); o.w = (unsigned)q[6 * 66] | ((unsigned)q[7 * 66] << 16);
            *(u32x4*)(dp + (size_t)d * 256 + c * 8) = o; }
        LDS_WAIT(); asm volatile("" ::: "memory");
    }
}

__device__ __forceinline__ void p9_route(Frame& F, const Args& a) {
    unsigned char* ws = F.ws; const float* X2 = a.out;
    const float* gff = a.in[IN_NORM_FFN_G]; const float* wgrp = a.in[IN_W_GRP]; const float* bgrp = a.in[IN_B_GRP]; const float* wrt = a.in[IN_W_RT]; const float* brt = a.in[IN_B_RT];
    float* wts = (float*)(ws + WS_ROUTE); float* rstd2 = wts + 2 * NTOK; int* lists = (int*)(ws + WS_LISTS);
    const int gw = F.bx * NWAVES + F.wave, NGW = F.G * NWAVES, lane = F.lane;
    const f32x4* wgp = (const f32x4*)(ws + WS_RTW); const f32x4* wep = wgp + 1024;
    float xn[16];
    if (gw < NTOK) {
#pragma unroll
        for (int i = 0; i < 16; ++i) xn[i] = X2[(size_t)gw * D + 64 * i + lane]; }
    int my_ea = -1, my_eb = -1, my_tok = -1, it_ = 0; float my_w1 = 0.f, my_w2 = 0.f, my_rstd = 0.f;
    for (int tok = gw; tok < NTOK; tok += NGW, ++it_) {
        float xa[16]; float s = 0.f;
#pragma unroll
        for (int i = 0; i < 16; ++i) { xa[i] = xn[i]; s += xa[i] * xa[i]; }
        if (tok + NGW < NTOK) {
#pragma unroll
            for (int i = 0; i < 16; ++i) xn[i] = X2[(size_t)(tok + NGW) * D + 64 * i + lane]; }
        const float rstd = 1.0f / sqrtf(wave_sum(s) * (1.f / D) + EPS);
        float lg[4] = {0.f, 0.f, 0.f, 0.f};
#pragma unroll
        for (int i = 0; i < 16; ++i) { const f32x4 wg = wgp[64 * i + lane];
#pragma unroll
            for (int c = 0; c < 4; ++c) lg[c] += xa[i] * wg[c]; }
#pragma unroll
        for (int i = 0; i < 4; ++i) lg[i] = rstd * wave_sum(lg[i]) + bgrp[i];
        int grp = 0; float gm = lg[0];
#pragma unroll
        for (int i = 1; i < 4; ++i) if (lg[i] > gm) { gm = lg[i]; grp = i; }
        grp = __builtin_amdgcn_readfirstlane(grp);
        float gs = 0.f;
#pragma unroll
        for (int i = 0; i < 4; ++i) gs += expf(lg[i] - gm);
        const float g_gate = 1.0f / gs;
        float lq[8];
#pragma unroll
        for (int i = 0; i < 8; ++i) lq[i] = 0.f;
        const f32x4* pwe = wep + (size_t)grp * (16 * 2 * 64) + lane;
#pragma unroll
        for (int i = 0; i < 16; ++i) { const f32x4 wa = pwe[(2 * i) * 64], wb = pwe[(2 * i + 1) * 64];
#pragma unroll
            for (int c = 0; c < 4; ++c) { lq[c] += xa[i] * wa[c]; lq[4 + c] += xa[i] * wb[c]; } }
#pragma unroll
        for (int i = 0; i < 8; ++i) lq[i] = rstd * wave_sum(lq[i]) + brt[grp * 8 + i];
        int i1 = 0; float m1 = lq[0];
#pragma unroll
        for (int i = 1; i < 8; ++i) if (lq[i] > m1) { m1 = lq[i]; i1 = i; }
        int i2 = -1; float m2 = -3.0e38f;
#pragma unroll
        for (int i = 0; i < 8; ++i) if (i != i1 && lq[i] > m2) { m2 = lq[i]; i2 = i; }
        const float e2 = expf(m2 - m1), den = 1.0f + e2; const float w1 = g_gate / den, w2 = g_gate * e2 / den;
        if (lane == it_) { my_ea = grp * 8 + i1; my_eb = grp * 8 + i2; my_tok = tok; my_w1 = w1; my_w2 = w2; my_rstd = rstd; }
    }
    LAS unsigned* cnt = (LAS unsigned*)(F.lds + MISC_OFF + 1024); LAS unsigned* base = cnt + 32;
    __syncthreads();
    if (F.tid < 32) cnt[F.tid] = 0u;
    __syncthreads();
    unsigned pa = 0u, pb = 0u;
    if (my_tok >= 0) { pa = __hip_atomic_fetch_add(cnt + my_ea, 1u, __ATOMIC_RELAXED, __HIP_MEMORY_SCOPE_WORKGROUP); pb = __hip_atomic_fetch_add(cnt + my_eb, 1u, __ATOMIC_RELAXED, __HIP_MEMORY_SCOPE_WORKGROUP); }
    __syncthreads();
    if (F.tid < 32) { const unsigned c = cnt[F.tid]; base[F.tid] = c ? __hip_atomic_fetch_add(F.ctl + CW_ECNT + 64 * F.tid, c, __ATOMIC_RELAXED, __HIP_MEMORY_SCOPE_AGENT) : 0u; }
    __syncthreads();
    if (my_tok >= 0) {
        lists[(size_t)my_ea * NTOK + base[my_ea] + pa] = my_tok * 2; lists[(size_t)my_eb * NTOK + base[my_eb] + pb] = my_tok * 2 + 1;
        wts[my_tok * 2] = my_w1; wts[my_tok * 2 + 1] = my_w2; rstd2[my_tok] = my_rstd;
    }
    __syncthreads();
}
__device__ __forceinline__ void moe_tiles(Frame& F) {
    __syncthreads();
    if (F.tid < NEXP) F.MISC[64 + F.tid] = __hip_atomic_load(F.ctl + CW_ECNT + 64 * F.tid, __ATOMIC_RELAXED, __HIP_MEMORY_SCOPE_AGENT);
    __syncthreads();
    if (F.tid == 0) { unsigned accu = 0u; for (int e = 0; e < NEXP; ++e) { const unsigned c = F.MISC[64 + e]; F.MISC[16 + e] = accu; accu += (c + 255u) >> 8; } F.MISC[16 + NEXP] = accu; }
    __syncthreads();
}
template <int WHICH> struct SchedMoe {
    volatile LAS unsigned* MISC; unsigned char* ws; int G, c;
    __device__ __forceinline__ bool next(int i, GU& u) const {
        const int L = i * G + c; const int T = (int)MISC[16 + NEXP]; if (L >= 4 * T) return false;
        const int tau = L >> 2, pn = L & 3;
        const int ln_ = threadIdx.x & 63; const int st_ = (ln_ >= 1 && ln_ < NEXP) ? (int)MISC[16 + ln_] : 0x7fffffff;
        const int e = __popcll(__ballot(st_ <= tau));
        const int lt = tau - (int)MISC[16 + e]; const int cnt = (int)MISC[64 + e]; int nv = cnt - lt * 256; nv = nv > 256 ? 256 : nv;
        u.rows = (const int*)(ws + WS_LISTS) + (size_t)e * NTOK + lt * 256; u.nvalid = nv; u.pm = tau; u.pn = pn; u.kind = 0; u.aux = e;
        if (WHICH == 0) { u.A = (const char*)ws + WS_X2B; u.B = (const char*)ws + WS_W13 + (size_t)e * D * D * 2 + (size_t)pn * 256 * D * 2; }
        else { u.A = (const char*)ws + WS_H1 + (size_t)tau * 256 * DEXP * 2; u.B = (const char*)ws + WS_W2 + (size_t)e * D * DEXP * 2 + (size_t)pn * 256 * DEXP * 2; }
        return true;
    }
};
struct EpiMoe1 {
    static constexpr bool PERM = true;
    const float* rstd2; bf16* H1;
    __device__ __forceinline__ void operator()(const f32x4 (&acc)[2][2][4][2], const GU& u, int wr, int wc, int fr, int fq) const {
        char* hb = (char*)H1 + (size_t)u.pm * 256 * DEXP * 2;
        const int j00 = (u.pn * 256 + 32 * wc + 8 * fq) >> 1;
#pragma unroll
        for (int ai = 0; ai < 2; ++ai) {
            int r = 128 * ai + 64 * wr + fr; LAUNDER(r);
#pragma unroll
            for (int m = 0; m < 4; ++m) { const bool ok = r < u.nvalid; const float rs = ok ? rstd2[u.rows[r] >> 1] : 0.f;
#pragma unroll
                for (int bj = 0; bj < 2; ++bj) { const f32x4 a1 = acc[ai][bj][m][0] * rs, a3 = acc[ai][bj][m][1] * rs; f32x4 hv;
#pragma unroll
                    for (int j = 0; j < 4; ++j) hv[j] = a1[j] * sigmoidf_(a1[j]) * a3[j];
                    u32x2 w; w.x = cvt_pk_bf16(hv[0], hv[1]); w.y = cvt_pk_bf16(hv[2], hv[3]); *(u32x2*)(hb + (unsigned)((r * DEXP + j00 + 64 * bj) * 2)) = w; }
                r += 16; LAUNDER(r); }
        }
    }
};
struct EpiMoe2 {
    static constexpr bool PERM = true;
    const float* wts; bf16* Y0; bf16* Y1;
    __device__ __forceinline__ void operator()(const f32x4 (&acc)[2][2][4][2], const GU& u, int wr, int wc, int fr, int fq) const {
#pragma unroll
        for (int ai = 0; ai < 2; ++ai)
#pragma unroll
            for (int m = 0; m < 4; ++m) { const int r = 128 * ai + 64 * wr + 16 * m + fr;
                if (r < u.nvalid) { const int ent = u.rows[r]; const float w8 = wts[ent]; bf16* dst = ((ent & 1) ? Y1 : Y0) + (size_t)(ent >> 1) * D + u.pn * 256 + 32 * wc + 8 * fq;
#pragma unroll
                    for (int bj = 0; bj < 2; ++bj) { const f32x4 v0 = acc[ai][bj][m][0] * w8, v1 = acc[ai][bj][m][1] * w8;
                        u32x4 w; w.x = cvt_pk_bf16(v0[0], v0[1]); w.y = cvt_pk_bf16(v0[2], v0[3]); w.z = cvt_pk_bf16(v1[0], v1[1]); w.w = cvt_pk_bf16(v1[2], v1[3]);
                        *(u32x4*)(dst + 128 * bj) = w; } } }
    }
};

__device__ __forceinline__ void p12_final(Frame& F, const Args& a) {
    const bf16* Y0 = (const bf16*)(F.ws + WS_YS0); const bf16* Y1 = (const bf16*)(F.ws + WS_YS1); const bf16* X2 = (const bf16*)(F.ws + WS_X2B); const float* g = a.in[IN_NORM_F_G];
    const int gw = F.bx * NWAVES + F.wave, NGW = F.G * NWAVES, lane = F.lane;
    for (int tok = gw; tok < NTOK; tok += NGW) {
        f32x4* xr = (f32x4*)(a.out + (size_t)tok * D) + lane; const u32x2* x2 = (const u32x2*)(X2 + (size_t)tok * D) + lane; const u32x2* y0 = (const u32x2*)(Y0 + (size_t)tok * D) + lane; const u32x2* y1 = (const u32x2*)(Y1 + (size_t)tok * D) + lane;
        f32x4 v[4]; float s = 0.f;
#pragma unroll
        for (int j = 0; j < 4; ++j) { const u32x2 xx = x2[64 * j], p = y0[64 * j], q = y1[64 * j];
            v[j].x = lo16(xx.x) + (lo16(p.x) + lo16(q.x)); v[j].y = hi16(xx.x) + (hi16(p.x) + hi16(q.x)); v[j].z = lo16(xx.y) + (lo16(p.y) + lo16(q.y)); v[j].w = hi16(xx.y) + (hi16(p.y) + hi16(q.y));
            s += (v[j].x * v[j].x + v[j].y * v[j].y) + (v[j].z * v[j].z + v[j].w * v[j].w); }
        const float rstd = 1.0f / sqrtf(wave_sum(s) * (1.f / D) + EPS);
#pragma unroll
        for (int j = 0; j < 4; ++j) { const f32x4 gg = ((const f32x4*)g + lane)[64 * j]; xr[64 * j] = v[j] * rstd * gg; }
    }
}

constexpr int N_PHASES = 14;
__global__ void __launch_bounds__(NTHREADS, 2) fwd(Args args) {
    extern __shared__ __attribute__((aligned(16))) unsigned char lds[];
    Frame F;
    F.lds = (LAS unsigned char*)lds; F.MISC = (volatile LAS unsigned*)(F.lds + MISC_OFF);
    F.tid = threadIdx.x; F.lane = F.tid & 63; F.wave = __builtin_amdgcn_readfirstlane(F.tid >> 6); F.G = gridDim.x; F.bx = blockIdx.x;
    F.ws = args.ws; F.ctl = (unsigned*)(args.ws + WS_CTL);
    unsigned char* ws = args.ws;
    for (int u = F.tid; u < (LDS_BYTES - RING_BYTES) / 4; u += NTHREADS) ((LAS unsigned*)(F.lds + RING_BYTES))[u] = 0u;
    __syncthreads();
    const int lo = args.ph_lo, hi = args.ph_hi;
    const bool one = (hi - lo) > 1;
    XcdBarrier bar; bar.bar = F.ctl + CW_BAR; bar.x = 0; bar.st = F.MISC + 8;
    if (one) bar = xcd_barrier_post(F.ctl + CW_BAR, F.MISC + 8);
#define IN(k) (lo <= (k) && (k) < hi && phase_begin(F))
#define SEAM(k) do { if (lo <= (k) && (k) + 1 < hi) xcd_barrier(bar); } while (0)

    if (IN(0)) { p0_prologue(F, args); } SEAM(0);
    if (IN(1)) {
        SchedP1 S{ws, F.G, F.bx};
        EpiP1 E{ws};
        pg8::gemm_phase<EpiP1, SchedP1, false>(F.lds, D, D, D, S, E);
        p1_gate_logits(F);
    } SEAM(1);
    if (IN(2)) {
        p2_retention_fast(F, F.bx, (bf16*)(ws + WS_RV));
        { const int w0 = F.bx * NWAVES + F.wave, nw = F.G * NWAVES;
            transpose_kv_tiles(F, (const bf16*)(ws + WS_KV6 + 3 * KV_STRIDE), (bf16*)args.out, w0, nw);
            transpose_kv_tiles(F, (const bf16*)(ws + WS_KV6 + 5 * KV_STRIDE), (bf16*)((unsigned char*)args.out + KV_STRIDE), w0, nw);
            transpose_memv_tiles(F, (bf16*)(ws + WS_MEMVT), w0, nw); }
        __syncthreads();
        { SchedCmp S{ws, 0, F.G, F.bx}; EpiCmp E{(float*)args.out + (size_t)16 * MiB};
            pg8::gemm_phase<EpiCmp, SchedCmp, false>(F.lds, 512, 2048, 4096, S, E); }
    } SEAM(2);
    if (IN(3)) { p2b_compress_out(F, args); } SEAM(3);
    if (IN(4)) { p3_ret_normalize(F); p3_nsa_fast(F, (const bf16*)args.out, (const bf16*)((const unsigned char*)args.out + KV_STRIDE), (bf16*)((unsigned char*)args.out + 64 * MiB)); } SEAM(4);
    if (IN(5)) {
        SchedP4 S{ws, F.G, F.bx, (const char*)args.out + 64 * MiB};
        EpiP4 E{(float*)(ws + WS_P4SCR) + (size_t)F.bx * (2 * 32 * 512 * 4), (bf16*)(ws + WS_Y)};
        pg8::gemm_phase<EpiP4, SchedP4, false>(F.lds, D, D, D, S, E);
    } SEAM(5);
    if (IN(6)) {
        SchedMN S{ws, WS_Y, W_OUT, F.G, F.bx}; EpiRes<true> E{args.in[IN_X], nullptr, nullptr, (bf16*)(ws + WS_X1B), (float*)(ws + WS_SSQ)};
        pg8::gemm_phase<EpiRes<true>, SchedMN, false>(F.lds, D, D, D, S, E);
    } SEAM(6);
    if (IN(7)) {
        const bool early = ((F.bx >> 3) & 1) == 0;
        if (early) expert_copies(F, args, 0, NEXP / 2);
        SchedMN S{ws, WS_X1B, W_XQ, F.G, F.bx}; EpiQ E{(const float*)(ws + WS_SSQ), (bf16*)(ws + WS_NQ)};
        pg8::gemm_phase<EpiQ, SchedMN, false>(F.lds, D, D, D, S, E);
        if (!early) { __syncthreads(); expert_copies(F, args, 0, NEXP / 2); }
    } SEAM(7);
    if (IN(8)) { p7_xattn_fast(F, (const bf16*)(ws + WS_MEMVT), (bf16*)(ws + WS_NQ)); } SEAM(8);
    if (IN(9)) {
        const bool early = ((F.bx >> 3) & 1) == 0;
        if (early) expert_copies(F, args, NEXP / 2, NEXP);
        SchedMN S{ws, WS_NQ, W_XO, F.G, F.bx}; EpiRes<false> E{nullptr, (const bf16*)(ws + WS_X1B), args.out, (bf16*)(ws + WS_X2B), nullptr};
        pg8::gemm_phase<EpiRes<false>, SchedMN, false>(F.lds, D, D, D, S, E);
        if (!early) { __syncthreads(); expert_copies(F, args, NEXP / 2, NEXP); }
    } SEAM(9);
    if (IN(10)) { p9_route(F, args); } SEAM(10);
    if (IN(11)) {
        moe_tiles(F);
        SchedMoe<0> S{F.MISC, ws, F.G, F.bx}; EpiMoe1 E{(const float*)(ws + WS_ROUTE) + 2 * NTOK, (bf16*)(ws + WS_H1)};
        pg8::gemm_phase<EpiMoe1, SchedMoe<0>, true>(F.lds, D, D, D, S, E);
    } SEAM(11);
    if (IN(12)) {
        moe_tiles(F);
        SchedMoe<1> S{F.MISC, ws, F.G, F.bx}; EpiMoe2 E{(const float*)(ws + WS_ROUTE), (bf16*)(ws + WS_YS0), (bf16*)(ws + WS_YS1)};
        pg8::gemm_phase<EpiMoe2, SchedMoe<1>, false>(F.lds, DEXP, DEXP, DEXP, S, E);
    } SEAM(12);
    if (IN(13)) { p12_final(F, args); }
#undef IN
#undef SEAM
}

extern "C" void kernel_launch(void* const* d_in, const int* in_sizes, int n_in, void* d_out, int out_size, void* d_ws, size_t ws_size, hipStream_t stream) {
    static int grid = 0;
    if (grid == 0) {
        if (n_in != 27 || in_sizes[0] != NTOK * D || out_size != NTOK * D || ws_size < WS_END) {
            fprintf(stderr, "kernel_launch: unexpected shapes: n_in %d in0 %d out %d ws %zu (need %zu)\n", n_in, n_in > 0 ? in_sizes[0] : -1, out_size, ws_size, (size_t)WS_END); grid = -1; return; }
        int dev = 0, cus = 0, per_cu = 0;
        if (hipGetDevice(&dev) != hipSuccess || hipDeviceGetAttribute(&cus, hipDeviceAttributeMultiprocessorCount, dev) != hipSuccess) { grid = -1; return; }
        if (hipFuncSetAttribute((const void*)fwd, hipFuncAttributeMaxDynamicSharedMemorySize, LDS_BYTES) != hipSuccess) { fprintf(stderr, "kernel_launch: hipFuncSetAttribute failed\n"); grid = -1; return; }
        if (hipOccupancyMaxActiveBlocksPerMultiprocessor(&per_cu, (const void*)fwd, NTHREADS, LDS_BYTES) != hipSuccess || per_cu < 1) fprintf(stderr, "kernel_launch: occupancy query reports %d\n", per_cu);
        (void)hipGetLastError();
        grid = cus < 256 ? cus : 256;
    }
    if (grid < 0) return;
    (void)hipMemsetAsync((char*)d_ws + WS_CTL, 0, CTL_ZERO_BYTES, stream);
    Args a{};
    for (int i = 0; i < 27; ++i) a.in[i] = (const float*)d_in[i];
    a.out = (float*)d_out; a.ws = (unsigned char*)d_ws;
#if MK_N_LAUNCHES == 1
    a.ph_lo = 0; a.ph_hi = N_PHASES;
    hipLaunchKernelGGL(fwd, dim3(grid), dim3(NTHREADS), LDS_BYTES, stream, a);
#else
    for (int p = 0; p < N_PHASES; ++p) { a.ph_lo = p; a.ph_hi = p + 1; hipLaunchKernelGGL(fwd, dim3(grid), dim3(NTHREADS), LDS_BYTES, stream, a); }
#endif
}
```

```cpp
#include <hip/hip_runtime.h>
#include <cstdio>
#include <cstdint>

#ifndef MK_N_LAUNCHES
#define MK_N_LAUNCHES 1
#endif

#define LAS __attribute__((address_space(3)))
#define GAS __attribute__((address_space(1)))
#define HD __host__ __device__
#define HDI __host__ __device__ __attribute__((always_inline)) inline
typedef unsigned short bf16;
typedef short bf16x8 __attribute__((ext_vector_type(8)));
typedef float f32x4 __attribute__((ext_vector_type(4)));
typedef float f32x2 __attribute__((ext_vector_type(2)));
typedef float f32x16 __attribute__((ext_vector_type(16)));
typedef unsigned u32x4 __attribute__((ext_vector_type(4)));
typedef unsigned u32x2 __attribute__((ext_vector_type(2)));

constexpr int D = 1024, BATCH = 8, SEQ = 4096, NTOK = BATCH * SEQ, NMEM = 256, NMEMTOK = BATCH * NMEM;
constexpr int DIN = 7704;
constexpr int C_RQ = 0, C_RK = 512, C_RV = 1024, C_RG = 2048, C_NQ = 3072, C_CK = 4096, C_NGL = 5632, C_GA = 5656, C_GB = 6680;
constexpr int NPROJ = 5632;
constexpr int NEXP = 32, DEXP = 512;
constexpr float EPS = 1e-6f;
constexpr int NWAVES = 8, NTHREADS = 512;

constexpr size_t MiB = 1u << 20;
constexpr size_t WS_CTL = 0, CTL_ZERO_BYTES = 1 * MiB;
constexpr size_t WS_ROPE_COS = 1 * MiB, WS_ROPE_SIN = 2 * MiB;
constexpr size_t WS_RTW = 3 * MiB + 512 * 1024;
constexpr size_t WS_SMALLW = 3 * MiB;
constexpr size_t WS_MEMVT = 24 * MiB;
constexpr size_t WS_KCMP = 4 * MiB, WS_VCMP = 5 * MiB, WS_VCMPT = 35 * MiB;
constexpr size_t WS_GATES = 10 * MiB;
constexpr size_t WS_SSQ = 13 * MiB;
constexpr size_t WS_ROUTE = 15 * MiB;
constexpr size_t WS_LISTS = 16 * MiB;
constexpr size_t WS_W = 36 * MiB;
constexpr size_t W_IN = WS_W;
constexpr size_t W_GA = W_IN + 11 * MiB, W_GB = W_GA + 2 * MiB;
constexpr size_t W_RO = W_GB + 2 * MiB, W_NO = W_RO + 2 * MiB, W_OUT = W_NO + 2 * MiB, W_XQ = W_OUT + 2 * MiB, W_XO = W_XQ + 2 * MiB;
constexpr size_t W_XKV = W_XO + 2 * MiB;
constexpr size_t W_C1K = W_XKV + 4 * MiB, W_C1V = W_C1K + 2 * MiB;
constexpr size_t WS_MEMN = W_C1V + 2 * MiB;
constexpr size_t WS_MEMKV = WS_MEMN + 4 * MiB;
constexpr size_t WS_H = 84 * MiB;
constexpr size_t WS_NQ = WS_H + 64 * MiB;
constexpr size_t WS_RV = WS_NQ + 64 * MiB;
constexpr size_t WS_RQ = WS_RV + 64 * MiB;
constexpr size_t WS_RK = WS_RQ + 32 * MiB;
constexpr size_t WS_RG = WS_RK + 32 * MiB;
constexpr size_t WS_KV6 = WS_RG + 64 * MiB;
constexpr size_t KV_STRIDE = 16 * MiB;
constexpr size_t WS_END = WS_KV6 + 96 * MiB;
constexpr size_t WS_Y = WS_RQ, WS_P4SCR = WS_RG, WS_W13 = WS_RQ, WS_W2 = WS_RG, WS_H1 = WS_KV6, WS_X1B = WS_H, WS_X2B = WS_RV, WS_YS0 = WS_H, WS_YS1 = WS_NQ;
static_assert(WS_MEMKV + 8 * MiB <= WS_H && WS_VCMPT + 1 * MiB <= WS_W && WS_MEMVT + 4 * MiB <= WS_VCMPT, "ws map");
constexpr int CW_BAR = 4096;
constexpr int CW_ECNT = 16384;
constexpr int LDS_BYTES = 147456, RING_BYTES = 131072, MISC_OFF = RING_BYTES + 320;

HD inline float bf2f(bf16 b) { return __builtin_bit_cast(float, (unsigned)b << 16); }
HD inline unsigned f2bf(float f) { unsigned u = __builtin_bit_cast(unsigned, f); return (u + 0x7fffu + ((u >> 16) & 1u)) >> 16; }
HD inline unsigned pk2(float lo, float hi) { return f2bf(lo) | (f2bf(hi) << 16); }
HD inline float lo16(unsigned w) { return __builtin_bit_cast(float, w << 16); }
HD inline float hi16(unsigned w) { return __builtin_bit_cast(float, w & 0xffff0000u); }
__device__ __forceinline__ unsigned cvt_pk_bf16(float lo, float hi) { unsigned r; asm volatile("v_cvt_pk_bf16_f32 %0, %1, %2" : "=v"(r) : "v"(lo), "v"(hi)); return r; }
#define DPP_F(v, ctrl, rmask) __builtin_bit_cast(float, __builtin_amdgcn_update_dpp(0, __builtin_bit_cast(int, v), ctrl, rmask, 0xf, false))
__device__ __forceinline__ float wave_sum(float v) {
    v += DPP_F(v, 0xB1, 0xf);
    v += DPP_F(v, 0x4E, 0xf);
    v += DPP_F(v, 0x141, 0xf);
    v += DPP_F(v, 0x140, 0xf);
    v += DPP_F(v, 0x142, 0xa);
    v += DPP_F(v, 0x143, 0xc);
    return __builtin_bit_cast(float, __builtin_amdgcn_readlane(__builtin_bit_cast(int, v), 63));
}
__device__ __forceinline__ float wave_max(float v) {
#pragma unroll
    for (int o = 1; o < 64; o <<= 1) v = fmaxf(v, __shfl_xor(v, o));
    return v;
}
__device__ __forceinline__ float sigmoidf_(float x) { return __builtin_amdgcn_rcpf(1.0f + __builtin_amdgcn_exp2f(-1.4426950408889634f * x)); }
#define LAUNDER(p) asm volatile("" : "+v"(p))
#define LDS_WAIT() asm volatile("s_waitcnt lgkmcnt(0)" ::: "memory")
#define VM_WAIT() asm volatile("s_waitcnt vmcnt(0)" ::: "memory")

#define XB_TMO      128
#define XB_XCNT(j)  (256  + 64 * (j))
#define XB_XSUB(j)  (1280 + 64 * (j))
#define XB_XGEN(j)  (2304 + 64 * (j))
#define XB_TOP      3328
#define XB_TOPGEN   3392
#define XCD_BAR_WORDS 3456
#define XB_SPIN_CAP (1u << 24)
__device__ __forceinline__ unsigned xb_ld(unsigned* p)              { return __hip_atomic_load(p, __ATOMIC_RELAXED, __HIP_MEMORY_SCOPE_AGENT); }
__device__ __forceinline__ unsigned xb_add(unsigned* p, unsigned v) { return __hip_atomic_fetch_add(p, v, __ATOMIC_RELAXED, __HIP_MEMORY_SCOPE_AGENT); }
__device__ __forceinline__ unsigned xb_xcc_id() { return (unsigned)__builtin_amdgcn_s_getreg((3 << 11) | 20) & 0xFu; }
#define XB_SPIN(cond, bar) do { unsigned _sp = 0; while (cond) { __builtin_amdgcn_s_sleep(1); \
    if ((++_sp & 255u) == 0u) { if (xb_ld(&(bar)[XB_TMO])) break; if (_sp > XB_SPIN_CAP) { atomicAdd(&(bar)[XB_TMO], 1u); break; } } } } while (0)
struct XcdBarrier { unsigned* bar; unsigned x; volatile LAS unsigned* st; };
__device__ __forceinline__ XcdBarrier xcd_barrier_post(unsigned* bar, volatile LAS unsigned* st) {
    XcdBarrier b; b.bar = bar; b.x = xb_xcc_id(); b.st = st;
    if (threadIdx.x == 0) (void)xb_add(&bar[XB_XCNT(b.x)], 1u);
    return b;
}
__device__ __forceinline__ void xcd_barrier_complete(unsigned* bar, unsigned x, unsigned& nloc, unsigned& nx) {
    const unsigned G = gridDim.x * gridDim.y * gridDim.z;
    unsigned sum, cnt, mine, sp = 0u;
    for (;;) {
        sum = 0u; cnt = 0u; mine = 0u;
#pragma unroll
        for (unsigned j = 0; j < 16; ++j) { const unsigned c = xb_ld(&bar[XB_XCNT(j)]); sum += c; cnt += (c > 0u) ? 1u : 0u; mine = (j == x) ? c : mine; }
        if (sum == G) break;
        __builtin_amdgcn_s_sleep(1);
        if ((++sp & 255u) == 0u) { if (xb_ld(&bar[XB_TMO])) break; if (sp > XB_SPIN_CAP) { atomicAdd(&bar[XB_TMO], 1u); break; } }
    }
    nloc = mine > 0u ? mine : 1u; nx = cnt > 0u ? cnt : 1u;
}
__device__ __forceinline__ void xcd_barrier(const XcdBarrier& b) {
    asm volatile("s_waitcnt vmcnt(0)" ::: "memory");
    __syncthreads();
    if (threadIdx.x == 0) {
        unsigned* bar = b.bar;
        __builtin_amdgcn_s_waitcnt(0);
        unsigned nloc = b.st[0], nx = b.st[1];
        if (nloc == 0u) { xcd_barrier_complete(bar, b.x, nloc, nx); b.st[0] = nloc; b.st[1] = nx; }
        const unsigned old = xb_add(&bar[XB_XSUB(b.x)], 1u);
        const unsigned gen = old / nloc;
        if (old + 1u == (gen + 1u) * nloc) {
            __builtin_amdgcn_fence(__ATOMIC_RELEASE, "agent");
            asm volatile("s_waitcnt vmcnt(0)" ::: "memory");
            const unsigned og = xb_add(&bar[XB_TOP], 1u);
            const unsigned tg = og / nx;
            if (og + 1u == (tg + 1u) * nx) xb_add(&bar[XB_TOPGEN], 1u);
            else XB_SPIN(xb_ld(&bar[XB_TOPGEN]) == tg, bar);
            __builtin_amdgcn_fence(__ATOMIC_ACQUIRE, "agent");
            xb_add(&bar[XB_XGEN(b.x)], 1u);
            asm volatile("s_waitcnt vmcnt(0)" ::: "memory");
        } else {
            XB_SPIN(xb_ld(&bar[XB_XGEN(b.x)]) == gen, bar);
            __builtin_amdgcn_fence(__ATOMIC_ACQUIRE, "agent");
            asm volatile("s_waitcnt vmcnt(0)" ::: "memory");
        }
    }
    __syncthreads();
}

namespace pg8 {
constexpr int BM = 256, BK = 64, HALF = 128, HTB = HALF * BK * 2, NXCD = 8, WGM = 8;
HD __forceinline__ int lds_byte(int r, int c) { const int st = (r >> 4) * 2 + (c >> 5), rr = r & 15, cc = c & 31, ob = rr * 64 + cc * 2; return st * 1024 + (ob ^ (((ob >> 9) & 1) << 5)); }
HD __forceinline__ void stage_rc(int b, int& R, int& C) { const int st = b / 1024, sb = b % 1024, swz = sb ^ (((sb >> 9) & 1) << 5); R = (st >> 1) * 16 + swz / 64; C = (st & 1) * 32 + (swz % 64) / 2; }
HD __forceinline__ int perm32(int rho) { const int n = rho >> 4, i = rho & 15; return 8 * (i >> 2) + 4 * n + (i & 3); }
HD __forceinline__ void tile_map(int L, int nM, int nN, int& pm, int& pn) {
    const int nwg = nM * nN; int wgid = L; { const int q = nwg / NXCD, r = nwg % NXCD, xcd = wgid % NXCD, off = wgid / NXCD; wgid = (xcd < r ? xcd * (q + 1) : r * (q + 1) + (xcd - r) * q) + off; }
    const int nig = WGM * nN, gid = wgid / nig, fm = gid * WGM, gsz = (nM - fm) < WGM ? (nM - fm) : WGM;
    pm = fm + ((wgid % nig) % gsz); pn = (wgid % nig) / gsz;
}
struct GU { const char* A; const char* B; const int* rows; int nvalid; int kind, pm, pn, aux; };
template <class Epi, class Sched, bool GATHER>
__device__ __forceinline__ void gemm_phase(LAS unsigned char* lds, const int K, const int lda, const int ldb, const Sched& S, const Epi& E) {
    int tid_ = threadIdx.x; LAUNDER(tid_);
    const int tid = tid_, wid = __builtin_amdgcn_readfirstlane(tid >> 6), lane = tid & 63, wr = wid >> 2, wc = wid & 3, fr = lane & 15, fq = lane >> 4;
    const int nt = K / BK;
    unsigned voffB[2];
#pragma unroll
    for (int i = 0; i < 2; ++i) { int R, C; stage_rc(tid * 16 + i * 8192, R, C); const int Rb = Epi::PERM ? ((R & ~31) + perm32(R & 31)) : R; voffB[i] = (unsigned)(Rb * ldb + C) * 2u; }
    const size_t kstep = (size_t)(BK * 2);
    const size_t hstepB = (size_t)HALF * ldb * 2;
    const unsigned ldsw = (unsigned)wid * 1024u;
    const int aoff = lds_byte(wr * 64 + fr, fq * 8), boff = lds_byte(wc * 32 + fr, fq * 8);
#define PG8_SA(b, h) (((b) * 2 + (h)) * HTB)
#define PG8_SB(b, h) ((4 + (b) * 2 + (h)) * HTB)
#define PG8_STAGE2(bufoff, gbase, v0, v1) do { \
        __builtin_amdgcn_global_load_lds((const unsigned*)((const char*)(gbase) + (v0)), (LAS unsigned*)(lds + (bufoff) + ldsw), 16, 0, 0); \
        __builtin_amdgcn_global_load_lds((const unsigned*)((const char*)(gbase) + (v1)), (LAS unsigned*)(lds + (bufoff) + ldsw + 8192), 16, 0, 0); } while (0)
#define PG8_STAGEB(bufoff, gbase) PG8_STAGE2(bufoff, gbase, voffB[0], voffB[1])
#define PG8_LDA(dst, b, h) do { _Pragma("unroll") for (int m = 0; m < 4; ++m) _Pragma("unroll") for (int k = 0; k < 2; ++k) dst[m][k] = *(const LAS bf16x8*)(lds + PG8_SA(b, h) + aoff + m * 2048 + k * 1024); } while (0)
#define PG8_LDB(dst, b, h) do { _Pragma("unroll") for (int n = 0; n < 2; ++n) _Pragma("unroll") for (int k = 0; k < 2; ++k) dst[n][k] = *(const LAS bf16x8*)(lds + PG8_SB(b, h) + boff + n * 2048 + k * 1024); } while (0)
#define PG8_MMA(ai, bj, At, Bt) do { __builtin_amdgcn_s_setprio(1); _Pragma("unroll") for (int m = 0; m < 4; ++m) _Pragma("unroll") for (int n = 0; n < 2; ++n) _Pragma("unroll") for (int k = 0; k < 2; ++k) \
        acc[ai][bj][m][n] = __builtin_amdgcn_mfma_f32_16x16x32_bf16(Bt[n][k], At[m][k], acc[ai][bj][m][n], 0, 0, 0); __builtin_amdgcn_s_setprio(0); } while (0)
#define PG8_WAIT_V(n) asm volatile("s_waitcnt vmcnt(" #n ")" ::: "memory")
#define PG8_WAIT_L(n) asm volatile("s_waitcnt lgkmcnt(" #n ")" ::: "memory")
#define PG8_BAR __builtin_amdgcn_s_barrier()
#define PG8_SCHED __builtin_amdgcn_sched_barrier(0)
#define PG8_VOFFA(u, vo) do { _Pragma("unroll") for (int h = 0; h < 2; ++h) _Pragma("unroll") for (int i = 0; i < 2; ++i) { int R_, C_; stage_rc(tid * 16 + i * 8192, R_, C_); const int R = R_ + HALF * h; \
        int ridx = R; if (GATHER) { ridx = (R < (u).nvalid) ? ((u).rows[R] >> 1) : 0; } vo[h][i] = (unsigned)(ridx * lda + C_) * 2u; } if (GATHER) asm volatile("" :: "v"(vo[0][0]), "v"(vo[0][1]), "v"(vo[1][0]), "v"(vo[1][1])); } while (0)
    GU cur, nxt; int ui = 0;
    if (!S.next(0, cur)) return;
    f32x4 acc[2][2][4][2];
#pragma unroll
    for (int a = 0; a < 2; ++a)
#pragma unroll
        for (int b = 0; b < 2; ++b)
#pragma unroll
            for (int m = 0; m < 4; ++m)
#pragma unroll
                for (int n = 0; n < 2; ++n) acc[a][b][m][n] = (f32x4){0.f, 0.f, 0.f, 0.f};
    bf16x8 At[4][2], B0[2][2], B1[2][2];
    unsigned cv[2][2], nv[2][2];
    PG8_VOFFA(cur, cv);
    const char* cA = cur.A; const char* cB = cur.B;
    PG8_STAGEB(PG8_SB(0, 0), cB); PG8_STAGEB(PG8_SB(0, 1), cB + hstepB); PG8_STAGE2(PG8_SA(0, 0), cA, cv[0][0], cv[0][1]); PG8_STAGE2(PG8_SA(0, 1), cA, cv[1][0], cv[1][1]);
    if (wr == 1) PG8_BAR;
    PG8_WAIT_V(2); PG8_BAR;
    PG8_STAGEB(PG8_SB(1, 0), cB + kstep); PG8_STAGE2(PG8_SA(1, 0), cA + kstep, cv[0][0], cv[0][1]); PG8_STAGEB(PG8_SB(1, 1), cB + hstepB + kstep);
    PG8_WAIT_V(6); PG8_BAR;
    for (;;) {
        const bool has_next = S.next(ui + 1, nxt);
        const char* nA = has_next ? nxt.A : cA; const char* nB = has_next ? nxt.B : cB;
        if (has_next) { PG8_VOFFA(nxt, nv); } else {
#pragma unroll
            for (int h = 0; h < 2; ++h)
#pragma unroll
                for (int i = 0; i < 2; ++i) nv[h][i] = cv[h][i]; }
        for (int t = 0; t < nt; t += 2) {
            const bool last = (t == nt - 2);
            const char* a1 = cA + (size_t)(t + 1) * kstep;
            const char* a2 = last ? nA : cA + (size_t)(t + 2) * kstep; const char* b2 = last ? nB : cB + (size_t)(t + 2) * kstep;
            const char* a3 = a2 + kstep; const char* b3 = b2 + kstep;
            const unsigned w00 = last ? nv[0][0] : cv[0][0], w01 = last ? nv[0][1] : cv[0][1], w10 = last ? nv[1][0] : cv[1][0], w11 = last ? nv[1][1] : cv[1][1];
            PG8_LDB(B0, 0, 0); PG8_LDB(B1, 0, 1); PG8_SCHED; PG8_LDA(At, 0, 0); PG8_STAGE2(PG8_SA(1, 1), a1, cv[1][0], cv[1][1]);
            PG8_WAIT_V(8); PG8_WAIT_L(0); PG8_BAR; PG8_MMA(0, 0, At, B0); PG8_MMA(0, 1, At, B1); PG8_BAR; PG8_SCHED;
            PG8_LDA(At, 0, 1); PG8_STAGEB(PG8_SB(0, 0), b2); PG8_STAGEB(PG8_SB(0, 1), b2 + hstepB); PG8_STAGE2(PG8_SA(0, 0), a2, w00, w01);
            PG8_WAIT_V(8); PG8_WAIT_L(0); PG8_BAR; PG8_MMA(1, 0, At, B0); PG8_MMA(1, 1, At, B1); PG8_BAR; PG8_SCHED;
            PG8_LDB(B0, 1, 0); PG8_LDB(B1, 1, 1); PG8_SCHED; PG8_LDA(At, 1, 0); PG8_STAGE2(PG8_SA(0, 1), a2, w10, w11);
            PG8_WAIT_V(8); PG8_WAIT_L(0); PG8_BAR; PG8_MMA(0, 0, At, B0); PG8_MMA(0, 1, At, B1); PG8_BAR; PG8_SCHED;
            PG8_LDA(At, 1, 1); PG8_STAGEB(PG8_SB(1, 0), b3); PG8_STAGEB(PG8_SB(1, 1), b3 + hstepB); PG8_STAGE2(PG8_SA(1, 0), a3, w00, w01);
            PG8_WAIT_V(8); PG8_WAIT_L(0); PG8_BAR; PG8_MMA(1, 0, At, B0); PG8_MMA(1, 1, At, B1); PG8_BAR; PG8_SCHED;
        }
        if (wr == 0) PG8_BAR;
        E(acc, cur, wr, wc, fr, fq);
        if (!has_next) break;
#pragma unroll
        for (int a = 0; a < 2; ++a)
#pragma unroll
            for (int b = 0; b < 2; ++b)
#pragma unroll
                for (int m = 0; m < 4; ++m)
#pragma unroll
                    for (int n = 0; n < 2; ++n) acc[a][b][m][n] = (f32x4){0.f, 0.f, 0.f, 0.f};
        cur = nxt; cA = nA; cB = nB; ++ui;
#pragma unroll
        for (int h = 0; h < 2; ++h)
#pragma unroll
            for (int i = 0; i < 2; ++i) cv[h][i] = nv[h][i];
        if (wr == 1) PG8_BAR;
    }
    PG8_WAIT_V(0);
    PG8_BAR;
#undef PG8_SA
#undef PG8_SB
#undef PG8_STAGE2
#undef PG8_STAGEB
#undef PG8_LDA
#undef PG8_LDB
#undef PG8_MMA
#undef PG8_WAIT_V
#undef PG8_WAIT_L
#undef PG8_BAR
#undef PG8_SCHED
#undef PG8_VOFFA
}
}
using pg8::GU;

struct Args {
    const float* in[27]; float* out; unsigned char* ws; int ph_lo, ph_hi; int pad0, pad1;
};
enum { IN_X = 0, IN_MEM, IN_NORM_MIX_G, IN_W_IN, IN_W_RET_O, IN_W_NSA_O, IN_W_OUT, IN_CMP_PE_K, IN_CMP_W1_K, IN_CMP_W2_K, IN_CMP_PE_V, IN_CMP_W1_V, IN_CMP_W2_V,
       IN_NORM_X_G, IN_NORM_MEM_G, IN_W_XQ, IN_W_XKV, IN_W_XO, IN_NORM_FFN_G, IN_W_GRP, IN_B_GRP, IN_W_RT, IN_B_RT, IN_W_E1, IN_W_E3, IN_W_E2, IN_NORM_F_G };
struct Frame {
    LAS unsigned char* lds; volatile LAS unsigned* MISC; unsigned* ctl; unsigned char* ws;
    int tid, lane, wave, G, bx;
};

__device__ __forceinline__ bool phase_begin(Frame& F) { int t = threadIdx.x; LAUNDER(t); F.tid = t; F.lane = t & 63; return true; }
__device__ __forceinline__ void transpose_item(const float* W, int ldw, int c0, int k0, bf16* WT, int ldt, int mode, int row_off, int cbase, const float* kscale, float scale, LAS float* scr, int lane) {
    float vv[32];
#pragma unroll
    for (int i = 0; i < 32; ++i) { const int kk = 2 * i + (lane >> 5); vv[i] = W[(size_t)(k0 + kk) * ldw + c0 + (lane & 31)]; }
    if (kscale) {
#pragma unroll
        for (int i = 0; i < 32; ++i) { const int kk = 2 * i + (lane >> 5); vv[i] *= kscale[k0 + kk]; } }
#pragma unroll
    for (int i = 0; i < 32; ++i) { const int kk = 2 * i + (lane >> 5); scr[kk * 33 + (lane & 31)] = vv[i] * scale; }
    LDS_WAIT(); asm volatile("" ::: "memory");
    const int c = lane & 7;
#pragma unroll
    for (int j = 0; j < 4; ++j) { const int n = (lane >> 3) + 8 * j; const LAS float* s = scr + (8 * c) * 33 + n;
        u32x4 o; o.x = pk2(s[0 * 33], s[1 * 33]); o.y = pk2(s[2 * 33], s[3 * 33]); o.z = pk2(s[4 * 33], s[5 * 33]); o.w = pk2(s[6 * 33], s[7 * 33]);
        const int jc = c0 - cbase + n; const int drow = mode == 0 ? row_off + jc : (8 * (jc >> 2) + 4 * row_off + (jc & 3));
        *(u32x4*)(WT + (size_t)drow * ldt + k0 + 8 * c) = o; }
    LDS_WAIT(); asm volatile("" ::: "memory");
}
__device__ __forceinline__ void transpose_matrix(Frame& F, int& item_base, const float* W, int ldw, int K, int cbase, int ncols, bf16* WT, int ldt, int mode, int row_off, const float* kscale, float scale) {
    LAS float* scr = (LAS float*)(F.lds + F.wave * 16384);
    const int gw = F.bx * NWAVES + F.wave, NGW = F.G * NWAVES;
    const int nb = ncols / 32, nitems = (K / 64) * nb;
    int it = (gw - item_base % NGW + NGW) % NGW;
    for (; it < nitems; it += NGW) transpose_item(W, ldw, cbase + 32 * (it % nb), 64 * (it / nb), WT, ldt, mode, row_off, cbase, kscale, scale, scr, F.lane);
    item_base += nitems;
}
__device__ __forceinline__ void rms_row_to_bf16(int lane, const float* xrow, const float* g, bf16* orow) {
    const f32x4* xr = (const f32x4*)xrow + lane; const f32x4* gr = (const f32x4*)g + lane;
    f32x4 v[4]; float s = 0.f;
#pragma unroll
    for (int j = 0; j < 4; ++j) { v[j] = xr[64 * j]; s += (v[j].x * v[j].x + v[j].y * v[j].y) + (v[j].z * v[j].z + v[j].w * v[j].w); }
    const float rstd = 1.0f / sqrtf(wave_sum(s) * (1.f / D) + EPS);
    unsigned long long* o8 = (unsigned long long*)orow + lane;
#pragma unroll
    for (int j = 0; j < 4; ++j) { const f32x4 gg = gr[64 * j];
        o8[64 * j] = (unsigned long long)pk2(v[j].x * rstd * gg.x, v[j].y * rstd * gg.y) | ((unsigned long long)pk2(v[j].z * rstd * gg.z, v[j].w * rstd * gg.w) << 32); }
}

struct XItem { const float* src; bf16* dst; const float* ks; float scale; int ldw, ldt, mode, row_off, csrc, c0, k0, has_ks; };
__device__ __forceinline__ void xitem_decode_expert(const Args& a, unsigned char* ws, int it, XItem& x) {
    const int e = it / 768, r = it % 768, which = r >> 8, t = r & 255;
    x.ks = a.in[IN_NORM_FFN_G]; x.scale = 1.0f;
    if (which < 2) { x.src = a.in[which ? IN_W_E3 : IN_W_E1] + (size_t)e * D * DEXP; x.ldw = DEXP; x.dst = (bf16*)(ws + WS_W13) + (size_t)e * D * D; x.ldt = D; x.mode = 1; x.row_off = which; x.has_ks = 1; x.c0 = 32 * (t & 15); x.k0 = 64 * (t >> 4); }
    else { x.src = a.in[IN_W_E2] + (size_t)e * DEXP * D; x.ldw = D; x.dst = (bf16*)(ws + WS_W2) + (size_t)e * D * DEXP; x.ldt = DEXP; x.mode = 0; x.row_off = 0; x.has_ks = 0; x.c0 = 32 * (t & 31); x.k0 = 64 * (t >> 5); }
    x.csrc = x.c0;
}
constexpr int P0_NITEMS = 7936;
__device__ __forceinline__ void xitem_decode_p0(const Args& a, unsigned char* ws, int it, XItem& x) {
    int in_ = IN_W_IN, ldw = DIN, cb = 0, nc = 512, ldt = D, ro = 0, first = 0; size_t dst = W_IN; float sc = 1.0f; int hk = 0;
#define P0E(FIRST, IN__, LDW, CB, NC, DST, LDT, RO, SC, HK) if (it >= (FIRST)) { in_ = (IN__); ldw = (LDW); cb = (CB); nc = (NC); dst = (DST); ldt = (LDT); ro = (RO); sc = (SC); hk = (HK); first = (FIRST); }
    P0E(256, IN_W_IN, DIN, 512, 512, W_IN, D, 512, 0.08838834764831845f, 0)
    P0E(512, IN_W_IN, DIN, 1024, NPROJ - 1024, W_IN, D, 1024, 1.0f, 0)
    P0E(2816, IN_W_IN, DIN, C_GA, 1024, W_GA, D, 0, 1.0f, 0)
    P0E(3328, IN_W_IN, DIN, C_GB, 1024, W_GB, D, 0, 1.0f, 0)
    P0E(3840, IN_W_RET_O, D, 0, D, W_RO, D, 0, 1.0f, 0)
    P0E(4352, IN_W_NSA_O, D, 0, D, W_NO, D, 0, 1.0f, 0)
    P0E(4864, IN_W_OUT, D, 0, D, W_OUT, D, 0, 1.0f, 0)
    P0E(5376, IN_W_XQ, D, 0, D, W_XQ, D, 0, 1.0f, 1)
    P0E(5888, IN_W_XO, D, 0, D, W_XO, D, 0, 1.0f, 0)
    P0E(6400, IN_W_XKV, 2 * D, 0, 2 * D, W_XKV, D, 0, 1.0f, 0)
    P0E(7424, IN_CMP_W1_K, 128, 0, 128, W_C1K, 4096, 0, 1.0f, 0)
    P0E(7680, IN_CMP_W1_V, 128, 0, 128, W_C1V, 4096, 0, 1.0f, 0)
#undef P0E
    const int t = it - first, nb = nc >> 5;
    x.src = a.in[in_]; x.dst = (bf16*)(ws + dst); x.ks = a.in[IN_NORM_X_G]; x.scale = sc; x.ldw = ldw; x.ldt = ldt; x.mode = 0; x.row_off = ro; x.has_ks = hk;
    x.c0 = 32 * (t % nb); x.csrc = cb + x.c0; x.k0 = 64 * (t / nb);
}
__device__ __forceinline__ void xitem_load(const XItem& x, int lane, float (&vv)[32], f32x4& k0v, f32x4& k1v) {
#pragma unroll
    for (int i = 0; i < 32; ++i) { const int kk = 2 * i + (lane >> 5); vv[i] = x.src[(size_t)(x.k0 + kk) * x.ldw + x.csrc + (lane & 31)]; }
    const f32x4* p = (const f32x4*)(x.ks + ((x.k0 + 8 * (lane & 7)) & 1023)); k0v = p[0]; k1v = p[1];
}
__device__ __forceinline__ void xitem_finish(const XItem& x, int lane, const float (&vv)[32], f32x4 k0v, f32x4 k1v, LAS float* scr) {
    if (!x.has_ks) { k0v = (f32x4){1.f, 1.f, 1.f, 1.f}; k1v = k0v; }
    k0v *= x.scale; k1v *= x.scale;
#pragma unroll
    for (int i = 0; i < 32; ++i) { const int kk = 2 * i + (lane >> 5); scr[kk * 33 + (lane & 31)] = vv[i]; }
    LDS_WAIT(); asm volatile("" ::: "memory");
    const int c = lane & 7;
#pragma unroll
    for (int j = 0; j < 4; ++j) { const int n = (lane >> 3) + 8 * j; const LAS float* s = scr + (8 * c) * 33 + n;
        u32x4 o; o.x = pk2(s[0 * 33] * k0v.x, s[1 * 33] * k0v.y); o.y = pk2(s[2 * 33] * k0v.z, s[3 * 33] * k0v.w); o.z = pk2(s[4 * 33] * k1v.x, s[5 * 33] * k1v.y); o.w = pk2(s[6 * 33] * k1v.z, s[7 * 33] * k1v.w);
        const int jc = x.c0 + n; const int drow = x.mode == 0 ? x.row_off + jc : (8 * (jc >> 2) + 4 * x.row_off + (jc & 3));
        *(u32x4*)(x.dst + (size_t)drow * x.ldt + x.k0 + 8 * c) = o; }
    LDS_WAIT(); asm volatile("" ::: "memory");
}
template <bool EXPERT>
__device__ __forceinline__ void run_items(Frame& F, const Args& a, int it_begin, int it_end) {
    LAS float* scr = (LAS float*)(F.lds + F.wave * 16384);
    const int gw = F.bx * NWAVES + F.wave, NGW = F.G * NWAVES, lane = F.lane;
    int it = it_begin + gw;
#define XDEC(i_, x_) do { if (EXPERT) xitem_decode_expert(a, F.ws, (i_), x_); else xitem_decode_p0(a, F.ws, (i_), x_); } while (0)
    if (it < it_end) {
        float va[32], vb[32]; f32x4 ka0, ka1, kb0, kb1; XItem xa, xb;
        XDEC(it, xa); xitem_load(xa, lane, va, ka0, ka1);
        for (;;) {
            int itn = it + NGW; bool hn = itn < it_end;
            XDEC(hn ? itn : it, xb); xitem_load(xb, lane, vb, kb0, kb1);
            xitem_finish(xa, lane, va, ka0, ka1, scr);
            if (!hn) break;
            it = itn; itn = it + NGW; hn = itn < it_end;
            XDEC(hn ? itn : it, xa); xitem_load(xa, lane, va, ka0, ka1);
            xitem_finish(xb, lane, vb, kb0, kb1, scr);
            if (!hn) break;
            it = itn;
        }
    }
#undef XDEC
    __syncthreads();
}
__device__ __forceinline__ void expert_copies(Frame& F, const Args& a, int e_lo, int e_hi) { run_items<true>(F, a, e_lo * 768, e_hi * 768); }

__device__ __forceinline__ void p0_prologue(Frame& F, const Args& a) {
    unsigned char* ws = F.ws;
    const float* w_in = a.in[IN_W_IN];
    run_items<false>(F, a, 0, P0_NITEMS);
    const int gt = F.bx * NTHREADS + F.tid, NGT = F.G * NTHREADS;
    for (int i = gt; i < 2 * 128 * 4096 / 8; i += NGT) { const int m = i / (128 * 4096 / 8), r = i % (128 * 4096 / 8);
        *(u32x4*)(ws + (m ? W_C1V : W_C1K) + (size_t)128 * 4096 * 2 + (size_t)r * 16) = (u32x4){0u, 0u, 0u, 0u}; }
    bf16* wngl = (bf16*)(ws + WS_SMALLW);
    for (int i = gt; i < 32 * 1024; i += NGT) { const int r = i >> 10, k = i & 1023; wngl[i] = r < 24 ? (bf16)f2bf(w_in[(size_t)k * DIN + C_NGL + r]) : (bf16)0; }
    bf16* w2k = (bf16*)(ws + WS_SMALLW + 65536); bf16* w2v = w2k + 128 * 128;
    for (int i = gt; i < 2 * 128 * 128; i += NGT) { const int m = i >> 14, r = i & 16383, f = r >> 7, e = r & 127; const float* src = a.in[m ? IN_CMP_W2_V : IN_CMP_W2_K];
        (m ? w2v : w2k)[f * 128 + e] = (bf16)f2bf(src[e * 128 + f]); }
    { const float* gff = a.in[IN_NORM_FFN_G]; const float* wgrp = a.in[IN_W_GRP]; const float* wrt = a.in[IN_W_RT]; float* wgp = (float*)(ws + WS_RTW); float* wep = wgp + 4096;
      for (int i = gt; i < 4096; i += NGT) wgp[i] = gff[i >> 2] * wgrp[i];
      for (int i = gt; i < 32768; i += NGT) { const int j = i & 3, l = (i >> 2) & 63, half = (i >> 8) & 1, ii = (i >> 9) & 15, grp = i >> 13, k = 64 * ii + l; wep[i] = gff[k] * wrt[k * 32 + grp * 8 + half * 4 + j]; } }
    float* cbias = (float*)(ws + WS_SMALLW + 65536 + 2 * 128 * 128 * 2);
    const int gw = F.bx * NWAVES + F.wave, NGW = F.G * NWAVES;
    for (int o = gw; o < 256; o += NGW) { const int m = o >> 7, e = o & 127; const float* pe = a.in[m ? IN_CMP_PE_V : IN_CMP_PE_K]; const float* w1 = a.in[m ? IN_CMP_W1_V : IN_CMP_W1_K];
        float s = 0.f; for (int k = F.lane; k < 4096; k += 64) s += pe[k] * w1[(size_t)k * 128 + e];
        s = wave_sum(s); if (F.lane == 0) cbias[o] = s; }
    float* cosT = (float*)(ws + WS_ROPE_COS); float* sinT = (float*)(ws + WS_ROPE_SIN);
    for (int i = gt; i < SEQ * 64; i += NGT) { const int pos = i >> 6, j = i & 63; const float inv = powf(10000.0f, -(float)(2 * j) / 128.0f); const float ang = (float)pos * inv;
        cosT[i] = cosf(ang); sinT[i] = sinf(ang); }
    { f32x4 nx[4]; const float* X = a.in[IN_X]; const f32x4* gr = (const f32x4*)a.in[IN_NORM_MIX_G] + F.lane;
      if (gw < NTOK) {
#pragma unroll
          for (int j = 0; j < 4; ++j) nx[j] = ((const f32x4*)(X + (size_t)gw * D) + F.lane)[64 * j]; }
      for (int m = gw; m < NTOK; m += NGW) { f32x4 v[4]; float sq = 0.f;
#pragma unroll
          for (int j = 0; j < 4; ++j) { v[j] = nx[j]; sq += (v[j].x * v[j].x + v[j].y * v[j].y) + (v[j].z * v[j].z + v[j].w * v[j].w); }
          if (m + NGW < NTOK) {
#pragma unroll
              for (int j = 0; j < 4; ++j) nx[j] = ((const f32x4*)(X + (size_t)(m + NGW) * D) + F.lane)[64 * j]; }
          const float rstd = 1.0f / sqrtf(wave_sum(sq) * (1.f / D) + EPS); unsigned long long* o8 = (unsigned long long*)((bf16*)(ws + WS_H) + (size_t)m * D) + F.lane;
#pragma unroll
          for (int j = 0; j < 4; ++j) { const f32x4 gg = gr[64 * j]; o8[64 * j] = (unsigned long long)pk2(v[j].x * rstd * gg.x, v[j].y * rstd * gg.y) | ((unsigned long long)pk2(v[j].z * rstd * gg.z, v[j].w * rstd * gg.w) << 32); } } }
    for (int m = gw; m < NMEMTOK; m += NGW) rms_row_to_bf16(F.lane, a.in[IN_MEM] + (size_t)m * D, a.in[IN_NORM_MEM_G], (bf16*)(ws + WS_MEMN) + (size_t)m * D);
}

struct SchedP1 {
    unsigned char* ws; int G, c;
    __device__ __forceinline__ bool next(int i, GU& u) const {
        constexpr int NP = 128 * 22; const int L = i * G + c;
        u.rows = nullptr; u.nvalid = 0; u.aux = 0;
        if (L < NP) { int pm, pn; pg8::tile_map(L, 128, 22, pm, pn); u.A = (const char*)ws + WS_H + (size_t)pm * 256 * D * 2; u.B = (const char*)ws + W_IN + (size_t)pn * 256 * D * 2; u.pm = pm; u.pn = pn;
            u.kind = pn < 2 ? 0 : pn < 4 ? 1 : pn < 8 ? 2 : pn < 12 ? 3 : pn < 16 ? 4 : 5; return true; }
        const int L2 = L - NP; if (L2 >= 64) return false;
        const int pm = L2 & 7, pn = L2 >> 3; u.A = (const char*)ws + WS_MEMN + (size_t)pm * 256 * D * 2; u.B = (const char*)ws + W_XKV + (size_t)pn * 256 * D * 2; u.pm = pm; u.pn = pn; u.kind = 6; return true;
    }
};
struct EpiP1 {
    static constexpr bool PERM = true;
    unsigned char* ws;
    __device__ __forceinline__ void operator()(const f32x4 (&acc)[2][2][4][2], const GU& u, int wr, int wc, int fr, int fq) const {
        const int kind = u.kind;
        const float* cosT = (const float*)(ws + WS_ROPE_COS); const float* sinT = (const float*)(ws + WS_ROPE_SIN);
#pragma unroll
        for (int ai = 0; ai < 2; ++ai)
#pragma unroll
            for (int m = 0; m < 4; ++m) {
                const int r = 128 * ai + 64 * wr + 16 * m + fr; const int tok = u.pm * 256 + r;
#pragma unroll
                for (int bj = 0; bj < 2; ++bj) {
                    f32x4 v0 = acc[ai][bj][m][0], v1 = acc[ai][bj][m][1];
                    const int ct = 128 * bj + 32 * wc + 8 * fq;
                    bf16* dst;
                    if (kind <= 1) {
                        const int s = tok & (SEQ - 1), i0 = ((ct & 127) >> 1);
                        const f32x4 cs = *(const f32x4*)(cosT + s * 64 + i0), sn = *(const f32x4*)(sinT + s * 64 + i0);
                        const f32x4 a0 = v0, a1 = v1;
                        v0[0] = a0[0] * cs[0] - a0[1] * sn[0]; v0[1] = a0[0] * sn[0] + a0[1] * cs[0];
                        v0[2] = a0[2] * cs[1] - a0[3] * sn[1]; v0[3] = a0[2] * sn[1] + a0[3] * cs[1];
                        v1[0] = a1[0] * cs[2] - a1[1] * sn[2]; v1[1] = a1[0] * sn[2] + a1[1] * cs[2];
                        v1[2] = a1[2] * cs[3] - a1[3] * sn[3]; v1[3] = a1[2] * sn[3] + a1[3] * cs[3];
                        dst = (bf16*)(ws + (kind == 0 ? WS_RQ : WS_RK)) + (size_t)tok * 512 + (u.pn & 1) * 256 + ct;
                    } else if (kind == 2) { dst = (bf16*)(ws + WS_RV) + (size_t)tok * 1024 + (u.pn - 4) * 256 + ct;
                    } else if (kind == 3) {
#pragma unroll
                        for (int j = 0; j < 4; ++j) { v0[j] = v0[j] * sigmoidf_(v0[j]); v1[j] = v1[j] * sigmoidf_(v1[j]); }
                        dst = (bf16*)(ws + WS_RG) + (size_t)tok * 1024 + (u.pn - 8) * 256 + ct;
                    } else if (kind == 4) { dst = (bf16*)(ws + WS_NQ) + (size_t)tok * 1024 + (u.pn - 12) * 256 + ct;
                    } else if (kind == 5) {
                        const int b = tok >> 12, s = tok & (SEQ - 1);
                        unsigned char* kvb = ws + WS_KV6 + (size_t)(u.pn - 16) * KV_STRIDE;
                        dst = (bf16*)kvb + ((size_t)(b * 2 + bj) * SEQ + s) * 128 + (ct & 127);
                    } else { dst = (bf16*)(ws + WS_MEMKV) + (size_t)tok * 2048 + u.pn * 256 + ct; }
                    u32x4 w; w.x = cvt_pk_bf16(v0[0], v0[1]); w.y = cvt_pk_bf16(v0[2], v0[3]); w.z = cvt_pk_bf16(v1[0], v1[1]); w.w = cvt_pk_bf16(v1[2], v1[3]);
                    *(u32x4*)dst = w;
                }
            }
    }
};
__device__ __forceinline__ void p1_gate_logits(Frame& F) {
    const bf16* H = (const bf16*)(F.ws + WS_H); const bf16* W = (const bf16*)(F.ws + WS_SMALLW); float* gates = (float*)(F.ws + WS_GATES);
    const int r = F.lane & 31, hh = F.lane >> 5;
    const int nb_ = F.G > 64 ? F.G - 64 : F.G, b0_ = F.G > 64 ? F.bx - 64 : F.bx;
    if (b0_ < 0) return;
    for (int rb = b0_ + nb_ * F.wave; rb < NTOK / 32; rb += nb_ * NWAVES) {
        f32x16 acc; for (int j = 0; j < 16; ++j) acc[j] = 0.f;
        const bf16* ap = H + (size_t)(rb * 32 + r) * D + 8 * hh; const bf16* bp = W + (size_t)r * D + 8 * hh;
        for (int s8 = 0; s8 < 8; ++s8) { bf16x8 av[8], bv[8];
#pragma unroll
            for (int q = 0; q < 8; ++q) { av[q] = *(const bf16x8*)(ap + 16 * (8 * s8 + q)); bv[q] = *(const bf16x8*)(bp + 16 * (8 * s8 + q)); }
#pragma unroll
            for (int q = 0; q < 8; ++q) acc = __builtin_amdgcn_mfma_f32_32x32x16_bf16(av[q], bv[q], acc, 0, 0, 0); }
        if (r < 24) {
#pragma unroll
            for (int reg = 0; reg < 16; ++reg) { const int row = (reg & 3) + 8 * (reg >> 2) + 4 * hh; gates[(size_t)(rb * 32 + row) * 24 + r] = sigmoidf_(acc[reg]); }
        }
    }
}

namespace retf {
constexpr int ROWB = 272;
constexpr int OFF_K = 0, OFF_V = 128 * 256, OFF_ZV = OFF_V + 128 * 64, OFF_ST = OFF_ZV + 128 * 64, OFF_PART = OFF_ST + 32 * ROWB, OFF_Q = OFF_PART + 4 * 4096;
static_assert(OFF_Q + 128 * 256 <= RING_BYTES, "retention LDS map");
typedef short s16x4 __attribute__((ext_vector_type(4)));
__device__ __forceinline__ u32x2 lds_tr(const LAS unsigned char* p) { return __builtin_bit_cast(u32x2, __builtin_amdgcn_ds_read_tr16_b64_v4i16((LAS s16x4*)p)); }
}
__device__ __forceinline__ void p2_retention_fast(Frame& F, int unit, bf16* outbase) {
    using namespace retf;
    const int bh = (unit & 7) * 4 + (unit >> 6), sl = (unit >> 3) & 7, b = bh >> 2, h = bh & 3;
    const bf16* rq = (const bf16*)(F.ws + WS_RQ); const bf16* rk = (const bf16*)(F.ws + WS_RK); const bf16* rv = (const bf16*)(F.ws + WS_RV);
    const int tid = F.tid, lane = F.lane, wave = F.wave, r = lane & 31, hi = lane >> 5; LAS unsigned char* lds = F.lds;
    const float lg = log2f(1.0f - exp2f(-5.0f - (float)h));
    const int nt = wave & 3, mh = wave >> 2;
    for (int i = tid; i < 32 * ROWB / 4; i += NTHREADS) ((LAS unsigned*)(lds + OFF_ST))[i] = 0u;
    f32x16 ST;
#pragma unroll
    for (int j = 0; j < 16; ++j) ST[j] = 0.f;
    const float gC = exp2f(128.0f * lg);
    const float zeta = exp2f((float)(127 - (tid >> 2)) * lg);
    const int blk = (lane >> 4) & 1, q4 = (lane & 15) >> 2, p4 = lane & 3;
    const int vtr = (4 * hi + q4) * 64 + 32 * blk + 8 * p4;
    const int ztr = (8 * hi + q4) * 64 + 32 * blk + 8 * p4;
    int ktr[2];
#pragma unroll
    for (int t = 0; t < 2; ++t) ktr[t] = 256 * (8 * hi + 4 * t + q4) + 16 * ((4 * nt + 2 * blk + (p4 >> 1)) ^ ((q4 << 2) | ((2 * hi + t) & 3))) + 8 * (p4 & 1);
    const int krow = 256 * r + 16 * (hi ^ (((r & 3) << 2) | ((r >> 2) & 3)));
    u32x4 kreg[4], qreg[4], vreg;
    {   const int tok0 = b * SEQ;
#pragma unroll
        for (int i = 0; i < 4; ++i) { const int p = tid + 512 * i, m = p >> 4, cc = p & 15; kreg[i] = *(const u32x4*)(rk + (size_t)(tok0 + m) * 512 + h * 128 + cc * 8); qreg[i] = *(const u32x4*)(rq + (size_t)(tok0 + m) * 512 + h * 128 + cc * 8); }
        { const int m = tid >> 2, cc = tid & 3; vreg = *(const u32x4*)(rv + (size_t)(tok0 + m) * 1024 + h * 256 + sl * 32 + cc * 8); } }
    u32x2 opk[4]; bf16* oprev = outbase;
#pragma unroll
    for (int i = 0; i < 4; ++i) opk[i] = (u32x2){0u, 0u};
    for (int c = 0; c < SEQ / 128; ++c) {
        const int tok0 = b * SEQ + c * 128;
        __syncthreads();
#pragma unroll
        for (int i = 0; i < 4; ++i) { const int p = tid + 512 * i, m = p >> 4, cc = p & 15; const int o_ = 256 * m + 16 * (cc ^ (((m & 3) << 2) | ((m >> 2) & 3)));
            *(LAS u32x4*)(lds + OFF_K + o_) = kreg[i]; *(LAS u32x4*)(lds + OFF_Q + o_) = qreg[i]; }
        { const u32x4 v = vreg; u32x4 zv;
            zv.x = cvt_pk_bf16(lo16(v.x) * zeta, hi16(v.x) * zeta); zv.y = cvt_pk_bf16(lo16(v.y) * zeta, hi16(v.y) * zeta); zv.z = cvt_pk_bf16(lo16(v.z) * zeta, hi16(v.z) * zeta); zv.w = cvt_pk_bf16(lo16(v.w) * zeta, hi16(v.w) * zeta);
            *(LAS u32x4*)(lds + OFF_V + tid * 16) = v; *(LAS u32x4*)(lds + OFF_ZV + tid * 16) = zv; }
        __syncthreads();
        if (mh == 0 && c > 0) {
#pragma unroll
            for (int i = 0; i < 4; ++i) *(u32x2*)(oprev + 8 * i + 4 * hi) = opk[i]; }
        if (c + 1 < SEQ / 128) { const int tok1 = tok0 + 128;
#pragma unroll
            for (int i = 0; i < 4; ++i) { const int p = tid + 512 * i, m = p >> 4, cc = p & 15; kreg[i] = *(const u32x4*)(rk + (size_t)(tok1 + m) * 512 + h * 128 + cc * 8); qreg[i] = *(const u32x4*)(rq + (size_t)(tok1 + m) * 512 + h * 128 + cc * 8); }
            { const int m = tid >> 2, cc = tid & 3; vreg = *(const u32x4*)(rv + (size_t)(tok1 + m) * 1024 + h * 256 + sl * 32 + cc * 8); } }
        bf16x8 qf[8];
#pragma unroll
        for (int s_ = 0; s_ < 8; ++s_) qf[s_] = *(const LAS bf16x8*)(lds + OFF_Q + 8192 * nt + (krow ^ (32 * s_)));
        f32x16 CR;
#pragma unroll
        for (int j = 0; j < 16; ++j) CR[j] = 0.f;
        if (mh == 0) {
#pragma unroll
            for (int s_ = 0; s_ < 8; ++s_) { const bf16x8 a = *(const LAS bf16x8*)(lds + OFF_ST + r * ROWB + (16 * s_ + 8 * hi) * 2); CR = __builtin_amdgcn_mfma_f32_32x32x16_bf16(a, qf[s_], CR, 0, 0, 0); }
        }
        f32x16 IN_;
#pragma unroll
        for (int j = 0; j < 16; ++j) IN_[j] = 0.f;
#pragma unroll
        for (int mi = 0; mi < 2; ++mi) { const int mt = 2 * mh + mi;
            if (mt <= nt) {
                f32x16 A;
#pragma unroll
                for (int j = 0; j < 16; ++j) A[j] = 0.f;
#pragma unroll
                for (int s_ = 0; s_ < 8; ++s_) { const bf16x8 a = *(const LAS bf16x8*)(lds + OFF_K + 8192 * mt + (krow ^ (32 * s_))); A = __builtin_amdgcn_mfma_f32_32x32x16_bf16(a, qf[s_], A, 0, 0, 0); }
#pragma unroll
                for (int j = 0; j < 16; ++j) { const int dd = (32 * nt + r) - (32 * mt + (j & 3) + 8 * (j >> 2) + 4 * hi); A[j] = dd >= 0 ? A[j] * __builtin_amdgcn_exp2f((float)dd * lg) : 0.f; }
#pragma unroll
                for (int s2 = 0; s2 < 2; ++s2) { u32x4 w; w.x = cvt_pk_bf16(A[8 * s2 + 0], A[8 * s2 + 1]); w.y = cvt_pk_bf16(A[8 * s2 + 2], A[8 * s2 + 3]); w.z = cvt_pk_bf16(A[8 * s2 + 4], A[8 * s2 + 5]); w.w = cvt_pk_bf16(A[8 * s2 + 6], A[8 * s2 + 7]);
                    const LAS unsigned char* vp = lds + OFF_V + vtr + (32 * mt + 16 * s2) * 64; const u32x2 lo = lds_tr(vp), hi2 = lds_tr(vp + 8 * 64);
                    IN_ = __builtin_amdgcn_mfma_f32_32x32x16_bf16(__builtin_bit_cast(bf16x8, (u32x4){lo.x, lo.y, hi2.x, hi2.y}), __builtin_bit_cast(bf16x8, w), IN_, 0, 0, 0); }
            } }
        if (mh == 1) {
#pragma unroll
            for (int j = 0; j < 16; ++j) ((LAS float*)(lds + OFF_PART))[(nt * 16 + j) * 64 + lane] = IN_[j];
        }
        __syncthreads();
        if (mh == 0) {
            const float xi = __builtin_amdgcn_exp2f((float)(32 * nt + r + 1) * lg);
            bf16* orow = outbase + (size_t)(tok0 + 32 * nt + r) * 1024 + h * 256 + sl * 32;
#pragma unroll
            for (int q4_ = 0; q4_ < 4; ++q4_) { float o_[4];
#pragma unroll
                for (int e = 0; e < 4; ++e) { const int j = 4 * q4_ + e; o_[e] = IN_[j] + ((const LAS float*)(lds + OFF_PART))[(nt * 16 + j) * 64 + lane] + xi * CR[j]; }
                opk[q4_] = (u32x2){cvt_pk_bf16(o_[0], o_[1]), cvt_pk_bf16(o_[2], o_[3])}; }
            oprev = orow;
        } else {
#pragma unroll
            for (int j = 0; j < 16; ++j) ST[j] *= gC;
#pragma unroll
            for (int s_ = 0; s_ < 8; ++s_) {
                const LAS unsigned char* zp = lds + OFF_ZV + ztr + (16 * s_) * 64; const u32x2 z0 = lds_tr(zp), z1 = lds_tr(zp + 4 * 64);
                const u32x2 k0 = lds_tr(lds + OFF_K + ktr[0] + 4096 * s_), k1 = lds_tr(lds + OFF_K + ktr[1] + 4096 * s_);
                ST = __builtin_amdgcn_mfma_f32_32x32x16_bf16(__builtin_bit_cast(bf16x8, (u32x4){z0.x, z0.y, z1.x, z1.y}), __builtin_bit_cast(bf16x8, (u32x4){k0.x, k0.y, k1.x, k1.y}), ST, 0, 0, 0); }
#pragma unroll
            for (int j = 0; j < 16; ++j) { const int dv = (j & 3) + 8 * (j >> 2) + 4 * hi; ((LAS unsigned short*)(lds + OFF_ST))[dv * (ROWB / 2) + 32 * nt + r] = (unsigned short)f2bf(ST[j]); }
        }
    }
    if (mh == 0) {
#pragma unroll
        for (int i = 0; i < 4; ++i) *(u32x2*)(oprev + 8 * i + 4 * hi) = opk[i]; }
    __syncthreads();
}
__device__ __forceinline__ void transpose_kv_tiles(Frame& F, const bf16* src, bf16* dst, int w0, int nw) {
    LAS unsigned short* tl_ = (LAS unsigned short*)(F.lds + F.wave * 16384); const int lane = F.lane;
    for (int tile = w0; tile < 16 * 64 * 2; tile += nw) {
        const int dh = tile & 1, st = (tile >> 1) & 63, bg = tile >> 7;
        const bf16* sp = src + ((size_t)bg * SEQ + st * 64) * 128 + dh * 64; bf16* dp = dst + ((size_t)bg * 128 + dh * 64) * SEQ + st * 64;
#pragma unroll
        for (int i = 0; i < 8; ++i) { const int row = i * 8 + (lane >> 3), c = lane & 7; const u32x4 v = *(const u32x4*)(sp + (size_t)row * 128 + c * 8); LAS unsigned short* q = tl_ + row * 66 + c * 8;
            q[0] = (unsigned short)(v.x & 0xffffu); q[1] = (unsigned short)(v.x >> 16); q[2] = (unsigned short)(v.y & 0xffffu); q[3] = (unsigned short)(v.y >> 16);
            q[4] = (unsigned short)(v.z & 0xffffu); q[5] = (unsigned short)(v.z >> 16); q[6] = (unsigned short)(v.w & 0xffffu); q[7] = (unsigned short)(v.w >> 16); }
        LDS_WAIT(); asm volatile("" ::: "memory");
#pragma unroll
        for (int i = 0; i < 8; ++i) { const int d = i * 8 + (lane >> 3), c = lane & 7; const LAS unsigned short* q = tl_ + (c * 8) * 66 + d;
            u32x4 o; o.x = (unsigned)q[0] | ((unsigned)q[66] << 16); o.y = (unsigned)q[2 * 66] | ((unsigned)q[3 * 66] << 16); o.z = (unsigned)q[4 * 66] | ((unsigned)q[5 * 66] << 16); o.w = (unsigned)q[6 * 66] | ((unsigned)q[7 * 66] << 16);
            *(u32x4*)(dp + (size_t)d * SEQ + c * 8) = o; }
        LDS_WAIT(); asm volatile("" ::: "memory");
    }
}
struct SchedCmp {
    unsigned char* ws; int first, G, c;
    __device__ __forceinline__ bool next(int i, GU& u) const {
        const int L = i * G + c - first; if (L < 0 || L >= 256) return false;
        const int ks = L & 7, mb = L >> 3, m = mb >> 4, bg = mb & 15;
        u.A = (const char*)ws + WS_KV6 + (size_t)m * KV_STRIDE + (size_t)bg * SEQ * 128 * 2 + (size_t)ks * 512 * 2; u.B = (const char*)ws + (m ? W_C1V : W_C1K) + (size_t)ks * 512 * 2;
        u.pm = mb; u.pn = 0; u.kind = ks; u.rows = nullptr; u.nvalid = 0; u.aux = 0; return true;
    }
};
struct EpiCmp {
    static constexpr bool PERM = false;
    float* hid;
    __device__ __forceinline__ void operator()(const f32x4 (&acc)[2][2][4][2], const GU& u, int wr, int wc, int fr, int fq) const {
#pragma unroll
        for (int ai = 0; ai < 2; ++ai)
#pragma unroll
            for (int m = 0; m < 4; ++m) { const int r = 128 * ai + 64 * wr + 16 * m + fr; float* rowp = hid + (size_t)u.kind * (32 * 256 * 128) + ((size_t)u.pm * 256 + r) * 128 + 32 * wc + 4 * fq;
#pragma unroll
                for (int n = 0; n < 2; ++n) *(f32x4*)(rowp + 16 * n) = acc[ai][0][m][n]; }
    }
};
__device__ __forceinline__ float gelu_tanh(float x) { const float u = 0.7978845608028654f * (x + 0.044715f * x * x * x); return 0.5f * x * (1.0f + tanhf(u)); }
__device__ __forceinline__ void p2b_compress_out(Frame& F, const Args& a) {
    const float* hid = (const float*)a.out + (size_t)16 * MiB; const float* cbias = (const float*)(F.ws + WS_SMALLW + 65536 + 2 * 128 * 128 * 2);
    const int gw = F.bx * NWAVES + F.wave, NGW = F.G * NWAVES, lane = F.lane;
    for (int m = 0; m < 2; ++m) {
        const float* w2 = a.in[m ? IN_CMP_W2_V : IN_CMP_W2_K];
        for (int base = m * 4096 + gw; base < (m + 1) * 4096; base += 2 * NGW) {
            float gv[2][2], o[2][2]; int rows[2]; bool valid[2];
#pragma unroll
            for (int q = 0; q < 2; ++q) { const int row = base + q * NGW; rows[q] = row; valid[q] = row < (m + 1) * 4096; const int n = row & 255;
#pragma unroll
                for (int h2 = 0; h2 < 2; ++h2) { float hsum = 0.f; const int e = lane + 64 * h2;
                    if (valid[q] && n < 255) {
#pragma unroll
                        for (int ks = 0; ks < 8; ++ks) hsum += hid[(size_t)ks * (32 * 256 * 128) + (size_t)row * 128 + e];
                        gv[q][h2] = gelu_tanh(hsum + cbias[m * 128 + e]); } else gv[q][h2] = 0.f; }
                o[q][0] = 0.f; o[q][1] = 0.f; }
#pragma unroll
            for (int h2 = 0; h2 < 2; ++h2) {
#pragma unroll 8
                for (int e = 0; e < 64; ++e) { const float wa = w2[(64 * h2 + e) * 128 + lane], wb = w2[(64 * h2 + e) * 128 + 64 + lane];
#pragma unroll
                    for (int q = 0; q < 2; ++q) { const float g = __builtin_bit_cast(float, __builtin_amdgcn_readlane(__builtin_bit_cast(int, gv[q][h2]), e)); o[q][0] += g * wa; o[q][1] += g * wb; } } }
#pragma unroll
            for (int q = 0; q < 2; ++q) if (valid[q]) { const int row = rows[q], n = row & 255;
                bf16* dst = (bf16*)(F.ws + (m ? WS_VCMP : WS_KCMP)) + (size_t)(row & 4095) * 128;
                dst[lane] = (bf16)f2bf(o[q][0]); dst[64 + lane] = (bf16)f2bf(o[q][1]);
                if (m == 1) { bf16* dt = (bf16*)(F.ws + WS_VCMPT) + (size_t)((row >> 8) & 15) * 128 * 256 + n; dt[(size_t)lane * 256] = (bf16)f2bf(o[q][0]); dt[(size_t)(64 + lane) * 256] = (bf16)f2bf(o[q][1]); } }
        }
    }
}

__device__ __forceinline__ void p3_ret_normalize(Frame& F) {
    bf16* rv = (bf16*)(F.ws + WS_RV); const bf16* rg = (const bf16*)(F.ws + WS_RG);
    const int gw = F.bx * NWAVES + F.wave, NGW = F.G * NWAVES;
    for (int it = gw; it < NTOK * 4; it += NGW) {
        u32x2* p = (u32x2*)(rv + (size_t)it * 256) + F.lane; const u32x2 w = *p; const u32x2 gq = *((const u32x2*)(rg + (size_t)it * 256) + F.lane);
        const float o0 = lo16(w.x), o1 = hi16(w.x), o2 = lo16(w.y), o3 = hi16(w.y);
        const float ss = wave_sum((o0 * o0 + o1 * o1) + (o2 * o2 + o3 * o3));
        const float r = 1.0f / sqrtf(ss * (1.0f / 256.0f) + EPS);
        u32x2 q; q.x = pk2(o0 * r * lo16(gq.x), o1 * r * hi16(gq.x)); q.y = pk2(o2 * r * lo16(gq.y), o3 * r * hi16(gq.y)); *p = q;
    }
}
namespace nsaf {
constexpr int KROW = 272, VROW = 136, KT_BYTES = 64 * KROW, VT_BYTES = 128 * VROW;
constexpr int OFF_K = 0, OFF_V = KT_BYTES, BUF_BYTES = KT_BYTES + VT_BYTES, OFF_IMP = 2 * BUF_BYTES, OFF_MASK = OFF_IMP + 64 * 64 * 4;
constexpr float NEG = -1.0e30f, MASKED = -3.0e38f, CS = 0.08838834764831845f * 1.4426950408889634f;
struct Stage { u32x4 k0, k1, v0, v1; };
__device__ __forceinline__ void stage_load(Stage& st, const bf16* K, const bf16* VT, size_t vpitch, int key0, int tid) {
    const int r0 = tid >> 4, c0 = tid & 15;
    st.k0 = *(const u32x4*)(K + (size_t)(key0 + r0) * 128 + c0 * 8); st.k1 = *(const u32x4*)(K + (size_t)(key0 + r0 + 32) * 128 + c0 * 8);
    const int d0 = tid >> 3, c1 = tid & 7;
    st.v0 = *(const u32x4*)(VT + (size_t)d0 * vpitch + key0 + c1 * 8); st.v1 = *(const u32x4*)(VT + (size_t)(d0 + 64) * vpitch + key0 + c1 * 8);
}
__device__ __forceinline__ void stage_write(const Stage& st, LAS unsigned char* lds, int tid) {
    const int r0 = tid >> 4, c0 = tid & 15;
    *(LAS u32x4*)(lds + OFF_K + r0 * KROW + c0 * 16) = st.k0; *(LAS u32x4*)(lds + OFF_K + (r0 + 32) * KROW + c0 * 16) = st.k1;
    const int d0 = tid >> 3, c1 = tid & 7;
    LAS unsigned char* p0 = lds + OFF_V + d0 * VROW + c1 * 16; LAS unsigned char* p1 = lds + OFF_V + (d0 + 64) * VROW + c1 * 16;
    *(LAS u32x2*)p0 = (u32x2){st.v0.x, st.v0.y}; *(LAS u32x2*)(p0 + 8) = (u32x2){st.v0.z, st.v0.w};
    *(LAS u32x2*)p1 = (u32x2){st.v1.x, st.v1.y}; *(LAS u32x2*)(p1 + 8) = (u32x2){st.v1.z, st.v1.w};
}
template <int MODE>
__device__ __forceinline__ void block_step(const LAS unsigned char* lds, LAS unsigned char* ldstab, const bf16x8 (&qf)[8], f32x16 (&O)[4], float& m, float& l, int blk, int jfast, int tl_in, int itile, int nvr_in, bool rowsel, float inv_l, int lane_in) {
    int tl = tl_in, nvr = nvr_in, lane = lane_in; LAUNDER(tl); LAUNDER(nvr); LAUNDER(lane);
    const int r = lane & 31, hi = lane >> 5;
    f32x16 S[2];
#pragma unroll
    for (int kh = 0; kh < 2; ++kh) {
#pragma unroll
        for (int j = 0; j < 16; ++j) S[kh][j] = 0.f;
    }
    {
        const unsigned kaddr = (unsigned)(size_t)(lds + OFF_K + r * KROW + 16 * hi);
        u32x4 ka[4], kb[4];
#define NSAF_KRD(dst, t, s4) asm volatile("ds_read_b128 %0, %1 offset:%2" : "=v"(dst) : "v"(kaddr), "i"((t) * 32 * KROW + (s4) * 32))
#define NSAF_KRD4(set, t, s0) do { NSAF_KRD(set[0], t, (s0)); NSAF_KRD(set[1], t, (s0) + 1); NSAF_KRD(set[2], t, (s0) + 2); NSAF_KRD(set[3], t, (s0) + 3); } while (0)
#define NSAF_KWAIT(n, set) asm volatile("s_waitcnt lgkmcnt(" #n ")" : "+v"(set[0]), "+v"(set[1]), "+v"(set[2]), "+v"(set[3]))
#define NSAF_KMMA(set, t, s0) do { _Pragma("unroll") for (int q_ = 0; q_ < 4; ++q_) S[t] = __builtin_amdgcn_mfma_f32_32x32x16_bf16(__builtin_bit_cast(bf16x8, set[q_]), qf[(s0) + q_], S[t], 0, 0, 0); } while (0)
        NSAF_KRD4(ka, 0, 0); NSAF_KRD4(kb, 0, 4);
        NSAF_KWAIT(4, ka); NSAF_KMMA(ka, 0, 0); NSAF_KRD4(ka, 1, 0);
        NSAF_KWAIT(4, kb); NSAF_KMMA(kb, 0, 4); NSAF_KRD4(kb, 1, 4);
        NSAF_KWAIT(4, ka); NSAF_KMMA(ka, 1, 0);
        NSAF_KWAIT(0, kb); NSAF_KMMA(kb, 1, 4);
#undef NSAF_KRD
#undef NSAF_KRD4
#undef NSAF_KWAIT
#undef NSAF_KMMA
    }
    bool need_mask;
    if (MODE <= 1) need_mask = true; else if (MODE == 2) need_mask = (blk == itile); else need_mask = (blk == itile) || (blk == itile - 8);
    if (MODE >= 2 && !need_mask && blk >= jfast) {
        const float msub = (MODE == 2 && !rowsel) ? 3.0e38f : m;
        float rs = 0.f;
#pragma unroll
        for (int kh = 0; kh < 2; ++kh)
#pragma unroll
            for (int j = 0; j < 16; ++j) { const float p = __builtin_amdgcn_exp2f(S[kh][j] - msub); S[kh][j] = p; rs += p; }
        l += rs;
    } else {
    float mx = MASKED;
    if (need_mask) {
        int lo_ = -1, hi_ = 63;
        if (MODE <= 1) hi_ = nvr - 64 * blk - 1; else if (MODE == 2) hi_ = tl; else { hi_ = (blk == itile) ? tl : 63; lo_ = (blk == itile - 8) ? tl : -1; }
        lo_ -= 4 * hi; hi_ -= 4 * hi;
#pragma unroll
        for (int kh = 0; kh < 2; ++kh)
#pragma unroll
            for (int j = 0; j < 16; ++j) { const int kc_ = 32 * kh + (j & 3) + 8 * (j >> 2); const bool ok = (kc_ > lo_) & (kc_ <= hi_); const float v = ok ? S[kh][j] : MASKED; S[kh][j] = v; mx = fmaxf(mx, v); }
    } else {
#pragma unroll
        for (int kh = 0; kh < 2; ++kh)
#pragma unroll
            for (int j = 0; j < 16; ++j) mx = fmaxf(mx, S[kh][j]);
    }
    if (MODE == 2) mx = rowsel ? mx : MASKED;
    if (MODE == 1) {
        LAS float* imp = (LAS float*)(ldstab + OFF_IMP) + tl * 64;
        const bool adder = (lane & 3) == 0;
#pragma unroll
        for (int kh = 0; kh < 2; ++kh)
#pragma unroll
            for (int q = 0; q < 4; ++q) {
                float p4[4];
#pragma unroll
                for (int e = 0; e < 4; ++e) { const float p = __builtin_amdgcn_exp2f(S[kh][4 * q + e] - m) * inv_l; S[kh][4 * q + e] = p; p4[e] = p; }
                float sb = (p4[0] + p4[1]) + (p4[2] + p4[3]), sn = p4[3];
                sb += DPP_F(sb, 0xB1, 0xf); sn += DPP_F(sn, 0xB1, 0xf);
                sb += DPP_F(sb, 0x4E, 0xf); sn += DPP_F(sn, 0x4E, 0xf);
                const int bin = 16 * blk + 8 * kh + 2 * q + hi;
                if (adder) { __hip_atomic_fetch_add(imp + bin, sb, __ATOMIC_RELAXED, __HIP_MEMORY_SCOPE_WORKGROUP); if (bin + 1 < 64) __hip_atomic_fetch_add(imp + bin + 1, sn, __ATOMIC_RELAXED, __HIP_MEMORY_SCOPE_WORKGROUP); }
            }
    } else {
        mx = fmaxf(mx, __shfl_xor(mx, 32));
        if (__any(mx > m + 8.0f)) { const float mn = fmaxf(m, mx); const float alpha = __builtin_amdgcn_exp2f(m - mn); m = mn; l *= alpha;
            if (MODE != 0) {
#pragma unroll
                for (int dt = 0; dt < 4; ++dt)
#pragma unroll
                    for (int j = 0; j < 16; ++j) O[dt][j] *= alpha; } }
        float rs = 0.f;
        if (MODE == 2) {
#pragma unroll
            for (int kh = 0; kh < 2; ++kh)
#pragma unroll
                for (int j = 0; j < 16; ++j) { const float p = rowsel ? __builtin_amdgcn_exp2f(S[kh][j] - m) : 0.f; S[kh][j] = p; rs += p; }
        } else {
#pragma unroll
            for (int kh = 0; kh < 2; ++kh)
#pragma unroll
                for (int j = 0; j < 16; ++j) { const float p = __builtin_amdgcn_exp2f(S[kh][j] - m); S[kh][j] = p; rs += p; }
        }
        l += rs;
        if (MODE == 0) return;
    }
    }
    bf16x8 pf[2][2];
#pragma unroll
    for (int kh = 0; kh < 2; ++kh)
#pragma unroll
        for (int s2 = 0; s2 < 2; ++s2) { u32x4 w; w.x = cvt_pk_bf16(S[kh][8 * s2 + 0], S[kh][8 * s2 + 1]); w.y = cvt_pk_bf16(S[kh][8 * s2 + 2], S[kh][8 * s2 + 3]); w.z = cvt_pk_bf16(S[kh][8 * s2 + 4], S[kh][8 * s2 + 5]); w.w = cvt_pk_bf16(S[kh][8 * s2 + 6], S[kh][8 * s2 + 7]);
            pf[kh][s2] = __builtin_bit_cast(bf16x8, w); }
    {
        const unsigned vaddr = (unsigned)(size_t)(lds + OFF_V + r * VROW + 8 * hi);
        u32x2 va[8], vb[8];
#define NSAF_VRD(dst, dt, i) asm volatile("ds_read_b64 %0, %1 offset:%2" : "=v"(dst) : "v"(vaddr), "i"((dt) * 32 * VROW + ((i) >> 1) * 32 + ((i) & 1) * 16))
#define NSAF_VRD8(set, dt) do { NSAF_VRD(set[0], dt, 0); NSAF_VRD(set[1], dt, 1); NSAF_VRD(set[2], dt, 2); NSAF_VRD(set[3], dt, 3); NSAF_VRD(set[4], dt, 4); NSAF_VRD(set[5], dt, 5); NSAF_VRD(set[6], dt, 6); NSAF_VRD(set[7], dt, 7); } while (0)
#define NSAF_VWAIT(n, set) asm volatile("s_waitcnt lgkmcnt(" #n ")" : "+v"(set[0]), "+v"(set[1]), "+v"(set[2]), "+v"(set[3]), "+v"(set[4]), "+v"(set[5]), "+v"(set[6]), "+v"(set[7]))
#define NSAF_VMMA(set, dt) do { _Pragma("unroll") for (int ks = 0; ks < 4; ++ks) { const u32x4 a_ = (u32x4){set[2 * ks].x, set[2 * ks].y, set[2 * ks + 1].x, set[2 * ks + 1].y}; \
            O[dt] = __builtin_amdgcn_mfma_f32_32x32x16_bf16(__builtin_bit_cast(bf16x8, a_), pf[ks >> 1][ks & 1], O[dt], 0, 0, 0); } } while (0)
        NSAF_VRD8(va, 0); NSAF_VRD8(vb, 1);
        NSAF_VWAIT(8, va); NSAF_VMMA(va, 0); NSAF_VRD8(va, 2);
        NSAF_VWAIT(8, vb); NSAF_VMMA(vb, 1); NSAF_VRD8(vb, 3);
        NSAF_VWAIT(8, va); NSAF_VMMA(va, 2);
        NSAF_VWAIT(0, vb); NSAF_VMMA(vb, 3);
#undef NSAF_VRD
#undef NSAF_VRD8
#undef NSAF_VWAIT
#undef NSAF_VMMA
    }
}
template <int MODE>
__device__ __forceinline__ void run_pass(LAS unsigned char* lds, const bf16* K, const bf16* VT, size_t vpitch, int jb, int je, const bf16x8 (&qf)[8], f32x16 (&O)[4], float& m, float& l, bool allowfast, int tl, int itile, int nvr, unsigned long long selmask, float inv_l, int tid, int lane) {
    Stage st; stage_load(st, K, VT, vpitch, jb * 64, tid); stage_write(st, lds, tid);
    if (jb < je) stage_load(st, K, VT, vpitch, (jb + 1) * 64, tid);
    __syncthreads();
    for (int j = jb; j <= je; ++j) {
        const int cur = (j - jb) & 1;
        if (j < je) { stage_write(st, lds + (cur ^ 1) * BUF_BYTES, tid); if (j + 1 < je) stage_load(st, K, VT, vpitch, (j + 2) * 64, tid); }
        const bool rowsel = (MODE == 2) ? (((selmask >> j) & 1ull) != 0ull) : true;
        if (MODE != 2 || __ballot(rowsel) != 0ull) block_step<MODE>(lds + cur * BUF_BYTES, lds, qf, O, m, l, j, allowfast ? jb + (MODE == 2 ? 1 : 2) : 0x7fffffff, tl, itile, nvr, rowsel, inv_l, lane);
        __syncthreads();
    }
}
}
__device__ __forceinline__ void p3_nsa_fast(Frame& F, const bf16* svT, const bf16* wvT, bf16* outbase) {
    using namespace nsaf;
    unsigned char* ws = F.ws; const int tid = F.tid, lane = F.lane, wave = F.wave; LAS unsigned char* lds = F.lds;
    bf16* nq = (bf16*)(ws + WS_NQ); const float* gates = (const float*)(ws + WS_GATES);
    const int r = lane & 31, hi = lane >> 5, qrow = wave * 32 + r, tl = qrow >> 2, head = qrow & 3;
    unsigned failmask = 0u;
    for (int trip = 0; trip < 2; ++trip) {
    for (int u4 = 0; u4 < 4; ++u4) {
        if (trip == 1 && ((failmask >> u4) & 1u) == 0u) continue;
        const bool allowfast = trip == 0;
        const int pr = (F.bx & 7) * 32 + (F.bx >> 3) + (u4 >> 1) * 256; if (F.bx >= 256) break;
        const int bg = pr >> 5, ii = pr & 31, itile = (u4 & 1) ? (63 - ii) : ii, g = bg & 1, b = bg >> 1;
        const int tok = b * SEQ + itile * 64 + tl, t = itile * 64 + tl;
        const bf16* kc = (const bf16*)(ws + WS_KCMP) + (size_t)bg * 256 * 128; const bf16* vcT = (const bf16*)(ws + WS_VCMPT) + (size_t)bg * 128 * 256;
        const bf16* ks = (const bf16*)(ws + WS_KV6 + 2 * KV_STRIDE) + (size_t)bg * SEQ * 128; const bf16* kw = (const bf16*)(ws + WS_KV6 + 4 * KV_STRIDE) + (size_t)bg * SEQ * 128;
        const bf16* vsT = svT + (size_t)bg * 128 * SEQ; const bf16* vwT = wvT + (size_t)bg * 128 * SEQ;
        __syncthreads();
        for (int i = tid; i < 64 * 64; i += NTHREADS) ((LAS float*)(lds + OFF_IMP))[i] = 0.f;
        bf16x8 qf[8];
        {
            LAS unsigned char* tb_ = lds + wave * 8704;
#pragma unroll
            for (int k_ = 0; k_ < 8; ++k_) { const int rr_ = 4 * k_ + (lane >> 4), ch_ = lane & 15, qr_ = wave * 32 + rr_;
                *(LAS u32x4*)(tb_ + rr_ * 272 + ch_ * 16) = *(const u32x4*)(nq + (size_t)(b * SEQ + itile * 64 + (qr_ >> 2)) * 1024 + g * 512 + (qr_ & 3) * 128 + ch_ * 8); }
            LDS_WAIT(); asm volatile("" ::: "memory");
#pragma unroll
            for (int s_ = 0; s_ < 8; ++s_) { const u32x4 w_ = *(const LAS u32x4*)(tb_ + r * 272 + (16 * s_ + 8 * hi) * 2);
                u32x4 o_; o_.x = cvt_pk_bf16(lo16(w_.x) * CS, hi16(w_.x) * CS); o_.y = cvt_pk_bf16(lo16(w_.y) * CS, hi16(w_.y) * CS); o_.z = cvt_pk_bf16(lo16(w_.z) * CS, hi16(w_.z) * CS); o_.w = cvt_pk_bf16(lo16(w_.w) * CS, hi16(w_.w) * CS);
                qf[s_] = __builtin_bit_cast(bf16x8, o_); }
            __syncthreads();
        }
        const float* gatep = gates + (size_t)tok * 24 + (g * 4 + head) * 3;
        const int nvr = (t >= 31) ? (((t - 31) >> 4) + 1 > 255 ? 255 : ((t - 31) >> 4) + 1) : 0;
        const int jec = ((4 * itile + 2) >> 6) > 3 ? 3 : ((4 * itile + 2) >> 6);
        f32x16 O[4];
#define NSAF_ZERO_O() do { _Pragma("unroll") for (int dt = 0; dt < 4; ++dt) _Pragma("unroll") for (int j = 0; j < 16; ++j) O[dt][j] = 0.f; } while (0)
#define NSAF_ADD2(a_, b_) cvt_pk_bf16(lo16(a_) + lo16(b_), hi16(a_) + hi16(b_))
#define NSAF_ACCUM(coef, FIRST) do { const float cf_ = (coef); LAS unsigned char* tb_ = lds + wave * 8704; \
        _Pragma("unroll") for (int dt = 0; dt < 4; ++dt) { _Pragma("unroll") for (int q4 = 0; q4 < 4; ++q4) \
            *(LAS u32x2*)(tb_ + r * 272 + (32 * dt + 8 * q4 + 4 * hi) * 2) = (u32x2){cvt_pk_bf16(cf_ * O[dt][4 * q4], cf_ * O[dt][4 * q4 + 1]), cvt_pk_bf16(cf_ * O[dt][4 * q4 + 2], cf_ * O[dt][4 * q4 + 3])}; } \
        LDS_WAIT(); asm volatile("" ::: "memory"); \
        _Pragma("unroll 2") for (int k_ = 0; k_ < 8; ++k_) { const int rr_ = 4 * k_ + (lane >> 4), ch_ = lane & 15, qr_ = wave * 32 + rr_; \
            const u32x4 nv_ = *(const LAS u32x4*)(tb_ + rr_ * 272 + ch_ * 16); \
            u32x4* gp_ = (u32x4*)(outbase + (size_t)(b * SEQ + itile * 64 + (qr_ >> 2)) * 1024 + g * 512 + (qr_ & 3) * 128 + ch_ * 8); \
            u32x4 w_ = nv_; if (!(FIRST)) { const u32x4 ov_ = *gp_; w_.x = NSAF_ADD2(nv_.x, ov_.x); w_.y = NSAF_ADD2(nv_.y, ov_.y); w_.z = NSAF_ADD2(nv_.z, ov_.z); w_.w = NSAF_ADD2(nv_.w, ov_.w); } \
            *gp_ = w_; } \
        asm volatile("" ::: "memory"); } while (0)
        float m = NEG, l = 0.f; NSAF_ZERO_O();
        run_pass<0>(lds, kc, vcT, 256, 0, jec, qf, O, m, l, false, tl, itile, nvr, 0ull, 0.f, tid, lane);
        l += __shfl_xor(l, 32); const float invl = l > 0.f ? 1.0f / l : 0.f;
        run_pass<1>(lds, kc, vcT, 256, 0, jec, qf, O, m, l, false, tl, itile, nvr, 0ull, invl, tid, lane);
        NSAF_ACCUM(gatep[0], true);
        __syncthreads();
        for (int tk = 0; tk < 8; ++tk) { const int tokl = wave * 8 + tk; float v = ((const LAS float*)(lds + OFF_IMP))[tokl * 64 + lane];
            const bool forced = (lane == 0) || (lane == itile) || (lane == itile - 1); v = (lane > itile) ? -1.0e4f : (forced ? 1.0e4f : v);
            int rank = 0;
#pragma unroll 16
            for (int i = 0; i < 64; ++i) { const float w = __builtin_bit_cast(float, __builtin_amdgcn_readlane(__builtin_bit_cast(int, v), i)); rank += (w > v || (w == v && i < lane)) ? 1 : 0; }
            const unsigned long long mk = __ballot(rank < 16);
            if (lane == 0) { ((LAS unsigned*)(lds + OFF_MASK))[tokl * 2] = (unsigned)mk; ((LAS unsigned*)(lds + OFF_MASK))[tokl * 2 + 1] = (unsigned)(mk >> 32); } }
        __syncthreads();
        const unsigned long long selmask = (unsigned long long)((const LAS unsigned*)(lds + OFF_MASK))[tl * 2] | ((unsigned long long)((const LAS unsigned*)(lds + OFF_MASK))[tl * 2 + 1] << 32);
        m = NEG; l = 0.f; NSAF_ZERO_O();
        run_pass<2>(lds, ks, vsT, SEQ, 0, itile, qf, O, m, l, allowfast, tl, itile, 0, selmask, 0.f, tid, lane);
        l += __shfl_xor(l, 32); bool bad = !(l < 1.0e12f);
        NSAF_ACCUM(l > 0.f ? gatep[1] / l : 0.f, false);
        __syncthreads();
        m = NEG; l = 0.f; NSAF_ZERO_O();
        run_pass<3>(lds, kw, vwT, SEQ, itile > 8 ? itile - 8 : 0, itile, qf, O, m, l, allowfast, tl, itile, 0, 0ull, 0.f, tid, lane);
        l += __shfl_xor(l, 32); bad = bad | !(l < 1.0e12f);
        NSAF_ACCUM(l > 0.f ? gatep[2] / l : 0.f, false);
        if (allowfast && __syncthreads_or(bad ? 1 : 0)) failmask |= 1u << u4;
#undef NSAF_ZERO_O
#undef NSAF_ACCUM
#undef NSAF_ADD2
    }
    if (failmask == 0u) break;
    }
    __syncthreads();
}
struct SchedP4 {
    unsigned char* ws; int G, c; const char* nsa;
    __device__ __forceinline__ bool next(int i, GU& u) const {
        const int ti = i >> 2, sub = i & 3; const int L = ti * G + c; if (L >= 128 * 4) return false;
        int pm, pn; pg8::tile_map(L, 128, 4, pm, pn);
        const size_t ao = sub == 1 ? WS_RV : sub == 3 ? WS_NQ : WS_H; const size_t bo = sub == 0 ? W_GA : sub == 1 ? W_RO : sub == 2 ? W_GB : W_NO;
        u.A = (sub == 3 ? nsa : (const char*)ws + ao) + (size_t)pm * 256 * D * 2; u.B = (const char*)ws + bo + (size_t)pn * 256 * D * 2; u.pm = pm; u.pn = pn; u.kind = sub; u.rows = nullptr; u.nvalid = 0; u.aux = 0; return true;
    }
};
struct EpiP4 {
    static constexpr bool PERM = true;
    float* scr;
    bf16* Y;
    static __device__ __forceinline__ u32x2 pk4(const f32x4 v) { return (u32x2){cvt_pk_bf16(v[0], v[1]), cvt_pk_bf16(v[2], v[3])}; }
    static __device__ __forceinline__ f32x4 up4(const u32x2 w) { return (f32x4){lo16(w.x), hi16(w.x), lo16(w.y), hi16(w.y)}; }
    __device__ __forceinline__ void operator()(const f32x4 (&acc)[2][2][4][2], const GU& u, int wr, int wc, int fr, int fq) const {
        u32x2* p0 = (u32x2*)scr + threadIdx.x; u32x2* p1 = p0 + 32 * 512;
        if (u.kind == 0 || u.kind == 2) {
            u32x2* p = u.kind == 0 ? p0 : p1;
#pragma unroll
            for (int ai = 0; ai < 2; ++ai)
#pragma unroll
                for (int m = 0; m < 4; ++m) {
#pragma unroll
                    for (int bj = 0; bj < 2; ++bj) { f32x4 v0 = acc[ai][bj][m][0], v1 = acc[ai][bj][m][1];
#pragma unroll
                        for (int j = 0; j < 4; ++j) { v0[j] = sigmoidf_(v0[j]); v1[j] = sigmoidf_(v1[j]); }
                        p[(2 * bj) * 512] = pk4(v0); p[(2 * bj + 1) * 512] = pk4(v1); }
                    p += 4 * 512; LAUNDER(p); }
        } else if (u.kind == 1) {
#pragma unroll
            for (int ai = 0; ai < 2; ++ai)
#pragma unroll
                for (int m = 0; m < 4; ++m) {
#pragma unroll
                    for (int bj = 0; bj < 2; ++bj) { p0[(2 * bj) * 512] = pk4(up4(p0[(2 * bj) * 512]) * acc[ai][bj][m][0]); p0[(2 * bj + 1) * 512] = pk4(up4(p0[(2 * bj + 1) * 512]) * acc[ai][bj][m][1]); }
                    p0 += 4 * 512; LAUNDER(p0); }
        } else {
            bf16* yb = Y + (size_t)(u.pm * 256 + 64 * wr + fr) * D + u.pn * 256 + 32 * wc + 8 * fq;
#pragma unroll
            for (int ai = 0; ai < 2; ++ai)
#pragma unroll
                for (int m = 0; m < 4; ++m) {
#pragma unroll
                    for (int bj = 0; bj < 2; ++bj) {
                        const f32x4 v0 = up4(p0[(2 * bj) * 512]) + up4(p1[(2 * bj) * 512]) * acc[ai][bj][m][0], v1 = up4(p0[(2 * bj + 1) * 512]) + up4(p1[(2 * bj + 1) * 512]) * acc[ai][bj][m][1];
                        u32x4 w; w.x = cvt_pk_bf16(v0[0], v0[1]); w.y = cvt_pk_bf16(v0[2], v0[3]); w.z = cvt_pk_bf16(v1[0], v1[1]); w.w = cvt_pk_bf16(v1[2], v1[3]);
                        *(u32x4*)(yb + (size_t)(128 * ai + 16 * m) * D + 128 * bj) = w; }
                    p0 += 4 * 512; p1 += 4 * 512; LAUNDER(p0); LAUNDER(p1); }
        }
    }
};

struct SchedMN {
    unsigned char* ws; size_t ao, bo; int G, c;
    __device__ __forceinline__ bool next(int i, GU& u) const {
        const int L = i * G + c; if (L >= 128 * 4) return false; int pm, pn; pg8::tile_map(L, 128, 4, pm, pn);
        u.A = (const char*)ws + ao + (size_t)pm * 256 * D * 2; u.B = (const char*)ws + bo + (size_t)pn * 256 * D * 2; u.pm = pm; u.pn = pn; u.kind = 0; u.rows = nullptr; u.nvalid = 0; u.aux = 0; return true;
    }
};
template <bool SSQ> struct EpiRes {
    static constexpr bool PERM = true;
    const float* basef; const bf16* baseb; float* out; bf16* ob; float* ssq;
    __device__ __forceinline__ void operator()(const f32x4 (&acc)[2][2][4][2], const GU& u, int wr, int wc, int fr, int fq) const {
#pragma unroll
        for (int ai = 0; ai < 2; ++ai)
#pragma unroll
            for (int m = 0; m < 4; ++m) { const int r = u.pm * 256 + 128 * ai + 64 * wr + 16 * m + fr; const size_t off = (size_t)r * D + u.pn * 256 + 32 * wc + 8 * fq; float sq = 0.f;
#pragma unroll
                for (int bj = 0; bj < 2; ++bj) { const size_t o = off + 128 * bj; f32x4 b0, b1;
                    if (SSQ) { b0 = *(const f32x4*)(basef + o); b1 = *(const f32x4*)(basef + o + 4); }
                    else { const u32x4 bw = *(const u32x4*)(baseb + o); b0 = (f32x4){lo16(bw.x), hi16(bw.x), lo16(bw.y), hi16(bw.y)}; b1 = (f32x4){lo16(bw.z), hi16(bw.z), lo16(bw.w), hi16(bw.w)}; }
                    const f32x4 v0 = b0 + acc[ai][bj][m][0], v1 = b1 + acc[ai][bj][m][1];
                    if (!SSQ) { *(f32x4*)(out + o) = v0; *(f32x4*)(out + o + 4) = v1; }
                    u32x4 w; w.x = cvt_pk_bf16(v0[0], v0[1]); w.y = cvt_pk_bf16(v0[2], v0[3]); w.z = cvt_pk_bf16(v1[0], v1[1]); w.w = cvt_pk_bf16(v1[2], v1[3]); *(u32x4*)(ob + o) = w;
                    sq += ((v0[0] * v0[0] + v0[1] * v0[1]) + (v0[2] * v0[2] + v0[3] * v0[3])) + ((v1[0] * v1[0] + v1[1] * v1[1]) + (v1[2] * v1[2] + v1[3] * v1[3])); }
                if (SSQ) { sq += __shfl_xor(sq, 16); sq += __shfl_xor(sq, 32); if (fq == 0) ssq[(size_t)r * 16 + u.pn * 4 + wc] = sq; }
            }
    }
};
struct EpiQ {
    static constexpr bool PERM = true;
    const float* ssq; bf16* Q;
    __device__ __forceinline__ void operator()(const f32x4 (&acc)[2][2][4][2], const GU& u, int wr, int wc, int fr, int fq) const {
#pragma unroll
        for (int ai = 0; ai < 2; ++ai)
#pragma unroll
            for (int m = 0; m < 4; ++m) { const int r = u.pm * 256 + 128 * ai + 64 * wr + 16 * m + fr; const f32x4* sp = (const f32x4*)(ssq + (size_t)r * 16);
                const f32x4 a = sp[0], b = sp[1], c = sp[2], d = sp[3]; const float tot = ((a[0] + a[1]) + (a[2] + a[3])) + ((b[0] + b[1]) + (b[2] + b[3])) + ((c[0] + c[1]) + (c[2] + c[3])) + ((d[0] + d[1]) + (d[2] + d[3]));
                const float rstd = 1.0f / sqrtf(tot * (1.0f / D) + EPS);
#pragma unroll
                for (int bj = 0; bj < 2; ++bj) { const f32x4 v0 = acc[ai][bj][m][0] * rstd, v1 = acc[ai][bj][m][1] * rstd;
                    u32x4 w; w.x = cvt_pk_bf16(v0[0], v0[1]); w.y = cvt_pk_bf16(v0[2], v0[3]); w.z = cvt_pk_bf16(v1[0], v1[1]); w.w = cvt_pk_bf16(v1[2], v1[3]);
                    *(u32x4*)(Q + (size_t)r * D + u.pn * 256 + 128 * bj + 32 * wc + 8 * fq) = w; } }
    }
};

namespace xatf {
constexpr int KROW = 528, VROW = 136, KT_BYTES = 64 * KROW, OFF_K = 0, OFF_V = KT_BYTES;
constexpr float NEG = -1.0e30f, CS = 0.0625f * 1.4426950408889634f;
struct Stage { u32x4 k[4]; u32x4 v[2]; };
__device__ __forceinline__ void stage_load(Stage& st, const bf16* K, const bf16* VT, int key0, int tid) {
#pragma unroll
    for (int i = 0; i < 4; ++i) { const int p = tid + 512 * i, row = p >> 5, c = p & 31; st.k[i] = *(const u32x4*)(K + (size_t)(key0 + row) * 2048 + c * 8); }
#pragma unroll
    for (int i = 0; i < 2; ++i) { const int p = tid + 512 * i, d = p >> 3, c = p & 7; st.v[i] = *(const u32x4*)(VT + (size_t)d * 256 + key0 + c * 8); }
}
__device__ __forceinline__ void stage_write(const Stage& st, LAS unsigned char* lds, int tid) {
#pragma unroll
    for (int i = 0; i < 4; ++i) { const int p = tid + 512 * i, row = p >> 5, c = p & 31; *(LAS u32x4*)(lds + OFF_K + row * KROW + c * 16) = st.k[i]; }
#pragma unroll
    for (int i = 0; i < 2; ++i) { const int p = tid + 512 * i, d = p >> 3, c = p & 7; LAS unsigned char* q = lds + OFF_V + d * VROW + c * 16;
        *(LAS u32x2*)q = (u32x2){st.v[i].x, st.v[i].y}; *(LAS u32x2*)(q + 8) = (u32x2){st.v[i].z, st.v[i].w}; }
}
__device__ __forceinline__ void block_step(const LAS unsigned char* lds, const bf16x8 (&qf)[16], f32x16 (&O)[4], float& m, float& l, int lane) {
    const int r = lane & 31, hi = lane >> 5;
    f32x16 S[2];
#pragma unroll
    for (int kh = 0; kh < 2; ++kh) {
#pragma unroll
        for (int j = 0; j < 16; ++j) S[kh][j] = 0.f;
#pragma unroll
        for (int s_ = 0; s_ < 16; ++s_) { const bf16x8 a = *(const LAS bf16x8*)(lds + OFF_K + (kh * 32 + r) * KROW + (16 * s_ + 8 * hi) * 2); S[kh] = __builtin_amdgcn_mfma_f32_32x32x16_bf16(a, qf[s_], S[kh], 0, 0, 0); }
    }
    float mx = NEG;
#pragma unroll
    for (int kh = 0; kh < 2; ++kh)
#pragma unroll
        for (int j = 0; j < 16; ++j) { const float v = S[kh][j] * CS; S[kh][j] = v; mx = fmaxf(mx, v); }
    mx = fmaxf(mx, __shfl_xor(mx, 32));
    const float mn = fmaxf(m, mx); const float alpha = __builtin_amdgcn_exp2f(m - mn); m = mn; float rs = 0.f;
#pragma unroll
    for (int kh = 0; kh < 2; ++kh)
#pragma unroll
        for (int j = 0; j < 16; ++j) { const float p = __builtin_amdgcn_exp2f(S[kh][j] - mn); S[kh][j] = p; rs += p; }
    l = l * alpha + rs;
#pragma unroll
    for (int dt = 0; dt < 4; ++dt)
#pragma unroll
        for (int j = 0; j < 16; ++j) O[dt][j] *= alpha;
    bf16x8 pf[2][2];
#pragma unroll
    for (int kh = 0; kh < 2; ++kh)
#pragma unroll
        for (int s2 = 0; s2 < 2; ++s2) { u32x4 w; w.x = cvt_pk_bf16(S[kh][8 * s2 + 0], S[kh][8 * s2 + 1]); w.y = cvt_pk_bf16(S[kh][8 * s2 + 2], S[kh][8 * s2 + 3]); w.z = cvt_pk_bf16(S[kh][8 * s2 + 4], S[kh][8 * s2 + 5]); w.w = cvt_pk_bf16(S[kh][8 * s2 + 6], S[kh][8 * s2 + 7]);
            pf[kh][s2] = __builtin_bit_cast(bf16x8, w); }
#pragma unroll
    for (int dt = 0; dt < 4; ++dt)
#pragma unroll
        for (int kh = 0; kh < 2; ++kh)
#pragma unroll
            for (int s2 = 0; s2 < 2; ++s2) { const LAS unsigned char* vp = lds + OFF_V + (dt * 32 + r) * VROW + (32 * kh + 16 * s2 + 4 * hi) * 2;
                const u32x2 lo = *(const LAS u32x2*)vp, hi2 = *(const LAS u32x2*)(vp + 16); const u32x4 av = (u32x4){lo.x, lo.y, hi2.x, hi2.y};
                O[dt] = __builtin_amdgcn_mfma_f32_32x32x16_bf16(__builtin_bit_cast(bf16x8, av), pf[kh][s2], O[dt], 0, 0, 0); }
}
}
__device__ __forceinline__ void p7_xattn_fast(Frame& F, const bf16* vT, bf16* outbase) {
    using namespace xatf;
    bf16* Q = (bf16*)(F.ws + WS_NQ); const bf16* KV = (const bf16*)(F.ws + WS_MEMKV);
    const int tid = F.tid, lane = F.lane, wave = F.wave, r = lane & 31, hi = lane >> 5; LAS unsigned char* lds = F.lds;
    for (int u = F.bx; u < BATCH * 4 * 16; u += F.G) {
        const int tt = u & 15, bh = u >> 4, b = bh >> 2, h = bh & 3; const int tok = b * SEQ + tt * 256 + wave * 32 + r;
        bf16* qrow = Q + (size_t)tok * D + h * 256; bf16* orow = outbase + (size_t)tok * D + h * 256; const bf16* Kb = KV + (size_t)(b * NMEM) * 2048 + h * 256;
        bf16x8 qf[16];
        LAS unsigned char* tb_ = lds + 61440 + wave * 8704;
        bf16* rows0 = Q + (size_t)(b * SEQ + tt * 256 + wave * 32) * D + h * 256;
#pragma unroll
        for (int hq = 0; hq < 2; ++hq) {
#pragma unroll 4
            for (int k_ = 0; k_ < 8; ++k_) { const int rr_ = 4 * k_ + (lane >> 4), ch_ = lane & 15; *(LAS u32x4*)(tb_ + rr_ * 272 + ch_ * 16) = *(const u32x4*)(rows0 + (size_t)rr_ * D + hq * 128 + ch_ * 8); }
            LDS_WAIT(); asm volatile("" ::: "memory");
#pragma unroll
            for (int s_ = 0; s_ < 8; ++s_) qf[8 * hq + s_] = *(const LAS bf16x8*)(tb_ + r * 272 + (16 * s_ + 8 * hi) * 2);
            LDS_WAIT(); asm volatile("" ::: "memory");
        }
        const bf16* VT0 = vT + (size_t)bh * 256 * 256;
        Stage st; stage_load(st, Kb, VT0, 0, tid);
        f32x16 O[4]; float m = NEG, l = 0.f;
        for (int idx = 0; idx < 8; ++idx) {
            const int half = idx >> 2, j = idx & 3;
            if (j == 0) { m = NEG; l = 0.f;
#pragma unroll
                for (int dt = 0; dt < 4; ++dt)
#pragma unroll
                    for (int jj = 0; jj < 16; ++jj) O[dt][jj] = 0.f; }
            __syncthreads(); stage_write(st, lds, tid);
            { const int i2 = idx < 7 ? idx + 1 : idx; stage_load(st, Kb, VT0 + (size_t)((i2 >> 2) * 128) * 256, (i2 & 3) * 64, tid); }
            __syncthreads();
            block_step(lds, qf, O, m, l, lane);
            if (j == 3) {
                l += __shfl_xor(l, 32); const float inv = 1.0f / l;
#pragma unroll
                for (int dt = 0; dt < 4; ++dt)
#pragma unroll
                    for (int q4 = 0; q4 < 4; ++q4) *(LAS u32x2*)(tb_ + r * 272 + (32 * dt + 8 * q4 + 4 * hi) * 2) = (u32x2){cvt_pk_bf16(O[dt][4 * q4] * inv, O[dt][4 * q4 + 1] * inv), cvt_pk_bf16(O[dt][4 * q4 + 2] * inv, O[dt][4 * q4 + 3] * inv)};
                LDS_WAIT(); asm volatile("" ::: "memory");
#pragma unroll 2
                for (int k_ = 0; k_ < 8; ++k_) { const int rr_ = 4 * k_ + (lane >> 4), ch_ = lane & 15; *(u32x4*)(rows0 + (size_t)rr_ * D + half * 128 + ch_ * 8) = *(const LAS u32x4*)(tb_ + rr_ * 272 + ch_ * 16); }
                LDS_WAIT(); asm volatile("" ::: "memory");
            }
        }
    }
    __syncthreads();
}
__device__ __forceinline__ void transpose_memv_tiles(Frame& F, bf16* vT, int w0, int nw) {
    LAS unsigned short* tl_ = (LAS unsigned short*)(F.lds + F.wave * 16384); const int lane = F.lane; const bf16* KV = (const bf16*)(F.ws + WS_MEMKV);
    for (int tile = w0; tile < 32 * 16; tile += nw) {
        const int dq = tile & 3, kq = (tile >> 2) & 3, bh = tile >> 4, b = bh >> 2, h = bh & 3;
        const bf16* sp = KV + (size_t)(b * NMEM + kq * 64) * 2048 + 1024 + h * 256 + dq * 64; bf16* dp = vT + ((size_t)bh * 256 + dq * 64) * 256 + kq * 64;
#pragma unroll
        for (int i = 0; i < 8; ++i) { const int row = i * 8 + (lane >> 3), c = lane & 7; const u32x4 v = *(const u32x4*)(sp + (size_t)row * 2048 + c * 8); LAS unsigned short* q = tl_ + row * 66 + c * 8;
            q[0] = (unsigned short)(v.x & 0xffffu); q[1] = (unsigned short)(v.x >> 16); q[2] = (unsigned short)(v.y & 0xffffu); q[3] = (unsigned short)(v.y >> 16);
            q[4] = (unsigned short)(v.z & 0xffffu); q[5] = (unsigned short)(v.z >> 16); q[6] = (unsigned short)(v.w & 0xffffu); q[7] = (unsigned short)(v.w >> 16); }
        LDS_WAIT(); asm volatile("" ::: "memory");
#pragma unroll
        for (int i = 0; i < 8; ++i) { const int d = i * 8 + (lane >> 3), c = lane & 7; const LAS unsigned short* q = tl_ + (c * 8) * 66 + d;
            u32x4 o; o.x = (unsigned)q[0] | ((unsigned)q[66] << 16); o.y = (unsigned)q[2 * 66] | ((unsigned)q[3 * 66] << 16); o.z = (unsigned)q[4 * 66] | ((unsigned)q[5 * 66] << 16); o.w = (unsigned)q[6 * 66] | ((unsigned)q[7 * 66] << 16);
            *(u32x4*)(dp + (size_t)d * 256 + c * 8) = o; }
        LDS_WAIT(); asm volatile("" ::: "memory");
    }
}

__device__ __forceinline__ void p9_route(Frame& F, const Args& a) {
    unsigned char* ws = F.ws; const float* X2 = a.out;
    const float* gff = a.in[IN_NORM_FFN_G]; const float* wgrp = a.in[IN_W_GRP]; const float* bgrp = a.in[IN_B_GRP]; const float* wrt = a.in[IN_W_RT]; const float* brt = a.in[IN_B_RT];
    float* wts = (float*)(ws + WS_ROUTE); float* rstd2 = wts + 2 * NTOK; int* lists = (int*)(ws + WS_LISTS);
    const int gw = F.bx * NWAVES + F.wave, NGW = F.G * NWAVES, lane = F.lane;
    const f32x4* wgp = (const f32x4*)(ws + WS_RTW); const f32x4* wep = wgp + 1024;
    float xn[16];
    if (gw < NTOK) {
#pragma unroll
        for (int i = 0; i < 16; ++i) xn[i] = X2[(size_t)gw * D + 64 * i + lane]; }
    int my_ea = -1, my_eb = -1, my_tok = -1, it_ = 0; float my_w1 = 0.f, my_w2 = 0.f, my_rstd = 0.f;
    for (int tok = gw; tok < NTOK; tok += NGW, ++it_) {
        float xa[16]; float s = 0.f;
#pragma unroll
        for (int i = 0; i < 16; ++i) { xa[i] = xn[i]; s += xa[i] * xa[i]; }
        if (tok + NGW < NTOK) {
#pragma unroll
            for (int i = 0; i < 16; ++i) xn[i] = X2[(size_t)(tok + NGW) * D + 64 * i + lane]; }
        const float rstd = 1.0f / sqrtf(wave_sum(s) * (1.f / D) + EPS);
        float lg[4] = {0.f, 0.f, 0.f, 0.f};
#pragma unroll
        for (int i = 0; i < 16; ++i) { const f32x4 wg = wgp[64 * i + lane];
#pragma unroll
            for (int c = 0; c < 4; ++c) lg[c] += xa[i] * wg[c]; }
#pragma unroll
        for (int i = 0; i < 4; ++i) lg[i] = rstd * wave_sum(lg[i]) + bgrp[i];
        int grp = 0; float gm = lg[0];
#pragma unroll
        for (int i = 1; i < 4; ++i) if (lg[i] > gm) { gm = lg[i]; grp = i; }
        grp = __builtin_amdgcn_readfirstlane(grp);
        float gs = 0.f;
#pragma unroll
        for (int i = 0; i < 4; ++i) gs += expf(lg[i] - gm);
        const float g_gate = 1.0f / gs;
        float lq[8];
#pragma unroll
        for (int i = 0; i < 8; ++i) lq[i] = 0.f;
        const f32x4* pwe = wep + (size_t)grp * (16 * 2 * 64) + lane;
#pragma unroll
        for (int i = 0; i < 16; ++i) { const f32x4 wa = pwe[(2 * i) * 64], wb = pwe[(2 * i + 1) * 64];
#pragma unroll
            for (int c = 0; c < 4; ++c) { lq[c] += xa[i] * wa[c]; lq[4 + c] += xa[i] * wb[c]; } }
#pragma unroll
        for (int i = 0; i < 8; ++i) lq[i] = rstd * wave_sum(lq[i]) + brt[grp * 8 + i];
        int i1 = 0; float m1 = lq[0];
#pragma unroll
        for (int i = 1; i < 8; ++i) if (lq[i] > m1) { m1 = lq[i]; i1 = i; }
        int i2 = -1; float m2 = -3.0e38f;
#pragma unroll
        for (int i = 0; i < 8; ++i) if (i != i1 && lq[i] > m2) { m2 = lq[i]; i2 = i; }
        const float e2 = expf(m2 - m1), den = 1.0f + e2; const float w1 = g_gate / den, w2 = g_gate * e2 / den;
        if (lane == it_) { my_ea = grp * 8 + i1; my_eb = grp * 8 + i2; my_tok = tok; my_w1 = w1; my_w2 = w2; my_rstd = rstd; }
    }
    LAS unsigned* cnt = (LAS unsigned*)(F.lds + MISC_OFF + 1024); LAS unsigned* base = cnt + 32;
    __syncthreads();
    if (F.tid < 32) cnt[F.tid] = 0u;
    __syncthreads();
    unsigned pa = 0u, pb = 0u;
    if (my_tok >= 0) { pa = __hip_atomic_fetch_add(cnt + my_ea, 1u, __ATOMIC_RELAXED, __HIP_MEMORY_SCOPE_WORKGROUP); pb = __hip_atomic_fetch_add(cnt + my_eb, 1u, __ATOMIC_RELAXED, __HIP_MEMORY_SCOPE_WORKGROUP); }
    __syncthreads();
    if (F.tid < 32) { const unsigned c = cnt[F.tid]; base[F.tid] = c ? __hip_atomic_fetch_add(F.ctl + CW_ECNT + 64 * F.tid, c, __ATOMIC_RELAXED, __HIP_MEMORY_SCOPE_AGENT) : 0u; }
    __syncthreads();
    if (my_tok >= 0) {
        lists[(size_t)my_ea * NTOK + base[my_ea] + pa] = my_tok * 2; lists[(size_t)my_eb * NTOK + base[my_eb] + pb] = my_tok * 2 + 1;
        wts[my_tok * 2] = my_w1; wts[my_tok * 2 + 1] = my_w2; rstd2[my_tok] = my_rstd;
    }
    __syncthreads();
}
__device__ __forceinline__ void moe_tiles(Frame& F) {
    __syncthreads();
    if (F.tid < NEXP) F.MISC[64 + F.tid] = __hip_atomic_load(F.ctl + CW_ECNT + 64 * F.tid, __ATOMIC_RELAXED, __HIP_MEMORY_SCOPE_AGENT);
    __syncthreads();
    if (F.tid == 0) { unsigned accu = 0u; for (int e = 0; e < NEXP; ++e) { const unsigned c = F.MISC[64 + e]; F.MISC[16 + e] = accu; accu += (c + 255u) >> 8; } F.MISC[16 + NEXP] = accu; }
    __syncthreads();
}
template <int WHICH> struct SchedMoe {
    volatile LAS unsigned* MISC; unsigned char* ws; int G, c;
    __device__ __forceinline__ bool next(int i, GU& u) const {
        const int L = G == 256 ? i * G + (c & 7) * 32 + (c >> 3) : i * G + c; const int T = (int)MISC[16 + NEXP]; if (L >= 4 * T) return false;
        const int tau = L >> 2, pn = L & 3;
        const int ln_ = threadIdx.x & 63; const int st_ = (ln_ >= 1 && ln_ < NEXP) ? (int)MISC[16 + ln_] : 0x7fffffff;
        const int e = __popcll(__ballot(st_ <= tau));
        const int lt = tau - (int)MISC[16 + e]; const int cnt = (int)MISC[64 + e]; int nv = cnt - lt * 256; nv = nv > 256 ? 256 : nv;
        u.rows = (const int*)(ws + WS_LISTS) + (size_t)e * NTOK + lt * 256; u.nvalid = nv; u.pm = tau; u.pn = pn; u.kind = 0; u.aux = e;
        if (WHICH == 0) { u.A = (const char*)ws + WS_X2B; u.B = (const char*)ws + WS_W13 + (size_t)e * D * D * 2 + (size_t)pn * 256 * D * 2; }
        else { u.A = (const char*)ws + WS_H1 + (size_t)tau * 256 * DEXP * 2; u.B = (const char*)ws + WS_W2 + (size_t)e * D * DEXP * 2 + (size_t)pn * 256 * DEXP * 2; }
        return true;
    }
};
struct EpiMoe1 {
    static constexpr bool PERM = true;
    const float* rstd2; bf16* H1;
    __device__ __forceinline__ void operator()(const f32x4 (&acc)[2][2][4][2], const GU& u, int wr, int wc, int fr, int fq) const {
        char* hb = (char*)H1 + (size_t)u.pm * 256 * DEXP * 2;
        const int j00 = (u.pn * 256 + 32 * wc + 8 * fq) >> 1;
#pragma unroll
        for (int ai = 0; ai < 2; ++ai) {
            int r = 128 * ai + 64 * wr + fr; LAUNDER(r);
#pragma unroll
            for (int m = 0; m < 4; ++m) { const bool ok = r < u.nvalid; const float rs = ok ? rstd2[u.rows[r] >> 1] : 0.f;
#pragma unroll
                for (int bj = 0; bj < 2; ++bj) { const f32x4 a1 = acc[ai][bj][m][0] * rs, a3 = acc[ai][bj][m][1] * rs; f32x4 hv;
#pragma unroll
                    for (int j = 0; j < 4; ++j) hv[j] = a1[j] * sigmoidf_(a1[j]) * a3[j];
                    u32x2 w; w.x = cvt_pk_bf16(hv[0], hv[1]); w.y = cvt_pk_bf16(hv[2], hv[3]); *(u32x2*)(hb + (unsigned)((r * DEXP + j00 + 64 * bj) * 2)) = w; }
                r += 16; LAUNDER(r); }
        }
    }
};
struct EpiMoe2 {
    static constexpr bool PERM = true;
    const float* wts; bf16* Y0; bf16* Y1;
    __device__ __forceinline__ void operator()(const f32x4 (&acc)[2][2][4][2], const GU& u, int wr, int wc, int fr, int fq) const {
        int ent[8]; float w8[8];
#pragma unroll
        for (int i = 0; i < 8; ++i) { const int r = 128 * (i >> 2) + 64 * wr + 16 * (i & 3) + fr; ent[i] = r < u.nvalid ? u.rows[r] : -1; }
#pragma unroll
        for (int i = 0; i < 8; ++i) w8[i] = ent[i] >= 0 ? wts[ent[i]] : 0.f;
#pragma unroll
        for (int i = 0; i < 8; ++i) { const int ai = i >> 2, m = i & 3;
            if (ent[i] >= 0) { bf16* dst = ((ent[i] & 1) ? Y1 : Y0) + (size_t)(ent[i] >> 1) * D + u.pn * 256 + 32 * wc + 8 * fq;
#pragma unroll
                for (int bj = 0; bj < 2; ++bj) { const f32x4 v0 = acc[ai][bj][m][0] * w8[i], v1 = acc[ai][bj][m][1] * w8[i];
                    u32x4 w; w.x = cvt_pk_bf16(v0[0], v0[1]); w.y = cvt_pk_bf16(v0[2], v0[3]); w.z = cvt_pk_bf16(v1[0], v1[1]); w.w = cvt_pk_bf16(v1[2], v1[3]);
                    *(u32x4*)(dst + 128 * bj) = w; } } }
    }
};

__device__ __forceinline__ void p12_final(Frame& F, const Args& a) {
    const bf16* Y0 = (const bf16*)(F.ws + WS_YS0); const bf16* Y1 = (const bf16*)(F.ws + WS_YS1); const bf16* X2 = (const bf16*)(F.ws + WS_X2B); const float* g = a.in[IN_NORM_F_G];
    const int gw = F.bx * NWAVES + F.wave, NGW = F.G * NWAVES, lane = F.lane;
    for (int tok = gw; tok < NTOK; tok += NGW) {
        f32x4* xr = (f32x4*)(a.out + (size_t)tok * D) + lane; const u32x2* x2 = (const u32x2*)(X2 + (size_t)tok * D) + lane; const u32x2* y0 = (const u32x2*)(Y0 + (size_t)tok * D) + lane; const u32x2* y1 = (const u32x2*)(Y1 + (size_t)tok * D) + lane;
        f32x4 v[4]; float s = 0.f;
#pragma unroll
        for (int j = 0; j < 4; ++j) { const u32x2 xx = x2[64 * j], p = y0[64 * j], q = y1[64 * j];
            v[j].x = lo16(xx.x) + (lo16(p.x) + lo16(q.x)); v[j].y = hi16(xx.x) + (hi16(p.x) + hi16(q.x)); v[j].z = lo16(xx.y) + (lo16(p.y) + lo16(q.y)); v[j].w = hi16(xx.y) + (hi16(p.y) + hi16(q.y));
            s += (v[j].x * v[j].x + v[j].y * v[j].y) + (v[j].z * v[j].z + v[j].w * v[j].w); }
        const float rstd = 1.0f / sqrtf(wave_sum(s) * (1.f / D) + EPS);
#pragma unroll
        for (int j = 0; j < 4; ++j) { const f32x4 gg = ((const f32x4*)g + lane)[64 * j]; xr[64 * j] = v[j] * rstd * gg; }
    }
}

constexpr int N_PHASES = 14;
__global__ void __launch_bounds__(NTHREADS, 2) fwd(Args args) {
    extern __shared__ __attribute__((aligned(16))) unsigned char lds[];
    Frame F;
    F.lds = (LAS unsigned char*)lds; F.MISC = (volatile LAS unsigned*)(F.lds + MISC_OFF);
    F.tid = threadIdx.x; F.lane = F.tid & 63; F.wave = __builtin_amdgcn_readfirstlane(F.tid >> 6); F.G = gridDim.x; F.bx = blockIdx.x;
    F.ws = args.ws; F.ctl = (unsigned*)(args.ws + WS_CTL);
    unsigned char* ws = args.ws;
    for (int u = F.tid; u < (LDS_BYTES - RING_BYTES) / 4; u += NTHREADS) ((LAS unsigned*)(F.lds + RING_BYTES))[u] = 0u;
    __syncthreads();
    const int lo = args.ph_lo, hi = args.ph_hi;
    const bool one = (hi - lo) > 1;
    XcdBarrier bar; bar.bar = F.ctl + CW_BAR; bar.x = 0; bar.st = F.MISC + 8;
    if (one) bar = xcd_barrier_post(F.ctl + CW_BAR, F.MISC + 8);
#define IN(k) (lo <= (k) && (k) < hi && phase_begin(F))
#define SEAM(k) do { if (lo <= (k) && (k) + 1 < hi) xcd_barrier(bar); } while (0)

    if (IN(0)) { p0_prologue(F, args); } SEAM(0);
    if (IN(1)) {
        SchedP1 S{ws, F.G, F.bx};
        EpiP1 E{ws};
        pg8::gemm_phase<EpiP1, SchedP1, false>(F.lds, D, D, D, S, E);
        p1_gate_logits(F);
    } SEAM(1);
    if (IN(2)) {
        p2_retention_fast(F, F.bx, (bf16*)(ws + WS_RV));
        { const int w0 = F.bx * NWAVES + F.wave, nw = F.G * NWAVES;
            transpose_kv_tiles(F, (const bf16*)(ws + WS_KV6 + 3 * KV_STRIDE), (bf16*)args.out, w0, nw);
            transpose_kv_tiles(F, (const bf16*)(ws + WS_KV6 + 5 * KV_STRIDE), (bf16*)((unsigned char*)args.out + KV_STRIDE), w0, nw);
            transpose_memv_tiles(F, (bf16*)(ws + WS_MEMVT), w0, nw); }
        __syncthreads();
        { SchedCmp S{ws, 0, F.G, F.bx}; EpiCmp E{(float*)args.out + (size_t)16 * MiB};
            pg8::gemm_phase<EpiCmp, SchedCmp, false>(F.lds, 512, 2048, 4096, S, E); }
    } SEAM(2);
    if (IN(3)) { p2b_compress_out(F, args); } SEAM(3);
    if (IN(4)) { p3_ret_normalize(F); p3_nsa_fast(F, (const bf16*)args.out, (const bf16*)((const unsigned char*)args.out + KV_STRIDE), (bf16*)((unsigned char*)args.out + 64 * MiB)); } SEAM(4);
    if (IN(5)) {
        SchedP4 S{ws, F.G, F.bx, (const char*)args.out + 64 * MiB};
        EpiP4 E{(float*)(ws + WS_P4SCR) + (size_t)F.bx * (2 * 32 * 512 * 4), (bf16*)(ws + WS_Y)};
        pg8::gemm_phase<EpiP4, SchedP4, false>(F.lds, D, D, D, S, E);
    } SEAM(5);
    if (IN(6)) {
        SchedMN S{ws, WS_Y, W_OUT, F.G, F.bx}; EpiRes<true> E{args.in[IN_X], nullptr, nullptr, (bf16*)(ws + WS_X1B), (float*)(ws + WS_SSQ)};
        pg8::gemm_phase<EpiRes<true>, SchedMN, false>(F.lds, D, D, D, S, E);
    } SEAM(6);
    if (IN(7)) {
        const bool early = ((F.bx >> 3) & 1) == 0;
        if (early) expert_copies(F, args, 0, NEXP / 2);
        SchedMN S{ws, WS_X1B, W_XQ, F.G, F.bx}; EpiQ E{(const float*)(ws + WS_SSQ), (bf16*)(ws + WS_NQ)};
        pg8::gemm_phase<EpiQ, SchedMN, false>(F.lds, D, D, D, S, E);
        if (!early) { __syncthreads(); expert_copies(F, args, 0, NEXP / 2); }
    } SEAM(7);
    if (IN(8)) { p7_xattn_fast(F, (const bf16*)(ws + WS_MEMVT), (bf16*)(ws + WS_NQ)); } SEAM(8);
    if (IN(9)) {
        const bool early = ((F.bx >> 3) & 1) == 0;
        if (early) expert_copies(F, args, NEXP / 2, NEXP);
        SchedMN S{ws, WS_NQ, W_XO, F.G, F.bx}; EpiRes<false> E{nullptr, (const bf16*)(ws + WS_X1B), args.out, (bf16*)(ws + WS_X2B), nullptr};
        pg8::gemm_phase<EpiRes<false>, SchedMN, false>(F.lds, D, D, D, S, E);
        if (!early) { __syncthreads(); expert_copies(F, args, NEXP / 2, NEXP); }
    } SEAM(9);
    if (IN(10)) { p9_route(F, args); } SEAM(10);
    if (IN(11)) {
        moe_tiles(F);
        SchedMoe<0> S{F.MISC, ws, F.G, F.bx}; EpiMoe1 E{(const float*)(ws + WS_ROUTE) + 2 * NTOK, (bf16*)(ws + WS_H1)};
        pg8::gemm_phase<EpiMoe1, SchedMoe<0>, true>(F.lds, D, D, D, S, E);
    } SEAM(11);
    if (IN(12)) {
        moe_tiles(F);
        SchedMoe<1> S{F.MISC, ws, F.G, F.bx}; EpiMoe2 E{(const float*)(ws + WS_ROUTE), (bf16*)(ws + WS_YS0), (bf16*)(ws + WS_YS1)};
        pg8::gemm_phase<EpiMoe2, SchedMoe<1>, false>(F.lds, DEXP, DEXP, DEXP, S, E);
    } SEAM(12);
    if (IN(13)) { p12_final(F, args); }
#undef IN
#undef SEAM
}

extern "C" void kernel_launch(void* const* d_in, const int* in_sizes, int n_in, void* d_out, int out_size, void* d_ws, size_t ws_size, hipStream_t stream) {
    static int grid = 0;
    if (grid == 0) {
        if (n_in != 27 || in_sizes[0] != NTOK * D || out_size != NTOK * D || ws_size < WS_END) {
            fprintf(stderr, "kernel_launch: unexpected shapes: n_in %d in0 %d out %d ws %zu (need %zu)\n", n_in, n_in > 0 ? in_sizes[0] : -1, out_size, ws_size, (size_t)WS_END); grid = -1; return; }
        int dev = 0, cus = 0, per_cu = 0;
        if (hipGetDevice(&dev) != hipSuccess || hipDeviceGetAttribute(&cus, hipDeviceAttributeMultiprocessorCount, dev) != hipSuccess) { grid = -1; return; }
        if (hipFuncSetAttribute((const void*)fwd, hipFuncAttributeMaxDynamicSharedMemorySize, LDS_BYTES) != hipSuccess) { fprintf(stderr, "kernel_launch: hipFuncSetAttribute failed\n"); grid = -1; return; }
        if (hipOccupancyMaxActiveBlocksPerMultiprocessor(&per_cu, (const void*)fwd, NTHREADS, LDS_BYTES) != hipSuccess || per_cu < 1) fprintf(stderr, "kernel_launch: occupancy query reports %d\n", per_cu);
        (void)hipGetLastError();
        grid = cus < 256 ? cus : 256;
    }
    if (grid < 0) return;
    (void)hipMemsetAsync((char*)d_ws + WS_CTL, 0, CTL_ZERO_BYTES, stream);
    Args a{};
    for (int i = 0; i < 27; ++i) a.in[i] = (const float*)d_in[i];
    a.out = (float*)d_out; a.ws = (unsigned char*)d_ws;
#if MK_N_LAUNCHES == 1
    a.ph_lo = 0; a.ph_hi = N_PHASES;
    hipLaunchKernelGGL(fwd, dim3(grid), dim3(NTHREADS), LDS_BYTES, stream, a);
#else
    for (int p = 0; p < N_PHASES; ++p) { a.ph_lo = p; a.ph_hi = p + 1; hipLaunchKernelGGL(fwd, dim3(grid), dim3(NTHREADS), LDS_BYTES, stream, a); }
#endif
}
```

```cpp
#include <hip/hip_runtime.h>
#include <cstdio>
#include <cstdint>

#ifndef MK_N_LAUNCHES
#define MK_N_LAUNCHES 1
#endif

#define LAS __attribute__((address_space(3)))
#define GAS __attribute__((address_space(1)))
#define HD __host__ __device__
#define HDI __host__ __device__ __attribute__((always_inline)) inline
typedef unsigned short bf16;
typedef short bf16x8 __attribute__((ext_vector_type(8)));
typedef float f32x4 __attribute__((ext_vector_type(4)));
typedef float f32x2 __attribute__((ext_vector_type(2)));
typedef float f32x16 __attribute__((ext_vector_type(16)));
typedef unsigned u32x4 __attribute__((ext_vector_type(4)));
typedef unsigned u32x2 __attribute__((ext_vector_type(2)));

constexpr int D = 1024, BATCH = 8, SEQ = 4096, NTOK = BATCH * SEQ, NMEM = 256, NMEMTOK = BATCH * NMEM;
constexpr int DIN = 7704;
constexpr int C_RQ = 0, C_RK = 512, C_RV = 1024, C_RG = 2048, C_NQ = 3072, C_CK = 4096, C_NGL = 5632, C_GA = 5656, C_GB = 6680;
constexpr int NPROJ = 5632;
constexpr int NEXP = 32, DEXP = 512;
constexpr float EPS = 1e-6f;
constexpr int NWAVES = 8, NTHREADS = 512;

constexpr size_t MiB = 1u << 20;
constexpr size_t WS_CTL = 0, CTL_ZERO_BYTES = 1 * MiB;
constexpr size_t WS_ROPE_COS = 1 * MiB, WS_ROPE_SIN = 2 * MiB;
constexpr size_t WS_RTW = 3 * MiB + 512 * 1024;
constexpr size_t WS_SMALLW = 3 * MiB;
constexpr size_t WS_MEMVT = 24 * MiB;
constexpr size_t WS_KCMP = 4 * MiB, WS_VCMP = 5 * MiB, WS_VCMPT = 35 * MiB;
constexpr size_t WS_GATES = 10 * MiB;
constexpr size_t WS_SSQ = 13 * MiB;
constexpr size_t WS_ROUTE = 15 * MiB;
constexpr size_t WS_LISTS = 16 * MiB;
constexpr size_t WS_W = 36 * MiB;
constexpr size_t W_IN = WS_W;
constexpr size_t W_GA = W_IN + 11 * MiB, W_GB = W_GA + 2 * MiB;
constexpr size_t W_RO = W_GB + 2 * MiB, W_NO = W_RO + 2 * MiB, W_OUT = W_NO + 2 * MiB, W_XQ = W_OUT + 2 * MiB, W_XO = W_XQ + 2 * MiB;
constexpr size_t W_XKV = W_XO + 2 * MiB;
constexpr size_t W_C1K = W_XKV + 4 * MiB, W_C1V = W_C1K + 2 * MiB;
constexpr size_t WS_MEMN = W_C1V + 2 * MiB;
constexpr size_t WS_MEMKV = WS_MEMN + 4 * MiB;
constexpr size_t WS_H = 84 * MiB;
constexpr size_t WS_NQ = WS_H + 64 * MiB;
constexpr size_t WS_RV = WS_NQ + 64 * MiB;
constexpr size_t WS_RQ = WS_RV + 64 * MiB;
constexpr size_t WS_RK = WS_RQ + 32 * MiB;
constexpr size_t WS_RG = WS_RK + 32 * MiB;
constexpr size_t WS_KV6 = WS_RG + 64 * MiB;
constexpr size_t KV_STRIDE = 16 * MiB;
constexpr size_t WS_END = WS_KV6 + 96 * MiB;
constexpr size_t WS_Y = WS_RQ, WS_P4SCR = WS_RG, WS_W13 = WS_RQ, WS_W2 = WS_RG, WS_H1 = WS_KV6, WS_X1B = WS_H, WS_X2B = WS_RV, WS_YS0 = WS_H, WS_YS1 = WS_NQ;
static_assert(WS_MEMKV + 8 * MiB <= WS_H && WS_VCMPT + 1 * MiB <= WS_W && WS_MEMVT + 4 * MiB <= WS_VCMPT, "ws map");
constexpr int CW_BAR = 4096;
constexpr int CW_ECNT = 16384;
constexpr int LDS_BYTES = 147456, RING_BYTES = 131072, MISC_OFF = RING_BYTES + 320;

HD inline float bf2f(bf16 b) { return __builtin_bit_cast(float, (unsigned)b << 16); }
HD inline unsigned f2bf(float f) { unsigned u = __builtin_bit_cast(unsigned, f); return (u + 0x7fffu + ((u >> 16) & 1u)) >> 16; }
HD inline unsigned pk2(float lo, float hi) { return f2bf(lo) | (f2bf(hi) << 16); }
HD inline float lo16(unsigned w) { return __builtin_bit_cast(float, w << 16); }
HD inline float hi16(unsigned w) { return __builtin_bit_cast(float, w & 0xffff0000u); }
__device__ __forceinline__ unsigned cvt_pk_bf16(float lo, float hi) { unsigned r; asm volatile("v_cvt_pk_bf16_f32 %0, %1, %2" : "=v"(r) : "v"(lo), "v"(hi)); return r; }
#define DPP_F(v, ctrl, rmask) __builtin_bit_cast(float, __builtin_amdgcn_update_dpp(0, __builtin_bit_cast(int, v), ctrl, rmask, 0xf, false))
__device__ __forceinline__ float wave_sum(float v) {
    v += DPP_F(v, 0xB1, 0xf);
    v += DPP_F(v, 0x4E, 0xf);
    v += DPP_F(v, 0x141, 0xf);
    v += DPP_F(v, 0x140, 0xf);
    v += DPP_F(v, 0x142, 0xa);
    v += DPP_F(v, 0x143, 0xc);
    return __builtin_bit_cast(float, __builtin_amdgcn_readlane(__builtin_bit_cast(int, v), 63));
}
__device__ __forceinline__ float wave_max(float v) {
#pragma unroll
    for (int o = 1; o < 64; o <<= 1) v = fmaxf(v, __shfl_xor(v, o));
    return v;
}
__device__ __forceinline__ float sigmoidf_(float x) { return __builtin_amdgcn_rcpf(1.0f + __builtin_amdgcn_exp2f(-1.4426950408889634f * x)); }
#define LAUNDER(p) asm volatile("" : "+v"(p))
#define LDS_WAIT() asm volatile("s_waitcnt lgkmcnt(0)" ::: "memory")
#define VM_WAIT() asm volatile("s_waitcnt vmcnt(0)" ::: "memory")

#define XB_TMO      128
#define XB_XCNT(j)  (256  + 64 * (j))
#define XB_XSUB(j)  (1280 + 64 * (j))
#define XB_XGEN(j)  (2304 + 64 * (j))
#define XB_TOP      3328
#define XB_TOPGEN   3392
#define XCD_BAR_WORDS 3456
#define XB_SPIN_CAP (1u << 24)
__device__ __forceinline__ unsigned xb_ld(unsigned* p)              { return __hip_atomic_load(p, __ATOMIC_RELAXED, __HIP_MEMORY_SCOPE_AGENT); }
__device__ __forceinline__ unsigned xb_add(unsigned* p, unsigned v) { return __hip_atomic_fetch_add(p, v, __ATOMIC_RELAXED, __HIP_MEMORY_SCOPE_AGENT); }
__device__ __forceinline__ unsigned xb_xcc_id() { return (unsigned)__builtin_amdgcn_s_getreg((3 << 11) | 20) & 0xFu; }
#define XB_SPIN(cond, bar) do { unsigned _sp = 0; while (cond) { __builtin_amdgcn_s_sleep(1); \
    if ((++_sp & 255u) == 0u) { if (xb_ld(&(bar)[XB_TMO])) break; if (_sp > XB_SPIN_CAP) { atomicAdd(&(bar)[XB_TMO], 1u); break; } } } } while (0)
struct XcdBarrier { unsigned* bar; unsigned x; volatile LAS unsigned* st; };
__device__ __forceinline__ XcdBarrier xcd_barrier_post(unsigned* bar, volatile LAS unsigned* st) {
    XcdBarrier b; b.bar = bar; b.x = xb_xcc_id(); b.st = st;
    if (threadIdx.x == 0) (void)xb_add(&bar[XB_XCNT(b.x)], 1u);
    return b;
}
__device__ __forceinline__ void xcd_barrier_complete(unsigned* bar, unsigned x, unsigned& nloc, unsigned& nx) {
    const unsigned G = gridDim.x * gridDim.y * gridDim.z;
    unsigned sum, cnt, mine, sp = 0u;
    for (;;) {
        sum = 0u; cnt = 0u; mine = 0u;
#pragma unroll
        for (unsigned j = 0; j < 16; ++j) { const unsigned c = xb_ld(&bar[XB_XCNT(j)]); sum += c; cnt += (c > 0u) ? 1u : 0u; mine = (j == x) ? c : mine; }
        if (sum == G) break;
        __builtin_amdgcn_s_sleep(1);
        if ((++sp & 255u) == 0u) { if (xb_ld(&bar[XB_TMO])) break; if (sp > XB_SPIN_CAP) { atomicAdd(&bar[XB_TMO], 1u); break; } }
    }
    nloc = mine > 0u ? mine : 1u; nx = cnt > 0u ? cnt : 1u;
}
__device__ __forceinline__ void xcd_barrier(const XcdBarrier& b) {
    asm volatile("s_waitcnt vmcnt(0)" ::: "memory");
    __syncthreads();
    if (threadIdx.x == 0) {
        unsigned* bar = b.bar;
        __builtin_amdgcn_s_waitcnt(0);
        unsigned nloc = b.st[0], nx = b.st[1];
        if (nloc == 0u) { xcd_barrier_complete(bar, b.x, nloc, nx); b.st[0] = nloc; b.st[1] = nx; }
        const unsigned old = xb_add(&bar[XB_XSUB(b.x)], 1u);
        const unsigned gen = old / nloc;
        if (old + 1u == (gen + 1u) * nloc) {
            __builtin_amdgcn_fence(__ATOMIC_RELEASE, "agent");
            asm volatile("s_waitcnt vmcnt(0)" ::: "memory");
            const unsigned og = xb_add(&bar[XB_TOP], 1u);
            const unsigned tg = og / nx;
            if (og + 1u == (tg + 1u) * nx) xb_add(&bar[XB_TOPGEN], 1u);
            else XB_SPIN(xb_ld(&bar[XB_TOPGEN]) == tg, bar);
            __builtin_amdgcn_fence(__ATOMIC_ACQUIRE, "agent");
            xb_add(&bar[XB_XGEN(b.x)], 1u);
            asm volatile("s_waitcnt vmcnt(0)" ::: "memory");
        } else {
            XB_SPIN(xb_ld(&bar[XB_XGEN(b.x)]) == gen, bar);
            __builtin_amdgcn_fence(__ATOMIC_ACQUIRE, "agent");
            asm volatile("s_waitcnt vmcnt(0)" ::: "memory");
        }
    }
    __syncthreads();
}

namespace pg8 {
constexpr int BM = 256, BK = 64, HALF = 128, HTB = HALF * BK * 2, NXCD = 8, WGM = 8;
HD __forceinline__ int lds_byte(int r, int c) { const int st = (r >> 4) * 2 + (c >> 5), rr = r & 15, cc = c & 31, ob = rr * 64 + cc * 2; return st * 1024 + (ob ^ (((ob >> 9) & 1) << 5)); }
HD __forceinline__ void stage_rc(int b, int& R, int& C) { const int st = b / 1024, sb = b % 1024, swz = sb ^ (((sb >> 9) & 1) << 5); R = (st >> 1) * 16 + swz / 64; C = (st & 1) * 32 + (swz % 64) / 2; }
HD __forceinline__ int perm32(int rho) { const int n = rho >> 4, i = rho & 15; return 8 * (i >> 2) + 4 * n + (i & 3); }
HD __forceinline__ void tile_map(int L, int nM, int nN, int& pm, int& pn) {
    const int nwg = nM * nN; int wgid = L; { const int q = nwg / NXCD, r = nwg % NXCD, xcd = wgid % NXCD, off = wgid / NXCD; wgid = (xcd < r ? xcd * (q + 1) : r * (q + 1) + (xcd - r) * q) + off; }
    const int nig = WGM * nN, gid = wgid / nig, fm = gid * WGM, gsz = (nM - fm) < WGM ? (nM - fm) : WGM;
    pm = fm + ((wgid % nig) % gsz); pn = (wgid % nig) / gsz;
}
struct GU { const char* A; const char* B; const int* rows; int nvalid; int kind, pm, pn, aux; };
template <class Epi, class Sched, bool GATHER>
__device__ __forceinline__ void gemm_phase(LAS unsigned char* lds, const int K, const int lda, const int ldb, const Sched& S, const Epi& E) {
    int tid_ = threadIdx.x; LAUNDER(tid_);
    const int tid = tid_, wid = __builtin_amdgcn_readfirstlane(tid >> 6), lane = tid & 63, wr = wid >> 2, wc = wid & 3, fr = lane & 15, fq = lane >> 4;
    const int nt = K / BK;
    unsigned voffB[2];
#pragma unroll
    for (int i = 0; i < 2; ++i) { int R, C; stage_rc(tid * 16 + i * 8192, R, C); const int Rb = Epi::PERM ? ((R & ~31) + perm32(R & 31)) : R; voffB[i] = (unsigned)(Rb * ldb + C) * 2u; }
    const size_t kstep = (size_t)(BK * 2);
    const size_t hstepB = (size_t)HALF * ldb * 2;
    const unsigned ldsw = (unsigned)wid * 1024u;
    const int aoff = lds_byte(wr * 64 + fr, fq * 8), boff = lds_byte(wc * 32 + fr, fq * 8);
#define PG8_SA(b, h) (((b) * 2 + (h)) * HTB)
#define PG8_SB(b, h) ((4 + (b) * 2 + (h)) * HTB)
#define PG8_STAGE2(bufoff, gbase, v0, v1) do { \
        __builtin_amdgcn_global_load_lds((const unsigned*)((const char*)(gbase) + (v0)), (LAS unsigned*)(lds + (bufoff) + ldsw), 16, 0, 0); \
        __builtin_amdgcn_global_load_lds((const unsigned*)((const char*)(gbase) + (v1)), (LAS unsigned*)(lds + (bufoff) + ldsw + 8192), 16, 0, 0); } while (0)
#define PG8_STAGEB(bufoff, gbase) PG8_STAGE2(bufoff, gbase, voffB[0], voffB[1])
#define PG8_LDA(dst, b, h) do { _Pragma("unroll") for (int m = 0; m < 4; ++m) _Pragma("unroll") for (int k = 0; k < 2; ++k) dst[m][k] = *(const LAS bf16x8*)(lds + PG8_SA(b, h) + aoff + m * 2048 + k * 1024); } while (0)
#define PG8_LDB(dst, b, h) do { _Pragma("unroll") for (int n = 0; n < 2; ++n) _Pragma("unroll") for (int k = 0; k < 2; ++k) dst[n][k] = *(const LAS bf16x8*)(lds + PG8_SB(b, h) + boff + n * 2048 + k * 1024); } while (0)
#define PG8_MMA(ai, bj, At, Bt) do { __builtin_amdgcn_s_setprio(1); _Pragma("unroll") for (int m = 0; m < 4; ++m) _Pragma("unroll") for (int n = 0; n < 2; ++n) _Pragma("unroll") for (int k = 0; k < 2; ++k) \
        acc[ai][bj][m][n] = __builtin_amdgcn_mfma_f32_16x16x32_bf16(Bt[n][k], At[m][k], acc[ai][bj][m][n], 0, 0, 0); __builtin_amdgcn_s_setprio(0); } while (0)
#define PG8_WAIT_V(n) asm volatile("s_waitcnt vmcnt(" #n ")" ::: "memory")
#define PG8_WAIT_L(n) asm volatile("s_waitcnt lgkmcnt(" #n ")" ::: "memory")
#define PG8_BAR __builtin_amdgcn_s_barrier()
#define PG8_SCHED __builtin_amdgcn_sched_barrier(0)
#define PG8_VOFFA(u, vo) do { _Pragma("unroll") for (int h = 0; h < 2; ++h) _Pragma("unroll") for (int i = 0; i < 2; ++i) { int R_, C_; stage_rc(tid * 16 + i * 8192, R_, C_); const int R = R_ + HALF * h; \
        int ridx = R; if (GATHER) { ridx = (R < (u).nvalid) ? ((u).rows[R] >> 1) : 0; } vo[h][i] = (unsigned)(ridx * lda + C_) * 2u; } if (GATHER) asm volatile("" :: "v"(vo[0][0]), "v"(vo[0][1]), "v"(vo[1][0]), "v"(vo[1][1])); } while (0)
    GU cur, nxt; int ui = 0;
    if (!S.next(0, cur)) return;
    f32x4 acc[2][2][4][2];
#pragma unroll
    for (int a = 0; a < 2; ++a)
#pragma unroll
        for (int b = 0; b < 2; ++b)
#pragma unroll
            for (int m = 0; m < 4; ++m)
#pragma unroll
                for (int n = 0; n < 2; ++n) acc[a][b][m][n] = (f32x4){0.f, 0.f, 0.f, 0.f};
    bf16x8 At[4][2], B0[2][2], B1[2][2];
    unsigned cv[2][2], nv[2][2];
    PG8_VOFFA(cur, cv);
    const char* cA = cur.A; const char* cB = cur.B;
    PG8_STAGEB(PG8_SB(0, 0), cB); PG8_STAGEB(PG8_SB(0, 1), cB + hstepB); PG8_STAGE2(PG8_SA(0, 0), cA, cv[0][0], cv[0][1]); PG8_STAGE2(PG8_SA(0, 1), cA, cv[1][0], cv[1][1]);
    if (wr == 1) PG8_BAR;
    PG8_WAIT_V(2); PG8_BAR;
    PG8_STAGEB(PG8_SB(1, 0), cB + kstep); PG8_STAGE2(PG8_SA(1, 0), cA + kstep, cv[0][0], cv[0][1]); PG8_STAGEB(PG8_SB(1, 1), cB + hstepB + kstep);
    PG8_WAIT_V(6); PG8_BAR;
    for (;;) {
        const bool has_next = S.next(ui + 1, nxt);
        const char* nA = has_next ? nxt.A : cA; const char* nB = has_next ? nxt.B : cB;
        if (has_next) { PG8_VOFFA(nxt, nv); } else {
#pragma unroll
            for (int h = 0; h < 2; ++h)
#pragma unroll
                for (int i = 0; i < 2; ++i) nv[h][i] = cv[h][i]; }
        for (int t = 0; t < nt; t += 2) {
            const bool last = (t == nt - 2);
            const char* a1 = cA + (size_t)(t + 1) * kstep;
            const char* a2 = last ? nA : cA + (size_t)(t + 2) * kstep; const char* b2 = last ? nB : cB + (size_t)(t + 2) * kstep;
            const char* a3 = a2 + kstep; const char* b3 = b2 + kstep;
            const unsigned w00 = last ? nv[0][0] : cv[0][0], w01 = last ? nv[0][1] : cv[0][1], w10 = last ? nv[1][0] : cv[1][0], w11 = last ? nv[1][1] : cv[1][1];
            PG8_LDB(B0, 0, 0); PG8_LDB(B1, 0, 1); PG8_SCHED; PG8_LDA(At, 0, 0); PG8_STAGE2(PG8_SA(1, 1), a1, cv[1][0], cv[1][1]);
            PG8_WAIT_V(8); PG8_WAIT_L(0); PG8_BAR; PG8_MMA(0, 0, At, B0); PG8_MMA(0, 1, At, B1); PG8_BAR; PG8_SCHED;
            PG8_LDA(At, 0, 1); PG8_STAGEB(PG8_SB(0, 0), b2); PG8_STAGEB(PG8_SB(0, 1), b2 + hstepB); PG8_STAGE2(PG8_SA(0, 0), a2, w00, w01);
            PG8_WAIT_V(8); PG8_WAIT_L(0); PG8_BAR; PG8_MMA(1, 0, At, B0); PG8_MMA(1, 1, At, B1); PG8_BAR; PG8_SCHED;
            PG8_LDB(B0, 1, 0); PG8_LDB(B1, 1, 1); PG8_SCHED; PG8_LDA(At, 1, 0); PG8_STAGE2(PG8_SA(0, 1), a2, w10, w11);
            PG8_WAIT_V(8); PG8_WAIT_L(0); PG8_BAR; PG8_MMA(0, 0, At, B0); PG8_MMA(0, 1, At, B1); PG8_BAR; PG8_SCHED;
            PG8_LDA(At, 1, 1); PG8_STAGEB(PG8_SB(1, 0), b3); PG8_STAGEB(PG8_SB(1, 1), b3 + hstepB); PG8_STAGE2(PG8_SA(1, 0), a3, w00, w01);
            PG8_WAIT_V(8); PG8_WAIT_L(0); PG8_BAR; PG8_MMA(1, 0, At, B0); PG8_MMA(1, 1, At, B1); PG8_BAR; PG8_SCHED;
        }
        if (wr == 0) PG8_BAR;
        E(acc, cur, wr, wc, fr, fq);
        if (!has_next) break;
#pragma unroll
        for (int a = 0; a < 2; ++a)
#pragma unroll
            for (int b = 0; b < 2; ++b)
#pragma unroll
                for (int m = 0; m < 4; ++m)
#pragma unroll
                    for (int n = 0; n < 2; ++n) acc[a][b][m][n] = (f32x4){0.f, 0.f, 0.f, 0.f};
        cur = nxt; cA = nA; cB = nB; ++ui;
#pragma unroll
        for (int h = 0; h < 2; ++h)
#pragma unroll
            for (int i = 0; i < 2; ++i) cv[h][i] = nv[h][i];
        if (wr == 1) PG8_BAR;
    }
    PG8_WAIT_V(0);
    PG8_BAR;
#undef PG8_SA
#undef PG8_SB
#undef PG8_STAGE2
#undef PG8_STAGEB
#undef PG8_LDA
#undef PG8_LDB
#undef PG8_MMA
#undef PG8_WAIT_V
#undef PG8_WAIT_L
#undef PG8_BAR
#undef PG8_SCHED
#undef PG8_VOFFA
}
}
using pg8::GU;

struct Args {
    const float* in[27]; float* out; unsigned char* ws; int ph_lo, ph_hi; int pad0, pad1;
};
enum { IN_X = 0, IN_MEM, IN_NORM_MIX_G, IN_W_IN, IN_W_RET_O, IN_W_NSA_O, IN_W_OUT, IN_CMP_PE_K, IN_CMP_W1_K, IN_CMP_W2_K, IN_CMP_PE_V, IN_CMP_W1_V, IN_CMP_W2_V,
       IN_NORM_X_G, IN_NORM_MEM_G, IN_W_XQ, IN_W_XKV, IN_W_XO, IN_NORM_FFN_G, IN_W_GRP, IN_B_GRP, IN_W_RT, IN_B_RT, IN_W_E1, IN_W_E3, IN_W_E2, IN_NORM_F_G };
struct Frame {
    LAS unsigned char* lds; volatile LAS unsigned* MISC; unsigned* ctl; unsigned char* ws;
    int tid, lane, wave, G, bx;
};

__device__ __forceinline__ bool phase_begin(Frame& F) { int t = threadIdx.x; LAUNDER(t); F.tid = t; F.lane = t & 63; return true; }
__device__ __forceinline__ void transpose_item(const float* W, int ldw, int c0, int k0, bf16* WT, int ldt, int mode, int row_off, int cbase, const float* kscale, float scale, LAS float* scr, int lane) {
    float vv[32];
#pragma unroll
    for (int i = 0; i < 32; ++i) { const int kk = 2 * i + (lane >> 5); vv[i] = W[(size_t)(k0 + kk) * ldw + c0 + (lane & 31)]; }
    if (kscale) {
#pragma unroll
        for (int i = 0; i < 32; ++i) { const int kk = 2 * i + (lane >> 5); vv[i] *= kscale[k0 + kk]; } }
#pragma unroll
    for (int i = 0; i < 32; ++i) { const int kk = 2 * i + (lane >> 5); scr[kk * 33 + (lane & 31)] = vv[i] * scale; }
    LDS_WAIT(); asm volatile("" ::: "memory");
    const int c = lane & 7;
#pragma unroll
    for (int j = 0; j < 4; ++j) { const int n = (lane >> 3) + 8 * j; const LAS float* s = scr + (8 * c) * 33 + n;
        u32x4 o; o.x = pk2(s[0 * 33], s[1 * 33]); o.y = pk2(s[2 * 33], s[3 * 33]); o.z = pk2(s[4 * 33], s[5 * 33]); o.w = pk2(s[6 * 33], s[7 * 33]);
        const int jc = c0 - cbase + n; const int drow = mode == 0 ? row_off + jc : (8 * (jc >> 2) + 4 * row_off + (jc & 3));
        *(u32x4*)(WT + (size_t)drow * ldt + k0 + 8 * c) = o; }
    LDS_WAIT(); asm volatile("" ::: "memory");
}
__device__ __forceinline__ void transpose_matrix(Frame& F, int& item_base, const float* W, int ldw, int K, int cbase, int ncols, bf16* WT, int ldt, int mode, int row_off, const float* kscale, float scale) {
    LAS float* scr = (LAS float*)(F.lds + F.wave * 16384);
    const int gw = F.bx * NWAVES + F.wave, NGW = F.G * NWAVES;
    const int nb = ncols / 32, nitems = (K / 64) * nb;
    int it = (gw - item_base % NGW + NGW) % NGW;
    for (; it < nitems; it += NGW) transpose_item(W, ldw, cbase + 32 * (it % nb), 64 * (it / nb), WT, ldt, mode, row_off, cbase, kscale, scale, scr, F.lane);
    item_base += nitems;
}
__device__ __forceinline__ void rms_row_to_bf16(int lane, const float* xrow, const float* g, bf16* orow) {
    const f32x4* xr = (const f32x4*)xrow + lane; const f32x4* gr = (const f32x4*)g + lane;
    f32x4 v[4]; float s = 0.f;
#pragma unroll
    for (int j = 0; j < 4; ++j) { v[j] = xr[64 * j]; s += (v[j].x * v[j].x + v[j].y * v[j].y) + (v[j].z * v[j].z + v[j].w * v[j].w); }
    const float rstd = 1.0f / sqrtf(wave_sum(s) * (1.f / D) + EPS);
    unsigned long long* o8 = (unsigned long long*)orow + lane;
#pragma unroll
    for (int j = 0; j < 4; ++j) { const f32x4 gg = gr[64 * j];
        o8[64 * j] = (unsigned long long)pk2(v[j].x * rstd * gg.x, v[j].y * rstd * gg.y) | ((unsigned long long)pk2(v[j].z * rstd * gg.z, v[j].w * rstd * gg.w) << 32); }
}

struct XItem { const float* src; bf16* dst; const float* ks; float scale; int ldw, ldt, mode, row_off, csrc, c0, k0, has_ks; };
__device__ __forceinline__ void xitem_decode_expert(const Args& a, unsigned char* ws, int it, XItem& x) {
    const int e = it / 768, r = it % 768, which = r >> 8, t = r & 255;
    x.ks = a.in[IN_NORM_FFN_G]; x.scale = 1.0f;
    if (which < 2) { x.src = a.in[which ? IN_W_E3 : IN_W_E1] + (size_t)e * D * DEXP; x.ldw = DEXP; x.dst = (bf16*)(ws + WS_W13) + (size_t)e * D * D; x.ldt = D; x.mode = 1; x.row_off = which; x.has_ks = 1; x.c0 = 32 * (t & 15); x.k0 = 64 * (t >> 4); }
    else { x.src = a.in[IN_W_E2] + (size_t)e * DEXP * D; x.ldw = D; x.dst = (bf16*)(ws + WS_W2) + (size_t)e * D * DEXP; x.ldt = DEXP; x.mode = 0; x.row_off = 0; x.has_ks = 0; x.c0 = 32 * (t & 31); x.k0 = 64 * (t >> 5); }
    x.csrc = x.c0;
}
constexpr int P0_NITEMS = 7936;
__device__ __forceinline__ void xitem_decode_p0(const Args& a, unsigned char* ws, int it, XItem& x) {
    int in_ = IN_W_IN, ldw = DIN, cb = 0, nc = 512, ldt = D, ro = 0, first = 0; size_t dst = W_IN; float sc = 1.0f; int hk = 0;
#define P0E(FIRST, IN__, LDW, CB, NC, DST, LDT, RO, SC, HK) if (it >= (FIRST)) { in_ = (IN__); ldw = (LDW); cb = (CB); nc = (NC); dst = (DST); ldt = (LDT); ro = (RO); sc = (SC); hk = (HK); first = (FIRST); }
    P0E(256, IN_W_IN, DIN, 512, 512, W_IN, D, 512, 0.08838834764831845f, 0)
    P0E(512, IN_W_IN, DIN, 1024, NPROJ - 1024, W_IN, D, 1024, 1.0f, 0)
    P0E(2816, IN_W_IN, DIN, C_GA, 1024, W_GA, D, 0, 1.0f, 0)
    P0E(3328, IN_W_IN, DIN, C_GB, 1024, W_GB, D, 0, 1.0f, 0)
    P0E(3840, IN_W_RET_O, D, 0, D, W_RO, D, 0, 1.0f, 0)
    P0E(4352, IN_W_NSA_O, D, 0, D, W_NO, D, 0, 1.0f, 0)
    P0E(4864, IN_W_OUT, D, 0, D, W_OUT, D, 0, 1.0f, 0)
    P0E(5376, IN_W_XQ, D, 0, D, W_XQ, D, 0, 1.0f, 1)
    P0E(5888, IN_W_XO, D, 0, D, W_XO, D, 0, 1.0f, 0)
    P0E(6400, IN_W_XKV, 2 * D, 0, 2 * D, W_XKV, D, 0, 1.0f, 0)
    P0E(7424, IN_CMP_W1_K, 128, 0, 128, W_C1K, 4096, 0, 1.0f, 0)
    P0E(7680, IN_CMP_W1_V, 128, 0, 128, W_C1V, 4096, 0, 1.0f, 0)
#undef P0E
    const int t = it - first, nb = nc >> 5;
    x.src = a.in[in_]; x.dst = (bf16*)(ws + dst); x.ks = a.in[IN_NORM_X_G]; x.scale = sc; x.ldw = ldw; x.ldt = ldt; x.mode = 0; x.row_off = ro; x.has_ks = hk;
    x.c0 = 32 * (t % nb); x.csrc = cb + x.c0; x.k0 = 64 * (t / nb);
}
__device__ __forceinline__ void xitem_load(const XItem& x, int lane, float (&vv)[32], f32x4& k0v, f32x4& k1v) {
#pragma unroll
    for (int i = 0; i < 32; ++i) { const int kk = 2 * i + (lane >> 5); vv[i] = x.src[(size_t)(x.k0 + kk) * x.ldw + x.csrc + (lane & 31)]; }
    const f32x4* p = (const f32x4*)(x.ks + ((x.k0 + 8 * (lane & 7)) & 1023)); k0v = p[0]; k1v = p[1];
}
__device__ __forceinline__ void xitem_finish(const XItem& x, int lane, const float (&vv)[32], f32x4 k0v, f32x4 k1v, LAS float* scr) {
    if (!x.has_ks) { k0v = (f32x4){1.f, 1.f, 1.f, 1.f}; k1v = k0v; }
    k0v *= x.scale; k1v *= x.scale;
#pragma unroll
    for (int i = 0; i < 32; ++i) { const int kk = 2 * i + (lane >> 5); scr[kk * 33 + (lane & 31)] = vv[i]; }
    LDS_WAIT(); asm volatile("" ::: "memory");
    const int c = lane & 7;
#pragma unroll
    for (int j = 0; j < 4; ++j) { const int n = (lane >> 3) + 8 * j; const LAS float* s = scr + (8 * c) * 33 + n;
        u32x4 o; o.x = pk2(s[0 * 33] * k0v.x, s[1 * 33] * k0v.y); o.y = pk2(s[2 * 33] * k0v.z, s[3 * 33] * k0v.w); o.z = pk2(s[4 * 33] * k1v.x, s[5 * 33] * k1v.y); o.w = pk2(s[6 * 33] * k1v.z, s[7 * 33] * k1v.w);
        const int jc = x.c0 + n; const int drow = x.mode == 0 ? x.row_off + jc : (8 * (jc >> 2) + 4 * x.row_off + (jc & 3));
        *(u32x4*)(x.dst + (size_t)drow * x.ldt + x.k0 + 8 * c) = o; }
    LDS_WAIT(); asm volatile("" ::: "memory");
}
template <bool EXPERT>
__device__ __forceinline__ void run_items(Frame& F, const Args& a, int it_begin, int it_end) {
    LAS float* scr = (LAS float*)(F.lds + F.wave * 16384);
    const int gw = F.bx * NWAVES + F.wave, NGW = F.G * NWAVES, lane = F.lane;
    int it = it_begin + gw;
#define XDEC(i_, x_) do { if (EXPERT) xitem_decode_expert(a, F.ws, (i_), x_); else xitem_decode_p0(a, F.ws, (i_), x_); } while (0)
    if (it < it_end) {
        float va[32], vb[32]; f32x4 ka0, ka1, kb0, kb1; XItem xa, xb;
        XDEC(it, xa); xitem_load(xa, lane, va, ka0, ka1);
        for (;;) {
            int itn = it + NGW; bool hn = itn < it_end;
            XDEC(hn ? itn : it, xb); xitem_load(xb, lane, vb, kb0, kb1);
            xitem_finish(xa, lane, va, ka0, ka1, scr);
            if (!hn) break;
            it = itn; itn = it + NGW; hn = itn < it_end;
            XDEC(hn ? itn : it, xa); xitem_load(xa, lane, va, ka0, ka1);
            xitem_finish(xb, lane, vb, kb0, kb1, scr);
            if (!hn) break;
            it = itn;
        }
    }
#undef XDEC
    __syncthreads();
}
__device__ __forceinline__ void expert_copies(Frame& F, const Args& a, int e_lo, int e_hi) { run_items<true>(F, a, e_lo * 768, e_hi * 768); }

__device__ __forceinline__ void p0_prologue(Frame& F, const Args& a) {
    unsigned char* ws = F.ws;
    const float* w_in = a.in[IN_W_IN];
    run_items<false>(F, a, 0, P0_NITEMS);
    const int gt = F.bx * NTHREADS + F.tid, NGT = F.G * NTHREADS;
    for (int i = gt; i < 2 * 128 * 4096 / 8; i += NGT) { const int m = i / (128 * 4096 / 8), r = i % (128 * 4096 / 8);
        *(u32x4*)(ws + (m ? W_C1V : W_C1K) + (size_t)128 * 4096 * 2 + (size_t)r * 16) = (u32x4){0u, 0u, 0u, 0u}; }
    bf16* wngl = (bf16*)(ws + WS_SMALLW);
    for (int i = gt; i < 32 * 1024; i += NGT) { const int r = i >> 10, k = i & 1023; wngl[i] = r < 24 ? (bf16)f2bf(w_in[(size_t)k * DIN + C_NGL + r]) : (bf16)0; }
    bf16* w2k = (bf16*)(ws + WS_SMALLW + 65536); bf16* w2v = w2k + 128 * 128;
    for (int i = gt; i < 2 * 128 * 128; i += NGT) { const int m = i >> 14, r = i & 16383, f = r >> 7, e = r & 127; const float* src = a.in[m ? IN_CMP_W2_V : IN_CMP_W2_K];
        (m ? w2v : w2k)[f * 128 + e] = (bf16)f2bf(src[e * 128 + f]); }
    { const float* gff = a.in[IN_NORM_FFN_G]; const float* wgrp = a.in[IN_W_GRP]; const float* wrt = a.in[IN_W_RT]; float* wgp = (float*)(ws + WS_RTW); float* wep = wgp + 4096;
      for (int i = gt; i < 4096; i += NGT) wgp[i] = gff[i >> 2] * wgrp[i];
      for (int i = gt; i < 32768; i += NGT) { const int j = i & 3, l = (i >> 2) & 63, half = (i >> 8) & 1, ii = (i >> 9) & 15, grp = i >> 13, k = 64 * ii + l; wep[i] = gff[k] * wrt[k * 32 + grp * 8 + half * 4 + j]; } }
    float* cbias = (float*)(ws + WS_SMALLW + 65536 + 2 * 128 * 128 * 2);
    const int gw = F.bx * NWAVES + F.wave, NGW = F.G * NWAVES;
    for (int o = gw; o < 256; o += NGW) { const int m = o >> 7, e = o & 127; const float* pe = a.in[m ? IN_CMP_PE_V : IN_CMP_PE_K]; const float* w1 = a.in[m ? IN_CMP_W1_V : IN_CMP_W1_K];
        float s = 0.f; for (int k = F.lane; k < 4096; k += 64) s += pe[k] * w1[(size_t)k * 128 + e];
        s = wave_sum(s); if (F.lane == 0) cbias[o] = s; }
    float* cosT = (float*)(ws + WS_ROPE_COS); float* sinT = (float*)(ws + WS_ROPE_SIN);
    for (int i = gt; i < SEQ * 64; i += NGT) { const int pos = i >> 6, j = i & 63; const float inv = powf(10000.0f, -(float)(2 * j) / 128.0f); const float ang = (float)pos * inv;
        cosT[i] = cosf(ang); sinT[i] = sinf(ang); }
    { f32x4 nx[4]; const float* X = a.in[IN_X]; const f32x4* gr = (const f32x4*)a.in[IN_NORM_MIX_G] + F.lane;
      if (gw < NTOK) {
#pragma unroll
          for (int j = 0; j < 4; ++j) nx[j] = ((const f32x4*)(X + (size_t)gw * D) + F.lane)[64 * j]; }
      for (int m = gw; m < NTOK; m += NGW) { f32x4 v[4]; float sq = 0.f;
#pragma unroll
          for (int j = 0; j < 4; ++j) { v[j] = nx[j]; sq += (v[j].x * v[j].x + v[j].y * v[j].y) + (v[j].z * v[j].z + v[j].w * v[j].w); }
          if (m + NGW < NTOK) {
#pragma unroll
              for (int j = 0; j < 4; ++j) nx[j] = ((const f32x4*)(X + (size_t)(m + NGW) * D) + F.lane)[64 * j]; }
          const float rstd = 1.0f / sqrtf(wave_sum(sq) * (1.f / D) + EPS); unsigned long long* o8 = (unsigned long long*)((bf16*)(ws + WS_H) + (size_t)m * D) + F.lane;
#pragma unroll
          for (int j = 0; j < 4; ++j) { const f32x4 gg = gr[64 * j]; o8[64 * j] = (unsigned long long)pk2(v[j].x * rstd * gg.x, v[j].y * rstd * gg.y) | ((unsigned long long)pk2(v[j].z * rstd * gg.z, v[j].w * rstd * gg.w) << 32); } } }
    for (int m = gw; m < NMEMTOK; m += NGW) rms_row_to_bf16(F.lane, a.in[IN_MEM] + (size_t)m * D, a.in[IN_NORM_MEM_G], (bf16*)(ws + WS_MEMN) + (size_t)m * D);
}

struct SchedP1 {
    unsigned char* ws; int G, c;
    __device__ __forceinline__ bool next(int i, GU& u) const {
        constexpr int NP = 128 * 22; const int L = i * G + c;
        u.rows = nullptr; u.nvalid = 0; u.aux = 0;
        if (L < NP) { int pm, pn; pg8::tile_map(L, 128, 22, pm, pn); u.A = (const char*)ws + WS_H + (size_t)pm * 256 * D * 2; u.B = (const char*)ws + W_IN + (size_t)pn * 256 * D * 2; u.pm = pm; u.pn = pn;
            u.kind = pn < 2 ? 0 : pn < 4 ? 1 : pn < 8 ? 2 : pn < 12 ? 3 : pn < 16 ? 4 : 5; return true; }
        const int L2 = L - NP; if (L2 >= 64) return false;
        const int pm = L2 & 7, pn = L2 >> 3; u.A = (const char*)ws + WS_MEMN + (size_t)pm * 256 * D * 2; u.B = (const char*)ws + W_XKV + (size_t)pn * 256 * D * 2; u.pm = pm; u.pn = pn; u.kind = 6; return true;
    }
};
struct EpiP1 {
    static constexpr bool PERM = true;
    unsigned char* ws;
    __device__ __forceinline__ void operator()(const f32x4 (&acc)[2][2][4][2], const GU& u, int wr, int wc, int fr, int fq) const {
        const int kind = u.kind;
        const float* cosT = (const float*)(ws + WS_ROPE_COS); const float* sinT = (const float*)(ws + WS_ROPE_SIN);
#pragma unroll
        for (int ai = 0; ai < 2; ++ai)
#pragma unroll
            for (int m = 0; m < 4; ++m) {
                const int r = 128 * ai + 64 * wr + 16 * m + fr; const int tok = u.pm * 256 + r;
#pragma unroll
                for (int bj = 0; bj < 2; ++bj) {
                    f32x4 v0 = acc[ai][bj][m][0], v1 = acc[ai][bj][m][1];
                    const int ct = 128 * bj + 32 * wc + 8 * fq;
                    bf16* dst;
                    if (kind <= 1) {
                        const int s = tok & (SEQ - 1), i0 = ((ct & 127) >> 1);
                        const f32x4 cs = *(const f32x4*)(cosT + s * 64 + i0), sn = *(const f32x4*)(sinT + s * 64 + i0);
                        const f32x4 a0 = v0, a1 = v1;
                        v0[0] = a0[0] * cs[0] - a0[1] * sn[0]; v0[1] = a0[0] * sn[0] + a0[1] * cs[0];
                        v0[2] = a0[2] * cs[1] - a0[3] * sn[1]; v0[3] = a0[2] * sn[1] + a0[3] * cs[1];
                        v1[0] = a1[0] * cs[2] - a1[1] * sn[2]; v1[1] = a1[0] * sn[2] + a1[1] * cs[2];
                        v1[2] = a1[2] * cs[3] - a1[3] * sn[3]; v1[3] = a1[2] * sn[3] + a1[3] * cs[3];
                        dst = (bf16*)(ws + (kind == 0 ? WS_RQ : WS_RK)) + (size_t)tok * 512 + (u.pn & 1) * 256 + ct;
                    } else if (kind == 2) { dst = (bf16*)(ws + WS_RV) + (size_t)tok * 1024 + (u.pn - 4) * 256 + ct;
                    } else if (kind == 3) {
#pragma unroll
                        for (int j = 0; j < 4; ++j) { v0[j] = v0[j] * sigmoidf_(v0[j]); v1[j] = v1[j] * sigmoidf_(v1[j]); }
                        dst = (bf16*)(ws + WS_RG) + (size_t)tok * 1024 + (u.pn - 8) * 256 + ct;
                    } else if (kind == 4) { dst = (bf16*)(ws + WS_NQ) + (size_t)tok * 1024 + (u.pn - 12) * 256 + ct;
                    } else if (kind == 5) {
                        const int b = tok >> 12, s = tok & (SEQ - 1);
                        unsigned char* kvb = ws + WS_KV6 + (size_t)(u.pn - 16) * KV_STRIDE;
                        dst = (bf16*)kvb + ((size_t)(b * 2 + bj) * SEQ + s) * 128 + (ct & 127);
                    } else { dst = (bf16*)(ws + WS_MEMKV) + (size_t)tok * 2048 + u.pn * 256 + ct; }
                    u32x4 w; w.x = cvt_pk_bf16(v0[0], v0[1]); w.y = cvt_pk_bf16(v0[2], v0[3]); w.z = cvt_pk_bf16(v1[0], v1[1]); w.w = cvt_pk_bf16(v1[2], v1[3]);
                    *(u32x4*)dst = w;
                }
            }
    }
};
__device__ __forceinline__ void p1_gate_logits(Frame& F) {
    const bf16* H = (const bf16*)(F.ws + WS_H); const bf16* W = (const bf16*)(F.ws + WS_SMALLW); float* gates = (float*)(F.ws + WS_GATES);
    const int r = F.lane & 31, hh = F.lane >> 5;
    const int nb_ = F.G > 64 ? F.G - 64 : F.G, b0_ = F.G > 64 ? F.bx - 64 : F.bx;
    if (b0_ < 0) return;
    for (int rb = b0_ + nb_ * F.wave; rb < NTOK / 32; rb += nb_ * NWAVES) {
        f32x16 acc; for (int j = 0; j < 16; ++j) acc[j] = 0.f;
        const bf16* ap = H + (size_t)(rb * 32 + r) * D + 8 * hh; const bf16* bp = W + (size_t)r * D + 8 * hh;
        for (int s8 = 0; s8 < 8; ++s8) { bf16x8 av[8], bv[8];
#pragma unroll
            for (int q = 0; q < 8; ++q) { av[q] = *(const bf16x8*)(ap + 16 * (8 * s8 + q)); bv[q] = *(const bf16x8*)(bp + 16 * (8 * s8 + q)); }
#pragma unroll
            for (int q = 0; q < 8; ++q) acc = __builtin_amdgcn_mfma_f32_32x32x16_bf16(av[q], bv[q], acc, 0, 0, 0); }
        if (r < 24) {
#pragma unroll
            for (int reg = 0; reg < 16; ++reg) { const int row = (reg & 3) + 8 * (reg >> 2) + 4 * hh; gates[(size_t)(rb * 32 + row) * 24 + r] = sigmoidf_(acc[reg]); }
        }
    }
}

namespace retf {
constexpr int ROWB = 272;
constexpr int OFF_K = 0, OFF_V = 128 * 256, OFF_ZV = OFF_V + 128 * 64, OFF_ST = OFF_ZV + 128 * 64, OFF_PART = OFF_ST + 32 * ROWB, OFF_Q = OFF_PART + 4 * 4096, OFF_ST2 = OFF_Q + 128 * 256;
static_assert(OFF_ST2 + 32 * ROWB <= RING_BYTES, "retention LDS map");
typedef short s16x4 __attribute__((ext_vector_type(4)));
__device__ __forceinline__ u32x2 lds_tr(const LAS unsigned char* p) { return __builtin_bit_cast(u32x2, __builtin_amdgcn_ds_read_tr16_b64_v4i16((LAS s16x4*)p)); }
#define RET_RD1(dst, addr, off) asm volatile("ds_read_b128 %0, %1 offset:%2" : "=v"(dst) : "v"(addr), "i"(off))
#define RET_RD2(set, addr, o0, o1) do { RET_RD1(set[0], addr, o0); RET_RD1(set[1], addr, o1); } while (0)
#define RET_TR(dst, addr, off) asm volatile("ds_read_b64_tr_b16 %0, %1 offset:%2" : "=v"(dst) : "v"(addr), "i"(off))
#define RET_WAIT2(n, set) asm volatile("s_waitcnt lgkmcnt(" #n ")" : "+v"(set[0]), "+v"(set[1]))
#define RET_MMA2(acc, set, s0) do { acc = __builtin_amdgcn_mfma_f32_32x32x16_bf16(__builtin_bit_cast(bf16x8, set[0]), qf[s0], acc, 0, 0, 0); acc = __builtin_amdgcn_mfma_f32_32x32x16_bf16(__builtin_bit_cast(bf16x8, set[1]), qf[(s0) + 1], acc, 0, 0, 0); } while (0)
}
__device__ __forceinline__ void p2_retention_fast(Frame& F, int unit, bf16* outbase) {
    using namespace retf;
    const int bh = (unit & 7) * 4 + (unit >> 6), sl = (unit >> 3) & 7, b = bh >> 2, h = bh & 3;
    const bf16* rq = (const bf16*)(F.ws + WS_RQ); const bf16* rk = (const bf16*)(F.ws + WS_RK); const bf16* rv = (const bf16*)(F.ws + WS_RV);
    const int tid = F.tid, lane = F.lane, wave = F.wave, r = lane & 31, hi = lane >> 5; LAS unsigned char* lds = F.lds;
    const float lg = log2f(1.0f - exp2f(-5.0f - (float)h));
    const int nt = wave & 3, mh = wave >> 2;
    for (int i = tid; i < 32 * ROWB / 4; i += NTHREADS) { ((LAS unsigned*)(lds + OFF_ST))[i] = 0u; ((LAS unsigned*)(lds + OFF_ST2))[i] = 0u; }
    f32x16 ST;
#pragma unroll
    for (int j = 0; j < 16; ++j) ST[j] = 0.f;
    const float gC = exp2f(128.0f * lg);
    const float zeta = exp2f((float)(127 - (tid >> 2)) * lg);
    const int blk = (lane >> 4) & 1, q4 = (lane & 15) >> 2, p4 = lane & 3;
    const int vtr = (4 * hi + q4) * 64 + 32 * blk + 8 * p4;
    const int ztr = (8 * hi + q4) * 64 + 32 * blk + 8 * p4;
    int ktr[2];
#pragma unroll
    for (int t = 0; t < 2; ++t) ktr[t] = 256 * (8 * hi + 4 * t + q4) + 16 * ((4 * nt + 2 * blk + (p4 >> 1)) ^ ((q4 << 2) | ((2 * hi + t) & 3))) + 8 * (p4 & 1);
    const int krow = 256 * r + 16 * (hi ^ (((r & 3) << 2) | ((r >> 2) & 3)));
    u32x4 kreg[4], qreg[4], vreg;
    {   const int tok0 = b * SEQ;
#pragma unroll
        for (int i = 0; i < 4; ++i) { const int p = tid + 512 * i, m = p >> 4, cc = p & 15; kreg[i] = *(const u32x4*)(rk + (size_t)(tok0 + m) * 512 + h * 128 + cc * 8); qreg[i] = *(const u32x4*)(rq + (size_t)(tok0 + m) * 512 + h * 128 + cc * 8); }
        { const int m = tid >> 2, cc = tid & 3; vreg = *(const u32x4*)(rv + (size_t)(tok0 + m) * 1024 + h * 256 + sl * 32 + cc * 8); } }
    u32x2 opk[4]; bf16* oprev = outbase;
#pragma unroll
    for (int i = 0; i < 4; ++i) opk[i] = (u32x2){0u, 0u};
    for (int c = 0; c < SEQ / 128; ++c) {
        const int tok0 = b * SEQ + c * 128;
#pragma unroll
        for (int i = 0; i < 4; ++i) { const int p = tid + 512 * i, m = p >> 4, cc = p & 15; const int o_ = 256 * m + 16 * (cc ^ (((m & 3) << 2) | ((m >> 2) & 3)));
            *(LAS u32x4*)(lds + OFF_K + o_) = kreg[i]; *(LAS u32x4*)(lds + OFF_Q + o_) = qreg[i]; }
        { const u32x4 v = vreg; u32x4 zv;
            zv.x = cvt_pk_bf16(lo16(v.x) * zeta, hi16(v.x) * zeta); zv.y = cvt_pk_bf16(lo16(v.y) * zeta, hi16(v.y) * zeta); zv.z = cvt_pk_bf16(lo16(v.z) * zeta, hi16(v.z) * zeta); zv.w = cvt_pk_bf16(lo16(v.w) * zeta, hi16(v.w) * zeta);
            *(LAS u32x4*)(lds + OFF_V + tid * 16) = v; *(LAS u32x4*)(lds + OFF_ZV + tid * 16) = zv; }
        __syncthreads();
        if (mh == 0 && c > 0) {
#pragma unroll
            for (int i = 0; i < 4; ++i) *(u32x2*)(oprev + 8 * i + 4 * hi) = opk[i]; }
        if (c + 1 < SEQ / 128) { const int tok1 = tok0 + 128;
#pragma unroll
            for (int i = 0; i < 4; ++i) { const int p = tid + 512 * i, m = p >> 4, cc = p & 15; kreg[i] = *(const u32x4*)(rk + (size_t)(tok1 + m) * 512 + h * 128 + cc * 8); qreg[i] = *(const u32x4*)(rq + (size_t)(tok1 + m) * 512 + h * 128 + cc * 8); }
            { const int m = tid >> 2, cc = tid & 3; vreg = *(const u32x4*)(rv + (size_t)(tok1 + m) * 1024 + h * 256 + sl * 32 + cc * 8); } }
        bf16x8 qf[8];
#pragma unroll
        for (int s_ = 0; s_ < 8; ++s_) qf[s_] = *(const LAS bf16x8*)(lds + OFF_Q + 8192 * nt + (krow ^ (32 * s_)));
        f32x16 CR;
#pragma unroll
        for (int j = 0; j < 16; ++j) CR[j] = 0.f;
        if (mh == 0) {
            const unsigned sa = (unsigned)(size_t)(lds + ((c & 1) ? OFF_ST2 : OFF_ST) + r * ROWB + 16 * hi);
            u32x4 fa[2], fb[2];
            RET_RD2(fa, sa, 0, 32); RET_RD2(fb, sa, 64, 96);
            RET_WAIT2(2, fa); RET_MMA2(CR, fa, 0); RET_RD2(fa, sa, 128, 160);
            RET_WAIT2(2, fb); RET_MMA2(CR, fb, 2); RET_RD2(fb, sa, 192, 224);
            RET_WAIT2(2, fa); RET_MMA2(CR, fa, 4);
            RET_WAIT2(0, fb); RET_MMA2(CR, fb, 6);
        }
        if (mh == 1) {
#pragma unroll
            for (int j = 0; j < 16; ++j) ST[j] *= gC;
#pragma unroll
            for (int s_ = 0; s_ < 8; ++s_) {
                const LAS unsigned char* zp = lds + OFF_ZV + ztr + (16 * s_) * 64; const u32x2 z0 = lds_tr(zp), z1 = lds_tr(zp + 4 * 64);
                const u32x2 k0 = lds_tr(lds + OFF_K + ktr[0] + 4096 * s_), k1 = lds_tr(lds + OFF_K + ktr[1] + 4096 * s_);
                ST = __builtin_amdgcn_mfma_f32_32x32x16_bf16(__builtin_bit_cast(bf16x8, (u32x4){z0.x, z0.y, z1.x, z1.y}), __builtin_bit_cast(bf16x8, (u32x4){k0.x, k0.y, k1.x, k1.y}), ST, 0, 0, 0); }
#pragma unroll
            for (int j = 0; j < 16; ++j) { const int dv = (j & 3) + 8 * (j >> 2) + 4 * hi; ((LAS unsigned short*)(lds + ((c & 1) ? OFF_ST : OFF_ST2)))[dv * (ROWB / 2) + 32 * nt + r] = (unsigned short)f2bf(ST[j]); }
        }
        f32x16 IN_;
#pragma unroll
        for (int j = 0; j < 16; ++j) IN_[j] = 0.f;
#pragma unroll
        for (int mi = 0; mi < 2; ++mi) { const int mt = 2 * mh + mi;
            if (mt <= nt) {
                f32x16 A;
#pragma unroll
                for (int j = 0; j < 16; ++j) A[j] = 0.f;
                {   const unsigned kb_ = (unsigned)(size_t)(lds + OFF_K) + 8192u * (unsigned)mt;
                    u32x4 fa[2], fb[2];
#define RET_KRD2(set, s0) do { RET_RD1(set[0], kb_ + (unsigned)(krow ^ (32 * (s0))), 0); RET_RD1(set[1], kb_ + (unsigned)(krow ^ (32 * ((s0) + 1))), 0); } while (0)
                    RET_KRD2(fa, 0); RET_KRD2(fb, 2);
                    RET_WAIT2(2, fa); RET_MMA2(A, fa, 0); RET_KRD2(fa, 4);
                    RET_WAIT2(2, fb); RET_MMA2(A, fb, 2); RET_KRD2(fb, 6);
                    RET_WAIT2(2, fa); RET_MMA2(A, fa, 4);
                    RET_WAIT2(0, fb); RET_MMA2(A, fb, 6);
#undef RET_KRD2
                }
#pragma unroll
                for (int j = 0; j < 16; ++j) { const int dd = (32 * nt + r) - (32 * mt + (j & 3) + 8 * (j >> 2) + 4 * hi); A[j] = dd >= 0 ? A[j] * __builtin_amdgcn_exp2f((float)dd * lg) : 0.f; }
#pragma unroll
                for (int s2 = 0; s2 < 2; ++s2) { u32x4 w; w.x = cvt_pk_bf16(A[8 * s2 + 0], A[8 * s2 + 1]); w.y = cvt_pk_bf16(A[8 * s2 + 2], A[8 * s2 + 3]); w.z = cvt_pk_bf16(A[8 * s2 + 4], A[8 * s2 + 5]); w.w = cvt_pk_bf16(A[8 * s2 + 6], A[8 * s2 + 7]);
                    const LAS unsigned char* vp = lds + OFF_V + vtr + (32 * mt + 16 * s2) * 64; const u32x2 lo = lds_tr(vp), hi2 = lds_tr(vp + 8 * 64);
                    IN_ = __builtin_amdgcn_mfma_f32_32x32x16_bf16(__builtin_bit_cast(bf16x8, (u32x4){lo.x, lo.y, hi2.x, hi2.y}), __builtin_bit_cast(bf16x8, w), IN_, 0, 0, 0); }
            } }
        if (mh == 1) {
#pragma unroll
            for (int j = 0; j < 16; ++j) ((LAS float*)(lds + OFF_PART))[(nt * 16 + j) * 64 + lane] = IN_[j];
        }
        __syncthreads();
        if (mh == 0) {
            const float xi = __builtin_amdgcn_exp2f((float)(32 * nt + r + 1) * lg);
            bf16* orow = outbase + (size_t)(tok0 + 32 * nt + r) * 1024 + h * 256 + sl * 32;
#pragma unroll
            for (int q4_ = 0; q4_ < 4; ++q4_) { float o_[4];
#pragma unroll
                for (int e = 0; e < 4; ++e) { const int j = 4 * q4_ + e; o_[e] = IN_[j] + ((const LAS float*)(lds + OFF_PART))[(nt * 16 + j) * 64 + lane] + xi * CR[j]; }
                opk[q4_] = (u32x2){cvt_pk_bf16(o_[0], o_[1]), cvt_pk_bf16(o_[2], o_[3])}; }
            oprev = orow;
        }
    }
    if (mh == 0) {
#pragma unroll
        for (int i = 0; i < 4; ++i) *(u32x2*)(oprev + 8 * i + 4 * hi) = opk[i]; }
    __syncthreads();
}
__device__ __forceinline__ void transpose_kv_tiles(Frame& F, const bf16* src, bf16* dst, int w0, int nw) {
    LAS unsigned short* tl_ = (LAS unsigned short*)(F.lds + F.wave * 16384); const int lane = F.lane;
    for (int tile = w0; tile < 16 * 64 * 2; tile += nw) {
        const int dh = tile & 1, st = (tile >> 1) & 63, bg = tile >> 7;
        const bf16* sp = src + ((size_t)bg * SEQ + st * 64) * 128 + dh * 64; bf16* dp = dst + ((size_t)bg * 128 + dh * 64) * SEQ + st * 64;
#pragma unroll
        for (int i = 0; i < 8; ++i) { const int row = i * 8 + (lane >> 3), c = lane & 7; const u32x4 v = *(const u32x4*)(sp + (size_t)row * 128 + c * 8); LAS unsigned short* q = tl_ + row * 66 + c * 8;
            q[0] = (unsigned short)(v.x & 0xffffu); q[1] = (unsigned short)(v.x >> 16); q[2] = (unsigned short)(v.y & 0xffffu); q[3] = (unsigned short)(v.y >> 16);
            q[4] = (unsigned short)(v.z & 0xffffu); q[5] = (unsigned short)(v.z >> 16); q[6] = (unsigned short)(v.w & 0xffffu); q[7] = (unsigned short)(v.w >> 16); }
        LDS_WAIT(); asm volatile("" ::: "memory");
#pragma unroll
        for (int i = 0; i < 8; ++i) { const int d = i * 8 + (lane >> 3), c = lane & 7; const LAS unsigned short* q = tl_ + (c * 8) * 66 + d;
            u32x4 o; o.x = (unsigned)q[0] | ((unsigned)q[66] << 16); o.y = (unsigned)q[2 * 66] | ((unsigned)q[3 * 66] << 16); o.z = (unsigned)q[4 * 66] | ((unsigned)q[5 * 66] << 16); o.w = (unsigned)q[6 * 66] | ((unsigned)q[7 * 66] << 16);
            *(u32x4*)(dp + (size_t)d * SEQ + c * 8) = o; }
        LDS_WAIT(); asm volatile("" ::: "memory");
    }
}
struct SchedCmp {
    unsigned char* ws; int first, G, c;
    __device__ __forceinline__ bool next(int i, GU& u) const {
        const int L = i * G + c - first; if (L < 0 || L >= 256) return false;
        const int ks = L & 7, mb = L >> 3, m = mb >> 4, bg = mb & 15;
        u.A = (const char*)ws + WS_KV6 + (size_t)m * KV_STRIDE + (size_t)bg * SEQ * 128 * 2 + (size_t)ks * 512 * 2; u.B = (const char*)ws + (m ? W_C1V : W_C1K) + (size_t)ks * 512 * 2;
        u.pm = mb; u.pn = 0; u.kind = ks; u.rows = nullptr; u.nvalid = 0; u.aux = 0; return true;
    }
};
struct EpiCmp {
    static constexpr bool PERM = false;
    float* hid;
    __device__ __forceinline__ void operator()(const f32x4 (&acc)[2][2][4][2], const GU& u, int wr, int wc, int fr, int fq) const {
#pragma unroll
        for (int ai = 0; ai < 2; ++ai)
#pragma unroll
            for (int m = 0; m < 4; ++m) { const int r = 128 * ai + 64 * wr + 16 * m + fr; float* rowp = hid + (size_t)u.kind * (32 * 256 * 128) + ((size_t)u.pm * 256 + r) * 128 + 32 * wc + 4 * fq;
#pragma unroll
                for (int n = 0; n < 2; ++n) *(f32x4*)(rowp + 16 * n) = acc[ai][0][m][n]; }
    }
};
__device__ __forceinline__ float gelu_tanh(float x) { const float u = 0.7978845608028654f * (x + 0.044715f * x * x * x); return 0.5f * x * (1.0f + tanhf(u)); }
__device__ __forceinline__ void p2b_compress_out(Frame& F, const Args& a) {
    const float* hid = (const float*)a.out + (size_t)16 * MiB; const float* cbias = (const float*)(F.ws + WS_SMALLW + 65536 + 2 * 128 * 128 * 2);
    const int gw = F.bx * NWAVES + F.wave, NGW = F.G * NWAVES, lane = F.lane;
    for (int m = 0; m < 2; ++m) {
        const float* w2 = a.in[m ? IN_CMP_W2_V : IN_CMP_W2_K];
        for (int base = m * 4096 + gw; base < (m + 1) * 4096; base += 2 * NGW) {
            float gv[2][2], o[2][2]; int rows[2]; bool valid[2];
#pragma unroll
            for (int q = 0; q < 2; ++q) { const int row = base + q * NGW; rows[q] = row; valid[q] = row < (m + 1) * 4096; const int n = row & 255;
#pragma unroll
                for (int h2 = 0; h2 < 2; ++h2) { float hsum = 0.f; const int e = lane + 64 * h2;
                    if (valid[q] && n < 255) {
#pragma unroll
                        for (int ks = 0; ks < 8; ++ks) hsum += hid[(size_t)ks * (32 * 256 * 128) + (size_t)row * 128 + e];
                        gv[q][h2] = gelu_tanh(hsum + cbias[m * 128 + e]); } else gv[q][h2] = 0.f; }
                o[q][0] = 0.f; o[q][1] = 0.f; }
#pragma unroll
            for (int h2 = 0; h2 < 2; ++h2) {
#pragma unroll 8
                for (int e = 0; e < 64; ++e) { const float wa = w2[(64 * h2 + e) * 128 + lane], wb = w2[(64 * h2 + e) * 128 + 64 + lane];
#pragma unroll
                    for (int q = 0; q < 2; ++q) { const float g = __builtin_bit_cast(float, __builtin_amdgcn_readlane(__builtin_bit_cast(int, gv[q][h2]), e)); o[q][0] += g * wa; o[q][1] += g * wb; } } }
#pragma unroll
            for (int q = 0; q < 2; ++q) if (valid[q]) { const int row = rows[q], n = row & 255;
                bf16* dst = (bf16*)(F.ws + (m ? WS_VCMP : WS_KCMP)) + (size_t)(row & 4095) * 128;
                dst[lane] = (bf16)f2bf(o[q][0]); dst[64 + lane] = (bf16)f2bf(o[q][1]);
                if (m == 1) { bf16* dt = (bf16*)(F.ws + WS_VCMPT) + (size_t)((row >> 8) & 15) * 128 * 256 + n; dt[(size_t)lane * 256] = (bf16)f2bf(o[q][0]); dt[(size_t)(64 + lane) * 256] = (bf16)f2bf(o[q][1]); } }
        }
    }
}

__device__ __forceinline__ void p3_ret_normalize(Frame& F) {
    bf16* rv = (bf16*)(F.ws + WS_RV); const bf16* rg = (const bf16*)(F.ws + WS_RG);
    const int gw = F.bx * NWAVES + F.wave, NGW = F.G * NWAVES;
    for (int it = gw; it < NTOK * 4; it += NGW) {
        u32x2* p = (u32x2*)(rv + (size_t)it * 256) + F.lane; const u32x2 w = *p; const u32x2 gq = *((const u32x2*)(rg + (size_t)it * 256) + F.lane);
        const float o0 = lo16(w.x), o1 = hi16(w.x), o2 = lo16(w.y), o3 = hi16(w.y);
        const float ss = wave_sum((o0 * o0 + o1 * o1) + (o2 * o2 + o3 * o3));
        const float r = 1.0f / sqrtf(ss * (1.0f / 256.0f) + EPS);
        u32x2 q; q.x = pk2(o0 * r * lo16(gq.x), o1 * r * hi16(gq.x)); q.y = pk2(o2 * r * lo16(gq.y), o3 * r * hi16(gq.y)); *p = q;
    }
}
namespace nsaf {
constexpr int KROW = 272, VROW = 136, KT_BYTES = 64 * KROW, VT_BYTES = 128 * VROW;
constexpr int OFF_K = 0, OFF_V = KT_BYTES, BUF_BYTES = KT_BYTES + VT_BYTES, OFF_IMP = 2 * BUF_BYTES, OFF_MASK = OFF_IMP + 64 * 64 * 4;
constexpr float NEG = -1.0e30f, MASKED = -3.0e38f, CS = 0.08838834764831845f * 1.4426950408889634f;
struct Stage { u32x4 k0, k1, v0, v1; };
__device__ __forceinline__ void stage_load(Stage& st, const bf16* K, const bf16* VT, size_t vpitch, int key0, int tid) {
    const int r0 = tid >> 4, c0 = tid & 15;
    st.k0 = *(const u32x4*)(K + (size_t)(key0 + r0) * 128 + c0 * 8); st.k1 = *(const u32x4*)(K + (size_t)(key0 + r0 + 32) * 128 + c0 * 8);
    const int d0 = tid >> 3, c1 = tid & 7;
    st.v0 = *(const u32x4*)(VT + (size_t)d0 * vpitch + key0 + c1 * 8); st.v1 = *(const u32x4*)(VT + (size_t)(d0 + 64) * vpitch + key0 + c1 * 8);
}
__device__ __forceinline__ void stage_write(const Stage& st, LAS unsigned char* lds, int tid) {
    const int r0 = tid >> 4, c0 = tid & 15;
    *(LAS u32x4*)(lds + OFF_K + r0 * KROW + c0 * 16) = st.k0; *(LAS u32x4*)(lds + OFF_K + (r0 + 32) * KROW + c0 * 16) = st.k1;
    const int d0 = tid >> 3, c1 = tid & 7;
    LAS unsigned char* p0 = lds + OFF_V + d0 * VROW + c1 * 16; LAS unsigned char* p1 = lds + OFF_V + (d0 + 64) * VROW + c1 * 16;
    *(LAS u32x2*)p0 = (u32x2){st.v0.x, st.v0.y}; *(LAS u32x2*)(p0 + 8) = (u32x2){st.v0.z, st.v0.w};
    *(LAS u32x2*)p1 = (u32x2){st.v1.x, st.v1.y}; *(LAS u32x2*)(p1 + 8) = (u32x2){st.v1.z, st.v1.w};
}
template <int MODE>
__device__ __forceinline__ void block_step(const LAS unsigned char* lds, LAS unsigned char* ldstab, const bf16x8 (&qf)[8], f32x16 (&O)[4], float& m, float& l, int blk, int jfast, int tl_in, int itile, int nvr_in, bool rowsel, float inv_l, int lane_in) {
    int tl = tl_in, nvr = nvr_in, lane = lane_in; LAUNDER(tl); LAUNDER(nvr); LAUNDER(lane);
    const int r = lane & 31, hi = lane >> 5;
    f32x16 S[2];
#pragma unroll
    for (int kh = 0; kh < 2; ++kh) {
#pragma unroll
        for (int j = 0; j < 16; ++j) S[kh][j] = 0.f;
    }
    {
        const unsigned kaddr = (unsigned)(size_t)(lds + OFF_K + r * KROW + 16 * hi);
        u32x4 ka[4], kb[4];
#define NSAF_KRD(dst, t, s4) asm volatile("ds_read_b128 %0, %1 offset:%2" : "=v"(dst) : "v"(kaddr), "i"((t) * 32 * KROW + (s4) * 32))
#define NSAF_KRD4(set, t, s0) do { NSAF_KRD(set[0], t, (s0)); NSAF_KRD(set[1], t, (s0) + 1); NSAF_KRD(set[2], t, (s0) + 2); NSAF_KRD(set[3], t, (s0) + 3); } while (0)
#define NSAF_KWAIT(n, set) asm volatile("s_waitcnt lgkmcnt(" #n ")" : "+v"(set[0]), "+v"(set[1]), "+v"(set[2]), "+v"(set[3]))
#define NSAF_KMMA(set, t, s0) do { _Pragma("unroll") for (int q_ = 0; q_ < 4; ++q_) S[t] = __builtin_amdgcn_mfma_f32_32x32x16_bf16(__builtin_bit_cast(bf16x8, set[q_]), qf[(s0) + q_], S[t], 0, 0, 0); } while (0)
        NSAF_KRD4(ka, 0, 0); NSAF_KRD4(kb, 0, 4);
        NSAF_KWAIT(4, ka); NSAF_KMMA(ka, 0, 0); NSAF_KRD4(ka, 1, 0);
        NSAF_KWAIT(4, kb); NSAF_KMMA(kb, 0, 4); NSAF_KRD4(kb, 1, 4);
        NSAF_KWAIT(4, ka); NSAF_KMMA(ka, 1, 0);
        NSAF_KWAIT(0, kb); NSAF_KMMA(kb, 1, 4);
#undef NSAF_KRD
#undef NSAF_KRD4
#undef NSAF_KWAIT
#undef NSAF_KMMA
    }
    bool need_mask;
    if (MODE <= 1) need_mask = true; else if (MODE == 2) need_mask = (blk == itile); else need_mask = (blk == itile) || (blk == itile - 8);
    if (MODE >= 2 && !need_mask && blk >= jfast) {
        const float msub = (MODE == 2 && !rowsel) ? 3.0e38f : m;
        float rs = 0.f;
#pragma unroll
        for (int kh = 0; kh < 2; ++kh)
#pragma unroll
            for (int j = 0; j < 16; ++j) { const float p = __builtin_amdgcn_exp2f(S[kh][j] - msub); S[kh][j] = p; rs += p; }
        l += rs;
    } else {
    float mx = MASKED;
    if (need_mask) {
        int lo_ = -1, hi_ = 63;
        if (MODE <= 1) hi_ = nvr - 64 * blk - 1; else if (MODE == 2) hi_ = tl; else { hi_ = (blk == itile) ? tl : 63; lo_ = (blk == itile - 8) ? tl : -1; }
        lo_ -= 4 * hi; hi_ -= 4 * hi;
#pragma unroll
        for (int kh = 0; kh < 2; ++kh)
#pragma unroll
            for (int j = 0; j < 16; ++j) { const int kc_ = 32 * kh + (j & 3) + 8 * (j >> 2); const bool ok = (kc_ > lo_) & (kc_ <= hi_); const float v = ok ? S[kh][j] : MASKED; S[kh][j] = v; mx = fmaxf(mx, v); }
    } else {
#pragma unroll
        for (int kh = 0; kh < 2; ++kh)
#pragma unroll
            for (int j = 0; j < 16; ++j) mx = fmaxf(mx, S[kh][j]);
    }
    if (MODE == 2) mx = rowsel ? mx : MASKED;
    if (MODE == 1) {
        LAS float* imp = (LAS float*)(ldstab + OFF_IMP) + tl * 64;
        const bool adder = (lane & 3) == 0;
#pragma unroll
        for (int kh = 0; kh < 2; ++kh)
#pragma unroll
            for (int q = 0; q < 4; ++q) {
                float p4[4];
#pragma unroll
                for (int e = 0; e < 4; ++e) { const float p = __builtin_amdgcn_exp2f(S[kh][4 * q + e] - m) * inv_l; S[kh][4 * q + e] = p; p4[e] = p; }
                float sb = (p4[0] + p4[1]) + (p4[2] + p4[3]), sn = p4[3];
                sb += DPP_F(sb, 0xB1, 0xf); sn += DPP_F(sn, 0xB1, 0xf);
                sb += DPP_F(sb, 0x4E, 0xf); sn += DPP_F(sn, 0x4E, 0xf);
                const int bin = 16 * blk + 8 * kh + 2 * q + hi;
                if (adder) { __hip_atomic_fetch_add(imp + bin, sb, __ATOMIC_RELAXED, __HIP_MEMORY_SCOPE_WORKGROUP); if (bin + 1 < 64) __hip_atomic_fetch_add(imp + bin + 1, sn, __ATOMIC_RELAXED, __HIP_MEMORY_SCOPE_WORKGROUP); }
            }
    } else {
        mx = fmaxf(mx, __shfl_xor(mx, 32));
        if (__any(mx > m + 8.0f)) { const float mn = fmaxf(m, mx); const float alpha = __builtin_amdgcn_exp2f(m - mn); m = mn; l *= alpha;
            if (MODE != 0) {
#pragma unroll
                for (int dt = 0; dt < 4; ++dt)
#pragma unroll
                    for (int j = 0; j < 16; ++j) O[dt][j] *= alpha; } }
        float rs = 0.f;
        if (MODE == 2) {
#pragma unroll
            for (int kh = 0; kh < 2; ++kh)
#pragma unroll
                for (int j = 0; j < 16; ++j) { const float p = rowsel ? __builtin_amdgcn_exp2f(S[kh][j] - m) : 0.f; S[kh][j] = p; rs += p; }
        } else {
#pragma unroll
            for (int kh = 0; kh < 2; ++kh)
#pragma unroll
                for (int j = 0; j < 16; ++j) { const float p = __builtin_amdgcn_exp2f(S[kh][j] - m); S[kh][j] = p; rs += p; }
        }
        l += rs;
        if (MODE == 0) return;
    }
    }
    bf16x8 pf[2][2];
#pragma unroll
    for (int kh = 0; kh < 2; ++kh)
#pragma unroll
        for (int s2 = 0; s2 < 2; ++s2) { u32x4 w; w.x = cvt_pk_bf16(S[kh][8 * s2 + 0], S[kh][8 * s2 + 1]); w.y = cvt_pk_bf16(S[kh][8 * s2 + 2], S[kh][8 * s2 + 3]); w.z = cvt_pk_bf16(S[kh][8 * s2 + 4], S[kh][8 * s2 + 5]); w.w = cvt_pk_bf16(S[kh][8 * s2 + 6], S[kh][8 * s2 + 7]);
            pf[kh][s2] = __builtin_bit_cast(bf16x8, w); }
    {
        const unsigned vaddr = (unsigned)(size_t)(lds + OFF_V + r * VROW + 8 * hi);
        u32x2 va[8], vb[8];
#define NSAF_VRD(dst, dt, i) asm volatile("ds_read_b64 %0, %1 offset:%2" : "=v"(dst) : "v"(vaddr), "i"((dt) * 32 * VROW + ((i) >> 1) * 32 + ((i) & 1) * 16))
#define NSAF_VRD8(set, dt) do { NSAF_VRD(set[0], dt, 0); NSAF_VRD(set[1], dt, 1); NSAF_VRD(set[2], dt, 2); NSAF_VRD(set[3], dt, 3); NSAF_VRD(set[4], dt, 4); NSAF_VRD(set[5], dt, 5); NSAF_VRD(set[6], dt, 6); NSAF_VRD(set[7], dt, 7); } while (0)
#define NSAF_VWAIT(n, set) asm volatile("s_waitcnt lgkmcnt(" #n ")" : "+v"(set[0]), "+v"(set[1]), "+v"(set[2]), "+v"(set[3]), "+v"(set[4]), "+v"(set[5]), "+v"(set[6]), "+v"(set[7]))
#define NSAF_VMMA(set, dt) do { _Pragma("unroll") for (int ks = 0; ks < 4; ++ks) { const u32x4 a_ = (u32x4){set[2 * ks].x, set[2 * ks].y, set[2 * ks + 1].x, set[2 * ks + 1].y}; \
            O[dt] = __builtin_amdgcn_mfma_f32_32x32x16_bf16(__builtin_bit_cast(bf16x8, a_), pf[ks >> 1][ks & 1], O[dt], 0, 0, 0); } } while (0)
        NSAF_VRD8(va, 0); NSAF_VRD8(vb, 1);
        NSAF_VWAIT(8, va); NSAF_VMMA(va, 0); NSAF_VRD8(va, 2);
        NSAF_VWAIT(8, vb); NSAF_VMMA(vb, 1); NSAF_VRD8(vb, 3);
        NSAF_VWAIT(8, va); NSAF_VMMA(va, 2);
        NSAF_VWAIT(0, vb); NSAF_VMMA(vb, 3);
#undef NSAF_VRD
#undef NSAF_VRD8
#undef NSAF_VWAIT
#undef NSAF_VMMA
    }
}
template <int MODE>
__device__ __forceinline__ void run_pass(LAS unsigned char* lds, const bf16* K, const bf16* VT, size_t vpitch, int jb, int je, const bf16x8 (&qf)[8], f32x16 (&O)[4], float& m, float& l, bool allowfast, int tl, int itile, int nvr, unsigned long long selmask, float inv_l, int tid, int lane) {
    Stage st; stage_load(st, K, VT, vpitch, jb * 64, tid); stage_write(st, lds, tid);
    if (jb < je) stage_load(st, K, VT, vpitch, (jb + 1) * 64, tid);
    __syncthreads();
    for (int j = jb; j <= je; ++j) {
        const int cur = (j - jb) & 1;
        if (j < je) { stage_write(st, lds + (cur ^ 1) * BUF_BYTES, tid); if (j + 1 < je) stage_load(st, K, VT, vpitch, (j + 2) * 64, tid); }
        const bool rowsel = (MODE == 2) ? (((selmask >> j) & 1ull) != 0ull) : true;
        if (MODE != 2 || __ballot(rowsel) != 0ull) block_step<MODE>(lds + cur * BUF_BYTES, lds, qf, O, m, l, j, allowfast ? jb + (MODE == 2 ? 1 : 2) : 0x7fffffff, tl, itile, nvr, rowsel, inv_l, lane);
        __syncthreads();
    }
}
}
__device__ __forceinline__ void p3_nsa_fast(Frame& F, const bf16* svT, const bf16* wvT, bf16* outbase) {
    using namespace nsaf;
    unsigned char* ws = F.ws; const int tid = F.tid, lane = F.lane, wave = F.wave; LAS unsigned char* lds = F.lds;
    bf16* nq = (bf16*)(ws + WS_NQ); const float* gates = (const float*)(ws + WS_GATES);
    const int r = lane & 31, hi = lane >> 5, qrow = wave * 32 + r, tl = qrow >> 2, head = qrow & 3;
    unsigned failmask = 0u;
    for (int trip = 0; trip < 2; ++trip) {
    for (int u4 = 0; u4 < 4; ++u4) {
        if (trip == 1 && ((failmask >> u4) & 1u) == 0u) continue;
        const bool allowfast = trip == 0;
        const int pr = (F.bx & 7) * 32 + (F.bx >> 3) + (u4 >> 1) * 256; if (F.bx >= 256) break;
        const int bg = pr >> 5, ii = pr & 31, itile = (u4 & 1) ? (63 - ii) : ii, g = bg & 1, b = bg >> 1;
        const int tok = b * SEQ + itile * 64 + tl, t = itile * 64 + tl;
        const bf16* kc = (const bf16*)(ws + WS_KCMP) + (size_t)bg * 256 * 128; const bf16* vcT = (const bf16*)(ws + WS_VCMPT) + (size_t)bg * 128 * 256;
        const bf16* ks = (const bf16*)(ws + WS_KV6 + 2 * KV_STRIDE) + (size_t)bg * SEQ * 128; const bf16* kw = (const bf16*)(ws + WS_KV6 + 4 * KV_STRIDE) + (size_t)bg * SEQ * 128;
        const bf16* vsT = svT + (size_t)bg * 128 * SEQ; const bf16* vwT = wvT + (size_t)bg * 128 * SEQ;
        __syncthreads();
        for (int i = tid; i < 64 * 64; i += NTHREADS) ((LAS float*)(lds + OFF_IMP))[i] = 0.f;
        bf16x8 qf[8];
        {
            LAS unsigned char* tb_ = lds + wave * 8704;
#pragma unroll
            for (int k_ = 0; k_ < 8; ++k_) { const int rr_ = 4 * k_ + (lane >> 4), ch_ = lane & 15, qr_ = wave * 32 + rr_;
                *(LAS u32x4*)(tb_ + rr_ * 272 + ch_ * 16) = *(const u32x4*)(nq + (size_t)(b * SEQ + itile * 64 + (qr_ >> 2)) * 1024 + g * 512 + (qr_ & 3) * 128 + ch_ * 8); }
            LDS_WAIT(); asm volatile("" ::: "memory");
#pragma unroll
            for (int s_ = 0; s_ < 8; ++s_) { const u32x4 w_ = *(const LAS u32x4*)(tb_ + r * 272 + (16 * s_ + 8 * hi) * 2);
                u32x4 o_; o_.x = cvt_pk_bf16(lo16(w_.x) * CS, hi16(w_.x) * CS); o_.y = cvt_pk_bf16(lo16(w_.y) * CS, hi16(w_.y) * CS); o_.z = cvt_pk_bf16(lo16(w_.z) * CS, hi16(w_.z) * CS); o_.w = cvt_pk_bf16(lo16(w_.w) * CS, hi16(w_.w) * CS);
                qf[s_] = __builtin_bit_cast(bf16x8, o_); }
            __syncthreads();
        }
        const float* gatep = gates + (size_t)tok * 24 + (g * 4 + head) * 3;
        const int nvr = (t >= 31) ? (((t - 31) >> 4) + 1 > 255 ? 255 : ((t - 31) >> 4) + 1) : 0;
        const int jec = ((4 * itile + 2) >> 6) > 3 ? 3 : ((4 * itile + 2) >> 6);
        f32x16 O[4];
#define NSAF_ZERO_O() do { _Pragma("unroll") for (int dt = 0; dt < 4; ++dt) _Pragma("unroll") for (int j = 0; j < 16; ++j) O[dt][j] = 0.f; } while (0)
#define NSAF_ADD2(a_, b_) cvt_pk_bf16(lo16(a_) + lo16(b_), hi16(a_) + hi16(b_))
#define NSAF_ACCUM(coef, FIRST) do { const float cf_ = (coef); LAS unsigned char* tb_ = lds + wave * 8704; \
        _Pragma("unroll") for (int dt = 0; dt < 4; ++dt) { _Pragma("unroll") for (int q4 = 0; q4 < 4; ++q4) \
            *(LAS u32x2*)(tb_ + r * 272 + (32 * dt + 8 * q4 + 4 * hi) * 2) = (u32x2){cvt_pk_bf16(cf_ * O[dt][4 * q4], cf_ * O[dt][4 * q4 + 1]), cvt_pk_bf16(cf_ * O[dt][4 * q4 + 2], cf_ * O[dt][4 * q4 + 3])}; } \
        LDS_WAIT(); asm volatile("" ::: "memory"); \
        _Pragma("unroll 2") for (int k_ = 0; k_ < 8; ++k_) { const int rr_ = 4 * k_ + (lane >> 4), ch_ = lane & 15, qr_ = wave * 32 + rr_; \
            const u32x4 nv_ = *(const LAS u32x4*)(tb_ + rr_ * 272 + ch_ * 16); \
            u32x4* gp_ = (u32x4*)(outbase + (size_t)(b * SEQ + itile * 64 + (qr_ >> 2)) * 1024 + g * 512 + (qr_ & 3) * 128 + ch_ * 8); \
            u32x4 w_ = nv_; if (!(FIRST)) { const u32x4 ov_ = *gp_; w_.x = NSAF_ADD2(nv_.x, ov_.x); w_.y = NSAF_ADD2(nv_.y, ov_.y); w_.z = NSAF_ADD2(nv_.z, ov_.z); w_.w = NSAF_ADD2(nv_.w, ov_.w); } \
            *gp_ = w_; } \
        asm volatile("" ::: "memory"); } while (0)
        float m = NEG, l = 0.f; NSAF_ZERO_O();
        run_pass<0>(lds, kc, vcT, 256, 0, jec, qf, O, m, l, false, tl, itile, nvr, 0ull, 0.f, tid, lane);
        l += __shfl_xor(l, 32); const float invl = l > 0.f ? 1.0f / l : 0.f;
        run_pass<1>(lds, kc, vcT, 256, 0, jec, qf, O, m, l, false, tl, itile, nvr, 0ull, invl, tid, lane);
        NSAF_ACCUM(gatep[0], true);
        __syncthreads();
        for (int tk = 0; tk < 8; ++tk) { const int tokl = wave * 8 + tk; float v = ((const LAS float*)(lds + OFF_IMP))[tokl * 64 + lane];
            const bool forced = (lane == 0) || (lane == itile) || (lane == itile - 1); v = (lane > itile) ? -1.0e4f : (forced ? 1.0e4f : v);
            int rank = 0;
#pragma unroll 16
            for (int i = 0; i < 64; ++i) { const float w = __builtin_bit_cast(float, __builtin_amdgcn_readlane(__builtin_bit_cast(int, v), i)); rank += (w > v || (w == v && i < lane)) ? 1 : 0; }
            const unsigned long long mk = __ballot(rank < 16);
            if (lane == 0) { ((LAS unsigned*)(lds + OFF_MASK))[tokl * 2] = (unsigned)mk; ((LAS unsigned*)(lds + OFF_MASK))[tokl * 2 + 1] = (unsigned)(mk >> 32); } }
        __syncthreads();
        const unsigned long long selmask = (unsigned long long)((const LAS unsigned*)(lds + OFF_MASK))[tl * 2] | ((unsigned long long)((const LAS unsigned*)(lds + OFF_MASK))[tl * 2 + 1] << 32);
        m = NEG; l = 0.f; NSAF_ZERO_O();
        run_pass<2>(lds, ks, vsT, SEQ, 0, itile, qf, O, m, l, allowfast, tl, itile, 0, selmask, 0.f, tid, lane);
        l += __shfl_xor(l, 32); bool bad = !(l < 1.0e12f);
        NSAF_ACCUM(l > 0.f ? gatep[1] / l : 0.f, false);
        __syncthreads();
        m = NEG; l = 0.f; NSAF_ZERO_O();
        run_pass<3>(lds, kw, vwT, SEQ, itile > 8 ? itile - 8 : 0, itile, qf, O, m, l, allowfast, tl, itile, 0, 0ull, 0.f, tid, lane);
        l += __shfl_xor(l, 32); bad = bad | !(l < 1.0e12f);
        NSAF_ACCUM(l > 0.f ? gatep[2] / l : 0.f, false);
        if (allowfast && __syncthreads_or(bad ? 1 : 0)) failmask |= 1u << u4;
#undef NSAF_ZERO_O
#undef NSAF_ACCUM
#undef NSAF_ADD2
    }
    if (failmask == 0u) break;
    }
    __syncthreads();
}
struct SchedP4 {
    unsigned char* ws; int G, c; const char* nsa;
    __device__ __forceinline__ bool next(int i, GU& u) const {
        const int ti = i >> 2, sub = i & 3; const int L = ti * G + c; if (L >= 128 * 4) return false;
        int pm, pn; pg8::tile_map(L, 128, 4, pm, pn);
        const size_t ao = sub == 1 ? WS_RV : sub == 3 ? WS_NQ : WS_H; const size_t bo = sub == 0 ? W_GA : sub == 1 ? W_RO : sub == 2 ? W_GB : W_NO;
        u.A = (sub == 3 ? nsa : (const char*)ws + ao) + (size_t)pm * 256 * D * 2; u.B = (const char*)ws + bo + (size_t)pn * 256 * D * 2; u.pm = pm; u.pn = pn; u.kind = sub; u.rows = nullptr; u.nvalid = 0; u.aux = 0; return true;
    }
};
struct EpiP4 {
    static constexpr bool PERM = true;
    float* scr;
    bf16* Y;
    static __device__ __forceinline__ u32x2 pk4(const f32x4 v) { return (u32x2){cvt_pk_bf16(v[0], v[1]), cvt_pk_bf16(v[2], v[3])}; }
    static __device__ __forceinline__ f32x4 up4(const u32x2 w) { return (f32x4){lo16(w.x), hi16(w.x), lo16(w.y), hi16(w.y)}; }
    __device__ __forceinline__ void operator()(const f32x4 (&acc)[2][2][4][2], const GU& u, int wr, int wc, int fr, int fq) const {
        u32x2* p0 = (u32x2*)scr + threadIdx.x; u32x2* p1 = p0 + 32 * 512;
        if (u.kind == 0 || u.kind == 2) {
            u32x2* p = u.kind == 0 ? p0 : p1;
#pragma unroll
            for (int ai = 0; ai < 2; ++ai)
#pragma unroll
                for (int m = 0; m < 4; ++m) {
#pragma unroll
                    for (int bj = 0; bj < 2; ++bj) { f32x4 v0 = acc[ai][bj][m][0], v1 = acc[ai][bj][m][1];
#pragma unroll
                        for (int j = 0; j < 4; ++j) { v0[j] = sigmoidf_(v0[j]); v1[j] = sigmoidf_(v1[j]); }
                        p[(2 * bj) * 512] = pk4(v0); p[(2 * bj + 1) * 512] = pk4(v1); }
                    p += 4 * 512; LAUNDER(p); }
        } else if (u.kind == 1) {
#pragma unroll
            for (int ai = 0; ai < 2; ++ai)
#pragma unroll
                for (int m = 0; m < 4; ++m) {
#pragma unroll
                    for (int bj = 0; bj < 2; ++bj) { p0[(2 * bj) * 512] = pk4(up4(p0[(2 * bj) * 512]) * acc[ai][bj][m][0]); p0[(2 * bj + 1) * 512] = pk4(up4(p0[(2 * bj + 1) * 512]) * acc[ai][bj][m][1]); }
                    p0 += 4 * 512; LAUNDER(p0); }
        } else {
            bf16* yb = Y + (size_t)(u.pm * 256 + 64 * wr + fr) * D + u.pn * 256 + 32 * wc + 8 * fq;
#pragma unroll
            for (int ai = 0; ai < 2; ++ai)
#pragma unroll
                for (int m = 0; m < 4; ++m) {
#pragma unroll
                    for (int bj = 0; bj < 2; ++bj) {
                        const f32x4 v0 = up4(p0[(2 * bj) * 512]) + up4(p1[(2 * bj) * 512]) * acc[ai][bj][m][0], v1 = up4(p0[(2 * bj + 1) * 512]) + up4(p1[(2 * bj + 1) * 512]) * acc[ai][bj][m][1];
                        u32x4 w; w.x = cvt_pk_bf16(v0[0], v0[1]); w.y = cvt_pk_bf16(v0[2], v0[3]); w.z = cvt_pk_bf16(v1[0], v1[1]); w.w = cvt_pk_bf16(v1[2], v1[3]);
                        *(u32x4*)(yb + (size_t)(128 * ai + 16 * m) * D + 128 * bj) = w; }
                    p0 += 4 * 512; p1 += 4 * 512; LAUNDER(p0); LAUNDER(p1); }
        }
    }
};

struct SchedMN {
    unsigned char* ws; size_t ao, bo; int G, c;
    __device__ __forceinline__ bool next(int i, GU& u) const {
        const int L = i * G + c; if (L >= 128 * 4) return false; int pm, pn; pg8::tile_map(L, 128, 4, pm, pn);
        u.A = (const char*)ws + ao + (size_t)pm * 256 * D * 2; u.B = (const char*)ws + bo + (size_t)pn * 256 * D * 2; u.pm = pm; u.pn = pn; u.kind = 0; u.rows = nullptr; u.nvalid = 0; u.aux = 0; return true;
    }
};
template <bool SSQ> struct EpiRes {
    static constexpr bool PERM = true;
    const float* basef; const bf16* baseb; float* out; bf16* ob; float* ssq;
    __device__ __forceinline__ void operator()(const f32x4 (&acc)[2][2][4][2], const GU& u, int wr, int wc, int fr, int fq) const {
#pragma unroll
        for (int ai = 0; ai < 2; ++ai)
#pragma unroll
            for (int m = 0; m < 4; ++m) { const int r = u.pm * 256 + 128 * ai + 64 * wr + 16 * m + fr; const size_t off = (size_t)r * D + u.pn * 256 + 32 * wc + 8 * fq; float sq = 0.f;
#pragma unroll
                for (int bj = 0; bj < 2; ++bj) { const size_t o = off + 128 * bj; f32x4 b0, b1;
                    if (SSQ) { b0 = *(const f32x4*)(basef + o); b1 = *(const f32x4*)(basef + o + 4); }
                    else { const u32x4 bw = *(const u32x4*)(baseb + o); b0 = (f32x4){lo16(bw.x), hi16(bw.x), lo16(bw.y), hi16(bw.y)}; b1 = (f32x4){lo16(bw.z), hi16(bw.z), lo16(bw.w), hi16(bw.w)}; }
                    const f32x4 v0 = b0 + acc[ai][bj][m][0], v1 = b1 + acc[ai][bj][m][1];
                    if (!SSQ) { *(f32x4*)(out + o) = v0; *(f32x4*)(out + o + 4) = v1; }
                    u32x4 w; w.x = cvt_pk_bf16(v0[0], v0[1]); w.y = cvt_pk_bf16(v0[2], v0[3]); w.z = cvt_pk_bf16(v1[0], v1[1]); w.w = cvt_pk_bf16(v1[2], v1[3]); *(u32x4*)(ob + o) = w;
                    sq += ((v0[0] * v0[0] + v0[1] * v0[1]) + (v0[2] * v0[2] + v0[3] * v0[3])) + ((v1[0] * v1[0] + v1[1] * v1[1]) + (v1[2] * v1[2] + v1[3] * v1[3])); }
                if (SSQ) { sq += __shfl_xor(sq, 16); sq += __shfl_xor(sq, 32); if (fq == 0) ssq[(size_t)r * 16 + u.pn * 4 + wc] = sq; }
            }
    }
};
struct EpiQ {
    static constexpr bool PERM = true;
    const float* ssq; bf16* Q;
    __device__ __forceinline__ void operator()(const f32x4 (&acc)[2][2][4][2], const GU& u, int wr, int wc, int fr, int fq) const {
#pragma unroll
        for (int ai = 0; ai < 2; ++ai)
#pragma unroll
            for (int m = 0; m < 4; ++m) { const int r = u.pm * 256 + 128 * ai + 64 * wr + 16 * m + fr; const f32x4* sp = (const f32x4*)(ssq + (size_t)r * 16);
                const f32x4 a = sp[0], b = sp[1], c = sp[2], d = sp[3]; const float tot = ((a[0] + a[1]) + (a[2] + a[3])) + ((b[0] + b[1]) + (b[2] + b[3])) + ((c[0] + c[1]) + (c[2] + c[3])) + ((d[0] + d[1]) + (d[2] + d[3]));
                const float rstd = 1.0f / sqrtf(tot * (1.0f / D) + EPS);
#pragma unroll
                for (int bj = 0; bj < 2; ++bj) { const f32x4 v0 = acc[ai][bj][m][0] * rstd, v1 = acc[ai][bj][m][1] * rstd;
                    u32x4 w; w.x = cvt_pk_bf16(v0[0], v0[1]); w.y = cvt_pk_bf16(v0[2], v0[3]); w.z = cvt_pk_bf16(v1[0], v1[1]); w.w = cvt_pk_bf16(v1[2], v1[3]);
                    *(u32x4*)(Q + (size_t)r * D + u.pn * 256 + 128 * bj + 32 * wc + 8 * fq) = w; } }
    }
};

namespace xatf {
constexpr int KROW = 528, VROW = 136, KT_BYTES = 64 * KROW, OFF_K = 0, OFF_V = KT_BYTES;
constexpr float NEG = -1.0e30f, CS = 0.0625f * 1.4426950408889634f;
struct Stage { u32x4 k[4]; u32x4 v[2]; };
__device__ __forceinline__ void stage_load(Stage& st, const bf16* K, const bf16* VT, int key0, int tid) {
#pragma unroll
    for (int i = 0; i < 4; ++i) { const int p = tid + 512 * i, row = p >> 5, c = p & 31; st.k[i] = *(const u32x4*)(K + (size_t)(key0 + row) * 2048 + c * 8); }
#pragma unroll
    for (int i = 0; i < 2; ++i) { const int p = tid + 512 * i, d = p >> 3, c = p & 7; st.v[i] = *(const u32x4*)(VT + (size_t)d * 256 + key0 + c * 8); }
}
__device__ __forceinline__ void stage_write(const Stage& st, LAS unsigned char* lds, int tid) {
#pragma unroll
    for (int i = 0; i < 4; ++i) { const int p = tid + 512 * i, row = p >> 5, c = p & 31; *(LAS u32x4*)(lds + OFF_K + row * KROW + c * 16) = st.k[i]; }
#pragma unroll
    for (int i = 0; i < 2; ++i) { const int p = tid + 512 * i, d = p >> 3, c = p & 7; LAS unsigned char* q = lds + OFF_V + d * VROW + c * 16;
        *(LAS u32x2*)q = (u32x2){st.v[i].x, st.v[i].y}; *(LAS u32x2*)(q + 8) = (u32x2){st.v[i].z, st.v[i].w}; }
}
__device__ __forceinline__ void block_step(const LAS unsigned char* lds, const bf16x8 (&qf)[16], f32x16 (&O)[4], float& m, float& l, int lane) {
    const int r = lane & 31, hi = lane >> 5;
    f32x16 S[2];
#pragma unroll
    for (int kh = 0; kh < 2; ++kh) {
#pragma unroll
        for (int j = 0; j < 16; ++j) S[kh][j] = 0.f;
#pragma unroll
        for (int s_ = 0; s_ < 16; ++s_) { const bf16x8 a = *(const LAS bf16x8*)(lds + OFF_K + (kh * 32 + r) * KROW + (16 * s_ + 8 * hi) * 2); S[kh] = __builtin_amdgcn_mfma_f32_32x32x16_bf16(a, qf[s_], S[kh], 0, 0, 0); }
    }
    float mx = NEG;
#pragma unroll
    for (int kh = 0; kh < 2; ++kh)
#pragma unroll
        for (int j = 0; j < 16; ++j) { const float v = S[kh][j] * CS; S[kh][j] = v; mx = fmaxf(mx, v); }
    mx = fmaxf(mx, __shfl_xor(mx, 32));
    const float mn = fmaxf(m, mx); const float alpha = __builtin_amdgcn_exp2f(m - mn); m = mn; float rs = 0.f;
#pragma unroll
    for (int kh = 0; kh < 2; ++kh)
#pragma unroll
        for (int j = 0; j < 16; ++j) { const float p = __builtin_amdgcn_exp2f(S[kh][j] - mn); S[kh][j] = p; rs += p; }
    l = l * alpha + rs;
#pragma unroll
    for (int dt = 0; dt < 4; ++dt)
#pragma unroll
        for (int j = 0; j < 16; ++j) O[dt][j] *= alpha;
    bf16x8 pf[2][2];
#pragma unroll
    for (int kh = 0; kh < 2; ++kh)
#pragma unroll
        for (int s2 = 0; s2 < 2; ++s2) { u32x4 w; w.x = cvt_pk_bf16(S[kh][8 * s2 + 0], S[kh][8 * s2 + 1]); w.y = cvt_pk_bf16(S[kh][8 * s2 + 2], S[kh][8 * s2 + 3]); w.z = cvt_pk_bf16(S[kh][8 * s2 + 4], S[kh][8 * s2 + 5]); w.w = cvt_pk_bf16(S[kh][8 * s2 + 6], S[kh][8 * s2 + 7]);
            pf[kh][s2] = __builtin_bit_cast(bf16x8, w); }
#pragma unroll
    for (int dt = 0; dt < 4; ++dt)
#pragma unroll
        for (int kh = 0; kh < 2; ++kh)
#pragma unroll
            for (int s2 = 0; s2 < 2; ++s2) { const LAS unsigned char* vp = lds + OFF_V + (dt * 32 + r) * VROW + (32 * kh + 16 * s2 + 4 * hi) * 2;
                const u32x2 lo = *(const LAS u32x2*)vp, hi2 = *(const LAS u32x2*)(vp + 16); const u32x4 av = (u32x4){lo.x, lo.y, hi2.x, hi2.y};
                O[dt] = __builtin_amdgcn_mfma_f32_32x32x16_bf16(__builtin_bit_cast(bf16x8, av), pf[kh][s2], O[dt], 0, 0, 0); }
}
}
__device__ __forceinline__ void p7_xattn_fast(Frame& F, const bf16* vT, bf16* outbase) {
    using namespace xatf;
    bf16* Q = (bf16*)(F.ws + WS_NQ); const bf16* KV = (const bf16*)(F.ws + WS_MEMKV);
    const int tid = F.tid, lane = F.lane, wave = F.wave, r = lane & 31, hi = lane >> 5; LAS unsigned char* lds = F.lds;
    for (int u = F.bx; u < BATCH * 4 * 16; u += F.G) {
        const int tt = u & 15, bh = u >> 4, b = bh >> 2, h = bh & 3; const int tok = b * SEQ + tt * 256 + wave * 32 + r;
        bf16* qrow = Q + (size_t)tok * D + h * 256; bf16* orow = outbase + (size_t)tok * D + h * 256; const bf16* Kb = KV + (size_t)(b * NMEM) * 2048 + h * 256;
        bf16x8 qf[16];
        LAS unsigned char* tb_ = lds + 61440 + wave * 8704;
        bf16* rows0 = Q + (size_t)(b * SEQ + tt * 256 + wave * 32) * D + h * 256;
#pragma unroll
        for (int hq = 0; hq < 2; ++hq) {
#pragma unroll 4
            for (int k_ = 0; k_ < 8; ++k_) { const int rr_ = 4 * k_ + (lane >> 4), ch_ = lane & 15; *(LAS u32x4*)(tb_ + rr_ * 272 + ch_ * 16) = *(const u32x4*)(rows0 + (size_t)rr_ * D + hq * 128 + ch_ * 8); }
            LDS_WAIT(); asm volatile("" ::: "memory");
#pragma unroll
            for (int s_ = 0; s_ < 8; ++s_) qf[8 * hq + s_] = *(const LAS bf16x8*)(tb_ + r * 272 + (16 * s_ + 8 * hi) * 2);
            LDS_WAIT(); asm volatile("" ::: "memory");
        }
        const bf16* VT0 = vT + (size_t)bh * 256 * 256;
        Stage st; stage_load(st, Kb, VT0, 0, tid);
        f32x16 O[4]; float m = NEG, l = 0.f;
        for (int idx = 0; idx < 8; ++idx) {
            const int half = idx >> 2, j = idx & 3;
            if (j == 0) { m = NEG; l = 0.f;
#pragma unroll
                for (int dt = 0; dt < 4; ++dt)
#pragma unroll
                    for (int jj = 0; jj < 16; ++jj) O[dt][jj] = 0.f; }
            __syncthreads(); stage_write(st, lds, tid);
            { const int i2 = idx < 7 ? idx + 1 : idx; stage_load(st, Kb, VT0 + (size_t)((i2 >> 2) * 128) * 256, (i2 & 3) * 64, tid); }
            __syncthreads();
            block_step(lds, qf, O, m, l, lane);
            if (j == 3) {
                l += __shfl_xor(l, 32); const float inv = 1.0f / l;
#pragma unroll
                for (int dt = 0; dt < 4; ++dt)
#pragma unroll
                    for (int q4 = 0; q4 < 4; ++q4) *(LAS u32x2*)(tb_ + r * 272 + (32 * dt + 8 * q4 + 4 * hi) * 2) = (u32x2){cvt_pk_bf16(O[dt][4 * q4] * inv, O[dt][4 * q4 + 1] * inv), cvt_pk_bf16(O[dt][4 * q4 + 2] * inv, O[dt][4 * q4 + 3] * inv)};
                LDS_WAIT(); asm volatile("" ::: "memory");
#pragma unroll 2
                for (int k_ = 0; k_ < 8; ++k_) { const int rr_ = 4 * k_ + (lane >> 4), ch_ = lane & 15; *(u32x4*)(rows0 + (size_t)rr_ * D + half * 128 + ch_ * 8) = *(const LAS u32x4*)(tb_ + rr_ * 272 + ch_ * 16); }
                LDS_WAIT(); asm volatile("" ::: "memory");
            }
        }
    }
    __syncthreads();
}
__device__ __forceinline__ void transpose_memv_tiles(Frame& F, bf16* vT, int w0, int nw) {
    LAS unsigned short* tl_ = (LAS unsigned short*)(F.lds + F.wave * 16384); const int lane = F.lane; const bf16* KV = (const bf16*)(F.ws + WS_MEMKV);
    for (int tile = w0; tile < 32 * 16; tile += nw) {
        const int dq = tile & 3, kq = (tile >> 2) & 3, bh = tile >> 4, b = bh >> 2, h = bh & 3;
        const bf16* sp = KV + (size_t)(b * NMEM + kq * 64) * 2048 + 1024 + h * 256 + dq * 64; bf16* dp = vT + ((size_t)bh * 256 + dq * 64) * 256 + kq * 64;
#pragma unroll
        for (int i = 0; i < 8; ++i) { const int row = i * 8 + (lane >> 3), c = lane & 7; const u32x4 v = *(const u32x4*)(sp + (size_t)row * 2048 + c * 8); LAS unsigned short* q = tl_ + row * 66 + c * 8;
            q[0] = (unsigned short)(v.x & 0xffffu); q[1] = (unsigned short)(v.x >> 16); q[2] = (unsigned short)(v.y & 0xffffu); q[3] = (unsigned short)(v.y >> 16);
            q[4] = (unsigned short)(v.z & 0xffffu); q[5] = (unsigned short)(v.z >> 16); q[6] = (unsigned short)(v.w & 0xffffu); q[7] = (unsigned short)(v.w >> 16); }
        LDS_WAIT(); asm volatile("" ::: "memory");
#pragma unroll
        for (int i = 0; i < 8; ++i) { const int d = i * 8 + (lane >> 3), c = lane & 7; const LAS unsigned short* q = tl_ + (c * 8) * 66 + d;
            u32x4 o; o.x = (unsigned)q[0] | ((unsigned)q[66] << 16); o.y = (unsigned)q[2 * 66] | ((unsigned)q[3 * 66] << 16); o.z = (unsigned)q[4 * 66] | ((unsigned)q[5 * 66] << 16); o.w = (unsigned)q[6 * 66] | ((unsigned)q[7 * 66] << 16);
            *(u32x4*)(dp + (size_t)d * 256 + c * 8) = o; }
        LDS_WAIT(); asm volatile("" ::: "memory");
    }
}

__device__ __forceinline__ void p9_route(Frame& F, const Args& a) {
    unsigned char* ws = F.ws; const float* X2 = a.out;
    const float* gff = a.in[IN_NORM_FFN_G]; const float* wgrp = a.in[IN_W_GRP]; const float* bgrp = a.in[IN_B_GRP]; const float* wrt = a.in[IN_W_RT]; const float* brt = a.in[IN_B_RT];
    float* wts = (float*)(ws + WS_ROUTE); float* rstd2 = wts + 2 * NTOK; int* lists = (int*)(ws + WS_LISTS);
    const int gw = F.bx * NWAVES + F.wave, NGW = F.G * NWAVES, lane = F.lane;
    const f32x4* wgp = (const f32x4*)(ws + WS_RTW); const f32x4* wep = wgp + 1024;
    float xn[16];
    if (gw < NTOK) {
#pragma unroll
        for (int i = 0; i < 16; ++i) xn[i] = X2[(size_t)gw * D + 64 * i + lane]; }
    int my_ea = -1, my_eb = -1, my_tok = -1, it_ = 0; float my_w1 = 0.f, my_w2 = 0.f, my_rstd = 0.f;
    for (int tok = gw; tok < NTOK; tok += NGW, ++it_) {
        float xa[16]; float s = 0.f;
#pragma unroll
        for (int i = 0; i < 16; ++i) { xa[i] = xn[i]; s += xa[i] * xa[i]; }
        if (tok + NGW < NTOK) {
#pragma unroll
            for (int i = 0; i < 16; ++i) xn[i] = X2[(size_t)(tok + NGW) * D + 64 * i + lane]; }
        const float rstd = 1.0f / sqrtf(wave_sum(s) * (1.f / D) + EPS);
        float lg[4] = {0.f, 0.f, 0.f, 0.f};
#pragma unroll
        for (int i = 0; i < 16; ++i) { const f32x4 wg = wgp[64 * i + lane];
#pragma unroll
            for (int c = 0; c < 4; ++c) lg[c] += xa[i] * wg[c]; }
#pragma unroll
        for (int i = 0; i < 4; ++i) lg[i] = rstd * wave_sum(lg[i]) + bgrp[i];
        int grp = 0; float gm = lg[0];
#pragma unroll
        for (int i = 1; i < 4; ++i) if (lg[i] > gm) { gm = lg[i]; grp = i; }
        grp = __builtin_amdgcn_readfirstlane(grp);
        float gs = 0.f;
#pragma unroll
        for (int i = 0; i < 4; ++i) gs += expf(lg[i] - gm);
        const float g_gate = 1.0f / gs;
        float lq[8];
#pragma unroll
        for (int i = 0; i < 8; ++i) lq[i] = 0.f;
        const f32x4* pwe = wep + (size_t)grp * (16 * 2 * 64) + lane;
#pragma unroll
        for (int i = 0; i < 16; ++i) { const f32x4 wa = pwe[(2 * i) * 64], wb = pwe[(2 * i + 1) * 64];
#pragma unroll
            for (int c = 0; c < 4; ++c) { lq[c] += xa[i] * wa[c]; lq[4 + c] += xa[i] * wb[c]; } }
#pragma unroll
        for (int i = 0; i < 8; ++i) lq[i] = rstd * wave_sum(lq[i]) + brt[grp * 8 + i];
        int i1 = 0; float m1 = lq[0];
#pragma unroll
        for (int i = 1; i < 8; ++i) if (lq[i] > m1) { m1 = lq[i]; i1 = i; }
        int i2 = -1; float m2 = -3.0e38f;
#pragma unroll
        for (int i = 0; i < 8; ++i) if (i != i1 && lq[i] > m2) { m2 = lq[i]; i2 = i; }
        const float e2 = expf(m2 - m1), den = 1.0f + e2; const float w1 = g_gate / den, w2 = g_gate * e2 / den;
        if (lane == it_) { my_ea = grp * 8 + i1; my_eb = grp * 8 + i2; my_tok = tok; my_w1 = w1; my_w2 = w2; my_rstd = rstd; }
    }
    LAS unsigned* cnt = (LAS unsigned*)(F.lds + MISC_OFF + 1024); LAS unsigned* base = cnt + 32;
    __syncthreads();
    if (F.tid < 32) cnt[F.tid] = 0u;
    __syncthreads();
    unsigned pa = 0u, pb = 0u;
    if (my_tok >= 0) { pa = __hip_atomic_fetch_add(cnt + my_ea, 1u, __ATOMIC_RELAXED, __HIP_MEMORY_SCOPE_WORKGROUP); pb = __hip_atomic_fetch_add(cnt + my_eb, 1u, __ATOMIC_RELAXED, __HIP_MEMORY_SCOPE_WORKGROUP); }
    __syncthreads();
    if (F.tid < 32) { const unsigned c = cnt[F.tid]; base[F.tid] = c ? __hip_atomic_fetch_add(F.ctl + CW_ECNT + 64 * F.tid, c, __ATOMIC_RELAXED, __HIP_MEMORY_SCOPE_AGENT) : 0u; }
    __syncthreads();
    if (my_tok >= 0) {
        lists[(size_t)my_ea * NTOK + base[my_ea] + pa] = my_tok * 2; lists[(size_t)my_eb * NTOK + base[my_eb] + pb] = my_tok * 2 + 1;
        wts[my_tok * 2] = my_w1; wts[my_tok * 2 + 1] = my_w2; rstd2[my_tok] = my_rstd;
    }
    __syncthreads();
}
__device__ __forceinline__ void moe_tiles(Frame& F) {
    __syncthreads();
    if (F.tid < NEXP) F.MISC[64 + F.tid] = __hip_atomic_load(F.ctl + CW_ECNT + 64 * F.tid, __ATOMIC_RELAXED, __HIP_MEMORY_SCOPE_AGENT);
    __syncthreads();
    if (F.tid == 0) { unsigned accu = 0u; for (int e = 0; e < NEXP; ++e) { const unsigned c = F.MISC[64 + e]; F.MISC[16 + e] = accu; accu += (c + 255u) >> 8; } F.MISC[16 + NEXP] = accu; }
    __syncthreads();
}
template <int WHICH> struct SchedMoe {
    volatile LAS unsigned* MISC; unsigned char* ws; int G, c;
    __device__ __forceinline__ bool next(int i, GU& u) const {
        const int L = G == 256 ? i * G + (c & 7) * 32 + (c >> 3) : i * G + c; const int T = (int)MISC[16 + NEXP]; if (L >= 4 * T) return false;
        const int tau = L >> 2, pn = L & 3;
        const int ln_ = threadIdx.x & 63; const int st_ = (ln_ >= 1 && ln_ < NEXP) ? (int)MISC[16 + ln_] : 0x7fffffff;
        const int e = __popcll(__ballot(st_ <= tau));
        const int lt = tau - (int)MISC[16 + e]; const int cnt = (int)MISC[64 + e]; int nv = cnt - lt * 256; nv = nv > 256 ? 256 : nv;
        u.rows = (const int*)(ws + WS_LISTS) + (size_t)e * NTOK + lt * 256; u.nvalid = nv; u.pm = tau; u.pn = pn; u.kind = 0; u.aux = e;
        if (WHICH == 0) { u.A = (const char*)ws + WS_X2B; u.B = (const char*)ws + WS_W13 + (size_t)e * D * D * 2 + (size_t)pn * 256 * D * 2; }
        else { u.A = (const char*)ws + WS_H1 + (size_t)tau * 256 * DEXP * 2; u.B = (const char*)ws + WS_W2 + (size_t)e * D * DEXP * 2 + (size_t)pn * 256 * DEXP * 2; }
        return true;
    }
};
struct EpiMoe1 {
    static constexpr bool PERM = true;
    const float* rstd2; bf16* H1;
    __device__ __forceinline__ void operator()(const f32x4 (&acc)[2][2][4][2], const GU& u, int wr, int wc, int fr, int fq) const {
        char* hb = (char*)H1 + (size_t)u.pm * 256 * DEXP * 2;
        const int j00 = (u.pn * 256 + 32 * wc + 8 * fq) >> 1;
#pragma unroll
        for (int ai = 0; ai < 2; ++ai) {
            int r = 128 * ai + 64 * wr + fr; LAUNDER(r);
#pragma unroll
            for (int m = 0; m < 4; ++m) { const bool ok = r < u.nvalid; const float rs = ok ? rstd2[u.rows[r] >> 1] : 0.f;
#pragma unroll
                for (int bj = 0; bj < 2; ++bj) { const f32x4 a1 = acc[ai][bj][m][0] * rs, a3 = acc[ai][bj][m][1] * rs; f32x4 hv;
#pragma unroll
                    for (int j = 0; j < 4; ++j) hv[j] = a1[j] * sigmoidf_(a1[j]) * a3[j];
                    u32x2 w; w.x = cvt_pk_bf16(hv[0], hv[1]); w.y = cvt_pk_bf16(hv[2], hv[3]); *(u32x2*)(hb + (unsigned)((r * DEXP + j00 + 64 * bj) * 2)) = w; }
                r += 16; LAUNDER(r); }
        }
    }
};
struct EpiMoe2 {
    static constexpr bool PERM = true;
    const float* wts; bf16* Y0; bf16* Y1;
    __device__ __forceinline__ void operator()(const f32x4 (&acc)[2][2][4][2], const GU& u, int wr, int wc, int fr, int fq) const {
        int ent[8]; float w8[8];
#pragma unroll
        for (int i = 0; i < 8; ++i) { const int r = 128 * (i >> 2) + 64 * wr + 16 * (i & 3) + fr; ent[i] = r < u.nvalid ? u.rows[r] : -1; }
#pragma unroll
        for (int i = 0; i < 8; ++i) w8[i] = ent[i] >= 0 ? wts[ent[i]] : 0.f;
#pragma unroll
        for (int i = 0; i < 8; ++i) { const int ai = i >> 2, m = i & 3;
            if (ent[i] >= 0) { bf16* dst = ((ent[i] & 1) ? Y1 : Y0) + (size_t)(ent[i] >> 1) * D + u.pn * 256 + 32 * wc + 8 * fq;
#pragma unroll
                for (int bj = 0; bj < 2; ++bj) { const f32x4 v0 = acc[ai][bj][m][0] * w8[i], v1 = acc[ai][bj][m][1] * w8[i];
                    u32x4 w; w.x = cvt_pk_bf16(v0[0], v0[1]); w.y = cvt_pk_bf16(v0[2], v0[3]); w.z = cvt_pk_bf16(v1[0], v1[1]); w.w = cvt_pk_bf16(v1[2], v1[3]);
                    *(u32x4*)(dst + 128 * bj) = w; } } }
    }
};

__device__ __forceinline__ void p12_final(Frame& F, const Args& a) {
    const bf16* Y0 = (const bf16*)(F.ws + WS_YS0); const bf16* Y1 = (const bf16*)(F.ws + WS_YS1); const bf16* X2 = (const bf16*)(F.ws + WS_X2B); const float* g = a.in[IN_NORM_F_G];
    const int gw = F.bx * NWAVES + F.wave, NGW = F.G * NWAVES, lane = F.lane;
    for (int tok = gw; tok < NTOK; tok += NGW) {
        f32x4* xr = (f32x4*)(a.out + (size_t)tok * D) + lane; const u32x2* x2 = (const u32x2*)(X2 + (size_t)tok * D) + lane; const u32x2* y0 = (const u32x2*)(Y0 + (size_t)tok * D) + lane; const u32x2* y1 = (const u32x2*)(Y1 + (size_t)tok * D) + lane;
        f32x4 v[4]; float s = 0.f;
#pragma unroll
        for (int j = 0; j < 4; ++j) { const u32x2 xx = x2[64 * j], p = y0[64 * j], q = y1[64 * j];
            v[j].x = lo16(xx.x) + (lo16(p.x) + lo16(q.x)); v[j].y = hi16(xx.x) + (hi16(p.x) + hi16(q.x)); v[j].z = lo16(xx.y) + (lo16(p.y) + lo16(q.y)); v[j].w = hi16(xx.y) + (hi16(p.y) + hi16(q.y));
            s += (v[j].x * v[j].x + v[j].y * v[j].y) + (v[j].z * v[j].z + v[j].w * v[j].w); }
        const float rstd = 1.0f / sqrtf(wave_sum(s) * (1.f / D) + EPS);
#pragma unroll
        for (int j = 0; j < 4; ++j) { const f32x4 gg = ((const f32x4*)g + lane)[64 * j]; xr[64 * j] = v[j] * rstd * gg; }
    }
}

constexpr int N_PHASES = 14;
__global__ void __launch_bounds__(NTHREADS, 2) fwd(Args args) {
    extern __shared__ __attribute__((aligned(16))) unsigned char lds[];
    Frame F;
    F.lds = (LAS unsigned char*)lds; F.MISC = (volatile LAS unsigned*)(F.lds + MISC_OFF);
    F.tid = threadIdx.x; F.lane = F.tid & 63; F.wave = __builtin_amdgcn_readfirstlane(F.tid >> 6); F.G = gridDim.x; F.bx = blockIdx.x;
    F.ws = args.ws; F.ctl = (unsigned*)(args.ws + WS_CTL);
    unsigned char* ws = args.ws;
    for (int u = F.tid; u < (LDS_BYTES - RING_BYTES) / 4; u += NTHREADS) ((LAS unsigned*)(F.lds + RING_BYTES))[u] = 0u;
    __syncthreads();
    const int lo = args.ph_lo, hi = args.ph_hi;
    const bool one = (hi - lo) > 1;
    XcdBarrier bar; bar.bar = F.ctl + CW_BAR; bar.x = 0; bar.st = F.MISC + 8;
    if (one) bar = xcd_barrier_post(F.ctl + CW_BAR, F.MISC + 8);
#define IN(k) (lo <= (k) && (k) < hi && phase_begin(F))
#define SEAM(k) do { if (lo <= (k) && (k) + 1 < hi) xcd_barrier(bar); } while (0)

    if (IN(0)) { p0_prologue(F, args); } SEAM(0);
    if (IN(1)) {
        SchedP1 S{ws, F.G, F.bx};
        EpiP1 E{ws};
        pg8::gemm_phase<EpiP1, SchedP1, false>(F.lds, D, D, D, S, E);
        p1_gate_logits(F);
    } SEAM(1);
    if (IN(2)) {
        p2_retention_fast(F, F.bx, (bf16*)(ws + WS_RV));
        { const int w0 = F.bx * NWAVES + F.wave, nw = F.G * NWAVES;
            transpose_kv_tiles(F, (const bf16*)(ws + WS_KV6 + 3 * KV_STRIDE), (bf16*)args.out, w0, nw);
            transpose_kv_tiles(F, (const bf16*)(ws + WS_KV6 + 5 * KV_STRIDE), (bf16*)((unsigned char*)args.out + KV_STRIDE), w0, nw);
            transpose_memv_tiles(F, (bf16*)(ws + WS_MEMVT), w0, nw); }
        __syncthreads();
        { SchedCmp S{ws, 0, F.G, F.bx}; EpiCmp E{(float*)args.out + (size_t)16 * MiB};
            pg8::gemm_phase<EpiCmp, SchedCmp, false>(F.lds, 512, 2048, 4096, S, E); }
    } SEAM(2);
    if (IN(3)) { p2b_compress_out(F, args); } SEAM(3);
    if (IN(4)) { p3_ret_normalize(F); p3_nsa_fast(F, (const bf16*)args.out, (const bf16*)((const unsigned char*)args.out + KV_STRIDE), (bf16*)((unsigned char*)args.out + 64 * MiB)); } SEAM(4);
    if (IN(5)) {
        SchedP4 S{ws, F.G, F.bx, (const char*)args.out + 64 * MiB};
        EpiP4 E{(float*)(ws + WS_P4SCR) + (size_t)F.bx * (2 * 32 * 512 * 4), (bf16*)(ws + WS_Y)};
        pg8::gemm_phase<EpiP4, SchedP4, false>(F.lds, D, D, D, S, E);
    } SEAM(5);
    if (IN(6)) {
        SchedMN S{ws, WS_Y, W_OUT, F.G, F.bx}; EpiRes<true> E{args.in[IN_X], nullptr, nullptr, (bf16*)(ws + WS_X1B), (float*)(ws + WS_SSQ)};
        pg8::gemm_phase<EpiRes<true>, SchedMN, false>(F.lds, D, D, D, S, E);
    } SEAM(6);
    if (IN(7)) {
        const bool early = ((F.bx >> 3) & 1) == 0;
        if (early) expert_copies(F, args, 0, NEXP / 2);
        SchedMN S{ws, WS_X1B, W_XQ, F.G, F.bx}; EpiQ E{(const float*)(ws + WS_SSQ), (bf16*)(ws + WS_NQ)};
        pg8::gemm_phase<EpiQ, SchedMN, false>(F.lds, D, D, D, S, E);
        if (!early) { __syncthreads(); expert_copies(F, args, 0, NEXP / 2); }
    } SEAM(7);
    if (IN(8)) { p7_xattn_fast(F, (const bf16*)(ws + WS_MEMVT), (bf16*)(ws + WS_NQ)); } SEAM(8);
    if (IN(9)) {
        const bool early = ((F.bx >> 3) & 1) == 0;
        if (early) expert_copies(F, args, NEXP / 2, NEXP);
        SchedMN S{ws, WS_NQ, W_XO, F.G, F.bx}; EpiRes<false> E{nullptr, (const bf16*)(ws + WS_X1B), args.out, (bf16*)(ws + WS_X2B), nullptr};
        pg8::gemm_phase<EpiRes<false>, SchedMN, false>(F.lds, D, D, D, S, E);
        if (!early) { __syncthreads(); expert_copies(F, args, NEXP / 2, NEXP); }
    } SEAM(9);
    if (IN(10)) { p9_route(F, args); } SEAM(10);
    if (IN(11)) {
        moe_tiles(F);
        SchedMoe<0> S{F.MISC, ws, F.G, F.bx}; EpiMoe1 E{(const float*)(ws + WS_ROUTE) + 2 * NTOK, (bf16*)(ws + WS_H1)};
        pg8::gemm_phase<EpiMoe1, SchedMoe<0>, true>(F.lds, D, D, D, S, E);
    } SEAM(11);
    if (IN(12)) {
        moe_tiles(F);
        SchedMoe<1> S{F.MISC, ws, F.G, F.bx}; EpiMoe2 E{(const float*)(ws + WS_ROUTE), (bf16*)(ws + WS_YS0), (bf16*)(ws + WS_YS1)};
        pg8::gemm_phase<EpiMoe2, SchedMoe<1>, false>(F.lds, DEXP, DEXP, DEXP, S, E);
    } SEAM(12);
    if (IN(13)) { p12_final(F, args); }
#undef IN
#undef SEAM
}

extern "C" void kernel_launch(void* const* d_in, const int* in_sizes, int n_in, void* d_out, int out_size, void* d_ws, size_t ws_size, hipStream_t stream) {
    static int grid = 0;
    if (grid == 0) {
        if (n_in != 27 || in_sizes[0] != NTOK * D || out_size != NTOK * D || ws_size < WS_END) {
            fprintf(stderr, "kernel_launch: unexpected shapes: n_in %d in0 %d out %d ws %zu (need %zu)\n", n_in, n_in > 0 ? in_sizes[0] : -1, out_size, ws_size, (size_t)WS_END); grid = -1; return; }
        int dev = 0, cus = 0, per_cu = 0;
        if (hipGetDevice(&dev) != hipSuccess || hipDeviceGetAttribute(&cus, hipDeviceAttributeMultiprocessorCount, dev) != hipSuccess) { grid = -1; return; }
        if (hipFuncSetAttribute((const void*)fwd, hipFuncAttributeMaxDynamicSharedMemorySize, LDS_BYTES) != hipSuccess) { fprintf(stderr, "kernel_launch: hipFuncSetAttribute failed\n"); grid = -1; return; }
        if (hipOccupancyMaxActiveBlocksPerMultiprocessor(&per_cu, (const void*)fwd, NTHREADS, LDS_BYTES) != hipSuccess || per_cu < 1) fprintf(stderr, "kernel_launch: occupancy query reports %d\n", per_cu);
        (void)hipGetLastError();
        grid = cus < 256 ? cus : 256;
    }
    if (grid < 0) return;
    (void)hipMemsetAsync((char*)d_ws + WS_CTL, 0, CTL_ZERO_BYTES, stream);
    Args a{};
    for (int i = 0; i < 27; ++i) a.in[i] = (const float*)d_in[i];
    a.out = (float*)d_out; a.ws = (unsigned char*)d_ws;
#if MK_N_LAUNCHES == 1
    a.ph_lo = 0; a.ph_hi = N_PHASES;
    hipLaunchKernelGGL(fwd, dim3(grid), dim3(NTHREADS), LDS_BYTES, stream, a);
#else
    for (int p = 0; p < N_PHASES; ++p) { a.ph_lo = p; a.ph_hi = p + 1; hipLaunchKernelGGL(fwd, dim3(grid), dim3(NTHREADS), LDS_BYTES, stream, a); }
#endif
}
```

```cpp
#include <hip/hip_runtime.h>
#include <cstdio>
#include <cstdint>

#ifndef MK_N_LAUNCHES
#define MK_N_LAUNCHES 1
#endif

#define LAS __attribute__((address_space(3)))
#define GAS __attribute__((address_space(1)))
#define HD __host__ __device__
#define HDI __host__ __device__ __attribute__((always_inline)) inline
typedef unsigned short bf16;
typedef short bf16x8 __attribute__((ext_vector_type(8)));
typedef float f32x4 __attribute__((ext_vector_type(4)));
typedef float f32x2 __attribute__((ext_vector_type(2)));
typedef float f32x16 __attribute__((ext_vector_type(16)));
typedef unsigned u32x4 __attribute__((ext_vector_type(4)));
typedef unsigned u32x2 __attribute__((ext_vector_type(2)));

constexpr int D = 1024, BATCH = 8, SEQ = 4096, NTOK = BATCH * SEQ, NMEM = 256, NMEMTOK = BATCH * NMEM;
constexpr int DIN = 7704;
constexpr int C_RQ = 0, C_RK = 512, C_RV = 1024, C_RG = 2048, C_NQ = 3072, C_CK = 4096, C_NGL = 5632, C_GA = 5656, C_GB = 6680;
constexpr int NPROJ = 5632;
constexpr int NEXP = 32, DEXP = 512;
constexpr float EPS = 1e-6f;
constexpr int NWAVES = 8, NTHREADS = 512;

constexpr size_t MiB = 1u << 20;
constexpr size_t WS_CTL = 0, CTL_ZERO_BYTES = 1 * MiB;
constexpr size_t WS_ROPE_COS = 1 * MiB, WS_ROPE_SIN = 2 * MiB;
constexpr size_t WS_RTW = 3 * MiB + 512 * 1024;
constexpr size_t WS_SMALLW = 3 * MiB;
constexpr size_t WS_MEMVT = 24 * MiB;
constexpr size_t WS_KCMP = 4 * MiB, WS_VCMP = 5 * MiB, WS_VCMPT = 35 * MiB;
constexpr size_t WS_GATES = 10 * MiB;
constexpr size_t WS_SSQ = 13 * MiB;
constexpr size_t WS_ROUTE = 15 * MiB;
constexpr size_t WS_LISTS = 16 * MiB;
constexpr size_t WS_W = 36 * MiB;
constexpr size_t W_IN = WS_W;
constexpr size_t W_GA = W_IN + 11 * MiB, W_GB = W_GA + 2 * MiB;
constexpr size_t W_RO = W_GB + 2 * MiB, W_NO = W_RO + 2 * MiB, W_OUT = W_NO + 2 * MiB, W_XQ = W_OUT + 2 * MiB, W_XO = W_XQ + 2 * MiB;
constexpr size_t W_XKV = W_XO + 2 * MiB;
constexpr size_t W_C1K = W_XKV + 4 * MiB, W_C1V = W_C1K + 2 * MiB;
constexpr size_t WS_MEMN = W_C1V + 2 * MiB;
constexpr size_t WS_MEMKV = WS_MEMN + 4 * MiB;
constexpr size_t WS_H = 84 * MiB;
constexpr size_t WS_NQ = WS_H + 64 * MiB;
constexpr size_t WS_RV = WS_NQ + 64 * MiB;
constexpr size_t WS_RQ = WS_RV + 64 * MiB;
constexpr size_t WS_RK = WS_RQ + 32 * MiB;
constexpr size_t WS_RG = WS_RK + 32 * MiB;
constexpr size_t WS_KV6 = WS_RG + 64 * MiB;
constexpr size_t KV_STRIDE = 16 * MiB;
constexpr size_t WS_END = WS_KV6 + 96 * MiB;
constexpr size_t WS_Y = WS_RQ, WS_P4SCR = WS_RG, WS_W13 = WS_RQ, WS_W2 = WS_RG, WS_H1 = WS_KV6, WS_X1B = WS_H, WS_X2B = WS_RV, WS_YS0 = WS_H, WS_YS1 = WS_NQ;
static_assert(WS_MEMKV + 8 * MiB <= WS_H && WS_VCMPT + 1 * MiB <= WS_W && WS_MEMVT + 4 * MiB <= WS_VCMPT, "ws map");
constexpr int CW_BAR = 4096;
constexpr int CW_ECNT = 16384;
constexpr int LDS_BYTES = 147456, RING_BYTES = 131072, MISC_OFF = RING_BYTES + 320;

HD inline float bf2f(bf16 b) { return __builtin_bit_cast(float, (unsigned)b << 16); }
HD inline unsigned f2bf(float f) { unsigned u = __builtin_bit_cast(unsigned, f); return (u + 0x7fffu + ((u >> 16) & 1u)) >> 16; }
HD inline unsigned pk2(float lo, float hi) { return f2bf(lo) | (f2bf(hi) << 16); }
HD inline float lo16(unsigned w) { return __builtin_bit_cast(float, w << 16); }
HD inline float hi16(unsigned w) { return __builtin_bit_cast(float, w & 0xffff0000u); }
__device__ __forceinline__ unsigned cvt_pk_bf16(float lo, float hi) { unsigned r; asm volatile("v_cvt_pk_bf16_f32 %0, %1, %2" : "=v"(r) : "v"(lo), "v"(hi)); return r; }
#define DPP_F(v, ctrl, rmask) __builtin_bit_cast(float, __builtin_amdgcn_update_dpp(0, __builtin_bit_cast(int, v), ctrl, rmask, 0xf, false))
__device__ __forceinline__ float wave_sum(float v) {
    v += DPP_F(v, 0xB1, 0xf);
    v += DPP_F(v, 0x4E, 0xf);
    v += DPP_F(v, 0x141, 0xf);
    v += DPP_F(v, 0x140, 0xf);
    v += DPP_F(v, 0x142, 0xa);
    v += DPP_F(v, 0x143, 0xc);
    return __builtin_bit_cast(float, __builtin_amdgcn_readlane(__builtin_bit_cast(int, v), 63));
}
__device__ __forceinline__ float wave_max(float v) {
#pragma unroll
    for (int o = 1; o < 64; o <<= 1) v = fmaxf(v, __shfl_xor(v, o));
    return v;
}
__device__ __forceinline__ float sigmoidf_(float x) { return __builtin_amdgcn_rcpf(1.0f + __builtin_amdgcn_exp2f(-1.4426950408889634f * x)); }
#define LAUNDER(p) asm volatile("" : "+v"(p))
#define LDS_WAIT() asm volatile("s_waitcnt lgkmcnt(0)" ::: "memory")
#define VM_WAIT() asm volatile("s_waitcnt vmcnt(0)" ::: "memory")

#define XB_TMO      128
#define XB_XCNT(j)  (256  + 64 * (j))
#define XB_XSUB(j)  (1280 + 64 * (j))
#define XB_XGEN(j)  (2304 + 64 * (j))
#define XB_TOP      3328
#define XB_TOPGEN   3392
#define XCD_BAR_WORDS 3456
#define XB_SPIN_CAP (1u << 24)
__device__ __forceinline__ unsigned xb_ld(unsigned* p)              { return __hip_atomic_load(p, __ATOMIC_RELAXED, __HIP_MEMORY_SCOPE_AGENT); }
__device__ __forceinline__ unsigned xb_add(unsigned* p, unsigned v) { return __hip_atomic_fetch_add(p, v, __ATOMIC_RELAXED, __HIP_MEMORY_SCOPE_AGENT); }
__device__ __forceinline__ unsigned xb_xcc_id() { return (unsigned)__builtin_amdgcn_s_getreg((3 << 11) | 20) & 0xFu; }
#define XB_SPIN(cond, bar) do { unsigned _sp = 0; while (cond) { __builtin_amdgcn_s_sleep(1); \
    if ((++_sp & 255u) == 0u) { if (xb_ld(&(bar)[XB_TMO])) break; if (_sp > XB_SPIN_CAP) { atomicAdd(&(bar)[XB_TMO], 1u); break; } } } } while (0)
struct XcdBarrier { unsigned* bar; unsigned x; volatile LAS unsigned* st; };
__device__ __forceinline__ XcdBarrier xcd_barrier_post(unsigned* bar, volatile LAS unsigned* st) {
    XcdBarrier b; b.bar = bar; b.x = xb_xcc_id(); b.st = st;
    if (threadIdx.x == 0) (void)xb_add(&bar[XB_XCNT(b.x)], 1u);
    return b;
}
__device__ __forceinline__ void xcd_barrier_complete(unsigned* bar, unsigned x, unsigned& nloc, unsigned& nx) {
    const unsigned G = gridDim.x * gridDim.y * gridDim.z;
    unsigned sum, cnt, mine, sp = 0u;
    for (;;) {
        sum = 0u; cnt = 0u; mine = 0u;
#pragma unroll
        for (unsigned j = 0; j < 16; ++j) { const unsigned c = xb_ld(&bar[XB_XCNT(j)]); sum += c; cnt += (c > 0u) ? 1u : 0u; mine = (j == x) ? c : mine; }
        if (sum == G) break;
        __builtin_amdgcn_s_sleep(1);
        if ((++sp & 255u) == 0u) { if (xb_ld(&bar[XB_TMO])) break; if (sp > XB_SPIN_CAP) { atomicAdd(&bar[XB_TMO], 1u); break; } }
    }
    nloc = mine > 0u ? mine : 1u; nx = cnt > 0u ? cnt : 1u;
}
__device__ __forceinline__ void xcd_barrier(const XcdBarrier& b) {
    asm volatile("s_waitcnt vmcnt(0)" ::: "memory");
    __syncthreads();
    if (threadIdx.x == 0) {
        unsigned* bar = b.bar;
        __builtin_amdgcn_s_waitcnt(0);
        unsigned nloc = b.st[0], nx = b.st[1];
        if (nloc == 0u) { xcd_barrier_complete(bar, b.x, nloc, nx); b.st[0] = nloc; b.st[1] = nx; }
        const unsigned old = xb_add(&bar[XB_XSUB(b.x)], 1u);
        const unsigned gen = old / nloc;
        if (old + 1u == (gen + 1u) * nloc) {
            __builtin_amdgcn_fence(__ATOMIC_RELEASE, "agent");
            asm volatile("s_waitcnt vmcnt(0)" ::: "memory");
            const unsigned og = xb_add(&bar[XB_TOP], 1u);
            const unsigned tg = og / nx;
            if (og + 1u == (tg + 1u) * nx) xb_add(&bar[XB_TOPGEN], 1u);
            else XB_SPIN(xb_ld(&bar[XB_TOPGEN]) == tg, bar);
            __builtin_amdgcn_fence(__ATOMIC_ACQUIRE, "agent");
            xb_add(&bar[XB_XGEN(b.x)], 1u);
            asm volatile("s_waitcnt vmcnt(0)" ::: "memory");
        } else {
            XB_SPIN(xb_ld(&bar[XB_XGEN(b.x)]) == gen, bar);
            __builtin_amdgcn_fence(__ATOMIC_ACQUIRE, "agent");
            asm volatile("s_waitcnt vmcnt(0)" ::: "memory");
        }
    }
    __syncthreads();
}

namespace pg8 {
constexpr int BM = 256, BK = 64, HALF = 128, HTB = HALF * BK * 2, NXCD = 8, WGM = 8;
HD __forceinline__ int lds_byte(int r, int c) { const int st = (r >> 4) * 2 + (c >> 5), rr = r & 15, cc = c & 31, ob = rr * 64 + cc * 2; return st * 1024 + (ob ^ (((ob >> 9) & 1) << 5)); }
HD __forceinline__ void stage_rc(int b, int& R, int& C) { const int st = b / 1024, sb = b % 1024, swz = sb ^ (((sb >> 9) & 1) << 5); R = (st >> 1) * 16 + swz / 64; C = (st & 1) * 32 + (swz % 64) / 2; }
HD __forceinline__ int perm32(int rho) { const int n = rho >> 4, i = rho & 15; return 8 * (i >> 2) + 4 * n + (i & 3); }
HD __forceinline__ void tile_map(int L, int nM, int nN, int& pm, int& pn) {
    const int nwg = nM * nN; int wgid = L; { const int q = nwg / NXCD, r = nwg % NXCD, xcd = wgid % NXCD, off = wgid / NXCD; wgid = (xcd < r ? xcd * (q + 1) : r * (q + 1) + (xcd - r) * q) + off; }
    const int nig = WGM * nN, gid = wgid / nig, fm = gid * WGM, gsz = (nM - fm) < WGM ? (nM - fm) : WGM;
    pm = fm + ((wgid % nig) % gsz); pn = (wgid % nig) / gsz;
}
struct GU { const char* A; const char* B; const int* rows; int nvalid; int kind, pm, pn, aux; };
template <class Epi, class Sched, bool GATHER>
__device__ __forceinline__ void gemm_phase(LAS unsigned char* lds, const int K, const int lda, const int ldb, const Sched& S, const Epi& E) {
    int tid_ = threadIdx.x; LAUNDER(tid_);
    const int tid = tid_, wid = __builtin_amdgcn_readfirstlane(tid >> 6), lane = tid & 63, wr = wid >> 2, wc = wid & 3, fr = lane & 15, fq = lane >> 4;
    const int nt = K / BK;
    unsigned voffB[2];
#pragma unroll
    for (int i = 0; i < 2; ++i) { int R, C; stage_rc(tid * 16 + i * 8192, R, C); const int Rb = Epi::PERM ? ((R & ~31) + perm32(R & 31)) : R; voffB[i] = (unsigned)(Rb * ldb + C) * 2u; }
    const size_t kstep = (size_t)(BK * 2);
    const size_t hstepB = (size_t)HALF * ldb * 2;
    const unsigned ldsw = (unsigned)wid * 1024u;
    const int aoff = lds_byte(wr * 64 + fr, fq * 8), boff = lds_byte(wc * 32 + fr, fq * 8);
#define PG8_SA(b, h) (((b) * 2 + (h)) * HTB)
#define PG8_SB(b, h) ((4 + (b) * 2 + (h)) * HTB)
#define PG8_STAGE2(bufoff, gbase, v0, v1) do { \
        __builtin_amdgcn_global_load_lds((const unsigned*)((const char*)(gbase) + (v0)), (LAS unsigned*)(lds + (bufoff) + ldsw), 16, 0, 0); \
        __builtin_amdgcn_global_load_lds((const unsigned*)((const char*)(gbase) + (v1)), (LAS unsigned*)(lds + (bufoff) + ldsw + 8192), 16, 0, 0); } while (0)
#define PG8_STAGEB(bufoff, gbase) PG8_STAGE2(bufoff, gbase, voffB[0], voffB[1])
#define PG8_LDA(dst, b, h) do { _Pragma("unroll") for (int m = 0; m < 4; ++m) _Pragma("unroll") for (int k = 0; k < 2; ++k) dst[m][k] = *(const LAS bf16x8*)(lds + PG8_SA(b, h) + aoff + m * 2048 + k * 1024); } while (0)
#define PG8_LDB(dst, b, h) do { _Pragma("unroll") for (int n = 0; n < 2; ++n) _Pragma("unroll") for (int k = 0; k < 2; ++k) dst[n][k] = *(const LAS bf16x8*)(lds + PG8_SB(b, h) + boff + n * 2048 + k * 1024); } while (0)
#define PG8_MMA(ai, bj, At, Bt) do { __builtin_amdgcn_s_setprio(1); _Pragma("unroll") for (int m = 0; m < 4; ++m) _Pragma("unroll") for (int n = 0; n < 2; ++n) _Pragma("unroll") for (int k = 0; k < 2; ++k) \
        acc[ai][bj][m][n] = __builtin_amdgcn_mfma_f32_16x16x32_bf16(Bt[n][k], At[m][k], acc[ai][bj][m][n], 0, 0, 0); __builtin_amdgcn_s_setprio(0); } while (0)
#define PG8_WAIT_V(n) asm volatile("s_waitcnt vmcnt(" #n ")" ::: "memory")
#define PG8_WAIT_L(n) asm volatile("s_waitcnt lgkmcnt(" #n ")" ::: "memory")
#define PG8_BAR __builtin_amdgcn_s_barrier()
#define PG8_SCHED __builtin_amdgcn_sched_barrier(0)
#define PG8_VOFFA(u, vo) do { _Pragma("unroll") for (int h = 0; h < 2; ++h) _Pragma("unroll") for (int i = 0; i < 2; ++i) { int R_, C_; stage_rc(tid * 16 + i * 8192, R_, C_); const int R = R_ + HALF * h; \
        int ridx = R; if (GATHER) { ridx = (R < (u).nvalid) ? ((u).rows[R] >> 1) : 0; } vo[h][i] = (unsigned)(ridx * lda + C_) * 2u; } if (GATHER) asm volatile("" :: "v"(vo[0][0]), "v"(vo[0][1]), "v"(vo[1][0]), "v"(vo[1][1])); } while (0)
    GU cur, nxt; int ui = 0;
    if (!S.next(0, cur)) return;
    f32x4 acc[2][2][4][2];
#pragma unroll
    for (int a = 0; a < 2; ++a)
#pragma unroll
        for (int b = 0; b < 2; ++b)
#pragma unroll
            for (int m = 0; m < 4; ++m)
#pragma unroll
                for (int n = 0; n < 2; ++n) acc[a][b][m][n] = (f32x4){0.f, 0.f, 0.f, 0.f};
    bf16x8 At[4][2], B0[2][2], B1[2][2];
    unsigned cv[2][2], nv[2][2];
    PG8_VOFFA(cur, cv);
    const char* cA = cur.A; const char* cB = cur.B;
    PG8_STAGEB(PG8_SB(0, 0), cB); PG8_STAGEB(PG8_SB(0, 1), cB + hstepB); PG8_STAGE2(PG8_SA(0, 0), cA, cv[0][0], cv[0][1]); PG8_STAGE2(PG8_SA(0, 1), cA, cv[1][0], cv[1][1]);
    if (wr == 1) PG8_BAR;
    PG8_WAIT_V(2); PG8_BAR;
    PG8_STAGEB(PG8_SB(1, 0), cB + kstep); PG8_STAGE2(PG8_SA(1, 0), cA + kstep, cv[0][0], cv[0][1]); PG8_STAGEB(PG8_SB(1, 1), cB + hstepB + kstep);
    PG8_WAIT_V(6); PG8_BAR;
    for (;;) {
        const bool has_next = S.next(ui + 1, nxt);
        const char* nA = has_next ? nxt.A : cA; const char* nB = has_next ? nxt.B : cB;
        if (has_next) { PG8_VOFFA(nxt, nv); } else {
#pragma unroll
            for (int h = 0; h < 2; ++h)
#pragma unroll
                for (int i = 0; i < 2; ++i) nv[h][i] = cv[h][i]; }
        for (int t = 0; t < nt; t += 2) {
            const bool last = (t == nt - 2);
            const char* a1 = cA + (size_t)(t + 1) * kstep;
            const char* a2 = last ? nA : cA + (size_t)(t + 2) * kstep; const char* b2 = last ? nB : cB + (size_t)(t + 2) * kstep;
            const char* a3 = a2 + kstep; const char* b3 = b2 + kstep;
            const unsigned w00 = last ? nv[0][0] : cv[0][0], w01 = last ? nv[0][1] : cv[0][1], w10 = last ? nv[1][0] : cv[1][0], w11 = last ? nv[1][1] : cv[1][1];
            PG8_LDB(B0, 0, 0); PG8_LDB(B1, 0, 1); PG8_SCHED; PG8_LDA(At, 0, 0); PG8_STAGE2(PG8_SA(1, 1), a1, cv[1][0], cv[1][1]);
            PG8_WAIT_V(8); PG8_WAIT_L(0); PG8_BAR; PG8_MMA(0, 0, At, B0); PG8_MMA(0, 1, At, B1); PG8_BAR; PG8_SCHED;
            PG8_LDA(At, 0, 1); PG8_STAGEB(PG8_SB(0, 0), b2); PG8_STAGEB(PG8_SB(0, 1), b2 + hstepB); PG8_STAGE2(PG8_SA(0, 0), a2, w00, w01);
            PG8_WAIT_V(8); PG8_WAIT_L(0); PG8_BAR; PG8_MMA(1, 0, At, B0); PG8_MMA(1, 1, At, B1); PG8_BAR; PG8_SCHED;
            PG8_LDB(B0, 1, 0); PG8_LDB(B1, 1, 1); PG8_SCHED; PG8_LDA(At, 1, 0); PG8_STAGE2(PG8_SA(0, 1), a2, w10, w11);
            PG8_WAIT_V(8); PG8_WAIT_L(0); PG8_BAR; PG8_MMA(0, 0, At, B0); PG8_MMA(0, 1, At, B1); PG8_BAR; PG8_SCHED;
            PG8_LDA(At, 1, 1); PG8_STAGEB(PG8_SB(1, 0), b3); PG8_STAGEB(PG8_SB(1, 1), b3 + hstepB); PG8_STAGE2(PG8_SA(1, 0), a3, w00, w01);
            PG8_WAIT_V(8); PG8_WAIT_L(0); PG8_BAR; PG8_MMA(1, 0, At, B0); PG8_MMA(1, 1, At, B1); PG8_BAR; PG8_SCHED;
        }
        if (wr == 0) PG8_BAR;
        E(acc, cur, wr, wc, fr, fq);
        if (!has_next) break;
#pragma unroll
        for (int a = 0; a < 2; ++a)
#pragma unroll
            for (int b = 0; b < 2; ++b)
#pragma unroll
                for (int m = 0; m < 4; ++m)
#pragma unroll
                    for (int n = 0; n < 2; ++n) acc[a][b][m][n] = (f32x4){0.f, 0.f, 0.f, 0.f};
        cur = nxt; cA = nA; cB = nB; ++ui;
#pragma unroll
        for (int h = 0; h < 2; ++h)
#pragma unroll
            for (int i = 0; i < 2; ++i) cv[h][i] = nv[h][i];
        if (wr == 1) PG8_BAR;
    }
    PG8_WAIT_V(0);
    PG8_BAR;
#undef PG8_SA
#undef PG8_SB
#undef PG8_STAGE2
#undef PG8_STAGEB
#undef PG8_LDA
#undef PG8_LDB
#undef PG8_MMA
#undef PG8_WAIT_V
#undef PG8_WAIT_L
#undef PG8_BAR
#undef PG8_SCHED
#undef PG8_VOFFA
}
}
using pg8::GU;

struct Args {
    const float* in[27]; float* out; unsigned char* ws; int ph_lo, ph_hi; int pad0, pad1;
};
enum { IN_X = 0, IN_MEM, IN_NORM_MIX_G, IN_W_IN, IN_W_RET_O, IN_W_NSA_O, IN_W_OUT, IN_CMP_PE_K, IN_CMP_W1_K, IN_CMP_W2_K, IN_CMP_PE_V, IN_CMP_W1_V, IN_CMP_W2_V,
       IN_NORM_X_G, IN_NORM_MEM_G, IN_W_XQ, IN_W_XKV, IN_W_XO, IN_NORM_FFN_G, IN_W_GRP, IN_B_GRP, IN_W_RT, IN_B_RT, IN_W_E1, IN_W_E3, IN_W_E2, IN_NORM_F_G };
struct Frame {
    LAS unsigned char* lds; volatile LAS unsigned* MISC; unsigned* ctl; unsigned char* ws;
    int tid, lane, wave, G, bx;
};

__device__ __forceinline__ bool phase_begin(Frame& F) { int t = threadIdx.x; LAUNDER(t); F.tid = t; F.lane = t & 63; return true; }
__device__ __forceinline__ void transpose_item(const float* W, int ldw, int c0, int k0, bf16* WT, int ldt, int mode, int row_off, int cbase, const float* kscale, float scale, LAS float* scr, int lane) {
    float vv[32];
#pragma unroll
    for (int i = 0; i < 32; ++i) { const int kk = 2 * i + (lane >> 5); vv[i] = W[(size_t)(k0 + kk) * ldw + c0 + (lane & 31)]; }
    if (kscale) {
#pragma unroll
        for (int i = 0; i < 32; ++i) { const int kk = 2 * i + (lane >> 5); vv[i] *= kscale[k0 + kk]; } }
#pragma unroll
    for (int i = 0; i < 32; ++i) { const int kk = 2 * i + (lane >> 5); scr[kk * 33 + (lane & 31)] = vv[i] * scale; }
    LDS_WAIT(); asm volatile("" ::: "memory");
    const int c = lane & 7;
#pragma unroll
    for (int j = 0; j < 4; ++j) { const int n = (lane >> 3) + 8 * j; const LAS float* s = scr + (8 * c) * 33 + n;
        u32x4 o; o.x = pk2(s[0 * 33], s[1 * 33]); o.y = pk2(s[2 * 33], s[3 * 33]); o.z = pk2(s[4 * 33], s[5 * 33]); o.w = pk2(s[6 * 33], s[7 * 33]);
        const int jc = c0 - cbase + n; const int drow = mode == 0 ? row_off + jc : (8 * (jc >> 2) + 4 * row_off + (jc & 3));
        *(u32x4*)(WT + (size_t)drow * ldt + k0 + 8 * c) = o; }
    LDS_WAIT(); asm volatile("" ::: "memory");
}
__device__ __forceinline__ void transpose_matrix(Frame& F, int& item_base, const float* W, int ldw, int K, int cbase, int ncols, bf16* WT, int ldt, int mode, int row_off, const float* kscale, float scale) {
    LAS float* scr = (LAS float*)(F.lds + F.wave * 16384);
    const int gw = F.bx * NWAVES + F.wave, NGW = F.G * NWAVES;
    const int nb = ncols / 32, nitems = (K / 64) * nb;
    int it = (gw - item_base % NGW + NGW) % NGW;
    for (; it < nitems; it += NGW) transpose_item(W, ldw, cbase + 32 * (it % nb), 64 * (it / nb), WT, ldt, mode, row_off, cbase, kscale, scale, scr, F.lane);
    item_base += nitems;
}
__device__ __forceinline__ void rms_row_to_bf16(int lane, const float* xrow, const float* g, bf16* orow) {
    const f32x4* xr = (const f32x4*)xrow + lane; const f32x4* gr = (const f32x4*)g + lane;
    f32x4 v[4]; float s = 0.f;
#pragma unroll
    for (int j = 0; j < 4; ++j) { v[j] = xr[64 * j]; s += (v[j].x * v[j].x + v[j].y * v[j].y) + (v[j].z * v[j].z + v[j].w * v[j].w); }
    const float rstd = 1.0f / sqrtf(wave_sum(s) * (1.f / D) + EPS);
    unsigned long long* o8 = (unsigned long long*)orow + lane;
#pragma unroll
    for (int j = 0; j < 4; ++j) { const f32x4 gg = gr[64 * j];
        o8[64 * j] = (unsigned long long)pk2(v[j].x * rstd * gg.x, v[j].y * rstd * gg.y) | ((unsigned long long)pk2(v[j].z * rstd * gg.z, v[j].w * rstd * gg.w) << 32); }
}

struct XItem { const float* src; bf16* dst; const float* ks; float scale; int ldw, ldt, mode, row_off, csrc, c0, k0, has_ks; };
__device__ __forceinline__ void xitem_decode_expert(const Args& a, unsigned char* ws, int it, XItem& x) {
    const int e = it / 768, r = it % 768, which = r >> 8, t = r & 255;
    x.ks = a.in[IN_NORM_FFN_G]; x.scale = 1.0f;
    if (which < 2) { x.src = a.in[which ? IN_W_E3 : IN_W_E1] + (size_t)e * D * DEXP; x.ldw = DEXP; x.dst = (bf16*)(ws + WS_W13) + (size_t)e * D * D; x.ldt = D; x.mode = 1; x.row_off = which; x.has_ks = 1; x.c0 = 32 * (t & 15); x.k0 = 64 * (t >> 4); }
    else { x.src = a.in[IN_W_E2] + (size_t)e * DEXP * D; x.ldw = D; x.dst = (bf16*)(ws + WS_W2) + (size_t)e * D * DEXP; x.ldt = DEXP; x.mode = 0; x.row_off = 0; x.has_ks = 0; x.c0 = 32 * (t & 31); x.k0 = 64 * (t >> 5); }
    x.csrc = x.c0;
}
constexpr int P0_NITEMS = 7936;
__device__ __forceinline__ void xitem_decode_p0(const Args& a, unsigned char* ws, int it, XItem& x) {
    int in_ = IN_W_IN, ldw = DIN, cb = 0, nc = 512, ldt = D, ro = 0, first = 0; size_t dst = W_IN; float sc = 1.0f; int hk = 0;
#define P0E(FIRST, IN__, LDW, CB, NC, DST, LDT, RO, SC, HK) if (it >= (FIRST)) { in_ = (IN__); ldw = (LDW); cb = (CB); nc = (NC); dst = (DST); ldt = (LDT); ro = (RO); sc = (SC); hk = (HK); first = (FIRST); }
    P0E(256, IN_W_IN, DIN, 512, 512, W_IN, D, 512, 0.08838834764831845f, 0)
    P0E(512, IN_W_IN, DIN, 1024, NPROJ - 1024, W_IN, D, 1024, 1.0f, 0)
    P0E(2816, IN_W_IN, DIN, C_GA, 1024, W_GA, D, 0, 1.0f, 0)
    P0E(3328, IN_W_IN, DIN, C_GB, 1024, W_GB, D, 0, 1.0f, 0)
    P0E(3840, IN_W_RET_O, D, 0, D, W_RO, D, 0, 1.0f, 0)
    P0E(4352, IN_W_NSA_O, D, 0, D, W_NO, D, 0, 1.0f, 0)
    P0E(4864, IN_W_OUT, D, 0, D, W_OUT, D, 0, 1.0f, 0)
    P0E(5376, IN_W_XQ, D, 0, D, W_XQ, D, 0, 1.0f, 1)
    P0E(5888, IN_W_XO, D, 0, D, W_XO, D, 0, 1.0f, 0)
    P0E(6400, IN_W_XKV, 2 * D, 0, 2 * D, W_XKV, D, 0, 1.0f, 0)
    P0E(7424, IN_CMP_W1_K, 128, 0, 128, W_C1K, 4096, 0, 1.0f, 0)
    P0E(7680, IN_CMP_W1_V, 128, 0, 128, W_C1V, 4096, 0, 1.0f, 0)
#undef P0E
    const int t = it - first, nb = nc >> 5;
    x.src = a.in[in_]; x.dst = (bf16*)(ws + dst); x.ks = a.in[IN_NORM_X_G]; x.scale = sc; x.ldw = ldw; x.ldt = ldt; x.mode = 0; x.row_off = ro; x.has_ks = hk;
    x.c0 = 32 * (t % nb); x.csrc = cb + x.c0; x.k0 = 64 * (t / nb);
}
__device__ __forceinline__ void xitem_load(const XItem& x, int lane, float (&vv)[32], f32x4& k0v, f32x4& k1v) {
#pragma unroll
    for (int i = 0; i < 32; ++i) { const int kk = 2 * i + (lane >> 5); vv[i] = x.src[(size_t)(x.k0 + kk) * x.ldw + x.csrc + (lane & 31)]; }
    const f32x4* p = (const f32x4*)(x.ks + ((x.k0 + 8 * (lane & 7)) & 1023)); k0v = p[0]; k1v = p[1];
}
__device__ __forceinline__ void xitem_finish(const XItem& x, int lane, const float (&vv)[32], f32x4 k0v, f32x4 k1v, LAS float* scr) {
    if (!x.has_ks) { k0v = (f32x4){1.f, 1.f, 1.f, 1.f}; k1v = k0v; }
    k0v *= x.scale; k1v *= x.scale;
#pragma unroll
    for (int i = 0; i < 32; ++i) { const int kk = 2 * i + (lane >> 5); scr[kk * 33 + (lane & 31)] = vv[i]; }
    LDS_WAIT(); asm volatile("" ::: "memory");
    const int c = lane & 7;
#pragma unroll
    for (int j = 0; j < 4; ++j) { const int n = (lane >> 3) + 8 * j; const LAS float* s = scr + (8 * c) * 33 + n;
        u32x4 o; o.x = pk2(s[0 * 33] * k0v.x, s[1 * 33] * k0v.y); o.y = pk2(s[2 * 33] * k0v.z, s[3 * 33] * k0v.w); o.z = pk2(s[4 * 33] * k1v.x, s[5 * 33] * k1v.y); o.w = pk2(s[6 * 33] * k1v.z, s[7 * 33] * k1v.w);
        const int jc = x.c0 + n; const int drow = x.mode == 0 ? x.row_off + jc : (8 * (jc >> 2) + 4 * x.row_off + (jc & 3));
        *(u32x4*)(x.dst + (size_t)drow * x.ldt + x.k0 + 8 * c) = o; }
    LDS_WAIT(); asm volatile("" ::: "memory");
}
template <bool EXPERT>
__device__ __forceinline__ void run_items(Frame& F, const Args& a, int it_begin, int it_end) {
    LAS float* scr = (LAS float*)(F.lds + F.wave * 16384);
    const int gw = F.bx * NWAVES + F.wave, NGW = F.G * NWAVES, lane = F.lane;
    int it = it_begin + gw;
#define XDEC(i_, x_) do { if (EXPERT) xitem_decode_expert(a, F.ws, (i_), x_); else xitem_decode_p0(a, F.ws, (i_), x_); } while (0)
    if (it < it_end) {
        float va[32], vb[32]; f32x4 ka0, ka1, kb0, kb1; XItem xa, xb;
        XDEC(it, xa); xitem_load(xa, lane, va, ka0, ka1);
        for (;;) {
            int itn = it + NGW; bool hn = itn < it_end;
            XDEC(hn ? itn : it, xb); xitem_load(xb, lane, vb, kb0, kb1);
            xitem_finish(xa, lane, va, ka0, ka1, scr);
            if (!hn) break;
            it = itn; itn = it + NGW; hn = itn < it_end;
            XDEC(hn ? itn : it, xa); xitem_load(xa, lane, va, ka0, ka1);
            xitem_finish(xb, lane, vb, kb0, kb1, scr);
            if (!hn) break;
            it = itn;
        }
    }
#undef XDEC
    __syncthreads();
}
__device__ __forceinline__ void expert_copies(Frame& F, const Args& a, int e_lo, int e_hi) { run_items<true>(F, a, e_lo * 768, e_hi * 768); }

__device__ __forceinline__ void p0_prologue(Frame& F, const Args& a) {
    unsigned char* ws = F.ws;
    const float* w_in = a.in[IN_W_IN];
    run_items<false>(F, a, 0, P0_NITEMS);
    const int gt = F.bx * NTHREADS + F.tid, NGT = F.G * NTHREADS;
    for (int i = gt; i < 2 * 128 * 4096 / 8; i += NGT) { const int m = i / (128 * 4096 / 8), r = i % (128 * 4096 / 8);
        *(u32x4*)(ws + (m ? W_C1V : W_C1K) + (size_t)128 * 4096 * 2 + (size_t)r * 16) = (u32x4){0u, 0u, 0u, 0u}; }
    bf16* wngl = (bf16*)(ws + WS_SMALLW);
    for (int i = gt; i < 32 * 1024; i += NGT) { const int r = i >> 10, k = i & 1023; wngl[i] = r < 24 ? (bf16)f2bf(w_in[(size_t)k * DIN + C_NGL + r]) : (bf16)0; }
    bf16* w2k = (bf16*)(ws + WS_SMALLW + 65536); bf16* w2v = w2k + 128 * 128;
    for (int i = gt; i < 2 * 128 * 128; i += NGT) { const int m = i >> 14, r = i & 16383, f = r >> 7, e = r & 127; const float* src = a.in[m ? IN_CMP_W2_V : IN_CMP_W2_K];
        (m ? w2v : w2k)[f * 128 + e] = (bf16)f2bf(src[e * 128 + f]); }
    { const float* gff = a.in[IN_NORM_FFN_G]; const float* wgrp = a.in[IN_W_GRP]; const float* wrt = a.in[IN_W_RT]; float* wgp = (float*)(ws + WS_RTW); float* wep = wgp + 4096;
      for (int i = gt; i < 4096; i += NGT) wgp[i] = gff[i >> 2] * wgrp[i];
      for (int i = gt; i < 32768; i += NGT) { const int j = i & 3, l = (i >> 2) & 63, half = (i >> 8) & 1, ii = (i >> 9) & 15, grp = i >> 13, k = 64 * ii + l; wep[i] = gff[k] * wrt[k * 32 + grp * 8 + half * 4 + j]; } }
    float* cpart = (float*)(ws + WS_SMALLW + 196608);
    const int gw = F.bx * NWAVES + F.wave, NGW = F.G * NWAVES;
    for (int o = gw; o < 128; o += NGW) { const int m = o >> 6, kb = o & 63; const float* pe = a.in[m ? IN_CMP_PE_V : IN_CMP_PE_K] + kb * 64; const float* w1 = a.in[m ? IN_CMP_W1_V : IN_CMP_W1_K] + (size_t)kb * 64 * 128;
        float s0 = 0.f, s1 = 0.f;
#pragma unroll 16
        for (int k = 0; k < 64; ++k) { const float p = pe[k]; s0 += p * w1[k * 128 + F.lane]; s1 += p * w1[k * 128 + 64 + F.lane]; }
        cpart[(size_t)o * 128 + F.lane] = s0; cpart[(size_t)o * 128 + 64 + F.lane] = s1; }
    float* cosT = (float*)(ws + WS_ROPE_COS); float* sinT = (float*)(ws + WS_ROPE_SIN);
    for (int i = gt; i < SEQ * 64; i += NGT) { const int pos = i >> 6, j = i & 63; const float inv = powf(10000.0f, -(float)(2 * j) / 128.0f); const float ang = (float)pos * inv;
        cosT[i] = cosf(ang); sinT[i] = sinf(ang); }
    { f32x4 nx[2][4]; const float* X = a.in[IN_X]; const f32x4* gr = (const f32x4*)a.in[IN_NORM_MIX_G] + F.lane;
#pragma unroll
      for (int q = 0; q < 2; ++q) { const int m0 = gw + q * NGW; const int mm = m0 < NTOK ? m0 : gw;
#pragma unroll
          for (int j = 0; j < 4; ++j) nx[q][j] = ((const f32x4*)(X + (size_t)mm * D) + F.lane)[64 * j]; }
      for (int m = gw; m < NTOK; m += 2 * NGW) { f32x4 v[2][4]; float sq[2] = {0.f, 0.f};
#pragma unroll
          for (int q = 0; q < 2; ++q)
#pragma unroll
              for (int j = 0; j < 4; ++j) { v[q][j] = nx[q][j]; sq[q] += (v[q][j].x * v[q][j].x + v[q][j].y * v[q][j].y) + (v[q][j].z * v[q][j].z + v[q][j].w * v[q][j].w); }
#pragma unroll
          for (int q = 0; q < 2; ++q) { const int m2 = m + (2 + q) * NGW; const int mm = m2 < NTOK ? m2 : m;
#pragma unroll
              for (int j = 0; j < 4; ++j) nx[q][j] = ((const f32x4*)(X + (size_t)mm * D) + F.lane)[64 * j]; }
#pragma unroll
          for (int q = 0; q < 2; ++q) { const int mr = m + q * NGW; if (mr < NTOK) {
              const float rstd = 1.0f / sqrtf(wave_sum(sq[q]) * (1.f / D) + EPS); unsigned long long* o8 = (unsigned long long*)((bf16*)(ws + WS_H) + (size_t)mr * D) + F.lane;
#pragma unroll
              for (int j = 0; j < 4; ++j) { const f32x4 gg = gr[64 * j]; o8[64 * j] = (unsigned long long)pk2(v[q][j].x * rstd * gg.x, v[q][j].y * rstd * gg.y) | ((unsigned long long)pk2(v[q][j].z * rstd * gg.z, v[q][j].w * rstd * gg.w) << 32); } } } } }
    for (int m = gw; m < NMEMTOK; m += NGW) rms_row_to_bf16(F.lane, a.in[IN_MEM] + (size_t)m * D, a.in[IN_NORM_MEM_G], (bf16*)(ws + WS_MEMN) + (size_t)m * D);
}

struct SchedP1 {
    unsigned char* ws; int G, c;
    __device__ __forceinline__ bool next(int i, GU& u) const {
        constexpr int NP = 128 * 22; const int L = i * G + c;
        u.rows = nullptr; u.nvalid = 0; u.aux = 0;
        if (L < NP) { int pm, pn; pg8::tile_map(L, 128, 22, pm, pn); u.A = (const char*)ws + WS_H + (size_t)pm * 256 * D * 2; u.B = (const char*)ws + W_IN + (size_t)pn * 256 * D * 2; u.pm = pm; u.pn = pn;
            u.kind = pn < 2 ? 0 : pn < 4 ? 1 : pn < 8 ? 2 : pn < 12 ? 3 : pn < 16 ? 4 : 5; return true; }
        const int L2 = L - NP; if (L2 >= 64) return false;
        const int pm = L2 & 7, pn = L2 >> 3; u.A = (const char*)ws + WS_MEMN + (size_t)pm * 256 * D * 2; u.B = (const char*)ws + W_XKV + (size_t)pn * 256 * D * 2; u.pm = pm; u.pn = pn; u.kind = 6; return true;
    }
};
struct EpiP1 {
    static constexpr bool PERM = true;
    unsigned char* ws;
    __device__ __forceinline__ void operator()(const f32x4 (&acc)[2][2][4][2], const GU& u, int wr, int wc, int fr, int fq) const {
        const int kind = u.kind;
        const float* cosT = (const float*)(ws + WS_ROPE_COS); const float* sinT = (const float*)(ws + WS_ROPE_SIN);
#pragma unroll
        for (int ai = 0; ai < 2; ++ai)
#pragma unroll
            for (int m = 0; m < 4; ++m) {
                const int r = 128 * ai + 64 * wr + 16 * m + fr; const int tok = u.pm * 256 + r;
#pragma unroll
                for (int bj = 0; bj < 2; ++bj) {
                    f32x4 v0 = acc[ai][bj][m][0], v1 = acc[ai][bj][m][1];
                    const int ct = 128 * bj + 32 * wc + 8 * fq;
                    bf16* dst;
                    if (kind <= 1) {
                        const int s = tok & (SEQ - 1), i0 = ((ct & 127) >> 1);
                        const f32x4 cs = *(const f32x4*)(cosT + s * 64 + i0), sn = *(const f32x4*)(sinT + s * 64 + i0);
                        const f32x4 a0 = v0, a1 = v1;
                        v0[0] = a0[0] * cs[0] - a0[1] * sn[0]; v0[1] = a0[0] * sn[0] + a0[1] * cs[0];
                        v0[2] = a0[2] * cs[1] - a0[3] * sn[1]; v0[3] = a0[2] * sn[1] + a0[3] * cs[1];
                        v1[0] = a1[0] * cs[2] - a1[1] * sn[2]; v1[1] = a1[0] * sn[2] + a1[1] * cs[2];
                        v1[2] = a1[2] * cs[3] - a1[3] * sn[3]; v1[3] = a1[2] * sn[3] + a1[3] * cs[3];
                        dst = (bf16*)(ws + (kind == 0 ? WS_RQ : WS_RK)) + (size_t)tok * 512 + (u.pn & 1) * 256 + ct;
                    } else if (kind == 2) { dst = (bf16*)(ws + WS_RV) + (size_t)tok * 1024 + (u.pn - 4) * 256 + ct;
                    } else if (kind == 3) {
#pragma unroll
                        for (int j = 0; j < 4; ++j) { v0[j] = v0[j] * sigmoidf_(v0[j]); v1[j] = v1[j] * sigmoidf_(v1[j]); }
                        dst = (bf16*)(ws + WS_RG) + (size_t)tok * 1024 + (u.pn - 8) * 256 + ct;
                    } else if (kind == 4) { dst = (bf16*)(ws + WS_NQ) + (size_t)tok * 1024 + (u.pn - 12) * 256 + ct;
                    } else if (kind == 5) {
                        const int b = tok >> 12, s = tok & (SEQ - 1);
                        unsigned char* kvb = ws + WS_KV6 + (size_t)(u.pn - 16) * KV_STRIDE;
                        dst = (bf16*)kvb + ((size_t)(b * 2 + bj) * SEQ + s) * 128 + (ct & 127);
                    } else { dst = (bf16*)(ws + WS_MEMKV) + (size_t)tok * 2048 + u.pn * 256 + ct; }
                    u32x4 w; w.x = cvt_pk_bf16(v0[0], v0[1]); w.y = cvt_pk_bf16(v0[2], v0[3]); w.z = cvt_pk_bf16(v1[0], v1[1]); w.w = cvt_pk_bf16(v1[2], v1[3]);
                    *(u32x4*)dst = w;
                }
            }
    }
};
__device__ __forceinline__ void p1_gate_logits(Frame& F) {
    const bf16* H = (const bf16*)(F.ws + WS_H); const bf16* W = (const bf16*)(F.ws + WS_SMALLW); float* gates = (float*)(F.ws + WS_GATES);
    const int r = F.lane & 31, hh = F.lane >> 5;
    const int nb_ = F.G > 64 ? F.G - 64 : F.G, b0_ = F.G > 64 ? F.bx - 64 : F.bx;
    if (b0_ < 0) return;
    for (int rb = b0_ + nb_ * F.wave; rb < NTOK / 32; rb += nb_ * NWAVES) {
        f32x16 acc; for (int j = 0; j < 16; ++j) acc[j] = 0.f;
        const bf16* ap = H + (size_t)(rb * 32 + r) * D + 8 * hh; const bf16* bp = W + (size_t)r * D + 8 * hh;
        for (int s8 = 0; s8 < 8; ++s8) { bf16x8 av[8], bv[8];
#pragma unroll
            for (int q = 0; q < 8; ++q) { av[q] = *(const bf16x8*)(ap + 16 * (8 * s8 + q)); bv[q] = *(const bf16x8*)(bp + 16 * (8 * s8 + q)); }
#pragma unroll
            for (int q = 0; q < 8; ++q) acc = __builtin_amdgcn_mfma_f32_32x32x16_bf16(av[q], bv[q], acc, 0, 0, 0); }
        if (r < 24) {
#pragma unroll
            for (int reg = 0; reg < 16; ++reg) { const int row = (reg & 3) + 8 * (reg >> 2) + 4 * hh; gates[(size_t)(rb * 32 + row) * 24 + r] = sigmoidf_(acc[reg]); }
        }
    }
}

namespace retf {
constexpr int ROWB = 272;
constexpr int OFF_K = 0, OFF_V = 128 * 256, OFF_ZV = OFF_V + 128 * 64, OFF_ST = OFF_ZV + 128 * 64, OFF_PART = OFF_ST + 32 * ROWB, OFF_Q = OFF_PART + 4 * 4096, OFF_ST2 = OFF_Q + 128 * 256;
static_assert(OFF_ST2 + 32 * ROWB <= RING_BYTES, "retention LDS map");
typedef short s16x4 __attribute__((ext_vector_type(4)));
__device__ __forceinline__ u32x2 lds_tr(const LAS unsigned char* p) { return __builtin_bit_cast(u32x2, __builtin_amdgcn_ds_read_tr16_b64_v4i16((LAS s16x4*)p)); }
#define RET_RD1(dst, addr, off) asm volatile("ds_read_b128 %0, %1 offset:%2" : "=v"(dst) : "v"(addr), "i"(off))
#define RET_RD2(set, addr, o0, o1) do { RET_RD1(set[0], addr, o0); RET_RD1(set[1], addr, o1); } while (0)
#define RET_TR(dst, addr, off) asm volatile("ds_read_b64_tr_b16 %0, %1 offset:%2" : "=v"(dst) : "v"(addr), "i"(off))
#define RET_WAIT2(n, set) asm volatile("s_waitcnt lgkmcnt(" #n ")" : "+v"(set[0]), "+v"(set[1]))
#define RET_MMA2(acc, set, s0) do { acc = __builtin_amdgcn_mfma_f32_32x32x16_bf16(__builtin_bit_cast(bf16x8, set[0]), qf[s0], acc, 0, 0, 0); acc = __builtin_amdgcn_mfma_f32_32x32x16_bf16(__builtin_bit_cast(bf16x8, set[1]), qf[(s0) + 1], acc, 0, 0, 0); } while (0)
}
__device__ __forceinline__ void p2_retention_fast(Frame& F, int unit, bf16* outbase) {
    using namespace retf;
    const int bh = (unit & 7) * 4 + (unit >> 6), sl = (unit >> 3) & 7, b = bh >> 2, h = bh & 3;
    const bf16* rq = (const bf16*)(F.ws + WS_RQ); const bf16* rk = (const bf16*)(F.ws + WS_RK); const bf16* rv = (const bf16*)(F.ws + WS_RV);
    const int tid = F.tid, lane = F.lane, wave = F.wave, r = lane & 31, hi = lane >> 5; LAS unsigned char* lds = F.lds;
    const float lg = log2f(1.0f - exp2f(-5.0f - (float)h));
    const int nt = wave & 3, mh = wave >> 2;
    for (int i = tid; i < 32 * ROWB / 4; i += NTHREADS) { ((LAS unsigned*)(lds + OFF_ST))[i] = 0u; ((LAS unsigned*)(lds + OFF_ST2))[i] = 0u; }
    f32x16 ST;
#pragma unroll
    for (int j = 0; j < 16; ++j) ST[j] = 0.f;
    const float gC = exp2f(128.0f * lg);
    const float zeta = exp2f((float)(127 - (tid >> 2)) * lg);
    const int blk = (lane >> 4) & 1, q4 = (lane & 15) >> 2, p4 = lane & 3;
    const int vtr = (4 * hi + q4) * 64 + 32 * blk + 8 * p4;
    const int ztr = (8 * hi + q4) * 64 + 32 * blk + 8 * p4;
    int ktr[2];
#pragma unroll
    for (int t = 0; t < 2; ++t) ktr[t] = 256 * (8 * hi + 4 * t + q4) + 16 * ((4 * nt + 2 * blk + (p4 >> 1)) ^ ((q4 << 2) | ((2 * hi + t) & 3))) + 8 * (p4 & 1);
    const int krow = 256 * r + 16 * (hi ^ (((r & 3) << 2) | ((r >> 2) & 3)));
    u32x4 kreg[4], qreg[4], vreg;
    {   const int tok0 = b * SEQ;
#pragma unroll
        for (int i = 0; i < 4; ++i) { const int p = tid + 512 * i, m = p >> 4, cc = p & 15; kreg[i] = *(const u32x4*)(rk + (size_t)(tok0 + m) * 512 + h * 128 + cc * 8); qreg[i] = *(const u32x4*)(rq + (size_t)(tok0 + m) * 512 + h * 128 + cc * 8); }
        { const int m = tid >> 2, cc = tid & 3; vreg = *(const u32x4*)(rv + (size_t)(tok0 + m) * 1024 + h * 256 + sl * 32 + cc * 8); } }
    u32x2 opk[4]; bf16* oprev = outbase;
#pragma unroll
    for (int i = 0; i < 4; ++i) opk[i] = (u32x2){0u, 0u};
    for (int c = 0; c < SEQ / 128; ++c) {
        const int tok0 = b * SEQ + c * 128;
#pragma unroll
        for (int i = 0; i < 4; ++i) { const int p = tid + 512 * i, m = p >> 4, cc = p & 15; const int o_ = 256 * m + 16 * (cc ^ (((m & 3) << 2) | ((m >> 2) & 3)));
            *(LAS u32x4*)(lds + OFF_K + o_) = kreg[i]; *(LAS u32x4*)(lds + OFF_Q + o_) = qreg[i]; }
        { const u32x4 v = vreg; u32x4 zv;
            zv.x = cvt_pk_bf16(lo16(v.x) * zeta, hi16(v.x) * zeta); zv.y = cvt_pk_bf16(lo16(v.y) * zeta, hi16(v.y) * zeta); zv.z = cvt_pk_bf16(lo16(v.z) * zeta, hi16(v.z) * zeta); zv.w = cvt_pk_bf16(lo16(v.w) * zeta, hi16(v.w) * zeta);
            *(LAS u32x4*)(lds + OFF_V + tid * 16) = v; *(LAS u32x4*)(lds + OFF_ZV + tid * 16) = zv; }
        __syncthreads();
        if (mh == 0 && c > 0) {
#pragma unroll
            for (int i = 0; i < 4; ++i) *(u32x2*)(oprev + 8 * i + 4 * hi) = opk[i]; }
        if (c + 1 < SEQ / 128) { const int tok1 = tok0 + 128;
#pragma unroll
            for (int i = 0; i < 4; ++i) { const int p = tid + 512 * i, m = p >> 4, cc = p & 15; kreg[i] = *(const u32x4*)(rk + (size_t)(tok1 + m) * 512 + h * 128 + cc * 8); qreg[i] = *(const u32x4*)(rq + (size_t)(tok1 + m) * 512 + h * 128 + cc * 8); }
            { const int m = tid >> 2, cc = tid & 3; vreg = *(const u32x4*)(rv + (size_t)(tok1 + m) * 1024 + h * 256 + sl * 32 + cc * 8); } }
        bf16x8 qf[8];
#pragma unroll
        for (int s_ = 0; s_ < 8; ++s_) qf[s_] = *(const LAS bf16x8*)(lds + OFF_Q + 8192 * nt + (krow ^ (32 * s_)));
        f32x16 CR;
#pragma unroll
        for (int j = 0; j < 16; ++j) CR[j] = 0.f;
        if (mh == 0) {
            const unsigned sa = (unsigned)(size_t)(lds + ((c & 1) ? OFF_ST2 : OFF_ST) + r * ROWB + 16 * hi);
            u32x4 fa[2], fb[2];
            RET_RD2(fa, sa, 0, 32); RET_RD2(fb, sa, 64, 96);
            RET_WAIT2(2, fa); RET_MMA2(CR, fa, 0); RET_RD2(fa, sa, 128, 160);
            RET_WAIT2(2, fb); RET_MMA2(CR, fb, 2); RET_RD2(fb, sa, 192, 224);
            RET_WAIT2(2, fa); RET_MMA2(CR, fa, 4);
            RET_WAIT2(0, fb); RET_MMA2(CR, fb, 6);
        }
        if (mh == 1) {
#pragma unroll
            for (int j = 0; j < 16; ++j) ST[j] *= gC;
#pragma unroll
            for (int s_ = 0; s_ < 8; ++s_) {
                const LAS unsigned char* zp = lds + OFF_ZV + ztr + (16 * s_) * 64; const u32x2 z0 = lds_tr(zp), z1 = lds_tr(zp + 4 * 64);
                const u32x2 k0 = lds_tr(lds + OFF_K + ktr[0] + 4096 * s_), k1 = lds_tr(lds + OFF_K + ktr[1] + 4096 * s_);
                ST = __builtin_amdgcn_mfma_f32_32x32x16_bf16(__builtin_bit_cast(bf16x8, (u32x4){z0.x, z0.y, z1.x, z1.y}), __builtin_bit_cast(bf16x8, (u32x4){k0.x, k0.y, k1.x, k1.y}), ST, 0, 0, 0); }
#pragma unroll
            for (int j = 0; j < 16; ++j) { const int dv = (j & 3) + 8 * (j >> 2) + 4 * hi; ((LAS unsigned short*)(lds + ((c & 1) ? OFF_ST : OFF_ST2)))[dv * (ROWB / 2) + 32 * nt + r] = (unsigned short)f2bf(ST[j]); }
        }
        f32x16 IN_;
#pragma unroll
        for (int j = 0; j < 16; ++j) IN_[j] = 0.f;
#pragma unroll
        for (int mi = 0; mi < 2; ++mi) { const int mt = 2 * mh + mi;
            if (mt <= nt) {
                f32x16 A;
#pragma unroll
                for (int j = 0; j < 16; ++j) A[j] = 0.f;
                {   const unsigned kb_ = (unsigned)(size_t)(lds + OFF_K) + 8192u * (unsigned)mt;
                    u32x4 fa[2], fb[2];
#define RET_KRD2(set, s0) do { RET_RD1(set[0], kb_ + (unsigned)(krow ^ (32 * (s0))), 0); RET_RD1(set[1], kb_ + (unsigned)(krow ^ (32 * ((s0) + 1))), 0); } while (0)
                    RET_KRD2(fa, 0); RET_KRD2(fb, 2);
                    RET_WAIT2(2, fa); RET_MMA2(A, fa, 0); RET_KRD2(fa, 4);
                    RET_WAIT2(2, fb); RET_MMA2(A, fb, 2); RET_KRD2(fb, 6);
                    RET_WAIT2(2, fa); RET_MMA2(A, fa, 4);
                    RET_WAIT2(0, fb); RET_MMA2(A, fb, 6);
#undef RET_KRD2
                }
#pragma unroll
                for (int j = 0; j < 16; ++j) { const int dd = (32 * nt + r) - (32 * mt + (j & 3) + 8 * (j >> 2) + 4 * hi); A[j] = dd >= 0 ? A[j] * __builtin_amdgcn_exp2f((float)dd * lg) : 0.f; }
#pragma unroll
                for (int s2 = 0; s2 < 2; ++s2) { u32x4 w; w.x = cvt_pk_bf16(A[8 * s2 + 0], A[8 * s2 + 1]); w.y = cvt_pk_bf16(A[8 * s2 + 2], A[8 * s2 + 3]); w.z = cvt_pk_bf16(A[8 * s2 + 4], A[8 * s2 + 5]); w.w = cvt_pk_bf16(A[8 * s2 + 6], A[8 * s2 + 7]);
                    const LAS unsigned char* vp = lds + OFF_V + vtr + (32 * mt + 16 * s2) * 64; const u32x2 lo = lds_tr(vp), hi2 = lds_tr(vp + 8 * 64);
                    IN_ = __builtin_amdgcn_mfma_f32_32x32x16_bf16(__builtin_bit_cast(bf16x8, (u32x4){lo.x, lo.y, hi2.x, hi2.y}), __builtin_bit_cast(bf16x8, w), IN_, 0, 0, 0); }
            } }
        if (mh == 1) {
#pragma unroll
            for (int j = 0; j < 16; ++j) ((LAS float*)(lds + OFF_PART))[(nt * 16 + j) * 64 + lane] = IN_[j];
        }
        __syncthreads();
        if (mh == 0) {
            const float xi = __builtin_amdgcn_exp2f((float)(32 * nt + r + 1) * lg);
            bf16* orow = outbase + (size_t)(tok0 + 32 * nt + r) * 1024 + h * 256 + sl * 32;
#pragma unroll
            for (int q4_ = 0; q4_ < 4; ++q4_) { float o_[4];
#pragma unroll
                for (int e = 0; e < 4; ++e) { const int j = 4 * q4_ + e; o_[e] = IN_[j] + ((const LAS float*)(lds + OFF_PART))[(nt * 16 + j) * 64 + lane] + xi * CR[j]; }
                opk[q4_] = (u32x2){cvt_pk_bf16(o_[0], o_[1]), cvt_pk_bf16(o_[2], o_[3])}; }
            oprev = orow;
        }
    }
    if (mh == 0) {
#pragma unroll
        for (int i = 0; i < 4; ++i) *(u32x2*)(oprev + 8 * i + 4 * hi) = opk[i]; }
    __syncthreads();
}
__device__ __forceinline__ void transpose_kv_tiles(Frame& F, const bf16* src, bf16* dst, int w0, int nw) {
    LAS unsigned short* tl_ = (LAS unsigned short*)(F.lds + F.wave * 16384); const int lane = F.lane;
    for (int tile = w0; tile < 16 * 64 * 2; tile += nw) {
        const int dh = tile & 1, st = (tile >> 1) & 63, bg = tile >> 7;
        const bf16* sp = src + ((size_t)bg * SEQ + st * 64) * 128 + dh * 64; bf16* dp = dst + ((size_t)bg * 128 + dh * 64) * SEQ + st * 64;
#pragma unroll
        for (int i = 0; i < 8; ++i) { const int row = i * 8 + (lane >> 3), c = lane & 7; const u32x4 v = *(const u32x4*)(sp + (size_t)row * 128 + c * 8); LAS unsigned short* q = tl_ + row * 66 + c * 8;
            q[0] = (unsigned short)(v.x & 0xffffu); q[1] = (unsigned short)(v.x >> 16); q[2] = (unsigned short)(v.y & 0xffffu); q[3] = (unsigned short)(v.y >> 16);
            q[4] = (unsigned short)(v.z & 0xffffu); q[5] = (unsigned short)(v.z >> 16); q[6] = (unsigned short)(v.w & 0xffffu); q[7] = (unsigned short)(v.w >> 16); }
        LDS_WAIT(); asm volatile("" ::: "memory");
#pragma unroll
        for (int i = 0; i < 8; ++i) { const int d = i * 8 + (lane >> 3), c = lane & 7; const LAS unsigned short* q = tl_ + (c * 8) * 66 + d;
            u32x4 o; o.x = (unsigned)q[0] | ((unsigned)q[66] << 16); o.y = (unsigned)q[2 * 66] | ((unsigned)q[3 * 66] << 16); o.z = (unsigned)q[4 * 66] | ((unsigned)q[5 * 66] << 16); o.w = (unsigned)q[6 * 66] | ((unsigned)q[7 * 66] << 16);
            *(u32x4*)(dp + (size_t)d * SEQ + c * 8) = o; }
        LDS_WAIT(); asm volatile("" ::: "memory");
    }
}
struct SchedCmp {
    unsigned char* ws; int first, G, c;
    __device__ __forceinline__ bool next(int i, GU& u) const {
        const int L = i * G + c - first; if (L < 0 || L >= 256) return false;
        const int ks = L & 7, mb = L >> 3, m = mb >> 4, bg = mb & 15;
        u.A = (const char*)ws + WS_KV6 + (size_t)m * KV_STRIDE + (size_t)bg * SEQ * 128 * 2 + (size_t)ks * 512 * 2; u.B = (const char*)ws + (m ? W_C1V : W_C1K) + (size_t)ks * 512 * 2;
        u.pm = mb; u.pn = 0; u.kind = ks; u.rows = nullptr; u.nvalid = 0; u.aux = 0; return true;
    }
};
struct EpiCmp {
    static constexpr bool PERM = false;
    float* hid;
    __device__ __forceinline__ void operator()(const f32x4 (&acc)[2][2][4][2], const GU& u, int wr, int wc, int fr, int fq) const {
#pragma unroll
        for (int ai = 0; ai < 2; ++ai)
#pragma unroll
            for (int m = 0; m < 4; ++m) { const int r = 128 * ai + 64 * wr + 16 * m + fr; float* rowp = hid + (size_t)u.kind * (32 * 256 * 128) + ((size_t)u.pm * 256 + r) * 128 + 32 * wc + 4 * fq;
#pragma unroll
                for (int n = 0; n < 2; ++n) *(f32x4*)(rowp + 16 * n) = acc[ai][0][m][n]; }
    }
};
__device__ __forceinline__ float gelu_tanh(float x) { const float u = 0.7978845608028654f * (x + 0.044715f * x * x * x); return 0.5f * x * (1.0f + tanhf(u)); }
__device__ __forceinline__ void p2b_compress_out(Frame& F, const Args& a) {
    const float* hid = (const float*)a.out + (size_t)16 * MiB; const float* cpart = (const float*)(F.ws + WS_SMALLW + 196608);
    const int gw = F.bx * NWAVES + F.wave, NGW = F.G * NWAVES, lane = F.lane;
    for (int m = 0; m < 2; ++m) {
        const float* w2 = a.in[m ? IN_CMP_W2_V : IN_CMP_W2_K];
        float cb[2] = {0.f, 0.f};
#pragma unroll 16
        for (int kb = 0; kb < 64; ++kb) { cb[0] += cpart[(size_t)(m * 64 + kb) * 128 + lane]; cb[1] += cpart[(size_t)(m * 64 + kb) * 128 + 64 + lane]; }
        for (int base = m * 4096 + gw; base < (m + 1) * 4096; base += 2 * NGW) {
            float gv[2][2], o[2][2]; int rows[2]; bool valid[2];
#pragma unroll
            for (int q = 0; q < 2; ++q) { const int row = base + q * NGW; rows[q] = row; valid[q] = row < (m + 1) * 4096; const int n = row & 255;
#pragma unroll
                for (int h2 = 0; h2 < 2; ++h2) { float hsum = 0.f; const int e = lane + 64 * h2;
                    if (valid[q] && n < 255) {
#pragma unroll
                        for (int ks = 0; ks < 8; ++ks) hsum += hid[(size_t)ks * (32 * 256 * 128) + (size_t)row * 128 + e];
                        gv[q][h2] = gelu_tanh(hsum + cb[h2]); } else gv[q][h2] = 0.f; }
                o[q][0] = 0.f; o[q][1] = 0.f; }
#pragma unroll
            for (int h2 = 0; h2 < 2; ++h2) {
#pragma unroll 8
                for (int e = 0; e < 64; ++e) { const float wa = w2[(64 * h2 + e) * 128 + lane], wb = w2[(64 * h2 + e) * 128 + 64 + lane];
#pragma unroll
                    for (int q = 0; q < 2; ++q) { const float g = __builtin_bit_cast(float, __builtin_amdgcn_readlane(__builtin_bit_cast(int, gv[q][h2]), e)); o[q][0] += g * wa; o[q][1] += g * wb; } } }
#pragma unroll
            for (int q = 0; q < 2; ++q) if (valid[q]) { const int row = rows[q], n = row & 255;
                bf16* dst = (bf16*)(F.ws + (m ? WS_VCMP : WS_KCMP)) + (size_t)(row & 4095) * 128;
                dst[lane] = (bf16)f2bf(o[q][0]); dst[64 + lane] = (bf16)f2bf(o[q][1]);
                if (m == 1) { bf16* dt = (bf16*)(F.ws + WS_VCMPT) + (size_t)((row >> 8) & 15) * 128 * 256 + n; dt[(size_t)lane * 256] = (bf16)f2bf(o[q][0]); dt[(size_t)(64 + lane) * 256] = (bf16)f2bf(o[q][1]); } }
        }
    }
}

__device__ __forceinline__ void p3_ret_normalize(Frame& F) {
    bf16* rv = (bf16*)(F.ws + WS_RV); const bf16* rg = (const bf16*)(F.ws + WS_RG);
    const int gw = F.bx * NWAVES + F.wave, NGW = F.G * NWAVES;
    for (int it = gw; it < NTOK * 4; it += NGW) {
        u32x2* p = (u32x2*)(rv + (size_t)it * 256) + F.lane; const u32x2 w = *p; const u32x2 gq = *((const u32x2*)(rg + (size_t)it * 256) + F.lane);
        const float o0 = lo16(w.x), o1 = hi16(w.x), o2 = lo16(w.y), o3 = hi16(w.y);
        const float ss = wave_sum((o0 * o0 + o1 * o1) + (o2 * o2 + o3 * o3));
        const float r = 1.0f / sqrtf(ss * (1.0f / 256.0f) + EPS);
        u32x2 q; q.x = pk2(o0 * r * lo16(gq.x), o1 * r * hi16(gq.x)); q.y = pk2(o2 * r * lo16(gq.y), o3 * r * hi16(gq.y)); *p = q;
    }
}
namespace nsaf {
constexpr int KROW = 272, VROW = 136, KT_BYTES = 64 * KROW, VT_BYTES = 128 * VROW;
constexpr int OFF_K = 0, OFF_V = KT_BYTES, BUF_BYTES = KT_BYTES + VT_BYTES, OFF_IMP = 2 * BUF_BYTES, OFF_MASK = OFF_IMP + 64 * 64 * 4;
constexpr float NEG = -1.0e30f, MASKED = -3.0e38f, CS = 0.08838834764831845f * 1.4426950408889634f;
struct Stage { u32x4 k0, k1, v0, v1; };
__device__ __forceinline__ void stage_load(Stage& st, const bf16* K, const bf16* VT, size_t vpitch, int key0, int tid) {
    const int r0 = tid >> 4, c0 = tid & 15;
    st.k0 = *(const u32x4*)(K + (size_t)(key0 + r0) * 128 + c0 * 8); st.k1 = *(const u32x4*)(K + (size_t)(key0 + r0 + 32) * 128 + c0 * 8);
    const int d0 = tid >> 3, c1 = tid & 7;
    st.v0 = *(const u32x4*)(VT + (size_t)d0 * vpitch + key0 + c1 * 8); st.v1 = *(const u32x4*)(VT + (size_t)(d0 + 64) * vpitch + key0 + c1 * 8);
}
__device__ __forceinline__ void stage_write(const Stage& st, LAS unsigned char* lds, int tid) {
    const int r0 = tid >> 4, c0 = tid & 15;
    *(LAS u32x4*)(lds + OFF_K + r0 * KROW + c0 * 16) = st.k0; *(LAS u32x4*)(lds + OFF_K + (r0 + 32) * KROW + c0 * 16) = st.k1;
    const int d0 = tid >> 3, c1 = tid & 7;
    LAS unsigned char* p0 = lds + OFF_V + d0 * VROW + c1 * 16; LAS unsigned char* p1 = lds + OFF_V + (d0 + 64) * VROW + c1 * 16;
    *(LAS u32x2*)p0 = (u32x2){st.v0.x, st.v0.y}; *(LAS u32x2*)(p0 + 8) = (u32x2){st.v0.z, st.v0.w};
    *(LAS u32x2*)p1 = (u32x2){st.v1.x, st.v1.y}; *(LAS u32x2*)(p1 + 8) = (u32x2){st.v1.z, st.v1.w};
}
template <int MODE>
__device__ __forceinline__ void block_step(const LAS unsigned char* lds, LAS unsigned char* ldstab, const bf16x8 (&qf)[8], f32x16 (&O)[4], float& m, float& l, int blk, int jfast, int tl_in, int itile, int nvr_in, bool rowsel, float inv_l, int lane_in) {
    int tl = tl_in, nvr = nvr_in, lane = lane_in; LAUNDER(tl); LAUNDER(nvr); LAUNDER(lane);
    const int r = lane & 31, hi = lane >> 5;
    f32x16 S[2];
#pragma unroll
    for (int kh = 0; kh < 2; ++kh) {
#pragma unroll
        for (int j = 0; j < 16; ++j) S[kh][j] = 0.f;
    }
    {
        const unsigned kaddr = (unsigned)(size_t)(lds + OFF_K + r * KROW + 16 * hi);
        u32x4 ka[4], kb[4];
#define NSAF_KRD(dst, t, s4) asm volatile("ds_read_b128 %0, %1 offset:%2" : "=v"(dst) : "v"(kaddr), "i"((t) * 32 * KROW + (s4) * 32))
#define NSAF_KRD4(set, t, s0) do { NSAF_KRD(set[0], t, (s0)); NSAF_KRD(set[1], t, (s0) + 1); NSAF_KRD(set[2], t, (s0) + 2); NSAF_KRD(set[3], t, (s0) + 3); } while (0)
#define NSAF_KWAIT(n, set) asm volatile("s_waitcnt lgkmcnt(" #n ")" : "+v"(set[0]), "+v"(set[1]), "+v"(set[2]), "+v"(set[3]))
#define NSAF_KMMA(set, t, s0) do { _Pragma("unroll") for (int q_ = 0; q_ < 4; ++q_) S[t] = __builtin_amdgcn_mfma_f32_32x32x16_bf16(__builtin_bit_cast(bf16x8, set[q_]), qf[(s0) + q_], S[t], 0, 0, 0); } while (0)
        NSAF_KRD4(ka, 0, 0); NSAF_KRD4(kb, 0, 4);
        NSAF_KWAIT(4, ka); NSAF_KMMA(ka, 0, 0); NSAF_KRD4(ka, 1, 0);
        NSAF_KWAIT(4, kb); NSAF_KMMA(kb, 0, 4); NSAF_KRD4(kb, 1, 4);
        NSAF_KWAIT(4, ka); NSAF_KMMA(ka, 1, 0);
        NSAF_KWAIT(0, kb); NSAF_KMMA(kb, 1, 4);
#undef NSAF_KRD
#undef NSAF_KRD4
#undef NSAF_KWAIT
#undef NSAF_KMMA
    }
    bool need_mask;
    if (MODE <= 1) need_mask = true; else if (MODE == 2) need_mask = (blk == itile); else need_mask = (blk == itile) || (blk == itile - 8);
    if (MODE >= 2 && !need_mask && blk >= jfast) {
        const float msub = (MODE == 2 && !rowsel) ? 3.0e38f : m;
        float rs = 0.f;
#pragma unroll
        for (int kh = 0; kh < 2; ++kh)
#pragma unroll
            for (int j = 0; j < 16; ++j) { const float p = __builtin_amdgcn_exp2f(S[kh][j] - msub); S[kh][j] = p; rs += p; }
        l += rs;
    } else {
    float mx = MASKED;
    if (need_mask) {
        int lo_ = -1, hi_ = 63;
        if (MODE <= 1) hi_ = nvr - 64 * blk - 1; else if (MODE == 2) hi_ = tl; else { hi_ = (blk == itile) ? tl : 63; lo_ = (blk == itile - 8) ? tl : -1; }
        lo_ -= 4 * hi; hi_ -= 4 * hi;
#pragma unroll
        for (int kh = 0; kh < 2; ++kh)
#pragma unroll
            for (int j = 0; j < 16; ++j) { const int kc_ = 32 * kh + (j & 3) + 8 * (j >> 2); const bool ok = (kc_ > lo_) & (kc_ <= hi_); const float v = ok ? S[kh][j] : MASKED; S[kh][j] = v; mx = fmaxf(mx, v); }
    } else {
#pragma unroll
        for (int kh = 0; kh < 2; ++kh)
#pragma unroll
            for (int j = 0; j < 16; ++j) mx = fmaxf(mx, S[kh][j]);
    }
    if (MODE == 2) mx = rowsel ? mx : MASKED;
    if (MODE == 1) {
        LAS float* imp = (LAS float*)(ldstab + OFF_IMP) + tl * 64;
        const bool adder = (lane & 3) == 0;
#pragma unroll
        for (int kh = 0; kh < 2; ++kh)
#pragma unroll
            for (int q = 0; q < 4; ++q) {
                float p4[4];
#pragma unroll
                for (int e = 0; e < 4; ++e) { const float p = __builtin_amdgcn_exp2f(S[kh][4 * q + e] - m) * inv_l; S[kh][4 * q + e] = p; p4[e] = p; }
                float sb = (p4[0] + p4[1]) + (p4[2] + p4[3]), sn = p4[3];
                sb += DPP_F(sb, 0xB1, 0xf); sn += DPP_F(sn, 0xB1, 0xf);
                sb += DPP_F(sb, 0x4E, 0xf); sn += DPP_F(sn, 0x4E, 0xf);
                const int bin = 16 * blk + 8 * kh + 2 * q + hi;
                if (adder) { __hip_atomic_fetch_add(imp + bin, sb, __ATOMIC_RELAXED, __HIP_MEMORY_SCOPE_WORKGROUP); if (bin + 1 < 64) __hip_atomic_fetch_add(imp + bin + 1, sn, __ATOMIC_RELAXED, __HIP_MEMORY_SCOPE_WORKGROUP); }
            }
    } else {
        mx = fmaxf(mx, __shfl_xor(mx, 32));
        if (__any(mx > m + 8.0f)) { const float mn = fmaxf(m, mx); const float alpha = __builtin_amdgcn_exp2f(m - mn); m = mn; l *= alpha;
            if (MODE != 0) {
#pragma unroll
                for (int dt = 0; dt < 4; ++dt)
#pragma unroll
                    for (int j = 0; j < 16; ++j) O[dt][j] *= alpha; } }
        float rs = 0.f;
        if (MODE == 2) {
#pragma unroll
            for (int kh = 0; kh < 2; ++kh)
#pragma unroll
                for (int j = 0; j < 16; ++j) { const float p = rowsel ? __builtin_amdgcn_exp2f(S[kh][j] - m) : 0.f; S[kh][j] = p; rs += p; }
        } else {
#pragma unroll
            for (int kh = 0; kh < 2; ++kh)
#pragma unroll
                for (int j = 0; j < 16; ++j) { const float p = __builtin_amdgcn_exp2f(S[kh][j] - m); S[kh][j] = p; rs += p; }
        }
        l += rs;
        if (MODE == 0) return;
    }
    }
    bf16x8 pf[2][2];
#pragma unroll
    for (int kh = 0; kh < 2; ++kh)
#pragma unroll
        for (int s2 = 0; s2 < 2; ++s2) { u32x4 w; w.x = cvt_pk_bf16(S[kh][8 * s2 + 0], S[kh][8 * s2 + 1]); w.y = cvt_pk_bf16(S[kh][8 * s2 + 2], S[kh][8 * s2 + 3]); w.z = cvt_pk_bf16(S[kh][8 * s2 + 4], S[kh][8 * s2 + 5]); w.w = cvt_pk_bf16(S[kh][8 * s2 + 6], S[kh][8 * s2 + 7]);
            pf[kh][s2] = __builtin_bit_cast(bf16x8, w); }
    {
        const unsigned vaddr = (unsigned)(size_t)(lds + OFF_V + r * VROW + 8 * hi);
        u32x2 va[8], vb[8];
#define NSAF_VRD(dst, dt, i) asm volatile("ds_read_b64 %0, %1 offset:%2" : "=v"(dst) : "v"(vaddr), "i"((dt) * 32 * VROW + ((i) >> 1) * 32 + ((i) & 1) * 16))
#define NSAF_VRD8(set, dt) do { NSAF_VRD(set[0], dt, 0); NSAF_VRD(set[1], dt, 1); NSAF_VRD(set[2], dt, 2); NSAF_VRD(set[3], dt, 3); NSAF_VRD(set[4], dt, 4); NSAF_VRD(set[5], dt, 5); NSAF_VRD(set[6], dt, 6); NSAF_VRD(set[7], dt, 7); } while (0)
#define NSAF_VWAIT(n, set) asm volatile("s_waitcnt lgkmcnt(" #n ")" : "+v"(set[0]), "+v"(set[1]), "+v"(set[2]), "+v"(set[3]), "+v"(set[4]), "+v"(set[5]), "+v"(set[6]), "+v"(set[7]))
#define NSAF_VMMA(set, dt) do { _Pragma("unroll") for (int ks = 0; ks < 4; ++ks) { const u32x4 a_ = (u32x4){set[2 * ks].x, set[2 * ks].y, set[2 * ks + 1].x, set[2 * ks + 1].y}; \
            O[dt] = __builtin_amdgcn_mfma_f32_32x32x16_bf16(__builtin_bit_cast(bf16x8, a_), pf[ks >> 1][ks & 1], O[dt], 0, 0, 0); } } while (0)
        NSAF_VRD8(va, 0); NSAF_VRD8(vb, 1);
        NSAF_VWAIT(8, va); NSAF_VMMA(va, 0); NSAF_VRD8(va, 2);
        NSAF_VWAIT(8, vb); NSAF_VMMA(vb, 1); NSAF_VRD8(vb, 3);
        NSAF_VWAIT(8, va); NSAF_VMMA(va, 2);
        NSAF_VWAIT(0, vb); NSAF_VMMA(vb, 3);
#undef NSAF_VRD
#undef NSAF_VRD8
#undef NSAF_VWAIT
#undef NSAF_VMMA
    }
}
template <int MODE>
__device__ __forceinline__ void run_pass(LAS unsigned char* lds, const bf16* K, const bf16* VT, size_t vpitch, int jb, int je, const bf16x8 (&qf)[8], f32x16 (&O)[4], float& m, float& l, bool allowfast, int tl, int itile, int nvr, unsigned long long selmask, float inv_l, int tid, int lane) {
    Stage st; stage_load(st, K, VT, vpitch, jb * 64, tid); stage_write(st, lds, tid);
    if (jb < je) stage_load(st, K, VT, vpitch, (jb + 1) * 64, tid);
    __syncthreads();
    for (int j = jb; j <= je; ++j) {
        const int cur = (j - jb) & 1;
        if (j < je) { stage_write(st, lds + (cur ^ 1) * BUF_BYTES, tid); if (j + 1 < je) stage_load(st, K, VT, vpitch, (j + 2) * 64, tid); }
        const bool rowsel = (MODE == 2) ? (((selmask >> j) & 1ull) != 0ull) : true;
        if (MODE != 2 || __ballot(rowsel) != 0ull) block_step<MODE>(lds + cur * BUF_BYTES, lds, qf, O, m, l, j, allowfast ? jb + (MODE == 2 ? 1 : 2) : 0x7fffffff, tl, itile, nvr, rowsel, inv_l, lane);
        __syncthreads();
    }
}
}
__device__ __forceinline__ void p3_nsa_fast(Frame& F, const bf16* svT, const bf16* wvT, bf16* outbase) {
    using namespace nsaf;
    unsigned char* ws = F.ws; const int tid = F.tid, lane = F.lane, wave = F.wave; LAS unsigned char* lds = F.lds;
    bf16* nq = (bf16*)(ws + WS_NQ); const float* gates = (const float*)(ws + WS_GATES);
    const int r = lane & 31, hi = lane >> 5, qrow = wave * 32 + r, tl = qrow >> 2, head = qrow & 3;
    unsigned failmask = 0u;
    for (int trip = 0; trip < 2; ++trip) {
    for (int u4 = 0; u4 < 4; ++u4) {
        if (trip == 1 && ((failmask >> u4) & 1u) == 0u) continue;
        const bool allowfast = trip == 0;
        const int pr = (F.bx & 7) * 32 + (F.bx >> 3) + (u4 >> 1) * 256; if (F.bx >= 256) break;
        const int bg = pr >> 5, ii = pr & 31, itile = (u4 & 1) ? (63 - ii) : ii, g = bg & 1, b = bg >> 1;
        const int tok = b * SEQ + itile * 64 + tl, t = itile * 64 + tl;
        const bf16* kc = (const bf16*)(ws + WS_KCMP) + (size_t)bg * 256 * 128; const bf16* vcT = (const bf16*)(ws + WS_VCMPT) + (size_t)bg * 128 * 256;
        const bf16* ks = (const bf16*)(ws + WS_KV6 + 2 * KV_STRIDE) + (size_t)bg * SEQ * 128; const bf16* kw = (const bf16*)(ws + WS_KV6 + 4 * KV_STRIDE) + (size_t)bg * SEQ * 128;
        const bf16* vsT = svT + (size_t)bg * 128 * SEQ; const bf16* vwT = wvT + (size_t)bg * 128 * SEQ;
        __syncthreads();
        for (int i = tid; i < 64 * 64; i += NTHREADS) ((LAS float*)(lds + OFF_IMP))[i] = 0.f;
        bf16x8 qf[8];
        {
            LAS unsigned char* tb_ = lds + wave * 8704;
#pragma unroll
            for (int k_ = 0; k_ < 8; ++k_) { const int rr_ = 4 * k_ + (lane >> 4), ch_ = lane & 15, qr_ = wave * 32 + rr_;
                *(LAS u32x4*)(tb_ + rr_ * 272 + ch_ * 16) = *(const u32x4*)(nq + (size_t)(b * SEQ + itile * 64 + (qr_ >> 2)) * 1024 + g * 512 + (qr_ & 3) * 128 + ch_ * 8); }
            LDS_WAIT(); asm volatile("" ::: "memory");
#pragma unroll
            for (int s_ = 0; s_ < 8; ++s_) { const u32x4 w_ = *(const LAS u32x4*)(tb_ + r * 272 + (16 * s_ + 8 * hi) * 2);
                u32x4 o_; o_.x = cvt_pk_bf16(lo16(w_.x) * CS, hi16(w_.x) * CS); o_.y = cvt_pk_bf16(lo16(w_.y) * CS, hi16(w_.y) * CS); o_.z = cvt_pk_bf16(lo16(w_.z) * CS, hi16(w_.z) * CS); o_.w = cvt_pk_bf16(lo16(w_.w) * CS, hi16(w_.w) * CS);
                qf[s_] = __builtin_bit_cast(bf16x8, o_); }
            __syncthreads();
        }
        const float* gatep = gates + (size_t)tok * 24 + (g * 4 + head) * 3;
        const int nvr = (t >= 31) ? (((t - 31) >> 4) + 1 > 255 ? 255 : ((t - 31) >> 4) + 1) : 0;
        const int jec = ((4 * itile + 2) >> 6) > 3 ? 3 : ((4 * itile + 2) >> 6);
        f32x16 O[4];
#define NSAF_ZERO_O() do { _Pragma("unroll") for (int dt = 0; dt < 4; ++dt) _Pragma("unroll") for (int j = 0; j < 16; ++j) O[dt][j] = 0.f; } while (0)
#define NSAF_ADD2(a_, b_) cvt_pk_bf16(lo16(a_) + lo16(b_), hi16(a_) + hi16(b_))
#define NSAF_ACCUM(coef, FIRST) do { const float cf_ = (coef); LAS unsigned char* tb_ = lds + wave * 8704; \
        _Pragma("unroll") for (int dt = 0; dt < 4; ++dt) { _Pragma("unroll") for (int q4 = 0; q4 < 4; ++q4) \
            *(LAS u32x2*)(tb_ + r * 272 + (32 * dt + 8 * q4 + 4 * hi) * 2) = (u32x2){cvt_pk_bf16(cf_ * O[dt][4 * q4], cf_ * O[dt][4 * q4 + 1]), cvt_pk_bf16(cf_ * O[dt][4 * q4 + 2], cf_ * O[dt][4 * q4 + 3])}; } \
        LDS_WAIT(); asm volatile("" ::: "memory"); \
        _Pragma("unroll 2") for (int k_ = 0; k_ < 8; ++k_) { const int rr_ = 4 * k_ + (lane >> 4), ch_ = lane & 15, qr_ = wave * 32 + rr_; \
            const u32x4 nv_ = *(const LAS u32x4*)(tb_ + rr_ * 272 + ch_ * 16); \
            u32x4* gp_ = (u32x4*)(outbase + (size_t)(b * SEQ + itile * 64 + (qr_ >> 2)) * 1024 + g * 512 + (qr_ & 3) * 128 + ch_ * 8); \
            u32x4 w_ = nv_; if (!(FIRST)) { const u32x4 ov_ = *gp_; w_.x = NSAF_ADD2(nv_.x, ov_.x); w_.y = NSAF_ADD2(nv_.y, ov_.y); w_.z = NSAF_ADD2(nv_.z, ov_.z); w_.w = NSAF_ADD2(nv_.w, ov_.w); } \
            *gp_ = w_; } \
        asm volatile("" ::: "memory"); } while (0)
        float m = NEG, l = 0.f; NSAF_ZERO_O();
        run_pass<0>(lds, kc, vcT, 256, 0, jec, qf, O, m, l, false, tl, itile, nvr, 0ull, 0.f, tid, lane);
        l += __shfl_xor(l, 32); const float invl = l > 0.f ? 1.0f / l : 0.f;
        run_pass<1>(lds, kc, vcT, 256, 0, jec, qf, O, m, l, false, tl, itile, nvr, 0ull, invl, tid, lane);
        NSAF_ACCUM(gatep[0], true);
        __syncthreads();
        for (int tk = 0; tk < 8; ++tk) { const int tokl = wave * 8 + tk; float v = ((const LAS float*)(lds + OFF_IMP))[tokl * 64 + lane];
            const bool forced = (lane == 0) || (lane == itile) || (lane == itile - 1); v = (lane > itile) ? -1.0e4f : (forced ? 1.0e4f : v);
            const unsigned u_ = __builtin_bit_cast(unsigned, v); const unsigned key = (u_ & 0x80000000u) ? ~u_ : (u_ | 0x80000000u);
            unsigned T = 0u;
#pragma unroll
            for (int bb = 31; bb >= 0; --bb) { const unsigned cand = T | (1u << bb); const int cnt = __popcll(__ballot(key >= cand)); T = cnt >= 16 ? cand : T; }
            const unsigned long long gt = __ballot(key > T); unsigned long long eq = __ballot(key == T), keep = 0ull;
            for (int need = 16 - __popcll(gt); need > 0; --need) { const unsigned long long low = eq & (0ull - eq); keep |= low; eq ^= low; }
            const unsigned long long mk = gt | keep;
            if (lane == 0) { ((LAS unsigned*)(lds + OFF_MASK))[tokl * 2] = (unsigned)mk; ((LAS unsigned*)(lds + OFF_MASK))[tokl * 2 + 1] = (unsigned)(mk >> 32); } }
        __syncthreads();
        const unsigned long long selmask = (unsigned long long)((const LAS unsigned*)(lds + OFF_MASK))[tl * 2] | ((unsigned long long)((const LAS unsigned*)(lds + OFF_MASK))[tl * 2 + 1] << 32);
        m = NEG; l = 0.f; NSAF_ZERO_O();
        run_pass<2>(lds, ks, vsT, SEQ, 0, itile, qf, O, m, l, allowfast, tl, itile, 0, selmask, 0.f, tid, lane);
        l += __shfl_xor(l, 32); bool bad = !(l < 1.0e12f);
        NSAF_ACCUM(l > 0.f ? gatep[1] / l : 0.f, false);
        __syncthreads();
        m = NEG; l = 0.f; NSAF_ZERO_O();
        run_pass<3>(lds, kw, vwT, SEQ, itile > 8 ? itile - 8 : 0, itile, qf, O, m, l, allowfast, tl, itile, 0, 0ull, 0.f, tid, lane);
        l += __shfl_xor(l, 32); bad = bad | !(l < 1.0e12f);
        NSAF_ACCUM(l > 0.f ? gatep[2] / l : 0.f, false);
        if (allowfast && __syncthreads_or(bad ? 1 : 0)) failmask |= 1u << u4;
#undef NSAF_ZERO_O
#undef NSAF_ACCUM
#undef NSAF_ADD2
    }
    if (failmask == 0u) break;
    }
    __syncthreads();
}
struct SchedP4 {
    unsigned char* ws; int G, c; const char* nsa;
    __device__ __forceinline__ bool next(int i, GU& u) const {
        const int ti = i >> 2, sub = i & 3; const int L = ti * G + c; if (L >= 128 * 4) return false;
        int pm, pn; pg8::tile_map(L, 128, 4, pm, pn);
        const size_t ao = sub == 1 ? WS_RV : sub == 3 ? WS_NQ : WS_H; const size_t bo = sub == 0 ? W_GA : sub == 1 ? W_RO : sub == 2 ? W_GB : W_NO;
        u.A = (sub == 3 ? nsa : (const char*)ws + ao) + (size_t)pm * 256 * D * 2; u.B = (const char*)ws + bo + (size_t)pn * 256 * D * 2; u.pm = pm; u.pn = pn; u.kind = sub; u.rows = nullptr; u.nvalid = 0; u.aux = 0; return true;
    }
};
struct EpiP4 {
    static constexpr bool PERM = true;
    float* scr;
    bf16* Y;
    static __device__ __forceinline__ u32x2 pk4(const f32x4 v) { return (u32x2){cvt_pk_bf16(v[0], v[1]), cvt_pk_bf16(v[2], v[3])}; }
    static __device__ __forceinline__ f32x4 up4(const u32x2 w) { return (f32x4){lo16(w.x), hi16(w.x), lo16(w.y), hi16(w.y)}; }
    __device__ __forceinline__ void operator()(const f32x4 (&acc)[2][2][4][2], const GU& u, int wr, int wc, int fr, int fq) const {
        u32x2* p0 = (u32x2*)scr + threadIdx.x; u32x2* p1 = p0 + 32 * 512;
        if (u.kind == 0 || u.kind == 2) {
            u32x2* p = u.kind == 0 ? p0 : p1;
#pragma unroll
            for (int ai = 0; ai < 2; ++ai)
#pragma unroll
                for (int m = 0; m < 4; ++m) {
#pragma unroll
                    for (int bj = 0; bj < 2; ++bj) { f32x4 v0 = acc[ai][bj][m][0], v1 = acc[ai][bj][m][1];
#pragma unroll
                        for (int j = 0; j < 4; ++j) { v0[j] = sigmoidf_(v0[j]); v1[j] = sigmoidf_(v1[j]); }
                        p[(2 * bj) * 512] = pk4(v0); p[(2 * bj + 1) * 512] = pk4(v1); }
                    p += 4 * 512; LAUNDER(p); }
        } else if (u.kind == 1) {
#pragma unroll
            for (int ai = 0; ai < 2; ++ai)
#pragma unroll
                for (int m = 0; m < 4; ++m) {
#pragma unroll
                    for (int bj = 0; bj < 2; ++bj) { p0[(2 * bj) * 512] = pk4(up4(p0[(2 * bj) * 512]) * acc[ai][bj][m][0]); p0[(2 * bj + 1) * 512] = pk4(up4(p0[(2 * bj + 1) * 512]) * acc[ai][bj][m][1]); }
                    p0 += 4 * 512; LAUNDER(p0); }
        } else {
            bf16* yb = Y + (size_t)(u.pm * 256 + 64 * wr + fr) * D + u.pn * 256 + 32 * wc + 8 * fq;
#pragma unroll
            for (int ai = 0; ai < 2; ++ai)
#pragma unroll
                for (int m = 0; m < 4; ++m) {
#pragma unroll
                    for (int bj = 0; bj < 2; ++bj) {
                        const f32x4 v0 = up4(p0[(2 * bj) * 512]) + up4(p1[(2 * bj) * 512]) * acc[ai][bj][m][0], v1 = up4(p0[(2 * bj + 1) * 512]) + up4(p1[(2 * bj + 1) * 512]) * acc[ai][bj][m][1];
                        u32x4 w; w.x = cvt_pk_bf16(v0[0], v0[1]); w.y = cvt_pk_bf16(v0[2], v0[3]); w.z = cvt_pk_bf16(v1[0], v1[1]); w.w = cvt_pk_bf16(v1[2], v1[3]);
                        *(u32x4*)(yb + (size_t)(128 * ai + 16 * m) * D + 128 * bj) = w; }
                    p0 += 4 * 512; p1 += 4 * 512; LAUNDER(p0); LAUNDER(p1); }
        }
    }
};

struct SchedMN {
    unsigned char* ws; size_t ao, bo; int G, c;
    __device__ __forceinline__ bool next(int i, GU& u) const {
        const int L = i * G + c; if (L >= 128 * 4) return false; int pm, pn; pg8::tile_map(L, 128, 4, pm, pn);
        u.A = (const char*)ws + ao + (size_t)pm * 256 * D * 2; u.B = (const char*)ws + bo + (size_t)pn * 256 * D * 2; u.pm = pm; u.pn = pn; u.kind = 0; u.rows = nullptr; u.nvalid = 0; u.aux = 0; return true;
    }
};
template <bool SSQ> struct EpiRes {
    static constexpr bool PERM = true;
    const float* basef; const bf16* baseb; float* out; bf16* ob; float* ssq;
    __device__ __forceinline__ void operator()(const f32x4 (&acc)[2][2][4][2], const GU& u, int wr, int wc, int fr, int fq) const {
#pragma unroll
        for (int ai = 0; ai < 2; ++ai)
#pragma unroll
            for (int m = 0; m < 4; ++m) { const int r = u.pm * 256 + 128 * ai + 64 * wr + 16 * m + fr; const size_t off = (size_t)r * D + u.pn * 256 + 32 * wc + 8 * fq; float sq = 0.f;
#pragma unroll
                for (int bj = 0; bj < 2; ++bj) { const size_t o = off + 128 * bj; f32x4 b0, b1;
                    if (SSQ) { b0 = *(const f32x4*)(basef + o); b1 = *(const f32x4*)(basef + o + 4); }
                    else { const u32x4 bw = *(const u32x4*)(baseb + o); b0 = (f32x4){lo16(bw.x), hi16(bw.x), lo16(bw.y), hi16(bw.y)}; b1 = (f32x4){lo16(bw.z), hi16(bw.z), lo16(bw.w), hi16(bw.w)}; }
                    const f32x4 v0 = b0 + acc[ai][bj][m][0], v1 = b1 + acc[ai][bj][m][1];
                    if (!SSQ) { *(f32x4*)(out + o) = v0; *(f32x4*)(out + o + 4) = v1; }
                    u32x4 w; w.x = cvt_pk_bf16(v0[0], v0[1]); w.y = cvt_pk_bf16(v0[2], v0[3]); w.z = cvt_pk_bf16(v1[0], v1[1]); w.w = cvt_pk_bf16(v1[2], v1[3]); *(u32x4*)(ob + o) = w;
                    sq += ((v0[0] * v0[0] + v0[1] * v0[1]) + (v0[2] * v0[2] + v0[3] * v0[3])) + ((v1[0] * v1[0] + v1[1] * v1[1]) + (v1[2] * v1[2] + v1[3] * v1[3])); }
                if (SSQ) { sq += __shfl_xor(sq, 16); sq += __shfl_xor(sq, 32); if (fq == 0) ssq[(size_t)r * 16 + u.pn * 4 + wc] = sq; }
            }
    }
};
struct EpiQ {
    static constexpr bool PERM = true;
    const float* ssq; bf16* Q;
    __device__ __forceinline__ void operator()(const f32x4 (&acc)[2][2][4][2], const GU& u, int wr, int wc, int fr, int fq) const {
#pragma unroll
        for (int ai = 0; ai < 2; ++ai)
#pragma unroll
            for (int m = 0; m < 4; ++m) { const int r = u.pm * 256 + 128 * ai + 64 * wr + 16 * m + fr; const f32x4* sp = (const f32x4*)(ssq + (size_t)r * 16);
                const f32x4 a = sp[0], b = sp[1], c = sp[2], d = sp[3]; const float tot = ((a[0] + a[1]) + (a[2] + a[3])) + ((b[0] + b[1]) + (b[2] + b[3])) + ((c[0] + c[1]) + (c[2] + c[3])) + ((d[0] + d[1]) + (d[2] + d[3]));
                const float rstd = 1.0f / sqrtf(tot * (1.0f / D) + EPS);
#pragma unroll
                for (int bj = 0; bj < 2; ++bj) { const f32x4 v0 = acc[ai][bj][m][0] * rstd, v1 = acc[ai][bj][m][1] * rstd;
                    u32x4 w; w.x = cvt_pk_bf16(v0[0], v0[1]); w.y = cvt_pk_bf16(v0[2], v0[3]); w.z = cvt_pk_bf16(v1[0], v1[1]); w.w = cvt_pk_bf16(v1[2], v1[3]);
                    *(u32x4*)(Q + (size_t)r * D + u.pn * 256 + 128 * bj + 32 * wc + 8 * fq) = w; } }
    }
};

namespace xatf {
constexpr int KROW = 528, VROW = 136, KT_BYTES = 64 * KROW, OFF_K = 0, OFF_V = KT_BYTES;
constexpr float NEG = -1.0e30f, CS = 0.0625f * 1.4426950408889634f;
struct Stage { u32x4 k[4]; u32x4 v[2]; };
__device__ __forceinline__ void stage_load(Stage& st, const bf16* K, const bf16* VT, int key0, int tid) {
#pragma unroll
    for (int i = 0; i < 4; ++i) { const int p = tid + 512 * i, row = p >> 5, c = p & 31; st.k[i] = *(const u32x4*)(K + (size_t)(key0 + row) * 2048 + c * 8); }
#pragma unroll
    for (int i = 0; i < 2; ++i) { const int p = tid + 512 * i, d = p >> 3, c = p & 7; st.v[i] = *(const u32x4*)(VT + (size_t)d * 256 + key0 + c * 8); }
}
__device__ __forceinline__ void stage_write(const Stage& st, LAS unsigned char* lds, int tid) {
#pragma unroll
    for (int i = 0; i < 4; ++i) { const int p = tid + 512 * i, row = p >> 5, c = p & 31; *(LAS u32x4*)(lds + OFF_K + row * KROW + c * 16) = st.k[i]; }
#pragma unroll
    for (int i = 0; i < 2; ++i) { const int p = tid + 512 * i, d = p >> 3, c = p & 7; LAS unsigned char* q = lds + OFF_V + d * VROW + c * 16;
        *(LAS u32x2*)q = (u32x2){st.v[i].x, st.v[i].y}; *(LAS u32x2*)(q + 8) = (u32x2){st.v[i].z, st.v[i].w}; }
}
__device__ __forceinline__ void block_step(const LAS unsigned char* lds, const bf16x8 (&qf)[16], f32x16 (&O)[4], float& m, float& l, int lane) {
    const int r = lane & 31, hi = lane >> 5;
    f32x16 S[2];
#pragma unroll
    for (int kh = 0; kh < 2; ++kh) {
#pragma unroll
        for (int j = 0; j < 16; ++j) S[kh][j] = 0.f;
#pragma unroll
        for (int s_ = 0; s_ < 16; ++s_) { const bf16x8 a = *(const LAS bf16x8*)(lds + OFF_K + (kh * 32 + r) * KROW + (16 * s_ + 8 * hi) * 2); S[kh] = __builtin_amdgcn_mfma_f32_32x32x16_bf16(a, qf[s_], S[kh], 0, 0, 0); }
    }
    float mx = NEG;
#pragma unroll
    for (int kh = 0; kh < 2; ++kh)
#pragma unroll
        for (int j = 0; j < 16; ++j) { const float v = S[kh][j] * CS; S[kh][j] = v; mx = fmaxf(mx, v); }
    mx = fmaxf(mx, __shfl_xor(mx, 32));
    const float mn = fmaxf(m, mx); const float alpha = __builtin_amdgcn_exp2f(m - mn); m = mn; float rs = 0.f;
#pragma unroll
    for (int kh = 0; kh < 2; ++kh)
#pragma unroll
        for (int j = 0; j < 16; ++j) { const float p = __builtin_amdgcn_exp2f(S[kh][j] - mn); S[kh][j] = p; rs += p; }
    l = l * alpha + rs;
#pragma unroll
    for (int dt = 0; dt < 4; ++dt)
#pragma unroll
        for (int j = 0; j < 16; ++j) O[dt][j] *= alpha;
    bf16x8 pf[2][2];
#pragma unroll
    for (int kh = 0; kh < 2; ++kh)
#pragma unroll
        for (int s2 = 0; s2 < 2; ++s2) { u32x4 w; w.x = cvt_pk_bf16(S[kh][8 * s2 + 0], S[kh][8 * s2 + 1]); w.y = cvt_pk_bf16(S[kh][8 * s2 + 2], S[kh][8 * s2 + 3]); w.z = cvt_pk_bf16(S[kh][8 * s2 + 4], S[kh][8 * s2 + 5]); w.w = cvt_pk_bf16(S[kh][8 * s2 + 6], S[kh][8 * s2 + 7]);
            pf[kh][s2] = __builtin_bit_cast(bf16x8, w); }
#pragma unroll
    for (int dt = 0; dt < 4; ++dt)
#pragma unroll
        for (int kh = 0; kh < 2; ++kh)
#pragma unroll
            for (int s2 = 0; s2 < 2; ++s2) { const LAS unsigned char* vp = lds + OFF_V + (dt * 32 + r) * VROW + (32 * kh + 16 * s2 + 4 * hi) * 2;
                const u32x2 lo = *(const LAS u32x2*)vp, hi2 = *(const LAS u32x2*)(vp + 16); const u32x4 av = (u32x4){lo.x, lo.y, hi2.x, hi2.y};
                O[dt] = __builtin_amdgcn_mfma_f32_32x32x16_bf16(__builtin_bit_cast(bf16x8, av), pf[kh][s2], O[dt], 0, 0, 0); }
}
}
__device__ __forceinline__ void p7_xattn_fast(Frame& F, const bf16* vT, bf16* outbase) {
    using namespace xatf;
    bf16* Q = (bf16*)(F.ws + WS_NQ); const bf16* KV = (const bf16*)(F.ws + WS_MEMKV);
    const int tid = F.tid, lane = F.lane, wave = F.wave, r = lane & 31, hi = lane >> 5; LAS unsigned char* lds = F.lds;
    for (int u = F.bx; u < BATCH * 4 * 16; u += F.G) {
        const int tt = u & 15, bh = u >> 4, b = bh >> 2, h = bh & 3; const int tok = b * SEQ + tt * 256 + wave * 32 + r;
        bf16* qrow = Q + (size_t)tok * D + h * 256; bf16* orow = outbase + (size_t)tok * D + h * 256; const bf16* Kb = KV + (size_t)(b * NMEM) * 2048 + h * 256;
        bf16x8 qf[16];
        LAS unsigned char* tb_ = lds + 61440 + wave * 8704;
        bf16* rows0 = Q + (size_t)(b * SEQ + tt * 256 + wave * 32) * D + h * 256;
#pragma unroll
        for (int hq = 0; hq < 2; ++hq) {
#pragma unroll 4
            for (int k_ = 0; k_ < 8; ++k_) { const int rr_ = 4 * k_ + (lane >> 4), ch_ = lane & 15; *(LAS u32x4*)(tb_ + rr_ * 272 + ch_ * 16) = *(const u32x4*)(rows0 + (size_t)rr_ * D + hq * 128 + ch_ * 8); }
            LDS_WAIT(); asm volatile("" ::: "memory");
#pragma unroll
            for (int s_ = 0; s_ < 8; ++s_) qf[8 * hq + s_] = *(const LAS bf16x8*)(tb_ + r * 272 + (16 * s_ + 8 * hi) * 2);
            LDS_WAIT(); asm volatile("" ::: "memory");
        }
        const bf16* VT0 = vT + (size_t)bh * 256 * 256;
        Stage st; stage_load(st, Kb, VT0, 0, tid);
        f32x16 O[4]; float m = NEG, l = 0.f;
        for (int idx = 0; idx < 8; ++idx) {
            const int half = idx >> 2, j = idx & 3;
            if (j == 0) { m = NEG; l = 0.f;
#pragma unroll
                for (int dt = 0; dt < 4; ++dt)
#pragma unroll
                    for (int jj = 0; jj < 16; ++jj) O[dt][jj] = 0.f; }
            __syncthreads(); stage_write(st, lds, tid);
            { const int i2 = idx < 7 ? idx + 1 : idx; stage_load(st, Kb, VT0 + (size_t)((i2 >> 2) * 128) * 256, (i2 & 3) * 64, tid); }
            __syncthreads();
            block_step(lds, qf, O, m, l, lane);
            if (j == 3) {
                l += __shfl_xor(l, 32); const float inv = 1.0f / l;
#pragma unroll
                for (int dt = 0; dt < 4; ++dt)
#pragma unroll
                    for (int q4 = 0; q4 < 4; ++q4) *(LAS u32x2*)(tb_ + r * 272 + (32 * dt + 8 * q4 + 4 * hi) * 2) = (u32x2){cvt_pk_bf16(O[dt][4 * q4] * inv, O[dt][4 * q4 + 1] * inv), cvt_pk_bf16(O[dt][4 * q4 + 2] * inv, O[dt][4 * q4 + 3] * inv)};
                LDS_WAIT(); asm volatile("" ::: "memory");
#pragma unroll 2
                for (int k_ = 0; k_ < 8; ++k_) { const int rr_ = 4 * k_ + (lane >> 4), ch_ = lane & 15; *(u32x4*)(rows0 + (size_t)rr_ * D + half * 128 + ch_ * 8) = *(const LAS u32x4*)(tb_ + rr_ * 272 + ch_ * 16); }
                LDS_WAIT(); asm volatile("" ::: "memory");
            }
        }
    }
    __syncthreads();
}
__device__ __forceinline__ void transpose_memv_tiles(Frame& F, bf16* vT, int w0, int nw) {
    LAS unsigned short* tl_ = (LAS unsigned short*)(F.lds + F.wave * 16384); const int lane = F.lane; const bf16* KV = (const bf16*)(F.ws + WS_MEMKV);
    for (int tile = w0; tile < 32 * 16; tile += nw) {
        const int dq = tile & 3, kq = (tile >> 2) & 3, bh = tile >> 4, b = bh >> 2, h = bh & 3;
        const bf16* sp = KV + (size_t)(b * NMEM + kq * 64) * 2048 + 1024 + h * 256 + dq * 64; bf16* dp = vT + ((size_t)bh * 256 + dq * 64) * 256 + kq * 64;
#pragma unroll
        for (int i = 0; i < 8; ++i) { const int row = i * 8 + (lane >> 3), c = lane & 7; const u32x4 v = *(const u32x4*)(sp + (size_t)row * 2048 + c * 8); LAS unsigned short* q = tl_ + row * 66 + c * 8;
            q[0] = (unsigned short)(v.x & 0xffffu); q[1] = (unsigned short)(v.x >> 16); q[2] = (unsigned short)(v.y & 0xffffu); q[3] = (unsigned short)(v.y >> 16);
            q[4] = (unsigned short)(v.z & 0xffffu); q[5] = (unsigned short)(v.z >> 16); q[6] = (unsigned short)(v.w & 0xffffu); q[7] = (unsigned short)(v.w >> 16); }
        LDS_WAIT(); asm volatile("" ::: "memory");
#pragma unroll
        for (int i = 0; i < 8; ++i) { const int d = i * 8 + (lane >> 3), c = lane & 7; const LAS unsigned short* q = tl_ + (c * 8) * 66 + d;
            u32x4 o; o.x = (unsigned)q[0] | ((unsigned)q[66] << 16); o.y = (unsigned)q[2 * 66] | ((unsigned)q[3 * 66] << 16); o.z = (unsigned)q[4 * 66] | ((unsigned)q[5 * 66] << 16); o.w = (unsigned)q[6 * 66] | ((unsigned)q[7 * 66] << 16);
            *(u32x4*)(dp + (size_t)d * 256 + c * 8) = o; }
        LDS_WAIT(); asm volatile("" ::: "memory");
    }
}

__device__ __forceinline__ void p9_route(Frame& F, const Args& a) {
    unsigned char* ws = F.ws; const float* X2 = a.out;
    const float* gff = a.in[IN_NORM_FFN_G]; const float* wgrp = a.in[IN_W_GRP]; const float* bgrp = a.in[IN_B_GRP]; const float* wrt = a.in[IN_W_RT]; const float* brt = a.in[IN_B_RT];
    float* wts = (float*)(ws + WS_ROUTE); float* rstd2 = wts + 2 * NTOK; int* lists = (int*)(ws + WS_LISTS);
    const int gw = F.bx * NWAVES + F.wave, NGW = F.G * NWAVES, lane = F.lane;
    const f32x4* wgp = (const f32x4*)(ws + WS_RTW); const f32x4* wep = wgp + 1024;
    float xn[16];
    if (gw < NTOK) {
#pragma unroll
        for (int i = 0; i < 16; ++i) xn[i] = X2[(size_t)gw * D + 64 * i + lane]; }
    int my_ea = -1, my_eb = -1, my_tok = -1, it_ = 0; float my_w1 = 0.f, my_w2 = 0.f, my_rstd = 0.f;
    for (int tok = gw; tok < NTOK; tok += NGW, ++it_) {
        float xa[16]; float s = 0.f;
#pragma unroll
        for (int i = 0; i < 16; ++i) { xa[i] = xn[i]; s += xa[i] * xa[i]; }
        if (tok + NGW < NTOK) {
#pragma unroll
            for (int i = 0; i < 16; ++i) xn[i] = X2[(size_t)(tok + NGW) * D + 64 * i + lane]; }
        const float rstd = 1.0f / sqrtf(wave_sum(s) * (1.f / D) + EPS);
        float lg[4] = {0.f, 0.f, 0.f, 0.f};
#pragma unroll
        for (int i = 0; i < 16; ++i) { const f32x4 wg = wgp[64 * i + lane];
#pragma unroll
            for (int c = 0; c < 4; ++c) lg[c] += xa[i] * wg[c]; }
#pragma unroll
        for (int i = 0; i < 4; ++i) lg[i] = rstd * wave_sum(lg[i]) + bgrp[i];
        int grp = 0; float gm = lg[0];
#pragma unroll
        for (int i = 1; i < 4; ++i) if (lg[i] > gm) { gm = lg[i]; grp = i; }
        grp = __builtin_amdgcn_readfirstlane(grp);
        float gs = 0.f;
#pragma unroll
        for (int i = 0; i < 4; ++i) gs += expf(lg[i] - gm);
        const float g_gate = 1.0f / gs;
        float lq[8];
#pragma unroll
        for (int i = 0; i < 8; ++i) lq[i] = 0.f;
        const f32x4* pwe = wep + (size_t)grp * (16 * 2 * 64) + lane;
#pragma unroll
        for (int i = 0; i < 16; ++i) { const f32x4 wa = pwe[(2 * i) * 64], wb = pwe[(2 * i + 1) * 64];
#pragma unroll
            for (int c = 0; c < 4; ++c) { lq[c] += xa[i] * wa[c]; lq[4 + c] += xa[i] * wb[c]; } }
#pragma unroll
        for (int i = 0; i < 8; ++i) lq[i] = rstd * wave_sum(lq[i]) + brt[grp * 8 + i];
        int i1 = 0; float m1 = lq[0];
#pragma unroll
        for (int i = 1; i < 8; ++i) if (lq[i] > m1) { m1 = lq[i]; i1 = i; }
        int i2 = -1; float m2 = -3.0e38f;
#pragma unroll
        for (int i = 0; i < 8; ++i) if (i != i1 && lq[i] > m2) { m2 = lq[i]; i2 = i; }
        const float e2 = expf(m2 - m1), den = 1.0f + e2; const float w1 = g_gate / den, w2 = g_gate * e2 / den;
        if (lane == it_) { my_ea = grp * 8 + i1; my_eb = grp * 8 + i2; my_tok = tok; my_w1 = w1; my_w2 = w2; my_rstd = rstd; }
    }
    LAS unsigned* cnt = (LAS unsigned*)(F.lds + MISC_OFF + 1024); LAS unsigned* base = cnt + 32;
    __syncthreads();
    if (F.tid < 32) cnt[F.tid] = 0u;
    __syncthreads();
    unsigned pa = 0u, pb = 0u;
    if (my_tok >= 0) { pa = __hip_atomic_fetch_add(cnt + my_ea, 1u, __ATOMIC_RELAXED, __HIP_MEMORY_SCOPE_WORKGROUP); pb = __hip_atomic_fetch_add(cnt + my_eb, 1u, __ATOMIC_RELAXED, __HIP_MEMORY_SCOPE_WORKGROUP); }
    __syncthreads();
    if (F.tid < 32) { const unsigned c = cnt[F.tid]; base[F.tid] = c ? __hip_atomic_fetch_add(F.ctl + CW_ECNT + 64 * F.tid, c, __ATOMIC_RELAXED, __HIP_MEMORY_SCOPE_AGENT) : 0u; }
    __syncthreads();
    if (my_tok >= 0) {
        lists[(size_t)my_ea * NTOK + base[my_ea] + pa] = my_tok * 2; lists[(size_t)my_eb * NTOK + base[my_eb] + pb] = my_tok * 2 + 1;
        wts[my_tok * 2] = my_w1; wts[my_tok * 2 + 1] = my_w2; rstd2[my_tok] = my_rstd;
    }
    __syncthreads();
}
__device__ __forceinline__ void moe_tiles(Frame& F) {
    __syncthreads();
    if (F.tid < NEXP) F.MISC[64 + F.tid] = __hip_atomic_load(F.ctl + CW_ECNT + 64 * F.tid, __ATOMIC_RELAXED, __HIP_MEMORY_SCOPE_AGENT);
    __syncthreads();
    if (F.tid == 0) { unsigned accu = 0u; for (int e = 0; e < NEXP; ++e) { const unsigned c = F.MISC[64 + e]; F.MISC[16 + e] = accu; accu += (c + 255u) >> 8; } F.MISC[16 + NEXP] = accu; }
    __syncthreads();
}
template <int WHICH> struct SchedMoe {
    volatile LAS unsigned* MISC; unsigned char* ws; int G, c;
    __device__ __forceinline__ bool next(int i, GU& u) const {
        const int L = G == 256 ? i * G + (c & 7) * 32 + (c >> 3) : i * G + c; const int T = (int)MISC[16 + NEXP]; if (L >= 4 * T) return false;
        const int tau = L >> 2, pn = L & 3;
        const int ln_ = threadIdx.x & 63; const int st_ = (ln_ >= 1 && ln_ < NEXP) ? (int)MISC[16 + ln_] : 0x7fffffff;
        const int e = __popcll(__ballot(st_ <= tau));
        const int lt = tau - (int)MISC[16 + e]; const int cnt = (int)MISC[64 + e]; int nv = cnt - lt * 256; nv = nv > 256 ? 256 : nv;
        u.rows = (const int*)(ws + WS_LISTS) + (size_t)e * NTOK + lt * 256; u.nvalid = nv; u.pm = tau; u.pn = pn; u.kind = 0; u.aux = e;
        if (WHICH == 0) { u.A = (const char*)ws + WS_X2B; u.B = (const char*)ws + WS_W13 + (size_t)e * D * D * 2 + (size_t)pn * 256 * D * 2; }
        else { u.A = (const char*)ws + WS_H1 + (size_t)tau * 256 * DEXP * 2; u.B = (const char*)ws + WS_W2 + (size_t)e * D * DEXP * 2 + (size_t)pn * 256 * DEXP * 2; }
        return true;
    }
};
struct EpiMoe1 {
    static constexpr bool PERM = true;
    const float* rstd2; bf16* H1;
    __device__ __forceinline__ void operator()(const f32x4 (&acc)[2][2][4][2], const GU& u, int wr, int wc, int fr, int fq) const {
        char* hb = (char*)H1 + (size_t)u.pm * 256 * DEXP * 2;
        const int j00 = (u.pn * 256 + 32 * wc + 8 * fq) >> 1;
#pragma unroll
        for (int ai = 0; ai < 2; ++ai) {
            int r = 128 * ai + 64 * wr + fr; LAUNDER(r);
#pragma unroll
            for (int m = 0; m < 4; ++m) { const bool ok = r < u.nvalid; const float rs = ok ? rstd2[u.rows[r] >> 1] : 0.f;
#pragma unroll
                for (int bj = 0; bj < 2; ++bj) { const f32x4 a1 = acc[ai][bj][m][0] * rs, a3 = acc[ai][bj][m][1] * rs; f32x4 hv;
#pragma unroll
                    for (int j = 0; j < 4; ++j) hv[j] = a1[j] * sigmoidf_(a1[j]) * a3[j];
                    u32x2 w; w.x = cvt_pk_bf16(hv[0], hv[1]); w.y = cvt_pk_bf16(hv[2], hv[3]); *(u32x2*)(hb + (unsigned)((r * DEXP + j00 + 64 * bj) * 2)) = w; }
                r += 16; LAUNDER(r); }
        }
    }
};
struct EpiMoe2 {
    static constexpr bool PERM = true;
    const float* wts; bf16* Y0; bf16* Y1;
    __device__ __forceinline__ void operator()(const f32x4 (&acc)[2][2][4][2], const GU& u, int wr, int wc, int fr, int fq) const {
        int ent[8]; float w8[8];
#pragma unroll
        for (int i = 0; i < 8; ++i) { const int r = 128 * (i >> 2) + 64 * wr + 16 * (i & 3) + fr; ent[i] = r < u.nvalid ? u.rows[r] : -1; }
#pragma unroll
        for (int i = 0; i < 8; ++i) w8[i] = ent[i] >= 0 ? wts[ent[i]] : 0.f;
#pragma unroll
        for (int i = 0; i < 8; ++i) { const int ai = i >> 2, m = i & 3;
            if (ent[i] >= 0) { bf16* dst = ((ent[i] & 1) ? Y1 : Y0) + (size_t)(ent[i] >> 1) * D + u.pn * 256 + 32 * wc + 8 * fq;
#pragma unroll
                for (int bj = 0; bj < 2; ++bj) { const f32x4 v0 = acc[ai][bj][m][0] * w8[i], v1 = acc[ai][bj][m][1] * w8[i];
                    u32x4 w; w.x = cvt_pk_bf16(v0[0], v0[1]); w.y = cvt_pk_bf16(v0[2], v0[3]); w.z = cvt_pk_bf16(v1[0], v1[1]); w.w = cvt_pk_bf16(v1[2], v1[3]);
                    *(u32x4*)(dst + 128 * bj) = w; } } }
    }
};

__device__ __forceinline__ void p12_final(Frame& F, const Args& a) {
    const bf16* Y0 = (const bf16*)(F.ws + WS_YS0); const bf16* Y1 = (const bf16*)(F.ws + WS_YS1); const bf16* X2 = (const bf16*)(F.ws + WS_X2B); const float* g = a.in[IN_NORM_F_G];
    const int gw = F.bx * NWAVES + F.wave, NGW = F.G * NWAVES, lane = F.lane;
    for (int tok = gw; tok < NTOK; tok += NGW) {
        f32x4* xr = (f32x4*)(a.out + (size_t)tok * D) + lane; const u32x2* x2 = (const u32x2*)(X2 + (size_t)tok * D) + lane; const u32x2* y0 = (const u32x2*)(Y0 + (size_t)tok * D) + lane; const u32x2* y1 = (const u32x2*)(Y1 + (size_t)tok * D) + lane;
        f32x4 v[4]; float s = 0.f;
#pragma unroll
        for (int j = 0; j < 4; ++j) { const u32x2 xx = x2[64 * j], p = y0[64 * j], q = y1[64 * j];
            v[j].x = lo16(xx.x) + (lo16(p.x) + lo16(q.x)); v[j].y = hi16(xx.x) + (hi16(p.x) + hi16(q.x)); v[j].z = lo16(xx.y) + (lo16(p.y) + lo16(q.y)); v[j].w = hi16(xx.y) + (hi16(p.y) + hi16(q.y));
            s += (v[j].x * v[j].x + v[j].y * v[j].y) + (v[j].z * v[j].z + v[j].w * v[j].w); }
        const float rstd = 1.0f / sqrtf(wave_sum(s) * (1.f / D) + EPS);
#pragma unroll
        for (int j = 0; j < 4; ++j) { const f32x4 gg = ((const f32x4*)g + lane)[64 * j]; xr[64 * j] = v[j] * rstd * gg; }
    }
}

constexpr int N_PHASES = 14;
__global__ void __launch_bounds__(NTHREADS, 2) fwd(Args args) {
    extern __shared__ __attribute__((aligned(16))) unsigned char lds[];
    Frame F;
    F.lds = (LAS unsigned char*)lds; F.MISC = (volatile LAS unsigned*)(F.lds + MISC_OFF);
    F.tid = threadIdx.x; F.lane = F.tid & 63; F.wave = __builtin_amdgcn_readfirstlane(F.tid >> 6); F.G = gridDim.x; F.bx = blockIdx.x;
    F.ws = args.ws; F.ctl = (unsigned*)(args.ws + WS_CTL);
    unsigned char* ws = args.ws;
    for (int u = F.tid; u < (LDS_BYTES - RING_BYTES) / 4; u += NTHREADS) ((LAS unsigned*)(F.lds + RING_BYTES))[u] = 0u;
    __syncthreads();
    const int lo = args.ph_lo, hi = args.ph_hi;
    const bool one = (hi - lo) > 1;
    XcdBarrier bar; bar.bar = F.ctl + CW_BAR; bar.x = 0; bar.st = F.MISC + 8;
    if (one) bar = xcd_barrier_post(F.ctl + CW_BAR, F.MISC + 8);
#define IN(k) (lo <= (k) && (k) < hi && phase_begin(F))
#define SEAM(k) do { if (lo <= (k) && (k) + 1 < hi) xcd_barrier(bar); } while (0)

    if (IN(0)) { p0_prologue(F, args); } SEAM(0);
    if (IN(1)) {
        SchedP1 S{ws, F.G, F.bx};
        EpiP1 E{ws};
        pg8::gemm_phase<EpiP1, SchedP1, false>(F.lds, D, D, D, S, E);
        p1_gate_logits(F);
    } SEAM(1);
    if (IN(2)) {
        p2_retention_fast(F, F.bx, (bf16*)(ws + WS_RV));
        { const int w0 = F.bx * NWAVES + F.wave, nw = F.G * NWAVES;
            transpose_kv_tiles(F, (const bf16*)(ws + WS_KV6 + 3 * KV_STRIDE), (bf16*)args.out, w0, nw);
            transpose_kv_tiles(F, (const bf16*)(ws + WS_KV6 + 5 * KV_STRIDE), (bf16*)((unsigned char*)args.out + KV_STRIDE), w0, nw);
            transpose_memv_tiles(F, (bf16*)(ws + WS_MEMVT), w0, nw); }
        __syncthreads();
        { SchedCmp S{ws, 0, F.G, F.bx}; EpiCmp E{(float*)args.out + (size_t)16 * MiB};
            pg8::gemm_phase<EpiCmp, SchedCmp, false>(F.lds, 512, 2048, 4096, S, E); }
    } SEAM(2);
    if (IN(3)) { p2b_compress_out(F, args); } SEAM(3);
    if (IN(4)) { p3_ret_normalize(F); p3_nsa_fast(F, (const bf16*)args.out, (const bf16*)((const unsigned char*)args.out + KV_STRIDE), (bf16*)((unsigned char*)args.out + 64 * MiB)); } SEAM(4);
    if (IN(5)) {
        SchedP4 S{ws, F.G, F.bx, (const char*)args.out + 64 * MiB};
        EpiP4 E{(float*)(ws + WS_P4SCR) + (size_t)F.bx * (2 * 32 * 512 * 4), (bf16*)(ws + WS_Y)};
        pg8::gemm_phase<EpiP4, SchedP4, false>(F.lds, D, D, D, S, E);
    } SEAM(5);
    if (IN(6)) {
        SchedMN S{ws, WS_Y, W_OUT, F.G, F.bx}; EpiRes<true> E{args.in[IN_X], nullptr, nullptr, (bf16*)(ws + WS_X1B), (float*)(ws + WS_SSQ)};
        pg8::gemm_phase<EpiRes<true>, SchedMN, false>(F.lds, D, D, D, S, E);
    } SEAM(6);
    if (IN(7)) {
        const bool early = ((F.bx >> 3) & 1) == 0;
        if (early) expert_copies(F, args, 0, NEXP / 2);
        SchedMN S{ws, WS_X1B, W_XQ, F.G, F.bx}; EpiQ E{(const float*)(ws + WS_SSQ), (bf16*)(ws + WS_NQ)};
        pg8::gemm_phase<EpiQ, SchedMN, false>(F.lds, D, D, D, S, E);
        if (!early) { __syncthreads(); expert_copies(F, args, 0, NEXP / 2); }
    } SEAM(7);
    if (IN(8)) { p7_xattn_fast(F, (const bf16*)(ws + WS_MEMVT), (bf16*)(ws + WS_NQ)); } SEAM(8);
    if (IN(9)) {
        const bool early = ((F.bx >> 3) & 1) == 0;
        if (early) expert_copies(F, args, NEXP / 2, NEXP);
        SchedMN S{ws, WS_NQ, W_XO, F.G, F.bx}; EpiRes<false> E{nullptr, (const bf16*)(ws + WS_X1B), args.out, (bf16*)(ws + WS_X2B), nullptr};
        pg8::gemm_phase<EpiRes<false>, SchedMN, false>(F.lds, D, D, D, S, E);
        if (!early) { __syncthreads(); expert_copies(F, args, NEXP / 2, NEXP); }
    } SEAM(9);
    if (IN(10)) { p9_route(F, args); } SEAM(10);
    if (IN(11)) {
        moe_tiles(F);
        SchedMoe<0> S{F.MISC, ws, F.G, F.bx}; EpiMoe1 E{(const float*)(ws + WS_ROUTE) + 2 * NTOK, (bf16*)(ws + WS_H1)};
        pg8::gemm_phase<EpiMoe1, SchedMoe<0>, true>(F.lds, D, D, D, S, E);
    } SEAM(11);
    if (IN(12)) {
        moe_tiles(F);
        SchedMoe<1> S{F.MISC, ws, F.G, F.bx}; EpiMoe2 E{(const float*)(ws + WS_ROUTE), (bf16*)(ws + WS_YS0), (bf16*)(ws + WS_YS1)};
        pg8::gemm_phase<EpiMoe2, SchedMoe<1>, false>(F.lds, DEXP, DEXP, DEXP, S, E);
    } SEAM(12);
    if (IN(13)) { p12_final(F, args); }
#undef IN
#undef SEAM
}

extern "C" void kernel_launch(void* const* d_in, const int* in_sizes, int n_in, void* d_out, int out_size, void* d_ws, size_t ws_size, hipStream_t stream) {
    static int grid = 0;
    if (grid == 0) {
        if (n_in != 27 || in_sizes[0] != NTOK * D || out_size != NTOK * D || ws_size < WS_END) {
            fprintf(stderr, "kernel_launch: unexpected shapes: n_in %d in0 %d out %d ws %zu (need %zu)\n", n_in, n_in > 0 ? in_sizes[0] : -1, out_size, ws_size, (size_t)WS_END); grid = -1; return; }
        int dev = 0, cus = 0, per_cu = 0;
        if (hipGetDevice(&dev) != hipSuccess || hipDeviceGetAttribute(&cus, hipDeviceAttributeMultiprocessorCount, dev) != hipSuccess) { grid = -1; return; }
        if (hipFuncSetAttribute((const void*)fwd, hipFuncAttributeMaxDynamicSharedMemorySize, LDS_BYTES) != hipSuccess) { fprintf(stderr, "kernel_launch: hipFuncSetAttribute failed\n"); grid = -1; return; }
        if (hipOccupancyMaxActiveBlocksPerMultiprocessor(&per_cu, (const void*)fwd, NTHREADS, LDS_BYTES) != hipSuccess || per_cu < 1) fprintf(stderr, "kernel_launch: occupancy query reports %d\n", per_cu);
        (void)hipGetLastError();
        grid = cus < 256 ? cus : 256;
    }
    if (grid < 0) return;
    (void)hipMemsetAsync((char*)d_ws + WS_CTL, 0, CTL_ZERO_BYTES, stream);
    Args a{};
    for (int i = 0; i < 27; ++i) a.in[i] = (const float*)d_in[i];
    a.out = (float*)d_out; a.ws = (unsigned char*)d_ws;
#if MK_N_LAUNCHES == 1
    a.ph_lo = 0; a.ph_hi = N_PHASES;
    hipLaunchKernelGGL(fwd, dim3(grid), dim3(NTHREADS), LDS_BYTES, stream, a);
#else
    for (int p = 0; p < N_PHASES; ++p) { a.ph_lo = p; a.ph_hi = p + 1; hipLaunchKernelGGL(fwd, dim3(grid), dim3(NTHREADS), LDS_BYTES, stream, a); }
#endif
}
```
